# Optimizing an MI355X kernel written in HIP

```python
import math
import jax, jax.numpy as jnp
from jax import lax
import numpy as np

D_MODEL = 1024
BATCH = 2
SEQ = 16384
DEPTH = 4

HEAD_DIM = 64
FOX_W = D_MODEL // 2
RWKV_W = D_MODEL // 4
RET_W = D_MODEL // 4
MIX_W = FOX_W + RWKV_W + RET_W
FOX_HEADS = FOX_W // HEAD_DIM
RWKV_HEADS = RWKV_W // HEAD_DIM
RET_HEADS = RET_W // HEAD_DIM
Q_BLOCK = 128
RET_CHUNK = 128
W_LORA = 64
A_LORA = 64
G_LORA = 128
LORA_W = W_LORA + A_LORA + G_LORA
ROPE_BASE = 10000.0
IN_SPLITS = (FOX_W, FOX_W, FOX_W, FOX_HEADS,
             RWKV_W, RWKV_W, RWKV_W, W_LORA, A_LORA, G_LORA,
             RET_W, RET_W, RET_W, RET_W)
IN_W = sum(IN_SPLITS)
N_GROUPS = 4
EXPERTS_PER_GROUP = 8
N_EXPERTS = N_GROUPS * EXPERTS_PER_GROUP
TOP_K = 2
D_EXPERT = 512
MOE_BLOCK = 128
ALPHA = (2.0 * DEPTH) ** 0.25
BETA = (8.0 * DEPTH) ** -0.25
LN_EPS = 1e-5
RWKV_GN_EPS = 64e-5
RET_GN_EPS = 1e-6

kernel_name = "hybrid_fox_rwkv7_retnet_hmoe_deepnorm"

F32 = jnp.float32


def split_columns(p, sizes):
    outs = []
    start = 0
    for s in sizes:
        outs.append(p[..., start:start + s])
        start += s
    return outs


def layer_norm(x, g, b):
    xf = x.astype(F32)
    mu = jnp.mean(xf, -1, keepdims=True)
    var = jnp.mean(jnp.square(xf - mu), -1, keepdims=True)
    return ((xf - mu) * lax.rsqrt(var + LN_EPS) * g + b).astype(x.dtype)


def head_norm(y, eps):
    yf = y.astype(F32)
    mu = jnp.mean(yf, -1, keepdims=True)
    var = jnp.mean(jnp.square(yf - mu), -1, keepdims=True)
    return (yf - mu) * lax.rsqrt(var + eps)


def fox_attention(q, k, v, f_logit):
    B_, S_, H, Dh = q.shape
    c = jnp.cumsum(jax.nn.log_sigmoid(f_logit.astype(F32)), axis=1)
    c = c.transpose(0, 2, 1)
    qh = q.transpose(0, 2, 1, 3)
    kh = k.transpose(0, 2, 1, 3)
    vh = v.transpose(0, 2, 1, 3)
    scale = Dh ** -0.5
    kpos = jnp.arange(S_)
    n_blk = S_ // Q_BLOCK

    def one_block(i):
        start = i * Q_BLOCK
        qb = lax.dynamic_slice_in_dim(qh, start, Q_BLOCK, axis=2)
        cb = lax.dynamic_slice_in_dim(c, start, Q_BLOCK, axis=2)
        s = jnp.einsum('bhqd,bhkd->bhqk', qb, kh).astype(F32) * scale
        s = s + cb[..., :, None] - c[..., None, :]
        qpos = start + jnp.arange(Q_BLOCK)
        s = jnp.where(kpos[None, :] <= qpos[:, None], s, -jnp.inf)
        p = jax.nn.softmax(s, axis=-1).astype(vh.dtype)
        return jnp.einsum('bhqk,bhkd->bhqd', p, vh)

    out = lax.map(one_block, jnp.arange(n_blk))
    out = out.transpose(1, 0, 3, 2, 4)
    return out.reshape(B_, S_, H * Dh)


def rwkv7_time_mix(r, k, v, wd, ad, gd, mu_rkv, mu_lora, w0, w2, a0, a2, g2,
                   k_k, k_a, r_k, ln_g, ln_b):
    B_, S_, _ = r.shape
    H, N = RWKV_HEADS, HEAD_DIM

    def shift_mix(p, mu):
        prev = jnp.pad(p, ((0, 0), (1, 0), (0, 0)))[:, :-1]
        return p + (prev - p) * mu

    r = shift_mix(r, mu_rkv[0]).astype(F32)
    k = shift_mix(k, mu_rkv[1]).astype(F32)
    v = shift_mix(v, mu_rkv[2]).astype(F32)
    lora = shift_mix(jnp.concatenate([wd, ad, gd], axis=-1), mu_lora).astype(F32)
    wd, ad, gd = split_columns(lora, (W_LORA, A_LORA, G_LORA))
    log_w = -jax.nn.softplus(-(w0 + jnp.tanh(wd) @ w2)) - 0.5
    decay = jnp.exp(-jnp.exp(log_w))
    a = jax.nn.sigmoid(a0 + ad @ a2)
    g = jax.nn.sigmoid(gd) @ g2
    kk = (k * k_k).reshape(B_, S_, H, N)
    kk = kk / jnp.maximum(jnp.sqrt(jnp.sum(kk * kk, -1, keepdims=True)), 1e-12)
    k = k * (1.0 + (a - 1.0) * k_a)
    rh = r.reshape(B_, S_, H, N)
    kh = k.reshape(B_, S_, H, N)
    vh = v.reshape(B_, S_, H, N)
    wh = decay.reshape(B_, S_, H, N)
    ah = a.reshape(B_, S_, H, N)

    def step(state, inp):
        r_t, w_t, k_t, v_t, kk_t, a_t = inp
        sa = jnp.einsum('bhvk,bhk->bhv', state, -kk_t)
        state = (state * w_t[:, :, None, :]
                 + sa[..., None] * (kk_t * a_t)[:, :, None, :]
                 + v_t[..., None] * k_t[:, :, None, :])
        return state, jnp.einsum('bhvk,bhk->bhv', state, r_t)

    xs = (jnp.moveaxis(rh, 1, 0), jnp.moveaxis(wh, 1, 0), jnp.moveaxis(kh, 1, 0),
          jnp.moveaxis(vh, 1, 0), jnp.moveaxis(kk, 1, 0), jnp.moveaxis(ah, 1, 0))
    s0 = jnp.zeros((B_, H, N, N), F32)
    _, y = lax.scan(step, s0, xs)
    y = jnp.moveaxis(y, 0, 1)
    y = head_norm(y, RWKV_GN_EPS) * ln_g.reshape(H, N) + ln_b.reshape(H, N)
    y = y + jnp.sum(rh * kh * r_k, -1, keepdims=True) * vh
    return y.reshape(B_, S_, RWKV_W) * g


def rotary(x, pos):
    d = x.shape[-1]
    half = d // 2
    inv = ROPE_BASE ** (-jnp.arange(half, dtype=F32) / half)
    ang = pos[:, None] * inv[None, :]
    cos, sin = jnp.cos(ang), jnp.sin(ang)
    xf = x.astype(F32)
    x1, x2 = xf[..., :half], xf[..., half:]
    return jnp.concatenate([x1 * cos - x2 * sin, x1 * sin + x2 * cos], axis=-1)


def retention(q, k, v, g, gn_g):
    B_, S_, _ = q.shape
    H, d, C = RET_HEADS, HEAD_DIM, RET_CHUNK
    n_chunk = S_ // C
    to_heads = lambda t: t.reshape(B_, S_, H, d).transpose(0, 2, 1, 3)
    pos = jnp.arange(S_, dtype=F32)
    qh = rotary(to_heads(q), pos)
    kh = rotary(to_heads(k), pos) * (d ** -0.5)
    vh = to_heads(v).astype(F32)
    qc = qh.reshape(B_, H, n_chunk, C, d)
    kc = kh.reshape(B_, H, n_chunk, C, d)
    vc = vh.reshape(B_, H, n_chunk, C, d)
    log_gamma = jnp.log1p(-jnp.exp2(-5.0 - jnp.arange(H, dtype=F32)))
    idx = jnp.arange(C, dtype=F32)
    diff = idx[:, None] - idx[None, :]
    dmask = jnp.where(diff >= 0, jnp.exp(jnp.maximum(diff, 0.0) * log_gamma[:, None, None]), 0.0)
    scores = jnp.einsum('bhncd,bhnsd->bhncs', qc, kc) * dmask[None, :, None]
    y_intra = jnp.einsum('bhncs,bhnse->bhnce', scores, vc)
    k_dec = jnp.exp((C - 1.0 - idx)[None, :] * log_gamma[:, None])
    q_dec = jnp.exp((idx + 1.0)[None, :] * log_gamma[:, None])
    kv = jnp.einsum('bhncd,bhnce->bhnde', kc * k_dec[None, :, None, :, None], vc)
    chunk_decay = jnp.exp(C * log_gamma)[None, :, None, None]

    def step(R, kv_n):
        return R * chunk_decay + kv_n, R

    _, R_prev = lax.scan(step, jnp.zeros((B_, H, d, d), F32), jnp.moveaxis(kv, 2, 0))
    R_prev = jnp.moveaxis(R_prev, 0, 2)
    y_cross = jnp.einsum('bhncd,bhnde->bhnce', qc * q_dec[None, :, None, :, None], R_prev)
    y = (y_intra + y_cross).reshape(B_, H, S_, d).transpose(0, 2, 1, 3)
    y = head_norm(y, RET_GN_EPS) * gn_g.reshape(H, d)
    return y.reshape(B_, S_, RET_W) * jax.nn.silu(g.astype(F32))


def hierarchical_moe(h, w_group, b_group, w_expert, b_expert, w1, w3, w2):
    B_, S_, D = h.shape
    T = B_ * S_
    hf = h.reshape(T, D)
    g_logits = (hf @ w_group + b_group).astype(F32)
    grp = jnp.argmax(g_logits, axis=-1)
    g_gate = jnp.take_along_axis(jax.nn.softmax(g_logits, -1), grp[:, None], axis=-1)
    e_logits = (hf @ w_expert + b_expert).astype(F32).reshape(T, N_GROUPS, EXPERTS_PER_GROUP)
    e_sel = jnp.take_along_axis(e_logits, grp[:, None, None], axis=1)[:, 0]
    top_val, top_idx = lax.top_k(e_sel, TOP_K)
    gates = g_gate * jax.nn.softmax(top_val, axis=-1)
    expert_id = grp[:, None] * EXPERTS_PER_GROUP + top_idx

    A = T * TOP_K
    eid = expert_id.reshape(A)
    tok = jnp.repeat(jnp.arange(T), TOP_K)
    gate = gates.reshape(A)
    order = jnp.argsort(eid)
    e_sorted, tok_sorted, gate_sorted = eid[order], tok[order], gate[order]
    counts = jnp.zeros((N_EXPERTS,), jnp.int32).at[eid].add(1)
    offsets = jnp.cumsum(counts) - counts
    padded = ((counts + MOE_BLOCK - 1) // MOE_BLOCK) * MOE_BLOCK
    pad_end = jnp.cumsum(padded)
    pad_off = pad_end - padded
    dest = pad_off[e_sorted] + (jnp.arange(A) - offsets[e_sorted])
    n_blk = A // MOE_BLOCK + N_EXPERTS
    x_pad = jnp.zeros((n_blk * MOE_BLOCK, D), h.dtype).at[dest].set(hf[tok_sorted])
    block_expert = jnp.minimum(
        jnp.searchsorted(pad_end, jnp.arange(n_blk) * MOE_BLOCK, side='right'), N_EXPERTS - 1)

    def expert_block(args):
        xb, e = args
        return (jax.nn.silu(xb @ w1[e]) * (xb @ w3[e])) @ w2[e]

    y_pad = lax.map(expert_block, (x_pad.reshape(n_blk, MOE_BLOCK, D), block_expert))
    y = y_pad.reshape(n_blk * MOE_BLOCK, D)[dest] * gate_sorted[:, None].astype(h.dtype)
    return jax.ops.segment_sum(y, tok_sorted, num_segments=T).reshape(B_, S_, D)


def setup_inputs(seed: int = 0) -> dict:
    key = jax.random.key(seed)
    ks = iter(jax.random.split(key, 32))
    L, D = DEPTH, D_MODEL

    def nrm(shape, scale):
        return scale * jax.random.normal(next(ks), shape, F32)

    def uni(shape):
        return jax.random.uniform(next(ks), shape, F32)

    return {
        "x": nrm((BATCH, SEQ, D), 1.0),
        "w_in": nrm((L, D, IN_W), D ** -0.5),
        "fox_fgate_bias": jnp.linspace(1.0, 6.0, FOX_HEADS, dtype=F32)[None, :] + nrm((L, FOX_HEADS), 0.1),
        "rwkv_mu_rkv": uni((L, 3, RWKV_W)),
        "rwkv_mu_lora": uni((L, LORA_W)),
        "rwkv_w0": jnp.linspace(-6.0, -1.0, RWKV_W, dtype=F32)[None, :] + nrm((L, RWKV_W), 0.1),
        "rwkv_w2": nrm((L, W_LORA, RWKV_W), 0.5 * W_LORA ** -0.5),
        "rwkv_a0": nrm((L, RWKV_W), 0.1),
        "rwkv_a2": nrm((L, A_LORA, RWKV_W), A_LORA ** -0.5),
        "rwkv_g2": nrm((L, G_LORA, RWKV_W), G_LORA ** -0.5),
        "rwkv_k_k": 0.85 + nrm((L, RWKV_W), 0.05),
        "rwkv_k_a": 1.0 + nrm((L, RWKV_W), 0.05),
        "rwkv_r_k": nrm((L, RWKV_HEADS, HEAD_DIM), 0.1),
        "rwkv_ln_g": 1.0 + nrm((L, RWKV_W), 0.05),
        "rwkv_ln_b": nrm((L, RWKV_W), 0.02),
        "ret_gn_g": 1.0 + nrm((L, RET_W), 0.05),
        "w_out": nrm((L, MIX_W, D), BETA * MIX_W ** -0.5),
        "ln1_g": 1.0 + nrm((L, D), 0.05),
        "ln1_b": nrm((L, D), 0.02),
        "ln2_g": 1.0 + nrm((L, D), 0.05),
        "ln2_b": nrm((L, D), 0.02),
        "moe_w_group": nrm((L, D, N_GROUPS), D ** -0.5),
        "moe_b_group": nrm((L, N_GROUPS), 0.01),
        "moe_w_expert": nrm((L, D, N_EXPERTS), D ** -0.5),
        "moe_b_expert": nrm((L, N_EXPERTS), 0.01),
        "moe_w1": nrm((L, N_EXPERTS, D, D_EXPERT), D ** -0.5),
        "moe_w3": nrm((L, N_EXPERTS, D, D_EXPERT), D ** -0.5),
        "moe_w2": nrm((L, N_EXPERTS, D_EXPERT, D), BETA * D_EXPERT ** -0.5),
    }


def reference(x, w_in, fox_fgate_bias, rwkv_mu_rkv, rwkv_mu_lora, rwkv_w0, rwkv_w2,
              rwkv_a0, rwkv_a2, rwkv_g2, rwkv_k_k, rwkv_k_a, rwkv_r_k, rwkv_ln_g, rwkv_ln_b,
              ret_gn_g, w_out, ln1_g, ln1_b, ln2_g, ln2_b, moe_w_group, moe_b_group,
              moe_w_expert, moe_b_expert, moe_w1, moe_w3, moe_w2):
    B_, S_, D = x.shape
    for l in range(DEPTH):
        p = x @ w_in[l]
        (fq, fk, fv, ff, rr, rk, rv, rwd, rad, rgd, tq, tk, tv, tg) = split_columns(p, IN_SPLITS)
        fox_heads = lambda t: t.reshape(B_, S_, FOX_HEADS, HEAD_DIM)
        y_fox = fox_attention(fox_heads(fq), fox_heads(fk), fox_heads(fv),
                              ff + fox_fgate_bias[l])
        y_rwkv = rwkv7_time_mix(rr, rk, rv, rwd, rad, rgd, rwkv_mu_rkv[l], rwkv_mu_lora[l],
                                rwkv_w0[l], rwkv_w2[l], rwkv_a0[l], rwkv_a2[l], rwkv_g2[l],
                                rwkv_k_k[l], rwkv_k_a[l], rwkv_r_k[l], rwkv_ln_g[l], rwkv_ln_b[l])
        y_ret = retention(tq, tk, tv, tg, ret_gn_g[l])
        mixed = jnp.concatenate([y_fox.astype(x.dtype), y_rwkv.astype(x.dtype),
                                 y_ret.astype(x.dtype)], axis=-1) @ w_out[l]
        x = layer_norm(ALPHA * x + mixed, ln1_g[l], ln1_b[l])
        moe = hierarchical_moe(x, moe_w_group[l], moe_b_group[l], moe_w_expert[l],
                               moe_b_expert[l], moe_w1[l], moe_w3[l], moe_w2[l])
        x = layer_norm(ALPHA * x + moe, ln2_g[l], ln2_b[l])
    return x
```

```cpp
#include <hip/hip_runtime.h>
#include <cstdio>
#include <cstdint>
#include <cmath>

constexpr int BATCH = 2, SEQ = 16384, DM = 1024, DEPTH = 4, T = BATCH * SEQ;
constexpr int INW = 3592;
constexpr int C_FQ = 0, C_FK = 512, C_FV = 1024, C_FF = 1536, C_RR = 1544, C_RK = 1800, C_RV = 2056, C_WD = 2312, C_AD = 2376, C_GD = 2440,
              C_TQ = 2568, C_TK = 2824, C_TV = 3080, C_TG = 3336;
constexpr int NE = 32, DE = 512, A_TOT = T * 2;
constexpr float ALPHA = 1.681792830507429f;
constexpr float LN_EPS = 1e-5f, RWKV_GN_EPS = 64e-5f, RET_GN_EPS = 1e-6f;
constexpr int NTHREADS = 512;
constexpr int LDS_BYTES = 65536;

constexpr size_t MiB = 1u << 20;
constexpr size_t WS_CTL = 0, CTL_BYTES = 1 * MiB;
constexpr size_t WS_LIST = 1 * MiB;
constexpr size_t WS_GATE = 9 * MiB;
constexpr size_t WS_CB = 10 * MiB;
constexpr size_t WS_ROPE = 11 * MiB;
constexpr size_t WS_RKD = 15 * MiB;
constexpr size_t WS_P = 16 * MiB;
constexpr size_t WS_H = 16 * MiB, WS_YP = 144 * MiB, WS_YO = 16 * MiB;
constexpr size_t WS_MIX = 472 * MiB;
constexpr size_t WS_U = 472 * MiB;
constexpr size_t WS_ST = 600 * MiB;
constexpr size_t WS_END = 888 * MiB;
constexpr int CW_CNT = 1024;

typedef float f32x16 __attribute__((ext_vector_type(16)));
typedef float f32x4 __attribute__((ext_vector_type(4)));

struct Args {
    const float* in[28]; float* out; unsigned char* ws; int l, pad;
};

__device__ __forceinline__ float sigmoidf_(float x) { return 1.0f / (1.0f + expf(-x)); }
__device__ __forceinline__ float logsigmoidf_(float x) { return x >= 0.f ? -log1pf(expf(-x)) : x - log1pf(expf(x)); }
__device__ __forceinline__ float wave_sum(float v) {
#pragma unroll
    for (int o = 1; o < 64; o <<= 1) v += __shfl_xor(v, o);
    return v;
}

template <class RowMap, class Epi>
__device__ __forceinline__ void gemm_tile_f32(float* lds, const float* __restrict__ A, int lda, RowMap rowmap, int nvalid,
                                              const float* __restrict__ B, int ldb, int col0, int N, int K, Epi epi) {
    float* As = lds;
    float* Bs = lds + 128 * 17;
    const int tid = threadIdx.x, lane = tid & 63, wid = tid >> 6, wm = wid & 3, wn = wid >> 2;
    const int arow = tid >> 2, akq = (tid & 3) * 4;
    const int src = (arow < nvalid) ? rowmap(arow) : -1;
    const float* ap = A + (size_t)(src < 0 ? 0 : src) * lda + akq;
    const int bk = tid >> 5, bn = (tid & 31) * 4;
    const bool bok = (col0 + bn) < N;
    const float* bp = B + (size_t)bk * ldb + col0 + bn;
    f32x16 acc0 = {}, acc1 = {};
    for (int k0 = 0; k0 < K; k0 += 16) {
        f32x4 av = (f32x4){0.f, 0.f, 0.f, 0.f}, bv = (f32x4){0.f, 0.f, 0.f, 0.f};
        if (src >= 0) av = *(const f32x4*)(ap + k0);
        if (bok) bv = *(const f32x4*)(bp + (size_t)k0 * ldb);
        __syncthreads();
        As[arow * 17 + akq + 0] = av[0]; As[arow * 17 + akq + 1] = av[1]; As[arow * 17 + akq + 2] = av[2]; As[arow * 17 + akq + 3] = av[3];
        *(f32x4*)(Bs + bk * 132 + bn) = bv;
        __syncthreads();
#pragma unroll
        for (int kk = 0; kk < 16; kk += 2) {
            const float a = As[(32 * wm + (lane & 31)) * 17 + kk + (lane >> 5)];
            const float b0 = Bs[(kk + (lane >> 5)) * 132 + 64 * wn + (lane & 31)];
            const float b1 = Bs[(kk + (lane >> 5)) * 132 + 64 * wn + 32 + (lane & 31)];
            acc0 = __builtin_amdgcn_mfma_f32_32x32x2f32(a, b0, acc0, 0, 0, 0);
            acc1 = __builtin_amdgcn_mfma_f32_32x32x2f32(a, b1, acc1, 0, 0, 0);
        }
    }
#pragma unroll
    for (int r = 0; r < 16; ++r) {
        const int i = 32 * wm + (r & 3) + 8 * (r >> 2) + 4 * (lane >> 5);
        const int c0 = col0 + 64 * wn + (lane & 31);
        if (i < nvalid) {
            if (c0 < N) epi(i, c0, acc0[r]);
            if (c0 + 32 < N) epi(i, c0 + 32, acc1[r]);
        }
    }
}

constexpr int NPH = 11;
template <int SUB> __global__ void __launch_bounds__(NTHREADS, 2) fwd(Args args) {
    extern __shared__ __attribute__((aligned(16))) unsigned char lds_raw[];
    float* lds = (float*)lds_raw;
    const int tid = threadIdx.x, lane = tid & 63, wid = tid >> 6;
    const int G = gridDim.x, bx = blockIdx.x;
    unsigned char* ws = args.ws;
    unsigned* ctl = (unsigned*)(ws + WS_CTL);
    float* X = args.out;
    float* P = (float*)(ws + WS_P);
    float* MIX = (float*)(ws + WS_MIX);
    float* CB = (float*)(ws + WS_CB);
    float* ROPE = (float*)(ws + WS_ROPE);
    float* RKD = (float*)(ws + WS_RKD);
    float* sR = (float*)(ws + WS_ST), *sW = sR + (size_t)T * 256, *sK = sW + (size_t)T * 256, *sV = sK + (size_t)T * 256, *sKK = sV + (size_t)T * 256,
          *sKA = sKK + (size_t)T * 256, *sG = sKA + (size_t)T * 256, *sRQ = sG + (size_t)T * 256, *sRK = sRQ + (size_t)T * 256;
    int* LIST = (int*)(ws + WS_LIST);
    float* GATE = (float*)(ws + WS_GATE);
    float* Hb = (float*)(ws + WS_H); float* YP = (float*)(ws + WS_YP); float* YO = (float*)(ws + WS_YO); float* Ub = (float*)(ws + WS_U);

    {
    if constexpr (SUB == -1) {
        const f32x4* xi = (const f32x4*)args.in[0]; f32x4* xo = (f32x4*)X;
        for (size_t i = (size_t)bx * NTHREADS + tid; i < (size_t)T * DM / 4; i += (size_t)G * NTHREADS) xo[i] = xi[i];
        for (int i = bx * NTHREADS + tid; i < SEQ * 32; i += G * NTHREADS) {
            const int pos = i >> 5, f = i & 31;
            const double inv = pow(10000.0, -(double)f / 32.0);
            const double ang = (double)pos * inv;
            ROPE[2 * i] = (float)cos(ang); ROPE[2 * i + 1] = (float)sin(ang);
        }
    }
    const int l = args.l;
    const float* w_in = args.in[1] + (size_t)l * DM * INW;
    if constexpr (SUB == 0) {
        const int tM = T / 128, tN = (INW + 127) / 128;
        for (int u = bx; u < tM * tN; u += G) {
            const int pm = u % tM, pn = u / tM;
            const int row0 = pm * 128;
            gemm_tile_f32(lds, X, DM, [=](int i) { return row0 + i; }, 128, w_in, INW, pn * 128, INW, DM,
                          [=](int i, int c, float v) { P[(size_t)(row0 + i) * INW + c] = v; });
        }
    } else if constexpr (SUB == 1) {
        const float* fbias = args.in[2] + l * 8;
        const int gw = bx * 8 + wid;
        if (gw < 16) {
            const int b = gw >> 3, h = gw & 7;
            double carry = 0.0;
            for (int t0 = 0; t0 < SEQ; t0 += 64) {
                const int t = t0 + lane;
                const float f = P[(size_t)(b * SEQ + t) * INW + C_FF + h] + fbias[h];
                double v = (double)logsigmoidf_(f);
#pragma unroll
                for (int o = 1; o < 64; o <<= 1) { const double n = __shfl_up(v, o); if (lane >= o) v += n; }
                v += carry;
                CB[(size_t)gw * SEQ + t] = (float)v;
                carry = __shfl(v, 63);
            }
        }
        const float* mu_rkv = args.in[3] + l * 3 * 256; const float* mu_lora = args.in[4] + l * 256;
        const float* w0 = args.in[5] + l * 256; const float* w2 = args.in[6] + (size_t)l * 64 * 256;
        const float* a0 = args.in[7] + l * 256; const float* a2 = args.in[8] + (size_t)l * 64 * 256;
        const float* g2 = args.in[9] + (size_t)l * 128 * 256;
        const float* k_k = args.in[10] + l * 256; const float* k_a = args.in[11] + l * 256; const float* r_k = args.in[12] + l * 256;
        const int half = tid >> 8, j = tid & 255;
        float* sh = lds + half * 256;
        for (int m0 = bx * 2; m0 < T; m0 += G * 2) {
            const int m = m0 + half; const int t = m % SEQ;
            const float* pr = P + (size_t)m * INW; const float* pp = pr - INW;
            const bool hp = t > 0;
            float cr = pr[C_RR + j], ck = pr[C_RK + j], cv = pr[C_RV + j], cl = pr[C_WD + j];
            float qr = hp ? pp[C_RR + j] : 0.f, qk = hp ? pp[C_RK + j] : 0.f, qv = hp ? pp[C_RV + j] : 0.f, ql = hp ? pp[C_WD + j] : 0.f;
            const float r = cr + (qr - cr) * mu_rkv[j], k = ck + (qk - ck) * mu_rkv[256 + j], v = cv + (qv - cv) * mu_rkv[512 + j];
            const float lo = cl + (ql - cl) * mu_lora[j];
            __syncthreads();
            sh[j] = (j < 64) ? tanhf(lo) : (j < 128 ? lo : sigmoidf_(lo));
            __syncthreads();
            float z = w0[j], za = a0[j], zg = 0.f;
#pragma unroll 4
            for (int i = 0; i < 64; ++i) { z += sh[i] * w2[i * 256 + j]; za += sh[64 + i] * a2[i * 256 + j]; }
#pragma unroll 4
            for (int i = 0; i < 128; ++i) zg += sh[128 + i] * g2[i * 256 + j];
            const float log_w = logsigmoidf_(z) - 0.5f;
            const float decay = expf(-expf(log_w));
            const float a = sigmoidf_(za);
            float kk = k * k_k[j];
            const float ss = wave_sum(kk * kk);
            kk = kk / fmaxf(sqrtf(ss), 1e-12f);
            const float k2 = k * (1.0f + (a - 1.0f) * k_a[j]);
            const float rkd = wave_sum(r * k2 * r_k[j]);
            const size_t o = (size_t)m * 256 + j;
            sR[o] = r; sW[o] = decay; sK[o] = k2; sV[o] = v; sKK[o] = kk; sKA[o] = kk * a; sG[o] = zg;
            if ((j & 63) == 0) RKD[(size_t)m * 4 + (j >> 6)] = rkd;
            const int d = j & 63, i32 = d & 31, hb = (j >> 6) * 64;
            const float c = ROPE[2 * (t * 32 + i32)], s = ROPE[2 * (t * 32 + i32) + 1];
            const float q1 = pr[C_TQ + hb + i32], q2 = pr[C_TQ + hb + 32 + i32], k1 = pr[C_TK + hb + i32], k2r = pr[C_TK + hb + 32 + i32];
            sRQ[o] = (d < 32) ? (q1 * c - q2 * s) : (q1 * s + q2 * c);
            sRK[o] = ((d < 32) ? (k1 * c - k2r * s) : (k1 * s + k2r * c)) * 0.125f;
        }
    } else if constexpr (SUB == 2) {
        float* Ks = lds; float* Vs = lds + 4096; float* Cs = lds + 8192;
        for (int it = bx; it < 16 * 32; it += G) {
            const int bh = it >> 5, ib = it & 31, b = bh >> 3, h = bh & 7;
            const float* cb = CB + (size_t)bh * SEQ;
            const int q = (tid < 256) ? (256 * ib + tid) : (SEQ - 256 * (ib + 1) + (tid - 256));
            const float* qp = P + (size_t)(b * SEQ + q) * INW + C_FQ + h * 64;
            float qv[64], o[64];
#pragma unroll
            for (int d = 0; d < 64; ++d) { qv[d] = qp[d] * 0.125f; o[d] = 0.f; }
            const float cq = cb[q];
            float mx = -INFINITY, lsum = 0.f;
            const int ntile = (SEQ - 256 * ib) / 64;
            for (int kt = 0; kt < ntile; ++kt) {
                __syncthreads();
#pragma unroll
                for (int rep = 0; rep < 2; ++rep) {
                    const int idx = tid + rep * 512, row = idx >> 4, c4 = (idx & 15) * 4;
                    const float* src = P + (size_t)(b * SEQ + kt * 64 + row) * INW + h * 64 + c4;
                    *(f32x4*)(Ks + row * 64 + c4) = *(const f32x4*)(src + C_FK);
                    *(f32x4*)(Vs + row * 64 + c4) = *(const f32x4*)(src + C_FV);
                }
                if (tid < 64) Cs[tid] = cb[kt * 64 + tid];
                __syncthreads();
                if (kt * 64 <= q) {
                    for (int kk = 0; kk < 64; ++kk) {
                        if (kt * 64 + kk > q) break;
                        float s = 0.f;
#pragma unroll
                        for (int d4 = 0; d4 < 16; ++d4) { const f32x4 kv = *(const f32x4*)(Ks + kk * 64 + d4 * 4);
                            s += qv[d4 * 4] * kv[0] + qv[d4 * 4 + 1] * kv[1] + qv[d4 * 4 + 2] * kv[2] + qv[d4 * 4 + 3] * kv[3]; }
                        s += cq - Cs[kk];
                        if (s > mx) { const float sc = expf(mx - s); lsum *= sc;
#pragma unroll
                            for (int d = 0; d < 64; ++d) o[d] *= sc;
                            mx = s; }
                        const float p = expf(s - mx); lsum += p;
#pragma unroll
                        for (int d4 = 0; d4 < 16; ++d4) { const f32x4 vv = *(const f32x4*)(Vs + kk * 64 + d4 * 4);
                            o[d4 * 4] += p * vv[0]; o[d4 * 4 + 1] += p * vv[1]; o[d4 * 4 + 2] += p * vv[2]; o[d4 * 4 + 3] += p * vv[3]; }
                    }
                }
            }
            const float inv = 1.0f / lsum;
            float* op = MIX + (size_t)(b * SEQ + q) * DM + h * 64;
#pragma unroll
            for (int d = 0; d < 64; ++d) op[d] = o[d] * inv;
        }
    } else if constexpr (SUB == 3) {
        for (int it = bx; it < 16; it += G) {
            const int v = tid >> 3, kq = tid & 7;
            if (it < 8) {
                const int b = it >> 2, h = it & 3;
                float st[8];
#pragma unroll
                for (int i = 0; i < 8; ++i) st[i] = 0.f;
                const size_t base = (size_t)b * SEQ * 256 + h * 64;
                for (int t = 0; t < SEQ; ++t) {
                    const size_t o = base + (size_t)t * 256 + kq * 8;
                    const f32x4 w0v = *(const f32x4*)(sW + o), w1v = *(const f32x4*)(sW + o + 4);
                    const f32x4 kk0 = *(const f32x4*)(sKK + o), kk1 = *(const f32x4*)(sKK + o + 4);
                    const f32x4 ka0 = *(const f32x4*)(sKA + o), ka1 = *(const f32x4*)(sKA + o + 4);
                    const f32x4 kv0 = *(const f32x4*)(sK + o), kv1 = *(const f32x4*)(sK + o + 4);
                    const f32x4 rv0 = *(const f32x4*)(sR + o), rv1 = *(const f32x4*)(sR + o + 4);
                    const float vv = sV[base + (size_t)t * 256 + v];
                    float sa = 0.f;
#pragma unroll
                    for (int i = 0; i < 4; ++i) { sa -= st[i] * kk0[i]; sa -= st[4 + i] * kk1[i]; }
                    sa += __shfl_xor(sa, 1); sa += __shfl_xor(sa, 2); sa += __shfl_xor(sa, 4);
                    float y = 0.f;
#pragma unroll
                    for (int i = 0; i < 4; ++i) { st[i] = st[i] * w0v[i] + sa * ka0[i] + vv * kv0[i]; y += st[i] * rv0[i];
                                                  st[4 + i] = st[4 + i] * w1v[i] + sa * ka1[i] + vv * kv1[i]; y += st[4 + i] * rv1[i]; }
                    y += __shfl_xor(y, 1); y += __shfl_xor(y, 2); y += __shfl_xor(y, 4);
                    if (kq == 0) MIX[(size_t)(b * SEQ + t) * DM + 512 + h * 64 + v] = y;
                }
            } else {
                const int b = (it - 8) >> 2, h = (it - 8) & 3;
                const float gamma = 1.0f - exp2f(-5.0f - (float)h);
                float st[8];
#pragma unroll
                for (int i = 0; i < 8; ++i) st[i] = 0.f;
                const size_t base = (size_t)b * SEQ * 256 + h * 64;
                for (int t = 0; t < SEQ; ++t) {
                    const size_t o = base + (size_t)t * 256 + kq * 8;
                    const f32x4 q0 = *(const f32x4*)(sRQ + o), q1 = *(const f32x4*)(sRQ + o + 4);
                    const f32x4 k0 = *(const f32x4*)(sRK + o), k1 = *(const f32x4*)(sRK + o + 4);
                    const float vv = P[(size_t)(b * SEQ + t) * INW + C_TV + h * 64 + v];
                    float y = 0.f;
#pragma unroll
                    for (int i = 0; i < 4; ++i) { st[i] = st[i] * gamma + k0[i] * vv; y += q0[i] * st[i]; st[4 + i] = st[4 + i] * gamma + k1[i] * vv; y += q1[i] * st[4 + i]; }
                    y += __shfl_xor(y, 1); y += __shfl_xor(y, 2); y += __shfl_xor(y, 4);
                    if (kq == 0) MIX[(size_t)(b * SEQ + t) * DM + 768 + h * 64 + v] = y;
                }
            }
        }
    } else if constexpr (SUB == 4) {
        const float* ln_g = args.in[13] + l * 256; const float* ln_b = args.in[14] + l * 256; const float* gn_g = args.in[15] + l * 256;
        const int half = tid >> 8, j = tid & 255;
        for (int m0 = bx * 2; m0 < T; m0 += G * 2) {
            const int m = m0 + half;
            {
                float y = MIX[(size_t)m * DM + 512 + j];
                const float mu = wave_sum(y) * (1.f / 64.f); const float dlt = y - mu; const float var = wave_sum(dlt * dlt) * (1.f / 64.f);
                y = dlt * (1.0f / sqrtf(var + RWKV_GN_EPS)) * ln_g[j] + ln_b[j];
                y += RKD[(size_t)m * 4 + (j >> 6)] * sV[(size_t)m * 256 + j];
                MIX[(size_t)m * DM + 512 + j] = y * sG[(size_t)m * 256 + j];
            }
            {
                float y = MIX[(size_t)m * DM + 768 + j];
                const float mu = wave_sum(y) * (1.f / 64.f); const float dlt = y - mu; const float var = wave_sum(dlt * dlt) * (1.f / 64.f);
                y = dlt * (1.0f / sqrtf(var + RET_GN_EPS)) * gn_g[j];
                const float g = P[(size_t)m * INW + C_TG + j];
                MIX[(size_t)m * DM + 768 + j] = y * (g * sigmoidf_(g));
            }
        }
    } else if constexpr (SUB == 5) {
        const float* w_out = args.in[16] + (size_t)l * DM * DM;
        const int tM = T / 128, tN = DM / 128;
        for (int u = bx; u < tM * tN; u += G) {
            const int pm = u % tM, pn = u / tM; const int row0 = pm * 128;
            gemm_tile_f32(lds, MIX, DM, [=](int i) { return row0 + i; }, 128, w_out, DM, pn * 128, DM, DM,
                          [=](int i, int c, float v) { YO[(size_t)(row0 + i) * DM + c] = v; });
        }
    } else if constexpr (SUB == 6) {
        const float* g1 = args.in[17] + l * DM; const float* b1 = args.in[18] + l * DM;
        const float* wg = args.in[21] + (size_t)l * DM * 4; const float* bg = args.in[22] + l * 4;
        const float* we = args.in[23] + (size_t)l * DM * 32; const float* be = args.in[24] + l * 32;
        unsigned* cnt = ctl + CW_CNT + 64 * l;
        for (int m = bx * 8 + wid; m < T; m += G * 8) {
            float v[16]; float s = 0.f;
#pragma unroll
            for (int jq = 0; jq < 4; ++jq) { const f32x4 xv = *(const f32x4*)(X + (size_t)m * DM + jq * 256 + lane * 4); const f32x4 yv = *(const f32x4*)(YO + (size_t)m * DM + jq * 256 + lane * 4);
#pragma unroll
                for (int e = 0; e < 4; ++e) { v[jq * 4 + e] = ALPHA * xv[e] + yv[e]; s += v[jq * 4 + e]; } }
            const float mean = wave_sum(s) * (1.f / DM); float s2 = 0.f;
#pragma unroll
            for (int i = 0; i < 16; ++i) { v[i] -= mean; s2 += v[i] * v[i]; }
            const float rstd = 1.0f / sqrtf(wave_sum(s2) * (1.f / DM) + LN_EPS);
#pragma unroll
            for (int jq = 0; jq < 4; ++jq) { f32x4 ov;
#pragma unroll
                for (int e = 0; e < 4; ++e) { const int c = jq * 256 + lane * 4 + e; v[jq * 4 + e] = v[jq * 4 + e] * rstd * g1[c] + b1[c]; ov[e] = v[jq * 4 + e]; }
                *(f32x4*)(X + (size_t)m * DM + jq * 256 + lane * 4) = ov; }
            float lg[36];
#pragma unroll
            for (int o = 0; o < 36; ++o) lg[o] = 0.f;
#pragma unroll
            for (int jq = 0; jq < 4; ++jq)
#pragma unroll
                for (int e = 0; e < 4; ++e) { const int c = jq * 256 + lane * 4 + e; const float xv = v[jq * 4 + e];
#pragma unroll
                    for (int o = 0; o < 4; ++o) lg[o] += xv * wg[c * 4 + o];
#pragma unroll
                    for (int o = 0; o < 32; ++o) lg[4 + o] += xv * we[c * 32 + o]; }
#pragma unroll
            for (int o = 0; o < 36; ++o) lg[o] = wave_sum(lg[o]);
            if (lane == 0) {
                int grp = 0; float gbest = lg[0] + bg[0];
#pragma unroll
                for (int o = 1; o < 4; ++o) { const float gv = lg[o] + bg[o]; if (gv > gbest) { gbest = gv; grp = o; } }
                float den = 0.f;
#pragma unroll
                for (int o = 0; o < 4; ++o) den += expf(lg[o] + bg[o] - gbest);
                const float ggate = 1.0f / den;
                float el[8];
#pragma unroll
                for (int o = 0; o < 8; ++o) { float vsel = lg[4 + o] + be[o];
#pragma unroll
                    for (int gq = 1; gq < 4; ++gq) vsel = (gq == grp) ? (lg[4 + gq * 8 + o] + be[gq * 8 + o]) : vsel;
                    el[o] = vsel; }
                int i0 = 0; float v0 = el[0];
#pragma unroll
                for (int o = 1; o < 8; ++o) if (el[o] > v0) { v0 = el[o]; i0 = o; }
                int i1 = -1; float v1 = -INFINITY;
#pragma unroll
                for (int o = 0; o < 8; ++o) if (o != i0 && (i1 < 0 || el[o] > v1)) { v1 = el[o]; i1 = o; }
                const float e1 = expf(v1 - v0); const float p0 = 1.0f / (1.0f + e1), p1 = e1 / (1.0f + e1);
                const int ex0 = grp * 8 + i0, ex1 = grp * 8 + i1;
                const unsigned q0 = atomicAdd(cnt + ex0, 1u); LIST[(size_t)ex0 * A_TOT + q0] = 2 * m;
                const unsigned q1 = atomicAdd(cnt + ex1, 1u); LIST[(size_t)ex1 * A_TOT + q1] = 2 * m + 1;
                GATE[2 * m] = ggate * p0; GATE[2 * m + 1] = ggate * p1;
            }
        }
    } else if constexpr (SUB == 7 || SUB == 8 || SUB == 9) {
        unsigned* cnt = ctl + CW_CNT + 64 * l;
        int* tstart = (int*)(lds + 8192);
        __syncthreads();
        if (tid == 0) { int acc = 0; for (int e = 0; e < NE; ++e) { tstart[e] = acc; acc += ((int)cnt[e] + 127) / 128; } tstart[NE] = acc; }
        __syncthreads();
        const int ntile = tstart[NE];
        const int tN = (SUB == 9) ? DM / 128 : DE / 128;
        const float* w1 = args.in[25] + (size_t)l * NE * DM * DE; const float* w3 = args.in[26] + (size_t)l * NE * DM * DE; const float* w2 = args.in[27] + (size_t)l * NE * DE * DM;
        for (int u = bx; u < ntile * tN; u += G) {
            const int rt = u / tN, pn = u % tN;
            int e = 0; while (tstart[e + 1] <= rt) ++e;
            const int r0 = (rt - tstart[e]) * 128; const int nvalid = min(128, (int)cnt[e] - r0);
            const int* lst = LIST + (size_t)e * A_TOT + r0;
            if constexpr (SUB == 7) {
                gemm_tile_f32(lds, X, DM, [=](int i) { return lst[i] >> 1; }, nvalid, w1 + (size_t)e * DM * DE, DE, pn * 128, DE, DM,
                              [=](int i, int c, float v) { Ub[(size_t)lst[i] * DE + c] = v; });
            } else if constexpr (SUB == 8) {
                gemm_tile_f32(lds, X, DM, [=](int i) { return lst[i] >> 1; }, nvalid, w3 + (size_t)e * DM * DE, DE, pn * 128, DE, DM,
                              [=](int i, int c, float v) { const size_t o = (size_t)lst[i] * DE + c; const float uu = Ub[o]; Hb[o] = uu * sigmoidf_(uu) * v; });
            } else {
                gemm_tile_f32(lds, Hb, DE, [=](int i) { return lst[i]; }, nvalid, w2 + (size_t)e * DE * DM, DM, pn * 128, DM, DE,
                              [=](int i, int c, float v) { YP[(size_t)lst[i] * DM + c] = v; });
            }
        }
    } else if constexpr (SUB == 10) {
        const float* g2 = args.in[19] + l * DM; const float* b2 = args.in[20] + l * DM;
        for (int m = bx * 8 + wid; m < T; m += G * 8) {
            const float ga = GATE[2 * m], gb = GATE[2 * m + 1];
            float v[16]; float s = 0.f;
#pragma unroll
            for (int jq = 0; jq < 4; ++jq) { const f32x4 xv = *(const f32x4*)(X + (size_t)m * DM + jq * 256 + lane * 4);
                const f32x4 ya = *(const f32x4*)(YP + (size_t)(2 * m) * DM + jq * 256 + lane * 4); const f32x4 yb = *(const f32x4*)(YP + (size_t)(2 * m + 1) * DM + jq * 256 + lane * 4);
#pragma unroll
                for (int e = 0; e < 4; ++e) { v[jq * 4 + e] = ALPHA * xv[e] + (ga * ya[e] + gb * yb[e]); s += v[jq * 4 + e]; } }
            const float mean = wave_sum(s) * (1.f / DM); float s2 = 0.f;
#pragma unroll
            for (int i = 0; i < 16; ++i) { v[i] -= mean; s2 += v[i] * v[i]; }
            const float rstd = 1.0f / sqrtf(wave_sum(s2) * (1.f / DM) + LN_EPS);
#pragma unroll
            for (int jq = 0; jq < 4; ++jq) { f32x4 ov;
#pragma unroll
                for (int e = 0; e < 4; ++e) { const int c = jq * 256 + lane * 4 + e; ov[e] = v[jq * 4 + e] * rstd * g2[c] + b2[c]; }
                *(f32x4*)(X + (size_t)m * DM + jq * 256 + lane * 4) = ov; }
        }
    }
    }
}

extern "C" void kernel_launch(void* const* d_in, const int* in_sizes, int n_in, void* d_out, int out_size, void* d_ws, size_t ws_size, hipStream_t stream) {
    static int grid = 0;
    if (grid == 0) {
        if (n_in != 28 || out_size != T * DM || ws_size < WS_END) { fprintf(stderr, "kernel_launch: unexpected shapes (n_in %d out %d ws %zu)\n", n_in, out_size, ws_size); grid = -1; return; }
        int dev = 0, cus = 0;
        (void)hipGetDevice(&dev); (void)hipDeviceGetAttribute(&cus, hipDeviceAttributeMultiprocessorCount, dev);
        (void)hipGetLastError();
        grid = cus > 0 ? cus : 256;
    }
    if (grid < 0) return;
    (void)hipMemsetAsync((char*)d_ws + WS_CTL, 0, CTL_BYTES, stream);
    Args a{};
    for (int i = 0; i < 28; ++i) a.in[i] = (const float*)d_in[i];
    a.out = (float*)d_out; a.ws = (unsigned char*)d_ws;
#define LAUNCH(SUBV, GRIDV) hipLaunchKernelGGL(fwd<SUBV>, dim3(GRIDV), dim3(NTHREADS), LDS_BYTES, stream, a)
    a.l = 0; LAUNCH(-1, grid * 2);
    for (int l = 0; l < DEPTH; ++l) {
        a.l = l;
        LAUNCH(0, grid); LAUNCH(1, grid * 2); LAUNCH(2, grid); LAUNCH(3, grid); LAUNCH(4, grid * 2); LAUNCH(5, grid);
        LAUNCH(6, grid * 2); LAUNCH(7, grid); LAUNCH(8, grid); LAUNCH(9, grid); LAUNCH(10, grid * 2);
    }
}
```

```cpp
#include <hip/hip_runtime.h>
#include <cstdio>
#include <cstdint>
#include <cmath>
__device__ __forceinline__ int ltid() { int t = __builtin_amdgcn_workitem_id_x(); asm volatile("" : "+v"(t)); return t; }

constexpr int BATCH = 2, SEQ = 16384, DM = 1024, DEPTH = 4, T = BATCH * SEQ;
constexpr int INW = 3592, PW = 3584;
constexpr int O_FF = 1536;
constexpr int C_FQ = 0, C_FK = 512, C_FV = 1024, C_RR = 1536, C_RK = 1792, C_RV = 2048, C_WD = 2304, C_AD = 2368, C_GD = 2432,
              C_TQ = 2560, C_TK = 2816, C_TV = 3072, C_TG = 3328;
constexpr int NE = 32, DE = 512, A_TOT = T * 2;
constexpr float ALPHA = 1.681792830507429f;
constexpr float LN_EPS = 1e-5f, RWKV_GN_EPS = 64e-5f, RET_GN_EPS = 1e-6f;
constexpr float QC2 = 0.125f * 1.4426950408889634f;
constexpr int NTHREADS = 512;
constexpr int LDS_MISC = 147456, LDS_ALL = 148480;

constexpr size_t MiB = 1u << 20;
constexpr size_t WS_CTL = 0, CTL_BYTES = 1 * MiB;
constexpr size_t WS_EP = 1 * MiB;
constexpr size_t WS_DEST = 2 * MiB;
constexpr size_t WS_GATE = 9 * MiB;
constexpr size_t WS_ROPE = 11 * MiB;
constexpr size_t WS_RKD = 15 * MiB;
constexpr size_t WS_WIN = 16 * MiB;
constexpr size_t WS_WOUT = 44 * MiB;
constexpr size_t WS_W13 = 52 * MiB;
constexpr size_t WS_W2 = 308 * MiB;
constexpr size_t WS_XB = 436 * MiB;
constexpr size_t WS_P = 500 * MiB;
constexpr size_t WS_MIXB = 724 * MiB;
constexpr size_t WS_CK = 788 * MiB;
constexpr size_t WS_LW = 3 * MiB;
constexpr size_t WS_YO = 788 * MiB;
constexpr size_t WS_XP = 500 * MiB;
constexpr size_t WS_H = 644 * MiB;
constexpr size_t WS_YP = 716 * MiB;
constexpr size_t WS_LCS = 1012 * MiB;
constexpr size_t WS_KA = 1014 * MiB;
constexpr size_t WS_END = 1018 * MiB;
constexpr size_t WS_TOT = 4 * MiB;
constexpr int CW_CNT = 1024;
constexpr int CW_Q = 2048;
constexpr int CW_BAR = 8192;
constexpr int MAXTILES = 288;

typedef float f32x16 __attribute__((ext_vector_type(16)));
typedef unsigned short bf16;

struct Args {
    const float* in[28]; float* out; unsigned char* ws;
};

__device__ __forceinline__ float sigmoidf_(float x) { return 1.0f / (1.0f + expf(-x)); }
__device__ __forceinline__ float logsigmoidf_(float x) { return x >= 0.f ? -log1pf(expf(-x)) : x - log1pf(expf(x)); }
__device__ __forceinline__ float wave_sum(float v) {
#pragma unroll
    for (int o = 1; o < 64; o <<= 1) v += __shfl_xor(v, o);
    return v;
}
__device__ __forceinline__ unsigned f2bf(float f) { unsigned u = __builtin_bit_cast(unsigned, f); return (u + 0x7fffu + ((u >> 16) & 1u)) >> 16; }
__device__ __forceinline__ unsigned pk2(float lo, float hi) { return f2bf(lo) | (f2bf(hi) << 16); }
__device__ __forceinline__ float bf2f(unsigned short b) { return __builtin_bit_cast(float, (unsigned)b << 16); }
__device__ __forceinline__ float pf(const bf16* Pb, size_t m, int c) { return bf2f(Pb[m * PW + c]); }

namespace pg8 {
#define PG8_LAS __attribute__((address_space(3)))
typedef unsigned short bf16_t;
typedef short bf16x8 __attribute__((ext_vector_type(8)));
typedef float f32x4 __attribute__((ext_vector_type(4)));
typedef unsigned u32x4 __attribute__((ext_vector_type(4)));
constexpr int BM = 256, BK = 64, HALF = 128, HTB = HALF * BK * 2  , STAGE_BYTES = 8 * HTB, NXCD = 8, WGM = 8;

__host__ __device__ __forceinline__ int lds_byte(int r, int c) { const int st = (r >> 4) * 2 + (c >> 5), rr = r & 15, cc = c & 31, ob = rr * 64 + cc * 2; return st * 1024 + (ob ^ (((ob >> 9) & 1) << 5)); }
__host__ __device__ __forceinline__ void stage_rc(int b, int& R, int& C) { const int st = b / 1024, sb = b % 1024, swz = sb ^ (((sb >> 9) & 1) << 5); R = (st >> 1) * 16 + swz / 64; C = (st & 1) * 32 + (swz % 64) / 2; }
__host__ __device__ __forceinline__ int perm32(int rho) { const int n = rho >> 4, i = rho & 15; return 8 * (i >> 2) + 4 * n + (i & 3); }

struct Unit { int pm, pn, pc; };
struct Gemm { const bf16_t* A; const bf16_t* Bt; int M, N, K; };

struct StaticOrder {
    int nM, nN, nwg, G, c;
    __host__ __device__ void init(int M, int N, int G_, int c_) { nM = M / BM; nN = N / BM; nwg = nM * nN; G = G_; c = c_; }
    __host__ __device__ bool next(int i, Unit& u) const {
        const long L = (long)i * G + c; if (L >= nwg) return false;
        int wgid = (int)L; { const int q = nwg / NXCD, r = nwg % NXCD, xcd = wgid % NXCD, off = wgid / NXCD; wgid = (xcd < r ? xcd * (q + 1) : r * (q + 1) + (xcd - r) * q) + off; }
        const int nig = WGM * nN, gid = wgid / nig, fm = gid * WGM, gsz = (nM - fm) < WGM ? (nM - fm) : WGM;
        u.pm = fm + ((wgid % nig) % gsz); u.pn = (wgid % nig) / gsz; u.pc = u.pn; return true;
    }
    __device__ __forceinline__ void a_ready(const Unit&) const {}
    __device__ __forceinline__ void done(const Unit&) const {}
};

__device__ __forceinline__ unsigned cvt_pk_bf16(float lo, float hi) { unsigned r; asm volatile("v_cvt_pk_bf16_f32 %0, %1, %2" : "=v"(r) : "v"(lo), "v"(hi)); return r; }

struct EpiF32 {
    static constexpr bool PERM = false, AFTER_DRAIN = false;
    float* O; int ldc;
    __device__ __forceinline__ void operator()(const f32x4 (&acc)[2][2][4][2], const Unit& u, int wr, int wc, int fr, int fq) const {
        const int row0 = u.pm * BM + wr * 64 + fr; const int col0 = u.pc * BM + wc * 32 + 4 * fq;
#pragma unroll
        for (int ai = 0; ai < 2; ++ai)
#pragma unroll
            for (int m = 0; m < 4; ++m) { float* rowp = O + (size_t)(row0 + ai * HALF + m * 16) * ldc + col0;
#pragma unroll
                for (int bj = 0; bj < 2; ++bj)
#pragma unroll
                    for (int n = 0; n < 2; ++n) *(f32x4*)(rowp + bj * HALF + n * 16) = acc[ai][bj][m][n]; }
    }
};
struct EpiSwiGlu {
    static constexpr bool PERM = true, AFTER_DRAIN = false;
    bf16_t* O; int ldc;
    __device__ __forceinline__ static float silu(float v) { return v * __builtin_amdgcn_rcpf(1.0f + __builtin_amdgcn_exp2f(-1.4426950408889634f * v)); }
    __device__ __forceinline__ void operator()(const f32x4 (&acc)[2][2][4][2], const Unit& u, int wr, int wc, int fr, int fq) const {
        const int row0 = u.pm * BM + wr * 64 + fr; const int col0 = u.pc * HALF + wc * 32 + 8 * fq;
#pragma unroll
        for (int ai = 0; ai < 2; ++ai)
#pragma unroll
            for (int m = 0; m < 4; ++m) { bf16_t* rowp = O + (size_t)(row0 + ai * HALF + m * 16) * ldc + col0;
                f32x4 h0, h1;
#pragma unroll
                for (int e = 0; e < 4; ++e) { h0[e] = silu(acc[ai][0][m][0][e]) * acc[ai][1][m][0][e]; h1[e] = silu(acc[ai][0][m][1][e]) * acc[ai][1][m][1][e]; }
                u32x4 w; w.x = cvt_pk_bf16(h0[0], h0[1]); w.y = cvt_pk_bf16(h0[2], h0[3]); w.z = cvt_pk_bf16(h1[0], h1[1]); w.w = cvt_pk_bf16(h1[2], h1[3]);
                *(u32x4*)rowp = w; }
    }
};
struct MoeOrder {
    int ntile, G, c; const PG8_LAS int* tile_e;
    __device__ __forceinline__ bool next(int i, Unit& u) const { const int L = i * G + c; if (L >= ntile * 4) return false; const int rt = L >> 2, pn = L & 3; u.pm = rt; u.pn = tile_e[rt] * 4 + pn; u.pc = pn; return true; }
    __device__ __forceinline__ void a_ready(const Unit&) const {}
    __device__ __forceinline__ void done(const Unit&) const {}
};
struct EpiInProj {
    static constexpr bool PERM = true, AFTER_DRAIN = false;
    bf16_t* O; int ldc; float qscale;
    __device__ __forceinline__ void operator()(const f32x4 (&acc)[2][2][4][2], const Unit& u, int wr, int wc, int fr, int fq) const {
        const int row0 = u.pm * BM + wr * 64 + fr; const int col0 = u.pc * BM + wc * 32 + 8 * fq;
        const float sc = (u.pc < 2) ? qscale : 1.f;
#pragma unroll
        for (int ai = 0; ai < 2; ++ai)
#pragma unroll
            for (int m = 0; m < 4; ++m) { bf16_t* rowp = O + (size_t)(row0 + ai * HALF + m * 16) * ldc + col0;
#pragma unroll
                for (int bj = 0; bj < 2; ++bj) { const f32x4 v0 = acc[ai][bj][m][0] * sc, v1 = acc[ai][bj][m][1] * sc;
                    u32x4 w; w.x = cvt_pk_bf16(v0[0], v0[1]); w.y = cvt_pk_bf16(v0[2], v0[3]); w.z = cvt_pk_bf16(v1[0], v1[1]); w.w = cvt_pk_bf16(v1[2], v1[3]);
                    *(u32x4*)(rowp + bj * HALF) = w; } }
    }
};
template <class Epi, class Sched, bool ALIGN_EPI = false, bool SP2 = false>
__device__ __forceinline__ void gemm_phase(PG8_LAS unsigned char* lds, const Gemm g, const Sched& S, const Epi& E) {
    const int tid = ltid(), wid = __builtin_amdgcn_readfirstlane(tid >> 6), lane = tid & 63, wr = wid >> 2, wc = wid & 3, fr = lane & 15, fq = lane >> 4;
    const int K = g.K, nt = K / BK;
    unsigned voffA[2], voffB[2];
#pragma unroll
    for (int i = 0; i < 2; ++i) { int R, C; stage_rc(tid * 16 + i * 8192, R, C); const int Rb = Epi::PERM ? ((R & ~31) + perm32(R & 31)) : R;
        voffA[i] = (unsigned)(R * K + C) * 2u; voffB[i] = (unsigned)(Rb * K + C) * 2u; }
    const size_t kstep = (size_t)(BK * 2);
    const size_t hstep = (size_t)HALF * K * 2;
    const size_t tstep = 2 * hstep;
    const unsigned ldsw = (unsigned)wid * 1024u;
    const int aoff = lds_byte(wr * 64 + fr, fq * 8), boff = lds_byte(wc * 32 + fr, fq * 8);
#define PG8_SA(b, h) (((b) * 2 + (h)) * HTB)
#define PG8_SB(b, h) ((4 + (b) * 2 + (h)) * HTB)
#define PG8_STAGE(bufoff, gbase, voff) do { _Pragma("unroll") for (int _i = 0; _i < 2; ++_i) \
        __builtin_amdgcn_global_load_lds((const unsigned*)((const char*)(gbase) + (voff)[_i]), (PG8_LAS unsigned*)(lds + (bufoff) + ldsw + _i * 8192), 16, 0, 0); } while (0)
#define PG8_LDA(dst, b, h) do { _Pragma("unroll") for (int m = 0; m < 4; ++m) _Pragma("unroll") for (int k = 0; k < 2; ++k) dst[m][k] = *(const PG8_LAS bf16x8*)(lds + PG8_SA(b, h) + aoff + m * 2048 + k * 1024); } while (0)
#define PG8_LDB(dst, b, h) do { _Pragma("unroll") for (int n = 0; n < 2; ++n) _Pragma("unroll") for (int k = 0; k < 2; ++k) dst[n][k] = *(const PG8_LAS bf16x8*)(lds + PG8_SB(b, h) + boff + n * 2048 + k * 1024); } while (0)
#define PG8_MMA(ai, bj, At, Bt) do { __builtin_amdgcn_s_setprio(1); _Pragma("unroll") for (int m = 0; m < 4; ++m) _Pragma("unroll") for (int n = 0; n < 2; ++n) _Pragma("unroll") for (int k = 0; k < 2; ++k) \
        acc[ai][bj][m][n] = __builtin_amdgcn_mfma_f32_16x16x32_bf16(Bt[n][k], At[m][k], acc[ai][bj][m][n], 0, 0, 0); __builtin_amdgcn_s_setprio(0); } while (0)
#define PG8_WAIT_V(n) asm volatile("s_waitcnt vmcnt(" #n ")" ::: "memory")
#define PG8_WAIT_L(n) asm volatile("s_waitcnt lgkmcnt(" #n ")" ::: "memory")
#define PG8_BAR __builtin_amdgcn_s_barrier()
#define PG8_SCHED __builtin_amdgcn_sched_barrier(0)
    Unit cur, nxt; int ui = 0;
    if (!S.next(0, cur)) return;
    f32x4 acc[2][2][4][2];
#pragma unroll
    for (int a = 0; a < 2; ++a)
#pragma unroll
        for (int b = 0; b < 2; ++b)
#pragma unroll
            for (int m = 0; m < 4; ++m)
#pragma unroll
                for (int n = 0; n < 2; ++n) acc[a][b][m][n] = (f32x4){0.f, 0.f, 0.f, 0.f};
    bf16x8 At[4][2], B0[2][2], B1[2][2];
    const char* cA = (const char*)g.A + (size_t)cur.pm * tstep; const char* cB = (const char*)g.Bt + (size_t)cur.pn * tstep;
    S.a_ready(cur);
    if constexpr (SP2) {
        PG8_STAGE(PG8_SB(0, 0), cB, voffB); PG8_STAGE(PG8_SB(0, 1), cB + hstep, voffB); PG8_STAGE(PG8_SA(0, 0), cA, voffA); PG8_STAGE(PG8_SA(0, 1), cA + hstep, voffA);
        if (wr == 1) PG8_BAR;
        PG8_WAIT_V(2); PG8_BAR;
        PG8_STAGE(PG8_SB(1, 0), cB + kstep, voffB); PG8_STAGE(PG8_SA(1, 0), cA + kstep, voffA); PG8_STAGE(PG8_SB(1, 1), cB + hstep + kstep, voffB);
        PG8_WAIT_V(6); PG8_BAR;
    } else {
        PG8_STAGE(PG8_SB(0, 0), cB, voffB); PG8_STAGE(PG8_SA(0, 0), cA, voffA); PG8_STAGE(PG8_SB(0, 1), cB + hstep, voffB); PG8_STAGE(PG8_SA(0, 1), cA + hstep, voffA);
        if (wr == 1) PG8_BAR;
        PG8_WAIT_V(4); PG8_BAR;
        PG8_STAGE(PG8_SB(1, 0), cB + kstep, voffB); PG8_STAGE(PG8_SA(1, 0), cA + kstep, voffA); PG8_STAGE(PG8_SB(1, 1), cB + hstep + kstep, voffB);
        PG8_WAIT_V(6); PG8_BAR;
    }
    for (;;) {
        const bool has_next = S.next(ui + 1, nxt);
        const char* nA = has_next ? (const char*)g.A + (size_t)nxt.pm * tstep : cA; const char* nB = has_next ? (const char*)g.Bt + (size_t)nxt.pn * tstep : cB;
        for (int t = 0; t < nt; t += 2) {
            const bool last = (t == nt - 2);
            const char* a1 = cA + (size_t)(t + 1) * kstep;
            const char* a2 = last ? nA : cA + (size_t)(t + 2) * kstep; const char* b2 = last ? nB : cB + (size_t)(t + 2) * kstep;
            const char* a3 = a2 + kstep; const char* b3 = b2 + kstep;
            if (last && has_next) S.a_ready(nxt);
            if constexpr (SP2) {
            PG8_LDB(B0, 0, 0); PG8_LDB(B1, 0, 1); PG8_SCHED; PG8_LDA(At, 0, 0); PG8_STAGE(PG8_SA(1, 1), a1 + hstep, voffA);
            PG8_WAIT_V(8); PG8_WAIT_L(0); PG8_BAR; PG8_MMA(0, 0, At, B0); PG8_MMA(0, 1, At, B1); PG8_BAR; PG8_SCHED;
            PG8_LDA(At, 0, 1); PG8_STAGE(PG8_SB(0, 0), b2, voffB); PG8_STAGE(PG8_SB(0, 1), b2 + hstep, voffB); PG8_STAGE(PG8_SA(0, 0), a2, voffA);
            PG8_WAIT_V(8); PG8_WAIT_L(0); PG8_BAR; PG8_MMA(1, 0, At, B0); PG8_MMA(1, 1, At, B1); PG8_BAR; PG8_SCHED;
            PG8_LDB(B0, 1, 0); PG8_LDB(B1, 1, 1); PG8_SCHED; PG8_LDA(At, 1, 0); PG8_STAGE(PG8_SA(0, 1), a2 + hstep, voffA);
            PG8_WAIT_V(8); PG8_WAIT_L(0); PG8_BAR; PG8_MMA(0, 0, At, B0); PG8_MMA(0, 1, At, B1); PG8_BAR; PG8_SCHED;
            PG8_LDA(At, 1, 1); PG8_STAGE(PG8_SB(1, 0), b3, voffB); PG8_STAGE(PG8_SB(1, 1), b3 + hstep, voffB); PG8_STAGE(PG8_SA(1, 0), a3, voffA);
            PG8_WAIT_V(8); PG8_WAIT_L(0); PG8_BAR; PG8_MMA(1, 0, At, B0); PG8_MMA(1, 1, At, B1); PG8_BAR; PG8_SCHED;
            } else {
            PG8_LDB(B0, 0, 0); PG8_SCHED; PG8_LDA(At, 0, 0); PG8_STAGE(PG8_SA(1, 1), a1 + hstep, voffA);
            PG8_WAIT_L(8); PG8_BAR; PG8_WAIT_L(0); PG8_MMA(0, 0, At, B0); PG8_BAR; PG8_SCHED;
            PG8_LDB(B1, 0, 1); PG8_STAGE(PG8_SB(0, 0), b2, voffB);
            PG8_BAR; PG8_WAIT_L(0); PG8_MMA(0, 1, At, B1); PG8_BAR;
            PG8_LDA(At, 0, 1); PG8_STAGE(PG8_SA(0, 0), a2, voffA);
            PG8_BAR; PG8_WAIT_L(0); PG8_MMA(1, 0, At, B0); PG8_BAR; PG8_SCHED;
            PG8_STAGE(PG8_SB(0, 1), b2 + hstep, voffB);
            PG8_WAIT_V(6); PG8_BAR; PG8_MMA(1, 1, At, B1); PG8_BAR;
            PG8_LDB(B0, 1, 0); PG8_SCHED; PG8_LDA(At, 1, 0); PG8_STAGE(PG8_SA(0, 1), a2 + hstep, voffA);
            PG8_WAIT_L(8); PG8_BAR; PG8_WAIT_L(0); PG8_MMA(0, 0, At, B0); PG8_BAR; PG8_SCHED;
            PG8_LDB(B1, 1, 1); PG8_STAGE(PG8_SB(1, 0), b3, voffB);
            PG8_BAR; PG8_WAIT_L(0); PG8_MMA(0, 1, At, B1); PG8_BAR;
            PG8_LDA(At, 1, 1); PG8_STAGE(PG8_SA(1, 0), a3, voffA);
            PG8_BAR; PG8_WAIT_L(0); PG8_MMA(1, 0, At, B0); PG8_BAR; PG8_SCHED;
            PG8_STAGE(PG8_SB(1, 1), b3 + hstep, voffB);
            PG8_WAIT_V(6); PG8_BAR; PG8_MMA(1, 1, At, B1); PG8_BAR;
            }
        }
        if constexpr (ALIGN_EPI) { if (wr == 0) PG8_BAR; }
        if constexpr (!Epi::AFTER_DRAIN) { E(acc, cur, wr, wc, fr, fq); S.done(cur); }
        if (!has_next) break;
#pragma unroll
        for (int a = 0; a < 2; ++a)
#pragma unroll
            for (int b = 0; b < 2; ++b)
#pragma unroll
                for (int m = 0; m < 4; ++m)
#pragma unroll
                    for (int n = 0; n < 2; ++n) acc[a][b][m][n] = (f32x4){0.f, 0.f, 0.f, 0.f};
        cur = nxt; cA = nA; cB = nB; ++ui;
        if constexpr (ALIGN_EPI) { if (wr == 1) PG8_BAR; }
    }
    PG8_WAIT_V(0);
    if constexpr (!ALIGN_EPI) { if (wr == 0) PG8_BAR; }
    PG8_BAR;
    if constexpr (Epi::AFTER_DRAIN) { E.fused(acc, cur, wr, wc, fr, fq, lds, wid, lane); S.done(cur); }
#undef PG8_SA
#undef PG8_SB
#undef PG8_STAGE
#undef PG8_LDA
#undef PG8_LDB
#undef PG8_MMA
#undef PG8_WAIT_V
#undef PG8_WAIT_L
#undef PG8_BAR
#undef PG8_SCHED
}
}

template <class RowMap, class Epi>
__device__ __forceinline__ void gemm_tile_f32(float* lds, const float* __restrict__ A, int lda, RowMap rowmap, int nvalid,
                                              const float* __restrict__ B, int ldb, int col0, int N, int K, Epi epi) {
    float* As = lds;
    float* Bs = lds + 128 * 17;
    const int tid = ltid(), lane = tid & 63, wid = tid >> 6, wm = wid & 3, wn = wid >> 2;
    const int arow = tid >> 2, akq = (tid & 3) * 4;
    const int src = (arow < nvalid) ? rowmap(arow) : -1;
    const float* ap = A + (size_t)(src < 0 ? 0 : src) * lda + akq;
    const int bk = tid >> 5, bn = (tid & 31) * 4;
    const bool bok = (col0 + bn) < N;
    const float* bp = B + (size_t)bk * ldb + col0 + bn;
    f32x16 acc0 = {}, acc1 = {};
    for (int k0 = 0; k0 < K; k0 += 16) {
        pg8::f32x4 av = (pg8::f32x4){0.f, 0.f, 0.f, 0.f}, bv = (pg8::f32x4){0.f, 0.f, 0.f, 0.f};
        if (src >= 0) av = *(const pg8::f32x4*)(ap + k0);
        if (bok) bv = *(const pg8::f32x4*)(bp + (size_t)k0 * ldb);
        __syncthreads();
        As[arow * 17 + akq + 0] = av[0]; As[arow * 17 + akq + 1] = av[1]; As[arow * 17 + akq + 2] = av[2]; As[arow * 17 + akq + 3] = av[3];
        *(pg8::f32x4*)(Bs + bk * 132 + bn) = bv;
        __syncthreads();
#pragma unroll
        for (int kk = 0; kk < 16; kk += 2) {
            const float a = As[(32 * wm + (lane & 31)) * 17 + kk + (lane >> 5)];
            const float b0 = Bs[(kk + (lane >> 5)) * 132 + 64 * wn + (lane & 31)];
            const float b1 = Bs[(kk + (lane >> 5)) * 132 + 64 * wn + 32 + (lane & 31)];
            acc0 = __builtin_amdgcn_mfma_f32_32x32x2f32(a, b0, acc0, 0, 0, 0);
            acc1 = __builtin_amdgcn_mfma_f32_32x32x2f32(a, b1, acc1, 0, 0, 0);
        }
    }
#pragma unroll
    for (int r = 0; r < 16; ++r) {
        const int i = 32 * wm + (r & 3) + 8 * (r >> 2) + 4 * (lane >> 5);
        const int c0 = col0 + 64 * wn + (lane & 31);
        if (i < nvalid) {
            if (c0 < N) epi(i, c0, acc0[r]);
            if (c0 + 32 < N) epi(i, c0 + 32, acc1[r]);
        }
    }
}

#include <hip/hip_bf16.h>
namespace attn_body {
using bf16=__hip_bfloat16;
using bf16x8=__attribute__((ext_vector_type(8)))short;
using s16x4=__attribute__((ext_vector_type(4)))short;
using f32x16=__attribute__((ext_vector_type(16)))float;
using u32x4=__attribute__((ext_vector_type(4)))unsigned;
typedef float f32x4_t __attribute__((ext_vector_type(4)));
constexpr int BATCH=2,NHEAD=8,SEQ=16384,D=64,DM=3584,OP=1024;
constexpr int NW=8,QBLK=32,QB=QBLK*NW,KVBLK=64,NQB=SEQ/QB;
constexpr int ATTN_PITCH=DM, ATTN_UNIT_ROWS=QB;
__device__ __forceinline__ int crow(int r,int hi){return (r&3)+8*(r>>2)+4*hi;}
#define SBAR() __builtin_amdgcn_sched_barrier(0)
__device__ __forceinline__ void cmask(f32x16&p0,f32x16&p1,int jb,int qrel,int hi){
  const float NEG=-INFINITY; int kb=64*jb+4*hi;
  #pragma unroll
  for(int r=0;r<16;++r){int kv=kb+(r&3)+8*(r>>2); if(kv>qrel)p0[r]=NEG; if(kv+32>qrel)p1[r]=NEG;}
}

constexpr int NSLOT=3, SLOTB=8192;
constexpr int LDS_K=0, LDS_V=NSLOT*SLOTB, LDS_WS=2*NSLOT*SLOTB, LDS_OST=LDS_WS+NW*64*4, LDS_BYTES=LDS_OST+NW*4096;
constexpr float C2=0.125f*1.4426950408889634f;
__device__ __forceinline__ void glds16(const void*gsrc,unsigned lds_dst){unsigned keep;
  asm volatile("s_mov_b32 %0, m0\n\ts_mov_b32 m0, %2\n\ts_nop 0\n\tglobal_load_lds_dwordx4 %1, off\n\ts_mov_b32 m0, %0":"=&s"(keep):"v"(gsrc),"s"(lds_dst):"memory");}
__device__ __forceinline__ float max3f(float a,float b,float c){float r;asm("v_max3_f32 %0, %1, %2, %3":"=v"(r):"v"(a),"v"(b),"v"(c));return r;}
__device__ __forceinline__ float max2f(float a,float b){float r;asm("v_max_f32_e32 %0, %1, %2":"=v"(r):"v"(a),"v"(b));return r;}
__device__ __forceinline__ float fadd_s(float a,float b){float r;asm("v_add_f32_e32 %0, %1, %2":"=v"(r):"v"(a),"v"(b));return r;}
__device__ __forceinline__ float fsub_s(float a,float b){float r;asm("v_sub_f32_e32 %0, %1, %2":"=v"(r):"v"(a),"v"(b));return r;}
typedef float f32x2_t __attribute__((ext_vector_type(2))); typedef __bf16 bf16x2_t __attribute__((ext_vector_type(2)));
__device__ __forceinline__ unsigned cvtpk_s(float lo,float hi){f32x2_t v={lo,hi};bf16x2_t b=__builtin_convertvector(v,bf16x2_t);return __builtin_bit_cast(unsigned,b);}
#define WAIT_BAR(N) asm volatile("s_waitcnt vmcnt(" #N ") lgkmcnt(0)\n\ts_barrier":::"memory")

__device__ __forceinline__ void qkt(f32x16&p0,f32x16&p1,const char*Kslot,const bf16x8*qr,int r32,int hi){
  const char*kb=Kslot+hi*1024+r32*16;
  #pragma unroll
  for(int d0=0;d0<4;++d0){
    const bf16x8 b0=*reinterpret_cast<const bf16x8*>(kb+d0*2048);
    const bf16x8 b1=*reinterpret_cast<const bf16x8*>(kb+d0*2048+512);
    p0=__builtin_amdgcn_mfma_f32_32x32x16_bf16(b0,qr[d0],p0,0,0,0);p1=__builtin_amdgcn_mfma_f32_32x32x16_bf16(b1,qr[d0],p1,0,0,0);}
}
typedef __attribute__((address_space(3))) const char* lds_cptr;
typedef short v4i16_t __attribute__((ext_vector_type(4)));
__device__ __forceinline__ void kload8(bf16x8*kf,lds_cptr kp){
  kf[0]=*(const __attribute__((address_space(3))) bf16x8*)(kp);      kf[1]=*(const __attribute__((address_space(3))) bf16x8*)(kp+512);
  kf[2]=*(const __attribute__((address_space(3))) bf16x8*)(kp+2048); kf[3]=*(const __attribute__((address_space(3))) bf16x8*)(kp+2560);
  kf[4]=*(const __attribute__((address_space(3))) bf16x8*)(kp+4096); kf[5]=*(const __attribute__((address_space(3))) bf16x8*)(kp+4608);
  kf[6]=*(const __attribute__((address_space(3))) bf16x8*)(kp+6144); kf[7]=*(const __attribute__((address_space(3))) bf16x8*)(kp+6656);
}
__device__ __forceinline__ void kload2(bf16x8*kf,lds_cptr kp,int j){ kf[2*j]=*(const __attribute__((address_space(3))) bf16x8*)(kp+j*2048); kf[2*j+1]=*(const __attribute__((address_space(3))) bf16x8*)(kp+j*2048+512); }
__device__ __forceinline__ s16x4 vtr(lds_cptr p){ return __builtin_bit_cast(s16x4,__builtin_amdgcn_ds_read_tr16_b64_v4i16((__attribute__((address_space(3))) v4i16_t*)p)); }
__device__ __forceinline__ float rowmax(const f32x16&p0,const f32x16&p1){
  float a=max3f(p0[0],p0[1],p1[0]),b=max3f(p0[2],p0[3],p1[1]);a=max3f(a,p1[2],p1[3]);
  #pragma unroll
  for(int r=4;r<16;r+=4){a=max3f(a,p0[r],p0[r+1]);b=max3f(b,p0[r+2],p0[r+3]);a=max3f(a,p1[r],p1[r+1]);b=max3f(b,p1[r+2],p1[r+3]);}
  const float m=max2f(a,b);
  auto rr=__builtin_amdgcn_permlane32_swap(__float_as_uint(m),__float_as_uint(m),false,false);
  return max2f(__uint_as_float(rr[0]),__uint_as_float(rr[1]));
}
__device__ __forceinline__ void pv(f32x16*o,int vb,bf16x8 pa0,bf16x8 pa1,bf16x8 pa2,bf16x8 pa3){
  #pragma unroll
  for(int d0=0;d0<2;++d0){s16x4 lo[4],hi[4];
    #pragma unroll
    for(int ks=0;ks<4;++ks){
      asm volatile("ds_read_b64_tr_b16 %0,%1 offset:%c2":"=&v"(lo[ks]):"v"(vb),"i"(d0*4096+ks*1024):"memory");
      asm volatile("ds_read_b64_tr_b16 %0,%1 offset:%c2":"=&v"(hi[ks]):"v"(vb),"i"(d0*4096+ks*1024+512):"memory");}
    asm volatile("s_waitcnt lgkmcnt(0)":::"memory");SBAR();
    #define PK(k) (bf16x8){lo[k][0],lo[k][1],lo[k][2],lo[k][3],hi[k][0],hi[k][1],hi[k][2],hi[k][3]}
    o[d0]=__builtin_amdgcn_mfma_f32_32x32x16_bf16(pa0,PK(0),o[d0],0,0,0);
    o[d0]=__builtin_amdgcn_mfma_f32_32x32x16_bf16(pa1,PK(1),o[d0],0,0,0);
    o[d0]=__builtin_amdgcn_mfma_f32_32x32x16_bf16(pa2,PK(2),o[d0],0,0,0);
    o[d0]=__builtin_amdgcn_mfma_f32_32x32x16_bf16(pa3,PK(3),o[d0],0,0,0);
    #undef PK
  }
}

#ifndef ATTN_STORE16
#define ATTN_STORE16(p,v) (*(u32x4*)(p)=(v))
#endif
template<int THRL> __device__ __forceinline__ void attn_unit(int b,int h,int qb,const bf16*Q,const bf16*__restrict__ K,const bf16*__restrict__ V,bf16*O,const unsigned char*KAg,char*shm){
  const int tid=ltid(),lane=tid&63,r32=lane&31,hi=lane>>5; const int wid=__builtin_amdgcn_readfirstlane(tid>>6);
  const long rowbase=(long)b*SEQ; const int q0=qb*QB;
  const bf16*Qw=Q+(rowbase+q0+wid*QBLK)*DM+h*D;
  const bf16*Kh=K+rowbase*DM+h*D,*Vh=V+rowbase*DM+h*D;
  const unsigned lds0=(unsigned)(uintptr_t)shm;
  float*wsf=(float*)(shm+LDS_WS)+wid*64;
  const bf16*ksrc=Kh+(long)lane*DM+wid*8;
  const bf16*vsrc=Vh+(long)(16*(wid&3)+(lane>>2))*DM+(wid>>2)*32+(lane&3)*8;
  const unsigned kdst=lds0+LDS_K+wid*1024, vdst=lds0+LDS_V+wid*1024;
  #define DMA_K(t,slot) glds16(ksrc+(long)(t)*KVBLK*DM,(unsigned)__builtin_amdgcn_readfirstlane(kdst+(slot)))
  #define DMA_V(t,slot) glds16(vsrc+(long)(t)*KVBLK*DM,(unsigned)__builtin_amdgcn_readfirstlane(vdst+(slot)))
  const int vb0=(int)(lds0+LDS_V)+((lane>>4)&1)*32+(lane&3)*8+(4*hi+((lane&15)>>2))*64;
  const char*Kbase=shm+LDS_K; bf16x8 kf[8];
  const lds_cptr shm3=(lds_cptr)shm; const lds_cptr kp0=shm3+LDS_K+hi*1024+r32*16; const lds_cptr vp0=shm3+LDS_V+((lane>>4)&1)*32+(lane&3)*8+(4*hi+((lane&15)>>2))*64;
  const int NT=(q0+QB)/KVBLK;
  u32x4 ka0,ka1; u32x4 qaw;
  const unsigned kavoff=(unsigned)r32*16u;
  const unsigned long long kab0=(unsigned long long)(uintptr_t)KAg+((unsigned long long)((b*NHEAD+h)*(long)SEQ))*16ull;
  #define KA_LOAD(t) do{ const unsigned long long a_=kab0+(unsigned long long)(t)*1024ull; const unsigned lo_=__builtin_amdgcn_readfirstlane((unsigned)a_),hi_=__builtin_amdgcn_readfirstlane((unsigned)(a_>>32)); \
    const unsigned long long sb_=((unsigned long long)hi_<<32)|lo_; \
    asm volatile("s_nop 4\n\tglobal_load_dwordx4 %0, %2, %3\n\tglobal_load_dwordx4 %1, %2, %3 offset:512":"=&v"(ka0),"=&v"(ka1):"v"(kavoff),"s"(sb_):"memory"); }while(0)
  #define QA_SET() do{ const float nm_=-mhat; const unsigned h_=cvtpk_s(nm_,0.f)&0xffffu; const float r1_=nm_-__uint_as_float(h_<<16); const unsigned m_=cvtpk_s(r1_,0.f)&0xffffu; \
    const float r2_=r1_-__uint_as_float(m_<<16); const unsigned l_=cvtpk_s(r2_,0.f)&0xffffu; \
    qaw[0]=hi?0u:0x3f803f80u; qaw[1]=hi?0u:(0x3f80u|(h_<<16)); qaw[2]=hi?0u:(m_|(l_<<16)); qaw[3]=0u; asm volatile("":"+v"(qaw)); }while(0)
  #define AUG(C0,C1) do{ C0=__builtin_amdgcn_mfma_f32_32x32x16_bf16(__builtin_bit_cast(bf16x8,ka0),__builtin_bit_cast(bf16x8,qaw),f32x16{},0,0,0); \
    C1=__builtin_amdgcn_mfma_f32_32x32x16_bf16(__builtin_bit_cast(bf16x8,ka1),__builtin_bit_cast(bf16x8,qaw),f32x16{},0,0,0); }while(0)
  #define PIN_KA() asm volatile("; KA landed":"+v"(ka0),"+v"(ka1)::"memory")
  #define WAIT_BAR_KA(N) do{ WAIT_BAR(N); PIN_KA(); }while(0)
  KA_LOAD(0);
  DMA_K(0,0);DMA_V(0,0);DMA_K(1,SLOTB);
  bf16x8 qr[4];
  #pragma unroll
  for(int d0=0;d0<4;++d0)qr[d0]=*reinterpret_cast<const bf16x8*>(&Qw[(long)r32*DM+d0*16+hi*8]);
  float mhat=0.f,l_reg=0.f;f32x16 o[2];o[0]=f32x16{};o[1]=f32x16{}; QA_SET();
  const int qrel=wid*QBLK+r32;
  #define CMASK(P0,P1,t) do{int jb_=(t)-(NT-4); if(jb_>=0)cmask(P0,P1,jb_,qrel,hi);}while(0)
  bool resc=false;
  #define START(P0,P1) do{ const float rm=rowmax(P0,P1); resc=false; \
    { const float dl=rm; mhat=fadd_s(mhat,dl); \
      _Pragma("unroll") for(int r=0;r<16;++r){P0[r]=fsub_s(P0[r],dl);P1[r]=fsub_s(P1[r],dl);} \
      QA_SET(); } \
    _Pragma("unroll") for(int r=0;r<16;++r)P0[r]=__builtin_amdgcn_exp2f(P0[r]); }while(0)
  #define RESC() do{ if(resc){ asm volatile("s_waitcnt lgkmcnt(0)":::"memory"); \
      _Pragma("unroll") for(int d_=0;d_<2;++d_) _Pragma("unroll") for(int r=0;r<16;++r)o[d_][r]*=wsf[crow(r,hi)]; } }while(0)
  f32x16 pA0,pA1,pB0,pB1;
  int sl_prev=0,sl_cur=0,sl_next=SLOTB;
  #define ROT() do{sl_prev=sl_cur;sl_cur=sl_next;sl_next=(sl_next==(NSLOT-1)*SLOTB)?0:sl_next+SLOTB;}while(0)
  DMA_K(2,2*SLOTB);
  WAIT_BAR_KA(3);
  AUG(pA0,pA1); qkt(pA0,pA1,Kbase,qr,r32,hi);asm volatile("s_nop 15\n\ts_nop 7":"+v"(pA0),"+v"(pA1));CMASK(pA0,pA1,0);
  START(pA0,pA1);
  _Pragma("unroll") for(int r=0;r<16;++r)pA1[r]=__builtin_amdgcn_exp2f(pA1[r]);
  WAIT_BAR(0);
  KA_LOAD(1);DMA_K(3,0);DMA_V(1,SLOTB);
  ROT();
  kload8(kf,kp0+sl_cur);
  WAIT_BAR_KA(2);
  s16x4 vlo[8],vhi[8]; u32x4 pw0,pw1,pw2,pw3;
  #define PKW(P,B) cvtpk_s(P[B],P[B+1])
  #define PAF(k) __builtin_bit_cast(bf16x8,pw##k)
  #define VFR(i) (bf16x8){vlo[i][0],vlo[i][1],vlo[i][2],vlo[i][3],vhi[i][0],vhi[i][1],vhi[i][2],vhi[i][3]}
  #define PIN(x) asm volatile("":"+v"(x))
  #define MX3(a,b,c) __builtin_fmaxf(__builtin_fmaxf((a),(b)),(c))
  #define GAPA(MF,A0,A1,A2,A3,W0,W1,PW) do{ MF; sacc+=A0; sacc+=A1; sacc+=A2; sacc+=A3; PIN(sacc); W0; W1; PIN(PW); SBAR(); }while(0)
  #define EX(v) __builtin_amdgcn_exp2f(v)
  #define GAPB(MF,X,B) do{ MF; X[B]=EX(X[B]); X[B+1]=EX(X[B+1]); X[B+2]=EX(X[B+2]); X[B+3]=EX(X[B+3]); PIN(X); SBAR(); }while(0)
  #define VRD(i) do{ vlo[i]=vtr(vp_+(((i)>>2)*4096+((i)&3)*1024)); vhi[i]=vtr(vp_+(((i)>>2)*4096+((i)&3)*1024+512)); }while(0)
  #define KRD(G,j) do{ if(G){ kload2(kf,kp0+sl_next,j); SBAR(); } }while(0)
  #define STEP(C0,C1,P0,P1,t,GK,GV,GL) do{ SBAR(); \
    const lds_cptr vp_=vp0+sl_prev; \
    AUG(C0,C1); SBAR(); \
    VRD(0); SBAR(); float sacc=(P0[0]+P0[1]); \
    GAPA(C0=__builtin_amdgcn_mfma_f32_32x32x16_bf16(kf[0],qr[0],C0,0,0,0), P0[2],P0[3],P0[4],P0[5],     pw0[0]=PKW(P0,0), pw0[1]=PKW(P0,2), pw0); \
    VRD(4); SBAR(); GAPA(C1=__builtin_amdgcn_mfma_f32_32x32x16_bf16(kf[1],qr[0],C1,0,0,0), P0[6],P0[7],P0[8],P0[9],     pw0[2]=PKW(P0,4), pw0[3]=PKW(P0,6), pw0); \
    VRD(1); SBAR(); GAPA(C0=__builtin_amdgcn_mfma_f32_32x32x16_bf16(kf[2],qr[1],C0,0,0,0),   P0[10],P0[11],P0[12],P0[13], pw1[0]=PKW(P0,8), pw1[1]=PKW(P0,10), pw1); \
    VRD(5); SBAR(); GAPA(C1=__builtin_amdgcn_mfma_f32_32x32x16_bf16(kf[3],qr[1],C1,0,0,0),   P0[14],P0[15],P1[0],P1[1],   pw1[2]=PKW(P0,12),pw1[3]=PKW(P0,14), pw1); \
    VRD(2); SBAR(); GAPA(C0=__builtin_amdgcn_mfma_f32_32x32x16_bf16(kf[4],qr[2],C0,0,0,0),   P1[2],P1[3],P1[4],P1[5],     pw2[0]=PKW(P1,0), pw2[1]=PKW(P1,2), pw2); \
    VRD(6); SBAR(); GAPA(C1=__builtin_amdgcn_mfma_f32_32x32x16_bf16(kf[5],qr[2],C1,0,0,0),   P1[6],P1[7],P1[8],P1[9],     pw2[2]=PKW(P1,4), pw2[3]=PKW(P1,6), pw2); \
    VRD(3); SBAR(); GAPA(C0=__builtin_amdgcn_mfma_f32_32x32x16_bf16(kf[6],qr[3],C0,0,0,0),   P1[10],P1[11],P1[12],P1[13], pw3[0]=PKW(P1,8), pw3[1]=PKW(P1,10), pw3); \
    VRD(7); SBAR(); GAPA(C1=__builtin_amdgcn_mfma_f32_32x32x16_bf16(kf[7],qr[3],C1,0,0,0),   P1[14],P1[15],0.f,0.f,       pw3[2]=PKW(P1,12),pw3[3]=PKW(P1,14), pw3); \
    l_reg+=sacc; \
    if(GL){KA_LOAD((t)+1);} if(GK){DMA_K((t)+3,sl_cur);} if(GV){DMA_V((t)+1,sl_next);} \
    CMASK(C0,C1,t); \
    { float a=MX3(C0[0],C0[1],C1[0]),b=MX3(C0[2],C0[3],C1[1]); a=MX3(a,C1[2],C1[3]); \
      _Pragma("unroll") for(int r=4;r<16;r+=4){a=MX3(a,C0[r],C0[r+1]);b=MX3(b,C0[r+2],C0[r+3]);a=MX3(a,C1[r],C1[r+1]);b=MX3(b,C1[r+2],C1[r+3]);} \
      float rm=__builtin_fmaxf(a,b); { auto rr=__builtin_amdgcn_permlane32_swap(__float_as_uint(rm),__float_as_uint(rm),false,false); rm=__builtin_fmaxf(__uint_as_float(rr[0]),__uint_as_float(rr[1])); } \
      resc=false; \
      if(__builtin_expect(__any(rm>(float)THRL),0)){ const float dl=__builtin_fmaxf(rm,0.f); mhat+=dl; \
        _Pragma("unroll") for(int r=0;r<16;++r){C0[r]-=dl;C1[r]-=dl;} \
        QA_SET(); \
        const float f=__builtin_amdgcn_exp2f(-dl); l_reg*=f; if(hi==0)wsf[r32]=f; resc=true; } } \
    SBAR(); \
    GAPB(o[0]=__builtin_amdgcn_mfma_f32_32x32x16_bf16(PAF(0),VFR(0),o[0],0,0,0), C0,0); \
    GAPB(o[1]=__builtin_amdgcn_mfma_f32_32x32x16_bf16(PAF(0),VFR(4),o[1],0,0,0), C0,4); \
    KRD(GL,0); GAPB(o[0]=__builtin_amdgcn_mfma_f32_32x32x16_bf16(PAF(1),VFR(1),o[0],0,0,0), C0,8); \
    KRD(GL,1); GAPB(o[1]=__builtin_amdgcn_mfma_f32_32x32x16_bf16(PAF(1),VFR(5),o[1],0,0,0), C0,12); \
    KRD(GL,2); GAPB(o[0]=__builtin_amdgcn_mfma_f32_32x32x16_bf16(PAF(2),VFR(2),o[0],0,0,0), C1,0); \
    KRD(GL,3); GAPB(o[1]=__builtin_amdgcn_mfma_f32_32x32x16_bf16(PAF(2),VFR(6),o[1],0,0,0), C1,4); \
    GAPB(o[0]=__builtin_amdgcn_mfma_f32_32x32x16_bf16(PAF(3),VFR(3),o[0],0,0,0), C1,8); \
    GAPB(o[1]=__builtin_amdgcn_mfma_f32_32x32x16_bf16(PAF(3),VFR(7),o[1],0,0,0), C1,12); \
    }while(0)
  int t=1;
  #undef CMASK
  #define CMASK(P0,P1,t) do{}while(0)
  for(;t+5<NT;t+=2){
    STEP(pB0,pB1,pA0,pA1,t,true,true,true);     WAIT_BAR_KA(2); RESC(); ROT();
    STEP(pA0,pA1,pB0,pB1,t+1,true,true,true);   WAIT_BAR_KA(2); RESC(); ROT();
  }
  #undef CMASK
  #define CMASK(P0,P1,t) do{int jb_=(t)-(NT-4); if(jb_>=0)cmask(P0,P1,jb_,qrel,hi);}while(0)
  #define ENDW(tt) do{ if((tt)+3<NT){WAIT_BAR(2);} else if((tt)+2<NT){WAIT_BAR(1);} else {WAIT_BAR(0);} PIN_KA(); }while(0)
  for(;t+1<NT;t+=2){
    STEP(pB0,pB1,pA0,pA1,t,(t+3<NT),(t+1<NT),(t+1<NT));       ENDW(t);   RESC(); ROT();
    STEP(pA0,pA1,pB0,pB1,t+1,(t+4<NT),(t+2<NT),(t+2<NT));     ENDW(t+1); RESC(); ROT();
  }
  STEP(pB0,pB1,pA0,pA1,NT-1,false,false,false); RESC();
  { float sacc=pB0[0]+pB0[1]; _Pragma("unroll") for(int r=2;r<16;++r)sacc+=pB0[r]; _Pragma("unroll") for(int r=0;r<16;++r)sacc+=pB1[r]; l_reg+=sacc;
    pw0=(u32x4){PKW(pB0,0),PKW(pB0,2),PKW(pB0,4),PKW(pB0,6)};pw1=(u32x4){PKW(pB0,8),PKW(pB0,10),PKW(pB0,12),PKW(pB0,14)};pw2=(u32x4){PKW(pB1,0),PKW(pB1,2),PKW(pB1,4),PKW(pB1,6)};pw3=(u32x4){PKW(pB1,8),PKW(pB1,10),PKW(pB1,12),PKW(pB1,14)};
    SBAR(); pv(o,vb0+sl_cur,PAF(0),PAF(1),PAF(2),PAF(3)); }
  #undef PKW
  #undef PAF
  #undef VFR
  #undef PIN
  #undef MX3
  #undef GAPA
  #undef GAPB
  #undef EX
  #undef VRD
  #undef KRD
  #undef STEP
  #undef ENDW
  {auto rr=__builtin_amdgcn_permlane32_swap(__float_as_uint(l_reg),__float_as_uint(l_reg),false,false);l_reg=__uint_as_float(rr[0])+__uint_as_float(rr[1]);}
  if(hi==0)wsf[32+r32]=l_reg;asm volatile("s_waitcnt lgkmcnt(0)":::"memory");
  float rli[16];
  #pragma unroll
  for(int r=0;r<16;++r)rli[r]=__builtin_amdgcn_rcpf(wsf[32+crow(r,hi)]);
  bf16*Ow=O+(rowbase+q0+wid*QBLK)*OP+h*D;
  { bf16*stg=(bf16*)(shm+LDS_OST)+wid*2048;
    #pragma unroll
    for(int r=0;r<16;++r){const int orow=crow(r,hi);
      #pragma unroll
      for(int d0=0;d0<2;++d0)stg[orow*64+d0*32+r32]=__float2bfloat16(o[d0][r]*rli[r]);}
    asm volatile("s_waitcnt lgkmcnt(0)":::"memory");
    #pragma unroll
    for(int i=0;i<4;++i){const int row=i*8+(lane>>3),ch=lane&7; const u32x4 v=*(const u32x4*)(stg+row*64+ch*8); ATTN_STORE16(Ow+(long)row*OP+ch*8,v);} }
  asm volatile("s_waitcnt lgkmcnt(0)\n\ts_barrier":::"memory");
  #undef DMA_K
  #undef DMA_V
  #undef KA_LOAD
  #undef QA_SET
  #undef AUG
  #undef WAIT_BAR_KA
  #undef PIN_KA
  #undef CMASK
  #undef START
  #undef RESC
  #undef ROT
}
constexpr int ATTN_LDS_BYTES=LDS_BYTES;
struct AttnTensors { const bf16* Q; const bf16* K; const bf16* V; bf16* O; const unsigned char* KA; };
struct AttnUnit { int bh; int qb; };
struct StaticOrder {
  int vcu;
  __device__ __forceinline__ explicit StaticOrder(int grid,int block):vcu((block%8)*(grid/8)+block/8){}
  __device__ __forceinline__ bool next(int i,AttnUnit&u)const{ if(i>=4)return false; const int s=vcu&15; u.bh=vcu>>4; u.qb=(i==0)?63-s:(i==1)?32+s:(i==2)?31-s:s; return true; }
  __device__ __forceinline__ void a_ready(const AttnUnit&)const{}
  __device__ __forceinline__ void done(const AttnUnit&)const{}
};
template<class Sched,int THRL=8> __device__ __forceinline__ void attn_phase(char*lds,const AttnTensors&T,const Sched&S){
  AttnUnit u;
  for(int i=0;S.next(i,u);++i){ S.a_ready(u); attn_unit<THRL>(u.bh/NHEAD,u.bh%NHEAD,u.qb,T.Q,T.K,T.V,T.O,T.KA,lds); S.done(u); }
}
#undef SBAR
#undef WAIT_BAR
}

namespace ck {
#define CK_LAS __attribute__((address_space(3)))
typedef unsigned short bf16_t;
typedef short bf16x8 __attribute__((ext_vector_type(8)));
typedef float f32x16 __attribute__((ext_vector_type(16)));
typedef float f32x4 __attribute__((ext_vector_type(4)));
typedef unsigned u32x4 __attribute__((ext_vector_type(4)));
typedef unsigned u32x2 __attribute__((ext_vector_type(2)));
typedef CK_LAS unsigned short* lbf;
typedef CK_LAS float* lf32;
constexpr int SB = 72;
constexpr int B9 = 64 * SB * 2;
constexpr int SF = 65;
constexpr int SM = 68;
constexpr int SX = 132;
__device__ __forceinline__ unsigned f2bf(float f) { unsigned u = __builtin_bit_cast(unsigned, f); return (u + 0x7fffu + ((u >> 16) & 1u)) >> 16; }
__device__ __forceinline__ unsigned pk2(float lo, float hi) { return f2bf(lo) | (f2bf(hi) << 16); }
__device__ __forceinline__ float bflo(unsigned w) { return __builtin_bit_cast(float, w << 16); }
__device__ __forceinline__ float bfhi(unsigned w) { return __builtin_bit_cast(float, w & 0xffff0000u); }
__device__ __forceinline__ int crow(int reg, int hh) { return (reg & 3) + 8 * (reg >> 2) + 4 * hh; }
__device__ __forceinline__ f32x16 mm_lds(lbf A, lbf BT, int I, int J, int lane, f32x16 acc) {
    const int r = lane & 31, hh = lane >> 5;
    const lbf ap = A + (32 * I + r) * SB + 8 * hh; const lbf bp = BT + (32 * J + r) * SB + 8 * hh;
#pragma unroll
    for (int s = 0; s < 4; ++s) { const bf16x8 a = *(const CK_LAS bf16x8*)(ap + 16 * s); const bf16x8 b = *(const CK_LAS bf16x8*)(bp + 16 * s); acc = __builtin_amdgcn_mfma_f32_32x32x16_bf16(a, b, acc, 0, 0, 0); }
    return acc;
}
__device__ __forceinline__ f32x16 mm_gA(const bf16_t* __restrict__ Ag, lbf BT, int I, int J, int lane, f32x16 acc) {
    const int r = lane & 31, hh = lane >> 5;
    bf16x8 a[4];
#pragma unroll
    for (int s = 0; s < 4; ++s) a[s] = *(const bf16x8*)(Ag + (32 * I + r) * 64 + 16 * s + 8 * hh);
    const lbf bp = BT + (32 * J + r) * SB + 8 * hh;
#pragma unroll
    for (int s = 0; s < 4; ++s) { const bf16x8 b = *(const CK_LAS bf16x8*)(bp + 16 * s); acc = __builtin_amdgcn_mfma_f32_32x32x16_bf16(a[s], b, acc, 0, 0, 0); }
    return acc;
}
__device__ __forceinline__ f32x16 mm_gg(const bf16_t* __restrict__ Ag, const bf16_t* __restrict__ BTg, int I, int J, int lane, f32x16 acc) {
    const int r = lane & 31, hh = lane >> 5;
#pragma unroll
    for (int s = 0; s < 4; ++s) { const bf16x8 a = *(const bf16x8*)(Ag + (32 * I + r) * 64 + 16 * s + 8 * hh); const bf16x8 b = *(const bf16x8*)(BTg + (32 * J + r) * 64 + 16 * s + 8 * hh);
        acc = __builtin_amdgcn_mfma_f32_32x32x16_bf16(a, b, acc, 0, 0, 0); }
    return acc;
}
__device__ __forceinline__ void frag_store(float* __restrict__ g, int wq, int lane, const f32x16& acc) {
    f32x4* p = (f32x4*)(g + ((size_t)(wq * 64 + lane)) * 16);
    p[0] = (f32x4){acc[0], acc[1], acc[2], acc[3]}; p[1] = (f32x4){acc[4], acc[5], acc[6], acc[7]}; p[2] = (f32x4){acc[8], acc[9], acc[10], acc[11]}; p[3] = (f32x4){acc[12], acc[13], acc[14], acc[15]};
}
__device__ __forceinline__ f32x16 frag_load(const float* __restrict__ g, int wq, int lane) {
    const f32x4* p = (const f32x4*)(g + ((size_t)(wq * 64 + lane)) * 16); const f32x4 a = p[0], b = p[1], c = p[2], d = p[3];
    return (f32x16){a[0], a[1], a[2], a[3], b[0], b[1], b[2], b[3], c[0], c[1], c[2], c[3], d[0], d[1], d[2], d[3]};
}
__device__ __forceinline__ void tile_store_T(lbf dst, int I, int J, int lane, const f32x16& acc) {
    const int r = lane & 31, hh = lane >> 5;
#pragma unroll
    for (int g = 0; g < 4; ++g) { u32x2 w; w.x = pk2(acc[4 * g], acc[4 * g + 1]); w.y = pk2(acc[4 * g + 2], acc[4 * g + 3]);
        *(CK_LAS u32x2*)(dst + (32 * J + r) * SB + 32 * I + 8 * g + 4 * hh) = w; }
}
__device__ __forceinline__ float fexp(float x) { return __builtin_amdgcn_exp2f(x * 1.4426950408889634f); }
__device__ __forceinline__ float sigm(float x) { return __builtin_amdgcn_rcpf(1.0f + fexp(-x)); }
__device__ __forceinline__ float ftanh(float x) { const float xc = fminf(fmaxf(x, -15.f), 15.f); return 1.0f - 2.0f * __builtin_amdgcn_rcpf(fexp(2.0f * xc) + 1.0f); }
__device__ __forceinline__ float logsig(float x) { const float ax = fabsf(x); return fminf(x, 0.f) - 0.6931471805599453f * __builtin_amdgcn_logf(1.0f + fexp(-ax)); }
template <int CTRL> __device__ __forceinline__ float dpp_f(float v) { return __builtin_bit_cast(float, __builtin_amdgcn_update_dpp(0, __builtin_bit_cast(int, v), CTRL, 0xf, 0xf, false)); }
__device__ __forceinline__ float quad_sum(float v) { v += dpp_f<0xB1>(v); v += dpp_f<0x4E>(v); return v; }

constexpr size_t O_PC = 0, O_QC = 16u << 20, O_GY = 48u << 20, O_YL = 64u << 20, O_VG = 96u << 20, O_GG = 112u << 20, O_H0 = 128u << 20, O_RKD = 144u << 20, O_KV = 145u << 20, O_RT = 177u << 20, O_END = 193u << 20;
struct RwkvParams {
    const float *mu_rkv, *mu_lora, *w0, *a0, *k_k, *k_a, *r_k, *ln_g, *ln_b, *gn_g;
    const bf16_t *w2t, *a2t, *g2t;
};

constexpr int L_U = 10 * B9, L_MM = L_U + 36864, L_GL = L_MM + 64 * SM * 4, L_END1 = L_GL + 256;
__device__ __forceinline__ void rwkv_stage1(CK_LAS unsigned char* lds, int item, const bf16_t* __restrict__ Pb, int PW, int C_RR, int C_RK, int C_RV, int C_WD, int SEQ, const RwkvParams& p, unsigned char* __restrict__ cw) {
    const int tid = ltid(), lane = tid & 63, wid = __builtin_amdgcn_readfirstlane(tid >> 6), quad = wid >> 2, wq = wid & 3, I = wq >> 1, J = wq & 1, r = lane & 31, hh = lane >> 5;
    const int b = item >> 10, h = (item >> 8) & 3, c = item & 255;
    const size_t m0 = (size_t)b * SEQ + (size_t)c * 64;
    const lbf Am = (lbf)(lds), Bm = (lbf)(lds + B9), Km = (lbf)(lds + 2 * B9), Rm = (lbf)(lds + 3 * B9), VT = (lbf)(lds + 4 * B9), BhT = (lbf)(lds + 5 * B9), KhT = (lbf)(lds + 6 * B9),
              Nm = (lbf)(lds + 7 * B9), Wb = (lbf)(lds + 8 * B9), Wk = (lbf)(lds + 9 * B9);
    const lbf TW = (lbf)(lds + L_U), AD = (lbf)(lds + L_U + B9), SG0 = (lbf)(lds + L_U + 2 * B9), SG1 = (lbf)(lds + L_U + 3 * B9);
    const lbf W2T = BhT, A2T = KhT, G2Ta = Nm, G2Tb = Wb;
    const lf32 X = (lf32)(lds + L_U), MM = (lf32)(lds + L_MM), GL = (lf32)(lds + L_GL);
    const lf32 AA = (lf32)(lds), GGl = (lf32)(lds + 2 * B9);
    const lbf ZlT = Km, X1T = Nm;
    const int t = tid >> 3, c8 = (tid & 7) * 8;
    const size_t m = m0 + t; const bool hp = (c * 64 + t) > 0;
    const bf16_t* pr = Pb + m * PW; const bf16_t* pp = pr - PW;
    float rr[8], kx[8], vv[8];
    {
        const u32x4 z4 = (u32x4){0u, 0u, 0u, 0u};
        const u32x4 cr = *(const u32x4*)(pr + C_RR + h * 64 + c8), ckk = *(const u32x4*)(pr + C_RK + h * 64 + c8), cv = *(const u32x4*)(pr + C_RV + h * 64 + c8);
        const u32x4 qr = hp ? *(const u32x4*)(pp + C_RR + h * 64 + c8) : z4, qk = hp ? *(const u32x4*)(pp + C_RK + h * 64 + c8) : z4, qv = hp ? *(const u32x4*)(pp + C_RV + h * 64 + c8) : z4;
#pragma unroll
        for (int e = 0; e < 8; ++e) { const int ch = h * 64 + c8 + e;
            const float a_ = (e & 1) ? bfhi(cr[e >> 1]) : bflo(cr[e >> 1]), b_ = (e & 1) ? bfhi(qr[e >> 1]) : bflo(qr[e >> 1]); rr[e] = a_ + (b_ - a_) * p.mu_rkv[ch];
            const float c_ = (e & 1) ? bfhi(ckk[e >> 1]) : bflo(ckk[e >> 1]), d_ = (e & 1) ? bfhi(qk[e >> 1]) : bflo(qk[e >> 1]); kx[e] = c_ + (d_ - c_) * p.mu_rkv[256 + ch];
            const float e_ = (e & 1) ? bfhi(cv[e >> 1]) : bflo(cv[e >> 1]), f_ = (e & 1) ? bfhi(qv[e >> 1]) : bflo(qv[e >> 1]); vv[e] = e_ + (f_ - e_) * p.mu_rkv[512 + ch]; }
#pragma unroll
        for (int q = 0; q < 4; ++q) { const u32x4 cl = *(const u32x4*)(pr + C_WD + q * 64 + c8); const u32x4 ql = hp ? *(const u32x4*)(pp + C_WD + q * 64 + c8) : z4;
            float lo[8];
#pragma unroll
            for (int e = 0; e < 8; ++e) { const float a_ = (e & 1) ? bfhi(cl[e >> 1]) : bflo(cl[e >> 1]), b_ = (e & 1) ? bfhi(ql[e >> 1]) : bflo(ql[e >> 1]); const float x = a_ + (b_ - a_) * p.mu_lora[q * 64 + c8 + e];
                lo[e] = (q == 0) ? ftanh(x) : (q == 1 ? x : sigm(x)); }
            u32x4 w; w.x = pk2(lo[0], lo[1]); w.y = pk2(lo[2], lo[3]); w.z = pk2(lo[4], lo[5]); w.w = pk2(lo[6], lo[7]);
            *(CK_LAS u32x4*)((q == 0 ? TW : q == 1 ? AD : q == 2 ? SG0 : SG1) + t * SB + c8) = w; }
        *(CK_LAS u32x4*)(W2T + t * SB + c8) = *(const u32x4*)(p.w2t + ((size_t)h * 64 + t) * 64 + c8);
        *(CK_LAS u32x4*)(A2T + t * SB + c8) = *(const u32x4*)(p.a2t + ((size_t)h * 64 + t) * 64 + c8);
        *(CK_LAS u32x4*)(G2Ta + t * SB + c8) = *(const u32x4*)(p.g2t + ((size_t)h * 64 + t) * 128 + c8);
        *(CK_LAS u32x4*)(G2Tb + t * SB + c8) = *(const u32x4*)(p.g2t + ((size_t)h * 64 + t) * 128 + 64 + c8);
    }
    __syncthreads();
    if (quad == 0) {
        f32x16 z = mm_lds(TW, W2T, I, J, lane, f32x16{}); f32x16 za = mm_lds(AD, A2T, I, J, lane, f32x16{});
        const int ch = 32 * J + r; const float w0c = p.w0[h * 64 + ch], a0c = p.a0[h * 64 + ch];
#pragma unroll
        for (int g = 0; g < 16; ++g) { const int tt = 32 * I + crow(g, hh); const float lw = logsig(w0c + z[g]) - 0.5f; MM[tt * SF + ch] = -fexp(lw); AA[tt * SF + ch] = sigm(a0c + za[g]); }
    } else {
        f32x16 zg = mm_lds(SG0, G2Ta, I, J, lane, f32x16{}); zg = mm_lds(SG1, G2Tb, I, J, lane, zg);
        const int ch = 32 * J + r;
#pragma unroll
        for (int g = 0; g < 16; ++g) { const int tt = 32 * I + crow(g, hh); GGl[tt * SF + ch] = zg[g]; }
    }
    __syncthreads();
    {
        const int ch = tid & 63, seg = tid >> 6; float v8[8]; float run = 0.f;
#pragma unroll
        for (int i = 0; i < 8; ++i) { run += MM[(seg * 8 + i) * SF + ch]; v8[i] = run; }
        const lf32 TOT = (lf32)(lds + L_U);
        TOT[seg * 64 + ch] = run;
        __syncthreads();
        float off = 0.f;
#pragma unroll
        for (int s2 = 0; s2 < 8; ++s2) off += (s2 < seg) ? TOT[s2 * 64 + ch] : 0.f;
#pragma unroll
        for (int i = 0; i < 8; ++i) MM[(seg * 8 + i) * SF + ch] = v8[i] + off;
    }
    __syncthreads();
    float aa[8], gg[8], lw[8], lwp[8], lwl[8];
#pragma unroll
    for (int e = 0; e < 8; ++e) { aa[e] = AA[t * SF + c8 + e]; gg[e] = GGl[t * SF + c8 + e]; lw[e] = MM[t * SF + c8 + e]; lwp[e] = t > 0 ? MM[(t - 1) * SF + c8 + e] : 0.f; lwl[e] = MM[63 * SF + c8 + e]; }
    __syncthreads();
    {
        float kk[8], k2[8]; float ss = 0.f, rk = 0.f;
#pragma unroll
        for (int e = 0; e < 8; ++e) { const int ch = h * 64 + c8 + e; kk[e] = kx[e] * p.k_k[ch]; ss += kk[e] * kk[e]; k2[e] = kx[e] * (1.0f + (aa[e] - 1.0f) * p.k_a[ch]); rk += rr[e] * k2[e] * p.r_k[ch]; }
        ss += __shfl_xor(ss, 1); ss += __shfl_xor(ss, 2); ss += __shfl_xor(ss, 4); rk += __shfl_xor(rk, 1); rk += __shfl_xor(rk, 2); rk += __shfl_xor(rk, 4);
        const float inv = 1.0f / fmaxf(sqrtf(ss), 1e-12f);
        float am[8], bm[8], km[8], rm[8];
#pragma unroll
        for (int e = 0; e < 8; ++e) { kk[e] *= inv; const float g_ = fexp(lw[e]), gi = fexp(-lw[e]), gp = fexp(lwp[e]), gl = fexp(lwl[e] - lw[e]); const float ka = kk[e] * aa[e];
            am[e] = -kk[e] * gp; bm[e] = ka * gi; km[e] = k2[e] * gi; rm[e] = rr[e] * g_;
            VT[(c8 + e) * SB + t] = (bf16_t)f2bf(vv[e]); BhT[(c8 + e) * SB + t] = (bf16_t)f2bf(ka * gl); KhT[(c8 + e) * SB + t] = (bf16_t)f2bf(k2[e] * gl);
            X[t * SX + c8 + e] = am[e]; }
        u32x4 w;
        w.x = pk2(am[0], am[1]); w.y = pk2(am[2], am[3]); w.z = pk2(am[4], am[5]); w.w = pk2(am[6], am[7]); *(CK_LAS u32x4*)(Am + t * SB + c8) = w;
        w.x = pk2(bm[0], bm[1]); w.y = pk2(bm[2], bm[3]); w.z = pk2(bm[4], bm[5]); w.w = pk2(bm[6], bm[7]); *(CK_LAS u32x4*)(Bm + t * SB + c8) = w;
        w.x = pk2(km[0], km[1]); w.y = pk2(km[2], km[3]); w.z = pk2(km[4], km[5]); w.w = pk2(km[6], km[7]); *(CK_LAS u32x4*)(Km + t * SB + c8) = w;
        w.x = pk2(rm[0], rm[1]); w.y = pk2(rm[2], rm[3]); w.z = pk2(rm[4], rm[5]); w.w = pk2(rm[6], rm[7]); *(CK_LAS u32x4*)(Rm + t * SB + c8) = w;
        if (t == 63) {
#pragma unroll
            for (int e = 0; e < 8; ++e) GL[c8 + e] = fexp(lwl[e]); }
        w.x = pk2(vv[0], vv[1]); w.y = pk2(vv[2], vv[3]); w.z = pk2(vv[4], vv[5]); w.w = pk2(vv[6], vv[7]); *(u32x4*)(cw + O_VG + (size_t)item * 8192 + (t * 64 + c8) * 2) = w;
        w.x = pk2(gg[0], gg[1]); w.y = pk2(gg[2], gg[3]); w.z = pk2(gg[4], gg[5]); w.w = pk2(gg[6], gg[7]); *(u32x4*)(cw + O_GG + (size_t)item * 8192 + (t * 64 + c8) * 2) = w;
        if ((tid & 7) == 0) *(float*)(cw + O_RKD + (size_t)item * 256 + t * 4) = rk;
    }
    __syncthreads();
    {
        const f32x16 p1 = mm_lds(Am, quad == 0 ? Bm : Km, I, J, lane, f32x16{}); const f32x16 p2 = mm_lds(Rm, quad == 0 ? Bm : Km, I, J, lane, f32x16{});
        const int ii = 32 * J + r;
#pragma unroll
        for (int g = 0; g < 16; ++g) { const int tt = 32 * I + crow(g, hh);
            if (quad == 0) { MM[tt * SM + (ii & 3) * 16 + (ii >> 2)] = (ii < tt) ? p1[g] : 0.f; Wb[tt * SB + ii] = (bf16_t)f2bf((ii <= tt) ? p2[g] : 0.f); }
            else { Nm[tt * SB + ii] = (bf16_t)f2bf((ii < tt) ? p1[g] : 0.f); Wk[tt * SB + ii] = (bf16_t)f2bf((ii <= tt) ? p2[g] : 0.f); } }
    }
    __syncthreads();
    if (quad == 0) { const f32x16 nv = mm_lds(Nm, VT, I, J, lane, f32x16{}); const int vcol = 64 + 32 * J + r;
#pragma unroll
        for (int g = 0; g < 16; ++g) X[(32 * I + crow(g, hh)) * SX + vcol] = nv[g]; }
    __syncthreads();
    {
        const int col = tid >> 2, q = tid & 3;
        float xs[16];
#pragma unroll
        for (int k = 0; k < 16; ++k) xs[k] = X[(q + 4 * k) * SX + col];
#pragma unroll
        for (int tt = 1; tt < 64; ++tt) {
            const CK_LAS f32x4* mr = (const CK_LAS f32x4*)(MM + tt * SM + q * 16);
            float s0 = 0.f, s1 = 0.f, s2 = 0.f, s3 = 0.f;
#pragma unroll
            for (int k4 = 0; k4 < (tt + 15) / 16; ++k4) { const f32x4 mv = mr[k4]; s0 += mv[0] * xs[4 * k4]; s1 += mv[1] * xs[4 * k4 + 1]; s2 += mv[2] * xs[4 * k4 + 2]; s3 += mv[3] * xs[4 * k4 + 3]; }
            const float sm = quad_sum((s0 + s1) + (s2 + s3));
            xs[tt >> 2] += (q == (tt & 3)) ? sm : 0.f;
        }
        const lbf dstT = (col < 64) ? (X1T + col * SB) : (ZlT + (col - 64) * SB);
#pragma unroll
        for (int k = 0; k < 16; ++k) dstT[q + 4 * k] = (bf16_t)f2bf(xs[k]);
    }
    __syncthreads();
    if (quad == 0) {
        const f32x16 gy = mm_lds(Wb, X1T, I, J, lane, f32x16{}); const f32x16 pc = mm_lds(BhT, X1T, I, J, lane, f32x16{});
        bf16_t* gyg = (bf16_t*)(cw + O_GY + (size_t)item * 8192); bf16_t* pcg = (bf16_t*)(cw + O_PC + (size_t)item * 8192);
        const int cc = 32 * J + r;
#pragma unroll
        for (int g = 0; g < 16; ++g) { const int rw = 32 * I + crow(g, hh);
            gyg[rw * 64 + cc] = (bf16_t)f2bf(gy[g] + __builtin_bit_cast(float, (unsigned)Rm[rw * SB + cc] << 16));
            pcg[rw * 64 + cc] = (bf16_t)f2bf(pc[g] + (rw == cc ? GL[cc] : 0.f)); }
    } else {
        f32x16 yl = mm_lds(ZlT, Wb, I, J, lane, f32x16{}); yl = mm_lds(VT, Wk, I, J, lane, yl);
        f32x16 qc = mm_lds(BhT, ZlT, I, J, lane, f32x16{}); qc = mm_lds(KhT, VT, I, J, lane, qc);
        frag_store((float*)(cw + O_YL + (size_t)item * 16384), wq, lane, yl); frag_store((float*)(cw + O_QC + (size_t)item * 16384), wq, lane, qc);
    }
    __syncthreads();
}

__device__ __forceinline__ void rwkv_scan(CK_LAS unsigned char* lds, int chain, unsigned char* __restrict__ cw) {
    const int tid = ltid(), lane = tid & 63, wid = __builtin_amdgcn_readfirstlane(tid >> 6), quad = wid >> 2, wq = wid & 3, I = wq >> 1, J = wq & 1, r = lane & 31, hh = lane >> 5, qtid = tid & 255;
    const lbf HT = (lbf)(lds + quad * B9);
    for (int i = qtid; i < 64 * SB / 2; i += 256) ((CK_LAS unsigned*)HT)[i] = 0u;
    __syncthreads();
    const bool on = chain >= 0; const size_t it0 = (size_t)(on ? chain : 0) * 256;
    const bf16_t* pcg = (const bf16_t*)(cw + O_PC) + it0 * 4096; const float* qcg = (const float*)(cw + O_QC) + it0 * 4096; bf16_t* h0g = (bf16_t*)(cw + O_H0) + it0 * 4096;
    bf16x8 a0[4], a1[4]; f32x16 q0, q1;
#define CK_LOADSTEP(A_, Q_, cc) do { const int c_ = (cc) < 256 ? (cc) : 255; _Pragma("unroll") for (int s_ = 0; s_ < 4; ++s_) A_[s_] = *(const bf16x8*)(pcg + (size_t)c_ * 4096 + (32 * I + r) * 64 + 16 * s_ + 8 * hh); Q_ = frag_load(qcg + (size_t)c_ * 4096, wq, lane); } while (0)
    CK_LOADSTEP(a0, q0, 0); CK_LOADSTEP(a1, q1, 1);
    for (int c = 0; c < 256; c += 2) {
#pragma unroll
        for (int half = 0; half < 2; ++half) {
            const int cc = c + half;
            if (on) { const int row = qtid >> 2, seg = (qtid & 3) * 16; const u32x4 w0 = *(const CK_LAS u32x4*)(HT + row * SB + seg), w1 = *(const CK_LAS u32x4*)(HT + row * SB + seg + 8);
                      u32x4* dst = (u32x4*)(h0g + (size_t)cc * 4096 + row * 64 + seg); dst[0] = w0; dst[1] = w1; }
            f32x16 acc = half == 0 ? q0 : q1;
            const lbf bp = HT + (32 * J + r) * SB + 8 * hh;
#pragma unroll
            for (int s_ = 0; s_ < 4; ++s_) { const bf16x8 bfr = *(const CK_LAS bf16x8*)(bp + 16 * s_); acc = __builtin_amdgcn_mfma_f32_32x32x16_bf16(half == 0 ? a0[s_] : a1[s_], bfr, acc, 0, 0, 0); }
            if (half == 0) CK_LOADSTEP(a0, q0, cc + 2); else CK_LOADSTEP(a1, q1, cc + 2);
            __syncthreads();
            tile_store_T(HT, I, J, lane, acc);
            __syncthreads();
        }
    }
#undef CK_LOADSTEP
}

__device__ __forceinline__ void rwkv_stage3(CK_LAS unsigned char* ldsq, int item, const RwkvParams& p, const unsigned char* __restrict__ cw, bf16_t* __restrict__ MIXB, int SEQ) {
    const int tid = ltid(), lane = tid & 63, wid = __builtin_amdgcn_readfirstlane(tid >> 6), wq = wid & 3, I = wq >> 1, J = wq & 1, r = lane & 31, hh = lane >> 5, qtid = tid & 255;
    const lf32 Y = (lf32)ldsq;
    if (item >= 0) {
        f32x16 acc = frag_load((const float*)(cw + O_YL) + (size_t)item * 4096, wq, lane);
        acc = mm_gg((const bf16_t*)(cw + O_H0) + (size_t)item * 4096, (const bf16_t*)(cw + O_GY) + (size_t)item * 4096, I, J, lane, acc);
#pragma unroll
        for (int g = 0; g < 16; ++g) Y[(32 * J + r) * SF + 32 * I + crow(g, hh)] = acc[g];
    }
    __syncthreads();
    if (item >= 0) {
        const int b = item >> 10, h = (item >> 8) & 3, c = item & 255; const int t = qtid >> 2, c16 = (qtid & 3) * 16;
        float y[16]; float s = 0.f;
#pragma unroll
        for (int e = 0; e < 16; ++e) { y[e] = Y[t * SF + c16 + e]; s += y[e]; }
        const float mu = quad_sum(s) * (1.f / 64.f); float s2 = 0.f;
#pragma unroll
        for (int e = 0; e < 16; ++e) { y[e] -= mu; s2 += y[e] * y[e]; }
        const float rstd = 1.0f / sqrtf(quad_sum(s2) * (1.f / 64.f) + 64e-5f);
        const u32x4* vg = (const u32x4*)(cw + O_VG + (size_t)item * 8192 + (t * 64 + c16) * 2); const u32x4* gg = (const u32x4*)(cw + O_GG + (size_t)item * 8192 + (t * 64 + c16) * 2);
        const float rk = *(const float*)(cw + O_RKD + (size_t)item * 256 + t * 4);
        unsigned ow[8];
#pragma unroll
        for (int hv = 0; hv < 2; ++hv) { const u32x4 vw = vg[hv], gw = gg[hv];
#pragma unroll
            for (int e2 = 0; e2 < 4; ++e2) { const int e = hv * 8 + 2 * e2; const int ch = h * 64 + c16 + e;
                const float o0 = (y[e] * rstd * p.ln_g[ch] + p.ln_b[ch] + rk * bflo(vw[e2])) * bflo(gw[e2]);
                const float o1 = (y[e + 1] * rstd * p.ln_g[ch + 1] + p.ln_b[ch + 1] + rk * bfhi(vw[e2])) * bfhi(gw[e2]);
                ow[hv * 4 + e2] = pk2(o0, o1); } }
        u32x4* dst = (u32x4*)(MIXB + ((size_t)b * SEQ + (size_t)c * 64 + t) * 1024 + 512 + h * 64 + c16);
        dst[0] = (u32x4){ow[0], ow[1], ow[2], ow[3]}; dst[1] = (u32x4){ow[4], ow[5], ow[6], ow[7]};
    }
    __syncthreads();
}

__device__ __forceinline__ void rot16(float (&o)[16], const bf16_t* __restrict__ prow, int colbase, int c16, const float* __restrict__ ropet  ) {
    const u32x4* own = (const u32x4*)(prow + colbase + c16); const u32x4* par = (const u32x4*)(prow + colbase + (c16 ^ 32));
    const f32x4* cs = (const f32x4*)(ropet + 2 * (c16 & 31));
#pragma unroll
    for (int hv = 0; hv < 2; ++hv) { const u32x4 ow = own[hv], pw = par[hv];
#pragma unroll
        for (int e2 = 0; e2 < 4; ++e2) { const f32x4 csv = cs[hv * 4 + e2];
            const float x0 = bflo(ow[e2]), x1 = bfhi(ow[e2]), p0 = bflo(pw[e2]), p1 = bfhi(pw[e2]);
            o[hv * 8 + 2 * e2] = (c16 < 32) ? (x0 * csv[0] - p0 * csv[1]) : (p0 * csv[1] + x0 * csv[0]);
            o[hv * 8 + 2 * e2 + 1] = (c16 < 32) ? (x1 * csv[2] - p1 * csv[3]) : (p1 * csv[3] + x1 * csv[2]); } }
}
__device__ __forceinline__ void ret_stage1(CK_LAS unsigned char* ldsq, int item, const bf16_t* __restrict__ Pb, int PW, int C_TK, int C_TV, int SEQ, const float* __restrict__ ROPE, unsigned char* __restrict__ cw) {
    const int tid = ltid(), lane = tid & 63, wid = __builtin_amdgcn_readfirstlane(tid >> 6), wq = wid & 3, I = wq >> 1, J = wq & 1, qtid = tid & 255;
    const lbf VT = (lbf)ldsq, KdT = (lbf)(ldsq + B9);
    if (item >= 0) {
        const int b = item >> 10, h = (item >> 8) & 3, c = item & 255; const int t = qtid >> 2, c16 = (qtid & 3) * 16; const int pos = c * 64 + t;
        const bf16_t* prow = Pb + ((size_t)b * SEQ + pos) * PW;
        float kr[16]; rot16(kr, prow, C_TK + h * 64, c16, ROPE + (size_t)pos * 64);
        const float lg = __builtin_amdgcn_logf(1.0f - __builtin_amdgcn_exp2f(-5.0f - (float)h));
        const float dec = 0.125f * __builtin_amdgcn_exp2f(lg * (float)(63 - t));
        const u32x4* vp = (const u32x4*)(prow + C_TV + h * 64 + c16);
#pragma unroll
        for (int hv = 0; hv < 2; ++hv) { const u32x4 vw = vp[hv];
#pragma unroll
            for (int e2 = 0; e2 < 4; ++e2) { const int e = hv * 8 + 2 * e2;
                VT[(c16 + e) * SB + t] = (bf16_t)(vw[e2] & 0xffffu); VT[(c16 + e + 1) * SB + t] = (bf16_t)(vw[e2] >> 16);
                KdT[(c16 + e) * SB + t] = (bf16_t)f2bf(kr[e] * dec); KdT[(c16 + e + 1) * SB + t] = (bf16_t)f2bf(kr[e + 1] * dec); } }
    }
    __syncthreads();
    if (item >= 0) { const f32x16 kv = mm_lds(VT, KdT, I, J, lane, f32x16{}); frag_store((float*)(cw + O_KV) + (size_t)item * 4096, wq, lane, kv); }
    __syncthreads();
}
__device__ __forceinline__ void ret_scan(int chain, unsigned char* __restrict__ cw) {
    const int tid = ltid(), lane = tid & 63, wid = __builtin_amdgcn_readfirstlane(tid >> 6), wq = wid & 3, I = wq >> 1, J = wq & 1, r = lane & 31, hh = lane >> 5;
    const int h = chain & 3; const float lg = __builtin_amdgcn_logf(1.0f - __builtin_amdgcn_exp2f(-5.0f - (float)h)); const float g64 = __builtin_amdgcn_exp2f(lg * 64.0f);
    const float* kvg = (const float*)(cw + O_KV) + (size_t)chain * 256 * 4096; bf16_t* rtg = (bf16_t*)(cw + O_RT) + (size_t)chain * 256 * 4096;
    f32x16 R = f32x16{}; f32x16 n0 = frag_load(kvg, wq, lane), n1 = frag_load(kvg + 4096, wq, lane);
    for (int c = 0; c < 256; c += 2) {
#pragma unroll
        for (int half = 0; half < 2; ++half) { const int cc = c + half; bf16_t* dst = rtg + (size_t)cc * 4096;
#pragma unroll
            for (int g = 0; g < 16; ++g) dst[(32 * I + crow(g, hh)) * 64 + 32 * J + r] = (bf16_t)f2bf(R[g]);
            const f32x16 kvc = half == 0 ? n0 : n1; const int nx = cc + 2 < 256 ? cc + 2 : 255;
            if (half == 0) n0 = frag_load(kvg + (size_t)nx * 4096, wq, lane); else n1 = frag_load(kvg + (size_t)nx * 4096, wq, lane);
#pragma unroll
            for (int g = 0; g < 16; ++g) R[g] = R[g] * g64 + kvc[g]; }
    }
}
constexpr int L_RET3 = 4 * B9 + 64 * SF * 4;
__device__ __forceinline__ void ret_stage3(CK_LAS unsigned char* ldsq, int item, const bf16_t* __restrict__ Pb, int PW, int C_TQ, int C_TK, int C_TV, int C_TG, int SEQ, const float* __restrict__ ROPE,
                                           const float* __restrict__ gn_g, const unsigned char* __restrict__ cw, bf16_t* __restrict__ MIXB) {
    const int tid = ltid(), lane = tid & 63, wid = __builtin_amdgcn_readfirstlane(tid >> 6), wq = wid & 3, I = wq >> 1, J = wq & 1, r = lane & 31, hh = lane >> 5, qtid = tid & 255;
    const lbf Qr = (lbf)ldsq, Kr = (lbf)(ldsq + B9), VT = (lbf)(ldsq + 2 * B9), Sb = (lbf)(ldsq + 3 * B9); const lf32 Y = (lf32)(ldsq + 4 * B9);
    const int b = item >= 0 ? item >> 10 : 0, h = item >= 0 ? (item >> 8) & 3 : 0, c = item >= 0 ? item & 255 : 0; const int t = qtid >> 2, c16 = (qtid & 3) * 16; const int pos = c * 64 + t;
    const float lg = __builtin_amdgcn_logf(1.0f - __builtin_amdgcn_exp2f(-5.0f - (float)h));
    const bf16_t* prow = Pb + ((size_t)b * SEQ + pos) * PW;
    if (item >= 0) {
        float qr[16], kr[16]; rot16(qr, prow, C_TQ + h * 64, c16, ROPE + (size_t)pos * 64); rot16(kr, prow, C_TK + h * 64, c16, ROPE + (size_t)pos * 64);
        u32x4 w;
        w.x = pk2(qr[0], qr[1]); w.y = pk2(qr[2], qr[3]); w.z = pk2(qr[4], qr[5]); w.w = pk2(qr[6], qr[7]); *(CK_LAS u32x4*)(Qr + t * SB + c16) = w;
        w.x = pk2(qr[8], qr[9]); w.y = pk2(qr[10], qr[11]); w.z = pk2(qr[12], qr[13]); w.w = pk2(qr[14], qr[15]); *(CK_LAS u32x4*)(Qr + t * SB + c16 + 8) = w;
#pragma unroll
        for (int e = 0; e < 16; ++e) kr[e] *= 0.125f;
        w.x = pk2(kr[0], kr[1]); w.y = pk2(kr[2], kr[3]); w.z = pk2(kr[4], kr[5]); w.w = pk2(kr[6], kr[7]); *(CK_LAS u32x4*)(Kr + t * SB + c16) = w;
        w.x = pk2(kr[8], kr[9]); w.y = pk2(kr[10], kr[11]); w.z = pk2(kr[12], kr[13]); w.w = pk2(kr[14], kr[15]); *(CK_LAS u32x4*)(Kr + t * SB + c16 + 8) = w;
        const u32x4* vp = (const u32x4*)(prow + C_TV + h * 64 + c16);
#pragma unroll
        for (int hv = 0; hv < 2; ++hv) { const u32x4 vw = vp[hv];
#pragma unroll
            for (int e2 = 0; e2 < 4; ++e2) { const int e = hv * 8 + 2 * e2; VT[(c16 + e) * SB + t] = (bf16_t)(vw[e2] & 0xffffu); VT[(c16 + e + 1) * SB + t] = (bf16_t)(vw[e2] >> 16); } }
    }
    __syncthreads();
    if (item >= 0) {
        f32x16 st = mm_lds(Kr, Qr, I, J, lane, f32x16{}); const int tt = 32 * J + r;
#pragma unroll
        for (int g = 0; g < 16; ++g) { const int ii = 32 * I + crow(g, hh); st[g] = (ii <= tt) ? st[g] * __builtin_amdgcn_exp2f(lg * (float)(tt - ii)) : 0.f; }
        tile_store_T(Sb, I, J, lane, st);
    }
    __syncthreads();
    if (item >= 0) {
        const f32x16 yi = mm_lds(VT, Sb, I, J, lane, f32x16{}); const f32x16 yc = mm_gA((const bf16_t*)(cw + O_RT) + (size_t)item * 4096, Qr, I, J, lane, f32x16{});
        const int tt = 32 * J + r; const float qd = __builtin_amdgcn_exp2f(lg * (float)(tt + 1));
#pragma unroll
        for (int g = 0; g < 16; ++g) Y[tt * SF + 32 * I + crow(g, hh)] = yi[g] + qd * yc[g];
    }
    __syncthreads();
    if (item >= 0) {
        float y[16]; float s = 0.f;
#pragma unroll
        for (int e = 0; e < 16; ++e) { y[e] = Y[t * SF + c16 + e]; s += y[e]; }
        const float mu = quad_sum(s) * (1.f / 64.f); float s2 = 0.f;
#pragma unroll
        for (int e = 0; e < 16; ++e) { y[e] -= mu; s2 += y[e] * y[e]; }
        const float rstd = 1.0f / sqrtf(quad_sum(s2) * (1.f / 64.f) + 1e-6f);
        const u32x4* gp = (const u32x4*)(prow + C_TG + h * 64 + c16); unsigned ow[8];
#pragma unroll
        for (int hv = 0; hv < 2; ++hv) { const u32x4 gw = gp[hv];
#pragma unroll
            for (int e2 = 0; e2 < 4; ++e2) { const int e = hv * 8 + 2 * e2; const int ch = h * 64 + c16 + e; const float g0 = bflo(gw[e2]), g1 = bfhi(gw[e2]);
                ow[hv * 4 + e2] = pk2(y[e] * rstd * gn_g[ch] * (g0 * sigm(g0)), y[e + 1] * rstd * gn_g[ch + 1] * (g1 * sigm(g1))); } }
        u32x4* dst = (u32x4*)(MIXB + ((size_t)b * SEQ + pos) * 1024 + 768 + h * 64 + c16);
        dst[0] = (u32x4){ow[0], ow[1], ow[2], ow[3]}; dst[1] = (u32x4){ow[4], ow[5], ow[6], ow[7]};
    }
    __syncthreads();
}
}

__device__ __forceinline__ void tr_tile(const float* __restrict__ src, size_t ld_src, bf16* __restrict__ dst, size_t ld_dst, float* scr, int lane) {
    pg8::f32x4 v[16];
#pragma unroll
    for (int i = 0; i < 16; ++i) v[i] = *(const pg8::f32x4*)(src + (size_t)(i * 4 + (lane >> 4)) * ld_src + (lane & 15) * 4);
#pragma unroll
    for (int i = 0; i < 16; ++i) { float* p = scr + (i * 4 + (lane >> 4)) * 65 + (lane & 15) * 4; p[0] = v[i][0]; p[1] = v[i][1]; p[2] = v[i][2]; p[3] = v[i][3]; }
    asm volatile("s_waitcnt lgkmcnt(0)" ::: "memory");
#pragma unroll
    for (int i = 0; i < 8; ++i) { const int n = i * 8 + (lane >> 3), kc = (lane & 7) * 8; const float* s = scr + kc * 65 + n;
        pg8::u32x4 o; o.x = pk2(s[0], s[65]); o.y = pk2(s[2 * 65], s[3 * 65]); o.z = pk2(s[4 * 65], s[5 * 65]); o.w = pk2(s[6 * 65], s[7 * 65]);
        *(pg8::u32x4*)(dst + (size_t)n * ld_dst + kc) = o; }
    asm volatile("s_waitcnt lgkmcnt(0)" ::: "memory");
}

#define LAS __attribute__((address_space(3)))
#define XB_TMO      128
#define XB_XCNT(j)  (256  + 64 * (j))
#define XB_XSUB(j)  (1280 + 64 * (j))
#define XB_XGEN(j)  (2304 + 64 * (j))
#define XB_TOP      3328
#define XB_TOPGEN   3392
#define XCD_BAR_WORDS 3456
#define XB_SPIN_CAP (1u << 18)

__device__ __forceinline__ unsigned xb_ld(unsigned* p)              { return __hip_atomic_load(p, __ATOMIC_RELAXED, __HIP_MEMORY_SCOPE_AGENT); }
__device__ __forceinline__ unsigned xb_add(unsigned* p, unsigned v) { return __hip_atomic_fetch_add(p, v, __ATOMIC_RELAXED, __HIP_MEMORY_SCOPE_AGENT); }
__device__ __forceinline__ unsigned xb_xcc_id() { return (unsigned)__builtin_amdgcn_s_getreg((3 << 11) | 20) & 0xFu; }
#define XB_SPIN(cond, bar) do { unsigned _sp = 0; while (cond) { __builtin_amdgcn_s_sleep(1); \
    if ((++_sp & 255u) == 0u) { if (xb_ld(&(bar)[XB_TMO])) break; if (_sp > XB_SPIN_CAP) { atomicAdd(&(bar)[XB_TMO], 1u); break; } } } } while (0)

struct XcdBarrier {
    unsigned* bar; unsigned x;
    volatile LAS unsigned* st;
};

__device__ __forceinline__ XcdBarrier xcd_barrier_post(unsigned* bar, volatile LAS unsigned* st) {
    XcdBarrier b; b.bar = bar; b.x = xb_xcc_id(); b.st = st;
    if (ltid() == 0) (void)xb_add(&bar[XB_XCNT(b.x)], 1u);
    return b;
}
__device__ __forceinline__ void xcd_barrier_complete(unsigned* bar, unsigned x, unsigned& nloc, unsigned& nx) {
    const unsigned G = gridDim.x * gridDim.y * gridDim.z;
    unsigned sum, cnt, mine, sp = 0u;
    for (;;) {
        sum = 0u; cnt = 0u; mine = 0u;
#pragma unroll
        for (unsigned j = 0; j < 16; ++j) { const unsigned c = xb_ld(&bar[XB_XCNT(j)]); sum += c; cnt += (c > 0u) ? 1u : 0u; mine = (j == x) ? c : mine; }
        if (sum == G) break;
        __builtin_amdgcn_s_sleep(1);
        if ((++sp & 255u) == 0u) { if (xb_ld(&bar[XB_TMO])) break; if (sp > XB_SPIN_CAP) { atomicAdd(&bar[XB_TMO], 1u); break; } }
    }
    nloc = mine > 0u ? mine : 1u; nx = cnt > 0u ? cnt : 1u;
}

__device__ __forceinline__ void xcd_barrier(const XcdBarrier& b) {
    asm volatile("s_waitcnt vmcnt(0)" ::: "memory");
    __syncthreads();
    if (ltid() == 0) {
        unsigned* bar = b.bar;
        __builtin_amdgcn_s_waitcnt(0);
        unsigned nloc = b.st[0], nx = b.st[1];
        if (nloc == 0u) { xcd_barrier_complete(bar, b.x, nloc, nx); b.st[0] = nloc; b.st[1] = nx; }
        const unsigned old = xb_add(&bar[XB_XSUB(b.x)], 1u);
        const unsigned gen = old / nloc;
        if (old + 1u == (gen + 1u) * nloc) {
            __builtin_amdgcn_fence(__ATOMIC_RELEASE, "agent");
            asm volatile("s_waitcnt vmcnt(0)" ::: "memory");
            const unsigned og = xb_add(&bar[XB_TOP], 1u);
            const unsigned tg = og / nx;
            if (og + 1u == (tg + 1u) * nx) xb_add(&bar[XB_TOPGEN], 1u);
            else XB_SPIN(xb_ld(&bar[XB_TOPGEN]) == tg, bar);
            __builtin_amdgcn_fence(__ATOMIC_ACQUIRE, "agent");
            xb_add(&bar[XB_XGEN(b.x)], 1u);
            asm volatile("s_waitcnt vmcnt(0)" ::: "memory");
        } else {
            XB_SPIN(xb_ld(&bar[XB_XGEN(b.x)]) == gen, bar);
            __builtin_amdgcn_fence(__ATOMIC_ACQUIRE, "agent");
            asm volatile("s_waitcnt vmcnt(0)" ::: "memory");
        }
    }
    __syncthreads();
}


__global__ void __launch_bounds__(NTHREADS, 2) mk_fwd(Args args) {
    extern __shared__ __attribute__((aligned(16))) unsigned char lds_raw[];
    float* lds = (float*)lds_raw;
    const int tid = ltid(), lane = tid & 63, wid = __builtin_amdgcn_readfirstlane(tid >> 6);
    const int G = gridDim.x, bx = blockIdx.x;
    unsigned char* ws = args.ws;
    unsigned* ctl = (unsigned*)(ws + WS_CTL);
    float* X = args.out;
    bf16* XB = (bf16*)(ws + WS_XB);
    bf16* Pb = (bf16*)(ws + WS_P);
    bf16* WIN = (bf16*)(ws + WS_WIN); bf16* WOUT = (bf16*)(ws + WS_WOUT); bf16* W13 = (bf16*)(ws + WS_W13); bf16* W2 = (bf16*)(ws + WS_W2);
    float* ROPE = (float*)(ws + WS_ROPE);
    double* LCS = (double*)(ws + WS_LCS); double* TOT = (double*)(ws + WS_TOT);
    unsigned char* KA = ws + WS_KA;
    unsigned char* cw = ws + WS_CK; bf16* LWT = (bf16*)(ws + WS_LW);
    int* EP = (int*)(ws + WS_EP); int* DEST = (int*)(ws + WS_DEST);
    float* GATE = (float*)(ws + WS_GATE);
    bf16* MIXB = (bf16*)(ws + WS_MIXB);
    bf16* XP = (bf16*)(ws + WS_XP); bf16* Hb = (bf16*)(ws + WS_H); bf16* YP = (bf16*)(ws + WS_YP); float* YO = (float*)(ws + WS_YO);
    typedef pg8::f32x4 f32x4;
    volatile LAS unsigned* MISC = (volatile LAS unsigned*)((LAS unsigned char*)lds_raw + LDS_MISC);
    for (int u = tid; u < (LDS_ALL - LDS_MISC) / 4; u += NTHREADS) MISC[u] = 0u;
    __syncthreads();
    XcdBarrier bar = xcd_barrier_post(ctl + CW_BAR, MISC + 8);
#define GRID_BAR() xcd_barrier(bar)

    {
            const int tid = ltid(), lane = tid & 63, wid = __builtin_amdgcn_readfirstlane(tid >> 6); (void)lane; (void)wid;
        const f32x4* xi = (const f32x4*)args.in[0]; f32x4* xo = (f32x4*)X; uint2* xb = (uint2*)XB;
        for (size_t i = (size_t)bx * NTHREADS + tid; i < (size_t)T * DM / 4; i += (size_t)G * NTHREADS) { const f32x4 v = xi[i]; xo[i] = v; xb[i] = make_uint2(pk2(v[0], v[1]), pk2(v[2], v[3])); }
        for (int i = bx * NTHREADS + tid; i < SEQ * 32; i += G * NTHREADS) {
            const int pos = i >> 5, f = i & 31;
            const double inv = pow(10000.0, -(double)f / 32.0);
            const double ang = (double)pos * inv;
            ROPE[2 * i] = (float)cos(ang); ROPE[2 * i + 1] = (float)sin(ang);
        }
        for (int i = bx * NTHREADS + tid; i < DEPTH * 256 * 256; i += G * NTHREADS) {
            const int l = i >> 16, rem = i & 65535, chg = rem >> 8, ii = rem & 255;
            if (ii < 64) LWT[((size_t)l * 256 + chg) * 64 + ii] = (bf16)f2bf(args.in[6][((size_t)l * 64 + ii) * 256 + chg]);
            else if (ii < 128) LWT[(size_t)DEPTH * 256 * 64 + ((size_t)l * 256 + chg) * 64 + (ii - 64)] = (bf16)f2bf(args.in[8][((size_t)l * 64 + (ii - 64)) * 256 + chg]);
            else LWT[(size_t)2 * DEPTH * 256 * 64 + ((size_t)l * 256 + chg) * 128 + (ii - 128)] = (bf16)f2bf(args.in[9][((size_t)l * 128 + (ii - 128)) * 256 + chg]);
        }
        float* scr = lds + wid * (64 * 65);
        constexpr int I_IN = 16 * 56, I_OUT = 16 * 16, I_13 = NE * 16 * 16, I_2 = NE * 8 * 16, I_L = I_IN + I_OUT + I_13 + I_2;
        for (int it = bx * 8 + wid; it < DEPTH * I_L; it += G * 8) {
            const int l = it / I_L; int r = it % I_L;
            if (r < I_IN) { const int kb = r / 56, nb = r % 56; const int nsrc = nb * 64 + (nb >= 24 ? 8 : 0);
                tr_tile(args.in[1] + (size_t)l * DM * INW + (size_t)kb * 64 * INW + nsrc, INW, WIN + (size_t)l * PW * DM + (size_t)nb * 64 * DM + kb * 64, DM, scr, lane); }
            else if (r < I_IN + I_OUT) { r -= I_IN; const int kb = r / 16, nb = r % 16;
                tr_tile(args.in[16] + (size_t)l * DM * DM + (size_t)kb * 64 * DM + nb * 64, DM, WOUT + (size_t)l * DM * DM + (size_t)nb * 64 * DM + kb * 64, DM, scr, lane); }
            else if (r < I_IN + I_OUT + I_13) { r -= I_IN + I_OUT; const int e = r >> 8, kb = (r >> 4) & 15, nb = r & 15;
                const int pn = nb >> 2, q = nb & 3; const float* srcw = (q < 2 ? args.in[25] : args.in[26]) + ((size_t)l * NE + e) * DM * DE;
                tr_tile(srcw + (size_t)kb * 64 * DE + pn * 128 + (q & 1) * 64, DE, W13 + ((size_t)l * NE + e) * DM * DM + (size_t)nb * 64 * DM + kb * 64, DM, scr, lane); }
            else { r -= I_IN + I_OUT + I_13; const int e = r >> 7, kb = (r >> 4) & 7, nb = r & 15;
                tr_tile(args.in[27] + ((size_t)l * NE + e) * DE * DM + (size_t)kb * 64 * DM + nb * 64, DM, W2 + ((size_t)l * NE + e) * DM * DE + (size_t)nb * 64 * DE + kb * 64, DE, scr, lane); }
        }
    }
    GRID_BAR();

    for (int l = 0; l < DEPTH; ++l) {
        {
            const int tid = ltid(), lane = tid & 63, wid = __builtin_amdgcn_readfirstlane(tid >> 6); (void)lane; (void)wid;
            const float* wf = args.in[1] + (size_t)l * DM * INW + O_FF; const float* fbias = args.in[2] + l * 8;
            float w[8][16];
#pragma unroll
            for (int jq = 0; jq < 4; ++jq)
#pragma unroll
                for (int e = 0; e < 4; ++e)
#pragma unroll
                    for (int h = 0; h < 8; ++h) w[h][jq * 4 + e] = wf[(size_t)(jq * 256 + lane * 4 + e) * INW + h];
            float* ffl = lds;
            for (int ch = bx; ch < T / 128; ch += G) {
                __syncthreads();
                for (int i = 0; i < 16; ++i) { const int tl = wid * 16 + i; const size_t m = (size_t)ch * 128 + tl;
                    float acc[8];
#pragma unroll
                    for (int h = 0; h < 8; ++h) acc[h] = 0.f;
#pragma unroll
                    for (int jq = 0; jq < 4; ++jq) { const f32x4 xv = *(const f32x4*)(X + m * DM + jq * 256 + lane * 4);
#pragma unroll
                        for (int e = 0; e < 4; ++e)
#pragma unroll
                            for (int h = 0; h < 8; ++h) acc[h] += xv[e] * w[h][jq * 4 + e]; }
#pragma unroll
                    for (int h = 0; h < 8; ++h) acc[h] = wave_sum(acc[h]);
                    if (lane < 8) { float v = acc[0];
#pragma unroll
                        for (int h = 1; h < 8; ++h) v = (lane == h) ? acc[h] : v;
                        ffl[tl * 8 + lane] = v + fbias[lane]; } }
                __syncthreads();
                {
                    const int h = wid; const int bb = (ch * 128) / SEQ, t0 = (ch * 128) % SEQ; double carry = 0.0;
#pragma unroll
                    for (int half = 0; half < 2; ++half) { double v = (double)logsigmoidf_(ffl[(half * 64 + lane) * 8 + h]);
#pragma unroll
                        for (int o = 1; o < 64; o <<= 1) { const double n = __shfl_up(v, o); if (lane >= o) v += n; }
                        v += carry; LCS[(size_t)(bb * 8 + h) * SEQ + t0 + half * 64 + lane] = v; carry = __shfl(v, 63); }
                    if (lane == 0) TOT[(bb * 8 + h) * 128 + t0 / 128] = carry;
                }
            }
            __syncthreads();
            pg8::Gemm g{XB, WIN + (size_t)l * PW * DM, T, PW, DM}; pg8::StaticOrder S; S.init(T, PW, G, bx);
            pg8::EpiInProj E{Pb, PW, QC2};
            pg8::gemm_phase<pg8::EpiInProj, pg8::StaticOrder, true, true>((PG8_LAS unsigned char*)lds_raw, g, S, E);
        }
        GRID_BAR();
        {
            const int tid = ltid(), lane = tid & 63, wid = __builtin_amdgcn_readfirstlane(tid >> 6); (void)lane; (void)wid;
            for (int ch = bx; ch < T / 128; ch += G) {
                const int h = wid; const int bb = (ch * 128) / SEQ, t0 = (ch * 128) % SEQ, ci = t0 / 128;
                double pre = 0.0;
                { const double* tp = TOT + (bb * 8 + h) * 128; double a = (lane < ci) ? tp[lane] : 0.0; a += (lane + 64 < ci) ? tp[lane + 64] : 0.0;
#pragma unroll
                  for (int o = 1; o < 64; o <<= 1) a += __shfl_xor(a, o);
                  pre = a; }
#pragma unroll
                for (int half = 0; half < 2; ++half) { const int t = t0 + half * 64 + lane; const double v = pre + LCS[(size_t)(bb * 8 + h) * SEQ + t];
                    const double bd = -v * 1.4426950408889634; const unsigned h_ = f2bf((float)bd); const double r1 = bd - (double)bf2f((unsigned short)h_);
                    const unsigned m_ = f2bf((float)r1); const double r2 = r1 - (double)bf2f((unsigned short)m_); const unsigned l_ = f2bf((float)r2);
                    *(pg8::u32x4*)(KA + ((size_t)(bb * 8 + h) * SEQ + t) * 16) = (pg8::u32x4){h_ | (m_ << 16), l_ | (0x3f80u << 16), 0x3f803f80u, 0u}; }
            }
            __syncthreads();
            const ck::RwkvParams rp{args.in[3] + l * 768, args.in[4] + l * 256, args.in[5] + l * 256, args.in[7] + l * 256, args.in[10] + l * 256, args.in[11] + l * 256, args.in[12] + l * 256,
                                    args.in[13] + l * 256, args.in[14] + l * 256, args.in[15] + l * 256,
                                    LWT + (size_t)l * 256 * 64, LWT + (size_t)DEPTH * 256 * 64 + (size_t)l * 256 * 64, LWT + (size_t)2 * DEPTH * 256 * 64 + (size_t)l * 256 * 128};
            for (int it = bx; it < 2048; it += G) ck::rwkv_stage1((CK_LAS unsigned char*)lds_raw, it, Pb, PW, C_RR, C_RK, C_RV, C_WD, SEQ, rp, cw);
            { const int quad = wid >> 2;
              for (int i0 = bx * 2; i0 < 2048; i0 += G * 2) ck::ret_stage1((CK_LAS unsigned char*)lds_raw + quad * 2 * ck::B9, i0 + quad, Pb, PW, C_TK, C_TV, SEQ, ROPE, cw); }
        }
        GRID_BAR();
        {
            const int tid = ltid(), lane = tid & 63, wid = __builtin_amdgcn_readfirstlane(tid >> 6); (void)lane; (void)wid;
            const int quad = wid >> 2;
            if (bx < 4) ck::rwkv_scan((CK_LAS unsigned char*)lds_raw, bx * 2 + quad, cw);
            else if (bx < 8) ck::ret_scan((bx - 4) * 2 + quad, cw);
            __syncthreads();
            const attn_body::AttnTensors AT{(const attn_body::bf16*)(Pb + C_FQ), (const attn_body::bf16*)(Pb + C_FK), (const attn_body::bf16*)(Pb + C_FV), (attn_body::bf16*)MIXB, KA};
            const int grp = bx & 7; unsigned* qh = ctl + CW_Q + 64 * (8 * l + grp);
            for (;;) {
                if (tid == 0) MISC[16] = atomicAdd(qh, 1u);
                __syncthreads();
                const unsigned idx = MISC[16];
                __syncthreads();
                if (idx >= 128u) break;
                const int qb = 63 - (int)(idx >> 1), bh = 2 * grp + (int)(idx & 1);
                attn_body::attn_unit<8>(bh / attn_body::NHEAD, bh % attn_body::NHEAD, qb, AT.Q, AT.K, AT.V, AT.O, AT.KA, (char*)lds_raw);
            }
        }
        GRID_BAR();
        {
            const int tid = ltid(), lane = tid & 63, wid = __builtin_amdgcn_readfirstlane(tid >> 6); (void)lane; (void)wid;
            const ck::RwkvParams rp{args.in[3] + l * 768, args.in[4] + l * 256, args.in[5] + l * 256, args.in[7] + l * 256, args.in[10] + l * 256, args.in[11] + l * 256, args.in[12] + l * 256,
                                    args.in[13] + l * 256, args.in[14] + l * 256, args.in[15] + l * 256, nullptr, nullptr, nullptr};
            const int quad = wid >> 2;
            for (int i0 = bx * 2; i0 < 2048; i0 += G * 2) ck::rwkv_stage3((CK_LAS unsigned char*)lds_raw + quad * 64 * ck::SF * 4, i0 + quad, rp, cw, MIXB, SEQ);
            for (int i0 = bx * 2; i0 < 2048; i0 += G * 2) ck::ret_stage3((CK_LAS unsigned char*)lds_raw + quad * ck::L_RET3, i0 + quad, Pb, PW, C_TQ, C_TK, C_TV, C_TG, SEQ, ROPE, args.in[15] + l * 256, cw, MIXB);
        }
        GRID_BAR();
        {
            const int tid = ltid(), lane = tid & 63, wid = __builtin_amdgcn_readfirstlane(tid >> 6); (void)lane; (void)wid;
            pg8::Gemm g{MIXB, WOUT + (size_t)l * DM * DM, T, DM, DM}; pg8::StaticOrder S; S.init(T, DM, G, bx);
            pg8::EpiF32 E{YO, DM};
            pg8::gemm_phase<pg8::EpiF32, pg8::StaticOrder, true, true>((PG8_LAS unsigned char*)lds_raw, g, S, E);
        }
        GRID_BAR();
        {
            const int tid = ltid(), lane = tid & 63, wid = __builtin_amdgcn_readfirstlane(tid >> 6); (void)lane; (void)wid;
            const float* g1 = args.in[17] + l * DM; const float* b1 = args.in[18] + l * DM;
            const float* wg = args.in[21] + (size_t)l * DM * 4; const float* bg = args.in[22] + l * 4;
            const float* we = args.in[23] + (size_t)l * DM * 32; const float* be = args.in[24] + l * 32;
            unsigned* cnt = ctl + CW_CNT + 64 * l;
            for (int m = bx * 8 + wid; m < T; m += G * 8) {
                float v[16]; float s = 0.f;
    #pragma unroll
                for (int jq = 0; jq < 4; ++jq) { const f32x4 xv = *(const f32x4*)(X + (size_t)m * DM + jq * 256 + lane * 4); const f32x4 yv = *(const f32x4*)(YO + (size_t)m * DM + jq * 256 + lane * 4);
    #pragma unroll
                    for (int e = 0; e < 4; ++e) { v[jq * 4 + e] = ALPHA * xv[e] + yv[e]; s += v[jq * 4 + e]; } }
                const float mean = wave_sum(s) * (1.f / DM); float s2 = 0.f;
    #pragma unroll
                for (int i = 0; i < 16; ++i) { v[i] -= mean; s2 += v[i] * v[i]; }
                const float rstd = 1.0f / sqrtf(wave_sum(s2) * (1.f / DM) + LN_EPS);
    #pragma unroll
                for (int jq = 0; jq < 4; ++jq) { f32x4 ov;
    #pragma unroll
                    for (int e = 0; e < 4; ++e) { const int c = jq * 256 + lane * 4 + e; v[jq * 4 + e] = v[jq * 4 + e] * rstd * g1[c] + b1[c]; ov[e] = v[jq * 4 + e]; }
                    *(f32x4*)(X + (size_t)m * DM + jq * 256 + lane * 4) = ov; }
                float lg[36];
    #pragma unroll
                for (int o = 0; o < 36; ++o) lg[o] = 0.f;
    #pragma unroll
                for (int jq = 0; jq < 4; ++jq)
    #pragma unroll
                    for (int e = 0; e < 4; ++e) { const int c = jq * 256 + lane * 4 + e; const float xv = v[jq * 4 + e];
    #pragma unroll
                        for (int o = 0; o < 4; ++o) lg[o] += xv * wg[c * 4 + o];
    #pragma unroll
                        for (int o = 0; o < 32; ++o) lg[4 + o] += xv * we[c * 32 + o]; }
    #pragma unroll
                for (int o = 0; o < 36; ++o) lg[o] = wave_sum(lg[o]);
                if (lane == 0) {
                    int grp = 0; float gbest = lg[0] + bg[0];
    #pragma unroll
                    for (int o = 1; o < 4; ++o) { const float gv = lg[o] + bg[o]; if (gv > gbest) { gbest = gv; grp = o; } }
                    float den = 0.f;
    #pragma unroll
                    for (int o = 0; o < 4; ++o) den += expf(lg[o] + bg[o] - gbest);
                    const float ggate = 1.0f / den;
                    float el[8];
    #pragma unroll
                    for (int o = 0; o < 8; ++o) { float vsel = lg[4 + o] + be[o];
    #pragma unroll
                        for (int gq = 1; gq < 4; ++gq) vsel = (gq == grp) ? (lg[4 + gq * 8 + o] + be[gq * 8 + o]) : vsel;
                        el[o] = vsel; }
                    int i0 = 0; float v0 = el[0];
    #pragma unroll
                    for (int o = 1; o < 8; ++o) if (el[o] > v0) { v0 = el[o]; i0 = o; }
                    int i1 = -1; float v1 = -INFINITY;
    #pragma unroll
                    for (int o = 0; o < 8; ++o) if (o != i0 && (i1 < 0 || el[o] > v1)) { v1 = el[o]; i1 = o; }
                    const float e1 = expf(v1 - v0); const float p0 = 1.0f / (1.0f + e1), p1 = e1 / (1.0f + e1);
                    const int ex0 = grp * 8 + i0, ex1 = grp * 8 + i1;
                    const unsigned q0 = atomicAdd(cnt + ex0, 1u); EP[2 * m] = (ex0 << 16) | (int)q0;
                    const unsigned q1 = atomicAdd(cnt + ex1, 1u); EP[2 * m + 1] = (ex1 << 16) | (int)q1;
                    GATE[2 * m] = ggate * p0; GATE[2 * m + 1] = ggate * p1;
                }
            }
        }
        GRID_BAR();
        {
            const int tid = ltid(), lane = tid & 63, wid = __builtin_amdgcn_readfirstlane(tid >> 6); (void)lane; (void)wid;
            __syncthreads();
            unsigned* cnt = ctl + CW_CNT + 64 * l;
            int* poff = (int*)lds;
            if (tid == 0) { int acc = 0; for (int e = 0; e < NE; ++e) { poff[e] = acc; acc += (((int)cnt[e] + 255) >> 8) << 8; } poff[NE] = acc; }
            __syncthreads();
            for (int m = bx * 8 + wid; m < T; m += G * 8) {
                uint2 w[4];
    #pragma unroll
                for (int jq = 0; jq < 4; ++jq) { const f32x4 xv = *(const f32x4*)(X + (size_t)m * DM + jq * 256 + lane * 4); w[jq] = make_uint2(pk2(xv[0], xv[1]), pk2(xv[2], xv[3])); }
    #pragma unroll
                for (int k = 0; k < 2; ++k) { const int ep = EP[2 * m + k]; const int dest = poff[ep >> 16] + (ep & 0xffff);
    #pragma unroll
                    for (int jq = 0; jq < 4; ++jq) *(uint2*)(XP + (size_t)dest * DM + jq * 256 + lane * 4) = w[jq];
                    if (lane == 0) DEST[2 * m + k] = dest; }
            }
        }
        GRID_BAR();
        {
            const int tid = ltid(), lane = tid & 63, wid = __builtin_amdgcn_readfirstlane(tid >> 6); (void)lane; (void)wid;
            unsigned* cnt = ctl + CW_CNT + 64 * l;
            PG8_LAS int* tile_e = (PG8_LAS int*)((PG8_LAS unsigned char*)lds_raw + 131072); PG8_LAS int* tst = tile_e + MAXTILES;
            __syncthreads();
            if (tid == 0) { int acc = 0; for (int e = 0; e < NE; ++e) { tst[e] = acc; acc += ((int)cnt[e] + 255) >> 8; } tst[NE] = acc; }
            __syncthreads();
            const int ntile = tst[NE];
            if (tid < ntile) { int e = 0; while (tst[e + 1] <= tid) ++e; tile_e[tid] = e; }
            __syncthreads();
            pg8::MoeOrder S{ntile, G, bx, tile_e};
            { pg8::Gemm g{XP, W13 + (size_t)l * NE * DM * DM, ntile * 256, DM, DM}; pg8::EpiSwiGlu E{Hb, DE};
              pg8::gemm_phase<pg8::EpiSwiGlu, pg8::MoeOrder, true, true>((PG8_LAS unsigned char*)lds_raw, g, S, E); }
            GRID_BAR();
            { pg8::Gemm g{Hb, W2 + (size_t)l * NE * DM * DE, ntile * 256, DM, DE}; pg8::EpiInProj E{YP, DM, 1.0f};
              pg8::gemm_phase<pg8::EpiInProj, pg8::MoeOrder, true, true>((PG8_LAS unsigned char*)lds_raw, g, S, E); }
        }
        GRID_BAR();
        {
            const int tid = ltid(), lane = tid & 63, wid = __builtin_amdgcn_readfirstlane(tid >> 6); (void)lane; (void)wid;
            const float* g2 = args.in[19] + l * DM; const float* b2 = args.in[20] + l * DM;
            for (int m = bx * 8 + wid; m < T; m += G * 8) {
                const float ga = GATE[2 * m], gb = GATE[2 * m + 1]; const size_t da = (size_t)DEST[2 * m], db = (size_t)DEST[2 * m + 1];
                float v[16]; float s = 0.f;
    #pragma unroll
                for (int jq = 0; jq < 4; ++jq) { const f32x4 xv = *(const f32x4*)(X + (size_t)m * DM + jq * 256 + lane * 4);
                    const uint2 wa = *(const uint2*)(YP + da * DM + jq * 256 + lane * 4), wb = *(const uint2*)(YP + db * DM + jq * 256 + lane * 4);
                    const f32x4 ya = (f32x4){__builtin_bit_cast(float, wa.x << 16), __builtin_bit_cast(float, wa.x & 0xffff0000u), __builtin_bit_cast(float, wa.y << 16), __builtin_bit_cast(float, wa.y & 0xffff0000u)};
                    const f32x4 yb = (f32x4){__builtin_bit_cast(float, wb.x << 16), __builtin_bit_cast(float, wb.x & 0xffff0000u), __builtin_bit_cast(float, wb.y << 16), __builtin_bit_cast(float, wb.y & 0xffff0000u)};
    #pragma unroll
                    for (int e = 0; e < 4; ++e) { v[jq * 4 + e] = ALPHA * xv[e] + (ga * ya[e] + gb * yb[e]); s += v[jq * 4 + e]; } }
                const float mean = wave_sum(s) * (1.f / DM); float s2 = 0.f;
    #pragma unroll
                for (int i = 0; i < 16; ++i) { v[i] -= mean; s2 += v[i] * v[i]; }
                const float rstd = 1.0f / sqrtf(wave_sum(s2) * (1.f / DM) + LN_EPS);
    #pragma unroll
                for (int jq = 0; jq < 4; ++jq) { f32x4 ov;
    #pragma unroll
                    for (int e = 0; e < 4; ++e) { const int c = jq * 256 + lane * 4 + e; ov[e] = v[jq * 4 + e] * rstd * g2[c] + b2[c]; }
                    *(f32x4*)(X + (size_t)m * DM + jq * 256 + lane * 4) = ov;
                    *(uint2*)(XB + (size_t)m * DM + jq * 256 + lane * 4) = make_uint2(pk2(ov[0], ov[1]), pk2(ov[2], ov[3])); }
            }
        }
        if (l + 1 < DEPTH) GRID_BAR();
    }
}

extern "C" void kernel_launch(void* const* d_in, const int* in_sizes, int n_in, void* d_out, int out_size, void* d_ws, size_t ws_size, hipStream_t stream) {
    static int grid = 0;
    if (grid == 0) {
        if (n_in != 28 || out_size != T * DM || ws_size < WS_END) { fprintf(stderr, "kernel_launch: unexpected shapes (n_in %d out %d ws %zu)\n", n_in, out_size, ws_size); grid = -1; return; }
        int dev = 0, cus = 0, per_cu = 0;
        (void)hipGetDevice(&dev); (void)hipDeviceGetAttribute(&cus, hipDeviceAttributeMultiprocessorCount, dev);
        (void)hipFuncSetAttribute((const void*)mk_fwd, hipFuncAttributeMaxDynamicSharedMemorySize, LDS_ALL);
        if (hipOccupancyMaxActiveBlocksPerMultiprocessor(&per_cu, (const void*)mk_fwd, NTHREADS, LDS_ALL) != hipSuccess || per_cu < 1) fprintf(stderr, "kernel_launch: occupancy query says %d blocks per CU\n", per_cu);
        (void)hipGetLastError();
        grid = cus > 0 ? cus : 256;
        if (grid != 256) fprintf(stderr, "kernel_launch: %d CUs (built for 256)\n", grid);
    }
    if (grid < 0) return;
    (void)hipMemsetAsync((char*)d_ws + WS_CTL, 0, CTL_BYTES, stream);
    Args a{};
    for (int i = 0; i < 28; ++i) a.in[i] = (const float*)d_in[i];
    a.out = (float*)d_out; a.ws = (unsigned char*)d_ws;
    hipLaunchKernelGGL(mk_fwd, dim3(grid), dim3(NTHREADS), LDS_ALL, stream, a);
}
```

```cpp
#include <hip/hip_runtime.h>
#include <cstdio>
#include <cstdint>
#include <cmath>
__device__ __forceinline__ int ltid() { int t = __builtin_amdgcn_workitem_id_x(); asm volatile("" : "+v"(t)); return t; }

constexpr int BATCH = 2, SEQ = 16384, DM = 1024, DEPTH = 4, T = BATCH * SEQ;
constexpr int INW = 3592, PW = 3584;
constexpr int O_FF = 1536;
constexpr int C_FQ = 0, C_FK = 512, C_FV = 1024, C_RR = 1536, C_RK = 1792, C_RV = 2048, C_WD = 2304, C_AD = 2368, C_GD = 2432,
              C_TQ = 2560, C_TK = 2816, C_TV = 3072, C_TG = 3328;
constexpr int NE = 32, DE = 512, A_TOT = T * 2;
constexpr float ALPHA = 1.681792830507429f;
constexpr float LN_EPS = 1e-5f, RWKV_GN_EPS = 64e-5f, RET_GN_EPS = 1e-6f;
constexpr float QC2 = 0.125f * 1.4426950408889634f;
constexpr int NTHREADS = 512;
#ifndef REP_P0
#define REP_P0 1
#endif
#ifndef REP_A
#define REP_A 1
#endif
#ifndef REP_C
#define REP_C 1
#endif
#ifndef REP_E
#define REP_E 1
#endif
#ifndef REP_F
#define REP_F 1
#endif
#ifndef REP_H
#define REP_H 1
#endif
#ifndef REP_IJ
#define REP_IJ 1
#endif
#ifndef REP_G
#define REP_G 1
#endif
#ifndef REP_K
#define REP_K 1
#endif
constexpr int LDS_MISC = 147456, LDS_ALL = 148480;

constexpr size_t MiB = 1u << 20;
constexpr size_t WS_CTL = 0, CTL_BYTES = 1 * MiB;
constexpr size_t WS_EP = 1 * MiB;
constexpr size_t WS_DEST = 2 * MiB;
constexpr size_t WS_GATE = 9 * MiB;
constexpr size_t WS_ROPE = 11 * MiB;
constexpr size_t WS_RKD = 15 * MiB;
constexpr size_t WS_WIN = 16 * MiB;
constexpr size_t WS_WOUT = 44 * MiB;
constexpr size_t WS_W13 = 52 * MiB;
constexpr size_t WS_W2 = 308 * MiB;
constexpr size_t WS_XB = 436 * MiB;
constexpr size_t WS_P = 500 * MiB;
constexpr size_t WS_MIXB = 724 * MiB;
constexpr size_t WS_CK = 788 * MiB;
constexpr size_t WS_LW = 3 * MiB;
constexpr size_t WS_YO = 788 * MiB;
constexpr size_t WS_XP = 500 * MiB;
constexpr size_t WS_H = 644 * MiB;
constexpr size_t WS_YP = 716 * MiB;
constexpr size_t WS_LCS = 1012 * MiB;
constexpr size_t WS_KA = 1014 * MiB;
constexpr size_t WS_END = 1018 * MiB;
constexpr size_t WS_WR = 5 * MiB;
constexpr size_t WS_SKIP = 4 * MiB + 65536;
constexpr size_t WS_TOT = 4 * MiB;
constexpr int CW_CNT = 1024;
constexpr int CW_Q = 2048;
constexpr int CW_BAR = 8192;
constexpr int MAXTILES = 288;

typedef float f32x16 __attribute__((ext_vector_type(16)));
typedef unsigned short bf16;

struct Args {
    const float* in[28]; float* out; unsigned char* ws;
};

__device__ __forceinline__ float sigmoidf_(float x) { return 1.0f / (1.0f + expf(-x)); }
__device__ __forceinline__ float logsigmoidf_(float x) { return x >= 0.f ? -log1pf(expf(-x)) : x - log1pf(expf(x)); }
__device__ __forceinline__ float wave_sum(float v) {
#pragma unroll
    for (int o = 1; o < 64; o <<= 1) v += __shfl_xor(v, o);
    return v;
}
__device__ __forceinline__ unsigned f2bf(float f) { unsigned u = __builtin_bit_cast(unsigned, f); return (u + 0x7fffu + ((u >> 16) & 1u)) >> 16; }
__device__ __forceinline__ unsigned pk2(float lo, float hi) { return f2bf(lo) | (f2bf(hi) << 16); }
__device__ __forceinline__ float bf2f(unsigned short b) { return __builtin_bit_cast(float, (unsigned)b << 16); }
__device__ __forceinline__ float pf(const bf16* Pb, size_t m, int c) { return bf2f(Pb[m * PW + c]); }

namespace pg8 {
#define PG8_LAS __attribute__((address_space(3)))
typedef unsigned short bf16_t;
typedef short bf16x8 __attribute__((ext_vector_type(8)));
typedef float f32x4 __attribute__((ext_vector_type(4)));
typedef unsigned u32x4 __attribute__((ext_vector_type(4)));
constexpr int BM = 256, BK = 64, HALF = 128, HTB = HALF * BK * 2  , STAGE_BYTES = 8 * HTB, NXCD = 8, WGM = 8;

__host__ __device__ __forceinline__ int lds_byte(int r, int c) { const int st = (r >> 4) * 2 + (c >> 5), rr = r & 15, cc = c & 31, ob = rr * 64 + cc * 2; return st * 1024 + (ob ^ (((ob >> 9) & 1) << 5)); }
__host__ __device__ __forceinline__ void stage_rc(int b, int& R, int& C) { const int st = b / 1024, sb = b % 1024, swz = sb ^ (((sb >> 9) & 1) << 5); R = (st >> 1) * 16 + swz / 64; C = (st & 1) * 32 + (swz % 64) / 2; }
__host__ __device__ __forceinline__ int perm32(int rho) { const int n = rho >> 4, i = rho & 15; return 8 * (i >> 2) + 4 * n + (i & 3); }

struct Unit { int pm, pn, pc; };
struct Gemm { const bf16_t* A; const bf16_t* Bt; int M, N, K; };

struct StaticOrder {
    int nM, nN, nwg, G, c;
    __host__ __device__ void init(int M, int N, int G_, int c_) { nM = M / BM; nN = N / BM; nwg = nM * nN; G = G_; c = c_; }
    __host__ __device__ bool next(int i, Unit& u) const {
        const long L = (long)i * G + c; if (L >= nwg) return false;
        int wgid = (int)L; { const int q = nwg / NXCD, r = nwg % NXCD, xcd = wgid % NXCD, off = wgid / NXCD; wgid = (xcd < r ? xcd * (q + 1) : r * (q + 1) + (xcd - r) * q) + off; }
        const int nig = WGM * nN, gid = wgid / nig, fm = gid * WGM, gsz = (nM - fm) < WGM ? (nM - fm) : WGM;
        u.pm = fm + ((wgid % nig) % gsz); u.pn = (wgid % nig) / gsz; u.pc = u.pn; return true;
    }
    __device__ __forceinline__ void a_ready(const Unit&) const {}
    __device__ __forceinline__ void done(const Unit&) const {}
};

__device__ __forceinline__ unsigned cvt_pk_bf16(float lo, float hi) { unsigned r; asm volatile("v_cvt_pk_bf16_f32 %0, %1, %2" : "=v"(r) : "v"(lo), "v"(hi)); return r; }

struct EpiF32 {
    static constexpr bool PERM = false, AFTER_DRAIN = false;
    float* O; int ldc;
    __device__ __forceinline__ void operator()(const f32x4 (&acc)[2][2][4][2], const Unit& u, int wr, int wc, int fr, int fq) const {
        const int row0 = u.pm * BM + wr * 64 + fr; const int col0 = u.pc * BM + wc * 32 + 4 * fq;
#pragma unroll
        for (int ai = 0; ai < 2; ++ai)
#pragma unroll
            for (int m = 0; m < 4; ++m) { float* rowp = O + (size_t)(row0 + ai * HALF + m * 16) * ldc + col0;
#pragma unroll
                for (int bj = 0; bj < 2; ++bj)
#pragma unroll
                    for (int n = 0; n < 2; ++n) *(f32x4*)(rowp + bj * HALF + n * 16) = acc[ai][bj][m][n]; }
    }
};
struct EpiSwiGlu {
    static constexpr bool PERM = true, AFTER_DRAIN = false;
    bf16_t* O; int ldc;
    __device__ __forceinline__ static float silu(float v) { return v * __builtin_amdgcn_rcpf(1.0f + __builtin_amdgcn_exp2f(-1.4426950408889634f * v)); }
    __device__ __forceinline__ void operator()(const f32x4 (&acc)[2][2][4][2], const Unit& u, int wr, int wc, int fr, int fq) const {
        const int row0 = u.pm * BM + wr * 64 + fr; const int col0 = u.pc * HALF + wc * 32 + 8 * fq;
#pragma unroll
        for (int ai = 0; ai < 2; ++ai)
#pragma unroll
            for (int m = 0; m < 4; ++m) { bf16_t* rowp = O + (size_t)(row0 + ai * HALF + m * 16) * ldc + col0;
                f32x4 h0, h1;
#pragma unroll
                for (int e = 0; e < 4; ++e) { h0[e] = silu(acc[ai][0][m][0][e]) * acc[ai][1][m][0][e]; h1[e] = silu(acc[ai][0][m][1][e]) * acc[ai][1][m][1][e]; }
                u32x4 w; w.x = cvt_pk_bf16(h0[0], h0[1]); w.y = cvt_pk_bf16(h0[2], h0[3]); w.z = cvt_pk_bf16(h1[0], h1[1]); w.w = cvt_pk_bf16(h1[2], h1[3]);
                *(u32x4*)rowp = w; }
    }
};
struct MoeOrder {
    int ntile, G, c; const PG8_LAS int* tile_e;
    __device__ __forceinline__ bool next(int i, Unit& u) const { const int L = i * G + c; if (L >= ntile * 4) return false; const int rt = L >> 2, pn = L & 3; u.pm = rt; u.pn = tile_e[rt] * 4 + pn; u.pc = pn; return true; }
    __device__ __forceinline__ void a_ready(const Unit&) const {}
    __device__ __forceinline__ void done(const Unit&) const {}
};
struct EpiInProj {
    static constexpr bool PERM = true, AFTER_DRAIN = false;
    bf16_t* O; int ldc; float qscale;
    __device__ __forceinline__ void operator()(const f32x4 (&acc)[2][2][4][2], const Unit& u, int wr, int wc, int fr, int fq) const {
        const int row0 = u.pm * BM + wr * 64 + fr; const int col0 = u.pc * BM + wc * 32 + 8 * fq;
        const float sc = (u.pc < 2) ? qscale : 1.f;
#pragma unroll
        for (int ai = 0; ai < 2; ++ai)
#pragma unroll
            for (int m = 0; m < 4; ++m) { bf16_t* rowp = O + (size_t)(row0 + ai * HALF + m * 16) * ldc + col0;
#pragma unroll
                for (int bj = 0; bj < 2; ++bj) { const f32x4 v0 = acc[ai][bj][m][0] * sc, v1 = acc[ai][bj][m][1] * sc;
                    u32x4 w; w.x = cvt_pk_bf16(v0[0], v0[1]); w.y = cvt_pk_bf16(v0[2], v0[3]); w.z = cvt_pk_bf16(v1[0], v1[1]); w.w = cvt_pk_bf16(v1[2], v1[3]);
                    *(u32x4*)(rowp + bj * HALF) = w; } }
    }
};
template <class Epi, class Sched, bool ALIGN_EPI = false, bool SP2 = false>
__device__ __forceinline__ void gemm_phase(PG8_LAS unsigned char* lds, const Gemm g, const Sched& S, const Epi& E) {
    const int tid = ltid(), wid = __builtin_amdgcn_readfirstlane(tid >> 6), lane = tid & 63, wr = wid >> 2, wc = wid & 3, fr = lane & 15, fq = lane >> 4;
    const int K = g.K, nt = K / BK;
    unsigned voffA[2], voffB[2];
#pragma unroll
    for (int i = 0; i < 2; ++i) { int R, C; stage_rc(tid * 16 + i * 8192, R, C); const int Rb = Epi::PERM ? ((R & ~31) + perm32(R & 31)) : R;
        voffA[i] = (unsigned)(R * K + C) * 2u; voffB[i] = (unsigned)(Rb * K + C) * 2u; }
    const size_t kstep = (size_t)(BK * 2);
    const size_t hstep = (size_t)HALF * K * 2;
    const size_t tstep = 2 * hstep;
    const unsigned ldsw = (unsigned)wid * 1024u;
    const int aoff = lds_byte(wr * 64 + fr, fq * 8), boff = lds_byte(wc * 32 + fr, fq * 8);
#define PG8_SA(b, h) (((b) * 2 + (h)) * HTB)
#define PG8_SB(b, h) ((4 + (b) * 2 + (h)) * HTB)
#define PG8_STAGE(bufoff, gbase, voff) do { _Pragma("unroll") for (int _i = 0; _i < 2; ++_i) \
        __builtin_amdgcn_global_load_lds((const unsigned*)((const char*)(gbase) + (voff)[_i]), (PG8_LAS unsigned*)(lds + (bufoff) + ldsw + _i * 8192), 16, 0, 0); } while (0)
#define PG8_LDA(dst, b, h) do { _Pragma("unroll") for (int m = 0; m < 4; ++m) _Pragma("unroll") for (int k = 0; k < 2; ++k) dst[m][k] = *(const PG8_LAS bf16x8*)(lds + PG8_SA(b, h) + aoff + m * 2048 + k * 1024); } while (0)
#define PG8_LDB(dst, b, h) do { _Pragma("unroll") for (int n = 0; n < 2; ++n) _Pragma("unroll") for (int k = 0; k < 2; ++k) dst[n][k] = *(const PG8_LAS bf16x8*)(lds + PG8_SB(b, h) + boff + n * 2048 + k * 1024); } while (0)
#define PG8_MMA(ai, bj, At, Bt) do { __builtin_amdgcn_s_setprio(1); _Pragma("unroll") for (int m = 0; m < 4; ++m) _Pragma("unroll") for (int n = 0; n < 2; ++n) _Pragma("unroll") for (int k = 0; k < 2; ++k) \
        acc[ai][bj][m][n] = __builtin_amdgcn_mfma_f32_16x16x32_bf16(Bt[n][k], At[m][k], acc[ai][bj][m][n], 0, 0, 0); __builtin_amdgcn_s_setprio(0); } while (0)
#define PG8_WAIT_V(n) asm volatile("s_waitcnt vmcnt(" #n ")" ::: "memory")
#define PG8_WAIT_L(n) asm volatile("s_waitcnt lgkmcnt(" #n ")" ::: "memory")
#define PG8_BAR __builtin_amdgcn_s_barrier()
#define PG8_SCHED __builtin_amdgcn_sched_barrier(0)
    Unit cur, nxt; int ui = 0;
    if (!S.next(0, cur)) return;
    f32x4 acc[2][2][4][2];
#pragma unroll
    for (int a = 0; a < 2; ++a)
#pragma unroll
        for (int b = 0; b < 2; ++b)
#pragma unroll
            for (int m = 0; m < 4; ++m)
#pragma unroll
                for (int n = 0; n < 2; ++n) acc[a][b][m][n] = (f32x4){0.f, 0.f, 0.f, 0.f};
    bf16x8 At[4][2], B0[2][2], B1[2][2];
    const char* cA = (const char*)g.A + (size_t)cur.pm * tstep; const char* cB = (const char*)g.Bt + (size_t)cur.pn * tstep;
    S.a_ready(cur);
    if constexpr (SP2) {
        PG8_STAGE(PG8_SB(0, 0), cB, voffB); PG8_STAGE(PG8_SB(0, 1), cB + hstep, voffB); PG8_STAGE(PG8_SA(0, 0), cA, voffA); PG8_STAGE(PG8_SA(0, 1), cA + hstep, voffA);
        if (wr == 1) PG8_BAR;
        PG8_WAIT_V(2); PG8_BAR;
        PG8_STAGE(PG8_SB(1, 0), cB + kstep, voffB); PG8_STAGE(PG8_SA(1, 0), cA + kstep, voffA); PG8_STAGE(PG8_SB(1, 1), cB + hstep + kstep, voffB);
        PG8_WAIT_V(6); PG8_BAR;
    } else {
        PG8_STAGE(PG8_SB(0, 0), cB, voffB); PG8_STAGE(PG8_SA(0, 0), cA, voffA); PG8_STAGE(PG8_SB(0, 1), cB + hstep, voffB); PG8_STAGE(PG8_SA(0, 1), cA + hstep, voffA);
        if (wr == 1) PG8_BAR;
        PG8_WAIT_V(4); PG8_BAR;
        PG8_STAGE(PG8_SB(1, 0), cB + kstep, voffB); PG8_STAGE(PG8_SA(1, 0), cA + kstep, voffA); PG8_STAGE(PG8_SB(1, 1), cB + hstep + kstep, voffB);
        PG8_WAIT_V(6); PG8_BAR;
    }
    for (;;) {
        const bool has_next = S.next(ui + 1, nxt);
        const char* nA = has_next ? (const char*)g.A + (size_t)nxt.pm * tstep : cA; const char* nB = has_next ? (const char*)g.Bt + (size_t)nxt.pn * tstep : cB;
        for (int t = 0; t < nt; t += 2) {
            const bool last = (t == nt - 2);
            const char* a1 = cA + (size_t)(t + 1) * kstep;
            const char* a2 = last ? nA : cA + (size_t)(t + 2) * kstep; const char* b2 = last ? nB : cB + (size_t)(t + 2) * kstep;
            const char* a3 = a2 + kstep; const char* b3 = b2 + kstep;
            if (last && has_next) S.a_ready(nxt);
            if constexpr (SP2) {
            PG8_LDB(B0, 0, 0); PG8_LDB(B1, 0, 1); PG8_SCHED; PG8_LDA(At, 0, 0); PG8_STAGE(PG8_SA(1, 1), a1 + hstep, voffA);
            PG8_WAIT_V(8); PG8_WAIT_L(0); PG8_BAR; PG8_MMA(0, 0, At, B0); PG8_MMA(0, 1, At, B1); PG8_BAR; PG8_SCHED;
            PG8_LDA(At, 0, 1); PG8_STAGE(PG8_SB(0, 0), b2, voffB); PG8_STAGE(PG8_SB(0, 1), b2 + hstep, voffB); PG8_STAGE(PG8_SA(0, 0), a2, voffA);
            PG8_WAIT_V(8); PG8_WAIT_L(0); PG8_BAR; PG8_MMA(1, 0, At, B0); PG8_MMA(1, 1, At, B1); PG8_BAR; PG8_SCHED;
            PG8_LDB(B0, 1, 0); PG8_LDB(B1, 1, 1); PG8_SCHED; PG8_LDA(At, 1, 0); PG8_STAGE(PG8_SA(0, 1), a2 + hstep, voffA);
            PG8_WAIT_V(8); PG8_WAIT_L(0); PG8_BAR; PG8_MMA(0, 0, At, B0); PG8_MMA(0, 1, At, B1); PG8_BAR; PG8_SCHED;
            PG8_LDA(At, 1, 1); PG8_STAGE(PG8_SB(1, 0), b3, voffB); PG8_STAGE(PG8_SB(1, 1), b3 + hstep, voffB); PG8_STAGE(PG8_SA(1, 0), a3, voffA);
            PG8_WAIT_V(8); PG8_WAIT_L(0); PG8_BAR; PG8_MMA(1, 0, At, B0); PG8_MMA(1, 1, At, B1); PG8_BAR; PG8_SCHED;
            } else {
            PG8_LDB(B0, 0, 0); PG8_SCHED; PG8_LDA(At, 0, 0); PG8_STAGE(PG8_SA(1, 1), a1 + hstep, voffA);
            PG8_WAIT_L(8); PG8_BAR; PG8_WAIT_L(0); PG8_MMA(0, 0, At, B0); PG8_BAR; PG8_SCHED;
            PG8_LDB(B1, 0, 1); PG8_STAGE(PG8_SB(0, 0), b2, voffB);
            PG8_BAR; PG8_WAIT_L(0); PG8_MMA(0, 1, At, B1); PG8_BAR;
            PG8_LDA(At, 0, 1); PG8_STAGE(PG8_SA(0, 0), a2, voffA);
            PG8_BAR; PG8_WAIT_L(0); PG8_MMA(1, 0, At, B0); PG8_BAR; PG8_SCHED;
            PG8_STAGE(PG8_SB(0, 1), b2 + hstep, voffB);
            PG8_WAIT_V(6); PG8_BAR; PG8_MMA(1, 1, At, B1); PG8_BAR;
            PG8_LDB(B0, 1, 0); PG8_SCHED; PG8_LDA(At, 1, 0); PG8_STAGE(PG8_SA(0, 1), a2 + hstep, voffA);
            PG8_WAIT_L(8); PG8_BAR; PG8_WAIT_L(0); PG8_MMA(0, 0, At, B0); PG8_BAR; PG8_SCHED;
            PG8_LDB(B1, 1, 1); PG8_STAGE(PG8_SB(1, 0), b3, voffB);
            PG8_BAR; PG8_WAIT_L(0); PG8_MMA(0, 1, At, B1); PG8_BAR;
            PG8_LDA(At, 1, 1); PG8_STAGE(PG8_SA(1, 0), a3, voffA);
            PG8_BAR; PG8_WAIT_L(0); PG8_MMA(1, 0, At, B0); PG8_BAR; PG8_SCHED;
            PG8_STAGE(PG8_SB(1, 1), b3 + hstep, voffB);
            PG8_WAIT_V(6); PG8_BAR; PG8_MMA(1, 1, At, B1); PG8_BAR;
            }
        }
        if constexpr (ALIGN_EPI) { if (wr == 0) PG8_BAR; }
        if constexpr (!Epi::AFTER_DRAIN) { E(acc, cur, wr, wc, fr, fq); S.done(cur); }
        if (!has_next) break;
#pragma unroll
        for (int a = 0; a < 2; ++a)
#pragma unroll
            for (int b = 0; b < 2; ++b)
#pragma unroll
                for (int m = 0; m < 4; ++m)
#pragma unroll
                    for (int n = 0; n < 2; ++n) acc[a][b][m][n] = (f32x4){0.f, 0.f, 0.f, 0.f};
        cur = nxt; cA = nA; cB = nB; ++ui;
        if constexpr (ALIGN_EPI) { if (wr == 1) PG8_BAR; }
    }
    PG8_WAIT_V(0);
    if constexpr (!ALIGN_EPI) { if (wr == 0) PG8_BAR; }
    PG8_BAR;
    if constexpr (Epi::AFTER_DRAIN) { E.fused(acc, cur, wr, wc, fr, fq, lds, wid, lane); S.done(cur); }
#undef PG8_SA
#undef PG8_SB
#undef PG8_STAGE
#undef PG8_LDA
#undef PG8_LDB
#undef PG8_MMA
#undef PG8_WAIT_V
#undef PG8_WAIT_L
#undef PG8_BAR
#undef PG8_SCHED
}
}

template <class RowMap, class Epi>
__device__ __forceinline__ void gemm_tile_f32(float* lds, const float* __restrict__ A, int lda, RowMap rowmap, int nvalid,
                                              const float* __restrict__ B, int ldb, int col0, int N, int K, Epi epi) {
    float* As = lds;
    float* Bs = lds + 128 * 17;
    const int tid = ltid(), lane = tid & 63, wid = tid >> 6, wm = wid & 3, wn = wid >> 2;
    const int arow = tid >> 2, akq = (tid & 3) * 4;
    const int src = (arow < nvalid) ? rowmap(arow) : -1;
    const float* ap = A + (size_t)(src < 0 ? 0 : src) * lda + akq;
    const int bk = tid >> 5, bn = (tid & 31) * 4;
    const bool bok = (col0 + bn) < N;
    const float* bp = B + (size_t)bk * ldb + col0 + bn;
    f32x16 acc0 = {}, acc1 = {};
    for (int k0 = 0; k0 < K; k0 += 16) {
        pg8::f32x4 av = (pg8::f32x4){0.f, 0.f, 0.f, 0.f}, bv = (pg8::f32x4){0.f, 0.f, 0.f, 0.f};
        if (src >= 0) av = *(const pg8::f32x4*)(ap + k0);
        if (bok) bv = *(const pg8::f32x4*)(bp + (size_t)k0 * ldb);
        __syncthreads();
        As[arow * 17 + akq + 0] = av[0]; As[arow * 17 + akq + 1] = av[1]; As[arow * 17 + akq + 2] = av[2]; As[arow * 17 + akq + 3] = av[3];
        *(pg8::f32x4*)(Bs + bk * 132 + bn) = bv;
        __syncthreads();
#pragma unroll
        for (int kk = 0; kk < 16; kk += 2) {
            const float a = As[(32 * wm + (lane & 31)) * 17 + kk + (lane >> 5)];
            const float b0 = Bs[(kk + (lane >> 5)) * 132 + 64 * wn + (lane & 31)];
            const float b1 = Bs[(kk + (lane >> 5)) * 132 + 64 * wn + 32 + (lane & 31)];
            acc0 = __builtin_amdgcn_mfma_f32_32x32x2f32(a, b0, acc0, 0, 0, 0);
            acc1 = __builtin_amdgcn_mfma_f32_32x32x2f32(a, b1, acc1, 0, 0, 0);
        }
    }
#pragma unroll
    for (int r = 0; r < 16; ++r) {
        const int i = 32 * wm + (r & 3) + 8 * (r >> 2) + 4 * (lane >> 5);
        const int c0 = col0 + 64 * wn + (lane & 31);
        if (i < nvalid) {
            if (c0 < N) epi(i, c0, acc0[r]);
            if (c0 + 32 < N) epi(i, c0 + 32, acc1[r]);
        }
    }
}

#include <hip/hip_bf16.h>
namespace attn_body {
using bf16=__hip_bfloat16;
using bf16x8=__attribute__((ext_vector_type(8)))short;
using s16x4=__attribute__((ext_vector_type(4)))short;
using f32x16=__attribute__((ext_vector_type(16)))float;
using u32x4=__attribute__((ext_vector_type(4)))unsigned;
typedef float f32x4_t __attribute__((ext_vector_type(4)));
constexpr int BATCH=2,NHEAD=8,SEQ=16384,D=64,DM=3584,OP=1024;
constexpr int NW=8,QBLK=32,QB=QBLK*NW,KVBLK=64,NQB=SEQ/QB;
constexpr int ATTN_PITCH=DM, ATTN_UNIT_ROWS=QB;
__device__ __forceinline__ int crow(int r,int hi){return (r&3)+8*(r>>2)+4*hi;}
#define SBAR() __builtin_amdgcn_sched_barrier(0)
__device__ __forceinline__ void cmask(f32x16&p0,f32x16&p1,int jb,int qrel,int hi){
  const float NEG=-INFINITY; int kb=64*jb+4*hi;
  #pragma unroll
  for(int r=0;r<16;++r){int kv=kb+(r&3)+8*(r>>2); if(kv>qrel)p0[r]=NEG; if(kv+32>qrel)p1[r]=NEG;}
}

constexpr int NSLOT=3, SLOTB=8192;
constexpr int LDS_K=0, LDS_V=NSLOT*SLOTB, LDS_WS=2*NSLOT*SLOTB, LDS_OST=LDS_WS+NW*64*4, LDS_BYTES=LDS_OST+NW*4096;
constexpr float C2=0.125f*1.4426950408889634f;
__device__ __forceinline__ void glds16(const void*gsrc,unsigned lds_dst){unsigned keep;
  asm volatile("s_mov_b32 %0, m0\n\ts_mov_b32 m0, %2\n\ts_nop 0\n\tglobal_load_lds_dwordx4 %1, off\n\ts_mov_b32 m0, %0":"=&s"(keep):"v"(gsrc),"s"(lds_dst):"memory");}
__device__ __forceinline__ float max3f(float a,float b,float c){float r;asm("v_max3_f32 %0, %1, %2, %3":"=v"(r):"v"(a),"v"(b),"v"(c));return r;}
__device__ __forceinline__ float max2f(float a,float b){float r;asm("v_max_f32_e32 %0, %1, %2":"=v"(r):"v"(a),"v"(b));return r;}
__device__ __forceinline__ float fadd_s(float a,float b){float r;asm("v_add_f32_e32 %0, %1, %2":"=v"(r):"v"(a),"v"(b));return r;}
__device__ __forceinline__ float fsub_s(float a,float b){float r;asm("v_sub_f32_e32 %0, %1, %2":"=v"(r):"v"(a),"v"(b));return r;}
typedef float f32x2_t __attribute__((ext_vector_type(2))); typedef __bf16 bf16x2_t __attribute__((ext_vector_type(2)));
__device__ __forceinline__ unsigned cvtpk_s(float lo,float hi){f32x2_t v={lo,hi};bf16x2_t b=__builtin_convertvector(v,bf16x2_t);return __builtin_bit_cast(unsigned,b);}
#define WAIT_BAR(N) asm volatile("s_waitcnt vmcnt(" #N ") lgkmcnt(0)\n\ts_barrier":::"memory")

__device__ __forceinline__ void qkt(f32x16&p0,f32x16&p1,const char*Kslot,const bf16x8*qr,int r32,int hi){
  const char*kb=Kslot+hi*1024+r32*16;
  #pragma unroll
  for(int d0=0;d0<4;++d0){
    const bf16x8 b0=*reinterpret_cast<const bf16x8*>(kb+d0*2048);
    const bf16x8 b1=*reinterpret_cast<const bf16x8*>(kb+d0*2048+512);
    p0=__builtin_amdgcn_mfma_f32_32x32x16_bf16(b0,qr[d0],p0,0,0,0);p1=__builtin_amdgcn_mfma_f32_32x32x16_bf16(b1,qr[d0],p1,0,0,0);}
}
typedef __attribute__((address_space(3))) const char* lds_cptr;
typedef short v4i16_t __attribute__((ext_vector_type(4)));
__device__ __forceinline__ void kload8(bf16x8*kf,lds_cptr kp){
  kf[0]=*(const __attribute__((address_space(3))) bf16x8*)(kp);      kf[1]=*(const __attribute__((address_space(3))) bf16x8*)(kp+512);
  kf[2]=*(const __attribute__((address_space(3))) bf16x8*)(kp+2048); kf[3]=*(const __attribute__((address_space(3))) bf16x8*)(kp+2560);
  kf[4]=*(const __attribute__((address_space(3))) bf16x8*)(kp+4096); kf[5]=*(const __attribute__((address_space(3))) bf16x8*)(kp+4608);
  kf[6]=*(const __attribute__((address_space(3))) bf16x8*)(kp+6144); kf[7]=*(const __attribute__((address_space(3))) bf16x8*)(kp+6656);
}
__device__ __forceinline__ void kload2(bf16x8*kf,lds_cptr kp,int j){ kf[2*j]=*(const __attribute__((address_space(3))) bf16x8*)(kp+j*2048); kf[2*j+1]=*(const __attribute__((address_space(3))) bf16x8*)(kp+j*2048+512); }
__device__ __forceinline__ s16x4 vtr(lds_cptr p){ return __builtin_bit_cast(s16x4,__builtin_amdgcn_ds_read_tr16_b64_v4i16((__attribute__((address_space(3))) v4i16_t*)p)); }
__device__ __forceinline__ float rowmax(const f32x16&p0,const f32x16&p1){
  float a=max3f(p0[0],p0[1],p1[0]),b=max3f(p0[2],p0[3],p1[1]);a=max3f(a,p1[2],p1[3]);
  #pragma unroll
  for(int r=4;r<16;r+=4){a=max3f(a,p0[r],p0[r+1]);b=max3f(b,p0[r+2],p0[r+3]);a=max3f(a,p1[r],p1[r+1]);b=max3f(b,p1[r+2],p1[r+3]);}
  const float m=max2f(a,b);
  auto rr=__builtin_amdgcn_permlane32_swap(__float_as_uint(m),__float_as_uint(m),false,false);
  return max2f(__uint_as_float(rr[0]),__uint_as_float(rr[1]));
}
__device__ __forceinline__ void pv(f32x16*o,int vb,bf16x8 pa0,bf16x8 pa1,bf16x8 pa2,bf16x8 pa3){
  #pragma unroll
  for(int d0=0;d0<2;++d0){s16x4 lo[4],hi[4];
    #pragma unroll
    for(int ks=0;ks<4;++ks){
      asm volatile("ds_read_b64_tr_b16 %0,%1 offset:%c2":"=&v"(lo[ks]):"v"(vb),"i"(d0*4096+ks*1024):"memory");
      asm volatile("ds_read_b64_tr_b16 %0,%1 offset:%c2":"=&v"(hi[ks]):"v"(vb),"i"(d0*4096+ks*1024+512):"memory");}
    asm volatile("s_waitcnt lgkmcnt(0)":::"memory");SBAR();
    #define PK(k) (bf16x8){lo[k][0],lo[k][1],lo[k][2],lo[k][3],hi[k][0],hi[k][1],hi[k][2],hi[k][3]}
    o[d0]=__builtin_amdgcn_mfma_f32_32x32x16_bf16(pa0,PK(0),o[d0],0,0,0);
    o[d0]=__builtin_amdgcn_mfma_f32_32x32x16_bf16(pa1,PK(1),o[d0],0,0,0);
    o[d0]=__builtin_amdgcn_mfma_f32_32x32x16_bf16(pa2,PK(2),o[d0],0,0,0);
    o[d0]=__builtin_amdgcn_mfma_f32_32x32x16_bf16(pa3,PK(3),o[d0],0,0,0);
    #undef PK
  }
}

#ifndef ATTN_STORE16
#define ATTN_STORE16(p,v) (*(u32x4*)(p)=(v))
#endif
template<int THRL> __device__ __forceinline__ void attn_unit(int b,int h,int qb,int t0,const bf16*Q,const bf16*__restrict__ K,const bf16*__restrict__ V,bf16*O,const unsigned char*KAg,char*shm){
  const int tid=ltid(),lane=tid&63,r32=lane&31,hi=lane>>5; const int wid=__builtin_amdgcn_readfirstlane(tid>>6);
  const long rowbase=(long)b*SEQ; const int q0=qb*QB;
  const bf16*Qw=Q+(rowbase+q0+wid*QBLK)*DM+h*D;
  const bf16*Kh=K+(rowbase+(long)t0*KVBLK)*DM+h*D,*Vh=V+(rowbase+(long)t0*KVBLK)*DM+h*D;
  const unsigned lds0=(unsigned)(uintptr_t)shm;
  float*wsf=(float*)(shm+LDS_WS)+wid*64;
  const bf16*ksrc=Kh+(long)lane*DM+wid*8;
  const bf16*vsrc=Vh+(long)(16*(wid&3)+(lane>>2))*DM+(wid>>2)*32+(lane&3)*8;
  const unsigned kdst=lds0+LDS_K+wid*1024, vdst=lds0+LDS_V+wid*1024;
  #define DMA_K(t,slot) glds16(ksrc+(long)(t)*KVBLK*DM,(unsigned)__builtin_amdgcn_readfirstlane(kdst+(slot)))
  #define DMA_V(t,slot) glds16(vsrc+(long)(t)*KVBLK*DM,(unsigned)__builtin_amdgcn_readfirstlane(vdst+(slot)))
  const int vb0=(int)(lds0+LDS_V)+((lane>>4)&1)*32+(lane&3)*8+(4*hi+((lane&15)>>2))*64;
  const char*Kbase=shm+LDS_K; bf16x8 kf[8];
  const lds_cptr shm3=(lds_cptr)shm; const lds_cptr kp0=shm3+LDS_K+hi*1024+r32*16; const lds_cptr vp0=shm3+LDS_V+((lane>>4)&1)*32+(lane&3)*8+(4*hi+((lane&15)>>2))*64;
  const int NT=(q0+QB)/KVBLK-t0;
  u32x4 ka0,ka1; u32x4 qaw;
  const unsigned kavoff=(unsigned)r32*16u;
  const unsigned long long kab0=(unsigned long long)(uintptr_t)KAg+((unsigned long long)((b*NHEAD+h)*(long)SEQ+(long)t0*KVBLK))*16ull;
  #define KA_LOAD(t) do{ const unsigned long long a_=kab0+(unsigned long long)(t)*1024ull; const unsigned lo_=__builtin_amdgcn_readfirstlane((unsigned)a_),hi_=__builtin_amdgcn_readfirstlane((unsigned)(a_>>32)); \
    const unsigned long long sb_=((unsigned long long)hi_<<32)|lo_; \
    asm volatile("s_nop 4\n\tglobal_load_dwordx4 %0, %2, %3\n\tglobal_load_dwordx4 %1, %2, %3 offset:512":"=&v"(ka0),"=&v"(ka1):"v"(kavoff),"s"(sb_):"memory"); }while(0)
  #define QA_SET() do{ const float nm_=-mhat; const unsigned h_=cvtpk_s(nm_,0.f)&0xffffu; const float r1_=nm_-__uint_as_float(h_<<16); const unsigned m_=cvtpk_s(r1_,0.f)&0xffffu; \
    const float r2_=r1_-__uint_as_float(m_<<16); const unsigned l_=cvtpk_s(r2_,0.f)&0xffffu; \
    qaw[0]=hi?0u:0x3f803f80u; qaw[1]=hi?0u:(0x3f80u|(h_<<16)); qaw[2]=hi?0u:(m_|(l_<<16)); qaw[3]=0u; asm volatile("":"+v"(qaw)); }while(0)
  #define AUG(C0,C1) do{ C0=__builtin_amdgcn_mfma_f32_32x32x16_bf16(__builtin_bit_cast(bf16x8,ka0),__builtin_bit_cast(bf16x8,qaw),f32x16{},0,0,0); \
    C1=__builtin_amdgcn_mfma_f32_32x32x16_bf16(__builtin_bit_cast(bf16x8,ka1),__builtin_bit_cast(bf16x8,qaw),f32x16{},0,0,0); }while(0)
  #define PIN_KA() asm volatile("; KA landed":"+v"(ka0),"+v"(ka1)::"memory")
  #define WAIT_BAR_KA(N) do{ WAIT_BAR(N); PIN_KA(); }while(0)
  KA_LOAD(0);
  DMA_K(0,0);DMA_V(0,0);DMA_K(1,SLOTB);
  bf16x8 qr[4];
  #pragma unroll
  for(int d0=0;d0<4;++d0)qr[d0]=*reinterpret_cast<const bf16x8*>(&Qw[(long)r32*DM+d0*16+hi*8]);
  float mhat=0.f,l_reg=0.f;f32x16 o[2];o[0]=f32x16{};o[1]=f32x16{}; QA_SET();
  const int qrel=wid*QBLK+r32;
  #define CMASK(P0,P1,t) do{int jb_=(t)-(NT-4); if(jb_>=0)cmask(P0,P1,jb_,qrel,hi);}while(0)
  bool resc=false;
  #define START(P0,P1) do{ const float rm=rowmax(P0,P1); resc=false; \
    { const float dl=rm; mhat=fadd_s(mhat,dl); \
      _Pragma("unroll") for(int r=0;r<16;++r){P0[r]=fsub_s(P0[r],dl);P1[r]=fsub_s(P1[r],dl);} \
      QA_SET(); } \
    _Pragma("unroll") for(int r=0;r<16;++r)P0[r]=__builtin_amdgcn_exp2f(P0[r]); }while(0)
  #define RESC() do{ if(resc){ asm volatile("s_waitcnt lgkmcnt(0)":::"memory"); \
      _Pragma("unroll") for(int d_=0;d_<2;++d_) _Pragma("unroll") for(int r=0;r<16;++r)o[d_][r]*=wsf[crow(r,hi)]; } }while(0)
  f32x16 pA0,pA1,pB0,pB1;
  int sl_prev=0,sl_cur=0,sl_next=SLOTB;
  #define ROT() do{sl_prev=sl_cur;sl_cur=sl_next;sl_next=(sl_next==(NSLOT-1)*SLOTB)?0:sl_next+SLOTB;}while(0)
  DMA_K(2,2*SLOTB);
  WAIT_BAR_KA(3);
  AUG(pA0,pA1); qkt(pA0,pA1,Kbase,qr,r32,hi);asm volatile("s_nop 15\n\ts_nop 7":"+v"(pA0),"+v"(pA1));CMASK(pA0,pA1,0);
  START(pA0,pA1);
  _Pragma("unroll") for(int r=0;r<16;++r)pA1[r]=__builtin_amdgcn_exp2f(pA1[r]);
  WAIT_BAR(0);
  KA_LOAD(1);DMA_K(3,0);DMA_V(1,SLOTB);
  ROT();
  kload8(kf,kp0+sl_cur);
  WAIT_BAR_KA(2);
  s16x4 vlo[8],vhi[8]; u32x4 pw0,pw1,pw2,pw3;
  #define PKW(P,B) cvtpk_s(P[B],P[B+1])
  #define PAF(k) __builtin_bit_cast(bf16x8,pw##k)
  #define VFR(i) (bf16x8){vlo[i][0],vlo[i][1],vlo[i][2],vlo[i][3],vhi[i][0],vhi[i][1],vhi[i][2],vhi[i][3]}
  #define PIN(x) asm volatile("":"+v"(x))
  #define MX3(a,b,c) __builtin_fmaxf(__builtin_fmaxf((a),(b)),(c))
  #define GAPA(MF,A0,A1,A2,A3,W0,W1,PW) do{ MF; sacc+=A0; sacc+=A1; sacc+=A2; sacc+=A3; PIN(sacc); W0; W1; PIN(PW); SBAR(); }while(0)
  #define EX(v) __builtin_amdgcn_exp2f(v)
  #define GAPB(MF,X,B) do{ MF; X[B]=EX(X[B]); X[B+1]=EX(X[B+1]); X[B+2]=EX(X[B+2]); X[B+3]=EX(X[B+3]); PIN(X); SBAR(); }while(0)
  #define VRD(i) do{ vlo[i]=vtr(vp_+(((i)>>2)*4096+((i)&3)*1024)); vhi[i]=vtr(vp_+(((i)>>2)*4096+((i)&3)*1024+512)); }while(0)
  #define KRD(G,j) do{ if(G){ kload2(kf,kp0+sl_next,j); SBAR(); } }while(0)
  #define STEP(C0,C1,P0,P1,t,GK,GV,GL) do{ SBAR(); \
    const lds_cptr vp_=vp0+sl_prev; \
    AUG(C0,C1); SBAR(); \
    VRD(0); SBAR(); float sacc=(P0[0]+P0[1]); \
    GAPA(C0=__builtin_amdgcn_mfma_f32_32x32x16_bf16(kf[0],qr[0],C0,0,0,0), P0[2],P0[3],P0[4],P0[5],     pw0[0]=PKW(P0,0), pw0[1]=PKW(P0,2), pw0); \
    VRD(4); SBAR(); GAPA(C1=__builtin_amdgcn_mfma_f32_32x32x16_bf16(kf[1],qr[0],C1,0,0,0), P0[6],P0[7],P0[8],P0[9],     pw0[2]=PKW(P0,4), pw0[3]=PKW(P0,6), pw0); \
    VRD(1); SBAR(); GAPA(C0=__builtin_amdgcn_mfma_f32_32x32x16_bf16(kf[2],qr[1],C0,0,0,0),   P0[10],P0[11],P0[12],P0[13], pw1[0]=PKW(P0,8), pw1[1]=PKW(P0,10), pw1); \
    VRD(5); SBAR(); GAPA(C1=__builtin_amdgcn_mfma_f32_32x32x16_bf16(kf[3],qr[1],C1,0,0,0),   P0[14],P0[15],P1[0],P1[1],   pw1[2]=PKW(P0,12),pw1[3]=PKW(P0,14), pw1); \
    VRD(2); SBAR(); GAPA(C0=__builtin_amdgcn_mfma_f32_32x32x16_bf16(kf[4],qr[2],C0,0,0,0),   P1[2],P1[3],P1[4],P1[5],     pw2[0]=PKW(P1,0), pw2[1]=PKW(P1,2), pw2); \
    VRD(6); SBAR(); GAPA(C1=__builtin_amdgcn_mfma_f32_32x32x16_bf16(kf[5],qr[2],C1,0,0,0),   P1[6],P1[7],P1[8],P1[9],     pw2[2]=PKW(P1,4), pw2[3]=PKW(P1,6), pw2); \
    VRD(3); SBAR(); GAPA(C0=__builtin_amdgcn_mfma_f32_32x32x16_bf16(kf[6],qr[3],C0,0,0,0),   P1[10],P1[11],P1[12],P1[13], pw3[0]=PKW(P1,8), pw3[1]=PKW(P1,10), pw3); \
    VRD(7); SBAR(); GAPA(C1=__builtin_amdgcn_mfma_f32_32x32x16_bf16(kf[7],qr[3],C1,0,0,0),   P1[14],P1[15],0.f,0.f,       pw3[2]=PKW(P1,12),pw3[3]=PKW(P1,14), pw3); \
    l_reg+=sacc; \
    if(GL){KA_LOAD((t)+1);} if(GK){DMA_K((t)+3,sl_cur);} if(GV){DMA_V((t)+1,sl_next);} \
    CMASK(C0,C1,t); \
    { float a=MX3(C0[0],C0[1],C1[0]),b=MX3(C0[2],C0[3],C1[1]); a=MX3(a,C1[2],C1[3]); \
      _Pragma("unroll") for(int r=4;r<16;r+=4){a=MX3(a,C0[r],C0[r+1]);b=MX3(b,C0[r+2],C0[r+3]);a=MX3(a,C1[r],C1[r+1]);b=MX3(b,C1[r+2],C1[r+3]);} \
      float rm=__builtin_fmaxf(a,b); { auto rr=__builtin_amdgcn_permlane32_swap(__float_as_uint(rm),__float_as_uint(rm),false,false); rm=__builtin_fmaxf(__uint_as_float(rr[0]),__uint_as_float(rr[1])); } \
      resc=false; \
      if(__builtin_expect(__any(rm>(float)THRL),0)){ const float dl=__builtin_fmaxf(rm,0.f); mhat+=dl; \
        _Pragma("unroll") for(int r=0;r<16;++r){C0[r]-=dl;C1[r]-=dl;} \
        QA_SET(); \
        const float f=__builtin_amdgcn_exp2f(-dl); l_reg*=f; if(hi==0)wsf[r32]=f; resc=true; } } \
    SBAR(); \
    GAPB(o[0]=__builtin_amdgcn_mfma_f32_32x32x16_bf16(PAF(0),VFR(0),o[0],0,0,0), C0,0); \
    GAPB(o[1]=__builtin_amdgcn_mfma_f32_32x32x16_bf16(PAF(0),VFR(4),o[1],0,0,0), C0,4); \
    KRD(GL,0); GAPB(o[0]=__builtin_amdgcn_mfma_f32_32x32x16_bf16(PAF(1),VFR(1),o[0],0,0,0), C0,8); \
    KRD(GL,1); GAPB(o[1]=__builtin_amdgcn_mfma_f32_32x32x16_bf16(PAF(1),VFR(5),o[1],0,0,0), C0,12); \
    KRD(GL,2); GAPB(o[0]=__builtin_amdgcn_mfma_f32_32x32x16_bf16(PAF(2),VFR(2),o[0],0,0,0), C1,0); \
    KRD(GL,3); GAPB(o[1]=__builtin_amdgcn_mfma_f32_32x32x16_bf16(PAF(2),VFR(6),o[1],0,0,0), C1,4); \
    GAPB(o[0]=__builtin_amdgcn_mfma_f32_32x32x16_bf16(PAF(3),VFR(3),o[0],0,0,0), C1,8); \
    GAPB(o[1]=__builtin_amdgcn_mfma_f32_32x32x16_bf16(PAF(3),VFR(7),o[1],0,0,0), C1,12); \
    }while(0)
  int t=1;
  #undef CMASK
  #define CMASK(P0,P1,t) do{}while(0)
  for(;t+5<NT;t+=2){
    STEP(pB0,pB1,pA0,pA1,t,true,true,true);     WAIT_BAR_KA(2); RESC(); ROT();
    STEP(pA0,pA1,pB0,pB1,t+1,true,true,true);   WAIT_BAR_KA(2); RESC(); ROT();
  }
  #undef CMASK
  #define CMASK(P0,P1,t) do{int jb_=(t)-(NT-4); if(jb_>=0)cmask(P0,P1,jb_,qrel,hi);}while(0)
  #define ENDW(tt) do{ if((tt)+3<NT){WAIT_BAR(2);} else if((tt)+2<NT){WAIT_BAR(1);} else {WAIT_BAR(0);} PIN_KA(); }while(0)
  for(;t+1<NT;t+=2){
    STEP(pB0,pB1,pA0,pA1,t,(t+3<NT),(t+1<NT),(t+1<NT));       ENDW(t);   RESC(); ROT();
    STEP(pA0,pA1,pB0,pB1,t+1,(t+4<NT),(t+2<NT),(t+2<NT));     ENDW(t+1); RESC(); ROT();
  }
  STEP(pB0,pB1,pA0,pA1,NT-1,false,false,false); RESC();
  { float sacc=pB0[0]+pB0[1]; _Pragma("unroll") for(int r=2;r<16;++r)sacc+=pB0[r]; _Pragma("unroll") for(int r=0;r<16;++r)sacc+=pB1[r]; l_reg+=sacc;
    pw0=(u32x4){PKW(pB0,0),PKW(pB0,2),PKW(pB0,4),PKW(pB0,6)};pw1=(u32x4){PKW(pB0,8),PKW(pB0,10),PKW(pB0,12),PKW(pB0,14)};pw2=(u32x4){PKW(pB1,0),PKW(pB1,2),PKW(pB1,4),PKW(pB1,6)};pw3=(u32x4){PKW(pB1,8),PKW(pB1,10),PKW(pB1,12),PKW(pB1,14)};
    SBAR(); pv(o,vb0+sl_cur,PAF(0),PAF(1),PAF(2),PAF(3)); }
  #undef PKW
  #undef PAF
  #undef VFR
  #undef PIN
  #undef MX3
  #undef GAPA
  #undef GAPB
  #undef EX
  #undef VRD
  #undef KRD
  #undef STEP
  #undef ENDW
  {auto rr=__builtin_amdgcn_permlane32_swap(__float_as_uint(l_reg),__float_as_uint(l_reg),false,false);l_reg=__uint_as_float(rr[0])+__uint_as_float(rr[1]);}
  if(hi==0)wsf[32+r32]=l_reg;asm volatile("s_waitcnt lgkmcnt(0)":::"memory");
  float rli[16];
  #pragma unroll
  for(int r=0;r<16;++r)rli[r]=__builtin_amdgcn_rcpf(wsf[32+crow(r,hi)]);
  bf16*Ow=O+(rowbase+q0+wid*QBLK)*OP+h*D;
  { bf16*stg=(bf16*)(shm+LDS_OST)+wid*2048;
    #pragma unroll
    for(int r=0;r<16;++r){const int orow=crow(r,hi);
      #pragma unroll
      for(int d0=0;d0<2;++d0)stg[orow*64+d0*32+r32]=__float2bfloat16(o[d0][r]*rli[r]);}
    asm volatile("s_waitcnt lgkmcnt(0)":::"memory");
    #pragma unroll
    for(int i=0;i<4;++i){const int row=i*8+(lane>>3),ch=lane&7; const u32x4 v=*(const u32x4*)(stg+row*64+ch*8); ATTN_STORE16(Ow+(long)row*OP+ch*8,v);} }
  asm volatile("s_waitcnt lgkmcnt(0)\n\ts_barrier":::"memory");
  #undef DMA_K
  #undef DMA_V
  #undef KA_LOAD
  #undef QA_SET
  #undef AUG
  #undef WAIT_BAR_KA
  #undef PIN_KA
  #undef CMASK
  #undef START
  #undef RESC
  #undef ROT
}
constexpr int ATTN_LDS_BYTES=LDS_BYTES;
struct AttnTensors { const bf16* Q; const bf16* K; const bf16* V; bf16* O; const unsigned char* KA; };
struct AttnUnit { int bh; int qb; };
struct StaticOrder {
  int vcu;
  __device__ __forceinline__ explicit StaticOrder(int grid,int block):vcu((block%8)*(grid/8)+block/8){}
  __device__ __forceinline__ bool next(int i,AttnUnit&u)const{ if(i>=4)return false; const int s=vcu&15; u.bh=vcu>>4; u.qb=(i==0)?63-s:(i==1)?32+s:(i==2)?31-s:s; return true; }
  __device__ __forceinline__ void a_ready(const AttnUnit&)const{}
  __device__ __forceinline__ void done(const AttnUnit&)const{}
};
template<class Sched,int THRL=8> __device__ __forceinline__ void attn_phase(char*lds,const AttnTensors&T,const Sched&S){
  AttnUnit u;
  for(int i=0;S.next(i,u);++i){ S.a_ready(u); attn_unit<THRL>(u.bh/NHEAD,u.bh%NHEAD,u.qb,0,T.Q,T.K,T.V,T.O,T.KA,lds); S.done(u); }
}
#undef SBAR
#undef WAIT_BAR
}

namespace ck {
#define CK_LAS __attribute__((address_space(3)))
typedef unsigned short bf16_t;
typedef short bf16x8 __attribute__((ext_vector_type(8)));
typedef float f32x16 __attribute__((ext_vector_type(16)));
typedef float f32x4 __attribute__((ext_vector_type(4)));
typedef unsigned u32x4 __attribute__((ext_vector_type(4)));
typedef unsigned u32x2 __attribute__((ext_vector_type(2)));
typedef CK_LAS unsigned short* lbf;
typedef CK_LAS float* lf32;
constexpr int SB = 72;
constexpr int B9 = 64 * SB * 2;
constexpr int SF = 65;
constexpr int SM = 68;
constexpr int SX = 132;
__device__ __forceinline__ unsigned f2bf(float f) { unsigned u = __builtin_bit_cast(unsigned, f); return (u + 0x7fffu + ((u >> 16) & 1u)) >> 16; }
__device__ __forceinline__ unsigned pk2(float lo, float hi) { return f2bf(lo) | (f2bf(hi) << 16); }
__device__ __forceinline__ float bflo(unsigned w) { return __builtin_bit_cast(float, w << 16); }
__device__ __forceinline__ float bfhi(unsigned w) { return __builtin_bit_cast(float, w & 0xffff0000u); }
__device__ __forceinline__ int crow(int reg, int hh) { return (reg & 3) + 8 * (reg >> 2) + 4 * hh; }
__device__ __forceinline__ f32x16 mm_lds(lbf A, lbf BT, int I, int J, int lane, f32x16 acc) {
    const int r = lane & 31, hh = lane >> 5;
    const lbf ap = A + (32 * I + r) * SB + 8 * hh; const lbf bp = BT + (32 * J + r) * SB + 8 * hh;
#pragma unroll
    for (int s = 0; s < 4; ++s) { const bf16x8 a = *(const CK_LAS bf16x8*)(ap + 16 * s); const bf16x8 b = *(const CK_LAS bf16x8*)(bp + 16 * s); acc = __builtin_amdgcn_mfma_f32_32x32x16_bf16(a, b, acc, 0, 0, 0); }
    return acc;
}
__device__ __forceinline__ f32x16 mm_gA(const bf16_t* __restrict__ Ag, lbf BT, int I, int J, int lane, f32x16 acc) {
    const int r = lane & 31, hh = lane >> 5;
    bf16x8 a[4];
#pragma unroll
    for (int s = 0; s < 4; ++s) a[s] = *(const bf16x8*)(Ag + (32 * I + r) * 64 + 16 * s + 8 * hh);
    const lbf bp = BT + (32 * J + r) * SB + 8 * hh;
#pragma unroll
    for (int s = 0; s < 4; ++s) { const bf16x8 b = *(const CK_LAS bf16x8*)(bp + 16 * s); acc = __builtin_amdgcn_mfma_f32_32x32x16_bf16(a[s], b, acc, 0, 0, 0); }
    return acc;
}
__device__ __forceinline__ f32x16 mm_gg(const bf16_t* __restrict__ Ag, const bf16_t* __restrict__ BTg, int I, int J, int lane, f32x16 acc) {
    const int r = lane & 31, hh = lane >> 5;
#pragma unroll
    for (int s = 0; s < 4; ++s) { const bf16x8 a = *(const bf16x8*)(Ag + (32 * I + r) * 64 + 16 * s + 8 * hh); const bf16x8 b = *(const bf16x8*)(BTg + (32 * J + r) * 64 + 16 * s + 8 * hh);
        acc = __builtin_amdgcn_mfma_f32_32x32x16_bf16(a, b, acc, 0, 0, 0); }
    return acc;
}
__device__ __forceinline__ void frag_store(float* __restrict__ g, int wq, int lane, const f32x16& acc) {
    f32x4* p = (f32x4*)(g + ((size_t)(wq * 64 + lane)) * 16);
    p[0] = (f32x4){acc[0], acc[1], acc[2], acc[3]}; p[1] = (f32x4){acc[4], acc[5], acc[6], acc[7]}; p[2] = (f32x4){acc[8], acc[9], acc[10], acc[11]}; p[3] = (f32x4){acc[12], acc[13], acc[14], acc[15]};
}
__device__ __forceinline__ f32x16 frag_load(const float* __restrict__ g, int wq, int lane) {
    const f32x4* p = (const f32x4*)(g + ((size_t)(wq * 64 + lane)) * 16); const f32x4 a = p[0], b = p[1], c = p[2], d = p[3];
    return (f32x16){a[0], a[1], a[2], a[3], b[0], b[1], b[2], b[3], c[0], c[1], c[2], c[3], d[0], d[1], d[2], d[3]};
}
__device__ __forceinline__ void frag_store_bf(bf16_t* __restrict__ g, int wq, int lane, const f32x16& acc) {
    u32x4* p = (u32x4*)(g + ((size_t)(wq * 64 + lane)) * 16);
    p[0] = (u32x4){pk2(acc[0], acc[1]), pk2(acc[2], acc[3]), pk2(acc[4], acc[5]), pk2(acc[6], acc[7])}; p[1] = (u32x4){pk2(acc[8], acc[9]), pk2(acc[10], acc[11]), pk2(acc[12], acc[13]), pk2(acc[14], acc[15])};
}
__device__ __forceinline__ f32x16 frag_load_bf(const bf16_t* __restrict__ g, int wq, int lane) {
    const u32x4* p = (const u32x4*)(g + ((size_t)(wq * 64 + lane)) * 16); const u32x4 a = p[0], b = p[1];
    return (f32x16){bflo(a[0]), bfhi(a[0]), bflo(a[1]), bfhi(a[1]), bflo(a[2]), bfhi(a[2]), bflo(a[3]), bfhi(a[3]), bflo(b[0]), bfhi(b[0]), bflo(b[1]), bfhi(b[1]), bflo(b[2]), bfhi(b[2]), bflo(b[3]), bfhi(b[3])};
}
__device__ __forceinline__ void tile_store_T(lbf dst, int I, int J, int lane, const f32x16& acc) {
    const int r = lane & 31, hh = lane >> 5;
#pragma unroll
    for (int g = 0; g < 4; ++g) { u32x2 w; w.x = pk2(acc[4 * g], acc[4 * g + 1]); w.y = pk2(acc[4 * g + 2], acc[4 * g + 3]);
        *(CK_LAS u32x2*)(dst + (32 * J + r) * SB + 32 * I + 8 * g + 4 * hh) = w; }
}
__device__ __forceinline__ float fexp(float x) { return __builtin_amdgcn_exp2f(x * 1.4426950408889634f); }
__device__ __forceinline__ float sigm(float x) { return __builtin_amdgcn_rcpf(1.0f + fexp(-x)); }
__device__ __forceinline__ float ftanh(float x) { const float xc = fminf(fmaxf(x, -15.f), 15.f); return 1.0f - 2.0f * __builtin_amdgcn_rcpf(fexp(2.0f * xc) + 1.0f); }
__device__ __forceinline__ float logsig(float x) { const float ax = fabsf(x); return fminf(x, 0.f) - 0.6931471805599453f * __builtin_amdgcn_logf(1.0f + fexp(-ax)); }
template <int CTRL> __device__ __forceinline__ float dpp_f(float v) { return __builtin_bit_cast(float, __builtin_amdgcn_update_dpp(0, __builtin_bit_cast(int, v), CTRL, 0xf, 0xf, false)); }
__device__ __forceinline__ float quad_sum(float v) { v += dpp_f<0xB1>(v); v += dpp_f<0x4E>(v); return v; }

constexpr size_t O_PC = 0, O_QC = 16u << 20, O_GY = 48u << 20, O_YL = 64u << 20, O_VG = 96u << 20, O_GG = 112u << 20, O_H0 = 128u << 20, O_RKD = 144u << 20, O_KV = 145u << 20, O_RT = 177u << 20, O_END = 193u << 20;
struct RwkvParams {
    const float *mu_rkv, *mu_lora, *w0, *a0, *k_k, *k_a, *r_k, *ln_g, *ln_b, *gn_g;
    const bf16_t *w2t, *a2t, *g2t;
};

constexpr int L_U = 10 * B9, L_MM = L_U + 36864, L_GL = L_MM + 64 * SM * 4, L_END1 = L_GL + 256;
__device__ __forceinline__ void rwkv_stage1(CK_LAS unsigned char* lds, int item, const bf16_t* __restrict__ Pb, int PW, int C_RR, int C_RK, int C_RV, int C_WD, int SEQ, const RwkvParams& p, unsigned char* __restrict__ cw) {
    const int tid = ltid(), lane = tid & 63, wid = __builtin_amdgcn_readfirstlane(tid >> 6), quad = wid >> 2, wq = wid & 3, I = wq >> 1, J = wq & 1, r = lane & 31, hh = lane >> 5;
    const int b = item >> 10, h = (item >> 8) & 3, c = item & 255;
    const size_t m0 = (size_t)b * SEQ + (size_t)c * 64;
    const lbf Am = (lbf)(lds), Bm = (lbf)(lds + B9), Km = (lbf)(lds + 2 * B9), Rm = (lbf)(lds + 3 * B9), VT = (lbf)(lds + 4 * B9), BhT = (lbf)(lds + 5 * B9), KhT = (lbf)(lds + 6 * B9),
              Nm = (lbf)(lds + 7 * B9), Wb = (lbf)(lds + 8 * B9), Wk = (lbf)(lds + 9 * B9);
    const lbf TW = (lbf)(lds + L_U), AD = (lbf)(lds + L_U + B9), SG0 = (lbf)(lds + L_U + 2 * B9), SG1 = (lbf)(lds + L_U + 3 * B9);
    const lbf W2T = BhT, A2T = KhT, G2Ta = Nm, G2Tb = Wb;
    const lf32 X = (lf32)(lds + L_U), MM = (lf32)(lds + L_MM), GL = (lf32)(lds + L_GL);
    const lf32 AA = (lf32)(lds), GGl = (lf32)(lds + 2 * B9);
    const lbf ZlT = Km, X1T = Nm;
    const int t = tid >> 3, c8 = (tid & 7) * 8;
    const size_t m = m0 + t; const bool hp = (c * 64 + t) > 0;
    const bf16_t* pr = Pb + m * PW; const bf16_t* pp = pr - PW;
    float rr[8], kx[8], vv[8];
    {
        const u32x4 z4 = (u32x4){0u, 0u, 0u, 0u};
        const u32x4 cr = *(const u32x4*)(pr + C_RR + h * 64 + c8), ckk = *(const u32x4*)(pr + C_RK + h * 64 + c8), cv = *(const u32x4*)(pr + C_RV + h * 64 + c8);
        const u32x4 qr = hp ? *(const u32x4*)(pp + C_RR + h * 64 + c8) : z4, qk = hp ? *(const u32x4*)(pp + C_RK + h * 64 + c8) : z4, qv = hp ? *(const u32x4*)(pp + C_RV + h * 64 + c8) : z4;
#pragma unroll
        for (int e = 0; e < 8; ++e) { const int ch = h * 64 + c8 + e;
            const float a_ = (e & 1) ? bfhi(cr[e >> 1]) : bflo(cr[e >> 1]), b_ = (e & 1) ? bfhi(qr[e >> 1]) : bflo(qr[e >> 1]); rr[e] = a_ + (b_ - a_) * p.mu_rkv[ch];
            const float c_ = (e & 1) ? bfhi(ckk[e >> 1]) : bflo(ckk[e >> 1]), d_ = (e & 1) ? bfhi(qk[e >> 1]) : bflo(qk[e >> 1]); kx[e] = c_ + (d_ - c_) * p.mu_rkv[256 + ch];
            const float e_ = (e & 1) ? bfhi(cv[e >> 1]) : bflo(cv[e >> 1]), f_ = (e & 1) ? bfhi(qv[e >> 1]) : bflo(qv[e >> 1]); vv[e] = e_ + (f_ - e_) * p.mu_rkv[512 + ch]; }
#pragma unroll
        for (int q = 0; q < 4; ++q) { const u32x4 cl = *(const u32x4*)(pr + C_WD + q * 64 + c8); const u32x4 ql = hp ? *(const u32x4*)(pp + C_WD + q * 64 + c8) : z4;
            float lo[8];
#pragma unroll
            for (int e = 0; e < 8; ++e) { const float a_ = (e & 1) ? bfhi(cl[e >> 1]) : bflo(cl[e >> 1]), b_ = (e & 1) ? bfhi(ql[e >> 1]) : bflo(ql[e >> 1]); const float x = a_ + (b_ - a_) * p.mu_lora[q * 64 + c8 + e];
                lo[e] = (q == 0) ? ftanh(x) : (q == 1 ? x : sigm(x)); }
            u32x4 w; w.x = pk2(lo[0], lo[1]); w.y = pk2(lo[2], lo[3]); w.z = pk2(lo[4], lo[5]); w.w = pk2(lo[6], lo[7]);
            *(CK_LAS u32x4*)((q == 0 ? TW : q == 1 ? AD : q == 2 ? SG0 : SG1) + t * SB + c8) = w; }
        *(CK_LAS u32x4*)(W2T + t * SB + c8) = *(const u32x4*)(p.w2t + ((size_t)h * 64 + t) * 64 + c8);
        *(CK_LAS u32x4*)(A2T + t * SB + c8) = *(const u32x4*)(p.a2t + ((size_t)h * 64 + t) * 64 + c8);
        *(CK_LAS u32x4*)(G2Ta + t * SB + c8) = *(const u32x4*)(p.g2t + ((size_t)h * 64 + t) * 128 + c8);
        *(CK_LAS u32x4*)(G2Tb + t * SB + c8) = *(const u32x4*)(p.g2t + ((size_t)h * 64 + t) * 128 + 64 + c8);
    }
    __syncthreads();
    if (quad == 0) {
        f32x16 z = mm_lds(TW, W2T, I, J, lane, f32x16{}); f32x16 za = mm_lds(AD, A2T, I, J, lane, f32x16{});
        const int ch = 32 * J + r; const float w0c = p.w0[h * 64 + ch], a0c = p.a0[h * 64 + ch];
#pragma unroll
        for (int g = 0; g < 16; ++g) { const int tt = 32 * I + crow(g, hh); const float lw = logsig(w0c + z[g]) - 0.5f; MM[tt * SF + ch] = -fexp(lw); AA[tt * SF + ch] = sigm(a0c + za[g]); }
    } else {
        f32x16 zg = mm_lds(SG0, G2Ta, I, J, lane, f32x16{}); zg = mm_lds(SG1, G2Tb, I, J, lane, zg);
        const int ch = 32 * J + r;
#pragma unroll
        for (int g = 0; g < 16; ++g) { const int tt = 32 * I + crow(g, hh); GGl[tt * SF + ch] = zg[g]; }
    }
    __syncthreads();
    {
        const int ch = tid & 63, seg = tid >> 6; float v8[8]; float run = 0.f;
#pragma unroll
        for (int i = 0; i < 8; ++i) { run += MM[(seg * 8 + i) * SF + ch]; v8[i] = run; }
        const lf32 TOT = (lf32)(lds + L_U);
        TOT[seg * 64 + ch] = run;
        __syncthreads();
        float off = 0.f;
#pragma unroll
        for (int s2 = 0; s2 < 8; ++s2) off += (s2 < seg) ? TOT[s2 * 64 + ch] : 0.f;
#pragma unroll
        for (int i = 0; i < 8; ++i) MM[(seg * 8 + i) * SF + ch] = v8[i] + off;
    }
    __syncthreads();
    float aa[8], gg[8], lw[8], lwp[8], lwl[8];
#pragma unroll
    for (int e = 0; e < 8; ++e) { aa[e] = AA[t * SF + c8 + e]; gg[e] = GGl[t * SF + c8 + e]; lw[e] = MM[t * SF + c8 + e]; lwp[e] = t > 0 ? MM[(t - 1) * SF + c8 + e] : 0.f; lwl[e] = MM[63 * SF + c8 + e]; }
    __syncthreads();
    {
        float kk[8], k2[8]; float ss = 0.f, rk = 0.f;
#pragma unroll
        for (int e = 0; e < 8; ++e) { const int ch = h * 64 + c8 + e; kk[e] = kx[e] * p.k_k[ch]; ss += kk[e] * kk[e]; k2[e] = kx[e] * (1.0f + (aa[e] - 1.0f) * p.k_a[ch]); rk += rr[e] * k2[e] * p.r_k[ch]; }
        ss += __shfl_xor(ss, 1); ss += __shfl_xor(ss, 2); ss += __shfl_xor(ss, 4); rk += __shfl_xor(rk, 1); rk += __shfl_xor(rk, 2); rk += __shfl_xor(rk, 4);
        const float inv = 1.0f / fmaxf(sqrtf(ss), 1e-12f);
        float am[8], bm[8], km[8], rm[8];
#pragma unroll
        for (int e = 0; e < 8; ++e) { kk[e] *= inv; const float g_ = fexp(lw[e]), gi = fexp(-lw[e]), gp = fexp(lwp[e]), gl = fexp(lwl[e] - lw[e]); const float ka = kk[e] * aa[e];
            am[e] = -kk[e] * gp; bm[e] = ka * gi; km[e] = k2[e] * gi; rm[e] = rr[e] * g_;
            VT[(c8 + e) * SB + t] = (bf16_t)f2bf(vv[e]); BhT[(c8 + e) * SB + t] = (bf16_t)f2bf(ka * gl); KhT[(c8 + e) * SB + t] = (bf16_t)f2bf(k2[e] * gl);
            X[t * SX + c8 + e] = am[e]; }
        u32x4 w;
        w.x = pk2(am[0], am[1]); w.y = pk2(am[2], am[3]); w.z = pk2(am[4], am[5]); w.w = pk2(am[6], am[7]); *(CK_LAS u32x4*)(Am + t * SB + c8) = w;
        w.x = pk2(bm[0], bm[1]); w.y = pk2(bm[2], bm[3]); w.z = pk2(bm[4], bm[5]); w.w = pk2(bm[6], bm[7]); *(CK_LAS u32x4*)(Bm + t * SB + c8) = w;
        w.x = pk2(km[0], km[1]); w.y = pk2(km[2], km[3]); w.z = pk2(km[4], km[5]); w.w = pk2(km[6], km[7]); *(CK_LAS u32x4*)(Km + t * SB + c8) = w;
        w.x = pk2(rm[0], rm[1]); w.y = pk2(rm[2], rm[3]); w.z = pk2(rm[4], rm[5]); w.w = pk2(rm[6], rm[7]); *(CK_LAS u32x4*)(Rm + t * SB + c8) = w;
        if (t == 63) {
#pragma unroll
            for (int e = 0; e < 8; ++e) GL[c8 + e] = fexp(lwl[e]); }
        w.x = pk2(vv[0], vv[1]); w.y = pk2(vv[2], vv[3]); w.z = pk2(vv[4], vv[5]); w.w = pk2(vv[6], vv[7]); *(u32x4*)(cw + O_VG + (size_t)item * 8192 + (t * 64 + c8) * 2) = w;
        w.x = pk2(gg[0], gg[1]); w.y = pk2(gg[2], gg[3]); w.z = pk2(gg[4], gg[5]); w.w = pk2(gg[6], gg[7]); *(u32x4*)(cw + O_GG + (size_t)item * 8192 + (t * 64 + c8) * 2) = w;
        if ((tid & 7) == 0) *(float*)(cw + O_RKD + (size_t)item * 256 + t * 4) = rk;
    }
    __syncthreads();
    {
        const f32x16 p1 = mm_lds(Am, quad == 0 ? Bm : Km, I, J, lane, f32x16{}); const f32x16 p2 = mm_lds(Rm, quad == 0 ? Bm : Km, I, J, lane, f32x16{});
        const int ii = 32 * J + r;
#pragma unroll
        for (int g = 0; g < 16; ++g) { const int tt = 32 * I + crow(g, hh);
            if (quad == 0) { MM[tt * SM + (ii & 3) * 16 + (ii >> 2)] = (ii < tt) ? p1[g] : 0.f; Wb[tt * SB + ii] = (bf16_t)f2bf((ii <= tt) ? p2[g] : 0.f); }
            else { Nm[tt * SB + ii] = (bf16_t)f2bf((ii < tt) ? p1[g] : 0.f); Wk[tt * SB + ii] = (bf16_t)f2bf((ii <= tt) ? p2[g] : 0.f); } }
    }
    __syncthreads();
    if (quad == 0) { const f32x16 nv = mm_lds(Nm, VT, I, J, lane, f32x16{}); const int vcol = 64 + 32 * J + r;
#pragma unroll
        for (int g = 0; g < 16; ++g) X[(32 * I + crow(g, hh)) * SX + vcol] = nv[g]; }
    __syncthreads();
    {
        const int col = tid >> 2, q = tid & 3;
        float xs[16];
#pragma unroll
        for (int k = 0; k < 16; ++k) xs[k] = X[(q + 4 * k) * SX + col];
#pragma unroll
        for (int tt = 1; tt < 64; ++tt) {
            const CK_LAS f32x4* mr = (const CK_LAS f32x4*)(MM + tt * SM + q * 16);
            float s0 = 0.f, s1 = 0.f, s2 = 0.f, s3 = 0.f;
#pragma unroll
            for (int k4 = 0; k4 < (tt + 15) / 16; ++k4) { const f32x4 mv = mr[k4]; s0 += mv[0] * xs[4 * k4]; s1 += mv[1] * xs[4 * k4 + 1]; s2 += mv[2] * xs[4 * k4 + 2]; s3 += mv[3] * xs[4 * k4 + 3]; }
            const float sm = quad_sum((s0 + s1) + (s2 + s3));
            xs[tt >> 2] += (q == (tt & 3)) ? sm : 0.f;
        }
        const lbf dstT = (col < 64) ? (X1T + col * SB) : (ZlT + (col - 64) * SB);
#pragma unroll
        for (int k = 0; k < 16; ++k) dstT[q + 4 * k] = (bf16_t)f2bf(xs[k]);
    }
    __syncthreads();
    if (quad == 0) {
        const f32x16 gy = mm_lds(Wb, X1T, I, J, lane, f32x16{}); const f32x16 pc = mm_lds(BhT, X1T, I, J, lane, f32x16{});
        bf16_t* gyg = (bf16_t*)(cw + O_GY + (size_t)item * 8192); bf16_t* pcg = (bf16_t*)(cw + O_PC + (size_t)item * 8192);
        const int cc = 32 * J + r;
#pragma unroll
        for (int g = 0; g < 16; ++g) { const int rw = 32 * I + crow(g, hh);
            gyg[rw * 64 + cc] = (bf16_t)f2bf(gy[g] + __builtin_bit_cast(float, (unsigned)Rm[rw * SB + cc] << 16));
            pcg[rw * 64 + cc] = (bf16_t)f2bf(pc[g] + (rw == cc ? GL[cc] : 0.f)); }
    } else {
        f32x16 yl = mm_lds(ZlT, Wb, I, J, lane, f32x16{}); yl = mm_lds(VT, Wk, I, J, lane, yl);
        f32x16 qc = mm_lds(BhT, ZlT, I, J, lane, f32x16{}); qc = mm_lds(KhT, VT, I, J, lane, qc);
        frag_store((float*)(cw + O_YL + (size_t)item * 16384), wq, lane, yl); frag_store_bf((bf16_t*)(cw + O_QC) + (size_t)item * 4096, wq, lane, qc);
    }
    __syncthreads();
}

__device__ __forceinline__ void rwkv_scan(CK_LAS unsigned char* lds, int chain, unsigned char* __restrict__ cw) {
    const int tid = ltid(), lane = tid & 63, wid = __builtin_amdgcn_readfirstlane(tid >> 6), quad = wid >> 2, wq = wid & 3, I = wq >> 1, J = wq & 1, r = lane & 31, hh = lane >> 5, qtid = tid & 255;
    const lbf HT = (lbf)(lds + quad * B9);
    for (int i = qtid; i < 64 * SB / 2; i += 256) ((CK_LAS unsigned*)HT)[i] = 0u;
    __syncthreads();
    const bool on = chain >= 0; const size_t it0 = (size_t)(on ? chain : 0) * 256;
    const bf16_t* pcg = (const bf16_t*)(cw + O_PC) + it0 * 4096; const bf16_t* qcg = (const bf16_t*)(cw + O_QC) + it0 * 4096; bf16_t* h0g = (bf16_t*)(cw + O_H0) + it0 * 4096;
    constexpr int PD = 5;
    bf16x8 ar[PD][4]; f32x16 qr[PD];
#define CK_LOADSTEP(A_, Q_, cc) do { const int c_ = (cc) < 256 ? (cc) : 255; _Pragma("unroll") for (int s_ = 0; s_ < 4; ++s_) A_[s_] = *(const bf16x8*)(pcg + (size_t)c_ * 4096 + (32 * I + r) * 64 + 16 * s_ + 8 * hh); Q_ = frag_load_bf(qcg + (size_t)c_ * 4096, wq, lane); } while (0)
#pragma unroll
    for (int k = 0; k < PD; ++k) CK_LOADSTEP(ar[k], qr[k], k);
    for (int c = 0; c < 256 + PD - 1; c += PD) {
#pragma unroll
        for (int k = 0; k < PD; ++k) {
            const int cc = c + k;
            if (cc < 256) {
            if (on) { const int row = qtid >> 2, seg = (qtid & 3) * 16; const u32x4 w0 = *(const CK_LAS u32x4*)(HT + row * SB + seg), w1 = *(const CK_LAS u32x4*)(HT + row * SB + seg + 8);
                      u32x4* dst = (u32x4*)(h0g + (size_t)cc * 4096 + row * 64 + seg); dst[0] = w0; dst[1] = w1; }
            f32x16 acc = qr[k];
            const lbf bp = HT + (32 * J + r) * SB + 8 * hh;
#pragma unroll
            for (int s_ = 0; s_ < 4; ++s_) { const bf16x8 bfr = *(const CK_LAS bf16x8*)(bp + 16 * s_); acc = __builtin_amdgcn_mfma_f32_32x32x16_bf16(ar[k][s_], bfr, acc, 0, 0, 0); }
            CK_LOADSTEP(ar[k], qr[k], cc + PD);
            asm volatile("s_waitcnt lgkmcnt(0)\n\ts_barrier" ::: "memory");
            tile_store_T(HT, I, J, lane, acc);
            asm volatile("s_waitcnt lgkmcnt(0)\n\ts_barrier" ::: "memory");
            }
        }
    }
#undef CK_LOADSTEP
}

__device__ __forceinline__ void rwkv_stage3(CK_LAS unsigned char* ldsq, int item, const RwkvParams& p, const unsigned char* __restrict__ cw, bf16_t* __restrict__ MIXB, int SEQ) {
    const int tid = ltid(), lane = tid & 63, wid = __builtin_amdgcn_readfirstlane(tid >> 6), wq = wid & 3, I = wq >> 1, J = wq & 1, r = lane & 31, hh = lane >> 5, qtid = tid & 255;
    const lf32 Y = (lf32)ldsq;
    if (item >= 0) {
        f32x16 acc = frag_load((const float*)(cw + O_YL) + (size_t)item * 4096, wq, lane);
        acc = mm_gg((const bf16_t*)(cw + O_H0) + (size_t)item * 4096, (const bf16_t*)(cw + O_GY) + (size_t)item * 4096, I, J, lane, acc);
#pragma unroll
        for (int g = 0; g < 16; ++g) Y[(32 * J + r) * SF + 32 * I + crow(g, hh)] = acc[g];
    }
    __syncthreads();
    if (item >= 0) {
        const int b = item >> 10, h = (item >> 8) & 3, c = item & 255; const int t = qtid >> 2, c16 = (qtid & 3) * 16;
        float y[16]; float s = 0.f;
#pragma unroll
        for (int e = 0; e < 16; ++e) { y[e] = Y[t * SF + c16 + e]; s += y[e]; }
        const float mu = quad_sum(s) * (1.f / 64.f); float s2 = 0.f;
#pragma unroll
        for (int e = 0; e < 16; ++e) { y[e] -= mu; s2 += y[e] * y[e]; }
        const float rstd = 1.0f / sqrtf(quad_sum(s2) * (1.f / 64.f) + 64e-5f);
        const u32x4* vg = (const u32x4*)(cw + O_VG + (size_t)item * 8192 + (t * 64 + c16) * 2); const u32x4* gg = (const u32x4*)(cw + O_GG + (size_t)item * 8192 + (t * 64 + c16) * 2);
        const float rk = *(const float*)(cw + O_RKD + (size_t)item * 256 + t * 4);
        unsigned ow[8];
#pragma unroll
        for (int hv = 0; hv < 2; ++hv) { const u32x4 vw = vg[hv], gw = gg[hv];
#pragma unroll
            for (int e2 = 0; e2 < 4; ++e2) { const int e = hv * 8 + 2 * e2; const int ch = h * 64 + c16 + e;
                const float o0 = (y[e] * rstd * p.ln_g[ch] + p.ln_b[ch] + rk * bflo(vw[e2])) * bflo(gw[e2]);
                const float o1 = (y[e + 1] * rstd * p.ln_g[ch + 1] + p.ln_b[ch + 1] + rk * bfhi(vw[e2])) * bfhi(gw[e2]);
                ow[hv * 4 + e2] = pk2(o0, o1); } }
        u32x4* dst = (u32x4*)(MIXB + ((size_t)b * SEQ + (size_t)c * 64 + t) * 1024 + 512 + h * 64 + c16);
        dst[0] = (u32x4){ow[0], ow[1], ow[2], ow[3]}; dst[1] = (u32x4){ow[4], ow[5], ow[6], ow[7]};
    }
    __syncthreads();
}

__device__ __forceinline__ void rot16(float (&o)[16], const bf16_t* __restrict__ prow, int colbase, int c16, const float* __restrict__ ropet  ) {
    const u32x4* own = (const u32x4*)(prow + colbase + c16); const u32x4* par = (const u32x4*)(prow + colbase + (c16 ^ 32));
    const f32x4* cs = (const f32x4*)(ropet + 2 * (c16 & 31));
#pragma unroll
    for (int hv = 0; hv < 2; ++hv) { const u32x4 ow = own[hv], pw = par[hv];
#pragma unroll
        for (int e2 = 0; e2 < 4; ++e2) { const f32x4 csv = cs[hv * 4 + e2];
            const float x0 = bflo(ow[e2]), x1 = bfhi(ow[e2]), p0 = bflo(pw[e2]), p1 = bfhi(pw[e2]);
            o[hv * 8 + 2 * e2] = (c16 < 32) ? (x0 * csv[0] - p0 * csv[1]) : (p0 * csv[1] + x0 * csv[0]);
            o[hv * 8 + 2 * e2 + 1] = (c16 < 32) ? (x1 * csv[2] - p1 * csv[3]) : (p1 * csv[3] + x1 * csv[2]); } }
}
__device__ __forceinline__ void ret_stage1(CK_LAS unsigned char* ldsq, int item, const bf16_t* __restrict__ Pb, int PW, int C_TK, int C_TV, int SEQ, const float* __restrict__ ROPE, unsigned char* __restrict__ cw) {
    const int tid = ltid(), lane = tid & 63, wid = __builtin_amdgcn_readfirstlane(tid >> 6), wq = wid & 3, I = wq >> 1, J = wq & 1, qtid = tid & 255;
    const lbf VT = (lbf)ldsq, KdT = (lbf)(ldsq + B9);
    if (item >= 0) {
        const int b = item >> 10, h = (item >> 8) & 3, c = item & 255; const int t = qtid >> 2, c16 = (qtid & 3) * 16; const int pos = c * 64 + t;
        const bf16_t* prow = Pb + ((size_t)b * SEQ + pos) * PW;
        float kr[16]; rot16(kr, prow, C_TK + h * 64, c16, ROPE + (size_t)pos * 64);
        const float lg = __builtin_amdgcn_logf(1.0f - __builtin_amdgcn_exp2f(-5.0f - (float)h));
        const float dec = 0.125f * __builtin_amdgcn_exp2f(lg * (float)(63 - t));
        const u32x4* vp = (const u32x4*)(prow + C_TV + h * 64 + c16);
#pragma unroll
        for (int hv = 0; hv < 2; ++hv) { const u32x4 vw = vp[hv];
#pragma unroll
            for (int e2 = 0; e2 < 4; ++e2) { const int e = hv * 8 + 2 * e2;
                VT[(c16 + e) * SB + t] = (bf16_t)(vw[e2] & 0xffffu); VT[(c16 + e + 1) * SB + t] = (bf16_t)(vw[e2] >> 16);
                KdT[(c16 + e) * SB + t] = (bf16_t)f2bf(kr[e] * dec); KdT[(c16 + e + 1) * SB + t] = (bf16_t)f2bf(kr[e + 1] * dec); } }
    }
    __syncthreads();
    if (item >= 0) { const f32x16 kv = mm_lds(VT, KdT, I, J, lane, f32x16{}); frag_store_bf((bf16_t*)(cw + O_KV) + (size_t)item * 4096, wq, lane, kv); }
    __syncthreads();
}
__device__ __forceinline__ void ret_scan(int chain, unsigned char* __restrict__ cw) {
    const int tid = ltid(), lane = tid & 63, wid = __builtin_amdgcn_readfirstlane(tid >> 6), wq = wid & 3, I = wq >> 1, J = wq & 1, r = lane & 31, hh = lane >> 5;
    const int h = chain & 3; const float lg = __builtin_amdgcn_logf(1.0f - __builtin_amdgcn_exp2f(-5.0f - (float)h)); const float g64 = __builtin_amdgcn_exp2f(lg * 64.0f);
    const bf16_t* kvg = (const bf16_t*)(cw + O_KV) + (size_t)chain * 256 * 4096; bf16_t* rtg = (bf16_t*)(cw + O_RT) + (size_t)chain * 256 * 4096;
    f32x16 R = f32x16{}; constexpr int PD = 8; f32x16 nx[PD];
#pragma unroll
    for (int k = 0; k < PD; ++k) nx[k] = frag_load_bf(kvg + (size_t)k * 4096, wq, lane);
    for (int c = 0; c < 256; c += PD) {
#pragma unroll
        for (int k = 0; k < PD; ++k) { const int cc = c + k; bf16_t* dst = rtg + (size_t)cc * 4096;
#pragma unroll
            for (int g = 0; g < 16; ++g) dst[(32 * I + crow(g, hh)) * 64 + 32 * J + r] = (bf16_t)f2bf(R[g]);
            const f32x16 kvc = nx[k]; const int nn = cc + PD < 256 ? cc + PD : 255;
            nx[k] = frag_load_bf(kvg + (size_t)nn * 4096, wq, lane);
#pragma unroll
            for (int g = 0; g < 16; ++g) R[g] = R[g] * g64 + kvc[g]; }
    }
}
constexpr int L_RET3 = 4 * B9 + 64 * SF * 4;
__device__ __forceinline__ void ret_stage3(CK_LAS unsigned char* ldsq, int item, const bf16_t* __restrict__ Pb, int PW, int C_TQ, int C_TK, int C_TV, int C_TG, int SEQ, const float* __restrict__ ROPE,
                                           const float* __restrict__ gn_g, const unsigned char* __restrict__ cw, bf16_t* __restrict__ MIXB) {
    const int tid = ltid(), lane = tid & 63, wid = __builtin_amdgcn_readfirstlane(tid >> 6), wq = wid & 3, I = wq >> 1, J = wq & 1, r = lane & 31, hh = lane >> 5, qtid = tid & 255;
    const lbf Qr = (lbf)ldsq, Kr = (lbf)(ldsq + B9), VT = (lbf)(ldsq + 2 * B9), Sb = (lbf)(ldsq + 3 * B9); const lf32 Y = (lf32)(ldsq + 4 * B9);
    const int b = item >= 0 ? item >> 10 : 0, h = item >= 0 ? (item >> 8) & 3 : 0, c = item >= 0 ? item & 255 : 0; const int t = qtid >> 2, c16 = (qtid & 3) * 16; const int pos = c * 64 + t;
    const float lg = __builtin_amdgcn_logf(1.0f - __builtin_amdgcn_exp2f(-5.0f - (float)h));
    const bf16_t* prow = Pb + ((size_t)b * SEQ + pos) * PW;
    if (item >= 0) {
        float qr[16], kr[16]; rot16(qr, prow, C_TQ + h * 64, c16, ROPE + (size_t)pos * 64); rot16(kr, prow, C_TK + h * 64, c16, ROPE + (size_t)pos * 64);
        u32x4 w;
        w.x = pk2(qr[0], qr[1]); w.y = pk2(qr[2], qr[3]); w.z = pk2(qr[4], qr[5]); w.w = pk2(qr[6], qr[7]); *(CK_LAS u32x4*)(Qr + t * SB + c16) = w;
        w.x = pk2(qr[8], qr[9]); w.y = pk2(qr[10], qr[11]); w.z = pk2(qr[12], qr[13]); w.w = pk2(qr[14], qr[15]); *(CK_LAS u32x4*)(Qr + t * SB + c16 + 8) = w;
#pragma unroll
        for (int e = 0; e < 16; ++e) kr[e] *= 0.125f;
        w.x = pk2(kr[0], kr[1]); w.y = pk2(kr[2], kr[3]); w.z = pk2(kr[4], kr[5]); w.w = pk2(kr[6], kr[7]); *(CK_LAS u32x4*)(Kr + t * SB + c16) = w;
        w.x = pk2(kr[8], kr[9]); w.y = pk2(kr[10], kr[11]); w.z = pk2(kr[12], kr[13]); w.w = pk2(kr[14], kr[15]); *(CK_LAS u32x4*)(Kr + t * SB + c16 + 8) = w;
        const u32x4* vp = (const u32x4*)(prow + C_TV + h * 64 + c16);
#pragma unroll
        for (int hv = 0; hv < 2; ++hv) { const u32x4 vw = vp[hv];
#pragma unroll
            for (int e2 = 0; e2 < 4; ++e2) { const int e = hv * 8 + 2 * e2; VT[(c16 + e) * SB + t] = (bf16_t)(vw[e2] & 0xffffu); VT[(c16 + e + 1) * SB + t] = (bf16_t)(vw[e2] >> 16); } }
    }
    __syncthreads();
    if (item >= 0) {
        f32x16 st = mm_lds(Kr, Qr, I, J, lane, f32x16{}); const int tt = 32 * J + r;
#pragma unroll
        for (int g = 0; g < 16; ++g) { const int ii = 32 * I + crow(g, hh); st[g] = (ii <= tt) ? st[g] * __builtin_amdgcn_exp2f(lg * (float)(tt - ii)) : 0.f; }
        tile_store_T(Sb, I, J, lane, st);
    }
    __syncthreads();
    if (item >= 0) {
        const f32x16 yi = mm_lds(VT, Sb, I, J, lane, f32x16{}); const f32x16 yc = mm_gA((const bf16_t*)(cw + O_RT) + (size_t)item * 4096, Qr, I, J, lane, f32x16{});
        const int tt = 32 * J + r; const float qd = __builtin_amdgcn_exp2f(lg * (float)(tt + 1));
#pragma unroll
        for (int g = 0; g < 16; ++g) Y[tt * SF + 32 * I + crow(g, hh)] = yi[g] + qd * yc[g];
    }
    __syncthreads();
    if (item >= 0) {
        float y[16]; float s = 0.f;
#pragma unroll
        for (int e = 0; e < 16; ++e) { y[e] = Y[t * SF + c16 + e]; s += y[e]; }
        const float mu = quad_sum(s) * (1.f / 64.f); float s2 = 0.f;
#pragma unroll
        for (int e = 0; e < 16; ++e) { y[e] -= mu; s2 += y[e] * y[e]; }
        const float rstd = 1.0f / sqrtf(quad_sum(s2) * (1.f / 64.f) + 1e-6f);
        const u32x4* gp = (const u32x4*)(prow + C_TG + h * 64 + c16); unsigned ow[8];
#pragma unroll
        for (int hv = 0; hv < 2; ++hv) { const u32x4 gw = gp[hv];
#pragma unroll
            for (int e2 = 0; e2 < 4; ++e2) { const int e = hv * 8 + 2 * e2; const int ch = h * 64 + c16 + e; const float g0 = bflo(gw[e2]), g1 = bfhi(gw[e2]);
                ow[hv * 4 + e2] = pk2(y[e] * rstd * gn_g[ch] * (g0 * sigm(g0)), y[e + 1] * rstd * gn_g[ch + 1] * (g1 * sigm(g1))); } }
        u32x4* dst = (u32x4*)(MIXB + ((size_t)b * SEQ + pos) * 1024 + 768 + h * 64 + c16);
        dst[0] = (u32x4){ow[0], ow[1], ow[2], ow[3]}; dst[1] = (u32x4){ow[4], ow[5], ow[6], ow[7]};
    }
    __syncthreads();
}
}

__device__ __forceinline__ void tr_tile(const float* __restrict__ src, size_t ld_src, bf16* __restrict__ dst, size_t ld_dst, float* scr, int lane) {
    pg8::f32x4 v[16];
#pragma unroll
    for (int i = 0; i < 16; ++i) v[i] = *(const pg8::f32x4*)(src + (size_t)(i * 4 + (lane >> 4)) * ld_src + (lane & 15) * 4);
#pragma unroll
    for (int i = 0; i < 16; ++i) { float* p = scr + (i * 4 + (lane >> 4)) * 65 + (lane & 15) * 4; p[0] = v[i][0]; p[1] = v[i][1]; p[2] = v[i][2]; p[3] = v[i][3]; }
    asm volatile("s_waitcnt lgkmcnt(0)" ::: "memory");
#pragma unroll
    for (int i = 0; i < 8; ++i) { const int n = i * 8 + (lane >> 3), kc = (lane & 7) * 8; const float* s = scr + kc * 65 + n;
        pg8::u32x4 o; o.x = pk2(s[0], s[65]); o.y = pk2(s[2 * 65], s[3 * 65]); o.z = pk2(s[4 * 65], s[5 * 65]); o.w = pk2(s[6 * 65], s[7 * 65]);
        *(pg8::u32x4*)(dst + (size_t)n * ld_dst + kc) = o; }
    asm volatile("s_waitcnt lgkmcnt(0)" ::: "memory");
}

#define LAS __attribute__((address_space(3)))
#define XB_TMO      128
#define XB_XCNT(j)  (256  + 64 * (j))
#define XB_XSUB(j)  (1280 + 64 * (j))
#define XB_XGEN(j)  (2304 + 64 * (j))
#define XB_TOP      3328
#define XB_TOPGEN   3392
#define XCD_BAR_WORDS 3456
#define XB_SPIN_CAP (1u << 18)

__device__ __forceinline__ unsigned xb_ld(unsigned* p)              { return __hip_atomic_load(p, __ATOMIC_RELAXED, __HIP_MEMORY_SCOPE_AGENT); }
__device__ __forceinline__ unsigned xb_add(unsigned* p, unsigned v) { return __hip_atomic_fetch_add(p, v, __ATOMIC_RELAXED, __HIP_MEMORY_SCOPE_AGENT); }
__device__ __forceinline__ unsigned xb_xcc_id() { return (unsigned)__builtin_amdgcn_s_getreg((3 << 11) | 20) & 0xFu; }
#define XB_SPIN(cond, bar) do { unsigned _sp = 0; while (cond) { __builtin_amdgcn_s_sleep(1); \
    if ((++_sp & 255u) == 0u) { if (xb_ld(&(bar)[XB_TMO])) break; if (_sp > XB_SPIN_CAP) { atomicAdd(&(bar)[XB_TMO], 1u); break; } } } } while (0)

struct XcdBarrier {
    unsigned* bar; unsigned x;
    volatile LAS unsigned* st;
};

__device__ __forceinline__ XcdBarrier xcd_barrier_post(unsigned* bar, volatile LAS unsigned* st) {
    XcdBarrier b; b.bar = bar; b.x = xb_xcc_id(); b.st = st;
    if (ltid() == 0) (void)xb_add(&bar[XB_XCNT(b.x)], 1u);
    return b;
}
__device__ __forceinline__ void xcd_barrier_complete(unsigned* bar, unsigned x, unsigned& nloc, unsigned& nx) {
    const unsigned G = gridDim.x * gridDim.y * gridDim.z;
    unsigned sum, cnt, mine, sp = 0u;
    for (;;) {
        sum = 0u; cnt = 0u; mine = 0u;
#pragma unroll
        for (unsigned j = 0; j < 16; ++j) { const unsigned c = xb_ld(&bar[XB_XCNT(j)]); sum += c; cnt += (c > 0u) ? 1u : 0u; mine = (j == x) ? c : mine; }
        if (sum == G) break;
        __builtin_amdgcn_s_sleep(1);
        if ((++sp & 255u) == 0u) { if (xb_ld(&bar[XB_TMO])) break; if (sp > XB_SPIN_CAP) { atomicAdd(&bar[XB_TMO], 1u); break; } }
    }
    nloc = mine > 0u ? mine : 1u; nx = cnt > 0u ? cnt : 1u;
}

__device__ __forceinline__ void xcd_barrier(const XcdBarrier& b) {
    asm volatile("s_waitcnt vmcnt(0)" ::: "memory");
    __syncthreads();
    if (ltid() == 0) {
        unsigned* bar = b.bar; asm volatile("" : "+s"(bar)); unsigned bx_ = b.x; asm volatile("" : "+s"(bx_));
        __builtin_amdgcn_s_waitcnt(0);
        unsigned nloc = b.st[0], nx = b.st[1];
        if (nloc == 0u) { xcd_barrier_complete(bar, bx_, nloc, nx); b.st[0] = nloc; b.st[1] = nx; }
        const unsigned old = xb_add(&bar[XB_XSUB(bx_)], 1u);
        const unsigned gen = old / nloc;
        if (old + 1u == (gen + 1u) * nloc) {
            __builtin_amdgcn_fence(__ATOMIC_RELEASE, "agent");
            asm volatile("s_waitcnt vmcnt(0)" ::: "memory");
            const unsigned og = xb_add(&bar[XB_TOP], 1u);
            const unsigned tg = og / nx;
            if (og + 1u == (tg + 1u) * nx) xb_add(&bar[XB_TOPGEN], 1u);
            else XB_SPIN(xb_ld(&bar[XB_TOPGEN]) == tg, bar);
            __builtin_amdgcn_fence(__ATOMIC_ACQUIRE, "agent");
            xb_add(&bar[XB_XGEN(bx_)], 1u);
            asm volatile("s_waitcnt vmcnt(0)" ::: "memory");
        } else {
            XB_SPIN(xb_ld(&bar[XB_XGEN(bx_)]) == gen, bar);
            __builtin_amdgcn_fence(__ATOMIC_ACQUIRE, "agent");
            asm volatile("s_waitcnt vmcnt(0)" ::: "memory");
        }
    }
    __syncthreads();
}


__global__ void __launch_bounds__(NTHREADS, 2) mk_fwd(Args args) {
    extern __shared__ __attribute__((aligned(16))) unsigned char lds_raw[];
    float* lds = (float*)lds_raw;
    const int tid = ltid(), lane = tid & 63, wid = __builtin_amdgcn_readfirstlane(tid >> 6);
    const int G = gridDim.x, bx = blockIdx.x;
    unsigned char* ws = args.ws;
    unsigned* ctl = (unsigned*)(ws + WS_CTL);
    float* X = args.out;
    bf16* XB = (bf16*)(ws + WS_XB);
    bf16* Pb = (bf16*)(ws + WS_P);
    bf16* WIN = (bf16*)(ws + WS_WIN); bf16* WOUT = (bf16*)(ws + WS_WOUT); bf16* W13 = (bf16*)(ws + WS_W13); bf16* W2 = (bf16*)(ws + WS_W2);
    float* ROPE = (float*)(ws + WS_ROPE);
    double* LCS = (double*)(ws + WS_LCS); double* TOT = (double*)(ws + WS_TOT);
    float* BE = (float*)(ws + WS_SKIP); float* QN2 = BE + 16 * 256; float* KN2 = QN2 + 16 * 128;
    unsigned char* KA = ws + WS_KA;
    unsigned char* cw = ws + WS_CK; bf16* LWT = (bf16*)(ws + WS_LW);
    int* EP = (int*)(ws + WS_EP); int* DEST = (int*)(ws + WS_DEST);
    float* GATE = (float*)(ws + WS_GATE);
    bf16* MIXB = (bf16*)(ws + WS_MIXB);
    bf16* XP = (bf16*)(ws + WS_XP); bf16* Hb = (bf16*)(ws + WS_H); bf16* YP = (bf16*)(ws + WS_YP); float* YO = (float*)(ws + WS_YO);
    typedef pg8::f32x4 f32x4;
    volatile LAS unsigned* MISC = (volatile LAS unsigned*)((LAS unsigned char*)lds_raw + LDS_MISC);
    for (int u = tid; u < (LDS_ALL - LDS_MISC) / 4; u += NTHREADS) MISC[u] = 0u;
    __syncthreads();
    XcdBarrier bar = xcd_barrier_post(ctl + CW_BAR, MISC + 8);
#define GRID_BAR() xcd_barrier(bar)

    for (int rep_ = 0; rep_ < REP_P0; ++rep_) {
            const int tid = ltid(), lane = tid & 63, wid = __builtin_amdgcn_readfirstlane(tid >> 6); (void)lane; (void)wid;
        const f32x4* xi = (const f32x4*)args.in[0]; f32x4* xo = (f32x4*)X; uint2* xb = (uint2*)XB;
        for (size_t i = (size_t)bx * NTHREADS + tid; i < (size_t)T * DM / 4; i += (size_t)G * NTHREADS) { const f32x4 v = xi[i]; xo[i] = v; xb[i] = make_uint2(pk2(v[0], v[1]), pk2(v[2], v[3])); }
        for (int i = bx * NTHREADS + tid; i < SEQ * 32; i += G * NTHREADS) {
            const int pos = i >> 5, f = i & 31;
            const double inv = pow(10000.0, -(double)f / 32.0);
            const double ang = (double)pos * inv;
            ROPE[2 * i] = (float)cos(ang); ROPE[2 * i + 1] = (float)sin(ang);
        }
        { bf16* WR = (bf16*)(ws + WS_WR);
          for (int i = bx * NTHREADS + tid; i < DEPTH * 48 * 1024; i += G * NTHREADS) { const int l_ = i / (48 * 1024), o = (i / 1024) % 48, k = i & 1023;
              const float wv = o < 4 ? args.in[21][((size_t)l_ * DM + k) * 4 + o] : (o < 36 ? args.in[23][((size_t)l_ * DM + k) * 32 + (o - 4)] : 0.f);
              const unsigned hi_ = f2bf(wv); const unsigned lo_ = f2bf(wv - bf2f((unsigned short)hi_));
              WR[((size_t)l_ * 2 + 0) * 48 * 1024 + o * 1024 + k] = (bf16)hi_; WR[((size_t)l_ * 2 + 1) * 48 * 1024 + o * 1024 + k] = (bf16)lo_; } }
        for (int i = bx * NTHREADS + tid; i < DEPTH * 256 * 256; i += G * NTHREADS) {
            const int l = i >> 16, rem = i & 65535, chg = rem >> 8, ii = rem & 255;
            if (ii < 64) LWT[((size_t)l * 256 + chg) * 64 + ii] = (bf16)f2bf(args.in[6][((size_t)l * 64 + ii) * 256 + chg]);
            else if (ii < 128) LWT[(size_t)DEPTH * 256 * 64 + ((size_t)l * 256 + chg) * 64 + (ii - 64)] = (bf16)f2bf(args.in[8][((size_t)l * 64 + (ii - 64)) * 256 + chg]);
            else LWT[(size_t)2 * DEPTH * 256 * 64 + ((size_t)l * 256 + chg) * 128 + (ii - 128)] = (bf16)f2bf(args.in[9][((size_t)l * 128 + (ii - 128)) * 256 + chg]);
        }
        float* scr = lds + wid * (64 * 65);
        constexpr int I_IN = 16 * 56, I_OUT = 16 * 16, I_13 = NE * 16 * 16, I_2 = NE * 8 * 16, I_L = I_IN + I_OUT + I_13 + I_2;
        for (int it = bx * 8 + wid; it < DEPTH * I_L; it += G * 8) {
            const int l = it / I_L; int r = it % I_L;
            if (r < I_IN) { const int kb = r / 56, nb = r % 56; const int nsrc = nb * 64 + (nb >= 24 ? 8 : 0);
                tr_tile(args.in[1] + (size_t)l * DM * INW + (size_t)kb * 64 * INW + nsrc, INW, WIN + (size_t)l * PW * DM + (size_t)nb * 64 * DM + kb * 64, DM, scr, lane); }
            else if (r < I_IN + I_OUT) { r -= I_IN; const int kb = r / 16, nb = r % 16;
                tr_tile(args.in[16] + (size_t)l * DM * DM + (size_t)kb * 64 * DM + nb * 64, DM, WOUT + (size_t)l * DM * DM + (size_t)nb * 64 * DM + kb * 64, DM, scr, lane); }
            else if (r < I_IN + I_OUT + I_13) { r -= I_IN + I_OUT; const int e = r >> 8, kb = (r >> 4) & 15, nb = r & 15;
                const int pn = nb >> 2, q = nb & 3; const float* srcw = (q < 2 ? args.in[25] : args.in[26]) + ((size_t)l * NE + e) * DM * DE;
                tr_tile(srcw + (size_t)kb * 64 * DE + pn * 128 + (q & 1) * 64, DE, W13 + ((size_t)l * NE + e) * DM * DM + (size_t)nb * 64 * DM + kb * 64, DM, scr, lane); }
            else { r -= I_IN + I_OUT + I_13; const int e = r >> 7, kb = (r >> 4) & 7, nb = r & 15;
                tr_tile(args.in[27] + ((size_t)l * NE + e) * DE * DM + (size_t)kb * 64 * DM + nb * 64, DM, W2 + ((size_t)l * NE + e) * DM * DE + (size_t)nb * 64 * DE + kb * 64, DE, scr, lane); }
        }
    }
    GRID_BAR();

    for (int l = 0; l < DEPTH; ++l) {
        for (int rep_ = 0; rep_ < REP_A; ++rep_) {
            const int tid = ltid(), lane = tid & 63, wid = __builtin_amdgcn_readfirstlane(tid >> 6); (void)lane; (void)wid;
            const float* wf = args.in[1] + (size_t)l * DM * INW + O_FF; const float* fbias = args.in[2] + l * 8;
            float w[8][16];
#pragma unroll
            for (int jq = 0; jq < 4; ++jq)
#pragma unroll
                for (int e = 0; e < 4; ++e)
#pragma unroll
                    for (int h = 0; h < 8; ++h) w[h][jq * 4 + e] = wf[(size_t)(jq * 256 + lane * 4 + e) * INW + h];
            float* ffl = lds;
            for (int ch = bx; ch < T / 128; ch += G) {
                __syncthreads();
                for (int i = 0; i < 16; ++i) { const int tl = wid * 16 + i; const size_t m = (size_t)ch * 128 + tl;
                    float acc[8];
#pragma unroll
                    for (int h = 0; h < 8; ++h) acc[h] = 0.f;
#pragma unroll
                    for (int jq = 0; jq < 4; ++jq) { const f32x4 xv = *(const f32x4*)(X + m * DM + jq * 256 + lane * 4);
#pragma unroll
                        for (int e = 0; e < 4; ++e)
#pragma unroll
                            for (int h = 0; h < 8; ++h) acc[h] += xv[e] * w[h][jq * 4 + e]; }
#pragma unroll
                    for (int h = 0; h < 8; ++h) acc[h] = wave_sum(acc[h]);
                    if (lane < 8) { float v = acc[0];
#pragma unroll
                        for (int h = 1; h < 8; ++h) v = (lane == h) ? acc[h] : v;
                        ffl[tl * 8 + lane] = v + fbias[lane]; } }
                __syncthreads();
                {
                    const int h = wid; const int bb = (ch * 128) / SEQ, t0 = (ch * 128) % SEQ; double carry = 0.0;
#pragma unroll
                    for (int half = 0; half < 2; ++half) { double v = (double)logsigmoidf_(ffl[(half * 64 + lane) * 8 + h]);
#pragma unroll
                        for (int o = 1; o < 64; o <<= 1) { const double n = __shfl_up(v, o); if (lane >= o) v += n; }
                        v += carry; LCS[(size_t)(bb * 8 + h) * SEQ + t0 + half * 64 + lane] = v; carry = __shfl(v, 63); }
                    if (lane == 0) TOT[(bb * 8 + h) * 128 + t0 / 128] = carry;
                }
            }
            __syncthreads();
            pg8::Gemm g{XB, WIN + (size_t)l * PW * DM, T, PW, DM}; pg8::StaticOrder S; S.init(T, PW, G, bx);
            pg8::EpiInProj E{Pb, PW, QC2};
            pg8::gemm_phase<pg8::EpiInProj, pg8::StaticOrder, true, true>((PG8_LAS unsigned char*)lds_raw, g, S, E);
        }
        GRID_BAR();
        for (int rep_ = 0; rep_ < REP_C; ++rep_) {
            const int tid = ltid(), lane = tid & 63, wid = __builtin_amdgcn_readfirstlane(tid >> 6); (void)lane; (void)wid;
            for (int ch = bx; ch < T / 128; ch += G) {
                const int h = wid; const int bb = (ch * 128) / SEQ, t0 = (ch * 128) % SEQ, ci = t0 / 128;
                double pre = 0.0;
                { const double* tp = TOT + (bb * 8 + h) * 128; double a = (lane < ci) ? tp[lane] : 0.0; a += (lane + 64 < ci) ? tp[lane + 64] : 0.0;
#pragma unroll
                  for (int o = 1; o < 64; o <<= 1) a += __shfl_xor(a, o);
                  pre = a; }
#pragma unroll
                for (int half = 0; half < 2; ++half) { const int t = t0 + half * 64 + lane; const double v = pre + LCS[(size_t)(bb * 8 + h) * SEQ + t];
                    const double bd = -v * 1.4426950408889634; const unsigned h_ = f2bf((float)bd); const double r1 = bd - (double)bf2f((unsigned short)h_);
                    const unsigned m_ = f2bf((float)r1); const double r2 = r1 - (double)bf2f((unsigned short)m_); const unsigned l_ = f2bf((float)r2);
                    *(pg8::u32x4*)(KA + ((size_t)(bb * 8 + h) * SEQ + t) * 16) = (pg8::u32x4){h_ | (m_ << 16), l_ | (0x3f80u << 16), 0x3f803f80u, 0u};
                    if (lane == 63) BE[(bb * 8 + h) * 256 + t / 64] = (float)bd; }
                { LAS unsigned* nrm = (LAS unsigned*)lds_raw;
                  __syncthreads();
                  if (tid < 16) nrm[tid] = 0u;
                  __syncthreads();
                  const int tl = tid >> 2, part = tid & 3; const bf16* prow = Pb + ((size_t)ch * 128 + tl) * PW;
#pragma unroll
                  for (int hq = 0; hq < 2; ++hq) { const int hd = part * 2 + hq;
#pragma unroll
                      for (int qk = 0; qk < 2; ++qk) { const pg8::u32x4* vp = (const pg8::u32x4*)(prow + (qk ? C_FK : C_FQ) + hd * 64); float ss = 0.f;
#pragma unroll
                          for (int v8 = 0; v8 < 8; ++v8) { const pg8::u32x4 wv = vp[v8];
#pragma unroll
                              for (int e = 0; e < 4; ++e) { const float lo_ = __builtin_bit_cast(float, wv[e] << 16), hi_ = __builtin_bit_cast(float, wv[e] & 0xffff0000u); ss += lo_ * lo_ + hi_ * hi_; } }
                          atomicMax((unsigned*)(nrm + qk * 8 + hd), __float_as_uint(ss)); } }
                  __syncthreads();
                  if (tid < 16) { const int hd = tid & 7; ((tid < 8) ? QN2 : KN2)[(bb * 8 + hd) * 128 + ci] = __uint_as_float(nrm[tid]); }
                }
            }
            __syncthreads();
            const ck::RwkvParams rp{args.in[3] + l * 768, args.in[4] + l * 256, args.in[5] + l * 256, args.in[7] + l * 256, args.in[10] + l * 256, args.in[11] + l * 256, args.in[12] + l * 256,
                                    args.in[13] + l * 256, args.in[14] + l * 256, args.in[15] + l * 256,
                                    LWT + (size_t)l * 256 * 64, LWT + (size_t)DEPTH * 256 * 64 + (size_t)l * 256 * 64, LWT + (size_t)2 * DEPTH * 256 * 64 + (size_t)l * 256 * 128};
            for (int it = bx; it < 2048; it += G) ck::rwkv_stage1((CK_LAS unsigned char*)lds_raw, it, Pb, PW, C_RR, C_RK, C_RV, C_WD, SEQ, rp, cw);
            { const int quad = wid >> 2;
              for (int i0 = bx * 2; i0 < 2048; i0 += G * 2) ck::ret_stage1((CK_LAS unsigned char*)lds_raw + quad * 2 * ck::B9, i0 + quad, Pb, PW, C_TK, C_TV, SEQ, ROPE, cw); }
        }
        GRID_BAR();
        {
            const int tid = ltid(), lane = tid & 63, wid = __builtin_amdgcn_readfirstlane(tid >> 6); (void)lane; (void)wid;
            const int quad = wid >> 2;
#ifndef REP_S
#define REP_S 1
#endif
            for (int rep_ = 0; rep_ < REP_S; ++rep_) {
            if (bx < 8) ck::rwkv_scan((CK_LAS unsigned char*)lds_raw, quad == 0 ? bx : -1, cw);
            else if (bx < 16) { if (quad == 0) ck::ret_scan(bx - 8, cw); }
            }
            __syncthreads();
            const attn_body::AttnTensors AT{(const attn_body::bf16*)(Pb + C_FQ), (const attn_body::bf16*)(Pb + C_FK), (const attn_body::bf16*)(Pb + C_FV), (attn_body::bf16*)MIXB, KA};
            for (int gtry = 0; gtry < 8; ++gtry) {
                const int grp = (bx + gtry) & 7; unsigned* qh = ctl + CW_Q + 64 * (8 * l + grp);
                for (;;) {
                    if (tid == 0) MISC[16] = atomicAdd(qh, 1u);
                    __syncthreads();
                    const unsigned idx = MISC[16];
                    if (idx >= 128u) { __syncthreads(); break; }
                    const int qb = 63 - (int)(idx >> 1), bh = 2 * grp + (int)(idx & 1);
                    if (wid == 0) {
                        const float qn2 = fmaxf(QN2[bh * 128 + 2 * qb], QN2[bh * 128 + 2 * qb + 1]);
                        float kn2 = fmaxf(lane <= 2 * qb + 1 ? KN2[bh * 128 + lane] : 0.f, lane + 64 <= 2 * qb + 1 ? KN2[bh * 128 + 64 + lane] : 0.f);
#pragma unroll
                        for (int o = 1; o < 64; o <<= 1) kn2 = fmaxf(kn2, __shfl_xor(kn2, o));
                        const float bound = 2.002f * sqrtf(qn2 * kn2) + 50.0f; const int ntq = 4 * qb;
                        const float bref = ntq > 0 ? BE[bh * 256 + ntq - 1] : 0.f;
                        int nsk = 0;
#pragma unroll
                        for (int q4 = 0; q4 < 4; ++q4) { const int tt = q4 * 64 + lane; const bool sk = tt < ntq && (bref - BE[bh * 256 + tt]) > bound; nsk += __popcll(__ballot(sk)); }
                        if (lane == 0) MISC[17] = (unsigned)(nsk & ~1);
                    }
                    __syncthreads();
                    const int t0 = (int)MISC[17];
                    attn_body::attn_unit<8>(bh / attn_body::NHEAD, bh % attn_body::NHEAD, qb, t0, AT.Q, AT.K, AT.V, AT.O, AT.KA, (char*)lds_raw);
                }
            }
        }
        GRID_BAR();
        for (int rep_ = 0; rep_ < REP_E; ++rep_) {
            const int tid = ltid(), lane = tid & 63, wid = __builtin_amdgcn_readfirstlane(tid >> 6); (void)lane; (void)wid;
            const ck::RwkvParams rp{args.in[3] + l * 768, args.in[4] + l * 256, args.in[5] + l * 256, args.in[7] + l * 256, args.in[10] + l * 256, args.in[11] + l * 256, args.in[12] + l * 256,
                                    args.in[13] + l * 256, args.in[14] + l * 256, args.in[15] + l * 256, nullptr, nullptr, nullptr};
            const int quad = wid >> 2;
            for (int i0 = bx * 2; i0 < 2048; i0 += G * 2) ck::rwkv_stage3((CK_LAS unsigned char*)lds_raw + quad * 64 * ck::SF * 4, i0 + quad, rp, cw, MIXB, SEQ);
            for (int i0 = bx * 2; i0 < 2048; i0 += G * 2) ck::ret_stage3((CK_LAS unsigned char*)lds_raw + quad * ck::L_RET3, i0 + quad, Pb, PW, C_TQ, C_TK, C_TV, C_TG, SEQ, ROPE, args.in[15] + l * 256, cw, MIXB);
        }
        GRID_BAR();
        for (int rep_ = 0; rep_ < REP_F; ++rep_) {
            const int tid = ltid(), lane = tid & 63, wid = __builtin_amdgcn_readfirstlane(tid >> 6); (void)lane; (void)wid;
            pg8::Gemm g{MIXB, WOUT + (size_t)l * DM * DM, T, DM, DM}; pg8::StaticOrder S; S.init(T, DM, G, bx);
            pg8::EpiF32 E{YO, DM};
            pg8::gemm_phase<pg8::EpiF32, pg8::StaticOrder, true, true>((PG8_LAS unsigned char*)lds_raw, g, S, E);
        }
        GRID_BAR();
        {
            const int tid = ltid(), lane = tid & 63, wid = __builtin_amdgcn_readfirstlane(tid >> 6); (void)lane; (void)wid;
            const float* g1 = args.in[17] + l * DM; const float* b1 = args.in[18] + l * DM;
            const float* bg = args.in[22] + l * 4; const float* be = args.in[24] + l * 32;
            unsigned* cnt = ctl + CW_CNT + 64 * l;
            const bf16* WRh = (const bf16*)(ws + WS_WR) + (size_t)l * 2 * 48 * 1024; const bf16* WRl = WRh + 48 * 1024;
            constexpr int XS = 1032;
            LAS unsigned short* XTh = (LAS unsigned short*)lds_raw; LAS unsigned short* XTl = XTh + 16 * XS;
            LAS float* PART = (LAS float*)((LAS unsigned char*)lds_raw + 2 * 16 * XS * 2);
            LAS float* LG = PART + 8 * 16 * 48;
            pg8::bf16x8 wh[4][3], wl[4][3];
#pragma unroll
            for (int s_ = 0; s_ < 4; ++s_)
#pragma unroll
                for (int nt = 0; nt < 3; ++nt) { const size_t o = (size_t)(16 * nt + (lane & 15)) * 1024 + 128 * wid + 32 * s_ + 8 * (lane >> 4);
                    wh[s_][nt] = *(const pg8::bf16x8*)(WRh + o); wl[s_][nt] = *(const pg8::bf16x8*)(WRl + o); }
            float gg[16], bb[16];
#pragma unroll
            for (int jq = 0; jq < 4; ++jq) { const f32x4 gv = *(const f32x4*)(g1 + jq * 256 + lane * 4), bv = *(const f32x4*)(b1 + jq * 256 + lane * 4);
#pragma unroll
                for (int e = 0; e < 4; ++e) { gg[jq * 4 + e] = gv[e]; bb[jq * 4 + e] = bv[e]; } }
            for (int blk = bx; blk < T / 16; blk += G) {
                const size_t m0 = (size_t)blk * 16;
#pragma unroll
                for (int i = 0; i < 2; ++i) { const int tl = wid * 2 + i; const size_t m = m0 + tl;
                    float v[16]; float sm = 0.f;
#pragma unroll
                    for (int jq = 0; jq < 4; ++jq) { const f32x4 xv = *(const f32x4*)(X + m * DM + jq * 256 + lane * 4); const f32x4 yv = *(const f32x4*)(YO + m * DM + jq * 256 + lane * 4);
#pragma unroll
                        for (int e = 0; e < 4; ++e) { v[jq * 4 + e] = ALPHA * xv[e] + yv[e]; sm += v[jq * 4 + e]; } }
                    const float mean = wave_sum(sm) * (1.f / DM); float s2 = 0.f;
#pragma unroll
                    for (int q = 0; q < 16; ++q) { v[q] -= mean; s2 += v[q] * v[q]; }
                    const float rstd = 1.0f / sqrtf(wave_sum(s2) * (1.f / DM) + LN_EPS);
#pragma unroll
                    for (int jq = 0; jq < 4; ++jq) { f32x4 ov; unsigned hw[4], lw[4];
#pragma unroll
                        for (int e = 0; e < 4; ++e) { const float o_ = v[jq * 4 + e] * rstd * gg[jq * 4 + e] + bb[jq * 4 + e]; ov[e] = o_; hw[e] = f2bf(o_); lw[e] = f2bf(o_ - bf2f((unsigned short)hw[e])); }
                        *(f32x4*)(X + m * DM + jq * 256 + lane * 4) = ov;
                        *(LAS ck::u32x2*)(XTh + tl * XS + jq * 256 + lane * 4) = (ck::u32x2){hw[0] | (hw[1] << 16), hw[2] | (hw[3] << 16)};
                        *(LAS ck::u32x2*)(XTl + tl * XS + jq * 256 + lane * 4) = (ck::u32x2){lw[0] | (lw[1] << 16), lw[2] | (lw[3] << 16)}; }
                }
                __syncthreads();
                {
                    pg8::f32x4 acc[3] = {pg8::f32x4{0.f, 0.f, 0.f, 0.f}, pg8::f32x4{0.f, 0.f, 0.f, 0.f}, pg8::f32x4{0.f, 0.f, 0.f, 0.f}};
#pragma unroll
                    for (int s_ = 0; s_ < 4; ++s_) { const int ko = (lane & 15) * XS + 128 * wid + 32 * s_ + 8 * (lane >> 4);
                        const pg8::bf16x8 ah = *(const LAS pg8::bf16x8*)(XTh + ko), al = *(const LAS pg8::bf16x8*)(XTl + ko);
#pragma unroll
                        for (int nt = 0; nt < 3; ++nt) { acc[nt] = __builtin_amdgcn_mfma_f32_16x16x32_bf16(ah, wh[s_][nt], acc[nt], 0, 0, 0);
                            acc[nt] = __builtin_amdgcn_mfma_f32_16x16x32_bf16(al, wh[s_][nt], acc[nt], 0, 0, 0); acc[nt] = __builtin_amdgcn_mfma_f32_16x16x32_bf16(ah, wl[s_][nt], acc[nt], 0, 0, 0); } }
#pragma unroll
                    for (int nt = 0; nt < 3; ++nt)
#pragma unroll
                        for (int r_ = 0; r_ < 4; ++r_) PART[(wid * 16 + 4 * (lane >> 4) + r_) * 48 + 16 * nt + (lane & 15)] = acc[nt][r_];
                }
                __syncthreads();
                for (int p_ = tid; p_ < 16 * 48; p_ += NTHREADS) { float a_ = 0.f;
#pragma unroll
                    for (int w_ = 0; w_ < 8; ++w_) a_ += PART[w_ * 16 * 48 + p_];
                    LG[p_] = a_; }
                __syncthreads();
                if (tid < 16) { const LAS float* lg = LG + tid * 48; const size_t m = m0 + tid;
                    int grp = 0; float gbest = lg[0] + bg[0];
#pragma unroll
                    for (int o = 1; o < 4; ++o) { const float gv = lg[o] + bg[o]; if (gv > gbest) { gbest = gv; grp = o; } }
                    float den = 0.f;
#pragma unroll
                    for (int o = 0; o < 4; ++o) den += expf(lg[o] + bg[o] - gbest);
                    const float ggate = 1.0f / den;
                    int i0 = 0; float v0 = lg[4 + grp * 8] + be[grp * 8];
                    for (int o = 1; o < 8; ++o) { const float ev = lg[4 + grp * 8 + o] + be[grp * 8 + o]; if (ev > v0) { v0 = ev; i0 = o; } }
                    int i1 = -1; float v1 = -INFINITY;
                    for (int o = 0; o < 8; ++o) { const float ev = lg[4 + grp * 8 + o] + be[grp * 8 + o]; if (o != i0 && (i1 < 0 || ev > v1)) { v1 = ev; i1 = o; } }
                    const float e1 = expf(v1 - v0); const float p0 = 1.0f / (1.0f + e1), p1 = e1 / (1.0f + e1);
                    const int ex0 = grp * 8 + i0, ex1 = grp * 8 + i1;
                    const unsigned q0 = atomicAdd(cnt + ex0, 1u); EP[2 * m] = (ex0 << 16) | (int)q0;
                    const unsigned q1 = atomicAdd(cnt + ex1, 1u); EP[2 * m + 1] = (ex1 << 16) | (int)q1;
                    GATE[2 * m] = ggate * p0; GATE[2 * m + 1] = ggate * p1;
                }
                __syncthreads();
            }
        }
        GRID_BAR();
        for (int rep_ = 0; rep_ < REP_H; ++rep_) {
            const int tid = ltid(), lane = tid & 63, wid = __builtin_amdgcn_readfirstlane(tid >> 6); (void)lane; (void)wid;
            __syncthreads();
            unsigned* cnt = ctl + CW_CNT + 64 * l;
            int* poff = (int*)lds;
            if (tid == 0) { int acc = 0; for (int e = 0; e < NE; ++e) { poff[e] = acc; acc += (((int)cnt[e] + 255) >> 8) << 8; } poff[NE] = acc; }
            __syncthreads();
            for (int m = bx * 8 + wid; m < T; m += G * 8) {
                uint2 w[4];
    #pragma unroll
                for (int jq = 0; jq < 4; ++jq) { const f32x4 xv = *(const f32x4*)(X + (size_t)m * DM + jq * 256 + lane * 4); w[jq] = make_uint2(pk2(xv[0], xv[1]), pk2(xv[2], xv[3])); }
    #pragma unroll
                for (int k = 0; k < 2; ++k) { const int ep = EP[2 * m + k]; const int dest = poff[ep >> 16] + (ep & 0xffff);
    #pragma unroll
                    for (int jq = 0; jq < 4; ++jq) *(uint2*)(XP + (size_t)dest * DM + jq * 256 + lane * 4) = w[jq];
                    if (lane == 0) DEST[2 * m + k] = dest; }
            }
        }
        GRID_BAR();
        for (int rep_ = 0; rep_ < REP_IJ; ++rep_) {
            const int tid = ltid(), lane = tid & 63, wid = __builtin_amdgcn_readfirstlane(tid >> 6); (void)lane; (void)wid;
            unsigned* cnt = ctl + CW_CNT + 64 * l;
            PG8_LAS int* tile_e = (PG8_LAS int*)((PG8_LAS unsigned char*)lds_raw + 131072); PG8_LAS int* tst = tile_e + MAXTILES;
            __syncthreads();
            if (tid == 0) { int acc = 0; for (int e = 0; e < NE; ++e) { tst[e] = acc; acc += ((int)cnt[e] + 255) >> 8; } tst[NE] = acc; }
            __syncthreads();
            const int ntile = tst[NE];
            if (tid < ntile) { int e = 0; while (tst[e + 1] <= tid) ++e; tile_e[tid] = e; }
            __syncthreads();
            pg8::MoeOrder S{ntile, G, bx, tile_e};
            { pg8::Gemm g{XP, W13 + (size_t)l * NE * DM * DM, ntile * 256, DM, DM}; pg8::EpiSwiGlu E{Hb, DE};
              pg8::gemm_phase<pg8::EpiSwiGlu, pg8::MoeOrder, true, true>((PG8_LAS unsigned char*)lds_raw, g, S, E); }
            GRID_BAR();
            { pg8::Gemm g{Hb, W2 + (size_t)l * NE * DM * DE, ntile * 256, DM, DE}; pg8::EpiInProj E{YP, DM, 1.0f};
              pg8::gemm_phase<pg8::EpiInProj, pg8::MoeOrder, true, true>((PG8_LAS unsigned char*)lds_raw, g, S, E); }
        }
        GRID_BAR();
        for (int rep_ = 0; rep_ < REP_K; ++rep_) { float* Xo = (rep_ == REP_K - 1) ? X : (float*)(ws + WS_XP); bf16* XBo = (rep_ == REP_K - 1) ? XB : (bf16*)(ws + WS_H);
            const int tid = ltid(), lane = tid & 63, wid = __builtin_amdgcn_readfirstlane(tid >> 6); (void)lane; (void)wid;
            const float* g2 = args.in[19] + l * DM; const float* b2 = args.in[20] + l * DM;
            for (int m = bx * 8 + wid; m < T; m += G * 8) {
                const float ga = GATE[2 * m], gb = GATE[2 * m + 1]; const size_t da = (size_t)DEST[2 * m], db = (size_t)DEST[2 * m + 1];
                float v[16]; float s = 0.f;
    #pragma unroll
                for (int jq = 0; jq < 4; ++jq) { const f32x4 xv = *(const f32x4*)(X + (size_t)m * DM + jq * 256 + lane * 4);
                    const uint2 wa = *(const uint2*)(YP + da * DM + jq * 256 + lane * 4), wb = *(const uint2*)(YP + db * DM + jq * 256 + lane * 4);
                    const f32x4 ya = (f32x4){__builtin_bit_cast(float, wa.x << 16), __builtin_bit_cast(float, wa.x & 0xffff0000u), __builtin_bit_cast(float, wa.y << 16), __builtin_bit_cast(float, wa.y & 0xffff0000u)};
                    const f32x4 yb = (f32x4){__builtin_bit_cast(float, wb.x << 16), __builtin_bit_cast(float, wb.x & 0xffff0000u), __builtin_bit_cast(float, wb.y << 16), __builtin_bit_cast(float, wb.y & 0xffff0000u)};
    #pragma unroll
                    for (int e = 0; e < 4; ++e) { v[jq * 4 + e] = ALPHA * xv[e] + (ga * ya[e] + gb * yb[e]); s += v[jq * 4 + e]; } }
                const float mean = wave_sum(s) * (1.f / DM); float s2 = 0.f;
    #pragma unroll
                for (int i = 0; i < 16; ++i) { v[i] -= mean; s2 += v[i] * v[i]; }
                const float rstd = 1.0f / sqrtf(wave_sum(s2) * (1.f / DM) + LN_EPS);
    #pragma unroll
                for (int jq = 0; jq < 4; ++jq) { f32x4 ov;
    #pragma unroll
                    for (int e = 0; e < 4; ++e) { const int c = jq * 256 + lane * 4 + e; ov[e] = v[jq * 4 + e] * rstd * g2[c] + b2[c]; }
                    *(f32x4*)(Xo + (size_t)m * DM + jq * 256 + lane * 4) = ov;
                    *(uint2*)(XBo + (size_t)m * DM + jq * 256 + lane * 4) = make_uint2(pk2(ov[0], ov[1]), pk2(ov[2], ov[3])); }
            }
        }
        if (l + 1 < DEPTH) GRID_BAR();
    }
}

extern "C" void kernel_launch(void* const* d_in, const int* in_sizes, int n_in, void* d_out, int out_size, void* d_ws, size_t ws_size, hipStream_t stream) {
    static int grid = 0;
    if (grid == 0) {
        if (n_in != 28 || out_size != T * DM || ws_size < WS_END) { fprintf(stderr, "kernel_launch: unexpected shapes (n_in %d out %d ws %zu)\n", n_in, out_size, ws_size); grid = -1; return; }
        int dev = 0, cus = 0, per_cu = 0;
        (void)hipGetDevice(&dev); (void)hipDeviceGetAttribute(&cus, hipDeviceAttributeMultiprocessorCount, dev);
        (void)hipFuncSetAttribute((const void*)mk_fwd, hipFuncAttributeMaxDynamicSharedMemorySize, LDS_ALL);
        if (hipOccupancyMaxActiveBlocksPerMultiprocessor(&per_cu, (const void*)mk_fwd, NTHREADS, LDS_ALL) != hipSuccess || per_cu < 1) fprintf(stderr, "kernel_launch: occupancy query says %d blocks per CU\n", per_cu);
        (void)hipGetLastError();
        grid = cus > 0 ? cus : 256;
        if (grid != 256) fprintf(stderr, "kernel_launch: %d CUs (built for 256)\n", grid);
    }
    if (grid < 0) return;
    (void)hipMemsetAsync((char*)d_ws + WS_CTL, 0, CTL_BYTES, stream);
    Args a{};
    for (int i = 0; i < 28; ++i) a.in[i] = (const float*)d_in[i];
    a.out = (float*)d_out; a.ws = (unsigned char*)d_ws;
    hipLaunchKernelGGL(mk_fwd, dim3(grid), dim3(NTHREADS), LDS_ALL, stream, a);
}
```

```cpp
#include <hip/hip_runtime.h>
#include <cstdio>
#include <cstdint>
#include <cmath>
__device__ __forceinline__ int ltid() { int t = __builtin_amdgcn_workitem_id_x(); asm volatile("" : "+v"(t)); return t; }

constexpr int BATCH = 2, SEQ = 16384, DM = 1024, DEPTH = 4, T = BATCH * SEQ;
constexpr int INW = 3592, PW = 3584;
constexpr int O_FF = 1536;
constexpr int C_FQ = 0, C_FK = 512, C_FV = 1024, C_RR = 1536, C_RK = 1792, C_RV = 2048, C_WD = 2304, C_AD = 2368, C_GD = 2432,
              C_TQ = 2560, C_TK = 2816, C_TV = 3072, C_TG = 3328;
constexpr int NE = 32, DE = 512, A_TOT = T * 2;
constexpr float ALPHA = 1.681792830507429f;
constexpr float LN_EPS = 1e-5f, RWKV_GN_EPS = 64e-5f, RET_GN_EPS = 1e-6f;
constexpr float QC2 = 0.125f * 1.4426950408889634f;
constexpr int NTHREADS = 512;
#ifndef REP_P0
#define REP_P0 1
#endif
#ifndef REP_A
#define REP_A 1
#endif
#ifndef REP_C
#define REP_C 1
#endif
#ifndef REP_E
#define REP_E 1
#endif
#ifndef REP_F
#define REP_F 1
#endif
#ifndef REP_H
#define REP_H 1
#endif
#ifndef REP_IJ
#define REP_IJ 1
#endif
#ifndef REP_G
#define REP_G 1
#endif
#ifndef REP_K
#define REP_K 1
#endif
constexpr int LDS_MISC = 147456, LDS_ALL = 148480;

constexpr size_t MiB = 1u << 20;
constexpr size_t WS_CTL = 0, CTL_BYTES = 1 * MiB;
constexpr size_t WS_EP = 1 * MiB;
constexpr size_t WS_DEST = 2 * MiB;
constexpr size_t WS_GATE = 9 * MiB;
constexpr size_t WS_ROPE = 11 * MiB;
constexpr size_t WS_RKD = 15 * MiB;
constexpr size_t WS_WIN = 16 * MiB;
constexpr size_t WS_WOUT = 44 * MiB;
constexpr size_t WS_W13 = 52 * MiB;
constexpr size_t WS_W2 = 308 * MiB;
constexpr size_t WS_XB = 436 * MiB;
constexpr size_t WS_P = 500 * MiB;
constexpr size_t WS_MIXB = 724 * MiB;
constexpr size_t WS_CK = 788 * MiB;
constexpr size_t WS_LW = 3 * MiB;
constexpr size_t WS_YO = 788 * MiB;
constexpr size_t WS_XP = 500 * MiB;
constexpr size_t WS_H = 644 * MiB;
constexpr size_t WS_YP = 716 * MiB;
constexpr size_t WS_LCS = 1012 * MiB;
constexpr size_t WS_KA = 1014 * MiB;
constexpr size_t WS_END = 1018 * MiB;
constexpr size_t WS_WR = 5 * MiB;
constexpr size_t WS_SKIP = 4 * MiB + 65536;
constexpr size_t WS_TOT = 4 * MiB;
constexpr int CW_CNT = 1024;
constexpr int CW_Q = 2048;
constexpr int CW_CV = 6144;
constexpr int CW_BAR = 8192;
constexpr int MAXTILES = 288;

typedef float f32x16 __attribute__((ext_vector_type(16)));
typedef unsigned short bf16;

struct Args {
    const float* in[28]; float* out; unsigned char* ws;
};

__device__ __forceinline__ float sigmoidf_(float x) { return 1.0f / (1.0f + expf(-x)); }
__device__ __forceinline__ float logsigmoidf_(float x) { return x >= 0.f ? -log1pf(expf(-x)) : x - log1pf(expf(x)); }
__device__ __forceinline__ float wave_sum(float v) {
#define WS_DPP(ctrl, rmask) v += __builtin_bit_cast(float, __builtin_amdgcn_update_dpp(0, __builtin_bit_cast(int, v), ctrl, rmask, 0xf, false))
    WS_DPP(0x111, 0xf); WS_DPP(0x112, 0xf); WS_DPP(0x114, 0xf); WS_DPP(0x118, 0xf); WS_DPP(0x142, 0xa); WS_DPP(0x143, 0xc);
#undef WS_DPP
    return __builtin_bit_cast(float, __builtin_amdgcn_readlane(__builtin_bit_cast(int, v), 63));
}
__device__ __forceinline__ unsigned f2bf(float f) { unsigned u = __builtin_bit_cast(unsigned, f); return (u + 0x7fffu + ((u >> 16) & 1u)) >> 16; }
__device__ __forceinline__ unsigned pk2(float lo, float hi) { return f2bf(lo) | (f2bf(hi) << 16); }
__device__ __forceinline__ float bf2f(unsigned short b) { return __builtin_bit_cast(float, (unsigned)b << 16); }
__device__ __forceinline__ float pf(const bf16* Pb, size_t m, int c) { return bf2f(Pb[m * PW + c]); }

namespace pg8 {
#define PG8_LAS __attribute__((address_space(3)))
typedef unsigned short bf16_t;
typedef short bf16x8 __attribute__((ext_vector_type(8)));
typedef float f32x4 __attribute__((ext_vector_type(4)));
typedef unsigned u32x4 __attribute__((ext_vector_type(4)));
constexpr int BM = 256, BK = 64, HALF = 128, HTB = HALF * BK * 2  , STAGE_BYTES = 8 * HTB, NXCD = 8, WGM = 8;

__host__ __device__ __forceinline__ int lds_byte(int r, int c) { const int st = (r >> 4) * 2 + (c >> 5), rr = r & 15, cc = c & 31, ob = rr * 64 + cc * 2; return st * 1024 + (ob ^ (((ob >> 9) & 1) << 5)); }
__host__ __device__ __forceinline__ void stage_rc(int b, int& R, int& C) { const int st = b / 1024, sb = b % 1024, swz = sb ^ (((sb >> 9) & 1) << 5); R = (st >> 1) * 16 + swz / 64; C = (st & 1) * 32 + (swz % 64) / 2; }
__host__ __device__ __forceinline__ int perm32(int rho) { const int n = rho >> 4, i = rho & 15; return 8 * (i >> 2) + 4 * n + (i & 3); }

struct Unit { int pm, pn, pc; };
struct Gemm { const bf16_t* A; const bf16_t* Bt; int M, N, K; };

struct StaticOrder {
    int nM, nN, nwg, G, c;
    __host__ __device__ void init(int M, int N, int G_, int c_) { nM = M / BM; nN = N / BM; nwg = nM * nN; G = G_; c = c_; }
    __host__ __device__ bool next(int i, Unit& u) const {
        const long L = (long)i * G + c; if (L >= nwg) return false;
        int wgid = (int)L; { const int q = nwg / NXCD, r = nwg % NXCD, xcd = wgid % NXCD, off = wgid / NXCD; wgid = (xcd < r ? xcd * (q + 1) : r * (q + 1) + (xcd - r) * q) + off; }
        const int nig = WGM * nN, gid = wgid / nig, fm = gid * WGM, gsz = (nM - fm) < WGM ? (nM - fm) : WGM;
        u.pm = fm + ((wgid % nig) % gsz); u.pn = (wgid % nig) / gsz; u.pc = u.pn; return true;
    }
    __device__ __forceinline__ void a_ready(const Unit&) const {}
    __device__ __forceinline__ void done(const Unit&) const {}
};

__device__ __forceinline__ unsigned cvt_pk_bf16(float lo, float hi) { unsigned r; asm volatile("v_cvt_pk_bf16_f32 %0, %1, %2" : "=v"(r) : "v"(lo), "v"(hi)); return r; }

struct EpiF32 {
    static constexpr bool PERM = false, AFTER_DRAIN = false;
    float* O; int ldc;
    __device__ __forceinline__ void operator()(const f32x4 (&acc)[2][2][4][2], const Unit& u, int wr, int wc, int fr, int fq) const {
        const int row0 = u.pm * BM + wr * 64 + fr; const int col0 = u.pc * BM + wc * 32 + 4 * fq;
#pragma unroll
        for (int ai = 0; ai < 2; ++ai)
#pragma unroll
            for (int m = 0; m < 4; ++m) { float* rowp = O + (size_t)(row0 + ai * HALF + m * 16) * ldc + col0;
#pragma unroll
                for (int bj = 0; bj < 2; ++bj)
#pragma unroll
                    for (int n = 0; n < 2; ++n) *(f32x4*)(rowp + bj * HALF + n * 16) = acc[ai][bj][m][n]; }
    }
};
struct EpiSwiGlu {
    static constexpr bool PERM = true, AFTER_DRAIN = false;
    bf16_t* O; int ldc;
    __device__ __forceinline__ static float silu(float v) { return v * __builtin_amdgcn_rcpf(1.0f + __builtin_amdgcn_exp2f(-1.4426950408889634f * v)); }
    __device__ __forceinline__ void operator()(const f32x4 (&acc)[2][2][4][2], const Unit& u, int wr, int wc, int fr, int fq) const {
        const int row0 = u.pm * BM + wr * 64 + fr; const int col0 = u.pc * HALF + wc * 32 + 8 * fq;
#pragma unroll
        for (int ai = 0; ai < 2; ++ai)
#pragma unroll
            for (int m = 0; m < 4; ++m) { bf16_t* rowp = O + (size_t)(row0 + ai * HALF + m * 16) * ldc + col0;
                f32x4 h0, h1;
#pragma unroll
                for (int e = 0; e < 4; ++e) { h0[e] = silu(acc[ai][0][m][0][e]) * acc[ai][1][m][0][e]; h1[e] = silu(acc[ai][0][m][1][e]) * acc[ai][1][m][1][e]; }
                u32x4 w; w.x = cvt_pk_bf16(h0[0], h0[1]); w.y = cvt_pk_bf16(h0[2], h0[3]); w.z = cvt_pk_bf16(h1[0], h1[1]); w.w = cvt_pk_bf16(h1[2], h1[3]);
                *(u32x4*)rowp = w; }
    }
};
struct MoeOrder {
    int ntile, G, c; const PG8_LAS int* tile_e;
    __device__ __forceinline__ bool next(int i, Unit& u) const { const int L = i * G + c; if (L >= ntile * 4) return false; const int rt = L >> 2, pn = L & 3; u.pm = rt; u.pn = tile_e[rt] * 4 + pn; u.pc = pn; return true; }
    __device__ __forceinline__ void a_ready(const Unit&) const {}
    __device__ __forceinline__ void done(const Unit&) const {}
};
struct EpiInProj {
    static constexpr bool PERM = true, AFTER_DRAIN = false;
    bf16_t* O; int ldc; float qscale;
    __device__ __forceinline__ void operator()(const f32x4 (&acc)[2][2][4][2], const Unit& u, int wr, int wc, int fr, int fq) const {
        const int row0 = u.pm * BM + wr * 64 + fr; const int col0 = u.pc * BM + wc * 32 + 8 * fq;
        const float sc = (u.pc < 2) ? qscale : 1.f;
#pragma unroll
        for (int ai = 0; ai < 2; ++ai)
#pragma unroll
            for (int m = 0; m < 4; ++m) { bf16_t* rowp = O + (size_t)(row0 + ai * HALF + m * 16) * ldc + col0;
#pragma unroll
                for (int bj = 0; bj < 2; ++bj) { const f32x4 v0 = acc[ai][bj][m][0] * sc, v1 = acc[ai][bj][m][1] * sc;
                    u32x4 w; w.x = cvt_pk_bf16(v0[0], v0[1]); w.y = cvt_pk_bf16(v0[2], v0[3]); w.z = cvt_pk_bf16(v1[0], v1[1]); w.w = cvt_pk_bf16(v1[2], v1[3]);
                    *(u32x4*)(rowp + bj * HALF) = w; } }
    }
};
template <class Epi, class Sched, bool ALIGN_EPI = false, bool SP2 = false>
__device__ __forceinline__ void gemm_phase(PG8_LAS unsigned char* lds, const Gemm g, const Sched& S, const Epi& E) {
    const int tid = ltid(), wid = __builtin_amdgcn_readfirstlane(tid >> 6), lane = tid & 63, wr = wid >> 2, wc = wid & 3, fr = lane & 15, fq = lane >> 4;
    const int K = g.K, nt = K / BK;
    unsigned voffA[2], voffB[2];
#pragma unroll
    for (int i = 0; i < 2; ++i) { int R, C; stage_rc(tid * 16 + i * 8192, R, C); const int Rb = Epi::PERM ? ((R & ~31) + perm32(R & 31)) : R;
        voffA[i] = (unsigned)(R * K + C) * 2u; voffB[i] = (unsigned)(Rb * K + C) * 2u; }
    const size_t kstep = (size_t)(BK * 2);
    const size_t hstep = (size_t)HALF * K * 2;
    const size_t tstep = 2 * hstep;
    const unsigned ldsw = (unsigned)wid * 1024u;
    const int aoff = lds_byte(wr * 64 + fr, fq * 8), boff = lds_byte(wc * 32 + fr, fq * 8);
#define PG8_SA(b, h) (((b) * 2 + (h)) * HTB)
#define PG8_SB(b, h) ((4 + (b) * 2 + (h)) * HTB)
#define PG8_STAGE(bufoff, gbase, voff) do { _Pragma("unroll") for (int _i = 0; _i < 2; ++_i) \
        __builtin_amdgcn_global_load_lds((const unsigned*)((const char*)(gbase) + (voff)[_i]), (PG8_LAS unsigned*)(lds + (bufoff) + ldsw + _i * 8192), 16, 0, 0); } while (0)
#define PG8_LDA(dst, b, h) do { _Pragma("unroll") for (int m = 0; m < 4; ++m) _Pragma("unroll") for (int k = 0; k < 2; ++k) dst[m][k] = *(const PG8_LAS bf16x8*)(lds + PG8_SA(b, h) + aoff + m * 2048 + k * 1024); } while (0)
#define PG8_LDB(dst, b, h) do { _Pragma("unroll") for (int n = 0; n < 2; ++n) _Pragma("unroll") for (int k = 0; k < 2; ++k) dst[n][k] = *(const PG8_LAS bf16x8*)(lds + PG8_SB(b, h) + boff + n * 2048 + k * 1024); } while (0)
#define PG8_MMA(ai, bj, At, Bt) do { __builtin_amdgcn_s_setprio(1); _Pragma("unroll") for (int m = 0; m < 4; ++m) _Pragma("unroll") for (int n = 0; n < 2; ++n) _Pragma("unroll") for (int k = 0; k < 2; ++k) \
        acc[ai][bj][m][n] = __builtin_amdgcn_mfma_f32_16x16x32_bf16(Bt[n][k], At[m][k], acc[ai][bj][m][n], 0, 0, 0); __builtin_amdgcn_s_setprio(0); } while (0)
#define PG8_WAIT_V(n) asm volatile("s_waitcnt vmcnt(" #n ")" ::: "memory")
#define PG8_WAIT_L(n) asm volatile("s_waitcnt lgkmcnt(" #n ")" ::: "memory")
#define PG8_BAR __builtin_amdgcn_s_barrier()
#define PG8_SCHED __builtin_amdgcn_sched_barrier(0)
    Unit cur, nxt; int ui = 0;
    if (!S.next(0, cur)) return;
    f32x4 acc[2][2][4][2];
#pragma unroll
    for (int a = 0; a < 2; ++a)
#pragma unroll
        for (int b = 0; b < 2; ++b)
#pragma unroll
            for (int m = 0; m < 4; ++m)
#pragma unroll
                for (int n = 0; n < 2; ++n) acc[a][b][m][n] = (f32x4){0.f, 0.f, 0.f, 0.f};
    bf16x8 At[4][2], B0[2][2], B1[2][2];
    const char* cA = (const char*)g.A + (size_t)cur.pm * tstep; const char* cB = (const char*)g.Bt + (size_t)cur.pn * tstep;
    S.a_ready(cur);
    if constexpr (SP2) {
        PG8_STAGE(PG8_SB(0, 0), cB, voffB); PG8_STAGE(PG8_SB(0, 1), cB + hstep, voffB); PG8_STAGE(PG8_SA(0, 0), cA, voffA); PG8_STAGE(PG8_SA(0, 1), cA + hstep, voffA);
        if (wr == 1) PG8_BAR;
        PG8_WAIT_V(2); PG8_BAR;
        PG8_STAGE(PG8_SB(1, 0), cB + kstep, voffB); PG8_STAGE(PG8_SA(1, 0), cA + kstep, voffA); PG8_STAGE(PG8_SB(1, 1), cB + hstep + kstep, voffB);
        PG8_WAIT_V(6); PG8_BAR;
    } else {
        PG8_STAGE(PG8_SB(0, 0), cB, voffB); PG8_STAGE(PG8_SA(0, 0), cA, voffA); PG8_STAGE(PG8_SB(0, 1), cB + hstep, voffB); PG8_STAGE(PG8_SA(0, 1), cA + hstep, voffA);
        if (wr == 1) PG8_BAR;
        PG8_WAIT_V(4); PG8_BAR;
        PG8_STAGE(PG8_SB(1, 0), cB + kstep, voffB); PG8_STAGE(PG8_SA(1, 0), cA + kstep, voffA); PG8_STAGE(PG8_SB(1, 1), cB + hstep + kstep, voffB);
        PG8_WAIT_V(6); PG8_BAR;
    }
    for (;;) {
        const bool has_next = S.next(ui + 1, nxt);
        const char* nA = has_next ? (const char*)g.A + (size_t)nxt.pm * tstep : cA; const char* nB = has_next ? (const char*)g.Bt + (size_t)nxt.pn * tstep : cB;
        for (int t = 0; t < nt; t += 2) {
            const bool last = (t == nt - 2);
            const char* a1 = cA + (size_t)(t + 1) * kstep;
            const char* a2 = last ? nA : cA + (size_t)(t + 2) * kstep; const char* b2 = last ? nB : cB + (size_t)(t + 2) * kstep;
            const char* a3 = a2 + kstep; const char* b3 = b2 + kstep;
            if (last && has_next) S.a_ready(nxt);
            if constexpr (SP2) {
            PG8_LDB(B0, 0, 0); PG8_LDB(B1, 0, 1); PG8_SCHED; PG8_LDA(At, 0, 0); PG8_STAGE(PG8_SA(1, 1), a1 + hstep, voffA);
            PG8_WAIT_V(8); PG8_WAIT_L(0); PG8_BAR; PG8_MMA(0, 0, At, B0); PG8_MMA(0, 1, At, B1); PG8_BAR; PG8_SCHED;
            PG8_LDA(At, 0, 1); PG8_STAGE(PG8_SB(0, 0), b2, voffB); PG8_STAGE(PG8_SB(0, 1), b2 + hstep, voffB); PG8_STAGE(PG8_SA(0, 0), a2, voffA);
            PG8_WAIT_V(8); PG8_WAIT_L(0); PG8_BAR; PG8_MMA(1, 0, At, B0); PG8_MMA(1, 1, At, B1); PG8_BAR; PG8_SCHED;
            PG8_LDB(B0, 1, 0); PG8_LDB(B1, 1, 1); PG8_SCHED; PG8_LDA(At, 1, 0); PG8_STAGE(PG8_SA(0, 1), a2 + hstep, voffA);
            PG8_WAIT_V(8); PG8_WAIT_L(0); PG8_BAR; PG8_MMA(0, 0, At, B0); PG8_MMA(0, 1, At, B1); PG8_BAR; PG8_SCHED;
            PG8_LDA(At, 1, 1); PG8_STAGE(PG8_SB(1, 0), b3, voffB); PG8_STAGE(PG8_SB(1, 1), b3 + hstep, voffB); PG8_STAGE(PG8_SA(1, 0), a3, voffA);
            PG8_WAIT_V(8); PG8_WAIT_L(0); PG8_BAR; PG8_MMA(1, 0, At, B0); PG8_MMA(1, 1, At, B1); PG8_BAR; PG8_SCHED;
            } else {
            PG8_LDB(B0, 0, 0); PG8_SCHED; PG8_LDA(At, 0, 0); PG8_STAGE(PG8_SA(1, 1), a1 + hstep, voffA);
            PG8_WAIT_L(8); PG8_BAR; PG8_WAIT_L(0); PG8_MMA(0, 0, At, B0); PG8_BAR; PG8_SCHED;
            PG8_LDB(B1, 0, 1); PG8_STAGE(PG8_SB(0, 0), b2, voffB);
            PG8_BAR; PG8_WAIT_L(0); PG8_MMA(0, 1, At, B1); PG8_BAR;
            PG8_LDA(At, 0, 1); PG8_STAGE(PG8_SA(0, 0), a2, voffA);
            PG8_BAR; PG8_WAIT_L(0); PG8_MMA(1, 0, At, B0); PG8_BAR; PG8_SCHED;
            PG8_STAGE(PG8_SB(0, 1), b2 + hstep, voffB);
            PG8_WAIT_V(6); PG8_BAR; PG8_MMA(1, 1, At, B1); PG8_BAR;
            PG8_LDB(B0, 1, 0); PG8_SCHED; PG8_LDA(At, 1, 0); PG8_STAGE(PG8_SA(0, 1), a2 + hstep, voffA);
            PG8_WAIT_L(8); PG8_BAR; PG8_WAIT_L(0); PG8_MMA(0, 0, At, B0); PG8_BAR; PG8_SCHED;
            PG8_LDB(B1, 1, 1); PG8_STAGE(PG8_SB(1, 0), b3, voffB);
            PG8_BAR; PG8_WAIT_L(0); PG8_MMA(0, 1, At, B1); PG8_BAR;
            PG8_LDA(At, 1, 1); PG8_STAGE(PG8_SA(1, 0), a3, voffA);
            PG8_BAR; PG8_WAIT_L(0); PG8_MMA(1, 0, At, B0); PG8_BAR; PG8_SCHED;
            PG8_STAGE(PG8_SB(1, 1), b3 + hstep, voffB);
            PG8_WAIT_V(6); PG8_BAR; PG8_MMA(1, 1, At, B1); PG8_BAR;
            }
        }
        if constexpr (ALIGN_EPI) { if (wr == 0) PG8_BAR; }
        if constexpr (!Epi::AFTER_DRAIN) { E(acc, cur, wr, wc, fr, fq); S.done(cur); }
        if (!has_next) break;
#pragma unroll
        for (int a = 0; a < 2; ++a)
#pragma unroll
            for (int b = 0; b < 2; ++b)
#pragma unroll
                for (int m = 0; m < 4; ++m)
#pragma unroll
                    for (int n = 0; n < 2; ++n) acc[a][b][m][n] = (f32x4){0.f, 0.f, 0.f, 0.f};
        cur = nxt; cA = nA; cB = nB; ++ui;
        if constexpr (ALIGN_EPI) { if (wr == 1) PG8_BAR; }
    }
    PG8_WAIT_V(0);
    if constexpr (!ALIGN_EPI) { if (wr == 0) PG8_BAR; }
    PG8_BAR;
    if constexpr (Epi::AFTER_DRAIN) { E.fused(acc, cur, wr, wc, fr, fq, lds, wid, lane); S.done(cur); }
#undef PG8_SA
#undef PG8_SB
#undef PG8_STAGE
#undef PG8_LDA
#undef PG8_LDB
#undef PG8_MMA
#undef PG8_WAIT_V
#undef PG8_WAIT_L
#undef PG8_BAR
#undef PG8_SCHED
}
}

template <class RowMap, class Epi>
__device__ __forceinline__ void gemm_tile_f32(float* lds, const float* __restrict__ A, int lda, RowMap rowmap, int nvalid,
                                              const float* __restrict__ B, int ldb, int col0, int N, int K, Epi epi) {
    float* As = lds;
    float* Bs = lds + 128 * 17;
    const int tid = ltid(), lane = tid & 63, wid = tid >> 6, wm = wid & 3, wn = wid >> 2;
    const int arow = tid >> 2, akq = (tid & 3) * 4;
    const int src = (arow < nvalid) ? rowmap(arow) : -1;
    const float* ap = A + (size_t)(src < 0 ? 0 : src) * lda + akq;
    const int bk = tid >> 5, bn = (tid & 31) * 4;
    const bool bok = (col0 + bn) < N;
    const float* bp = B + (size_t)bk * ldb + col0 + bn;
    f32x16 acc0 = {}, acc1 = {};
    for (int k0 = 0; k0 < K; k0 += 16) {
        pg8::f32x4 av = (pg8::f32x4){0.f, 0.f, 0.f, 0.f}, bv = (pg8::f32x4){0.f, 0.f, 0.f, 0.f};
        if (src >= 0) av = *(const pg8::f32x4*)(ap + k0);
        if (bok) bv = *(const pg8::f32x4*)(bp + (size_t)k0 * ldb);
        __syncthreads();
        As[arow * 17 + akq + 0] = av[0]; As[arow * 17 + akq + 1] = av[1]; As[arow * 17 + akq + 2] = av[2]; As[arow * 17 + akq + 3] = av[3];
        *(pg8::f32x4*)(Bs + bk * 132 + bn) = bv;
        __syncthreads();
#pragma unroll
        for (int kk = 0; kk < 16; kk += 2) {
            const float a = As[(32 * wm + (lane & 31)) * 17 + kk + (lane >> 5)];
            const float b0 = Bs[(kk + (lane >> 5)) * 132 + 64 * wn + (lane & 31)];
            const float b1 = Bs[(kk + (lane >> 5)) * 132 + 64 * wn + 32 + (lane & 31)];
            acc0 = __builtin_amdgcn_mfma_f32_32x32x2f32(a, b0, acc0, 0, 0, 0);
            acc1 = __builtin_amdgcn_mfma_f32_32x32x2f32(a, b1, acc1, 0, 0, 0);
        }
    }
#pragma unroll
    for (int r = 0; r < 16; ++r) {
        const int i = 32 * wm + (r & 3) + 8 * (r >> 2) + 4 * (lane >> 5);
        const int c0 = col0 + 64 * wn + (lane & 31);
        if (i < nvalid) {
            if (c0 < N) epi(i, c0, acc0[r]);
            if (c0 + 32 < N) epi(i, c0 + 32, acc1[r]);
        }
    }
}

#include <hip/hip_bf16.h>
namespace attn_body {
using bf16=__hip_bfloat16;
using bf16x8=__attribute__((ext_vector_type(8)))short;
using s16x4=__attribute__((ext_vector_type(4)))short;
using f32x16=__attribute__((ext_vector_type(16)))float;
using u32x4=__attribute__((ext_vector_type(4)))unsigned;
typedef float f32x4_t __attribute__((ext_vector_type(4)));
constexpr int BATCH=2,NHEAD=8,SEQ=16384,D=64,DM=3584,OP=1024;
constexpr int NW=8,QBLK=32,QB=QBLK*NW,KVBLK=64,NQB=SEQ/QB;
constexpr int ATTN_PITCH=DM, ATTN_UNIT_ROWS=QB;
__device__ __forceinline__ int crow(int r,int hi){return (r&3)+8*(r>>2)+4*hi;}
#define SBAR() __builtin_amdgcn_sched_barrier(0)
__device__ __forceinline__ void cmask(f32x16&p0,f32x16&p1,int jb,int qrel,int hi){
  const float NEG=-INFINITY; int kb=64*jb+4*hi;
  #pragma unroll
  for(int r=0;r<16;++r){int kv=kb+(r&3)+8*(r>>2); if(kv>qrel)p0[r]=NEG; if(kv+32>qrel)p1[r]=NEG;}
}

constexpr int NSLOT=3, SLOTB=8192;
constexpr int LDS_K=0, LDS_V=NSLOT*SLOTB, LDS_WS=2*NSLOT*SLOTB, LDS_OST=LDS_WS+NW*64*4, LDS_BYTES=LDS_OST+NW*4096;
constexpr float C2=0.125f*1.4426950408889634f;
__device__ __forceinline__ void glds16(const void*gsrc,unsigned lds_dst){unsigned keep;
  asm volatile("s_mov_b32 %0, m0\n\ts_mov_b32 m0, %2\n\ts_nop 0\n\tglobal_load_lds_dwordx4 %1, off\n\ts_mov_b32 m0, %0":"=&s"(keep):"v"(gsrc),"s"(lds_dst):"memory");}
__device__ __forceinline__ float max3f(float a,float b,float c){float r;asm("v_max3_f32 %0, %1, %2, %3":"=v"(r):"v"(a),"v"(b),"v"(c));return r;}
__device__ __forceinline__ float max2f(float a,float b){float r;asm("v_max_f32_e32 %0, %1, %2":"=v"(r):"v"(a),"v"(b));return r;}
__device__ __forceinline__ float fadd_s(float a,float b){float r;asm("v_add_f32_e32 %0, %1, %2":"=v"(r):"v"(a),"v"(b));return r;}
__device__ __forceinline__ float fsub_s(float a,float b){float r;asm("v_sub_f32_e32 %0, %1, %2":"=v"(r):"v"(a),"v"(b));return r;}
typedef float f32x2_t __attribute__((ext_vector_type(2))); typedef __bf16 bf16x2_t __attribute__((ext_vector_type(2)));
__device__ __forceinline__ unsigned cvtpk_s(float lo,float hi){f32x2_t v={lo,hi};bf16x2_t b=__builtin_convertvector(v,bf16x2_t);return __builtin_bit_cast(unsigned,b);}
#define WAIT_BAR(N) asm volatile("s_waitcnt vmcnt(" #N ") lgkmcnt(0)\n\ts_barrier":::"memory")

__device__ __forceinline__ void qkt(f32x16&p0,f32x16&p1,const char*Kslot,const bf16x8*qr,int r32,int hi){
  const char*kb=Kslot+hi*1024+r32*16;
  #pragma unroll
  for(int d0=0;d0<4;++d0){
    const bf16x8 b0=*reinterpret_cast<const bf16x8*>(kb+d0*2048);
    const bf16x8 b1=*reinterpret_cast<const bf16x8*>(kb+d0*2048+512);
    p0=__builtin_amdgcn_mfma_f32_32x32x16_bf16(b0,qr[d0],p0,0,0,0);p1=__builtin_amdgcn_mfma_f32_32x32x16_bf16(b1,qr[d0],p1,0,0,0);}
}
typedef __attribute__((address_space(3))) const char* lds_cptr;
typedef short v4i16_t __attribute__((ext_vector_type(4)));
__device__ __forceinline__ void kload8(bf16x8*kf,lds_cptr kp){
  kf[0]=*(const __attribute__((address_space(3))) bf16x8*)(kp);      kf[1]=*(const __attribute__((address_space(3))) bf16x8*)(kp+512);
  kf[2]=*(const __attribute__((address_space(3))) bf16x8*)(kp+2048); kf[3]=*(const __attribute__((address_space(3))) bf16x8*)(kp+2560);
  kf[4]=*(const __attribute__((address_space(3))) bf16x8*)(kp+4096); kf[5]=*(const __attribute__((address_space(3))) bf16x8*)(kp+4608);
  kf[6]=*(const __attribute__((address_space(3))) bf16x8*)(kp+6144); kf[7]=*(const __attribute__((address_space(3))) bf16x8*)(kp+6656);
}
__device__ __forceinline__ void kload2(bf16x8*kf,lds_cptr kp,int j){ kf[2*j]=*(const __attribute__((address_space(3))) bf16x8*)(kp+j*2048); kf[2*j+1]=*(const __attribute__((address_space(3))) bf16x8*)(kp+j*2048+512); }
__device__ __forceinline__ s16x4 vtr(lds_cptr p){ return __builtin_bit_cast(s16x4,__builtin_amdgcn_ds_read_tr16_b64_v4i16((__attribute__((address_space(3))) v4i16_t*)p)); }
__device__ __forceinline__ float rowmax(const f32x16&p0,const f32x16&p1){
  float a=max3f(p0[0],p0[1],p1[0]),b=max3f(p0[2],p0[3],p1[1]);a=max3f(a,p1[2],p1[3]);
  #pragma unroll
  for(int r=4;r<16;r+=4){a=max3f(a,p0[r],p0[r+1]);b=max3f(b,p0[r+2],p0[r+3]);a=max3f(a,p1[r],p1[r+1]);b=max3f(b,p1[r+2],p1[r+3]);}
  const float m=max2f(a,b);
  auto rr=__builtin_amdgcn_permlane32_swap(__float_as_uint(m),__float_as_uint(m),false,false);
  return max2f(__uint_as_float(rr[0]),__uint_as_float(rr[1]));
}
__device__ __forceinline__ void pv(f32x16*o,int vb,bf16x8 pa0,bf16x8 pa1,bf16x8 pa2,bf16x8 pa3){
  #pragma unroll
  for(int d0=0;d0<2;++d0){s16x4 lo[4],hi[4];
    #pragma unroll
    for(int ks=0;ks<4;++ks){
      asm volatile("ds_read_b64_tr_b16 %0,%1 offset:%c2":"=&v"(lo[ks]):"v"(vb),"i"(d0*4096+ks*1024):"memory");
      asm volatile("ds_read_b64_tr_b16 %0,%1 offset:%c2":"=&v"(hi[ks]):"v"(vb),"i"(d0*4096+ks*1024+512):"memory");}
    asm volatile("s_waitcnt lgkmcnt(0)":::"memory");SBAR();
    #define PK(k) (bf16x8){lo[k][0],lo[k][1],lo[k][2],lo[k][3],hi[k][0],hi[k][1],hi[k][2],hi[k][3]}
    o[d0]=__builtin_amdgcn_mfma_f32_32x32x16_bf16(pa0,PK(0),o[d0],0,0,0);
    o[d0]=__builtin_amdgcn_mfma_f32_32x32x16_bf16(pa1,PK(1),o[d0],0,0,0);
    o[d0]=__builtin_amdgcn_mfma_f32_32x32x16_bf16(pa2,PK(2),o[d0],0,0,0);
    o[d0]=__builtin_amdgcn_mfma_f32_32x32x16_bf16(pa3,PK(3),o[d0],0,0,0);
    #undef PK
  }
}

#ifndef ATTN_STORE16
#define ATTN_STORE16(p,v) (*(u32x4*)(p)=(v))
#endif
template<int THRL> __device__ __forceinline__ void attn_unit(int b,int h,int qb,int t0,const bf16*Q,const bf16*__restrict__ K,const bf16*__restrict__ V,bf16*O,const unsigned char*KAg,char*shm){
  const int tid=ltid(),lane=tid&63,r32=lane&31,hi=lane>>5; const int wid=__builtin_amdgcn_readfirstlane(tid>>6);
  const long rowbase=(long)b*SEQ; const int q0=qb*QB;
  const bf16*Qw=Q+(rowbase+q0+wid*QBLK)*DM+h*D;
  const bf16*Kh=K+(rowbase+(long)t0*KVBLK)*DM+h*D,*Vh=V+(rowbase+(long)t0*KVBLK)*DM+h*D;
  const unsigned lds0=(unsigned)(uintptr_t)shm;
  float*wsf=(float*)(shm+LDS_WS)+wid*64;
  const bf16*ksrc=Kh+(long)lane*DM+wid*8;
  const bf16*vsrc=Vh+(long)(16*(wid&3)+(lane>>2))*DM+(wid>>2)*32+(lane&3)*8;
  const unsigned kdst=lds0+LDS_K+wid*1024, vdst=lds0+LDS_V+wid*1024;
  #define DMA_K(t,slot) glds16(ksrc+(long)(t)*KVBLK*DM,(unsigned)__builtin_amdgcn_readfirstlane(kdst+(slot)))
  #define DMA_V(t,slot) glds16(vsrc+(long)(t)*KVBLK*DM,(unsigned)__builtin_amdgcn_readfirstlane(vdst+(slot)))
  const int vb0=(int)(lds0+LDS_V)+((lane>>4)&1)*32+(lane&3)*8+(4*hi+((lane&15)>>2))*64;
  const char*Kbase=shm+LDS_K; bf16x8 kf[8];
  const lds_cptr shm3=(lds_cptr)shm; const lds_cptr kp0=shm3+LDS_K+hi*1024+r32*16; const lds_cptr vp0=shm3+LDS_V+((lane>>4)&1)*32+(lane&3)*8+(4*hi+((lane&15)>>2))*64;
  const int NT=(q0+QB)/KVBLK-t0;
  u32x4 ka0,ka1; u32x4 qaw;
  const unsigned kavoff=(unsigned)r32*16u;
  const unsigned long long kab0=(unsigned long long)(uintptr_t)KAg+((unsigned long long)((b*NHEAD+h)*(long)SEQ+(long)t0*KVBLK))*16ull;
  #define KA_LOAD(t) do{ const unsigned long long a_=kab0+(unsigned long long)(t)*1024ull; const unsigned lo_=__builtin_amdgcn_readfirstlane((unsigned)a_),hi_=__builtin_amdgcn_readfirstlane((unsigned)(a_>>32)); \
    const unsigned long long sb_=((unsigned long long)hi_<<32)|lo_; \
    asm volatile("s_nop 4\n\tglobal_load_dwordx4 %0, %2, %3\n\tglobal_load_dwordx4 %1, %2, %3 offset:512":"=&v"(ka0),"=&v"(ka1):"v"(kavoff),"s"(sb_):"memory"); }while(0)
  #define QA_SET() do{ const float nm_=-mhat; const unsigned h_=cvtpk_s(nm_,0.f)&0xffffu; const float r1_=nm_-__uint_as_float(h_<<16); const unsigned m_=cvtpk_s(r1_,0.f)&0xffffu; \
    const float r2_=r1_-__uint_as_float(m_<<16); const unsigned l_=cvtpk_s(r2_,0.f)&0xffffu; \
    qaw[0]=hi?0u:0x3f803f80u; qaw[1]=hi?0u:(0x3f80u|(h_<<16)); qaw[2]=hi?0u:(m_|(l_<<16)); qaw[3]=0u; asm volatile("":"+v"(qaw)); }while(0)
  #define AUG(C0,C1) do{ C0=__builtin_amdgcn_mfma_f32_32x32x16_bf16(__builtin_bit_cast(bf16x8,ka0),__builtin_bit_cast(bf16x8,qaw),f32x16{},0,0,0); \
    C1=__builtin_amdgcn_mfma_f32_32x32x16_bf16(__builtin_bit_cast(bf16x8,ka1),__builtin_bit_cast(bf16x8,qaw),f32x16{},0,0,0); }while(0)
  #define PIN_KA() asm volatile("; KA landed":"+v"(ka0),"+v"(ka1)::"memory")
  #define WAIT_BAR_KA(N) do{ WAIT_BAR(N); PIN_KA(); }while(0)
  KA_LOAD(0);
  DMA_K(0,0);DMA_V(0,0);DMA_K(1,SLOTB);
  bf16x8 qr[4];
  #pragma unroll
  for(int d0=0;d0<4;++d0)qr[d0]=*reinterpret_cast<const bf16x8*>(&Qw[(long)r32*DM+d0*16+hi*8]);
  float mhat=0.f,l_reg=0.f;f32x16 o[2];o[0]=f32x16{};o[1]=f32x16{}; QA_SET();
  const int qrel=wid*QBLK+r32;
  #define CMASK(P0,P1,t) do{int jb_=(t)-(NT-4); if(jb_>=0)cmask(P0,P1,jb_,qrel,hi);}while(0)
  bool resc=false;
  #define START(P0,P1) do{ const float rm=rowmax(P0,P1); resc=false; \
    { const float dl=rm; mhat=fadd_s(mhat,dl); \
      _Pragma("unroll") for(int r=0;r<16;++r){P0[r]=fsub_s(P0[r],dl);P1[r]=fsub_s(P1[r],dl);} \
      QA_SET(); } \
    _Pragma("unroll") for(int r=0;r<16;++r)P0[r]=__builtin_amdgcn_exp2f(P0[r]); }while(0)
  #define RESC() do{ if(resc){ asm volatile("s_waitcnt lgkmcnt(0)":::"memory"); \
      _Pragma("unroll") for(int d_=0;d_<2;++d_) _Pragma("unroll") for(int r=0;r<16;++r)o[d_][r]*=wsf[crow(r,hi)]; } }while(0)
  f32x16 pA0,pA1,pB0,pB1;
  int sl_prev=0,sl_cur=0,sl_next=SLOTB;
  #define ROT() do{sl_prev=sl_cur;sl_cur=sl_next;sl_next=(sl_next==(NSLOT-1)*SLOTB)?0:sl_next+SLOTB;}while(0)
  DMA_K(2,2*SLOTB);
  WAIT_BAR_KA(3);
  AUG(pA0,pA1); qkt(pA0,pA1,Kbase,qr,r32,hi);asm volatile("s_nop 15\n\ts_nop 7":"+v"(pA0),"+v"(pA1));CMASK(pA0,pA1,0);
  START(pA0,pA1);
  _Pragma("unroll") for(int r=0;r<16;++r)pA1[r]=__builtin_amdgcn_exp2f(pA1[r]);
  WAIT_BAR(0);
  KA_LOAD(1);DMA_K(3,0);DMA_V(1,SLOTB);
  ROT();
  kload8(kf,kp0+sl_cur);
  WAIT_BAR_KA(2);
  s16x4 vlo[8],vhi[8]; u32x4 pw0,pw1,pw2,pw3;
  #define PKW(P,B) cvtpk_s(P[B],P[B+1])
  #define PAF(k) __builtin_bit_cast(bf16x8,pw##k)
  #define VFR(i) (bf16x8){vlo[i][0],vlo[i][1],vlo[i][2],vlo[i][3],vhi[i][0],vhi[i][1],vhi[i][2],vhi[i][3]}
  #define PIN(x) asm volatile("":"+v"(x))
  #define MX3(a,b,c) __builtin_fmaxf(__builtin_fmaxf((a),(b)),(c))
  #define GAPA(MF,A0,A1,A2,A3,W0,W1,PW) do{ MF; sacc+=A0; sacc+=A1; sacc+=A2; sacc+=A3; PIN(sacc); W0; W1; PIN(PW); SBAR(); }while(0)
  #define EX(v) __builtin_amdgcn_exp2f(v)
  #define GAPB(MF,X,B) do{ MF; X[B]=EX(X[B]); X[B+1]=EX(X[B+1]); X[B+2]=EX(X[B+2]); X[B+3]=EX(X[B+3]); PIN(X); SBAR(); }while(0)
  #define VRD(i) do{ vlo[i]=vtr(vp_+(((i)>>2)*4096+((i)&3)*1024)); vhi[i]=vtr(vp_+(((i)>>2)*4096+((i)&3)*1024+512)); }while(0)
  #define KRD(G,j) do{ if(G){ kload2(kf,kp0+sl_next,j); SBAR(); } }while(0)
  #define STEP(C0,C1,P0,P1,t,GK,GV,GL) do{ SBAR(); \
    const lds_cptr vp_=vp0+sl_prev; \
    AUG(C0,C1); SBAR(); \
    VRD(0); SBAR(); float sacc=(P0[0]+P0[1]); \
    GAPA(C0=__builtin_amdgcn_mfma_f32_32x32x16_bf16(kf[0],qr[0],C0,0,0,0), P0[2],P0[3],P0[4],P0[5],     pw0[0]=PKW(P0,0), pw0[1]=PKW(P0,2), pw0); \
    VRD(4); SBAR(); GAPA(C1=__builtin_amdgcn_mfma_f32_32x32x16_bf16(kf[1],qr[0],C1,0,0,0), P0[6],P0[7],P0[8],P0[9],     pw0[2]=PKW(P0,4), pw0[3]=PKW(P0,6), pw0); \
    VRD(1); SBAR(); GAPA(C0=__builtin_amdgcn_mfma_f32_32x32x16_bf16(kf[2],qr[1],C0,0,0,0),   P0[10],P0[11],P0[12],P0[13], pw1[0]=PKW(P0,8), pw1[1]=PKW(P0,10), pw1); \
    VRD(5); SBAR(); GAPA(C1=__builtin_amdgcn_mfma_f32_32x32x16_bf16(kf[3],qr[1],C1,0,0,0),   P0[14],P0[15],P1[0],P1[1],   pw1[2]=PKW(P0,12),pw1[3]=PKW(P0,14), pw1); \
    VRD(2); SBAR(); GAPA(C0=__builtin_amdgcn_mfma_f32_32x32x16_bf16(kf[4],qr[2],C0,0,0,0),   P1[2],P1[3],P1[4],P1[5],     pw2[0]=PKW(P1,0), pw2[1]=PKW(P1,2), pw2); \
    VRD(6); SBAR(); GAPA(C1=__builtin_amdgcn_mfma_f32_32x32x16_bf16(kf[5],qr[2],C1,0,0,0),   P1[6],P1[7],P1[8],P1[9],     pw2[2]=PKW(P1,4), pw2[3]=PKW(P1,6), pw2); \
    VRD(3); SBAR(); GAPA(C0=__builtin_amdgcn_mfma_f32_32x32x16_bf16(kf[6],qr[3],C0,0,0,0),   P1[10],P1[11],P1[12],P1[13], pw3[0]=PKW(P1,8), pw3[1]=PKW(P1,10), pw3); \
    VRD(7); SBAR(); GAPA(C1=__builtin_amdgcn_mfma_f32_32x32x16_bf16(kf[7],qr[3],C1,0,0,0),   P1[14],P1[15],0.f,0.f,       pw3[2]=PKW(P1,12),pw3[3]=PKW(P1,14), pw3); \
    l_reg+=sacc; \
    if(GL){KA_LOAD((t)+1);} if(GK){DMA_K((t)+3,sl_cur);} if(GV){DMA_V((t)+1,sl_next);} \
    CMASK(C0,C1,t); \
    { float a=MX3(C0[0],C0[1],C1[0]),b=MX3(C0[2],C0[3],C1[1]); a=MX3(a,C1[2],C1[3]); \
      _Pragma("unroll") for(int r=4;r<16;r+=4){a=MX3(a,C0[r],C0[r+1]);b=MX3(b,C0[r+2],C0[r+3]);a=MX3(a,C1[r],C1[r+1]);b=MX3(b,C1[r+2],C1[r+3]);} \
      float rm=__builtin_fmaxf(a,b); { auto rr=__builtin_amdgcn_permlane32_swap(__float_as_uint(rm),__float_as_uint(rm),false,false); rm=__builtin_fmaxf(__uint_as_float(rr[0]),__uint_as_float(rr[1])); } \
      resc=false; \
      if(__builtin_expect(__any(rm>(float)THRL),0)){ const float dl=__builtin_fmaxf(rm,0.f); mhat+=dl; \
        _Pragma("unroll") for(int r=0;r<16;++r){C0[r]-=dl;C1[r]-=dl;} \
        QA_SET(); \
        const float f=__builtin_amdgcn_exp2f(-dl); l_reg*=f; if(hi==0)wsf[r32]=f; resc=true; } } \
    SBAR(); \
    GAPB(o[0]=__builtin_amdgcn_mfma_f32_32x32x16_bf16(PAF(0),VFR(0),o[0],0,0,0), C0,0); \
    GAPB(o[1]=__builtin_amdgcn_mfma_f32_32x32x16_bf16(PAF(0),VFR(4),o[1],0,0,0), C0,4); \
    KRD(GL,0); GAPB(o[0]=__builtin_amdgcn_mfma_f32_32x32x16_bf16(PAF(1),VFR(1),o[0],0,0,0), C0,8); \
    KRD(GL,1); GAPB(o[1]=__builtin_amdgcn_mfma_f32_32x32x16_bf16(PAF(1),VFR(5),o[1],0,0,0), C0,12); \
    KRD(GL,2); GAPB(o[0]=__builtin_amdgcn_mfma_f32_32x32x16_bf16(PAF(2),VFR(2),o[0],0,0,0), C1,0); \
    KRD(GL,3); GAPB(o[1]=__builtin_amdgcn_mfma_f32_32x32x16_bf16(PAF(2),VFR(6),o[1],0,0,0), C1,4); \
    GAPB(o[0]=__builtin_amdgcn_mfma_f32_32x32x16_bf16(PAF(3),VFR(3),o[0],0,0,0), C1,8); \
    GAPB(o[1]=__builtin_amdgcn_mfma_f32_32x32x16_bf16(PAF(3),VFR(7),o[1],0,0,0), C1,12); \
    }while(0)
  int t=1;
  #undef CMASK
  #define CMASK(P0,P1,t) do{}while(0)
  for(;t+5<NT;t+=2){
    STEP(pB0,pB1,pA0,pA1,t,true,true,true);     WAIT_BAR_KA(2); RESC(); ROT();
    STEP(pA0,pA1,pB0,pB1,t+1,true,true,true);   WAIT_BAR_KA(2); RESC(); ROT();
  }
  #undef CMASK
  #define CMASK(P0,P1,t) do{int jb_=(t)-(NT-4); if(jb_>=0)cmask(P0,P1,jb_,qrel,hi);}while(0)
  #define ENDW(tt) do{ if((tt)+3<NT){WAIT_BAR(2);} else if((tt)+2<NT){WAIT_BAR(1);} else {WAIT_BAR(0);} PIN_KA(); }while(0)
  for(;t+1<NT;t+=2){
    STEP(pB0,pB1,pA0,pA1,t,(t+3<NT),(t+1<NT),(t+1<NT));       ENDW(t);   RESC(); ROT();
    STEP(pA0,pA1,pB0,pB1,t+1,(t+4<NT),(t+2<NT),(t+2<NT));     ENDW(t+1); RESC(); ROT();
  }
  STEP(pB0,pB1,pA0,pA1,NT-1,false,false,false); RESC();
  { float sacc=pB0[0]+pB0[1]; _Pragma("unroll") for(int r=2;r<16;++r)sacc+=pB0[r]; _Pragma("unroll") for(int r=0;r<16;++r)sacc+=pB1[r]; l_reg+=sacc;
    pw0=(u32x4){PKW(pB0,0),PKW(pB0,2),PKW(pB0,4),PKW(pB0,6)};pw1=(u32x4){PKW(pB0,8),PKW(pB0,10),PKW(pB0,12),PKW(pB0,14)};pw2=(u32x4){PKW(pB1,0),PKW(pB1,2),PKW(pB1,4),PKW(pB1,6)};pw3=(u32x4){PKW(pB1,8),PKW(pB1,10),PKW(pB1,12),PKW(pB1,14)};
    SBAR(); pv(o,vb0+sl_cur,PAF(0),PAF(1),PAF(2),PAF(3)); }
  #undef PKW
  #undef PAF
  #undef VFR
  #undef PIN
  #undef MX3
  #undef GAPA
  #undef GAPB
  #undef EX
  #undef VRD
  #undef KRD
  #undef STEP
  #undef ENDW
  {auto rr=__builtin_amdgcn_permlane32_swap(__float_as_uint(l_reg),__float_as_uint(l_reg),false,false);l_reg=__uint_as_float(rr[0])+__uint_as_float(rr[1]);}
  if(hi==0)wsf[32+r32]=l_reg;asm volatile("s_waitcnt lgkmcnt(0)":::"memory");
  float rli[16];
  #pragma unroll
  for(int r=0;r<16;++r)rli[r]=__builtin_amdgcn_rcpf(wsf[32+crow(r,hi)]);
  bf16*Ow=O+(rowbase+q0+wid*QBLK)*OP+h*D;
  { bf16*stg=(bf16*)(shm+LDS_OST)+wid*2048;
    #pragma unroll
    for(int r=0;r<16;++r){const int orow=crow(r,hi);
      #pragma unroll
      for(int d0=0;d0<2;++d0)stg[orow*64+d0*32+r32]=__float2bfloat16(o[d0][r]*rli[r]);}
    asm volatile("s_waitcnt lgkmcnt(0)":::"memory");
    #pragma unroll
    for(int i=0;i<4;++i){const int row=i*8+(lane>>3),ch=lane&7; const u32x4 v=*(const u32x4*)(stg+row*64+ch*8); ATTN_STORE16(Ow+(long)row*OP+ch*8,v);} }
  asm volatile("s_waitcnt lgkmcnt(0)\n\ts_barrier":::"memory");
  #undef DMA_K
  #undef DMA_V
  #undef KA_LOAD
  #undef QA_SET
  #undef AUG
  #undef WAIT_BAR_KA
  #undef PIN_KA
  #undef CMASK
  #undef START
  #undef RESC
  #undef ROT
}
constexpr int ATTN_LDS_BYTES=LDS_BYTES;
struct AttnTensors { const bf16* Q; const bf16* K; const bf16* V; bf16* O; const unsigned char* KA; };
struct AttnUnit { int bh; int qb; };
struct StaticOrder {
  int vcu;
  __device__ __forceinline__ explicit StaticOrder(int grid,int block):vcu((block%8)*(grid/8)+block/8){}
  __device__ __forceinline__ bool next(int i,AttnUnit&u)const{ if(i>=4)return false; const int s=vcu&15; u.bh=vcu>>4; u.qb=(i==0)?63-s:(i==1)?32+s:(i==2)?31-s:s; return true; }
  __device__ __forceinline__ void a_ready(const AttnUnit&)const{}
  __device__ __forceinline__ void done(const AttnUnit&)const{}
};
template<class Sched,int THRL=8> __device__ __forceinline__ void attn_phase(char*lds,const AttnTensors&T,const Sched&S){
  AttnUnit u;
  for(int i=0;S.next(i,u);++i){ S.a_ready(u); attn_unit<THRL>(u.bh/NHEAD,u.bh%NHEAD,u.qb,0,T.Q,T.K,T.V,T.O,T.KA,lds); S.done(u); }
}
#undef SBAR
#undef WAIT_BAR
}

namespace ck {
#define CK_LAS __attribute__((address_space(3)))
typedef unsigned short bf16_t;
typedef short bf16x8 __attribute__((ext_vector_type(8)));
typedef float f32x16 __attribute__((ext_vector_type(16)));
typedef float f32x4 __attribute__((ext_vector_type(4)));
typedef unsigned u32x4 __attribute__((ext_vector_type(4)));
typedef unsigned u32x2 __attribute__((ext_vector_type(2)));
typedef CK_LAS unsigned short* lbf;
typedef CK_LAS float* lf32;
constexpr int SB = 72;
constexpr int B9 = 64 * SB * 2;
constexpr int SF = 65;
constexpr int SM = 68;
constexpr int SX = 132;
__device__ __forceinline__ unsigned f2bf(float f) { unsigned u = __builtin_bit_cast(unsigned, f); return (u + 0x7fffu + ((u >> 16) & 1u)) >> 16; }
__device__ __forceinline__ unsigned pk2(float lo, float hi) { return f2bf(lo) | (f2bf(hi) << 16); }
__device__ __forceinline__ float bflo(unsigned w) { return __builtin_bit_cast(float, w << 16); }
__device__ __forceinline__ float bfhi(unsigned w) { return __builtin_bit_cast(float, w & 0xffff0000u); }
__device__ __forceinline__ int crow(int reg, int hh) { return (reg & 3) + 8 * (reg >> 2) + 4 * hh; }
__device__ __forceinline__ f32x16 mm_lds(lbf A, lbf BT, int I, int J, int lane, f32x16 acc) {
    const int r = lane & 31, hh = lane >> 5;
    const lbf ap = A + (32 * I + r) * SB + 8 * hh; const lbf bp = BT + (32 * J + r) * SB + 8 * hh;
#pragma unroll
    for (int s = 0; s < 4; ++s) { const bf16x8 a = *(const CK_LAS bf16x8*)(ap + 16 * s); const bf16x8 b = *(const CK_LAS bf16x8*)(bp + 16 * s); acc = __builtin_amdgcn_mfma_f32_32x32x16_bf16(a, b, acc, 0, 0, 0); }
    return acc;
}
__device__ __forceinline__ f32x16 mm_gA(const bf16_t* __restrict__ Ag, lbf BT, int I, int J, int lane, f32x16 acc) {
    const int r = lane & 31, hh = lane >> 5;
    bf16x8 a[4];
#pragma unroll
    for (int s = 0; s < 4; ++s) a[s] = *(const bf16x8*)(Ag + (32 * I + r) * 64 + 16 * s + 8 * hh);
    const lbf bp = BT + (32 * J + r) * SB + 8 * hh;
#pragma unroll
    for (int s = 0; s < 4; ++s) { const bf16x8 b = *(const CK_LAS bf16x8*)(bp + 16 * s); acc = __builtin_amdgcn_mfma_f32_32x32x16_bf16(a[s], b, acc, 0, 0, 0); }
    return acc;
}
__device__ __forceinline__ f32x16 mm_gg(const bf16_t* __restrict__ Ag, const bf16_t* __restrict__ BTg, int I, int J, int lane, f32x16 acc) {
    const int r = lane & 31, hh = lane >> 5;
#pragma unroll
    for (int s = 0; s < 4; ++s) { const bf16x8 a = *(const bf16x8*)(Ag + (32 * I + r) * 64 + 16 * s + 8 * hh); const bf16x8 b = *(const bf16x8*)(BTg + (32 * J + r) * 64 + 16 * s + 8 * hh);
        acc = __builtin_amdgcn_mfma_f32_32x32x16_bf16(a, b, acc, 0, 0, 0); }
    return acc;
}
__device__ __forceinline__ void frag_store(float* __restrict__ g, int wq, int lane, const f32x16& acc) {
    f32x4* p = (f32x4*)(g + ((size_t)(wq * 64 + lane)) * 16);
    p[0] = (f32x4){acc[0], acc[1], acc[2], acc[3]}; p[1] = (f32x4){acc[4], acc[5], acc[6], acc[7]}; p[2] = (f32x4){acc[8], acc[9], acc[10], acc[11]}; p[3] = (f32x4){acc[12], acc[13], acc[14], acc[15]};
}
__device__ __forceinline__ f32x16 frag_load(const float* __restrict__ g, int wq, int lane) {
    const f32x4* p = (const f32x4*)(g + ((size_t)(wq * 64 + lane)) * 16); const f32x4 a = p[0], b = p[1], c = p[2], d = p[3];
    return (f32x16){a[0], a[1], a[2], a[3], b[0], b[1], b[2], b[3], c[0], c[1], c[2], c[3], d[0], d[1], d[2], d[3]};
}
__device__ __forceinline__ void frag_store_bf(bf16_t* __restrict__ g, int wq, int lane, const f32x16& acc) {
    u32x4* p = (u32x4*)(g + ((size_t)(wq * 64 + lane)) * 16);
    p[0] = (u32x4){pk2(acc[0], acc[1]), pk2(acc[2], acc[3]), pk2(acc[4], acc[5]), pk2(acc[6], acc[7])}; p[1] = (u32x4){pk2(acc[8], acc[9]), pk2(acc[10], acc[11]), pk2(acc[12], acc[13]), pk2(acc[14], acc[15])};
}
__device__ __forceinline__ f32x16 frag_load_bf(const bf16_t* __restrict__ g, int wq, int lane) {
    const u32x4* p = (const u32x4*)(g + ((size_t)(wq * 64 + lane)) * 16); const u32x4 a = p[0], b = p[1];
    return (f32x16){bflo(a[0]), bfhi(a[0]), bflo(a[1]), bfhi(a[1]), bflo(a[2]), bfhi(a[2]), bflo(a[3]), bfhi(a[3]), bflo(b[0]), bfhi(b[0]), bflo(b[1]), bfhi(b[1]), bflo(b[2]), bfhi(b[2]), bflo(b[3]), bfhi(b[3])};
}
__device__ __forceinline__ void tile_store_T(lbf dst, int I, int J, int lane, const f32x16& acc) {
    const int r = lane & 31, hh = lane >> 5;
#pragma unroll
    for (int g = 0; g < 4; ++g) { u32x2 w; w.x = pk2(acc[4 * g], acc[4 * g + 1]); w.y = pk2(acc[4 * g + 2], acc[4 * g + 3]);
        *(CK_LAS u32x2*)(dst + (32 * J + r) * SB + 32 * I + 8 * g + 4 * hh) = w; }
}
__device__ __forceinline__ float fexp(float x) { return __builtin_amdgcn_exp2f(x * 1.4426950408889634f); }
__device__ __forceinline__ float sigm(float x) { return __builtin_amdgcn_rcpf(1.0f + fexp(-x)); }
__device__ __forceinline__ float ftanh(float x) { const float xc = fminf(fmaxf(x, -15.f), 15.f); return 1.0f - 2.0f * __builtin_amdgcn_rcpf(fexp(2.0f * xc) + 1.0f); }
__device__ __forceinline__ float logsig(float x) { const float ax = fabsf(x); return fminf(x, 0.f) - 0.6931471805599453f * __builtin_amdgcn_logf(1.0f + fexp(-ax)); }
template <int CTRL> __device__ __forceinline__ float dpp_f(float v) { return __builtin_bit_cast(float, __builtin_amdgcn_update_dpp(0, __builtin_bit_cast(int, v), CTRL, 0xf, 0xf, false)); }
__device__ __forceinline__ float quad_sum(float v) { v += dpp_f<0xB1>(v); v += dpp_f<0x4E>(v); return v; }

constexpr size_t O_PC = 0, O_QC = 16u << 20, O_GY = 48u << 20, O_YL = 64u << 20, O_VG = 96u << 20, O_GG = 112u << 20, O_H0 = 128u << 20, O_RKD = 144u << 20, O_KV = 145u << 20, O_RT = 177u << 20, O_END = 193u << 20;
struct RwkvParams {
    const float *mu_rkv, *mu_lora, *w0, *a0, *k_k, *k_a, *r_k, *ln_g, *ln_b, *gn_g;
    const bf16_t *w2t, *a2t, *g2t;
};

constexpr int L_U = 10 * B9, L_MM = L_U + 36864, L_GL = L_MM + 64 * SM * 4, L_END1 = L_GL + 256;
__device__ __forceinline__ void rwkv_stage1(CK_LAS unsigned char* lds, int item, const bf16_t* __restrict__ Pb, int PW, int C_RR, int C_RK, int C_RV, int C_WD, int SEQ, const RwkvParams& p, unsigned char* __restrict__ cw) {
    const int tid = ltid(), lane = tid & 63, wid = __builtin_amdgcn_readfirstlane(tid >> 6), quad = wid >> 2, wq = wid & 3, I = wq >> 1, J = wq & 1, r = lane & 31, hh = lane >> 5;
    const int b = item >> 10, h = (item >> 8) & 3, c = item & 255;
    const size_t m0 = (size_t)b * SEQ + (size_t)c * 64;
    const lbf Am = (lbf)(lds), Bm = (lbf)(lds + B9), Km = (lbf)(lds + 2 * B9), Rm = (lbf)(lds + 3 * B9), VT = (lbf)(lds + 4 * B9), BhT = (lbf)(lds + 5 * B9), KhT = (lbf)(lds + 6 * B9),
              Nm = (lbf)(lds + 7 * B9), Wb = (lbf)(lds + 8 * B9), Wk = (lbf)(lds + 9 * B9);
    const lbf TW = (lbf)(lds + L_U), AD = (lbf)(lds + L_U + B9), SG0 = (lbf)(lds + L_U + 2 * B9), SG1 = (lbf)(lds + L_U + 3 * B9);
    const lbf W2T = BhT, A2T = KhT, G2Ta = Nm, G2Tb = Wb;
    const lf32 X = (lf32)(lds + L_U), MM = (lf32)(lds + L_MM), GL = (lf32)(lds + L_GL);
    const lf32 AA = (lf32)(lds), GGl = (lf32)(lds + 2 * B9);
    const lbf ZlT = Km, X1T = Nm;
    const int t = tid >> 3, c8 = (tid & 7) * 8;
    const size_t m = m0 + t; const bool hp = (c * 64 + t) > 0;
    const bf16_t* pr = Pb + m * PW; const bf16_t* pp = pr - PW;
    float rr[8], kx[8], vv[8];
    {
        const u32x4 z4 = (u32x4){0u, 0u, 0u, 0u};
        const u32x4 cr = *(const u32x4*)(pr + C_RR + h * 64 + c8), ckk = *(const u32x4*)(pr + C_RK + h * 64 + c8), cv = *(const u32x4*)(pr + C_RV + h * 64 + c8);
        const u32x4 qr = hp ? *(const u32x4*)(pp + C_RR + h * 64 + c8) : z4, qk = hp ? *(const u32x4*)(pp + C_RK + h * 64 + c8) : z4, qv = hp ? *(const u32x4*)(pp + C_RV + h * 64 + c8) : z4;
#pragma unroll
        for (int e = 0; e < 8; ++e) { const int ch = h * 64 + c8 + e;
            const float a_ = (e & 1) ? bfhi(cr[e >> 1]) : bflo(cr[e >> 1]), b_ = (e & 1) ? bfhi(qr[e >> 1]) : bflo(qr[e >> 1]); rr[e] = a_ + (b_ - a_) * p.mu_rkv[ch];
            const float c_ = (e & 1) ? bfhi(ckk[e >> 1]) : bflo(ckk[e >> 1]), d_ = (e & 1) ? bfhi(qk[e >> 1]) : bflo(qk[e >> 1]); kx[e] = c_ + (d_ - c_) * p.mu_rkv[256 + ch];
            const float e_ = (e & 1) ? bfhi(cv[e >> 1]) : bflo(cv[e >> 1]), f_ = (e & 1) ? bfhi(qv[e >> 1]) : bflo(qv[e >> 1]); vv[e] = e_ + (f_ - e_) * p.mu_rkv[512 + ch]; }
#pragma unroll
        for (int q = 0; q < 4; ++q) { const u32x4 cl = *(const u32x4*)(pr + C_WD + q * 64 + c8); const u32x4 ql = hp ? *(const u32x4*)(pp + C_WD + q * 64 + c8) : z4;
            float lo[8];
#pragma unroll
            for (int e = 0; e < 8; ++e) { const float a_ = (e & 1) ? bfhi(cl[e >> 1]) : bflo(cl[e >> 1]), b_ = (e & 1) ? bfhi(ql[e >> 1]) : bflo(ql[e >> 1]); const float x = a_ + (b_ - a_) * p.mu_lora[q * 64 + c8 + e];
                lo[e] = (q == 0) ? ftanh(x) : (q == 1 ? x : sigm(x)); }
            u32x4 w; w.x = pk2(lo[0], lo[1]); w.y = pk2(lo[2], lo[3]); w.z = pk2(lo[4], lo[5]); w.w = pk2(lo[6], lo[7]);
            *(CK_LAS u32x4*)((q == 0 ? TW : q == 1 ? AD : q == 2 ? SG0 : SG1) + t * SB + c8) = w; }
        *(CK_LAS u32x4*)(W2T + t * SB + c8) = *(const u32x4*)(p.w2t + ((size_t)h * 64 + t) * 64 + c8);
        *(CK_LAS u32x4*)(A2T + t * SB + c8) = *(const u32x4*)(p.a2t + ((size_t)h * 64 + t) * 64 + c8);
        *(CK_LAS u32x4*)(G2Ta + t * SB + c8) = *(const u32x4*)(p.g2t + ((size_t)h * 64 + t) * 128 + c8);
        *(CK_LAS u32x4*)(G2Tb + t * SB + c8) = *(const u32x4*)(p.g2t + ((size_t)h * 64 + t) * 128 + 64 + c8);
    }
    __syncthreads();
    if (quad == 0) {
        f32x16 z = mm_lds(TW, W2T, I, J, lane, f32x16{}); f32x16 za = mm_lds(AD, A2T, I, J, lane, f32x16{});
        const int ch = 32 * J + r; const float w0c = p.w0[h * 64 + ch], a0c = p.a0[h * 64 + ch];
#pragma unroll
        for (int g = 0; g < 16; ++g) { const int tt = 32 * I + crow(g, hh); const float lw = logsig(w0c + z[g]) - 0.5f; MM[tt * SF + ch] = -fexp(lw); AA[tt * SF + ch] = sigm(a0c + za[g]); }
    } else {
        f32x16 zg = mm_lds(SG0, G2Ta, I, J, lane, f32x16{}); zg = mm_lds(SG1, G2Tb, I, J, lane, zg);
        const int ch = 32 * J + r;
#pragma unroll
        for (int g = 0; g < 16; ++g) { const int tt = 32 * I + crow(g, hh); GGl[tt * SF + ch] = zg[g]; }
    }
    __syncthreads();
    {
        const int ch = tid & 63, seg = tid >> 6; float v8[8]; float run = 0.f;
#pragma unroll
        for (int i = 0; i < 8; ++i) { run += MM[(seg * 8 + i) * SF + ch]; v8[i] = run; }
        const lf32 TOT = (lf32)(lds + L_U);
        TOT[seg * 64 + ch] = run;
        __syncthreads();
        float off = 0.f;
#pragma unroll
        for (int s2 = 0; s2 < 8; ++s2) off += (s2 < seg) ? TOT[s2 * 64 + ch] : 0.f;
#pragma unroll
        for (int i = 0; i < 8; ++i) MM[(seg * 8 + i) * SF + ch] = v8[i] + off;
    }
    __syncthreads();
    float aa[8], gg[8], lw[8], lwp[8], lwl[8];
#pragma unroll
    for (int e = 0; e < 8; ++e) { aa[e] = AA[t * SF + c8 + e]; gg[e] = GGl[t * SF + c8 + e]; lw[e] = MM[t * SF + c8 + e]; lwp[e] = t > 0 ? MM[(t - 1) * SF + c8 + e] : 0.f; lwl[e] = MM[63 * SF + c8 + e]; }
    __syncthreads();
    {
        float kk[8], k2[8]; float ss = 0.f, rk = 0.f;
#pragma unroll
        for (int e = 0; e < 8; ++e) { const int ch = h * 64 + c8 + e; kk[e] = kx[e] * p.k_k[ch]; ss += kk[e] * kk[e]; k2[e] = kx[e] * (1.0f + (aa[e] - 1.0f) * p.k_a[ch]); rk += rr[e] * k2[e] * p.r_k[ch]; }
        ss += __shfl_xor(ss, 1); ss += __shfl_xor(ss, 2); ss += __shfl_xor(ss, 4); rk += __shfl_xor(rk, 1); rk += __shfl_xor(rk, 2); rk += __shfl_xor(rk, 4);
        const float inv = 1.0f / fmaxf(sqrtf(ss), 1e-12f);
        float am[8], bm[8], km[8], rm[8];
#pragma unroll
        for (int e = 0; e < 8; ++e) { kk[e] *= inv; const float g_ = fexp(lw[e]), gi = fexp(-lw[e]), gp = fexp(lwp[e]), gl = fexp(lwl[e] - lw[e]); const float ka = kk[e] * aa[e];
            am[e] = -kk[e] * gp; bm[e] = ka * gi; km[e] = k2[e] * gi; rm[e] = rr[e] * g_;
            VT[(c8 + e) * SB + t] = (bf16_t)f2bf(vv[e]); BhT[(c8 + e) * SB + t] = (bf16_t)f2bf(ka * gl); KhT[(c8 + e) * SB + t] = (bf16_t)f2bf(k2[e] * gl);
            X[t * SX + c8 + e] = am[e]; }
        u32x4 w;
        w.x = pk2(am[0], am[1]); w.y = pk2(am[2], am[3]); w.z = pk2(am[4], am[5]); w.w = pk2(am[6], am[7]); *(CK_LAS u32x4*)(Am + t * SB + c8) = w;
        w.x = pk2(bm[0], bm[1]); w.y = pk2(bm[2], bm[3]); w.z = pk2(bm[4], bm[5]); w.w = pk2(bm[6], bm[7]); *(CK_LAS u32x4*)(Bm + t * SB + c8) = w;
        w.x = pk2(km[0], km[1]); w.y = pk2(km[2], km[3]); w.z = pk2(km[4], km[5]); w.w = pk2(km[6], km[7]); *(CK_LAS u32x4*)(Km + t * SB + c8) = w;
        w.x = pk2(rm[0], rm[1]); w.y = pk2(rm[2], rm[3]); w.z = pk2(rm[4], rm[5]); w.w = pk2(rm[6], rm[7]); *(CK_LAS u32x4*)(Rm + t * SB + c8) = w;
        if (t == 63) {
#pragma unroll
            for (int e = 0; e < 8; ++e) GL[c8 + e] = fexp(lwl[e]); }
        w.x = pk2(vv[0], vv[1]); w.y = pk2(vv[2], vv[3]); w.z = pk2(vv[4], vv[5]); w.w = pk2(vv[6], vv[7]); *(u32x4*)(cw + O_VG + (size_t)item * 8192 + (t * 64 + c8) * 2) = w;
        w.x = pk2(gg[0], gg[1]); w.y = pk2(gg[2], gg[3]); w.z = pk2(gg[4], gg[5]); w.w = pk2(gg[6], gg[7]); *(u32x4*)(cw + O_GG + (size_t)item * 8192 + (t * 64 + c8) * 2) = w;
        if ((tid & 7) == 0) *(float*)(cw + O_RKD + (size_t)item * 256 + t * 4) = rk;
    }
    __syncthreads();
    {
        const f32x16 p1 = mm_lds(Am, quad == 0 ? Bm : Km, I, J, lane, f32x16{}); const f32x16 p2 = mm_lds(Rm, quad == 0 ? Bm : Km, I, J, lane, f32x16{});
        const int ii = 32 * J + r;
#pragma unroll
        for (int g = 0; g < 16; ++g) { const int tt = 32 * I + crow(g, hh);
            if (quad == 0) { MM[tt * SM + (ii & 3) * 16 + (ii >> 2)] = (ii < tt) ? p1[g] : 0.f; Wb[tt * SB + ii] = (bf16_t)f2bf((ii <= tt) ? p2[g] : 0.f); }
            else { Nm[tt * SB + ii] = (bf16_t)f2bf((ii < tt) ? p1[g] : 0.f); Wk[tt * SB + ii] = (bf16_t)f2bf((ii <= tt) ? p2[g] : 0.f); } }
    }
    __syncthreads();
    if (quad == 0) { const f32x16 nv = mm_lds(Nm, VT, I, J, lane, f32x16{}); const int vcol = 64 + 32 * J + r;
#pragma unroll
        for (int g = 0; g < 16; ++g) X[(32 * I + crow(g, hh)) * SX + vcol] = nv[g]; }
    __syncthreads();
    {
        const int col = tid >> 2, q = tid & 3;
        float xs[16];
#pragma unroll
        for (int k = 0; k < 16; ++k) xs[k] = X[(q + 4 * k) * SX + col];
#pragma unroll
        for (int tt = 1; tt < 64; ++tt) {
            const CK_LAS f32x4* mr = (const CK_LAS f32x4*)(MM + tt * SM + q * 16);
            float s0 = 0.f, s1 = 0.f, s2 = 0.f, s3 = 0.f;
#pragma unroll
            for (int k4 = 0; k4 < (tt + 15) / 16; ++k4) { const f32x4 mv = mr[k4]; s0 += mv[0] * xs[4 * k4]; s1 += mv[1] * xs[4 * k4 + 1]; s2 += mv[2] * xs[4 * k4 + 2]; s3 += mv[3] * xs[4 * k4 + 3]; }
            const float sm = quad_sum((s0 + s1) + (s2 + s3));
            xs[tt >> 2] += (q == (tt & 3)) ? sm : 0.f;
        }
        const lbf dstT = (col < 64) ? (X1T + col * SB) : (ZlT + (col - 64) * SB);
#pragma unroll
        for (int k = 0; k < 16; ++k) dstT[q + 4 * k] = (bf16_t)f2bf(xs[k]);
    }
    __syncthreads();
    if (quad == 0) {
        const f32x16 gy = mm_lds(Wb, X1T, I, J, lane, f32x16{}); const f32x16 pc = mm_lds(BhT, X1T, I, J, lane, f32x16{});
        bf16_t* gyg = (bf16_t*)(cw + O_GY + (size_t)item * 8192); bf16_t* pcg = (bf16_t*)(cw + O_PC + (size_t)item * 8192);
        const int cc = 32 * J + r;
#pragma unroll
        for (int g = 0; g < 16; ++g) { const int rw = 32 * I + crow(g, hh);
            gyg[rw * 64 + cc] = (bf16_t)f2bf(gy[g] + __builtin_bit_cast(float, (unsigned)Rm[rw * SB + cc] << 16));
            pcg[rw * 64 + cc] = (bf16_t)f2bf(pc[g] + (rw == cc ? GL[cc] : 0.f)); }
    } else {
        f32x16 yl = mm_lds(ZlT, Wb, I, J, lane, f32x16{}); yl = mm_lds(VT, Wk, I, J, lane, yl);
        f32x16 qc = mm_lds(BhT, ZlT, I, J, lane, f32x16{}); qc = mm_lds(KhT, VT, I, J, lane, qc);
        frag_store((float*)(cw + O_YL + (size_t)item * 16384), wq, lane, yl); frag_store_bf((bf16_t*)(cw + O_QC) + (size_t)item * 4096, wq, lane, qc);
    }
    __syncthreads();
}

__device__ __forceinline__ void rwkv_scan(CK_LAS unsigned char* lds, int chain, unsigned char* __restrict__ cw) {
    const int tid = ltid(), lane = tid & 63, wid = __builtin_amdgcn_readfirstlane(tid >> 6), quad = wid >> 2, wq = wid & 3, I = wq >> 1, J = wq & 1, r = lane & 31, hh = lane >> 5, qtid = tid & 255;
    const lbf HT = (lbf)(lds + quad * B9);
    for (int i = qtid; i < 64 * SB / 2; i += 256) ((CK_LAS unsigned*)HT)[i] = 0u;
    __syncthreads();
    const bool on = chain >= 0; const size_t it0 = (size_t)(on ? chain : 0) * 256;
    const bf16_t* pcg = (const bf16_t*)(cw + O_PC) + it0 * 4096; const bf16_t* qcg = (const bf16_t*)(cw + O_QC) + it0 * 4096; bf16_t* h0g = (bf16_t*)(cw + O_H0) + it0 * 4096;
    constexpr int PD = 5;
    bf16x8 ar[PD][4]; f32x16 qr[PD];
#define CK_LOADSTEP(A_, Q_, cc) do { const int c_ = (cc) < 256 ? (cc) : 255; _Pragma("unroll") for (int s_ = 0; s_ < 4; ++s_) A_[s_] = *(const bf16x8*)(pcg + (size_t)c_ * 4096 + (32 * I + r) * 64 + 16 * s_ + 8 * hh); Q_ = frag_load_bf(qcg + (size_t)c_ * 4096, wq, lane); } while (0)
#pragma unroll
    for (int k = 0; k < PD; ++k) CK_LOADSTEP(ar[k], qr[k], k);
    for (int c = 0; c < 256 + PD - 1; c += PD) {
#pragma unroll
        for (int k = 0; k < PD; ++k) {
            const int cc = c + k;
            if (cc < 256) {
            if (on) { const int row = qtid >> 2, seg = (qtid & 3) * 16; const u32x4 w0 = *(const CK_LAS u32x4*)(HT + row * SB + seg), w1 = *(const CK_LAS u32x4*)(HT + row * SB + seg + 8);
                      u32x4* dst = (u32x4*)(h0g + (size_t)cc * 4096 + row * 64 + seg); dst[0] = w0; dst[1] = w1; }
            f32x16 acc = qr[k];
            const lbf bp = HT + (32 * J + r) * SB + 8 * hh;
#pragma unroll
            for (int s_ = 0; s_ < 4; ++s_) { const bf16x8 bfr = *(const CK_LAS bf16x8*)(bp + 16 * s_); acc = __builtin_amdgcn_mfma_f32_32x32x16_bf16(ar[k][s_], bfr, acc, 0, 0, 0); }
            CK_LOADSTEP(ar[k], qr[k], cc + PD);
            asm volatile("s_waitcnt lgkmcnt(0)\n\ts_barrier" ::: "memory");
            tile_store_T(HT, I, J, lane, acc);
            asm volatile("s_waitcnt lgkmcnt(0)\n\ts_barrier" ::: "memory");
            }
        }
    }
#undef CK_LOADSTEP
}

__device__ __forceinline__ void rwkv_stage3(CK_LAS unsigned char* ldsq, int item, const RwkvParams& p, const unsigned char* __restrict__ cw, bf16_t* __restrict__ MIXB, int SEQ) {
    const int tid = ltid(), lane = tid & 63, wid = __builtin_amdgcn_readfirstlane(tid >> 6), wq = wid & 3, I = wq >> 1, J = wq & 1, r = lane & 31, hh = lane >> 5, qtid = tid & 255;
    const lf32 Y = (lf32)ldsq;
    if (item >= 0) {
        f32x16 acc = frag_load((const float*)(cw + O_YL) + (size_t)item * 4096, wq, lane);
        acc = mm_gg((const bf16_t*)(cw + O_H0) + (size_t)item * 4096, (const bf16_t*)(cw + O_GY) + (size_t)item * 4096, I, J, lane, acc);
#pragma unroll
        for (int g = 0; g < 16; ++g) Y[(32 * J + r) * SF + 32 * I + crow(g, hh)] = acc[g];
    }
    __syncthreads();
    if (item >= 0) {
        const int b = item >> 10, h = (item >> 8) & 3, c = item & 255; const int t = qtid >> 2, c16 = (qtid & 3) * 16;
        float y[16]; float s = 0.f;
#pragma unroll
        for (int e = 0; e < 16; ++e) { y[e] = Y[t * SF + c16 + e]; s += y[e]; }
        const float mu = quad_sum(s) * (1.f / 64.f); float s2 = 0.f;
#pragma unroll
        for (int e = 0; e < 16; ++e) { y[e] -= mu; s2 += y[e] * y[e]; }
        const float rstd = 1.0f / sqrtf(quad_sum(s2) * (1.f / 64.f) + 64e-5f);
        const u32x4* vg = (const u32x4*)(cw + O_VG + (size_t)item * 8192 + (t * 64 + c16) * 2); const u32x4* gg = (const u32x4*)(cw + O_GG + (size_t)item * 8192 + (t * 64 + c16) * 2);
        const float rk = *(const float*)(cw + O_RKD + (size_t)item * 256 + t * 4);
        unsigned ow[8];
#pragma unroll
        for (int hv = 0; hv < 2; ++hv) { const u32x4 vw = vg[hv], gw = gg[hv];
#pragma unroll
            for (int e2 = 0; e2 < 4; ++e2) { const int e = hv * 8 + 2 * e2; const int ch = h * 64 + c16 + e;
                const float o0 = (y[e] * rstd * p.ln_g[ch] + p.ln_b[ch] + rk * bflo(vw[e2])) * bflo(gw[e2]);
                const float o1 = (y[e + 1] * rstd * p.ln_g[ch + 1] + p.ln_b[ch + 1] + rk * bfhi(vw[e2])) * bfhi(gw[e2]);
                ow[hv * 4 + e2] = pk2(o0, o1); } }
        u32x4* dst = (u32x4*)(MIXB + ((size_t)b * SEQ + (size_t)c * 64 + t) * 1024 + 512 + h * 64 + c16);
        dst[0] = (u32x4){ow[0], ow[1], ow[2], ow[3]}; dst[1] = (u32x4){ow[4], ow[5], ow[6], ow[7]};
    }
    __syncthreads();
}

__device__ __forceinline__ void rot16(float (&o)[16], const bf16_t* __restrict__ prow, int colbase, int c16, const float* __restrict__ ropet  ) {
    const u32x4* own = (const u32x4*)(prow + colbase + c16); const u32x4* par = (const u32x4*)(prow + colbase + (c16 ^ 32));
    const f32x4* cs = (const f32x4*)(ropet + 2 * (c16 & 31));
#pragma unroll
    for (int hv = 0; hv < 2; ++hv) { const u32x4 ow = own[hv], pw = par[hv];
#pragma unroll
        for (int e2 = 0; e2 < 4; ++e2) { const f32x4 csv = cs[hv * 4 + e2];
            const float x0 = bflo(ow[e2]), x1 = bfhi(ow[e2]), p0 = bflo(pw[e2]), p1 = bfhi(pw[e2]);
            o[hv * 8 + 2 * e2] = (c16 < 32) ? (x0 * csv[0] - p0 * csv[1]) : (p0 * csv[1] + x0 * csv[0]);
            o[hv * 8 + 2 * e2 + 1] = (c16 < 32) ? (x1 * csv[2] - p1 * csv[3]) : (p1 * csv[3] + x1 * csv[2]); } }
}
__device__ __forceinline__ void ret_stage1(CK_LAS unsigned char* ldsq, int item, const bf16_t* __restrict__ Pb, int PW, int C_TK, int C_TV, int SEQ, const float* __restrict__ ROPE, unsigned char* __restrict__ cw) {
    const int tid = ltid(), lane = tid & 63, wid = __builtin_amdgcn_readfirstlane(tid >> 6), wq = wid & 3, I = wq >> 1, J = wq & 1, qtid = tid & 255;
    const lbf VT = (lbf)ldsq, KdT = (lbf)(ldsq + B9);
    if (item >= 0) {
        const int b = item >> 10, h = (item >> 8) & 3, c = item & 255; const int t = qtid >> 2, c16 = (qtid & 3) * 16; const int pos = c * 64 + t;
        const bf16_t* prow = Pb + ((size_t)b * SEQ + pos) * PW;
        float kr[16]; rot16(kr, prow, C_TK + h * 64, c16, ROPE + (size_t)pos * 64);
        const float lg = __builtin_amdgcn_logf(1.0f - __builtin_amdgcn_exp2f(-5.0f - (float)h));
        const float dec = 0.125f * __builtin_amdgcn_exp2f(lg * (float)(63 - t));
        const u32x4* vp = (const u32x4*)(prow + C_TV + h * 64 + c16);
#pragma unroll
        for (int hv = 0; hv < 2; ++hv) { const u32x4 vw = vp[hv];
#pragma unroll
            for (int e2 = 0; e2 < 4; ++e2) { const int e = hv * 8 + 2 * e2;
                VT[(c16 + e) * SB + t] = (bf16_t)(vw[e2] & 0xffffu); VT[(c16 + e + 1) * SB + t] = (bf16_t)(vw[e2] >> 16);
                KdT[(c16 + e) * SB + t] = (bf16_t)f2bf(kr[e] * dec); KdT[(c16 + e + 1) * SB + t] = (bf16_t)f2bf(kr[e + 1] * dec); } }
    }
    __syncthreads();
    if (item >= 0) { const f32x16 kv = mm_lds(VT, KdT, I, J, lane, f32x16{}); frag_store_bf((bf16_t*)(cw + O_KV) + (size_t)item * 4096, wq, lane, kv); }
    __syncthreads();
}
__device__ __forceinline__ void ret_scan(int chain, unsigned char* __restrict__ cw) {
    const int tid = ltid(), lane = tid & 63, wid = __builtin_amdgcn_readfirstlane(tid >> 6), wq = wid & 3, I = wq >> 1, J = wq & 1, r = lane & 31, hh = lane >> 5;
    const int h = chain & 3; const float lg = __builtin_amdgcn_logf(1.0f - __builtin_amdgcn_exp2f(-5.0f - (float)h)); const float g64 = __builtin_amdgcn_exp2f(lg * 64.0f);
    const bf16_t* kvg = (const bf16_t*)(cw + O_KV) + (size_t)chain * 256 * 4096; bf16_t* rtg = (bf16_t*)(cw + O_RT) + (size_t)chain * 256 * 4096;
    f32x16 R = f32x16{}; constexpr int PD = 8; f32x16 nx[PD];
#pragma unroll
    for (int k = 0; k < PD; ++k) nx[k] = frag_load_bf(kvg + (size_t)k * 4096, wq, lane);
    for (int c = 0; c < 256; c += PD) {
#pragma unroll
        for (int k = 0; k < PD; ++k) { const int cc = c + k; bf16_t* dst = rtg + (size_t)cc * 4096;
#pragma unroll
            for (int g = 0; g < 16; ++g) dst[(32 * I + crow(g, hh)) * 64 + 32 * J + r] = (bf16_t)f2bf(R[g]);
            const f32x16 kvc = nx[k]; const int nn = cc + PD < 256 ? cc + PD : 255;
            nx[k] = frag_load_bf(kvg + (size_t)nn * 4096, wq, lane);
#pragma unroll
            for (int g = 0; g < 16; ++g) R[g] = R[g] * g64 + kvc[g]; }
    }
}
constexpr int L_RET3 = 4 * B9 + 64 * SF * 4;
__device__ __forceinline__ void ret_stage3(CK_LAS unsigned char* ldsq, int item, const bf16_t* __restrict__ Pb, int PW, int C_TQ, int C_TK, int C_TV, int C_TG, int SEQ, const float* __restrict__ ROPE,
                                           const float* __restrict__ gn_g, const unsigned char* __restrict__ cw, bf16_t* __restrict__ MIXB) {
    const int tid = ltid(), lane = tid & 63, wid = __builtin_amdgcn_readfirstlane(tid >> 6), wq = wid & 3, I = wq >> 1, J = wq & 1, r = lane & 31, hh = lane >> 5, qtid = tid & 255;
    const lbf Qr = (lbf)ldsq, Kr = (lbf)(ldsq + B9), VT = (lbf)(ldsq + 2 * B9), Sb = (lbf)(ldsq + 3 * B9); const lf32 Y = (lf32)(ldsq + 4 * B9);
    const int b = item >= 0 ? item >> 10 : 0, h = item >= 0 ? (item >> 8) & 3 : 0, c = item >= 0 ? item & 255 : 0; const int t = qtid >> 2, c16 = (qtid & 3) * 16; const int pos = c * 64 + t;
    const float lg = __builtin_amdgcn_logf(1.0f - __builtin_amdgcn_exp2f(-5.0f - (float)h));
    const bf16_t* prow = Pb + ((size_t)b * SEQ + pos) * PW;
    if (item >= 0) {
        float qr[16], kr[16]; rot16(qr, prow, C_TQ + h * 64, c16, ROPE + (size_t)pos * 64); rot16(kr, prow, C_TK + h * 64, c16, ROPE + (size_t)pos * 64);
        u32x4 w;
        w.x = pk2(qr[0], qr[1]); w.y = pk2(qr[2], qr[3]); w.z = pk2(qr[4], qr[5]); w.w = pk2(qr[6], qr[7]); *(CK_LAS u32x4*)(Qr + t * SB + c16) = w;
        w.x = pk2(qr[8], qr[9]); w.y = pk2(qr[10], qr[11]); w.z = pk2(qr[12], qr[13]); w.w = pk2(qr[14], qr[15]); *(CK_LAS u32x4*)(Qr + t * SB + c16 + 8) = w;
#pragma unroll
        for (int e = 0; e < 16; ++e) kr[e] *= 0.125f;
        w.x = pk2(kr[0], kr[1]); w.y = pk2(kr[2], kr[3]); w.z = pk2(kr[4], kr[5]); w.w = pk2(kr[6], kr[7]); *(CK_LAS u32x4*)(Kr + t * SB + c16) = w;
        w.x = pk2(kr[8], kr[9]); w.y = pk2(kr[10], kr[11]); w.z = pk2(kr[12], kr[13]); w.w = pk2(kr[14], kr[15]); *(CK_LAS u32x4*)(Kr + t * SB + c16 + 8) = w;
        const u32x4* vp = (const u32x4*)(prow + C_TV + h * 64 + c16);
#pragma unroll
        for (int hv = 0; hv < 2; ++hv) { const u32x4 vw = vp[hv];
#pragma unroll
            for (int e2 = 0; e2 < 4; ++e2) { const int e = hv * 8 + 2 * e2; VT[(c16 + e) * SB + t] = (bf16_t)(vw[e2] & 0xffffu); VT[(c16 + e + 1) * SB + t] = (bf16_t)(vw[e2] >> 16); } }
    }
    __syncthreads();
    if (item >= 0) {
        f32x16 st = mm_lds(Kr, Qr, I, J, lane, f32x16{}); const int tt = 32 * J + r;
#pragma unroll
        for (int g = 0; g < 16; ++g) { const int ii = 32 * I + crow(g, hh); st[g] = (ii <= tt) ? st[g] * __builtin_amdgcn_exp2f(lg * (float)(tt - ii)) : 0.f; }
        tile_store_T(Sb, I, J, lane, st);
    }
    __syncthreads();
    if (item >= 0) {
        const f32x16 yi = mm_lds(VT, Sb, I, J, lane, f32x16{}); const f32x16 yc = mm_gA((const bf16_t*)(cw + O_RT) + (size_t)item * 4096, Qr, I, J, lane, f32x16{});
        const int tt = 32 * J + r; const float qd = __builtin_amdgcn_exp2f(lg * (float)(tt + 1));
#pragma unroll
        for (int g = 0; g < 16; ++g) Y[tt * SF + 32 * I + crow(g, hh)] = yi[g] + qd * yc[g];
    }
    __syncthreads();
    if (item >= 0) {
        float y[16]; float s = 0.f;
#pragma unroll
        for (int e = 0; e < 16; ++e) { y[e] = Y[t * SF + c16 + e]; s += y[e]; }
        const float mu = quad_sum(s) * (1.f / 64.f); float s2 = 0.f;
#pragma unroll
        for (int e = 0; e < 16; ++e) { y[e] -= mu; s2 += y[e] * y[e]; }
        const float rstd = 1.0f / sqrtf(quad_sum(s2) * (1.f / 64.f) + 1e-6f);
        const u32x4* gp = (const u32x4*)(prow + C_TG + h * 64 + c16); unsigned ow[8];
#pragma unroll
        for (int hv = 0; hv < 2; ++hv) { const u32x4 gw = gp[hv];
#pragma unroll
            for (int e2 = 0; e2 < 4; ++e2) { const int e = hv * 8 + 2 * e2; const int ch = h * 64 + c16 + e; const float g0 = bflo(gw[e2]), g1 = bfhi(gw[e2]);
                ow[hv * 4 + e2] = pk2(y[e] * rstd * gn_g[ch] * (g0 * sigm(g0)), y[e + 1] * rstd * gn_g[ch + 1] * (g1 * sigm(g1))); } }
        u32x4* dst = (u32x4*)(MIXB + ((size_t)b * SEQ + pos) * 1024 + 768 + h * 64 + c16);
        dst[0] = (u32x4){ow[0], ow[1], ow[2], ow[3]}; dst[1] = (u32x4){ow[4], ow[5], ow[6], ow[7]};
    }
    __syncthreads();
}
}

__device__ __forceinline__ void tr_tile(const float* __restrict__ src, size_t ld_src, bf16* __restrict__ dst, size_t ld_dst, float* scr, int lane) {
    pg8::f32x4 v[16];
#pragma unroll
    for (int i = 0; i < 16; ++i) v[i] = *(const pg8::f32x4*)(src + (size_t)(i * 4 + (lane >> 4)) * ld_src + (lane & 15) * 4);
#pragma unroll
    for (int i = 0; i < 16; ++i) { float* p = scr + (i * 4 + (lane >> 4)) * 65 + (lane & 15) * 4; p[0] = v[i][0]; p[1] = v[i][1]; p[2] = v[i][2]; p[3] = v[i][3]; }
    asm volatile("s_waitcnt lgkmcnt(0)" ::: "memory");
#pragma unroll
    for (int i = 0; i < 8; ++i) { const int n = i * 8 + (lane >> 3), kc = (lane & 7) * 8; const float* s = scr + kc * 65 + n;
        pg8::u32x4 o; o.x = pk2(s[0], s[65]); o.y = pk2(s[2 * 65], s[3 * 65]); o.z = pk2(s[4 * 65], s[5 * 65]); o.w = pk2(s[6 * 65], s[7 * 65]);
        *(pg8::u32x4*)(dst + (size_t)n * ld_dst + kc) = o; }
    asm volatile("s_waitcnt lgkmcnt(0)" ::: "memory");
}

constexpr int CV_13 = NE * 16 * 16, CV_2 = NE * 8 * 16, CV_L = CV_13 + CV_2, NCONV = DEPTH * CV_L;
__device__ __forceinline__ void conv_item(int it, const float* __restrict__ w1, const float* __restrict__ w3, const float* __restrict__ w2, bf16* __restrict__ W13, bf16* __restrict__ W2, float* scr, int lane) {
    const int l = it / CV_L; int r = it % CV_L;
    if (r < CV_13) { const int e = r >> 8, kb = (r >> 4) & 15, nb = r & 15;
        const int pn = nb >> 2, q = nb & 3; const float* srcw = (q < 2 ? w1 : w3) + ((size_t)l * NE + e) * DM * DE;
        tr_tile(srcw + (size_t)kb * 64 * DE + pn * 128 + (q & 1) * 64, DE, W13 + ((size_t)l * NE + e) * DM * DM + (size_t)nb * 64 * DM + kb * 64, DM, scr, lane); }
    else { r -= CV_13; const int e = r >> 7, kb = (r >> 4) & 7, nb = r & 15;
        tr_tile(w2 + ((size_t)l * NE + e) * DE * DM + (size_t)kb * 64 * DM + nb * 64, DM, W2 + ((size_t)l * NE + e) * DM * DE + (size_t)nb * 64 * DE + kb * 64, DE, scr, lane); }
}

#define LAS __attribute__((address_space(3)))
#define XB_TMO      128
#define XB_XCNT(j)  (256  + 64 * (j))
#define XB_XSUB(j)  (1280 + 64 * (j))
#define XB_XGEN(j)  (2304 + 64 * (j))
#define XB_TOP      3328
#define XB_TOPGEN   3392
#define XCD_BAR_WORDS 3456
#define XB_SPIN_CAP (1u << 18)

__device__ __forceinline__ unsigned xb_ld(unsigned* p)              { return __hip_atomic_load(p, __ATOMIC_RELAXED, __HIP_MEMORY_SCOPE_AGENT); }
__device__ __forceinline__ unsigned xb_add(unsigned* p, unsigned v) { return __hip_atomic_fetch_add(p, v, __ATOMIC_RELAXED, __HIP_MEMORY_SCOPE_AGENT); }
__device__ __forceinline__ unsigned xb_xcc_id() { return (unsigned)__builtin_amdgcn_s_getreg((3 << 11) | 20) & 0xFu; }
#define XB_SPIN(cond, bar) do { unsigned _sp = 0; while (cond) { __builtin_amdgcn_s_sleep(1); \
    if ((++_sp & 255u) == 0u) { if (xb_ld(&(bar)[XB_TMO])) break; if (_sp > XB_SPIN_CAP) { atomicAdd(&(bar)[XB_TMO], 1u); break; } } } } while (0)

struct XcdBarrier {
    unsigned* bar; unsigned x;
    volatile LAS unsigned* st;
};

__device__ __forceinline__ XcdBarrier xcd_barrier_post(unsigned* bar, volatile LAS unsigned* st) {
    XcdBarrier b; b.bar = bar; b.x = xb_xcc_id(); b.st = st;
    if (ltid() == 0) (void)xb_add(&bar[XB_XCNT(b.x)], 1u);
    return b;
}
__device__ __forceinline__ void xcd_barrier_complete(unsigned* bar, unsigned x, unsigned& nloc, unsigned& nx) {
    const unsigned G = gridDim.x * gridDim.y * gridDim.z;
    unsigned sum, cnt, mine, sp = 0u;
    for (;;) {
        sum = 0u; cnt = 0u; mine = 0u;
#pragma unroll
        for (unsigned j = 0; j < 16; ++j) { const unsigned c = xb_ld(&bar[XB_XCNT(j)]); sum += c; cnt += (c > 0u) ? 1u : 0u; mine = (j == x) ? c : mine; }
        if (sum == G) break;
        __builtin_amdgcn_s_sleep(1);
        if ((++sp & 255u) == 0u) { if (xb_ld(&bar[XB_TMO])) break; if (sp > XB_SPIN_CAP) { atomicAdd(&bar[XB_TMO], 1u); break; } }
    }
    nloc = mine > 0u ? mine : 1u; nx = cnt > 0u ? cnt : 1u;
}

__device__ __forceinline__ void xcd_barrier(const XcdBarrier& b) {
    asm volatile("s_waitcnt vmcnt(0)" ::: "memory");
    __syncthreads();
    if (ltid() == 0) {
        unsigned* bar = b.bar; asm volatile("" : "+s"(bar)); unsigned bx_ = b.x; asm volatile("" : "+s"(bx_));
        __builtin_amdgcn_s_waitcnt(0);
        unsigned nloc = b.st[0], nx = b.st[1];
        if (nloc == 0u) { xcd_barrier_complete(bar, bx_, nloc, nx); b.st[0] = nloc; b.st[1] = nx; }
        const unsigned old = xb_add(&bar[XB_XSUB(bx_)], 1u);
        const unsigned gen = old / nloc;
        if (old + 1u == (gen + 1u) * nloc) {
            __builtin_amdgcn_fence(__ATOMIC_RELEASE, "agent");
            asm volatile("s_waitcnt vmcnt(0)" ::: "memory");
            const unsigned og = xb_add(&bar[XB_TOP], 1u);
            const unsigned tg = og / nx;
            if (og + 1u == (tg + 1u) * nx) xb_add(&bar[XB_TOPGEN], 1u);
            else XB_SPIN(xb_ld(&bar[XB_TOPGEN]) == tg, bar);
            __builtin_amdgcn_fence(__ATOMIC_ACQUIRE, "agent");
            xb_add(&bar[XB_XGEN(bx_)], 1u);
            asm volatile("s_waitcnt vmcnt(0)" ::: "memory");
        } else {
            XB_SPIN(xb_ld(&bar[XB_XGEN(bx_)]) == gen, bar);
            __builtin_amdgcn_fence(__ATOMIC_ACQUIRE, "agent");
            asm volatile("s_waitcnt vmcnt(0)" ::: "memory");
        }
    }
    __syncthreads();
}


__global__ void __launch_bounds__(NTHREADS, 2) mk_fwd(Args args) {
    extern __shared__ __attribute__((aligned(16))) unsigned char lds_raw[];
    float* lds = (float*)lds_raw;
    const int tid = ltid(), lane = tid & 63, wid = __builtin_amdgcn_readfirstlane(tid >> 6);
    const int G = gridDim.x, bx = blockIdx.x;
    unsigned char* ws = args.ws;
    unsigned* ctl = (unsigned*)(ws + WS_CTL);
    float* X = args.out;
    bf16* XB = (bf16*)(ws + WS_XB);
    bf16* Pb = (bf16*)(ws + WS_P);
    bf16* WIN = (bf16*)(ws + WS_WIN); bf16* WOUT = (bf16*)(ws + WS_WOUT); bf16* W13 = (bf16*)(ws + WS_W13); bf16* W2 = (bf16*)(ws + WS_W2);
    float* ROPE = (float*)(ws + WS_ROPE);
    double* LCS = (double*)(ws + WS_LCS); double* TOT = (double*)(ws + WS_TOT);
    float* BE = (float*)(ws + WS_SKIP); float* QN2 = BE + 16 * 256; float* KN2 = QN2 + 16 * 128;
    unsigned char* KA = ws + WS_KA;
    unsigned char* cw = ws + WS_CK; bf16* LWT = (bf16*)(ws + WS_LW);
    int* EP = (int*)(ws + WS_EP); int* DEST = (int*)(ws + WS_DEST);
    float* GATE = (float*)(ws + WS_GATE);
    bf16* MIXB = (bf16*)(ws + WS_MIXB);
    bf16* XP = (bf16*)(ws + WS_XP); bf16* Hb = (bf16*)(ws + WS_H); bf16* YP = (bf16*)(ws + WS_YP); bf16* YO = (bf16*)(ws + WS_YO);
    typedef pg8::f32x4 f32x4;
    volatile LAS unsigned* MISC = (volatile LAS unsigned*)((LAS unsigned char*)lds_raw + LDS_MISC);
    for (int u = tid; u < (LDS_ALL - LDS_MISC) / 4; u += NTHREADS) MISC[u] = 0u;
    __syncthreads();
    XcdBarrier bar = xcd_barrier_post(ctl + CW_BAR, MISC + 8);
#define GRID_BAR() xcd_barrier(bar)

    for (int rep_ = 0; rep_ < REP_P0; ++rep_) {
            const int tid = ltid(), lane = tid & 63, wid = __builtin_amdgcn_readfirstlane(tid >> 6); (void)lane; (void)wid;
        const f32x4* xi = (const f32x4*)args.in[0]; uint2* xb = (uint2*)XB;
        for (size_t i = (size_t)bx * NTHREADS + tid; i < (size_t)T * DM / 4; i += (size_t)G * NTHREADS) { const f32x4 v = xi[i]; xb[i] = make_uint2(pk2(v[0], v[1]), pk2(v[2], v[3])); }
        for (int i = bx * NTHREADS + tid; i < SEQ * 32; i += G * NTHREADS) {
            const int pos = i >> 5, f = i & 31;
            const double inv = pow(10000.0, -(double)f / 32.0);
            const double ang = (double)pos * inv;
            ROPE[2 * i] = (float)cos(ang); ROPE[2 * i + 1] = (float)sin(ang);
        }
        { bf16* WR = (bf16*)(ws + WS_WR);
          for (int i = bx * NTHREADS + tid; i < DEPTH * 48 * 1024; i += G * NTHREADS) { const int l_ = i / (48 * 1024), o = (i / 1024) % 48, k = i & 1023;
              const float wv = o < 4 ? args.in[21][((size_t)l_ * DM + k) * 4 + o] : (o < 36 ? args.in[23][((size_t)l_ * DM + k) * 32 + (o - 4)] : 0.f);
              const unsigned hi_ = f2bf(wv); const unsigned lo_ = f2bf(wv - bf2f((unsigned short)hi_));
              WR[((size_t)l_ * 2 + 0) * 48 * 1024 + o * 1024 + k] = (bf16)hi_; WR[((size_t)l_ * 2 + 1) * 48 * 1024 + o * 1024 + k] = (bf16)lo_; } }
        for (int i = bx * NTHREADS + tid; i < DEPTH * 256 * 256; i += G * NTHREADS) {
            const int l = i >> 16, rem = i & 65535, chg = rem >> 8, ii = rem & 255;
            if (ii < 64) LWT[((size_t)l * 256 + chg) * 64 + ii] = (bf16)f2bf(args.in[6][((size_t)l * 64 + ii) * 256 + chg]);
            else if (ii < 128) LWT[(size_t)DEPTH * 256 * 64 + ((size_t)l * 256 + chg) * 64 + (ii - 64)] = (bf16)f2bf(args.in[8][((size_t)l * 64 + (ii - 64)) * 256 + chg]);
            else LWT[(size_t)2 * DEPTH * 256 * 64 + ((size_t)l * 256 + chg) * 128 + (ii - 128)] = (bf16)f2bf(args.in[9][((size_t)l * 128 + (ii - 128)) * 256 + chg]);
        }
        float* scr = lds + wid * (64 * 65);
        constexpr int I_IN = 16 * 56, I_OUT = 16 * 16, I_L = I_IN + I_OUT;
        for (int it = bx * 8 + wid; it < DEPTH * I_L; it += G * 8) {
            const int l = it / I_L; int r = it % I_L;
            if (r < I_IN) { const int kb = r / 56, nb = r % 56; const int nsrc = nb * 64 + (nb >= 24 ? 8 : 0);
                tr_tile(args.in[1] + (size_t)l * DM * INW + (size_t)kb * 64 * INW + nsrc, INW, WIN + (size_t)l * PW * DM + (size_t)nb * 64 * DM + kb * 64, DM, scr, lane); }
            else { r -= I_IN; const int kb = r / 16, nb = r % 16;
                tr_tile(args.in[16] + (size_t)l * DM * DM + (size_t)kb * 64 * DM + nb * 64, DM, WOUT + (size_t)l * DM * DM + (size_t)nb * 64 * DM + kb * 64, DM, scr, lane); }
        }
        __syncthreads();
        {
            const float* wf = args.in[1] + O_FF; const float* fbias = args.in[2];
            float w[8][16];
#pragma unroll
            for (int jq = 0; jq < 4; ++jq)
#pragma unroll
                for (int e = 0; e < 4; ++e)
#pragma unroll
                    for (int h = 0; h < 8; ++h) w[h][jq * 4 + e] = wf[(size_t)(jq * 256 + lane * 4 + e) * INW + h];
            float* ffl = lds;
            for (int ch = bx; ch < T / 128; ch += G) {
                __syncthreads();
                for (int i = 0; i < 16; ++i) { const int tl = wid * 16 + i; const size_t m = (size_t)ch * 128 + tl;
                    float acc[8];
#pragma unroll
                    for (int h = 0; h < 8; ++h) acc[h] = 0.f;
#pragma unroll
                    for (int jq = 0; jq < 4; ++jq) { const f32x4 xv = *(const f32x4*)(args.in[0] + m * DM + jq * 256 + lane * 4);
#pragma unroll
                        for (int e = 0; e < 4; ++e)
#pragma unroll
                            for (int h = 0; h < 8; ++h) acc[h] += xv[e] * w[h][jq * 4 + e]; }
#pragma unroll
                    for (int h = 0; h < 8; ++h) acc[h] = wave_sum(acc[h]);
                    if (lane < 8) { float v = acc[0];
#pragma unroll
                        for (int h = 1; h < 8; ++h) v = (lane == h) ? acc[h] : v;
                        ffl[tl * 8 + lane] = v + fbias[lane]; } }
                __syncthreads();
                {
                    const int h = wid; const int bb = (ch * 128) / SEQ, t0 = (ch * 128) % SEQ; double carry = 0.0;
#pragma unroll
                    for (int half = 0; half < 2; ++half) { double v = (double)logsigmoidf_(ffl[(half * 64 + lane) * 8 + h]);
#pragma unroll
                        for (int o = 1; o < 64; o <<= 1) { const double n = __shfl_up(v, o); if (lane >= o) v += n; }
                        v += carry; LCS[(size_t)(bb * 8 + h) * SEQ + t0 + half * 64 + lane] = v; carry = __shfl(v, 63); }
                    if (lane == 0) TOT[(bb * 8 + h) * 128 + t0 / 128] = carry;
                }
            }
            __syncthreads();
        }
    }
    GRID_BAR();

    for (int l = 0; l < DEPTH; ++l) {
        for (int rep_ = 0; rep_ < REP_A; ++rep_) {
            const int tid = ltid(), lane = tid & 63, wid = __builtin_amdgcn_readfirstlane(tid >> 6); (void)lane; (void)wid;
            pg8::Gemm g{XB, WIN + (size_t)l * PW * DM, T, PW, DM}; pg8::StaticOrder S; S.init(T, PW, G, bx);
            pg8::EpiInProj E{Pb, PW, QC2};
            pg8::gemm_phase<pg8::EpiInProj, pg8::StaticOrder, true, true>((PG8_LAS unsigned char*)lds_raw, g, S, E);
        }
        GRID_BAR();
        for (int rep_ = 0; rep_ < REP_C; ++rep_) {
            const int tid = ltid(), lane = tid & 63, wid = __builtin_amdgcn_readfirstlane(tid >> 6); (void)lane; (void)wid;
            for (int ch = bx; ch < T / 128; ch += G) {
                const int h = wid; const int bb = (ch * 128) / SEQ, t0 = (ch * 128) % SEQ, ci = t0 / 128;
                double pre = 0.0;
                { const double* tp = TOT + (bb * 8 + h) * 128; double a = (lane < ci) ? tp[lane] : 0.0; a += (lane + 64 < ci) ? tp[lane + 64] : 0.0;
#pragma unroll
                  for (int o = 1; o < 64; o <<= 1) a += __shfl_xor(a, o);
                  pre = a; }
#pragma unroll
                for (int half = 0; half < 2; ++half) { const int t = t0 + half * 64 + lane; const double v = pre + LCS[(size_t)(bb * 8 + h) * SEQ + t];
                    const double bd = -v * 1.4426950408889634; const unsigned h_ = f2bf((float)bd); const double r1 = bd - (double)bf2f((unsigned short)h_);
                    const unsigned m_ = f2bf((float)r1); const double r2 = r1 - (double)bf2f((unsigned short)m_); const unsigned l_ = f2bf((float)r2);
                    *(pg8::u32x4*)(KA + ((size_t)(bb * 8 + h) * SEQ + t) * 16) = (pg8::u32x4){h_ | (m_ << 16), l_ | (0x3f80u << 16), 0x3f803f80u, 0u};
                    if (lane == 63) BE[(bb * 8 + h) * 256 + t / 64] = (float)bd; }
                { LAS unsigned* nrm = (LAS unsigned*)lds_raw;
                  __syncthreads();
                  if (tid < 16) nrm[tid] = 0u;
                  __syncthreads();
                  const int tl = tid >> 2, part = tid & 3; const bf16* prow = Pb + ((size_t)ch * 128 + tl) * PW;
#pragma unroll
                  for (int hq = 0; hq < 2; ++hq) { const int hd = part * 2 + hq;
#pragma unroll
                      for (int qk = 0; qk < 2; ++qk) { const pg8::u32x4* vp = (const pg8::u32x4*)(prow + (qk ? C_FK : C_FQ) + hd * 64); float ss = 0.f;
#pragma unroll
                          for (int v8 = 0; v8 < 8; ++v8) { const pg8::u32x4 wv = vp[v8];
#pragma unroll
                              for (int e = 0; e < 4; ++e) { const float lo_ = __builtin_bit_cast(float, wv[e] << 16), hi_ = __builtin_bit_cast(float, wv[e] & 0xffff0000u); ss += lo_ * lo_ + hi_ * hi_; } }
                          atomicMax((unsigned*)(nrm + qk * 8 + hd), __float_as_uint(ss)); } }
                  __syncthreads();
                  if (tid < 16) { const int hd = tid & 7; ((tid < 8) ? QN2 : KN2)[(bb * 8 + hd) * 128 + ci] = __uint_as_float(nrm[tid]); }
                }
            }
            __syncthreads();
            const ck::RwkvParams rp{args.in[3] + l * 768, args.in[4] + l * 256, args.in[5] + l * 256, args.in[7] + l * 256, args.in[10] + l * 256, args.in[11] + l * 256, args.in[12] + l * 256,
                                    args.in[13] + l * 256, args.in[14] + l * 256, args.in[15] + l * 256,
                                    LWT + (size_t)l * 256 * 64, LWT + (size_t)DEPTH * 256 * 64 + (size_t)l * 256 * 64, LWT + (size_t)2 * DEPTH * 256 * 64 + (size_t)l * 256 * 128};
#ifndef REP_S1
#define REP_S1 1
#endif
#ifndef REP_R1
#define REP_R1 1
#endif
            for (int rr_ = 0; rr_ < REP_S1; ++rr_)
            for (int it = bx; it < 2048; it += G) ck::rwkv_stage1((CK_LAS unsigned char*)lds_raw, it, Pb, PW, C_RR, C_RK, C_RV, C_WD, SEQ, rp, cw);
            { const int quad = wid >> 2;
              for (int rr_ = 0; rr_ < REP_R1; ++rr_)
              for (int i0 = bx * 2; i0 < 2048; i0 += G * 2) ck::ret_stage1((CK_LAS unsigned char*)lds_raw + quad * 2 * ck::B9, i0 + quad, Pb, PW, C_TK, C_TV, SEQ, ROPE, cw); }
        }
        GRID_BAR();
        {
            const int tid = ltid(), lane = tid & 63, wid = __builtin_amdgcn_readfirstlane(tid >> 6); (void)lane; (void)wid;
            const int quad = wid >> 2;
#ifndef REP_S
#define REP_S 1
#endif
            for (int rep_ = 0; rep_ < REP_S; ++rep_) {
            if (bx < 8) ck::rwkv_scan((CK_LAS unsigned char*)lds_raw, quad == 0 ? bx : -1, cw);
            else if (bx < 16) { if (quad == 0) ck::ret_scan(bx - 8, cw); }
            }
            __syncthreads();
            const attn_body::AttnTensors AT{(const attn_body::bf16*)(Pb + C_FQ), (const attn_body::bf16*)(Pb + C_FK), (const attn_body::bf16*)(Pb + C_FV), (attn_body::bf16*)MIXB, KA};
            bool cvdone = false;
            for (int gtry = 0; gtry < 8; ++gtry) {
                const int grp = (bx + gtry) & 7; unsigned* qh = ctl + CW_Q + 64 * (8 * l + grp);
                for (;;) {
                    if (tid == 0) MISC[16] = atomicAdd(qh, 1u);
                    __syncthreads();
                    const unsigned idx = MISC[16];
                    if (idx >= 128u) { __syncthreads(); break; }
                    const int qb = 63 - (int)(idx >> 1), bh = 2 * grp + (int)(idx & 1);
                    if (wid == 0) {
                        const float qn2 = fmaxf(QN2[bh * 128 + 2 * qb], QN2[bh * 128 + 2 * qb + 1]);
                        float kn2 = fmaxf(lane <= 2 * qb + 1 ? KN2[bh * 128 + lane] : 0.f, lane + 64 <= 2 * qb + 1 ? KN2[bh * 128 + 64 + lane] : 0.f);
#pragma unroll
                        for (int o = 1; o < 64; o <<= 1) kn2 = fmaxf(kn2, __shfl_xor(kn2, o));
                        const float bound = 2.002f * sqrtf(qn2 * kn2) + 50.0f; const int ntq = 4 * qb;
                        const float bref = ntq > 0 ? BE[bh * 256 + ntq - 1] : 0.f;
                        int nsk = 0;
#pragma unroll
                        for (int q4 = 0; q4 < 4; ++q4) { const int tt = q4 * 64 + lane; const bool sk = tt < ntq && (bref - BE[bh * 256 + tt]) > bound; nsk += __popcll(__ballot(sk)); }
                        if (lane == 0) MISC[17] = (unsigned)(nsk & ~1);
                    }
                    __syncthreads();
                    const int t0 = (int)MISC[17];
                    attn_body::attn_unit<8>(bh / attn_body::NHEAD, bh % attn_body::NHEAD, qb, t0, AT.Q, AT.K, AT.V, AT.O, AT.KA, (char*)lds_raw);
                    if (!cvdone) {
                        if (tid == 0) MISC[18] = atomicAdd(ctl + CW_CV, 16u);
                        __syncthreads();
                        const int tk = (int)MISC[18];
                        if (tk >= NCONV) cvdone = true;
                        else { const int t2 = ltid(), lane2 = t2 & 63, wid2 = __builtin_amdgcn_readfirstlane(t2 >> 6);
                            float* scr = lds + wid2 * (64 * 65);
                            _Pragma("clang loop unroll(disable)") for (int q2 = 0; q2 < 2; ++q2) { const int itc = tk + 8 * q2 + wid2; if (itc < NCONV) conv_item(itc, args.in[25], args.in[26], args.in[27], W13, W2, scr, lane2); } }
                        __syncthreads();
                    }
                }
            }
        }
        GRID_BAR();
        for (int rep_ = 0; rep_ < REP_E; ++rep_) {
            const int tid = ltid(), lane = tid & 63, wid = __builtin_amdgcn_readfirstlane(tid >> 6); (void)lane; (void)wid;
            const ck::RwkvParams rp{args.in[3] + l * 768, args.in[4] + l * 256, args.in[5] + l * 256, args.in[7] + l * 256, args.in[10] + l * 256, args.in[11] + l * 256, args.in[12] + l * 256,
                                    args.in[13] + l * 256, args.in[14] + l * 256, args.in[15] + l * 256, nullptr, nullptr, nullptr};
            const int quad = wid >> 2;
            for (int i0 = bx * 2; i0 < 2048; i0 += G * 2) ck::rwkv_stage3((CK_LAS unsigned char*)lds_raw + quad * 64 * ck::SF * 4, i0 + quad, rp, cw, MIXB, SEQ);
            for (int i0 = bx * 2; i0 < 2048; i0 += G * 2) ck::ret_stage3((CK_LAS unsigned char*)lds_raw + quad * ck::L_RET3, i0 + quad, Pb, PW, C_TQ, C_TK, C_TV, C_TG, SEQ, ROPE, args.in[15] + l * 256, cw, MIXB);
        }
        GRID_BAR();
        for (int rep_ = 0; rep_ < REP_F; ++rep_) {
            const int tid = ltid(), lane = tid & 63, wid = __builtin_amdgcn_readfirstlane(tid >> 6); (void)lane; (void)wid;
            pg8::Gemm g{MIXB, WOUT + (size_t)l * DM * DM, T, DM, DM}; pg8::StaticOrder S; S.init(T, DM, G, bx);
            pg8::EpiInProj E{YO, DM, 1.0f};
            pg8::gemm_phase<pg8::EpiInProj, pg8::StaticOrder, true, true>((PG8_LAS unsigned char*)lds_raw, g, S, E);
        }
        GRID_BAR();
        {
            const int tid = ltid(), lane = tid & 63, wid = __builtin_amdgcn_readfirstlane(tid >> 6); (void)lane; (void)wid;
            const float* g1 = args.in[17] + l * DM; const float* b1 = args.in[18] + l * DM;
            const float* bg = args.in[22] + l * 4; const float* be = args.in[24] + l * 32;
            unsigned* cnt = ctl + CW_CNT + 64 * l;
            const bf16* WRh = (const bf16*)(ws + WS_WR) + (size_t)l * 2 * 48 * 1024; const bf16* WRl = WRh + 48 * 1024;
            constexpr int XS = 1032;
            LAS unsigned short* XTh = (LAS unsigned short*)lds_raw; LAS unsigned short* XTl = XTh + 16 * XS;
            LAS float* PART = (LAS float*)((LAS unsigned char*)lds_raw + 2 * 16 * XS * 2);
            LAS float* LG = PART + 8 * 16 * 48;
            pg8::bf16x8 wh[4][3], wl[4][3];
#pragma unroll
            for (int s_ = 0; s_ < 4; ++s_)
#pragma unroll
                for (int nt = 0; nt < 3; ++nt) { const size_t o = (size_t)(16 * nt + (lane & 15)) * 1024 + 128 * wid + 32 * s_ + 8 * (lane >> 4);
                    wh[s_][nt] = *(const pg8::bf16x8*)(WRh + o); wl[s_][nt] = *(const pg8::bf16x8*)(WRl + o); }
            float gg[16], bb[16];
#pragma unroll
            for (int jq = 0; jq < 4; ++jq) { const f32x4 gv = *(const f32x4*)(g1 + jq * 256 + lane * 4), bv = *(const f32x4*)(b1 + jq * 256 + lane * 4);
#pragma unroll
                for (int e = 0; e < 4; ++e) { gg[jq * 4 + e] = gv[e]; bb[jq * 4 + e] = bv[e]; } }
            for (int blk = bx; blk < T / 16; blk += G) {
                const size_t m0 = (size_t)blk * 16;
#pragma unroll
                for (int i = 0; i < 2; ++i) { const int tl = wid * 2 + i; const size_t m = m0 + tl;
                    float v[16]; float sm = 0.f;
#pragma unroll
                    for (int jq = 0; jq < 4; ++jq) { const uint2 xw = *(const uint2*)(XB + m * DM + jq * 256 + lane * 4), yw = *(const uint2*)(YO + m * DM + jq * 256 + lane * 4);
                        const f32x4 xv = (f32x4){__builtin_bit_cast(float, xw.x << 16), __builtin_bit_cast(float, xw.x & 0xffff0000u), __builtin_bit_cast(float, xw.y << 16), __builtin_bit_cast(float, xw.y & 0xffff0000u)};
                        const f32x4 yv = (f32x4){__builtin_bit_cast(float, yw.x << 16), __builtin_bit_cast(float, yw.x & 0xffff0000u), __builtin_bit_cast(float, yw.y << 16), __builtin_bit_cast(float, yw.y & 0xffff0000u)};
#pragma unroll
                        for (int e = 0; e < 4; ++e) { v[jq * 4 + e] = ALPHA * xv[e] + yv[e]; sm += v[jq * 4 + e]; } }
                    const float mean = wave_sum(sm) * (1.f / DM); float s2 = 0.f;
#pragma unroll
                    for (int q = 0; q < 16; ++q) { v[q] -= mean; s2 += v[q] * v[q]; }
                    const float rstd = 1.0f / sqrtf(wave_sum(s2) * (1.f / DM) + LN_EPS);
#pragma unroll
                    for (int jq = 0; jq < 4; ++jq) { f32x4 ov; unsigned hw[4], lw[4];
#pragma unroll
                        for (int e = 0; e < 4; ++e) { const float o_ = v[jq * 4 + e] * rstd * gg[jq * 4 + e] + bb[jq * 4 + e]; ov[e] = o_; hw[e] = f2bf(o_); lw[e] = f2bf(o_ - bf2f((unsigned short)hw[e])); }
                        *(uint2*)(XB + m * DM + jq * 256 + lane * 4) = make_uint2(hw[0] | (hw[1] << 16), hw[2] | (hw[3] << 16));
                        *(LAS ck::u32x2*)(XTh + tl * XS + jq * 256 + lane * 4) = (ck::u32x2){hw[0] | (hw[1] << 16), hw[2] | (hw[3] << 16)};
                        *(LAS ck::u32x2*)(XTl + tl * XS + jq * 256 + lane * 4) = (ck::u32x2){lw[0] | (lw[1] << 16), lw[2] | (lw[3] << 16)}; }
                }
                __syncthreads();
                {
                    pg8::f32x4 acc[3] = {pg8::f32x4{0.f, 0.f, 0.f, 0.f}, pg8::f32x4{0.f, 0.f, 0.f, 0.f}, pg8::f32x4{0.f, 0.f, 0.f, 0.f}};
#pragma unroll
                    for (int s_ = 0; s_ < 4; ++s_) { const int ko = (lane & 15) * XS + 128 * wid + 32 * s_ + 8 * (lane >> 4);
                        const pg8::bf16x8 ah = *(const LAS pg8::bf16x8*)(XTh + ko), al = *(const LAS pg8::bf16x8*)(XTl + ko);
#pragma unroll
                        for (int nt = 0; nt < 3; ++nt) { acc[nt] = __builtin_amdgcn_mfma_f32_16x16x32_bf16(ah, wh[s_][nt], acc[nt], 0, 0, 0);
                            acc[nt] = __builtin_amdgcn_mfma_f32_16x16x32_bf16(al, wh[s_][nt], acc[nt], 0, 0, 0); acc[nt] = __builtin_amdgcn_mfma_f32_16x16x32_bf16(ah, wl[s_][nt], acc[nt], 0, 0, 0); } }
#pragma unroll
                    for (int nt = 0; nt < 3; ++nt)
#pragma unroll
                        for (int r_ = 0; r_ < 4; ++r_) PART[(wid * 16 + 4 * (lane >> 4) + r_) * 48 + 16 * nt + (lane & 15)] = acc[nt][r_];
                }
                __syncthreads();
                for (int p_ = tid; p_ < 16 * 48; p_ += NTHREADS) { float a_ = 0.f;
#pragma unroll
                    for (int w_ = 0; w_ < 8; ++w_) a_ += PART[w_ * 16 * 48 + p_];
                    LG[p_] = a_; }
                __syncthreads();
                if (tid < 16) { const LAS float* lg = LG + tid * 48; const size_t m = m0 + tid;
                    int grp = 0; float gbest = lg[0] + bg[0];
#pragma unroll
                    for (int o = 1; o < 4; ++o) { const float gv = lg[o] + bg[o]; if (gv > gbest) { gbest = gv; grp = o; } }
                    float den = 0.f;
#pragma unroll
                    for (int o = 0; o < 4; ++o) den += expf(lg[o] + bg[o] - gbest);
                    const float ggate = 1.0f / den;
                    int i0 = 0; float v0 = lg[4 + grp * 8] + be[grp * 8];
                    for (int o = 1; o < 8; ++o) { const float ev = lg[4 + grp * 8 + o] + be[grp * 8 + o]; if (ev > v0) { v0 = ev; i0 = o; } }
                    int i1 = -1; float v1 = -INFINITY;
                    for (int o = 0; o < 8; ++o) { const float ev = lg[4 + grp * 8 + o] + be[grp * 8 + o]; if (o != i0 && (i1 < 0 || ev > v1)) { v1 = ev; i1 = o; } }
                    const float e1 = expf(v1 - v0); const float p0 = 1.0f / (1.0f + e1), p1 = e1 / (1.0f + e1);
                    const int ex0 = grp * 8 + i0, ex1 = grp * 8 + i1;
                    const unsigned q0 = atomicAdd(cnt + ex0, 1u); EP[2 * m] = (ex0 << 16) | (int)q0;
                    const unsigned q1 = atomicAdd(cnt + ex1, 1u); EP[2 * m + 1] = (ex1 << 16) | (int)q1;
                    GATE[2 * m] = ggate * p0; GATE[2 * m + 1] = ggate * p1;
                }
                __syncthreads();
            }
        }
        GRID_BAR();
        for (int rep_ = 0; rep_ < REP_H; ++rep_) {
            const int tid = ltid(), lane = tid & 63, wid = __builtin_amdgcn_readfirstlane(tid >> 6); (void)lane; (void)wid;
            {
                const int endl = (l + 1) * CV_L;
                for (;;) { if (tid == 0) MISC[18] = atomicAdd(ctl + CW_CV, 8u);
                    __syncthreads();
                    const int tk = (int)MISC[18];
                    if (tk + wid < NCONV) conv_item(tk + wid, args.in[25], args.in[26], args.in[27], W13, W2, lds + wid * (64 * 65), lane);
                    __syncthreads();
                    if (tk + 8 >= endl) break; }
            }
            __syncthreads();
            unsigned* cnt = ctl + CW_CNT + 64 * l;
            int* poff = (int*)lds;
            if (tid == 0) { int acc = 0; for (int e = 0; e < NE; ++e) { poff[e] = acc; acc += (((int)cnt[e] + 255) >> 8) << 8; } poff[NE] = acc; }
            __syncthreads();
            for (int m = bx * 8 + wid; m < T; m += G * 8) {
                uint2 w[4];
    #pragma unroll
                for (int jq = 0; jq < 4; ++jq) w[jq] = *(const uint2*)(XB + (size_t)m * DM + jq * 256 + lane * 4);
    #pragma unroll
                for (int k = 0; k < 2; ++k) { const int ep = EP[2 * m + k]; const int dest = poff[ep >> 16] + (ep & 0xffff);
    #pragma unroll
                    for (int jq = 0; jq < 4; ++jq) *(uint2*)(XP + (size_t)dest * DM + jq * 256 + lane * 4) = w[jq];
                    if (lane == 0) DEST[2 * m + k] = dest; }
            }
        }
        GRID_BAR();
        for (int rep_ = 0; rep_ < REP_IJ; ++rep_) {
            const int tid = ltid(), lane = tid & 63, wid = __builtin_amdgcn_readfirstlane(tid >> 6); (void)lane; (void)wid;
            unsigned* cnt = ctl + CW_CNT + 64 * l;
            PG8_LAS int* tile_e = (PG8_LAS int*)((PG8_LAS unsigned char*)lds_raw + 131072); PG8_LAS int* tst = tile_e + MAXTILES;
            __syncthreads();
            if (tid == 0) { int acc = 0; for (int e = 0; e < NE; ++e) { tst[e] = acc; acc += ((int)cnt[e] + 255) >> 8; } tst[NE] = acc; }
            __syncthreads();
            const int ntile = tst[NE];
            if (tid < ntile) { int e = 0; while (tst[e + 1] <= tid) ++e; tile_e[tid] = e; }
            __syncthreads();
            pg8::MoeOrder S{ntile, G, bx, tile_e};
            { pg8::Gemm g{XP, W13 + (size_t)l * NE * DM * DM, ntile * 256, DM, DM}; pg8::EpiSwiGlu E{Hb, DE};
              pg8::gemm_phase<pg8::EpiSwiGlu, pg8::MoeOrder, true, true>((PG8_LAS unsigned char*)lds_raw, g, S, E); }
            GRID_BAR();
            { pg8::Gemm g{Hb, W2 + (size_t)l * NE * DM * DE, ntile * 256, DM, DE}; pg8::EpiInProj E{YP, DM, 1.0f};
              pg8::gemm_phase<pg8::EpiInProj, pg8::MoeOrder, true, true>((PG8_LAS unsigned char*)lds_raw, g, S, E); }
        }
        GRID_BAR();
        for (int rep_ = 0; rep_ < REP_K; ++rep_) { float* Xo = (rep_ == REP_K - 1) ? X : (float*)(ws + WS_XP); bf16* XBo = (rep_ == REP_K - 1) ? XB : (bf16*)(ws + WS_H);
            const int tid = ltid(), lane = tid & 63, wid = __builtin_amdgcn_readfirstlane(tid >> 6); (void)lane; (void)wid;
            const float* g2 = args.in[19] + l * DM; const float* b2 = args.in[20] + l * DM;
            const bool doff = (l + 1 < DEPTH); const int ln = doff ? l + 1 : l;
            const float* wf = args.in[1] + (size_t)ln * DM * INW + O_FF; const float* fbias = args.in[2] + ln * 8;
            LAS f32x4* W4 = (LAS f32x4*)((LAS unsigned char*)lds_raw + 4096);
            __syncthreads();
            for (int q = tid; q < 40 * 64; q += NTHREADS) { const int row = q >> 6, ln_ = q & 63; f32x4 val;
                if (row < 32) { const int h = row >> 2, jq = row & 3;
#pragma unroll
                    for (int e = 0; e < 4; ++e) val[e] = wf[(size_t)(jq * 256 + ln_ * 4 + e) * INW + h]; }
                else if (row < 36) val = *(const f32x4*)(g2 + (row - 32) * 256 + ln_ * 4);
                else val = *(const f32x4*)(b2 + (row - 36) * 256 + ln_ * 4);
                W4[q] = val; }
            float* ffl = lds;
            for (int ch = bx; ch < T / 128; ch += G) {
                __syncthreads();
                const size_t mw = (size_t)ch * 128 + wid * 16;
                const int dA = lane < 16 ? DEST[2 * (mw + lane)] : 0, dB = lane < 16 ? DEST[2 * (mw + lane) + 1] : 0;
                const float gA = lane < 16 ? GATE[2 * (mw + lane)] : 0.f, gB = lane < 16 ? GATE[2 * (mw + lane) + 1] : 0.f;
                f32x4 xA[2][4], xB[2][4]; uint2 aA[2][4], aB[2][4], bA[2][4], bB[2][4]; float gA2[2][2], gB2[2][2];
#define K_LOAD(XS, WAS, WBS, GS, IEXP) _Pragma("unroll")                     for (int u = 0; u < 2; ++u) { const size_t m = mw + IEXP + u;                         const size_t da = (size_t)__builtin_amdgcn_readlane(dA, IEXP + u), db = (size_t)__builtin_amdgcn_readlane(dB, IEXP + u);                         GS[u][0] = __builtin_bit_cast(float, __builtin_amdgcn_readlane(__builtin_bit_cast(int, gA), IEXP + u)); GS[u][1] = __builtin_bit_cast(float, __builtin_amdgcn_readlane(__builtin_bit_cast(int, gB), IEXP + u)); _Pragma("unroll")                         for (int jq = 0; jq < 4; ++jq) { { const uint2 xw_ = *(const uint2*)(XB + m * DM + jq * 256 + lane * 4); XS[u][jq] = (f32x4){__builtin_bit_cast(float, xw_.x << 16), __builtin_bit_cast(float, xw_.x & 0xffff0000u), __builtin_bit_cast(float, xw_.y << 16), __builtin_bit_cast(float, xw_.y & 0xffff0000u)}; }                             WAS[u][jq] = *(const uint2*)(YP + da * DM + jq * 256 + lane * 4); WBS[u][jq] = *(const uint2*)(YP + db * DM + jq * 256 + lane * 4); } }
                { const int i = 0; K_LOAD(xA, aA, bA, gA2, i); }
                for (int i = 0; i < 16; i += 4) {
                    { const int i1 = i + 2; K_LOAD(xB, aB, bB, gB2, i1); }
#pragma unroll
                    for (int u = 0; u < 2; ++u) { const int tl = wid * 16 + i + u; const size_t m = mw + i + u; const float ga = gA2[u][0], gb = gA2[u][1];
                    float v[16]; float s_ = 0.f;
#pragma unroll
                    for (int jq = 0; jq < 4; ++jq) { const uint2 w0 = aA[u][jq], w1 = bA[u][jq];
                        const f32x4 ya = (f32x4){__builtin_bit_cast(float, w0.x << 16), __builtin_bit_cast(float, w0.x & 0xffff0000u), __builtin_bit_cast(float, w0.y << 16), __builtin_bit_cast(float, w0.y & 0xffff0000u)};
                        const f32x4 yb = (f32x4){__builtin_bit_cast(float, w1.x << 16), __builtin_bit_cast(float, w1.x & 0xffff0000u), __builtin_bit_cast(float, w1.y << 16), __builtin_bit_cast(float, w1.y & 0xffff0000u)};
#pragma unroll
                        for (int e = 0; e < 4; ++e) { v[jq * 4 + e] = ALPHA * xA[u][jq][e] + (ga * ya[e] + gb * yb[e]); s_ += v[jq * 4 + e]; } }
                    const float mean = wave_sum(s_) * (1.f / DM); float s2 = 0.f;
#pragma unroll
                    for (int q = 0; q < 16; ++q) { v[q] -= mean; s2 += v[q] * v[q]; }
                    const float rstd = 1.0f / sqrtf(wave_sum(s2) * (1.f / DM) + LN_EPS);
                    float acc[8];
#pragma unroll
                    for (int h = 0; h < 8; ++h) acc[h] = 0.f;
#pragma unroll
                    for (int jq = 0; jq < 4; ++jq) { f32x4 ov;
                        const f32x4 gv = W4[(32 + jq) * 64 + lane], bv = W4[(36 + jq) * 64 + lane];
#pragma unroll
                        for (int e = 0; e < 4; ++e) ov[e] = v[jq * 4 + e] * rstd * gv[e] + bv[e];
                        if (doff) {
#pragma unroll
                            for (int h = 0; h < 8; ++h) { const f32x4 wv = W4[(h * 4 + jq) * 64 + lane]; acc[h] += (ov[0] * wv[0] + ov[1] * wv[1]) + (ov[2] * wv[2] + ov[3] * wv[3]); } }
                        if (!doff) *(f32x4*)(Xo + m * DM + jq * 256 + lane * 4) = ov;
                        *(uint2*)(XBo + m * DM + jq * 256 + lane * 4) = make_uint2(pk2(ov[0], ov[1]), pk2(ov[2], ov[3])); }
                    if (doff) {
#pragma unroll
                        for (int h = 0; h < 8; ++h) acc[h] = wave_sum(acc[h]);
                        if (lane < 8) { float fv = acc[0];
#pragma unroll
                            for (int h = 1; h < 8; ++h) fv = (lane == h) ? acc[h] : fv;
                            ffl[tl * 8 + lane] = fv + fbias[lane]; } }
                    }

                    if (i + 4 < 16) { const int i2 = i + 4; K_LOAD(xA, aA, bA, gA2, i2); }
#pragma unroll
                    for (int u = 0; u < 2; ++u) { const int tl = wid * 16 + (i + 2) + u; const size_t m = mw + (i + 2) + u; const float ga = gB2[u][0], gb = gB2[u][1];
                    float v[16]; float s_ = 0.f;
#pragma unroll
                    for (int jq = 0; jq < 4; ++jq) { const uint2 w0 = aB[u][jq], w1 = bB[u][jq];
                        const f32x4 ya = (f32x4){__builtin_bit_cast(float, w0.x << 16), __builtin_bit_cast(float, w0.x & 0xffff0000u), __builtin_bit_cast(float, w0.y << 16), __builtin_bit_cast(float, w0.y & 0xffff0000u)};
                        const f32x4 yb = (f32x4){__builtin_bit_cast(float, w1.x << 16), __builtin_bit_cast(float, w1.x & 0xffff0000u), __builtin_bit_cast(float, w1.y << 16), __builtin_bit_cast(float, w1.y & 0xffff0000u)};
#pragma unroll
                        for (int e = 0; e < 4; ++e) { v[jq * 4 + e] = ALPHA * xB[u][jq][e] + (ga * ya[e] + gb * yb[e]); s_ += v[jq * 4 + e]; } }
                    const float mean = wave_sum(s_) * (1.f / DM); float s2 = 0.f;
#pragma unroll
                    for (int q = 0; q < 16; ++q) { v[q] -= mean; s2 += v[q] * v[q]; }
                    const float rstd = 1.0f / sqrtf(wave_sum(s2) * (1.f / DM) + LN_EPS);
                    float acc[8];
#pragma unroll
                    for (int h = 0; h < 8; ++h) acc[h] = 0.f;
#pragma unroll
                    for (int jq = 0; jq < 4; ++jq) { f32x4 ov;
                        const f32x4 gv = W4[(32 + jq) * 64 + lane], bv = W4[(36 + jq) * 64 + lane];
#pragma unroll
                        for (int e = 0; e < 4; ++e) ov[e] = v[jq * 4 + e] * rstd * gv[e] + bv[e];
                        if (doff) {
#pragma unroll
                            for (int h = 0; h < 8; ++h) { const f32x4 wv = W4[(h * 4 + jq) * 64 + lane]; acc[h] += (ov[0] * wv[0] + ov[1] * wv[1]) + (ov[2] * wv[2] + ov[3] * wv[3]); } }
                        if (!doff) *(f32x4*)(Xo + m * DM + jq * 256 + lane * 4) = ov;
                        *(uint2*)(XBo + m * DM + jq * 256 + lane * 4) = make_uint2(pk2(ov[0], ov[1]), pk2(ov[2], ov[3])); }
                    if (doff) {
#pragma unroll
                        for (int h = 0; h < 8; ++h) acc[h] = wave_sum(acc[h]);
                        if (lane < 8) { float fv = acc[0];
#pragma unroll
                            for (int h = 1; h < 8; ++h) fv = (lane == h) ? acc[h] : fv;
                            ffl[tl * 8 + lane] = fv + fbias[lane]; } }
                    }

                }
#undef K_LOAD
                __syncthreads();
                if (doff) {
                    const int h = wid; const int bb = (ch * 128) / SEQ, t0 = (ch * 128) % SEQ; double carry = 0.0;
#pragma unroll
                    for (int half = 0; half < 2; ++half) { double vv = (double)logsigmoidf_(ffl[(half * 64 + lane) * 8 + h]);
#pragma unroll
                        for (int o = 1; o < 64; o <<= 1) { const double n = __shfl_up(vv, o); if (lane >= o) vv += n; }
                        vv += carry; LCS[(size_t)(bb * 8 + h) * SEQ + t0 + half * 64 + lane] = vv; carry = __shfl(vv, 63); }
                    if (lane == 0) TOT[(bb * 8 + h) * 128 + t0 / 128] = carry;
                }
            }
        }
        if (l + 1 < DEPTH) GRID_BAR();
    }
}

extern "C" void kernel_launch(void* const* d_in, const int* in_sizes, int n_in, void* d_out, int out_size, void* d_ws, size_t ws_size, hipStream_t stream) {
    static int grid = 0;
    if (grid == 0) {
        if (n_in != 28 || out_size != T * DM || ws_size < WS_END) { fprintf(stderr, "kernel_launch: unexpected shapes (n_in %d out %d ws %zu)\n", n_in, out_size, ws_size); grid = -1; return; }
        int dev = 0, cus = 0, per_cu = 0;
        (void)hipGetDevice(&dev); (void)hipDeviceGetAttribute(&cus, hipDeviceAttributeMultiprocessorCount, dev);
        (void)hipFuncSetAttribute((const void*)mk_fwd, hipFuncAttributeMaxDynamicSharedMemorySize, LDS_ALL);
        if (hipOccupancyMaxActiveBlocksPerMultiprocessor(&per_cu, (const void*)mk_fwd, NTHREADS, LDS_ALL) != hipSuccess || per_cu < 1) fprintf(stderr, "kernel_launch: occupancy query says %d blocks per CU\n", per_cu);
        (void)hipGetLastError();
        grid = cus > 0 ? cus : 256;
        if (grid != 256) fprintf(stderr, "kernel_launch: %d CUs (built for 256)\n", grid);
    }
    if (grid < 0) return;
    (void)hipMemsetAsync((char*)d_ws + WS_CTL, 0, CTL_BYTES, stream);
    Args a{};
    for (int i = 0; i < 28; ++i) a.in[i] = (const float*)d_in[i];
    a.out = (float*)d_out; a.ws = (unsigned char*)d_ws;
    hipLaunchKernelGGL(mk_fwd, dim3(grid), dim3(NTHREADS), LDS_ALL, stream, a);
}
```

```cpp
#include <hip/hip_runtime.h>
#include <cstdio>
#include <cstdint>
#include <cmath>
__device__ __forceinline__ int ltid() { int t = __builtin_amdgcn_workitem_id_x(); asm volatile("" : "+v"(t)); return t; }

constexpr int BATCH = 2, SEQ = 16384, DM = 1024, DEPTH = 4, T = BATCH * SEQ;
constexpr int INW = 3592, PW = 3584;
constexpr int O_FF = 1536;
constexpr int C_FQ = 0, C_FK = 512, C_FV = 1024, C_RR = 1536, C_RK = 1792, C_RV = 2048, C_WD = 2304, C_AD = 2368, C_GD = 2432,
              C_TQ = 2560, C_TK = 2816, C_TV = 3072, C_TG = 3328;
constexpr int NE = 32, DE = 512, A_TOT = T * 2;
constexpr float ALPHA = 1.681792830507429f;
constexpr float LN_EPS = 1e-5f, RWKV_GN_EPS = 64e-5f, RET_GN_EPS = 1e-6f;
constexpr float QC2 = 0.125f * 1.4426950408889634f;
constexpr int NTHREADS = 512;
#ifndef REP_P0
#define REP_P0 1
#endif
#ifndef REP_A
#define REP_A 1
#endif
#ifndef REP_C
#define REP_C 1
#endif
#ifndef REP_E
#define REP_E 1
#endif
#ifndef REP_F
#define REP_F 1
#endif
#ifndef REP_H
#define REP_H 1
#endif
#ifndef REP_IJ
#define REP_IJ 1
#endif
#ifndef REP_G
#define REP_G 1
#endif
#ifndef REP_K
#define REP_K 1
#endif
constexpr int LDS_MISC = 147456, LDS_ALL = 148480;

constexpr size_t MiB = 1u << 20;
constexpr size_t WS_CTL = 0, CTL_BYTES = 1 * MiB;
constexpr size_t WS_EP = 1 * MiB;
constexpr size_t WS_DEST = 2 * MiB;
constexpr size_t WS_GATE = 9 * MiB;
constexpr size_t WS_ROPE = 11 * MiB;
constexpr size_t WS_RKD = 15 * MiB;
constexpr size_t WS_WIN = 16 * MiB;
constexpr size_t WS_WOUT = 44 * MiB;
constexpr size_t WS_W13 = 52 * MiB;
constexpr size_t WS_W2 = 308 * MiB;
constexpr size_t WS_XB = 436 * MiB;
constexpr size_t WS_P = 500 * MiB;
constexpr size_t WS_MIXB = 724 * MiB;
constexpr size_t WS_CK = 788 * MiB;
constexpr size_t WS_LW = 3 * MiB;
constexpr size_t WS_YO = 788 * MiB;
constexpr size_t WS_XP = 500 * MiB;
constexpr size_t WS_H = 644 * MiB;
constexpr size_t WS_YP = 716 * MiB;
constexpr size_t WS_LCS = 1012 * MiB;
constexpr size_t WS_KA = 1014 * MiB;
constexpr size_t WS_END = 1018 * MiB;
constexpr size_t WS_WR = 5 * MiB;
constexpr size_t WS_SKIP = 4 * MiB + 65536;
constexpr size_t WS_TOT = 4 * MiB;
constexpr int CW_CNT = 32768;
constexpr int CW_Q = 2048;
constexpr int CW_L1 = 20480;
constexpr int CW_SF = 12288;
constexpr int CW_EQ = 4096;
constexpr int CW_CV = 6144;
constexpr int CW_BAR = 8192;
constexpr int MAXTILES = 288;

typedef float f32x16 __attribute__((ext_vector_type(16)));
typedef unsigned short bf16;

struct Args {
    const float* in[28]; float* out; unsigned char* ws;
};

__device__ __forceinline__ float sigmoidf_(float x) { return 1.0f / (1.0f + expf(-x)); }
__device__ __forceinline__ float logsigmoidf_(float x) { return x >= 0.f ? -log1pf(expf(-x)) : x - log1pf(expf(x)); }
__device__ __forceinline__ float wave_sum(float v) {
#define WS_DPP(ctrl, rmask) v += __builtin_bit_cast(float, __builtin_amdgcn_update_dpp(0, __builtin_bit_cast(int, v), ctrl, rmask, 0xf, false))
    WS_DPP(0x111, 0xf); WS_DPP(0x112, 0xf); WS_DPP(0x114, 0xf); WS_DPP(0x118, 0xf); WS_DPP(0x142, 0xa); WS_DPP(0x143, 0xc);
#undef WS_DPP
    return __builtin_bit_cast(float, __builtin_amdgcn_readlane(__builtin_bit_cast(int, v), 63));
}
__device__ __forceinline__ unsigned f2bf(float f) { unsigned u = __builtin_bit_cast(unsigned, f); return (u + 0x7fffu + ((u >> 16) & 1u)) >> 16; }
__device__ __forceinline__ unsigned pk2(float lo, float hi) { return f2bf(lo) | (f2bf(hi) << 16); }
__device__ __forceinline__ float bf2f(unsigned short b) { return __builtin_bit_cast(float, (unsigned)b << 16); }
__device__ __forceinline__ float pf(const bf16* Pb, size_t m, int c) { return bf2f(Pb[m * PW + c]); }

namespace pg8 {
#define PG8_LAS __attribute__((address_space(3)))
typedef unsigned short bf16_t;
typedef short bf16x8 __attribute__((ext_vector_type(8)));
typedef float f32x4 __attribute__((ext_vector_type(4)));
typedef unsigned u32x4 __attribute__((ext_vector_type(4)));
constexpr int BM = 256, BK = 64, HALF = 128, HTB = HALF * BK * 2  , STAGE_BYTES = 8 * HTB, NXCD = 8, WGM = 8;

__host__ __device__ __forceinline__ int lds_byte(int r, int c) { const int st = (r >> 4) * 2 + (c >> 5), rr = r & 15, cc = c & 31, ob = rr * 64 + cc * 2; return st * 1024 + (ob ^ (((ob >> 9) & 1) << 5)); }
__host__ __device__ __forceinline__ void stage_rc(int b, int& R, int& C) { const int st = b / 1024, sb = b % 1024, swz = sb ^ (((sb >> 9) & 1) << 5); R = (st >> 1) * 16 + swz / 64; C = (st & 1) * 32 + (swz % 64) / 2; }
__host__ __device__ __forceinline__ int perm32(int rho) { const int n = rho >> 4, i = rho & 15; return 8 * (i >> 2) + 4 * n + (i & 3); }

struct Unit { int pm, pn, pc; };
struct Gemm { const bf16_t* A; const bf16_t* Bt; int M, N, K; };

struct StaticOrder {
    int nM, nN, nwg, G, c;
    __host__ __device__ void init(int M, int N, int G_, int c_) { nM = M / BM; nN = N / BM; nwg = nM * nN; G = G_; c = c_; }
    __host__ __device__ bool next(int i, Unit& u) const {
        const long L = (long)i * G + c; if (L >= nwg) return false;
        int wgid = (int)L; { const int q = nwg / NXCD, r = nwg % NXCD, xcd = wgid % NXCD, off = wgid / NXCD; wgid = (xcd < r ? xcd * (q + 1) : r * (q + 1) + (xcd - r) * q) + off; }
        const int nig = WGM * nN, gid = wgid / nig, fm = gid * WGM, gsz = (nM - fm) < WGM ? (nM - fm) : WGM;
        u.pm = fm + ((wgid % nig) % gsz); u.pn = (wgid % nig) / gsz; u.pc = u.pn; return true;
    }
    __device__ __forceinline__ void a_ready(const Unit&) const {}
    __device__ __forceinline__ void done(const Unit&) const {}
};

__device__ __forceinline__ unsigned cvt_pk_bf16(float lo, float hi) { unsigned r; asm volatile("v_cvt_pk_bf16_f32 %0, %1, %2" : "=v"(r) : "v"(lo), "v"(hi)); return r; }

struct EpiF32 {
    static constexpr bool PERM = false, AFTER_DRAIN = false;
    float* O; int ldc;
    __device__ __forceinline__ void operator()(const f32x4 (&acc)[2][2][4][2], const Unit& u, int wr, int wc, int fr, int fq) const {
        const int row0 = u.pm * BM + wr * 64 + fr; const int col0 = u.pc * BM + wc * 32 + 4 * fq;
#pragma unroll
        for (int ai = 0; ai < 2; ++ai)
#pragma unroll
            for (int m = 0; m < 4; ++m) { float* rowp = O + (size_t)(row0 + ai * HALF + m * 16) * ldc + col0;
#pragma unroll
                for (int bj = 0; bj < 2; ++bj)
#pragma unroll
                    for (int n = 0; n < 2; ++n) *(f32x4*)(rowp + bj * HALF + n * 16) = acc[ai][bj][m][n]; }
    }
};
struct EpiSwiGlu {
    static constexpr bool PERM = true, AFTER_DRAIN = false;
    bf16_t* O; int ldc;
    __device__ __forceinline__ static float silu(float v) { return v * __builtin_amdgcn_rcpf(1.0f + __builtin_amdgcn_exp2f(-1.4426950408889634f * v)); }
    __device__ __forceinline__ void operator()(const f32x4 (&acc)[2][2][4][2], const Unit& u, int wr, int wc, int fr, int fq) const {
        const int row0 = u.pm * BM + wr * 64 + fr; const int col0 = u.pc * HALF + wc * 32 + 8 * fq;
#pragma unroll
        for (int ai = 0; ai < 2; ++ai)
#pragma unroll
            for (int m = 0; m < 4; ++m) { bf16_t* rowp = O + (size_t)(row0 + ai * HALF + m * 16) * ldc + col0;
                f32x4 h0, h1;
#pragma unroll
                for (int e = 0; e < 4; ++e) { h0[e] = silu(acc[ai][0][m][0][e]) * acc[ai][1][m][0][e]; h1[e] = silu(acc[ai][0][m][1][e]) * acc[ai][1][m][1][e]; }
                u32x4 w; w.x = cvt_pk_bf16(h0[0], h0[1]); w.y = cvt_pk_bf16(h0[2], h0[3]); w.z = cvt_pk_bf16(h1[0], h1[1]); w.w = cvt_pk_bf16(h1[2], h1[3]);
                *(u32x4*)rowp = w; }
    }
};
struct MoeOrder {
    int ntile, G, c; const PG8_LAS int* tile_e;
    __device__ __forceinline__ bool next(int i, Unit& u) const { const int L = i * G + c; if (L >= ntile * 4) return false; const int rt = L >> 2, pn = L & 3; u.pm = rt; u.pn = tile_e[rt] * 4 + pn; u.pc = pn; return true; }
    __device__ __forceinline__ void a_ready(const Unit&) const {}
    __device__ __forceinline__ void done(const Unit&) const {}
};
struct EpiInProj {
    static constexpr bool PERM = true, AFTER_DRAIN = false;
    bf16_t* O; int ldc; float qscale;
    __device__ __forceinline__ void operator()(const f32x4 (&acc)[2][2][4][2], const Unit& u, int wr, int wc, int fr, int fq) const {
        const int row0 = u.pm * BM + wr * 64 + fr; const int col0 = u.pc * BM + wc * 32 + 8 * fq;
        const float sc = (u.pc < 2) ? qscale : 1.f;
#pragma unroll
        for (int ai = 0; ai < 2; ++ai)
#pragma unroll
            for (int m = 0; m < 4; ++m) { bf16_t* rowp = O + (size_t)(row0 + ai * HALF + m * 16) * ldc + col0;
#pragma unroll
                for (int bj = 0; bj < 2; ++bj) { const f32x4 v0 = acc[ai][bj][m][0] * sc, v1 = acc[ai][bj][m][1] * sc;
                    u32x4 w; w.x = cvt_pk_bf16(v0[0], v0[1]); w.y = cvt_pk_bf16(v0[2], v0[3]); w.z = cvt_pk_bf16(v1[0], v1[1]); w.w = cvt_pk_bf16(v1[2], v1[3]);
                    *(u32x4*)(rowp + bj * HALF) = w; } }
    }
};
template <class Epi, class Sched, bool ALIGN_EPI = false, bool SP2 = false>
__device__ __forceinline__ void gemm_phase(PG8_LAS unsigned char* lds, const Gemm g, const Sched& S, const Epi& E) {
    const int tid = ltid(), wid = __builtin_amdgcn_readfirstlane(tid >> 6), lane = tid & 63, wr = wid >> 2, wc = wid & 3, fr = lane & 15, fq = lane >> 4;
    const int K = g.K, nt = K / BK;
    unsigned voffA[2], voffB[2];
#pragma unroll
    for (int i = 0; i < 2; ++i) { int R, C; stage_rc(tid * 16 + i * 8192, R, C); const int Rb = Epi::PERM ? ((R & ~31) + perm32(R & 31)) : R;
        voffA[i] = (unsigned)(R * K + C) * 2u; voffB[i] = (unsigned)(Rb * K + C) * 2u; }
    const size_t kstep = (size_t)(BK * 2);
    const size_t hstep = (size_t)HALF * K * 2;
    const size_t tstep = 2 * hstep;
    const unsigned ldsw = (unsigned)wid * 1024u;
    const int aoff = lds_byte(wr * 64 + fr, fq * 8), boff = lds_byte(wc * 32 + fr, fq * 8);
#define PG8_SA(b, h) (((b) * 2 + (h)) * HTB)
#define PG8_SB(b, h) ((4 + (b) * 2 + (h)) * HTB)
#define PG8_STAGE(bufoff, gbase, voff) do { _Pragma("unroll") for (int _i = 0; _i < 2; ++_i) \
        __builtin_amdgcn_global_load_lds((const unsigned*)((const char*)(gbase) + (voff)[_i]), (PG8_LAS unsigned*)(lds + (bufoff) + ldsw + _i * 8192), 16, 0, 0); } while (0)
#define PG8_LDA(dst, b, h) do { _Pragma("unroll") for (int m = 0; m < 4; ++m) _Pragma("unroll") for (int k = 0; k < 2; ++k) dst[m][k] = *(const PG8_LAS bf16x8*)(lds + PG8_SA(b, h) + aoff + m * 2048 + k * 1024); } while (0)
#define PG8_LDB(dst, b, h) do { _Pragma("unroll") for (int n = 0; n < 2; ++n) _Pragma("unroll") for (int k = 0; k < 2; ++k) dst[n][k] = *(const PG8_LAS bf16x8*)(lds + PG8_SB(b, h) + boff + n * 2048 + k * 1024); } while (0)
#define PG8_MMA(ai, bj, At, Bt) do { __builtin_amdgcn_s_setprio(1); _Pragma("unroll") for (int m = 0; m < 4; ++m) _Pragma("unroll") for (int n = 0; n < 2; ++n) _Pragma("unroll") for (int k = 0; k < 2; ++k) \
        acc[ai][bj][m][n] = __builtin_amdgcn_mfma_f32_16x16x32_bf16(Bt[n][k], At[m][k], acc[ai][bj][m][n], 0, 0, 0); __builtin_amdgcn_s_setprio(0); } while (0)
#define PG8_WAIT_V(n) asm volatile("s_waitcnt vmcnt(" #n ")" ::: "memory")
#define PG8_WAIT_L(n) asm volatile("s_waitcnt lgkmcnt(" #n ")" ::: "memory")
#define PG8_BAR __builtin_amdgcn_s_barrier()
#define PG8_SCHED __builtin_amdgcn_sched_barrier(0)
    Unit cur, nxt; int ui = 0;
    if (!S.next(0, cur)) return;
    f32x4 acc[2][2][4][2];
#pragma unroll
    for (int a = 0; a < 2; ++a)
#pragma unroll
        for (int b = 0; b < 2; ++b)
#pragma unroll
            for (int m = 0; m < 4; ++m)
#pragma unroll
                for (int n = 0; n < 2; ++n) acc[a][b][m][n] = (f32x4){0.f, 0.f, 0.f, 0.f};
    bf16x8 At[4][2], B0[2][2], B1[2][2];
    const char* cA = (const char*)g.A + (size_t)cur.pm * tstep; const char* cB = (const char*)g.Bt + (size_t)cur.pn * tstep;
    S.a_ready(cur);
    if constexpr (SP2) {
        PG8_STAGE(PG8_SB(0, 0), cB, voffB); PG8_STAGE(PG8_SB(0, 1), cB + hstep, voffB); PG8_STAGE(PG8_SA(0, 0), cA, voffA); PG8_STAGE(PG8_SA(0, 1), cA + hstep, voffA);
        if (wr == 1) PG8_BAR;
        PG8_WAIT_V(2); PG8_BAR;
        PG8_STAGE(PG8_SB(1, 0), cB + kstep, voffB); PG8_STAGE(PG8_SA(1, 0), cA + kstep, voffA); PG8_STAGE(PG8_SB(1, 1), cB + hstep + kstep, voffB);
        PG8_WAIT_V(6); PG8_BAR;
    } else {
        PG8_STAGE(PG8_SB(0, 0), cB, voffB); PG8_STAGE(PG8_SA(0, 0), cA, voffA); PG8_STAGE(PG8_SB(0, 1), cB + hstep, voffB); PG8_STAGE(PG8_SA(0, 1), cA + hstep, voffA);
        if (wr == 1) PG8_BAR;
        PG8_WAIT_V(4); PG8_BAR;
        PG8_STAGE(PG8_SB(1, 0), cB + kstep, voffB); PG8_STAGE(PG8_SA(1, 0), cA + kstep, voffA); PG8_STAGE(PG8_SB(1, 1), cB + hstep + kstep, voffB);
        PG8_WAIT_V(6); PG8_BAR;
    }
    for (;;) {
        const bool has_next = S.next(ui + 1, nxt);
        const char* nA = has_next ? (const char*)g.A + (size_t)nxt.pm * tstep : cA; const char* nB = has_next ? (const char*)g.Bt + (size_t)nxt.pn * tstep : cB;
        for (int t = 0; t < nt; t += 2) {
            const bool last = (t == nt - 2);
            const char* a1 = cA + (size_t)(t + 1) * kstep;
            const char* a2 = last ? nA : cA + (size_t)(t + 2) * kstep; const char* b2 = last ? nB : cB + (size_t)(t + 2) * kstep;
            const char* a3 = a2 + kstep; const char* b3 = b2 + kstep;
            if (last && has_next) S.a_ready(nxt);
            if constexpr (SP2) {
            PG8_LDB(B0, 0, 0); PG8_LDB(B1, 0, 1); PG8_SCHED; PG8_LDA(At, 0, 0); PG8_STAGE(PG8_SA(1, 1), a1 + hstep, voffA);
            PG8_WAIT_V(8); PG8_WAIT_L(0); PG8_BAR; PG8_MMA(0, 0, At, B0); PG8_MMA(0, 1, At, B1); PG8_BAR; PG8_SCHED;
            PG8_LDA(At, 0, 1); PG8_STAGE(PG8_SB(0, 0), b2, voffB); PG8_STAGE(PG8_SB(0, 1), b2 + hstep, voffB); PG8_STAGE(PG8_SA(0, 0), a2, voffA);
            PG8_WAIT_V(8); PG8_WAIT_L(0); PG8_BAR; PG8_MMA(1, 0, At, B0); PG8_MMA(1, 1, At, B1); PG8_BAR; PG8_SCHED;
            PG8_LDB(B0, 1, 0); PG8_LDB(B1, 1, 1); PG8_SCHED; PG8_LDA(At, 1, 0); PG8_STAGE(PG8_SA(0, 1), a2 + hstep, voffA);
            PG8_WAIT_V(8); PG8_WAIT_L(0); PG8_BAR; PG8_MMA(0, 0, At, B0); PG8_MMA(0, 1, At, B1); PG8_BAR; PG8_SCHED;
            PG8_LDA(At, 1, 1); PG8_STAGE(PG8_SB(1, 0), b3, voffB); PG8_STAGE(PG8_SB(1, 1), b3 + hstep, voffB); PG8_STAGE(PG8_SA(1, 0), a3, voffA);
            PG8_WAIT_V(8); PG8_WAIT_L(0); PG8_BAR; PG8_MMA(1, 0, At, B0); PG8_MMA(1, 1, At, B1); PG8_BAR; PG8_SCHED;
            } else {
            PG8_LDB(B0, 0, 0); PG8_SCHED; PG8_LDA(At, 0, 0); PG8_STAGE(PG8_SA(1, 1), a1 + hstep, voffA);
            PG8_WAIT_L(8); PG8_BAR; PG8_WAIT_L(0); PG8_MMA(0, 0, At, B0); PG8_BAR; PG8_SCHED;
            PG8_LDB(B1, 0, 1); PG8_STAGE(PG8_SB(0, 0), b2, voffB);
            PG8_BAR; PG8_WAIT_L(0); PG8_MMA(0, 1, At, B1); PG8_BAR;
            PG8_LDA(At, 0, 1); PG8_STAGE(PG8_SA(0, 0), a2, voffA);
            PG8_BAR; PG8_WAIT_L(0); PG8_MMA(1, 0, At, B0); PG8_BAR; PG8_SCHED;
            PG8_STAGE(PG8_SB(0, 1), b2 + hstep, voffB);
            PG8_WAIT_V(6); PG8_BAR; PG8_MMA(1, 1, At, B1); PG8_BAR;
            PG8_LDB(B0, 1, 0); PG8_SCHED; PG8_LDA(At, 1, 0); PG8_STAGE(PG8_SA(0, 1), a2 + hstep, voffA);
            PG8_WAIT_L(8); PG8_BAR; PG8_WAIT_L(0); PG8_MMA(0, 0, At, B0); PG8_BAR; PG8_SCHED;
            PG8_LDB(B1, 1, 1); PG8_STAGE(PG8_SB(1, 0), b3, voffB);
            PG8_BAR; PG8_WAIT_L(0); PG8_MMA(0, 1, At, B1); PG8_BAR;
            PG8_LDA(At, 1, 1); PG8_STAGE(PG8_SA(1, 0), a3, voffA);
            PG8_BAR; PG8_WAIT_L(0); PG8_MMA(1, 0, At, B0); PG8_BAR; PG8_SCHED;
            PG8_STAGE(PG8_SB(1, 1), b3 + hstep, voffB);
            PG8_WAIT_V(6); PG8_BAR; PG8_MMA(1, 1, At, B1); PG8_BAR;
            }
        }
        if constexpr (ALIGN_EPI) { if (wr == 0) PG8_BAR; }
        if constexpr (!Epi::AFTER_DRAIN) { E(acc, cur, wr, wc, fr, fq); S.done(cur); }
        if (!has_next) break;
#pragma unroll
        for (int a = 0; a < 2; ++a)
#pragma unroll
            for (int b = 0; b < 2; ++b)
#pragma unroll
                for (int m = 0; m < 4; ++m)
#pragma unroll
                    for (int n = 0; n < 2; ++n) acc[a][b][m][n] = (f32x4){0.f, 0.f, 0.f, 0.f};
        cur = nxt; cA = nA; cB = nB; ++ui;
        if constexpr (ALIGN_EPI) { if (wr == 1) PG8_BAR; }
    }
    PG8_WAIT_V(0);
    if constexpr (!ALIGN_EPI) { if (wr == 0) PG8_BAR; }
    PG8_BAR;
    if constexpr (Epi::AFTER_DRAIN) { E.fused(acc, cur, wr, wc, fr, fq, lds, wid, lane); S.done(cur); }
#undef PG8_SA
#undef PG8_SB
#undef PG8_STAGE
#undef PG8_LDA
#undef PG8_LDB
#undef PG8_MMA
#undef PG8_WAIT_V
#undef PG8_WAIT_L
#undef PG8_BAR
#undef PG8_SCHED
}
}

template <class RowMap, class Epi>
__device__ __forceinline__ void gemm_tile_f32(float* lds, const float* __restrict__ A, int lda, RowMap rowmap, int nvalid,
                                              const float* __restrict__ B, int ldb, int col0, int N, int K, Epi epi) {
    float* As = lds;
    float* Bs = lds + 128 * 17;
    const int tid = ltid(), lane = tid & 63, wid = tid >> 6, wm = wid & 3, wn = wid >> 2;
    const int arow = tid >> 2, akq = (tid & 3) * 4;
    const int src = (arow < nvalid) ? rowmap(arow) : -1;
    const float* ap = A + (size_t)(src < 0 ? 0 : src) * lda + akq;
    const int bk = tid >> 5, bn = (tid & 31) * 4;
    const bool bok = (col0 + bn) < N;
    const float* bp = B + (size_t)bk * ldb + col0 + bn;
    f32x16 acc0 = {}, acc1 = {};
    for (int k0 = 0; k0 < K; k0 += 16) {
        pg8::f32x4 av = (pg8::f32x4){0.f, 0.f, 0.f, 0.f}, bv = (pg8::f32x4){0.f, 0.f, 0.f, 0.f};
        if (src >= 0) av = *(const pg8::f32x4*)(ap + k0);
        if (bok) bv = *(const pg8::f32x4*)(bp + (size_t)k0 * ldb);
        __syncthreads();
        As[arow * 17 + akq + 0] = av[0]; As[arow * 17 + akq + 1] = av[1]; As[arow * 17 + akq + 2] = av[2]; As[arow * 17 + akq + 3] = av[3];
        *(pg8::f32x4*)(Bs + bk * 132 + bn) = bv;
        __syncthreads();
#pragma unroll
        for (int kk = 0; kk < 16; kk += 2) {
            const float a = As[(32 * wm + (lane & 31)) * 17 + kk + (lane >> 5)];
            const float b0 = Bs[(kk + (lane >> 5)) * 132 + 64 * wn + (lane & 31)];
            const float b1 = Bs[(kk + (lane >> 5)) * 132 + 64 * wn + 32 + (lane & 31)];
            acc0 = __builtin_amdgcn_mfma_f32_32x32x2f32(a, b0, acc0, 0, 0, 0);
            acc1 = __builtin_amdgcn_mfma_f32_32x32x2f32(a, b1, acc1, 0, 0, 0);
        }
    }
#pragma unroll
    for (int r = 0; r < 16; ++r) {
        const int i = 32 * wm + (r & 3) + 8 * (r >> 2) + 4 * (lane >> 5);
        const int c0 = col0 + 64 * wn + (lane & 31);
        if (i < nvalid) {
            if (c0 < N) epi(i, c0, acc0[r]);
            if (c0 + 32 < N) epi(i, c0 + 32, acc1[r]);
        }
    }
}

#include <hip/hip_bf16.h>
namespace attn_body {
using bf16=__hip_bfloat16;
using bf16x8=__attribute__((ext_vector_type(8)))short;
using s16x4=__attribute__((ext_vector_type(4)))short;
using f32x16=__attribute__((ext_vector_type(16)))float;
using u32x4=__attribute__((ext_vector_type(4)))unsigned;
typedef float f32x4_t __attribute__((ext_vector_type(4)));
constexpr int BATCH=2,NHEAD=8,SEQ=16384,D=64,DM=3584,OP=1024;
constexpr int NW=8,QBLK=32,QB=QBLK*NW,KVBLK=64,NQB=SEQ/QB;
constexpr int ATTN_PITCH=DM, ATTN_UNIT_ROWS=QB;
__device__ __forceinline__ int crow(int r,int hi){return (r&3)+8*(r>>2)+4*hi;}
#define SBAR() __builtin_amdgcn_sched_barrier(0)
__device__ __forceinline__ void cmask(f32x16&p0,f32x16&p1,int jb,int qrel,int hi){
  const float NEG=-INFINITY; int kb=64*jb+4*hi;
  #pragma unroll
  for(int r=0;r<16;++r){int kv=kb+(r&3)+8*(r>>2); if(kv>qrel)p0[r]=NEG; if(kv+32>qrel)p1[r]=NEG;}
}

constexpr int NSLOT=3, SLOTB=8192;
constexpr int LDS_K=0, LDS_V=NSLOT*SLOTB, LDS_WS=2*NSLOT*SLOTB, LDS_OST=LDS_WS+NW*64*4, LDS_BYTES=LDS_OST+NW*4096;
constexpr float C2=0.125f*1.4426950408889634f;
__device__ __forceinline__ void glds16(const void*gsrc,unsigned lds_dst){unsigned keep;
  asm volatile("s_mov_b32 %0, m0\n\ts_mov_b32 m0, %2\n\ts_nop 0\n\tglobal_load_lds_dwordx4 %1, off\n\ts_mov_b32 m0, %0":"=&s"(keep):"v"(gsrc),"s"(lds_dst):"memory");}
__device__ __forceinline__ float max3f(float a,float b,float c){float r;asm("v_max3_f32 %0, %1, %2, %3":"=v"(r):"v"(a),"v"(b),"v"(c));return r;}
__device__ __forceinline__ float max2f(float a,float b){float r;asm("v_max_f32_e32 %0, %1, %2":"=v"(r):"v"(a),"v"(b));return r;}
__device__ __forceinline__ float fadd_s(float a,float b){float r;asm("v_add_f32_e32 %0, %1, %2":"=v"(r):"v"(a),"v"(b));return r;}
__device__ __forceinline__ float fsub_s(float a,float b){float r;asm("v_sub_f32_e32 %0, %1, %2":"=v"(r):"v"(a),"v"(b));return r;}
typedef float f32x2_t __attribute__((ext_vector_type(2))); typedef __bf16 bf16x2_t __attribute__((ext_vector_type(2)));
__device__ __forceinline__ unsigned cvtpk_s(float lo,float hi){f32x2_t v={lo,hi};bf16x2_t b=__builtin_convertvector(v,bf16x2_t);return __builtin_bit_cast(unsigned,b);}
#define WAIT_BAR(N) asm volatile("s_waitcnt vmcnt(" #N ") lgkmcnt(0)\n\ts_barrier":::"memory")

__device__ __forceinline__ void qkt(f32x16&p0,f32x16&p1,const char*Kslot,const bf16x8*qr,int r32,int hi){
  const char*kb=Kslot+hi*1024+r32*16;
  #pragma unroll
  for(int d0=0;d0<4;++d0){
    const bf16x8 b0=*reinterpret_cast<const bf16x8*>(kb+d0*2048);
    const bf16x8 b1=*reinterpret_cast<const bf16x8*>(kb+d0*2048+512);
    p0=__builtin_amdgcn_mfma_f32_32x32x16_bf16(b0,qr[d0],p0,0,0,0);p1=__builtin_amdgcn_mfma_f32_32x32x16_bf16(b1,qr[d0],p1,0,0,0);}
}
typedef __attribute__((address_space(3))) const char* lds_cptr;
typedef short v4i16_t __attribute__((ext_vector_type(4)));
__device__ __forceinline__ void kload8(bf16x8*kf,lds_cptr kp){
  kf[0]=*(const __attribute__((address_space(3))) bf16x8*)(kp);      kf[1]=*(const __attribute__((address_space(3))) bf16x8*)(kp+512);
  kf[2]=*(const __attribute__((address_space(3))) bf16x8*)(kp+2048); kf[3]=*(const __attribute__((address_space(3))) bf16x8*)(kp+2560);
  kf[4]=*(const __attribute__((address_space(3))) bf16x8*)(kp+4096); kf[5]=*(const __attribute__((address_space(3))) bf16x8*)(kp+4608);
  kf[6]=*(const __attribute__((address_space(3))) bf16x8*)(kp+6144); kf[7]=*(const __attribute__((address_space(3))) bf16x8*)(kp+6656);
}
__device__ __forceinline__ void kload2(bf16x8*kf,lds_cptr kp,int j){ kf[2*j]=*(const __attribute__((address_space(3))) bf16x8*)(kp+j*2048); kf[2*j+1]=*(const __attribute__((address_space(3))) bf16x8*)(kp+j*2048+512); }
__device__ __forceinline__ s16x4 vtr(lds_cptr p){ return __builtin_bit_cast(s16x4,__builtin_amdgcn_ds_read_tr16_b64_v4i16((__attribute__((address_space(3))) v4i16_t*)p)); }
__device__ __forceinline__ float rowmax(const f32x16&p0,const f32x16&p1){
  float a=max3f(p0[0],p0[1],p1[0]),b=max3f(p0[2],p0[3],p1[1]);a=max3f(a,p1[2],p1[3]);
  #pragma unroll
  for(int r=4;r<16;r+=4){a=max3f(a,p0[r],p0[r+1]);b=max3f(b,p0[r+2],p0[r+3]);a=max3f(a,p1[r],p1[r+1]);b=max3f(b,p1[r+2],p1[r+3]);}
  const float m=max2f(a,b);
  auto rr=__builtin_amdgcn_permlane32_swap(__float_as_uint(m),__float_as_uint(m),false,false);
  return max2f(__uint_as_float(rr[0]),__uint_as_float(rr[1]));
}
__device__ __forceinline__ void pv(f32x16*o,int vb,bf16x8 pa0,bf16x8 pa1,bf16x8 pa2,bf16x8 pa3){
  #pragma unroll
  for(int d0=0;d0<2;++d0){s16x4 lo[4],hi[4];
    #pragma unroll
    for(int ks=0;ks<4;++ks){
      asm volatile("ds_read_b64_tr_b16 %0,%1 offset:%c2":"=&v"(lo[ks]):"v"(vb),"i"(d0*4096+ks*1024):"memory");
      asm volatile("ds_read_b64_tr_b16 %0,%1 offset:%c2":"=&v"(hi[ks]):"v"(vb),"i"(d0*4096+ks*1024+512):"memory");}
    asm volatile("s_waitcnt lgkmcnt(0)":::"memory");SBAR();
    #define PK(k) (bf16x8){lo[k][0],lo[k][1],lo[k][2],lo[k][3],hi[k][0],hi[k][1],hi[k][2],hi[k][3]}
    o[d0]=__builtin_amdgcn_mfma_f32_32x32x16_bf16(pa0,PK(0),o[d0],0,0,0);
    o[d0]=__builtin_amdgcn_mfma_f32_32x32x16_bf16(pa1,PK(1),o[d0],0,0,0);
    o[d0]=__builtin_amdgcn_mfma_f32_32x32x16_bf16(pa2,PK(2),o[d0],0,0,0);
    o[d0]=__builtin_amdgcn_mfma_f32_32x32x16_bf16(pa3,PK(3),o[d0],0,0,0);
    #undef PK
  }
}

#ifndef ATTN_STORE16
#define ATTN_STORE16(p,v) (*(u32x4*)(p)=(v))
#endif
template<int THRL> __device__ __forceinline__ void attn_unit(int b,int h,int qb,int t0,const bf16*Q,const bf16*__restrict__ K,const bf16*__restrict__ V,bf16*O,const unsigned char*KAg,char*shm){
  const int tid=ltid(),lane=tid&63,r32=lane&31,hi=lane>>5; const int wid=__builtin_amdgcn_readfirstlane(tid>>6);
  const long rowbase=(long)b*SEQ; const int q0=qb*QB;
  const bf16*Qw=Q+(rowbase+q0+wid*QBLK)*DM+h*D;
  const bf16*Kh=K+(rowbase+(long)t0*KVBLK)*DM+h*D,*Vh=V+(rowbase+(long)t0*KVBLK)*DM+h*D;
  const unsigned lds0=(unsigned)(uintptr_t)shm;
  float*wsf=(float*)(shm+LDS_WS)+wid*64;
  const bf16*ksrc=Kh+(long)lane*DM+wid*8;
  const bf16*vsrc=Vh+(long)(16*(wid&3)+(lane>>2))*DM+(wid>>2)*32+(lane&3)*8;
  const unsigned kdst=lds0+LDS_K+wid*1024, vdst=lds0+LDS_V+wid*1024;
  #define DMA_K(t,slot) glds16(ksrc+(long)(t)*KVBLK*DM,(unsigned)__builtin_amdgcn_readfirstlane(kdst+(slot)))
  #define DMA_V(t,slot) glds16(vsrc+(long)(t)*KVBLK*DM,(unsigned)__builtin_amdgcn_readfirstlane(vdst+(slot)))
  const int vb0=(int)(lds0+LDS_V)+((lane>>4)&1)*32+(lane&3)*8+(4*hi+((lane&15)>>2))*64;
  const char*Kbase=shm+LDS_K; bf16x8 kf[8];
  const lds_cptr shm3=(lds_cptr)shm; const lds_cptr kp0=shm3+LDS_K+hi*1024+r32*16; const lds_cptr vp0=shm3+LDS_V+((lane>>4)&1)*32+(lane&3)*8+(4*hi+((lane&15)>>2))*64;
  const int NT=(q0+QB)/KVBLK-t0;
  u32x4 ka0,ka1; u32x4 qaw;
  const unsigned kavoff=(unsigned)r32*16u;
  const unsigned long long kab0=(unsigned long long)(uintptr_t)KAg+((unsigned long long)((b*NHEAD+h)*(long)SEQ+(long)t0*KVBLK))*16ull;
  #define KA_LOAD(t) do{ const unsigned long long a_=kab0+(unsigned long long)(t)*1024ull; const unsigned lo_=__builtin_amdgcn_readfirstlane((unsigned)a_),hi_=__builtin_amdgcn_readfirstlane((unsigned)(a_>>32)); \
    const unsigned long long sb_=((unsigned long long)hi_<<32)|lo_; \
    asm volatile("s_nop 4\n\tglobal_load_dwordx4 %0, %2, %3\n\tglobal_load_dwordx4 %1, %2, %3 offset:512":"=&v"(ka0),"=&v"(ka1):"v"(kavoff),"s"(sb_):"memory"); }while(0)
  #define QA_SET() do{ const float nm_=-mhat; const unsigned h_=cvtpk_s(nm_,0.f)&0xffffu; const float r1_=nm_-__uint_as_float(h_<<16); const unsigned m_=cvtpk_s(r1_,0.f)&0xffffu; \
    const float r2_=r1_-__uint_as_float(m_<<16); const unsigned l_=cvtpk_s(r2_,0.f)&0xffffu; \
    qaw[0]=hi?0u:0x3f803f80u; qaw[1]=hi?0u:(0x3f80u|(h_<<16)); qaw[2]=hi?0u:(m_|(l_<<16)); qaw[3]=0u; asm volatile("":"+v"(qaw)); }while(0)
  #define AUG(C0,C1) do{ C0=__builtin_amdgcn_mfma_f32_32x32x16_bf16(__builtin_bit_cast(bf16x8,ka0),__builtin_bit_cast(bf16x8,qaw),f32x16{},0,0,0); \
    C1=__builtin_amdgcn_mfma_f32_32x32x16_bf16(__builtin_bit_cast(bf16x8,ka1),__builtin_bit_cast(bf16x8,qaw),f32x16{},0,0,0); }while(0)
  #define PIN_KA() asm volatile("; KA landed":"+v"(ka0),"+v"(ka1)::"memory")
  #define WAIT_BAR_KA(N) do{ WAIT_BAR(N); PIN_KA(); }while(0)
  KA_LOAD(0);
  DMA_K(0,0);DMA_V(0,0);DMA_K(1,SLOTB);
  bf16x8 qr[4];
  #pragma unroll
  for(int d0=0;d0<4;++d0)qr[d0]=*reinterpret_cast<const bf16x8*>(&Qw[(long)r32*DM+d0*16+hi*8]);
  float mhat=0.f,l_reg=0.f;f32x16 o[2];o[0]=f32x16{};o[1]=f32x16{}; QA_SET();
  const int qrel=wid*QBLK+r32;
  #define CMASK(P0,P1,t) do{int jb_=(t)-(NT-4); if(jb_>=0)cmask(P0,P1,jb_,qrel,hi);}while(0)
  bool resc=false;
  #define START(P0,P1) do{ const float rm=rowmax(P0,P1); resc=false; \
    { const float dl=rm; mhat=fadd_s(mhat,dl); \
      _Pragma("unroll") for(int r=0;r<16;++r){P0[r]=fsub_s(P0[r],dl);P1[r]=fsub_s(P1[r],dl);} \
      QA_SET(); } \
    _Pragma("unroll") for(int r=0;r<16;++r)P0[r]=__builtin_amdgcn_exp2f(P0[r]); }while(0)
  #define RESC() do{ if(resc){ asm volatile("s_waitcnt lgkmcnt(0)":::"memory"); \
      _Pragma("unroll") for(int d_=0;d_<2;++d_) _Pragma("unroll") for(int r=0;r<16;++r)o[d_][r]*=wsf[crow(r,hi)]; } }while(0)
  f32x16 pA0,pA1,pB0,pB1;
  int sl_prev=0,sl_cur=0,sl_next=SLOTB;
  #define ROT() do{sl_prev=sl_cur;sl_cur=sl_next;sl_next=(sl_next==(NSLOT-1)*SLOTB)?0:sl_next+SLOTB;}while(0)
  DMA_K(2,2*SLOTB);
  WAIT_BAR_KA(3);
  AUG(pA0,pA1); qkt(pA0,pA1,Kbase,qr,r32,hi);asm volatile("s_nop 15\n\ts_nop 7":"+v"(pA0),"+v"(pA1));CMASK(pA0,pA1,0);
  START(pA0,pA1);
  _Pragma("unroll") for(int r=0;r<16;++r)pA1[r]=__builtin_amdgcn_exp2f(pA1[r]);
  WAIT_BAR(0);
  KA_LOAD(1);DMA_K(3,0);DMA_V(1,SLOTB);
  ROT();
  kload8(kf,kp0+sl_cur);
  WAIT_BAR_KA(2);
  s16x4 vlo[8],vhi[8]; u32x4 pw0,pw1,pw2,pw3;
  #define PKW(P,B) cvtpk_s(P[B],P[B+1])
  #define PAF(k) __builtin_bit_cast(bf16x8,pw##k)
  #define VFR(i) (bf16x8){vlo[i][0],vlo[i][1],vlo[i][2],vlo[i][3],vhi[i][0],vhi[i][1],vhi[i][2],vhi[i][3]}
  #define PIN(x) asm volatile("":"+v"(x))
  #define MX3(a,b,c) __builtin_fmaxf(__builtin_fmaxf((a),(b)),(c))
  #define GAPA(MF,A0,A1,A2,A3,W0,W1,PW) do{ MF; sacc+=A0; sacc+=A1; sacc+=A2; sacc+=A3; PIN(sacc); W0; W1; PIN(PW); SBAR(); }while(0)
  #define EX(v) __builtin_amdgcn_exp2f(v)
  #define GAPB(MF,X,B) do{ MF; X[B]=EX(X[B]); X[B+1]=EX(X[B+1]); X[B+2]=EX(X[B+2]); X[B+3]=EX(X[B+3]); PIN(X); SBAR(); }while(0)
  #define VRD(i) do{ vlo[i]=vtr(vp_+(((i)>>2)*4096+((i)&3)*1024)); vhi[i]=vtr(vp_+(((i)>>2)*4096+((i)&3)*1024+512)); }while(0)
  #define KRD(G,j) do{ if(G){ kload2(kf,kp0+sl_next,j); SBAR(); } }while(0)
  #define STEP(C0,C1,P0,P1,t,GK,GV,GL) do{ SBAR(); \
    const lds_cptr vp_=vp0+sl_prev; \
    AUG(C0,C1); SBAR(); \
    VRD(0); SBAR(); float sacc=(P0[0]+P0[1]); \
    GAPA(C0=__builtin_amdgcn_mfma_f32_32x32x16_bf16(kf[0],qr[0],C0,0,0,0), P0[2],P0[3],P0[4],P0[5],     pw0[0]=PKW(P0,0), pw0[1]=PKW(P0,2), pw0); \
    VRD(4); SBAR(); GAPA(C1=__builtin_amdgcn_mfma_f32_32x32x16_bf16(kf[1],qr[0],C1,0,0,0), P0[6],P0[7],P0[8],P0[9],     pw0[2]=PKW(P0,4), pw0[3]=PKW(P0,6), pw0); \
    VRD(1); SBAR(); GAPA(C0=__builtin_amdgcn_mfma_f32_32x32x16_bf16(kf[2],qr[1],C0,0,0,0),   P0[10],P0[11],P0[12],P0[13], pw1[0]=PKW(P0,8), pw1[1]=PKW(P0,10), pw1); \
    VRD(5); SBAR(); GAPA(C1=__builtin_amdgcn_mfma_f32_32x32x16_bf16(kf[3],qr[1],C1,0,0,0),   P0[14],P0[15],P1[0],P1[1],   pw1[2]=PKW(P0,12),pw1[3]=PKW(P0,14), pw1); \
    VRD(2); SBAR(); GAPA(C0=__builtin_amdgcn_mfma_f32_32x32x16_bf16(kf[4],qr[2],C0,0,0,0),   P1[2],P1[3],P1[4],P1[5],     pw2[0]=PKW(P1,0), pw2[1]=PKW(P1,2), pw2); \
    VRD(6); SBAR(); GAPA(C1=__builtin_amdgcn_mfma_f32_32x32x16_bf16(kf[5],qr[2],C1,0,0,0),   P1[6],P1[7],P1[8],P1[9],     pw2[2]=PKW(P1,4), pw2[3]=PKW(P1,6), pw2); \
    VRD(3); SBAR(); GAPA(C0=__builtin_amdgcn_mfma_f32_32x32x16_bf16(kf[6],qr[3],C0,0,0,0),   P1[10],P1[11],P1[12],P1[13], pw3[0]=PKW(P1,8), pw3[1]=PKW(P1,10), pw3); \
    VRD(7); SBAR(); GAPA(C1=__builtin_amdgcn_mfma_f32_32x32x16_bf16(kf[7],qr[3],C1,0,0,0),   P1[14],P1[15],0.f,0.f,       pw3[2]=PKW(P1,12),pw3[3]=PKW(P1,14), pw3); \
    l_reg+=sacc; \
    if(GL){KA_LOAD((t)+1);} if(GK){DMA_K((t)+3,sl_cur);} if(GV){DMA_V((t)+1,sl_next);} \
    CMASK(C0,C1,t); \
    { float a=MX3(C0[0],C0[1],C1[0]),b=MX3(C0[2],C0[3],C1[1]); a=MX3(a,C1[2],C1[3]); \
      _Pragma("unroll") for(int r=4;r<16;r+=4){a=MX3(a,C0[r],C0[r+1]);b=MX3(b,C0[r+2],C0[r+3]);a=MX3(a,C1[r],C1[r+1]);b=MX3(b,C1[r+2],C1[r+3]);} \
      float rm=__builtin_fmaxf(a,b); { auto rr=__builtin_amdgcn_permlane32_swap(__float_as_uint(rm),__float_as_uint(rm),false,false); rm=__builtin_fmaxf(__uint_as_float(rr[0]),__uint_as_float(rr[1])); } \
      resc=false; \
      if(__builtin_expect(__any(rm>(float)THRL),0)){ const float dl=__builtin_fmaxf(rm,0.f); mhat+=dl; \
        _Pragma("unroll") for(int r=0;r<16;++r){C0[r]-=dl;C1[r]-=dl;} \
        QA_SET(); \
        const float f=__builtin_amdgcn_exp2f(-dl); l_reg*=f; if(hi==0)wsf[r32]=f; resc=true; } } \
    SBAR(); \
    GAPB(o[0]=__builtin_amdgcn_mfma_f32_32x32x16_bf16(PAF(0),VFR(0),o[0],0,0,0), C0,0); \
    GAPB(o[1]=__builtin_amdgcn_mfma_f32_32x32x16_bf16(PAF(0),VFR(4),o[1],0,0,0), C0,4); \
    KRD(GL,0); GAPB(o[0]=__builtin_amdgcn_mfma_f32_32x32x16_bf16(PAF(1),VFR(1),o[0],0,0,0), C0,8); \
    KRD(GL,1); GAPB(o[1]=__builtin_amdgcn_mfma_f32_32x32x16_bf16(PAF(1),VFR(5),o[1],0,0,0), C0,12); \
    KRD(GL,2); GAPB(o[0]=__builtin_amdgcn_mfma_f32_32x32x16_bf16(PAF(2),VFR(2),o[0],0,0,0), C1,0); \
    KRD(GL,3); GAPB(o[1]=__builtin_amdgcn_mfma_f32_32x32x16_bf16(PAF(2),VFR(6),o[1],0,0,0), C1,4); \
    GAPB(o[0]=__builtin_amdgcn_mfma_f32_32x32x16_bf16(PAF(3),VFR(3),o[0],0,0,0), C1,8); \
    GAPB(o[1]=__builtin_amdgcn_mfma_f32_32x32x16_bf16(PAF(3),VFR(7),o[1],0,0,0), C1,12); \
    }while(0)
  int t=1;
  #undef CMASK
  #define CMASK(P0,P1,t) do{}while(0)
  for(;t+5<NT;t+=2){
    STEP(pB0,pB1,pA0,pA1,t,true,true,true);     WAIT_BAR_KA(2); RESC(); ROT();
    STEP(pA0,pA1,pB0,pB1,t+1,true,true,true);   WAIT_BAR_KA(2); RESC(); ROT();
  }
  #undef CMASK
  #define CMASK(P0,P1,t) do{int jb_=(t)-(NT-4); if(jb_>=0)cmask(P0,P1,jb_,qrel,hi);}while(0)
  #define ENDW(tt) do{ if((tt)+3<NT){WAIT_BAR(2);} else if((tt)+2<NT){WAIT_BAR(1);} else {WAIT_BAR(0);} PIN_KA(); }while(0)
  for(;t+1<NT;t+=2){
    STEP(pB0,pB1,pA0,pA1,t,(t+3<NT),(t+1<NT),(t+1<NT));       ENDW(t);   RESC(); ROT();
    STEP(pA0,pA1,pB0,pB1,t+1,(t+4<NT),(t+2<NT),(t+2<NT));     ENDW(t+1); RESC(); ROT();
  }
  STEP(pB0,pB1,pA0,pA1,NT-1,false,false,false); RESC();
  { float sacc=pB0[0]+pB0[1]; _Pragma("unroll") for(int r=2;r<16;++r)sacc+=pB0[r]; _Pragma("unroll") for(int r=0;r<16;++r)sacc+=pB1[r]; l_reg+=sacc;
    pw0=(u32x4){PKW(pB0,0),PKW(pB0,2),PKW(pB0,4),PKW(pB0,6)};pw1=(u32x4){PKW(pB0,8),PKW(pB0,10),PKW(pB0,12),PKW(pB0,14)};pw2=(u32x4){PKW(pB1,0),PKW(pB1,2),PKW(pB1,4),PKW(pB1,6)};pw3=(u32x4){PKW(pB1,8),PKW(pB1,10),PKW(pB1,12),PKW(pB1,14)};
    SBAR(); pv(o,vb0+sl_cur,PAF(0),PAF(1),PAF(2),PAF(3)); }
  #undef PKW
  #undef PAF
  #undef VFR
  #undef PIN
  #undef MX3
  #undef GAPA
  #undef GAPB
  #undef EX
  #undef VRD
  #undef KRD
  #undef STEP
  #undef ENDW
  {auto rr=__builtin_amdgcn_permlane32_swap(__float_as_uint(l_reg),__float_as_uint(l_reg),false,false);l_reg=__uint_as_float(rr[0])+__uint_as_float(rr[1]);}
  if(hi==0)wsf[32+r32]=l_reg;asm volatile("s_waitcnt lgkmcnt(0)":::"memory");
  float rli[16];
  #pragma unroll
  for(int r=0;r<16;++r)rli[r]=__builtin_amdgcn_rcpf(wsf[32+crow(r,hi)]);
  bf16*Ow=O+(rowbase+q0+wid*QBLK)*OP+h*D;
  { bf16*stg=(bf16*)(shm+LDS_OST)+wid*2048;
    #pragma unroll
    for(int r=0;r<16;++r){const int orow=crow(r,hi);
      #pragma unroll
      for(int d0=0;d0<2;++d0)stg[orow*64+d0*32+r32]=__float2bfloat16(o[d0][r]*rli[r]);}
    asm volatile("s_waitcnt lgkmcnt(0)":::"memory");
    #pragma unroll
    for(int i=0;i<4;++i){const int row=i*8+(lane>>3),ch=lane&7; const u32x4 v=*(const u32x4*)(stg+row*64+ch*8); ATTN_STORE16(Ow+(long)row*OP+ch*8,v);} }
  asm volatile("s_waitcnt lgkmcnt(0)\n\ts_barrier":::"memory");
  #undef DMA_K
  #undef DMA_V
  #undef KA_LOAD
  #undef QA_SET
  #undef AUG
  #undef WAIT_BAR_KA
  #undef PIN_KA
  #undef CMASK
  #undef START
  #undef RESC
  #undef ROT
}
constexpr int ATTN_LDS_BYTES=LDS_BYTES;
struct AttnTensors { const bf16* Q; const bf16* K; const bf16* V; bf16* O; const unsigned char* KA; };
struct AttnUnit { int bh; int qb; };
struct StaticOrder {
  int vcu;
  __device__ __forceinline__ explicit StaticOrder(int grid,int block):vcu((block%8)*(grid/8)+block/8){}
  __device__ __forceinline__ bool next(int i,AttnUnit&u)const{ if(i>=4)return false; const int s=vcu&15; u.bh=vcu>>4; u.qb=(i==0)?63-s:(i==1)?32+s:(i==2)?31-s:s; return true; }
  __device__ __forceinline__ void a_ready(const AttnUnit&)const{}
  __device__ __forceinline__ void done(const AttnUnit&)const{}
};
template<class Sched,int THRL=8> __device__ __forceinline__ void attn_phase(char*lds,const AttnTensors&T,const Sched&S){
  AttnUnit u;
  for(int i=0;S.next(i,u);++i){ S.a_ready(u); attn_unit<THRL>(u.bh/NHEAD,u.bh%NHEAD,u.qb,0,T.Q,T.K,T.V,T.O,T.KA,lds); S.done(u); }
}
#undef SBAR
#undef WAIT_BAR
}

namespace ck {
#define CK_LAS __attribute__((address_space(3)))
typedef unsigned short bf16_t;
typedef short bf16x8 __attribute__((ext_vector_type(8)));
typedef float f32x16 __attribute__((ext_vector_type(16)));
typedef float f32x4 __attribute__((ext_vector_type(4)));
typedef unsigned u32x4 __attribute__((ext_vector_type(4)));
typedef unsigned u32x2 __attribute__((ext_vector_type(2)));
typedef CK_LAS unsigned short* lbf;
typedef CK_LAS float* lf32;
constexpr int SB = 72;
constexpr int B9 = 64 * SB * 2;
constexpr int SF = 65;
constexpr int SM = 68;
constexpr int SX = 132;
__device__ __forceinline__ unsigned f2bf(float f) { unsigned u = __builtin_bit_cast(unsigned, f); return (u + 0x7fffu + ((u >> 16) & 1u)) >> 16; }
__device__ __forceinline__ unsigned pk2(float lo, float hi) { return f2bf(lo) | (f2bf(hi) << 16); }
__device__ __forceinline__ float bflo(unsigned w) { return __builtin_bit_cast(float, w << 16); }
__device__ __forceinline__ float bfhi(unsigned w) { return __builtin_bit_cast(float, w & 0xffff0000u); }
__device__ __forceinline__ int crow(int reg, int hh) { return (reg & 3) + 8 * (reg >> 2) + 4 * hh; }
__device__ __forceinline__ f32x16 mm_lds(lbf A, lbf BT, int I, int J, int lane, f32x16 acc) {
    const int r = lane & 31, hh = lane >> 5;
    const lbf ap = A + (32 * I + r) * SB + 8 * hh; const lbf bp = BT + (32 * J + r) * SB + 8 * hh;
#pragma unroll
    for (int s = 0; s < 4; ++s) { const bf16x8 a = *(const CK_LAS bf16x8*)(ap + 16 * s); const bf16x8 b = *(const CK_LAS bf16x8*)(bp + 16 * s); acc = __builtin_amdgcn_mfma_f32_32x32x16_bf16(a, b, acc, 0, 0, 0); }
    return acc;
}
__device__ __forceinline__ f32x16 mm_gA(const bf16_t* __restrict__ Ag, lbf BT, int I, int J, int lane, f32x16 acc) {
    const int r = lane & 31, hh = lane >> 5;
    bf16x8 a[4];
#pragma unroll
    for (int s = 0; s < 4; ++s) a[s] = *(const bf16x8*)(Ag + (32 * I + r) * 64 + 16 * s + 8 * hh);
    const lbf bp = BT + (32 * J + r) * SB + 8 * hh;
#pragma unroll
    for (int s = 0; s < 4; ++s) { const bf16x8 b = *(const CK_LAS bf16x8*)(bp + 16 * s); acc = __builtin_amdgcn_mfma_f32_32x32x16_bf16(a[s], b, acc, 0, 0, 0); }
    return acc;
}
__device__ __forceinline__ f32x16 mm_gg(const bf16_t* __restrict__ Ag, const bf16_t* __restrict__ BTg, int I, int J, int lane, f32x16 acc) {
    const int r = lane & 31, hh = lane >> 5;
#pragma unroll
    for (int s = 0; s < 4; ++s) { const bf16x8 a = *(const bf16x8*)(Ag + (32 * I + r) * 64 + 16 * s + 8 * hh); const bf16x8 b = *(const bf16x8*)(BTg + (32 * J + r) * 64 + 16 * s + 8 * hh);
        acc = __builtin_amdgcn_mfma_f32_32x32x16_bf16(a, b, acc, 0, 0, 0); }
    return acc;
}
__device__ __forceinline__ f32x16 mm_rA(const bf16x8 (&a)[4], lbf BT, int J, int lane, f32x16 acc) {
    const int r = lane & 31, hh = lane >> 5; const lbf bp = BT + (32 * J + r) * SB + 8 * hh;
#pragma unroll
    for (int s = 0; s < 4; ++s) { const bf16x8 b = *(const CK_LAS bf16x8*)(bp + 16 * s); acc = __builtin_amdgcn_mfma_f32_32x32x16_bf16(a[s], b, acc, 0, 0, 0); }
    return acc;
}
__device__ __forceinline__ void load_gA(bf16x8 (&a)[4], const bf16_t* __restrict__ Ag, int I, int lane) {
    const int r = lane & 31, hh = lane >> 5;
#pragma unroll
    for (int s = 0; s < 4; ++s) a[s] = *(const bf16x8*)(Ag + (32 * I + r) * 64 + 16 * s + 8 * hh);
}
__device__ __forceinline__ f32x16 mm_lA_gB(lbf A, const bf16_t* __restrict__ BTg, int I, int J, int lane, f32x16 acc) {
    const int r = lane & 31, hh = lane >> 5; bf16x8 b[4];
#pragma unroll
    for (int s = 0; s < 4; ++s) b[s] = *(const bf16x8*)(BTg + (32 * J + r) * 64 + 16 * s + 8 * hh);
    const lbf ap = A + (32 * I + r) * SB + 8 * hh;
#pragma unroll
    for (int s = 0; s < 4; ++s) { const bf16x8 a = *(const CK_LAS bf16x8*)(ap + 16 * s); acc = __builtin_amdgcn_mfma_f32_32x32x16_bf16(a, b[s], acc, 0, 0, 0); }
    return acc;
}
__device__ __forceinline__ void frag_store(float* __restrict__ g, int wq, int lane, const f32x16& acc) {
    f32x4* p = (f32x4*)(g + ((size_t)(wq * 64 + lane)) * 16);
    p[0] = (f32x4){acc[0], acc[1], acc[2], acc[3]}; p[1] = (f32x4){acc[4], acc[5], acc[6], acc[7]}; p[2] = (f32x4){acc[8], acc[9], acc[10], acc[11]}; p[3] = (f32x4){acc[12], acc[13], acc[14], acc[15]};
}
__device__ __forceinline__ f32x16 frag_load(const float* __restrict__ g, int wq, int lane) {
    const f32x4* p = (const f32x4*)(g + ((size_t)(wq * 64 + lane)) * 16); const f32x4 a = p[0], b = p[1], c = p[2], d = p[3];
    return (f32x16){a[0], a[1], a[2], a[3], b[0], b[1], b[2], b[3], c[0], c[1], c[2], c[3], d[0], d[1], d[2], d[3]};
}
__device__ __forceinline__ void frag_store_bf(bf16_t* __restrict__ g, int wq, int lane, const f32x16& acc) {
    u32x4* p = (u32x4*)(g + ((size_t)(wq * 64 + lane)) * 16);
    p[0] = (u32x4){pk2(acc[0], acc[1]), pk2(acc[2], acc[3]), pk2(acc[4], acc[5]), pk2(acc[6], acc[7])}; p[1] = (u32x4){pk2(acc[8], acc[9]), pk2(acc[10], acc[11]), pk2(acc[12], acc[13]), pk2(acc[14], acc[15])};
}
__device__ __forceinline__ f32x16 frag_load_bf(const bf16_t* __restrict__ g, int wq, int lane) {
    const u32x4* p = (const u32x4*)(g + ((size_t)(wq * 64 + lane)) * 16); const u32x4 a = p[0], b = p[1];
    return (f32x16){bflo(a[0]), bfhi(a[0]), bflo(a[1]), bfhi(a[1]), bflo(a[2]), bfhi(a[2]), bflo(a[3]), bfhi(a[3]), bflo(b[0]), bfhi(b[0]), bflo(b[1]), bfhi(b[1]), bflo(b[2]), bfhi(b[2]), bflo(b[3]), bfhi(b[3])};
}
__device__ __forceinline__ void tile_store_T(lbf dst, int I, int J, int lane, const f32x16& acc) {
    const int r = lane & 31, hh = lane >> 5;
#pragma unroll
    for (int g = 0; g < 4; ++g) { u32x2 w; w.x = pk2(acc[4 * g], acc[4 * g + 1]); w.y = pk2(acc[4 * g + 2], acc[4 * g + 3]);
        *(CK_LAS u32x2*)(dst + (32 * J + r) * SB + 32 * I + 8 * g + 4 * hh) = w; }
}
__device__ __forceinline__ float fexp(float x) { return __builtin_amdgcn_exp2f(x * 1.4426950408889634f); }
__device__ __forceinline__ float sigm(float x) { return __builtin_amdgcn_rcpf(1.0f + fexp(-x)); }
__device__ __forceinline__ float ftanh(float x) { const float xc = fminf(fmaxf(x, -15.f), 15.f); return 1.0f - 2.0f * __builtin_amdgcn_rcpf(fexp(2.0f * xc) + 1.0f); }
__device__ __forceinline__ float logsig(float x) { const float ax = fabsf(x); return fminf(x, 0.f) - 0.6931471805599453f * __builtin_amdgcn_logf(1.0f + fexp(-ax)); }
template <int CTRL> __device__ __forceinline__ float dpp_f(float v) { return __builtin_bit_cast(float, __builtin_amdgcn_update_dpp(0, __builtin_bit_cast(int, v), CTRL, 0xf, 0xf, false)); }
__device__ __forceinline__ float quad_sum(float v) { v += dpp_f<0xB1>(v); v += dpp_f<0x4E>(v); return v; }

constexpr size_t O_PC = 0, O_QC = 16u << 20, O_GY = 48u << 20, O_YL = 64u << 20, O_VG = 96u << 20, O_GG = 112u << 20, O_H0 = 128u << 20, O_RKD = 144u << 20, O_KV = 145u << 20, O_RT = 177u << 20, O_END = 193u << 20,
                 O_PG = 193u << 20, O_QG = 195u << 20, O_HG = 197u << 20, O_KG = 199u << 20, O_RG = 203u << 20, O_END2 = 207u << 20;
struct RwkvParams {
    const float *mu_rkv, *mu_lora, *w0, *a0, *k_k, *k_a, *r_k, *ln_g, *ln_b, *gn_g;
    const bf16_t *w2t, *a2t, *g2t;
};

constexpr int L_U = 10 * B9, L_MM = L_U + 36864, L_GL = L_MM + 64 * SM * 4, L_END1 = L_GL + 256;
__device__ __forceinline__ void rwkv_stage1(CK_LAS unsigned char* lds, int item, const bf16_t* __restrict__ Pb, int PW, int C_RR, int C_RK, int C_RV, int C_WD, int SEQ, const RwkvParams& p, unsigned char* __restrict__ cw) {
    const int tid = ltid(), lane = tid & 63, wid = __builtin_amdgcn_readfirstlane(tid >> 6), quad = wid >> 2, wq = wid & 3, I = wq >> 1, J = wq & 1, r = lane & 31, hh = lane >> 5;
    const int b = item >> 10, h = (item >> 8) & 3, c = item & 255;
    const size_t m0 = (size_t)b * SEQ + (size_t)c * 64;
    const lbf Am = (lbf)(lds), Bm = (lbf)(lds + B9), Km = (lbf)(lds + 2 * B9), Rm = (lbf)(lds + 3 * B9), VT = (lbf)(lds + 4 * B9), BhT = (lbf)(lds + 5 * B9), KhT = (lbf)(lds + 6 * B9),
              Nm = (lbf)(lds + 7 * B9), Wb = (lbf)(lds + 8 * B9), Wk = (lbf)(lds + 9 * B9);
    const lbf TW = (lbf)(lds + L_U), AD = (lbf)(lds + L_U + B9), SG0 = (lbf)(lds + L_U + 2 * B9), SG1 = (lbf)(lds + L_U + 3 * B9);
    const lbf W2T = BhT, A2T = KhT, G2Ta = Nm, G2Tb = Wb;
    const lf32 X = (lf32)(lds + L_U), MM = (lf32)(lds + L_MM), GL = (lf32)(lds + L_GL);
    const lf32 AA = (lf32)(lds), GGl = (lf32)(lds + 2 * B9);
    const lbf ZlT = Km, X1T = Nm;
    const int t = tid >> 3, c8 = (tid & 7) * 8;
    const size_t m = m0 + t; const bool hp = (c * 64 + t) > 0;
    const bf16_t* pr = Pb + m * PW; const bf16_t* pp = pr - PW;
    float rr[8], kx[8], vv[8];
    {
        const u32x4 z4 = (u32x4){0u, 0u, 0u, 0u};
        const u32x4 cr = *(const u32x4*)(pr + C_RR + h * 64 + c8), ckk = *(const u32x4*)(pr + C_RK + h * 64 + c8), cv = *(const u32x4*)(pr + C_RV + h * 64 + c8);
        const u32x4 qr = hp ? *(const u32x4*)(pp + C_RR + h * 64 + c8) : z4, qk = hp ? *(const u32x4*)(pp + C_RK + h * 64 + c8) : z4, qv = hp ? *(const u32x4*)(pp + C_RV + h * 64 + c8) : z4;
#pragma unroll
        for (int e = 0; e < 8; ++e) { const int ch = h * 64 + c8 + e;
            const float a_ = (e & 1) ? bfhi(cr[e >> 1]) : bflo(cr[e >> 1]), b_ = (e & 1) ? bfhi(qr[e >> 1]) : bflo(qr[e >> 1]); rr[e] = a_ + (b_ - a_) * p.mu_rkv[ch];
            const float c_ = (e & 1) ? bfhi(ckk[e >> 1]) : bflo(ckk[e >> 1]), d_ = (e & 1) ? bfhi(qk[e >> 1]) : bflo(qk[e >> 1]); kx[e] = c_ + (d_ - c_) * p.mu_rkv[256 + ch];
            const float e_ = (e & 1) ? bfhi(cv[e >> 1]) : bflo(cv[e >> 1]), f_ = (e & 1) ? bfhi(qv[e >> 1]) : bflo(qv[e >> 1]); vv[e] = e_ + (f_ - e_) * p.mu_rkv[512 + ch]; }
#pragma unroll
        for (int q = 0; q < 4; ++q) { const u32x4 cl = *(const u32x4*)(pr + C_WD + q * 64 + c8); const u32x4 ql = hp ? *(const u32x4*)(pp + C_WD + q * 64 + c8) : z4;
            float lo[8];
#pragma unroll
            for (int e = 0; e < 8; ++e) { const float a_ = (e & 1) ? bfhi(cl[e >> 1]) : bflo(cl[e >> 1]), b_ = (e & 1) ? bfhi(ql[e >> 1]) : bflo(ql[e >> 1]); const float x = a_ + (b_ - a_) * p.mu_lora[q * 64 + c8 + e];
                lo[e] = (q == 0) ? ftanh(x) : (q == 1 ? x : sigm(x)); }
            u32x4 w; w.x = pk2(lo[0], lo[1]); w.y = pk2(lo[2], lo[3]); w.z = pk2(lo[4], lo[5]); w.w = pk2(lo[6], lo[7]);
            *(CK_LAS u32x4*)((q == 0 ? TW : q == 1 ? AD : q == 2 ? SG0 : SG1) + t * SB + c8) = w; }
        *(CK_LAS u32x4*)(W2T + t * SB + c8) = *(const u32x4*)(p.w2t + ((size_t)h * 64 + t) * 64 + c8);
        *(CK_LAS u32x4*)(A2T + t * SB + c8) = *(const u32x4*)(p.a2t + ((size_t)h * 64 + t) * 64 + c8);
        *(CK_LAS u32x4*)(G2Ta + t * SB + c8) = *(const u32x4*)(p.g2t + ((size_t)h * 64 + t) * 128 + c8);
        *(CK_LAS u32x4*)(G2Tb + t * SB + c8) = *(const u32x4*)(p.g2t + ((size_t)h * 64 + t) * 128 + 64 + c8);
    }
    __syncthreads();
    if (quad == 0) {
        f32x16 z = mm_lds(TW, W2T, I, J, lane, f32x16{}); f32x16 za = mm_lds(AD, A2T, I, J, lane, f32x16{});
        const int ch = 32 * J + r; const float w0c = p.w0[h * 64 + ch], a0c = p.a0[h * 64 + ch];
#pragma unroll
        for (int g = 0; g < 16; ++g) { const int tt = 32 * I + crow(g, hh); const float lw = logsig(w0c + z[g]) - 0.5f; MM[tt * SF + ch] = -fexp(lw); AA[tt * SF + ch] = sigm(a0c + za[g]); }
    } else {
        f32x16 zg = mm_lds(SG0, G2Ta, I, J, lane, f32x16{}); zg = mm_lds(SG1, G2Tb, I, J, lane, zg);
        const int ch = 32 * J + r;
#pragma unroll
        for (int g = 0; g < 16; ++g) { const int tt = 32 * I + crow(g, hh); GGl[tt * SF + ch] = zg[g]; }
    }
    __syncthreads();
    {
        const int ch = tid & 63, seg = tid >> 6; float v8[8]; float run = 0.f;
#pragma unroll
        for (int i = 0; i < 8; ++i) { run += MM[(seg * 8 + i) * SF + ch]; v8[i] = run; }
        const lf32 TOT = (lf32)(lds + L_U);
        TOT[seg * 64 + ch] = run;
        __syncthreads();
        float off = 0.f;
#pragma unroll
        for (int s2 = 0; s2 < 8; ++s2) off += (s2 < seg) ? TOT[s2 * 64 + ch] : 0.f;
#pragma unroll
        for (int i = 0; i < 8; ++i) MM[(seg * 8 + i) * SF + ch] = v8[i] + off;
    }
    __syncthreads();
    float aa[8], gg[8], lw[8], lwp[8], lwl[8];
#pragma unroll
    for (int e = 0; e < 8; ++e) { aa[e] = AA[t * SF + c8 + e]; gg[e] = GGl[t * SF + c8 + e]; lw[e] = MM[t * SF + c8 + e]; lwp[e] = t > 0 ? MM[(t - 1) * SF + c8 + e] : 0.f; lwl[e] = MM[63 * SF + c8 + e]; }
    __syncthreads();
    {
        float kk[8], k2[8]; float ss = 0.f, rk = 0.f;
#pragma unroll
        for (int e = 0; e < 8; ++e) { const int ch = h * 64 + c8 + e; kk[e] = kx[e] * p.k_k[ch]; ss += kk[e] * kk[e]; k2[e] = kx[e] * (1.0f + (aa[e] - 1.0f) * p.k_a[ch]); rk += rr[e] * k2[e] * p.r_k[ch]; }
        ss += __shfl_xor(ss, 1); ss += __shfl_xor(ss, 2); ss += __shfl_xor(ss, 4); rk += __shfl_xor(rk, 1); rk += __shfl_xor(rk, 2); rk += __shfl_xor(rk, 4);
        const float inv = 1.0f / fmaxf(sqrtf(ss), 1e-12f);
        float am[8], bm[8], km[8], rm[8];
#pragma unroll
        for (int e = 0; e < 8; ++e) { kk[e] *= inv; const float g_ = fexp(lw[e]), gi = fexp(-lw[e]), gp = fexp(lwp[e]), gl = fexp(lwl[e] - lw[e]); const float ka = kk[e] * aa[e];
            am[e] = -kk[e] * gp; bm[e] = ka * gi; km[e] = k2[e] * gi; rm[e] = rr[e] * g_;
            VT[(c8 + e) * SB + t] = (bf16_t)f2bf(vv[e]); BhT[(c8 + e) * SB + t] = (bf16_t)f2bf(ka * gl); KhT[(c8 + e) * SB + t] = (bf16_t)f2bf(k2[e] * gl);
            X[t * SX + c8 + e] = am[e]; }
        u32x4 w;
        w.x = pk2(am[0], am[1]); w.y = pk2(am[2], am[3]); w.z = pk2(am[4], am[5]); w.w = pk2(am[6], am[7]); *(CK_LAS u32x4*)(Am + t * SB + c8) = w;
        w.x = pk2(bm[0], bm[1]); w.y = pk2(bm[2], bm[3]); w.z = pk2(bm[4], bm[5]); w.w = pk2(bm[6], bm[7]); *(CK_LAS u32x4*)(Bm + t * SB + c8) = w;
        w.x = pk2(km[0], km[1]); w.y = pk2(km[2], km[3]); w.z = pk2(km[4], km[5]); w.w = pk2(km[6], km[7]); *(CK_LAS u32x4*)(Km + t * SB + c8) = w;
        w.x = pk2(rm[0], rm[1]); w.y = pk2(rm[2], rm[3]); w.z = pk2(rm[4], rm[5]); w.w = pk2(rm[6], rm[7]); *(CK_LAS u32x4*)(Rm + t * SB + c8) = w;
        if (t == 63) {
#pragma unroll
            for (int e = 0; e < 8; ++e) GL[c8 + e] = fexp(lwl[e]); }
        w.x = pk2(vv[0], vv[1]); w.y = pk2(vv[2], vv[3]); w.z = pk2(vv[4], vv[5]); w.w = pk2(vv[6], vv[7]); *(u32x4*)(cw + O_VG + (size_t)item * 8192 + (t * 64 + c8) * 2) = w;
        w.x = pk2(gg[0], gg[1]); w.y = pk2(gg[2], gg[3]); w.z = pk2(gg[4], gg[5]); w.w = pk2(gg[6], gg[7]); *(u32x4*)(cw + O_GG + (size_t)item * 8192 + (t * 64 + c8) * 2) = w;
        if ((tid & 7) == 0) *(float*)(cw + O_RKD + (size_t)item * 256 + t * 4) = rk;
    }
    __syncthreads();
    {
        const f32x16 p1 = mm_lds(Am, quad == 0 ? Bm : Km, I, J, lane, f32x16{}); const f32x16 p2 = mm_lds(Rm, quad == 0 ? Bm : Km, I, J, lane, f32x16{});
        const int ii = 32 * J + r;
#pragma unroll
        for (int g = 0; g < 16; ++g) { const int tt = 32 * I + crow(g, hh);
            if (quad == 0) { MM[tt * SM + (ii & 3) * 16 + (ii >> 2)] = (ii < tt) ? p1[g] : 0.f; Wb[tt * SB + ii] = (bf16_t)f2bf((ii <= tt) ? p2[g] : 0.f); }
            else { Nm[tt * SB + ii] = (bf16_t)f2bf((ii < tt) ? p1[g] : 0.f); Wk[tt * SB + ii] = (bf16_t)f2bf((ii <= tt) ? p2[g] : 0.f); } }
    }
    __syncthreads();
    if (quad == 0) { const f32x16 nv = mm_lds(Nm, VT, I, J, lane, f32x16{}); const int vcol = 64 + 32 * J + r;
#pragma unroll
        for (int g = 0; g < 16; ++g) X[(32 * I + crow(g, hh)) * SX + vcol] = nv[g]; }
    __syncthreads();
    {
        const int col = tid >> 2, q = tid & 3;
        float xs[16];
#pragma unroll
        for (int k = 0; k < 16; ++k) xs[k] = X[(q + 4 * k) * SX + col];
#pragma unroll
        for (int tt = 1; tt < 64; ++tt) {
            const CK_LAS f32x4* mr = (const CK_LAS f32x4*)(MM + tt * SM + q * 16);
            float s0 = 0.f, s1 = 0.f, s2 = 0.f, s3 = 0.f;
#pragma unroll
            for (int k4 = 0; k4 < (tt + 15) / 16; ++k4) { const f32x4 mv = mr[k4]; s0 += mv[0] * xs[4 * k4]; s1 += mv[1] * xs[4 * k4 + 1]; s2 += mv[2] * xs[4 * k4 + 2]; s3 += mv[3] * xs[4 * k4 + 3]; }
            const float sm = quad_sum((s0 + s1) + (s2 + s3));
            xs[tt >> 2] += (q == (tt & 3)) ? sm : 0.f;
        }
        const lbf dstT = (col < 64) ? (X1T + col * SB) : (ZlT + (col - 64) * SB);
#pragma unroll
        for (int k = 0; k < 16; ++k) dstT[q + 4 * k] = (bf16_t)f2bf(xs[k]);
    }
    __syncthreads();
    if (quad == 0) {
        const f32x16 gy = mm_lds(Wb, X1T, I, J, lane, f32x16{}); const f32x16 pc = mm_lds(BhT, X1T, I, J, lane, f32x16{});
        bf16_t* gyg = (bf16_t*)(cw + O_GY + (size_t)item * 8192); bf16_t* pcg = (bf16_t*)(cw + O_PC + (size_t)item * 8192);
        const int cc = 32 * J + r;
#pragma unroll
        for (int g = 0; g < 16; ++g) { const int rw = 32 * I + crow(g, hh);
            gyg[rw * 64 + cc] = (bf16_t)f2bf(gy[g] + __builtin_bit_cast(float, (unsigned)Rm[rw * SB + cc] << 16));
            pcg[rw * 64 + cc] = (bf16_t)f2bf(pc[g] + (rw == cc ? GL[cc] : 0.f)); }
    } else {
        f32x16 yl = mm_lds(ZlT, Wb, I, J, lane, f32x16{}); yl = mm_lds(VT, Wk, I, J, lane, yl);
        f32x16 qc = mm_lds(BhT, ZlT, I, J, lane, f32x16{}); qc = mm_lds(KhT, VT, I, J, lane, qc);
        frag_store((float*)(cw + O_YL + (size_t)item * 16384), wq, lane, yl); frag_store_bf((bf16_t*)(cw + O_QC) + (size_t)item * 4096, wq, lane, qc);
    }
    __syncthreads();
}

template <int NST> __device__ __forceinline__ void rwkv_scan(CK_LAS unsigned char* lds, int chain, const bf16_t* __restrict__ pcb, const bf16_t* __restrict__ qcb, bf16_t* __restrict__ h0b) {
    const int tid = ltid(), lane = tid & 63, wid = __builtin_amdgcn_readfirstlane(tid >> 6), quad = wid >> 2, wq = wid & 3, I = wq >> 1, J = wq & 1, r = lane & 31, hh = lane >> 5, qtid = tid & 255;
    const lbf HT = (lbf)(lds + quad * B9);
    for (int i = qtid; i < 64 * SB / 2; i += 256) ((CK_LAS unsigned*)HT)[i] = 0u;
    __syncthreads();
    const bool on = chain >= 0; const size_t it0 = (size_t)(on ? chain : 0) * NST;
    const bf16_t* pcg = pcb + it0 * 4096; const bf16_t* qcg = qcb + it0 * 4096; bf16_t* h0g = h0b + it0 * 4096;
    constexpr int PD = 5;
    bf16x8 ar[PD][4]; f32x16 qr[PD];
#define CK_LOADSTEP(A_, Q_, cc) do { const int c_ = (cc) < NST ? (cc) : NST - 1; _Pragma("unroll") for (int s_ = 0; s_ < 4; ++s_) A_[s_] = *(const bf16x8*)(pcg + (size_t)c_ * 4096 + (32 * I + r) * 64 + 16 * s_ + 8 * hh); Q_ = frag_load_bf(qcg + (size_t)c_ * 4096, wq, lane); } while (0)
#pragma unroll
    for (int k = 0; k < PD; ++k) CK_LOADSTEP(ar[k], qr[k], k);
    for (int c = 0; c < NST + PD - 1; c += PD) {
#pragma unroll
        for (int k = 0; k < PD; ++k) {
            const int cc = c + k;
            if (cc < NST) {
            if (on) { const int row = qtid >> 2, seg = (qtid & 3) * 16; const u32x4 w0 = *(const CK_LAS u32x4*)(HT + row * SB + seg), w1 = *(const CK_LAS u32x4*)(HT + row * SB + seg + 8);
                      u32x4* dst = (u32x4*)(h0g + (size_t)cc * 4096 + row * 64 + seg); dst[0] = w0; dst[1] = w1; }
            f32x16 acc = qr[k];
            const lbf bp = HT + (32 * J + r) * SB + 8 * hh;
#pragma unroll
            for (int s_ = 0; s_ < 4; ++s_) { const bf16x8 bfr = *(const CK_LAS bf16x8*)(bp + 16 * s_); acc = __builtin_amdgcn_mfma_f32_32x32x16_bf16(ar[k][s_], bfr, acc, 0, 0, 0); }
            CK_LOADSTEP(ar[k], qr[k], cc + PD);
            asm volatile("s_waitcnt lgkmcnt(0)\n\ts_barrier" ::: "memory");
            tile_store_T(HT, I, J, lane, acc);
            asm volatile("s_waitcnt lgkmcnt(0)\n\ts_barrier" ::: "memory");
            }
        }
    }
#undef CK_LOADSTEP
}

__device__ __forceinline__ void rwkv_level1(CK_LAS unsigned char* lds, int task, unsigned char* __restrict__ cw) {
    const int tid = ltid(), lane = tid & 63, wid = __builtin_amdgcn_readfirstlane(tid >> 6), quad = wid >> 2, wq = wid & 3, I = wq >> 1, J = wq & 1, r = lane & 31, hh = lane >> 5;
    const lbf PTh = (lbf)(lds + quad * 4 * B9), PTl = PTh + 64 * SB, QTh = PTl + 64 * SB, QTl = QTh + 64 * SB;
    const bool on = task >= 0; const int tk = on ? task : 0; const size_t item0 = (size_t)(tk >> 5) * 256 + (size_t)(tk & 31) * 8;
    f32x16 PG, QG = f32x16{};
#pragma unroll
    for (int g = 0; g < 16; ++g) PG[g] = (I == J && crow(g, hh) == r) ? 1.0f : 0.0f;
    for (int j = 0; j < 8; ++j) {
        const size_t item = item0 + j;
        bf16x8 a[4]; load_gA(a, (const bf16_t*)(cw + O_PC) + item * 4096, I, lane);
        f32x16 qn = frag_load_bf((const bf16_t*)(cw + O_QC) + item * 4096, wq, lane);
        f32x16 pl, ql;
#pragma unroll
        for (int g = 0; g < 16; ++g) { pl[g] = PG[g] - __builtin_bit_cast(float, f2bf(PG[g]) << 16); ql[g] = QG[g] - __builtin_bit_cast(float, f2bf(QG[g]) << 16); }
        tile_store_T(PTh, I, J, lane, PG); tile_store_T(PTl, I, J, lane, pl); tile_store_T(QTh, I, J, lane, QG); tile_store_T(QTl, I, J, lane, ql);
        __syncthreads();
        f32x16 pn = mm_rA(a, PTh, J, lane, f32x16{}); pn = mm_rA(a, PTl, J, lane, pn);
        qn = mm_rA(a, QTh, J, lane, qn); qn = mm_rA(a, QTl, J, lane, qn);
        __syncthreads();
        PG = pn; QG = qn;
    }
    if (on) { bf16_t* pgg = (bf16_t*)(cw + O_PG) + (size_t)tk * 4096; const int cc = 32 * J + r;
#pragma unroll
        for (int g = 0; g < 16; ++g) pgg[(32 * I + crow(g, hh)) * 64 + cc] = (bf16_t)f2bf(PG[g]);
        frag_store_bf((bf16_t*)(cw + O_QG) + (size_t)tk * 4096, wq, lane, QG); }
}

constexpr int L_RW3 = B9 + 64 * SF * 4;
__device__ __forceinline__ void rwkv_stage3g(CK_LAS unsigned char* ldsq, int task, const RwkvParams& p, const unsigned char* __restrict__ cw, bf16_t* __restrict__ MIXB, int SEQ) {
    const int tid = ltid(), lane = tid & 63, wid = __builtin_amdgcn_readfirstlane(tid >> 6), wq = wid & 3, I = wq >> 1, J = wq & 1, r = lane & 31, hh = lane >> 5, qtid = tid & 255;
    const lbf HT = (lbf)ldsq; const lf32 Y = (lf32)(ldsq + B9);
    const bool on = task >= 0; const int tk = on ? task : 0; const int item0 = (tk >> 5) * 256 + (tk & 31) * 8;
    { const int row = qtid >> 2, seg = (qtid & 3) * 16; const u32x4* src = (const u32x4*)((const bf16_t*)(cw + O_HG) + (size_t)tk * 4096 + row * 64 + seg);
      *(CK_LAS u32x4*)(HT + row * SB + seg) = src[0]; *(CK_LAS u32x4*)(HT + row * SB + seg + 8) = src[1]; }
    __syncthreads();
    for (int j = 0; j < 8; ++j) {
        const int item = item0 + j;
        bf16x8 a[4]; load_gA(a, (const bf16_t*)(cw + O_PC) + (size_t)item * 4096, I, lane);
        f32x16 hn = frag_load_bf((const bf16_t*)(cw + O_QC) + (size_t)item * 4096, wq, lane);
        {
            f32x16 acc = frag_load((const float*)(cw + O_YL) + (size_t)item * 4096, wq, lane);
            acc = mm_lA_gB(HT, (const bf16_t*)(cw + O_GY) + (size_t)item * 4096, I, J, lane, acc);
#pragma unroll
            for (int g = 0; g < 16; ++g) Y[(32 * J + r) * SF + 32 * I + crow(g, hh)] = acc[g];
        }
        hn = mm_rA(a, HT, J, lane, hn);
        __syncthreads();
        tile_store_T(HT, I, J, lane, hn);
        if (on) {
            const int b = item >> 10, h = (item >> 8) & 3, c = item & 255; const int t = qtid >> 2, c16 = (qtid & 3) * 16;
            float y[16]; float s = 0.f;
#pragma unroll
            for (int e = 0; e < 16; ++e) { y[e] = Y[t * SF + c16 + e]; s += y[e]; }
            const float mu = quad_sum(s) * (1.f / 64.f); float s2 = 0.f;
#pragma unroll
            for (int e = 0; e < 16; ++e) { y[e] -= mu; s2 += y[e] * y[e]; }
            const float rstd = 1.0f / sqrtf(quad_sum(s2) * (1.f / 64.f) + 64e-5f);
            const u32x4* vg = (const u32x4*)(cw + O_VG + (size_t)item * 8192 + (t * 64 + c16) * 2); const u32x4* gg = (const u32x4*)(cw + O_GG + (size_t)item * 8192 + (t * 64 + c16) * 2);
            const float rk = *(const float*)(cw + O_RKD + (size_t)item * 256 + t * 4);
            unsigned ow[8];
#pragma unroll
            for (int hv = 0; hv < 2; ++hv) { const u32x4 vw = vg[hv], gw = gg[hv];
#pragma unroll
                for (int e2 = 0; e2 < 4; ++e2) { const int e = hv * 8 + 2 * e2; const int ch = h * 64 + c16 + e;
                    const float o0 = (y[e] * rstd * p.ln_g[ch] + p.ln_b[ch] + rk * bflo(vw[e2])) * bflo(gw[e2]);
                    const float o1 = (y[e + 1] * rstd * p.ln_g[ch + 1] + p.ln_b[ch + 1] + rk * bfhi(vw[e2])) * bfhi(gw[e2]);
                    ow[hv * 4 + e2] = pk2(o0, o1); } }
            u32x4* dst = (u32x4*)(MIXB + ((size_t)b * SEQ + (size_t)c * 64 + t) * 1024 + 512 + h * 64 + c16);
            dst[0] = (u32x4){ow[0], ow[1], ow[2], ow[3]}; dst[1] = (u32x4){ow[4], ow[5], ow[6], ow[7]};
        }
        __syncthreads();
    }
}

__device__ __forceinline__ void rwkv_stage3(CK_LAS unsigned char* ldsq, int item, const RwkvParams& p, const unsigned char* __restrict__ cw, bf16_t* __restrict__ MIXB, int SEQ) {
    const int tid = ltid(), lane = tid & 63, wid = __builtin_amdgcn_readfirstlane(tid >> 6), wq = wid & 3, I = wq >> 1, J = wq & 1, r = lane & 31, hh = lane >> 5, qtid = tid & 255;
    const lf32 Y = (lf32)ldsq;
    if (item >= 0) {
        f32x16 acc = frag_load((const float*)(cw + O_YL) + (size_t)item * 4096, wq, lane);
        acc = mm_gg((const bf16_t*)(cw + O_H0) + (size_t)item * 4096, (const bf16_t*)(cw + O_GY) + (size_t)item * 4096, I, J, lane, acc);
#pragma unroll
        for (int g = 0; g < 16; ++g) Y[(32 * J + r) * SF + 32 * I + crow(g, hh)] = acc[g];
    }
    __syncthreads();
    if (item >= 0) {
        const int b = item >> 10, h = (item >> 8) & 3, c = item & 255; const int t = qtid >> 2, c16 = (qtid & 3) * 16;
        float y[16]; float s = 0.f;
#pragma unroll
        for (int e = 0; e < 16; ++e) { y[e] = Y[t * SF + c16 + e]; s += y[e]; }
        const float mu = quad_sum(s) * (1.f / 64.f); float s2 = 0.f;
#pragma unroll
        for (int e = 0; e < 16; ++e) { y[e] -= mu; s2 += y[e] * y[e]; }
        const float rstd = 1.0f / sqrtf(quad_sum(s2) * (1.f / 64.f) + 64e-5f);
        const u32x4* vg = (const u32x4*)(cw + O_VG + (size_t)item * 8192 + (t * 64 + c16) * 2); const u32x4* gg = (const u32x4*)(cw + O_GG + (size_t)item * 8192 + (t * 64 + c16) * 2);
        const float rk = *(const float*)(cw + O_RKD + (size_t)item * 256 + t * 4);
        unsigned ow[8];
#pragma unroll
        for (int hv = 0; hv < 2; ++hv) { const u32x4 vw = vg[hv], gw = gg[hv];
#pragma unroll
            for (int e2 = 0; e2 < 4; ++e2) { const int e = hv * 8 + 2 * e2; const int ch = h * 64 + c16 + e;
                const float o0 = (y[e] * rstd * p.ln_g[ch] + p.ln_b[ch] + rk * bflo(vw[e2])) * bflo(gw[e2]);
                const float o1 = (y[e + 1] * rstd * p.ln_g[ch + 1] + p.ln_b[ch + 1] + rk * bfhi(vw[e2])) * bfhi(gw[e2]);
                ow[hv * 4 + e2] = pk2(o0, o1); } }
        u32x4* dst = (u32x4*)(MIXB + ((size_t)b * SEQ + (size_t)c * 64 + t) * 1024 + 512 + h * 64 + c16);
        dst[0] = (u32x4){ow[0], ow[1], ow[2], ow[3]}; dst[1] = (u32x4){ow[4], ow[5], ow[6], ow[7]};
    }
    __syncthreads();
}

__device__ __forceinline__ void rot16(float (&o)[16], const bf16_t* __restrict__ prow, int colbase, int c16, const float* __restrict__ ropet  ) {
    const u32x4* own = (const u32x4*)(prow + colbase + c16); const u32x4* par = (const u32x4*)(prow + colbase + (c16 ^ 32));
    const f32x4* cs = (const f32x4*)(ropet + 2 * (c16 & 31));
#pragma unroll
    for (int hv = 0; hv < 2; ++hv) { const u32x4 ow = own[hv], pw = par[hv];
#pragma unroll
        for (int e2 = 0; e2 < 4; ++e2) { const f32x4 csv = cs[hv * 4 + e2];
            const float x0 = bflo(ow[e2]), x1 = bfhi(ow[e2]), p0 = bflo(pw[e2]), p1 = bfhi(pw[e2]);
            o[hv * 8 + 2 * e2] = (c16 < 32) ? (x0 * csv[0] - p0 * csv[1]) : (p0 * csv[1] + x0 * csv[0]);
            o[hv * 8 + 2 * e2 + 1] = (c16 < 32) ? (x1 * csv[2] - p1 * csv[3]) : (p1 * csv[3] + x1 * csv[2]); } }
}
__device__ __forceinline__ void ret_stage1(CK_LAS unsigned char* ldsq, int item, const bf16_t* __restrict__ Pb, int PW, int C_TK, int C_TV, int SEQ, const float* __restrict__ ROPE, unsigned char* __restrict__ cw) {
    const int tid = ltid(), lane = tid & 63, wid = __builtin_amdgcn_readfirstlane(tid >> 6), wq = wid & 3, I = wq >> 1, J = wq & 1, qtid = tid & 255;
    const lbf VT = (lbf)ldsq, KdT = (lbf)(ldsq + B9);
    if (item >= 0) {
        const int b = item >> 10, h = (item >> 8) & 3, c = item & 255; const int t = qtid >> 2, c16 = (qtid & 3) * 16; const int pos = c * 64 + t;
        const bf16_t* prow = Pb + ((size_t)b * SEQ + pos) * PW;
        float kr[16]; rot16(kr, prow, C_TK + h * 64, c16, ROPE + (size_t)pos * 64);
        const float lg = __builtin_amdgcn_logf(1.0f - __builtin_amdgcn_exp2f(-5.0f - (float)h));
        const float dec = 0.125f * __builtin_amdgcn_exp2f(lg * (float)(63 - t));
        const u32x4* vp = (const u32x4*)(prow + C_TV + h * 64 + c16);
#pragma unroll
        for (int hv = 0; hv < 2; ++hv) { const u32x4 vw = vp[hv];
#pragma unroll
            for (int e2 = 0; e2 < 4; ++e2) { const int e = hv * 8 + 2 * e2;
                VT[(c16 + e) * SB + t] = (bf16_t)(vw[e2] & 0xffffu); VT[(c16 + e + 1) * SB + t] = (bf16_t)(vw[e2] >> 16);
                KdT[(c16 + e) * SB + t] = (bf16_t)f2bf(kr[e] * dec); KdT[(c16 + e + 1) * SB + t] = (bf16_t)f2bf(kr[e + 1] * dec); } }
    }
    __syncthreads();
    if (item >= 0) { const f32x16 kv = mm_lds(VT, KdT, I, J, lane, f32x16{}); frag_store_bf((bf16_t*)(cw + O_KV) + (size_t)item * 4096, wq, lane, kv); }
    __syncthreads();
}
__device__ __forceinline__ void ret_scan(int chain, unsigned char* __restrict__ cw) {
    const int tid = ltid(), lane = tid & 63, wid = __builtin_amdgcn_readfirstlane(tid >> 6), wq = wid & 3, I = wq >> 1, J = wq & 1, r = lane & 31, hh = lane >> 5;
    const int h = chain & 3; const float lg = __builtin_amdgcn_logf(1.0f - __builtin_amdgcn_exp2f(-5.0f - (float)h)); const float g64 = __builtin_amdgcn_exp2f(lg * 64.0f);
    const bf16_t* kvg = (const bf16_t*)(cw + O_KV) + (size_t)chain * 256 * 4096; bf16_t* rtg = (bf16_t*)(cw + O_RT) + (size_t)chain * 256 * 4096;
    f32x16 R = f32x16{}; constexpr int PD = 8; f32x16 nx[PD];
#pragma unroll
    for (int k = 0; k < PD; ++k) nx[k] = frag_load_bf(kvg + (size_t)k * 4096, wq, lane);
    for (int c = 0; c < 256; c += PD) {
#pragma unroll
        for (int k = 0; k < PD; ++k) { const int cc = c + k; bf16_t* dst = rtg + (size_t)cc * 4096;
#pragma unroll
            for (int g = 0; g < 16; ++g) dst[(32 * I + crow(g, hh)) * 64 + 32 * J + r] = (bf16_t)f2bf(R[g]);
            const f32x16 kvc = nx[k]; const int nn = cc + PD < 256 ? cc + PD : 255;
            nx[k] = frag_load_bf(kvg + (size_t)nn * 4096, wq, lane);
#pragma unroll
            for (int g = 0; g < 16; ++g) R[g] = R[g] * g64 + kvc[g]; }
    }
}
constexpr int L_RET3 = 4 * B9 + 64 * SF * 4;
__device__ __forceinline__ void ret_stage3(CK_LAS unsigned char* ldsq, int item, const bf16_t* __restrict__ Pb, int PW, int C_TQ, int C_TK, int C_TV, int C_TG, int SEQ, const float* __restrict__ ROPE,
                                           const float* __restrict__ gn_g, const unsigned char* __restrict__ cw, bf16_t* __restrict__ MIXB) {
    const int tid = ltid(), lane = tid & 63, wid = __builtin_amdgcn_readfirstlane(tid >> 6), wq = wid & 3, I = wq >> 1, J = wq & 1, r = lane & 31, hh = lane >> 5, qtid = tid & 255;
    const lbf Qr = (lbf)ldsq, Kr = (lbf)(ldsq + B9), VT = (lbf)(ldsq + 2 * B9), Sb = (lbf)(ldsq + 3 * B9); const lf32 Y = (lf32)(ldsq + 4 * B9);
    const int b = item >= 0 ? item >> 10 : 0, h = item >= 0 ? (item >> 8) & 3 : 0, c = item >= 0 ? item & 255 : 0; const int t = qtid >> 2, c16 = (qtid & 3) * 16; const int pos = c * 64 + t;
    const float lg = __builtin_amdgcn_logf(1.0f - __builtin_amdgcn_exp2f(-5.0f - (float)h));
    const bf16_t* prow = Pb + ((size_t)b * SEQ + pos) * PW;
    if (item >= 0) {
        float qr[16], kr[16]; rot16(qr, prow, C_TQ + h * 64, c16, ROPE + (size_t)pos * 64); rot16(kr, prow, C_TK + h * 64, c16, ROPE + (size_t)pos * 64);
        u32x4 w;
        w.x = pk2(qr[0], qr[1]); w.y = pk2(qr[2], qr[3]); w.z = pk2(qr[4], qr[5]); w.w = pk2(qr[6], qr[7]); *(CK_LAS u32x4*)(Qr + t * SB + c16) = w;
        w.x = pk2(qr[8], qr[9]); w.y = pk2(qr[10], qr[11]); w.z = pk2(qr[12], qr[13]); w.w = pk2(qr[14], qr[15]); *(CK_LAS u32x4*)(Qr + t * SB + c16 + 8) = w;
#pragma unroll
        for (int e = 0; e < 16; ++e) kr[e] *= 0.125f;
        w.x = pk2(kr[0], kr[1]); w.y = pk2(kr[2], kr[3]); w.z = pk2(kr[4], kr[5]); w.w = pk2(kr[6], kr[7]); *(CK_LAS u32x4*)(Kr + t * SB + c16) = w;
        w.x = pk2(kr[8], kr[9]); w.y = pk2(kr[10], kr[11]); w.z = pk2(kr[12], kr[13]); w.w = pk2(kr[14], kr[15]); *(CK_LAS u32x4*)(Kr + t * SB + c16 + 8) = w;
        const u32x4* vp = (const u32x4*)(prow + C_TV + h * 64 + c16);
#pragma unroll
        for (int hv = 0; hv < 2; ++hv) { const u32x4 vw = vp[hv];
#pragma unroll
            for (int e2 = 0; e2 < 4; ++e2) { const int e = hv * 8 + 2 * e2; VT[(c16 + e) * SB + t] = (bf16_t)(vw[e2] & 0xffffu); VT[(c16 + e + 1) * SB + t] = (bf16_t)(vw[e2] >> 16); } }
    }
    __syncthreads();
    if (item >= 0) {
        f32x16 st = mm_lds(Kr, Qr, I, J, lane, f32x16{}); const int tt = 32 * J + r;
#pragma unroll
        for (int g = 0; g < 16; ++g) { const int ii = 32 * I + crow(g, hh); st[g] = (ii <= tt) ? st[g] * __builtin_amdgcn_exp2f(lg * (float)(tt - ii)) : 0.f; }
        tile_store_T(Sb, I, J, lane, st);
    }
    __syncthreads();
    if (item >= 0) {
        const f32x16 yi = mm_lds(VT, Sb, I, J, lane, f32x16{}); const f32x16 yc = mm_gA((const bf16_t*)(cw + O_RT) + (size_t)item * 4096, Qr, I, J, lane, f32x16{});
        const int tt = 32 * J + r; const float qd = __builtin_amdgcn_exp2f(lg * (float)(tt + 1));
#pragma unroll
        for (int g = 0; g < 16; ++g) Y[tt * SF + 32 * I + crow(g, hh)] = yi[g] + qd * yc[g];
    }
    __syncthreads();
    if (item >= 0) {
        float y[16]; float s = 0.f;
#pragma unroll
        for (int e = 0; e < 16; ++e) { y[e] = Y[t * SF + c16 + e]; s += y[e]; }
        const float mu = quad_sum(s) * (1.f / 64.f); float s2 = 0.f;
#pragma unroll
        for (int e = 0; e < 16; ++e) { y[e] -= mu; s2 += y[e] * y[e]; }
        const float rstd = 1.0f / sqrtf(quad_sum(s2) * (1.f / 64.f) + 1e-6f);
        const u32x4* gp = (const u32x4*)(prow + C_TG + h * 64 + c16); unsigned ow[8];
#pragma unroll
        for (int hv = 0; hv < 2; ++hv) { const u32x4 gw = gp[hv];
#pragma unroll
            for (int e2 = 0; e2 < 4; ++e2) { const int e = hv * 8 + 2 * e2; const int ch = h * 64 + c16 + e; const float g0 = bflo(gw[e2]), g1 = bfhi(gw[e2]);
                ow[hv * 4 + e2] = pk2(y[e] * rstd * gn_g[ch] * (g0 * sigm(g0)), y[e + 1] * rstd * gn_g[ch + 1] * (g1 * sigm(g1))); } }
        u32x4* dst = (u32x4*)(MIXB + ((size_t)b * SEQ + pos) * 1024 + 768 + h * 64 + c16);
        dst[0] = (u32x4){ow[0], ow[1], ow[2], ow[3]}; dst[1] = (u32x4){ow[4], ow[5], ow[6], ow[7]};
    }
    __syncthreads();
}
__device__ __forceinline__ void ret_level1(int task, unsigned char* __restrict__ cw) {
    const int tid = ltid(), lane = tid & 63, wid = __builtin_amdgcn_readfirstlane(tid >> 6), wq = wid & 3;
    const int h = (task >> 5) & 3; const float lg = __builtin_amdgcn_logf(1.0f - __builtin_amdgcn_exp2f(-5.0f - (float)h)); const float g64 = __builtin_amdgcn_exp2f(lg * 64.0f);
    const bf16_t* kvg = (const bf16_t*)(cw + O_KV) + ((size_t)(task >> 5) * 256 + (size_t)(task & 31) * 8) * 4096;
    f32x16 kv[8];
#pragma unroll
    for (int j = 0; j < 8; ++j) kv[j] = frag_load_bf(kvg + (size_t)j * 4096, wq, lane);
    f32x16 acc = kv[0];
#pragma unroll
    for (int j = 1; j < 8; ++j)
#pragma unroll
        for (int g = 0; g < 16; ++g) acc[g] = acc[g] * g64 + kv[j][g];
    frag_store((float*)(cw + O_KG) + (size_t)task * 4096, wq, lane, acc);
}
__device__ __forceinline__ void ret_scan_groups(int chain, unsigned char* __restrict__ cw) {
    const int tid = ltid(), lane = tid & 63, wid = __builtin_amdgcn_readfirstlane(tid >> 6), wq = wid & 3;
    const int h = chain & 3; const float lg = __builtin_amdgcn_logf(1.0f - __builtin_amdgcn_exp2f(-5.0f - (float)h)); const float g512 = __builtin_amdgcn_exp2f(lg * 512.0f);
    const float* kgg = (const float*)(cw + O_KG) + (size_t)chain * 32 * 4096; float* rgg = (float*)(cw + O_RG) + (size_t)chain * 32 * 4096;
    f32x16 R = f32x16{}; f32x16 nx[4];
#pragma unroll
    for (int k = 0; k < 4; ++k) nx[k] = frag_load(kgg + (size_t)k * 4096, wq, lane);
    for (int c = 0; c < 32; c += 4) {
#pragma unroll
        for (int k = 0; k < 4; ++k) { const int cc = c + k; frag_store(rgg + (size_t)cc * 4096, wq, lane, R);
            const f32x16 kvc = nx[k]; const int nn = cc + 4 < 32 ? cc + 4 : 31; nx[k] = frag_load(kgg + (size_t)nn * 4096, wq, lane);
#pragma unroll
            for (int g = 0; g < 16; ++g) R[g] = R[g] * g512 + kvc[g]; }
    }
}
constexpr int L_RET3G = 5 * B9 + 64 * SF * 4;
__device__ __forceinline__ void ret_stage3g(CK_LAS unsigned char* ldsq, int task, const bf16_t* __restrict__ Pb, int PW, int C_TQ, int C_TK, int C_TV, int C_TG, int SEQ, const float* __restrict__ ROPE,
                                           const float* __restrict__ gn_g, const unsigned char* __restrict__ cw, bf16_t* __restrict__ MIXB) {
    const int tid = ltid(), lane = tid & 63, wid = __builtin_amdgcn_readfirstlane(tid >> 6), wq = wid & 3, I = wq >> 1, J = wq & 1, r = lane & 31, hh = lane >> 5, qtid = tid & 255;
    const lbf Qr = (lbf)ldsq, Kr = (lbf)(ldsq + B9), VT = (lbf)(ldsq + 2 * B9), Sb = (lbf)(ldsq + 3 * B9), RTL = (lbf)(ldsq + 4 * B9); const lf32 Y = (lf32)(ldsq + 5 * B9);
    const int tk = task >= 0 ? task : 0; const int item0 = (tk >> 5) * 256 + (tk & 31) * 8;
    f32x16 R = frag_load((const float*)(cw + O_RG) + (size_t)tk * 4096, wq, lane);
    for (int j = 0; j < 8; ++j) { const int item = task >= 0 ? item0 + j : -1;
    const int b = item >= 0 ? item >> 10 : 0, h = item >= 0 ? (item >> 8) & 3 : 0, c = item >= 0 ? item & 255 : 0; const int t = qtid >> 2, c16 = (qtid & 3) * 16; const int pos = c * 64 + t;
    const float lg = __builtin_amdgcn_logf(1.0f - __builtin_amdgcn_exp2f(-5.0f - (float)h));
    const bf16_t* prow = Pb + ((size_t)b * SEQ + pos) * PW;
    if (item >= 0) {
#pragma unroll
        for (int g_ = 0; g_ < 16; ++g_) RTL[(32 * I + crow(g_, hh)) * SB + 32 * J + r] = (bf16_t)f2bf(R[g_]);
        float qr[16], kr[16]; rot16(qr, prow, C_TQ + h * 64, c16, ROPE + (size_t)pos * 64); rot16(kr, prow, C_TK + h * 64, c16, ROPE + (size_t)pos * 64);
        u32x4 w;
        w.x = pk2(qr[0], qr[1]); w.y = pk2(qr[2], qr[3]); w.z = pk2(qr[4], qr[5]); w.w = pk2(qr[6], qr[7]); *(CK_LAS u32x4*)(Qr + t * SB + c16) = w;
        w.x = pk2(qr[8], qr[9]); w.y = pk2(qr[10], qr[11]); w.z = pk2(qr[12], qr[13]); w.w = pk2(qr[14], qr[15]); *(CK_LAS u32x4*)(Qr + t * SB + c16 + 8) = w;
#pragma unroll
        for (int e = 0; e < 16; ++e) kr[e] *= 0.125f;
        w.x = pk2(kr[0], kr[1]); w.y = pk2(kr[2], kr[3]); w.z = pk2(kr[4], kr[5]); w.w = pk2(kr[6], kr[7]); *(CK_LAS u32x4*)(Kr + t * SB + c16) = w;
        w.x = pk2(kr[8], kr[9]); w.y = pk2(kr[10], kr[11]); w.z = pk2(kr[12], kr[13]); w.w = pk2(kr[14], kr[15]); *(CK_LAS u32x4*)(Kr + t * SB + c16 + 8) = w;
        const u32x4* vp = (const u32x4*)(prow + C_TV + h * 64 + c16);
#pragma unroll
        for (int hv = 0; hv < 2; ++hv) { const u32x4 vw = vp[hv];
#pragma unroll
            for (int e2 = 0; e2 < 4; ++e2) { const int e = hv * 8 + 2 * e2; VT[(c16 + e) * SB + t] = (bf16_t)(vw[e2] & 0xffffu); VT[(c16 + e + 1) * SB + t] = (bf16_t)(vw[e2] >> 16); } }
    }
    __syncthreads();
    if (item >= 0) {
        f32x16 st = mm_lds(Kr, Qr, I, J, lane, f32x16{}); const int tt = 32 * J + r;
#pragma unroll
        for (int g = 0; g < 16; ++g) { const int ii = 32 * I + crow(g, hh); st[g] = (ii <= tt) ? st[g] * __builtin_amdgcn_exp2f(lg * (float)(tt - ii)) : 0.f; }
        tile_store_T(Sb, I, J, lane, st);
    }
    __syncthreads();
    if (item >= 0) {
        const f32x16 yi = mm_lds(VT, Sb, I, J, lane, f32x16{}); const f32x16 yc = mm_lds(RTL, Qr, I, J, lane, f32x16{});
        const int tt = 32 * J + r; const float qd = __builtin_amdgcn_exp2f(lg * (float)(tt + 1));
#pragma unroll
        for (int g = 0; g < 16; ++g) Y[tt * SF + 32 * I + crow(g, hh)] = yi[g] + qd * yc[g];
    }
    __syncthreads();
    if (item >= 0) {
        float y[16]; float s = 0.f;
#pragma unroll
        for (int e = 0; e < 16; ++e) { y[e] = Y[t * SF + c16 + e]; s += y[e]; }
        const float mu = quad_sum(s) * (1.f / 64.f); float s2 = 0.f;
#pragma unroll
        for (int e = 0; e < 16; ++e) { y[e] -= mu; s2 += y[e] * y[e]; }
        const float rstd = 1.0f / sqrtf(quad_sum(s2) * (1.f / 64.f) + 1e-6f);
        const u32x4* gp = (const u32x4*)(prow + C_TG + h * 64 + c16); unsigned ow[8];
#pragma unroll
        for (int hv = 0; hv < 2; ++hv) { const u32x4 gw = gp[hv];
#pragma unroll
            for (int e2 = 0; e2 < 4; ++e2) { const int e = hv * 8 + 2 * e2; const int ch = h * 64 + c16 + e; const float g0 = bflo(gw[e2]), g1 = bfhi(gw[e2]);
                ow[hv * 4 + e2] = pk2(y[e] * rstd * gn_g[ch] * (g0 * sigm(g0)), y[e + 1] * rstd * gn_g[ch + 1] * (g1 * sigm(g1))); } }
        u32x4* dst = (u32x4*)(MIXB + ((size_t)b * SEQ + pos) * 1024 + 768 + h * 64 + c16);
        dst[0] = (u32x4){ow[0], ow[1], ow[2], ow[3]}; dst[1] = (u32x4){ow[4], ow[5], ow[6], ow[7]};
    }
    if (item >= 0) { const f32x16 kvc = frag_load_bf((const bf16_t*)(cw + O_KV) + (size_t)item * 4096, wq, lane); const float g64 = __builtin_amdgcn_exp2f(lg * 64.0f);
#pragma unroll
        for (int g_ = 0; g_ < 16; ++g_) R[g_] = R[g_] * g64 + kvc[g_]; }
    __syncthreads();
    }
}
}

__device__ __forceinline__ void tr_tile(const float* __restrict__ src, size_t ld_src, bf16* __restrict__ dst, size_t ld_dst, float* scr, int lane) {
    pg8::f32x4 v[16];
#pragma unroll
    for (int i = 0; i < 16; ++i) v[i] = *(const pg8::f32x4*)(src + (size_t)(i * 4 + (lane >> 4)) * ld_src + (lane & 15) * 4);
#pragma unroll
    for (int i = 0; i < 16; ++i) { float* p = scr + (i * 4 + (lane >> 4)) * 65 + (lane & 15) * 4; p[0] = v[i][0]; p[1] = v[i][1]; p[2] = v[i][2]; p[3] = v[i][3]; }
    asm volatile("s_waitcnt lgkmcnt(0)" ::: "memory");
#pragma unroll
    for (int i = 0; i < 8; ++i) { const int n = i * 8 + (lane >> 3), kc = (lane & 7) * 8; const float* s = scr + kc * 65 + n;
        pg8::u32x4 o; o.x = pk2(s[0], s[65]); o.y = pk2(s[2 * 65], s[3 * 65]); o.z = pk2(s[4 * 65], s[5 * 65]); o.w = pk2(s[6 * 65], s[7 * 65]);
        *(pg8::u32x4*)(dst + (size_t)n * ld_dst + kc) = o; }
    asm volatile("s_waitcnt lgkmcnt(0)" ::: "memory");
}

constexpr int CV_13 = NE * 16 * 16, CV_2 = NE * 8 * 16, CV_L = CV_13 + CV_2, NCONV = DEPTH * CV_L;
__device__ __forceinline__ void conv_item(int it, const float* __restrict__ w1, const float* __restrict__ w3, const float* __restrict__ w2, bf16* __restrict__ W13, bf16* __restrict__ W2, float* scr, int lane) {
    const int l = it / CV_L; int r = it % CV_L;
    if (r < CV_13) { const int e = r >> 8, kb = (r >> 4) & 15, nb = r & 15;
        const int pn = nb >> 2, q = nb & 3; const float* srcw = (q < 2 ? w1 : w3) + ((size_t)l * NE + e) * DM * DE;
        tr_tile(srcw + (size_t)kb * 64 * DE + pn * 128 + (q & 1) * 64, DE, W13 + ((size_t)l * NE + e) * DM * DM + (size_t)nb * 64 * DM + kb * 64, DM, scr, lane); }
    else { r -= CV_13; const int e = r >> 7, kb = (r >> 4) & 7, nb = r & 15;
        tr_tile(w2 + ((size_t)l * NE + e) * DE * DM + (size_t)kb * 64 * DM + nb * 64, DM, W2 + ((size_t)l * NE + e) * DM * DE + (size_t)nb * 64 * DE + kb * 64, DE, scr, lane); }
}

#define LAS __attribute__((address_space(3)))
#define XB_TMO      128
#define XB_XCNT(j)  (256  + 64 * (j))
#define XB_XSUB(j)  (1280 + 64 * (j))
#define XB_XGEN(j)  (2304 + 64 * (j))
#define XB_TOP      3328
#define XB_TOPGEN   3392
#define XCD_BAR_WORDS 3456
#define XB_SPIN_CAP (1u << 18)

__device__ __forceinline__ unsigned xb_ld(unsigned* p)              { return __hip_atomic_load(p, __ATOMIC_RELAXED, __HIP_MEMORY_SCOPE_AGENT); }
__device__ __forceinline__ unsigned xb_add(unsigned* p, unsigned v) { return __hip_atomic_fetch_add(p, v, __ATOMIC_RELAXED, __HIP_MEMORY_SCOPE_AGENT); }
__device__ __forceinline__ unsigned xb_xcc_id() { return (unsigned)__builtin_amdgcn_s_getreg((3 << 11) | 20) & 0xFu; }
#define XB_SPIN(cond, bar) do { unsigned _sp = 0; while (cond) { __builtin_amdgcn_s_sleep(1); \
    if ((++_sp & 255u) == 0u) { if (xb_ld(&(bar)[XB_TMO])) break; if (_sp > XB_SPIN_CAP) { atomicAdd(&(bar)[XB_TMO], 1u); break; } } } } while (0)

struct XcdBarrier {
    unsigned* bar; unsigned x;
    volatile LAS unsigned* st;
};

__device__ __forceinline__ XcdBarrier xcd_barrier_post(unsigned* bar, volatile LAS unsigned* st) {
    XcdBarrier b; b.bar = bar; b.x = xb_xcc_id(); b.st = st;
    if (ltid() == 0) (void)xb_add(&bar[XB_XCNT(b.x)], 1u);
    return b;
}
__device__ __forceinline__ void xcd_barrier_complete(unsigned* bar, unsigned x, unsigned& nloc, unsigned& nx) {
    const unsigned G = gridDim.x * gridDim.y * gridDim.z;
    unsigned sum, cnt, mine, sp = 0u;
    for (;;) {
        sum = 0u; cnt = 0u; mine = 0u;
#pragma unroll
        for (unsigned j = 0; j < 16; ++j) { const unsigned c = xb_ld(&bar[XB_XCNT(j)]); sum += c; cnt += (c > 0u) ? 1u : 0u; mine = (j == x) ? c : mine; }
        if (sum == G) break;
        __builtin_amdgcn_s_sleep(1);
        if ((++sp & 255u) == 0u) { if (xb_ld(&bar[XB_TMO])) break; if (sp > XB_SPIN_CAP) { atomicAdd(&bar[XB_TMO], 1u); break; } }
    }
    nloc = mine > 0u ? mine : 1u; nx = cnt > 0u ? cnt : 1u;
}

__device__ __forceinline__ void xcd_barrier(const XcdBarrier& b) {
    asm volatile("s_waitcnt vmcnt(0)" ::: "memory");
    __syncthreads();
    if (ltid() == 0) {
        unsigned* bar = b.bar; asm volatile("" : "+s"(bar)); unsigned bx_ = b.x; asm volatile("" : "+s"(bx_));
        __builtin_amdgcn_s_waitcnt(0);
        unsigned nloc = b.st[0], nx = b.st[1];
        if (nloc == 0u) { xcd_barrier_complete(bar, bx_, nloc, nx); b.st[0] = nloc; b.st[1] = nx; }
        const unsigned old = xb_add(&bar[XB_XSUB(bx_)], 1u);
        const unsigned gen = old / nloc;
        if (old + 1u == (gen + 1u) * nloc) {
            __builtin_amdgcn_fence(__ATOMIC_RELEASE, "agent");
            asm volatile("s_waitcnt vmcnt(0)" ::: "memory");
            const unsigned og = xb_add(&bar[XB_TOP], 1u);
            const unsigned tg = og / nx;
            if (og + 1u == (tg + 1u) * nx) xb_add(&bar[XB_TOPGEN], 1u);
            else XB_SPIN(xb_ld(&bar[XB_TOPGEN]) == tg, bar);
            __builtin_amdgcn_fence(__ATOMIC_ACQUIRE, "agent");
            xb_add(&bar[XB_XGEN(bx_)], 1u);
            asm volatile("s_waitcnt vmcnt(0)" ::: "memory");
        } else {
            XB_SPIN(xb_ld(&bar[XB_XGEN(bx_)]) == gen, bar);
            __builtin_amdgcn_fence(__ATOMIC_ACQUIRE, "agent");
            asm volatile("s_waitcnt vmcnt(0)" ::: "memory");
        }
    }
    __syncthreads();
}


__global__ void __launch_bounds__(NTHREADS, 2) mk_fwd(Args args) {
    extern __shared__ __attribute__((aligned(16))) unsigned char lds_raw[];
    float* lds = (float*)lds_raw;
    const int tid = ltid(), lane = tid & 63, wid = __builtin_amdgcn_readfirstlane(tid >> 6);
    const int G = gridDim.x, bx = blockIdx.x;
    unsigned char* ws = args.ws;
    unsigned* ctl = (unsigned*)(ws + WS_CTL);
    float* X = args.out;
    bf16* XB = (bf16*)(ws + WS_XB);
    bf16* Pb = (bf16*)(ws + WS_P);
    bf16* WIN = (bf16*)(ws + WS_WIN); bf16* WOUT = (bf16*)(ws + WS_WOUT); bf16* W13 = (bf16*)(ws + WS_W13); bf16* W2 = (bf16*)(ws + WS_W2);
    float* ROPE = (float*)(ws + WS_ROPE);
    double* LCS = (double*)(ws + WS_LCS); double* TOT = (double*)(ws + WS_TOT);
    float* BE = (float*)(ws + WS_SKIP); float* QN2 = BE + 16 * 256; float* KN2 = QN2 + 16 * 128;
    unsigned char* KA = ws + WS_KA;
    unsigned char* cw = ws + WS_CK; bf16* LWT = (bf16*)(ws + WS_LW);
    int* EP = (int*)(ws + WS_EP); int* DEST = (int*)(ws + WS_DEST);
    float* GATE = (float*)(ws + WS_GATE);
    bf16* MIXB = (bf16*)(ws + WS_MIXB);
    bf16* XP = (bf16*)(ws + WS_XP); bf16* Hb = (bf16*)(ws + WS_H); bf16* YP = (bf16*)(ws + WS_YP); bf16* YO = (bf16*)(ws + WS_YO);
    typedef pg8::f32x4 f32x4;
    volatile LAS unsigned* MISC = (volatile LAS unsigned*)((LAS unsigned char*)lds_raw + LDS_MISC);
    for (int u = tid; u < (LDS_ALL - LDS_MISC) / 4; u += NTHREADS) MISC[u] = 0u;
    __syncthreads();
    XcdBarrier bar = xcd_barrier_post(ctl + CW_BAR, MISC + 8);
#define GRID_BAR() xcd_barrier(bar)

    for (int rep_ = 0; rep_ < REP_P0; ++rep_) {
            const int tid = ltid(), lane = tid & 63, wid = __builtin_amdgcn_readfirstlane(tid >> 6); (void)lane; (void)wid;
        const f32x4* xi = (const f32x4*)args.in[0]; uint2* xb = (uint2*)XB;
        for (size_t i = (size_t)bx * NTHREADS + tid; i < (size_t)T * DM / 4; i += (size_t)G * NTHREADS) { const f32x4 v = xi[i]; xb[i] = make_uint2(pk2(v[0], v[1]), pk2(v[2], v[3])); }
        for (int i = bx * NTHREADS + tid; i < SEQ * 32; i += G * NTHREADS) {
            const int pos = i >> 5, f = i & 31;
            const double inv = pow(10000.0, -(double)f / 32.0);
            const double ang = (double)pos * inv;
            ROPE[2 * i] = (float)cos(ang); ROPE[2 * i + 1] = (float)sin(ang);
        }
        { bf16* WR = (bf16*)(ws + WS_WR);
          for (int i = bx * NTHREADS + tid; i < DEPTH * 48 * 1024; i += G * NTHREADS) { const int l_ = i / (48 * 1024), o = (i / 1024) % 48, k = i & 1023;
              const float wv = o < 4 ? args.in[21][((size_t)l_ * DM + k) * 4 + o] : (o < 36 ? args.in[23][((size_t)l_ * DM + k) * 32 + (o - 4)] : 0.f);
              const unsigned hi_ = f2bf(wv); const unsigned lo_ = f2bf(wv - bf2f((unsigned short)hi_));
              WR[((size_t)l_ * 2 + 0) * 48 * 1024 + o * 1024 + k] = (bf16)hi_; WR[((size_t)l_ * 2 + 1) * 48 * 1024 + o * 1024 + k] = (bf16)lo_; } }
        for (int i = bx * NTHREADS + tid; i < DEPTH * 256 * 256; i += G * NTHREADS) {
            const int l = i >> 16, rem = i & 65535, chg = rem >> 8, ii = rem & 255;
            if (ii < 64) LWT[((size_t)l * 256 + chg) * 64 + ii] = (bf16)f2bf(args.in[6][((size_t)l * 64 + ii) * 256 + chg]);
            else if (ii < 128) LWT[(size_t)DEPTH * 256 * 64 + ((size_t)l * 256 + chg) * 64 + (ii - 64)] = (bf16)f2bf(args.in[8][((size_t)l * 64 + (ii - 64)) * 256 + chg]);
            else LWT[(size_t)2 * DEPTH * 256 * 64 + ((size_t)l * 256 + chg) * 128 + (ii - 128)] = (bf16)f2bf(args.in[9][((size_t)l * 128 + (ii - 128)) * 256 + chg]);
        }
        float* scr = lds + wid * (64 * 65);
        constexpr int I_IN = 16 * 56, I_OUT = 16 * 16, I_L = I_IN + I_OUT;
        for (int it = bx * 8 + wid; it < DEPTH * I_L; it += G * 8) {
            const int l = it / I_L; int r = it % I_L;
            if (r < I_IN) { const int kb = r / 56, nb = r % 56; const int nsrc = nb * 64 + (nb >= 24 ? 8 : 0);
                tr_tile(args.in[1] + (size_t)l * DM * INW + (size_t)kb * 64 * INW + nsrc, INW, WIN + (size_t)l * PW * DM + (size_t)nb * 64 * DM + kb * 64, DM, scr, lane); }
            else { r -= I_IN; const int kb = r / 16, nb = r % 16;
                tr_tile(args.in[16] + (size_t)l * DM * DM + (size_t)kb * 64 * DM + nb * 64, DM, WOUT + (size_t)l * DM * DM + (size_t)nb * 64 * DM + kb * 64, DM, scr, lane); }
        }
        __syncthreads();
        {
            const float* wf = args.in[1] + O_FF; const float* fbias = args.in[2];
            float w[8][16];
#pragma unroll
            for (int jq = 0; jq < 4; ++jq)
#pragma unroll
                for (int e = 0; e < 4; ++e)
#pragma unroll
                    for (int h = 0; h < 8; ++h) w[h][jq * 4 + e] = wf[(size_t)(jq * 256 + lane * 4 + e) * INW + h];
            float* ffl = lds;
            for (int ch = bx; ch < T / 128; ch += G) {
                __syncthreads();
                for (int i = 0; i < 16; ++i) { const int tl = wid * 16 + i; const size_t m = (size_t)ch * 128 + tl;
                    float acc[8];
#pragma unroll
                    for (int h = 0; h < 8; ++h) acc[h] = 0.f;
#pragma unroll
                    for (int jq = 0; jq < 4; ++jq) { const f32x4 xv = *(const f32x4*)(args.in[0] + m * DM + jq * 256 + lane * 4);
#pragma unroll
                        for (int e = 0; e < 4; ++e)
#pragma unroll
                            for (int h = 0; h < 8; ++h) acc[h] += xv[e] * w[h][jq * 4 + e]; }
#pragma unroll
                    for (int h = 0; h < 8; ++h) acc[h] = wave_sum(acc[h]);
                    if (lane < 8) { float v = acc[0];
#pragma unroll
                        for (int h = 1; h < 8; ++h) v = (lane == h) ? acc[h] : v;
                        ffl[tl * 8 + lane] = v + fbias[lane]; } }
                __syncthreads();
                {
                    const int h = wid; const int bb = (ch * 128) / SEQ, t0 = (ch * 128) % SEQ; double carry = 0.0;
#pragma unroll
                    for (int half = 0; half < 2; ++half) { double v = (double)logsigmoidf_(ffl[(half * 64 + lane) * 8 + h]);
#pragma unroll
                        for (int o = 1; o < 64; o <<= 1) { const double n = __shfl_up(v, o); if (lane >= o) v += n; }
                        v += carry; LCS[(size_t)(bb * 8 + h) * SEQ + t0 + half * 64 + lane] = v; carry = __shfl(v, 63); }
                    if (lane == 0) TOT[(bb * 8 + h) * 128 + t0 / 128] = carry;
                }
            }
            __syncthreads();
        }
    }
    GRID_BAR();

    for (int l = 0; l < DEPTH; ++l) {
        for (int rep_ = 0; rep_ < REP_A; ++rep_) {
            const int tid = ltid(), lane = tid & 63, wid = __builtin_amdgcn_readfirstlane(tid >> 6); (void)lane; (void)wid;
            pg8::Gemm g{XB, WIN + (size_t)l * PW * DM, T, PW, DM}; pg8::StaticOrder S; S.init(T, PW, G, bx);
            pg8::EpiInProj E{Pb, PW, QC2};
            pg8::gemm_phase<pg8::EpiInProj, pg8::StaticOrder, true, true>((PG8_LAS unsigned char*)lds_raw, g, S, E);
        }
        GRID_BAR();
        for (int rep_ = 0; rep_ < REP_C; ++rep_) {
            const int tid = ltid(), lane = tid & 63, wid = __builtin_amdgcn_readfirstlane(tid >> 6); (void)lane; (void)wid;
            for (int ch = bx; ch < T / 128; ch += G) {
                const int h = wid; const int bb = (ch * 128) / SEQ, t0 = (ch * 128) % SEQ, ci = t0 / 128;
                double pre = 0.0;
                { const double* tp = TOT + (bb * 8 + h) * 128; double a = (lane < ci) ? tp[lane] : 0.0; a += (lane + 64 < ci) ? tp[lane + 64] : 0.0;
#pragma unroll
                  for (int o = 1; o < 64; o <<= 1) a += __shfl_xor(a, o);
                  pre = a; }
#pragma unroll
                for (int half = 0; half < 2; ++half) { const int t = t0 + half * 64 + lane; const double v = pre + LCS[(size_t)(bb * 8 + h) * SEQ + t];
                    const double bd = -v * 1.4426950408889634; const unsigned h_ = f2bf((float)bd); const double r1 = bd - (double)bf2f((unsigned short)h_);
                    const unsigned m_ = f2bf((float)r1); const double r2 = r1 - (double)bf2f((unsigned short)m_); const unsigned l_ = f2bf((float)r2);
                    *(pg8::u32x4*)(KA + ((size_t)(bb * 8 + h) * SEQ + t) * 16) = (pg8::u32x4){h_ | (m_ << 16), l_ | (0x3f80u << 16), 0x3f803f80u, 0u};
                    if (lane == 63) BE[(bb * 8 + h) * 256 + t / 64] = (float)bd; }
                { LAS unsigned* nrm = (LAS unsigned*)lds_raw;
                  __syncthreads();
                  if (tid < 16) nrm[tid] = 0u;
                  __syncthreads();
                  const int tl = tid >> 2, part = tid & 3; const bf16* prow = Pb + ((size_t)ch * 128 + tl) * PW;
#pragma unroll
                  for (int hq = 0; hq < 2; ++hq) { const int hd = part * 2 + hq;
#pragma unroll
                      for (int qk = 0; qk < 2; ++qk) { const pg8::u32x4* vp = (const pg8::u32x4*)(prow + (qk ? C_FK : C_FQ) + hd * 64); float ss = 0.f;
#pragma unroll
                          for (int v8 = 0; v8 < 8; ++v8) { const pg8::u32x4 wv = vp[v8];
#pragma unroll
                              for (int e = 0; e < 4; ++e) { const float lo_ = __builtin_bit_cast(float, wv[e] << 16), hi_ = __builtin_bit_cast(float, wv[e] & 0xffff0000u); ss += lo_ * lo_ + hi_ * hi_; } }
                          atomicMax((unsigned*)(nrm + qk * 8 + hd), __float_as_uint(ss)); } }
                  __syncthreads();
                  if (tid < 16) { const int hd = tid & 7; ((tid < 8) ? QN2 : KN2)[(bb * 8 + hd) * 128 + ci] = __uint_as_float(nrm[tid]); }
                }
            }
            __syncthreads();
            const ck::RwkvParams rp{args.in[3] + l * 768, args.in[4] + l * 256, args.in[5] + l * 256, args.in[7] + l * 256, args.in[10] + l * 256, args.in[11] + l * 256, args.in[12] + l * 256,
                                    args.in[13] + l * 256, args.in[14] + l * 256, args.in[15] + l * 256,
                                    LWT + (size_t)l * 256 * 64, LWT + (size_t)DEPTH * 256 * 64 + (size_t)l * 256 * 64, LWT + (size_t)2 * DEPTH * 256 * 64 + (size_t)l * 256 * 128};
#ifndef REP_S1
#define REP_S1 1
#endif
#ifndef REP_R1
#define REP_R1 1
#endif
            for (int rr_ = 0; rr_ < REP_S1; ++rr_)
            for (int it = bx; it < 2048; it += G) ck::rwkv_stage1((CK_LAS unsigned char*)lds_raw, it, Pb, PW, C_RR, C_RK, C_RV, C_WD, SEQ, rp, cw);
            { const int quad = wid >> 2;
              for (int rr_ = 0; rr_ < REP_R1; ++rr_)
              for (int i0 = bx * 2; i0 < 2048; i0 += G * 2) ck::ret_stage1((CK_LAS unsigned char*)lds_raw + quad * 2 * ck::B9, i0 + quad, Pb, PW, C_TK, C_TV, SEQ, ROPE, cw); }
        }
        GRID_BAR();
        {
            const int tid = ltid(), lane = tid & 63, wid = __builtin_amdgcn_readfirstlane(tid >> 6); (void)lane; (void)wid;
            const int quad = wid >> 2;
#ifndef REP_S
#define REP_S 1
#endif
            for (int rep_ = 0; rep_ < REP_S; ++rep_) {
            if (bx < 128) {
                ck::rwkv_level1((CK_LAS unsigned char*)lds_raw, 2 * bx + quad, cw);
                asm volatile("s_waitcnt vmcnt(0)" ::: "memory"); __syncthreads();
                if (tid == 0) { __builtin_amdgcn_fence(__ATOMIC_RELEASE, "agent"); asm volatile("s_waitcnt vmcnt(0)" ::: "memory");
                                __hip_atomic_fetch_add(ctl + CW_L1 + 64 * (16 * l + (bx >> 4)), 2u, __ATOMIC_RELAXED, __HIP_MEMORY_SCOPE_AGENT); }
            }
            if (bx >= 128) {
                ck::ret_level1(2 * (bx - 128) + quad, cw);
                asm volatile("s_waitcnt vmcnt(0)" ::: "memory"); __syncthreads();
                if (tid == 0) { __builtin_amdgcn_fence(__ATOMIC_RELEASE, "agent"); asm volatile("s_waitcnt vmcnt(0)" ::: "memory");
                                __hip_atomic_fetch_add(ctl + CW_L1 + 64 * (16 * l + 8 + ((bx - 128) >> 4)), 2u, __ATOMIC_RELAXED, __HIP_MEMORY_SCOPE_AGENT); }
            }
            if (bx < 8) {
                if (wid == 0) { unsigned spins = 0;
                    while (__hip_atomic_load(ctl + CW_L1 + 64 * (16 * l + bx), __ATOMIC_RELAXED, __HIP_MEMORY_SCOPE_AGENT) < 32u) { if (++spins > (1u << 22)) break; __builtin_amdgcn_s_sleep(2); }
                    __builtin_amdgcn_fence(__ATOMIC_ACQUIRE, "agent"); asm volatile("s_waitcnt vmcnt(0)" ::: "memory"); }
                __syncthreads();
                ck::rwkv_scan<32>((CK_LAS unsigned char*)lds_raw, quad == 0 ? bx : -1, (const ck::bf16_t*)(cw + ck::O_PG), (const ck::bf16_t*)(cw + ck::O_QG), (ck::bf16_t*)(cw + ck::O_HG));
            }
            else if (bx < 16) {
                if (wid == 0) { unsigned spins = 0;
                    while (__hip_atomic_load(ctl + CW_L1 + 64 * (16 * l + bx), __ATOMIC_RELAXED, __HIP_MEMORY_SCOPE_AGENT) < 32u) { if (++spins > (1u << 22)) break; __builtin_amdgcn_s_sleep(2); }
                    __builtin_amdgcn_fence(__ATOMIC_ACQUIRE, "agent"); asm volatile("s_waitcnt vmcnt(0)" ::: "memory"); }
                __syncthreads();
                if (quad == 0) ck::ret_scan_groups(bx - 8, cw);
            }
            if (bx < 16) {
                asm volatile("s_waitcnt vmcnt(0)" ::: "memory"); __syncthreads();
                if (tid == 0) { __builtin_amdgcn_fence(__ATOMIC_RELEASE, "agent"); asm volatile("s_waitcnt vmcnt(0)" ::: "memory");
                                __hip_atomic_store(ctl + CW_SF + 64 * (16 * l + bx), 1u, __ATOMIC_RELAXED, __HIP_MEMORY_SCOPE_AGENT); }
            }
            }
            __syncthreads();
            const attn_body::AttnTensors AT{(const attn_body::bf16*)(Pb + C_FQ), (const attn_body::bf16*)(Pb + C_FK), (const attn_body::bf16*)(Pb + C_FV), (attn_body::bf16*)MIXB, KA};
            bool cvdone = false;
#ifndef REP_D
#define REP_D 1
#endif
            for (int rd_ = 0; rd_ < REP_D; ++rd_)
            for (int gtry = 0; gtry < 8; ++gtry) {
                const int grp = (bx + gtry) & 7; unsigned* qh = ctl + (rd_ ? 20480 : CW_Q) + 64 * (8 * l + grp);
                for (;;) {
                    if (tid == 0) MISC[16] = atomicAdd(qh, 1u);
                    __syncthreads();
                    const unsigned idx = MISC[16];
                    if (idx >= 128u) { __syncthreads(); break; }
                    const int qb = 63 - (int)(idx >> 1), bh = 2 * grp + (int)(idx & 1);
                    if (wid == 0) {
                        const float qn2 = fmaxf(QN2[bh * 128 + 2 * qb], QN2[bh * 128 + 2 * qb + 1]);
                        float kn2 = fmaxf(lane <= 2 * qb + 1 ? KN2[bh * 128 + lane] : 0.f, lane + 64 <= 2 * qb + 1 ? KN2[bh * 128 + 64 + lane] : 0.f);
#pragma unroll
                        for (int o = 1; o < 64; o <<= 1) kn2 = fmaxf(kn2, __shfl_xor(kn2, o));
                        const float bound = 2.002f * sqrtf(qn2 * kn2) + 50.0f; const int ntq = 4 * qb;
                        const float bref = ntq > 0 ? BE[bh * 256 + ntq - 1] : 0.f;
                        int nsk = 0;
#pragma unroll
                        for (int q4 = 0; q4 < 4; ++q4) { const int tt = q4 * 64 + lane; const bool sk = tt < ntq && (bref - BE[bh * 256 + tt]) > bound; nsk += __popcll(__ballot(sk)); }
                        if (lane == 0) MISC[17] = (unsigned)(nsk & ~1);
                    }
                    __syncthreads();
                    const int t0 = (int)MISC[17];
                    attn_body::attn_unit<8>(bh / attn_body::NHEAD, bh % attn_body::NHEAD, qb, t0, AT.Q, AT.K, AT.V, AT.O, AT.KA, (char*)lds_raw);
                    if (!cvdone) {
                        if (tid == 0) MISC[18] = atomicAdd(ctl + CW_CV, 16u);
                        __syncthreads();
                        const int tk = (int)MISC[18];
                        if (tk >= NCONV) cvdone = true;
                        else { const int t2 = ltid(), lane2 = t2 & 63, wid2 = __builtin_amdgcn_readfirstlane(t2 >> 6);
                            float* scr = lds + wid2 * (64 * 65);
                            _Pragma("clang loop unroll(disable)") for (int q2 = 0; q2 < 2; ++q2) { const int itc = tk + 8 * q2 + wid2; if (itc < NCONV) conv_item(itc, args.in[25], args.in[26], args.in[27], W13, W2, scr, lane2); } }
                        __syncthreads();
                    }
                }
            }
        }
        {
            const int tid = ltid(), lane = tid & 63, wid = __builtin_amdgcn_readfirstlane(tid >> 6); (void)lane; (void)wid;
            __syncthreads();
            if (wid == 0) {
                unsigned spins = 0;
                for (;;) { const unsigned f = lane < 16 ? __hip_atomic_load(ctl + CW_SF + 64 * (16 * l + lane), __ATOMIC_RELAXED, __HIP_MEMORY_SCOPE_AGENT) : 1u;
                    if (__all(f != 0u)) break; if (++spins > (1u << 22)) break; __builtin_amdgcn_s_sleep(2); }
                __builtin_amdgcn_fence(__ATOMIC_ACQUIRE, "agent"); asm volatile("s_waitcnt vmcnt(0)" ::: "memory");
            }
            __syncthreads();
            const ck::RwkvParams rp{args.in[3] + l * 768, args.in[4] + l * 256, args.in[5] + l * 256, args.in[7] + l * 256, args.in[10] + l * 256, args.in[11] + l * 256, args.in[12] + l * 256,
                                    args.in[13] + l * 256, args.in[14] + l * 256, args.in[15] + l * 256, nullptr, nullptr, nullptr};
            const int quad = wid >> 2;
            for (;;) {
                if (tid == 0) MISC[16] = atomicAdd(ctl + CW_EQ + 64 * l, 1u);
                __syncthreads();
                const int p = (int)MISC[16];
                __syncthreads();
                if (p >= 128 + 128) break;
                if (p < 128) ck::rwkv_stage3g((CK_LAS unsigned char*)lds_raw + quad * ck::L_RW3, 2 * p + quad, rp, cw, MIXB, SEQ);
                else ck::ret_stage3g((CK_LAS unsigned char*)lds_raw + quad * ck::L_RET3G, 2 * (p - 128) + quad, Pb, PW, C_TQ, C_TK, C_TV, C_TG, SEQ, ROPE, args.in[15] + l * 256, cw, MIXB);
            }
        }
        GRID_BAR();
        for (int rep_ = 0; rep_ < REP_F; ++rep_) {
            const int tid = ltid(), lane = tid & 63, wid = __builtin_amdgcn_readfirstlane(tid >> 6); (void)lane; (void)wid;
            pg8::Gemm g{MIXB, WOUT + (size_t)l * DM * DM, T, DM, DM}; pg8::StaticOrder S; S.init(T, DM, G, bx);
            pg8::EpiInProj E{YO, DM, 1.0f};
            pg8::gemm_phase<pg8::EpiInProj, pg8::StaticOrder, true, true>((PG8_LAS unsigned char*)lds_raw, g, S, E);
        }
        GRID_BAR();
        {
            const int tid = ltid(), lane = tid & 63, wid = __builtin_amdgcn_readfirstlane(tid >> 6); (void)lane; (void)wid;
            const float* g1 = args.in[17] + l * DM; const float* b1 = args.in[18] + l * DM;
            const float* bg = args.in[22] + l * 4; const float* be = args.in[24] + l * 32;
            unsigned* cnt = ctl + CW_CNT + 64 * 32 * l;
            const bf16* WRh = (const bf16*)(ws + WS_WR) + (size_t)l * 2 * 48 * 1024; const bf16* WRl = WRh + 48 * 1024;
            constexpr int XS = 1032;
            LAS unsigned short* XT = (LAS unsigned short*)lds_raw;
            LAS float* PART = (LAS float*)((LAS unsigned char*)lds_raw + 32 * XS * 2);
            LAS float* LG = PART + 8 * 32 * 48;
            LAS unsigned* LCNT = (LAS unsigned*)(LG + 128 * 48);
            if (tid < 32) LCNT[tid] = 0u;
            pg8::bf16x8 wh[4][3], wl[4][3];
#pragma unroll
            for (int s_ = 0; s_ < 4; ++s_)
#pragma unroll
                for (int nt = 0; nt < 3; ++nt) { const size_t o = (size_t)(16 * nt + (lane & 15)) * 1024 + 128 * wid + 32 * s_ + 8 * (lane >> 4);
                    wh[s_][nt] = *(const pg8::bf16x8*)(WRh + o); wl[s_][nt] = *(const pg8::bf16x8*)(WRl + o); }
            float gg[16], bb[16];
#pragma unroll
            for (int jq = 0; jq < 4; ++jq) { const f32x4 gv = *(const f32x4*)(g1 + jq * 256 + lane * 4), bv = *(const f32x4*)(b1 + jq * 256 + lane * 4);
#pragma unroll
                for (int e = 0; e < 4; ++e) { gg[jq * 4 + e] = gv[e]; bb[jq * 4 + e] = bv[e]; } }
            for (int ch = bx; ch < T / 128; ch += G) {
                for (int blk = 0; blk < 4; ++blk) {
                    const size_t m0 = (size_t)ch * 128 + blk * 32;
                    uint2 xw[4][4], yw[4][4];
#pragma unroll
                    for (int i = 0; i < 4; ++i) { const size_t m = m0 + wid * 4 + i;
#pragma unroll
                        for (int jq = 0; jq < 4; ++jq) { xw[i][jq] = *(const uint2*)(XB + m * DM + jq * 256 + lane * 4); yw[i][jq] = *(const uint2*)(YO + m * DM + jq * 256 + lane * 4); } }
#pragma unroll
                    for (int i = 0; i < 4; ++i) { const int tl = wid * 4 + i; const size_t m = m0 + tl;
                        float v[16]; float sm = 0.f;
#pragma unroll
                        for (int jq = 0; jq < 4; ++jq) { const uint2 a_ = xw[i][jq], c_ = yw[i][jq];
                            const f32x4 xv = (f32x4){__builtin_bit_cast(float, a_.x << 16), __builtin_bit_cast(float, a_.x & 0xffff0000u), __builtin_bit_cast(float, a_.y << 16), __builtin_bit_cast(float, a_.y & 0xffff0000u)};
                            const f32x4 yv = (f32x4){__builtin_bit_cast(float, c_.x << 16), __builtin_bit_cast(float, c_.x & 0xffff0000u), __builtin_bit_cast(float, c_.y << 16), __builtin_bit_cast(float, c_.y & 0xffff0000u)};
#pragma unroll
                            for (int e = 0; e < 4; ++e) { v[jq * 4 + e] = ALPHA * xv[e] + yv[e]; sm += v[jq * 4 + e]; } }
                        const float mean = wave_sum(sm) * (1.f / DM); float s2 = 0.f;
#pragma unroll
                        for (int q = 0; q < 16; ++q) { v[q] -= mean; s2 += v[q] * v[q]; }
                        const float rstd = 1.0f / sqrtf(wave_sum(s2) * (1.f / DM) + LN_EPS);
#pragma unroll
                        for (int jq = 0; jq < 4; ++jq) { unsigned hw[4];
#pragma unroll
                            for (int e = 0; e < 4; ++e) hw[e] = f2bf(v[jq * 4 + e] * rstd * gg[jq * 4 + e] + bb[jq * 4 + e]);
                            const ck::u32x2 pw = (ck::u32x2){hw[0] | (hw[1] << 16), hw[2] | (hw[3] << 16)};
                            *(uint2*)(XB + m * DM + jq * 256 + lane * 4) = make_uint2(pw.x, pw.y);
                            *(LAS ck::u32x2*)(XT + tl * XS + jq * 256 + lane * 4) = pw; }
                    }
                    __syncthreads();
                    {
                        pg8::f32x4 acc[2][3];
#pragma unroll
                        for (int mt = 0; mt < 2; ++mt)
#pragma unroll
                            for (int nt = 0; nt < 3; ++nt) acc[mt][nt] = pg8::f32x4{0.f, 0.f, 0.f, 0.f};
#pragma unroll
                        for (int s_ = 0; s_ < 4; ++s_)
#pragma unroll
                            for (int mt = 0; mt < 2; ++mt) { const pg8::bf16x8 ax = *(const LAS pg8::bf16x8*)(XT + (16 * mt + (lane & 15)) * XS + 128 * wid + 32 * s_ + 8 * (lane >> 4));
#pragma unroll
                                for (int nt = 0; nt < 3; ++nt) { acc[mt][nt] = __builtin_amdgcn_mfma_f32_16x16x32_bf16(ax, wh[s_][nt], acc[mt][nt], 0, 0, 0); acc[mt][nt] = __builtin_amdgcn_mfma_f32_16x16x32_bf16(ax, wl[s_][nt], acc[mt][nt], 0, 0, 0); } }
#pragma unroll
                        for (int mt = 0; mt < 2; ++mt)
#pragma unroll
                            for (int nt = 0; nt < 3; ++nt)
#pragma unroll
                                for (int r_ = 0; r_ < 4; ++r_) PART[(wid * 32 + 16 * mt + 4 * (lane >> 4) + r_) * 48 + 16 * nt + (lane & 15)] = acc[mt][nt][r_];
                    }
                    __syncthreads();
                    for (int p_ = tid; p_ < 32 * 48; p_ += NTHREADS) { float a_ = 0.f;
#pragma unroll
                        for (int w_ = 0; w_ < 8; ++w_) a_ += PART[w_ * 32 * 48 + p_];
                        LG[blk * 32 * 48 + p_] = a_; }
                }
                __syncthreads();
                int ex0 = 0, ex1 = 0; unsigned lp0 = 0, lp1 = 0;
                if (tid < 128) { const LAS float* lg = LG + tid * 48; const size_t m = (size_t)ch * 128 + tid;
                    int grp = 0; float gbest = lg[0] + bg[0];
#pragma unroll
                    for (int o = 1; o < 4; ++o) { const float gv = lg[o] + bg[o]; if (gv > gbest) { gbest = gv; grp = o; } }
                    float den = 0.f;
#pragma unroll
                    for (int o = 0; o < 4; ++o) den += expf(lg[o] + bg[o] - gbest);
                    const float ggate = 1.0f / den;
                    int i0 = 0; float v0 = lg[4 + grp * 8] + be[grp * 8];
                    for (int o = 1; o < 8; ++o) { const float ev = lg[4 + grp * 8 + o] + be[grp * 8 + o]; if (ev > v0) { v0 = ev; i0 = o; } }
                    int i1 = -1; float v1 = -INFINITY;
                    for (int o = 0; o < 8; ++o) { const float ev = lg[4 + grp * 8 + o] + be[grp * 8 + o]; if (o != i0 && (i1 < 0 || ev > v1)) { v1 = ev; i1 = o; } }
                    const float e1 = expf(v1 - v0); const float p0 = 1.0f / (1.0f + e1), p1 = e1 / (1.0f + e1);
                    ex0 = grp * 8 + i0; ex1 = grp * 8 + i1;
                    lp0 = atomicAdd((unsigned*)(LCNT + ex0), 1u); lp1 = atomicAdd((unsigned*)(LCNT + ex1), 1u);
                    GATE[2 * m] = ggate * p0; GATE[2 * m + 1] = ggate * p1;
                }
                __syncthreads();
                if (tid < 32) { const unsigned c_ = LCNT[tid]; LCNT[32 + tid] = c_ ? atomicAdd(cnt + 64 * tid, c_) : 0u; }
                __syncthreads();
                if (tid < 128) { const size_t m = (size_t)ch * 128 + tid; EP[2 * m] = (ex0 << 16) | (int)(LCNT[32 + ex0] + lp0); EP[2 * m + 1] = (ex1 << 16) | (int)(LCNT[32 + ex1] + lp1); }
                __syncthreads();
                if (tid < 32) LCNT[tid] = 0u;
            }
        }
        GRID_BAR();
        for (int rep_ = 0; rep_ < REP_H; ++rep_) {
            const int tid = ltid(), lane = tid & 63, wid = __builtin_amdgcn_readfirstlane(tid >> 6); (void)lane; (void)wid;
            {
                const int endl = (l + 1) * CV_L;
                for (;;) { if (tid == 0) MISC[18] = atomicAdd(ctl + CW_CV, 8u);
                    __syncthreads();
                    const int tk = (int)MISC[18];
                    if (tk + wid < NCONV) conv_item(tk + wid, args.in[25], args.in[26], args.in[27], W13, W2, lds + wid * (64 * 65), lane);
                    __syncthreads();
                    if (tk + 8 >= endl) break; }
            }
            __syncthreads();
            unsigned* cnt = ctl + CW_CNT + 64 * 32 * l;
            int* poff = (int*)lds;
            if (tid == 0) { int acc = 0; for (int e = 0; e < NE; ++e) { poff[e] = acc; acc += (((int)cnt[64 * e] + 255) >> 8) << 8; } poff[NE] = acc; }
            __syncthreads();
            for (int m = bx * 8 + wid; m < T; m += G * 8) {
                uint2 w[4];
    #pragma unroll
                for (int jq = 0; jq < 4; ++jq) w[jq] = *(const uint2*)(XB + (size_t)m * DM + jq * 256 + lane * 4);
    #pragma unroll
                for (int k = 0; k < 2; ++k) { const int ep = EP[2 * m + k]; const int dest = poff[ep >> 16] + (ep & 0xffff);
    #pragma unroll
                    for (int jq = 0; jq < 4; ++jq) *(uint2*)(XP + (size_t)dest * DM + jq * 256 + lane * 4) = w[jq];
                    if (lane == 0) DEST[2 * m + k] = dest; }
            }
        }
        GRID_BAR();
        for (int rep_ = 0; rep_ < REP_IJ; ++rep_) {
            const int tid = ltid(), lane = tid & 63, wid = __builtin_amdgcn_readfirstlane(tid >> 6); (void)lane; (void)wid;
            unsigned* cnt = ctl + CW_CNT + 64 * 32 * l;
            PG8_LAS int* tile_e = (PG8_LAS int*)((PG8_LAS unsigned char*)lds_raw + 131072); PG8_LAS int* tst = tile_e + MAXTILES;
            __syncthreads();
            if (tid == 0) { int acc = 0; for (int e = 0; e < NE; ++e) { tst[e] = acc; acc += ((int)cnt[64 * e] + 255) >> 8; } tst[NE] = acc; }
            __syncthreads();
            const int ntile = tst[NE];
            if (tid < ntile) { int e = 0; while (tst[e + 1] <= tid) ++e; tile_e[tid] = e; }
            __syncthreads();
            pg8::MoeOrder S{ntile, G, bx, tile_e};
            { pg8::Gemm g{XP, W13 + (size_t)l * NE * DM * DM, ntile * 256, DM, DM}; pg8::EpiSwiGlu E{Hb, DE};
              pg8::gemm_phase<pg8::EpiSwiGlu, pg8::MoeOrder, true, true>((PG8_LAS unsigned char*)lds_raw, g, S, E); }
            GRID_BAR();
            { pg8::Gemm g{Hb, W2 + (size_t)l * NE * DM * DE, ntile * 256, DM, DE}; pg8::EpiInProj E{YP, DM, 1.0f};
              pg8::gemm_phase<pg8::EpiInProj, pg8::MoeOrder, true, true>((PG8_LAS unsigned char*)lds_raw, g, S, E); }
        }
        GRID_BAR();
        for (int rep_ = 0; rep_ < REP_K; ++rep_) { float* Xo = (rep_ == REP_K - 1) ? X : (float*)(ws + WS_XP); bf16* XBo = (rep_ == REP_K - 1) ? XB : (bf16*)(ws + WS_H);
            const int tid = ltid(), lane = tid & 63, wid = __builtin_amdgcn_readfirstlane(tid >> 6); (void)lane; (void)wid;
            const float* g2 = args.in[19] + l * DM; const float* b2 = args.in[20] + l * DM;
            const bool doff = (l + 1 < DEPTH); const int ln = doff ? l + 1 : l;
            const float* wf = args.in[1] + (size_t)ln * DM * INW + O_FF; const float* fbias = args.in[2] + ln * 8;
            LAS f32x4* W4 = (LAS f32x4*)((LAS unsigned char*)lds_raw + 4096);
            __syncthreads();
            for (int q = tid; q < 40 * 64; q += NTHREADS) { const int row = q >> 6, ln_ = q & 63; f32x4 val;
                if (row < 32) { const int h = row >> 2, jq = row & 3;
#pragma unroll
                    for (int e = 0; e < 4; ++e) val[e] = wf[(size_t)(jq * 256 + ln_ * 4 + e) * INW + h]; }
                else if (row < 36) val = *(const f32x4*)(g2 + (row - 32) * 256 + ln_ * 4);
                else val = *(const f32x4*)(b2 + (row - 36) * 256 + ln_ * 4);
                W4[q] = val; }
            float* ffl = lds;
            for (int ch = bx; ch < T / 128; ch += G) {
                __syncthreads();
                const size_t mw = (size_t)ch * 128 + wid * 16;
                const int dA = lane < 16 ? DEST[2 * (mw + lane)] : 0, dB = lane < 16 ? DEST[2 * (mw + lane) + 1] : 0;
                const float gA = lane < 16 ? GATE[2 * (mw + lane)] : 0.f, gB = lane < 16 ? GATE[2 * (mw + lane) + 1] : 0.f;
                f32x4 xA[2][4], xB[2][4]; uint2 aA[2][4], aB[2][4], bA[2][4], bB[2][4]; float gA2[2][2], gB2[2][2];
#define K_LOAD(XS, WAS, WBS, GS, IEXP) _Pragma("unroll")                     for (int u = 0; u < 2; ++u) { const size_t m = mw + IEXP + u;                         const size_t da = (size_t)__builtin_amdgcn_readlane(dA, IEXP + u), db = (size_t)__builtin_amdgcn_readlane(dB, IEXP + u);                         GS[u][0] = __builtin_bit_cast(float, __builtin_amdgcn_readlane(__builtin_bit_cast(int, gA), IEXP + u)); GS[u][1] = __builtin_bit_cast(float, __builtin_amdgcn_readlane(__builtin_bit_cast(int, gB), IEXP + u)); _Pragma("unroll")                         for (int jq = 0; jq < 4; ++jq) { { const uint2 xw_ = *(const uint2*)(XB + m * DM + jq * 256 + lane * 4); XS[u][jq] = (f32x4){__builtin_bit_cast(float, xw_.x << 16), __builtin_bit_cast(float, xw_.x & 0xffff0000u), __builtin_bit_cast(float, xw_.y << 16), __builtin_bit_cast(float, xw_.y & 0xffff0000u)}; }                             WAS[u][jq] = *(const uint2*)(YP + da * DM + jq * 256 + lane * 4); WBS[u][jq] = *(const uint2*)(YP + db * DM + jq * 256 + lane * 4); } }
                { const int i = 0; K_LOAD(xA, aA, bA, gA2, i); }
                for (int i = 0; i < 16; i += 4) {
                    { const int i1 = i + 2; K_LOAD(xB, aB, bB, gB2, i1); }
#pragma unroll
                    for (int u = 0; u < 2; ++u) { const int tl = wid * 16 + i + u; const size_t m = mw + i + u; const float ga = gA2[u][0], gb = gA2[u][1];
                    float v[16]; float s_ = 0.f;
#pragma unroll
                    for (int jq = 0; jq < 4; ++jq) { const uint2 w0 = aA[u][jq], w1 = bA[u][jq];
                        const f32x4 ya = (f32x4){__builtin_bit_cast(float, w0.x << 16), __builtin_bit_cast(float, w0.x & 0xffff0000u), __builtin_bit_cast(float, w0.y << 16), __builtin_bit_cast(float, w0.y & 0xffff0000u)};
                        const f32x4 yb = (f32x4){__builtin_bit_cast(float, w1.x << 16), __builtin_bit_cast(float, w1.x & 0xffff0000u), __builtin_bit_cast(float, w1.y << 16), __builtin_bit_cast(float, w1.y & 0xffff0000u)};
#pragma unroll
                        for (int e = 0; e < 4; ++e) { v[jq * 4 + e] = ALPHA * xA[u][jq][e] + (ga * ya[e] + gb * yb[e]); s_ += v[jq * 4 + e]; } }
                    const float mean = wave_sum(s_) * (1.f / DM); float s2 = 0.f;
#pragma unroll
                    for (int q = 0; q < 16; ++q) { v[q] -= mean; s2 += v[q] * v[q]; }
                    const float rstd = 1.0f / sqrtf(wave_sum(s2) * (1.f / DM) + LN_EPS);
                    float acc[8];
#pragma unroll
                    for (int h = 0; h < 8; ++h) acc[h] = 0.f;
#pragma unroll
                    for (int jq = 0; jq < 4; ++jq) { f32x4 ov;
                        const f32x4 gv = W4[(32 + jq) * 64 + lane], bv = W4[(36 + jq) * 64 + lane];
#pragma unroll
                        for (int e = 0; e < 4; ++e) ov[e] = v[jq * 4 + e] * rstd * gv[e] + bv[e];
                        if (doff) {
#pragma unroll
                            for (int h = 0; h < 8; ++h) { const f32x4 wv = W4[(h * 4 + jq) * 64 + lane]; acc[h] += (ov[0] * wv[0] + ov[1] * wv[1]) + (ov[2] * wv[2] + ov[3] * wv[3]); } }
                        if (!doff) *(f32x4*)(Xo + m * DM + jq * 256 + lane * 4) = ov;
                        *(uint2*)(XBo + m * DM + jq * 256 + lane * 4) = make_uint2(pk2(ov[0], ov[1]), pk2(ov[2], ov[3])); }
                    if (doff) {
#pragma unroll
                        for (int h = 0; h < 8; ++h) acc[h] = wave_sum(acc[h]);
                        if (lane < 8) { float fv = acc[0];
#pragma unroll
                            for (int h = 1; h < 8; ++h) fv = (lane == h) ? acc[h] : fv;
                            ffl[tl * 8 + lane] = fv + fbias[lane]; } }
                    }

                    if (i + 4 < 16) { const int i2 = i + 4; K_LOAD(xA, aA, bA, gA2, i2); }
#pragma unroll
                    for (int u = 0; u < 2; ++u) { const int tl = wid * 16 + (i + 2) + u; const size_t m = mw + (i + 2) + u; const float ga = gB2[u][0], gb = gB2[u][1];
                    float v[16]; float s_ = 0.f;
#pragma unroll
                    for (int jq = 0; jq < 4; ++jq) { const uint2 w0 = aB[u][jq], w1 = bB[u][jq];
                        const f32x4 ya = (f32x4){__builtin_bit_cast(float, w0.x << 16), __builtin_bit_cast(float, w0.x & 0xffff0000u), __builtin_bit_cast(float, w0.y << 16), __builtin_bit_cast(float, w0.y & 0xffff0000u)};
                        const f32x4 yb = (f32x4){__builtin_bit_cast(float, w1.x << 16), __builtin_bit_cast(float, w1.x & 0xffff0000u), __builtin_bit_cast(float, w1.y << 16), __builtin_bit_cast(float, w1.y & 0xffff0000u)};
#pragma unroll
                        for (int e = 0; e < 4; ++e) { v[jq * 4 + e] = ALPHA * xB[u][jq][e] + (ga * ya[e] + gb * yb[e]); s_ += v[jq * 4 + e]; } }
                    const float mean = wave_sum(s_) * (1.f / DM); float s2 = 0.f;
#pragma unroll
                    for (int q = 0; q < 16; ++q) { v[q] -= mean; s2 += v[q] * v[q]; }
                    const float rstd = 1.0f / sqrtf(wave_sum(s2) * (1.f / DM) + LN_EPS);
                    float acc[8];
#pragma unroll
                    for (int h = 0; h < 8; ++h) acc[h] = 0.f;
#pragma unroll
                    for (int jq = 0; jq < 4; ++jq) { f32x4 ov;
                        const f32x4 gv = W4[(32 + jq) * 64 + lane], bv = W4[(36 + jq) * 64 + lane];
#pragma unroll
                        for (int e = 0; e < 4; ++e) ov[e] = v[jq * 4 + e] * rstd * gv[e] + bv[e];
                        if (doff) {
#pragma unroll
                            for (int h = 0; h < 8; ++h) { const f32x4 wv = W4[(h * 4 + jq) * 64 + lane]; acc[h] += (ov[0] * wv[0] + ov[1] * wv[1]) + (ov[2] * wv[2] + ov[3] * wv[3]); } }
                        if (!doff) *(f32x4*)(Xo + m * DM + jq * 256 + lane * 4) = ov;
                        *(uint2*)(XBo + m * DM + jq * 256 + lane * 4) = make_uint2(pk2(ov[0], ov[1]), pk2(ov[2], ov[3])); }
                    if (doff) {
#pragma unroll
                        for (int h = 0; h < 8; ++h) acc[h] = wave_sum(acc[h]);
                        if (lane < 8) { float fv = acc[0];
#pragma unroll
                            for (int h = 1; h < 8; ++h) fv = (lane == h) ? acc[h] : fv;
                            ffl[tl * 8 + lane] = fv + fbias[lane]; } }
                    }

                }
#undef K_LOAD
                __syncthreads();
                if (doff) {
                    const int h = wid; const int bb = (ch * 128) / SEQ, t0 = (ch * 128) % SEQ; double carry = 0.0;
#pragma unroll
                    for (int half = 0; half < 2; ++half) { double vv = (double)logsigmoidf_(ffl[(half * 64 + lane) * 8 + h]);
#pragma unroll
                        for (int o = 1; o < 64; o <<= 1) { const double n = __shfl_up(vv, o); if (lane >= o) vv += n; }
                        vv += carry; LCS[(size_t)(bb * 8 + h) * SEQ + t0 + half * 64 + lane] = vv; carry = __shfl(vv, 63); }
                    if (lane == 0) TOT[(bb * 8 + h) * 128 + t0 / 128] = carry;
                }
            }
        }
        if (l + 1 < DEPTH) GRID_BAR();
    }
}

extern "C" void kernel_launch(void* const* d_in, const int* in_sizes, int n_in, void* d_out, int out_size, void* d_ws, size_t ws_size, hipStream_t stream) {
    static int grid = 0;
    if (grid == 0) {
        if (n_in != 28 || out_size != T * DM || ws_size < WS_END) { fprintf(stderr, "kernel_launch: unexpected shapes (n_in %d out %d ws %zu)\n", n_in, out_size, ws_size); grid = -1; return; }
        int dev = 0, cus = 0, per_cu = 0;
        (void)hipGetDevice(&dev); (void)hipDeviceGetAttribute(&cus, hipDeviceAttributeMultiprocessorCount, dev);
        (void)hipFuncSetAttribute((const void*)mk_fwd, hipFuncAttributeMaxDynamicSharedMemorySize, LDS_ALL);
        if (hipOccupancyMaxActiveBlocksPerMultiprocessor(&per_cu, (const void*)mk_fwd, NTHREADS, LDS_ALL) != hipSuccess || per_cu < 1) fprintf(stderr, "kernel_launch: occupancy query says %d blocks per CU\n", per_cu);
        (void)hipGetLastError();
        grid = cus > 0 ? cus : 256;
        if (grid != 256) fprintf(stderr, "kernel_launch: %d CUs (built for 256)\n", grid);
    }
    if (grid < 0) return;
    (void)hipMemsetAsync((char*)d_ws + WS_CTL, 0, CTL_BYTES, stream);
    Args a{};
    for (int i = 0; i < 28; ++i) a.in[i] = (const float*)d_in[i];
    a.out = (float*)d_out; a.ws = (unsigned char*)d_ws;
    hipLaunchKernelGGL(mk_fwd, dim3(grid), dim3(NTHREADS), LDS_ALL, stream, a);
}
```

```cpp
#include <hip/hip_runtime.h>
#include <cstdio>
#include <cstdint>
#include <cmath>
__device__ __forceinline__ int ltid() { int t = __builtin_amdgcn_workitem_id_x(); asm volatile("" : "+v"(t)); return t; }

constexpr int BATCH = 2, SEQ = 16384, DM = 1024, DEPTH = 4, T = BATCH * SEQ;
constexpr int INW = 3592, PW = 3584;
constexpr int O_FF = 1536;
constexpr int C_FQ = 0, C_FK = 512, C_FV = 1024, C_RR = 1536, C_RK = 1792, C_RV = 2048, C_WD = 2304, C_AD = 2368, C_GD = 2432,
              C_TQ = 2560, C_TK = 2816, C_TV = 3072, C_TG = 3328;
constexpr int NE = 32, DE = 512, A_TOT = T * 2;
constexpr float ALPHA = 1.681792830507429f;
constexpr float LN_EPS = 1e-5f, RWKV_GN_EPS = 64e-5f, RET_GN_EPS = 1e-6f;
constexpr float QC2 = 0.125f * 1.4426950408889634f;
constexpr int NTHREADS = 512;
#ifndef REP_P0
#define REP_P0 1
#endif
#ifndef REP_A
#define REP_A 1
#endif
#ifndef REP_C
#define REP_C 1
#endif
#ifndef REP_E
#define REP_E 1
#endif
#ifndef REP_F
#define REP_F 1
#endif
#ifndef REP_H
#define REP_H 1
#endif
#ifndef REP_IJ
#define REP_IJ 1
#endif
#ifndef REP_G
#define REP_G 1
#endif
#ifndef REP_K
#define REP_K 1
#endif
constexpr int LDS_MISC = 147456, LDS_ALL = 148480;

constexpr size_t MiB = 1u << 20;
constexpr size_t WS_CTL = 0, CTL_BYTES = 1 * MiB;
constexpr size_t WS_EP = 1 * MiB;
constexpr size_t WS_DEST = 2 * MiB;
constexpr size_t WS_GATE = 9 * MiB;
constexpr size_t WS_ROPE = 11 * MiB;
constexpr size_t WS_RKD = 15 * MiB;
constexpr size_t WS_WIN = 16 * MiB;
constexpr size_t WS_WOUT = 44 * MiB;
constexpr size_t WS_W13 = 52 * MiB;
constexpr size_t WS_W2 = 308 * MiB;
constexpr size_t WS_XB = 436 * MiB;
constexpr size_t WS_P = 500 * MiB;
constexpr size_t WS_MIXB = 724 * MiB;
constexpr size_t WS_CK = 788 * MiB;
constexpr size_t WS_LW = 3 * MiB;
constexpr size_t WS_YO = 788 * MiB;
constexpr size_t WS_XP = 500 * MiB;
constexpr size_t WS_H = 644 * MiB;
constexpr size_t WS_YP = 716 * MiB;
constexpr size_t WS_LCS = 1012 * MiB;
constexpr size_t WS_KA = 1014 * MiB;
constexpr size_t WS_END = 1018 * MiB;
constexpr size_t WS_WR = 5 * MiB;
constexpr size_t WS_SKIP = 4 * MiB + 65536;
constexpr size_t WS_TOT = 4 * MiB;
constexpr int CW_CNT = 32768;
constexpr int CW_Q = 2048;
constexpr int CW_L1 = 20480;
constexpr int CW_SF = 12288;
constexpr int CW_EQ = 4096;
constexpr int CW_CV = 6144;
constexpr int CW_BAR = 8192;
constexpr int MAXTILES = 288;

typedef float f32x16 __attribute__((ext_vector_type(16)));
typedef unsigned short bf16;

struct Args {
    const float* in[28]; float* out; unsigned char* ws;
};

__device__ __forceinline__ float sigmoidf_(float x) { return 1.0f / (1.0f + expf(-x)); }
__device__ __forceinline__ float logsigmoidf_(float x) { return x >= 0.f ? -log1pf(expf(-x)) : x - log1pf(expf(x)); }
__device__ __forceinline__ float wave_sum(float v) {
#define WS_DPP(ctrl, rmask) v += __builtin_bit_cast(float, __builtin_amdgcn_update_dpp(0, __builtin_bit_cast(int, v), ctrl, rmask, 0xf, false))
    WS_DPP(0x111, 0xf); WS_DPP(0x112, 0xf); WS_DPP(0x114, 0xf); WS_DPP(0x118, 0xf); WS_DPP(0x142, 0xa); WS_DPP(0x143, 0xc);
#undef WS_DPP
    return __builtin_bit_cast(float, __builtin_amdgcn_readlane(__builtin_bit_cast(int, v), 63));
}
typedef float f32x2hw __attribute__((ext_vector_type(2))); typedef __bf16 bf16x2hw __attribute__((ext_vector_type(2)));
__device__ __forceinline__ unsigned pk2(float lo, float hi) { f32x2hw v = {lo, hi}; bf16x2hw b = __builtin_convertvector(v, bf16x2hw); return __builtin_bit_cast(unsigned, b); }
__device__ __forceinline__ unsigned f2bf(float f) { return pk2(f, 0.f) & 0xffffu; }
__device__ __forceinline__ float bf2f(unsigned short b) { return __builtin_bit_cast(float, (unsigned)b << 16); }
__device__ __forceinline__ float pf(const bf16* Pb, size_t m, int c) { return bf2f(Pb[m * PW + c]); }

namespace pg8 {
#define PG8_LAS __attribute__((address_space(3)))
typedef unsigned short bf16_t;
typedef short bf16x8 __attribute__((ext_vector_type(8)));
typedef float f32x4 __attribute__((ext_vector_type(4)));
typedef unsigned u32x4 __attribute__((ext_vector_type(4)));
constexpr int BM = 256, BK = 64, HALF = 128, HTB = HALF * BK * 2  , STAGE_BYTES = 8 * HTB, NXCD = 8, WGM = 8;

__host__ __device__ __forceinline__ int lds_byte(int r, int c) { const int st = (r >> 4) * 2 + (c >> 5), rr = r & 15, cc = c & 31, ob = rr * 64 + cc * 2; return st * 1024 + (ob ^ (((ob >> 9) & 1) << 5)); }
__host__ __device__ __forceinline__ void stage_rc(int b, int& R, int& C) { const int st = b / 1024, sb = b % 1024, swz = sb ^ (((sb >> 9) & 1) << 5); R = (st >> 1) * 16 + swz / 64; C = (st & 1) * 32 + (swz % 64) / 2; }
__host__ __device__ __forceinline__ int perm32(int rho) { const int n = rho >> 4, i = rho & 15; return 8 * (i >> 2) + 4 * n + (i & 3); }

struct Unit { int pm, pn, pc; };
struct Gemm { const bf16_t* A; const bf16_t* Bt; int M, N, K; };

struct StaticOrder {
    int nM, nN, nwg, G, c;
    __host__ __device__ void init(int M, int N, int G_, int c_) { nM = M / BM; nN = N / BM; nwg = nM * nN; G = G_; c = c_; }
    __host__ __device__ bool next(int i, Unit& u) const {
        const long L = (long)i * G + c; if (L >= nwg) return false;
        int wgid = (int)L; { const int q = nwg / NXCD, r = nwg % NXCD, xcd = wgid % NXCD, off = wgid / NXCD; wgid = (xcd < r ? xcd * (q + 1) : r * (q + 1) + (xcd - r) * q) + off; }
        const int nig = WGM * nN, gid = wgid / nig, fm = gid * WGM, gsz = (nM - fm) < WGM ? (nM - fm) : WGM;
        u.pm = fm + ((wgid % nig) % gsz); u.pn = (wgid % nig) / gsz; u.pc = u.pn; return true;
    }
    __device__ __forceinline__ void a_ready(const Unit&) const {}
    __device__ __forceinline__ void done(const Unit&) const {}
};

__device__ __forceinline__ unsigned cvt_pk_bf16(float lo, float hi) { unsigned r; asm volatile("v_cvt_pk_bf16_f32 %0, %1, %2" : "=v"(r) : "v"(lo), "v"(hi)); return r; }

struct EpiF32 {
    static constexpr bool PERM = false, AFTER_DRAIN = false;
    float* O; int ldc;
    __device__ __forceinline__ void operator()(const f32x4 (&acc)[2][2][4][2], const Unit& u, int wr, int wc, int fr, int fq) const {
        const int row0 = u.pm * BM + wr * 64 + fr; const int col0 = u.pc * BM + wc * 32 + 4 * fq;
#pragma unroll
        for (int ai = 0; ai < 2; ++ai)
#pragma unroll
            for (int m = 0; m < 4; ++m) { float* rowp = O + (size_t)(row0 + ai * HALF + m * 16) * ldc + col0;
#pragma unroll
                for (int bj = 0; bj < 2; ++bj)
#pragma unroll
                    for (int n = 0; n < 2; ++n) *(f32x4*)(rowp + bj * HALF + n * 16) = acc[ai][bj][m][n]; }
    }
};
struct EpiSwiGlu {
    static constexpr bool PERM = true, AFTER_DRAIN = false;
    bf16_t* O; int ldc;
    __device__ __forceinline__ static float silu(float v) { return v * __builtin_amdgcn_rcpf(1.0f + __builtin_amdgcn_exp2f(-1.4426950408889634f * v)); }
    __device__ __forceinline__ void operator()(const f32x4 (&acc)[2][2][4][2], const Unit& u, int wr, int wc, int fr, int fq) const {
        const int row0 = u.pm * BM + wr * 64 + fr; const int col0 = u.pc * HALF + wc * 32 + 8 * fq;
#pragma unroll
        for (int ai = 0; ai < 2; ++ai)
#pragma unroll
            for (int m = 0; m < 4; ++m) { bf16_t* rowp = O + (size_t)(row0 + ai * HALF + m * 16) * ldc + col0;
                f32x4 h0, h1;
#pragma unroll
                for (int e = 0; e < 4; ++e) { h0[e] = silu(acc[ai][0][m][0][e]) * acc[ai][1][m][0][e]; h1[e] = silu(acc[ai][0][m][1][e]) * acc[ai][1][m][1][e]; }
                u32x4 w; w.x = cvt_pk_bf16(h0[0], h0[1]); w.y = cvt_pk_bf16(h0[2], h0[3]); w.z = cvt_pk_bf16(h1[0], h1[1]); w.w = cvt_pk_bf16(h1[2], h1[3]);
                *(u32x4*)rowp = w; }
    }
};
struct MoeOrder {
    int ntile, G, c; const PG8_LAS int* tile_e;
    __device__ __forceinline__ bool next(int i, Unit& u) const { const int L = i * G + c; if (L >= ntile * 4) return false; const int rt = L >> 2, pn = L & 3; u.pm = rt; u.pn = tile_e[rt] * 4 + pn; u.pc = pn; return true; }
    __device__ __forceinline__ void a_ready(const Unit&) const {}
    __device__ __forceinline__ void done(const Unit&) const {}
};
struct EpiInProj {
    static constexpr bool PERM = true, AFTER_DRAIN = false;
    bf16_t* O; int ldc; float qscale;
    __device__ __forceinline__ void operator()(const f32x4 (&acc)[2][2][4][2], const Unit& u, int wr, int wc, int fr, int fq) const {
        const int row0 = u.pm * BM + wr * 64 + fr; const int col0 = u.pc * BM + wc * 32 + 8 * fq;
        const float sc = (u.pc < 2) ? qscale : 1.f;
#pragma unroll
        for (int ai = 0; ai < 2; ++ai)
#pragma unroll
            for (int m = 0; m < 4; ++m) { bf16_t* rowp = O + (size_t)(row0 + ai * HALF + m * 16) * ldc + col0;
#pragma unroll
                for (int bj = 0; bj < 2; ++bj) { const f32x4 v0 = acc[ai][bj][m][0] * sc, v1 = acc[ai][bj][m][1] * sc;
                    u32x4 w; w.x = cvt_pk_bf16(v0[0], v0[1]); w.y = cvt_pk_bf16(v0[2], v0[3]); w.z = cvt_pk_bf16(v1[0], v1[1]); w.w = cvt_pk_bf16(v1[2], v1[3]);
                    *(u32x4*)(rowp + bj * HALF) = w; } }
    }
};
template <class Epi, class Sched, bool ALIGN_EPI = false, bool SP2 = false>
__device__ __forceinline__ void gemm_phase(PG8_LAS unsigned char* lds, const Gemm g, const Sched& S, const Epi& E) {
    const int tid = ltid(), wid = __builtin_amdgcn_readfirstlane(tid >> 6), lane = tid & 63, wr = wid >> 2, wc = wid & 3, fr = lane & 15, fq = lane >> 4;
    const int K = g.K, nt = K / BK;
    unsigned voffA[2], voffB[2];
#pragma unroll
    for (int i = 0; i < 2; ++i) { int R, C; stage_rc(tid * 16 + i * 8192, R, C); const int Rb = Epi::PERM ? ((R & ~31) + perm32(R & 31)) : R;
        voffA[i] = (unsigned)(R * K + C) * 2u; voffB[i] = (unsigned)(Rb * K + C) * 2u; }
    const size_t kstep = (size_t)(BK * 2);
    const size_t hstep = (size_t)HALF * K * 2;
    const size_t tstep = 2 * hstep;
    const unsigned ldsw = (unsigned)wid * 1024u;
    const int aoff = lds_byte(wr * 64 + fr, fq * 8), boff = lds_byte(wc * 32 + fr, fq * 8);
#define PG8_SA(b, h) (((b) * 2 + (h)) * HTB)
#define PG8_SB(b, h) ((4 + (b) * 2 + (h)) * HTB)
#define PG8_STAGE(bufoff, gbase, voff) do { _Pragma("unroll") for (int _i = 0; _i < 2; ++_i) \
        __builtin_amdgcn_global_load_lds((const unsigned*)((const char*)(gbase) + (voff)[_i]), (PG8_LAS unsigned*)(lds + (bufoff) + ldsw + _i * 8192), 16, 0, 0); } while (0)
#define PG8_LDA(dst, b, h) do { _Pragma("unroll") for (int m = 0; m < 4; ++m) _Pragma("unroll") for (int k = 0; k < 2; ++k) dst[m][k] = *(const PG8_LAS bf16x8*)(lds + PG8_SA(b, h) + aoff + m * 2048 + k * 1024); } while (0)
#define PG8_LDB(dst, b, h) do { _Pragma("unroll") for (int n = 0; n < 2; ++n) _Pragma("unroll") for (int k = 0; k < 2; ++k) dst[n][k] = *(const PG8_LAS bf16x8*)(lds + PG8_SB(b, h) + boff + n * 2048 + k * 1024); } while (0)
#define PG8_MMA(ai, bj, At, Bt) do { __builtin_amdgcn_s_setprio(1); _Pragma("unroll") for (int m = 0; m < 4; ++m) _Pragma("unroll") for (int n = 0; n < 2; ++n) _Pragma("unroll") for (int k = 0; k < 2; ++k) \
        acc[ai][bj][m][n] = __builtin_amdgcn_mfma_f32_16x16x32_bf16(Bt[n][k], At[m][k], acc[ai][bj][m][n], 0, 0, 0); __builtin_amdgcn_s_setprio(0); } while (0)
#define PG8_WAIT_V(n) asm volatile("s_waitcnt vmcnt(" #n ")" ::: "memory")
#define PG8_WAIT_L(n) asm volatile("s_waitcnt lgkmcnt(" #n ")" ::: "memory")
#define PG8_BAR __builtin_amdgcn_s_barrier()
#define PG8_SCHED __builtin_amdgcn_sched_barrier(0)
    Unit cur, nxt; int ui = 0;
    if (!S.next(0, cur)) return;
    f32x4 acc[2][2][4][2];
#pragma unroll
    for (int a = 0; a < 2; ++a)
#pragma unroll
        for (int b = 0; b < 2; ++b)
#pragma unroll
            for (int m = 0; m < 4; ++m)
#pragma unroll
                for (int n = 0; n < 2; ++n) acc[a][b][m][n] = (f32x4){0.f, 0.f, 0.f, 0.f};
    bf16x8 At[4][2], B0[2][2], B1[2][2];
    const char* cA = (const char*)g.A + (size_t)cur.pm * tstep; const char* cB = (const char*)g.Bt + (size_t)cur.pn * tstep;
    S.a_ready(cur);
    if constexpr (SP2) {
        PG8_STAGE(PG8_SB(0, 0), cB, voffB); PG8_STAGE(PG8_SB(0, 1), cB + hstep, voffB); PG8_STAGE(PG8_SA(0, 0), cA, voffA); PG8_STAGE(PG8_SA(0, 1), cA + hstep, voffA);
        if (wr == 1) PG8_BAR;
        PG8_WAIT_V(2); PG8_BAR;
        PG8_STAGE(PG8_SB(1, 0), cB + kstep, voffB); PG8_STAGE(PG8_SA(1, 0), cA + kstep, voffA); PG8_STAGE(PG8_SB(1, 1), cB + hstep + kstep, voffB);
        PG8_WAIT_V(6); PG8_BAR;
    } else {
        PG8_STAGE(PG8_SB(0, 0), cB, voffB); PG8_STAGE(PG8_SA(0, 0), cA, voffA); PG8_STAGE(PG8_SB(0, 1), cB + hstep, voffB); PG8_STAGE(PG8_SA(0, 1), cA + hstep, voffA);
        if (wr == 1) PG8_BAR;
        PG8_WAIT_V(4); PG8_BAR;
        PG8_STAGE(PG8_SB(1, 0), cB + kstep, voffB); PG8_STAGE(PG8_SA(1, 0), cA + kstep, voffA); PG8_STAGE(PG8_SB(1, 1), cB + hstep + kstep, voffB);
        PG8_WAIT_V(6); PG8_BAR;
    }
    for (;;) {
        const bool has_next = S.next(ui + 1, nxt);
        const char* nA = has_next ? (const char*)g.A + (size_t)nxt.pm * tstep : cA; const char* nB = has_next ? (const char*)g.Bt + (size_t)nxt.pn * tstep : cB;
        for (int t = 0; t < nt; t += 2) {
            const bool last = (t == nt - 2);
            const char* a1 = cA + (size_t)(t + 1) * kstep;
            const char* a2 = last ? nA : cA + (size_t)(t + 2) * kstep; const char* b2 = last ? nB : cB + (size_t)(t + 2) * kstep;
            const char* a3 = a2 + kstep; const char* b3 = b2 + kstep;
            if (last && has_next) S.a_ready(nxt);
            if constexpr (SP2) {
            PG8_LDB(B0, 0, 0); PG8_LDB(B1, 0, 1); PG8_SCHED; PG8_LDA(At, 0, 0); PG8_STAGE(PG8_SA(1, 1), a1 + hstep, voffA);
            PG8_WAIT_V(8); PG8_WAIT_L(0); PG8_BAR; PG8_MMA(0, 0, At, B0); PG8_MMA(0, 1, At, B1); PG8_BAR; PG8_SCHED;
            PG8_LDA(At, 0, 1); PG8_STAGE(PG8_SB(0, 0), b2, voffB); PG8_STAGE(PG8_SB(0, 1), b2 + hstep, voffB); PG8_STAGE(PG8_SA(0, 0), a2, voffA);
            PG8_WAIT_V(8); PG8_WAIT_L(0); PG8_BAR; PG8_MMA(1, 0, At, B0); PG8_MMA(1, 1, At, B1); PG8_BAR; PG8_SCHED;
            PG8_LDB(B0, 1, 0); PG8_LDB(B1, 1, 1); PG8_SCHED; PG8_LDA(At, 1, 0); PG8_STAGE(PG8_SA(0, 1), a2 + hstep, voffA);
            PG8_WAIT_V(8); PG8_WAIT_L(0); PG8_BAR; PG8_MMA(0, 0, At, B0); PG8_MMA(0, 1, At, B1); PG8_BAR; PG8_SCHED;
            PG8_LDA(At, 1, 1); PG8_STAGE(PG8_SB(1, 0), b3, voffB); PG8_STAGE(PG8_SB(1, 1), b3 + hstep, voffB); PG8_STAGE(PG8_SA(1, 0), a3, voffA);
            PG8_WAIT_V(8); PG8_WAIT_L(0); PG8_BAR; PG8_MMA(1, 0, At, B0); PG8_MMA(1, 1, At, B1); PG8_BAR; PG8_SCHED;
            } else {
            PG8_LDB(B0, 0, 0); PG8_SCHED; PG8_LDA(At, 0, 0); PG8_STAGE(PG8_SA(1, 1), a1 + hstep, voffA);
            PG8_WAIT_L(8); PG8_BAR; PG8_WAIT_L(0); PG8_MMA(0, 0, At, B0); PG8_BAR; PG8_SCHED;
            PG8_LDB(B1, 0, 1); PG8_STAGE(PG8_SB(0, 0), b2, voffB);
            PG8_BAR; PG8_WAIT_L(0); PG8_MMA(0, 1, At, B1); PG8_BAR;
            PG8_LDA(At, 0, 1); PG8_STAGE(PG8_SA(0, 0), a2, voffA);
            PG8_BAR; PG8_WAIT_L(0); PG8_MMA(1, 0, At, B0); PG8_BAR; PG8_SCHED;
            PG8_STAGE(PG8_SB(0, 1), b2 + hstep, voffB);
            PG8_WAIT_V(6); PG8_BAR; PG8_MMA(1, 1, At, B1); PG8_BAR;
            PG8_LDB(B0, 1, 0); PG8_SCHED; PG8_LDA(At, 1, 0); PG8_STAGE(PG8_SA(0, 1), a2 + hstep, voffA);
            PG8_WAIT_L(8); PG8_BAR; PG8_WAIT_L(0); PG8_MMA(0, 0, At, B0); PG8_BAR; PG8_SCHED;
            PG8_LDB(B1, 1, 1); PG8_STAGE(PG8_SB(1, 0), b3, voffB);
            PG8_BAR; PG8_WAIT_L(0); PG8_MMA(0, 1, At, B1); PG8_BAR;
            PG8_LDA(At, 1, 1); PG8_STAGE(PG8_SA(1, 0), a3, voffA);
            PG8_BAR; PG8_WAIT_L(0); PG8_MMA(1, 0, At, B0); PG8_BAR; PG8_SCHED;
            PG8_STAGE(PG8_SB(1, 1), b3 + hstep, voffB);
            PG8_WAIT_V(6); PG8_BAR; PG8_MMA(1, 1, At, B1); PG8_BAR;
            }
        }
        if constexpr (ALIGN_EPI) { if (wr == 0) PG8_BAR; }
        if constexpr (!Epi::AFTER_DRAIN) { E(acc, cur, wr, wc, fr, fq); S.done(cur); }
        if (!has_next) break;
#pragma unroll
        for (int a = 0; a < 2; ++a)
#pragma unroll
            for (int b = 0; b < 2; ++b)
#pragma unroll
                for (int m = 0; m < 4; ++m)
#pragma unroll
                    for (int n = 0; n < 2; ++n) acc[a][b][m][n] = (f32x4){0.f, 0.f, 0.f, 0.f};
        cur = nxt; cA = nA; cB = nB; ++ui;
        if constexpr (ALIGN_EPI) { if (wr == 1) PG8_BAR; }
    }
    PG8_WAIT_V(0);
    if constexpr (!ALIGN_EPI) { if (wr == 0) PG8_BAR; }
    PG8_BAR;
    if constexpr (Epi::AFTER_DRAIN) { E.fused(acc, cur, wr, wc, fr, fq, lds, wid, lane); S.done(cur); }
#undef PG8_SA
#undef PG8_SB
#undef PG8_STAGE
#undef PG8_LDA
#undef PG8_LDB
#undef PG8_MMA
#undef PG8_WAIT_V
#undef PG8_WAIT_L
#undef PG8_BAR
#undef PG8_SCHED
}
}

template <class RowMap, class Epi>
__device__ __forceinline__ void gemm_tile_f32(float* lds, const float* __restrict__ A, int lda, RowMap rowmap, int nvalid,
                                              const float* __restrict__ B, int ldb, int col0, int N, int K, Epi epi) {
    float* As = lds;
    float* Bs = lds + 128 * 17;
    const int tid = ltid(), lane = tid & 63, wid = tid >> 6, wm = wid & 3, wn = wid >> 2;
    const int arow = tid >> 2, akq = (tid & 3) * 4;
    const int src = (arow < nvalid) ? rowmap(arow) : -1;
    const float* ap = A + (size_t)(src < 0 ? 0 : src) * lda + akq;
    const int bk = tid >> 5, bn = (tid & 31) * 4;
    const bool bok = (col0 + bn) < N;
    const float* bp = B + (size_t)bk * ldb + col0 + bn;
    f32x16 acc0 = {}, acc1 = {};
    for (int k0 = 0; k0 < K; k0 += 16) {
        pg8::f32x4 av = (pg8::f32x4){0.f, 0.f, 0.f, 0.f}, bv = (pg8::f32x4){0.f, 0.f, 0.f, 0.f};
        if (src >= 0) av = *(const pg8::f32x4*)(ap + k0);
        if (bok) bv = *(const pg8::f32x4*)(bp + (size_t)k0 * ldb);
        __syncthreads();
        As[arow * 17 + akq + 0] = av[0]; As[arow * 17 + akq + 1] = av[1]; As[arow * 17 + akq + 2] = av[2]; As[arow * 17 + akq + 3] = av[3];
        *(pg8::f32x4*)(Bs + bk * 132 + bn) = bv;
        __syncthreads();
#pragma unroll
        for (int kk = 0; kk < 16; kk += 2) {
            const float a = As[(32 * wm + (lane & 31)) * 17 + kk + (lane >> 5)];
            const float b0 = Bs[(kk + (lane >> 5)) * 132 + 64 * wn + (lane & 31)];
            const float b1 = Bs[(kk + (lane >> 5)) * 132 + 64 * wn + 32 + (lane & 31)];
            acc0 = __builtin_amdgcn_mfma_f32_32x32x2f32(a, b0, acc0, 0, 0, 0);
            acc1 = __builtin_amdgcn_mfma_f32_32x32x2f32(a, b1, acc1, 0, 0, 0);
        }
    }
#pragma unroll
    for (int r = 0; r < 16; ++r) {
        const int i = 32 * wm + (r & 3) + 8 * (r >> 2) + 4 * (lane >> 5);
        const int c0 = col0 + 64 * wn + (lane & 31);
        if (i < nvalid) {
            if (c0 < N) epi(i, c0, acc0[r]);
            if (c0 + 32 < N) epi(i, c0 + 32, acc1[r]);
        }
    }
}

#include <hip/hip_bf16.h>
namespace attn_body {
using bf16=__hip_bfloat16;
using bf16x8=__attribute__((ext_vector_type(8)))short;
using s16x4=__attribute__((ext_vector_type(4)))short;
using f32x16=__attribute__((ext_vector_type(16)))float;
using u32x4=__attribute__((ext_vector_type(4)))unsigned;
typedef float f32x4_t __attribute__((ext_vector_type(4)));
constexpr int BATCH=2,NHEAD=8,SEQ=16384,D=64,DM=3584,OP=1024;
constexpr int NW=8,QBLK=32,QB=QBLK*NW,KVBLK=64,NQB=SEQ/QB;
constexpr int ATTN_PITCH=DM, ATTN_UNIT_ROWS=QB;
__device__ __forceinline__ int crow(int r,int hi){return (r&3)+8*(r>>2)+4*hi;}
#define SBAR() __builtin_amdgcn_sched_barrier(0)
__device__ __forceinline__ void cmask(f32x16&p0,f32x16&p1,int jb,int qrel,int hi){
  const float NEG=-INFINITY; int kb=64*jb+4*hi;
  #pragma unroll
  for(int r=0;r<16;++r){int kv=kb+(r&3)+8*(r>>2); if(kv>qrel)p0[r]=NEG; if(kv+32>qrel)p1[r]=NEG;}
}

constexpr int NSLOT=3, SLOTB=8192;
constexpr int LDS_K=0, LDS_V=NSLOT*SLOTB, LDS_WS=2*NSLOT*SLOTB, LDS_OST=LDS_WS+NW*64*4, LDS_BYTES=LDS_OST+NW*4096;
constexpr float C2=0.125f*1.4426950408889634f;
__device__ __forceinline__ void glds16(const void*gsrc,unsigned lds_dst){unsigned keep;
  asm volatile("s_mov_b32 %0, m0\n\ts_mov_b32 m0, %2\n\ts_nop 0\n\tglobal_load_lds_dwordx4 %1, off\n\ts_mov_b32 m0, %0":"=&s"(keep):"v"(gsrc),"s"(lds_dst):"memory");}
__device__ __forceinline__ float max3f(float a,float b,float c){float r;asm("v_max3_f32 %0, %1, %2, %3":"=v"(r):"v"(a),"v"(b),"v"(c));return r;}
__device__ __forceinline__ float max2f(float a,float b){float r;asm("v_max_f32_e32 %0, %1, %2":"=v"(r):"v"(a),"v"(b));return r;}
__device__ __forceinline__ float fadd_s(float a,float b){float r;asm("v_add_f32_e32 %0, %1, %2":"=v"(r):"v"(a),"v"(b));return r;}
__device__ __forceinline__ float fsub_s(float a,float b){float r;asm("v_sub_f32_e32 %0, %1, %2":"=v"(r):"v"(a),"v"(b));return r;}
typedef float f32x2_t __attribute__((ext_vector_type(2))); typedef __bf16 bf16x2_t __attribute__((ext_vector_type(2)));
__device__ __forceinline__ unsigned cvtpk_s(float lo,float hi){f32x2_t v={lo,hi};bf16x2_t b=__builtin_convertvector(v,bf16x2_t);return __builtin_bit_cast(unsigned,b);}
#define WAIT_BAR(N) asm volatile("s_waitcnt vmcnt(" #N ") lgkmcnt(0)\n\ts_barrier":::"memory")

__device__ __forceinline__ void qkt(f32x16&p0,f32x16&p1,const char*Kslot,const bf16x8*qr,int r32,int hi){
  const char*kb=Kslot+hi*1024+r32*16;
  #pragma unroll
  for(int d0=0;d0<4;++d0){
    const bf16x8 b0=*reinterpret_cast<const bf16x8*>(kb+d0*2048);
    const bf16x8 b1=*reinterpret_cast<const bf16x8*>(kb+d0*2048+512);
    p0=__builtin_amdgcn_mfma_f32_32x32x16_bf16(b0,qr[d0],p0,0,0,0);p1=__builtin_amdgcn_mfma_f32_32x32x16_bf16(b1,qr[d0],p1,0,0,0);}
}
typedef __attribute__((address_space(3))) const char* lds_cptr;
typedef short v4i16_t __attribute__((ext_vector_type(4)));
__device__ __forceinline__ void kload8(bf16x8*kf,lds_cptr kp){
  kf[0]=*(const __attribute__((address_space(3))) bf16x8*)(kp);      kf[1]=*(const __attribute__((address_space(3))) bf16x8*)(kp+512);
  kf[2]=*(const __attribute__((address_space(3))) bf16x8*)(kp+2048); kf[3]=*(const __attribute__((address_space(3))) bf16x8*)(kp+2560);
  kf[4]=*(const __attribute__((address_space(3))) bf16x8*)(kp+4096); kf[5]=*(const __attribute__((address_space(3))) bf16x8*)(kp+4608);
  kf[6]=*(const __attribute__((address_space(3))) bf16x8*)(kp+6144); kf[7]=*(const __attribute__((address_space(3))) bf16x8*)(kp+6656);
}
__device__ __forceinline__ void kload2(bf16x8*kf,lds_cptr kp,int j){ kf[2*j]=*(const __attribute__((address_space(3))) bf16x8*)(kp+j*2048); kf[2*j+1]=*(const __attribute__((address_space(3))) bf16x8*)(kp+j*2048+512); }
__device__ __forceinline__ s16x4 vtr(lds_cptr p){ return __builtin_bit_cast(s16x4,__builtin_amdgcn_ds_read_tr16_b64_v4i16((__attribute__((address_space(3))) v4i16_t*)p)); }
__device__ __forceinline__ float rowmax(const f32x16&p0,const f32x16&p1){
  float a=max3f(p0[0],p0[1],p1[0]),b=max3f(p0[2],p0[3],p1[1]);a=max3f(a,p1[2],p1[3]);
  #pragma unroll
  for(int r=4;r<16;r+=4){a=max3f(a,p0[r],p0[r+1]);b=max3f(b,p0[r+2],p0[r+3]);a=max3f(a,p1[r],p1[r+1]);b=max3f(b,p1[r+2],p1[r+3]);}
  const float m=max2f(a,b);
  auto rr=__builtin_amdgcn_permlane32_swap(__float_as_uint(m),__float_as_uint(m),false,false);
  return max2f(__uint_as_float(rr[0]),__uint_as_float(rr[1]));
}
__device__ __forceinline__ void pv(f32x16*o,int vb,bf16x8 pa0,bf16x8 pa1,bf16x8 pa2,bf16x8 pa3){
  #pragma unroll
  for(int d0=0;d0<2;++d0){s16x4 lo[4],hi[4];
    #pragma unroll
    for(int ks=0;ks<4;++ks){
      asm volatile("ds_read_b64_tr_b16 %0,%1 offset:%c2":"=&v"(lo[ks]):"v"(vb),"i"(d0*4096+ks*1024):"memory");
      asm volatile("ds_read_b64_tr_b16 %0,%1 offset:%c2":"=&v"(hi[ks]):"v"(vb),"i"(d0*4096+ks*1024+512):"memory");}
    asm volatile("s_waitcnt lgkmcnt(0)":::"memory");SBAR();
    #define PK(k) (bf16x8){lo[k][0],lo[k][1],lo[k][2],lo[k][3],hi[k][0],hi[k][1],hi[k][2],hi[k][3]}
    o[d0]=__builtin_amdgcn_mfma_f32_32x32x16_bf16(pa0,PK(0),o[d0],0,0,0);
    o[d0]=__builtin_amdgcn_mfma_f32_32x32x16_bf16(pa1,PK(1),o[d0],0,0,0);
    o[d0]=__builtin_amdgcn_mfma_f32_32x32x16_bf16(pa2,PK(2),o[d0],0,0,0);
    o[d0]=__builtin_amdgcn_mfma_f32_32x32x16_bf16(pa3,PK(3),o[d0],0,0,0);
    #undef PK
  }
}

#ifndef ATTN_STORE16
#define ATTN_STORE16(p,v) (*(u32x4*)(p)=(v))
#endif
template<int THRL> __device__ __forceinline__ void attn_unit(int b,int h,int qb,int t0,const bf16*Q,const bf16*__restrict__ K,const bf16*__restrict__ V,bf16*O,const unsigned char*KAg,char*shm){
  const int tid=ltid(),lane=tid&63,r32=lane&31,hi=lane>>5; const int wid=__builtin_amdgcn_readfirstlane(tid>>6);
  const long rowbase=(long)b*SEQ; const int q0=qb*QB;
  const bf16*Qw=Q+(rowbase+q0+wid*QBLK)*DM+h*D;
  const bf16*Kh=K+(rowbase+(long)t0*KVBLK)*DM+h*D,*Vh=V+(rowbase+(long)t0*KVBLK)*DM+h*D;
  const unsigned lds0=(unsigned)(uintptr_t)shm;
  float*wsf=(float*)(shm+LDS_WS)+wid*64;
  const bf16*ksrc=Kh+(long)lane*DM+wid*8;
  const bf16*vsrc=Vh+(long)(16*(wid&3)+(lane>>2))*DM+(wid>>2)*32+(lane&3)*8;
  const unsigned kdst=lds0+LDS_K+wid*1024, vdst=lds0+LDS_V+wid*1024;
  #define DMA_K(t,slot) glds16(ksrc+(long)(t)*KVBLK*DM,(unsigned)__builtin_amdgcn_readfirstlane(kdst+(slot)))
  #define DMA_V(t,slot) glds16(vsrc+(long)(t)*KVBLK*DM,(unsigned)__builtin_amdgcn_readfirstlane(vdst+(slot)))
  const int vb0=(int)(lds0+LDS_V)+((lane>>4)&1)*32+(lane&3)*8+(4*hi+((lane&15)>>2))*64;
  const char*Kbase=shm+LDS_K; bf16x8 kf[8];
  const lds_cptr shm3=(lds_cptr)shm; const lds_cptr kp0=shm3+LDS_K+hi*1024+r32*16; const lds_cptr vp0=shm3+LDS_V+((lane>>4)&1)*32+(lane&3)*8+(4*hi+((lane&15)>>2))*64;
  const int NT=(q0+QB)/KVBLK-t0;
  u32x4 ka0,ka1; u32x4 qaw;
  const unsigned kavoff=(unsigned)r32*16u;
  const unsigned long long kab0=(unsigned long long)(uintptr_t)KAg+((unsigned long long)((b*NHEAD+h)*(long)SEQ+(long)t0*KVBLK))*16ull;
  #define KA_LOAD(t) do{ const unsigned long long a_=kab0+(unsigned long long)(t)*1024ull; const unsigned lo_=__builtin_amdgcn_readfirstlane((unsigned)a_),hi_=__builtin_amdgcn_readfirstlane((unsigned)(a_>>32)); \
    const unsigned long long sb_=((unsigned long long)hi_<<32)|lo_; \
    asm volatile("s_nop 4\n\tglobal_load_dwordx4 %0, %2, %3\n\tglobal_load_dwordx4 %1, %2, %3 offset:512":"=&v"(ka0),"=&v"(ka1):"v"(kavoff),"s"(sb_):"memory"); }while(0)
  #define QA_SET() do{ const float nm_=-mhat; const unsigned h_=cvtpk_s(nm_,0.f)&0xffffu; const float r1_=nm_-__uint_as_float(h_<<16); const unsigned m_=cvtpk_s(r1_,0.f)&0xffffu; \
    const float r2_=r1_-__uint_as_float(m_<<16); const unsigned l_=cvtpk_s(r2_,0.f)&0xffffu; \
    qaw[0]=hi?0u:0x3f803f80u; qaw[1]=hi?0u:(0x3f80u|(h_<<16)); qaw[2]=hi?0u:(m_|(l_<<16)); qaw[3]=0u; asm volatile("":"+v"(qaw)); }while(0)
  #define AUG(C0,C1) do{ C0=__builtin_amdgcn_mfma_f32_32x32x16_bf16(__builtin_bit_cast(bf16x8,ka0),__builtin_bit_cast(bf16x8,qaw),f32x16{},0,0,0); \
    C1=__builtin_amdgcn_mfma_f32_32x32x16_bf16(__builtin_bit_cast(bf16x8,ka1),__builtin_bit_cast(bf16x8,qaw),f32x16{},0,0,0); }while(0)
  #define PIN_KA() asm volatile("; KA landed":"+v"(ka0),"+v"(ka1)::"memory")
  #define WAIT_BAR_KA(N) do{ WAIT_BAR(N); PIN_KA(); }while(0)
  KA_LOAD(0);
  DMA_K(0,0);DMA_V(0,0);DMA_K(1,SLOTB);
  bf16x8 qr[4];
  #pragma unroll
  for(int d0=0;d0<4;++d0)qr[d0]=*reinterpret_cast<const bf16x8*>(&Qw[(long)r32*DM+d0*16+hi*8]);
  float mhat=0.f,l_reg=0.f;f32x16 o[2];o[0]=f32x16{};o[1]=f32x16{}; QA_SET();
  const int qrel=wid*QBLK+r32;
  #define CMASK(P0,P1,t) do{int jb_=(t)-(NT-4); if(jb_>=0)cmask(P0,P1,jb_,qrel,hi);}while(0)
  bool resc=false;
  #define START(P0,P1) do{ const float rm=rowmax(P0,P1); resc=false; \
    { const float dl=rm; mhat=fadd_s(mhat,dl); \
      _Pragma("unroll") for(int r=0;r<16;++r){P0[r]=fsub_s(P0[r],dl);P1[r]=fsub_s(P1[r],dl);} \
      QA_SET(); } \
    _Pragma("unroll") for(int r=0;r<16;++r)P0[r]=__builtin_amdgcn_exp2f(P0[r]); }while(0)
  #define RESC() do{ if(resc){ asm volatile("s_waitcnt lgkmcnt(0)":::"memory"); \
      _Pragma("unroll") for(int d_=0;d_<2;++d_) _Pragma("unroll") for(int r=0;r<16;++r)o[d_][r]*=wsf[crow(r,hi)]; } }while(0)
  f32x16 pA0,pA1,pB0,pB1;
  int sl_prev=0,sl_cur=0,sl_next=SLOTB;
  #define ROT() do{sl_prev=sl_cur;sl_cur=sl_next;sl_next=(sl_next==(NSLOT-1)*SLOTB)?0:sl_next+SLOTB;}while(0)
  DMA_K(2,2*SLOTB);
  WAIT_BAR_KA(3);
  AUG(pA0,pA1); qkt(pA0,pA1,Kbase,qr,r32,hi);asm volatile("s_nop 15\n\ts_nop 7":"+v"(pA0),"+v"(pA1));CMASK(pA0,pA1,0);
  START(pA0,pA1);
  _Pragma("unroll") for(int r=0;r<16;++r)pA1[r]=__builtin_amdgcn_exp2f(pA1[r]);
  WAIT_BAR(0);
  KA_LOAD(1);DMA_K(3,0);DMA_V(1,SLOTB);
  ROT();
  kload8(kf,kp0+sl_cur);
  WAIT_BAR_KA(2);
  s16x4 vlo[8],vhi[8]; u32x4 pw0,pw1,pw2,pw3;
  #define PKW(P,B) cvtpk_s(P[B],P[B+1])
  #define PAF(k) __builtin_bit_cast(bf16x8,pw##k)
  #define VFR(i) (bf16x8){vlo[i][0],vlo[i][1],vlo[i][2],vlo[i][3],vhi[i][0],vhi[i][1],vhi[i][2],vhi[i][3]}
  #define PIN(x) asm volatile("":"+v"(x))
  #define MX3(a,b,c) __builtin_fmaxf(__builtin_fmaxf((a),(b)),(c))
  #define GAPA(MF,A0,A1,A2,A3,W0,W1,PW) do{ MF; sacc+=A0; sacc+=A1; sacc+=A2; sacc+=A3; PIN(sacc); W0; W1; PIN(PW); SBAR(); }while(0)
  #define EX(v) __builtin_amdgcn_exp2f(v)
  #define GAPB(MF,X,B) do{ MF; X[B]=EX(X[B]); X[B+1]=EX(X[B+1]); X[B+2]=EX(X[B+2]); X[B+3]=EX(X[B+3]); PIN(X); SBAR(); }while(0)
  #define VRD(i) do{ vlo[i]=vtr(vp_+(((i)>>2)*4096+((i)&3)*1024)); vhi[i]=vtr(vp_+(((i)>>2)*4096+((i)&3)*1024+512)); }while(0)
  #define KRD(G,j) do{ if(G){ kload2(kf,kp0+sl_next,j); SBAR(); } }while(0)
  #define STEP(C0,C1,P0,P1,t,GK,GV,GL) do{ SBAR(); \
    const lds_cptr vp_=vp0+sl_prev; \
    AUG(C0,C1); SBAR(); \
    VRD(0); SBAR(); float sacc=(P0[0]+P0[1]); \
    GAPA(C0=__builtin_amdgcn_mfma_f32_32x32x16_bf16(kf[0],qr[0],C0,0,0,0), P0[2],P0[3],P0[4],P0[5],     pw0[0]=PKW(P0,0), pw0[1]=PKW(P0,2), pw0); \
    VRD(4); SBAR(); GAPA(C1=__builtin_amdgcn_mfma_f32_32x32x16_bf16(kf[1],qr[0],C1,0,0,0), P0[6],P0[7],P0[8],P0[9],     pw0[2]=PKW(P0,4), pw0[3]=PKW(P0,6), pw0); \
    VRD(1); SBAR(); GAPA(C0=__builtin_amdgcn_mfma_f32_32x32x16_bf16(kf[2],qr[1],C0,0,0,0),   P0[10],P0[11],P0[12],P0[13], pw1[0]=PKW(P0,8), pw1[1]=PKW(P0,10), pw1); \
    VRD(5); SBAR(); GAPA(C1=__builtin_amdgcn_mfma_f32_32x32x16_bf16(kf[3],qr[1],C1,0,0,0),   P0[14],P0[15],P1[0],P1[1],   pw1[2]=PKW(P0,12),pw1[3]=PKW(P0,14), pw1); \
    VRD(2); SBAR(); GAPA(C0=__builtin_amdgcn_mfma_f32_32x32x16_bf16(kf[4],qr[2],C0,0,0,0),   P1[2],P1[3],P1[4],P1[5],     pw2[0]=PKW(P1,0), pw2[1]=PKW(P1,2), pw2); \
    VRD(6); SBAR(); GAPA(C1=__builtin_amdgcn_mfma_f32_32x32x16_bf16(kf[5],qr[2],C1,0,0,0),   P1[6],P1[7],P1[8],P1[9],     pw2[2]=PKW(P1,4), pw2[3]=PKW(P1,6), pw2); \
    VRD(3); SBAR(); GAPA(C0=__builtin_amdgcn_mfma_f32_32x32x16_bf16(kf[6],qr[3],C0,0,0,0),   P1[10],P1[11],P1[12],P1[13], pw3[0]=PKW(P1,8), pw3[1]=PKW(P1,10), pw3); \
    VRD(7); SBAR(); GAPA(C1=__builtin_amdgcn_mfma_f32_32x32x16_bf16(kf[7],qr[3],C1,0,0,0),   P1[14],P1[15],0.f,0.f,       pw3[2]=PKW(P1,12),pw3[3]=PKW(P1,14), pw3); \
    l_reg+=sacc; \
    if(GL){KA_LOAD((t)+1);} if(GK){DMA_K((t)+3,sl_cur);} if(GV){DMA_V((t)+1,sl_next);} \
    CMASK(C0,C1,t); \
    { float a=MX3(C0[0],C0[1],C1[0]),b=MX3(C0[2],C0[3],C1[1]); a=MX3(a,C1[2],C1[3]); \
      _Pragma("unroll") for(int r=4;r<16;r+=4){a=MX3(a,C0[r],C0[r+1]);b=MX3(b,C0[r+2],C0[r+3]);a=MX3(a,C1[r],C1[r+1]);b=MX3(b,C1[r+2],C1[r+3]);} \
      float rm=__builtin_fmaxf(a,b); { auto rr=__builtin_amdgcn_permlane32_swap(__float_as_uint(rm),__float_as_uint(rm),false,false); rm=__builtin_fmaxf(__uint_as_float(rr[0]),__uint_as_float(rr[1])); } \
      resc=false; \
      if(__builtin_expect(__any(rm>(float)THRL),0)){ const float dl=__builtin_fmaxf(rm,0.f); mhat+=dl; \
        _Pragma("unroll") for(int r=0;r<16;++r){C0[r]-=dl;C1[r]-=dl;} \
        QA_SET(); \
        const float f=__builtin_amdgcn_exp2f(-dl); l_reg*=f; if(hi==0)wsf[r32]=f; resc=true; } } \
    SBAR(); \
    GAPB(o[0]=__builtin_amdgcn_mfma_f32_32x32x16_bf16(PAF(0),VFR(0),o[0],0,0,0), C0,0); \
    GAPB(o[1]=__builtin_amdgcn_mfma_f32_32x32x16_bf16(PAF(0),VFR(4),o[1],0,0,0), C0,4); \
    KRD(GL,0); GAPB(o[0]=__builtin_amdgcn_mfma_f32_32x32x16_bf16(PAF(1),VFR(1),o[0],0,0,0), C0,8); \
    KRD(GL,1); GAPB(o[1]=__builtin_amdgcn_mfma_f32_32x32x16_bf16(PAF(1),VFR(5),o[1],0,0,0), C0,12); \
    KRD(GL,2); GAPB(o[0]=__builtin_amdgcn_mfma_f32_32x32x16_bf16(PAF(2),VFR(2),o[0],0,0,0), C1,0); \
    KRD(GL,3); GAPB(o[1]=__builtin_amdgcn_mfma_f32_32x32x16_bf16(PAF(2),VFR(6),o[1],0,0,0), C1,4); \
    GAPB(o[0]=__builtin_amdgcn_mfma_f32_32x32x16_bf16(PAF(3),VFR(3),o[0],0,0,0), C1,8); \
    GAPB(o[1]=__builtin_amdgcn_mfma_f32_32x32x16_bf16(PAF(3),VFR(7),o[1],0,0,0), C1,12); \
    }while(0)
  int t=1;
  #undef CMASK
  #define CMASK(P0,P1,t) do{}while(0)
  for(;t+5<NT;t+=2){
    STEP(pB0,pB1,pA0,pA1,t,true,true,true);     WAIT_BAR_KA(2); RESC(); ROT();
    STEP(pA0,pA1,pB0,pB1,t+1,true,true,true);   WAIT_BAR_KA(2); RESC(); ROT();
  }
  #undef CMASK
  #define CMASK(P0,P1,t) do{int jb_=(t)-(NT-4); if(jb_>=0)cmask(P0,P1,jb_,qrel,hi);}while(0)
  #define ENDW(tt) do{ if((tt)+3<NT){WAIT_BAR(2);} else if((tt)+2<NT){WAIT_BAR(1);} else {WAIT_BAR(0);} PIN_KA(); }while(0)
  for(;t+1<NT;t+=2){
    STEP(pB0,pB1,pA0,pA1,t,(t+3<NT),(t+1<NT),(t+1<NT));       ENDW(t);   RESC(); ROT();
    STEP(pA0,pA1,pB0,pB1,t+1,(t+4<NT),(t+2<NT),(t+2<NT));     ENDW(t+1); RESC(); ROT();
  }
  STEP(pB0,pB1,pA0,pA1,NT-1,false,false,false); RESC();
  { float sacc=pB0[0]+pB0[1]; _Pragma("unroll") for(int r=2;r<16;++r)sacc+=pB0[r]; _Pragma("unroll") for(int r=0;r<16;++r)sacc+=pB1[r]; l_reg+=sacc;
    pw0=(u32x4){PKW(pB0,0),PKW(pB0,2),PKW(pB0,4),PKW(pB0,6)};pw1=(u32x4){PKW(pB0,8),PKW(pB0,10),PKW(pB0,12),PKW(pB0,14)};pw2=(u32x4){PKW(pB1,0),PKW(pB1,2),PKW(pB1,4),PKW(pB1,6)};pw3=(u32x4){PKW(pB1,8),PKW(pB1,10),PKW(pB1,12),PKW(pB1,14)};
    SBAR(); pv(o,vb0+sl_cur,PAF(0),PAF(1),PAF(2),PAF(3)); }
  #undef PKW
  #undef PAF
  #undef VFR
  #undef PIN
  #undef MX3
  #undef GAPA
  #undef GAPB
  #undef EX
  #undef VRD
  #undef KRD
  #undef STEP
  #undef ENDW
  {auto rr=__builtin_amdgcn_permlane32_swap(__float_as_uint(l_reg),__float_as_uint(l_reg),false,false);l_reg=__uint_as_float(rr[0])+__uint_as_float(rr[1]);}
  if(hi==0)wsf[32+r32]=l_reg;asm volatile("s_waitcnt lgkmcnt(0)":::"memory");
  float rli[16];
  #pragma unroll
  for(int r=0;r<16;++r)rli[r]=__builtin_amdgcn_rcpf(wsf[32+crow(r,hi)]);
  bf16*Ow=O+(rowbase+q0+wid*QBLK)*OP+h*D;
  { bf16*stg=(bf16*)(shm+LDS_OST)+wid*2048;
    #pragma unroll
    for(int r=0;r<16;++r){const int orow=crow(r,hi);
      #pragma unroll
      for(int d0=0;d0<2;++d0)stg[orow*64+d0*32+r32]=__float2bfloat16(o[d0][r]*rli[r]);}
    asm volatile("s_waitcnt lgkmcnt(0)":::"memory");
    #pragma unroll
    for(int i=0;i<4;++i){const int row=i*8+(lane>>3),ch=lane&7; const u32x4 v=*(const u32x4*)(stg+row*64+ch*8); ATTN_STORE16(Ow+(long)row*OP+ch*8,v);} }
  asm volatile("s_waitcnt lgkmcnt(0)\n\ts_barrier":::"memory");
  #undef DMA_K
  #undef DMA_V
  #undef KA_LOAD
  #undef QA_SET
  #undef AUG
  #undef WAIT_BAR_KA
  #undef PIN_KA
  #undef CMASK
  #undef START
  #undef RESC
  #undef ROT
}
constexpr int ATTN_LDS_BYTES=LDS_BYTES;
struct AttnTensors { const bf16* Q; const bf16* K; const bf16* V; bf16* O; const unsigned char* KA; };
struct AttnUnit { int bh; int qb; };
struct StaticOrder {
  int vcu;
  __device__ __forceinline__ explicit StaticOrder(int grid,int block):vcu((block%8)*(grid/8)+block/8){}
  __device__ __forceinline__ bool next(int i,AttnUnit&u)const{ if(i>=4)return false; const int s=vcu&15; u.bh=vcu>>4; u.qb=(i==0)?63-s:(i==1)?32+s:(i==2)?31-s:s; return true; }
  __device__ __forceinline__ void a_ready(const AttnUnit&)const{}
  __device__ __forceinline__ void done(const AttnUnit&)const{}
};
template<class Sched,int THRL=8> __device__ __forceinline__ void attn_phase(char*lds,const AttnTensors&T,const Sched&S){
  AttnUnit u;
  for(int i=0;S.next(i,u);++i){ S.a_ready(u); attn_unit<THRL>(u.bh/NHEAD,u.bh%NHEAD,u.qb,0,T.Q,T.K,T.V,T.O,T.KA,lds); S.done(u); }
}
#undef SBAR
#undef WAIT_BAR
}

namespace ck {
#define CK_LAS __attribute__((address_space(3)))
typedef unsigned short bf16_t;
typedef short bf16x8 __attribute__((ext_vector_type(8)));
typedef float f32x16 __attribute__((ext_vector_type(16)));
typedef float f32x4 __attribute__((ext_vector_type(4)));
typedef unsigned u32x4 __attribute__((ext_vector_type(4)));
typedef unsigned u32x2 __attribute__((ext_vector_type(2)));
typedef CK_LAS unsigned short* lbf;
typedef CK_LAS float* lf32;
constexpr int SB = 72;
constexpr int B9 = 64 * SB * 2;
constexpr int SF = 65;
constexpr int SM = 68;
constexpr int SX = 132;
__device__ __forceinline__ unsigned pk2(float lo, float hi) { return ::pk2(lo, hi); }
__device__ __forceinline__ unsigned f2bf(float f) { return ::f2bf(f); }
__device__ __forceinline__ float bflo(unsigned w) { return __builtin_bit_cast(float, w << 16); }
__device__ __forceinline__ float bfhi(unsigned w) { return __builtin_bit_cast(float, w & 0xffff0000u); }
__device__ __forceinline__ int crow(int reg, int hh) { return (reg & 3) + 8 * (reg >> 2) + 4 * hh; }
__device__ __forceinline__ f32x16 mm_lds(lbf A, lbf BT, int I, int J, int lane, f32x16 acc) {
    const int r = lane & 31, hh = lane >> 5;
    const lbf ap = A + (32 * I + r) * SB + 8 * hh; const lbf bp = BT + (32 * J + r) * SB + 8 * hh;
#pragma unroll
    for (int s = 0; s < 4; ++s) { const bf16x8 a = *(const CK_LAS bf16x8*)(ap + 16 * s); const bf16x8 b = *(const CK_LAS bf16x8*)(bp + 16 * s); acc = __builtin_amdgcn_mfma_f32_32x32x16_bf16(a, b, acc, 0, 0, 0); }
    return acc;
}
__device__ __forceinline__ f32x16 mm_gA(const bf16_t* __restrict__ Ag, lbf BT, int I, int J, int lane, f32x16 acc) {
    const int r = lane & 31, hh = lane >> 5;
    bf16x8 a[4];
#pragma unroll
    for (int s = 0; s < 4; ++s) a[s] = *(const bf16x8*)(Ag + (32 * I + r) * 64 + 16 * s + 8 * hh);
    const lbf bp = BT + (32 * J + r) * SB + 8 * hh;
#pragma unroll
    for (int s = 0; s < 4; ++s) { const bf16x8 b = *(const CK_LAS bf16x8*)(bp + 16 * s); acc = __builtin_amdgcn_mfma_f32_32x32x16_bf16(a[s], b, acc, 0, 0, 0); }
    return acc;
}
__device__ __forceinline__ f32x16 mm_gg(const bf16_t* __restrict__ Ag, const bf16_t* __restrict__ BTg, int I, int J, int lane, f32x16 acc) {
    const int r = lane & 31, hh = lane >> 5;
#pragma unroll
    for (int s = 0; s < 4; ++s) { const bf16x8 a = *(const bf16x8*)(Ag + (32 * I + r) * 64 + 16 * s + 8 * hh); const bf16x8 b = *(const bf16x8*)(BTg + (32 * J + r) * 64 + 16 * s + 8 * hh);
        acc = __builtin_amdgcn_mfma_f32_32x32x16_bf16(a, b, acc, 0, 0, 0); }
    return acc;
}
__device__ __forceinline__ f32x16 mm_rA(const bf16x8 (&a)[4], lbf BT, int J, int lane, f32x16 acc) {
    const int r = lane & 31, hh = lane >> 5; const lbf bp = BT + (32 * J + r) * SB + 8 * hh;
#pragma unroll
    for (int s = 0; s < 4; ++s) { const bf16x8 b = *(const CK_LAS bf16x8*)(bp + 16 * s); acc = __builtin_amdgcn_mfma_f32_32x32x16_bf16(a[s], b, acc, 0, 0, 0); }
    return acc;
}
__device__ __forceinline__ void load_gA(bf16x8 (&a)[4], const bf16_t* __restrict__ Ag, int I, int lane) {
    const int r = lane & 31, hh = lane >> 5;
#pragma unroll
    for (int s = 0; s < 4; ++s) a[s] = *(const bf16x8*)(Ag + (32 * I + r) * 64 + 16 * s + 8 * hh);
}
__device__ __forceinline__ f32x16 mm_lA_gB(lbf A, const bf16_t* __restrict__ BTg, int I, int J, int lane, f32x16 acc) {
    const int r = lane & 31, hh = lane >> 5; bf16x8 b[4];
#pragma unroll
    for (int s = 0; s < 4; ++s) b[s] = *(const bf16x8*)(BTg + (32 * J + r) * 64 + 16 * s + 8 * hh);
    const lbf ap = A + (32 * I + r) * SB + 8 * hh;
#pragma unroll
    for (int s = 0; s < 4; ++s) { const bf16x8 a = *(const CK_LAS bf16x8*)(ap + 16 * s); acc = __builtin_amdgcn_mfma_f32_32x32x16_bf16(a, b[s], acc, 0, 0, 0); }
    return acc;
}
__device__ __forceinline__ void frag_store(float* __restrict__ g, int wq, int lane, const f32x16& acc) {
    f32x4* p = (f32x4*)(g + ((size_t)(wq * 64 + lane)) * 16);
    p[0] = (f32x4){acc[0], acc[1], acc[2], acc[3]}; p[1] = (f32x4){acc[4], acc[5], acc[6], acc[7]}; p[2] = (f32x4){acc[8], acc[9], acc[10], acc[11]}; p[3] = (f32x4){acc[12], acc[13], acc[14], acc[15]};
}
__device__ __forceinline__ f32x16 frag_load(const float* __restrict__ g, int wq, int lane) {
    const f32x4* p = (const f32x4*)(g + ((size_t)(wq * 64 + lane)) * 16); const f32x4 a = p[0], b = p[1], c = p[2], d = p[3];
    return (f32x16){a[0], a[1], a[2], a[3], b[0], b[1], b[2], b[3], c[0], c[1], c[2], c[3], d[0], d[1], d[2], d[3]};
}
__device__ __forceinline__ void frag_store_bf(bf16_t* __restrict__ g, int wq, int lane, const f32x16& acc) {
    u32x4* p = (u32x4*)(g + ((size_t)(wq * 64 + lane)) * 16);
    p[0] = (u32x4){pk2(acc[0], acc[1]), pk2(acc[2], acc[3]), pk2(acc[4], acc[5]), pk2(acc[6], acc[7])}; p[1] = (u32x4){pk2(acc[8], acc[9]), pk2(acc[10], acc[11]), pk2(acc[12], acc[13]), pk2(acc[14], acc[15])};
}
__device__ __forceinline__ f32x16 frag_load_bf(const bf16_t* __restrict__ g, int wq, int lane) {
    const u32x4* p = (const u32x4*)(g + ((size_t)(wq * 64 + lane)) * 16); const u32x4 a = p[0], b = p[1];
    return (f32x16){bflo(a[0]), bfhi(a[0]), bflo(a[1]), bfhi(a[1]), bflo(a[2]), bfhi(a[2]), bflo(a[3]), bfhi(a[3]), bflo(b[0]), bfhi(b[0]), bflo(b[1]), bfhi(b[1]), bflo(b[2]), bfhi(b[2]), bflo(b[3]), bfhi(b[3])};
}
__device__ __forceinline__ void tile_store_T(lbf dst, int I, int J, int lane, const f32x16& acc) {
    const int r = lane & 31, hh = lane >> 5;
#pragma unroll
    for (int g = 0; g < 4; ++g) { u32x2 w; w.x = pk2(acc[4 * g], acc[4 * g + 1]); w.y = pk2(acc[4 * g + 2], acc[4 * g + 3]);
        *(CK_LAS u32x2*)(dst + (32 * J + r) * SB + 32 * I + 8 * g + 4 * hh) = w; }
}
__device__ __forceinline__ float fexp(float x) { return __builtin_amdgcn_exp2f(x * 1.4426950408889634f); }
__device__ __forceinline__ float sigm(float x) { return __builtin_amdgcn_rcpf(1.0f + fexp(-x)); }
__device__ __forceinline__ float ftanh(float x) { const float xc = fminf(fmaxf(x, -15.f), 15.f); return 1.0f - 2.0f * __builtin_amdgcn_rcpf(fexp(2.0f * xc) + 1.0f); }
__device__ __forceinline__ float logsig(float x) { const float ax = fabsf(x); return fminf(x, 0.f) - 0.6931471805599453f * __builtin_amdgcn_logf(1.0f + fexp(-ax)); }
template <int CTRL> __device__ __forceinline__ float dpp_f(float v) { return __builtin_bit_cast(float, __builtin_amdgcn_update_dpp(0, __builtin_bit_cast(int, v), CTRL, 0xf, 0xf, false)); }
__device__ __forceinline__ float quad_sum(float v) { v += dpp_f<0xB1>(v); v += dpp_f<0x4E>(v); return v; }

constexpr size_t O_PC = 0, O_QC = 16u << 20, O_GY = 48u << 20, O_YL = 64u << 20, O_VG = 96u << 20, O_GG = 112u << 20, O_H0 = 128u << 20, O_RKD = 144u << 20, O_KV = 145u << 20, O_RT = 177u << 20, O_END = 193u << 20,
                 O_PG = 193u << 20, O_QG = 195u << 20, O_HG = 197u << 20, O_KG = 199u << 20, O_RG = 203u << 20, O_END2 = 207u << 20;
struct RwkvParams {
    const float *mu_rkv, *mu_lora, *w0, *a0, *k_k, *k_a, *r_k, *ln_g, *ln_b, *gn_g;
    const bf16_t *w2t, *a2t, *g2t;
};

constexpr int L_U = 10 * B9, L_MM = L_U + 36864, L_GL = L_MM + 64 * SM * 4, L_END1 = L_GL + 256;
__device__ __forceinline__ void rwkv_stage1(CK_LAS unsigned char* lds, int item, const bf16_t* __restrict__ Pb, int PW, int C_RR, int C_RK, int C_RV, int C_WD, int SEQ, const RwkvParams& p, unsigned char* __restrict__ cw) {
    const int tid = ltid(), lane = tid & 63, wid = __builtin_amdgcn_readfirstlane(tid >> 6), quad = wid >> 2, wq = wid & 3, I = wq >> 1, J = wq & 1, r = lane & 31, hh = lane >> 5;
    const int b = item >> 10, h = (item >> 8) & 3, c = item & 255;
    const size_t m0 = (size_t)b * SEQ + (size_t)c * 64;
    const lbf Am = (lbf)(lds), Bm = (lbf)(lds + B9), Km = (lbf)(lds + 2 * B9), Rm = (lbf)(lds + 3 * B9), VT = (lbf)(lds + 4 * B9), BhT = (lbf)(lds + 5 * B9), KhT = (lbf)(lds + 6 * B9),
              Nm = (lbf)(lds + 7 * B9), Wb = (lbf)(lds + 8 * B9), Wk = (lbf)(lds + 9 * B9);
    const lbf TW = (lbf)(lds + L_U), AD = (lbf)(lds + L_U + B9), SG0 = (lbf)(lds + L_U + 2 * B9), SG1 = (lbf)(lds + L_U + 3 * B9);
    const lbf W2T = BhT, A2T = KhT, G2Ta = Nm, G2Tb = Wb;
    const lf32 X = (lf32)(lds + L_U), MM = (lf32)(lds + L_MM), GL = (lf32)(lds + L_GL);
    const lf32 AA = (lf32)(lds), GGl = (lf32)(lds + 2 * B9);
    const lbf ZlT = Km, X1T = Nm;
    const int t = tid >> 3, c8 = (tid & 7) * 8;
    const size_t m = m0 + t; const bool hp = (c * 64 + t) > 0;
    const bf16_t* pr = Pb + m * PW; const bf16_t* pp = pr - PW;
    float rr[8], kx[8], vv[8];
    {
        const u32x4 z4 = (u32x4){0u, 0u, 0u, 0u};
        const u32x4 cr = *(const u32x4*)(pr + C_RR + h * 64 + c8), ckk = *(const u32x4*)(pr + C_RK + h * 64 + c8), cv = *(const u32x4*)(pr + C_RV + h * 64 + c8);
        const u32x4 qr = hp ? *(const u32x4*)(pp + C_RR + h * 64 + c8) : z4, qk = hp ? *(const u32x4*)(pp + C_RK + h * 64 + c8) : z4, qv = hp ? *(const u32x4*)(pp + C_RV + h * 64 + c8) : z4;
#pragma unroll
        for (int e = 0; e < 8; ++e) { const int ch = h * 64 + c8 + e;
            const float a_ = (e & 1) ? bfhi(cr[e >> 1]) : bflo(cr[e >> 1]), b_ = (e & 1) ? bfhi(qr[e >> 1]) : bflo(qr[e >> 1]); rr[e] = a_ + (b_ - a_) * p.mu_rkv[ch];
            const float c_ = (e & 1) ? bfhi(ckk[e >> 1]) : bflo(ckk[e >> 1]), d_ = (e & 1) ? bfhi(qk[e >> 1]) : bflo(qk[e >> 1]); kx[e] = c_ + (d_ - c_) * p.mu_rkv[256 + ch];
            const float e_ = (e & 1) ? bfhi(cv[e >> 1]) : bflo(cv[e >> 1]), f_ = (e & 1) ? bfhi(qv[e >> 1]) : bflo(qv[e >> 1]); vv[e] = e_ + (f_ - e_) * p.mu_rkv[512 + ch]; }
#pragma unroll
        for (int q = 0; q < 4; ++q) { const u32x4 cl = *(const u32x4*)(pr + C_WD + q * 64 + c8); const u32x4 ql = hp ? *(const u32x4*)(pp + C_WD + q * 64 + c8) : z4;
            float lo[8];
#pragma unroll
            for (int e = 0; e < 8; ++e) { const float a_ = (e & 1) ? bfhi(cl[e >> 1]) : bflo(cl[e >> 1]), b_ = (e & 1) ? bfhi(ql[e >> 1]) : bflo(ql[e >> 1]); const float x = a_ + (b_ - a_) * p.mu_lora[q * 64 + c8 + e];
                lo[e] = (q == 0) ? ftanh(x) : (q == 1 ? x : sigm(x)); }
            u32x4 w; w.x = pk2(lo[0], lo[1]); w.y = pk2(lo[2], lo[3]); w.z = pk2(lo[4], lo[5]); w.w = pk2(lo[6], lo[7]);
            *(CK_LAS u32x4*)((q == 0 ? TW : q == 1 ? AD : q == 2 ? SG0 : SG1) + t * SB + c8) = w; }
        *(CK_LAS u32x4*)(W2T + t * SB + c8) = *(const u32x4*)(p.w2t + ((size_t)h * 64 + t) * 64 + c8);
        *(CK_LAS u32x4*)(A2T + t * SB + c8) = *(const u32x4*)(p.a2t + ((size_t)h * 64 + t) * 64 + c8);
        *(CK_LAS u32x4*)(G2Ta + t * SB + c8) = *(const u32x4*)(p.g2t + ((size_t)h * 64 + t) * 128 + c8);
        *(CK_LAS u32x4*)(G2Tb + t * SB + c8) = *(const u32x4*)(p.g2t + ((size_t)h * 64 + t) * 128 + 64 + c8);
    }
    __syncthreads();
    if (quad == 0) {
        f32x16 z = mm_lds(TW, W2T, I, J, lane, f32x16{}); f32x16 za = mm_lds(AD, A2T, I, J, lane, f32x16{});
        const int ch = 32 * J + r; const float w0c = p.w0[h * 64 + ch], a0c = p.a0[h * 64 + ch];
#pragma unroll
        for (int g = 0; g < 16; ++g) { const int tt = 32 * I + crow(g, hh); const float lw = logsig(w0c + z[g]) - 0.5f; MM[tt * SF + ch] = -fexp(lw); AA[tt * SF + ch] = sigm(a0c + za[g]); }
    } else {
        f32x16 zg = mm_lds(SG0, G2Ta, I, J, lane, f32x16{}); zg = mm_lds(SG1, G2Tb, I, J, lane, zg);
        const int ch = 32 * J + r;
#pragma unroll
        for (int g = 0; g < 16; ++g) { const int tt = 32 * I + crow(g, hh); GGl[tt * SF + ch] = zg[g]; }
    }
    __syncthreads();
    {
        const int ch = tid & 63, seg = tid >> 6; float v8[8]; float run = 0.f;
#pragma unroll
        for (int i = 0; i < 8; ++i) { run += MM[(seg * 8 + i) * SF + ch]; v8[i] = run; }
        const lf32 TOT = (lf32)(lds + L_U);
        TOT[seg * 64 + ch] = run;
        __syncthreads();
        float off = 0.f;
#pragma unroll
        for (int s2 = 0; s2 < 8; ++s2) off += (s2 < seg) ? TOT[s2 * 64 + ch] : 0.f;
#pragma unroll
        for (int i = 0; i < 8; ++i) MM[(seg * 8 + i) * SF + ch] = v8[i] + off;
    }
    __syncthreads();
    float aa[8], gg[8], lw[8], lwp[8], lwl[8];
#pragma unroll
    for (int e = 0; e < 8; ++e) { aa[e] = AA[t * SF + c8 + e]; gg[e] = GGl[t * SF + c8 + e]; lw[e] = MM[t * SF + c8 + e]; lwp[e] = t > 0 ? MM[(t - 1) * SF + c8 + e] : 0.f; lwl[e] = MM[63 * SF + c8 + e]; }
    __syncthreads();
    {
        float kk[8], k2[8]; float ss = 0.f, rk = 0.f;
#pragma unroll
        for (int e = 0; e < 8; ++e) { const int ch = h * 64 + c8 + e; kk[e] = kx[e] * p.k_k[ch]; ss += kk[e] * kk[e]; k2[e] = kx[e] * (1.0f + (aa[e] - 1.0f) * p.k_a[ch]); rk += rr[e] * k2[e] * p.r_k[ch]; }
        ss = quad_sum(ss); ss += dpp_f<0x141>(ss); rk = quad_sum(rk); rk += dpp_f<0x141>(rk);
        const float inv = 1.0f / fmaxf(sqrtf(ss), 1e-12f);
        float am[8], bm[8], km[8], rm[8];
#pragma unroll
        for (int e = 0; e < 8; ++e) { kk[e] *= inv; const float g_ = fexp(lw[e]), gi = fexp(-lw[e]), gp = fexp(lwp[e]), gl = fexp(lwl[e] - lw[e]); const float ka = kk[e] * aa[e];
            am[e] = -kk[e] * gp; bm[e] = ka * gi; km[e] = k2[e] * gi; rm[e] = rr[e] * g_;
            VT[(c8 + e) * SB + t] = (bf16_t)f2bf(vv[e]); BhT[(c8 + e) * SB + t] = (bf16_t)f2bf(ka * gl); KhT[(c8 + e) * SB + t] = (bf16_t)f2bf(k2[e] * gl);
            X[t * SX + c8 + e] = am[e]; }
        u32x4 w;
        w.x = pk2(am[0], am[1]); w.y = pk2(am[2], am[3]); w.z = pk2(am[4], am[5]); w.w = pk2(am[6], am[7]); *(CK_LAS u32x4*)(Am + t * SB + c8) = w;
        w.x = pk2(bm[0], bm[1]); w.y = pk2(bm[2], bm[3]); w.z = pk2(bm[4], bm[5]); w.w = pk2(bm[6], bm[7]); *(CK_LAS u32x4*)(Bm + t * SB + c8) = w;
        w.x = pk2(km[0], km[1]); w.y = pk2(km[2], km[3]); w.z = pk2(km[4], km[5]); w.w = pk2(km[6], km[7]); *(CK_LAS u32x4*)(Km + t * SB + c8) = w;
        w.x = pk2(rm[0], rm[1]); w.y = pk2(rm[2], rm[3]); w.z = pk2(rm[4], rm[5]); w.w = pk2(rm[6], rm[7]); *(CK_LAS u32x4*)(Rm + t * SB + c8) = w;
        if (t == 63) {
#pragma unroll
            for (int e = 0; e < 8; ++e) GL[c8 + e] = fexp(lwl[e]); }
        w.x = pk2(vv[0], vv[1]); w.y = pk2(vv[2], vv[3]); w.z = pk2(vv[4], vv[5]); w.w = pk2(vv[6], vv[7]); *(u32x4*)(cw + O_VG + (size_t)item * 8192 + (t * 64 + c8) * 2) = w;
        w.x = pk2(gg[0], gg[1]); w.y = pk2(gg[2], gg[3]); w.z = pk2(gg[4], gg[5]); w.w = pk2(gg[6], gg[7]); *(u32x4*)(cw + O_GG + (size_t)item * 8192 + (t * 64 + c8) * 2) = w;
        if ((tid & 7) == 0) *(float*)(cw + O_RKD + (size_t)item * 256 + t * 4) = rk;
    }
    __syncthreads();
    {
        const f32x16 p1 = mm_lds(Am, quad == 0 ? Bm : Km, I, J, lane, f32x16{}); const f32x16 p2 = mm_lds(Rm, quad == 0 ? Bm : Km, I, J, lane, f32x16{});
        const int ii = 32 * J + r;
#pragma unroll
        for (int g = 0; g < 16; ++g) { const int tt = 32 * I + crow(g, hh);
            if (quad == 0) { MM[tt * SM + (ii & 3) * 16 + (ii >> 2)] = (ii < tt) ? p1[g] : 0.f; Wb[tt * SB + ii] = (bf16_t)f2bf((ii <= tt) ? p2[g] : 0.f); }
            else { Nm[tt * SB + ii] = (bf16_t)f2bf((ii < tt) ? p1[g] : 0.f); Wk[tt * SB + ii] = (bf16_t)f2bf((ii <= tt) ? p2[g] : 0.f); } }
    }
    __syncthreads();
    if (quad == 0) { const f32x16 nv = mm_lds(Nm, VT, I, J, lane, f32x16{}); const int vcol = 64 + 32 * J + r;
#pragma unroll
        for (int g = 0; g < 16; ++g) X[(32 * I + crow(g, hh)) * SX + vcol] = nv[g]; }
    __syncthreads();
    {
        const int col = tid >> 2, q = tid & 3;
        float xs[16];
#pragma unroll
        for (int k = 0; k < 16; ++k) xs[k] = X[(q + 4 * k) * SX + col];
#pragma unroll
        for (int tt = 1; tt < 64; ++tt) {
            const CK_LAS f32x4* mr = (const CK_LAS f32x4*)(MM + tt * SM + q * 16);
            float s0 = 0.f, s1 = 0.f, s2 = 0.f, s3 = 0.f;
#pragma unroll
            for (int k4 = 0; k4 < (tt + 15) / 16; ++k4) { const f32x4 mv = mr[k4]; s0 += mv[0] * xs[4 * k4]; s1 += mv[1] * xs[4 * k4 + 1]; s2 += mv[2] * xs[4 * k4 + 2]; s3 += mv[3] * xs[4 * k4 + 3]; }
            const float sm = quad_sum((s0 + s1) + (s2 + s3));
            xs[tt >> 2] += (q == (tt & 3)) ? sm : 0.f;
        }
        const lbf dstT = (col < 64) ? (X1T + col * SB) : (ZlT + (col - 64) * SB);
#pragma unroll
        for (int k = 0; k < 16; ++k) dstT[q + 4 * k] = (bf16_t)f2bf(xs[k]);
    }
    __syncthreads();
    if (quad == 0) {
        const f32x16 gy = mm_lds(Wb, X1T, I, J, lane, f32x16{}); const f32x16 pc = mm_lds(BhT, X1T, I, J, lane, f32x16{});
        bf16_t* gyg = (bf16_t*)(cw + O_GY + (size_t)item * 8192); bf16_t* pcg = (bf16_t*)(cw + O_PC + (size_t)item * 8192);
        const int cc = 32 * J + r;
#pragma unroll
        for (int g = 0; g < 16; ++g) { const int rw = 32 * I + crow(g, hh);
            gyg[rw * 64 + cc] = (bf16_t)f2bf(gy[g] + __builtin_bit_cast(float, (unsigned)Rm[rw * SB + cc] << 16));
            pcg[rw * 64 + cc] = (bf16_t)f2bf(pc[g] + (rw == cc ? GL[cc] : 0.f)); }
    } else {
        f32x16 yl = mm_lds(ZlT, Wb, I, J, lane, f32x16{}); yl = mm_lds(VT, Wk, I, J, lane, yl);
        f32x16 qc = mm_lds(BhT, ZlT, I, J, lane, f32x16{}); qc = mm_lds(KhT, VT, I, J, lane, qc);
        frag_store((float*)(cw + O_YL + (size_t)item * 16384), wq, lane, yl); frag_store_bf((bf16_t*)(cw + O_QC) + (size_t)item * 4096, wq, lane, qc);
    }
    __syncthreads();
}

template <int NST> __device__ __forceinline__ void rwkv_scan(CK_LAS unsigned char* lds, int chain, const bf16_t* __restrict__ pcb, const bf16_t* __restrict__ qcb, bf16_t* __restrict__ h0b) {
    const int tid = ltid(), lane = tid & 63, wid = __builtin_amdgcn_readfirstlane(tid >> 6), quad = wid >> 2, wq = wid & 3, I = wq >> 1, J = wq & 1, r = lane & 31, hh = lane >> 5, qtid = tid & 255;
    const lbf HT = (lbf)(lds + quad * B9);
    for (int i = qtid; i < 64 * SB / 2; i += 256) ((CK_LAS unsigned*)HT)[i] = 0u;
    __syncthreads();
    const bool on = chain >= 0; const size_t it0 = (size_t)(on ? chain : 0) * NST;
    const bf16_t* pcg = pcb + it0 * 4096; const bf16_t* qcg = qcb + it0 * 4096; bf16_t* h0g = h0b + it0 * 4096;
    constexpr int PD = 5;
    bf16x8 ar[PD][4]; f32x16 qr[PD];
#define CK_LOADSTEP(A_, Q_, cc) do { const int c_ = (cc) < NST ? (cc) : NST - 1; _Pragma("unroll") for (int s_ = 0; s_ < 4; ++s_) A_[s_] = *(const bf16x8*)(pcg + (size_t)c_ * 4096 + (32 * I + r) * 64 + 16 * s_ + 8 * hh); Q_ = frag_load_bf(qcg + (size_t)c_ * 4096, wq, lane); } while (0)
#pragma unroll
    for (int k = 0; k < PD; ++k) CK_LOADSTEP(ar[k], qr[k], k);
    for (int c = 0; c < NST + PD - 1; c += PD) {
#pragma unroll
        for (int k = 0; k < PD; ++k) {
            const int cc = c + k;
            if (cc < NST) {
            if (on) { const int row = qtid >> 2, seg = (qtid & 3) * 16; const u32x4 w0 = *(const CK_LAS u32x4*)(HT + row * SB + seg), w1 = *(const CK_LAS u32x4*)(HT + row * SB + seg + 8);
                      u32x4* dst = (u32x4*)(h0g + (size_t)cc * 4096 + row * 64 + seg); dst[0] = w0; dst[1] = w1; }
            f32x16 acc = qr[k];
            const lbf bp = HT + (32 * J + r) * SB + 8 * hh;
#pragma unroll
            for (int s_ = 0; s_ < 4; ++s_) { const bf16x8 bfr = *(const CK_LAS bf16x8*)(bp + 16 * s_); acc = __builtin_amdgcn_mfma_f32_32x32x16_bf16(ar[k][s_], bfr, acc, 0, 0, 0); }
            CK_LOADSTEP(ar[k], qr[k], cc + PD);
            asm volatile("s_waitcnt lgkmcnt(0)\n\ts_barrier" ::: "memory");
            tile_store_T(HT, I, J, lane, acc);
            asm volatile("s_waitcnt lgkmcnt(0)\n\ts_barrier" ::: "memory");
            }
        }
    }
#undef CK_LOADSTEP
}

__device__ __forceinline__ void rwkv_level1(CK_LAS unsigned char* lds, int task, unsigned char* __restrict__ cw) {
    const int tid = ltid(), lane = tid & 63, wid = __builtin_amdgcn_readfirstlane(tid >> 6), quad = wid >> 2, wq = wid & 3, I = wq >> 1, J = wq & 1, r = lane & 31, hh = lane >> 5;
    const lbf PTh = (lbf)(lds + quad * 4 * B9), PTl = PTh + 64 * SB, QTh = PTl + 64 * SB, QTl = QTh + 64 * SB;
    const bool on = task >= 0; const int tk = on ? task : 0; const size_t item0 = (size_t)(tk >> 5) * 256 + (size_t)(tk & 31) * 8;
    f32x16 PG, QG = f32x16{};
#pragma unroll
    for (int g = 0; g < 16; ++g) PG[g] = (I == J && crow(g, hh) == r) ? 1.0f : 0.0f;
    for (int j = 0; j < 8; ++j) {
        const size_t item = item0 + j;
        bf16x8 a[4]; load_gA(a, (const bf16_t*)(cw + O_PC) + item * 4096, I, lane);
        f32x16 qn = frag_load_bf((const bf16_t*)(cw + O_QC) + item * 4096, wq, lane);
        f32x16 pl, ql;
#pragma unroll
        for (int g = 0; g < 16; ++g) { pl[g] = PG[g] - __builtin_bit_cast(float, f2bf(PG[g]) << 16); ql[g] = QG[g] - __builtin_bit_cast(float, f2bf(QG[g]) << 16); }
        tile_store_T(PTh, I, J, lane, PG); tile_store_T(PTl, I, J, lane, pl); tile_store_T(QTh, I, J, lane, QG); tile_store_T(QTl, I, J, lane, ql);
        __syncthreads();
        f32x16 pn = mm_rA(a, PTh, J, lane, f32x16{}); pn = mm_rA(a, PTl, J, lane, pn);
        qn = mm_rA(a, QTh, J, lane, qn); qn = mm_rA(a, QTl, J, lane, qn);
        __syncthreads();
        PG = pn; QG = qn;
    }
    if (on) { bf16_t* pgg = (bf16_t*)(cw + O_PG) + (size_t)tk * 4096; const int cc = 32 * J + r;
#pragma unroll
        for (int g = 0; g < 16; ++g) pgg[(32 * I + crow(g, hh)) * 64 + cc] = (bf16_t)f2bf(PG[g]);
        frag_store_bf((bf16_t*)(cw + O_QG) + (size_t)tk * 4096, wq, lane, QG); }
}

constexpr int L_RW3 = B9 + 64 * SF * 4;
__device__ __forceinline__ void rwkv_stage3g(CK_LAS unsigned char* ldsq, int task, const RwkvParams& p, const unsigned char* __restrict__ cw, bf16_t* __restrict__ MIXB, int SEQ) {
    const int tid = ltid(), lane = tid & 63, wid = __builtin_amdgcn_readfirstlane(tid >> 6), wq = wid & 3, I = wq >> 1, J = wq & 1, r = lane & 31, hh = lane >> 5, qtid = tid & 255;
    const lbf HT = (lbf)ldsq; const lf32 Y = (lf32)(ldsq + B9);
    const bool on = task >= 0; const int tk = on ? task : 0; const int item0 = (tk >> 5) * 256 + (tk & 31) * 8;
    { const int row = qtid >> 2, seg = (qtid & 3) * 16; const u32x4* src = (const u32x4*)((const bf16_t*)(cw + O_HG) + (size_t)tk * 4096 + row * 64 + seg);
      *(CK_LAS u32x4*)(HT + row * SB + seg) = src[0]; *(CK_LAS u32x4*)(HT + row * SB + seg + 8) = src[1]; }
    __syncthreads();
    for (int j = 0; j < 8; ++j) {
        const int item = item0 + j;
        bf16x8 a[4]; load_gA(a, (const bf16_t*)(cw + O_PC) + (size_t)item * 4096, I, lane);
        f32x16 hn = frag_load_bf((const bf16_t*)(cw + O_QC) + (size_t)item * 4096, wq, lane);
        {
            f32x16 acc = frag_load((const float*)(cw + O_YL) + (size_t)item * 4096, wq, lane);
            acc = mm_lA_gB(HT, (const bf16_t*)(cw + O_GY) + (size_t)item * 4096, I, J, lane, acc);
#pragma unroll
            for (int g = 0; g < 16; ++g) Y[(32 * J + r) * SF + 32 * I + crow(g, hh)] = acc[g];
        }
        hn = mm_rA(a, HT, J, lane, hn);
        __syncthreads();
        tile_store_T(HT, I, J, lane, hn);
        if (on) {
            const int b = item >> 10, h = (item >> 8) & 3, c = item & 255; const int t = qtid >> 2, c16 = (qtid & 3) * 16;
            float y[16]; float s = 0.f;
#pragma unroll
            for (int e = 0; e < 16; ++e) { y[e] = Y[t * SF + c16 + e]; s += y[e]; }
            const float mu = quad_sum(s) * (1.f / 64.f); float s2 = 0.f;
#pragma unroll
            for (int e = 0; e < 16; ++e) { y[e] -= mu; s2 += y[e] * y[e]; }
            const float rstd = 1.0f / sqrtf(quad_sum(s2) * (1.f / 64.f) + 64e-5f);
            const u32x4* vg = (const u32x4*)(cw + O_VG + (size_t)item * 8192 + (t * 64 + c16) * 2); const u32x4* gg = (const u32x4*)(cw + O_GG + (size_t)item * 8192 + (t * 64 + c16) * 2);
            const float rk = *(const float*)(cw + O_RKD + (size_t)item * 256 + t * 4);
            unsigned ow[8];
#pragma unroll
            for (int hv = 0; hv < 2; ++hv) { const u32x4 vw = vg[hv], gw = gg[hv];
#pragma unroll
                for (int e2 = 0; e2 < 4; ++e2) { const int e = hv * 8 + 2 * e2; const int ch = h * 64 + c16 + e;
                    const float o0 = (y[e] * rstd * p.ln_g[ch] + p.ln_b[ch] + rk * bflo(vw[e2])) * bflo(gw[e2]);
                    const float o1 = (y[e + 1] * rstd * p.ln_g[ch + 1] + p.ln_b[ch + 1] + rk * bfhi(vw[e2])) * bfhi(gw[e2]);
                    ow[hv * 4 + e2] = pk2(o0, o1); } }
            u32x4* dst = (u32x4*)(MIXB + ((size_t)b * SEQ + (size_t)c * 64 + t) * 1024 + 512 + h * 64 + c16);
            dst[0] = (u32x4){ow[0], ow[1], ow[2], ow[3]}; dst[1] = (u32x4){ow[4], ow[5], ow[6], ow[7]};
        }
        __syncthreads();
    }
}

__device__ __forceinline__ void rwkv_stage3(CK_LAS unsigned char* ldsq, int item, const RwkvParams& p, const unsigned char* __restrict__ cw, bf16_t* __restrict__ MIXB, int SEQ) {
    const int tid = ltid(), lane = tid & 63, wid = __builtin_amdgcn_readfirstlane(tid >> 6), wq = wid & 3, I = wq >> 1, J = wq & 1, r = lane & 31, hh = lane >> 5, qtid = tid & 255;
    const lf32 Y = (lf32)ldsq;
    if (item >= 0) {
        f32x16 acc = frag_load((const float*)(cw + O_YL) + (size_t)item * 4096, wq, lane);
        acc = mm_gg((const bf16_t*)(cw + O_H0) + (size_t)item * 4096, (const bf16_t*)(cw + O_GY) + (size_t)item * 4096, I, J, lane, acc);
#pragma unroll
        for (int g = 0; g < 16; ++g) Y[(32 * J + r) * SF + 32 * I + crow(g, hh)] = acc[g];
    }
    __syncthreads();
    if (item >= 0) {
        const int b = item >> 10, h = (item >> 8) & 3, c = item & 255; const int t = qtid >> 2, c16 = (qtid & 3) * 16;
        float y[16]; float s = 0.f;
#pragma unroll
        for (int e = 0; e < 16; ++e) { y[e] = Y[t * SF + c16 + e]; s += y[e]; }
        const float mu = quad_sum(s) * (1.f / 64.f); float s2 = 0.f;
#pragma unroll
        for (int e = 0; e < 16; ++e) { y[e] -= mu; s2 += y[e] * y[e]; }
        const float rstd = 1.0f / sqrtf(quad_sum(s2) * (1.f / 64.f) + 64e-5f);
        const u32x4* vg = (const u32x4*)(cw + O_VG + (size_t)item * 8192 + (t * 64 + c16) * 2); const u32x4* gg = (const u32x4*)(cw + O_GG + (size_t)item * 8192 + (t * 64 + c16) * 2);
        const float rk = *(const float*)(cw + O_RKD + (size_t)item * 256 + t * 4);
        unsigned ow[8];
#pragma unroll
        for (int hv = 0; hv < 2; ++hv) { const u32x4 vw = vg[hv], gw = gg[hv];
#pragma unroll
            for (int e2 = 0; e2 < 4; ++e2) { const int e = hv * 8 + 2 * e2; const int ch = h * 64 + c16 + e;
                const float o0 = (y[e] * rstd * p.ln_g[ch] + p.ln_b[ch] + rk * bflo(vw[e2])) * bflo(gw[e2]);
                const float o1 = (y[e + 1] * rstd * p.ln_g[ch + 1] + p.ln_b[ch + 1] + rk * bfhi(vw[e2])) * bfhi(gw[e2]);
                ow[hv * 4 + e2] = pk2(o0, o1); } }
        u32x4* dst = (u32x4*)(MIXB + ((size_t)b * SEQ + (size_t)c * 64 + t) * 1024 + 512 + h * 64 + c16);
        dst[0] = (u32x4){ow[0], ow[1], ow[2], ow[3]}; dst[1] = (u32x4){ow[4], ow[5], ow[6], ow[7]};
    }
    __syncthreads();
}

__device__ __forceinline__ void rot16(float (&o)[16], const bf16_t* __restrict__ prow, int colbase, int c16, const float* __restrict__ ropet  ) {
    const u32x4* own = (const u32x4*)(prow + colbase + c16); const u32x4* par = (const u32x4*)(prow + colbase + (c16 ^ 32));
    const f32x4* cs = (const f32x4*)(ropet + 2 * (c16 & 31));
#pragma unroll
    for (int hv = 0; hv < 2; ++hv) { const u32x4 ow = own[hv], pw = par[hv];
#pragma unroll
        for (int e2 = 0; e2 < 4; ++e2) { const f32x4 csv = cs[hv * 4 + e2];
            const float x0 = bflo(ow[e2]), x1 = bfhi(ow[e2]), p0 = bflo(pw[e2]), p1 = bfhi(pw[e2]);
            o[hv * 8 + 2 * e2] = (c16 < 32) ? (x0 * csv[0] - p0 * csv[1]) : (p0 * csv[1] + x0 * csv[0]);
            o[hv * 8 + 2 * e2 + 1] = (c16 < 32) ? (x1 * csv[2] - p1 * csv[3]) : (p1 * csv[3] + x1 * csv[2]); } }
}
__device__ __forceinline__ void ret_stage1(CK_LAS unsigned char* ldsq, int item, const bf16_t* __restrict__ Pb, int PW, int C_TK, int C_TV, int SEQ, const float* __restrict__ ROPE, unsigned char* __restrict__ cw) {
    const int tid = ltid(), lane = tid & 63, wid = __builtin_amdgcn_readfirstlane(tid >> 6), wq = wid & 3, I = wq >> 1, J = wq & 1, qtid = tid & 255;
    const lbf VT = (lbf)ldsq, KdT = (lbf)(ldsq + B9);
    if (item >= 0) {
        const int b = item >> 10, h = (item >> 8) & 3, c = item & 255; const int t = qtid >> 2, c16 = (qtid & 3) * 16; const int pos = c * 64 + t;
        const bf16_t* prow = Pb + ((size_t)b * SEQ + pos) * PW;
        float kr[16]; rot16(kr, prow, C_TK + h * 64, c16, ROPE + (size_t)pos * 64);
        const float lg = __builtin_amdgcn_logf(1.0f - __builtin_amdgcn_exp2f(-5.0f - (float)h));
        const float dec = 0.125f * __builtin_amdgcn_exp2f(lg * (float)(63 - t));
        const u32x4* vp = (const u32x4*)(prow + C_TV + h * 64 + c16);
#pragma unroll
        for (int hv = 0; hv < 2; ++hv) { const u32x4 vw = vp[hv];
#pragma unroll
            for (int e2 = 0; e2 < 4; ++e2) { const int e = hv * 8 + 2 * e2;
                VT[(c16 + e) * SB + t] = (bf16_t)(vw[e2] & 0xffffu); VT[(c16 + e + 1) * SB + t] = (bf16_t)(vw[e2] >> 16);
                KdT[(c16 + e) * SB + t] = (bf16_t)f2bf(kr[e] * dec); KdT[(c16 + e + 1) * SB + t] = (bf16_t)f2bf(kr[e + 1] * dec); } }
    }
    __syncthreads();
    if (item >= 0) { const f32x16 kv = mm_lds(VT, KdT, I, J, lane, f32x16{}); frag_store_bf((bf16_t*)(cw + O_KV) + (size_t)item * 4096, wq, lane, kv); }
    __syncthreads();
}
__device__ __forceinline__ void ret_scan(int chain, unsigned char* __restrict__ cw) {
    const int tid = ltid(), lane = tid & 63, wid = __builtin_amdgcn_readfirstlane(tid >> 6), wq = wid & 3, I = wq >> 1, J = wq & 1, r = lane & 31, hh = lane >> 5;
    const int h = chain & 3; const float lg = __builtin_amdgcn_logf(1.0f - __builtin_amdgcn_exp2f(-5.0f - (float)h)); const float g64 = __builtin_amdgcn_exp2f(lg * 64.0f);
    const bf16_t* kvg = (const bf16_t*)(cw + O_KV) + (size_t)chain * 256 * 4096; bf16_t* rtg = (bf16_t*)(cw + O_RT) + (size_t)chain * 256 * 4096;
    f32x16 R = f32x16{}; constexpr int PD = 8; f32x16 nx[PD];
#pragma unroll
    for (int k = 0; k < PD; ++k) nx[k] = frag_load_bf(kvg + (size_t)k * 4096, wq, lane);
    for (int c = 0; c < 256; c += PD) {
#pragma unroll
        for (int k = 0; k < PD; ++k) { const int cc = c + k; bf16_t* dst = rtg + (size_t)cc * 4096;
#pragma unroll
            for (int g = 0; g < 16; ++g) dst[(32 * I + crow(g, hh)) * 64 + 32 * J + r] = (bf16_t)f2bf(R[g]);
            const f32x16 kvc = nx[k]; const int nn = cc + PD < 256 ? cc + PD : 255;
            nx[k] = frag_load_bf(kvg + (size_t)nn * 4096, wq, lane);
#pragma unroll
            for (int g = 0; g < 16; ++g) R[g] = R[g] * g64 + kvc[g]; }
    }
}
constexpr int L_RET3 = 4 * B9 + 64 * SF * 4;
__device__ __forceinline__ void ret_stage3(CK_LAS unsigned char* ldsq, int item, const bf16_t* __restrict__ Pb, int PW, int C_TQ, int C_TK, int C_TV, int C_TG, int SEQ, const float* __restrict__ ROPE,
                                           const float* __restrict__ gn_g, const unsigned char* __restrict__ cw, bf16_t* __restrict__ MIXB) {
    const int tid = ltid(), lane = tid & 63, wid = __builtin_amdgcn_readfirstlane(tid >> 6), wq = wid & 3, I = wq >> 1, J = wq & 1, r = lane & 31, hh = lane >> 5, qtid = tid & 255;
    const lbf Qr = (lbf)ldsq, Kr = (lbf)(ldsq + B9), VT = (lbf)(ldsq + 2 * B9), Sb = (lbf)(ldsq + 3 * B9); const lf32 Y = (lf32)(ldsq + 4 * B9);
    const int b = item >= 0 ? item >> 10 : 0, h = item >= 0 ? (item >> 8) & 3 : 0, c = item >= 0 ? item & 255 : 0; const int t = qtid >> 2, c16 = (qtid & 3) * 16; const int pos = c * 64 + t;
    const float lg = __builtin_amdgcn_logf(1.0f - __builtin_amdgcn_exp2f(-5.0f - (float)h));
    const bf16_t* prow = Pb + ((size_t)b * SEQ + pos) * PW;
    if (item >= 0) {
        float qr[16], kr[16]; rot16(qr, prow, C_TQ + h * 64, c16, ROPE + (size_t)pos * 64); rot16(kr, prow, C_TK + h * 64, c16, ROPE + (size_t)pos * 64);
        u32x4 w;
        w.x = pk2(qr[0], qr[1]); w.y = pk2(qr[2], qr[3]); w.z = pk2(qr[4], qr[5]); w.w = pk2(qr[6], qr[7]); *(CK_LAS u32x4*)(Qr + t * SB + c16) = w;
        w.x = pk2(qr[8], qr[9]); w.y = pk2(qr[10], qr[11]); w.z = pk2(qr[12], qr[13]); w.w = pk2(qr[14], qr[15]); *(CK_LAS u32x4*)(Qr + t * SB + c16 + 8) = w;
#pragma unroll
        for (int e = 0; e < 16; ++e) kr[e] *= 0.125f;
        w.x = pk2(kr[0], kr[1]); w.y = pk2(kr[2], kr[3]); w.z = pk2(kr[4], kr[5]); w.w = pk2(kr[6], kr[7]); *(CK_LAS u32x4*)(Kr + t * SB + c16) = w;
        w.x = pk2(kr[8], kr[9]); w.y = pk2(kr[10], kr[11]); w.z = pk2(kr[12], kr[13]); w.w = pk2(kr[14], kr[15]); *(CK_LAS u32x4*)(Kr + t * SB + c16 + 8) = w;
        const u32x4* vp = (const u32x4*)(prow + C_TV + h * 64 + c16);
#pragma unroll
        for (int hv = 0; hv < 2; ++hv) { const u32x4 vw = vp[hv];
#pragma unroll
            for (int e2 = 0; e2 < 4; ++e2) { const int e = hv * 8 + 2 * e2; VT[(c16 + e) * SB + t] = (bf16_t)(vw[e2] & 0xffffu); VT[(c16 + e + 1) * SB + t] = (bf16_t)(vw[e2] >> 16); } }
    }
    __syncthreads();
    if (item >= 0) {
        f32x16 st = mm_lds(Kr, Qr, I, J, lane, f32x16{}); const int tt = 32 * J + r;
#pragma unroll
        for (int g = 0; g < 16; ++g) { const int ii = 32 * I + crow(g, hh); st[g] = (ii <= tt) ? st[g] * __builtin_amdgcn_exp2f(lg * (float)(tt - ii)) : 0.f; }
        tile_store_T(Sb, I, J, lane, st);
    }
    __syncthreads();
    if (item >= 0) {
        const f32x16 yi = mm_lds(VT, Sb, I, J, lane, f32x16{}); const f32x16 yc = mm_gA((const bf16_t*)(cw + O_RT) + (size_t)item * 4096, Qr, I, J, lane, f32x16{});
        const int tt = 32 * J + r; const float qd = __builtin_amdgcn_exp2f(lg * (float)(tt + 1));
#pragma unroll
        for (int g = 0; g < 16; ++g) Y[tt * SF + 32 * I + crow(g, hh)] = yi[g] + qd * yc[g];
    }
    __syncthreads();
    if (item >= 0) {
        float y[16]; float s = 0.f;
#pragma unroll
        for (int e = 0; e < 16; ++e) { y[e] = Y[t * SF + c16 + e]; s += y[e]; }
        const float mu = quad_sum(s) * (1.f / 64.f); float s2 = 0.f;
#pragma unroll
        for (int e = 0; e < 16; ++e) { y[e] -= mu; s2 += y[e] * y[e]; }
        const float rstd = 1.0f / sqrtf(quad_sum(s2) * (1.f / 64.f) + 1e-6f);
        const u32x4* gp = (const u32x4*)(prow + C_TG + h * 64 + c16); unsigned ow[8];
#pragma unroll
        for (int hv = 0; hv < 2; ++hv) { const u32x4 gw = gp[hv];
#pragma unroll
            for (int e2 = 0; e2 < 4; ++e2) { const int e = hv * 8 + 2 * e2; const int ch = h * 64 + c16 + e; const float g0 = bflo(gw[e2]), g1 = bfhi(gw[e2]);
                ow[hv * 4 + e2] = pk2(y[e] * rstd * gn_g[ch] * (g0 * sigm(g0)), y[e + 1] * rstd * gn_g[ch + 1] * (g1 * sigm(g1))); } }
        u32x4* dst = (u32x4*)(MIXB + ((size_t)b * SEQ + pos) * 1024 + 768 + h * 64 + c16);
        dst[0] = (u32x4){ow[0], ow[1], ow[2], ow[3]}; dst[1] = (u32x4){ow[4], ow[5], ow[6], ow[7]};
    }
    __syncthreads();
}
__device__ __forceinline__ void ret_level1(int task, unsigned char* __restrict__ cw) {
    const int tid = ltid(), lane = tid & 63, wid = __builtin_amdgcn_readfirstlane(tid >> 6), wq = wid & 3;
    const int h = (task >> 5) & 3; const float lg = __builtin_amdgcn_logf(1.0f - __builtin_amdgcn_exp2f(-5.0f - (float)h)); const float g64 = __builtin_amdgcn_exp2f(lg * 64.0f);
    const bf16_t* kvg = (const bf16_t*)(cw + O_KV) + ((size_t)(task >> 5) * 256 + (size_t)(task & 31) * 8) * 4096;
    f32x16 kv[8];
#pragma unroll
    for (int j = 0; j < 8; ++j) kv[j] = frag_load_bf(kvg + (size_t)j * 4096, wq, lane);
    f32x16 acc = kv[0];
#pragma unroll
    for (int j = 1; j < 8; ++j)
#pragma unroll
        for (int g = 0; g < 16; ++g) acc[g] = acc[g] * g64 + kv[j][g];
    frag_store((float*)(cw + O_KG) + (size_t)task * 4096, wq, lane, acc);
}
__device__ __forceinline__ void ret_scan_groups(int chain, unsigned char* __restrict__ cw) {
    const int tid = ltid(), lane = tid & 63, wid = __builtin_amdgcn_readfirstlane(tid >> 6), wq = wid & 3;
    const int h = chain & 3; const float lg = __builtin_amdgcn_logf(1.0f - __builtin_amdgcn_exp2f(-5.0f - (float)h)); const float g512 = __builtin_amdgcn_exp2f(lg * 512.0f);
    const float* kgg = (const float*)(cw + O_KG) + (size_t)chain * 32 * 4096; float* rgg = (float*)(cw + O_RG) + (size_t)chain * 32 * 4096;
    f32x16 R = f32x16{}; f32x16 nx[4];
#pragma unroll
    for (int k = 0; k < 4; ++k) nx[k] = frag_load(kgg + (size_t)k * 4096, wq, lane);
    for (int c = 0; c < 32; c += 4) {
#pragma unroll
        for (int k = 0; k < 4; ++k) { const int cc = c + k; frag_store(rgg + (size_t)cc * 4096, wq, lane, R);
            const f32x16 kvc = nx[k]; const int nn = cc + 4 < 32 ? cc + 4 : 31; nx[k] = frag_load(kgg + (size_t)nn * 4096, wq, lane);
#pragma unroll
            for (int g = 0; g < 16; ++g) R[g] = R[g] * g512 + kvc[g]; }
    }
}
constexpr int L_RET3G = 5 * B9 + 64 * SF * 4;
__device__ __forceinline__ void ret_stage3g(CK_LAS unsigned char* ldsq, int task, const bf16_t* __restrict__ Pb, int PW, int C_TQ, int C_TK, int C_TV, int C_TG, int SEQ, const float* __restrict__ ROPE,
                                           const float* __restrict__ gn_g, const unsigned char* __restrict__ cw, bf16_t* __restrict__ MIXB) {
    const int tid = ltid(), lane = tid & 63, wid = __builtin_amdgcn_readfirstlane(tid >> 6), wq = wid & 3, I = wq >> 1, J = wq & 1, r = lane & 31, hh = lane >> 5, qtid = tid & 255;
    const lbf Qr = (lbf)ldsq, Kr = (lbf)(ldsq + B9), VT = (lbf)(ldsq + 2 * B9), Sb = (lbf)(ldsq + 3 * B9), RTL = (lbf)(ldsq + 4 * B9); const lf32 Y = (lf32)(ldsq + 5 * B9);
    const int tk = task >= 0 ? task : 0; const int item0 = (tk >> 5) * 256 + (tk & 31) * 8;
    f32x16 R = frag_load((const float*)(cw + O_RG) + (size_t)tk * 4096, wq, lane);
    for (int j = 0; j < 8; ++j) { const int item = task >= 0 ? item0 + j : -1;
    const int b = item >= 0 ? item >> 10 : 0, h = item >= 0 ? (item >> 8) & 3 : 0, c = item >= 0 ? item & 255 : 0; const int t = qtid >> 2, c16 = (qtid & 3) * 16; const int pos = c * 64 + t;
    const float lg = __builtin_amdgcn_logf(1.0f - __builtin_amdgcn_exp2f(-5.0f - (float)h));
    const bf16_t* prow = Pb + ((size_t)b * SEQ + pos) * PW;
    if (item >= 0) {
#pragma unroll
        for (int g_ = 0; g_ < 16; ++g_) RTL[(32 * I + crow(g_, hh)) * SB + 32 * J + r] = (bf16_t)f2bf(R[g_]);
        float qr[16], kr[16]; rot16(qr, prow, C_TQ + h * 64, c16, ROPE + (size_t)pos * 64); rot16(kr, prow, C_TK + h * 64, c16, ROPE + (size_t)pos * 64);
        u32x4 w;
        w.x = pk2(qr[0], qr[1]); w.y = pk2(qr[2], qr[3]); w.z = pk2(qr[4], qr[5]); w.w = pk2(qr[6], qr[7]); *(CK_LAS u32x4*)(Qr + t * SB + c16) = w;
        w.x = pk2(qr[8], qr[9]); w.y = pk2(qr[10], qr[11]); w.z = pk2(qr[12], qr[13]); w.w = pk2(qr[14], qr[15]); *(CK_LAS u32x4*)(Qr + t * SB + c16 + 8) = w;
#pragma unroll
        for (int e = 0; e < 16; ++e) kr[e] *= 0.125f;
        w.x = pk2(kr[0], kr[1]); w.y = pk2(kr[2], kr[3]); w.z = pk2(kr[4], kr[5]); w.w = pk2(kr[6], kr[7]); *(CK_LAS u32x4*)(Kr + t * SB + c16) = w;
        w.x = pk2(kr[8], kr[9]); w.y = pk2(kr[10], kr[11]); w.z = pk2(kr[12], kr[13]); w.w = pk2(kr[14], kr[15]); *(CK_LAS u32x4*)(Kr + t * SB + c16 + 8) = w;
        const u32x4* vp = (const u32x4*)(prow + C_TV + h * 64 + c16);
#pragma unroll
        for (int hv = 0; hv < 2; ++hv) { const u32x4 vw = vp[hv];
#pragma unroll
            for (int e2 = 0; e2 < 4; ++e2) { const int e = hv * 8 + 2 * e2; VT[(c16 + e) * SB + t] = (bf16_t)(vw[e2] & 0xffffu); VT[(c16 + e + 1) * SB + t] = (bf16_t)(vw[e2] >> 16); } }
    }
    __syncthreads();
    if (item >= 0) {
        f32x16 st = mm_lds(Kr, Qr, I, J, lane, f32x16{}); const int tt = 32 * J + r;
#pragma unroll
        for (int g = 0; g < 16; ++g) { const int ii = 32 * I + crow(g, hh); st[g] = (ii <= tt) ? st[g] * __builtin_amdgcn_exp2f(lg * (float)(tt - ii)) : 0.f; }
        tile_store_T(Sb, I, J, lane, st);
    }
    __syncthreads();
    if (item >= 0) {
        const f32x16 yi = mm_lds(VT, Sb, I, J, lane, f32x16{}); const f32x16 yc = mm_lds(RTL, Qr, I, J, lane, f32x16{});
        const int tt = 32 * J + r; const float qd = __builtin_amdgcn_exp2f(lg * (float)(tt + 1));
#pragma unroll
        for (int g = 0; g < 16; ++g) Y[tt * SF + 32 * I + crow(g, hh)] = yi[g] + qd * yc[g];
    }
    __syncthreads();
    if (item >= 0) {
        float y[16]; float s = 0.f;
#pragma unroll
        for (int e = 0; e < 16; ++e) { y[e] = Y[t * SF + c16 + e]; s += y[e]; }
        const float mu = quad_sum(s) * (1.f / 64.f); float s2 = 0.f;
#pragma unroll
        for (int e = 0; e < 16; ++e) { y[e] -= mu; s2 += y[e] * y[e]; }
        const float rstd = 1.0f / sqrtf(quad_sum(s2) * (1.f / 64.f) + 1e-6f);
        const u32x4* gp = (const u32x4*)(prow + C_TG + h * 64 + c16); unsigned ow[8];
#pragma unroll
        for (int hv = 0; hv < 2; ++hv) { const u32x4 gw = gp[hv];
#pragma unroll
            for (int e2 = 0; e2 < 4; ++e2) { const int e = hv * 8 + 2 * e2; const int ch = h * 64 + c16 + e; const float g0 = bflo(gw[e2]), g1 = bfhi(gw[e2]);
                ow[hv * 4 + e2] = pk2(y[e] * rstd * gn_g[ch] * (g0 * sigm(g0)), y[e + 1] * rstd * gn_g[ch + 1] * (g1 * sigm(g1))); } }
        u32x4* dst = (u32x4*)(MIXB + ((size_t)b * SEQ + pos) * 1024 + 768 + h * 64 + c16);
        dst[0] = (u32x4){ow[0], ow[1], ow[2], ow[3]}; dst[1] = (u32x4){ow[4], ow[5], ow[6], ow[7]};
    }
    if (item >= 0) { const f32x16 kvc = frag_load_bf((const bf16_t*)(cw + O_KV) + (size_t)item * 4096, wq, lane); const float g64 = __builtin_amdgcn_exp2f(lg * 64.0f);
#pragma unroll
        for (int g_ = 0; g_ < 16; ++g_) R[g_] = R[g_] * g64 + kvc[g_]; }
    __syncthreads();
    }
}
}

__device__ __forceinline__ void tr_tile(const float* __restrict__ src, size_t ld_src, bf16* __restrict__ dst, size_t ld_dst, float* scr, int lane) {
    pg8::f32x4 v[16];
#pragma unroll
    for (int i = 0; i < 16; ++i) v[i] = *(const pg8::f32x4*)(src + (size_t)(i * 4 + (lane >> 4)) * ld_src + (lane & 15) * 4);
#pragma unroll
    for (int i = 0; i < 16; ++i) { float* p = scr + (i * 4 + (lane >> 4)) * 65 + (lane & 15) * 4; p[0] = v[i][0]; p[1] = v[i][1]; p[2] = v[i][2]; p[3] = v[i][3]; }
    asm volatile("s_waitcnt lgkmcnt(0)" ::: "memory");
#pragma unroll
    for (int i = 0; i < 8; ++i) { const int n = i * 8 + (lane >> 3), kc = (lane & 7) * 8; const float* s = scr + kc * 65 + n;
        pg8::u32x4 o; o.x = pk2(s[0], s[65]); o.y = pk2(s[2 * 65], s[3 * 65]); o.z = pk2(s[4 * 65], s[5 * 65]); o.w = pk2(s[6 * 65], s[7 * 65]);
        *(pg8::u32x4*)(dst + (size_t)n * ld_dst + kc) = o; }
    asm volatile("s_waitcnt lgkmcnt(0)" ::: "memory");
}

constexpr int CV_13 = NE * 16 * 16, CV_2 = NE * 8 * 16, CV_L = CV_13 + CV_2, NCONV = DEPTH * CV_L;
__device__ __forceinline__ void conv_item(int it, const float* __restrict__ w1, const float* __restrict__ w3, const float* __restrict__ w2, bf16* __restrict__ W13, bf16* __restrict__ W2, float* scr, int lane) {
    const int l = it / CV_L; int r = it % CV_L;
    if (r < CV_13) { const int e = r >> 8, kb = (r >> 4) & 15, nb = r & 15;
        const int pn = nb >> 2, q = nb & 3; const float* srcw = (q < 2 ? w1 : w3) + ((size_t)l * NE + e) * DM * DE;
        tr_tile(srcw + (size_t)kb * 64 * DE + pn * 128 + (q & 1) * 64, DE, W13 + ((size_t)l * NE + e) * DM * DM + (size_t)nb * 64 * DM + kb * 64, DM, scr, lane); }
    else { r -= CV_13; const int e = r >> 7, kb = (r >> 4) & 7, nb = r & 15;
        tr_tile(w2 + ((size_t)l * NE + e) * DE * DM + (size_t)kb * 64 * DM + nb * 64, DM, W2 + ((size_t)l * NE + e) * DM * DE + (size_t)nb * 64 * DE + kb * 64, DE, scr, lane); }
}

#define LAS __attribute__((address_space(3)))
#define XB_TMO      128
#define XB_XCNT(j)  (256  + 64 * (j))
#define XB_XSUB(j)  (1280 + 64 * (j))
#define XB_XGEN(j)  (2304 + 64 * (j))
#define XB_TOP      3328
#define XB_TOPGEN   3392
#define XCD_BAR_WORDS 3456
#define XB_SPIN_CAP (1u << 18)

__device__ __forceinline__ unsigned xb_ld(unsigned* p)              { return __hip_atomic_load(p, __ATOMIC_RELAXED, __HIP_MEMORY_SCOPE_AGENT); }
__device__ __forceinline__ unsigned xb_add(unsigned* p, unsigned v) { return __hip_atomic_fetch_add(p, v, __ATOMIC_RELAXED, __HIP_MEMORY_SCOPE_AGENT); }
__device__ __forceinline__ unsigned xb_xcc_id() { return (unsigned)__builtin_amdgcn_s_getreg((3 << 11) | 20) & 0xFu; }
#define XB_SPIN(cond, bar) do { unsigned _sp = 0; while (cond) { __builtin_amdgcn_s_sleep(1); \
    if ((++_sp & 255u) == 0u) { if (xb_ld(&(bar)[XB_TMO])) break; if (_sp > XB_SPIN_CAP) { atomicAdd(&(bar)[XB_TMO], 1u); break; } } } } while (0)

struct XcdBarrier {
    unsigned* bar; unsigned x;
    volatile LAS unsigned* st;
};

__device__ __forceinline__ XcdBarrier xcd_barrier_post(unsigned* bar, volatile LAS unsigned* st) {
    XcdBarrier b; b.bar = bar; b.x = xb_xcc_id(); b.st = st;
    if (ltid() == 0) (void)xb_add(&bar[XB_XCNT(b.x)], 1u);
    return b;
}
__device__ __forceinline__ void xcd_barrier_complete(unsigned* bar, unsigned x, unsigned& nloc, unsigned& nx) {
    const unsigned G = gridDim.x * gridDim.y * gridDim.z;
    unsigned sum, cnt, mine, sp = 0u;
    for (;;) {
        sum = 0u; cnt = 0u; mine = 0u;
#pragma unroll
        for (unsigned j = 0; j < 16; ++j) { const unsigned c = xb_ld(&bar[XB_XCNT(j)]); sum += c; cnt += (c > 0u) ? 1u : 0u; mine = (j == x) ? c : mine; }
        if (sum == G) break;
        __builtin_amdgcn_s_sleep(1);
        if ((++sp & 255u) == 0u) { if (xb_ld(&bar[XB_TMO])) break; if (sp > XB_SPIN_CAP) { atomicAdd(&bar[XB_TMO], 1u); break; } }
    }
    nloc = mine > 0u ? mine : 1u; nx = cnt > 0u ? cnt : 1u;
}

__device__ __forceinline__ void xcd_barrier(const XcdBarrier& b) {
    asm volatile("s_waitcnt vmcnt(0)" ::: "memory");
    __syncthreads();
    if (ltid() == 0) {
        unsigned* bar = b.bar; asm volatile("" : "+s"(bar)); unsigned bx_ = b.x; asm volatile("" : "+s"(bx_));
        __builtin_amdgcn_s_waitcnt(0);
        unsigned nloc = b.st[0], nx = b.st[1];
        if (nloc == 0u) { xcd_barrier_complete(bar, bx_, nloc, nx); b.st[0] = nloc; b.st[1] = nx; }
        const unsigned old = xb_add(&bar[XB_XSUB(bx_)], 1u);
        const unsigned gen = old / nloc;
        if (old + 1u == (gen + 1u) * nloc) {
            __builtin_amdgcn_fence(__ATOMIC_RELEASE, "agent");
            asm volatile("s_waitcnt vmcnt(0)" ::: "memory");
            const unsigned og = xb_add(&bar[XB_TOP], 1u);
            const unsigned tg = og / nx;
            if (og + 1u == (tg + 1u) * nx) xb_add(&bar[XB_TOPGEN], 1u);
            else XB_SPIN(xb_ld(&bar[XB_TOPGEN]) == tg, bar);
            __builtin_amdgcn_fence(__ATOMIC_ACQUIRE, "agent");
            xb_add(&bar[XB_XGEN(bx_)], 1u);
            asm volatile("s_waitcnt vmcnt(0)" ::: "memory");
        } else {
            XB_SPIN(xb_ld(&bar[XB_XGEN(bx_)]) == gen, bar);
            __builtin_amdgcn_fence(__ATOMIC_ACQUIRE, "agent");
            asm volatile("s_waitcnt vmcnt(0)" ::: "memory");
        }
    }
    __syncthreads();
}


__global__ void __launch_bounds__(NTHREADS, 2) mk_fwd(Args args) {
    extern __shared__ __attribute__((aligned(16))) unsigned char lds_raw[];
    float* lds = (float*)lds_raw;
    const int tid = ltid(), lane = tid & 63, wid = __builtin_amdgcn_readfirstlane(tid >> 6);
    const int G = gridDim.x, bx = blockIdx.x;
    unsigned char* ws = args.ws;
    unsigned* ctl = (unsigned*)(ws + WS_CTL);
    float* X = args.out;
    bf16* XB = (bf16*)(ws + WS_XB);
    bf16* Pb = (bf16*)(ws + WS_P);
    bf16* WIN = (bf16*)(ws + WS_WIN); bf16* WOUT = (bf16*)(ws + WS_WOUT); bf16* W13 = (bf16*)(ws + WS_W13); bf16* W2 = (bf16*)(ws + WS_W2);
    float* ROPE = (float*)(ws + WS_ROPE);
    double* LCS = (double*)(ws + WS_LCS); double* TOT = (double*)(ws + WS_TOT);
    float* BE = (float*)(ws + WS_SKIP); float* QN2 = BE + 16 * 256; float* KN2 = QN2 + 16 * 128;
    unsigned char* KA = ws + WS_KA;
    unsigned char* cw = ws + WS_CK; bf16* LWT = (bf16*)(ws + WS_LW);
    int* EP = (int*)(ws + WS_EP); int* DEST = (int*)(ws + WS_DEST);
    float* GATE = (float*)(ws + WS_GATE);
    bf16* MIXB = (bf16*)(ws + WS_MIXB);
    bf16* XP = (bf16*)(ws + WS_XP); bf16* Hb = (bf16*)(ws + WS_H); bf16* YP = (bf16*)(ws + WS_YP); bf16* YO = (bf16*)(ws + WS_YO);
    typedef pg8::f32x4 f32x4;
    volatile LAS unsigned* MISC = (volatile LAS unsigned*)((LAS unsigned char*)lds_raw + LDS_MISC);
    for (int u = tid; u < (LDS_ALL - LDS_MISC) / 4; u += NTHREADS) MISC[u] = 0u;
    __syncthreads();
    XcdBarrier bar = xcd_barrier_post(ctl + CW_BAR, MISC + 8);
#define GRID_BAR() xcd_barrier(bar)

    for (int rep_ = 0; rep_ < REP_P0; ++rep_) {
            const int tid = ltid(), lane = tid & 63, wid = __builtin_amdgcn_readfirstlane(tid >> 6); (void)lane; (void)wid;
        const f32x4* xi = (const f32x4*)args.in[0]; uint2* xb = (uint2*)XB;
        for (size_t i = (size_t)bx * NTHREADS + tid; i < (size_t)T * DM / 4; i += (size_t)G * NTHREADS) { const f32x4 v = xi[i]; xb[i] = make_uint2(pk2(v[0], v[1]), pk2(v[2], v[3])); }
        for (int i = bx * NTHREADS + tid; i < SEQ * 32; i += G * NTHREADS) {
            const int pos = i >> 5, f = i & 31;
            const double inv = pow(10000.0, -(double)f / 32.0);
            const double ang = (double)pos * inv;
            ROPE[2 * i] = (float)cos(ang); ROPE[2 * i + 1] = (float)sin(ang);
        }
        { bf16* WR = (bf16*)(ws + WS_WR);
          for (int i = bx * NTHREADS + tid; i < DEPTH * 48 * 1024; i += G * NTHREADS) { const int l_ = i / (48 * 1024), o = (i / 1024) % 48, k = i & 1023;
              const float wv = o < 4 ? args.in[21][((size_t)l_ * DM + k) * 4 + o] : (o < 36 ? args.in[23][((size_t)l_ * DM + k) * 32 + (o - 4)] : 0.f);
              const unsigned hi_ = f2bf(wv); const unsigned lo_ = f2bf(wv - bf2f((unsigned short)hi_));
              WR[((size_t)l_ * 2 + 0) * 48 * 1024 + o * 1024 + k] = (bf16)hi_; WR[((size_t)l_ * 2 + 1) * 48 * 1024 + o * 1024 + k] = (bf16)lo_; } }
        for (int i = bx * NTHREADS + tid; i < DEPTH * 256 * 256; i += G * NTHREADS) {
            const int l = i >> 16, rem = i & 65535, chg = rem >> 8, ii = rem & 255;
            if (ii < 64) LWT[((size_t)l * 256 + chg) * 64 + ii] = (bf16)f2bf(args.in[6][((size_t)l * 64 + ii) * 256 + chg]);
            else if (ii < 128) LWT[(size_t)DEPTH * 256 * 64 + ((size_t)l * 256 + chg) * 64 + (ii - 64)] = (bf16)f2bf(args.in[8][((size_t)l * 64 + (ii - 64)) * 256 + chg]);
            else LWT[(size_t)2 * DEPTH * 256 * 64 + ((size_t)l * 256 + chg) * 128 + (ii - 128)] = (bf16)f2bf(args.in[9][((size_t)l * 128 + (ii - 128)) * 256 + chg]);
        }
        float* scr = lds + wid * (64 * 65);
        constexpr int I_IN = 16 * 56, I_OUT = 16 * 16, I_L = I_IN + I_OUT;
        for (int it = bx * 8 + wid; it < DEPTH * I_L; it += G * 8) {
            const int l = it / I_L; int r = it % I_L;
            if (r < I_IN) { const int kb = r / 56, nb = r % 56; const int nsrc = nb * 64 + (nb >= 24 ? 8 : 0);
                tr_tile(args.in[1] + (size_t)l * DM * INW + (size_t)kb * 64 * INW + nsrc, INW, WIN + (size_t)l * PW * DM + (size_t)nb * 64 * DM + kb * 64, DM, scr, lane); }
            else { r -= I_IN; const int kb = r / 16, nb = r % 16;
                tr_tile(args.in[16] + (size_t)l * DM * DM + (size_t)kb * 64 * DM + nb * 64, DM, WOUT + (size_t)l * DM * DM + (size_t)nb * 64 * DM + kb * 64, DM, scr, lane); }
        }
        __syncthreads();
        {
            const float* wf = args.in[1] + O_FF; const float* fbias = args.in[2];
            float w[8][16];
#pragma unroll
            for (int jq = 0; jq < 4; ++jq)
#pragma unroll
                for (int e = 0; e < 4; ++e)
#pragma unroll
                    for (int h = 0; h < 8; ++h) w[h][jq * 4 + e] = wf[(size_t)(jq * 256 + lane * 4 + e) * INW + h];
            float* ffl = lds;
            for (int ch = bx; ch < T / 128; ch += G) {
                __syncthreads();
                for (int i = 0; i < 16; ++i) { const int tl = wid * 16 + i; const size_t m = (size_t)ch * 128 + tl;
                    float acc[8];
#pragma unroll
                    for (int h = 0; h < 8; ++h) acc[h] = 0.f;
#pragma unroll
                    for (int jq = 0; jq < 4; ++jq) { const f32x4 xv = *(const f32x4*)(args.in[0] + m * DM + jq * 256 + lane * 4);
#pragma unroll
                        for (int e = 0; e < 4; ++e)
#pragma unroll
                            for (int h = 0; h < 8; ++h) acc[h] += xv[e] * w[h][jq * 4 + e]; }
#pragma unroll
                    for (int h = 0; h < 8; ++h) acc[h] = wave_sum(acc[h]);
                    if (lane < 8) { float v = acc[0];
#pragma unroll
                        for (int h = 1; h < 8; ++h) v = (lane == h) ? acc[h] : v;
                        ffl[tl * 8 + lane] = v + fbias[lane]; } }
                __syncthreads();
                {
                    const int h = wid; const int bb = (ch * 128) / SEQ, t0 = (ch * 128) % SEQ; double carry = 0.0;
#pragma unroll
                    for (int half = 0; half < 2; ++half) { double v = (double)logsigmoidf_(ffl[(half * 64 + lane) * 8 + h]);
#pragma unroll
                        for (int o = 1; o < 64; o <<= 1) { const double n = __shfl_up(v, o); if (lane >= o) v += n; }
                        v += carry; LCS[(size_t)(bb * 8 + h) * SEQ + t0 + half * 64 + lane] = v; carry = __shfl(v, 63); }
                    if (lane == 0) TOT[(bb * 8 + h) * 128 + t0 / 128] = carry;
                }
            }
            __syncthreads();
        }
    }
    GRID_BAR();

    for (int l = 0; l < DEPTH; ++l) {
        for (int rep_ = 0; rep_ < REP_A; ++rep_) {
            const int tid = ltid(), lane = tid & 63, wid = __builtin_amdgcn_readfirstlane(tid >> 6); (void)lane; (void)wid;
            pg8::Gemm g{XB, WIN + (size_t)l * PW * DM, T, PW, DM}; pg8::StaticOrder S; S.init(T, PW, G, bx);
            pg8::EpiInProj E{Pb, PW, QC2};
            pg8::gemm_phase<pg8::EpiInProj, pg8::StaticOrder, true, true>((PG8_LAS unsigned char*)lds_raw, g, S, E);
        }
        GRID_BAR();
        for (int rep_ = 0; rep_ < REP_C; ++rep_) {
            const int tid = ltid(), lane = tid & 63, wid = __builtin_amdgcn_readfirstlane(tid >> 6); (void)lane; (void)wid;
            for (int ch = bx; ch < T / 128; ch += G) {
                const int h = wid; const int bb = (ch * 128) / SEQ, t0 = (ch * 128) % SEQ, ci = t0 / 128;
                double pre = 0.0;
                { const double* tp = TOT + (bb * 8 + h) * 128; double a = (lane < ci) ? tp[lane] : 0.0; a += (lane + 64 < ci) ? tp[lane + 64] : 0.0;
#pragma unroll
                  for (int o = 1; o < 64; o <<= 1) a += __shfl_xor(a, o);
                  pre = a; }
#pragma unroll
                for (int half = 0; half < 2; ++half) { const int t = t0 + half * 64 + lane; const double v = pre + LCS[(size_t)(bb * 8 + h) * SEQ + t];
                    const double bd = -v * 1.4426950408889634; const unsigned h_ = f2bf((float)bd); const double r1 = bd - (double)bf2f((unsigned short)h_);
                    const unsigned m_ = f2bf((float)r1); const double r2 = r1 - (double)bf2f((unsigned short)m_); const unsigned l_ = f2bf((float)r2);
                    *(pg8::u32x4*)(KA + ((size_t)(bb * 8 + h) * SEQ + t) * 16) = (pg8::u32x4){h_ | (m_ << 16), l_ | (0x3f80u << 16), 0x3f803f80u, 0u};
                    if (lane == 63) BE[(bb * 8 + h) * 256 + t / 64] = (float)bd; }
                { LAS unsigned* nrm = (LAS unsigned*)lds_raw;
                  __syncthreads();
                  if (tid < 16) nrm[tid] = 0u;
                  __syncthreads();
                  const int tl = tid >> 2, part = tid & 3; const bf16* prow = Pb + ((size_t)ch * 128 + tl) * PW;
#pragma unroll
                  for (int hq = 0; hq < 2; ++hq) { const int hd = part * 2 + hq;
#pragma unroll
                      for (int qk = 0; qk < 2; ++qk) { const pg8::u32x4* vp = (const pg8::u32x4*)(prow + (qk ? C_FK : C_FQ) + hd * 64); float ss = 0.f;
#pragma unroll
                          for (int v8 = 0; v8 < 8; ++v8) { const pg8::u32x4 wv = vp[v8];
#pragma unroll
                              for (int e = 0; e < 4; ++e) { const float lo_ = __builtin_bit_cast(float, wv[e] << 16), hi_ = __builtin_bit_cast(float, wv[e] & 0xffff0000u); ss += lo_ * lo_ + hi_ * hi_; } }
                          atomicMax((unsigned*)(nrm + qk * 8 + hd), __float_as_uint(ss)); } }
                  __syncthreads();
                  if (tid < 16) { const int hd = tid & 7; ((tid < 8) ? QN2 : KN2)[(bb * 8 + hd) * 128 + ci] = __uint_as_float(nrm[tid]); }
                }
            }
            __syncthreads();
            const ck::RwkvParams rp{args.in[3] + l * 768, args.in[4] + l * 256, args.in[5] + l * 256, args.in[7] + l * 256, args.in[10] + l * 256, args.in[11] + l * 256, args.in[12] + l * 256,
                                    args.in[13] + l * 256, args.in[14] + l * 256, args.in[15] + l * 256,
                                    LWT + (size_t)l * 256 * 64, LWT + (size_t)DEPTH * 256 * 64 + (size_t)l * 256 * 64, LWT + (size_t)2 * DEPTH * 256 * 64 + (size_t)l * 256 * 128};
#ifndef REP_S1
#define REP_S1 1
#endif
#ifndef REP_R1
#define REP_R1 1
#endif
            for (int rr_ = 0; rr_ < REP_S1; ++rr_)
            for (int it = bx; it < 2048; it += G) ck::rwkv_stage1((CK_LAS unsigned char*)lds_raw, it, Pb, PW, C_RR, C_RK, C_RV, C_WD, SEQ, rp, cw);
            { const int quad = wid >> 2;
              for (int rr_ = 0; rr_ < REP_R1; ++rr_)
              for (int i0 = bx * 2; i0 < 2048; i0 += G * 2) ck::ret_stage1((CK_LAS unsigned char*)lds_raw + quad * 2 * ck::B9, i0 + quad, Pb, PW, C_TK, C_TV, SEQ, ROPE, cw); }
        }
        GRID_BAR();
        {
            const int tid = ltid(), lane = tid & 63, wid = __builtin_amdgcn_readfirstlane(tid >> 6); (void)lane; (void)wid;
            const int quad = wid >> 2;
#ifndef REP_S
#define REP_S 1
#endif
            for (int rep_ = 0; rep_ < REP_S; ++rep_) {
            if (bx < 128) {
                ck::rwkv_level1((CK_LAS unsigned char*)lds_raw, 2 * bx + quad, cw);
                asm volatile("s_waitcnt vmcnt(0)" ::: "memory"); __syncthreads();
                if (tid == 0) { __builtin_amdgcn_fence(__ATOMIC_RELEASE, "agent"); asm volatile("s_waitcnt vmcnt(0)" ::: "memory");
                                __hip_atomic_fetch_add(ctl + CW_L1 + 64 * (16 * l + (bx >> 4)), 2u, __ATOMIC_RELAXED, __HIP_MEMORY_SCOPE_AGENT); }
            }
            if (bx >= 128) {
                ck::ret_level1(2 * (bx - 128) + quad, cw);
                asm volatile("s_waitcnt vmcnt(0)" ::: "memory"); __syncthreads();
                if (tid == 0) { __builtin_amdgcn_fence(__ATOMIC_RELEASE, "agent"); asm volatile("s_waitcnt vmcnt(0)" ::: "memory");
                                __hip_atomic_fetch_add(ctl + CW_L1 + 64 * (16 * l + 8 + ((bx - 128) >> 4)), 2u, __ATOMIC_RELAXED, __HIP_MEMORY_SCOPE_AGENT); }
            }
            if (bx < 8) {
                if (wid == 0) { unsigned spins = 0;
                    while (__hip_atomic_load(ctl + CW_L1 + 64 * (16 * l + bx), __ATOMIC_RELAXED, __HIP_MEMORY_SCOPE_AGENT) < 32u) { if (++spins > (1u << 22)) break; __builtin_amdgcn_s_sleep(2); }
                    __builtin_amdgcn_fence(__ATOMIC_ACQUIRE, "agent"); asm volatile("s_waitcnt vmcnt(0)" ::: "memory"); }
                __syncthreads();
                ck::rwkv_scan<32>((CK_LAS unsigned char*)lds_raw, quad == 0 ? bx : -1, (const ck::bf16_t*)(cw + ck::O_PG), (const ck::bf16_t*)(cw + ck::O_QG), (ck::bf16_t*)(cw + ck::O_HG));
            }
            else if (bx < 16) {
                if (wid == 0) { unsigned spins = 0;
                    while (__hip_atomic_load(ctl + CW_L1 + 64 * (16 * l + bx), __ATOMIC_RELAXED, __HIP_MEMORY_SCOPE_AGENT) < 32u) { if (++spins > (1u << 22)) break; __builtin_amdgcn_s_sleep(2); }
                    __builtin_amdgcn_fence(__ATOMIC_ACQUIRE, "agent"); asm volatile("s_waitcnt vmcnt(0)" ::: "memory"); }
                __syncthreads();
                if (quad == 0) ck::ret_scan_groups(bx - 8, cw);
            }
            if (bx < 16) {
                asm volatile("s_waitcnt vmcnt(0)" ::: "memory"); __syncthreads();
                if (tid == 0) { __builtin_amdgcn_fence(__ATOMIC_RELEASE, "agent"); asm volatile("s_waitcnt vmcnt(0)" ::: "memory");
                                __hip_atomic_store(ctl + CW_SF + 64 * (16 * l + bx), 1u, __ATOMIC_RELAXED, __HIP_MEMORY_SCOPE_AGENT); }
            }
            }
            __syncthreads();
            const attn_body::AttnTensors AT{(const attn_body::bf16*)(Pb + C_FQ), (const attn_body::bf16*)(Pb + C_FK), (const attn_body::bf16*)(Pb + C_FV), (attn_body::bf16*)MIXB, KA};
            bool cvdone = false;
#ifndef REP_D
#define REP_D 1
#endif
            for (int rd_ = 0; rd_ < REP_D; ++rd_)
            for (int gtry = 0; gtry < 8; ++gtry) {
                const int grp = (bx + gtry) & 7; unsigned* qh = ctl + (rd_ ? 20480 : CW_Q) + 64 * (8 * l + grp);
                for (;;) {
                    if (tid == 0) MISC[16] = atomicAdd(qh, 1u);
                    __syncthreads();
                    const unsigned idx = MISC[16];
                    if (idx >= 128u) { __syncthreads(); break; }
                    const int qb = 63 - (int)(idx >> 1), bh = 2 * grp + (int)(idx & 1);
                    if (wid == 0) {
                        const float qn2 = fmaxf(QN2[bh * 128 + 2 * qb], QN2[bh * 128 + 2 * qb + 1]);
                        float kn2 = fmaxf(lane <= 2 * qb + 1 ? KN2[bh * 128 + lane] : 0.f, lane + 64 <= 2 * qb + 1 ? KN2[bh * 128 + 64 + lane] : 0.f);
#pragma unroll
                        for (int o = 1; o < 64; o <<= 1) kn2 = fmaxf(kn2, __shfl_xor(kn2, o));
                        const float bound = 2.002f * sqrtf(qn2 * kn2) + 40.0f; const int ntq = 4 * qb;
                        const float bref = ntq > 0 ? BE[bh * 256 + ntq - 1] : 0.f;
                        int nsk = 0;
#pragma unroll
                        for (int q4 = 0; q4 < 4; ++q4) { const int tt = q4 * 64 + lane; const bool sk = tt < ntq && (bref - BE[bh * 256 + tt]) > bound; nsk += __popcll(__ballot(sk)); }
                        if (lane == 0) MISC[17] = (unsigned)(nsk & ~1);
                    }
                    __syncthreads();
                    const int t0 = (int)MISC[17];
                    attn_body::attn_unit<8>(bh / attn_body::NHEAD, bh % attn_body::NHEAD, qb, t0, AT.Q, AT.K, AT.V, AT.O, AT.KA, (char*)lds_raw);
                    if (!cvdone) {
                        if (tid == 0) MISC[18] = atomicAdd(ctl + CW_CV, 16u);
                        __syncthreads();
                        const int tk = (int)MISC[18];
                        if (tk >= NCONV) cvdone = true;
                        else { const int t2 = ltid(), lane2 = t2 & 63, wid2 = __builtin_amdgcn_readfirstlane(t2 >> 6);
                            float* scr = lds + wid2 * (64 * 65);
                            _Pragma("clang loop unroll(disable)") for (int q2 = 0; q2 < 2; ++q2) { const int itc = tk + 8 * q2 + wid2; if (itc < NCONV) conv_item(itc, args.in[25], args.in[26], args.in[27], W13, W2, scr, lane2); } }
                        __syncthreads();
                    }
                }
            }
        }
        {
            const int tid = ltid(), lane = tid & 63, wid = __builtin_amdgcn_readfirstlane(tid >> 6); (void)lane; (void)wid;
            __syncthreads();
            if (wid == 0) {
                unsigned spins = 0;
                for (;;) { const unsigned f = lane < 16 ? __hip_atomic_load(ctl + CW_SF + 64 * (16 * l + lane), __ATOMIC_RELAXED, __HIP_MEMORY_SCOPE_AGENT) : 1u;
                    if (__all(f != 0u)) break; if (++spins > (1u << 22)) break; __builtin_amdgcn_s_sleep(2); }
                __builtin_amdgcn_fence(__ATOMIC_ACQUIRE, "agent"); asm volatile("s_waitcnt vmcnt(0)" ::: "memory");
            }
            __syncthreads();
            const ck::RwkvParams rp{args.in[3] + l * 768, args.in[4] + l * 256, args.in[5] + l * 256, args.in[7] + l * 256, args.in[10] + l * 256, args.in[11] + l * 256, args.in[12] + l * 256,
                                    args.in[13] + l * 256, args.in[14] + l * 256, args.in[15] + l * 256, nullptr, nullptr, nullptr};
            const int quad = wid >> 2;
            for (;;) {
                if (tid == 0) MISC[16] = atomicAdd(ctl + CW_EQ + 64 * l, 1u);
                __syncthreads();
                const int p = (int)MISC[16];
                __syncthreads();
                if (p >= 128 + 128) break;
                if (p < 128) ck::rwkv_stage3g((CK_LAS unsigned char*)lds_raw + quad * ck::L_RW3, 2 * p + quad, rp, cw, MIXB, SEQ);
                else ck::ret_stage3g((CK_LAS unsigned char*)lds_raw + quad * ck::L_RET3G, 2 * (p - 128) + quad, Pb, PW, C_TQ, C_TK, C_TV, C_TG, SEQ, ROPE, args.in[15] + l * 256, cw, MIXB);
            }
        }
        GRID_BAR();
        for (int rep_ = 0; rep_ < REP_F; ++rep_) {
            const int tid = ltid(), lane = tid & 63, wid = __builtin_amdgcn_readfirstlane(tid >> 6); (void)lane; (void)wid;
            pg8::Gemm g{MIXB, WOUT + (size_t)l * DM * DM, T, DM, DM}; pg8::StaticOrder S; S.init(T, DM, G, bx);
            pg8::EpiInProj E{YO, DM, 1.0f};
            pg8::gemm_phase<pg8::EpiInProj, pg8::StaticOrder, true, true>((PG8_LAS unsigned char*)lds_raw, g, S, E);
        }
        GRID_BAR();
        {
            const int tid = ltid(), lane = tid & 63, wid = __builtin_amdgcn_readfirstlane(tid >> 6); (void)lane; (void)wid;
            const float* g1 = args.in[17] + l * DM; const float* b1 = args.in[18] + l * DM;
            const float* bg = args.in[22] + l * 4; const float* be = args.in[24] + l * 32;
            unsigned* cnt = ctl + CW_CNT + 64 * 32 * l;
            const bf16* WRh = (const bf16*)(ws + WS_WR) + (size_t)l * 2 * 48 * 1024; const bf16* WRl = WRh + 48 * 1024;
            constexpr int XS = 1032;
            LAS unsigned short* XT = (LAS unsigned short*)lds_raw;
            LAS float* PART = (LAS float*)((LAS unsigned char*)lds_raw + 32 * XS * 2);
            LAS float* LG = PART + 8 * 32 * 48;
            LAS unsigned* LCNT = (LAS unsigned*)(LG + 128 * 48);
            if (tid < 32) LCNT[tid] = 0u;
            pg8::bf16x8 wh[4][3], wl[4][3];
#pragma unroll
            for (int s_ = 0; s_ < 4; ++s_)
#pragma unroll
                for (int nt = 0; nt < 3; ++nt) { const size_t o = (size_t)(16 * nt + (lane & 15)) * 1024 + 128 * wid + 32 * s_ + 8 * (lane >> 4);
                    wh[s_][nt] = *(const pg8::bf16x8*)(WRh + o); wl[s_][nt] = *(const pg8::bf16x8*)(WRl + o); }
            float gg[16], bb[16];
#pragma unroll
            for (int jq = 0; jq < 4; ++jq) { const f32x4 gv = *(const f32x4*)(g1 + jq * 256 + lane * 4), bv = *(const f32x4*)(b1 + jq * 256 + lane * 4);
#pragma unroll
                for (int e = 0; e < 4; ++e) { gg[jq * 4 + e] = gv[e]; bb[jq * 4 + e] = bv[e]; } }
            for (int ch = bx; ch < T / 128; ch += G) {
                for (int blk = 0; blk < 4; ++blk) {
                    const size_t m0 = (size_t)ch * 128 + blk * 32;
                    uint2 xw[4][4], yw[4][4];
#pragma unroll
                    for (int i = 0; i < 4; ++i) { const size_t m = m0 + wid * 4 + i;
#pragma unroll
                        for (int jq = 0; jq < 4; ++jq) { xw[i][jq] = *(const uint2*)(XB + m * DM + jq * 256 + lane * 4); yw[i][jq] = *(const uint2*)(YO + m * DM + jq * 256 + lane * 4); } }
#pragma unroll
                    for (int i = 0; i < 4; ++i) { const int tl = wid * 4 + i; const size_t m = m0 + tl;
                        float v[16]; float sm = 0.f;
#pragma unroll
                        for (int jq = 0; jq < 4; ++jq) { const uint2 a_ = xw[i][jq], c_ = yw[i][jq];
                            const f32x4 xv = (f32x4){__builtin_bit_cast(float, a_.x << 16), __builtin_bit_cast(float, a_.x & 0xffff0000u), __builtin_bit_cast(float, a_.y << 16), __builtin_bit_cast(float, a_.y & 0xffff0000u)};
                            const f32x4 yv = (f32x4){__builtin_bit_cast(float, c_.x << 16), __builtin_bit_cast(float, c_.x & 0xffff0000u), __builtin_bit_cast(float, c_.y << 16), __builtin_bit_cast(float, c_.y & 0xffff0000u)};
#pragma unroll
                            for (int e = 0; e < 4; ++e) { v[jq * 4 + e] = ALPHA * xv[e] + yv[e]; sm += v[jq * 4 + e]; } }
                        const float mean = wave_sum(sm) * (1.f / DM); float s2 = 0.f;
#pragma unroll
                        for (int q = 0; q < 16; ++q) { v[q] -= mean; s2 += v[q] * v[q]; }
                        const float rstd = 1.0f / sqrtf(wave_sum(s2) * (1.f / DM) + LN_EPS);
#pragma unroll
                        for (int jq = 0; jq < 4; ++jq) { unsigned hw[4];
#pragma unroll
                            for (int e = 0; e < 4; ++e) hw[e] = f2bf(v[jq * 4 + e] * rstd * gg[jq * 4 + e] + bb[jq * 4 + e]);
                            const ck::u32x2 pw = (ck::u32x2){hw[0] | (hw[1] << 16), hw[2] | (hw[3] << 16)};
                            *(uint2*)(XB + m * DM + jq * 256 + lane * 4) = make_uint2(pw.x, pw.y);
                            *(LAS ck::u32x2*)(XT + tl * XS + jq * 256 + lane * 4) = pw; }
                    }
                    __syncthreads();
                    {
                        pg8::f32x4 acc[2][3];
#pragma unroll
                        for (int mt = 0; mt < 2; ++mt)
#pragma unroll
                            for (int nt = 0; nt < 3; ++nt) acc[mt][nt] = pg8::f32x4{0.f, 0.f, 0.f, 0.f};
#pragma unroll
                        for (int s_ = 0; s_ < 4; ++s_)
#pragma unroll
                            for (int mt = 0; mt < 2; ++mt) { const pg8::bf16x8 ax = *(const LAS pg8::bf16x8*)(XT + (16 * mt + (lane & 15)) * XS + 128 * wid + 32 * s_ + 8 * (lane >> 4));
#pragma unroll
                                for (int nt = 0; nt < 3; ++nt) { acc[mt][nt] = __builtin_amdgcn_mfma_f32_16x16x32_bf16(ax, wh[s_][nt], acc[mt][nt], 0, 0, 0); acc[mt][nt] = __builtin_amdgcn_mfma_f32_16x16x32_bf16(ax, wl[s_][nt], acc[mt][nt], 0, 0, 0); } }
#pragma unroll
                        for (int mt = 0; mt < 2; ++mt)
#pragma unroll
                            for (int nt = 0; nt < 3; ++nt)
#pragma unroll
                                for (int r_ = 0; r_ < 4; ++r_) PART[(wid * 32 + 16 * mt + 4 * (lane >> 4) + r_) * 48 + 16 * nt + (lane & 15)] = acc[mt][nt][r_];
                    }
                    __syncthreads();
                    for (int p_ = tid; p_ < 32 * 48; p_ += NTHREADS) { float a_ = 0.f;
#pragma unroll
                        for (int w_ = 0; w_ < 8; ++w_) a_ += PART[w_ * 32 * 48 + p_];
                        LG[blk * 32 * 48 + p_] = a_; }
                }
                __syncthreads();
                int ex0 = 0, ex1 = 0; unsigned lp0 = 0, lp1 = 0;
                if (tid < 128) { const LAS float* lg = LG + tid * 48; const size_t m = (size_t)ch * 128 + tid;
                    int grp = 0; float gbest = lg[0] + bg[0];
#pragma unroll
                    for (int o = 1; o < 4; ++o) { const float gv = lg[o] + bg[o]; if (gv > gbest) { gbest = gv; grp = o; } }
                    float den = 0.f;
#pragma unroll
                    for (int o = 0; o < 4; ++o) den += expf(lg[o] + bg[o] - gbest);
                    const float ggate = 1.0f / den;
                    int i0 = 0; float v0 = lg[4 + grp * 8] + be[grp * 8];
                    for (int o = 1; o < 8; ++o) { const float ev = lg[4 + grp * 8 + o] + be[grp * 8 + o]; if (ev > v0) { v0 = ev; i0 = o; } }
                    int i1 = -1; float v1 = -INFINITY;
                    for (int o = 0; o < 8; ++o) { const float ev = lg[4 + grp * 8 + o] + be[grp * 8 + o]; if (o != i0 && (i1 < 0 || ev > v1)) { v1 = ev; i1 = o; } }
                    const float e1 = expf(v1 - v0); const float p0 = 1.0f / (1.0f + e1), p1 = e1 / (1.0f + e1);
                    ex0 = grp * 8 + i0; ex1 = grp * 8 + i1;
                    lp0 = atomicAdd((unsigned*)(LCNT + ex0), 1u); lp1 = atomicAdd((unsigned*)(LCNT + ex1), 1u);
                    GATE[2 * m] = ggate * p0; GATE[2 * m + 1] = ggate * p1;
                }
                __syncthreads();
                if (tid < 32) { const unsigned c_ = LCNT[tid]; LCNT[32 + tid] = c_ ? atomicAdd(cnt + 64 * tid, c_) : 0u; }
                __syncthreads();
                if (tid < 128) { const size_t m = (size_t)ch * 128 + tid; EP[2 * m] = (ex0 << 16) | (int)(LCNT[32 + ex0] + lp0); EP[2 * m + 1] = (ex1 << 16) | (int)(LCNT[32 + ex1] + lp1); }
                __syncthreads();
                if (tid < 32) LCNT[tid] = 0u;
            }
        }
        GRID_BAR();
        for (int rep_ = 0; rep_ < REP_H; ++rep_) {
            const int tid = ltid(), lane = tid & 63, wid = __builtin_amdgcn_readfirstlane(tid >> 6); (void)lane; (void)wid;
            {
                const int endl = (l + 1) * CV_L;
                for (;;) { if (tid == 0) MISC[18] = atomicAdd(ctl + CW_CV, 8u);
                    __syncthreads();
                    const int tk = (int)MISC[18];
                    if (tk + wid < NCONV) conv_item(tk + wid, args.in[25], args.in[26], args.in[27], W13, W2, lds + wid * (64 * 65), lane);
                    __syncthreads();
                    if (tk + 8 >= endl) break; }
            }
            __syncthreads();
            unsigned* cnt = ctl + CW_CNT + 64 * 32 * l;
            int* poff = (int*)lds;
            if (tid == 0) { int acc = 0; for (int e = 0; e < NE; ++e) { poff[e] = acc; acc += (((int)cnt[64 * e] + 255) >> 8) << 8; } poff[NE] = acc; }
            __syncthreads();
            for (int m = bx * 8 + wid; m < T; m += G * 8) {
                uint2 w[4];
    #pragma unroll
                for (int jq = 0; jq < 4; ++jq) w[jq] = *(const uint2*)(XB + (size_t)m * DM + jq * 256 + lane * 4);
    #pragma unroll
                for (int k = 0; k < 2; ++k) { const int ep = EP[2 * m + k]; const int dest = poff[ep >> 16] + (ep & 0xffff);
    #pragma unroll
                    for (int jq = 0; jq < 4; ++jq) *(uint2*)(XP + (size_t)dest * DM + jq * 256 + lane * 4) = w[jq];
                    if (lane == 0) DEST[2 * m + k] = dest; }
            }
        }
        GRID_BAR();
        for (int rep_ = 0; rep_ < REP_IJ; ++rep_) {
            const int tid = ltid(), lane = tid & 63, wid = __builtin_amdgcn_readfirstlane(tid >> 6); (void)lane; (void)wid;
            unsigned* cnt = ctl + CW_CNT + 64 * 32 * l;
            PG8_LAS int* tile_e = (PG8_LAS int*)((PG8_LAS unsigned char*)lds_raw + 131072); PG8_LAS int* tst = tile_e + MAXTILES;
            __syncthreads();
            if (tid == 0) { int acc = 0; for (int e = 0; e < NE; ++e) { tst[e] = acc; acc += ((int)cnt[64 * e] + 255) >> 8; } tst[NE] = acc; }
            __syncthreads();
            const int ntile = tst[NE];
            if (tid < ntile) { int e = 0; while (tst[e + 1] <= tid) ++e; tile_e[tid] = e; }
            __syncthreads();
            pg8::MoeOrder S{ntile, G, bx, tile_e};
            { pg8::Gemm g{XP, W13 + (size_t)l * NE * DM * DM, ntile * 256, DM, DM}; pg8::EpiSwiGlu E{Hb, DE};
              pg8::gemm_phase<pg8::EpiSwiGlu, pg8::MoeOrder, true, true>((PG8_LAS unsigned char*)lds_raw, g, S, E); }
            GRID_BAR();
            { pg8::Gemm g{Hb, W2 + (size_t)l * NE * DM * DE, ntile * 256, DM, DE}; pg8::EpiInProj E{YP, DM, 1.0f};
              pg8::gemm_phase<pg8::EpiInProj, pg8::MoeOrder, true, true>((PG8_LAS unsigned char*)lds_raw, g, S, E); }
        }
        GRID_BAR();
        for (int rep_ = 0; rep_ < REP_K; ++rep_) { float* Xo = (rep_ == REP_K - 1) ? X : (float*)(ws + WS_XP); bf16* XBo = (rep_ == REP_K - 1) ? XB : (bf16*)(ws + WS_H);
            const int tid = ltid(), lane = tid & 63, wid = __builtin_amdgcn_readfirstlane(tid >> 6); (void)lane; (void)wid;
            const float* g2 = args.in[19] + l * DM; const float* b2 = args.in[20] + l * DM;
            const bool doff = (l + 1 < DEPTH); const int ln = doff ? l + 1 : l;
            const float* wf = args.in[1] + (size_t)ln * DM * INW + O_FF; const float* fbias = args.in[2] + ln * 8;
            LAS f32x4* W4 = (LAS f32x4*)((LAS unsigned char*)lds_raw + 4096);
            __syncthreads();
            for (int q = tid; q < 40 * 64; q += NTHREADS) { const int row = q >> 6, ln_ = q & 63; f32x4 val;
                if (row < 32) { const int h = row >> 2, jq = row & 3;
#pragma unroll
                    for (int e = 0; e < 4; ++e) val[e] = wf[(size_t)(jq * 256 + ln_ * 4 + e) * INW + h]; }
                else if (row < 36) val = *(const f32x4*)(g2 + (row - 32) * 256 + ln_ * 4);
                else val = *(const f32x4*)(b2 + (row - 36) * 256 + ln_ * 4);
                W4[q] = val; }
            float* ffl = lds;
            for (int ch = bx; ch < T / 128; ch += G) {
                __syncthreads();
                const size_t mw = (size_t)ch * 128 + wid * 16;
                const int dA = lane < 16 ? DEST[2 * (mw + lane)] : 0, dB = lane < 16 ? DEST[2 * (mw + lane) + 1] : 0;
                const float gA = lane < 16 ? GATE[2 * (mw + lane)] : 0.f, gB = lane < 16 ? GATE[2 * (mw + lane) + 1] : 0.f;
                f32x4 xA[2][4], xB[2][4]; uint2 aA[2][4], aB[2][4], bA[2][4], bB[2][4]; float gA2[2][2], gB2[2][2];
#define K_LOAD(XS, WAS, WBS, GS, IEXP) _Pragma("unroll")                     for (int u = 0; u < 2; ++u) { const size_t m = mw + IEXP + u;                         const size_t da = (size_t)__builtin_amdgcn_readlane(dA, IEXP + u), db = (size_t)__builtin_amdgcn_readlane(dB, IEXP + u);                         GS[u][0] = __builtin_bit_cast(float, __builtin_amdgcn_readlane(__builtin_bit_cast(int, gA), IEXP + u)); GS[u][1] = __builtin_bit_cast(float, __builtin_amdgcn_readlane(__builtin_bit_cast(int, gB), IEXP + u)); _Pragma("unroll")                         for (int jq = 0; jq < 4; ++jq) { { const uint2 xw_ = *(const uint2*)(XB + m * DM + jq * 256 + lane * 4); XS[u][jq] = (f32x4){__builtin_bit_cast(float, xw_.x << 16), __builtin_bit_cast(float, xw_.x & 0xffff0000u), __builtin_bit_cast(float, xw_.y << 16), __builtin_bit_cast(float, xw_.y & 0xffff0000u)}; }                             WAS[u][jq] = *(const uint2*)(YP + da * DM + jq * 256 + lane * 4); WBS[u][jq] = *(const uint2*)(YP + db * DM + jq * 256 + lane * 4); } }
                { const int i = 0; K_LOAD(xA, aA, bA, gA2, i); }
                for (int i = 0; i < 16; i += 4) {
                    { const int i1 = i + 2; K_LOAD(xB, aB, bB, gB2, i1); }
#pragma unroll
                    for (int u = 0; u < 2; ++u) { const int tl = wid * 16 + i + u; const size_t m = mw + i + u; const float ga = gA2[u][0], gb = gA2[u][1];
                    float v[16]; float s_ = 0.f;
#pragma unroll
                    for (int jq = 0; jq < 4; ++jq) { const uint2 w0 = aA[u][jq], w1 = bA[u][jq];
                        const f32x4 ya = (f32x4){__builtin_bit_cast(float, w0.x << 16), __builtin_bit_cast(float, w0.x & 0xffff0000u), __builtin_bit_cast(float, w0.y << 16), __builtin_bit_cast(float, w0.y & 0xffff0000u)};
                        const f32x4 yb = (f32x4){__builtin_bit_cast(float, w1.x << 16), __builtin_bit_cast(float, w1.x & 0xffff0000u), __builtin_bit_cast(float, w1.y << 16), __builtin_bit_cast(float, w1.y & 0xffff0000u)};
#pragma unroll
                        for (int e = 0; e < 4; ++e) { v[jq * 4 + e] = ALPHA * xA[u][jq][e] + (ga * ya[e] + gb * yb[e]); s_ += v[jq * 4 + e]; } }
                    const float mean = wave_sum(s_) * (1.f / DM); float s2 = 0.f;
#pragma unroll
                    for (int q = 0; q < 16; ++q) { v[q] -= mean; s2 += v[q] * v[q]; }
                    const float rstd = 1.0f / sqrtf(wave_sum(s2) * (1.f / DM) + LN_EPS);
                    float acc[8];
#pragma unroll
                    for (int h = 0; h < 8; ++h) acc[h] = 0.f;
#pragma unroll
                    for (int jq = 0; jq < 4; ++jq) { f32x4 ov;
                        const f32x4 gv = W4[(32 + jq) * 64 + lane], bv = W4[(36 + jq) * 64 + lane];
#pragma unroll
                        for (int e = 0; e < 4; ++e) ov[e] = v[jq * 4 + e] * rstd * gv[e] + bv[e];
                        if (doff) {
#pragma unroll
                            for (int h = 0; h < 8; ++h) { const f32x4 wv = W4[(h * 4 + jq) * 64 + lane]; acc[h] += (ov[0] * wv[0] + ov[1] * wv[1]) + (ov[2] * wv[2] + ov[3] * wv[3]); } }
                        if (!doff) *(f32x4*)(Xo + m * DM + jq * 256 + lane * 4) = ov;
                        *(uint2*)(XBo + m * DM + jq * 256 + lane * 4) = make_uint2(pk2(ov[0], ov[1]), pk2(ov[2], ov[3])); }
                    if (doff) {
#pragma unroll
                        for (int h = 0; h < 8; ++h) acc[h] = wave_sum(acc[h]);
                        if (lane < 8) { float fv = acc[0];
#pragma unroll
                            for (int h = 1; h < 8; ++h) fv = (lane == h) ? acc[h] : fv;
                            ffl[tl * 8 + lane] = fv + fbias[lane]; } }
                    }

                    if (i + 4 < 16) { const int i2 = i + 4; K_LOAD(xA, aA, bA, gA2, i2); }
#pragma unroll
                    for (int u = 0; u < 2; ++u) { const int tl = wid * 16 + (i + 2) + u; const size_t m = mw + (i + 2) + u; const float ga = gB2[u][0], gb = gB2[u][1];
                    float v[16]; float s_ = 0.f;
#pragma unroll
                    for (int jq = 0; jq < 4; ++jq) { const uint2 w0 = aB[u][jq], w1 = bB[u][jq];
                        const f32x4 ya = (f32x4){__builtin_bit_cast(float, w0.x << 16), __builtin_bit_cast(float, w0.x & 0xffff0000u), __builtin_bit_cast(float, w0.y << 16), __builtin_bit_cast(float, w0.y & 0xffff0000u)};
                        const f32x4 yb = (f32x4){__builtin_bit_cast(float, w1.x << 16), __builtin_bit_cast(float, w1.x & 0xffff0000u), __builtin_bit_cast(float, w1.y << 16), __builtin_bit_cast(float, w1.y & 0xffff0000u)};
#pragma unroll
                        for (int e = 0; e < 4; ++e) { v[jq * 4 + e] = ALPHA * xB[u][jq][e] + (ga * ya[e] + gb * yb[e]); s_ += v[jq * 4 + e]; } }
                    const float mean = wave_sum(s_) * (1.f / DM); float s2 = 0.f;
#pragma unroll
                    for (int q = 0; q < 16; ++q) { v[q] -= mean; s2 += v[q] * v[q]; }
                    const float rstd = 1.0f / sqrtf(wave_sum(s2) * (1.f / DM) + LN_EPS);
                    float acc[8];
#pragma unroll
                    for (int h = 0; h < 8; ++h) acc[h] = 0.f;
#pragma unroll
                    for (int jq = 0; jq < 4; ++jq) { f32x4 ov;
                        const f32x4 gv = W4[(32 + jq) * 64 + lane], bv = W4[(36 + jq) * 64 + lane];
#pragma unroll
                        for (int e = 0; e < 4; ++e) ov[e] = v[jq * 4 + e] * rstd * gv[e] + bv[e];
                        if (doff) {
#pragma unroll
                            for (int h = 0; h < 8; ++h) { const f32x4 wv = W4[(h * 4 + jq) * 64 + lane]; acc[h] += (ov[0] * wv[0] + ov[1] * wv[1]) + (ov[2] * wv[2] + ov[3] * wv[3]); } }
                        if (!doff) *(f32x4*)(Xo + m * DM + jq * 256 + lane * 4) = ov;
                        *(uint2*)(XBo + m * DM + jq * 256 + lane * 4) = make_uint2(pk2(ov[0], ov[1]), pk2(ov[2], ov[3])); }
                    if (doff) {
#pragma unroll
                        for (int h = 0; h < 8; ++h) acc[h] = wave_sum(acc[h]);
                        if (lane < 8) { float fv = acc[0];
#pragma unroll
                            for (int h = 1; h < 8; ++h) fv = (lane == h) ? acc[h] : fv;
                            ffl[tl * 8 + lane] = fv + fbias[lane]; } }
                    }

                }
#undef K_LOAD
                __syncthreads();
                if (doff) {
                    const int h = wid; const int bb = (ch * 128) / SEQ, t0 = (ch * 128) % SEQ; double carry = 0.0;
#pragma unroll
                    for (int half = 0; half < 2; ++half) { double vv = (double)logsigmoidf_(ffl[(half * 64 + lane) * 8 + h]);
#pragma unroll
                        for (int o = 1; o < 64; o <<= 1) { const double n = __shfl_up(vv, o); if (lane >= o) vv += n; }
                        vv += carry; LCS[(size_t)(bb * 8 + h) * SEQ + t0 + half * 64 + lane] = vv; carry = __shfl(vv, 63); }
                    if (lane == 0) TOT[(bb * 8 + h) * 128 + t0 / 128] = carry;
                }
            }
        }
        if (l + 1 < DEPTH) GRID_BAR();
    }
}

extern "C" void kernel_launch(void* const* d_in, const int* in_sizes, int n_in, void* d_out, int out_size, void* d_ws, size_t ws_size, hipStream_t stream) {
    static int grid = 0;
    if (grid == 0) {
        if (n_in != 28 || out_size != T * DM || ws_size < WS_END) { fprintf(stderr, "kernel_launch: unexpected shapes (n_in %d out %d ws %zu)\n", n_in, out_size, ws_size); grid = -1; return; }
        int dev = 0, cus = 0, per_cu = 0;
        (void)hipGetDevice(&dev); (void)hipDeviceGetAttribute(&cus, hipDeviceAttributeMultiprocessorCount, dev);
        (void)hipFuncSetAttribute((const void*)mk_fwd, hipFuncAttributeMaxDynamicSharedMemorySize, LDS_ALL);
        if (hipOccupancyMaxActiveBlocksPerMultiprocessor(&per_cu, (const void*)mk_fwd, NTHREADS, LDS_ALL) != hipSuccess || per_cu < 1) fprintf(stderr, "kernel_launch: occupancy query says %d blocks per CU\n", per_cu);
        (void)hipGetLastError();
        grid = cus > 0 ? cus : 256;
        if (grid != 256) fprintf(stderr, "kernel_launch: %d CUs (built for 256)\n", grid);
    }
    if (grid < 0) return;
    (void)hipMemsetAsync((char*)d_ws + WS_CTL, 0, CTL_BYTES, stream);
    Args a{};
    for (int i = 0; i < 28; ++i) a.in[i] = (const float*)d_in[i];
    a.out = (float*)d_out; a.ws = (unsigned char*)d_ws;
    hipLaunchKernelGGL(mk_fwd, dim3(grid), dim3(NTHREADS), LDS_ALL, stream, a);
}
```

```cpp
#include <hip/hip_runtime.h>
#include <cstdio>
#include <cstdint>
#include <cmath>
__device__ __forceinline__ int ltid() { int t = __builtin_amdgcn_workitem_id_x(); asm volatile("" : "+v"(t)); return t; }

constexpr int BATCH = 2, SEQ = 16384, DM = 1024, DEPTH = 4, T = BATCH * SEQ;
constexpr int INW = 3592, PW = 3584;
constexpr int O_FF = 1536;
constexpr int C_FQ = 0, C_FK = 512, C_FV = 1024, C_RR = 1536, C_RK = 1792, C_RV = 2048, C_WD = 2304, C_AD = 2368, C_GD = 2432,
              C_TQ = 2560, C_TK = 2816, C_TV = 3072, C_TG = 3328;
constexpr int NE = 32, DE = 512, A_TOT = T * 2;
constexpr float ALPHA = 1.681792830507429f;
constexpr float LN_EPS = 1e-5f, RWKV_GN_EPS = 64e-5f, RET_GN_EPS = 1e-6f;
constexpr float QC2 = 0.125f * 1.4426950408889634f;
constexpr int NTHREADS = 512;
#ifndef REP_P0
#define REP_P0 1
#endif
#ifndef REP_A
#define REP_A 1
#endif
#ifndef REP_C
#define REP_C 1
#endif
#ifndef REP_E
#define REP_E 1
#endif
#ifndef REP_F
#define REP_F 1
#endif
#ifndef REP_H
#define REP_H 1
#endif
#ifndef REP_IJ
#define REP_IJ 1
#endif
#ifndef REP_G
#define REP_G 1
#endif
#ifndef REP_K
#define REP_K 1
#endif
constexpr int LDS_MISC = 147456, LDS_ALL = 148480;

constexpr size_t MiB = 1u << 20;
constexpr size_t WS_CTL = 0, CTL_BYTES = 1 * MiB;
constexpr size_t WS_EP = 1 * MiB;
constexpr size_t WS_DEST = 2 * MiB;
constexpr size_t WS_GATE = 9 * MiB;
constexpr size_t WS_ROPE = 11 * MiB;
constexpr size_t WS_RKD = 15 * MiB;
constexpr size_t WS_WIN = 16 * MiB;
constexpr size_t WS_WOUT = 44 * MiB;
constexpr size_t WS_W13 = 52 * MiB;
constexpr size_t WS_W2 = 308 * MiB;
constexpr size_t WS_XB = 436 * MiB;
constexpr size_t WS_P = 500 * MiB;
constexpr size_t WS_MIXB = 724 * MiB;
constexpr size_t WS_CK = 788 * MiB;
constexpr size_t WS_LW = 3 * MiB;
constexpr size_t WS_YO = 788 * MiB;
constexpr size_t WS_XP = 500 * MiB;
constexpr size_t WS_H = 644 * MiB;
constexpr size_t WS_YP = 716 * MiB;
constexpr size_t WS_LCS = 1012 * MiB;
constexpr size_t WS_KA = 1014 * MiB;
constexpr size_t WS_END = 1018 * MiB;
constexpr size_t WS_WR = 5 * MiB;
constexpr size_t WS_SKIP = 4 * MiB + 65536;
constexpr size_t WS_TOT = 4 * MiB;
constexpr int CW_CNT = 32768;
constexpr int CW_Q = 2048;
constexpr int CW_L1 = 20480;
constexpr int CW_SF = 12288;
constexpr int CW_EQ = 4096;
constexpr int CW_CV = 6144;
constexpr int CW_BAR = 8192;
constexpr int MAXTILES = 288;

typedef float f32x16 __attribute__((ext_vector_type(16)));
typedef unsigned short bf16;

struct Args {
    const float* in[28]; float* out; unsigned char* ws;
};

__device__ __forceinline__ float sigmoidf_(float x) { return 1.0f / (1.0f + expf(-x)); }
__device__ __forceinline__ float logsigmoidf_(float x) { return x >= 0.f ? -log1pf(expf(-x)) : x - log1pf(expf(x)); }
__device__ __forceinline__ float wave_sum(float v) {
#define WS_DPP(ctrl, rmask) v += __builtin_bit_cast(float, __builtin_amdgcn_update_dpp(0, __builtin_bit_cast(int, v), ctrl, rmask, 0xf, false))
    WS_DPP(0x111, 0xf); WS_DPP(0x112, 0xf); WS_DPP(0x114, 0xf); WS_DPP(0x118, 0xf); WS_DPP(0x142, 0xa); WS_DPP(0x143, 0xc);
#undef WS_DPP
    return __builtin_bit_cast(float, __builtin_amdgcn_readlane(__builtin_bit_cast(int, v), 63));
}
typedef float f32x2hw __attribute__((ext_vector_type(2))); typedef __bf16 bf16x2hw __attribute__((ext_vector_type(2)));
__device__ __forceinline__ unsigned pk2(float lo, float hi) { f32x2hw v = {lo, hi}; bf16x2hw b = __builtin_convertvector(v, bf16x2hw); return __builtin_bit_cast(unsigned, b); }
__device__ __forceinline__ unsigned f2bf(float f) { return pk2(f, 0.f) & 0xffffu; }
__device__ __forceinline__ float bf2f(unsigned short b) { return __builtin_bit_cast(float, (unsigned)b << 16); }
__device__ __forceinline__ float pf(const bf16* Pb, size_t m, int c) { return bf2f(Pb[m * PW + c]); }

namespace pg8 {
#define PG8_LAS __attribute__((address_space(3)))
typedef unsigned short bf16_t;
typedef short bf16x8 __attribute__((ext_vector_type(8)));
typedef float f32x4 __attribute__((ext_vector_type(4)));
typedef unsigned u32x4 __attribute__((ext_vector_type(4)));
constexpr int BM = 256, BK = 64, HALF = 128, HTB = HALF * BK * 2  , STAGE_BYTES = 8 * HTB, NXCD = 8, WGM = 8;

__host__ __device__ __forceinline__ int lds_byte(int r, int c) { const int st = (r >> 4) * 2 + (c >> 5), rr = r & 15, cc = c & 31, ob = rr * 64 + cc * 2; return st * 1024 + (ob ^ (((ob >> 9) & 1) << 5)); }
__host__ __device__ __forceinline__ void stage_rc(int b, int& R, int& C) { const int st = b / 1024, sb = b % 1024, swz = sb ^ (((sb >> 9) & 1) << 5); R = (st >> 1) * 16 + swz / 64; C = (st & 1) * 32 + (swz % 64) / 2; }
__host__ __device__ __forceinline__ int perm32(int rho) { const int n = rho >> 4, i = rho & 15; return 8 * (i >> 2) + 4 * n + (i & 3); }

struct Unit { int pm, pn, pc; };
struct Gemm { const bf16_t* A; const bf16_t* Bt; int M, N, K; };

struct StaticOrder {
    int nM, nN, nwg, G, c;
    __host__ __device__ void init(int M, int N, int G_, int c_) { nM = M / BM; nN = N / BM; nwg = nM * nN; G = G_; c = c_; }
    __host__ __device__ bool next(int i, Unit& u) const {
        const long L = (long)i * G + c; if (L >= nwg) return false;
        int wgid = (int)L; { const int q = nwg / NXCD, r = nwg % NXCD, xcd = wgid % NXCD, off = wgid / NXCD; wgid = (xcd < r ? xcd * (q + 1) : r * (q + 1) + (xcd - r) * q) + off; }
        const int nig = WGM * nN, gid = wgid / nig, fm = gid * WGM, gsz = (nM - fm) < WGM ? (nM - fm) : WGM;
        u.pm = fm + ((wgid % nig) % gsz); u.pn = (wgid % nig) / gsz; u.pc = u.pn; return true;
    }
    __device__ __forceinline__ void a_ready(const Unit&) const {}
    __device__ __forceinline__ void done(const Unit&) const {}
};

__device__ __forceinline__ unsigned cvt_pk_bf16(float lo, float hi) { unsigned r; asm volatile("v_cvt_pk_bf16_f32 %0, %1, %2" : "=v"(r) : "v"(lo), "v"(hi)); return r; }

struct EpiF32 {
    static constexpr bool PERM = false, AFTER_DRAIN = false;
    float* O; int ldc;
    __device__ __forceinline__ void operator()(const f32x4 (&acc)[2][2][4][2], const Unit& u, int wr, int wc, int fr, int fq) const {
        const int row0 = u.pm * BM + wr * 64 + fr; const int col0 = u.pc * BM + wc * 32 + 4 * fq;
#pragma unroll
        for (int ai = 0; ai < 2; ++ai)
#pragma unroll
            for (int m = 0; m < 4; ++m) { float* rowp = O + (size_t)(row0 + ai * HALF + m * 16) * ldc + col0;
#pragma unroll
                for (int bj = 0; bj < 2; ++bj)
#pragma unroll
                    for (int n = 0; n < 2; ++n) *(f32x4*)(rowp + bj * HALF + n * 16) = acc[ai][bj][m][n]; }
    }
};
struct EpiSwiGlu {
    static constexpr bool PERM = true, AFTER_DRAIN = false;
    bf16_t* O; int ldc;
    __device__ __forceinline__ static float silu(float v) { return v * __builtin_amdgcn_rcpf(1.0f + __builtin_amdgcn_exp2f(-1.4426950408889634f * v)); }
    __device__ __forceinline__ void operator()(const f32x4 (&acc)[2][2][4][2], const Unit& u, int wr, int wc, int fr, int fq) const {
        const int row0 = u.pm * BM + wr * 64 + fr; const int col0 = u.pc * HALF + wc * 32 + 8 * fq;
#pragma unroll
        for (int ai = 0; ai < 2; ++ai)
#pragma unroll
            for (int m = 0; m < 4; ++m) { bf16_t* rowp = O + (size_t)(row0 + ai * HALF + m * 16) * ldc + col0;
                f32x4 h0, h1;
#pragma unroll
                for (int e = 0; e < 4; ++e) { h0[e] = silu(acc[ai][0][m][0][e]) * acc[ai][1][m][0][e]; h1[e] = silu(acc[ai][0][m][1][e]) * acc[ai][1][m][1][e]; }
                u32x4 w; w.x = cvt_pk_bf16(h0[0], h0[1]); w.y = cvt_pk_bf16(h0[2], h0[3]); w.z = cvt_pk_bf16(h1[0], h1[1]); w.w = cvt_pk_bf16(h1[2], h1[3]);
                *(u32x4*)rowp = w; }
    }
};
struct MoeOrder {
    int ntile, G, c; const PG8_LAS int* tile_e;
    __device__ __forceinline__ bool next(int i, Unit& u) const { const int L = i * G + c; if (L >= ntile * 4) return false; const int rt = L >> 2, pn = L & 3; u.pm = rt; u.pn = tile_e[rt] * 4 + pn; u.pc = pn; return true; }
    __device__ __forceinline__ void a_ready(const Unit&) const {}
    __device__ __forceinline__ void done(const Unit&) const {}
};
struct EpiInProj {
    static constexpr bool PERM = true, AFTER_DRAIN = false;
    bf16_t* O; int ldc; float qscale;
    __device__ __forceinline__ void operator()(const f32x4 (&acc)[2][2][4][2], const Unit& u, int wr, int wc, int fr, int fq) const {
        const int row0 = u.pm * BM + wr * 64 + fr; const int col0 = u.pc * BM + wc * 32 + 8 * fq;
        const float sc = (u.pc < 2) ? qscale : 1.f;
#pragma unroll
        for (int ai = 0; ai < 2; ++ai)
#pragma unroll
            for (int m = 0; m < 4; ++m) { bf16_t* rowp = O + (size_t)(row0 + ai * HALF + m * 16) * ldc + col0;
#pragma unroll
                for (int bj = 0; bj < 2; ++bj) { const f32x4 v0 = acc[ai][bj][m][0] * sc, v1 = acc[ai][bj][m][1] * sc;
                    u32x4 w; w.x = cvt_pk_bf16(v0[0], v0[1]); w.y = cvt_pk_bf16(v0[2], v0[3]); w.z = cvt_pk_bf16(v1[0], v1[1]); w.w = cvt_pk_bf16(v1[2], v1[3]);
                    *(u32x4*)(rowp + bj * HALF) = w; } }
    }
};
template <class Epi, class Sched, bool ALIGN_EPI = false, bool SP2 = false>
__device__ __forceinline__ void gemm_phase(PG8_LAS unsigned char* lds, const Gemm g, const Sched& S, const Epi& E) {
    const int tid = ltid(), wid = __builtin_amdgcn_readfirstlane(tid >> 6), lane = tid & 63, wr = wid >> 2, wc = wid & 3, fr = lane & 15, fq = lane >> 4;
    const int K = g.K, nt = K / BK;
    unsigned voffA[2], voffB[2];
#pragma unroll
    for (int i = 0; i < 2; ++i) { int R, C; stage_rc(tid * 16 + i * 8192, R, C); const int Rb = Epi::PERM ? ((R & ~31) + perm32(R & 31)) : R;
        voffA[i] = (unsigned)(R * K + C) * 2u; voffB[i] = (unsigned)(Rb * K + C) * 2u; }
    const size_t kstep = (size_t)(BK * 2);
    const size_t hstep = (size_t)HALF * K * 2;
    const size_t tstep = 2 * hstep;
    const unsigned ldsw = (unsigned)wid * 1024u;
    const int aoff = lds_byte(wr * 64 + fr, fq * 8), boff = lds_byte(wc * 32 + fr, fq * 8);
#define PG8_SA(b, h) (((b) * 2 + (h)) * HTB)
#define PG8_SB(b, h) ((4 + (b) * 2 + (h)) * HTB)
#define PG8_STAGE(bufoff, gbase, voff) do { _Pragma("unroll") for (int _i = 0; _i < 2; ++_i) \
        __builtin_amdgcn_global_load_lds((const unsigned*)((const char*)(gbase) + (voff)[_i]), (PG8_LAS unsigned*)(lds + (bufoff) + ldsw + _i * 8192), 16, 0, 0); } while (0)
#define PG8_LDA(dst, b, h) do { _Pragma("unroll") for (int m = 0; m < 4; ++m) _Pragma("unroll") for (int k = 0; k < 2; ++k) dst[m][k] = *(const PG8_LAS bf16x8*)(lds + PG8_SA(b, h) + aoff + m * 2048 + k * 1024); } while (0)
#define PG8_LDB(dst, b, h) do { _Pragma("unroll") for (int n = 0; n < 2; ++n) _Pragma("unroll") for (int k = 0; k < 2; ++k) dst[n][k] = *(const PG8_LAS bf16x8*)(lds + PG8_SB(b, h) + boff + n * 2048 + k * 1024); } while (0)
#define PG8_MMA(ai, bj, At, Bt) do { __builtin_amdgcn_s_setprio(1); _Pragma("unroll") for (int m = 0; m < 4; ++m) _Pragma("unroll") for (int n = 0; n < 2; ++n) _Pragma("unroll") for (int k = 0; k < 2; ++k) \
        acc[ai][bj][m][n] = __builtin_amdgcn_mfma_f32_16x16x32_bf16(Bt[n][k], At[m][k], acc[ai][bj][m][n], 0, 0, 0); __builtin_amdgcn_s_setprio(0); } while (0)
#define PG8_WAIT_V(n) asm volatile("s_waitcnt vmcnt(" #n ")" ::: "memory")
#define PG8_WAIT_L(n) asm volatile("s_waitcnt lgkmcnt(" #n ")" ::: "memory")
#define PG8_BAR __builtin_amdgcn_s_barrier()
#define PG8_SCHED __builtin_amdgcn_sched_barrier(0)
    Unit cur, nxt; int ui = 0;
    if (!S.next(0, cur)) return;
    f32x4 acc[2][2][4][2];
#pragma unroll
    for (int a = 0; a < 2; ++a)
#pragma unroll
        for (int b = 0; b < 2; ++b)
#pragma unroll
            for (int m = 0; m < 4; ++m)
#pragma unroll
                for (int n = 0; n < 2; ++n) acc[a][b][m][n] = (f32x4){0.f, 0.f, 0.f, 0.f};
    bf16x8 At[4][2], B0[2][2], B1[2][2];
    const char* cA = (const char*)g.A + (size_t)cur.pm * tstep; const char* cB = (const char*)g.Bt + (size_t)cur.pn * tstep;
    S.a_ready(cur);
    if constexpr (SP2) {
        PG8_STAGE(PG8_SB(0, 0), cB, voffB); PG8_STAGE(PG8_SB(0, 1), cB + hstep, voffB); PG8_STAGE(PG8_SA(0, 0), cA, voffA); PG8_STAGE(PG8_SA(0, 1), cA + hstep, voffA);
        if (wr == 1) PG8_BAR;
        PG8_WAIT_V(2); PG8_BAR;
        PG8_STAGE(PG8_SB(1, 0), cB + kstep, voffB); PG8_STAGE(PG8_SA(1, 0), cA + kstep, voffA); PG8_STAGE(PG8_SB(1, 1), cB + hstep + kstep, voffB);
        PG8_WAIT_V(6); PG8_BAR;
    } else {
        PG8_STAGE(PG8_SB(0, 0), cB, voffB); PG8_STAGE(PG8_SA(0, 0), cA, voffA); PG8_STAGE(PG8_SB(0, 1), cB + hstep, voffB); PG8_STAGE(PG8_SA(0, 1), cA + hstep, voffA);
        if (wr == 1) PG8_BAR;
        PG8_WAIT_V(4); PG8_BAR;
        PG8_STAGE(PG8_SB(1, 0), cB + kstep, voffB); PG8_STAGE(PG8_SA(1, 0), cA + kstep, voffA); PG8_STAGE(PG8_SB(1, 1), cB + hstep + kstep, voffB);
        PG8_WAIT_V(6); PG8_BAR;
    }
    for (;;) {
        const bool has_next = S.next(ui + 1, nxt);
        const char* nA = has_next ? (const char*)g.A + (size_t)nxt.pm * tstep : cA; const char* nB = has_next ? (const char*)g.Bt + (size_t)nxt.pn * tstep : cB;
        for (int t = 0; t < nt; t += 2) {
            const bool last = (t == nt - 2);
            const char* a1 = cA + (size_t)(t + 1) * kstep;
            const char* a2 = last ? nA : cA + (size_t)(t + 2) * kstep; const char* b2 = last ? nB : cB + (size_t)(t + 2) * kstep;
            const char* a3 = a2 + kstep; const char* b3 = b2 + kstep;
            if (last && has_next) S.a_ready(nxt);
            if constexpr (SP2) {
            PG8_LDB(B0, 0, 0); PG8_LDB(B1, 0, 1); PG8_SCHED; PG8_LDA(At, 0, 0); PG8_STAGE(PG8_SA(1, 1), a1 + hstep, voffA);
            PG8_WAIT_V(8); PG8_WAIT_L(0); PG8_BAR; PG8_MMA(0, 0, At, B0); PG8_MMA(0, 1, At, B1); PG8_BAR; PG8_SCHED;
            PG8_LDA(At, 0, 1); PG8_STAGE(PG8_SB(0, 0), b2, voffB); PG8_STAGE(PG8_SB(0, 1), b2 + hstep, voffB); PG8_STAGE(PG8_SA(0, 0), a2, voffA);
            PG8_WAIT_V(8); PG8_WAIT_L(0); PG8_BAR; PG8_MMA(1, 0, At, B0); PG8_MMA(1, 1, At, B1); PG8_BAR; PG8_SCHED;
            PG8_LDB(B0, 1, 0); PG8_LDB(B1, 1, 1); PG8_SCHED; PG8_LDA(At, 1, 0); PG8_STAGE(PG8_SA(0, 1), a2 + hstep, voffA);
            PG8_WAIT_V(8); PG8_WAIT_L(0); PG8_BAR; PG8_MMA(0, 0, At, B0); PG8_MMA(0, 1, At, B1); PG8_BAR; PG8_SCHED;
            PG8_LDA(At, 1, 1); PG8_STAGE(PG8_SB(1, 0), b3, voffB); PG8_STAGE(PG8_SB(1, 1), b3 + hstep, voffB); PG8_STAGE(PG8_SA(1, 0), a3, voffA);
            PG8_WAIT_V(8); PG8_WAIT_L(0); PG8_BAR; PG8_MMA(1, 0, At, B0); PG8_MMA(1, 1, At, B1); PG8_BAR; PG8_SCHED;
            } else {
            PG8_LDB(B0, 0, 0); PG8_SCHED; PG8_LDA(At, 0, 0); PG8_STAGE(PG8_SA(1, 1), a1 + hstep, voffA);
            PG8_WAIT_L(8); PG8_BAR; PG8_WAIT_L(0); PG8_MMA(0, 0, At, B0); PG8_BAR; PG8_SCHED;
            PG8_LDB(B1, 0, 1); PG8_STAGE(PG8_SB(0, 0), b2, voffB);
            PG8_BAR; PG8_WAIT_L(0); PG8_MMA(0, 1, At, B1); PG8_BAR;
            PG8_LDA(At, 0, 1); PG8_STAGE(PG8_SA(0, 0), a2, voffA);
            PG8_BAR; PG8_WAIT_L(0); PG8_MMA(1, 0, At, B0); PG8_BAR; PG8_SCHED;
            PG8_STAGE(PG8_SB(0, 1), b2 + hstep, voffB);
            PG8_WAIT_V(6); PG8_BAR; PG8_MMA(1, 1, At, B1); PG8_BAR;
            PG8_LDB(B0, 1, 0); PG8_SCHED; PG8_LDA(At, 1, 0); PG8_STAGE(PG8_SA(0, 1), a2 + hstep, voffA);
            PG8_WAIT_L(8); PG8_BAR; PG8_WAIT_L(0); PG8_MMA(0, 0, At, B0); PG8_BAR; PG8_SCHED;
            PG8_LDB(B1, 1, 1); PG8_STAGE(PG8_SB(1, 0), b3, voffB);
            PG8_BAR; PG8_WAIT_L(0); PG8_MMA(0, 1, At, B1); PG8_BAR;
            PG8_LDA(At, 1, 1); PG8_STAGE(PG8_SA(1, 0), a3, voffA);
            PG8_BAR; PG8_WAIT_L(0); PG8_MMA(1, 0, At, B0); PG8_BAR; PG8_SCHED;
            PG8_STAGE(PG8_SB(1, 1), b3 + hstep, voffB);
            PG8_WAIT_V(6); PG8_BAR; PG8_MMA(1, 1, At, B1); PG8_BAR;
            }
        }
        if constexpr (ALIGN_EPI) { if (wr == 0) PG8_BAR; }
        if constexpr (!Epi::AFTER_DRAIN) { E(acc, cur, wr, wc, fr, fq); S.done(cur); }
        if (!has_next) break;
#pragma unroll
        for (int a = 0; a < 2; ++a)
#pragma unroll
            for (int b = 0; b < 2; ++b)
#pragma unroll
                for (int m = 0; m < 4; ++m)
#pragma unroll
                    for (int n = 0; n < 2; ++n) acc[a][b][m][n] = (f32x4){0.f, 0.f, 0.f, 0.f};
        cur = nxt; cA = nA; cB = nB; ++ui;
        if constexpr (ALIGN_EPI) { if (wr == 1) PG8_BAR; }
    }
    PG8_WAIT_V(0);
    if constexpr (!ALIGN_EPI) { if (wr == 0) PG8_BAR; }
    PG8_BAR;
    if constexpr (Epi::AFTER_DRAIN) { E.fused(acc, cur, wr, wc, fr, fq, lds, wid, lane); S.done(cur); }
#undef PG8_SA
#undef PG8_SB
#undef PG8_STAGE
#undef PG8_LDA
#undef PG8_LDB
#undef PG8_MMA
#undef PG8_WAIT_V
#undef PG8_WAIT_L
#undef PG8_BAR
#undef PG8_SCHED
}
}

template <class RowMap, class Epi>
__device__ __forceinline__ void gemm_tile_f32(float* lds, const float* __restrict__ A, int lda, RowMap rowmap, int nvalid,
                                              const float* __restrict__ B, int ldb, int col0, int N, int K, Epi epi) {
    float* As = lds;
    float* Bs = lds + 128 * 17;
    const int tid = ltid(), lane = tid & 63, wid = tid >> 6, wm = wid & 3, wn = wid >> 2;
    const int arow = tid >> 2, akq = (tid & 3) * 4;
    const int src = (arow < nvalid) ? rowmap(arow) : -1;
    const float* ap = A + (size_t)(src < 0 ? 0 : src) * lda + akq;
    const int bk = tid >> 5, bn = (tid & 31) * 4;
    const bool bok = (col0 + bn) < N;
    const float* bp = B + (size_t)bk * ldb + col0 + bn;
    f32x16 acc0 = {}, acc1 = {};
    for (int k0 = 0; k0 < K; k0 += 16) {
        pg8::f32x4 av = (pg8::f32x4){0.f, 0.f, 0.f, 0.f}, bv = (pg8::f32x4){0.f, 0.f, 0.f, 0.f};
        if (src >= 0) av = *(const pg8::f32x4*)(ap + k0);
        if (bok) bv = *(const pg8::f32x4*)(bp + (size_t)k0 * ldb);
        __syncthreads();
        As[arow * 17 + akq + 0] = av[0]; As[arow * 17 + akq + 1] = av[1]; As[arow * 17 + akq + 2] = av[2]; As[arow * 17 + akq + 3] = av[3];
        *(pg8::f32x4*)(Bs + bk * 132 + bn) = bv;
        __syncthreads();
#pragma unroll
        for (int kk = 0; kk < 16; kk += 2) {
            const float a = As[(32 * wm + (lane & 31)) * 17 + kk + (lane >> 5)];
            const float b0 = Bs[(kk + (lane >> 5)) * 132 + 64 * wn + (lane & 31)];
            const float b1 = Bs[(kk + (lane >> 5)) * 132 + 64 * wn + 32 + (lane & 31)];
            acc0 = __builtin_amdgcn_mfma_f32_32x32x2f32(a, b0, acc0, 0, 0, 0);
            acc1 = __builtin_amdgcn_mfma_f32_32x32x2f32(a, b1, acc1, 0, 0, 0);
        }
    }
#pragma unroll
    for (int r = 0; r < 16; ++r) {
        const int i = 32 * wm + (r & 3) + 8 * (r >> 2) + 4 * (lane >> 5);
        const int c0 = col0 + 64 * wn + (lane & 31);
        if (i < nvalid) {
            if (c0 < N) epi(i, c0, acc0[r]);
            if (c0 + 32 < N) epi(i, c0 + 32, acc1[r]);
        }
    }
}

#include <hip/hip_bf16.h>
namespace attn_body {
using bf16=__hip_bfloat16;
using bf16x8=__attribute__((ext_vector_type(8)))short;
using s16x4=__attribute__((ext_vector_type(4)))short;
using f32x16=__attribute__((ext_vector_type(16)))float;
using u32x4=__attribute__((ext_vector_type(4)))unsigned;
typedef float f32x4_t __attribute__((ext_vector_type(4)));
constexpr int BATCH=2,NHEAD=8,SEQ=16384,D=64,DM=3584,OP=1024;
constexpr int NW=8,QBLK=32,QB=QBLK*NW,KVBLK=64,NQB=SEQ/QB;
constexpr int ATTN_PITCH=DM, ATTN_UNIT_ROWS=QB;
__device__ __forceinline__ int crow(int r,int hi){return (r&3)+8*(r>>2)+4*hi;}
#define SBAR() __builtin_amdgcn_sched_barrier(0)
__device__ __forceinline__ void cmask(f32x16&p0,f32x16&p1,int jb,int qrel,int hi){
  const float NEG=-INFINITY; int kb=64*jb+4*hi;
  #pragma unroll
  for(int r=0;r<16;++r){int kv=kb+(r&3)+8*(r>>2); if(kv>qrel)p0[r]=NEG; if(kv+32>qrel)p1[r]=NEG;}
}

constexpr int NSLOT=3, SLOTB=8192;
constexpr int LDS_K=0, LDS_V=NSLOT*SLOTB, LDS_WS=2*NSLOT*SLOTB, LDS_OST=LDS_WS+NW*64*4, LDS_BYTES=LDS_OST+NW*4096;
constexpr float C2=0.125f*1.4426950408889634f;
__device__ __forceinline__ void glds16(const void*gsrc,unsigned lds_dst){unsigned keep;
  asm volatile("s_mov_b32 %0, m0\n\ts_mov_b32 m0, %2\n\ts_nop 0\n\tglobal_load_lds_dwordx4 %1, off\n\ts_mov_b32 m0, %0":"=&s"(keep):"v"(gsrc),"s"(lds_dst):"memory");}
__device__ __forceinline__ float max3f(float a,float b,float c){float r;asm("v_max3_f32 %0, %1, %2, %3":"=v"(r):"v"(a),"v"(b),"v"(c));return r;}
__device__ __forceinline__ float max2f(float a,float b){float r;asm("v_max_f32_e32 %0, %1, %2":"=v"(r):"v"(a),"v"(b));return r;}
__device__ __forceinline__ float fadd_s(float a,float b){float r;asm("v_add_f32_e32 %0, %1, %2":"=v"(r):"v"(a),"v"(b));return r;}
__device__ __forceinline__ float fsub_s(float a,float b){float r;asm("v_sub_f32_e32 %0, %1, %2":"=v"(r):"v"(a),"v"(b));return r;}
typedef float f32x2_t __attribute__((ext_vector_type(2))); typedef __bf16 bf16x2_t __attribute__((ext_vector_type(2)));
__device__ __forceinline__ unsigned cvtpk_s(float lo,float hi){f32x2_t v={lo,hi};bf16x2_t b=__builtin_convertvector(v,bf16x2_t);return __builtin_bit_cast(unsigned,b);}
#define WAIT_BAR(N) asm volatile("s_waitcnt vmcnt(" #N ") lgkmcnt(0)\n\ts_barrier":::"memory")

__device__ __forceinline__ void qkt(f32x16&p0,f32x16&p1,const char*Kslot,const bf16x8*qr,int r32,int hi){
  const char*kb=Kslot+hi*1024+r32*16;
  #pragma unroll
  for(int d0=0;d0<4;++d0){
    const bf16x8 b0=*reinterpret_cast<const bf16x8*>(kb+d0*2048);
    const bf16x8 b1=*reinterpret_cast<const bf16x8*>(kb+d0*2048+512);
    p0=__builtin_amdgcn_mfma_f32_32x32x16_bf16(b0,qr[d0],p0,0,0,0);p1=__builtin_amdgcn_mfma_f32_32x32x16_bf16(b1,qr[d0],p1,0,0,0);}
}
typedef __attribute__((address_space(3))) const char* lds_cptr;
typedef short v4i16_t __attribute__((ext_vector_type(4)));
__device__ __forceinline__ void kload8(bf16x8*kf,lds_cptr kp){
  kf[0]=*(const __attribute__((address_space(3))) bf16x8*)(kp);      kf[1]=*(const __attribute__((address_space(3))) bf16x8*)(kp+512);
  kf[2]=*(const __attribute__((address_space(3))) bf16x8*)(kp+2048); kf[3]=*(const __attribute__((address_space(3))) bf16x8*)(kp+2560);
  kf[4]=*(const __attribute__((address_space(3))) bf16x8*)(kp+4096); kf[5]=*(const __attribute__((address_space(3))) bf16x8*)(kp+4608);
  kf[6]=*(const __attribute__((address_space(3))) bf16x8*)(kp+6144); kf[7]=*(const __attribute__((address_space(3))) bf16x8*)(kp+6656);
}
__device__ __forceinline__ void kload2(bf16x8*kf,lds_cptr kp,int j){ kf[2*j]=*(const __attribute__((address_space(3))) bf16x8*)(kp+j*2048); kf[2*j+1]=*(const __attribute__((address_space(3))) bf16x8*)(kp+j*2048+512); }
__device__ __forceinline__ s16x4 vtr(lds_cptr p){ return __builtin_bit_cast(s16x4,__builtin_amdgcn_ds_read_tr16_b64_v4i16((__attribute__((address_space(3))) v4i16_t*)p)); }
__device__ __forceinline__ float rowmax(const f32x16&p0,const f32x16&p1){
  float a=max3f(p0[0],p0[1],p1[0]),b=max3f(p0[2],p0[3],p1[1]);a=max3f(a,p1[2],p1[3]);
  #pragma unroll
  for(int r=4;r<16;r+=4){a=max3f(a,p0[r],p0[r+1]);b=max3f(b,p0[r+2],p0[r+3]);a=max3f(a,p1[r],p1[r+1]);b=max3f(b,p1[r+2],p1[r+3]);}
  const float m=max2f(a,b);
  auto rr=__builtin_amdgcn_permlane32_swap(__float_as_uint(m),__float_as_uint(m),false,false);
  return max2f(__uint_as_float(rr[0]),__uint_as_float(rr[1]));
}
__device__ __forceinline__ void pv(f32x16*o,int vb,bf16x8 pa0,bf16x8 pa1,bf16x8 pa2,bf16x8 pa3){
  #pragma unroll
  for(int d0=0;d0<2;++d0){s16x4 lo[4],hi[4];
    #pragma unroll
    for(int ks=0;ks<4;++ks){
      asm volatile("ds_read_b64_tr_b16 %0,%1 offset:%c2":"=&v"(lo[ks]):"v"(vb),"i"(d0*4096+ks*1024):"memory");
      asm volatile("ds_read_b64_tr_b16 %0,%1 offset:%c2":"=&v"(hi[ks]):"v"(vb),"i"(d0*4096+ks*1024+512):"memory");}
    asm volatile("s_waitcnt lgkmcnt(0)":::"memory");SBAR();
    #define PK(k) (bf16x8){lo[k][0],lo[k][1],lo[k][2],lo[k][3],hi[k][0],hi[k][1],hi[k][2],hi[k][3]}
    o[d0]=__builtin_amdgcn_mfma_f32_32x32x16_bf16(pa0,PK(0),o[d0],0,0,0);
    o[d0]=__builtin_amdgcn_mfma_f32_32x32x16_bf16(pa1,PK(1),o[d0],0,0,0);
    o[d0]=__builtin_amdgcn_mfma_f32_32x32x16_bf16(pa2,PK(2),o[d0],0,0,0);
    o[d0]=__builtin_amdgcn_mfma_f32_32x32x16_bf16(pa3,PK(3),o[d0],0,0,0);
    #undef PK
  }
}

#ifndef ATTN_STORE16
#define ATTN_STORE16(p,v) (*(u32x4*)(p)=(v))
#endif
template<int THRL> __device__ __forceinline__ void attn_unit(int b,int h,int qb,int t0,const bf16*Q,const bf16*__restrict__ K,const bf16*__restrict__ V,bf16*O,const unsigned char*KAg,char*shm){
  const int tid=ltid(),lane=tid&63,r32=lane&31,hi=lane>>5; const int wid=__builtin_amdgcn_readfirstlane(tid>>6);
  const long rowbase=(long)b*SEQ; const int q0=qb*QB;
  const bf16*Qw=Q+(rowbase+q0+wid*QBLK)*DM+h*D;
  const bf16*Kh=K+(rowbase+(long)t0*KVBLK)*DM+h*D,*Vh=V+(rowbase+(long)t0*KVBLK)*DM+h*D;
  const unsigned lds0=(unsigned)(uintptr_t)shm;
  float*wsf=(float*)(shm+LDS_WS)+wid*64;
  const bf16*ksrc=Kh+(long)lane*DM+wid*8;
  const bf16*vsrc=Vh+(long)(16*(wid&3)+(lane>>2))*DM+(wid>>2)*32+(lane&3)*8;
  const unsigned kdst=lds0+LDS_K+wid*1024, vdst=lds0+LDS_V+wid*1024;
  #define DMA_K(t,slot) glds16(ksrc+(long)(t)*KVBLK*DM,(unsigned)__builtin_amdgcn_readfirstlane(kdst+(slot)))
  #define DMA_V(t,slot) glds16(vsrc+(long)(t)*KVBLK*DM,(unsigned)__builtin_amdgcn_readfirstlane(vdst+(slot)))
  const int vb0=(int)(lds0+LDS_V)+((lane>>4)&1)*32+(lane&3)*8+(4*hi+((lane&15)>>2))*64;
  const char*Kbase=shm+LDS_K; bf16x8 kf[8];
  const lds_cptr shm3=(lds_cptr)shm; const lds_cptr kp0=shm3+LDS_K+hi*1024+r32*16; const lds_cptr vp0=shm3+LDS_V+((lane>>4)&1)*32+(lane&3)*8+(4*hi+((lane&15)>>2))*64;
  const int NT=(q0+QB)/KVBLK-t0;
  u32x4 ka0,ka1; u32x4 qaw;
  const unsigned kavoff=(unsigned)r32*16u;
  const unsigned long long kab0=(unsigned long long)(uintptr_t)KAg+((unsigned long long)((b*NHEAD+h)*(long)SEQ+(long)t0*KVBLK))*16ull;
  #define KA_LOAD(t) do{ const unsigned long long a_=kab0+(unsigned long long)(t)*1024ull; const unsigned lo_=__builtin_amdgcn_readfirstlane((unsigned)a_),hi_=__builtin_amdgcn_readfirstlane((unsigned)(a_>>32)); \
    const unsigned long long sb_=((unsigned long long)hi_<<32)|lo_; \
    asm volatile("s_nop 4\n\tglobal_load_dwordx4 %0, %2, %3\n\tglobal_load_dwordx4 %1, %2, %3 offset:512":"=&v"(ka0),"=&v"(ka1):"v"(kavoff),"s"(sb_):"memory"); }while(0)
  #define QA_SET() do{ const float nm_=-mhat; const unsigned h_=cvtpk_s(nm_,0.f)&0xffffu; const float r1_=nm_-__uint_as_float(h_<<16); const unsigned m_=cvtpk_s(r1_,0.f)&0xffffu; \
    const float r2_=r1_-__uint_as_float(m_<<16); const unsigned l_=cvtpk_s(r2_,0.f)&0xffffu; \
    qaw[0]=hi?0u:0x3f803f80u; qaw[1]=hi?0u:(0x3f80u|(h_<<16)); qaw[2]=hi?0u:(m_|(l_<<16)); qaw[3]=0u; asm volatile("":"+v"(qaw)); }while(0)
  #define AUG(C0,C1) do{ C0=__builtin_amdgcn_mfma_f32_32x32x16_bf16(__builtin_bit_cast(bf16x8,ka0),__builtin_bit_cast(bf16x8,qaw),f32x16{},0,0,0); \
    C1=__builtin_amdgcn_mfma_f32_32x32x16_bf16(__builtin_bit_cast(bf16x8,ka1),__builtin_bit_cast(bf16x8,qaw),f32x16{},0,0,0); }while(0)
  #define PIN_KA() asm volatile("; KA landed":"+v"(ka0),"+v"(ka1)::"memory")
  #define WAIT_BAR_KA(N) do{ WAIT_BAR(N); PIN_KA(); }while(0)
  KA_LOAD(0);
  DMA_K(0,0);DMA_V(0,0);DMA_K(1,SLOTB);
  bf16x8 qr[4];
  #pragma unroll
  for(int d0=0;d0<4;++d0)qr[d0]=*reinterpret_cast<const bf16x8*>(&Qw[(long)r32*DM+d0*16+hi*8]);
  float mhat=0.f,l_reg=0.f;f32x16 o[2];o[0]=f32x16{};o[1]=f32x16{}; QA_SET();
  const int qrel=wid*QBLK+r32;
  #define CMASK(P0,P1,t) do{int jb_=(t)-(NT-4); if(jb_>=0)cmask(P0,P1,jb_,qrel,hi);}while(0)
  bool resc=false;
  #define START(P0,P1) do{ const float rm=rowmax(P0,P1); resc=false; \
    { const float dl=rm; mhat=fadd_s(mhat,dl); \
      _Pragma("unroll") for(int r=0;r<16;++r){P0[r]=fsub_s(P0[r],dl);P1[r]=fsub_s(P1[r],dl);} \
      QA_SET(); } \
    _Pragma("unroll") for(int r=0;r<16;++r)P0[r]=__builtin_amdgcn_exp2f(P0[r]); }while(0)
  #define RESC() do{ if(resc){ asm volatile("s_waitcnt lgkmcnt(0)":::"memory"); \
      _Pragma("unroll") for(int d_=0;d_<2;++d_) _Pragma("unroll") for(int r=0;r<16;++r)o[d_][r]*=wsf[crow(r,hi)]; } }while(0)
  f32x16 pA0,pA1,pB0,pB1;
  int sl_prev=0,sl_cur=0,sl_next=SLOTB;
  #define ROT() do{sl_prev=sl_cur;sl_cur=sl_next;sl_next=(sl_next==(NSLOT-1)*SLOTB)?0:sl_next+SLOTB;}while(0)
  DMA_K(2,2*SLOTB);
  WAIT_BAR_KA(3);
  AUG(pA0,pA1); qkt(pA0,pA1,Kbase,qr,r32,hi);asm volatile("s_nop 15\n\ts_nop 7":"+v"(pA0),"+v"(pA1));CMASK(pA0,pA1,0);
  START(pA0,pA1);
  _Pragma("unroll") for(int r=0;r<16;++r)pA1[r]=__builtin_amdgcn_exp2f(pA1[r]);
  WAIT_BAR(0);
  KA_LOAD(1);DMA_K(3,0);DMA_V(1,SLOTB);
  ROT();
  kload8(kf,kp0+sl_cur);
  WAIT_BAR_KA(2);
  s16x4 vlo[8],vhi[8]; u32x4 pw0,pw1,pw2,pw3;
  #define PKW(P,B) cvtpk_s(P[B],P[B+1])
  #define PAF(k) __builtin_bit_cast(bf16x8,pw##k)
  #define VFR(i) (bf16x8){vlo[i][0],vlo[i][1],vlo[i][2],vlo[i][3],vhi[i][0],vhi[i][1],vhi[i][2],vhi[i][3]}
  #define PIN(x) asm volatile("":"+v"(x))
  #define MX3(a,b,c) __builtin_fmaxf(__builtin_fmaxf((a),(b)),(c))
  #define GAPA(MF,A0,A1,A2,A3,W0,W1,PW) do{ MF; sacc+=A0; sacc+=A1; sacc+=A2; sacc+=A3; PIN(sacc); W0; W1; PIN(PW); SBAR(); }while(0)
  #define EX(v) __builtin_amdgcn_exp2f(v)
  #define GAPB(MF,X,B) do{ MF; X[B]=EX(X[B]); X[B+1]=EX(X[B+1]); X[B+2]=EX(X[B+2]); X[B+3]=EX(X[B+3]); PIN(X); SBAR(); }while(0)
  #define VRD(i) do{ vlo[i]=vtr(vp_+(((i)>>2)*4096+((i)&3)*1024)); vhi[i]=vtr(vp_+(((i)>>2)*4096+((i)&3)*1024+512)); }while(0)
  #define KRD(G,j) do{ if(G){ kload2(kf,kp0+sl_next,j); SBAR(); } }while(0)
  #define STEP(C0,C1,P0,P1,t,GK,GV,GL) do{ SBAR(); \
    const lds_cptr vp_=vp0+sl_prev; \
    AUG(C0,C1); SBAR(); \
    VRD(0); SBAR(); float sacc=(P0[0]+P0[1]); \
    GAPA(C0=__builtin_amdgcn_mfma_f32_32x32x16_bf16(kf[0],qr[0],C0,0,0,0), P0[2],P0[3],P0[4],P0[5],     pw0[0]=PKW(P0,0), pw0[1]=PKW(P0,2), pw0); \
    VRD(4); SBAR(); GAPA(C1=__builtin_amdgcn_mfma_f32_32x32x16_bf16(kf[1],qr[0],C1,0,0,0), P0[6],P0[7],P0[8],P0[9],     pw0[2]=PKW(P0,4), pw0[3]=PKW(P0,6), pw0); \
    VRD(1); SBAR(); GAPA(C0=__builtin_amdgcn_mfma_f32_32x32x16_bf16(kf[2],qr[1],C0,0,0,0),   P0[10],P0[11],P0[12],P0[13], pw1[0]=PKW(P0,8), pw1[1]=PKW(P0,10), pw1); \
    VRD(5); SBAR(); GAPA(C1=__builtin_amdgcn_mfma_f32_32x32x16_bf16(kf[3],qr[1],C1,0,0,0),   P0[14],P0[15],P1[0],P1[1],   pw1[2]=PKW(P0,12),pw1[3]=PKW(P0,14), pw1); \
    VRD(2); SBAR(); GAPA(C0=__builtin_amdgcn_mfma_f32_32x32x16_bf16(kf[4],qr[2],C0,0,0,0),   P1[2],P1[3],P1[4],P1[5],     pw2[0]=PKW(P1,0), pw2[1]=PKW(P1,2), pw2); \
    VRD(6); SBAR(); GAPA(C1=__builtin_amdgcn_mfma_f32_32x32x16_bf16(kf[5],qr[2],C1,0,0,0),   P1[6],P1[7],P1[8],P1[9],     pw2[2]=PKW(P1,4), pw2[3]=PKW(P1,6), pw2); \
    VRD(3); SBAR(); GAPA(C0=__builtin_amdgcn_mfma_f32_32x32x16_bf16(kf[6],qr[3],C0,0,0,0),   P1[10],P1[11],P1[12],P1[13], pw3[0]=PKW(P1,8), pw3[1]=PKW(P1,10), pw3); \
    VRD(7); SBAR(); GAPA(C1=__builtin_amdgcn_mfma_f32_32x32x16_bf16(kf[7],qr[3],C1,0,0,0),   P1[14],P1[15],0.f,0.f,       pw3[2]=PKW(P1,12),pw3[3]=PKW(P1,14), pw3); \
    l_reg+=sacc; \
    if(GL){KA_LOAD((t)+1);} if(GK){DMA_K((t)+3,sl_cur);} if(GV){DMA_V((t)+1,sl_next);} \
    CMASK(C0,C1,t); \
    { float a=MX3(C0[0],C0[1],C1[0]),b=MX3(C0[2],C0[3],C1[1]); a=MX3(a,C1[2],C1[3]); \
      _Pragma("unroll") for(int r=4;r<16;r+=4){a=MX3(a,C0[r],C0[r+1]);b=MX3(b,C0[r+2],C0[r+3]);a=MX3(a,C1[r],C1[r+1]);b=MX3(b,C1[r+2],C1[r+3]);} \
      float rm=__builtin_fmaxf(a,b); { auto rr=__builtin_amdgcn_permlane32_swap(__float_as_uint(rm),__float_as_uint(rm),false,false); rm=__builtin_fmaxf(__uint_as_float(rr[0]),__uint_as_float(rr[1])); } \
      resc=false; \
      if(__builtin_expect(__any(rm>(float)THRL),0)){ const float dl=__builtin_fmaxf(rm,0.f); mhat+=dl; \
        _Pragma("unroll") for(int r=0;r<16;++r){C0[r]-=dl;C1[r]-=dl;} \
        QA_SET(); \
        const float f=__builtin_amdgcn_exp2f(-dl); l_reg*=f; if(hi==0)wsf[r32]=f; resc=true; } } \
    SBAR(); \
    GAPB(o[0]=__builtin_amdgcn_mfma_f32_32x32x16_bf16(PAF(0),VFR(0),o[0],0,0,0), C0,0); \
    GAPB(o[1]=__builtin_amdgcn_mfma_f32_32x32x16_bf16(PAF(0),VFR(4),o[1],0,0,0), C0,4); \
    KRD(GL,0); GAPB(o[0]=__builtin_amdgcn_mfma_f32_32x32x16_bf16(PAF(1),VFR(1),o[0],0,0,0), C0,8); \
    KRD(GL,1); GAPB(o[1]=__builtin_amdgcn_mfma_f32_32x32x16_bf16(PAF(1),VFR(5),o[1],0,0,0), C0,12); \
    KRD(GL,2); GAPB(o[0]=__builtin_amdgcn_mfma_f32_32x32x16_bf16(PAF(2),VFR(2),o[0],0,0,0), C1,0); \
    KRD(GL,3); GAPB(o[1]=__builtin_amdgcn_mfma_f32_32x32x16_bf16(PAF(2),VFR(6),o[1],0,0,0), C1,4); \
    GAPB(o[0]=__builtin_amdgcn_mfma_f32_32x32x16_bf16(PAF(3),VFR(3),o[0],0,0,0), C1,8); \
    GAPB(o[1]=__builtin_amdgcn_mfma_f32_32x32x16_bf16(PAF(3),VFR(7),o[1],0,0,0), C1,12); \
    }while(0)
  int t=1;
  #undef CMASK
  #define CMASK(P0,P1,t) do{}while(0)
  for(;t+5<NT;t+=2){
    STEP(pB0,pB1,pA0,pA1,t,true,true,true);     WAIT_BAR_KA(2); RESC(); ROT();
    STEP(pA0,pA1,pB0,pB1,t+1,true,true,true);   WAIT_BAR_KA(2); RESC(); ROT();
  }
  #undef CMASK
  #define CMASK(P0,P1,t) do{int jb_=(t)-(NT-4); if(jb_>=0)cmask(P0,P1,jb_,qrel,hi);}while(0)
  #define ENDW(tt) do{ if((tt)+3<NT){WAIT_BAR(2);} else if((tt)+2<NT){WAIT_BAR(1);} else {WAIT_BAR(0);} PIN_KA(); }while(0)
  for(;t+1<NT;t+=2){
    STEP(pB0,pB1,pA0,pA1,t,(t+3<NT),(t+1<NT),(t+1<NT));       ENDW(t);   RESC(); ROT();
    STEP(pA0,pA1,pB0,pB1,t+1,(t+4<NT),(t+2<NT),(t+2<NT));     ENDW(t+1); RESC(); ROT();
  }
  STEP(pB0,pB1,pA0,pA1,NT-1,false,false,false); RESC();
  { float sacc=pB0[0]+pB0[1]; _Pragma("unroll") for(int r=2;r<16;++r)sacc+=pB0[r]; _Pragma("unroll") for(int r=0;r<16;++r)sacc+=pB1[r]; l_reg+=sacc;
    pw0=(u32x4){PKW(pB0,0),PKW(pB0,2),PKW(pB0,4),PKW(pB0,6)};pw1=(u32x4){PKW(pB0,8),PKW(pB0,10),PKW(pB0,12),PKW(pB0,14)};pw2=(u32x4){PKW(pB1,0),PKW(pB1,2),PKW(pB1,4),PKW(pB1,6)};pw3=(u32x4){PKW(pB1,8),PKW(pB1,10),PKW(pB1,12),PKW(pB1,14)};
    SBAR(); pv(o,vb0+sl_cur,PAF(0),PAF(1),PAF(2),PAF(3)); }
  #undef PKW
  #undef PAF
  #undef VFR
  #undef PIN
  #undef MX3
  #undef GAPA
  #undef GAPB
  #undef EX
  #undef VRD
  #undef KRD
  #undef STEP
  #undef ENDW
  {auto rr=__builtin_amdgcn_permlane32_swap(__float_as_uint(l_reg),__float_as_uint(l_reg),false,false);l_reg=__uint_as_float(rr[0])+__uint_as_float(rr[1]);}
  if(hi==0)wsf[32+r32]=l_reg;asm volatile("s_waitcnt lgkmcnt(0)":::"memory");
  float rli[16];
  #pragma unroll
  for(int r=0;r<16;++r)rli[r]=__builtin_amdgcn_rcpf(wsf[32+crow(r,hi)]);
  bf16*Ow=O+(rowbase+q0+wid*QBLK)*OP+h*D;
  { bf16*stg=(bf16*)(shm+LDS_OST)+wid*2048;
    #pragma unroll
    for(int r=0;r<16;++r){const int orow=crow(r,hi);
      #pragma unroll
      for(int d0=0;d0<2;++d0)stg[orow*64+d0*32+r32]=__float2bfloat16(o[d0][r]*rli[r]);}
    asm volatile("s_waitcnt lgkmcnt(0)":::"memory");
    #pragma unroll
    for(int i=0;i<4;++i){const int row=i*8+(lane>>3),ch=lane&7; const u32x4 v=*(const u32x4*)(stg+row*64+ch*8); ATTN_STORE16(Ow+(long)row*OP+ch*8,v);} }
  asm volatile("s_waitcnt lgkmcnt(0)\n\ts_barrier":::"memory");
  #undef DMA_K
  #undef DMA_V
  #undef KA_LOAD
  #undef QA_SET
  #undef AUG
  #undef WAIT_BAR_KA
  #undef PIN_KA
  #undef CMASK
  #undef START
  #undef RESC
  #undef ROT
}
constexpr int ATTN_LDS_BYTES=LDS_BYTES;
struct AttnTensors { const bf16* Q; const bf16* K; const bf16* V; bf16* O; const unsigned char* KA; };
struct AttnUnit { int bh; int qb; };
struct StaticOrder {
  int vcu;
  __device__ __forceinline__ explicit StaticOrder(int grid,int block):vcu((block%8)*(grid/8)+block/8){}
  __device__ __forceinline__ bool next(int i,AttnUnit&u)const{ if(i>=4)return false; const int s=vcu&15; u.bh=vcu>>4; u.qb=(i==0)?63-s:(i==1)?32+s:(i==2)?31-s:s; return true; }
  __device__ __forceinline__ void a_ready(const AttnUnit&)const{}
  __device__ __forceinline__ void done(const AttnUnit&)const{}
};
template<class Sched,int THRL=8> __device__ __forceinline__ void attn_phase(char*lds,const AttnTensors&T,const Sched&S){
  AttnUnit u;
  for(int i=0;S.next(i,u);++i){ S.a_ready(u); attn_unit<THRL>(u.bh/NHEAD,u.bh%NHEAD,u.qb,0,T.Q,T.K,T.V,T.O,T.KA,lds); S.done(u); }
}
#undef SBAR
#undef WAIT_BAR
}

namespace ck {
#define CK_LAS __attribute__((address_space(3)))
typedef unsigned short bf16_t;
typedef short bf16x8 __attribute__((ext_vector_type(8)));
typedef float f32x16 __attribute__((ext_vector_type(16)));
typedef float f32x4 __attribute__((ext_vector_type(4)));
typedef unsigned u32x4 __attribute__((ext_vector_type(4)));
typedef unsigned u32x2 __attribute__((ext_vector_type(2)));
typedef CK_LAS unsigned short* lbf;
typedef CK_LAS float* lf32;
constexpr int SB = 72;
constexpr int B9 = 64 * SB * 2;
constexpr int SF = 65;
constexpr int SM = 68;
constexpr int SX = 132;
__device__ __forceinline__ unsigned pk2(float lo, float hi) { return ::pk2(lo, hi); }
__device__ __forceinline__ unsigned f2bf(float f) { return ::f2bf(f); }
__device__ __forceinline__ float bflo(unsigned w) { return __builtin_bit_cast(float, w << 16); }
__device__ __forceinline__ float bfhi(unsigned w) { return __builtin_bit_cast(float, w & 0xffff0000u); }
__device__ __forceinline__ int crow(int reg, int hh) { return (reg & 3) + 8 * (reg >> 2) + 4 * hh; }
__device__ __forceinline__ f32x16 mm_lds(lbf A, lbf BT, int I, int J, int lane, f32x16 acc) {
    const int r = lane & 31, hh = lane >> 5;
    const lbf ap = A + (32 * I + r) * SB + 8 * hh; const lbf bp = BT + (32 * J + r) * SB + 8 * hh;
#pragma unroll
    for (int s = 0; s < 4; ++s) { const bf16x8 a = *(const CK_LAS bf16x8*)(ap + 16 * s); const bf16x8 b = *(const CK_LAS bf16x8*)(bp + 16 * s); acc = __builtin_amdgcn_mfma_f32_32x32x16_bf16(a, b, acc, 0, 0, 0); }
    return acc;
}
__device__ __forceinline__ f32x16 mm_gA(const bf16_t* __restrict__ Ag, lbf BT, int I, int J, int lane, f32x16 acc) {
    const int r = lane & 31, hh = lane >> 5;
    bf16x8 a[4];
#pragma unroll
    for (int s = 0; s < 4; ++s) a[s] = *(const bf16x8*)(Ag + (32 * I + r) * 64 + 16 * s + 8 * hh);
    const lbf bp = BT + (32 * J + r) * SB + 8 * hh;
#pragma unroll
    for (int s = 0; s < 4; ++s) { const bf16x8 b = *(const CK_LAS bf16x8*)(bp + 16 * s); acc = __builtin_amdgcn_mfma_f32_32x32x16_bf16(a[s], b, acc, 0, 0, 0); }
    return acc;
}
__device__ __forceinline__ f32x16 mm_gg(const bf16_t* __restrict__ Ag, const bf16_t* __restrict__ BTg, int I, int J, int lane, f32x16 acc) {
    const int r = lane & 31, hh = lane >> 5;
#pragma unroll
    for (int s = 0; s < 4; ++s) { const bf16x8 a = *(const bf16x8*)(Ag + (32 * I + r) * 64 + 16 * s + 8 * hh); const bf16x8 b = *(const bf16x8*)(BTg + (32 * J + r) * 64 + 16 * s + 8 * hh);
        acc = __builtin_amdgcn_mfma_f32_32x32x16_bf16(a, b, acc, 0, 0, 0); }
    return acc;
}
__device__ __forceinline__ f32x16 mm_rA(const bf16x8 (&a)[4], lbf BT, int J, int lane, f32x16 acc) {
    const int r = lane & 31, hh = lane >> 5; const lbf bp = BT + (32 * J + r) * SB + 8 * hh;
#pragma unroll
    for (int s = 0; s < 4; ++s) { const bf16x8 b = *(const CK_LAS bf16x8*)(bp + 16 * s); acc = __builtin_amdgcn_mfma_f32_32x32x16_bf16(a[s], b, acc, 0, 0, 0); }
    return acc;
}
__device__ __forceinline__ void load_gA(bf16x8 (&a)[4], const bf16_t* __restrict__ Ag, int I, int lane) {
    const int r = lane & 31, hh = lane >> 5;
#pragma unroll
    for (int s = 0; s < 4; ++s) a[s] = *(const bf16x8*)(Ag + (32 * I + r) * 64 + 16 * s + 8 * hh);
}
__device__ __forceinline__ f32x16 mm_lA_gB(lbf A, const bf16_t* __restrict__ BTg, int I, int J, int lane, f32x16 acc) {
    const int r = lane & 31, hh = lane >> 5; bf16x8 b[4];
#pragma unroll
    for (int s = 0; s < 4; ++s) b[s] = *(const bf16x8*)(BTg + (32 * J + r) * 64 + 16 * s + 8 * hh);
    const lbf ap = A + (32 * I + r) * SB + 8 * hh;
#pragma unroll
    for (int s = 0; s < 4; ++s) { const bf16x8 a = *(const CK_LAS bf16x8*)(ap + 16 * s); acc = __builtin_amdgcn_mfma_f32_32x32x16_bf16(a, b[s], acc, 0, 0, 0); }
    return acc;
}
__device__ __forceinline__ void frag_store(float* __restrict__ g, int wq, int lane, const f32x16& acc) {
    f32x4* p = (f32x4*)(g + ((size_t)(wq * 64 + lane)) * 16);
    p[0] = (f32x4){acc[0], acc[1], acc[2], acc[3]}; p[1] = (f32x4){acc[4], acc[5], acc[6], acc[7]}; p[2] = (f32x4){acc[8], acc[9], acc[10], acc[11]}; p[3] = (f32x4){acc[12], acc[13], acc[14], acc[15]};
}
__device__ __forceinline__ f32x16 frag_load(const float* __restrict__ g, int wq, int lane) {
    const f32x4* p = (const f32x4*)(g + ((size_t)(wq * 64 + lane)) * 16); const f32x4 a = p[0], b = p[1], c = p[2], d = p[3];
    return (f32x16){a[0], a[1], a[2], a[3], b[0], b[1], b[2], b[3], c[0], c[1], c[2], c[3], d[0], d[1], d[2], d[3]};
}
__device__ __forceinline__ void frag_store_bf(bf16_t* __restrict__ g, int wq, int lane, const f32x16& acc) {
    u32x4* p = (u32x4*)(g + ((size_t)(wq * 64 + lane)) * 16);
    p[0] = (u32x4){pk2(acc[0], acc[1]), pk2(acc[2], acc[3]), pk2(acc[4], acc[5]), pk2(acc[6], acc[7])}; p[1] = (u32x4){pk2(acc[8], acc[9]), pk2(acc[10], acc[11]), pk2(acc[12], acc[13]), pk2(acc[14], acc[15])};
}
__device__ __forceinline__ f32x16 frag_load_bf(const bf16_t* __restrict__ g, int wq, int lane) {
    const u32x4* p = (const u32x4*)(g + ((size_t)(wq * 64 + lane)) * 16); const u32x4 a = p[0], b = p[1];
    return (f32x16){bflo(a[0]), bfhi(a[0]), bflo(a[1]), bfhi(a[1]), bflo(a[2]), bfhi(a[2]), bflo(a[3]), bfhi(a[3]), bflo(b[0]), bfhi(b[0]), bflo(b[1]), bfhi(b[1]), bflo(b[2]), bfhi(b[2]), bflo(b[3]), bfhi(b[3])};
}
__device__ __forceinline__ void tile_store_T(lbf dst, int I, int J, int lane, const f32x16& acc) {
    const int r = lane & 31, hh = lane >> 5;
#pragma unroll
    for (int g = 0; g < 4; ++g) { u32x2 w; w.x = pk2(acc[4 * g], acc[4 * g + 1]); w.y = pk2(acc[4 * g + 2], acc[4 * g + 3]);
        *(CK_LAS u32x2*)(dst + (32 * J + r) * SB + 32 * I + 8 * g + 4 * hh) = w; }
}
__device__ __forceinline__ float fexp(float x) { return __builtin_amdgcn_exp2f(x * 1.4426950408889634f); }
__device__ __forceinline__ float sigm(float x) { return __builtin_amdgcn_rcpf(1.0f + fexp(-x)); }
__device__ __forceinline__ float ftanh(float x) { const float xc = fminf(fmaxf(x, -15.f), 15.f); return 1.0f - 2.0f * __builtin_amdgcn_rcpf(fexp(2.0f * xc) + 1.0f); }
__device__ __forceinline__ float logsig(float x) { const float ax = fabsf(x); return fminf(x, 0.f) - 0.6931471805599453f * __builtin_amdgcn_logf(1.0f + fexp(-ax)); }
template <int CTRL> __device__ __forceinline__ float dpp_f(float v) { return __builtin_bit_cast(float, __builtin_amdgcn_update_dpp(0, __builtin_bit_cast(int, v), CTRL, 0xf, 0xf, false)); }
__device__ __forceinline__ float quad_sum(float v) { v += dpp_f<0xB1>(v); v += dpp_f<0x4E>(v); return v; }

constexpr size_t O_PC = 0, O_QC = 16u << 20, O_GY = 48u << 20, O_YL = 64u << 20, O_VG = 96u << 20, O_GG = 112u << 20, O_H0 = 128u << 20, O_RKD = 144u << 20, O_KV = 145u << 20, O_RT = 177u << 20, O_END = 193u << 20,
                 O_PG = 193u << 20, O_QG = 195u << 20, O_HG = 197u << 20, O_KG = 199u << 20, O_RG = 203u << 20, O_END2 = 207u << 20;
struct RwkvParams {
    const float *mu_rkv, *mu_lora, *w0, *a0, *k_k, *k_a, *r_k, *ln_g, *ln_b, *gn_g;
    const bf16_t *w2t, *a2t, *g2t;
};

constexpr int L_U = 10 * B9, L_MM = L_U + 36864, L_GL = L_MM + 64 * SM * 4, L_END1 = L_GL + 256;
__device__ __forceinline__ void rwkv_stage1(CK_LAS unsigned char* lds, int item, const bf16_t* __restrict__ Pb, int PW, int C_RR, int C_RK, int C_RV, int C_WD, int SEQ, const RwkvParams& p, unsigned char* __restrict__ cw) {
    const int tid = ltid(), lane = tid & 63, wid = __builtin_amdgcn_readfirstlane(tid >> 6), quad = wid >> 2, wq = wid & 3, I = wq >> 1, J = wq & 1, r = lane & 31, hh = lane >> 5;
    const int b = item >> 10, h = (item >> 8) & 3, c = item & 255;
    const size_t m0 = (size_t)b * SEQ + (size_t)c * 64;
    const lbf Am = (lbf)(lds), Bm = (lbf)(lds + B9), Km = (lbf)(lds + 2 * B9), Rm = (lbf)(lds + 3 * B9), VT = (lbf)(lds + 4 * B9), BhT = (lbf)(lds + 5 * B9), KhT = (lbf)(lds + 6 * B9),
              Nm = (lbf)(lds + 7 * B9), Wb = (lbf)(lds + 8 * B9), Wk = (lbf)(lds + 9 * B9);
    const lbf TW = (lbf)(lds + L_U), AD = (lbf)(lds + L_U + B9), SG0 = (lbf)(lds + L_U + 2 * B9), SG1 = (lbf)(lds + L_U + 3 * B9);
    const lbf W2T = BhT, A2T = KhT, G2Ta = Nm, G2Tb = Wb;
    const lf32 X = (lf32)(lds + L_U), MM = (lf32)(lds + L_MM), GL = (lf32)(lds + L_GL);
    const lf32 AA = (lf32)(lds), GGl = (lf32)(lds + 2 * B9);
    const lbf ZlT = Km, X1T = Nm;
    const int t = tid >> 3, c8 = (tid & 7) * 8;
    const size_t m = m0 + t; const bool hp = (c * 64 + t) > 0;
    const bf16_t* pr = Pb + m * PW; const bf16_t* pp = pr - PW;
    float rr[8], kx[8], vv[8];
    {
        const u32x4 z4 = (u32x4){0u, 0u, 0u, 0u};
        const u32x4 cr = *(const u32x4*)(pr + C_RR + h * 64 + c8), ckk = *(const u32x4*)(pr + C_RK + h * 64 + c8), cv = *(const u32x4*)(pr + C_RV + h * 64 + c8);
        const u32x4 qr = hp ? *(const u32x4*)(pp + C_RR + h * 64 + c8) : z4, qk = hp ? *(const u32x4*)(pp + C_RK + h * 64 + c8) : z4, qv = hp ? *(const u32x4*)(pp + C_RV + h * 64 + c8) : z4;
#pragma unroll
        for (int e = 0; e < 8; ++e) { const int ch = h * 64 + c8 + e;
            const float a_ = (e & 1) ? bfhi(cr[e >> 1]) : bflo(cr[e >> 1]), b_ = (e & 1) ? bfhi(qr[e >> 1]) : bflo(qr[e >> 1]); rr[e] = a_ + (b_ - a_) * p.mu_rkv[ch];
            const float c_ = (e & 1) ? bfhi(ckk[e >> 1]) : bflo(ckk[e >> 1]), d_ = (e & 1) ? bfhi(qk[e >> 1]) : bflo(qk[e >> 1]); kx[e] = c_ + (d_ - c_) * p.mu_rkv[256 + ch];
            const float e_ = (e & 1) ? bfhi(cv[e >> 1]) : bflo(cv[e >> 1]), f_ = (e & 1) ? bfhi(qv[e >> 1]) : bflo(qv[e >> 1]); vv[e] = e_ + (f_ - e_) * p.mu_rkv[512 + ch]; }
#pragma unroll
        for (int q = 0; q < 4; ++q) { const u32x4 cl = *(const u32x4*)(pr + C_WD + q * 64 + c8); const u32x4 ql = hp ? *(const u32x4*)(pp + C_WD + q * 64 + c8) : z4;
            float lo[8];
#pragma unroll
            for (int e = 0; e < 8; ++e) { const float a_ = (e & 1) ? bfhi(cl[e >> 1]) : bflo(cl[e >> 1]), b_ = (e & 1) ? bfhi(ql[e >> 1]) : bflo(ql[e >> 1]); const float x = a_ + (b_ - a_) * p.mu_lora[q * 64 + c8 + e];
                lo[e] = (q == 0) ? ftanh(x) : (q == 1 ? x : sigm(x)); }
            u32x4 w; w.x = pk2(lo[0], lo[1]); w.y = pk2(lo[2], lo[3]); w.z = pk2(lo[4], lo[5]); w.w = pk2(lo[6], lo[7]);
            *(CK_LAS u32x4*)((q == 0 ? TW : q == 1 ? AD : q == 2 ? SG0 : SG1) + t * SB + c8) = w; }
        *(CK_LAS u32x4*)(W2T + t * SB + c8) = *(const u32x4*)(p.w2t + ((size_t)h * 64 + t) * 64 + c8);
        *(CK_LAS u32x4*)(A2T + t * SB + c8) = *(const u32x4*)(p.a2t + ((size_t)h * 64 + t) * 64 + c8);
        *(CK_LAS u32x4*)(G2Ta + t * SB + c8) = *(const u32x4*)(p.g2t + ((size_t)h * 64 + t) * 128 + c8);
        *(CK_LAS u32x4*)(G2Tb + t * SB + c8) = *(const u32x4*)(p.g2t + ((size_t)h * 64 + t) * 128 + 64 + c8);
    }
    __syncthreads();
    if (quad == 0) {
        f32x16 z = mm_lds(TW, W2T, I, J, lane, f32x16{}); f32x16 za = mm_lds(AD, A2T, I, J, lane, f32x16{});
        const int ch = 32 * J + r; const float w0c = p.w0[h * 64 + ch], a0c = p.a0[h * 64 + ch];
#pragma unroll
        for (int g = 0; g < 16; ++g) { const int tt = 32 * I + crow(g, hh); const float lw = logsig(w0c + z[g]) - 0.5f; MM[tt * SF + ch] = -fexp(lw); AA[tt * SF + ch] = sigm(a0c + za[g]); }
    } else {
        f32x16 zg = mm_lds(SG0, G2Ta, I, J, lane, f32x16{}); zg = mm_lds(SG1, G2Tb, I, J, lane, zg);
        const int ch = 32 * J + r;
#pragma unroll
        for (int g = 0; g < 16; ++g) { const int tt = 32 * I + crow(g, hh); GGl[tt * SF + ch] = zg[g]; }
    }
    __syncthreads();
    {
        const int ch = tid & 63, seg = tid >> 6; float v8[8]; float run = 0.f;
#pragma unroll
        for (int i = 0; i < 8; ++i) { run += MM[(seg * 8 + i) * SF + ch]; v8[i] = run; }
        const lf32 TOT = (lf32)(lds + L_U);
        TOT[seg * 64 + ch] = run;
        __syncthreads();
        float off = 0.f;
#pragma unroll
        for (int s2 = 0; s2 < 8; ++s2) off += (s2 < seg) ? TOT[s2 * 64 + ch] : 0.f;
#pragma unroll
        for (int i = 0; i < 8; ++i) MM[(seg * 8 + i) * SF + ch] = v8[i] + off;
    }
    __syncthreads();
    float aa[8], gg[8], lw[8], lwp[8], lwl[8];
#pragma unroll
    for (int e = 0; e < 8; ++e) { aa[e] = AA[t * SF + c8 + e]; gg[e] = GGl[t * SF + c8 + e]; lw[e] = MM[t * SF + c8 + e]; lwp[e] = t > 0 ? MM[(t - 1) * SF + c8 + e] : 0.f; lwl[e] = MM[63 * SF + c8 + e]; }
    __syncthreads();
    {
        float kk[8], k2[8]; float ss = 0.f, rk = 0.f;
#pragma unroll
        for (int e = 0; e < 8; ++e) { const int ch = h * 64 + c8 + e; kk[e] = kx[e] * p.k_k[ch]; ss += kk[e] * kk[e]; k2[e] = kx[e] * (1.0f + (aa[e] - 1.0f) * p.k_a[ch]); rk += rr[e] * k2[e] * p.r_k[ch]; }
        ss = quad_sum(ss); ss += dpp_f<0x141>(ss); rk = quad_sum(rk); rk += dpp_f<0x141>(rk);
        const float inv = 1.0f / fmaxf(sqrtf(ss), 1e-12f);
        float am[8], bm[8], km[8], rm[8];
#pragma unroll
        for (int e = 0; e < 8; ++e) { kk[e] *= inv; const float g_ = fexp(lw[e]), gi = fexp(-lw[e]), gp = fexp(lwp[e]), gl = fexp(lwl[e] - lw[e]); const float ka = kk[e] * aa[e];
            am[e] = -kk[e] * gp; bm[e] = ka * gi; km[e] = k2[e] * gi; rm[e] = rr[e] * g_;
            VT[(c8 + e) * SB + t] = (bf16_t)f2bf(vv[e]); BhT[(c8 + e) * SB + t] = (bf16_t)f2bf(ka * gl); KhT[(c8 + e) * SB + t] = (bf16_t)f2bf(k2[e] * gl);
            X[t * SX + c8 + e] = am[e]; }
        u32x4 w;
        w.x = pk2(am[0], am[1]); w.y = pk2(am[2], am[3]); w.z = pk2(am[4], am[5]); w.w = pk2(am[6], am[7]); *(CK_LAS u32x4*)(Am + t * SB + c8) = w;
        w.x = pk2(bm[0], bm[1]); w.y = pk2(bm[2], bm[3]); w.z = pk2(bm[4], bm[5]); w.w = pk2(bm[6], bm[7]); *(CK_LAS u32x4*)(Bm + t * SB + c8) = w;
        w.x = pk2(km[0], km[1]); w.y = pk2(km[2], km[3]); w.z = pk2(km[4], km[5]); w.w = pk2(km[6], km[7]); *(CK_LAS u32x4*)(Km + t * SB + c8) = w;
        w.x = pk2(rm[0], rm[1]); w.y = pk2(rm[2], rm[3]); w.z = pk2(rm[4], rm[5]); w.w = pk2(rm[6], rm[7]); *(CK_LAS u32x4*)(Rm + t * SB + c8) = w;
        if (t == 63) {
#pragma unroll
            for (int e = 0; e < 8; ++e) GL[c8 + e] = fexp(lwl[e]); }
        w.x = pk2(vv[0], vv[1]); w.y = pk2(vv[2], vv[3]); w.z = pk2(vv[4], vv[5]); w.w = pk2(vv[6], vv[7]); *(u32x4*)(cw + O_VG + (size_t)item * 8192 + (t * 64 + c8) * 2) = w;
        w.x = pk2(gg[0], gg[1]); w.y = pk2(gg[2], gg[3]); w.z = pk2(gg[4], gg[5]); w.w = pk2(gg[6], gg[7]); *(u32x4*)(cw + O_GG + (size_t)item * 8192 + (t * 64 + c8) * 2) = w;
        if ((tid & 7) == 0) *(float*)(cw + O_RKD + (size_t)item * 256 + t * 4) = rk;
    }
    __syncthreads();
    {
        const f32x16 p1 = mm_lds(Am, quad == 0 ? Bm : Km, I, J, lane, f32x16{}); const f32x16 p2 = mm_lds(Rm, quad == 0 ? Bm : Km, I, J, lane, f32x16{});
        const int ii = 32 * J + r;
#pragma unroll
        for (int g = 0; g < 16; ++g) { const int tt = 32 * I + crow(g, hh);
            if (quad == 0) { MM[tt * SM + (ii & 3) * 16 + (ii >> 2)] = (ii < tt) ? p1[g] : 0.f; Wb[tt * SB + ii] = (bf16_t)f2bf((ii <= tt) ? p2[g] : 0.f); }
            else { Nm[tt * SB + ii] = (bf16_t)f2bf((ii < tt) ? p1[g] : 0.f); Wk[tt * SB + ii] = (bf16_t)f2bf((ii <= tt) ? p2[g] : 0.f); } }
    }
    __syncthreads();
    if (quad == 0) { const f32x16 nv = mm_lds(Nm, VT, I, J, lane, f32x16{}); const int vcol = 64 + 32 * J + r;
#pragma unroll
        for (int g = 0; g < 16; ++g) X[(32 * I + crow(g, hh)) * SX + vcol] = nv[g]; }
    __syncthreads();
    {
        const int col = tid >> 2, q = tid & 3;
        float xs[16];
#pragma unroll
        for (int k = 0; k < 16; ++k) xs[k] = X[(q + 4 * k) * SX + col];
#pragma unroll
        for (int tt = 1; tt < 64; ++tt) {
            const CK_LAS f32x4* mr = (const CK_LAS f32x4*)(MM + tt * SM + q * 16);
            float s0 = 0.f, s1 = 0.f, s2 = 0.f, s3 = 0.f;
#pragma unroll
            for (int k4 = 0; k4 < (tt + 15) / 16; ++k4) { const f32x4 mv = mr[k4]; s0 += mv[0] * xs[4 * k4]; s1 += mv[1] * xs[4 * k4 + 1]; s2 += mv[2] * xs[4 * k4 + 2]; s3 += mv[3] * xs[4 * k4 + 3]; }
            const float sm = quad_sum((s0 + s1) + (s2 + s3));
            xs[tt >> 2] += (q == (tt & 3)) ? sm : 0.f;
        }
        const lbf dstT = (col < 64) ? (X1T + col * SB) : (ZlT + (col - 64) * SB);
#pragma unroll
        for (int k = 0; k < 16; ++k) dstT[q + 4 * k] = (bf16_t)f2bf(xs[k]);
    }
    __syncthreads();
    if (quad == 0) {
        const f32x16 gy = mm_lds(Wb, X1T, I, J, lane, f32x16{}); const f32x16 pc = mm_lds(BhT, X1T, I, J, lane, f32x16{});
        bf16_t* gyg = (bf16_t*)(cw + O_GY + (size_t)item * 8192); bf16_t* pcg = (bf16_t*)(cw + O_PC + (size_t)item * 8192);
        const int cc = 32 * J + r;
#pragma unroll
        for (int g = 0; g < 16; ++g) { const int rw = 32 * I + crow(g, hh);
            gyg[rw * 64 + cc] = (bf16_t)f2bf(gy[g] + __builtin_bit_cast(float, (unsigned)Rm[rw * SB + cc] << 16));
            pcg[rw * 64 + cc] = (bf16_t)f2bf(pc[g] + (rw == cc ? GL[cc] : 0.f)); }
    } else {
        f32x16 yl = mm_lds(ZlT, Wb, I, J, lane, f32x16{}); yl = mm_lds(VT, Wk, I, J, lane, yl);
        f32x16 qc = mm_lds(BhT, ZlT, I, J, lane, f32x16{}); qc = mm_lds(KhT, VT, I, J, lane, qc);
        frag_store((float*)(cw + O_YL + (size_t)item * 16384), wq, lane, yl); frag_store_bf((bf16_t*)(cw + O_QC) + (size_t)item * 4096, wq, lane, qc);
    }
    __syncthreads();
}

template <int NST> __device__ __forceinline__ void rwkv_scan(CK_LAS unsigned char* lds, int chain, const bf16_t* __restrict__ pcb, const bf16_t* __restrict__ qcb, bf16_t* __restrict__ h0b) {
    const int tid = ltid(), lane = tid & 63, wid = __builtin_amdgcn_readfirstlane(tid >> 6), quad = wid >> 2, wq = wid & 3, I = wq >> 1, J = wq & 1, r = lane & 31, hh = lane >> 5, qtid = tid & 255;
    const lbf HT = (lbf)(lds + quad * B9);
    for (int i = qtid; i < 64 * SB / 2; i += 256) ((CK_LAS unsigned*)HT)[i] = 0u;
    __syncthreads();
    const bool on = chain >= 0; const size_t it0 = (size_t)(on ? chain : 0) * NST;
    const bf16_t* pcg = pcb + it0 * 4096; const bf16_t* qcg = qcb + it0 * 4096; bf16_t* h0g = h0b + it0 * 4096;
    constexpr int PD = 5;
    bf16x8 ar[PD][4]; f32x16 qr[PD];
#define CK_LOADSTEP(A_, Q_, cc) do { const int c_ = (cc) < NST ? (cc) : NST - 1; _Pragma("unroll") for (int s_ = 0; s_ < 4; ++s_) A_[s_] = *(const bf16x8*)(pcg + (size_t)c_ * 4096 + (32 * I + r) * 64 + 16 * s_ + 8 * hh); Q_ = frag_load_bf(qcg + (size_t)c_ * 4096, wq, lane); } while (0)
#pragma unroll
    for (int k = 0; k < PD; ++k) CK_LOADSTEP(ar[k], qr[k], k);
    for (int c = 0; c < NST + PD - 1; c += PD) {
#pragma unroll
        for (int k = 0; k < PD; ++k) {
            const int cc = c + k;
            if (cc < NST) {
            if (on) { const int row = qtid >> 2, seg = (qtid & 3) * 16; const u32x4 w0 = *(const CK_LAS u32x4*)(HT + row * SB + seg), w1 = *(const CK_LAS u32x4*)(HT + row * SB + seg + 8);
                      u32x4* dst = (u32x4*)(h0g + (size_t)cc * 4096 + row * 64 + seg); dst[0] = w0; dst[1] = w1; }
            f32x16 acc = qr[k];
            const lbf bp = HT + (32 * J + r) * SB + 8 * hh;
#pragma unroll
            for (int s_ = 0; s_ < 4; ++s_) { const bf16x8 bfr = *(const CK_LAS bf16x8*)(bp + 16 * s_); acc = __builtin_amdgcn_mfma_f32_32x32x16_bf16(ar[k][s_], bfr, acc, 0, 0, 0); }
            CK_LOADSTEP(ar[k], qr[k], cc + PD);
            asm volatile("s_waitcnt lgkmcnt(0)\n\ts_barrier" ::: "memory");
            tile_store_T(HT, I, J, lane, acc);
            asm volatile("s_waitcnt lgkmcnt(0)\n\ts_barrier" ::: "memory");
            }
        }
    }
#undef CK_LOADSTEP
}

__device__ __forceinline__ void rwkv_level1(CK_LAS unsigned char* lds, int task, unsigned char* __restrict__ cw) {
    const int tid = ltid(), lane = tid & 63, wid = __builtin_amdgcn_readfirstlane(tid >> 6), quad = wid >> 2, wq = wid & 3, I = wq >> 1, J = wq & 1, r = lane & 31, hh = lane >> 5;
    const lbf PTh = (lbf)(lds + quad * 4 * B9), PTl = PTh + 64 * SB, QTh = PTl + 64 * SB, QTl = QTh + 64 * SB;
    const bool on = task >= 0; const int tk = on ? task : 0; const size_t item0 = (size_t)(tk >> 5) * 256 + (size_t)(tk & 31) * 8;
    f32x16 PG, QG = f32x16{};
#pragma unroll
    for (int g = 0; g < 16; ++g) PG[g] = (I == J && crow(g, hh) == r) ? 1.0f : 0.0f;
    for (int j = 0; j < 8; ++j) {
        const size_t item = item0 + j;
        bf16x8 a[4]; load_gA(a, (const bf16_t*)(cw + O_PC) + item * 4096, I, lane);
        f32x16 qn = frag_load_bf((const bf16_t*)(cw + O_QC) + item * 4096, wq, lane);
        f32x16 pl, ql;
#pragma unroll
        for (int g = 0; g < 16; ++g) { pl[g] = PG[g] - __builtin_bit_cast(float, f2bf(PG[g]) << 16); ql[g] = QG[g] - __builtin_bit_cast(float, f2bf(QG[g]) << 16); }
        tile_store_T(PTh, I, J, lane, PG); tile_store_T(PTl, I, J, lane, pl); tile_store_T(QTh, I, J, lane, QG); tile_store_T(QTl, I, J, lane, ql);
        __syncthreads();
        f32x16 pn = mm_rA(a, PTh, J, lane, f32x16{}); pn = mm_rA(a, PTl, J, lane, pn);
        qn = mm_rA(a, QTh, J, lane, qn); qn = mm_rA(a, QTl, J, lane, qn);
        __syncthreads();
        PG = pn; QG = qn;
    }
    if (on) { bf16_t* pgg = (bf16_t*)(cw + O_PG) + (size_t)tk * 4096; const int cc = 32 * J + r;
#pragma unroll
        for (int g = 0; g < 16; ++g) pgg[(32 * I + crow(g, hh)) * 64 + cc] = (bf16_t)f2bf(PG[g]);
        frag_store_bf((bf16_t*)(cw + O_QG) + (size_t)tk * 4096, wq, lane, QG); }
}

constexpr int L_RW3 = B9 + 64 * SF * 4;
__device__ __forceinline__ void rwkv_stage3g(CK_LAS unsigned char* ldsq, int task, const RwkvParams& p, const unsigned char* __restrict__ cw, bf16_t* __restrict__ MIXB, int SEQ) {
    const int tid = ltid(), lane = tid & 63, wid = __builtin_amdgcn_readfirstlane(tid >> 6), wq = wid & 3, I = wq >> 1, J = wq & 1, r = lane & 31, hh = lane >> 5, qtid = tid & 255;
    const lbf HT = (lbf)ldsq; const lf32 Y = (lf32)(ldsq + B9);
    const bool on = task >= 0; const int tk = on ? task : 0; const int item0 = (tk >> 5) * 256 + (tk & 31) * 8;
    { const int row = qtid >> 2, seg = (qtid & 3) * 16; const u32x4* src = (const u32x4*)((const bf16_t*)(cw + O_HG) + (size_t)tk * 4096 + row * 64 + seg);
      *(CK_LAS u32x4*)(HT + row * SB + seg) = src[0]; *(CK_LAS u32x4*)(HT + row * SB + seg + 8) = src[1]; }
    __syncthreads();
    for (int j = 0; j < 8; ++j) {
        const int item = item0 + j;
        bf16x8 a[4]; load_gA(a, (const bf16_t*)(cw + O_PC) + (size_t)item * 4096, I, lane);
        f32x16 hn = frag_load_bf((const bf16_t*)(cw + O_QC) + (size_t)item * 4096, wq, lane);
        {
            f32x16 acc = frag_load((const float*)(cw + O_YL) + (size_t)item * 4096, wq, lane);
            acc = mm_lA_gB(HT, (const bf16_t*)(cw + O_GY) + (size_t)item * 4096, I, J, lane, acc);
#pragma unroll
            for (int g = 0; g < 16; ++g) Y[(32 * J + r) * SF + 32 * I + crow(g, hh)] = acc[g];
        }
        hn = mm_rA(a, HT, J, lane, hn);
        __syncthreads();
        tile_store_T(HT, I, J, lane, hn);
        if (on) {
            const int b = item >> 10, h = (item >> 8) & 3, c = item & 255; const int t = qtid >> 2, c16 = (qtid & 3) * 16;
            float y[16]; float s = 0.f;
#pragma unroll
            for (int e = 0; e < 16; ++e) { y[e] = Y[t * SF + c16 + e]; s += y[e]; }
            const float mu = quad_sum(s) * (1.f / 64.f); float s2 = 0.f;
#pragma unroll
            for (int e = 0; e < 16; ++e) { y[e] -= mu; s2 += y[e] * y[e]; }
            const float rstd = 1.0f / sqrtf(quad_sum(s2) * (1.f / 64.f) + 64e-5f);
            const u32x4* vg = (const u32x4*)(cw + O_VG + (size_t)item * 8192 + (t * 64 + c16) * 2); const u32x4* gg = (const u32x4*)(cw + O_GG + (size_t)item * 8192 + (t * 64 + c16) * 2);
            const float rk = *(const float*)(cw + O_RKD + (size_t)item * 256 + t * 4);
            unsigned ow[8];
#pragma unroll
            for (int hv = 0; hv < 2; ++hv) { const u32x4 vw = vg[hv], gw = gg[hv];
#pragma unroll
                for (int e2 = 0; e2 < 4; ++e2) { const int e = hv * 8 + 2 * e2; const int ch = h * 64 + c16 + e;
                    const float o0 = (y[e] * rstd * p.ln_g[ch] + p.ln_b[ch] + rk * bflo(vw[e2])) * bflo(gw[e2]);
                    const float o1 = (y[e + 1] * rstd * p.ln_g[ch + 1] + p.ln_b[ch + 1] + rk * bfhi(vw[e2])) * bfhi(gw[e2]);
                    ow[hv * 4 + e2] = pk2(o0, o1); } }
            u32x4* dst = (u32x4*)(MIXB + ((size_t)b * SEQ + (size_t)c * 64 + t) * 1024 + 512 + h * 64 + c16);
            dst[0] = (u32x4){ow[0], ow[1], ow[2], ow[3]}; dst[1] = (u32x4){ow[4], ow[5], ow[6], ow[7]};
        }
        __syncthreads();
    }
}

__device__ __forceinline__ void rwkv_stage3(CK_LAS unsigned char* ldsq, int item, const RwkvParams& p, const unsigned char* __restrict__ cw, bf16_t* __restrict__ MIXB, int SEQ) {
    const int tid = ltid(), lane = tid & 63, wid = __builtin_amdgcn_readfirstlane(tid >> 6), wq = wid & 3, I = wq >> 1, J = wq & 1, r = lane & 31, hh = lane >> 5, qtid = tid & 255;
    const lf32 Y = (lf32)ldsq;
    if (item >= 0) {
        f32x16 acc = frag_load((const float*)(cw + O_YL) + (size_t)item * 4096, wq, lane);
        acc = mm_gg((const bf16_t*)(cw + O_H0) + (size_t)item * 4096, (const bf16_t*)(cw + O_GY) + (size_t)item * 4096, I, J, lane, acc);
#pragma unroll
        for (int g = 0; g < 16; ++g) Y[(32 * J + r) * SF + 32 * I + crow(g, hh)] = acc[g];
    }
    __syncthreads();
    if (item >= 0) {
        const int b = item >> 10, h = (item >> 8) & 3, c = item & 255; const int t = qtid >> 2, c16 = (qtid & 3) * 16;
        float y[16]; float s = 0.f;
#pragma unroll
        for (int e = 0; e < 16; ++e) { y[e] = Y[t * SF + c16 + e]; s += y[e]; }
        const float mu = quad_sum(s) * (1.f / 64.f); float s2 = 0.f;
#pragma unroll
        for (int e = 0; e < 16; ++e) { y[e] -= mu; s2 += y[e] * y[e]; }
        const float rstd = 1.0f / sqrtf(quad_sum(s2) * (1.f / 64.f) + 64e-5f);
        const u32x4* vg = (const u32x4*)(cw + O_VG + (size_t)item * 8192 + (t * 64 + c16) * 2); const u32x4* gg = (const u32x4*)(cw + O_GG + (size_t)item * 8192 + (t * 64 + c16) * 2);
        const float rk = *(const float*)(cw + O_RKD + (size_t)item * 256 + t * 4);
        unsigned ow[8];
#pragma unroll
        for (int hv = 0; hv < 2; ++hv) { const u32x4 vw = vg[hv], gw = gg[hv];
#pragma unroll
            for (int e2 = 0; e2 < 4; ++e2) { const int e = hv * 8 + 2 * e2; const int ch = h * 64 + c16 + e;
                const float o0 = (y[e] * rstd * p.ln_g[ch] + p.ln_b[ch] + rk * bflo(vw[e2])) * bflo(gw[e2]);
                const float o1 = (y[e + 1] * rstd * p.ln_g[ch + 1] + p.ln_b[ch + 1] + rk * bfhi(vw[e2])) * bfhi(gw[e2]);
                ow[hv * 4 + e2] = pk2(o0, o1); } }
        u32x4* dst = (u32x4*)(MIXB + ((size_t)b * SEQ + (size_t)c * 64 + t) * 1024 + 512 + h * 64 + c16);
        dst[0] = (u32x4){ow[0], ow[1], ow[2], ow[3]}; dst[1] = (u32x4){ow[4], ow[5], ow[6], ow[7]};
    }
    __syncthreads();
}

__device__ __forceinline__ void rot16(float (&o)[16], const bf16_t* __restrict__ prow, int colbase, int c16, const float* __restrict__ ropet  ) {
    const u32x4* own = (const u32x4*)(prow + colbase + c16); const u32x4* par = (const u32x4*)(prow + colbase + (c16 ^ 32));
    const f32x4* cs = (const f32x4*)(ropet + 2 * (c16 & 31));
#pragma unroll
    for (int hv = 0; hv < 2; ++hv) { const u32x4 ow = own[hv], pw = par[hv];
#pragma unroll
        for (int e2 = 0; e2 < 4; ++e2) { const f32x4 csv = cs[hv * 4 + e2];
            const float x0 = bflo(ow[e2]), x1 = bfhi(ow[e2]), p0 = bflo(pw[e2]), p1 = bfhi(pw[e2]);
            o[hv * 8 + 2 * e2] = (c16 < 32) ? (x0 * csv[0] - p0 * csv[1]) : (p0 * csv[1] + x0 * csv[0]);
            o[hv * 8 + 2 * e2 + 1] = (c16 < 32) ? (x1 * csv[2] - p1 * csv[3]) : (p1 * csv[3] + x1 * csv[2]); } }
}
__device__ __forceinline__ void ret_stage1(CK_LAS unsigned char* ldsq, int item, const bf16_t* __restrict__ Pb, int PW, int C_TK, int C_TV, int SEQ, const float* __restrict__ ROPE, unsigned char* __restrict__ cw) {
    const int tid = ltid(), lane = tid & 63, wid = __builtin_amdgcn_readfirstlane(tid >> 6), wq = wid & 3, I = wq >> 1, J = wq & 1, qtid = tid & 255;
    const lbf VT = (lbf)ldsq, KdT = (lbf)(ldsq + B9);
    if (item >= 0) {
        const int b = item >> 10, h = (item >> 8) & 3, c = item & 255; const int t = qtid >> 2, c16 = (qtid & 3) * 16; const int pos = c * 64 + t;
        const bf16_t* prow = Pb + ((size_t)b * SEQ + pos) * PW;
        float kr[16]; rot16(kr, prow, C_TK + h * 64, c16, ROPE + (size_t)pos * 64);
        const float lg = __builtin_amdgcn_logf(1.0f - __builtin_amdgcn_exp2f(-5.0f - (float)h));
        const float dec = 0.125f * __builtin_amdgcn_exp2f(lg * (float)(63 - t));
        const u32x4* vp = (const u32x4*)(prow + C_TV + h * 64 + c16);
#pragma unroll
        for (int hv = 0; hv < 2; ++hv) { const u32x4 vw = vp[hv];
#pragma unroll
            for (int e2 = 0; e2 < 4; ++e2) { const int e = hv * 8 + 2 * e2;
                VT[(c16 + e) * SB + t] = (bf16_t)(vw[e2] & 0xffffu); VT[(c16 + e + 1) * SB + t] = (bf16_t)(vw[e2] >> 16);
                KdT[(c16 + e) * SB + t] = (bf16_t)f2bf(kr[e] * dec); KdT[(c16 + e + 1) * SB + t] = (bf16_t)f2bf(kr[e + 1] * dec); } }
    }
    __syncthreads();
    if (item >= 0) { const f32x16 kv = mm_lds(VT, KdT, I, J, lane, f32x16{}); frag_store_bf((bf16_t*)(cw + O_KV) + (size_t)item * 4096, wq, lane, kv); }
    __syncthreads();
}
__device__ __forceinline__ void ret_scan(int chain, unsigned char* __restrict__ cw) {
    const int tid = ltid(), lane = tid & 63, wid = __builtin_amdgcn_readfirstlane(tid >> 6), wq = wid & 3, I = wq >> 1, J = wq & 1, r = lane & 31, hh = lane >> 5;
    const int h = chain & 3; const float lg = __builtin_amdgcn_logf(1.0f - __builtin_amdgcn_exp2f(-5.0f - (float)h)); const float g64 = __builtin_amdgcn_exp2f(lg * 64.0f);
    const bf16_t* kvg = (const bf16_t*)(cw + O_KV) + (size_t)chain * 256 * 4096; bf16_t* rtg = (bf16_t*)(cw + O_RT) + (size_t)chain * 256 * 4096;
    f32x16 R = f32x16{}; constexpr int PD = 8; f32x16 nx[PD];
#pragma unroll
    for (int k = 0; k < PD; ++k) nx[k] = frag_load_bf(kvg + (size_t)k * 4096, wq, lane);
    for (int c = 0; c < 256; c += PD) {
#pragma unroll
        for (int k = 0; k < PD; ++k) { const int cc = c + k; bf16_t* dst = rtg + (size_t)cc * 4096;
#pragma unroll
            for (int g = 0; g < 16; ++g) dst[(32 * I + crow(g, hh)) * 64 + 32 * J + r] = (bf16_t)f2bf(R[g]);
            const f32x16 kvc = nx[k]; const int nn = cc + PD < 256 ? cc + PD : 255;
            nx[k] = frag_load_bf(kvg + (size_t)nn * 4096, wq, lane);
#pragma unroll
            for (int g = 0; g < 16; ++g) R[g] = R[g] * g64 + kvc[g]; }
    }
}
constexpr int L_RET3 = 4 * B9 + 64 * SF * 4;
__device__ __forceinline__ void ret_stage3(CK_LAS unsigned char* ldsq, int item, const bf16_t* __restrict__ Pb, int PW, int C_TQ, int C_TK, int C_TV, int C_TG, int SEQ, const float* __restrict__ ROPE,
                                           const float* __restrict__ gn_g, const unsigned char* __restrict__ cw, bf16_t* __restrict__ MIXB) {
    const int tid = ltid(), lane = tid & 63, wid = __builtin_amdgcn_readfirstlane(tid >> 6), wq = wid & 3, I = wq >> 1, J = wq & 1, r = lane & 31, hh = lane >> 5, qtid = tid & 255;
    const lbf Qr = (lbf)ldsq, Kr = (lbf)(ldsq + B9), VT = (lbf)(ldsq + 2 * B9), Sb = (lbf)(ldsq + 3 * B9); const lf32 Y = (lf32)(ldsq + 4 * B9);
    const int b = item >= 0 ? item >> 10 : 0, h = item >= 0 ? (item >> 8) & 3 : 0, c = item >= 0 ? item & 255 : 0; const int t = qtid >> 2, c16 = (qtid & 3) * 16; const int pos = c * 64 + t;
    const float lg = __builtin_amdgcn_logf(1.0f - __builtin_amdgcn_exp2f(-5.0f - (float)h));
    const bf16_t* prow = Pb + ((size_t)b * SEQ + pos) * PW;
    if (item >= 0) {
        float qr[16], kr[16]; rot16(qr, prow, C_TQ + h * 64, c16, ROPE + (size_t)pos * 64); rot16(kr, prow, C_TK + h * 64, c16, ROPE + (size_t)pos * 64);
        u32x4 w;
        w.x = pk2(qr[0], qr[1]); w.y = pk2(qr[2], qr[3]); w.z = pk2(qr[4], qr[5]); w.w = pk2(qr[6], qr[7]); *(CK_LAS u32x4*)(Qr + t * SB + c16) = w;
        w.x = pk2(qr[8], qr[9]); w.y = pk2(qr[10], qr[11]); w.z = pk2(qr[12], qr[13]); w.w = pk2(qr[14], qr[15]); *(CK_LAS u32x4*)(Qr + t * SB + c16 + 8) = w;
#pragma unroll
        for (int e = 0; e < 16; ++e) kr[e] *= 0.125f;
        w.x = pk2(kr[0], kr[1]); w.y = pk2(kr[2], kr[3]); w.z = pk2(kr[4], kr[5]); w.w = pk2(kr[6], kr[7]); *(CK_LAS u32x4*)(Kr + t * SB + c16) = w;
        w.x = pk2(kr[8], kr[9]); w.y = pk2(kr[10], kr[11]); w.z = pk2(kr[12], kr[13]); w.w = pk2(kr[14], kr[15]); *(CK_LAS u32x4*)(Kr + t * SB + c16 + 8) = w;
        const u32x4* vp = (const u32x4*)(prow + C_TV + h * 64 + c16);
#pragma unroll
        for (int hv = 0; hv < 2; ++hv) { const u32x4 vw = vp[hv];
#pragma unroll
            for (int e2 = 0; e2 < 4; ++e2) { const int e = hv * 8 + 2 * e2; VT[(c16 + e) * SB + t] = (bf16_t)(vw[e2] & 0xffffu); VT[(c16 + e + 1) * SB + t] = (bf16_t)(vw[e2] >> 16); } }
    }
    __syncthreads();
    if (item >= 0) {
        f32x16 st = mm_lds(Kr, Qr, I, J, lane, f32x16{}); const int tt = 32 * J + r;
#pragma unroll
        for (int g = 0; g < 16; ++g) { const int ii = 32 * I + crow(g, hh); st[g] = (ii <= tt) ? st[g] * __builtin_amdgcn_exp2f(lg * (float)(tt - ii)) : 0.f; }
        tile_store_T(Sb, I, J, lane, st);
    }
    __syncthreads();
    if (item >= 0) {
        const f32x16 yi = mm_lds(VT, Sb, I, J, lane, f32x16{}); const f32x16 yc = mm_gA((const bf16_t*)(cw + O_RT) + (size_t)item * 4096, Qr, I, J, lane, f32x16{});
        const int tt = 32 * J + r; const float qd = __builtin_amdgcn_exp2f(lg * (float)(tt + 1));
#pragma unroll
        for (int g = 0; g < 16; ++g) Y[tt * SF + 32 * I + crow(g, hh)] = yi[g] + qd * yc[g];
    }
    __syncthreads();
    if (item >= 0) {
        float y[16]; float s = 0.f;
#pragma unroll
        for (int e = 0; e < 16; ++e) { y[e] = Y[t * SF + c16 + e]; s += y[e]; }
        const float mu = quad_sum(s) * (1.f / 64.f); float s2 = 0.f;
#pragma unroll
        for (int e = 0; e < 16; ++e) { y[e] -= mu; s2 += y[e] * y[e]; }
        const float rstd = 1.0f / sqrtf(quad_sum(s2) * (1.f / 64.f) + 1e-6f);
        const u32x4* gp = (const u32x4*)(prow + C_TG + h * 64 + c16); unsigned ow[8];
#pragma unroll
        for (int hv = 0; hv < 2; ++hv) { const u32x4 gw = gp[hv];
#pragma unroll
            for (int e2 = 0; e2 < 4; ++e2) { const int e = hv * 8 + 2 * e2; const int ch = h * 64 + c16 + e; const float g0 = bflo(gw[e2]), g1 = bfhi(gw[e2]);
                ow[hv * 4 + e2] = pk2(y[e] * rstd * gn_g[ch] * (g0 * sigm(g0)), y[e + 1] * rstd * gn_g[ch + 1] * (g1 * sigm(g1))); } }
        u32x4* dst = (u32x4*)(MIXB + ((size_t)b * SEQ + pos) * 1024 + 768 + h * 64 + c16);
        dst[0] = (u32x4){ow[0], ow[1], ow[2], ow[3]}; dst[1] = (u32x4){ow[4], ow[5], ow[6], ow[7]};
    }
    __syncthreads();
}
__device__ __forceinline__ void ret_level1(int task, unsigned char* __restrict__ cw) {
    const int tid = ltid(), lane = tid & 63, wid = __builtin_amdgcn_readfirstlane(tid >> 6), wq = wid & 3;
    const int h = (task >> 5) & 3; const float lg = __builtin_amdgcn_logf(1.0f - __builtin_amdgcn_exp2f(-5.0f - (float)h)); const float g64 = __builtin_amdgcn_exp2f(lg * 64.0f);
    const bf16_t* kvg = (const bf16_t*)(cw + O_KV) + ((size_t)(task >> 5) * 256 + (size_t)(task & 31) * 8) * 4096;
    f32x16 kv[8];
#pragma unroll
    for (int j = 0; j < 8; ++j) kv[j] = frag_load_bf(kvg + (size_t)j * 4096, wq, lane);
    f32x16 acc = kv[0];
#pragma unroll
    for (int j = 1; j < 8; ++j)
#pragma unroll
        for (int g = 0; g < 16; ++g) acc[g] = acc[g] * g64 + kv[j][g];
    frag_store((float*)(cw + O_KG) + (size_t)task * 4096, wq, lane, acc);
}
__device__ __forceinline__ void ret_scan_groups(int chain, unsigned char* __restrict__ cw) {
    const int tid = ltid(), lane = tid & 63, wid = __builtin_amdgcn_readfirstlane(tid >> 6), wq = wid & 3;
    const int h = chain & 3; const float lg = __builtin_amdgcn_logf(1.0f - __builtin_amdgcn_exp2f(-5.0f - (float)h)); const float g512 = __builtin_amdgcn_exp2f(lg * 512.0f);
    const float* kgg = (const float*)(cw + O_KG) + (size_t)chain * 32 * 4096; float* rgg = (float*)(cw + O_RG) + (size_t)chain * 32 * 4096;
    f32x16 R = f32x16{}; f32x16 nx[4];
#pragma unroll
    for (int k = 0; k < 4; ++k) nx[k] = frag_load(kgg + (size_t)k * 4096, wq, lane);
    for (int c = 0; c < 32; c += 4) {
#pragma unroll
        for (int k = 0; k < 4; ++k) { const int cc = c + k; frag_store(rgg + (size_t)cc * 4096, wq, lane, R);
            const f32x16 kvc = nx[k]; const int nn = cc + 4 < 32 ? cc + 4 : 31; nx[k] = frag_load(kgg + (size_t)nn * 4096, wq, lane);
#pragma unroll
            for (int g = 0; g < 16; ++g) R[g] = R[g] * g512 + kvc[g]; }
    }
}
constexpr int L_RET3G = 5 * B9 + 64 * SF * 4;
__device__ __forceinline__ void ret_stage3g(CK_LAS unsigned char* ldsq, int task, const bf16_t* __restrict__ Pb, int PW, int C_TQ, int C_TK, int C_TV, int C_TG, int SEQ, const float* __restrict__ ROPE,
                                           const float* __restrict__ gn_g, const unsigned char* __restrict__ cw, bf16_t* __restrict__ MIXB) {
    const int tid = ltid(), lane = tid & 63, wid = __builtin_amdgcn_readfirstlane(tid >> 6), wq = wid & 3, I = wq >> 1, J = wq & 1, r = lane & 31, hh = lane >> 5, qtid = tid & 255;
    const lbf Qr = (lbf)ldsq, Kr = (lbf)(ldsq + B9), VT = (lbf)(ldsq + 2 * B9), Sb = (lbf)(ldsq + 3 * B9), RTL = (lbf)(ldsq + 4 * B9); const lf32 Y = (lf32)(ldsq + 5 * B9);
    const int tk = task >= 0 ? task : 0; const int item0 = (tk >> 5) * 256 + (tk & 31) * 8;
    f32x16 R = frag_load((const float*)(cw + O_RG) + (size_t)tk * 4096, wq, lane);
    for (int j = 0; j < 8; ++j) { const int item = task >= 0 ? item0 + j : -1;
    const int b = item >= 0 ? item >> 10 : 0, h = item >= 0 ? (item >> 8) & 3 : 0, c = item >= 0 ? item & 255 : 0; const int t = qtid >> 2, c16 = (qtid & 3) * 16; const int pos = c * 64 + t;
    const float lg = __builtin_amdgcn_logf(1.0f - __builtin_amdgcn_exp2f(-5.0f - (float)h));
    const bf16_t* prow = Pb + ((size_t)b * SEQ + pos) * PW;
    if (item >= 0) {
#pragma unroll
        for (int g_ = 0; g_ < 16; ++g_) RTL[(32 * I + crow(g_, hh)) * SB + 32 * J + r] = (bf16_t)f2bf(R[g_]);
        float qr[16], kr[16]; rot16(qr, prow, C_TQ + h * 64, c16, ROPE + (size_t)pos * 64); rot16(kr, prow, C_TK + h * 64, c16, ROPE + (size_t)pos * 64);
        u32x4 w;
        w.x = pk2(qr[0], qr[1]); w.y = pk2(qr[2], qr[3]); w.z = pk2(qr[4], qr[5]); w.w = pk2(qr[6], qr[7]); *(CK_LAS u32x4*)(Qr + t * SB + c16) = w;
        w.x = pk2(qr[8], qr[9]); w.y = pk2(qr[10], qr[11]); w.z = pk2(qr[12], qr[13]); w.w = pk2(qr[14], qr[15]); *(CK_LAS u32x4*)(Qr + t * SB + c16 + 8) = w;
#pragma unroll
        for (int e = 0; e < 16; ++e) kr[e] *= 0.125f;
        w.x = pk2(kr[0], kr[1]); w.y = pk2(kr[2], kr[3]); w.z = pk2(kr[4], kr[5]); w.w = pk2(kr[6], kr[7]); *(CK_LAS u32x4*)(Kr + t * SB + c16) = w;
        w.x = pk2(kr[8], kr[9]); w.y = pk2(kr[10], kr[11]); w.z = pk2(kr[12], kr[13]); w.w = pk2(kr[14], kr[15]); *(CK_LAS u32x4*)(Kr + t * SB + c16 + 8) = w;
        const u32x4* vp = (const u32x4*)(prow + C_TV + h * 64 + c16);
#pragma unroll
        for (int hv = 0; hv < 2; ++hv) { const u32x4 vw = vp[hv];
#pragma unroll
            for (int e2 = 0; e2 < 4; ++e2) { const int e = hv * 8 + 2 * e2; VT[(c16 + e) * SB + t] = (bf16_t)(vw[e2] & 0xffffu); VT[(c16 + e + 1) * SB + t] = (bf16_t)(vw[e2] >> 16); } }
    }
    __syncthreads();
    if (item >= 0) {
        f32x16 st = mm_lds(Kr, Qr, I, J, lane, f32x16{}); const int tt = 32 * J + r;
#pragma unroll
        for (int g = 0; g < 16; ++g) { const int ii = 32 * I + crow(g, hh); st[g] = (ii <= tt) ? st[g] * __builtin_amdgcn_exp2f(lg * (float)(tt - ii)) : 0.f; }
        tile_store_T(Sb, I, J, lane, st);
    }
    __syncthreads();
    if (item >= 0) {
        const f32x16 yi = mm_lds(VT, Sb, I, J, lane, f32x16{}); const f32x16 yc = mm_lds(RTL, Qr, I, J, lane, f32x16{});
        const int tt = 32 * J + r; const float qd = __builtin_amdgcn_exp2f(lg * (float)(tt + 1));
#pragma unroll
        for (int g = 0; g < 16; ++g) Y[tt * SF + 32 * I + crow(g, hh)] = yi[g] + qd * yc[g];
    }
    __syncthreads();
    if (item >= 0) {
        float y[16]; float s = 0.f;
#pragma unroll
        for (int e = 0; e < 16; ++e) { y[e] = Y[t * SF + c16 + e]; s += y[e]; }
        const float mu = quad_sum(s) * (1.f / 64.f); float s2 = 0.f;
#pragma unroll
        for (int e = 0; e < 16; ++e) { y[e] -= mu; s2 += y[e] * y[e]; }
        const float rstd = 1.0f / sqrtf(quad_sum(s2) * (1.f / 64.f) + 1e-6f);
        const u32x4* gp = (const u32x4*)(prow + C_TG + h * 64 + c16); unsigned ow[8];
#pragma unroll
        for (int hv = 0; hv < 2; ++hv) { const u32x4 gw = gp[hv];
#pragma unroll
            for (int e2 = 0; e2 < 4; ++e2) { const int e = hv * 8 + 2 * e2; const int ch = h * 64 + c16 + e; const float g0 = bflo(gw[e2]), g1 = bfhi(gw[e2]);
                ow[hv * 4 + e2] = pk2(y[e] * rstd * gn_g[ch] * (g0 * sigm(g0)), y[e + 1] * rstd * gn_g[ch + 1] * (g1 * sigm(g1))); } }
        u32x4* dst = (u32x4*)(MIXB + ((size_t)b * SEQ + pos) * 1024 + 768 + h * 64 + c16);
        dst[0] = (u32x4){ow[0], ow[1], ow[2], ow[3]}; dst[1] = (u32x4){ow[4], ow[5], ow[6], ow[7]};
    }
    if (item >= 0) { const f32x16 kvc = frag_load_bf((const bf16_t*)(cw + O_KV) + (size_t)item * 4096, wq, lane); const float g64 = __builtin_amdgcn_exp2f(lg * 64.0f);
#pragma unroll
        for (int g_ = 0; g_ < 16; ++g_) R[g_] = R[g_] * g64 + kvc[g_]; }
    __syncthreads();
    }
}
}

__device__ __forceinline__ void tr_tile(const float* __restrict__ src, size_t ld_src, bf16* __restrict__ dst, size_t ld_dst, float* scr, int lane) {
    pg8::f32x4 v[16];
#pragma unroll
    for (int i = 0; i < 16; ++i) v[i] = *(const pg8::f32x4*)(src + (size_t)(i * 4 + (lane >> 4)) * ld_src + (lane & 15) * 4);
#pragma unroll
    for (int i = 0; i < 16; ++i) { float* p = scr + (i * 4 + (lane >> 4)) * 65 + (lane & 15) * 4; p[0] = v[i][0]; p[1] = v[i][1]; p[2] = v[i][2]; p[3] = v[i][3]; }
    asm volatile("s_waitcnt lgkmcnt(0)" ::: "memory");
#pragma unroll
    for (int i = 0; i < 8; ++i) { const int n = i * 8 + (lane >> 3), kc = (lane & 7) * 8; const float* s = scr + kc * 65 + n;
        pg8::u32x4 o; o.x = pk2(s[0], s[65]); o.y = pk2(s[2 * 65], s[3 * 65]); o.z = pk2(s[4 * 65], s[5 * 65]); o.w = pk2(s[6 * 65], s[7 * 65]);
        *(pg8::u32x4*)(dst + (size_t)n * ld_dst + kc) = o; }
    asm volatile("s_waitcnt lgkmcnt(0)" ::: "memory");
}

constexpr int CV_13 = NE * 16 * 16, CV_2 = NE * 8 * 16, CV_L = CV_13 + CV_2, NCONV = DEPTH * CV_L;
__device__ __forceinline__ void conv_item(int it, const float* __restrict__ w1, const float* __restrict__ w3, const float* __restrict__ w2, bf16* __restrict__ W13, bf16* __restrict__ W2, float* scr, int lane) {
    const int l = it / CV_L; int r = it % CV_L;
    if (r < CV_13) { const int e = r >> 8, kb = (r >> 4) & 15, nb = r & 15;
        const int pn = nb >> 2, q = nb & 3; const float* srcw = (q < 2 ? w1 : w3) + ((size_t)l * NE + e) * DM * DE;
        tr_tile(srcw + (size_t)kb * 64 * DE + pn * 128 + (q & 1) * 64, DE, W13 + ((size_t)l * NE + e) * DM * DM + (size_t)nb * 64 * DM + kb * 64, DM, scr, lane); }
    else { r -= CV_13; const int e = r >> 7, kb = (r >> 4) & 7, nb = r & 15;
        tr_tile(w2 + ((size_t)l * NE + e) * DE * DM + (size_t)kb * 64 * DM + nb * 64, DM, W2 + ((size_t)l * NE + e) * DM * DE + (size_t)nb * 64 * DE + kb * 64, DE, scr, lane); }
}

#define LAS __attribute__((address_space(3)))
#define XB_TMO      128
#define XB_XCNT(j)  (256  + 64 * (j))
#define XB_XSUB(j)  (1280 + 64 * (j))
#define XB_XGEN(j)  (2304 + 64 * (j))
#define XB_TOP      3328
#define XB_TOPGEN   3392
#define XCD_BAR_WORDS 3456
#define XB_SPIN_CAP (1u << 18)

__device__ __forceinline__ unsigned xb_ld(unsigned* p)              { return __hip_atomic_load(p, __ATOMIC_RELAXED, __HIP_MEMORY_SCOPE_AGENT); }
__device__ __forceinline__ unsigned xb_add(unsigned* p, unsigned v) { return __hip_atomic_fetch_add(p, v, __ATOMIC_RELAXED, __HIP_MEMORY_SCOPE_AGENT); }
__device__ __forceinline__ unsigned xb_xcc_id() { return (unsigned)__builtin_amdgcn_s_getreg((3 << 11) | 20) & 0xFu; }
#define XB_SPIN(cond, bar) do { unsigned _sp = 0; while (cond) { __builtin_amdgcn_s_sleep(1); \
    if ((++_sp & 255u) == 0u) { if (xb_ld(&(bar)[XB_TMO])) break; if (_sp > XB_SPIN_CAP) { atomicAdd(&(bar)[XB_TMO], 1u); break; } } } } while (0)

struct XcdBarrier {
    unsigned* bar; unsigned x;
    volatile LAS unsigned* st;
};

__device__ __forceinline__ XcdBarrier xcd_barrier_post(unsigned* bar, volatile LAS unsigned* st) {
    XcdBarrier b; b.bar = bar; b.x = xb_xcc_id(); b.st = st;
    if (ltid() == 0) (void)xb_add(&bar[XB_XCNT(b.x)], 1u);
    return b;
}
__device__ __forceinline__ void xcd_barrier_complete(unsigned* bar, unsigned x, unsigned& nloc, unsigned& nx) {
    const unsigned G = gridDim.x * gridDim.y * gridDim.z;
    unsigned sum, cnt, mine, sp = 0u;
    for (;;) {
        sum = 0u; cnt = 0u; mine = 0u;
#pragma unroll
        for (unsigned j = 0; j < 16; ++j) { const unsigned c = xb_ld(&bar[XB_XCNT(j)]); sum += c; cnt += (c > 0u) ? 1u : 0u; mine = (j == x) ? c : mine; }
        if (sum == G) break;
        __builtin_amdgcn_s_sleep(1);
        if ((++sp & 255u) == 0u) { if (xb_ld(&bar[XB_TMO])) break; if (sp > XB_SPIN_CAP) { atomicAdd(&bar[XB_TMO], 1u); break; } }
    }
    nloc = mine > 0u ? mine : 1u; nx = cnt > 0u ? cnt : 1u;
}

__device__ __forceinline__ void xcd_barrier(const XcdBarrier& b) {
    asm volatile("s_waitcnt vmcnt(0)" ::: "memory");
    __syncthreads();
    if (ltid() == 0) {
        unsigned* bar = b.bar; asm volatile("" : "+s"(bar)); unsigned bx_ = b.x; asm volatile("" : "+s"(bx_));
        __builtin_amdgcn_s_waitcnt(0);
        unsigned nloc = b.st[0], nx = b.st[1];
        if (nloc == 0u) { xcd_barrier_complete(bar, bx_, nloc, nx); b.st[0] = nloc; b.st[1] = nx; }
        const unsigned old = xb_add(&bar[XB_XSUB(bx_)], 1u);
        const unsigned gen = old / nloc;
        if (old + 1u == (gen + 1u) * nloc) {
            __builtin_amdgcn_fence(__ATOMIC_RELEASE, "agent");
            asm volatile("s_waitcnt vmcnt(0)" ::: "memory");
            const unsigned og = xb_add(&bar[XB_TOP], 1u);
            const unsigned tg = og / nx;
            if (og + 1u == (tg + 1u) * nx) xb_add(&bar[XB_TOPGEN], 1u);
            else XB_SPIN(xb_ld(&bar[XB_TOPGEN]) == tg, bar);
            __builtin_amdgcn_fence(__ATOMIC_ACQUIRE, "agent");
            xb_add(&bar[XB_XGEN(bx_)], 1u);
            asm volatile("s_waitcnt vmcnt(0)" ::: "memory");
        } else {
            XB_SPIN(xb_ld(&bar[XB_XGEN(bx_)]) == gen, bar);
            __builtin_amdgcn_fence(__ATOMIC_ACQUIRE, "agent");
            asm volatile("s_waitcnt vmcnt(0)" ::: "memory");
        }
    }
    __syncthreads();
}


__global__ void __launch_bounds__(NTHREADS, 2) mk_fwd(Args args) {
    extern __shared__ __attribute__((aligned(16))) unsigned char lds_raw[];
    float* lds = (float*)lds_raw;
    const int tid = ltid(), lane = tid & 63, wid = __builtin_amdgcn_readfirstlane(tid >> 6);
    const int G = gridDim.x, bx = blockIdx.x;
    unsigned char* ws = args.ws;
    unsigned* ctl = (unsigned*)(ws + WS_CTL);
    float* X = args.out;
    bf16* XB = (bf16*)(ws + WS_XB);
    bf16* Pb = (bf16*)(ws + WS_P);
    bf16* WIN = (bf16*)(ws + WS_WIN); bf16* WOUT = (bf16*)(ws + WS_WOUT); bf16* W13 = (bf16*)(ws + WS_W13); bf16* W2 = (bf16*)(ws + WS_W2);
    float* ROPE = (float*)(ws + WS_ROPE);
    double* LCS = (double*)(ws + WS_LCS); double* TOT = (double*)(ws + WS_TOT);
    float* BE = (float*)(ws + WS_SKIP); float* QN2 = BE + 16 * 256; float* KN2 = QN2 + 16 * 128;
    unsigned char* KA = ws + WS_KA;
    unsigned char* cw = ws + WS_CK; bf16* LWT = (bf16*)(ws + WS_LW);
    int* EP = (int*)(ws + WS_EP); int* DEST = (int*)(ws + WS_DEST);
    float* GATE = (float*)(ws + WS_GATE);
    bf16* MIXB = (bf16*)(ws + WS_MIXB);
    bf16* XP = (bf16*)(ws + WS_XP); bf16* Hb = (bf16*)(ws + WS_H); bf16* YP = (bf16*)(ws + WS_YP); bf16* YO = (bf16*)(ws + WS_YO);
    typedef pg8::f32x4 f32x4;
    volatile LAS unsigned* MISC = (volatile LAS unsigned*)((LAS unsigned char*)lds_raw + LDS_MISC);
    for (int u = tid; u < (LDS_ALL - LDS_MISC) / 4; u += NTHREADS) MISC[u] = 0u;
    __syncthreads();
    XcdBarrier bar = xcd_barrier_post(ctl + CW_BAR, MISC + 8);
#define GRID_BAR() xcd_barrier(bar)

    for (int rep_ = 0; rep_ < REP_P0; ++rep_) {
            const int tid = ltid(), lane = tid & 63, wid = __builtin_amdgcn_readfirstlane(tid >> 6); (void)lane; (void)wid;
        const f32x4* xi = (const f32x4*)args.in[0]; uint2* xb = (uint2*)XB;
        for (size_t i = (size_t)bx * NTHREADS + tid; i < (size_t)T * DM / 4; i += (size_t)G * NTHREADS) { const f32x4 v = xi[i]; xb[i] = make_uint2(pk2(v[0], v[1]), pk2(v[2], v[3])); }
        for (int i = bx * NTHREADS + tid; i < SEQ * 32; i += G * NTHREADS) {
            const int pos = i >> 5, f = i & 31;
            const double inv = pow(10000.0, -(double)f / 32.0);
            const double ang = (double)pos * inv;
            ROPE[2 * i] = (float)cos(ang); ROPE[2 * i + 1] = (float)sin(ang);
        }
        { bf16* WR = (bf16*)(ws + WS_WR);
          for (int i = bx * NTHREADS + tid; i < DEPTH * 48 * 1024; i += G * NTHREADS) { const int l_ = i / (48 * 1024), o = (i / 1024) % 48, k = i & 1023;
              const float wv = o < 4 ? args.in[21][((size_t)l_ * DM + k) * 4 + o] : (o < 36 ? args.in[23][((size_t)l_ * DM + k) * 32 + (o - 4)] : 0.f);
              const unsigned hi_ = f2bf(wv); const unsigned lo_ = f2bf(wv - bf2f((unsigned short)hi_));
              WR[((size_t)l_ * 2 + 0) * 48 * 1024 + o * 1024 + k] = (bf16)hi_; WR[((size_t)l_ * 2 + 1) * 48 * 1024 + o * 1024 + k] = (bf16)lo_; } }
        for (int i = bx * NTHREADS + tid; i < DEPTH * 256 * 256; i += G * NTHREADS) {
            const int l = i >> 16, rem = i & 65535, chg = rem >> 8, ii = rem & 255;
            if (ii < 64) LWT[((size_t)l * 256 + chg) * 64 + ii] = (bf16)f2bf(args.in[6][((size_t)l * 64 + ii) * 256 + chg]);
            else if (ii < 128) LWT[(size_t)DEPTH * 256 * 64 + ((size_t)l * 256 + chg) * 64 + (ii - 64)] = (bf16)f2bf(args.in[8][((size_t)l * 64 + (ii - 64)) * 256 + chg]);
            else LWT[(size_t)2 * DEPTH * 256 * 64 + ((size_t)l * 256 + chg) * 128 + (ii - 128)] = (bf16)f2bf(args.in[9][((size_t)l * 128 + (ii - 128)) * 256 + chg]);
        }
        float* scr = lds + wid * (64 * 65);
        constexpr int I_IN = 16 * 56, I_OUT = 16 * 16, I_L = I_IN + I_OUT;
        for (int it = bx * 8 + wid; it < DEPTH * I_L; it += G * 8) {
            const int l = it / I_L; int r = it % I_L;
            if (r < I_IN) { const int kb = r / 56, nb = r % 56; const int nsrc = nb * 64 + (nb >= 24 ? 8 : 0);
                tr_tile(args.in[1] + (size_t)l * DM * INW + (size_t)kb * 64 * INW + nsrc, INW, WIN + (size_t)l * PW * DM + (size_t)nb * 64 * DM + kb * 64, DM, scr, lane); }
            else { r -= I_IN; const int kb = r / 16, nb = r % 16;
                tr_tile(args.in[16] + (size_t)l * DM * DM + (size_t)kb * 64 * DM + nb * 64, DM, WOUT + (size_t)l * DM * DM + (size_t)nb * 64 * DM + kb * 64, DM, scr, lane); }
        }
        __syncthreads();
        {
            const float* wf = args.in[1] + O_FF; const float* fbias = args.in[2];
            float w[8][16];
#pragma unroll
            for (int jq = 0; jq < 4; ++jq)
#pragma unroll
                for (int e = 0; e < 4; ++e)
#pragma unroll
                    for (int h = 0; h < 8; ++h) w[h][jq * 4 + e] = wf[(size_t)(jq * 256 + lane * 4 + e) * INW + h];
            float* ffl = lds;
            for (int ch = bx; ch < T / 128; ch += G) {
                __syncthreads();
                for (int i = 0; i < 16; ++i) { const int tl = wid * 16 + i; const size_t m = (size_t)ch * 128 + tl;
                    float acc[8];
#pragma unroll
                    for (int h = 0; h < 8; ++h) acc[h] = 0.f;
#pragma unroll
                    for (int jq = 0; jq < 4; ++jq) { const f32x4 xv = *(const f32x4*)(args.in[0] + m * DM + jq * 256 + lane * 4);
#pragma unroll
                        for (int e = 0; e < 4; ++e)
#pragma unroll
                            for (int h = 0; h < 8; ++h) acc[h] += xv[e] * w[h][jq * 4 + e]; }
#pragma unroll
                    for (int h = 0; h < 8; ++h) acc[h] = wave_sum(acc[h]);
                    if (lane < 8) { float v = acc[0];
#pragma unroll
                        for (int h = 1; h < 8; ++h) v = (lane == h) ? acc[h] : v;
                        ffl[tl * 8 + lane] = v + fbias[lane]; } }
                __syncthreads();
                {
                    const int h = wid; const int bb = (ch * 128) / SEQ, t0 = (ch * 128) % SEQ; double carry = 0.0;
#pragma unroll
                    for (int half = 0; half < 2; ++half) { double v = (double)logsigmoidf_(ffl[(half * 64 + lane) * 8 + h]);
#pragma unroll
                        for (int o = 1; o < 64; o <<= 1) { const double n = __shfl_up(v, o); if (lane >= o) v += n; }
                        v += carry; LCS[(size_t)(bb * 8 + h) * SEQ + t0 + half * 64 + lane] = v; carry = __shfl(v, 63); }
                    if (lane == 0) TOT[(bb * 8 + h) * 128 + t0 / 128] = carry;
                }
            }
            __syncthreads();
        }
    }
    GRID_BAR();

    for (int l = 0; l < DEPTH; ++l) {
        for (int rep_ = 0; rep_ < REP_A; ++rep_) {
            const int tid = ltid(), lane = tid & 63, wid = __builtin_amdgcn_readfirstlane(tid >> 6); (void)lane; (void)wid;
            pg8::Gemm g{XB, WIN + (size_t)l * PW * DM, T, PW, DM}; pg8::StaticOrder S; S.init(T, PW, G, bx);
            pg8::EpiInProj E{Pb, PW, QC2};
            pg8::gemm_phase<pg8::EpiInProj, pg8::StaticOrder, true, true>((PG8_LAS unsigned char*)lds_raw, g, S, E);
        }
        GRID_BAR();
        for (int rep_ = 0; rep_ < REP_C; ++rep_) {
            const int tid = ltid(), lane = tid & 63, wid = __builtin_amdgcn_readfirstlane(tid >> 6); (void)lane; (void)wid;
            for (int ch = bx; ch < T / 128; ch += G) {
                const int h = wid; const int bb = (ch * 128) / SEQ, t0 = (ch * 128) % SEQ, ci = t0 / 128;
                double pre = 0.0;
                { const double* tp = TOT + (bb * 8 + h) * 128; double a = (lane < ci) ? tp[lane] : 0.0; a += (lane + 64 < ci) ? tp[lane + 64] : 0.0;
#pragma unroll
                  for (int o = 1; o < 64; o <<= 1) a += __shfl_xor(a, o);
                  pre = a; }
#pragma unroll
                for (int half = 0; half < 2; ++half) { const int t = t0 + half * 64 + lane; const double v = pre + LCS[(size_t)(bb * 8 + h) * SEQ + t];
                    const double bd = -v * 1.4426950408889634; const unsigned h_ = f2bf((float)bd); const double r1 = bd - (double)bf2f((unsigned short)h_);
                    const unsigned m_ = f2bf((float)r1); const double r2 = r1 - (double)bf2f((unsigned short)m_); const unsigned l_ = f2bf((float)r2);
                    *(pg8::u32x4*)(KA + ((size_t)(bb * 8 + h) * SEQ + t) * 16) = (pg8::u32x4){h_ | (m_ << 16), l_ | (0x3f80u << 16), 0x3f803f80u, 0u};
                    if (lane == 63) BE[(bb * 8 + h) * 256 + t / 64] = (float)bd; }
                { LAS unsigned* nrm = (LAS unsigned*)lds_raw;
                  __syncthreads();
                  if (tid < 16) nrm[tid] = 0u;
                  __syncthreads();
                  const int tl = tid >> 2, part = tid & 3; const bf16* prow = Pb + ((size_t)ch * 128 + tl) * PW;
#pragma unroll
                  for (int hq = 0; hq < 2; ++hq) { const int hd = part * 2 + hq;
#pragma unroll
                      for (int qk = 0; qk < 2; ++qk) { const pg8::u32x4* vp = (const pg8::u32x4*)(prow + (qk ? C_FK : C_FQ) + hd * 64); float ss = 0.f;
#pragma unroll
                          for (int v8 = 0; v8 < 8; ++v8) { const pg8::u32x4 wv = vp[v8];
#pragma unroll
                              for (int e = 0; e < 4; ++e) { const float lo_ = __builtin_bit_cast(float, wv[e] << 16), hi_ = __builtin_bit_cast(float, wv[e] & 0xffff0000u); ss += lo_ * lo_ + hi_ * hi_; } }
                          atomicMax((unsigned*)(nrm + qk * 8 + hd), __float_as_uint(ss)); } }
                  __syncthreads();
                  if (tid < 16) { const int hd = tid & 7; ((tid < 8) ? QN2 : KN2)[(bb * 8 + hd) * 128 + ci] = __uint_as_float(nrm[tid]); }
                }
            }
            __syncthreads();
            const ck::RwkvParams rp{args.in[3] + l * 768, args.in[4] + l * 256, args.in[5] + l * 256, args.in[7] + l * 256, args.in[10] + l * 256, args.in[11] + l * 256, args.in[12] + l * 256,
                                    args.in[13] + l * 256, args.in[14] + l * 256, args.in[15] + l * 256,
                                    LWT + (size_t)l * 256 * 64, LWT + (size_t)DEPTH * 256 * 64 + (size_t)l * 256 * 64, LWT + (size_t)2 * DEPTH * 256 * 64 + (size_t)l * 256 * 128};
#ifndef REP_S1
#define REP_S1 1
#endif
#ifndef REP_R1
#define REP_R1 1
#endif
            for (int rr_ = 0; rr_ < REP_S1; ++rr_)
            for (int it = bx; it < 2048; it += G) ck::rwkv_stage1((CK_LAS unsigned char*)lds_raw, it, Pb, PW, C_RR, C_RK, C_RV, C_WD, SEQ, rp, cw);
            { const int quad = wid >> 2;
              for (int rr_ = 0; rr_ < REP_R1; ++rr_)
              for (int i0 = bx * 2; i0 < 2048; i0 += G * 2) ck::ret_stage1((CK_LAS unsigned char*)lds_raw + quad * 2 * ck::B9, i0 + quad, Pb, PW, C_TK, C_TV, SEQ, ROPE, cw); }
        }
        GRID_BAR();
        {
            const int tid = ltid(), lane = tid & 63, wid = __builtin_amdgcn_readfirstlane(tid >> 6); (void)lane; (void)wid;
            const int quad = wid >> 2;
#ifndef REP_S
#define REP_S 1
#endif
            for (int rep_ = 0; rep_ < REP_S; ++rep_) {
            if (bx < 128) {
                ck::rwkv_level1((CK_LAS unsigned char*)lds_raw, 2 * bx + quad, cw);
                asm volatile("s_waitcnt vmcnt(0)" ::: "memory"); __syncthreads();
                if (tid == 0) { __builtin_amdgcn_fence(__ATOMIC_RELEASE, "agent"); asm volatile("s_waitcnt vmcnt(0)" ::: "memory");
                                __hip_atomic_fetch_add(ctl + CW_L1 + 64 * (16 * l + (bx >> 4)), 2u, __ATOMIC_RELAXED, __HIP_MEMORY_SCOPE_AGENT); }
            }
            if (bx >= 128) {
                ck::ret_level1(2 * (bx - 128) + quad, cw);
                asm volatile("s_waitcnt vmcnt(0)" ::: "memory"); __syncthreads();
                if (tid == 0) { __builtin_amdgcn_fence(__ATOMIC_RELEASE, "agent"); asm volatile("s_waitcnt vmcnt(0)" ::: "memory");
                                __hip_atomic_fetch_add(ctl + CW_L1 + 64 * (16 * l + 8 + ((bx - 128) >> 4)), 2u, __ATOMIC_RELAXED, __HIP_MEMORY_SCOPE_AGENT); }
            }
            if (bx < 8) {
                if (wid == 0) { unsigned spins = 0;
                    while (__hip_atomic_load(ctl + CW_L1 + 64 * (16 * l + bx), __ATOMIC_RELAXED, __HIP_MEMORY_SCOPE_AGENT) < 32u) { if (++spins > (1u << 22)) break; __builtin_amdgcn_s_sleep(2); }
                    __builtin_amdgcn_fence(__ATOMIC_ACQUIRE, "agent"); asm volatile("s_waitcnt vmcnt(0)" ::: "memory"); }
                __syncthreads();
                ck::rwkv_scan<32>((CK_LAS unsigned char*)lds_raw, quad == 0 ? bx : -1, (const ck::bf16_t*)(cw + ck::O_PG), (const ck::bf16_t*)(cw + ck::O_QG), (ck::bf16_t*)(cw + ck::O_HG));
            }
            else if (bx < 16) {
                if (wid == 0) { unsigned spins = 0;
                    while (__hip_atomic_load(ctl + CW_L1 + 64 * (16 * l + bx), __ATOMIC_RELAXED, __HIP_MEMORY_SCOPE_AGENT) < 32u) { if (++spins > (1u << 22)) break; __builtin_amdgcn_s_sleep(2); }
                    __builtin_amdgcn_fence(__ATOMIC_ACQUIRE, "agent"); asm volatile("s_waitcnt vmcnt(0)" ::: "memory"); }
                __syncthreads();
                if (quad == 0) ck::ret_scan_groups(bx - 8, cw);
            }
            if (bx < 16) {
                asm volatile("s_waitcnt vmcnt(0)" ::: "memory"); __syncthreads();
                if (tid == 0) { __builtin_amdgcn_fence(__ATOMIC_RELEASE, "agent"); asm volatile("s_waitcnt vmcnt(0)" ::: "memory");
                                __hip_atomic_store(ctl + CW_SF + 64 * (16 * l + bx), 1u, __ATOMIC_RELAXED, __HIP_MEMORY_SCOPE_AGENT); }
            }
            }
            __syncthreads();
            const attn_body::AttnTensors AT{(const attn_body::bf16*)(Pb + C_FQ), (const attn_body::bf16*)(Pb + C_FK), (const attn_body::bf16*)(Pb + C_FV), (attn_body::bf16*)MIXB, KA};
            bool cvdone = false;
#ifndef REP_D
#define REP_D 1
#endif
            for (int apass = 0; apass < 2; ++apass) {
            if (apass == 1) {
            __syncthreads();
            if (wid == 0) {
                unsigned spins = 0;
                for (;;) { const unsigned f = lane < 16 ? __hip_atomic_load(ctl + CW_SF + 64 * (16 * l + lane), __ATOMIC_RELAXED, __HIP_MEMORY_SCOPE_AGENT) : 1u;
                    if (__all(f != 0u)) break; if (++spins > (1u << 22)) break; __builtin_amdgcn_s_sleep(2); }
                __builtin_amdgcn_fence(__ATOMIC_ACQUIRE, "agent"); asm volatile("s_waitcnt vmcnt(0)" ::: "memory");
            }
            __syncthreads();
            const ck::RwkvParams rp{args.in[3] + l * 768, args.in[4] + l * 256, args.in[5] + l * 256, args.in[7] + l * 256, args.in[10] + l * 256, args.in[11] + l * 256, args.in[12] + l * 256,
                                    args.in[13] + l * 256, args.in[14] + l * 256, args.in[15] + l * 256, nullptr, nullptr, nullptr};
            for (;;) {
                if (tid == 0) MISC[16] = atomicAdd(ctl + CW_EQ + 64 * l, 1u);
                __syncthreads();
                const int p = (int)MISC[16];
                __syncthreads();
                if (p >= 128 + 128) break;
                if (p < 128) ck::rwkv_stage3g((CK_LAS unsigned char*)lds_raw + quad * ck::L_RW3, 2 * p + quad, rp, cw, MIXB, SEQ);
                else ck::ret_stage3g((CK_LAS unsigned char*)lds_raw + quad * ck::L_RET3G, 2 * (p - 128) + quad, Pb, PW, C_TQ, C_TK, C_TV, C_TG, SEQ, ROPE, args.in[15] + l * 256, cw, MIXB);
            }
            __syncthreads();
            }
            for (int rd_ = 0; rd_ < REP_D; ++rd_)
            for (int gtry = 0; gtry < 8; ++gtry) {
                int grp = (bx + gtry) & 7;
                if (apass == 0) { if (gtry >= 4) continue; const int k_ = bx & 7, g0 = (k_ & 4) ? 7 : 3, g2 = (k_ & 2) ? 6 : 2; grp = gtry == 0 ? g0 : gtry == 1 ? (g0 ^ 4) : gtry == 2 ? g2 : (g2 ^ 4); }
                else if ((grp & 3) >= 2) continue;
                unsigned* qh = ctl + (rd_ ? 20480 : CW_Q) + 64 * (8 * l + grp);
                for (;;) {
                    if (tid == 0) MISC[16] = atomicAdd(qh, 1u);
                    __syncthreads();
                    const unsigned idx = MISC[16];
                    if (idx >= 128u) { __syncthreads(); break; }
                    const int qb = 63 - (int)(idx >> 1), bh = 2 * grp + (int)(idx & 1);
                    if (wid == 0) {
                        const float qn2 = fmaxf(QN2[bh * 128 + 2 * qb], QN2[bh * 128 + 2 * qb + 1]);
                        float kn2 = fmaxf(lane <= 2 * qb + 1 ? KN2[bh * 128 + lane] : 0.f, lane + 64 <= 2 * qb + 1 ? KN2[bh * 128 + 64 + lane] : 0.f);
#pragma unroll
                        for (int o = 1; o < 64; o <<= 1) kn2 = fmaxf(kn2, __shfl_xor(kn2, o));
                        const float bound = 2.002f * sqrtf(qn2 * kn2) + 40.0f; const int ntq = 4 * qb;
                        const float bref = ntq > 0 ? BE[bh * 256 + ntq - 1] : 0.f;
                        int nsk = 0;
#pragma unroll
                        for (int q4 = 0; q4 < 4; ++q4) { const int tt = q4 * 64 + lane; const bool sk = tt < ntq && (bref - BE[bh * 256 + tt]) > bound; nsk += __popcll(__ballot(sk)); }
                        if (lane == 0) MISC[17] = (unsigned)(nsk & ~1);
                    }
                    __syncthreads();
                    const int t0 = (int)MISC[17];
                    attn_body::attn_unit<8>(bh / attn_body::NHEAD, bh % attn_body::NHEAD, qb, t0, AT.Q, AT.K, AT.V, AT.O, AT.KA, (char*)lds_raw);
                    if (!cvdone) {
                        if (tid == 0) MISC[18] = atomicAdd(ctl + CW_CV, 16u);
                        __syncthreads();
                        const int tk = (int)MISC[18];
                        if (tk >= NCONV) cvdone = true;
                        else { const int t2 = ltid(), lane2 = t2 & 63, wid2 = __builtin_amdgcn_readfirstlane(t2 >> 6);
                            float* scr = lds + wid2 * (64 * 65);
                            _Pragma("clang loop unroll(disable)") for (int q2 = 0; q2 < 2; ++q2) { const int itc = tk + 8 * q2 + wid2; if (itc < NCONV) conv_item(itc, args.in[25], args.in[26], args.in[27], W13, W2, scr, lane2); } }
                        __syncthreads();
                    }
                }
            }
            }
        }
        GRID_BAR();
        for (int rep_ = 0; rep_ < REP_F; ++rep_) {
            const int tid = ltid(), lane = tid & 63, wid = __builtin_amdgcn_readfirstlane(tid >> 6); (void)lane; (void)wid;
            pg8::Gemm g{MIXB, WOUT + (size_t)l * DM * DM, T, DM, DM}; pg8::StaticOrder S; S.init(T, DM, G, bx);
            pg8::EpiInProj E{YO, DM, 1.0f};
            pg8::gemm_phase<pg8::EpiInProj, pg8::StaticOrder, true, true>((PG8_LAS unsigned char*)lds_raw, g, S, E);
        }
        GRID_BAR();
        {
            const int tid = ltid(), lane = tid & 63, wid = __builtin_amdgcn_readfirstlane(tid >> 6); (void)lane; (void)wid;
            const float* g1 = args.in[17] + l * DM; const float* b1 = args.in[18] + l * DM;
            const float* bg = args.in[22] + l * 4; const float* be = args.in[24] + l * 32;
            unsigned* cnt = ctl + CW_CNT + 64 * 32 * l;
            const bf16* WRh = (const bf16*)(ws + WS_WR) + (size_t)l * 2 * 48 * 1024; const bf16* WRl = WRh + 48 * 1024;
            constexpr int XS = 1032;
            LAS unsigned short* XT = (LAS unsigned short*)lds_raw;
            LAS float* PART = (LAS float*)((LAS unsigned char*)lds_raw + 32 * XS * 2);
            LAS float* LG = PART + 8 * 32 * 48;
            LAS unsigned* LCNT = (LAS unsigned*)(LG + 128 * 48);
            if (tid < 32) LCNT[tid] = 0u;
            pg8::bf16x8 wh[4][3], wl[4][3];
#pragma unroll
            for (int s_ = 0; s_ < 4; ++s_)
#pragma unroll
                for (int nt = 0; nt < 3; ++nt) { const size_t o = (size_t)(16 * nt + (lane & 15)) * 1024 + 128 * wid + 32 * s_ + 8 * (lane >> 4);
                    wh[s_][nt] = *(const pg8::bf16x8*)(WRh + o); wl[s_][nt] = *(const pg8::bf16x8*)(WRl + o); }
            float gg[16], bb[16];
#pragma unroll
            for (int jq = 0; jq < 4; ++jq) { const f32x4 gv = *(const f32x4*)(g1 + jq * 256 + lane * 4), bv = *(const f32x4*)(b1 + jq * 256 + lane * 4);
#pragma unroll
                for (int e = 0; e < 4; ++e) { gg[jq * 4 + e] = gv[e]; bb[jq * 4 + e] = bv[e]; } }
            for (int ch = bx; ch < T / 128; ch += G) {
                for (int blk = 0; blk < 4; ++blk) {
                    const size_t m0 = (size_t)ch * 128 + blk * 32;
                    uint2 xw[4][4], yw[4][4];
#pragma unroll
                    for (int i = 0; i < 4; ++i) { const size_t m = m0 + wid * 4 + i;
#pragma unroll
                        for (int jq = 0; jq < 4; ++jq) { xw[i][jq] = *(const uint2*)(XB + m * DM + jq * 256 + lane * 4); yw[i][jq] = *(const uint2*)(YO + m * DM + jq * 256 + lane * 4); } }
#pragma unroll
                    for (int i = 0; i < 4; ++i) { const int tl = wid * 4 + i; const size_t m = m0 + tl;
                        float v[16]; float sm = 0.f;
#pragma unroll
                        for (int jq = 0; jq < 4; ++jq) { const uint2 a_ = xw[i][jq], c_ = yw[i][jq];
                            const f32x4 xv = (f32x4){__builtin_bit_cast(float, a_.x << 16), __builtin_bit_cast(float, a_.x & 0xffff0000u), __builtin_bit_cast(float, a_.y << 16), __builtin_bit_cast(float, a_.y & 0xffff0000u)};
                            const f32x4 yv = (f32x4){__builtin_bit_cast(float, c_.x << 16), __builtin_bit_cast(float, c_.x & 0xffff0000u), __builtin_bit_cast(float, c_.y << 16), __builtin_bit_cast(float, c_.y & 0xffff0000u)};
#pragma unroll
                            for (int e = 0; e < 4; ++e) { v[jq * 4 + e] = ALPHA * xv[e] + yv[e]; sm += v[jq * 4 + e]; } }
                        const float mean = wave_sum(sm) * (1.f / DM); float s2 = 0.f;
#pragma unroll
                        for (int q = 0; q < 16; ++q) { v[q] -= mean; s2 += v[q] * v[q]; }
                        const float rstd = 1.0f / sqrtf(wave_sum(s2) * (1.f / DM) + LN_EPS);
#pragma unroll
                        for (int jq = 0; jq < 4; ++jq) { unsigned hw[4];
#pragma unroll
                            for (int e = 0; e < 4; ++e) hw[e] = f2bf(v[jq * 4 + e] * rstd * gg[jq * 4 + e] + bb[jq * 4 + e]);
                            const ck::u32x2 pw = (ck::u32x2){hw[0] | (hw[1] << 16), hw[2] | (hw[3] << 16)};
                            *(uint2*)(XB + m * DM + jq * 256 + lane * 4) = make_uint2(pw.x, pw.y);
                            *(LAS ck::u32x2*)(XT + tl * XS + jq * 256 + lane * 4) = pw; }
                    }
                    __syncthreads();
                    {
                        pg8::f32x4 acc[2][3];
#pragma unroll
                        for (int mt = 0; mt < 2; ++mt)
#pragma unroll
                            for (int nt = 0; nt < 3; ++nt) acc[mt][nt] = pg8::f32x4{0.f, 0.f, 0.f, 0.f};
#pragma unroll
                        for (int s_ = 0; s_ < 4; ++s_)
#pragma unroll
                            for (int mt = 0; mt < 2; ++mt) { const pg8::bf16x8 ax = *(const LAS pg8::bf16x8*)(XT + (16 * mt + (lane & 15)) * XS + 128 * wid + 32 * s_ + 8 * (lane >> 4));
#pragma unroll
                                for (int nt = 0; nt < 3; ++nt) { acc[mt][nt] = __builtin_amdgcn_mfma_f32_16x16x32_bf16(ax, wh[s_][nt], acc[mt][nt], 0, 0, 0); acc[mt][nt] = __builtin_amdgcn_mfma_f32_16x16x32_bf16(ax, wl[s_][nt], acc[mt][nt], 0, 0, 0); } }
#pragma unroll
                        for (int mt = 0; mt < 2; ++mt)
#pragma unroll
                            for (int nt = 0; nt < 3; ++nt)
#pragma unroll
                                for (int r_ = 0; r_ < 4; ++r_) PART[(wid * 32 + 16 * mt + 4 * (lane >> 4) + r_) * 48 + 16 * nt + (lane & 15)] = acc[mt][nt][r_];
                    }
                    __syncthreads();
                    for (int p_ = tid; p_ < 32 * 48; p_ += NTHREADS) { float a_ = 0.f;
#pragma unroll
                        for (int w_ = 0; w_ < 8; ++w_) a_ += PART[w_ * 32 * 48 + p_];
                        LG[blk * 32 * 48 + p_] = a_; }
                }
                __syncthreads();
                int ex0 = 0, ex1 = 0; unsigned lp0 = 0, lp1 = 0;
                if (tid < 128) { const LAS float* lg = LG + tid * 48; const size_t m = (size_t)ch * 128 + tid;
                    int grp = 0; float gbest = lg[0] + bg[0];
#pragma unroll
                    for (int o = 1; o < 4; ++o) { const float gv = lg[o] + bg[o]; if (gv > gbest) { gbest = gv; grp = o; } }
                    float den = 0.f;
#pragma unroll
                    for (int o = 0; o < 4; ++o) den += expf(lg[o] + bg[o] - gbest);
                    const float ggate = 1.0f / den;
                    int i0 = 0; float v0 = lg[4 + grp * 8] + be[grp * 8];
                    for (int o = 1; o < 8; ++o) { const float ev = lg[4 + grp * 8 + o] + be[grp * 8 + o]; if (ev > v0) { v0 = ev; i0 = o; } }
                    int i1 = -1; float v1 = -INFINITY;
                    for (int o = 0; o < 8; ++o) { const float ev = lg[4 + grp * 8 + o] + be[grp * 8 + o]; if (o != i0 && (i1 < 0 || ev > v1)) { v1 = ev; i1 = o; } }
                    const float e1 = expf(v1 - v0); const float p0 = 1.0f / (1.0f + e1), p1 = e1 / (1.0f + e1);
                    ex0 = grp * 8 + i0; ex1 = grp * 8 + i1;
                    lp0 = atomicAdd((unsigned*)(LCNT + ex0), 1u); lp1 = atomicAdd((unsigned*)(LCNT + ex1), 1u);
                    GATE[2 * m] = ggate * p0; GATE[2 * m + 1] = ggate * p1;
                }
                __syncthreads();
                if (tid < 32) { const unsigned c_ = LCNT[tid]; LCNT[32 + tid] = c_ ? atomicAdd(cnt + 64 * tid, c_) : 0u; }
                __syncthreads();
                if (tid < 128) { const size_t m = (size_t)ch * 128 + tid; EP[2 * m] = (ex0 << 16) | (int)(LCNT[32 + ex0] + lp0); EP[2 * m + 1] = (ex1 << 16) | (int)(LCNT[32 + ex1] + lp1); }
                __syncthreads();
                if (tid < 32) LCNT[tid] = 0u;
            }
        }
        GRID_BAR();
        for (int rep_ = 0; rep_ < REP_H; ++rep_) {
            const int tid = ltid(), lane = tid & 63, wid = __builtin_amdgcn_readfirstlane(tid >> 6); (void)lane; (void)wid;
            {
                const int endl = (l + 1) * CV_L;
                for (;;) { if (tid == 0) MISC[18] = atomicAdd(ctl + CW_CV, 8u);
                    __syncthreads();
                    const int tk = (int)MISC[18];
                    if (tk + wid < NCONV) conv_item(tk + wid, args.in[25], args.in[26], args.in[27], W13, W2, lds + wid * (64 * 65), lane);
                    __syncthreads();
                    if (tk + 8 >= endl) break; }
            }
            __syncthreads();
            unsigned* cnt = ctl + CW_CNT + 64 * 32 * l;
            int* poff = (int*)lds;
            if (tid == 0) { int acc = 0; for (int e = 0; e < NE; ++e) { poff[e] = acc; acc += (((int)cnt[64 * e] + 255) >> 8) << 8; } poff[NE] = acc; }
            __syncthreads();
            for (int m = bx * 8 + wid; m < T; m += G * 8) {
                uint2 w[4];
    #pragma unroll
                for (int jq = 0; jq < 4; ++jq) w[jq] = *(const uint2*)(XB + (size_t)m * DM + jq * 256 + lane * 4);
    #pragma unroll
                for (int k = 0; k < 2; ++k) { const int ep = EP[2 * m + k]; const int dest = poff[ep >> 16] + (ep & 0xffff);
    #pragma unroll
                    for (int jq = 0; jq < 4; ++jq) *(uint2*)(XP + (size_t)dest * DM + jq * 256 + lane * 4) = w[jq];
                    if (lane == 0) DEST[2 * m + k] = dest; }
            }
        }
        GRID_BAR();
        for (int rep_ = 0; rep_ < REP_IJ; ++rep_) {
            const int tid = ltid(), lane = tid & 63, wid = __builtin_amdgcn_readfirstlane(tid >> 6); (void)lane; (void)wid;
            unsigned* cnt = ctl + CW_CNT + 64 * 32 * l;
            PG8_LAS int* tile_e = (PG8_LAS int*)((PG8_LAS unsigned char*)lds_raw + 131072); PG8_LAS int* tst = tile_e + MAXTILES;
            __syncthreads();
            if (tid == 0) { int acc = 0; for (int e = 0; e < NE; ++e) { tst[e] = acc; acc += ((int)cnt[64 * e] + 255) >> 8; } tst[NE] = acc; }
            __syncthreads();
            const int ntile = tst[NE];
            if (tid < ntile) { int e = 0; while (tst[e + 1] <= tid) ++e; tile_e[tid] = e; }
            __syncthreads();
            pg8::MoeOrder S{ntile, G, bx, tile_e};
            { pg8::Gemm g{XP, W13 + (size_t)l * NE * DM * DM, ntile * 256, DM, DM}; pg8::EpiSwiGlu E{Hb, DE};
              pg8::gemm_phase<pg8::EpiSwiGlu, pg8::MoeOrder, true, true>((PG8_LAS unsigned char*)lds_raw, g, S, E); }
            GRID_BAR();
            { pg8::Gemm g{Hb, W2 + (size_t)l * NE * DM * DE, ntile * 256, DM, DE}; pg8::EpiInProj E{YP, DM, 1.0f};
              pg8::gemm_phase<pg8::EpiInProj, pg8::MoeOrder, true, true>((PG8_LAS unsigned char*)lds_raw, g, S, E); }
        }
        GRID_BAR();
        for (int rep_ = 0; rep_ < REP_K; ++rep_) { float* Xo = (rep_ == REP_K - 1) ? X : (float*)(ws + WS_XP); bf16* XBo = (rep_ == REP_K - 1) ? XB : (bf16*)(ws + WS_H);
            const int tid = ltid(), lane = tid & 63, wid = __builtin_amdgcn_readfirstlane(tid >> 6); (void)lane; (void)wid;
            const float* g2 = args.in[19] + l * DM; const float* b2 = args.in[20] + l * DM;
            const bool doff = (l + 1 < DEPTH); const int ln = doff ? l + 1 : l;
            const float* wf = args.in[1] + (size_t)ln * DM * INW + O_FF; const float* fbias = args.in[2] + ln * 8;
            LAS f32x4* W4 = (LAS f32x4*)((LAS unsigned char*)lds_raw + 4096);
            __syncthreads();
            for (int q = tid; q < 40 * 64; q += NTHREADS) { const int row = q >> 6, ln_ = q & 63; f32x4 val;
                if (row < 32) { const int h = row >> 2, jq = row & 3;
#pragma unroll
                    for (int e = 0; e < 4; ++e) val[e] = wf[(size_t)(jq * 256 + ln_ * 4 + e) * INW + h]; }
                else if (row < 36) val = *(const f32x4*)(g2 + (row - 32) * 256 + ln_ * 4);
                else val = *(const f32x4*)(b2 + (row - 36) * 256 + ln_ * 4);
                W4[q] = val; }
            float* ffl = lds;
            for (int ch = bx; ch < T / 128; ch += G) {
                __syncthreads();
                const size_t mw = (size_t)ch * 128 + wid * 16;
                const int dA = lane < 16 ? DEST[2 * (mw + lane)] : 0, dB = lane < 16 ? DEST[2 * (mw + lane) + 1] : 0;
                const float gA = lane < 16 ? GATE[2 * (mw + lane)] : 0.f, gB = lane < 16 ? GATE[2 * (mw + lane) + 1] : 0.f;
                f32x4 xA[2][4], xB[2][4]; uint2 aA[2][4], aB[2][4], bA[2][4], bB[2][4]; float gA2[2][2], gB2[2][2];
#define K_LOAD(XS, WAS, WBS, GS, IEXP) _Pragma("unroll")                     for (int u = 0; u < 2; ++u) { const size_t m = mw + IEXP + u;                         const size_t da = (size_t)__builtin_amdgcn_readlane(dA, IEXP + u), db = (size_t)__builtin_amdgcn_readlane(dB, IEXP + u);                         GS[u][0] = __builtin_bit_cast(float, __builtin_amdgcn_readlane(__builtin_bit_cast(int, gA), IEXP + u)); GS[u][1] = __builtin_bit_cast(float, __builtin_amdgcn_readlane(__builtin_bit_cast(int, gB), IEXP + u)); _Pragma("unroll")                         for (int jq = 0; jq < 4; ++jq) { { const uint2 xw_ = *(const uint2*)(XB + m * DM + jq * 256 + lane * 4); XS[u][jq] = (f32x4){__builtin_bit_cast(float, xw_.x << 16), __builtin_bit_cast(float, xw_.x & 0xffff0000u), __builtin_bit_cast(float, xw_.y << 16), __builtin_bit_cast(float, xw_.y & 0xffff0000u)}; }                             WAS[u][jq] = *(const uint2*)(YP + da * DM + jq * 256 + lane * 4); WBS[u][jq] = *(const uint2*)(YP + db * DM + jq * 256 + lane * 4); } }
                { const int i = 0; K_LOAD(xA, aA, bA, gA2, i); }
                for (int i = 0; i < 16; i += 4) {
                    { const int i1 = i + 2; K_LOAD(xB, aB, bB, gB2, i1); }
#pragma unroll
                    for (int u = 0; u < 2; ++u) { const int tl = wid * 16 + i + u; const size_t m = mw + i + u; const float ga = gA2[u][0], gb = gA2[u][1];
                    float v[16]; float s_ = 0.f;
#pragma unroll
                    for (int jq = 0; jq < 4; ++jq) { const uint2 w0 = aA[u][jq], w1 = bA[u][jq];
                        const f32x4 ya = (f32x4){__builtin_bit_cast(float, w0.x << 16), __builtin_bit_cast(float, w0.x & 0xffff0000u), __builtin_bit_cast(float, w0.y << 16), __builtin_bit_cast(float, w0.y & 0xffff0000u)};
                        const f32x4 yb = (f32x4){__builtin_bit_cast(float, w1.x << 16), __builtin_bit_cast(float, w1.x & 0xffff0000u), __builtin_bit_cast(float, w1.y << 16), __builtin_bit_cast(float, w1.y & 0xffff0000u)};
#pragma unroll
                        for (int e = 0; e < 4; ++e) { v[jq * 4 + e] = ALPHA * xA[u][jq][e] + (ga * ya[e] + gb * yb[e]); s_ += v[jq * 4 + e]; } }
                    const float mean = wave_sum(s_) * (1.f / DM); float s2 = 0.f;
#pragma unroll
                    for (int q = 0; q < 16; ++q) { v[q] -= mean; s2 += v[q] * v[q]; }
                    const float rstd = 1.0f / sqrtf(wave_sum(s2) * (1.f / DM) + LN_EPS);
                    float acc[8];
#pragma unroll
                    for (int h = 0; h < 8; ++h) acc[h] = 0.f;
#pragma unroll
                    for (int jq = 0; jq < 4; ++jq) { f32x4 ov;
                        const f32x4 gv = W4[(32 + jq) * 64 + lane], bv = W4[(36 + jq) * 64 + lane];
#pragma unroll
                        for (int e = 0; e < 4; ++e) ov[e] = v[jq * 4 + e] * rstd * gv[e] + bv[e];
                        if (doff) {
#pragma unroll
                            for (int h = 0; h < 8; ++h) { const f32x4 wv = W4[(h * 4 + jq) * 64 + lane]; acc[h] += (ov[0] * wv[0] + ov[1] * wv[1]) + (ov[2] * wv[2] + ov[3] * wv[3]); } }
                        if (!doff) *(f32x4*)(Xo + m * DM + jq * 256 + lane * 4) = ov;
                        *(uint2*)(XBo + m * DM + jq * 256 + lane * 4) = make_uint2(pk2(ov[0], ov[1]), pk2(ov[2], ov[3])); }
                    if (doff) {
#pragma unroll
                        for (int h = 0; h < 8; ++h) acc[h] = wave_sum(acc[h]);
                        if (lane < 8) { float fv = acc[0];
#pragma unroll
                            for (int h = 1; h < 8; ++h) fv = (lane == h) ? acc[h] : fv;
                            ffl[tl * 8 + lane] = fv + fbias[lane]; } }
                    }

                    if (i + 4 < 16) { const int i2 = i + 4; K_LOAD(xA, aA, bA, gA2, i2); }
#pragma unroll
                    for (int u = 0; u < 2; ++u) { const int tl = wid * 16 + (i + 2) + u; const size_t m = mw + (i + 2) + u; const float ga = gB2[u][0], gb = gB2[u][1];
                    float v[16]; float s_ = 0.f;
#pragma unroll
                    for (int jq = 0; jq < 4; ++jq) { const uint2 w0 = aB[u][jq], w1 = bB[u][jq];
                        const f32x4 ya = (f32x4){__builtin_bit_cast(float, w0.x << 16), __builtin_bit_cast(float, w0.x & 0xffff0000u), __builtin_bit_cast(float, w0.y << 16), __builtin_bit_cast(float, w0.y & 0xffff0000u)};
                        const f32x4 yb = (f32x4){__builtin_bit_cast(float, w1.x << 16), __builtin_bit_cast(float, w1.x & 0xffff0000u), __builtin_bit_cast(float, w1.y << 16), __builtin_bit_cast(float, w1.y & 0xffff0000u)};
#pragma unroll
                        for (int e = 0; e < 4; ++e) { v[jq * 4 + e] = ALPHA * xB[u][jq][e] + (ga * ya[e] + gb * yb[e]); s_ += v[jq * 4 + e]; } }
                    const float mean = wave_sum(s_) * (1.f / DM); float s2 = 0.f;
#pragma unroll
                    for (int q = 0; q < 16; ++q) { v[q] -= mean; s2 += v[q] * v[q]; }
                    const float rstd = 1.0f / sqrtf(wave_sum(s2) * (1.f / DM) + LN_EPS);
                    float acc[8];
#pragma unroll
                    for (int h = 0; h < 8; ++h) acc[h] = 0.f;
#pragma unroll
                    for (int jq = 0; jq < 4; ++jq) { f32x4 ov;
                        const f32x4 gv = W4[(32 + jq) * 64 + lane], bv = W4[(36 + jq) * 64 + lane];
#pragma unroll
                        for (int e = 0; e < 4; ++e) ov[e] = v[jq * 4 + e] * rstd * gv[e] + bv[e];
                        if (doff) {
#pragma unroll
                            for (int h = 0; h < 8; ++h) { const f32x4 wv = W4[(h * 4 + jq) * 64 + lane]; acc[h] += (ov[0] * wv[0] + ov[1] * wv[1]) + (ov[2] * wv[2] + ov[3] * wv[3]); } }
                        if (!doff) *(f32x4*)(Xo + m * DM + jq * 256 + lane * 4) = ov;
                        *(uint2*)(XBo + m * DM + jq * 256 + lane * 4) = make_uint2(pk2(ov[0], ov[1]), pk2(ov[2], ov[3])); }
                    if (doff) {
#pragma unroll
                        for (int h = 0; h < 8; ++h) acc[h] = wave_sum(acc[h]);
                        if (lane < 8) { float fv = acc[0];
#pragma unroll
                            for (int h = 1; h < 8; ++h) fv = (lane == h) ? acc[h] : fv;
                            ffl[tl * 8 + lane] = fv + fbias[lane]; } }
                    }

                }
#undef K_LOAD
                __syncthreads();
                if (doff) {
                    const int h = wid; const int bb = (ch * 128) / SEQ, t0 = (ch * 128) % SEQ; double carry = 0.0;
#pragma unroll
                    for (int half = 0; half < 2; ++half) { double vv = (double)logsigmoidf_(ffl[(half * 64 + lane) * 8 + h]);
#pragma unroll
                        for (int o = 1; o < 64; o <<= 1) { const double n = __shfl_up(vv, o); if (lane >= o) vv += n; }
                        vv += carry; LCS[(size_t)(bb * 8 + h) * SEQ + t0 + half * 64 + lane] = vv; carry = __shfl(vv, 63); }
                    if (lane == 0) TOT[(bb * 8 + h) * 128 + t0 / 128] = carry;
                }
            }
        }
        if (l + 1 < DEPTH) GRID_BAR();
    }
}

extern "C" void kernel_launch(void* const* d_in, const int* in_sizes, int n_in, void* d_out, int out_size, void* d_ws, size_t ws_size, hipStream_t stream) {
    static int grid = 0;
    if (grid == 0) {
        if (n_in != 28 || out_size != T * DM || ws_size < WS_END) { fprintf(stderr, "kernel_launch: unexpected shapes (n_in %d out %d ws %zu)\n", n_in, out_size, ws_size); grid = -1; return; }
        int dev = 0, cus = 0, per_cu = 0;
        (void)hipGetDevice(&dev); (void)hipDeviceGetAttribute(&cus, hipDeviceAttributeMultiprocessorCount, dev);
        (void)hipFuncSetAttribute((const void*)mk_fwd, hipFuncAttributeMaxDynamicSharedMemorySize, LDS_ALL);
        if (hipOccupancyMaxActiveBlocksPerMultiprocessor(&per_cu, (const void*)mk_fwd, NTHREADS, LDS_ALL) != hipSuccess || per_cu < 1) fprintf(stderr, "kernel_launch: occupancy query says %d blocks per CU\n", per_cu);
        (void)hipGetLastError();
        grid = cus > 0 ? cus : 256;
        if (grid != 256) fprintf(stderr, "kernel_launch: %d CUs (built for 256)\n", grid);
    }
    if (grid < 0) return;
    (void)hipMemsetAsync((char*)d_ws + WS_CTL, 0, CTL_BYTES, stream);
    Args a{};
    for (int i = 0; i < 28; ++i) a.in[i] = (const float*)d_in[i];
    a.out = (float*)d_out; a.ws = (unsigned char*)d_ws;
    hipLaunchKernelGGL(mk_fwd, dim3(grid), dim3(NTHREADS), LDS_ALL, stream, a);
}
```

```cpp
#include <hip/hip_runtime.h>
#include <cstdio>
#include <cstdint>
#include <cmath>
__device__ __forceinline__ int ltid() { int t = __builtin_amdgcn_workitem_id_x(); asm volatile("" : "+v"(t)); return t; }

constexpr int BATCH = 2, SEQ = 16384, DM = 1024, DEPTH = 4, T = BATCH * SEQ;
constexpr int INW = 3592, PW = 3584;
constexpr int O_FF = 1536;
constexpr int C_FQ = 0, C_FK = 512, C_FV = 1024, C_RR = 1536, C_RK = 1792, C_RV = 2048, C_WD = 2304, C_AD = 2368, C_GD = 2432,
              C_TQ = 2560, C_TK = 2816, C_TV = 3072, C_TG = 3328;
constexpr int NE = 32, DE = 512, A_TOT = T * 2;
constexpr float ALPHA = 1.681792830507429f;
constexpr float LN_EPS = 1e-5f, RWKV_GN_EPS = 64e-5f, RET_GN_EPS = 1e-6f;
constexpr float QC2 = 0.125f * 1.4426950408889634f;
constexpr int NTHREADS = 512;
#ifndef REP_P0
#define REP_P0 1
#endif
#ifndef REP_A
#define REP_A 1
#endif
#ifndef REP_C
#define REP_C 1
#endif
#ifndef REP_E
#define REP_E 1
#endif
#ifndef REP_F
#define REP_F 1
#endif
#ifndef REP_H
#define REP_H 1
#endif
#ifndef REP_IJ
#define REP_IJ 1
#endif
#ifndef REP_G
#define REP_G 1
#endif
#ifndef REP_K
#define REP_K 1
#endif
constexpr int LDS_MISC = 147456, LDS_ALL = 148480;

constexpr size_t MiB = 1u << 20;
constexpr size_t WS_CTL = 0, CTL_BYTES = 1 * MiB;
constexpr size_t WS_EP = 1 * MiB;
constexpr size_t WS_DEST = 2 * MiB;
constexpr size_t WS_GATE = 9 * MiB;
constexpr size_t WS_ROPE = 11 * MiB;
constexpr size_t WS_RKD = 15 * MiB;
constexpr size_t WS_WIN = 16 * MiB;
constexpr size_t WS_WOUT = 44 * MiB;
constexpr size_t WS_W13 = 52 * MiB;
constexpr size_t WS_W2 = 308 * MiB;
constexpr size_t WS_XB = 436 * MiB;
constexpr size_t WS_P = 500 * MiB;
constexpr size_t WS_MIXB = 724 * MiB;
constexpr size_t WS_CK = 788 * MiB;
constexpr size_t WS_LW = 3 * MiB;
constexpr size_t WS_YO = 788 * MiB;
constexpr size_t WS_XP = 500 * MiB;
constexpr int LCAP = 32768;
constexpr size_t WS_H = 644 * MiB;
constexpr size_t WS_YP = 716 * MiB;
constexpr size_t WS_LCS = 1012 * MiB;
constexpr size_t WS_KA = 1014 * MiB;
constexpr size_t WS_END = 1018 * MiB;
constexpr size_t WS_WR = 5 * MiB;
constexpr size_t WS_SKIP = 4 * MiB + 65536;
constexpr size_t WS_TOT = 4 * MiB;
constexpr int CW_CNT = 32768;
constexpr int CW_Q = 2048;
constexpr int CW_L1 = 20480;
constexpr int CW_SF = 12288;
constexpr int CW_EQ = 4096;
constexpr int CW_CV = 6144;
constexpr int CW_BAR = 8192;
constexpr int MAXTILES = 288;

typedef float f32x16 __attribute__((ext_vector_type(16)));
typedef unsigned short bf16;

struct Args {
    const float* in[28]; float* out; unsigned char* ws;
};

__device__ __forceinline__ float sigmoidf_(float x) { return 1.0f / (1.0f + expf(-x)); }
__device__ __forceinline__ float logsigmoidf_(float x) { return x >= 0.f ? -log1pf(expf(-x)) : x - log1pf(expf(x)); }
__device__ __forceinline__ float wave_sum(float v) {
#define WS_DPP(ctrl, rmask) v += __builtin_bit_cast(float, __builtin_amdgcn_update_dpp(0, __builtin_bit_cast(int, v), ctrl, rmask, 0xf, false))
    WS_DPP(0x111, 0xf); WS_DPP(0x112, 0xf); WS_DPP(0x114, 0xf); WS_DPP(0x118, 0xf); WS_DPP(0x142, 0xa); WS_DPP(0x143, 0xc);
#undef WS_DPP
    return __builtin_bit_cast(float, __builtin_amdgcn_readlane(__builtin_bit_cast(int, v), 63));
}
typedef float f32x2hw __attribute__((ext_vector_type(2))); typedef __bf16 bf16x2hw __attribute__((ext_vector_type(2)));
__device__ __forceinline__ unsigned pk2(float lo, float hi) { f32x2hw v = {lo, hi}; bf16x2hw b = __builtin_convertvector(v, bf16x2hw); return __builtin_bit_cast(unsigned, b); }
__device__ __forceinline__ unsigned f2bf(float f) { return pk2(f, 0.f) & 0xffffu; }
__device__ __forceinline__ float bf2f(unsigned short b) { return __builtin_bit_cast(float, (unsigned)b << 16); }
__device__ __forceinline__ float pf(const bf16* Pb, size_t m, int c) { return bf2f(Pb[m * PW + c]); }

namespace pg8 {
#define PG8_LAS __attribute__((address_space(3)))
typedef unsigned short bf16_t;
typedef short bf16x8 __attribute__((ext_vector_type(8)));
typedef float f32x4 __attribute__((ext_vector_type(4)));
typedef unsigned u32x4 __attribute__((ext_vector_type(4)));
constexpr int BM = 256, BK = 64, HALF = 128, HTB = HALF * BK * 2  , STAGE_BYTES = 8 * HTB, NXCD = 8, WGM = 8;

__host__ __device__ __forceinline__ int lds_byte(int r, int c) { const int st = (r >> 4) * 2 + (c >> 5), rr = r & 15, cc = c & 31, ob = rr * 64 + cc * 2; return st * 1024 + (ob ^ (((ob >> 9) & 1) << 5)); }
__host__ __device__ __forceinline__ void stage_rc(int b, int& R, int& C) { const int st = b / 1024, sb = b % 1024, swz = sb ^ (((sb >> 9) & 1) << 5); R = (st >> 1) * 16 + swz / 64; C = (st & 1) * 32 + (swz % 64) / 2; }
__host__ __device__ __forceinline__ int perm32(int rho) { const int n = rho >> 4, i = rho & 15; return 8 * (i >> 2) + 4 * n + (i & 3); }

struct Unit { int pm, pn, pc; };
struct Gemm { const bf16_t* A; const bf16_t* Bt; int M, N, K; };

struct StaticOrder {
    int nM, nN, nwg, G, c;
    __host__ __device__ void init(int M, int N, int G_, int c_) { nM = M / BM; nN = N / BM; nwg = nM * nN; G = G_; c = c_; }
    __host__ __device__ bool next(int i, Unit& u) const {
        const long L = (long)i * G + c; if (L >= nwg) return false;
        int wgid = (int)L; { const int q = nwg / NXCD, r = nwg % NXCD, xcd = wgid % NXCD, off = wgid / NXCD; wgid = (xcd < r ? xcd * (q + 1) : r * (q + 1) + (xcd - r) * q) + off; }
        const int nig = WGM * nN, gid = wgid / nig, fm = gid * WGM, gsz = (nM - fm) < WGM ? (nM - fm) : WGM;
        u.pm = fm + ((wgid % nig) % gsz); u.pn = (wgid % nig) / gsz; u.pc = u.pn; return true;
    }
    __device__ __forceinline__ void a_ready(const Unit&) const {}
    __device__ __forceinline__ void done(const Unit&) const {}
};

__device__ __forceinline__ unsigned cvt_pk_bf16(float lo, float hi) { unsigned r; asm volatile("v_cvt_pk_bf16_f32 %0, %1, %2" : "=v"(r) : "v"(lo), "v"(hi)); return r; }

struct EpiF32 {
    static constexpr bool PERM = false, AFTER_DRAIN = false;
    float* O; int ldc;
    __device__ __forceinline__ void operator()(const f32x4 (&acc)[2][2][4][2], const Unit& u, int wr, int wc, int fr, int fq) const {
        const int row0 = u.pm * BM + wr * 64 + fr; const int col0 = u.pc * BM + wc * 32 + 4 * fq;
#pragma unroll
        for (int ai = 0; ai < 2; ++ai)
#pragma unroll
            for (int m = 0; m < 4; ++m) { float* rowp = O + (size_t)(row0 + ai * HALF + m * 16) * ldc + col0;
#pragma unroll
                for (int bj = 0; bj < 2; ++bj)
#pragma unroll
                    for (int n = 0; n < 2; ++n) *(f32x4*)(rowp + bj * HALF + n * 16) = acc[ai][bj][m][n]; }
    }
};
struct EpiSwiGlu {
    static constexpr bool PERM = true, AFTER_DRAIN = false;
    bf16_t* O; int ldc;
    __device__ __forceinline__ static float silu(float v) { return v * __builtin_amdgcn_rcpf(1.0f + __builtin_amdgcn_exp2f(-1.4426950408889634f * v)); }
    __device__ __forceinline__ void operator()(const f32x4 (&acc)[2][2][4][2], const Unit& u, int wr, int wc, int fr, int fq) const {
        const int row0 = u.pm * BM + wr * 64 + fr; const int col0 = u.pc * HALF + wc * 32 + 8 * fq;
#pragma unroll
        for (int ai = 0; ai < 2; ++ai)
#pragma unroll
            for (int m = 0; m < 4; ++m) { bf16_t* rowp = O + (size_t)(row0 + ai * HALF + m * 16) * ldc + col0;
                f32x4 h0, h1;
#pragma unroll
                for (int e = 0; e < 4; ++e) { h0[e] = silu(acc[ai][0][m][0][e]) * acc[ai][1][m][0][e]; h1[e] = silu(acc[ai][0][m][1][e]) * acc[ai][1][m][1][e]; }
                u32x4 w; w.x = cvt_pk_bf16(h0[0], h0[1]); w.y = cvt_pk_bf16(h0[2], h0[3]); w.z = cvt_pk_bf16(h1[0], h1[1]); w.w = cvt_pk_bf16(h1[2], h1[3]);
                *(u32x4*)rowp = w; }
    }
};
struct MoeOrder {
    int ntile, G, c; const PG8_LAS int* tile_e;
    __device__ __forceinline__ bool next(int i, Unit& u) const { const int L = i * G + c; if (L >= ntile * 4) return false; const int rt = L >> 2, pn = L & 3; u.pm = rt; u.pn = tile_e[rt] * 4 + pn; u.pc = pn; return true; }
    __device__ __forceinline__ void a_ready(const Unit&) const {}
    __device__ __forceinline__ void done(const Unit&) const {}
};
struct EpiInProj {
    static constexpr bool PERM = true, AFTER_DRAIN = false;
    bf16_t* O; int ldc; float qscale;
    __device__ __forceinline__ void operator()(const f32x4 (&acc)[2][2][4][2], const Unit& u, int wr, int wc, int fr, int fq) const {
        const int row0 = u.pm * BM + wr * 64 + fr; const int col0 = u.pc * BM + wc * 32 + 8 * fq;
        const float sc = (u.pc < 2) ? qscale : 1.f;
#pragma unroll
        for (int ai = 0; ai < 2; ++ai)
#pragma unroll
            for (int m = 0; m < 4; ++m) { bf16_t* rowp = O + (size_t)(row0 + ai * HALF + m * 16) * ldc + col0;
#pragma unroll
                for (int bj = 0; bj < 2; ++bj) { const f32x4 v0 = acc[ai][bj][m][0] * sc, v1 = acc[ai][bj][m][1] * sc;
                    u32x4 w; w.x = cvt_pk_bf16(v0[0], v0[1]); w.y = cvt_pk_bf16(v0[2], v0[3]); w.z = cvt_pk_bf16(v1[0], v1[1]); w.w = cvt_pk_bf16(v1[2], v1[3]);
                    *(u32x4*)(rowp + bj * HALF) = w; } }
    }
};
template <class Epi, class Sched, bool ALIGN_EPI = false, bool SP2 = false, bool GATHER = false>
__device__ __forceinline__ void gemm_phase(PG8_LAS unsigned char* lds, const Gemm g, const Sched& S, const Epi& E, const PG8_LAS unsigned* rowoff = nullptr) {
    static_assert(!GATHER || SP2, "GATHER is written for the SP2 loop only");
    const int tid = ltid(), wid = __builtin_amdgcn_readfirstlane(tid >> 6), lane = tid & 63, wr = wid >> 2, wc = wid & 3, fr = lane & 15, fq = lane >> 4;
    const int K = g.K, nt = K / BK;
    unsigned voffA[2], voffB[2];
#pragma unroll
    for (int i = 0; i < 2; ++i) { int R, C; stage_rc(tid * 16 + i * 8192, R, C); const int Rb = Epi::PERM ? ((R & ~31) + perm32(R & 31)) : R;
        voffA[i] = GATHER ? ((unsigned)(R * 4) | ((unsigned)(C * 2) << 16)) : (unsigned)(R * K + C) * 2u; voffB[i] = (unsigned)(Rb * K + C) * 2u; }
    unsigned vc[2][2];
#define PG8_GLOAD(dst, u_) do { _Pragma("unroll") for (int h_ = 0; h_ < 2; ++h_) _Pragma("unroll") for (int i_ = 0; i_ < 2; ++i_) \
        dst[h_][i_] = *(const PG8_LAS unsigned*)((const PG8_LAS unsigned char*)rowoff + (u_) * 1024 + h_ * 512 + (voffA[i_] & 0xffffu)) + (voffA[i_] >> 16); } while (0)
#define PG8_STAGE_A(bufoff, gbase, H, VG) do { if constexpr (GATHER) PG8_STAGE(bufoff, gbase, VG[H]); else PG8_STAGE(bufoff, (gbase) + (H) * hstep, voffA); } while (0)
    const size_t kstep = (size_t)(BK * 2);
    const size_t hstep = (size_t)HALF * K * 2;
    const size_t tstep = 2 * hstep;
    const unsigned ldsw = (unsigned)wid * 1024u;
    const int aoff = lds_byte(wr * 64 + fr, fq * 8), boff = lds_byte(wc * 32 + fr, fq * 8);
#define PG8_SA(b, h) (((b) * 2 + (h)) * HTB)
#define PG8_SB(b, h) ((4 + (b) * 2 + (h)) * HTB)
#define PG8_STAGE(bufoff, gbase, voff) do { _Pragma("unroll") for (int _i = 0; _i < 2; ++_i) \
        __builtin_amdgcn_global_load_lds((const unsigned*)((const char*)(gbase) + (voff)[_i]), (PG8_LAS unsigned*)(lds + (bufoff) + ldsw + _i * 8192), 16, 0, 0); } while (0)
#define PG8_LDA(dst, b, h) do { _Pragma("unroll") for (int m = 0; m < 4; ++m) _Pragma("unroll") for (int k = 0; k < 2; ++k) dst[m][k] = *(const PG8_LAS bf16x8*)(lds + PG8_SA(b, h) + aoff + m * 2048 + k * 1024); } while (0)
#define PG8_LDB(dst, b, h) do { _Pragma("unroll") for (int n = 0; n < 2; ++n) _Pragma("unroll") for (int k = 0; k < 2; ++k) dst[n][k] = *(const PG8_LAS bf16x8*)(lds + PG8_SB(b, h) + boff + n * 2048 + k * 1024); } while (0)
#define PG8_MMA(ai, bj, At, Bt) do { __builtin_amdgcn_s_setprio(1); _Pragma("unroll") for (int m = 0; m < 4; ++m) _Pragma("unroll") for (int n = 0; n < 2; ++n) _Pragma("unroll") for (int k = 0; k < 2; ++k) \
        acc[ai][bj][m][n] = __builtin_amdgcn_mfma_f32_16x16x32_bf16(Bt[n][k], At[m][k], acc[ai][bj][m][n], 0, 0, 0); __builtin_amdgcn_s_setprio(0); } while (0)
#define PG8_WAIT_V(n) asm volatile("s_waitcnt vmcnt(" #n ")" ::: "memory")
#define PG8_WAIT_L(n) asm volatile("s_waitcnt lgkmcnt(" #n ")" ::: "memory")
#define PG8_BAR __builtin_amdgcn_s_barrier()
#define PG8_SCHED __builtin_amdgcn_sched_barrier(0)
    Unit cur, nxt; int ui = 0;
    if (!S.next(0, cur)) return;
    f32x4 acc[2][2][4][2];
#pragma unroll
    for (int a = 0; a < 2; ++a)
#pragma unroll
        for (int b = 0; b < 2; ++b)
#pragma unroll
            for (int m = 0; m < 4; ++m)
#pragma unroll
                for (int n = 0; n < 2; ++n) acc[a][b][m][n] = (f32x4){0.f, 0.f, 0.f, 0.f};
    bf16x8 At[4][2], B0[2][2], B1[2][2];
    const char* cA = (const char*)g.A + (GATHER ? (size_t)0 : (size_t)cur.pm * tstep); const char* cB = (const char*)g.Bt + (size_t)cur.pn * tstep;
    S.a_ready(cur);
    if constexpr (GATHER) PG8_GLOAD(vc, 0);
    if constexpr (SP2) {
        PG8_STAGE(PG8_SB(0, 0), cB, voffB); PG8_STAGE(PG8_SB(0, 1), cB + hstep, voffB); PG8_STAGE_A(PG8_SA(0, 0), cA, 0, vc); PG8_STAGE_A(PG8_SA(0, 1), cA, 1, vc);
        if (wr == 1) PG8_BAR;
        PG8_WAIT_V(2); PG8_BAR;
        PG8_STAGE(PG8_SB(1, 0), cB + kstep, voffB); PG8_STAGE_A(PG8_SA(1, 0), cA + kstep, 0, vc); PG8_STAGE(PG8_SB(1, 1), cB + hstep + kstep, voffB);
        PG8_WAIT_V(6); PG8_BAR;
    } else {
        PG8_STAGE(PG8_SB(0, 0), cB, voffB); PG8_STAGE(PG8_SA(0, 0), cA, voffA); PG8_STAGE(PG8_SB(0, 1), cB + hstep, voffB); PG8_STAGE(PG8_SA(0, 1), cA + hstep, voffA);
        if (wr == 1) PG8_BAR;
        PG8_WAIT_V(4); PG8_BAR;
        PG8_STAGE(PG8_SB(1, 0), cB + kstep, voffB); PG8_STAGE(PG8_SA(1, 0), cA + kstep, voffA); PG8_STAGE(PG8_SB(1, 1), cB + hstep + kstep, voffB);
        PG8_WAIT_V(6); PG8_BAR;
    }
    for (;;) {
        const bool has_next = S.next(ui + 1, nxt);
        const char* nA = (has_next && !GATHER) ? (const char*)g.A + (size_t)nxt.pm * tstep : cA; const char* nB = has_next ? (const char*)g.Bt + (size_t)nxt.pn * tstep : cB;
        for (int t = 0; t < nt; t += 2) {
            const bool last = (t == nt - 2);
            const char* a1 = cA + (size_t)(t + 1) * kstep;
            const char* a2 = last ? nA : cA + (size_t)(t + 2) * kstep; const char* b2 = last ? nB : cB + (size_t)(t + 2) * kstep;
            const char* a3 = a2 + kstep; const char* b3 = b2 + kstep;
            if (last && has_next) S.a_ready(nxt);
            if constexpr (SP2) {
            PG8_LDB(B0, 0, 0); PG8_LDB(B1, 0, 1); PG8_SCHED; PG8_LDA(At, 0, 0); PG8_STAGE_A(PG8_SA(1, 1), a1, 1, vc);
            if constexpr (GATHER) { if (last && has_next) PG8_GLOAD(vc, ui + 1); }
            PG8_WAIT_V(8); PG8_WAIT_L(0); PG8_BAR; PG8_MMA(0, 0, At, B0); PG8_MMA(0, 1, At, B1); PG8_BAR; PG8_SCHED;
            PG8_LDA(At, 0, 1); PG8_STAGE(PG8_SB(0, 0), b2, voffB); PG8_STAGE(PG8_SB(0, 1), b2 + hstep, voffB); PG8_STAGE_A(PG8_SA(0, 0), a2, 0, vc);
            PG8_WAIT_V(8); PG8_WAIT_L(0); PG8_BAR; PG8_MMA(1, 0, At, B0); PG8_MMA(1, 1, At, B1); PG8_BAR; PG8_SCHED;
            PG8_LDB(B0, 1, 0); PG8_LDB(B1, 1, 1); PG8_SCHED; PG8_LDA(At, 1, 0); PG8_STAGE_A(PG8_SA(0, 1), a2, 1, vc);
            PG8_WAIT_V(8); PG8_WAIT_L(0); PG8_BAR; PG8_MMA(0, 0, At, B0); PG8_MMA(0, 1, At, B1); PG8_BAR; PG8_SCHED;
            PG8_LDA(At, 1, 1); PG8_STAGE(PG8_SB(1, 0), b3, voffB); PG8_STAGE(PG8_SB(1, 1), b3 + hstep, voffB); PG8_STAGE_A(PG8_SA(1, 0), a3, 0, vc);
            PG8_WAIT_V(8); PG8_WAIT_L(0); PG8_BAR; PG8_MMA(1, 0, At, B0); PG8_MMA(1, 1, At, B1); PG8_BAR; PG8_SCHED;
            } else {
            PG8_LDB(B0, 0, 0); PG8_SCHED; PG8_LDA(At, 0, 0); PG8_STAGE(PG8_SA(1, 1), a1 + hstep, voffA);
            PG8_WAIT_L(8); PG8_BAR; PG8_WAIT_L(0); PG8_MMA(0, 0, At, B0); PG8_BAR; PG8_SCHED;
            PG8_LDB(B1, 0, 1); PG8_STAGE(PG8_SB(0, 0), b2, voffB);
            PG8_BAR; PG8_WAIT_L(0); PG8_MMA(0, 1, At, B1); PG8_BAR;
            PG8_LDA(At, 0, 1); PG8_STAGE(PG8_SA(0, 0), a2, voffA);
            PG8_BAR; PG8_WAIT_L(0); PG8_MMA(1, 0, At, B0); PG8_BAR; PG8_SCHED;
            PG8_STAGE(PG8_SB(0, 1), b2 + hstep, voffB);
            PG8_WAIT_V(6); PG8_BAR; PG8_MMA(1, 1, At, B1); PG8_BAR;
            PG8_LDB(B0, 1, 0); PG8_SCHED; PG8_LDA(At, 1, 0); PG8_STAGE(PG8_SA(0, 1), a2 + hstep, voffA);
            PG8_WAIT_L(8); PG8_BAR; PG8_WAIT_L(0); PG8_MMA(0, 0, At, B0); PG8_BAR; PG8_SCHED;
            PG8_LDB(B1, 1, 1); PG8_STAGE(PG8_SB(1, 0), b3, voffB);
            PG8_BAR; PG8_WAIT_L(0); PG8_MMA(0, 1, At, B1); PG8_BAR;
            PG8_LDA(At, 1, 1); PG8_STAGE(PG8_SA(1, 0), a3, voffA);
            PG8_BAR; PG8_WAIT_L(0); PG8_MMA(1, 0, At, B0); PG8_BAR; PG8_SCHED;
            PG8_STAGE(PG8_SB(1, 1), b3 + hstep, voffB);
            PG8_WAIT_V(6); PG8_BAR; PG8_MMA(1, 1, At, B1); PG8_BAR;
            }
        }
        if constexpr (ALIGN_EPI) { if (wr == 0) PG8_BAR; }
        if constexpr (!Epi::AFTER_DRAIN) { E(acc, cur, wr, wc, fr, fq); S.done(cur); }
        if (!has_next) break;
#pragma unroll
        for (int a = 0; a < 2; ++a)
#pragma unroll
            for (int b = 0; b < 2; ++b)
#pragma unroll
                for (int m = 0; m < 4; ++m)
#pragma unroll
                    for (int n = 0; n < 2; ++n) acc[a][b][m][n] = (f32x4){0.f, 0.f, 0.f, 0.f};
        cur = nxt; cA = nA; cB = nB; ++ui;
        if constexpr (ALIGN_EPI) { if (wr == 1) PG8_BAR; }
    }
    PG8_WAIT_V(0);
    if constexpr (!ALIGN_EPI) { if (wr == 0) PG8_BAR; }
    PG8_BAR;
    if constexpr (Epi::AFTER_DRAIN) { E.fused(acc, cur, wr, wc, fr, fq, lds, wid, lane); S.done(cur); }
#undef PG8_SA
#undef PG8_SB
#undef PG8_STAGE
#undef PG8_STAGE_A
#undef PG8_GLOAD
#undef PG8_LDA
#undef PG8_LDB
#undef PG8_MMA
#undef PG8_WAIT_V
#undef PG8_WAIT_L
#undef PG8_BAR
#undef PG8_SCHED
}
}

template <class RowMap, class Epi>
__device__ __forceinline__ void gemm_tile_f32(float* lds, const float* __restrict__ A, int lda, RowMap rowmap, int nvalid,
                                              const float* __restrict__ B, int ldb, int col0, int N, int K, Epi epi) {
    float* As = lds;
    float* Bs = lds + 128 * 17;
    const int tid = ltid(), lane = tid & 63, wid = tid >> 6, wm = wid & 3, wn = wid >> 2;
    const int arow = tid >> 2, akq = (tid & 3) * 4;
    const int src = (arow < nvalid) ? rowmap(arow) : -1;
    const float* ap = A + (size_t)(src < 0 ? 0 : src) * lda + akq;
    const int bk = tid >> 5, bn = (tid & 31) * 4;
    const bool bok = (col0 + bn) < N;
    const float* bp = B + (size_t)bk * ldb + col0 + bn;
    f32x16 acc0 = {}, acc1 = {};
    for (int k0 = 0; k0 < K; k0 += 16) {
        pg8::f32x4 av = (pg8::f32x4){0.f, 0.f, 0.f, 0.f}, bv = (pg8::f32x4){0.f, 0.f, 0.f, 0.f};
        if (src >= 0) av = *(const pg8::f32x4*)(ap + k0);
        if (bok) bv = *(const pg8::f32x4*)(bp + (size_t)k0 * ldb);
        __syncthreads();
        As[arow * 17 + akq + 0] = av[0]; As[arow * 17 + akq + 1] = av[1]; As[arow * 17 + akq + 2] = av[2]; As[arow * 17 + akq + 3] = av[3];
        *(pg8::f32x4*)(Bs + bk * 132 + bn) = bv;
        __syncthreads();
#pragma unroll
        for (int kk = 0; kk < 16; kk += 2) {
            const float a = As[(32 * wm + (lane & 31)) * 17 + kk + (lane >> 5)];
            const float b0 = Bs[(kk + (lane >> 5)) * 132 + 64 * wn + (lane & 31)];
            const float b1 = Bs[(kk + (lane >> 5)) * 132 + 64 * wn + 32 + (lane & 31)];
            acc0 = __builtin_amdgcn_mfma_f32_32x32x2f32(a, b0, acc0, 0, 0, 0);
            acc1 = __builtin_amdgcn_mfma_f32_32x32x2f32(a, b1, acc1, 0, 0, 0);
        }
    }
#pragma unroll
    for (int r = 0; r < 16; ++r) {
        const int i = 32 * wm + (r & 3) + 8 * (r >> 2) + 4 * (lane >> 5);
        const int c0 = col0 + 64 * wn + (lane & 31);
        if (i < nvalid) {
            if (c0 < N) epi(i, c0, acc0[r]);
            if (c0 + 32 < N) epi(i, c0 + 32, acc1[r]);
        }
    }
}

#include <hip/hip_bf16.h>
namespace attn_body {
using bf16=__hip_bfloat16;
using bf16x8=__attribute__((ext_vector_type(8)))short;
using s16x4=__attribute__((ext_vector_type(4)))short;
using f32x16=__attribute__((ext_vector_type(16)))float;
using u32x4=__attribute__((ext_vector_type(4)))unsigned;
typedef float f32x4_t __attribute__((ext_vector_type(4)));
constexpr int BATCH=2,NHEAD=8,SEQ=16384,D=64,DM=3584,OP=1024;
constexpr int NW=8,QBLK=32,QB=QBLK*NW,KVBLK=64,NQB=SEQ/QB;
constexpr int ATTN_PITCH=DM, ATTN_UNIT_ROWS=QB;
__device__ __forceinline__ int crow(int r,int hi){return (r&3)+8*(r>>2)+4*hi;}
#define SBAR() __builtin_amdgcn_sched_barrier(0)
__device__ __forceinline__ void cmask(f32x16&p0,f32x16&p1,int jb,int qrel,int hi){
  const float NEG=-INFINITY; int kb=64*jb+4*hi;
  #pragma unroll
  for(int r=0;r<16;++r){int kv=kb+(r&3)+8*(r>>2); if(kv>qrel)p0[r]=NEG; if(kv+32>qrel)p1[r]=NEG;}
}

constexpr int NSLOT=3, SLOTB=8192;
constexpr int LDS_K=0, LDS_V=NSLOT*SLOTB, LDS_WS=2*NSLOT*SLOTB, LDS_OST=LDS_WS+NW*64*4, LDS_BYTES=LDS_OST+NW*4096;
constexpr float C2=0.125f*1.4426950408889634f;
__device__ __forceinline__ void glds16(const void*gsrc,unsigned lds_dst){unsigned keep;
  asm volatile("s_mov_b32 %0, m0\n\ts_mov_b32 m0, %2\n\ts_nop 0\n\tglobal_load_lds_dwordx4 %1, off\n\ts_mov_b32 m0, %0":"=&s"(keep):"v"(gsrc),"s"(lds_dst):"memory");}
__device__ __forceinline__ float max3f(float a,float b,float c){float r;asm("v_max3_f32 %0, %1, %2, %3":"=v"(r):"v"(a),"v"(b),"v"(c));return r;}
__device__ __forceinline__ float max2f(float a,float b){float r;asm("v_max_f32_e32 %0, %1, %2":"=v"(r):"v"(a),"v"(b));return r;}
__device__ __forceinline__ float fadd_s(float a,float b){float r;asm("v_add_f32_e32 %0, %1, %2":"=v"(r):"v"(a),"v"(b));return r;}
__device__ __forceinline__ float fsub_s(float a,float b){float r;asm("v_sub_f32_e32 %0, %1, %2":"=v"(r):"v"(a),"v"(b));return r;}
typedef float f32x2_t __attribute__((ext_vector_type(2))); typedef __bf16 bf16x2_t __attribute__((ext_vector_type(2)));
__device__ __forceinline__ unsigned cvtpk_s(float lo,float hi){f32x2_t v={lo,hi};bf16x2_t b=__builtin_convertvector(v,bf16x2_t);return __builtin_bit_cast(unsigned,b);}
#define WAIT_BAR(N) asm volatile("s_waitcnt vmcnt(" #N ") lgkmcnt(0)\n\ts_barrier":::"memory")

__device__ __forceinline__ void qkt(f32x16&p0,f32x16&p1,const char*Kslot,const bf16x8*qr,int r32,int hi){
  const char*kb=Kslot+hi*1024+r32*16;
  #pragma unroll
  for(int d0=0;d0<4;++d0){
    const bf16x8 b0=*reinterpret_cast<const bf16x8*>(kb+d0*2048);
    const bf16x8 b1=*reinterpret_cast<const bf16x8*>(kb+d0*2048+512);
    p0=__builtin_amdgcn_mfma_f32_32x32x16_bf16(b0,qr[d0],p0,0,0,0);p1=__builtin_amdgcn_mfma_f32_32x32x16_bf16(b1,qr[d0],p1,0,0,0);}
}
typedef __attribute__((address_space(3))) const char* lds_cptr;
typedef short v4i16_t __attribute__((ext_vector_type(4)));
__device__ __forceinline__ void kload8(bf16x8*kf,lds_cptr kp){
  kf[0]=*(const __attribute__((address_space(3))) bf16x8*)(kp);      kf[1]=*(const __attribute__((address_space(3))) bf16x8*)(kp+512);
  kf[2]=*(const __attribute__((address_space(3))) bf16x8*)(kp+2048); kf[3]=*(const __attribute__((address_space(3))) bf16x8*)(kp+2560);
  kf[4]=*(const __attribute__((address_space(3))) bf16x8*)(kp+4096); kf[5]=*(const __attribute__((address_space(3))) bf16x8*)(kp+4608);
  kf[6]=*(const __attribute__((address_space(3))) bf16x8*)(kp+6144); kf[7]=*(const __attribute__((address_space(3))) bf16x8*)(kp+6656);
}
__device__ __forceinline__ void kload2(bf16x8*kf,lds_cptr kp,int j){ kf[2*j]=*(const __attribute__((address_space(3))) bf16x8*)(kp+j*2048); kf[2*j+1]=*(const __attribute__((address_space(3))) bf16x8*)(kp+j*2048+512); }
__device__ __forceinline__ s16x4 vtr(lds_cptr p){ return __builtin_bit_cast(s16x4,__builtin_amdgcn_ds_read_tr16_b64_v4i16((__attribute__((address_space(3))) v4i16_t*)p)); }
__device__ __forceinline__ float rowmax(const f32x16&p0,const f32x16&p1){
  float a=max3f(p0[0],p0[1],p1[0]),b=max3f(p0[2],p0[3],p1[1]);a=max3f(a,p1[2],p1[3]);
  #pragma unroll
  for(int r=4;r<16;r+=4){a=max3f(a,p0[r],p0[r+1]);b=max3f(b,p0[r+2],p0[r+3]);a=max3f(a,p1[r],p1[r+1]);b=max3f(b,p1[r+2],p1[r+3]);}
  const float m=max2f(a,b);
  auto rr=__builtin_amdgcn_permlane32_swap(__float_as_uint(m),__float_as_uint(m),false,false);
  return max2f(__uint_as_float(rr[0]),__uint_as_float(rr[1]));
}
__device__ __forceinline__ void pv(f32x16*o,int vb,bf16x8 pa0,bf16x8 pa1,bf16x8 pa2,bf16x8 pa3){
  #pragma unroll
  for(int d0=0;d0<2;++d0){s16x4 lo[4],hi[4];
    #pragma unroll
    for(int ks=0;ks<4;++ks){
      asm volatile("ds_read_b64_tr_b16 %0,%1 offset:%c2":"=&v"(lo[ks]):"v"(vb),"i"(d0*4096+ks*1024):"memory");
      asm volatile("ds_read_b64_tr_b16 %0,%1 offset:%c2":"=&v"(hi[ks]):"v"(vb),"i"(d0*4096+ks*1024+512):"memory");}
    asm volatile("s_waitcnt lgkmcnt(0)":::"memory");SBAR();
    #define PK(k) (bf16x8){lo[k][0],lo[k][1],lo[k][2],lo[k][3],hi[k][0],hi[k][1],hi[k][2],hi[k][3]}
    o[d0]=__builtin_amdgcn_mfma_f32_32x32x16_bf16(pa0,PK(0),o[d0],0,0,0);
    o[d0]=__builtin_amdgcn_mfma_f32_32x32x16_bf16(pa1,PK(1),o[d0],0,0,0);
    o[d0]=__builtin_amdgcn_mfma_f32_32x32x16_bf16(pa2,PK(2),o[d0],0,0,0);
    o[d0]=__builtin_amdgcn_mfma_f32_32x32x16_bf16(pa3,PK(3),o[d0],0,0,0);
    #undef PK
  }
}

#ifndef ATTN_STORE16
#define ATTN_STORE16(p,v) (*(u32x4*)(p)=(v))
#endif
template<int THRL> __device__ __forceinline__ void attn_unit(int b,int h,int qb,int t0,const bf16*Q,const bf16*__restrict__ K,const bf16*__restrict__ V,bf16*O,const unsigned char*KAg,char*shm){
  const int tid=ltid(),lane=tid&63,r32=lane&31,hi=lane>>5; const int wid=__builtin_amdgcn_readfirstlane(tid>>6);
  const long rowbase=(long)b*SEQ; const int q0=qb*QB;
  const bf16*Qw=Q+(rowbase+q0+wid*QBLK)*DM+h*D;
  const bf16*Kh=K+(rowbase+(long)t0*KVBLK)*DM+h*D,*Vh=V+(rowbase+(long)t0*KVBLK)*DM+h*D;
  const unsigned lds0=(unsigned)(uintptr_t)shm;
  float*wsf=(float*)(shm+LDS_WS)+wid*64;
  const bf16*ksrc=Kh+(long)lane*DM+wid*8;
  const bf16*vsrc=Vh+(long)(16*(wid&3)+(lane>>2))*DM+(wid>>2)*32+(lane&3)*8;
  const unsigned kdst=lds0+LDS_K+wid*1024, vdst=lds0+LDS_V+wid*1024;
  #define DMA_K(t,slot) glds16(ksrc+(long)(t)*KVBLK*DM,(unsigned)__builtin_amdgcn_readfirstlane(kdst+(slot)))
  #define DMA_V(t,slot) glds16(vsrc+(long)(t)*KVBLK*DM,(unsigned)__builtin_amdgcn_readfirstlane(vdst+(slot)))
  const int vb0=(int)(lds0+LDS_V)+((lane>>4)&1)*32+(lane&3)*8+(4*hi+((lane&15)>>2))*64;
  const char*Kbase=shm+LDS_K; bf16x8 kf[8];
  const lds_cptr shm3=(lds_cptr)shm; const lds_cptr kp0=shm3+LDS_K+hi*1024+r32*16; const lds_cptr vp0=shm3+LDS_V+((lane>>4)&1)*32+(lane&3)*8+(4*hi+((lane&15)>>2))*64;
  const int NT=(q0+QB)/KVBLK-t0;
  u32x4 ka0,ka1; u32x4 qaw;
  const unsigned kavoff=(unsigned)r32*16u;
  const unsigned long long kab0=(unsigned long long)(uintptr_t)KAg+((unsigned long long)((b*NHEAD+h)*(long)SEQ+(long)t0*KVBLK))*16ull;
  #define KA_LOAD(t) do{ const unsigned long long a_=kab0+(unsigned long long)(t)*1024ull; const unsigned lo_=__builtin_amdgcn_readfirstlane((unsigned)a_),hi_=__builtin_amdgcn_readfirstlane((unsigned)(a_>>32)); \
    const unsigned long long sb_=((unsigned long long)hi_<<32)|lo_; \
    asm volatile("s_nop 4\n\tglobal_load_dwordx4 %0, %2, %3\n\tglobal_load_dwordx4 %1, %2, %3 offset:512":"=&v"(ka0),"=&v"(ka1):"v"(kavoff),"s"(sb_):"memory"); }while(0)
  #define QA_SET() do{ const float nm_=-mhat; const unsigned h_=cvtpk_s(nm_,0.f)&0xffffu; const float r1_=nm_-__uint_as_float(h_<<16); const unsigned m_=cvtpk_s(r1_,0.f)&0xffffu; \
    const float r2_=r1_-__uint_as_float(m_<<16); const unsigned l_=cvtpk_s(r2_,0.f)&0xffffu; \
    qaw[0]=hi?0u:0x3f803f80u; qaw[1]=hi?0u:(0x3f80u|(h_<<16)); qaw[2]=hi?0u:(m_|(l_<<16)); qaw[3]=0u; asm volatile("":"+v"(qaw)); }while(0)
  #define AUG(C0,C1) do{ C0=__builtin_amdgcn_mfma_f32_32x32x16_bf16(__builtin_bit_cast(bf16x8,ka0),__builtin_bit_cast(bf16x8,qaw),f32x16{},0,0,0); \
    C1=__builtin_amdgcn_mfma_f32_32x32x16_bf16(__builtin_bit_cast(bf16x8,ka1),__builtin_bit_cast(bf16x8,qaw),f32x16{},0,0,0); }while(0)
  #define PIN_KA() asm volatile("; KA landed":"+v"(ka0),"+v"(ka1)::"memory")
  #define WAIT_BAR_KA(N) do{ WAIT_BAR(N); PIN_KA(); }while(0)
  KA_LOAD(0);
  DMA_K(0,0);DMA_V(0,0);DMA_K(1,SLOTB);
  bf16x8 qr[4];
  #pragma unroll
  for(int d0=0;d0<4;++d0)qr[d0]=*reinterpret_cast<const bf16x8*>(&Qw[(long)r32*DM+d0*16+hi*8]);
  float mhat=0.f,l_reg=0.f;f32x16 o[2];o[0]=f32x16{};o[1]=f32x16{}; QA_SET();
  const int qrel=wid*QBLK+r32;
  #define CMASK(P0,P1,t) do{int jb_=(t)-(NT-4); if(jb_>=0)cmask(P0,P1,jb_,qrel,hi);}while(0)
  bool resc=false;
  #define START(P0,P1) do{ const float rm=rowmax(P0,P1); resc=false; \
    { const float dl=rm; mhat=fadd_s(mhat,dl); \
      _Pragma("unroll") for(int r=0;r<16;++r){P0[r]=fsub_s(P0[r],dl);P1[r]=fsub_s(P1[r],dl);} \
      QA_SET(); } \
    _Pragma("unroll") for(int r=0;r<16;++r)P0[r]=__builtin_amdgcn_exp2f(P0[r]); }while(0)
  #define RESC() do{ if(resc){ asm volatile("s_waitcnt lgkmcnt(0)":::"memory"); \
      _Pragma("unroll") for(int d_=0;d_<2;++d_) _Pragma("unroll") for(int r=0;r<16;++r)o[d_][r]*=wsf[crow(r,hi)]; } }while(0)
  f32x16 pA0,pA1,pB0,pB1;
  int sl_prev=0,sl_cur=0,sl_next=SLOTB;
  #define ROT() do{sl_prev=sl_cur;sl_cur=sl_next;sl_next=(sl_next==(NSLOT-1)*SLOTB)?0:sl_next+SLOTB;}while(0)
  DMA_K(2,2*SLOTB);
  WAIT_BAR_KA(3);
  AUG(pA0,pA1); qkt(pA0,pA1,Kbase,qr,r32,hi);asm volatile("s_nop 15\n\ts_nop 7":"+v"(pA0),"+v"(pA1));CMASK(pA0,pA1,0);
  START(pA0,pA1);
  _Pragma("unroll") for(int r=0;r<16;++r)pA1[r]=__builtin_amdgcn_exp2f(pA1[r]);
  WAIT_BAR(0);
  KA_LOAD(1);DMA_K(3,0);DMA_V(1,SLOTB);
  ROT();
  kload8(kf,kp0+sl_cur);
  WAIT_BAR_KA(2);
  s16x4 vlo[8],vhi[8]; u32x4 pw0,pw1,pw2,pw3;
  #define PKW(P,B) cvtpk_s(P[B],P[B+1])
  #define PAF(k) __builtin_bit_cast(bf16x8,pw##k)
  #define VFR(i) (bf16x8){vlo[i][0],vlo[i][1],vlo[i][2],vlo[i][3],vhi[i][0],vhi[i][1],vhi[i][2],vhi[i][3]}
  #define PIN(x) asm volatile("":"+v"(x))
  #define MX3(a,b,c) __builtin_fmaxf(__builtin_fmaxf((a),(b)),(c))
  #define GAPA(MF,A0,A1,A2,A3,W0,W1,PW) do{ MF; sacc+=A0; sacc+=A1; sacc+=A2; sacc+=A3; PIN(sacc); W0; W1; PIN(PW); SBAR(); }while(0)
  #define EX(v) __builtin_amdgcn_exp2f(v)
  #define GAPB(MF,X,B) do{ MF; X[B]=EX(X[B]); X[B+1]=EX(X[B+1]); X[B+2]=EX(X[B+2]); X[B+3]=EX(X[B+3]); PIN(X); SBAR(); }while(0)
  #define VRD(i) do{ vlo[i]=vtr(vp_+(((i)>>2)*4096+((i)&3)*1024)); vhi[i]=vtr(vp_+(((i)>>2)*4096+((i)&3)*1024+512)); }while(0)
  #define KRD(G,j) do{ if(G){ kload2(kf,kp0+sl_next,j); SBAR(); } }while(0)
  #define STEP(C0,C1,P0,P1,t,GK,GV,GL) do{ SBAR(); \
    const lds_cptr vp_=vp0+sl_prev; \
    AUG(C0,C1); SBAR(); \
    VRD(0); SBAR(); float sacc=(P0[0]+P0[1]); \
    GAPA(C0=__builtin_amdgcn_mfma_f32_32x32x16_bf16(kf[0],qr[0],C0,0,0,0), P0[2],P0[3],P0[4],P0[5],     pw0[0]=PKW(P0,0), pw0[1]=PKW(P0,2), pw0); \
    VRD(4); SBAR(); GAPA(C1=__builtin_amdgcn_mfma_f32_32x32x16_bf16(kf[1],qr[0],C1,0,0,0), P0[6],P0[7],P0[8],P0[9],     pw0[2]=PKW(P0,4), pw0[3]=PKW(P0,6), pw0); \
    VRD(1); SBAR(); GAPA(C0=__builtin_amdgcn_mfma_f32_32x32x16_bf16(kf[2],qr[1],C0,0,0,0),   P0[10],P0[11],P0[12],P0[13], pw1[0]=PKW(P0,8), pw1[1]=PKW(P0,10), pw1); \
    VRD(5); SBAR(); GAPA(C1=__builtin_amdgcn_mfma_f32_32x32x16_bf16(kf[3],qr[1],C1,0,0,0),   P0[14],P0[15],P1[0],P1[1],   pw1[2]=PKW(P0,12),pw1[3]=PKW(P0,14), pw1); \
    VRD(2); SBAR(); GAPA(C0=__builtin_amdgcn_mfma_f32_32x32x16_bf16(kf[4],qr[2],C0,0,0,0),   P1[2],P1[3],P1[4],P1[5],     pw2[0]=PKW(P1,0), pw2[1]=PKW(P1,2), pw2); \
    VRD(6); SBAR(); GAPA(C1=__builtin_amdgcn_mfma_f32_32x32x16_bf16(kf[5],qr[2],C1,0,0,0),   P1[6],P1[7],P1[8],P1[9],     pw2[2]=PKW(P1,4), pw2[3]=PKW(P1,6), pw2); \
    VRD(3); SBAR(); GAPA(C0=__builtin_amdgcn_mfma_f32_32x32x16_bf16(kf[6],qr[3],C0,0,0,0),   P1[10],P1[11],P1[12],P1[13], pw3[0]=PKW(P1,8), pw3[1]=PKW(P1,10), pw3); \
    VRD(7); SBAR(); GAPA(C1=__builtin_amdgcn_mfma_f32_32x32x16_bf16(kf[7],qr[3],C1,0,0,0),   P1[14],P1[15],0.f,0.f,       pw3[2]=PKW(P1,12),pw3[3]=PKW(P1,14), pw3); \
    l_reg+=sacc; \
    if(GL){KA_LOAD((t)+1);} if(GK){DMA_K((t)+3,sl_cur);} if(GV){DMA_V((t)+1,sl_next);} \
    CMASK(C0,C1,t); \
    { float a=MX3(C0[0],C0[1],C1[0]),b=MX3(C0[2],C0[3],C1[1]); a=MX3(a,C1[2],C1[3]); \
      _Pragma("unroll") for(int r=4;r<16;r+=4){a=MX3(a,C0[r],C0[r+1]);b=MX3(b,C0[r+2],C0[r+3]);a=MX3(a,C1[r],C1[r+1]);b=MX3(b,C1[r+2],C1[r+3]);} \
      float rm=__builtin_fmaxf(a,b); { auto rr=__builtin_amdgcn_permlane32_swap(__float_as_uint(rm),__float_as_uint(rm),false,false); rm=__builtin_fmaxf(__uint_as_float(rr[0]),__uint_as_float(rr[1])); } \
      resc=false; \
      if(__builtin_expect(__any(rm>(float)THRL),0)){ const float dl=__builtin_fmaxf(rm,0.f); mhat+=dl; \
        _Pragma("unroll") for(int r=0;r<16;++r){C0[r]-=dl;C1[r]-=dl;} \
        QA_SET(); \
        const float f=__builtin_amdgcn_exp2f(-dl); l_reg*=f; if(hi==0)wsf[r32]=f; resc=true; } } \
    SBAR(); \
    GAPB(o[0]=__builtin_amdgcn_mfma_f32_32x32x16_bf16(PAF(0),VFR(0),o[0],0,0,0), C0,0); \
    GAPB(o[1]=__builtin_amdgcn_mfma_f32_32x32x16_bf16(PAF(0),VFR(4),o[1],0,0,0), C0,4); \
    KRD(GL,0); GAPB(o[0]=__builtin_amdgcn_mfma_f32_32x32x16_bf16(PAF(1),VFR(1),o[0],0,0,0), C0,8); \
    KRD(GL,1); GAPB(o[1]=__builtin_amdgcn_mfma_f32_32x32x16_bf16(PAF(1),VFR(5),o[1],0,0,0), C0,12); \
    KRD(GL,2); GAPB(o[0]=__builtin_amdgcn_mfma_f32_32x32x16_bf16(PAF(2),VFR(2),o[0],0,0,0), C1,0); \
    KRD(GL,3); GAPB(o[1]=__builtin_amdgcn_mfma_f32_32x32x16_bf16(PAF(2),VFR(6),o[1],0,0,0), C1,4); \
    GAPB(o[0]=__builtin_amdgcn_mfma_f32_32x32x16_bf16(PAF(3),VFR(3),o[0],0,0,0), C1,8); \
    GAPB(o[1]=__builtin_amdgcn_mfma_f32_32x32x16_bf16(PAF(3),VFR(7),o[1],0,0,0), C1,12); \
    }while(0)
  int t=1;
  #undef CMASK
  #define CMASK(P0,P1,t) do{}while(0)
  for(;t+5<NT;t+=2){
    STEP(pB0,pB1,pA0,pA1,t,true,true,true);     WAIT_BAR_KA(2); RESC(); ROT();
    STEP(pA0,pA1,pB0,pB1,t+1,true,true,true);   WAIT_BAR_KA(2); RESC(); ROT();
  }
  #undef CMASK
  #define CMASK(P0,P1,t) do{int jb_=(t)-(NT-4); if(jb_>=0)cmask(P0,P1,jb_,qrel,hi);}while(0)
  #define ENDW(tt) do{ if((tt)+3<NT){WAIT_BAR(2);} else if((tt)+2<NT){WAIT_BAR(1);} else {WAIT_BAR(0);} PIN_KA(); }while(0)
  for(;t+1<NT;t+=2){
    STEP(pB0,pB1,pA0,pA1,t,(t+3<NT),(t+1<NT),(t+1<NT));       ENDW(t);   RESC(); ROT();
    STEP(pA0,pA1,pB0,pB1,t+1,(t+4<NT),(t+2<NT),(t+2<NT));     ENDW(t+1); RESC(); ROT();
  }
  STEP(pB0,pB1,pA0,pA1,NT-1,false,false,false); RESC();
  { float sacc=pB0[0]+pB0[1]; _Pragma("unroll") for(int r=2;r<16;++r)sacc+=pB0[r]; _Pragma("unroll") for(int r=0;r<16;++r)sacc+=pB1[r]; l_reg+=sacc;
    pw0=(u32x4){PKW(pB0,0),PKW(pB0,2),PKW(pB0,4),PKW(pB0,6)};pw1=(u32x4){PKW(pB0,8),PKW(pB0,10),PKW(pB0,12),PKW(pB0,14)};pw2=(u32x4){PKW(pB1,0),PKW(pB1,2),PKW(pB1,4),PKW(pB1,6)};pw3=(u32x4){PKW(pB1,8),PKW(pB1,10),PKW(pB1,12),PKW(pB1,14)};
    SBAR(); pv(o,vb0+sl_cur,PAF(0),PAF(1),PAF(2),PAF(3)); }
  #undef PKW
  #undef PAF
  #undef VFR
  #undef PIN
  #undef MX3
  #undef GAPA
  #undef GAPB
  #undef EX
  #undef VRD
  #undef KRD
  #undef STEP
  #undef ENDW
  {auto rr=__builtin_amdgcn_permlane32_swap(__float_as_uint(l_reg),__float_as_uint(l_reg),false,false);l_reg=__uint_as_float(rr[0])+__uint_as_float(rr[1]);}
  if(hi==0)wsf[32+r32]=l_reg;asm volatile("s_waitcnt lgkmcnt(0)":::"memory");
  float rli[16];
  #pragma unroll
  for(int r=0;r<16;++r)rli[r]=__builtin_amdgcn_rcpf(wsf[32+crow(r,hi)]);
  bf16*Ow=O+(rowbase+q0+wid*QBLK)*OP+h*D;
  { bf16*stg=(bf16*)(shm+LDS_OST)+wid*2048;
    #pragma unroll
    for(int r=0;r<16;++r){const int orow=crow(r,hi);
      #pragma unroll
      for(int d0=0;d0<2;++d0)stg[orow*64+d0*32+r32]=__float2bfloat16(o[d0][r]*rli[r]);}
    asm volatile("s_waitcnt lgkmcnt(0)":::"memory");
    #pragma unroll
    for(int i=0;i<4;++i){const int row=i*8+(lane>>3),ch=lane&7; const u32x4 v=*(const u32x4*)(stg+row*64+ch*8); ATTN_STORE16(Ow+(long)row*OP+ch*8,v);} }
  asm volatile("s_waitcnt lgkmcnt(0)\n\ts_barrier":::"memory");
  #undef DMA_K
  #undef DMA_V
  #undef KA_LOAD
  #undef QA_SET
  #undef AUG
  #undef WAIT_BAR_KA
  #undef PIN_KA
  #undef CMASK
  #undef START
  #undef RESC
  #undef ROT
}
constexpr int ATTN_LDS_BYTES=LDS_BYTES;
struct AttnTensors { const bf16* Q; const bf16* K; const bf16* V; bf16* O; const unsigned char* KA; };
struct AttnUnit { int bh; int qb; };
struct StaticOrder {
  int vcu;
  __device__ __forceinline__ explicit StaticOrder(int grid,int block):vcu((block%8)*(grid/8)+block/8){}
  __device__ __forceinline__ bool next(int i,AttnUnit&u)const{ if(i>=4)return false; const int s=vcu&15; u.bh=vcu>>4; u.qb=(i==0)?63-s:(i==1)?32+s:(i==2)?31-s:s; return true; }
  __device__ __forceinline__ void a_ready(const AttnUnit&)const{}
  __device__ __forceinline__ void done(const AttnUnit&)const{}
};
template<class Sched,int THRL=8> __device__ __forceinline__ void attn_phase(char*lds,const AttnTensors&T,const Sched&S){
  AttnUnit u;
  for(int i=0;S.next(i,u);++i){ S.a_ready(u); attn_unit<THRL>(u.bh/NHEAD,u.bh%NHEAD,u.qb,0,T.Q,T.K,T.V,T.O,T.KA,lds); S.done(u); }
}
#undef SBAR
#undef WAIT_BAR
}

namespace ck {
#define CK_LAS __attribute__((address_space(3)))
typedef unsigned short bf16_t;
typedef short bf16x8 __attribute__((ext_vector_type(8)));
typedef float f32x16 __attribute__((ext_vector_type(16)));
typedef float f32x4 __attribute__((ext_vector_type(4)));
typedef unsigned u32x4 __attribute__((ext_vector_type(4)));
typedef unsigned u32x2 __attribute__((ext_vector_type(2)));
typedef CK_LAS unsigned short* lbf;
typedef CK_LAS float* lf32;
constexpr int SB = 72;
constexpr int B9 = 64 * SB * 2;
constexpr int SF = 65;
constexpr int SM = 68;
constexpr int SX = 132;
__device__ __forceinline__ unsigned pk2(float lo, float hi) { return ::pk2(lo, hi); }
__device__ __forceinline__ unsigned f2bf(float f) { return ::f2bf(f); }
__device__ __forceinline__ float bflo(unsigned w) { return __builtin_bit_cast(float, w << 16); }
__device__ __forceinline__ float bfhi(unsigned w) { return __builtin_bit_cast(float, w & 0xffff0000u); }
__device__ __forceinline__ int crow(int reg, int hh) { return (reg & 3) + 8 * (reg >> 2) + 4 * hh; }
__device__ __forceinline__ f32x16 mm_lds(lbf A, lbf BT, int I, int J, int lane, f32x16 acc) {
    const int r = lane & 31, hh = lane >> 5;
    const lbf ap = A + (32 * I + r) * SB + 8 * hh; const lbf bp = BT + (32 * J + r) * SB + 8 * hh;
#pragma unroll
    for (int s = 0; s < 4; ++s) { const bf16x8 a = *(const CK_LAS bf16x8*)(ap + 16 * s); const bf16x8 b = *(const CK_LAS bf16x8*)(bp + 16 * s); acc = __builtin_amdgcn_mfma_f32_32x32x16_bf16(a, b, acc, 0, 0, 0); }
    return acc;
}
__device__ __forceinline__ f32x16 mm_gA(const bf16_t* __restrict__ Ag, lbf BT, int I, int J, int lane, f32x16 acc) {
    const int r = lane & 31, hh = lane >> 5;
    bf16x8 a[4];
#pragma unroll
    for (int s = 0; s < 4; ++s) a[s] = *(const bf16x8*)(Ag + (32 * I + r) * 64 + 16 * s + 8 * hh);
    const lbf bp = BT + (32 * J + r) * SB + 8 * hh;
#pragma unroll
    for (int s = 0; s < 4; ++s) { const bf16x8 b = *(const CK_LAS bf16x8*)(bp + 16 * s); acc = __builtin_amdgcn_mfma_f32_32x32x16_bf16(a[s], b, acc, 0, 0, 0); }
    return acc;
}
__device__ __forceinline__ f32x16 mm_gg(const bf16_t* __restrict__ Ag, const bf16_t* __restrict__ BTg, int I, int J, int lane, f32x16 acc) {
    const int r = lane & 31, hh = lane >> 5;
#pragma unroll
    for (int s = 0; s < 4; ++s) { const bf16x8 a = *(const bf16x8*)(Ag + (32 * I + r) * 64 + 16 * s + 8 * hh); const bf16x8 b = *(const bf16x8*)(BTg + (32 * J + r) * 64 + 16 * s + 8 * hh);
        acc = __builtin_amdgcn_mfma_f32_32x32x16_bf16(a, b, acc, 0, 0, 0); }
    return acc;
}
__device__ __forceinline__ f32x16 mm_rA(const bf16x8 (&a)[4], lbf BT, int J, int lane, f32x16 acc) {
    const int r = lane & 31, hh = lane >> 5; const lbf bp = BT + (32 * J + r) * SB + 8 * hh;
#pragma unroll
    for (int s = 0; s < 4; ++s) { const bf16x8 b = *(const CK_LAS bf16x8*)(bp + 16 * s); acc = __builtin_amdgcn_mfma_f32_32x32x16_bf16(a[s], b, acc, 0, 0, 0); }
    return acc;
}
__device__ __forceinline__ void load_gA(bf16x8 (&a)[4], const bf16_t* __restrict__ Ag, int I, int lane) {
    const int r = lane & 31, hh = lane >> 5;
#pragma unroll
    for (int s = 0; s < 4; ++s) a[s] = *(const bf16x8*)(Ag + (32 * I + r) * 64 + 16 * s + 8 * hh);
}
__device__ __forceinline__ f32x16 mm_lA_gB(lbf A, const bf16_t* __restrict__ BTg, int I, int J, int lane, f32x16 acc) {
    const int r = lane & 31, hh = lane >> 5; bf16x8 b[4];
#pragma unroll
    for (int s = 0; s < 4; ++s) b[s] = *(const bf16x8*)(BTg + (32 * J + r) * 64 + 16 * s + 8 * hh);
    const lbf ap = A + (32 * I + r) * SB + 8 * hh;
#pragma unroll
    for (int s = 0; s < 4; ++s) { const bf16x8 a = *(const CK_LAS bf16x8*)(ap + 16 * s); acc = __builtin_amdgcn_mfma_f32_32x32x16_bf16(a, b[s], acc, 0, 0, 0); }
    return acc;
}
__device__ __forceinline__ void frag_store(float* __restrict__ g, int wq, int lane, const f32x16& acc) {
    f32x4* p = (f32x4*)(g + ((size_t)(wq * 64 + lane)) * 16);
    p[0] = (f32x4){acc[0], acc[1], acc[2], acc[3]}; p[1] = (f32x4){acc[4], acc[5], acc[6], acc[7]}; p[2] = (f32x4){acc[8], acc[9], acc[10], acc[11]}; p[3] = (f32x4){acc[12], acc[13], acc[14], acc[15]};
}
__device__ __forceinline__ f32x16 frag_load(const float* __restrict__ g, int wq, int lane) {
    const f32x4* p = (const f32x4*)(g + ((size_t)(wq * 64 + lane)) * 16); const f32x4 a = p[0], b = p[1], c = p[2], d = p[3];
    return (f32x16){a[0], a[1], a[2], a[3], b[0], b[1], b[2], b[3], c[0], c[1], c[2], c[3], d[0], d[1], d[2], d[3]};
}
__device__ __forceinline__ void frag_store_bf(bf16_t* __restrict__ g, int wq, int lane, const f32x16& acc) {
    u32x4* p = (u32x4*)(g + ((size_t)(wq * 64 + lane)) * 16);
    p[0] = (u32x4){pk2(acc[0], acc[1]), pk2(acc[2], acc[3]), pk2(acc[4], acc[5]), pk2(acc[6], acc[7])}; p[1] = (u32x4){pk2(acc[8], acc[9]), pk2(acc[10], acc[11]), pk2(acc[12], acc[13]), pk2(acc[14], acc[15])};
}
__device__ __forceinline__ f32x16 frag_load_bf(const bf16_t* __restrict__ g, int wq, int lane) {
    const u32x4* p = (const u32x4*)(g + ((size_t)(wq * 64 + lane)) * 16); const u32x4 a = p[0], b = p[1];
    return (f32x16){bflo(a[0]), bfhi(a[0]), bflo(a[1]), bfhi(a[1]), bflo(a[2]), bfhi(a[2]), bflo(a[3]), bfhi(a[3]), bflo(b[0]), bfhi(b[0]), bflo(b[1]), bfhi(b[1]), bflo(b[2]), bfhi(b[2]), bflo(b[3]), bfhi(b[3])};
}
__device__ __forceinline__ void tile_store_T(lbf dst, int I, int J, int lane, const f32x16& acc) {
    const int r = lane & 31, hh = lane >> 5;
#pragma unroll
    for (int g = 0; g < 4; ++g) { u32x2 w; w.x = pk2(acc[4 * g], acc[4 * g + 1]); w.y = pk2(acc[4 * g + 2], acc[4 * g + 3]);
        *(CK_LAS u32x2*)(dst + (32 * J + r) * SB + 32 * I + 8 * g + 4 * hh) = w; }
}
__device__ __forceinline__ float fexp(float x) { return __builtin_amdgcn_exp2f(x * 1.4426950408889634f); }
__device__ __forceinline__ float sigm(float x) { return __builtin_amdgcn_rcpf(1.0f + fexp(-x)); }
__device__ __forceinline__ float ftanh(float x) { const float xc = fminf(fmaxf(x, -15.f), 15.f); return 1.0f - 2.0f * __builtin_amdgcn_rcpf(fexp(2.0f * xc) + 1.0f); }
__device__ __forceinline__ float logsig(float x) { const float ax = fabsf(x); return fminf(x, 0.f) - 0.6931471805599453f * __builtin_amdgcn_logf(1.0f + fexp(-ax)); }
template <int CTRL> __device__ __forceinline__ float dpp_f(float v) { return __builtin_bit_cast(float, __builtin_amdgcn_update_dpp(0, __builtin_bit_cast(int, v), CTRL, 0xf, 0xf, false)); }
__device__ __forceinline__ float quad_sum(float v) { v += dpp_f<0xB1>(v); v += dpp_f<0x4E>(v); return v; }

constexpr size_t O_PC = 0, O_QC = 16u << 20, O_GY = 48u << 20, O_YL = 64u << 20, O_VG = 96u << 20, O_GG = 112u << 20, O_H0 = 128u << 20, O_RKD = 144u << 20, O_KV = 145u << 20, O_RT = 177u << 20, O_END = 193u << 20,
                 O_PG = 193u << 20, O_QG = 195u << 20, O_HG = 197u << 20, O_KG = 199u << 20, O_RG = 203u << 20, O_END2 = 207u << 20;
struct RwkvParams {
    const float *mu_rkv, *mu_lora, *w0, *a0, *k_k, *k_a, *r_k, *ln_g, *ln_b, *gn_g;
    const bf16_t *w2t, *a2t, *g2t;
};

constexpr int L_U = 10 * B9, L_MM = L_U + 36864, L_GL = L_MM + 64 * SM * 4, L_END1 = L_GL + 256;
__device__ __forceinline__ void rwkv_stage1(CK_LAS unsigned char* lds, int item, const bf16_t* __restrict__ Pb, int PW, int C_RR, int C_RK, int C_RV, int C_WD, int SEQ, const RwkvParams& p, unsigned char* __restrict__ cw) {
    const int tid = ltid(), lane = tid & 63, wid = __builtin_amdgcn_readfirstlane(tid >> 6), quad = wid >> 2, wq = wid & 3, I = wq >> 1, J = wq & 1, r = lane & 31, hh = lane >> 5;
    const int b = item >> 10, h = (item >> 8) & 3, c = item & 255;
    const size_t m0 = (size_t)b * SEQ + (size_t)c * 64;
    const lbf Am = (lbf)(lds), Bm = (lbf)(lds + B9), Km = (lbf)(lds + 2 * B9), Rm = (lbf)(lds + 3 * B9), VT = (lbf)(lds + 4 * B9), BhT = (lbf)(lds + 5 * B9), KhT = (lbf)(lds + 6 * B9),
              Nm = (lbf)(lds + 7 * B9), Wb = (lbf)(lds + 8 * B9), Wk = (lbf)(lds + 9 * B9);
    const lbf TW = (lbf)(lds + L_U), AD = (lbf)(lds + L_U + B9), SG0 = (lbf)(lds + L_U + 2 * B9), SG1 = (lbf)(lds + L_U + 3 * B9);
    const lbf W2T = BhT, A2T = KhT, G2Ta = Nm, G2Tb = Wb;
    const lf32 X = (lf32)(lds + L_U), MM = (lf32)(lds + L_MM), GL = (lf32)(lds + L_GL);
    const lf32 AA = (lf32)(lds), GGl = (lf32)(lds + 2 * B9);
    const lbf ZlT = Km, X1T = Nm;
    const int t = tid >> 3, c8 = (tid & 7) * 8;
    const size_t m = m0 + t; const bool hp = (c * 64 + t) > 0;
    const bf16_t* pr = Pb + m * PW; const bf16_t* pp = pr - PW;
    float rr[8], kx[8], vv[8];
    {
        const u32x4 z4 = (u32x4){0u, 0u, 0u, 0u};
        const u32x4 cr = *(const u32x4*)(pr + C_RR + h * 64 + c8), ckk = *(const u32x4*)(pr + C_RK + h * 64 + c8), cv = *(const u32x4*)(pr + C_RV + h * 64 + c8);
        const u32x4 qr = hp ? *(const u32x4*)(pp + C_RR + h * 64 + c8) : z4, qk = hp ? *(const u32x4*)(pp + C_RK + h * 64 + c8) : z4, qv = hp ? *(const u32x4*)(pp + C_RV + h * 64 + c8) : z4;
#pragma unroll
        for (int e = 0; e < 8; ++e) { const int ch = h * 64 + c8 + e;
            const float a_ = (e & 1) ? bfhi(cr[e >> 1]) : bflo(cr[e >> 1]), b_ = (e & 1) ? bfhi(qr[e >> 1]) : bflo(qr[e >> 1]); rr[e] = a_ + (b_ - a_) * p.mu_rkv[ch];
            const float c_ = (e & 1) ? bfhi(ckk[e >> 1]) : bflo(ckk[e >> 1]), d_ = (e & 1) ? bfhi(qk[e >> 1]) : bflo(qk[e >> 1]); kx[e] = c_ + (d_ - c_) * p.mu_rkv[256 + ch];
            const float e_ = (e & 1) ? bfhi(cv[e >> 1]) : bflo(cv[e >> 1]), f_ = (e & 1) ? bfhi(qv[e >> 1]) : bflo(qv[e >> 1]); vv[e] = e_ + (f_ - e_) * p.mu_rkv[512 + ch]; }
#pragma unroll
        for (int q = 0; q < 4; ++q) { const u32x4 cl = *(const u32x4*)(pr + C_WD + q * 64 + c8); const u32x4 ql = hp ? *(const u32x4*)(pp + C_WD + q * 64 + c8) : z4;
            float lo[8];
#pragma unroll
            for (int e = 0; e < 8; ++e) { const float a_ = (e & 1) ? bfhi(cl[e >> 1]) : bflo(cl[e >> 1]), b_ = (e & 1) ? bfhi(ql[e >> 1]) : bflo(ql[e >> 1]); const float x = a_ + (b_ - a_) * p.mu_lora[q * 64 + c8 + e];
                lo[e] = (q == 0) ? ftanh(x) : (q == 1 ? x : sigm(x)); }
            u32x4 w; w.x = pk2(lo[0], lo[1]); w.y = pk2(lo[2], lo[3]); w.z = pk2(lo[4], lo[5]); w.w = pk2(lo[6], lo[7]);
            *(CK_LAS u32x4*)((q == 0 ? TW : q == 1 ? AD : q == 2 ? SG0 : SG1) + t * SB + c8) = w; }
        *(CK_LAS u32x4*)(W2T + t * SB + c8) = *(const u32x4*)(p.w2t + ((size_t)h * 64 + t) * 64 + c8);
        *(CK_LAS u32x4*)(A2T + t * SB + c8) = *(const u32x4*)(p.a2t + ((size_t)h * 64 + t) * 64 + c8);
        *(CK_LAS u32x4*)(G2Ta + t * SB + c8) = *(const u32x4*)(p.g2t + ((size_t)h * 64 + t) * 128 + c8);
        *(CK_LAS u32x4*)(G2Tb + t * SB + c8) = *(const u32x4*)(p.g2t + ((size_t)h * 64 + t) * 128 + 64 + c8);
    }
    __syncthreads();
    if (quad == 0) {
        f32x16 z = mm_lds(TW, W2T, I, J, lane, f32x16{}); f32x16 za = mm_lds(AD, A2T, I, J, lane, f32x16{});
        const int ch = 32 * J + r; const float w0c = p.w0[h * 64 + ch], a0c = p.a0[h * 64 + ch];
#pragma unroll
        for (int g = 0; g < 16; ++g) { const int tt = 32 * I + crow(g, hh); const float lw = logsig(w0c + z[g]) - 0.5f; MM[tt * SF + ch] = -fexp(lw); AA[tt * SF + ch] = sigm(a0c + za[g]); }
    } else {
        f32x16 zg = mm_lds(SG0, G2Ta, I, J, lane, f32x16{}); zg = mm_lds(SG1, G2Tb, I, J, lane, zg);
        const int ch = 32 * J + r;
#pragma unroll
        for (int g = 0; g < 16; ++g) { const int tt = 32 * I + crow(g, hh); GGl[tt * SF + ch] = zg[g]; }
    }
    __syncthreads();
    {
        const int ch = tid & 63, seg = tid >> 6; float v8[8]; float run = 0.f;
#pragma unroll
        for (int i = 0; i < 8; ++i) { run += MM[(seg * 8 + i) * SF + ch]; v8[i] = run; }
        const lf32 TOT = (lf32)(lds + L_U);
        TOT[seg * 64 + ch] = run;
        __syncthreads();
        float off = 0.f;
#pragma unroll
        for (int s2 = 0; s2 < 8; ++s2) off += (s2 < seg) ? TOT[s2 * 64 + ch] : 0.f;
#pragma unroll
        for (int i = 0; i < 8; ++i) MM[(seg * 8 + i) * SF + ch] = v8[i] + off;
    }
    __syncthreads();
    float aa[8], gg[8], lw[8], lwp[8], lwl[8];
#pragma unroll
    for (int e = 0; e < 8; ++e) { aa[e] = AA[t * SF + c8 + e]; gg[e] = GGl[t * SF + c8 + e]; lw[e] = MM[t * SF + c8 + e]; lwp[e] = t > 0 ? MM[(t - 1) * SF + c8 + e] : 0.f; lwl[e] = MM[63 * SF + c8 + e]; }
    __syncthreads();
    {
        float kk[8], k2[8]; float ss = 0.f, rk = 0.f;
#pragma unroll
        for (int e = 0; e < 8; ++e) { const int ch = h * 64 + c8 + e; kk[e] = kx[e] * p.k_k[ch]; ss += kk[e] * kk[e]; k2[e] = kx[e] * (1.0f + (aa[e] - 1.0f) * p.k_a[ch]); rk += rr[e] * k2[e] * p.r_k[ch]; }
        ss = quad_sum(ss); ss += dpp_f<0x141>(ss); rk = quad_sum(rk); rk += dpp_f<0x141>(rk);
        const float inv = 1.0f / fmaxf(sqrtf(ss), 1e-12f);
        float am[8], bm[8], km[8], rm[8];
#pragma unroll
        for (int e = 0; e < 8; ++e) { kk[e] *= inv; const float g_ = fexp(lw[e]), gi = fexp(-lw[e]), gp = fexp(lwp[e]), gl = fexp(lwl[e] - lw[e]); const float ka = kk[e] * aa[e];
            am[e] = -kk[e] * gp; bm[e] = ka * gi; km[e] = k2[e] * gi; rm[e] = rr[e] * g_;
            VT[(c8 + e) * SB + t] = (bf16_t)f2bf(vv[e]); BhT[(c8 + e) * SB + t] = (bf16_t)f2bf(ka * gl); KhT[(c8 + e) * SB + t] = (bf16_t)f2bf(k2[e] * gl);
            X[t * SX + c8 + e] = am[e]; }
        u32x4 w;
        w.x = pk2(am[0], am[1]); w.y = pk2(am[2], am[3]); w.z = pk2(am[4], am[5]); w.w = pk2(am[6], am[7]); *(CK_LAS u32x4*)(Am + t * SB + c8) = w;
        w.x = pk2(bm[0], bm[1]); w.y = pk2(bm[2], bm[3]); w.z = pk2(bm[4], bm[5]); w.w = pk2(bm[6], bm[7]); *(CK_LAS u32x4*)(Bm + t * SB + c8) = w;
        w.x = pk2(km[0], km[1]); w.y = pk2(km[2], km[3]); w.z = pk2(km[4], km[5]); w.w = pk2(km[6], km[7]); *(CK_LAS u32x4*)(Km + t * SB + c8) = w;
        w.x = pk2(rm[0], rm[1]); w.y = pk2(rm[2], rm[3]); w.z = pk2(rm[4], rm[5]); w.w = pk2(rm[6], rm[7]); *(CK_LAS u32x4*)(Rm + t * SB + c8) = w;
        if (t == 63) {
#pragma unroll
            for (int e = 0; e < 8; ++e) GL[c8 + e] = fexp(lwl[e]); }
        w.x = pk2(vv[0], vv[1]); w.y = pk2(vv[2], vv[3]); w.z = pk2(vv[4], vv[5]); w.w = pk2(vv[6], vv[7]); *(u32x4*)(cw + O_VG + (size_t)item * 8192 + (t * 64 + c8) * 2) = w;
        w.x = pk2(gg[0], gg[1]); w.y = pk2(gg[2], gg[3]); w.z = pk2(gg[4], gg[5]); w.w = pk2(gg[6], gg[7]); *(u32x4*)(cw + O_GG + (size_t)item * 8192 + (t * 64 + c8) * 2) = w;
        if ((tid & 7) == 0) *(float*)(cw + O_RKD + (size_t)item * 256 + t * 4) = rk;
    }
    __syncthreads();
    {
        const f32x16 p1 = mm_lds(Am, quad == 0 ? Bm : Km, I, J, lane, f32x16{}); const f32x16 p2 = mm_lds(Rm, quad == 0 ? Bm : Km, I, J, lane, f32x16{});
        const int ii = 32 * J + r;
#pragma unroll
        for (int g = 0; g < 16; ++g) { const int tt = 32 * I + crow(g, hh);
            if (quad == 0) { MM[tt * SM + (ii & 3) * 16 + (ii >> 2)] = (ii < tt) ? p1[g] : 0.f; Wb[tt * SB + ii] = (bf16_t)f2bf((ii <= tt) ? p2[g] : 0.f); }
            else { Nm[tt * SB + ii] = (bf16_t)f2bf((ii < tt) ? p1[g] : 0.f); Wk[tt * SB + ii] = (bf16_t)f2bf((ii <= tt) ? p2[g] : 0.f); } }
    }
    __syncthreads();
    if (quad == 0) { const f32x16 nv = mm_lds(Nm, VT, I, J, lane, f32x16{}); const int vcol = 64 + 32 * J + r;
#pragma unroll
        for (int g = 0; g < 16; ++g) X[(32 * I + crow(g, hh)) * SX + vcol] = nv[g]; }
    __syncthreads();
    {
        const int col = tid >> 2, q = tid & 3;
        float xs[16];
#pragma unroll
        for (int k = 0; k < 16; ++k) xs[k] = X[(q + 4 * k) * SX + col];
#pragma unroll
        for (int tt = 1; tt < 64; ++tt) {
            const CK_LAS f32x4* mr = (const CK_LAS f32x4*)(MM + tt * SM + q * 16);
            float s0 = 0.f, s1 = 0.f, s2 = 0.f, s3 = 0.f;
#pragma unroll
            for (int k4 = 0; k4 < (tt + 15) / 16; ++k4) { const f32x4 mv = mr[k4]; s0 += mv[0] * xs[4 * k4]; s1 += mv[1] * xs[4 * k4 + 1]; s2 += mv[2] * xs[4 * k4 + 2]; s3 += mv[3] * xs[4 * k4 + 3]; }
            const float sm = quad_sum((s0 + s1) + (s2 + s3));
            xs[tt >> 2] += (q == (tt & 3)) ? sm : 0.f;
        }
        const lbf dstT = (col < 64) ? (X1T + col * SB) : (ZlT + (col - 64) * SB);
#pragma unroll
        for (int k = 0; k < 16; ++k) dstT[q + 4 * k] = (bf16_t)f2bf(xs[k]);
    }
    __syncthreads();
    if (quad == 0) {
        const f32x16 gy = mm_lds(Wb, X1T, I, J, lane, f32x16{}); const f32x16 pc = mm_lds(BhT, X1T, I, J, lane, f32x16{});
        bf16_t* gyg = (bf16_t*)(cw + O_GY + (size_t)item * 8192); bf16_t* pcg = (bf16_t*)(cw + O_PC + (size_t)item * 8192);
        const int cc = 32 * J + r;
#pragma unroll
        for (int g = 0; g < 16; ++g) { const int rw = 32 * I + crow(g, hh);
            gyg[rw * 64 + cc] = (bf16_t)f2bf(gy[g] + __builtin_bit_cast(float, (unsigned)Rm[rw * SB + cc] << 16));
            pcg[rw * 64 + cc] = (bf16_t)f2bf(pc[g] + (rw == cc ? GL[cc] : 0.f)); }
    } else {
        f32x16 yl = mm_lds(ZlT, Wb, I, J, lane, f32x16{}); yl = mm_lds(VT, Wk, I, J, lane, yl);
        f32x16 qc = mm_lds(BhT, ZlT, I, J, lane, f32x16{}); qc = mm_lds(KhT, VT, I, J, lane, qc);
        frag_store((float*)(cw + O_YL + (size_t)item * 16384), wq, lane, yl); frag_store_bf((bf16_t*)(cw + O_QC) + (size_t)item * 4096, wq, lane, qc);
    }
    __syncthreads();
}

template <int NST> __device__ __forceinline__ void rwkv_scan(CK_LAS unsigned char* lds, int chain, const bf16_t* __restrict__ pcb, const bf16_t* __restrict__ qcb, bf16_t* __restrict__ h0b) {
    const int tid = ltid(), lane = tid & 63, wid = __builtin_amdgcn_readfirstlane(tid >> 6), quad = wid >> 2, wq = wid & 3, I = wq >> 1, J = wq & 1, r = lane & 31, hh = lane >> 5, qtid = tid & 255;
    const lbf HT = (lbf)(lds + quad * B9);
    for (int i = qtid; i < 64 * SB / 2; i += 256) ((CK_LAS unsigned*)HT)[i] = 0u;
    __syncthreads();
    const bool on = chain >= 0; const size_t it0 = (size_t)(on ? chain : 0) * NST;
    const bf16_t* pcg = pcb + it0 * 4096; const bf16_t* qcg = qcb + it0 * 4096; bf16_t* h0g = h0b + it0 * 4096;
    constexpr int PD = 5;
    bf16x8 ar[PD][4]; f32x16 qr[PD];
#define CK_LOADSTEP(A_, Q_, cc) do { const int c_ = (cc) < NST ? (cc) : NST - 1; _Pragma("unroll") for (int s_ = 0; s_ < 4; ++s_) A_[s_] = *(const bf16x8*)(pcg + (size_t)c_ * 4096 + (32 * I + r) * 64 + 16 * s_ + 8 * hh); Q_ = frag_load_bf(qcg + (size_t)c_ * 4096, wq, lane); } while (0)
#pragma unroll
    for (int k = 0; k < PD; ++k) CK_LOADSTEP(ar[k], qr[k], k);
    for (int c = 0; c < NST + PD - 1; c += PD) {
#pragma unroll
        for (int k = 0; k < PD; ++k) {
            const int cc = c + k;
            if (cc < NST) {
            if (on) { const int row = qtid >> 2, seg = (qtid & 3) * 16; const u32x4 w0 = *(const CK_LAS u32x4*)(HT + row * SB + seg), w1 = *(const CK_LAS u32x4*)(HT + row * SB + seg + 8);
                      u32x4* dst = (u32x4*)(h0g + (size_t)cc * 4096 + row * 64 + seg); dst[0] = w0; dst[1] = w1; }
            f32x16 acc = qr[k];
            const lbf bp = HT + (32 * J + r) * SB + 8 * hh;
#pragma unroll
            for (int s_ = 0; s_ < 4; ++s_) { const bf16x8 bfr = *(const CK_LAS bf16x8*)(bp + 16 * s_); acc = __builtin_amdgcn_mfma_f32_32x32x16_bf16(ar[k][s_], bfr, acc, 0, 0, 0); }
            CK_LOADSTEP(ar[k], qr[k], cc + PD);
            asm volatile("s_waitcnt lgkmcnt(0)\n\ts_barrier" ::: "memory");
            tile_store_T(HT, I, J, lane, acc);
            asm volatile("s_waitcnt lgkmcnt(0)\n\ts_barrier" ::: "memory");
            }
        }
    }
#undef CK_LOADSTEP
}

__device__ __forceinline__ void rwkv_level1(CK_LAS unsigned char* lds, int task, unsigned char* __restrict__ cw) {
    const int tid = ltid(), lane = tid & 63, wid = __builtin_amdgcn_readfirstlane(tid >> 6), quad = wid >> 2, wq = wid & 3, I = wq >> 1, J = wq & 1, r = lane & 31, hh = lane >> 5;
    const lbf PTh = (lbf)(lds + quad * 4 * B9), PTl = PTh + 64 * SB, QTh = PTl + 64 * SB, QTl = QTh + 64 * SB;
    const bool on = task >= 0; const int tk = on ? task : 0; const size_t item0 = (size_t)(tk >> 5) * 256 + (size_t)(tk & 31) * 8;
    f32x16 PG, QG = f32x16{};
#pragma unroll
    for (int g = 0; g < 16; ++g) PG[g] = (I == J && crow(g, hh) == r) ? 1.0f : 0.0f;
    for (int j = 0; j < 8; ++j) {
        const size_t item = item0 + j;
        bf16x8 a[4]; load_gA(a, (const bf16_t*)(cw + O_PC) + item * 4096, I, lane);
        f32x16 qn = frag_load_bf((const bf16_t*)(cw + O_QC) + item * 4096, wq, lane);
        f32x16 pl, ql;
#pragma unroll
        for (int g = 0; g < 16; ++g) { pl[g] = PG[g] - __builtin_bit_cast(float, f2bf(PG[g]) << 16); ql[g] = QG[g] - __builtin_bit_cast(float, f2bf(QG[g]) << 16); }
        tile_store_T(PTh, I, J, lane, PG); tile_store_T(PTl, I, J, lane, pl); tile_store_T(QTh, I, J, lane, QG); tile_store_T(QTl, I, J, lane, ql);
        __syncthreads();
        f32x16 pn = mm_rA(a, PTh, J, lane, f32x16{}); pn = mm_rA(a, PTl, J, lane, pn);
        qn = mm_rA(a, QTh, J, lane, qn); qn = mm_rA(a, QTl, J, lane, qn);
        __syncthreads();
        PG = pn; QG = qn;
    }
    if (on) { bf16_t* pgg = (bf16_t*)(cw + O_PG) + (size_t)tk * 4096; const int cc = 32 * J + r;
#pragma unroll
        for (int g = 0; g < 16; ++g) pgg[(32 * I + crow(g, hh)) * 64 + cc] = (bf16_t)f2bf(PG[g]);
        frag_store_bf((bf16_t*)(cw + O_QG) + (size_t)tk * 4096, wq, lane, QG); }
}

constexpr int L_RW3 = B9 + 64 * SF * 4;
__device__ __forceinline__ void rwkv_stage3g(CK_LAS unsigned char* ldsq, int task, const RwkvParams& p, const unsigned char* __restrict__ cw, bf16_t* __restrict__ MIXB, int SEQ) {
    const int tid = ltid(), lane = tid & 63, wid = __builtin_amdgcn_readfirstlane(tid >> 6), wq = wid & 3, I = wq >> 1, J = wq & 1, r = lane & 31, hh = lane >> 5, qtid = tid & 255;
    const lbf HT = (lbf)ldsq; const lf32 Y = (lf32)(ldsq + B9);
    const bool on = task >= 0; const int tk = on ? task : 0; const int item0 = (tk >> 5) * 256 + (tk & 31) * 8;
    { const int row = qtid >> 2, seg = (qtid & 3) * 16; const u32x4* src = (const u32x4*)((const bf16_t*)(cw + O_HG) + (size_t)tk * 4096 + row * 64 + seg);
      *(CK_LAS u32x4*)(HT + row * SB + seg) = src[0]; *(CK_LAS u32x4*)(HT + row * SB + seg + 8) = src[1]; }
    __syncthreads();
    for (int j = 0; j < 8; ++j) {
        const int item = item0 + j;
        bf16x8 a[4]; load_gA(a, (const bf16_t*)(cw + O_PC) + (size_t)item * 4096, I, lane);
        f32x16 hn = frag_load_bf((const bf16_t*)(cw + O_QC) + (size_t)item * 4096, wq, lane);
        {
            f32x16 acc = frag_load((const float*)(cw + O_YL) + (size_t)item * 4096, wq, lane);
            acc = mm_lA_gB(HT, (const bf16_t*)(cw + O_GY) + (size_t)item * 4096, I, J, lane, acc);
#pragma unroll
            for (int g = 0; g < 16; ++g) Y[(32 * J + r) * SF + 32 * I + crow(g, hh)] = acc[g];
        }
        hn = mm_rA(a, HT, J, lane, hn);
        __syncthreads();
        tile_store_T(HT, I, J, lane, hn);
        if (on) {
            const int b = item >> 10, h = (item >> 8) & 3, c = item & 255; const int t = qtid >> 2, c16 = (qtid & 3) * 16;
            float y[16]; float s = 0.f;
#pragma unroll
            for (int e = 0; e < 16; ++e) { y[e] = Y[t * SF + c16 + e]; s += y[e]; }
            const float mu = quad_sum(s) * (1.f / 64.f); float s2 = 0.f;
#pragma unroll
            for (int e = 0; e < 16; ++e) { y[e] -= mu; s2 += y[e] * y[e]; }
            const float rstd = 1.0f / sqrtf(quad_sum(s2) * (1.f / 64.f) + 64e-5f);
            const u32x4* vg = (const u32x4*)(cw + O_VG + (size_t)item * 8192 + (t * 64 + c16) * 2); const u32x4* gg = (const u32x4*)(cw + O_GG + (size_t)item * 8192 + (t * 64 + c16) * 2);
            const float rk = *(const float*)(cw + O_RKD + (size_t)item * 256 + t * 4);
            unsigned ow[8];
#pragma unroll
            for (int hv = 0; hv < 2; ++hv) { const u32x4 vw = vg[hv], gw = gg[hv];
#pragma unroll
                for (int e2 = 0; e2 < 4; ++e2) { const int e = hv * 8 + 2 * e2; const int ch = h * 64 + c16 + e;
                    const float o0 = (y[e] * rstd * p.ln_g[ch] + p.ln_b[ch] + rk * bflo(vw[e2])) * bflo(gw[e2]);
                    const float o1 = (y[e + 1] * rstd * p.ln_g[ch + 1] + p.ln_b[ch + 1] + rk * bfhi(vw[e2])) * bfhi(gw[e2]);
                    ow[hv * 4 + e2] = pk2(o0, o1); } }
            u32x4* dst = (u32x4*)(MIXB + ((size_t)b * SEQ + (size_t)c * 64 + t) * 1024 + 512 + h * 64 + c16);
            dst[0] = (u32x4){ow[0], ow[1], ow[2], ow[3]}; dst[1] = (u32x4){ow[4], ow[5], ow[6], ow[7]};
        }
        __syncthreads();
    }
}

__device__ __forceinline__ void rwkv_stage3(CK_LAS unsigned char* ldsq, int item, const RwkvParams& p, const unsigned char* __restrict__ cw, bf16_t* __restrict__ MIXB, int SEQ) {
    const int tid = ltid(), lane = tid & 63, wid = __builtin_amdgcn_readfirstlane(tid >> 6), wq = wid & 3, I = wq >> 1, J = wq & 1, r = lane & 31, hh = lane >> 5, qtid = tid & 255;
    const lf32 Y = (lf32)ldsq;
    if (item >= 0) {
        f32x16 acc = frag_load((const float*)(cw + O_YL) + (size_t)item * 4096, wq, lane);
        acc = mm_gg((const bf16_t*)(cw + O_H0) + (size_t)item * 4096, (const bf16_t*)(cw + O_GY) + (size_t)item * 4096, I, J, lane, acc);
#pragma unroll
        for (int g = 0; g < 16; ++g) Y[(32 * J + r) * SF + 32 * I + crow(g, hh)] = acc[g];
    }
    __syncthreads();
    if (item >= 0) {
        const int b = item >> 10, h = (item >> 8) & 3, c = item & 255; const int t = qtid >> 2, c16 = (qtid & 3) * 16;
        float y[16]; float s = 0.f;
#pragma unroll
        for (int e = 0; e < 16; ++e) { y[e] = Y[t * SF + c16 + e]; s += y[e]; }
        const float mu = quad_sum(s) * (1.f / 64.f); float s2 = 0.f;
#pragma unroll
        for (int e = 0; e < 16; ++e) { y[e] -= mu; s2 += y[e] * y[e]; }
        const float rstd = 1.0f / sqrtf(quad_sum(s2) * (1.f / 64.f) + 64e-5f);
        const u32x4* vg = (const u32x4*)(cw + O_VG + (size_t)item * 8192 + (t * 64 + c16) * 2); const u32x4* gg = (const u32x4*)(cw + O_GG + (size_t)item * 8192 + (t * 64 + c16) * 2);
        const float rk = *(const float*)(cw + O_RKD + (size_t)item * 256 + t * 4);
        unsigned ow[8];
#pragma unroll
        for (int hv = 0; hv < 2; ++hv) { const u32x4 vw = vg[hv], gw = gg[hv];
#pragma unroll
            for (int e2 = 0; e2 < 4; ++e2) { const int e = hv * 8 + 2 * e2; const int ch = h * 64 + c16 + e;
                const float o0 = (y[e] * rstd * p.ln_g[ch] + p.ln_b[ch] + rk * bflo(vw[e2])) * bflo(gw[e2]);
                const float o1 = (y[e + 1] * rstd * p.ln_g[ch + 1] + p.ln_b[ch + 1] + rk * bfhi(vw[e2])) * bfhi(gw[e2]);
                ow[hv * 4 + e2] = pk2(o0, o1); } }
        u32x4* dst = (u32x4*)(MIXB + ((size_t)b * SEQ + (size_t)c * 64 + t) * 1024 + 512 + h * 64 + c16);
        dst[0] = (u32x4){ow[0], ow[1], ow[2], ow[3]}; dst[1] = (u32x4){ow[4], ow[5], ow[6], ow[7]};
    }
    __syncthreads();
}

__device__ __forceinline__ void rot16(float (&o)[16], const bf16_t* __restrict__ prow, int colbase, int c16, const float* __restrict__ ropet  ) {
    const u32x4* own = (const u32x4*)(prow + colbase + c16); const u32x4* par = (const u32x4*)(prow + colbase + (c16 ^ 32));
    const f32x4* cs = (const f32x4*)(ropet + 2 * (c16 & 31));
#pragma unroll
    for (int hv = 0; hv < 2; ++hv) { const u32x4 ow = own[hv], pw = par[hv];
#pragma unroll
        for (int e2 = 0; e2 < 4; ++e2) { const f32x4 csv = cs[hv * 4 + e2];
            const float x0 = bflo(ow[e2]), x1 = bfhi(ow[e2]), p0 = bflo(pw[e2]), p1 = bfhi(pw[e2]);
            o[hv * 8 + 2 * e2] = (c16 < 32) ? (x0 * csv[0] - p0 * csv[1]) : (p0 * csv[1] + x0 * csv[0]);
            o[hv * 8 + 2 * e2 + 1] = (c16 < 32) ? (x1 * csv[2] - p1 * csv[3]) : (p1 * csv[3] + x1 * csv[2]); } }
}
__device__ __forceinline__ void ret_stage1(CK_LAS unsigned char* ldsq, int item, const bf16_t* __restrict__ Pb, int PW, int C_TK, int C_TV, int SEQ, const float* __restrict__ ROPE, unsigned char* __restrict__ cw) {
    const int tid = ltid(), lane = tid & 63, wid = __builtin_amdgcn_readfirstlane(tid >> 6), wq = wid & 3, I = wq >> 1, J = wq & 1, qtid = tid & 255;
    const lbf VT = (lbf)ldsq, KdT = (lbf)(ldsq + B9);
    if (item >= 0) {
        const int b = item >> 10, h = (item >> 8) & 3, c = item & 255; const int t = qtid >> 2, c16 = (qtid & 3) * 16; const int pos = c * 64 + t;
        const bf16_t* prow = Pb + ((size_t)b * SEQ + pos) * PW;
        float kr[16]; rot16(kr, prow, C_TK + h * 64, c16, ROPE + (size_t)pos * 64);
        const float lg = __builtin_amdgcn_logf(1.0f - __builtin_amdgcn_exp2f(-5.0f - (float)h));
        const float dec = 0.125f * __builtin_amdgcn_exp2f(lg * (float)(63 - t));
        const u32x4* vp = (const u32x4*)(prow + C_TV + h * 64 + c16);
#pragma unroll
        for (int hv = 0; hv < 2; ++hv) { const u32x4 vw = vp[hv];
#pragma unroll
            for (int e2 = 0; e2 < 4; ++e2) { const int e = hv * 8 + 2 * e2;
                VT[(c16 + e) * SB + t] = (bf16_t)(vw[e2] & 0xffffu); VT[(c16 + e + 1) * SB + t] = (bf16_t)(vw[e2] >> 16);
                KdT[(c16 + e) * SB + t] = (bf16_t)f2bf(kr[e] * dec); KdT[(c16 + e + 1) * SB + t] = (bf16_t)f2bf(kr[e + 1] * dec); } }
    }
    __syncthreads();
    if (item >= 0) { const f32x16 kv = mm_lds(VT, KdT, I, J, lane, f32x16{}); frag_store_bf((bf16_t*)(cw + O_KV) + (size_t)item * 4096, wq, lane, kv); }
    __syncthreads();
}
__device__ __forceinline__ void ret_scan(int chain, unsigned char* __restrict__ cw) {
    const int tid = ltid(), lane = tid & 63, wid = __builtin_amdgcn_readfirstlane(tid >> 6), wq = wid & 3, I = wq >> 1, J = wq & 1, r = lane & 31, hh = lane >> 5;
    const int h = chain & 3; const float lg = __builtin_amdgcn_logf(1.0f - __builtin_amdgcn_exp2f(-5.0f - (float)h)); const float g64 = __builtin_amdgcn_exp2f(lg * 64.0f);
    const bf16_t* kvg = (const bf16_t*)(cw + O_KV) + (size_t)chain * 256 * 4096; bf16_t* rtg = (bf16_t*)(cw + O_RT) + (size_t)chain * 256 * 4096;
    f32x16 R = f32x16{}; constexpr int PD = 8; f32x16 nx[PD];
#pragma unroll
    for (int k = 0; k < PD; ++k) nx[k] = frag_load_bf(kvg + (size_t)k * 4096, wq, lane);
    for (int c = 0; c < 256; c += PD) {
#pragma unroll
        for (int k = 0; k < PD; ++k) { const int cc = c + k; bf16_t* dst = rtg + (size_t)cc * 4096;
#pragma unroll
            for (int g = 0; g < 16; ++g) dst[(32 * I + crow(g, hh)) * 64 + 32 * J + r] = (bf16_t)f2bf(R[g]);
            const f32x16 kvc = nx[k]; const int nn = cc + PD < 256 ? cc + PD : 255;
            nx[k] = frag_load_bf(kvg + (size_t)nn * 4096, wq, lane);
#pragma unroll
            for (int g = 0; g < 16; ++g) R[g] = R[g] * g64 + kvc[g]; }
    }
}
constexpr int L_RET3 = 4 * B9 + 64 * SF * 4;
__device__ __forceinline__ void ret_stage3(CK_LAS unsigned char* ldsq, int item, const bf16_t* __restrict__ Pb, int PW, int C_TQ, int C_TK, int C_TV, int C_TG, int SEQ, const float* __restrict__ ROPE,
                                           const float* __restrict__ gn_g, const unsigned char* __restrict__ cw, bf16_t* __restrict__ MIXB) {
    const int tid = ltid(), lane = tid & 63, wid = __builtin_amdgcn_readfirstlane(tid >> 6), wq = wid & 3, I = wq >> 1, J = wq & 1, r = lane & 31, hh = lane >> 5, qtid = tid & 255;
    const lbf Qr = (lbf)ldsq, Kr = (lbf)(ldsq + B9), VT = (lbf)(ldsq + 2 * B9), Sb = (lbf)(ldsq + 3 * B9); const lf32 Y = (lf32)(ldsq + 4 * B9);
    const int b = item >= 0 ? item >> 10 : 0, h = item >= 0 ? (item >> 8) & 3 : 0, c = item >= 0 ? item & 255 : 0; const int t = qtid >> 2, c16 = (qtid & 3) * 16; const int pos = c * 64 + t;
    const float lg = __builtin_amdgcn_logf(1.0f - __builtin_amdgcn_exp2f(-5.0f - (float)h));
    const bf16_t* prow = Pb + ((size_t)b * SEQ + pos) * PW;
    if (item >= 0) {
        float qr[16], kr[16]; rot16(qr, prow, C_TQ + h * 64, c16, ROPE + (size_t)pos * 64); rot16(kr, prow, C_TK + h * 64, c16, ROPE + (size_t)pos * 64);
        u32x4 w;
        w.x = pk2(qr[0], qr[1]); w.y = pk2(qr[2], qr[3]); w.z = pk2(qr[4], qr[5]); w.w = pk2(qr[6], qr[7]); *(CK_LAS u32x4*)(Qr + t * SB + c16) = w;
        w.x = pk2(qr[8], qr[9]); w.y = pk2(qr[10], qr[11]); w.z = pk2(qr[12], qr[13]); w.w = pk2(qr[14], qr[15]); *(CK_LAS u32x4*)(Qr + t * SB + c16 + 8) = w;
#pragma unroll
        for (int e = 0; e < 16; ++e) kr[e] *= 0.125f;
        w.x = pk2(kr[0], kr[1]); w.y = pk2(kr[2], kr[3]); w.z = pk2(kr[4], kr[5]); w.w = pk2(kr[6], kr[7]); *(CK_LAS u32x4*)(Kr + t * SB + c16) = w;
        w.x = pk2(kr[8], kr[9]); w.y = pk2(kr[10], kr[11]); w.z = pk2(kr[12], kr[13]); w.w = pk2(kr[14], kr[15]); *(CK_LAS u32x4*)(Kr + t * SB + c16 + 8) = w;
        const u32x4* vp = (const u32x4*)(prow + C_TV + h * 64 + c16);
#pragma unroll
        for (int hv = 0; hv < 2; ++hv) { const u32x4 vw = vp[hv];
#pragma unroll
            for (int e2 = 0; e2 < 4; ++e2) { const int e = hv * 8 + 2 * e2; VT[(c16 + e) * SB + t] = (bf16_t)(vw[e2] & 0xffffu); VT[(c16 + e + 1) * SB + t] = (bf16_t)(vw[e2] >> 16); } }
    }
    __syncthreads();
    if (item >= 0) {
        f32x16 st = mm_lds(Kr, Qr, I, J, lane, f32x16{}); const int tt = 32 * J + r;
#pragma unroll
        for (int g = 0; g < 16; ++g) { const int ii = 32 * I + crow(g, hh); st[g] = (ii <= tt) ? st[g] * __builtin_amdgcn_exp2f(lg * (float)(tt - ii)) : 0.f; }
        tile_store_T(Sb, I, J, lane, st);
    }
    __syncthreads();
    if (item >= 0) {
        const f32x16 yi = mm_lds(VT, Sb, I, J, lane, f32x16{}); const f32x16 yc = mm_gA((const bf16_t*)(cw + O_RT) + (size_t)item * 4096, Qr, I, J, lane, f32x16{});
        const int tt = 32 * J + r; const float qd = __builtin_amdgcn_exp2f(lg * (float)(tt + 1));
#pragma unroll
        for (int g = 0; g < 16; ++g) Y[tt * SF + 32 * I + crow(g, hh)] = yi[g] + qd * yc[g];
    }
    __syncthreads();
    if (item >= 0) {
        float y[16]; float s = 0.f;
#pragma unroll
        for (int e = 0; e < 16; ++e) { y[e] = Y[t * SF + c16 + e]; s += y[e]; }
        const float mu = quad_sum(s) * (1.f / 64.f); float s2 = 0.f;
#pragma unroll
        for (int e = 0; e < 16; ++e) { y[e] -= mu; s2 += y[e] * y[e]; }
        const float rstd = 1.0f / sqrtf(quad_sum(s2) * (1.f / 64.f) + 1e-6f);
        const u32x4* gp = (const u32x4*)(prow + C_TG + h * 64 + c16); unsigned ow[8];
#pragma unroll
        for (int hv = 0; hv < 2; ++hv) { const u32x4 gw = gp[hv];
#pragma unroll
            for (int e2 = 0; e2 < 4; ++e2) { const int e = hv * 8 + 2 * e2; const int ch = h * 64 + c16 + e; const float g0 = bflo(gw[e2]), g1 = bfhi(gw[e2]);
                ow[hv * 4 + e2] = pk2(y[e] * rstd * gn_g[ch] * (g0 * sigm(g0)), y[e + 1] * rstd * gn_g[ch + 1] * (g1 * sigm(g1))); } }
        u32x4* dst = (u32x4*)(MIXB + ((size_t)b * SEQ + pos) * 1024 + 768 + h * 64 + c16);
        dst[0] = (u32x4){ow[0], ow[1], ow[2], ow[3]}; dst[1] = (u32x4){ow[4], ow[5], ow[6], ow[7]};
    }
    __syncthreads();
}
__device__ __forceinline__ void ret_level1(int task, unsigned char* __restrict__ cw) {
    const int tid = ltid(), lane = tid & 63, wid = __builtin_amdgcn_readfirstlane(tid >> 6), wq = wid & 3;
    const int h = (task >> 5) & 3; const float lg = __builtin_amdgcn_logf(1.0f - __builtin_amdgcn_exp2f(-5.0f - (float)h)); const float g64 = __builtin_amdgcn_exp2f(lg * 64.0f);
    const bf16_t* kvg = (const bf16_t*)(cw + O_KV) + ((size_t)(task >> 5) * 256 + (size_t)(task & 31) * 8) * 4096;
    f32x16 kv[8];
#pragma unroll
    for (int j = 0; j < 8; ++j) kv[j] = frag_load_bf(kvg + (size_t)j * 4096, wq, lane);
    f32x16 acc = kv[0];
#pragma unroll
    for (int j = 1; j < 8; ++j)
#pragma unroll
        for (int g = 0; g < 16; ++g) acc[g] = acc[g] * g64 + kv[j][g];
    frag_store((float*)(cw + O_KG) + (size_t)task * 4096, wq, lane, acc);
}
__device__ __forceinline__ void ret_scan_groups(int chain, unsigned char* __restrict__ cw) {
    const int tid = ltid(), lane = tid & 63, wid = __builtin_amdgcn_readfirstlane(tid >> 6), wq = wid & 3;
    const int h = chain & 3; const float lg = __builtin_amdgcn_logf(1.0f - __builtin_amdgcn_exp2f(-5.0f - (float)h)); const float g512 = __builtin_amdgcn_exp2f(lg * 512.0f);
    const float* kgg = (const float*)(cw + O_KG) + (size_t)chain * 32 * 4096; float* rgg = (float*)(cw + O_RG) + (size_t)chain * 32 * 4096;
    f32x16 R = f32x16{}; f32x16 nx[4];
#pragma unroll
    for (int k = 0; k < 4; ++k) nx[k] = frag_load(kgg + (size_t)k * 4096, wq, lane);
    for (int c = 0; c < 32; c += 4) {
#pragma unroll
        for (int k = 0; k < 4; ++k) { const int cc = c + k; frag_store(rgg + (size_t)cc * 4096, wq, lane, R);
            const f32x16 kvc = nx[k]; const int nn = cc + 4 < 32 ? cc + 4 : 31; nx[k] = frag_load(kgg + (size_t)nn * 4096, wq, lane);
#pragma unroll
            for (int g = 0; g < 16; ++g) R[g] = R[g] * g512 + kvc[g]; }
    }
}
constexpr int L_RET3G = 5 * B9 + 64 * SF * 4;
__device__ __forceinline__ void ret_stage3g(CK_LAS unsigned char* ldsq, int task, const bf16_t* __restrict__ Pb, int PW, int C_TQ, int C_TK, int C_TV, int C_TG, int SEQ, const float* __restrict__ ROPE,
                                           const float* __restrict__ gn_g, const unsigned char* __restrict__ cw, bf16_t* __restrict__ MIXB) {
    const int tid = ltid(), lane = tid & 63, wid = __builtin_amdgcn_readfirstlane(tid >> 6), wq = wid & 3, I = wq >> 1, J = wq & 1, r = lane & 31, hh = lane >> 5, qtid = tid & 255;
    const lbf Qr = (lbf)ldsq, Kr = (lbf)(ldsq + B9), VT = (lbf)(ldsq + 2 * B9), Sb = (lbf)(ldsq + 3 * B9), RTL = (lbf)(ldsq + 4 * B9); const lf32 Y = (lf32)(ldsq + 5 * B9);
    const int tk = task >= 0 ? task : 0; const int item0 = (tk >> 5) * 256 + (tk & 31) * 8;
    f32x16 R = frag_load((const float*)(cw + O_RG) + (size_t)tk * 4096, wq, lane);
    for (int j = 0; j < 8; ++j) { const int item = task >= 0 ? item0 + j : -1;
    const int b = item >= 0 ? item >> 10 : 0, h = item >= 0 ? (item >> 8) & 3 : 0, c = item >= 0 ? item & 255 : 0; const int t = qtid >> 2, c16 = (qtid & 3) * 16; const int pos = c * 64 + t;
    const float lg = __builtin_amdgcn_logf(1.0f - __builtin_amdgcn_exp2f(-5.0f - (float)h));
    const bf16_t* prow = Pb + ((size_t)b * SEQ + pos) * PW;
    if (item >= 0) {
#pragma unroll
        for (int g_ = 0; g_ < 16; ++g_) RTL[(32 * I + crow(g_, hh)) * SB + 32 * J + r] = (bf16_t)f2bf(R[g_]);
        float qr[16], kr[16]; rot16(qr, prow, C_TQ + h * 64, c16, ROPE + (size_t)pos * 64); rot16(kr, prow, C_TK + h * 64, c16, ROPE + (size_t)pos * 64);
        u32x4 w;
        w.x = pk2(qr[0], qr[1]); w.y = pk2(qr[2], qr[3]); w.z = pk2(qr[4], qr[5]); w.w = pk2(qr[6], qr[7]); *(CK_LAS u32x4*)(Qr + t * SB + c16) = w;
        w.x = pk2(qr[8], qr[9]); w.y = pk2(qr[10], qr[11]); w.z = pk2(qr[12], qr[13]); w.w = pk2(qr[14], qr[15]); *(CK_LAS u32x4*)(Qr + t * SB + c16 + 8) = w;
#pragma unroll
        for (int e = 0; e < 16; ++e) kr[e] *= 0.125f;
        w.x = pk2(kr[0], kr[1]); w.y = pk2(kr[2], kr[3]); w.z = pk2(kr[4], kr[5]); w.w = pk2(kr[6], kr[7]); *(CK_LAS u32x4*)(Kr + t * SB + c16) = w;
        w.x = pk2(kr[8], kr[9]); w.y = pk2(kr[10], kr[11]); w.z = pk2(kr[12], kr[13]); w.w = pk2(kr[14], kr[15]); *(CK_LAS u32x4*)(Kr + t * SB + c16 + 8) = w;
        const u32x4* vp = (const u32x4*)(prow + C_TV + h * 64 + c16);
#pragma unroll
        for (int hv = 0; hv < 2; ++hv) { const u32x4 vw = vp[hv];
#pragma unroll
            for (int e2 = 0; e2 < 4; ++e2) { const int e = hv * 8 + 2 * e2; VT[(c16 + e) * SB + t] = (bf16_t)(vw[e2] & 0xffffu); VT[(c16 + e + 1) * SB + t] = (bf16_t)(vw[e2] >> 16); } }
    }
    __syncthreads();
    if (item >= 0) {
        f32x16 st = mm_lds(Kr, Qr, I, J, lane, f32x16{}); const int tt = 32 * J + r;
#pragma unroll
        for (int g = 0; g < 16; ++g) { const int ii = 32 * I + crow(g, hh); st[g] = (ii <= tt) ? st[g] * __builtin_amdgcn_exp2f(lg * (float)(tt - ii)) : 0.f; }
        tile_store_T(Sb, I, J, lane, st);
    }
    __syncthreads();
    if (item >= 0) {
        const f32x16 yi = mm_lds(VT, Sb, I, J, lane, f32x16{}); const f32x16 yc = mm_lds(RTL, Qr, I, J, lane, f32x16{});
        const int tt = 32 * J + r; const float qd = __builtin_amdgcn_exp2f(lg * (float)(tt + 1));
#pragma unroll
        for (int g = 0; g < 16; ++g) Y[tt * SF + 32 * I + crow(g, hh)] = yi[g] + qd * yc[g];
    }
    __syncthreads();
    if (item >= 0) {
        float y[16]; float s = 0.f;
#pragma unroll
        for (int e = 0; e < 16; ++e) { y[e] = Y[t * SF + c16 + e]; s += y[e]; }
        const float mu = quad_sum(s) * (1.f / 64.f); float s2 = 0.f;
#pragma unroll
        for (int e = 0; e < 16; ++e) { y[e] -= mu; s2 += y[e] * y[e]; }
        const float rstd = 1.0f / sqrtf(quad_sum(s2) * (1.f / 64.f) + 1e-6f);
        const u32x4* gp = (const u32x4*)(prow + C_TG + h * 64 + c16); unsigned ow[8];
#pragma unroll
        for (int hv = 0; hv < 2; ++hv) { const u32x4 gw = gp[hv];
#pragma unroll
            for (int e2 = 0; e2 < 4; ++e2) { const int e = hv * 8 + 2 * e2; const int ch = h * 64 + c16 + e; const float g0 = bflo(gw[e2]), g1 = bfhi(gw[e2]);
                ow[hv * 4 + e2] = pk2(y[e] * rstd * gn_g[ch] * (g0 * sigm(g0)), y[e + 1] * rstd * gn_g[ch + 1] * (g1 * sigm(g1))); } }
        u32x4* dst = (u32x4*)(MIXB + ((size_t)b * SEQ + pos) * 1024 + 768 + h * 64 + c16);
        dst[0] = (u32x4){ow[0], ow[1], ow[2], ow[3]}; dst[1] = (u32x4){ow[4], ow[5], ow[6], ow[7]};
    }
    if (item >= 0) { const f32x16 kvc = frag_load_bf((const bf16_t*)(cw + O_KV) + (size_t)item * 4096, wq, lane); const float g64 = __builtin_amdgcn_exp2f(lg * 64.0f);
#pragma unroll
        for (int g_ = 0; g_ < 16; ++g_) R[g_] = R[g_] * g64 + kvc[g_]; }
    __syncthreads();
    }
}
}

__device__ __forceinline__ void tr_tile(const float* __restrict__ src, size_t ld_src, bf16* __restrict__ dst, size_t ld_dst, float* scr, int lane) {
    pg8::f32x4 v[16];
#pragma unroll
    for (int i = 0; i < 16; ++i) v[i] = *(const pg8::f32x4*)(src + (size_t)(i * 4 + (lane >> 4)) * ld_src + (lane & 15) * 4);
#pragma unroll
    for (int i = 0; i < 16; ++i) { float* p = scr + (i * 4 + (lane >> 4)) * 65 + (lane & 15) * 4; p[0] = v[i][0]; p[1] = v[i][1]; p[2] = v[i][2]; p[3] = v[i][3]; }
    asm volatile("s_waitcnt lgkmcnt(0)" ::: "memory");
#pragma unroll
    for (int i = 0; i < 8; ++i) { const int n = i * 8 + (lane >> 3), kc = (lane & 7) * 8; const float* s = scr + kc * 65 + n;
        pg8::u32x4 o; o.x = pk2(s[0], s[65]); o.y = pk2(s[2 * 65], s[3 * 65]); o.z = pk2(s[4 * 65], s[5 * 65]); o.w = pk2(s[6 * 65], s[7 * 65]);
        *(pg8::u32x4*)(dst + (size_t)n * ld_dst + kc) = o; }
    asm volatile("s_waitcnt lgkmcnt(0)" ::: "memory");
}

constexpr int CV_13 = NE * 16 * 16, CV_2 = NE * 8 * 16, CV_L = CV_13 + CV_2, NCONV = DEPTH * CV_L;
__device__ __forceinline__ void conv_item(int it, const float* __restrict__ w1, const float* __restrict__ w3, const float* __restrict__ w2, bf16* __restrict__ W13, bf16* __restrict__ W2, float* scr, int lane) {
    const int l = it / CV_L; int r = it % CV_L;
    if (r < CV_13) { const int e = r >> 8, kb = (r >> 4) & 15, nb = r & 15;
        const int pn = nb >> 2, q = nb & 3; const float* srcw = (q < 2 ? w1 : w3) + ((size_t)l * NE + e) * DM * DE;
        tr_tile(srcw + (size_t)kb * 64 * DE + pn * 128 + (q & 1) * 64, DE, W13 + ((size_t)l * NE + e) * DM * DM + (size_t)nb * 64 * DM + kb * 64, DM, scr, lane); }
    else { r -= CV_13; const int e = r >> 7, kb = (r >> 4) & 7, nb = r & 15;
        tr_tile(w2 + ((size_t)l * NE + e) * DE * DM + (size_t)kb * 64 * DM + nb * 64, DM, W2 + ((size_t)l * NE + e) * DM * DE + (size_t)nb * 64 * DE + kb * 64, DE, scr, lane); }
}

#define LAS __attribute__((address_space(3)))
#define XB_TMO      128
#define XB_XCNT(j)  (256  + 64 * (j))
#define XB_XSUB(j)  (1280 + 64 * (j))
#define XB_XGEN(j)  (2304 + 64 * (j))
#define XB_TOP      3328
#define XB_TOPGEN   3392
#define XCD_BAR_WORDS 3456
#define XB_SPIN_CAP (1u << 18)

__device__ __forceinline__ unsigned xb_ld(unsigned* p)              { return __hip_atomic_load(p, __ATOMIC_RELAXED, __HIP_MEMORY_SCOPE_AGENT); }
__device__ __forceinline__ unsigned xb_add(unsigned* p, unsigned v) { return __hip_atomic_fetch_add(p, v, __ATOMIC_RELAXED, __HIP_MEMORY_SCOPE_AGENT); }
__device__ __forceinline__ unsigned xb_xcc_id() { return (unsigned)__builtin_amdgcn_s_getreg((3 << 11) | 20) & 0xFu; }
#define XB_SPIN(cond, bar) do { unsigned _sp = 0; while (cond) { __builtin_amdgcn_s_sleep(1); \
    if ((++_sp & 255u) == 0u) { if (xb_ld(&(bar)[XB_TMO])) break; if (_sp > XB_SPIN_CAP) { atomicAdd(&(bar)[XB_TMO], 1u); break; } } } } while (0)

struct XcdBarrier {
    unsigned* bar; unsigned x;
    volatile LAS unsigned* st;
};

__device__ __forceinline__ XcdBarrier xcd_barrier_post(unsigned* bar, volatile LAS unsigned* st) {
    XcdBarrier b; b.bar = bar; b.x = xb_xcc_id(); b.st = st;
    if (ltid() == 0) (void)xb_add(&bar[XB_XCNT(b.x)], 1u);
    return b;
}
__device__ __forceinline__ void xcd_barrier_complete(unsigned* bar, unsigned x, unsigned& nloc, unsigned& nx) {
    const unsigned G = gridDim.x * gridDim.y * gridDim.z;
    unsigned sum, cnt, mine, sp = 0u;
    for (;;) {
        sum = 0u; cnt = 0u; mine = 0u;
#pragma unroll
        for (unsigned j = 0; j < 16; ++j) { const unsigned c = xb_ld(&bar[XB_XCNT(j)]); sum += c; cnt += (c > 0u) ? 1u : 0u; mine = (j == x) ? c : mine; }
        if (sum == G) break;
        __builtin_amdgcn_s_sleep(1);
        if ((++sp & 255u) == 0u) { if (xb_ld(&bar[XB_TMO])) break; if (sp > XB_SPIN_CAP) { atomicAdd(&bar[XB_TMO], 1u); break; } }
    }
    nloc = mine > 0u ? mine : 1u; nx = cnt > 0u ? cnt : 1u;
}

__device__ __forceinline__ void xcd_barrier(const XcdBarrier& b) {
    asm volatile("s_waitcnt vmcnt(0)" ::: "memory");
    __syncthreads();
    if (ltid() == 0) {
        unsigned* bar = b.bar; asm volatile("" : "+s"(bar)); unsigned bx_ = b.x; asm volatile("" : "+s"(bx_));
        __builtin_amdgcn_s_waitcnt(0);
        unsigned nloc = b.st[0], nx = b.st[1];
        if (nloc == 0u) { xcd_barrier_complete(bar, bx_, nloc, nx); b.st[0] = nloc; b.st[1] = nx; }
        const unsigned old = xb_add(&bar[XB_XSUB(bx_)], 1u);
        const unsigned gen = old / nloc;
        if (old + 1u == (gen + 1u) * nloc) {
            __builtin_amdgcn_fence(__ATOMIC_RELEASE, "agent");
            asm volatile("s_waitcnt vmcnt(0)" ::: "memory");
            const unsigned og = xb_add(&bar[XB_TOP], 1u);
            const unsigned tg = og / nx;
            if (og + 1u == (tg + 1u) * nx) xb_add(&bar[XB_TOPGEN], 1u);
            else XB_SPIN(xb_ld(&bar[XB_TOPGEN]) == tg, bar);
            __builtin_amdgcn_fence(__ATOMIC_ACQUIRE, "agent");
            xb_add(&bar[XB_XGEN(bx_)], 1u);
            asm volatile("s_waitcnt vmcnt(0)" ::: "memory");
        } else {
            XB_SPIN(xb_ld(&bar[XB_XGEN(bx_)]) == gen, bar);
            __builtin_amdgcn_fence(__ATOMIC_ACQUIRE, "agent");
            asm volatile("s_waitcnt vmcnt(0)" ::: "memory");
        }
    }
    __syncthreads();
}


__global__ void __launch_bounds__(NTHREADS, 2) mk_fwd(Args args) {
    extern __shared__ __attribute__((aligned(16))) unsigned char lds_raw[];
    float* lds = (float*)lds_raw;
    const int tid = ltid(), lane = tid & 63, wid = __builtin_amdgcn_readfirstlane(tid >> 6);
    const int G = gridDim.x, bx = blockIdx.x;
    unsigned char* ws = args.ws;
    unsigned* ctl = (unsigned*)(ws + WS_CTL);
    float* X = args.out;
    bf16* XB = (bf16*)(ws + WS_XB);
    bf16* Pb = (bf16*)(ws + WS_P);
    bf16* WIN = (bf16*)(ws + WS_WIN); bf16* WOUT = (bf16*)(ws + WS_WOUT); bf16* W13 = (bf16*)(ws + WS_W13); bf16* W2 = (bf16*)(ws + WS_W2);
    float* ROPE = (float*)(ws + WS_ROPE);
    double* LCS = (double*)(ws + WS_LCS); double* TOT = (double*)(ws + WS_TOT);
    float* BE = (float*)(ws + WS_SKIP); float* QN2 = BE + 16 * 256; float* KN2 = QN2 + 16 * 128;
    unsigned char* KA = ws + WS_KA;
    unsigned char* cw = ws + WS_CK; bf16* LWT = (bf16*)(ws + WS_LW);
    int* EP = (int*)(ws + WS_EP);
    float* GATE = (float*)(ws + WS_GATE);
    bf16* MIXB = (bf16*)(ws + WS_MIXB);
    int* LIST = (int*)(ws + WS_XP); bf16* Hb = (bf16*)(ws + WS_H); bf16* YP = (bf16*)(ws + WS_YP); bf16* YO = (bf16*)(ws + WS_YO);
    typedef pg8::f32x4 f32x4;
    volatile LAS unsigned* MISC = (volatile LAS unsigned*)((LAS unsigned char*)lds_raw + LDS_MISC);
    for (int u = tid; u < (LDS_ALL - LDS_MISC) / 4; u += NTHREADS) MISC[u] = 0u;
    __syncthreads();
    XcdBarrier bar = xcd_barrier_post(ctl + CW_BAR, MISC + 8);
#define GRID_BAR() xcd_barrier(bar)

    for (int rep_ = 0; rep_ < REP_P0; ++rep_) {
            const int tid = ltid(), lane = tid & 63, wid = __builtin_amdgcn_readfirstlane(tid >> 6); (void)lane; (void)wid;
        const f32x4* xi = (const f32x4*)args.in[0]; uint2* xb = (uint2*)XB;
        for (size_t i = (size_t)bx * NTHREADS + tid; i < (size_t)T * DM / 4; i += (size_t)G * NTHREADS) { const f32x4 v = xi[i]; xb[i] = make_uint2(pk2(v[0], v[1]), pk2(v[2], v[3])); }
        for (int i = bx * NTHREADS + tid; i < SEQ * 32; i += G * NTHREADS) {
            const int pos = i >> 5, f = i & 31;
            const double inv = pow(10000.0, -(double)f / 32.0);
            const double ang = (double)pos * inv;
            ROPE[2 * i] = (float)cos(ang); ROPE[2 * i + 1] = (float)sin(ang);
        }
        { bf16* WR = (bf16*)(ws + WS_WR);
          for (int i = bx * NTHREADS + tid; i < DEPTH * 48 * 1024; i += G * NTHREADS) { const int l_ = i / (48 * 1024), o = (i / 1024) % 48, k = i & 1023;
              const float wv = o < 4 ? args.in[21][((size_t)l_ * DM + k) * 4 + o] : (o < 36 ? args.in[23][((size_t)l_ * DM + k) * 32 + (o - 4)] : 0.f);
              const unsigned hi_ = f2bf(wv); const unsigned lo_ = f2bf(wv - bf2f((unsigned short)hi_));
              WR[((size_t)l_ * 2 + 0) * 48 * 1024 + o * 1024 + k] = (bf16)hi_; WR[((size_t)l_ * 2 + 1) * 48 * 1024 + o * 1024 + k] = (bf16)lo_; } }
        for (int i = bx * NTHREADS + tid; i < DEPTH * 256 * 256; i += G * NTHREADS) {
            const int l = i >> 16, rem = i & 65535, chg = rem >> 8, ii = rem & 255;
            if (ii < 64) LWT[((size_t)l * 256 + chg) * 64 + ii] = (bf16)f2bf(args.in[6][((size_t)l * 64 + ii) * 256 + chg]);
            else if (ii < 128) LWT[(size_t)DEPTH * 256 * 64 + ((size_t)l * 256 + chg) * 64 + (ii - 64)] = (bf16)f2bf(args.in[8][((size_t)l * 64 + (ii - 64)) * 256 + chg]);
            else LWT[(size_t)2 * DEPTH * 256 * 64 + ((size_t)l * 256 + chg) * 128 + (ii - 128)] = (bf16)f2bf(args.in[9][((size_t)l * 128 + (ii - 128)) * 256 + chg]);
        }
        float* scr = lds + wid * (64 * 65);
        constexpr int I_IN = 16 * 56, I_OUT = 16 * 16, I_L = I_IN + I_OUT;
        for (int it = bx * 8 + wid; it < DEPTH * I_L; it += G * 8) {
            const int l = it / I_L; int r = it % I_L;
            if (r < I_IN) { const int kb = r / 56, nb = r % 56; const int nsrc = nb * 64 + (nb >= 24 ? 8 : 0);
                tr_tile(args.in[1] + (size_t)l * DM * INW + (size_t)kb * 64 * INW + nsrc, INW, WIN + (size_t)l * PW * DM + (size_t)nb * 64 * DM + kb * 64, DM, scr, lane); }
            else { r -= I_IN; const int kb = r / 16, nb = r % 16;
                tr_tile(args.in[16] + (size_t)l * DM * DM + (size_t)kb * 64 * DM + nb * 64, DM, WOUT + (size_t)l * DM * DM + (size_t)nb * 64 * DM + kb * 64, DM, scr, lane); }
        }
        __syncthreads();
        {
            const float* wf = args.in[1] + O_FF; const float* fbias = args.in[2];
            float w[8][16];
#pragma unroll
            for (int jq = 0; jq < 4; ++jq)
#pragma unroll
                for (int e = 0; e < 4; ++e)
#pragma unroll
                    for (int h = 0; h < 8; ++h) w[h][jq * 4 + e] = wf[(size_t)(jq * 256 + lane * 4 + e) * INW + h];
            float* ffl = lds;
            for (int ch = bx; ch < T / 128; ch += G) {
                __syncthreads();
                for (int i = 0; i < 16; ++i) { const int tl = wid * 16 + i; const size_t m = (size_t)ch * 128 + tl;
                    float acc[8];
#pragma unroll
                    for (int h = 0; h < 8; ++h) acc[h] = 0.f;
#pragma unroll
                    for (int jq = 0; jq < 4; ++jq) { const f32x4 xv = *(const f32x4*)(args.in[0] + m * DM + jq * 256 + lane * 4);
#pragma unroll
                        for (int e = 0; e < 4; ++e)
#pragma unroll
                            for (int h = 0; h < 8; ++h) acc[h] += xv[e] * w[h][jq * 4 + e]; }
#pragma unroll
                    for (int h = 0; h < 8; ++h) acc[h] = wave_sum(acc[h]);
                    if (lane < 8) { float v = acc[0];
#pragma unroll
                        for (int h = 1; h < 8; ++h) v = (lane == h) ? acc[h] : v;
                        ffl[tl * 8 + lane] = v + fbias[lane]; } }
                __syncthreads();
                {
                    const int h = wid; const int bb = (ch * 128) / SEQ, t0 = (ch * 128) % SEQ; double carry = 0.0;
#pragma unroll
                    for (int half = 0; half < 2; ++half) { double v = (double)logsigmoidf_(ffl[(half * 64 + lane) * 8 + h]);
#pragma unroll
                        for (int o = 1; o < 64; o <<= 1) { const double n = __shfl_up(v, o); if (lane >= o) v += n; }
                        v += carry; LCS[(size_t)(bb * 8 + h) * SEQ + t0 + half * 64 + lane] = v; carry = __shfl(v, 63); }
                    if (lane == 0) TOT[(bb * 8 + h) * 128 + t0 / 128] = carry;
                }
            }
            __syncthreads();
        }
    }
    GRID_BAR();

    for (int l = 0; l < DEPTH; ++l) {
        for (int rep_ = 0; rep_ < REP_A; ++rep_) {
            const int tid = ltid(), lane = tid & 63, wid = __builtin_amdgcn_readfirstlane(tid >> 6); (void)lane; (void)wid;
            pg8::Gemm g{XB, WIN + (size_t)l * PW * DM, T, PW, DM}; pg8::StaticOrder S; S.init(T, PW, G, bx);
            pg8::EpiInProj E{Pb, PW, QC2};
            pg8::gemm_phase<pg8::EpiInProj, pg8::StaticOrder, true, true>((PG8_LAS unsigned char*)lds_raw, g, S, E);
        }
        GRID_BAR();
        for (int rep_ = 0; rep_ < REP_C; ++rep_) {
            const int tid = ltid(), lane = tid & 63, wid = __builtin_amdgcn_readfirstlane(tid >> 6); (void)lane; (void)wid;
            for (int ch = bx; ch < T / 128; ch += G) {
                const int h = wid; const int bb = (ch * 128) / SEQ, t0 = (ch * 128) % SEQ, ci = t0 / 128;
                double pre = 0.0;
                { const double* tp = TOT + (bb * 8 + h) * 128; double a = (lane < ci) ? tp[lane] : 0.0; a += (lane + 64 < ci) ? tp[lane + 64] : 0.0;
#pragma unroll
                  for (int o = 1; o < 64; o <<= 1) a += __shfl_xor(a, o);
                  pre = a; }
#pragma unroll
                for (int half = 0; half < 2; ++half) { const int t = t0 + half * 64 + lane; const double v = pre + LCS[(size_t)(bb * 8 + h) * SEQ + t];
                    const double bd = -v * 1.4426950408889634; const unsigned h_ = f2bf((float)bd); const double r1 = bd - (double)bf2f((unsigned short)h_);
                    const unsigned m_ = f2bf((float)r1); const double r2 = r1 - (double)bf2f((unsigned short)m_); const unsigned l_ = f2bf((float)r2);
                    *(pg8::u32x4*)(KA + ((size_t)(bb * 8 + h) * SEQ + t) * 16) = (pg8::u32x4){h_ | (m_ << 16), l_ | (0x3f80u << 16), 0x3f803f80u, 0u};
                    if (lane == 63) BE[(bb * 8 + h) * 256 + t / 64] = (float)bd; }
                { LAS unsigned* nrm = (LAS unsigned*)lds_raw;
                  __syncthreads();
                  if (tid < 16) nrm[tid] = 0u;
                  __syncthreads();
                  const int tl = tid >> 2, part = tid & 3; const bf16* prow = Pb + ((size_t)ch * 128 + tl) * PW;
#pragma unroll
                  for (int hq = 0; hq < 2; ++hq) { const int hd = part * 2 + hq;
#pragma unroll
                      for (int qk = 0; qk < 2; ++qk) { const pg8::u32x4* vp = (const pg8::u32x4*)(prow + (qk ? C_FK : C_FQ) + hd * 64); float ss = 0.f;
#pragma unroll
                          for (int v8 = 0; v8 < 8; ++v8) { const pg8::u32x4 wv = vp[v8];
#pragma unroll
                              for (int e = 0; e < 4; ++e) { const float lo_ = __builtin_bit_cast(float, wv[e] << 16), hi_ = __builtin_bit_cast(float, wv[e] & 0xffff0000u); ss += lo_ * lo_ + hi_ * hi_; } }
                          atomicMax((unsigned*)(nrm + qk * 8 + hd), __float_as_uint(ss)); } }
                  __syncthreads();
                  if (tid < 16) { const int hd = tid & 7; ((tid < 8) ? QN2 : KN2)[(bb * 8 + hd) * 128 + ci] = __uint_as_float(nrm[tid]); }
                }
            }
            __syncthreads();
            const ck::RwkvParams rp{args.in[3] + l * 768, args.in[4] + l * 256, args.in[5] + l * 256, args.in[7] + l * 256, args.in[10] + l * 256, args.in[11] + l * 256, args.in[12] + l * 256,
                                    args.in[13] + l * 256, args.in[14] + l * 256, args.in[15] + l * 256,
                                    LWT + (size_t)l * 256 * 64, LWT + (size_t)DEPTH * 256 * 64 + (size_t)l * 256 * 64, LWT + (size_t)2 * DEPTH * 256 * 64 + (size_t)l * 256 * 128};
#ifndef REP_S1
#define REP_S1 1
#endif
#ifndef REP_R1
#define REP_R1 1
#endif
            for (int rr_ = 0; rr_ < REP_S1; ++rr_)
            for (int it = bx; it < 2048; it += G) ck::rwkv_stage1((CK_LAS unsigned char*)lds_raw, it, Pb, PW, C_RR, C_RK, C_RV, C_WD, SEQ, rp, cw);
            { const int quad = wid >> 2;
              for (int rr_ = 0; rr_ < REP_R1; ++rr_)
              for (int i0 = bx * 2; i0 < 2048; i0 += G * 2) ck::ret_stage1((CK_LAS unsigned char*)lds_raw + quad * 2 * ck::B9, i0 + quad, Pb, PW, C_TK, C_TV, SEQ, ROPE, cw); }
        }
        GRID_BAR();
        {
            const int tid = ltid(), lane = tid & 63, wid = __builtin_amdgcn_readfirstlane(tid >> 6); (void)lane; (void)wid;
            const int quad = wid >> 2;
#ifndef REP_S
#define REP_S 1
#endif
            for (int rep_ = 0; rep_ < REP_S; ++rep_) {
            if (bx < 128) {
                ck::rwkv_level1((CK_LAS unsigned char*)lds_raw, 2 * bx + quad, cw);
                asm volatile("s_waitcnt vmcnt(0)" ::: "memory"); __syncthreads();
                if (tid == 0) { __builtin_amdgcn_fence(__ATOMIC_RELEASE, "agent"); asm volatile("s_waitcnt vmcnt(0)" ::: "memory");
                                __hip_atomic_fetch_add(ctl + CW_L1 + 64 * (16 * l + (bx >> 4)), 2u, __ATOMIC_RELAXED, __HIP_MEMORY_SCOPE_AGENT); }
            }
            if (bx >= 128) {
                ck::ret_level1(2 * (bx - 128) + quad, cw);
                asm volatile("s_waitcnt vmcnt(0)" ::: "memory"); __syncthreads();
                if (tid == 0) { __builtin_amdgcn_fence(__ATOMIC_RELEASE, "agent"); asm volatile("s_waitcnt vmcnt(0)" ::: "memory");
                                __hip_atomic_fetch_add(ctl + CW_L1 + 64 * (16 * l + 8 + ((bx - 128) >> 4)), 2u, __ATOMIC_RELAXED, __HIP_MEMORY_SCOPE_AGENT); }
            }
            if (bx < 8) {
                if (wid == 0) { unsigned spins = 0;
                    while (__hip_atomic_load(ctl + CW_L1 + 64 * (16 * l + bx), __ATOMIC_RELAXED, __HIP_MEMORY_SCOPE_AGENT) < 32u) { if (++spins > (1u << 22)) break; __builtin_amdgcn_s_sleep(2); }
                    __builtin_amdgcn_fence(__ATOMIC_ACQUIRE, "agent"); asm volatile("s_waitcnt vmcnt(0)" ::: "memory"); }
                __syncthreads();
                ck::rwkv_scan<32>((CK_LAS unsigned char*)lds_raw, quad == 0 ? bx : -1, (const ck::bf16_t*)(cw + ck::O_PG), (const ck::bf16_t*)(cw + ck::O_QG), (ck::bf16_t*)(cw + ck::O_HG));
            }
            else if (bx < 16) {
                if (wid == 0) { unsigned spins = 0;
                    while (__hip_atomic_load(ctl + CW_L1 + 64 * (16 * l + bx), __ATOMIC_RELAXED, __HIP_MEMORY_SCOPE_AGENT) < 32u) { if (++spins > (1u << 22)) break; __builtin_amdgcn_s_sleep(2); }
                    __builtin_amdgcn_fence(__ATOMIC_ACQUIRE, "agent"); asm volatile("s_waitcnt vmcnt(0)" ::: "memory"); }
                __syncthreads();
                if (quad == 0) ck::ret_scan_groups(bx - 8, cw);
            }
            if (bx < 16) {
                asm volatile("s_waitcnt vmcnt(0)" ::: "memory"); __syncthreads();
                if (tid == 0) { __builtin_amdgcn_fence(__ATOMIC_RELEASE, "agent"); asm volatile("s_waitcnt vmcnt(0)" ::: "memory");
                                __hip_atomic_store(ctl + CW_SF + 64 * (16 * l + bx), 1u, __ATOMIC_RELAXED, __HIP_MEMORY_SCOPE_AGENT); }
            }
            }
            __syncthreads();
            const attn_body::AttnTensors AT{(const attn_body::bf16*)(Pb + C_FQ), (const attn_body::bf16*)(Pb + C_FK), (const attn_body::bf16*)(Pb + C_FV), (attn_body::bf16*)MIXB, KA};
            bool cvdone = false;
#ifndef REP_D
#define REP_D 1
#endif
            for (int apass = 0; apass < 2; ++apass) {
            if (apass == 1) {
            __syncthreads();
            if (wid == 0) {
                unsigned spins = 0;
                for (;;) { const unsigned f = lane < 16 ? __hip_atomic_load(ctl + CW_SF + 64 * (16 * l + lane), __ATOMIC_RELAXED, __HIP_MEMORY_SCOPE_AGENT) : 1u;
                    if (__all(f != 0u)) break; if (++spins > (1u << 22)) break; __builtin_amdgcn_s_sleep(2); }
                __builtin_amdgcn_fence(__ATOMIC_ACQUIRE, "agent"); asm volatile("s_waitcnt vmcnt(0)" ::: "memory");
            }
            __syncthreads();
            const ck::RwkvParams rp{args.in[3] + l * 768, args.in[4] + l * 256, args.in[5] + l * 256, args.in[7] + l * 256, args.in[10] + l * 256, args.in[11] + l * 256, args.in[12] + l * 256,
                                    args.in[13] + l * 256, args.in[14] + l * 256, args.in[15] + l * 256, nullptr, nullptr, nullptr};
            for (;;) {
                if (tid == 0) MISC[16] = atomicAdd(ctl + CW_EQ + 64 * l, 1u);
                __syncthreads();
                const int p = (int)MISC[16];
                __syncthreads();
                if (p >= 128 + 128) break;
                if (p < 128) ck::rwkv_stage3g((CK_LAS unsigned char*)lds_raw + quad * ck::L_RW3, 2 * p + quad, rp, cw, MIXB, SEQ);
                else ck::ret_stage3g((CK_LAS unsigned char*)lds_raw + quad * ck::L_RET3G, 2 * (p - 128) + quad, Pb, PW, C_TQ, C_TK, C_TV, C_TG, SEQ, ROPE, args.in[15] + l * 256, cw, MIXB);
            }
            __syncthreads();
            }
            for (int rd_ = 0; rd_ < REP_D; ++rd_)
            for (int gtry = 0; gtry < 8; ++gtry) {
                int grp = (bx + gtry) & 7;
                if (apass == 0) { if (gtry >= 4) continue; const int k_ = bx & 7, g0 = (k_ & 4) ? 7 : 3, g2 = (k_ & 2) ? 6 : 2; grp = gtry == 0 ? g0 : gtry == 1 ? (g0 ^ 4) : gtry == 2 ? g2 : (g2 ^ 4); }
                else if ((grp & 3) >= 2) continue;
                unsigned* qh = ctl + (rd_ ? 20480 : CW_Q) + 64 * (8 * l + grp);
                for (;;) {
                    if (tid == 0) MISC[16] = atomicAdd(qh, 1u);
                    __syncthreads();
                    const unsigned idx = MISC[16];
                    if (idx >= 128u) { __syncthreads(); break; }
                    const int qb = 63 - (int)(idx >> 1), bh = 2 * grp + (int)(idx & 1);
                    if (wid == 0) {
                        const float qn2 = fmaxf(QN2[bh * 128 + 2 * qb], QN2[bh * 128 + 2 * qb + 1]);
                        float kn2 = fmaxf(lane <= 2 * qb + 1 ? KN2[bh * 128 + lane] : 0.f, lane + 64 <= 2 * qb + 1 ? KN2[bh * 128 + 64 + lane] : 0.f);
#pragma unroll
                        for (int o = 1; o < 64; o <<= 1) kn2 = fmaxf(kn2, __shfl_xor(kn2, o));
                        const float bound = 2.002f * sqrtf(qn2 * kn2) + 40.0f; const int ntq = 4 * qb;
                        const float bref = ntq > 0 ? BE[bh * 256 + ntq - 1] : 0.f;
                        int nsk = 0;
#pragma unroll
                        for (int q4 = 0; q4 < 4; ++q4) { const int tt = q4 * 64 + lane; const bool sk = tt < ntq && (bref - BE[bh * 256 + tt]) > bound; nsk += __popcll(__ballot(sk)); }
                        if (lane == 0) MISC[17] = (unsigned)(nsk & ~1);
                    }
                    __syncthreads();
                    const int t0 = (int)MISC[17];
                    attn_body::attn_unit<8>(bh / attn_body::NHEAD, bh % attn_body::NHEAD, qb, t0, AT.Q, AT.K, AT.V, AT.O, AT.KA, (char*)lds_raw);
                    if (!cvdone) {
                        if (tid == 0) MISC[18] = atomicAdd(ctl + CW_CV, 16u);
                        __syncthreads();
                        const int tk = (int)MISC[18];
                        if (tk >= NCONV) cvdone = true;
                        else { const int t2 = ltid(), lane2 = t2 & 63, wid2 = __builtin_amdgcn_readfirstlane(t2 >> 6);
                            float* scr = lds + wid2 * (64 * 65);
                            _Pragma("clang loop unroll(disable)") for (int q2 = 0; q2 < 2; ++q2) { const int itc = tk + 8 * q2 + wid2; if (itc < NCONV) conv_item(itc, args.in[25], args.in[26], args.in[27], W13, W2, scr, lane2); } }
                        __syncthreads();
                    }
                }
            }
            }
        }
        GRID_BAR();
        for (int rep_ = 0; rep_ < REP_F; ++rep_) {
            const int tid = ltid(), lane = tid & 63, wid = __builtin_amdgcn_readfirstlane(tid >> 6); (void)lane; (void)wid;
            pg8::Gemm g{MIXB, WOUT + (size_t)l * DM * DM, T, DM, DM}; pg8::StaticOrder S; S.init(T, DM, G, bx);
            pg8::EpiInProj E{YO, DM, 1.0f};
            pg8::gemm_phase<pg8::EpiInProj, pg8::StaticOrder, true, true>((PG8_LAS unsigned char*)lds_raw, g, S, E);
        }
        GRID_BAR();
        {
            const int tid = ltid(), lane = tid & 63, wid = __builtin_amdgcn_readfirstlane(tid >> 6); (void)lane; (void)wid;
            const float* g1 = args.in[17] + l * DM; const float* b1 = args.in[18] + l * DM;
            const float* bg = args.in[22] + l * 4; const float* be = args.in[24] + l * 32;
            unsigned* cnt = ctl + CW_CNT + 64 * 32 * l;
            const bf16* WRh = (const bf16*)(ws + WS_WR) + (size_t)l * 2 * 48 * 1024; const bf16* WRl = WRh + 48 * 1024;
            constexpr int XS = 1032;
            LAS unsigned short* XT = (LAS unsigned short*)lds_raw;
            LAS float* PART = (LAS float*)((LAS unsigned char*)lds_raw + 32 * XS * 2);
            LAS float* LG = PART + 8 * 32 * 48;
            LAS unsigned* LCNT = (LAS unsigned*)(LG + 128 * 48);
            if (tid < 32) LCNT[tid] = 0u;
            pg8::bf16x8 wh[4][3], wl[4][3];
#pragma unroll
            for (int s_ = 0; s_ < 4; ++s_)
#pragma unroll
                for (int nt = 0; nt < 3; ++nt) { const size_t o = (size_t)(16 * nt + (lane & 15)) * 1024 + 128 * wid + 32 * s_ + 8 * (lane >> 4);
                    wh[s_][nt] = *(const pg8::bf16x8*)(WRh + o); wl[s_][nt] = *(const pg8::bf16x8*)(WRl + o); }
            float gg[16], bb[16];
#pragma unroll
            for (int jq = 0; jq < 4; ++jq) { const f32x4 gv = *(const f32x4*)(g1 + jq * 256 + lane * 4), bv = *(const f32x4*)(b1 + jq * 256 + lane * 4);
#pragma unroll
                for (int e = 0; e < 4; ++e) { gg[jq * 4 + e] = gv[e]; bb[jq * 4 + e] = bv[e]; } }
            for (int ch = bx; ch < T / 128; ch += G) {
                for (int blk = 0; blk < 4; ++blk) {
                    const size_t m0 = (size_t)ch * 128 + blk * 32;
                    uint2 xw[4][4], yw[4][4];
#pragma unroll
                    for (int i = 0; i < 4; ++i) { const size_t m = m0 + wid * 4 + i;
#pragma unroll
                        for (int jq = 0; jq < 4; ++jq) { xw[i][jq] = *(const uint2*)(XB + m * DM + jq * 256 + lane * 4); yw[i][jq] = *(const uint2*)(YO + m * DM + jq * 256 + lane * 4); } }
#pragma unroll
                    for (int i = 0; i < 4; ++i) { const int tl = wid * 4 + i; const size_t m = m0 + tl;
                        float v[16]; float sm = 0.f;
#pragma unroll
                        for (int jq = 0; jq < 4; ++jq) { const uint2 a_ = xw[i][jq], c_ = yw[i][jq];
                            const f32x4 xv = (f32x4){__builtin_bit_cast(float, a_.x << 16), __builtin_bit_cast(float, a_.x & 0xffff0000u), __builtin_bit_cast(float, a_.y << 16), __builtin_bit_cast(float, a_.y & 0xffff0000u)};
                            const f32x4 yv = (f32x4){__builtin_bit_cast(float, c_.x << 16), __builtin_bit_cast(float, c_.x & 0xffff0000u), __builtin_bit_cast(float, c_.y << 16), __builtin_bit_cast(float, c_.y & 0xffff0000u)};
#pragma unroll
                            for (int e = 0; e < 4; ++e) { v[jq * 4 + e] = ALPHA * xv[e] + yv[e]; sm += v[jq * 4 + e]; } }
                        const float mean = wave_sum(sm) * (1.f / DM); float s2 = 0.f;
#pragma unroll
                        for (int q = 0; q < 16; ++q) { v[q] -= mean; s2 += v[q] * v[q]; }
                        const float rstd = 1.0f / sqrtf(wave_sum(s2) * (1.f / DM) + LN_EPS);
#pragma unroll
                        for (int jq = 0; jq < 4; ++jq) { unsigned hw[4];
#pragma unroll
                            for (int e = 0; e < 4; ++e) hw[e] = f2bf(v[jq * 4 + e] * rstd * gg[jq * 4 + e] + bb[jq * 4 + e]);
                            const ck::u32x2 pw = (ck::u32x2){hw[0] | (hw[1] << 16), hw[2] | (hw[3] << 16)};
                            *(uint2*)(XB + m * DM + jq * 256 + lane * 4) = make_uint2(pw.x, pw.y);
                            *(LAS ck::u32x2*)(XT + tl * XS + jq * 256 + lane * 4) = pw; }
                    }
                    __syncthreads();
                    {
                        pg8::f32x4 acc[2][3];
#pragma unroll
                        for (int mt = 0; mt < 2; ++mt)
#pragma unroll
                            for (int nt = 0; nt < 3; ++nt) acc[mt][nt] = pg8::f32x4{0.f, 0.f, 0.f, 0.f};
#pragma unroll
                        for (int s_ = 0; s_ < 4; ++s_)
#pragma unroll
                            for (int mt = 0; mt < 2; ++mt) { const pg8::bf16x8 ax = *(const LAS pg8::bf16x8*)(XT + (16 * mt + (lane & 15)) * XS + 128 * wid + 32 * s_ + 8 * (lane >> 4));
#pragma unroll
                                for (int nt = 0; nt < 3; ++nt) { acc[mt][nt] = __builtin_amdgcn_mfma_f32_16x16x32_bf16(ax, wh[s_][nt], acc[mt][nt], 0, 0, 0); acc[mt][nt] = __builtin_amdgcn_mfma_f32_16x16x32_bf16(ax, wl[s_][nt], acc[mt][nt], 0, 0, 0); } }
#pragma unroll
                        for (int mt = 0; mt < 2; ++mt)
#pragma unroll
                            for (int nt = 0; nt < 3; ++nt)
#pragma unroll
                                for (int r_ = 0; r_ < 4; ++r_) PART[(wid * 32 + 16 * mt + 4 * (lane >> 4) + r_) * 48 + 16 * nt + (lane & 15)] = acc[mt][nt][r_];
                    }
                    __syncthreads();
                    for (int p_ = tid; p_ < 32 * 48; p_ += NTHREADS) { float a_ = 0.f;
#pragma unroll
                        for (int w_ = 0; w_ < 8; ++w_) a_ += PART[w_ * 32 * 48 + p_];
                        LG[blk * 32 * 48 + p_] = a_; }
                }
                __syncthreads();
                int ex0 = 0, ex1 = 0; unsigned lp0 = 0, lp1 = 0;
                if (tid < 128) { const LAS float* lg = LG + tid * 48; const size_t m = (size_t)ch * 128 + tid;
                    int grp = 0; float gbest = lg[0] + bg[0];
#pragma unroll
                    for (int o = 1; o < 4; ++o) { const float gv = lg[o] + bg[o]; if (gv > gbest) { gbest = gv; grp = o; } }
                    float den = 0.f;
#pragma unroll
                    for (int o = 0; o < 4; ++o) den += expf(lg[o] + bg[o] - gbest);
                    const float ggate = 1.0f / den;
                    int i0 = 0; float v0 = lg[4 + grp * 8] + be[grp * 8];
                    for (int o = 1; o < 8; ++o) { const float ev = lg[4 + grp * 8 + o] + be[grp * 8 + o]; if (ev > v0) { v0 = ev; i0 = o; } }
                    int i1 = -1; float v1 = -INFINITY;
                    for (int o = 0; o < 8; ++o) { const float ev = lg[4 + grp * 8 + o] + be[grp * 8 + o]; if (o != i0 && (i1 < 0 || ev > v1)) { v1 = ev; i1 = o; } }
                    const float e1 = expf(v1 - v0); const float p0 = 1.0f / (1.0f + e1), p1 = e1 / (1.0f + e1);
                    ex0 = grp * 8 + i0; ex1 = grp * 8 + i1;
                    lp0 = atomicAdd((unsigned*)(LCNT + ex0), 1u); lp1 = atomicAdd((unsigned*)(LCNT + ex1), 1u);
                    GATE[2 * m] = ggate * p0; GATE[2 * m + 1] = ggate * p1;
                }
                __syncthreads();
                if (tid < 32) { const unsigned c_ = LCNT[tid]; LCNT[32 + tid] = c_ ? atomicAdd(cnt + 64 * tid, c_) : 0u; }
                __syncthreads();
                if (tid < 128) { const size_t m = (size_t)ch * 128 + tid; const int q0 = (int)(LCNT[32 + ex0] + lp0), q1 = (int)(LCNT[32 + ex1] + lp1); EP[2 * m] = (ex0 << 16) | q0; EP[2 * m + 1] = (ex1 << 16) | q1;
                                 LIST[ex0 * LCAP + q0] = (int)m; LIST[ex1 * LCAP + q1] = (int)m; }
                __syncthreads();
                if (tid < 32) LCNT[tid] = 0u;
            }
            {
                __syncthreads();
                const int endl = (l + 1) * CV_L;
                for (;;) { if (tid == 0) MISC[18] = atomicAdd(ctl + CW_CV, 8u);
                    __syncthreads();
                    const int tk = (int)MISC[18];
                    if (tk + wid < NCONV) conv_item(tk + wid, args.in[25], args.in[26], args.in[27], W13, W2, lds + wid * (64 * 65), lane);
                    __syncthreads();
                    if (tk + 8 >= endl) break; }
            }
        }
        GRID_BAR();
        for (int rep_ = 0; rep_ < REP_IJ; ++rep_) {
            const int tid = ltid(), lane = tid & 63, wid = __builtin_amdgcn_readfirstlane(tid >> 6); (void)lane; (void)wid;
            unsigned* cnt = ctl + CW_CNT + 64 * 32 * l;
            PG8_LAS int* tile_e = (PG8_LAS int*)((PG8_LAS unsigned char*)lds_raw + 131072); PG8_LAS int* tst = tile_e + MAXTILES;
            __syncthreads();
            if (tid == 0) { int acc = 0; for (int e = 0; e < NE; ++e) { tst[e] = acc; acc += ((int)cnt[64 * e] + 255) >> 8; } tst[NE] = acc; }
            __syncthreads();
            const int ntile = tst[NE];
            if (tid < ntile) { int e = 0; while (tst[e + 1] <= tid) ++e; tile_e[tid] = e; }
            __syncthreads();
            pg8::MoeOrder S{ntile, G, bx, tile_e};
            PG8_LAS unsigned* rowoff = (PG8_LAS unsigned*)((PG8_LAS unsigned char*)lds_raw + 133120);
            for (int i = 0; i < 5; ++i) { const int L = i * G + bx; if (L >= ntile * 4) break;
                const int rt = L >> 2, e = tile_e[rt], p_ = (rt - tst[e]) * 256 + (tid & 255);
                if (tid < 256) rowoff[i * 256 + tid] = (p_ < (int)cnt[64 * e]) ? (unsigned)LIST[e * LCAP + p_] * (unsigned)(DM * 2) : 0u; }
            __syncthreads();
            { pg8::Gemm g{XB, W13 + (size_t)l * NE * DM * DM, ntile * 256, DM, DM}; pg8::EpiSwiGlu E{Hb, DE};
              pg8::gemm_phase<pg8::EpiSwiGlu, pg8::MoeOrder, true, true, true>((PG8_LAS unsigned char*)lds_raw, g, S, E, rowoff); }
            GRID_BAR();
            { pg8::Gemm g{Hb, W2 + (size_t)l * NE * DM * DE, ntile * 256, DM, DE}; pg8::EpiInProj E{YP, DM, 1.0f};
              pg8::gemm_phase<pg8::EpiInProj, pg8::MoeOrder, true, true>((PG8_LAS unsigned char*)lds_raw, g, S, E); }
        }
        GRID_BAR();
        for (int rep_ = 0; rep_ < REP_K; ++rep_) { float* Xo = (rep_ == REP_K - 1) ? X : (float*)(ws + WS_XP); bf16* XBo = (rep_ == REP_K - 1) ? XB : (bf16*)(ws + WS_H);
            const int tid = ltid(), lane = tid & 63, wid = __builtin_amdgcn_readfirstlane(tid >> 6); (void)lane; (void)wid;
            const float* g2 = args.in[19] + l * DM; const float* b2 = args.in[20] + l * DM;
            const bool doff = (l + 1 < DEPTH); const int ln = doff ? l + 1 : l;
            const float* wf = args.in[1] + (size_t)ln * DM * INW + O_FF; const float* fbias = args.in[2] + ln * 8;
            LAS f32x4* W4 = (LAS f32x4*)((LAS unsigned char*)lds_raw + 4096);
            __syncthreads();
            for (int q = tid; q < 40 * 64; q += NTHREADS) { const int row = q >> 6, ln_ = q & 63; f32x4 val;
                if (row < 32) { const int h = row >> 2, jq = row & 3;
#pragma unroll
                    for (int e = 0; e < 4; ++e) val[e] = wf[(size_t)(jq * 256 + ln_ * 4 + e) * INW + h]; }
                else if (row < 36) val = *(const f32x4*)(g2 + (row - 32) * 256 + ln_ * 4);
                else val = *(const f32x4*)(b2 + (row - 36) * 256 + ln_ * 4);
                W4[q] = val; }
            float* ffl = lds;
            LAS int* poffK = (LAS int*)((LAS unsigned char*)lds_raw + 49152);
            if (tid == 0) { const unsigned* cnt = ctl + CW_CNT + 64 * 32 * l; int acc = 0; for (int e = 0; e < NE; ++e) { poffK[e] = acc; acc += (((int)cnt[64 * e] + 255) >> 8) << 8; } }
            for (int ch = bx; ch < T / 128; ch += G) {
                __syncthreads();
                const size_t mw = (size_t)ch * 128 + wid * 16;
                const int eA = lane < 16 ? EP[2 * (mw + lane)] : 0, eB = lane < 16 ? EP[2 * (mw + lane) + 1] : 0; const int dA = poffK[eA >> 16] + (eA & 0xffff), dB = poffK[eB >> 16] + (eB & 0xffff);
                const float gA = lane < 16 ? GATE[2 * (mw + lane)] : 0.f, gB = lane < 16 ? GATE[2 * (mw + lane) + 1] : 0.f;
                f32x4 xA[2][4], xB[2][4]; uint2 aA[2][4], aB[2][4], bA[2][4], bB[2][4]; float gA2[2][2], gB2[2][2];
#define K_LOAD(XS, WAS, WBS, GS, IEXP) _Pragma("unroll")                     for (int u = 0; u < 2; ++u) { const size_t m = mw + IEXP + u;                         const size_t da = (size_t)__builtin_amdgcn_readlane(dA, IEXP + u), db = (size_t)__builtin_amdgcn_readlane(dB, IEXP + u);                         GS[u][0] = __builtin_bit_cast(float, __builtin_amdgcn_readlane(__builtin_bit_cast(int, gA), IEXP + u)); GS[u][1] = __builtin_bit_cast(float, __builtin_amdgcn_readlane(__builtin_bit_cast(int, gB), IEXP + u)); _Pragma("unroll")                         for (int jq = 0; jq < 4; ++jq) { { const uint2 xw_ = *(const uint2*)(XB + m * DM + jq * 256 + lane * 4); XS[u][jq] = (f32x4){__builtin_bit_cast(float, xw_.x << 16), __builtin_bit_cast(float, xw_.x & 0xffff0000u), __builtin_bit_cast(float, xw_.y << 16), __builtin_bit_cast(float, xw_.y & 0xffff0000u)}; }                             WAS[u][jq] = *(const uint2*)(YP + da * DM + jq * 256 + lane * 4); WBS[u][jq] = *(const uint2*)(YP + db * DM + jq * 256 + lane * 4); } }
                { const int i = 0; K_LOAD(xA, aA, bA, gA2, i); }
                for (int i = 0; i < 16; i += 4) {
                    { const int i1 = i + 2; K_LOAD(xB, aB, bB, gB2, i1); }
#pragma unroll
                    for (int u = 0; u < 2; ++u) { const int tl = wid * 16 + i + u; const size_t m = mw + i + u; const float ga = gA2[u][0], gb = gA2[u][1];
                    float v[16]; float s_ = 0.f;
#pragma unroll
                    for (int jq = 0; jq < 4; ++jq) { const uint2 w0 = aA[u][jq], w1 = bA[u][jq];
                        const f32x4 ya = (f32x4){__builtin_bit_cast(float, w0.x << 16), __builtin_bit_cast(float, w0.x & 0xffff0000u), __builtin_bit_cast(float, w0.y << 16), __builtin_bit_cast(float, w0.y & 0xffff0000u)};
                        const f32x4 yb = (f32x4){__builtin_bit_cast(float, w1.x << 16), __builtin_bit_cast(float, w1.x & 0xffff0000u), __builtin_bit_cast(float, w1.y << 16), __builtin_bit_cast(float, w1.y & 0xffff0000u)};
#pragma unroll
                        for (int e = 0; e < 4; ++e) { v[jq * 4 + e] = ALPHA * xA[u][jq][e] + (ga * ya[e] + gb * yb[e]); s_ += v[jq * 4 + e]; } }
                    const float mean = wave_sum(s_) * (1.f / DM); float s2 = 0.f;
#pragma unroll
                    for (int q = 0; q < 16; ++q) { v[q] -= mean; s2 += v[q] * v[q]; }
                    const float rstd = 1.0f / sqrtf(wave_sum(s2) * (1.f / DM) + LN_EPS);
                    float acc[8];
#pragma unroll
                    for (int h = 0; h < 8; ++h) acc[h] = 0.f;
#pragma unroll
                    for (int jq = 0; jq < 4; ++jq) { f32x4 ov;
                        const f32x4 gv = W4[(32 + jq) * 64 + lane], bv = W4[(36 + jq) * 64 + lane];
#pragma unroll
                        for (int e = 0; e < 4; ++e) ov[e] = v[jq * 4 + e] * rstd * gv[e] + bv[e];
                        if (doff) {
#pragma unroll
                            for (int h = 0; h < 8; ++h) { const f32x4 wv = W4[(h * 4 + jq) * 64 + lane]; acc[h] += (ov[0] * wv[0] + ov[1] * wv[1]) + (ov[2] * wv[2] + ov[3] * wv[3]); } }
                        if (!doff) *(f32x4*)(Xo + m * DM + jq * 256 + lane * 4) = ov;
                        *(uint2*)(XBo + m * DM + jq * 256 + lane * 4) = make_uint2(pk2(ov[0], ov[1]), pk2(ov[2], ov[3])); }
                    if (doff) {
#pragma unroll
                        for (int h = 0; h < 8; ++h) acc[h] = wave_sum(acc[h]);
                        if (lane < 8) { float fv = acc[0];
#pragma unroll
                            for (int h = 1; h < 8; ++h) fv = (lane == h) ? acc[h] : fv;
                            ffl[tl * 8 + lane] = fv + fbias[lane]; } }
                    }

                    if (i + 4 < 16) { const int i2 = i + 4; K_LOAD(xA, aA, bA, gA2, i2); }
#pragma unroll
                    for (int u = 0; u < 2; ++u) { const int tl = wid * 16 + (i + 2) + u; const size_t m = mw + (i + 2) + u; const float ga = gB2[u][0], gb = gB2[u][1];
                    float v[16]; float s_ = 0.f;
#pragma unroll
                    for (int jq = 0; jq < 4; ++jq) { const uint2 w0 = aB[u][jq], w1 = bB[u][jq];
                        const f32x4 ya = (f32x4){__builtin_bit_cast(float, w0.x << 16), __builtin_bit_cast(float, w0.x & 0xffff0000u), __builtin_bit_cast(float, w0.y << 16), __builtin_bit_cast(float, w0.y & 0xffff0000u)};
                        const f32x4 yb = (f32x4){__builtin_bit_cast(float, w1.x << 16), __builtin_bit_cast(float, w1.x & 0xffff0000u), __builtin_bit_cast(float, w1.y << 16), __builtin_bit_cast(float, w1.y & 0xffff0000u)};
#pragma unroll
                        for (int e = 0; e < 4; ++e) { v[jq * 4 + e] = ALPHA * xB[u][jq][e] + (ga * ya[e] + gb * yb[e]); s_ += v[jq * 4 + e]; } }
                    const float mean = wave_sum(s_) * (1.f / DM); float s2 = 0.f;
#pragma unroll
                    for (int q = 0; q < 16; ++q) { v[q] -= mean; s2 += v[q] * v[q]; }
                    const float rstd = 1.0f / sqrtf(wave_sum(s2) * (1.f / DM) + LN_EPS);
                    float acc[8];
#pragma unroll
                    for (int h = 0; h < 8; ++h) acc[h] = 0.f;
#pragma unroll
                    for (int jq = 0; jq < 4; ++jq) { f32x4 ov;
                        const f32x4 gv = W4[(32 + jq) * 64 + lane], bv = W4[(36 + jq) * 64 + lane];
#pragma unroll
                        for (int e = 0; e < 4; ++e) ov[e] = v[jq * 4 + e] * rstd * gv[e] + bv[e];
                        if (doff) {
#pragma unroll
                            for (int h = 0; h < 8; ++h) { const f32x4 wv = W4[(h * 4 + jq) * 64 + lane]; acc[h] += (ov[0] * wv[0] + ov[1] * wv[1]) + (ov[2] * wv[2] + ov[3] * wv[3]); } }
                        if (!doff) *(f32x4*)(Xo + m * DM + jq * 256 + lane * 4) = ov;
                        *(uint2*)(XBo + m * DM + jq * 256 + lane * 4) = make_uint2(pk2(ov[0], ov[1]), pk2(ov[2], ov[3])); }
                    if (doff) {
#pragma unroll
                        for (int h = 0; h < 8; ++h) acc[h] = wave_sum(acc[h]);
                        if (lane < 8) { float fv = acc[0];
#pragma unroll
                            for (int h = 1; h < 8; ++h) fv = (lane == h) ? acc[h] : fv;
                            ffl[tl * 8 + lane] = fv + fbias[lane]; } }
                    }

                }
#undef K_LOAD
                __syncthreads();
                if (doff) {
                    const int h = wid; const int bb = (ch * 128) / SEQ, t0 = (ch * 128) % SEQ; double carry = 0.0;
#pragma unroll
                    for (int half = 0; half < 2; ++half) { double vv = (double)logsigmoidf_(ffl[(half * 64 + lane) * 8 + h]);
#pragma unroll
                        for (int o = 1; o < 64; o <<= 1) { const double n = __shfl_up(vv, o); if (lane >= o) vv += n; }
                        vv += carry; LCS[(size_t)(bb * 8 + h) * SEQ + t0 + half * 64 + lane] = vv; carry = __shfl(vv, 63); }
                    if (lane == 0) TOT[(bb * 8 + h) * 128 + t0 / 128] = carry;
                }
            }
        }
        if (l + 1 < DEPTH) GRID_BAR();
    }
}

extern "C" void kernel_launch(void* const* d_in, const int* in_sizes, int n_in, void* d_out, int out_size, void* d_ws, size_t ws_size, hipStream_t stream) {
    static int grid = 0;
    if (grid == 0) {
        if (n_in != 28 || out_size != T * DM || ws_size < WS_END) { fprintf(stderr, "kernel_launch: unexpected shapes (n_in %d out %d ws %zu)\n", n_in, out_size, ws_size); grid = -1; return; }
        int dev = 0, cus = 0, per_cu = 0;
        (void)hipGetDevice(&dev); (void)hipDeviceGetAttribute(&cus, hipDeviceAttributeMultiprocessorCount, dev);
        (void)hipFuncSetAttribute((const void*)mk_fwd, hipFuncAttributeMaxDynamicSharedMemorySize, LDS_ALL);
        if (hipOccupancyMaxActiveBlocksPerMultiprocessor(&per_cu, (const void*)mk_fwd, NTHREADS, LDS_ALL) != hipSuccess || per_cu < 1) fprintf(stderr, "kernel_launch: occupancy query says %d blocks per CU\n", per_cu);
        (void)hipGetLastError();
        grid = cus > 0 ? cus : 256;
        if (grid != 256) fprintf(stderr, "kernel_launch: %d CUs (built for 256)\n", grid);
    }
    if (grid < 0) return;
    (void)hipMemsetAsync((char*)d_ws + WS_CTL, 0, CTL_BYTES, stream);
    Args a{};
    for (int i = 0; i < 28; ++i) a.in[i] = (const float*)d_in[i];
    a.out = (float*)d_out; a.ws = (unsigned char*)d_ws;
    hipLaunchKernelGGL(mk_fwd, dim3(grid), dim3(NTHREADS), LDS_ALL, stream, a);
}
```

```cpp
#include <hip/hip_runtime.h>
#include <cstdio>
#include <cstdint>
#include <cmath>
__device__ __forceinline__ int ltid() { int t = __builtin_amdgcn_workitem_id_x(); asm volatile("" : "+v"(t)); return t; }

constexpr int BATCH = 2, SEQ = 16384, DM = 1024, DEPTH = 4, T = BATCH * SEQ;
constexpr int INW = 3592, PW = 3584;
constexpr int O_FF = 1536;
constexpr int C_FQ = 0, C_FK = 512, C_FV = 1024, C_RR = 1536, C_RK = 1792, C_RV = 2048, C_WD = 2304, C_AD = 2368, C_GD = 2432,
              C_TQ = 2560, C_TK = 2816, C_TV = 3072, C_TG = 3328;
constexpr int NE = 32, DE = 512, A_TOT = T * 2;
constexpr float ALPHA = 1.681792830507429f;
constexpr float LN_EPS = 1e-5f, RWKV_GN_EPS = 64e-5f, RET_GN_EPS = 1e-6f;
constexpr float QC2 = 0.125f * 1.4426950408889634f;
constexpr int NTHREADS = 512;
#ifndef REP_P0
#define REP_P0 1
#endif
#ifndef REP_A
#define REP_A 1
#endif
#ifndef REP_C
#define REP_C 1
#endif
#ifndef REP_E
#define REP_E 1
#endif
#ifndef REP_F
#define REP_F 1
#endif
#ifndef REP_H
#define REP_H 1
#endif
#ifndef REP_IJ
#define REP_IJ 1
#endif
#ifndef REP_G
#define REP_G 1
#endif
#ifndef REP_K
#define REP_K 1
#endif
constexpr int LDS_MISC = 147456, LDS_ALL = 148480;

constexpr size_t MiB = 1u << 20;
constexpr size_t WS_CTL = 0, CTL_BYTES = 1 * MiB;
constexpr size_t WS_EP = 1 * MiB;
constexpr size_t WS_DEST = 2 * MiB;
constexpr size_t WS_GATE = 9 * MiB;
constexpr size_t WS_ROPE = 11 * MiB;
constexpr size_t WS_RKD = 15 * MiB;
constexpr size_t WS_WIN = 16 * MiB;
constexpr size_t WS_WOUT = 44 * MiB;
constexpr size_t WS_W13 = 52 * MiB;
constexpr size_t WS_W2 = 308 * MiB;
constexpr size_t WS_XB = 436 * MiB;
constexpr size_t WS_P = 500 * MiB;
constexpr size_t WS_MIXB = 724 * MiB;
constexpr size_t WS_CK = 788 * MiB;
constexpr size_t WS_LW = 3 * MiB;
constexpr size_t WS_YO = 788 * MiB;
constexpr size_t WS_XP = 500 * MiB;
constexpr int LCAP = 32768;
constexpr size_t WS_H = 644 * MiB;
constexpr size_t WS_YP = 716 * MiB;
constexpr size_t WS_LCS = 1012 * MiB;
constexpr size_t WS_KA = 1014 * MiB;
constexpr size_t WS_END = 1018 * MiB;
constexpr size_t WS_WR = 5 * MiB;
constexpr size_t WS_SKIP = 4 * MiB + 65536;
constexpr size_t WS_TOT = 4 * MiB;
constexpr int CW_CNT = 32768;
constexpr int CW_Q = 2048;
constexpr int CW_L1 = 20480;
constexpr int CW_SF = 12288;
constexpr int CW_EQ = 4096;
constexpr int CW_CV = 6144;
constexpr int CW_BAR = 8192;
constexpr int MAXTILES = 288;

typedef float f32x16 __attribute__((ext_vector_type(16)));
typedef unsigned short bf16;

struct Args {
    const float* in[28]; float* out; unsigned char* ws;
};

__device__ __forceinline__ float sigmoidf_(float x) { return 1.0f / (1.0f + expf(-x)); }
__device__ __forceinline__ float logsigmoidf_(float x) { return x >= 0.f ? -log1pf(expf(-x)) : x - log1pf(expf(x)); }
__device__ __forceinline__ float wave_sum(float v) {
#define WS_DPP(ctrl, rmask) v += __builtin_bit_cast(float, __builtin_amdgcn_update_dpp(0, __builtin_bit_cast(int, v), ctrl, rmask, 0xf, false))
    WS_DPP(0x111, 0xf); WS_DPP(0x112, 0xf); WS_DPP(0x114, 0xf); WS_DPP(0x118, 0xf); WS_DPP(0x142, 0xa); WS_DPP(0x143, 0xc);
#undef WS_DPP
    return __builtin_bit_cast(float, __builtin_amdgcn_readlane(__builtin_bit_cast(int, v), 63));
}
typedef float f32x2hw __attribute__((ext_vector_type(2))); typedef __bf16 bf16x2hw __attribute__((ext_vector_type(2)));
__device__ __forceinline__ unsigned pk2(float lo, float hi) { f32x2hw v = {lo, hi}; bf16x2hw b = __builtin_convertvector(v, bf16x2hw); return __builtin_bit_cast(unsigned, b); }
__device__ __forceinline__ unsigned f2bf(float f) { return pk2(f, 0.f) & 0xffffu; }
__device__ __forceinline__ float bf2f(unsigned short b) { return __builtin_bit_cast(float, (unsigned)b << 16); }
__device__ __forceinline__ float pf(const bf16* Pb, size_t m, int c) { return bf2f(Pb[m * PW + c]); }

namespace pg8 {
#define PG8_LAS __attribute__((address_space(3)))
typedef unsigned short bf16_t;
typedef short bf16x8 __attribute__((ext_vector_type(8)));
typedef float f32x4 __attribute__((ext_vector_type(4)));
typedef unsigned u32x4 __attribute__((ext_vector_type(4)));
constexpr int BM = 256, BK = 64, HALF = 128, HTB = HALF * BK * 2  , STAGE_BYTES = 8 * HTB, NXCD = 8, WGM = 8;

__host__ __device__ __forceinline__ int lds_byte(int r, int c) { const int st = (r >> 4) * 2 + (c >> 5), rr = r & 15, cc = c & 31, ob = rr * 64 + cc * 2; return st * 1024 + (ob ^ (((ob >> 9) & 1) << 5)); }
__host__ __device__ __forceinline__ void stage_rc(int b, int& R, int& C) { const int st = b / 1024, sb = b % 1024, swz = sb ^ (((sb >> 9) & 1) << 5); R = (st >> 1) * 16 + swz / 64; C = (st & 1) * 32 + (swz % 64) / 2; }
__host__ __device__ __forceinline__ int perm32(int rho) { const int n = rho >> 4, i = rho & 15; return 8 * (i >> 2) + 4 * n + (i & 3); }

struct Unit { int pm, pn, pc; };
struct Gemm { const bf16_t* A; const bf16_t* Bt; int M, N, K; };

struct StaticOrder {
    int nM, nN, nwg, G, c;
    __host__ __device__ void init(int M, int N, int G_, int c_) { nM = M / BM; nN = N / BM; nwg = nM * nN; G = G_; c = c_; }
    __host__ __device__ bool next(int i, Unit& u) const {
        const long L = (long)i * G + c; if (L >= nwg) return false;
        int wgid = (int)L; { const int q = nwg / NXCD, r = nwg % NXCD, xcd = wgid % NXCD, off = wgid / NXCD; wgid = (xcd < r ? xcd * (q + 1) : r * (q + 1) + (xcd - r) * q) + off; }
        const int nig = WGM * nN, gid = wgid / nig, fm = gid * WGM, gsz = (nM - fm) < WGM ? (nM - fm) : WGM;
        u.pm = fm + ((wgid % nig) % gsz); u.pn = (wgid % nig) / gsz; u.pc = u.pn; return true;
    }
    __device__ __forceinline__ void a_ready(const Unit&) const {}
    __device__ __forceinline__ void done(const Unit&) const {}
};

__device__ __forceinline__ unsigned cvt_pk_bf16(float lo, float hi) { unsigned r; asm volatile("v_cvt_pk_bf16_f32 %0, %1, %2" : "=v"(r) : "v"(lo), "v"(hi)); return r; }

struct EpiF32 {
    static constexpr bool PERM = false, AFTER_DRAIN = false;
    float* O; int ldc;
    __device__ __forceinline__ void operator()(const f32x4 (&acc)[2][2][4][2], const Unit& u, int wr, int wc, int fr, int fq) const {
        const int row0 = u.pm * BM + wr * 64 + fr; const int col0 = u.pc * BM + wc * 32 + 4 * fq;
#pragma unroll
        for (int ai = 0; ai < 2; ++ai)
#pragma unroll
            for (int m = 0; m < 4; ++m) { float* rowp = O + (size_t)(row0 + ai * HALF + m * 16) * ldc + col0;
#pragma unroll
                for (int bj = 0; bj < 2; ++bj)
#pragma unroll
                    for (int n = 0; n < 2; ++n) *(f32x4*)(rowp + bj * HALF + n * 16) = acc[ai][bj][m][n]; }
    }
};
struct EpiSwiGlu {
    static constexpr bool PERM = true, AFTER_DRAIN = false;
    bf16_t* O; int ldc;
    __device__ __forceinline__ static float silu(float v) { return v * __builtin_amdgcn_rcpf(1.0f + __builtin_amdgcn_exp2f(-1.4426950408889634f * v)); }
    __device__ __forceinline__ void operator()(const f32x4 (&acc)[2][2][4][2], const Unit& u, int wr, int wc, int fr, int fq) const {
        const int row0 = u.pm * BM + wr * 64 + fr; const int col0 = u.pc * HALF + wc * 32 + 8 * fq;
#pragma unroll
        for (int ai = 0; ai < 2; ++ai)
#pragma unroll
            for (int m = 0; m < 4; ++m) { bf16_t* rowp = O + (size_t)(row0 + ai * HALF + m * 16) * ldc + col0;
                f32x4 h0, h1;
#pragma unroll
                for (int e = 0; e < 4; ++e) { h0[e] = silu(acc[ai][0][m][0][e]) * acc[ai][1][m][0][e]; h1[e] = silu(acc[ai][0][m][1][e]) * acc[ai][1][m][1][e]; }
                u32x4 w; w.x = cvt_pk_bf16(h0[0], h0[1]); w.y = cvt_pk_bf16(h0[2], h0[3]); w.z = cvt_pk_bf16(h1[0], h1[1]); w.w = cvt_pk_bf16(h1[2], h1[3]);
                *(u32x4*)rowp = w; }
    }
};
struct MoeOrder {
    int ntile, G, c; const PG8_LAS int* tile_e;
    __device__ __forceinline__ bool next(int i, Unit& u) const { const int L = i * G + c; if (L >= ntile * 4) return false; const int rt = L >> 2, pn = L & 3; u.pm = rt; u.pn = tile_e[rt] * 4 + pn; u.pc = pn; return true; }
    __device__ __forceinline__ void a_ready(const Unit&) const {}
    __device__ __forceinline__ void done(const Unit&) const {}
};
struct EpiInProj {
    static constexpr bool PERM = true, AFTER_DRAIN = false;
    bf16_t* O; int ldc; float qscale;
    __device__ __forceinline__ void operator()(const f32x4 (&acc)[2][2][4][2], const Unit& u, int wr, int wc, int fr, int fq) const {
        const int row0 = u.pm * BM + wr * 64 + fr; const int col0 = u.pc * BM + wc * 32 + 8 * fq;
        const float sc = (u.pc < 2) ? qscale : 1.f;
#pragma unroll
        for (int ai = 0; ai < 2; ++ai)
#pragma unroll
            for (int m = 0; m < 4; ++m) { bf16_t* rowp = O + (size_t)(row0 + ai * HALF + m * 16) * ldc + col0;
#pragma unroll
                for (int bj = 0; bj < 2; ++bj) { const f32x4 v0 = acc[ai][bj][m][0] * sc, v1 = acc[ai][bj][m][1] * sc;
                    u32x4 w; w.x = cvt_pk_bf16(v0[0], v0[1]); w.y = cvt_pk_bf16(v0[2], v0[3]); w.z = cvt_pk_bf16(v1[0], v1[1]); w.w = cvt_pk_bf16(v1[2], v1[3]);
                    *(u32x4*)(rowp + bj * HALF) = w; } }
    }
};
template <class Epi, class Sched, bool ALIGN_EPI = false, bool SP2 = false, bool GATHER = false>
__device__ __forceinline__ void gemm_phase(PG8_LAS unsigned char* lds, const Gemm g, const Sched& S, const Epi& E, const PG8_LAS unsigned* rowoff = nullptr) {
    static_assert(!GATHER || SP2, "GATHER is written for the SP2 loop only");
    const int tid = ltid(), wid = __builtin_amdgcn_readfirstlane(tid >> 6), lane = tid & 63, wr = wid >> 2, wc = wid & 3, fr = lane & 15, fq = lane >> 4;
    const int K = g.K, nt = K / BK;
    unsigned voffA[2], voffB[2];
#pragma unroll
    for (int i = 0; i < 2; ++i) { int R, C; stage_rc(tid * 16 + i * 8192, R, C); const int Rb = Epi::PERM ? ((R & ~31) + perm32(R & 31)) : R;
        voffA[i] = GATHER ? ((unsigned)(R * 4) | ((unsigned)(C * 2) << 16)) : (unsigned)(R * K + C) * 2u; voffB[i] = (unsigned)(Rb * K + C) * 2u; }
    unsigned vc[2][2];
#define PG8_GLOAD(dst, u_) do { _Pragma("unroll") for (int h_ = 0; h_ < 2; ++h_) _Pragma("unroll") for (int i_ = 0; i_ < 2; ++i_) \
        dst[h_][i_] = *(const PG8_LAS unsigned*)((const PG8_LAS unsigned char*)rowoff + (u_) * 1024 + h_ * 512 + (voffA[i_] & 0xffffu)) + (voffA[i_] >> 16); } while (0)
#define PG8_STAGE_A(bufoff, gbase, H, VG) do { if constexpr (GATHER) PG8_STAGE(bufoff, gbase, VG[H]); else PG8_STAGE(bufoff, (gbase) + (H) * hstep, voffA); } while (0)
    const size_t kstep = (size_t)(BK * 2);
    const size_t hstep = (size_t)HALF * K * 2;
    const size_t tstep = 2 * hstep;
    const unsigned ldsw = (unsigned)wid * 1024u;
    const int aoff = lds_byte(wr * 64 + fr, fq * 8), boff = lds_byte(wc * 32 + fr, fq * 8);
#define PG8_SA(b, h) (((b) * 2 + (h)) * HTB)
#define PG8_SB(b, h) ((4 + (b) * 2 + (h)) * HTB)
#define PG8_STAGE(bufoff, gbase, voff) do { _Pragma("unroll") for (int _i = 0; _i < 2; ++_i) \
        __builtin_amdgcn_global_load_lds((const unsigned*)((const char*)(gbase) + (voff)[_i]), (PG8_LAS unsigned*)(lds + (bufoff) + ldsw + _i * 8192), 16, 0, 0); } while (0)
#define PG8_LDA(dst, b, h) do { _Pragma("unroll") for (int m = 0; m < 4; ++m) _Pragma("unroll") for (int k = 0; k < 2; ++k) dst[m][k] = *(const PG8_LAS bf16x8*)(lds + PG8_SA(b, h) + aoff + m * 2048 + k * 1024); } while (0)
#define PG8_LDB(dst, b, h) do { _Pragma("unroll") for (int n = 0; n < 2; ++n) _Pragma("unroll") for (int k = 0; k < 2; ++k) dst[n][k] = *(const PG8_LAS bf16x8*)(lds + PG8_SB(b, h) + boff + n * 2048 + k * 1024); } while (0)
#define PG8_MMA(ai, bj, At, Bt) do { __builtin_amdgcn_s_setprio(1); _Pragma("unroll") for (int m = 0; m < 4; ++m) _Pragma("unroll") for (int n = 0; n < 2; ++n) _Pragma("unroll") for (int k = 0; k < 2; ++k) \
        acc[ai][bj][m][n] = __builtin_amdgcn_mfma_f32_16x16x32_bf16(Bt[n][k], At[m][k], acc[ai][bj][m][n], 0, 0, 0); __builtin_amdgcn_s_setprio(0); } while (0)
#define PG8_WAIT_V(n) asm volatile("s_waitcnt vmcnt(" #n ")" ::: "memory")
#define PG8_WAIT_L(n) asm volatile("s_waitcnt lgkmcnt(" #n ")" ::: "memory")
#define PG8_BAR __builtin_amdgcn_s_barrier()
#define PG8_SCHED __builtin_amdgcn_sched_barrier(0)
    Unit cur, nxt; int ui = 0;
    if (!S.next(0, cur)) return;
    f32x4 acc[2][2][4][2];
#pragma unroll
    for (int a = 0; a < 2; ++a)
#pragma unroll
        for (int b = 0; b < 2; ++b)
#pragma unroll
            for (int m = 0; m < 4; ++m)
#pragma unroll
                for (int n = 0; n < 2; ++n) acc[a][b][m][n] = (f32x4){0.f, 0.f, 0.f, 0.f};
    bf16x8 At[4][2], B0[2][2], B1[2][2];
    const char* cA = (const char*)g.A + (GATHER ? (size_t)0 : (size_t)cur.pm * tstep); const char* cB = (const char*)g.Bt + (size_t)cur.pn * tstep;
    S.a_ready(cur);
    if constexpr (GATHER) PG8_GLOAD(vc, 0);
    if constexpr (SP2) {
        PG8_STAGE(PG8_SB(0, 0), cB, voffB); PG8_STAGE(PG8_SB(0, 1), cB + hstep, voffB); PG8_STAGE_A(PG8_SA(0, 0), cA, 0, vc); PG8_STAGE_A(PG8_SA(0, 1), cA, 1, vc);
        if (wr == 1) PG8_BAR;
        PG8_WAIT_V(2); PG8_BAR;
        PG8_STAGE(PG8_SB(1, 0), cB + kstep, voffB); PG8_STAGE_A(PG8_SA(1, 0), cA + kstep, 0, vc); PG8_STAGE(PG8_SB(1, 1), cB + hstep + kstep, voffB);
        PG8_WAIT_V(6); PG8_BAR;
    } else {
        PG8_STAGE(PG8_SB(0, 0), cB, voffB); PG8_STAGE(PG8_SA(0, 0), cA, voffA); PG8_STAGE(PG8_SB(0, 1), cB + hstep, voffB); PG8_STAGE(PG8_SA(0, 1), cA + hstep, voffA);
        if (wr == 1) PG8_BAR;
        PG8_WAIT_V(4); PG8_BAR;
        PG8_STAGE(PG8_SB(1, 0), cB + kstep, voffB); PG8_STAGE(PG8_SA(1, 0), cA + kstep, voffA); PG8_STAGE(PG8_SB(1, 1), cB + hstep + kstep, voffB);
        PG8_WAIT_V(6); PG8_BAR;
    }
    for (;;) {
        const bool has_next = S.next(ui + 1, nxt);
        const char* nA = (has_next && !GATHER) ? (const char*)g.A + (size_t)nxt.pm * tstep : cA; const char* nB = has_next ? (const char*)g.Bt + (size_t)nxt.pn * tstep : cB;
        for (int t = 0; t < nt; t += 2) {
            const bool last = (t == nt - 2);
            const char* a1 = cA + (size_t)(t + 1) * kstep;
            const char* a2 = last ? nA : cA + (size_t)(t + 2) * kstep; const char* b2 = last ? nB : cB + (size_t)(t + 2) * kstep;
            const char* a3 = a2 + kstep; const char* b3 = b2 + kstep;
            if (last && has_next) S.a_ready(nxt);
            if constexpr (SP2) {
            PG8_LDB(B0, 0, 0); PG8_LDB(B1, 0, 1); PG8_SCHED; PG8_LDA(At, 0, 0); PG8_STAGE_A(PG8_SA(1, 1), a1, 1, vc);
            if constexpr (GATHER) { if (last && has_next) PG8_GLOAD(vc, ui + 1); }
            PG8_WAIT_V(8); PG8_WAIT_L(0); PG8_BAR; PG8_MMA(0, 0, At, B0); PG8_MMA(0, 1, At, B1); PG8_BAR; PG8_SCHED;
            PG8_LDA(At, 0, 1); PG8_STAGE(PG8_SB(0, 0), b2, voffB); PG8_STAGE(PG8_SB(0, 1), b2 + hstep, voffB); PG8_STAGE_A(PG8_SA(0, 0), a2, 0, vc);
            PG8_WAIT_V(8); PG8_WAIT_L(0); PG8_BAR; PG8_MMA(1, 0, At, B0); PG8_MMA(1, 1, At, B1); PG8_BAR; PG8_SCHED;
            PG8_LDB(B0, 1, 0); PG8_LDB(B1, 1, 1); PG8_SCHED; PG8_LDA(At, 1, 0); PG8_STAGE_A(PG8_SA(0, 1), a2, 1, vc);
            PG8_WAIT_V(8); PG8_WAIT_L(0); PG8_BAR; PG8_MMA(0, 0, At, B0); PG8_MMA(0, 1, At, B1); PG8_BAR; PG8_SCHED;
            PG8_LDA(At, 1, 1); PG8_STAGE(PG8_SB(1, 0), b3, voffB); PG8_STAGE(PG8_SB(1, 1), b3 + hstep, voffB); PG8_STAGE_A(PG8_SA(1, 0), a3, 0, vc);
            PG8_WAIT_V(8); PG8_WAIT_L(0); PG8_BAR; PG8_MMA(1, 0, At, B0); PG8_MMA(1, 1, At, B1); PG8_BAR; PG8_SCHED;
            } else {
            PG8_LDB(B0, 0, 0); PG8_SCHED; PG8_LDA(At, 0, 0); PG8_STAGE(PG8_SA(1, 1), a1 + hstep, voffA);
            PG8_WAIT_L(8); PG8_BAR; PG8_WAIT_L(0); PG8_MMA(0, 0, At, B0); PG8_BAR; PG8_SCHED;
            PG8_LDB(B1, 0, 1); PG8_STAGE(PG8_SB(0, 0), b2, voffB);
            PG8_BAR; PG8_WAIT_L(0); PG8_MMA(0, 1, At, B1); PG8_BAR;
            PG8_LDA(At, 0, 1); PG8_STAGE(PG8_SA(0, 0), a2, voffA);
            PG8_BAR; PG8_WAIT_L(0); PG8_MMA(1, 0, At, B0); PG8_BAR; PG8_SCHED;
            PG8_STAGE(PG8_SB(0, 1), b2 + hstep, voffB);
            PG8_WAIT_V(6); PG8_BAR; PG8_MMA(1, 1, At, B1); PG8_BAR;
            PG8_LDB(B0, 1, 0); PG8_SCHED; PG8_LDA(At, 1, 0); PG8_STAGE(PG8_SA(0, 1), a2 + hstep, voffA);
            PG8_WAIT_L(8); PG8_BAR; PG8_WAIT_L(0); PG8_MMA(0, 0, At, B0); PG8_BAR; PG8_SCHED;
            PG8_LDB(B1, 1, 1); PG8_STAGE(PG8_SB(1, 0), b3, voffB);
            PG8_BAR; PG8_WAIT_L(0); PG8_MMA(0, 1, At, B1); PG8_BAR;
            PG8_LDA(At, 1, 1); PG8_STAGE(PG8_SA(1, 0), a3, voffA);
            PG8_BAR; PG8_WAIT_L(0); PG8_MMA(1, 0, At, B0); PG8_BAR; PG8_SCHED;
            PG8_STAGE(PG8_SB(1, 1), b3 + hstep, voffB);
            PG8_WAIT_V(6); PG8_BAR; PG8_MMA(1, 1, At, B1); PG8_BAR;
            }
        }
        if constexpr (ALIGN_EPI) { if (wr == 0) PG8_BAR; }
        if constexpr (!Epi::AFTER_DRAIN) { E(acc, cur, wr, wc, fr, fq); S.done(cur); }
        if (!has_next) break;
#pragma unroll
        for (int a = 0; a < 2; ++a)
#pragma unroll
            for (int b = 0; b < 2; ++b)
#pragma unroll
                for (int m = 0; m < 4; ++m)
#pragma unroll
                    for (int n = 0; n < 2; ++n) acc[a][b][m][n] = (f32x4){0.f, 0.f, 0.f, 0.f};
        cur = nxt; cA = nA; cB = nB; ++ui;
        if constexpr (ALIGN_EPI) { if (wr == 1) PG8_BAR; }
    }
    PG8_WAIT_V(0);
    if constexpr (!ALIGN_EPI) { if (wr == 0) PG8_BAR; }
    PG8_BAR;
    if constexpr (Epi::AFTER_DRAIN) { E.fused(acc, cur, wr, wc, fr, fq, lds, wid, lane); S.done(cur); }
#undef PG8_SA
#undef PG8_SB
#undef PG8_STAGE
#undef PG8_STAGE_A
#undef PG8_GLOAD
#undef PG8_LDA
#undef PG8_LDB
#undef PG8_MMA
#undef PG8_WAIT_V
#undef PG8_WAIT_L
#undef PG8_BAR
#undef PG8_SCHED
}
}

template <class RowMap, class Epi>
__device__ __forceinline__ void gemm_tile_f32(float* lds, const float* __restrict__ A, int lda, RowMap rowmap, int nvalid,
                                              const float* __restrict__ B, int ldb, int col0, int N, int K, Epi epi) {
    float* As = lds;
    float* Bs = lds + 128 * 17;
    const int tid = ltid(), lane = tid & 63, wid = tid >> 6, wm = wid & 3, wn = wid >> 2;
    const int arow = tid >> 2, akq = (tid & 3) * 4;
    const int src = (arow < nvalid) ? rowmap(arow) : -1;
    const float* ap = A + (size_t)(src < 0 ? 0 : src) * lda + akq;
    const int bk = tid >> 5, bn = (tid & 31) * 4;
    const bool bok = (col0 + bn) < N;
    const float* bp = B + (size_t)bk * ldb + col0 + bn;
    f32x16 acc0 = {}, acc1 = {};
    for (int k0 = 0; k0 < K; k0 += 16) {
        pg8::f32x4 av = (pg8::f32x4){0.f, 0.f, 0.f, 0.f}, bv = (pg8::f32x4){0.f, 0.f, 0.f, 0.f};
        if (src >= 0) av = *(const pg8::f32x4*)(ap + k0);
        if (bok) bv = *(const pg8::f32x4*)(bp + (size_t)k0 * ldb);
        __syncthreads();
        As[arow * 17 + akq + 0] = av[0]; As[arow * 17 + akq + 1] = av[1]; As[arow * 17 + akq + 2] = av[2]; As[arow * 17 + akq + 3] = av[3];
        *(pg8::f32x4*)(Bs + bk * 132 + bn) = bv;
        __syncthreads();
#pragma unroll
        for (int kk = 0; kk < 16; kk += 2) {
            const float a = As[(32 * wm + (lane & 31)) * 17 + kk + (lane >> 5)];
            const float b0 = Bs[(kk + (lane >> 5)) * 132 + 64 * wn + (lane & 31)];
            const float b1 = Bs[(kk + (lane >> 5)) * 132 + 64 * wn + 32 + (lane & 31)];
            acc0 = __builtin_amdgcn_mfma_f32_32x32x2f32(a, b0, acc0, 0, 0, 0);
            acc1 = __builtin_amdgcn_mfma_f32_32x32x2f32(a, b1, acc1, 0, 0, 0);
        }
    }
#pragma unroll
    for (int r = 0; r < 16; ++r) {
        const int i = 32 * wm + (r & 3) + 8 * (r >> 2) + 4 * (lane >> 5);
        const int c0 = col0 + 64 * wn + (lane & 31);
        if (i < nvalid) {
            if (c0 < N) epi(i, c0, acc0[r]);
            if (c0 + 32 < N) epi(i, c0 + 32, acc1[r]);
        }
    }
}

#include <hip/hip_bf16.h>
namespace attn_body {
using bf16=__hip_bfloat16;
using bf16x8=__attribute__((ext_vector_type(8)))short;
using s16x4=__attribute__((ext_vector_type(4)))short;
using f32x16=__attribute__((ext_vector_type(16)))float;
using u32x4=__attribute__((ext_vector_type(4)))unsigned;
typedef float f32x4_t __attribute__((ext_vector_type(4)));
constexpr int BATCH=2,NHEAD=8,SEQ=16384,D=64,DM=3584,OP=1024;
constexpr int NW=8,QBLK=32,QB=QBLK*NW,KVBLK=64,NQB=SEQ/QB;
constexpr int ATTN_PITCH=DM, ATTN_UNIT_ROWS=QB;
__device__ __forceinline__ int crow(int r,int hi){return (r&3)+8*(r>>2)+4*hi;}
#define SBAR() __builtin_amdgcn_sched_barrier(0)
__device__ __forceinline__ void cmask(f32x16&p0,f32x16&p1,int jb,int qrel,int hi){
  const float NEG=-INFINITY; int kb=64*jb+4*hi;
  #pragma unroll
  for(int r=0;r<16;++r){int kv=kb+(r&3)+8*(r>>2); if(kv>qrel)p0[r]=NEG; if(kv+32>qrel)p1[r]=NEG;}
}

constexpr int NSLOT=3, SLOTB=8192;
constexpr int LDS_K=0, LDS_V=NSLOT*SLOTB, LDS_WS=2*NSLOT*SLOTB, LDS_OST=LDS_WS+NW*64*4, LDS_BYTES=LDS_OST+NW*4096;
constexpr float C2=0.125f*1.4426950408889634f;
__device__ __forceinline__ void glds16(const void*gsrc,unsigned lds_dst){unsigned keep;
  asm volatile("s_mov_b32 %0, m0\n\ts_mov_b32 m0, %2\n\ts_nop 0\n\tglobal_load_lds_dwordx4 %1, off\n\ts_mov_b32 m0, %0":"=&s"(keep):"v"(gsrc),"s"(lds_dst):"memory");}
__device__ __forceinline__ float max3f(float a,float b,float c){float r;asm("v_max3_f32 %0, %1, %2, %3":"=v"(r):"v"(a),"v"(b),"v"(c));return r;}
__device__ __forceinline__ float max2f(float a,float b){float r;asm("v_max_f32_e32 %0, %1, %2":"=v"(r):"v"(a),"v"(b));return r;}
__device__ __forceinline__ float fadd_s(float a,float b){float r;asm("v_add_f32_e32 %0, %1, %2":"=v"(r):"v"(a),"v"(b));return r;}
__device__ __forceinline__ float fsub_s(float a,float b){float r;asm("v_sub_f32_e32 %0, %1, %2":"=v"(r):"v"(a),"v"(b));return r;}
typedef float f32x2_t __attribute__((ext_vector_type(2))); typedef __bf16 bf16x2_t __attribute__((ext_vector_type(2)));
__device__ __forceinline__ unsigned cvtpk_s(float lo,float hi){f32x2_t v={lo,hi};bf16x2_t b=__builtin_convertvector(v,bf16x2_t);return __builtin_bit_cast(unsigned,b);}
#define WAIT_BAR(N) asm volatile("s_waitcnt vmcnt(" #N ") lgkmcnt(0)\n\ts_barrier":::"memory")

__device__ __forceinline__ void qkt(f32x16&p0,f32x16&p1,const char*Kslot,const bf16x8*qr,int r32,int hi){
  const char*kb=Kslot+hi*1024+r32*16;
  #pragma unroll
  for(int d0=0;d0<4;++d0){
    const bf16x8 b0=*reinterpret_cast<const bf16x8*>(kb+d0*2048);
    const bf16x8 b1=*reinterpret_cast<const bf16x8*>(kb+d0*2048+512);
    p0=__builtin_amdgcn_mfma_f32_32x32x16_bf16(b0,qr[d0],p0,0,0,0);p1=__builtin_amdgcn_mfma_f32_32x32x16_bf16(b1,qr[d0],p1,0,0,0);}
}
typedef __attribute__((address_space(3))) const char* lds_cptr;
typedef short v4i16_t __attribute__((ext_vector_type(4)));
__device__ __forceinline__ void kload8(bf16x8*kf,lds_cptr kp){
  kf[0]=*(const __attribute__((address_space(3))) bf16x8*)(kp);      kf[1]=*(const __attribute__((address_space(3))) bf16x8*)(kp+512);
  kf[2]=*(const __attribute__((address_space(3))) bf16x8*)(kp+2048); kf[3]=*(const __attribute__((address_space(3))) bf16x8*)(kp+2560);
  kf[4]=*(const __attribute__((address_space(3))) bf16x8*)(kp+4096); kf[5]=*(const __attribute__((address_space(3))) bf16x8*)(kp+4608);
  kf[6]=*(const __attribute__((address_space(3))) bf16x8*)(kp+6144); kf[7]=*(const __attribute__((address_space(3))) bf16x8*)(kp+6656);
}
__device__ __forceinline__ void kload2(bf16x8*kf,lds_cptr kp,int j){ kf[2*j]=*(const __attribute__((address_space(3))) bf16x8*)(kp+j*2048); kf[2*j+1]=*(const __attribute__((address_space(3))) bf16x8*)(kp+j*2048+512); }
__device__ __forceinline__ s16x4 vtr(lds_cptr p){ return __builtin_bit_cast(s16x4,__builtin_amdgcn_ds_read_tr16_b64_v4i16((__attribute__((address_space(3))) v4i16_t*)p)); }
__device__ __forceinline__ float rowmax(const f32x16&p0,const f32x16&p1){
  float a=max3f(p0[0],p0[1],p1[0]),b=max3f(p0[2],p0[3],p1[1]);a=max3f(a,p1[2],p1[3]);
  #pragma unroll
  for(int r=4;r<16;r+=4){a=max3f(a,p0[r],p0[r+1]);b=max3f(b,p0[r+2],p0[r+3]);a=max3f(a,p1[r],p1[r+1]);b=max3f(b,p1[r+2],p1[r+3]);}
  const float m=max2f(a,b);
  auto rr=__builtin_amdgcn_permlane32_swap(__float_as_uint(m),__float_as_uint(m),false,false);
  return max2f(__uint_as_float(rr[0]),__uint_as_float(rr[1]));
}
__device__ __forceinline__ void pv(f32x16*o,int vb,bf16x8 pa0,bf16x8 pa1,bf16x8 pa2,bf16x8 pa3){
  #pragma unroll
  for(int d0=0;d0<2;++d0){s16x4 lo[4],hi[4];
    #pragma unroll
    for(int ks=0;ks<4;++ks){
      asm volatile("ds_read_b64_tr_b16 %0,%1 offset:%c2":"=&v"(lo[ks]):"v"(vb),"i"(d0*4096+ks*1024):"memory");
      asm volatile("ds_read_b64_tr_b16 %0,%1 offset:%c2":"=&v"(hi[ks]):"v"(vb),"i"(d0*4096+ks*1024+512):"memory");}
    asm volatile("s_waitcnt lgkmcnt(0)":::"memory");SBAR();
    #define PK(k) (bf16x8){lo[k][0],lo[k][1],lo[k][2],lo[k][3],hi[k][0],hi[k][1],hi[k][2],hi[k][3]}
    o[d0]=__builtin_amdgcn_mfma_f32_32x32x16_bf16(pa0,PK(0),o[d0],0,0,0);
    o[d0]=__builtin_amdgcn_mfma_f32_32x32x16_bf16(pa1,PK(1),o[d0],0,0,0);
    o[d0]=__builtin_amdgcn_mfma_f32_32x32x16_bf16(pa2,PK(2),o[d0],0,0,0);
    o[d0]=__builtin_amdgcn_mfma_f32_32x32x16_bf16(pa3,PK(3),o[d0],0,0,0);
    #undef PK
  }
}

#ifndef ATTN_STORE16
#define ATTN_STORE16(p,v) (*(u32x4*)(p)=(v))
#endif
template<int THRL> __device__ __forceinline__ void attn_unit(int b,int h,int qb,int t0,const bf16*Q,const bf16*__restrict__ K,const bf16*__restrict__ V,bf16*O,const unsigned char*KAg,char*shm){
  const int tid=ltid(),lane=tid&63,r32=lane&31,hi=lane>>5; const int wid=__builtin_amdgcn_readfirstlane(tid>>6);
  const long rowbase=(long)b*SEQ; const int q0=qb*QB;
  const bf16*Qw=Q+(rowbase+q0+wid*QBLK)*DM+h*D;
  const bf16*Kh=K+(rowbase+(long)t0*KVBLK)*DM+h*D,*Vh=V+(rowbase+(long)t0*KVBLK)*DM+h*D;
  const unsigned lds0=(unsigned)(uintptr_t)shm;
  float*wsf=(float*)(shm+LDS_WS)+wid*64;
  const bf16*ksrc=Kh+(long)lane*DM+wid*8;
  const bf16*vsrc=Vh+(long)(16*(wid&3)+(lane>>2))*DM+(wid>>2)*32+(lane&3)*8;
  const unsigned kdst=lds0+LDS_K+wid*1024, vdst=lds0+LDS_V+wid*1024;
  #define DMA_K(t,slot) glds16(ksrc+(long)(t)*KVBLK*DM,(unsigned)__builtin_amdgcn_readfirstlane(kdst+(slot)))
  #define DMA_V(t,slot) glds16(vsrc+(long)(t)*KVBLK*DM,(unsigned)__builtin_amdgcn_readfirstlane(vdst+(slot)))
  const int vb0=(int)(lds0+LDS_V)+((lane>>4)&1)*32+(lane&3)*8+(4*hi+((lane&15)>>2))*64;
  const char*Kbase=shm+LDS_K; bf16x8 kf[8];
  const lds_cptr shm3=(lds_cptr)shm; const lds_cptr kp0=shm3+LDS_K+hi*1024+r32*16; const lds_cptr vp0=shm3+LDS_V+((lane>>4)&1)*32+(lane&3)*8+(4*hi+((lane&15)>>2))*64;
  const int NT=(q0+QB)/KVBLK-t0;
  u32x4 ka0,ka1; u32x4 qaw;
  const unsigned kavoff=(unsigned)r32*16u;
  const unsigned long long kab0=(unsigned long long)(uintptr_t)KAg+((unsigned long long)((b*NHEAD+h)*(long)SEQ+(long)t0*KVBLK))*16ull;
  #define KA_LOAD(t) do{ const unsigned long long a_=kab0+(unsigned long long)(t)*1024ull; const unsigned lo_=__builtin_amdgcn_readfirstlane((unsigned)a_),hi_=__builtin_amdgcn_readfirstlane((unsigned)(a_>>32)); \
    const unsigned long long sb_=((unsigned long long)hi_<<32)|lo_; \
    asm volatile("s_nop 4\n\tglobal_load_dwordx4 %0, %2, %3\n\tglobal_load_dwordx4 %1, %2, %3 offset:512":"=&v"(ka0),"=&v"(ka1):"v"(kavoff),"s"(sb_):"memory"); }while(0)
  #define QA_SET() do{ const float nm_=-mhat; const unsigned h_=cvtpk_s(nm_,0.f)&0xffffu; const float r1_=nm_-__uint_as_float(h_<<16); const unsigned m_=cvtpk_s(r1_,0.f)&0xffffu; \
    const float r2_=r1_-__uint_as_float(m_<<16); const unsigned l_=cvtpk_s(r2_,0.f)&0xffffu; \
    qaw[0]=hi?0u:0x3f803f80u; qaw[1]=hi?0u:(0x3f80u|(h_<<16)); qaw[2]=hi?0u:(m_|(l_<<16)); qaw[3]=0u; asm volatile("":"+v"(qaw)); }while(0)
  #define AUG(C0,C1) do{ C0=__builtin_amdgcn_mfma_f32_32x32x16_bf16(__builtin_bit_cast(bf16x8,ka0),__builtin_bit_cast(bf16x8,qaw),f32x16{},0,0,0); \
    C1=__builtin_amdgcn_mfma_f32_32x32x16_bf16(__builtin_bit_cast(bf16x8,ka1),__builtin_bit_cast(bf16x8,qaw),f32x16{},0,0,0); }while(0)
  #define PIN_KA() asm volatile("; KA landed":"+v"(ka0),"+v"(ka1)::"memory")
  #define WAIT_BAR_KA(N) do{ WAIT_BAR(N); PIN_KA(); }while(0)
  KA_LOAD(0);
  DMA_K(0,0);DMA_V(0,0);DMA_K(1,SLOTB);
  bf16x8 qr[4];
  #pragma unroll
  for(int d0=0;d0<4;++d0)qr[d0]=*reinterpret_cast<const bf16x8*>(&Qw[(long)r32*DM+d0*16+hi*8]);
  float mhat=0.f,l_reg=0.f;f32x16 o[2];o[0]=f32x16{};o[1]=f32x16{}; QA_SET();
  const int qrel=wid*QBLK+r32;
  #define CMASK(P0,P1,t) do{int jb_=(t)-(NT-4); if(jb_>=0)cmask(P0,P1,jb_,qrel,hi);}while(0)
  bool resc=false;
  #define START(P0,P1) do{ const float rm=rowmax(P0,P1); resc=false; \
    { const float dl=rm; mhat=fadd_s(mhat,dl); \
      _Pragma("unroll") for(int r=0;r<16;++r){P0[r]=fsub_s(P0[r],dl);P1[r]=fsub_s(P1[r],dl);} \
      QA_SET(); } \
    _Pragma("unroll") for(int r=0;r<16;++r)P0[r]=__builtin_amdgcn_exp2f(P0[r]); }while(0)
  #define RESC() do{ if(resc){ asm volatile("s_waitcnt lgkmcnt(0)":::"memory"); \
      _Pragma("unroll") for(int d_=0;d_<2;++d_) _Pragma("unroll") for(int r=0;r<16;++r)o[d_][r]*=wsf[crow(r,hi)]; } }while(0)
  f32x16 pA0,pA1,pB0,pB1;
  int sl_prev=0,sl_cur=0,sl_next=SLOTB;
  #define ROT() do{sl_prev=sl_cur;sl_cur=sl_next;sl_next=(sl_next==(NSLOT-1)*SLOTB)?0:sl_next+SLOTB;}while(0)
  DMA_K(2,2*SLOTB);
  WAIT_BAR_KA(3);
  AUG(pA0,pA1); qkt(pA0,pA1,Kbase,qr,r32,hi);asm volatile("s_nop 15\n\ts_nop 7":"+v"(pA0),"+v"(pA1));CMASK(pA0,pA1,0);
  START(pA0,pA1);
  _Pragma("unroll") for(int r=0;r<16;++r)pA1[r]=__builtin_amdgcn_exp2f(pA1[r]);
  WAIT_BAR(0);
  KA_LOAD(1);DMA_K(3,0);DMA_V(1,SLOTB);
  ROT();
  kload8(kf,kp0+sl_cur);
  WAIT_BAR_KA(2);
  s16x4 vlo[8],vhi[8]; u32x4 pw0,pw1,pw2,pw3;
  #define PKW(P,B) cvtpk_s(P[B],P[B+1])
  #define PAF(k) __builtin_bit_cast(bf16x8,pw##k)
  #define VFR(i) (bf16x8){vlo[i][0],vlo[i][1],vlo[i][2],vlo[i][3],vhi[i][0],vhi[i][1],vhi[i][2],vhi[i][3]}
  #define PIN(x) asm volatile("":"+v"(x))
  #define MX3(a,b,c) __builtin_fmaxf(__builtin_fmaxf((a),(b)),(c))
  #define GAPA(MF,A0,A1,A2,A3,W0,W1,PW) do{ MF; sacc+=A0; sacc+=A1; sacc+=A2; sacc+=A3; PIN(sacc); W0; W1; PIN(PW); SBAR(); }while(0)
  #define EX(v) __builtin_amdgcn_exp2f(v)
  #define GAPB(MF,X,B) do{ MF; X[B]=EX(X[B]); X[B+1]=EX(X[B+1]); X[B+2]=EX(X[B+2]); X[B+3]=EX(X[B+3]); PIN(X); SBAR(); }while(0)
  #define VRD(i) do{ vlo[i]=vtr(vp_+(((i)>>2)*4096+((i)&3)*1024)); vhi[i]=vtr(vp_+(((i)>>2)*4096+((i)&3)*1024+512)); }while(0)
  #define KRD(G,j) do{ if(G){ kload2(kf,kp0+sl_next,j); SBAR(); } }while(0)
  #define STEP(C0,C1,P0,P1,t,GK,GV,GL) do{ SBAR(); \
    const lds_cptr vp_=vp0+sl_prev; \
    AUG(C0,C1); SBAR(); \
    VRD(0); SBAR(); float sacc=(P0[0]+P0[1]); \
    GAPA(C0=__builtin_amdgcn_mfma_f32_32x32x16_bf16(kf[0],qr[0],C0,0,0,0), P0[2],P0[3],P0[4],P0[5],     pw0[0]=PKW(P0,0), pw0[1]=PKW(P0,2), pw0); \
    VRD(4); SBAR(); GAPA(C1=__builtin_amdgcn_mfma_f32_32x32x16_bf16(kf[1],qr[0],C1,0,0,0), P0[6],P0[7],P0[8],P0[9],     pw0[2]=PKW(P0,4), pw0[3]=PKW(P0,6), pw0); \
    VRD(1); SBAR(); GAPA(C0=__builtin_amdgcn_mfma_f32_32x32x16_bf16(kf[2],qr[1],C0,0,0,0),   P0[10],P0[11],P0[12],P0[13], pw1[0]=PKW(P0,8), pw1[1]=PKW(P0,10), pw1); \
    VRD(5); SBAR(); GAPA(C1=__builtin_amdgcn_mfma_f32_32x32x16_bf16(kf[3],qr[1],C1,0,0,0),   P0[14],P0[15],P1[0],P1[1],   pw1[2]=PKW(P0,12),pw1[3]=PKW(P0,14), pw1); \
    VRD(2); SBAR(); GAPA(C0=__builtin_amdgcn_mfma_f32_32x32x16_bf16(kf[4],qr[2],C0,0,0,0),   P1[2],P1[3],P1[4],P1[5],     pw2[0]=PKW(P1,0), pw2[1]=PKW(P1,2), pw2); \
    VRD(6); SBAR(); GAPA(C1=__builtin_amdgcn_mfma_f32_32x32x16_bf16(kf[5],qr[2],C1,0,0,0),   P1[6],P1[7],P1[8],P1[9],     pw2[2]=PKW(P1,4), pw2[3]=PKW(P1,6), pw2); \
    VRD(3); SBAR(); GAPA(C0=__builtin_amdgcn_mfma_f32_32x32x16_bf16(kf[6],qr[3],C0,0,0,0),   P1[10],P1[11],P1[12],P1[13], pw3[0]=PKW(P1,8), pw3[1]=PKW(P1,10), pw3); \
    VRD(7); SBAR(); GAPA(C1=__builtin_amdgcn_mfma_f32_32x32x16_bf16(kf[7],qr[3],C1,0,0,0),   P1[14],P1[15],0.f,0.f,       pw3[2]=PKW(P1,12),pw3[3]=PKW(P1,14), pw3); \
    l_reg+=sacc; \
    if(GL){KA_LOAD((t)+1);} if(GK){DMA_K((t)+3,sl_cur);} if(GV){DMA_V((t)+1,sl_next);} \
    CMASK(C0,C1,t); \
    { float a=MX3(C0[0],C0[1],C1[0]),b=MX3(C0[2],C0[3],C1[1]); a=MX3(a,C1[2],C1[3]); \
      _Pragma("unroll") for(int r=4;r<16;r+=4){a=MX3(a,C0[r],C0[r+1]);b=MX3(b,C0[r+2],C0[r+3]);a=MX3(a,C1[r],C1[r+1]);b=MX3(b,C1[r+2],C1[r+3]);} \
      float rm=__builtin_fmaxf(a,b); { auto rr=__builtin_amdgcn_permlane32_swap(__float_as_uint(rm),__float_as_uint(rm),false,false); rm=__builtin_fmaxf(__uint_as_float(rr[0]),__uint_as_float(rr[1])); } \
      resc=false; \
      if(__builtin_expect(__any(rm>(float)THRL),0)){ const float dl=__builtin_fmaxf(rm,0.f); mhat+=dl; \
        _Pragma("unroll") for(int r=0;r<16;++r){C0[r]-=dl;C1[r]-=dl;} \
        QA_SET(); \
        const float f=__builtin_amdgcn_exp2f(-dl); l_reg*=f; if(hi==0)wsf[r32]=f; resc=true; } } \
    SBAR(); \
    GAPB(o[0]=__builtin_amdgcn_mfma_f32_32x32x16_bf16(PAF(0),VFR(0),o[0],0,0,0), C0,0); \
    GAPB(o[1]=__builtin_amdgcn_mfma_f32_32x32x16_bf16(PAF(0),VFR(4),o[1],0,0,0), C0,4); \
    KRD(GL,0); GAPB(o[0]=__builtin_amdgcn_mfma_f32_32x32x16_bf16(PAF(1),VFR(1),o[0],0,0,0), C0,8); \
    KRD(GL,1); GAPB(o[1]=__builtin_amdgcn_mfma_f32_32x32x16_bf16(PAF(1),VFR(5),o[1],0,0,0), C0,12); \
    KRD(GL,2); GAPB(o[0]=__builtin_amdgcn_mfma_f32_32x32x16_bf16(PAF(2),VFR(2),o[0],0,0,0), C1,0); \
    KRD(GL,3); GAPB(o[1]=__builtin_amdgcn_mfma_f32_32x32x16_bf16(PAF(2),VFR(6),o[1],0,0,0), C1,4); \
    GAPB(o[0]=__builtin_amdgcn_mfma_f32_32x32x16_bf16(PAF(3),VFR(3),o[0],0,0,0), C1,8); \
    GAPB(o[1]=__builtin_amdgcn_mfma_f32_32x32x16_bf16(PAF(3),VFR(7),o[1],0,0,0), C1,12); \
    }while(0)
  int t=1;
  #undef CMASK
  #define CMASK(P0,P1,t) do{}while(0)
  for(;t+5<NT;t+=2){
    STEP(pB0,pB1,pA0,pA1,t,true,true,true);     WAIT_BAR_KA(2); RESC(); ROT();
    STEP(pA0,pA1,pB0,pB1,t+1,true,true,true);   WAIT_BAR_KA(2); RESC(); ROT();
  }
  #undef CMASK
  #define CMASK(P0,P1,t) do{int jb_=(t)-(NT-4); if(jb_>=0)cmask(P0,P1,jb_,qrel,hi);}while(0)
  #define ENDW(tt) do{ if((tt)+3<NT){WAIT_BAR(2);} else if((tt)+2<NT){WAIT_BAR(1);} else {WAIT_BAR(0);} PIN_KA(); }while(0)
  for(;t+1<NT;t+=2){
    STEP(pB0,pB1,pA0,pA1,t,(t+3<NT),(t+1<NT),(t+1<NT));       ENDW(t);   RESC(); ROT();
    STEP(pA0,pA1,pB0,pB1,t+1,(t+4<NT),(t+2<NT),(t+2<NT));     ENDW(t+1); RESC(); ROT();
  }
  STEP(pB0,pB1,pA0,pA1,NT-1,false,false,false); RESC();
  { float sacc=pB0[0]+pB0[1]; _Pragma("unroll") for(int r=2;r<16;++r)sacc+=pB0[r]; _Pragma("unroll") for(int r=0;r<16;++r)sacc+=pB1[r]; l_reg+=sacc;
    pw0=(u32x4){PKW(pB0,0),PKW(pB0,2),PKW(pB0,4),PKW(pB0,6)};pw1=(u32x4){PKW(pB0,8),PKW(pB0,10),PKW(pB0,12),PKW(pB0,14)};pw2=(u32x4){PKW(pB1,0),PKW(pB1,2),PKW(pB1,4),PKW(pB1,6)};pw3=(u32x4){PKW(pB1,8),PKW(pB1,10),PKW(pB1,12),PKW(pB1,14)};
    SBAR(); pv(o,vb0+sl_cur,PAF(0),PAF(1),PAF(2),PAF(3)); }
  #undef PKW
  #undef PAF
  #undef VFR
  #undef PIN
  #undef MX3
  #undef GAPA
  #undef GAPB
  #undef EX
  #undef VRD
  #undef KRD
  #undef STEP
  #undef ENDW
  {auto rr=__builtin_amdgcn_permlane32_swap(__float_as_uint(l_reg),__float_as_uint(l_reg),false,false);l_reg=__uint_as_float(rr[0])+__uint_as_float(rr[1]);}
  if(hi==0)wsf[32+r32]=l_reg;asm volatile("s_waitcnt lgkmcnt(0)":::"memory");
  float rli[16];
  #pragma unroll
  for(int r=0;r<16;++r)rli[r]=__builtin_amdgcn_rcpf(wsf[32+crow(r,hi)]);
  bf16*Ow=O+(rowbase+q0+wid*QBLK)*OP+h*D;
  { bf16*stg=(bf16*)(shm+LDS_OST)+wid*2048;
    #pragma unroll
    for(int r=0;r<16;++r){const int orow=crow(r,hi);
      #pragma unroll
      for(int d0=0;d0<2;++d0)stg[orow*64+d0*32+r32]=__float2bfloat16(o[d0][r]*rli[r]);}
    asm volatile("s_waitcnt lgkmcnt(0)":::"memory");
    #pragma unroll
    for(int i=0;i<4;++i){const int row=i*8+(lane>>3),ch=lane&7; const u32x4 v=*(const u32x4*)(stg+row*64+ch*8); ATTN_STORE16(Ow+(long)row*OP+ch*8,v);} }
  asm volatile("s_waitcnt lgkmcnt(0)\n\ts_barrier":::"memory");
  #undef DMA_K
  #undef DMA_V
  #undef KA_LOAD
  #undef QA_SET
  #undef AUG
  #undef WAIT_BAR_KA
  #undef PIN_KA
  #undef CMASK
  #undef START
  #undef RESC
  #undef ROT
}
constexpr int ATTN_LDS_BYTES=LDS_BYTES;
struct AttnTensors { const bf16* Q; const bf16* K; const bf16* V; bf16* O; const unsigned char* KA; };
struct AttnUnit { int bh; int qb; };
struct StaticOrder {
  int vcu;
  __device__ __forceinline__ explicit StaticOrder(int grid,int block):vcu((block%8)*(grid/8)+block/8){}
  __device__ __forceinline__ bool next(int i,AttnUnit&u)const{ if(i>=4)return false; const int s=vcu&15; u.bh=vcu>>4; u.qb=(i==0)?63-s:(i==1)?32+s:(i==2)?31-s:s; return true; }
  __device__ __forceinline__ void a_ready(const AttnUnit&)const{}
  __device__ __forceinline__ void done(const AttnUnit&)const{}
};
template<class Sched,int THRL=8> __device__ __forceinline__ void attn_phase(char*lds,const AttnTensors&T,const Sched&S){
  AttnUnit u;
  for(int i=0;S.next(i,u);++i){ S.a_ready(u); attn_unit<THRL>(u.bh/NHEAD,u.bh%NHEAD,u.qb,0,T.Q,T.K,T.V,T.O,T.KA,lds); S.done(u); }
}
#undef SBAR
#undef WAIT_BAR
}

namespace ck {
#define CK_LAS __attribute__((address_space(3)))
typedef unsigned short bf16_t;
typedef short bf16x8 __attribute__((ext_vector_type(8)));
typedef float f32x16 __attribute__((ext_vector_type(16)));
typedef float f32x4 __attribute__((ext_vector_type(4)));
typedef unsigned u32x4 __attribute__((ext_vector_type(4)));
typedef unsigned u32x2 __attribute__((ext_vector_type(2)));
typedef CK_LAS unsigned short* lbf;
typedef CK_LAS float* lf32;
constexpr int SB = 72;
constexpr int B9 = 64 * SB * 2;
constexpr int SF = 65;
constexpr int SM = 68;
constexpr int SX = 132;
__device__ __forceinline__ unsigned pk2(float lo, float hi) { return ::pk2(lo, hi); }
__device__ __forceinline__ unsigned f2bf(float f) { return ::f2bf(f); }
__device__ __forceinline__ float bflo(unsigned w) { return __builtin_bit_cast(float, w << 16); }
__device__ __forceinline__ float bfhi(unsigned w) { return __builtin_bit_cast(float, w & 0xffff0000u); }
__device__ __forceinline__ int crow(int reg, int hh) { return (reg & 3) + 8 * (reg >> 2) + 4 * hh; }
__device__ __forceinline__ f32x16 mm_lds(lbf A, lbf BT, int I, int J, int lane, f32x16 acc) {
    const int r = lane & 31, hh = lane >> 5;
    const lbf ap = A + (32 * I + r) * SB + 8 * hh; const lbf bp = BT + (32 * J + r) * SB + 8 * hh;
#pragma unroll
    for (int s = 0; s < 4; ++s) { const bf16x8 a = *(const CK_LAS bf16x8*)(ap + 16 * s); const bf16x8 b = *(const CK_LAS bf16x8*)(bp + 16 * s); acc = __builtin_amdgcn_mfma_f32_32x32x16_bf16(a, b, acc, 0, 0, 0); }
    return acc;
}
__device__ __forceinline__ f32x16 mm_gA(const bf16_t* __restrict__ Ag, lbf BT, int I, int J, int lane, f32x16 acc) {
    const int r = lane & 31, hh = lane >> 5;
    bf16x8 a[4];
#pragma unroll
    for (int s = 0; s < 4; ++s) a[s] = *(const bf16x8*)(Ag + (32 * I + r) * 64 + 16 * s + 8 * hh);
    const lbf bp = BT + (32 * J + r) * SB + 8 * hh;
#pragma unroll
    for (int s = 0; s < 4; ++s) { const bf16x8 b = *(const CK_LAS bf16x8*)(bp + 16 * s); acc = __builtin_amdgcn_mfma_f32_32x32x16_bf16(a[s], b, acc, 0, 0, 0); }
    return acc;
}
__device__ __forceinline__ f32x16 mm_gg(const bf16_t* __restrict__ Ag, const bf16_t* __restrict__ BTg, int I, int J, int lane, f32x16 acc) {
    const int r = lane & 31, hh = lane >> 5;
#pragma unroll
    for (int s = 0; s < 4; ++s) { const bf16x8 a = *(const bf16x8*)(Ag + (32 * I + r) * 64 + 16 * s + 8 * hh); const bf16x8 b = *(const bf16x8*)(BTg + (32 * J + r) * 64 + 16 * s + 8 * hh);
        acc = __builtin_amdgcn_mfma_f32_32x32x16_bf16(a, b, acc, 0, 0, 0); }
    return acc;
}
__device__ __forceinline__ f32x16 mm_rA(const bf16x8 (&a)[4], lbf BT, int J, int lane, f32x16 acc) {
    const int r = lane & 31, hh = lane >> 5; const lbf bp = BT + (32 * J + r) * SB + 8 * hh;
#pragma unroll
    for (int s = 0; s < 4; ++s) { const bf16x8 b = *(const CK_LAS bf16x8*)(bp + 16 * s); acc = __builtin_amdgcn_mfma_f32_32x32x16_bf16(a[s], b, acc, 0, 0, 0); }
    return acc;
}
__device__ __forceinline__ void load_gA(bf16x8 (&a)[4], const bf16_t* __restrict__ Ag, int I, int lane) {
    const int r = lane & 31, hh = lane >> 5;
#pragma unroll
    for (int s = 0; s < 4; ++s) a[s] = *(const bf16x8*)(Ag + (32 * I + r) * 64 + 16 * s + 8 * hh);
}
__device__ __forceinline__ f32x16 mm_lA_gB(lbf A, const bf16_t* __restrict__ BTg, int I, int J, int lane, f32x16 acc) {
    const int r = lane & 31, hh = lane >> 5; bf16x8 b[4];
#pragma unroll
    for (int s = 0; s < 4; ++s) b[s] = *(const bf16x8*)(BTg + (32 * J + r) * 64 + 16 * s + 8 * hh);
    const lbf ap = A + (32 * I + r) * SB + 8 * hh;
#pragma unroll
    for (int s = 0; s < 4; ++s) { const bf16x8 a = *(const CK_LAS bf16x8*)(ap + 16 * s); acc = __builtin_amdgcn_mfma_f32_32x32x16_bf16(a, b[s], acc, 0, 0, 0); }
    return acc;
}
__device__ __forceinline__ void frag_store(float* __restrict__ g, int wq, int lane, const f32x16& acc) {
    f32x4* p = (f32x4*)(g + ((size_t)(wq * 64 + lane)) * 16);
    p[0] = (f32x4){acc[0], acc[1], acc[2], acc[3]}; p[1] = (f32x4){acc[4], acc[5], acc[6], acc[7]}; p[2] = (f32x4){acc[8], acc[9], acc[10], acc[11]}; p[3] = (f32x4){acc[12], acc[13], acc[14], acc[15]};
}
__device__ __forceinline__ f32x16 frag_load(const float* __restrict__ g, int wq, int lane) {
    const f32x4* p = (const f32x4*)(g + ((size_t)(wq * 64 + lane)) * 16); const f32x4 a = p[0], b = p[1], c = p[2], d = p[3];
    return (f32x16){a[0], a[1], a[2], a[3], b[0], b[1], b[2], b[3], c[0], c[1], c[2], c[3], d[0], d[1], d[2], d[3]};
}
__device__ __forceinline__ void frag_store_bf(bf16_t* __restrict__ g, int wq, int lane, const f32x16& acc) {
    u32x4* p = (u32x4*)(g + ((size_t)(wq * 64 + lane)) * 16);
    p[0] = (u32x4){pk2(acc[0], acc[1]), pk2(acc[2], acc[3]), pk2(acc[4], acc[5]), pk2(acc[6], acc[7])}; p[1] = (u32x4){pk2(acc[8], acc[9]), pk2(acc[10], acc[11]), pk2(acc[12], acc[13]), pk2(acc[14], acc[15])};
}
__device__ __forceinline__ f32x16 frag_load_bf(const bf16_t* __restrict__ g, int wq, int lane) {
    const u32x4* p = (const u32x4*)(g + ((size_t)(wq * 64 + lane)) * 16); const u32x4 a = p[0], b = p[1];
    return (f32x16){bflo(a[0]), bfhi(a[0]), bflo(a[1]), bfhi(a[1]), bflo(a[2]), bfhi(a[2]), bflo(a[3]), bfhi(a[3]), bflo(b[0]), bfhi(b[0]), bflo(b[1]), bfhi(b[1]), bflo(b[2]), bfhi(b[2]), bflo(b[3]), bfhi(b[3])};
}
__device__ __forceinline__ void tile_store_T(lbf dst, int I, int J, int lane, const f32x16& acc) {
    const int r = lane & 31, hh = lane >> 5;
#pragma unroll
    for (int g = 0; g < 4; ++g) { u32x2 w; w.x = pk2(acc[4 * g], acc[4 * g + 1]); w.y = pk2(acc[4 * g + 2], acc[4 * g + 3]);
        *(CK_LAS u32x2*)(dst + (32 * J + r) * SB + 32 * I + 8 * g + 4 * hh) = w; }
}
__device__ __forceinline__ float fexp(float x) { return __builtin_amdgcn_exp2f(x * 1.4426950408889634f); }
__device__ __forceinline__ float sigm(float x) { return __builtin_amdgcn_rcpf(1.0f + fexp(-x)); }
__device__ __forceinline__ float ftanh(float x) { const float xc = fminf(fmaxf(x, -15.f), 15.f); return 1.0f - 2.0f * __builtin_amdgcn_rcpf(fexp(2.0f * xc) + 1.0f); }
__device__ __forceinline__ float logsig(float x) { const float ax = fabsf(x); return fminf(x, 0.f) - 0.6931471805599453f * __builtin_amdgcn_logf(1.0f + fexp(-ax)); }
template <int CTRL> __device__ __forceinline__ float dpp_f(float v) { return __builtin_bit_cast(float, __builtin_amdgcn_update_dpp(0, __builtin_bit_cast(int, v), CTRL, 0xf, 0xf, false)); }
__device__ __forceinline__ float quad_sum(float v) { v += dpp_f<0xB1>(v); v += dpp_f<0x4E>(v); return v; }

constexpr size_t O_PC = 0, O_QC = 16u << 20, O_GY = 48u << 20, O_YL = 64u << 20, O_VG = 96u << 20, O_GG = 112u << 20, O_H0 = 128u << 20, O_RKD = 144u << 20, O_KV = 145u << 20, O_RT = 177u << 20, O_END = 193u << 20,
                 O_PG = 193u << 20, O_QG = 195u << 20, O_HG = 197u << 20, O_KG = 199u << 20, O_RG = 203u << 20, O_END2 = 207u << 20;
struct RwkvParams {
    const float *mu_rkv, *mu_lora, *w0, *a0, *k_k, *k_a, *r_k, *ln_g, *ln_b, *gn_g;
    const bf16_t *w2t, *a2t, *g2t;
};

constexpr int L_U = 10 * B9, L_MM = L_U + 36864, L_GL = L_MM + 64 * SM * 4, L_END1 = L_GL + 256;
__device__ __forceinline__ void rwkv_stage1(CK_LAS unsigned char* lds, int item, const bf16_t* __restrict__ Pb, int PW, int C_RR, int C_RK, int C_RV, int C_WD, int SEQ, const RwkvParams& p, unsigned char* __restrict__ cw) {
    const int tid = ltid(), lane = tid & 63, wid = __builtin_amdgcn_readfirstlane(tid >> 6), quad = wid >> 2, wq = wid & 3, I = wq >> 1, J = wq & 1, r = lane & 31, hh = lane >> 5;
    const int b = item >> 10, h = (item >> 8) & 3, c = item & 255;
    const size_t m0 = (size_t)b * SEQ + (size_t)c * 64;
    const lbf Am = (lbf)(lds), Bm = (lbf)(lds + B9), Km = (lbf)(lds + 2 * B9), Rm = (lbf)(lds + 3 * B9), VT = (lbf)(lds + 4 * B9), BhT = (lbf)(lds + 5 * B9), KhT = (lbf)(lds + 6 * B9),
              Nm = (lbf)(lds + 7 * B9), Wb = (lbf)(lds + 8 * B9), Wk = (lbf)(lds + 9 * B9);
    const lbf TW = (lbf)(lds + L_U), AD = (lbf)(lds + L_U + B9), SG0 = (lbf)(lds + L_U + 2 * B9), SG1 = (lbf)(lds + L_U + 3 * B9);
    const lbf W2T = BhT, A2T = KhT, G2Ta = Nm, G2Tb = Wb;
    const lf32 X = (lf32)(lds + L_U), MM = (lf32)(lds + L_MM), GL = (lf32)(lds + L_GL);
    const lf32 AA = (lf32)(lds), GGl = (lf32)(lds + 2 * B9);
    const lbf ZlT = Km, X1T = Nm;
    const int t = tid >> 3, c8 = (tid & 7) * 8;
    const size_t m = m0 + t; const bool hp = (c * 64 + t) > 0;
    const bf16_t* pr = Pb + m * PW; const bf16_t* pp = pr - PW;
    float rr[8], kx[8], vv[8];
    {
        const u32x4 z4 = (u32x4){0u, 0u, 0u, 0u};
        const u32x4 cr = *(const u32x4*)(pr + C_RR + h * 64 + c8), ckk = *(const u32x4*)(pr + C_RK + h * 64 + c8), cv = *(const u32x4*)(pr + C_RV + h * 64 + c8);
        const u32x4 qr = hp ? *(const u32x4*)(pp + C_RR + h * 64 + c8) : z4, qk = hp ? *(const u32x4*)(pp + C_RK + h * 64 + c8) : z4, qv = hp ? *(const u32x4*)(pp + C_RV + h * 64 + c8) : z4;
#pragma unroll
        for (int e = 0; e < 8; ++e) { const int ch = h * 64 + c8 + e;
            const float a_ = (e & 1) ? bfhi(cr[e >> 1]) : bflo(cr[e >> 1]), b_ = (e & 1) ? bfhi(qr[e >> 1]) : bflo(qr[e >> 1]); rr[e] = a_ + (b_ - a_) * p.mu_rkv[ch];
            const float c_ = (e & 1) ? bfhi(ckk[e >> 1]) : bflo(ckk[e >> 1]), d_ = (e & 1) ? bfhi(qk[e >> 1]) : bflo(qk[e >> 1]); kx[e] = c_ + (d_ - c_) * p.mu_rkv[256 + ch];
            const float e_ = (e & 1) ? bfhi(cv[e >> 1]) : bflo(cv[e >> 1]), f_ = (e & 1) ? bfhi(qv[e >> 1]) : bflo(qv[e >> 1]); vv[e] = e_ + (f_ - e_) * p.mu_rkv[512 + ch]; }
#pragma unroll
        for (int q = 0; q < 4; ++q) { const u32x4 cl = *(const u32x4*)(pr + C_WD + q * 64 + c8); const u32x4 ql = hp ? *(const u32x4*)(pp + C_WD + q * 64 + c8) : z4;
            float lo[8];
#pragma unroll
            for (int e = 0; e < 8; ++e) { const float a_ = (e & 1) ? bfhi(cl[e >> 1]) : bflo(cl[e >> 1]), b_ = (e & 1) ? bfhi(ql[e >> 1]) : bflo(ql[e >> 1]); const float x = a_ + (b_ - a_) * p.mu_lora[q * 64 + c8 + e];
                lo[e] = (q == 0) ? ftanh(x) : (q == 1 ? x : sigm(x)); }
            u32x4 w; w.x = pk2(lo[0], lo[1]); w.y = pk2(lo[2], lo[3]); w.z = pk2(lo[4], lo[5]); w.w = pk2(lo[6], lo[7]);
            *(CK_LAS u32x4*)((q == 0 ? TW : q == 1 ? AD : q == 2 ? SG0 : SG1) + t * SB + c8) = w; }
        *(CK_LAS u32x4*)(W2T + t * SB + c8) = *(const u32x4*)(p.w2t + ((size_t)h * 64 + t) * 64 + c8);
        *(CK_LAS u32x4*)(A2T + t * SB + c8) = *(const u32x4*)(p.a2t + ((size_t)h * 64 + t) * 64 + c8);
        *(CK_LAS u32x4*)(G2Ta + t * SB + c8) = *(const u32x4*)(p.g2t + ((size_t)h * 64 + t) * 128 + c8);
        *(CK_LAS u32x4*)(G2Tb + t * SB + c8) = *(const u32x4*)(p.g2t + ((size_t)h * 64 + t) * 128 + 64 + c8);
    }
    __syncthreads();
    if (quad == 0) {
        f32x16 z = mm_lds(TW, W2T, I, J, lane, f32x16{}); f32x16 za = mm_lds(AD, A2T, I, J, lane, f32x16{});
        const int ch = 32 * J + r; const float w0c = p.w0[h * 64 + ch], a0c = p.a0[h * 64 + ch];
#pragma unroll
        for (int g = 0; g < 16; ++g) { const int tt = 32 * I + crow(g, hh); const float lw = logsig(w0c + z[g]) - 0.5f; MM[tt * SF + ch] = -fexp(lw); AA[tt * SF + ch] = sigm(a0c + za[g]); }
    } else {
        f32x16 zg = mm_lds(SG0, G2Ta, I, J, lane, f32x16{}); zg = mm_lds(SG1, G2Tb, I, J, lane, zg);
        const int ch = 32 * J + r;
#pragma unroll
        for (int g = 0; g < 16; ++g) { const int tt = 32 * I + crow(g, hh); GGl[tt * SF + ch] = zg[g]; }
    }
    __syncthreads();
    {
        const int ch = tid & 63, seg = tid >> 6; float v8[8]; float run = 0.f;
#pragma unroll
        for (int i = 0; i < 8; ++i) { run += MM[(seg * 8 + i) * SF + ch]; v8[i] = run; }
        const lf32 TOT = (lf32)(lds + L_U);
        TOT[seg * 64 + ch] = run;
        __syncthreads();
        float off = 0.f;
#pragma unroll
        for (int s2 = 0; s2 < 8; ++s2) off += (s2 < seg) ? TOT[s2 * 64 + ch] : 0.f;
#pragma unroll
        for (int i = 0; i < 8; ++i) MM[(seg * 8 + i) * SF + ch] = v8[i] + off;
    }
    __syncthreads();
    float aa[8], gg[8], lw[8], lwp[8], lwl[8];
#pragma unroll
    for (int e = 0; e < 8; ++e) { aa[e] = AA[t * SF + c8 + e]; gg[e] = GGl[t * SF + c8 + e]; lw[e] = MM[t * SF + c8 + e]; lwp[e] = t > 0 ? MM[(t - 1) * SF + c8 + e] : 0.f; lwl[e] = MM[63 * SF + c8 + e]; }
    __syncthreads();
    {
        float kk[8], k2[8]; float ss = 0.f, rk = 0.f;
#pragma unroll
        for (int e = 0; e < 8; ++e) { const int ch = h * 64 + c8 + e; kk[e] = kx[e] * p.k_k[ch]; ss += kk[e] * kk[e]; k2[e] = kx[e] * (1.0f + (aa[e] - 1.0f) * p.k_a[ch]); rk += rr[e] * k2[e] * p.r_k[ch]; }
        ss = quad_sum(ss); ss += dpp_f<0x141>(ss); rk = quad_sum(rk); rk += dpp_f<0x141>(rk);
        const float inv = 1.0f / fmaxf(sqrtf(ss), 1e-12f);
        float am[8], bm[8], km[8], rm[8];
#pragma unroll
        for (int e = 0; e < 8; ++e) { kk[e] *= inv; const float g_ = fexp(lw[e]), gi = fexp(-lw[e]), gp = fexp(lwp[e]), gl = fexp(lwl[e] - lw[e]); const float ka = kk[e] * aa[e];
            am[e] = -kk[e] * gp; bm[e] = ka * gi; km[e] = k2[e] * gi; rm[e] = rr[e] * g_;
            VT[(c8 + e) * SB + t] = (bf16_t)f2bf(vv[e]); BhT[(c8 + e) * SB + t] = (bf16_t)f2bf(ka * gl); KhT[(c8 + e) * SB + t] = (bf16_t)f2bf(k2[e] * gl);
            X[t * SX + c8 + e] = am[e]; }
        u32x4 w;
        w.x = pk2(am[0], am[1]); w.y = pk2(am[2], am[3]); w.z = pk2(am[4], am[5]); w.w = pk2(am[6], am[7]); *(CK_LAS u32x4*)(Am + t * SB + c8) = w;
        w.x = pk2(bm[0], bm[1]); w.y = pk2(bm[2], bm[3]); w.z = pk2(bm[4], bm[5]); w.w = pk2(bm[6], bm[7]); *(CK_LAS u32x4*)(Bm + t * SB + c8) = w;
        w.x = pk2(km[0], km[1]); w.y = pk2(km[2], km[3]); w.z = pk2(km[4], km[5]); w.w = pk2(km[6], km[7]); *(CK_LAS u32x4*)(Km + t * SB + c8) = w;
        w.x = pk2(rm[0], rm[1]); w.y = pk2(rm[2], rm[3]); w.z = pk2(rm[4], rm[5]); w.w = pk2(rm[6], rm[7]); *(CK_LAS u32x4*)(Rm + t * SB + c8) = w;
        if (t == 63) {
#pragma unroll
            for (int e = 0; e < 8; ++e) GL[c8 + e] = fexp(lwl[e]); }
        w.x = pk2(vv[0], vv[1]); w.y = pk2(vv[2], vv[3]); w.z = pk2(vv[4], vv[5]); w.w = pk2(vv[6], vv[7]); *(u32x4*)(cw + O_VG + (size_t)item * 8192 + (t * 64 + c8) * 2) = w;
        w.x = pk2(gg[0], gg[1]); w.y = pk2(gg[2], gg[3]); w.z = pk2(gg[4], gg[5]); w.w = pk2(gg[6], gg[7]); *(u32x4*)(cw + O_GG + (size_t)item * 8192 + (t * 64 + c8) * 2) = w;
        if ((tid & 7) == 0) *(float*)(cw + O_RKD + (size_t)item * 256 + t * 4) = rk;
    }
    __syncthreads();
    {
        const f32x16 p1 = mm_lds(Am, quad == 0 ? Bm : Km, I, J, lane, f32x16{}); const f32x16 p2 = mm_lds(Rm, quad == 0 ? Bm : Km, I, J, lane, f32x16{});
        const int ii = 32 * J + r;
#pragma unroll
        for (int g = 0; g < 16; ++g) { const int tt = 32 * I + crow(g, hh);
            if (quad == 0) { MM[tt * SM + (ii & 3) * 16 + (ii >> 2)] = (ii < tt) ? p1[g] : 0.f; Wb[tt * SB + ii] = (bf16_t)f2bf((ii <= tt) ? p2[g] : 0.f); }
            else { Nm[tt * SB + ii] = (bf16_t)f2bf((ii < tt) ? p1[g] : 0.f); Wk[tt * SB + ii] = (bf16_t)f2bf((ii <= tt) ? p2[g] : 0.f); } }
    }
    __syncthreads();
    if (quad == 0) { const f32x16 nv = mm_lds(Nm, VT, I, J, lane, f32x16{}); const int vcol = 64 + 32 * J + r;
#pragma unroll
        for (int g = 0; g < 16; ++g) X[(32 * I + crow(g, hh)) * SX + vcol] = nv[g]; }
    __syncthreads();
    {
        const int col = tid >> 2, q = tid & 3;
        float xs[16];
#pragma unroll
        for (int k = 0; k < 16; ++k) xs[k] = X[(q + 4 * k) * SX + col];
#pragma unroll
        for (int tt = 1; tt < 64; ++tt) {
            const CK_LAS f32x4* mr = (const CK_LAS f32x4*)(MM + tt * SM + q * 16);
            float s0 = 0.f, s1 = 0.f, s2 = 0.f, s3 = 0.f;
#pragma unroll
            for (int k4 = 0; k4 < (tt + 15) / 16; ++k4) { const f32x4 mv = mr[k4]; s0 += mv[0] * xs[4 * k4]; s1 += mv[1] * xs[4 * k4 + 1]; s2 += mv[2] * xs[4 * k4 + 2]; s3 += mv[3] * xs[4 * k4 + 3]; }
            const float sm = quad_sum((s0 + s1) + (s2 + s3));
            xs[tt >> 2] += (q == (tt & 3)) ? sm : 0.f;
        }
        const lbf dstT = (col < 64) ? (X1T + col * SB) : (ZlT + (col - 64) * SB);
#pragma unroll
        for (int k = 0; k < 16; ++k) dstT[q + 4 * k] = (bf16_t)f2bf(xs[k]);
    }
    __syncthreads();
    if (quad == 0) {
        const f32x16 gy = mm_lds(Wb, X1T, I, J, lane, f32x16{}); const f32x16 pc = mm_lds(BhT, X1T, I, J, lane, f32x16{});
        bf16_t* gyg = (bf16_t*)(cw + O_GY + (size_t)item * 8192); bf16_t* pcg = (bf16_t*)(cw + O_PC + (size_t)item * 8192);
        const int cc = 32 * J + r;
#pragma unroll
        for (int g = 0; g < 16; ++g) { const int rw = 32 * I + crow(g, hh);
            gyg[rw * 64 + cc] = (bf16_t)f2bf(gy[g] + __builtin_bit_cast(float, (unsigned)Rm[rw * SB + cc] << 16));
            pcg[rw * 64 + cc] = (bf16_t)f2bf(pc[g] + (rw == cc ? GL[cc] : 0.f)); }
    } else {
        f32x16 yl = mm_lds(ZlT, Wb, I, J, lane, f32x16{}); yl = mm_lds(VT, Wk, I, J, lane, yl);
        f32x16 qc = mm_lds(BhT, ZlT, I, J, lane, f32x16{}); qc = mm_lds(KhT, VT, I, J, lane, qc);
        frag_store((float*)(cw + O_YL + (size_t)item * 16384), wq, lane, yl); frag_store_bf((bf16_t*)(cw + O_QC) + (size_t)item * 4096, wq, lane, qc);
    }
    __syncthreads();
}

template <int NST> __device__ __forceinline__ void rwkv_scan(CK_LAS unsigned char* lds, int chain, const bf16_t* __restrict__ pcb, const bf16_t* __restrict__ qcb, bf16_t* __restrict__ h0b) {
    const int tid = ltid(), lane = tid & 63, wid = __builtin_amdgcn_readfirstlane(tid >> 6), quad = wid >> 2, wq = wid & 3, I = wq >> 1, J = wq & 1, r = lane & 31, hh = lane >> 5, qtid = tid & 255;
    const lbf HT = (lbf)(lds + quad * B9);
    for (int i = qtid; i < 64 * SB / 2; i += 256) ((CK_LAS unsigned*)HT)[i] = 0u;
    __syncthreads();
    const bool on = chain >= 0; const size_t it0 = (size_t)(on ? chain : 0) * NST;
    const bf16_t* pcg = pcb + it0 * 4096; const bf16_t* qcg = qcb + it0 * 4096; bf16_t* h0g = h0b + it0 * 4096;
    constexpr int PD = 5;
    bf16x8 ar[PD][4]; f32x16 qr[PD];
#define CK_LOADSTEP(A_, Q_, cc) do { const int c_ = (cc) < NST ? (cc) : NST - 1; _Pragma("unroll") for (int s_ = 0; s_ < 4; ++s_) A_[s_] = *(const bf16x8*)(pcg + (size_t)c_ * 4096 + (32 * I + r) * 64 + 16 * s_ + 8 * hh); Q_ = frag_load_bf(qcg + (size_t)c_ * 4096, wq, lane); } while (0)
#pragma unroll
    for (int k = 0; k < PD; ++k) CK_LOADSTEP(ar[k], qr[k], k);
    for (int c = 0; c < NST + PD - 1; c += PD) {
#pragma unroll
        for (int k = 0; k < PD; ++k) {
            const int cc = c + k;
            if (cc < NST) {
            if (on) { const int row = qtid >> 2, seg = (qtid & 3) * 16; const u32x4 w0 = *(const CK_LAS u32x4*)(HT + row * SB + seg), w1 = *(const CK_LAS u32x4*)(HT + row * SB + seg + 8);
                      u32x4* dst = (u32x4*)(h0g + (size_t)cc * 4096 + row * 64 + seg); dst[0] = w0; dst[1] = w1; }
            f32x16 acc = qr[k];
            const lbf bp = HT + (32 * J + r) * SB + 8 * hh;
#pragma unroll
            for (int s_ = 0; s_ < 4; ++s_) { const bf16x8 bfr = *(const CK_LAS bf16x8*)(bp + 16 * s_); acc = __builtin_amdgcn_mfma_f32_32x32x16_bf16(ar[k][s_], bfr, acc, 0, 0, 0); }
            CK_LOADSTEP(ar[k], qr[k], cc + PD);
            asm volatile("s_waitcnt lgkmcnt(0)\n\ts_barrier" ::: "memory");
            tile_store_T(HT, I, J, lane, acc);
            asm volatile("s_waitcnt lgkmcnt(0)\n\ts_barrier" ::: "memory");
            }
        }
    }
#undef CK_LOADSTEP
}

__device__ __forceinline__ void rwkv_level1(CK_LAS unsigned char* lds, int task, unsigned char* __restrict__ cw) {
    const int tid = ltid(), lane = tid & 63, wid = __builtin_amdgcn_readfirstlane(tid >> 6), quad = wid >> 2, wq = wid & 3, I = wq >> 1, J = wq & 1, r = lane & 31, hh = lane >> 5;
    const lbf PTh = (lbf)(lds + quad * 4 * B9), PTl = PTh + 64 * SB, QTh = PTl + 64 * SB, QTl = QTh + 64 * SB;
    const bool on = task >= 0; const int tk = on ? task : 0; const size_t item0 = (size_t)(tk >> 5) * 256 + (size_t)(tk & 31) * 8;
    f32x16 PG, QG = f32x16{};
#pragma unroll
    for (int g = 0; g < 16; ++g) PG[g] = (I == J && crow(g, hh) == r) ? 1.0f : 0.0f;
    for (int j = 0; j < 8; ++j) {
        const size_t item = item0 + j;
        bf16x8 a[4]; load_gA(a, (const bf16_t*)(cw + O_PC) + item * 4096, I, lane);
        f32x16 qn = frag_load_bf((const bf16_t*)(cw + O_QC) + item * 4096, wq, lane);
        f32x16 pl, ql;
#pragma unroll
        for (int g = 0; g < 16; ++g) { pl[g] = PG[g] - __builtin_bit_cast(float, f2bf(PG[g]) << 16); ql[g] = QG[g] - __builtin_bit_cast(float, f2bf(QG[g]) << 16); }
        tile_store_T(PTh, I, J, lane, PG); tile_store_T(PTl, I, J, lane, pl); tile_store_T(QTh, I, J, lane, QG); tile_store_T(QTl, I, J, lane, ql);
        __syncthreads();
        f32x16 pn = mm_rA(a, PTh, J, lane, f32x16{}); pn = mm_rA(a, PTl, J, lane, pn);
        qn = mm_rA(a, QTh, J, lane, qn); qn = mm_rA(a, QTl, J, lane, qn);
        __syncthreads();
        PG = pn; QG = qn;
    }
    if (on) { bf16_t* pgg = (bf16_t*)(cw + O_PG) + (size_t)tk * 4096; const int cc = 32 * J + r;
#pragma unroll
        for (int g = 0; g < 16; ++g) pgg[(32 * I + crow(g, hh)) * 64 + cc] = (bf16_t)f2bf(PG[g]);
        frag_store_bf((bf16_t*)(cw + O_QG) + (size_t)tk * 4096, wq, lane, QG); }
}

constexpr int L_RW3 = B9 + 64 * SF * 4;
__device__ __forceinline__ void rwkv_stage3g(CK_LAS unsigned char* ldsq, int task, const RwkvParams& p, const unsigned char* __restrict__ cw, bf16_t* __restrict__ MIXB, int SEQ) {
    const int tid = ltid(), lane = tid & 63, wid = __builtin_amdgcn_readfirstlane(tid >> 6), wq = wid & 3, I = wq >> 1, J = wq & 1, r = lane & 31, hh = lane >> 5, qtid = tid & 255;
    const lbf HT = (lbf)ldsq; const lf32 Y = (lf32)(ldsq + B9);
    const bool on = task >= 0; const int tk = on ? task : 0; const int item0 = (tk >> 5) * 256 + (tk & 31) * 8;
    { const int row = qtid >> 2, seg = (qtid & 3) * 16; const u32x4* src = (const u32x4*)((const bf16_t*)(cw + O_HG) + (size_t)tk * 4096 + row * 64 + seg);
      *(CK_LAS u32x4*)(HT + row * SB + seg) = src[0]; *(CK_LAS u32x4*)(HT + row * SB + seg + 8) = src[1]; }
    __syncthreads();
    for (int j = 0; j < 8; ++j) {
        const int item = item0 + j;
        bf16x8 a[4]; load_gA(a, (const bf16_t*)(cw + O_PC) + (size_t)item * 4096, I, lane);
        f32x16 hn = frag_load_bf((const bf16_t*)(cw + O_QC) + (size_t)item * 4096, wq, lane);
        {
            f32x16 acc = frag_load((const float*)(cw + O_YL) + (size_t)item * 4096, wq, lane);
            acc = mm_lA_gB(HT, (const bf16_t*)(cw + O_GY) + (size_t)item * 4096, I, J, lane, acc);
#pragma unroll
            for (int g = 0; g < 16; ++g) Y[(32 * J + r) * SF + 32 * I + crow(g, hh)] = acc[g];
        }
        hn = mm_rA(a, HT, J, lane, hn);
        __syncthreads();
        tile_store_T(HT, I, J, lane, hn);
        if (on) {
            const int b = item >> 10, h = (item >> 8) & 3, c = item & 255; const int t = qtid >> 2, c16 = (qtid & 3) * 16;
            float y[16]; float s = 0.f;
#pragma unroll
            for (int e = 0; e < 16; ++e) { y[e] = Y[t * SF + c16 + e]; s += y[e]; }
            const float mu = quad_sum(s) * (1.f / 64.f); float s2 = 0.f;
#pragma unroll
            for (int e = 0; e < 16; ++e) { y[e] -= mu; s2 += y[e] * y[e]; }
            const float rstd = 1.0f / sqrtf(quad_sum(s2) * (1.f / 64.f) + 64e-5f);
            const u32x4* vg = (const u32x4*)(cw + O_VG + (size_t)item * 8192 + (t * 64 + c16) * 2); const u32x4* gg = (const u32x4*)(cw + O_GG + (size_t)item * 8192 + (t * 64 + c16) * 2);
            const float rk = *(const float*)(cw + O_RKD + (size_t)item * 256 + t * 4);
            unsigned ow[8];
#pragma unroll
            for (int hv = 0; hv < 2; ++hv) { const u32x4 vw = vg[hv], gw = gg[hv];
#pragma unroll
                for (int e2 = 0; e2 < 4; ++e2) { const int e = hv * 8 + 2 * e2; const int ch = h * 64 + c16 + e;
                    const float o0 = (y[e] * rstd * p.ln_g[ch] + p.ln_b[ch] + rk * bflo(vw[e2])) * bflo(gw[e2]);
                    const float o1 = (y[e + 1] * rstd * p.ln_g[ch + 1] + p.ln_b[ch + 1] + rk * bfhi(vw[e2])) * bfhi(gw[e2]);
                    ow[hv * 4 + e2] = pk2(o0, o1); } }
            u32x4* dst = (u32x4*)(MIXB + ((size_t)b * SEQ + (size_t)c * 64 + t) * 1024 + 512 + h * 64 + c16);
            dst[0] = (u32x4){ow[0], ow[1], ow[2], ow[3]}; dst[1] = (u32x4){ow[4], ow[5], ow[6], ow[7]};
        }
        __syncthreads();
    }
}

__device__ __forceinline__ void rwkv_stage3(CK_LAS unsigned char* ldsq, int item, const RwkvParams& p, const unsigned char* __restrict__ cw, bf16_t* __restrict__ MIXB, int SEQ) {
    const int tid = ltid(), lane = tid & 63, wid = __builtin_amdgcn_readfirstlane(tid >> 6), wq = wid & 3, I = wq >> 1, J = wq & 1, r = lane & 31, hh = lane >> 5, qtid = tid & 255;
    const lf32 Y = (lf32)ldsq;
    if (item >= 0) {
        f32x16 acc = frag_load((const float*)(cw + O_YL) + (size_t)item * 4096, wq, lane);
        acc = mm_gg((const bf16_t*)(cw + O_H0) + (size_t)item * 4096, (const bf16_t*)(cw + O_GY) + (size_t)item * 4096, I, J, lane, acc);
#pragma unroll
        for (int g = 0; g < 16; ++g) Y[(32 * J + r) * SF + 32 * I + crow(g, hh)] = acc[g];
    }
    __syncthreads();
    if (item >= 0) {
        const int b = item >> 10, h = (item >> 8) & 3, c = item & 255; const int t = qtid >> 2, c16 = (qtid & 3) * 16;
        float y[16]; float s = 0.f;
#pragma unroll
        for (int e = 0; e < 16; ++e) { y[e] = Y[t * SF + c16 + e]; s += y[e]; }
        const float mu = quad_sum(s) * (1.f / 64.f); float s2 = 0.f;
#pragma unroll
        for (int e = 0; e < 16; ++e) { y[e] -= mu; s2 += y[e] * y[e]; }
        const float rstd = 1.0f / sqrtf(quad_sum(s2) * (1.f / 64.f) + 64e-5f);
        const u32x4* vg = (const u32x4*)(cw + O_VG + (size_t)item * 8192 + (t * 64 + c16) * 2); const u32x4* gg = (const u32x4*)(cw + O_GG + (size_t)item * 8192 + (t * 64 + c16) * 2);
        const float rk = *(const float*)(cw + O_RKD + (size_t)item * 256 + t * 4);
        unsigned ow[8];
#pragma unroll
        for (int hv = 0; hv < 2; ++hv) { const u32x4 vw = vg[hv], gw = gg[hv];
#pragma unroll
            for (int e2 = 0; e2 < 4; ++e2) { const int e = hv * 8 + 2 * e2; const int ch = h * 64 + c16 + e;
                const float o0 = (y[e] * rstd * p.ln_g[ch] + p.ln_b[ch] + rk * bflo(vw[e2])) * bflo(gw[e2]);
                const float o1 = (y[e + 1] * rstd * p.ln_g[ch + 1] + p.ln_b[ch + 1] + rk * bfhi(vw[e2])) * bfhi(gw[e2]);
                ow[hv * 4 + e2] = pk2(o0, o1); } }
        u32x4* dst = (u32x4*)(MIXB + ((size_t)b * SEQ + (size_t)c * 64 + t) * 1024 + 512 + h * 64 + c16);
        dst[0] = (u32x4){ow[0], ow[1], ow[2], ow[3]}; dst[1] = (u32x4){ow[4], ow[5], ow[6], ow[7]};
    }
    __syncthreads();
}

__device__ __forceinline__ void rot16(float (&o)[16], const bf16_t* __restrict__ prow, int colbase, int c16, const float* __restrict__ ropet  ) {
    const u32x4* own = (const u32x4*)(prow + colbase + c16); const u32x4* par = (const u32x4*)(prow + colbase + (c16 ^ 32));
    const f32x4* cs = (const f32x4*)(ropet + 2 * (c16 & 31));
#pragma unroll
    for (int hv = 0; hv < 2; ++hv) { const u32x4 ow = own[hv], pw = par[hv];
#pragma unroll
        for (int e2 = 0; e2 < 4; ++e2) { const f32x4 csv = cs[hv * 4 + e2];
            const float x0 = bflo(ow[e2]), x1 = bfhi(ow[e2]), p0 = bflo(pw[e2]), p1 = bfhi(pw[e2]);
            o[hv * 8 + 2 * e2] = (c16 < 32) ? (x0 * csv[0] - p0 * csv[1]) : (p0 * csv[1] + x0 * csv[0]);
            o[hv * 8 + 2 * e2 + 1] = (c16 < 32) ? (x1 * csv[2] - p1 * csv[3]) : (p1 * csv[3] + x1 * csv[2]); } }
}
__device__ __forceinline__ void ret_stage1(CK_LAS unsigned char* ldsq, int item, const bf16_t* __restrict__ Pb, int PW, int C_TK, int C_TV, int SEQ, const float* __restrict__ ROPE, unsigned char* __restrict__ cw) {
    const int tid = ltid(), lane = tid & 63, wid = __builtin_amdgcn_readfirstlane(tid >> 6), wq = wid & 3, I = wq >> 1, J = wq & 1, qtid = tid & 255;
    const lbf VT = (lbf)ldsq, KdT = (lbf)(ldsq + B9);
    if (item >= 0) {
        const int b = item >> 10, h = (item >> 8) & 3, c = item & 255; const int t = qtid >> 2, c16 = (qtid & 3) * 16; const int pos = c * 64 + t;
        const bf16_t* prow = Pb + ((size_t)b * SEQ + pos) * PW;
        float kr[16]; rot16(kr, prow, C_TK + h * 64, c16, ROPE + (size_t)pos * 64);
        const float lg = __builtin_amdgcn_logf(1.0f - __builtin_amdgcn_exp2f(-5.0f - (float)h));
        const float dec = 0.125f * __builtin_amdgcn_exp2f(lg * (float)(63 - t));
        const u32x4* vp = (const u32x4*)(prow + C_TV + h * 64 + c16);
#pragma unroll
        for (int hv = 0; hv < 2; ++hv) { const u32x4 vw = vp[hv];
#pragma unroll
            for (int e2 = 0; e2 < 4; ++e2) { const int e = hv * 8 + 2 * e2;
                VT[(c16 + e) * SB + t] = (bf16_t)(vw[e2] & 0xffffu); VT[(c16 + e + 1) * SB + t] = (bf16_t)(vw[e2] >> 16);
                KdT[(c16 + e) * SB + t] = (bf16_t)f2bf(kr[e] * dec); KdT[(c16 + e + 1) * SB + t] = (bf16_t)f2bf(kr[e + 1] * dec); } }
    }
    __syncthreads();
    if (item >= 0) { const f32x16 kv = mm_lds(VT, KdT, I, J, lane, f32x16{}); frag_store_bf((bf16_t*)(cw + O_KV) + (size_t)item * 4096, wq, lane, kv); }
    __syncthreads();
}
__device__ __forceinline__ void ret_scan(int chain, unsigned char* __restrict__ cw) {
    const int tid = ltid(), lane = tid & 63, wid = __builtin_amdgcn_readfirstlane(tid >> 6), wq = wid & 3, I = wq >> 1, J = wq & 1, r = lane & 31, hh = lane >> 5;
    const int h = chain & 3; const float lg = __builtin_amdgcn_logf(1.0f - __builtin_amdgcn_exp2f(-5.0f - (float)h)); const float g64 = __builtin_amdgcn_exp2f(lg * 64.0f);
    const bf16_t* kvg = (const bf16_t*)(cw + O_KV) + (size_t)chain * 256 * 4096; bf16_t* rtg = (bf16_t*)(cw + O_RT) + (size_t)chain * 256 * 4096;
    f32x16 R = f32x16{}; constexpr int PD = 8; f32x16 nx[PD];
#pragma unroll
    for (int k = 0; k < PD; ++k) nx[k] = frag_load_bf(kvg + (size_t)k * 4096, wq, lane);
    for (int c = 0; c < 256; c += PD) {
#pragma unroll
        for (int k = 0; k < PD; ++k) { const int cc = c + k; bf16_t* dst = rtg + (size_t)cc * 4096;
#pragma unroll
            for (int g = 0; g < 16; ++g) dst[(32 * I + crow(g, hh)) * 64 + 32 * J + r] = (bf16_t)f2bf(R[g]);
            const f32x16 kvc = nx[k]; const int nn = cc + PD < 256 ? cc + PD : 255;
            nx[k] = frag_load_bf(kvg + (size_t)nn * 4096, wq, lane);
#pragma unroll
            for (int g = 0; g < 16; ++g) R[g] = R[g] * g64 + kvc[g]; }
    }
}
constexpr int L_RET3 = 4 * B9 + 64 * SF * 4;
__device__ __forceinline__ void ret_stage3(CK_LAS unsigned char* ldsq, int item, const bf16_t* __restrict__ Pb, int PW, int C_TQ, int C_TK, int C_TV, int C_TG, int SEQ, const float* __restrict__ ROPE,
                                           const float* __restrict__ gn_g, const unsigned char* __restrict__ cw, bf16_t* __restrict__ MIXB) {
    const int tid = ltid(), lane = tid & 63, wid = __builtin_amdgcn_readfirstlane(tid >> 6), wq = wid & 3, I = wq >> 1, J = wq & 1, r = lane & 31, hh = lane >> 5, qtid = tid & 255;
    const lbf Qr = (lbf)ldsq, Kr = (lbf)(ldsq + B9), VT = (lbf)(ldsq + 2 * B9), Sb = (lbf)(ldsq + 3 * B9); const lf32 Y = (lf32)(ldsq + 4 * B9);
    const int b = item >= 0 ? item >> 10 : 0, h = item >= 0 ? (item >> 8) & 3 : 0, c = item >= 0 ? item & 255 : 0; const int t = qtid >> 2, c16 = (qtid & 3) * 16; const int pos = c * 64 + t;
    const float lg = __builtin_amdgcn_logf(1.0f - __builtin_amdgcn_exp2f(-5.0f - (float)h));
    const bf16_t* prow = Pb + ((size_t)b * SEQ + pos) * PW;
    if (item >= 0) {
        float qr[16], kr[16]; rot16(qr, prow, C_TQ + h * 64, c16, ROPE + (size_t)pos * 64); rot16(kr, prow, C_TK + h * 64, c16, ROPE + (size_t)pos * 64);
        u32x4 w;
        w.x = pk2(qr[0], qr[1]); w.y = pk2(qr[2], qr[3]); w.z = pk2(qr[4], qr[5]); w.w = pk2(qr[6], qr[7]); *(CK_LAS u32x4*)(Qr + t * SB + c16) = w;
        w.x = pk2(qr[8], qr[9]); w.y = pk2(qr[10], qr[11]); w.z = pk2(qr[12], qr[13]); w.w = pk2(qr[14], qr[15]); *(CK_LAS u32x4*)(Qr + t * SB + c16 + 8) = w;
#pragma unroll
        for (int e = 0; e < 16; ++e) kr[e] *= 0.125f;
        w.x = pk2(kr[0], kr[1]); w.y = pk2(kr[2], kr[3]); w.z = pk2(kr[4], kr[5]); w.w = pk2(kr[6], kr[7]); *(CK_LAS u32x4*)(Kr + t * SB + c16) = w;
        w.x = pk2(kr[8], kr[9]); w.y = pk2(kr[10], kr[11]); w.z = pk2(kr[12], kr[13]); w.w = pk2(kr[14], kr[15]); *(CK_LAS u32x4*)(Kr + t * SB + c16 + 8) = w;
        const u32x4* vp = (const u32x4*)(prow + C_TV + h * 64 + c16);
#pragma unroll
        for (int hv = 0; hv < 2; ++hv) { const u32x4 vw = vp[hv];
#pragma unroll
            for (int e2 = 0; e2 < 4; ++e2) { const int e = hv * 8 + 2 * e2; VT[(c16 + e) * SB + t] = (bf16_t)(vw[e2] & 0xffffu); VT[(c16 + e + 1) * SB + t] = (bf16_t)(vw[e2] >> 16); } }
    }
    __syncthreads();
    if (item >= 0) {
        f32x16 st = mm_lds(Kr, Qr, I, J, lane, f32x16{}); const int tt = 32 * J + r;
#pragma unroll
        for (int g = 0; g < 16; ++g) { const int ii = 32 * I + crow(g, hh); st[g] = (ii <= tt) ? st[g] * __builtin_amdgcn_exp2f(lg * (float)(tt - ii)) : 0.f; }
        tile_store_T(Sb, I, J, lane, st);
    }
    __syncthreads();
    if (item >= 0) {
        const f32x16 yi = mm_lds(VT, Sb, I, J, lane, f32x16{}); const f32x16 yc = mm_gA((const bf16_t*)(cw + O_RT) + (size_t)item * 4096, Qr, I, J, lane, f32x16{});
        const int tt = 32 * J + r; const float qd = __builtin_amdgcn_exp2f(lg * (float)(tt + 1));
#pragma unroll
        for (int g = 0; g < 16; ++g) Y[tt * SF + 32 * I + crow(g, hh)] = yi[g] + qd * yc[g];
    }
    __syncthreads();
    if (item >= 0) {
        float y[16]; float s = 0.f;
#pragma unroll
        for (int e = 0; e < 16; ++e) { y[e] = Y[t * SF + c16 + e]; s += y[e]; }
        const float mu = quad_sum(s) * (1.f / 64.f); float s2 = 0.f;
#pragma unroll
        for (int e = 0; e < 16; ++e) { y[e] -= mu; s2 += y[e] * y[e]; }
        const float rstd = 1.0f / sqrtf(quad_sum(s2) * (1.f / 64.f) + 1e-6f);
        const u32x4* gp = (const u32x4*)(prow + C_TG + h * 64 + c16); unsigned ow[8];
#pragma unroll
        for (int hv = 0; hv < 2; ++hv) { const u32x4 gw = gp[hv];
#pragma unroll
            for (int e2 = 0; e2 < 4; ++e2) { const int e = hv * 8 + 2 * e2; const int ch = h * 64 + c16 + e; const float g0 = bflo(gw[e2]), g1 = bfhi(gw[e2]);
                ow[hv * 4 + e2] = pk2(y[e] * rstd * gn_g[ch] * (g0 * sigm(g0)), y[e + 1] * rstd * gn_g[ch + 1] * (g1 * sigm(g1))); } }
        u32x4* dst = (u32x4*)(MIXB + ((size_t)b * SEQ + pos) * 1024 + 768 + h * 64 + c16);
        dst[0] = (u32x4){ow[0], ow[1], ow[2], ow[3]}; dst[1] = (u32x4){ow[4], ow[5], ow[6], ow[7]};
    }
    __syncthreads();
}
__device__ __forceinline__ void ret_level1(int task, unsigned char* __restrict__ cw) {
    const int tid = ltid(), lane = tid & 63, wid = __builtin_amdgcn_readfirstlane(tid >> 6), wq = wid & 3;
    const int h = (task >> 5) & 3; const float lg = __builtin_amdgcn_logf(1.0f - __builtin_amdgcn_exp2f(-5.0f - (float)h)); const float g64 = __builtin_amdgcn_exp2f(lg * 64.0f);
    const bf16_t* kvg = (const bf16_t*)(cw + O_KV) + ((size_t)(task >> 5) * 256 + (size_t)(task & 31) * 8) * 4096;
    f32x16 kv[8];
#pragma unroll
    for (int j = 0; j < 8; ++j) kv[j] = frag_load_bf(kvg + (size_t)j * 4096, wq, lane);
    f32x16 acc = kv[0];
#pragma unroll
    for (int j = 1; j < 8; ++j)
#pragma unroll
        for (int g = 0; g < 16; ++g) acc[g] = acc[g] * g64 + kv[j][g];
    frag_store((float*)(cw + O_KG) + (size_t)task * 4096, wq, lane, acc);
}
__device__ __forceinline__ void ret_scan_groups(int chain, unsigned char* __restrict__ cw) {
    const int tid = ltid(), lane = tid & 63, wid = __builtin_amdgcn_readfirstlane(tid >> 6), wq = wid & 3;
    const int h = chain & 3; const float lg = __builtin_amdgcn_logf(1.0f - __builtin_amdgcn_exp2f(-5.0f - (float)h)); const float g512 = __builtin_amdgcn_exp2f(lg * 512.0f);
    const float* kgg = (const float*)(cw + O_KG) + (size_t)chain * 32 * 4096; float* rgg = (float*)(cw + O_RG) + (size_t)chain * 32 * 4096;
    f32x16 R = f32x16{}; f32x16 nx[4];
#pragma unroll
    for (int k = 0; k < 4; ++k) nx[k] = frag_load(kgg + (size_t)k * 4096, wq, lane);
    for (int c = 0; c < 32; c += 4) {
#pragma unroll
        for (int k = 0; k < 4; ++k) { const int cc = c + k; frag_store(rgg + (size_t)cc * 4096, wq, lane, R);
            const f32x16 kvc = nx[k]; const int nn = cc + 4 < 32 ? cc + 4 : 31; nx[k] = frag_load(kgg + (size_t)nn * 4096, wq, lane);
#pragma unroll
            for (int g = 0; g < 16; ++g) R[g] = R[g] * g512 + kvc[g]; }
    }
}
constexpr int L_RET3G = 5 * B9 + 64 * SF * 4;
__device__ __forceinline__ void ret_stage3g(CK_LAS unsigned char* ldsq, int task, const bf16_t* __restrict__ Pb, int PW, int C_TQ, int C_TK, int C_TV, int C_TG, int SEQ, const float* __restrict__ ROPE,
                                           const float* __restrict__ gn_g, const unsigned char* __restrict__ cw, bf16_t* __restrict__ MIXB) {
    const int tid = ltid(), lane = tid & 63, wid = __builtin_amdgcn_readfirstlane(tid >> 6), wq = wid & 3, I = wq >> 1, J = wq & 1, r = lane & 31, hh = lane >> 5, qtid = tid & 255;
    const lbf Qr = (lbf)ldsq, Kr = (lbf)(ldsq + B9), VT = (lbf)(ldsq + 2 * B9), Sb = (lbf)(ldsq + 3 * B9), RTL = (lbf)(ldsq + 4 * B9); const lf32 Y = (lf32)(ldsq + 5 * B9);
    const int tk = task >= 0 ? task : 0; const int item0 = (tk >> 5) * 256 + (tk & 31) * 8;
    f32x16 R = frag_load((const float*)(cw + O_RG) + (size_t)tk * 4096, wq, lane);
    for (int j = 0; j < 8; ++j) { const int item = task >= 0 ? item0 + j : -1;
    const int b = item >= 0 ? item >> 10 : 0, h = item >= 0 ? (item >> 8) & 3 : 0, c = item >= 0 ? item & 255 : 0; const int t = qtid >> 2, c16 = (qtid & 3) * 16; const int pos = c * 64 + t;
    const float lg = __builtin_amdgcn_logf(1.0f - __builtin_amdgcn_exp2f(-5.0f - (float)h));
    const bf16_t* prow = Pb + ((size_t)b * SEQ + pos) * PW;
    if (item >= 0) {
#pragma unroll
        for (int g_ = 0; g_ < 16; ++g_) RTL[(32 * I + crow(g_, hh)) * SB + 32 * J + r] = (bf16_t)f2bf(R[g_]);
        float qr[16], kr[16]; rot16(qr, prow, C_TQ + h * 64, c16, ROPE + (size_t)pos * 64); rot16(kr, prow, C_TK + h * 64, c16, ROPE + (size_t)pos * 64);
        u32x4 w;
        w.x = pk2(qr[0], qr[1]); w.y = pk2(qr[2], qr[3]); w.z = pk2(qr[4], qr[5]); w.w = pk2(qr[6], qr[7]); *(CK_LAS u32x4*)(Qr + t * SB + c16) = w;
        w.x = pk2(qr[8], qr[9]); w.y = pk2(qr[10], qr[11]); w.z = pk2(qr[12], qr[13]); w.w = pk2(qr[14], qr[15]); *(CK_LAS u32x4*)(Qr + t * SB + c16 + 8) = w;
#pragma unroll
        for (int e = 0; e < 16; ++e) kr[e] *= 0.125f;
        w.x = pk2(kr[0], kr[1]); w.y = pk2(kr[2], kr[3]); w.z = pk2(kr[4], kr[5]); w.w = pk2(kr[6], kr[7]); *(CK_LAS u32x4*)(Kr + t * SB + c16) = w;
        w.x = pk2(kr[8], kr[9]); w.y = pk2(kr[10], kr[11]); w.z = pk2(kr[12], kr[13]); w.w = pk2(kr[14], kr[15]); *(CK_LAS u32x4*)(Kr + t * SB + c16 + 8) = w;
        const u32x4* vp = (const u32x4*)(prow + C_TV + h * 64 + c16);
#pragma unroll
        for (int hv = 0; hv < 2; ++hv) { const u32x4 vw = vp[hv];
#pragma unroll
            for (int e2 = 0; e2 < 4; ++e2) { const int e = hv * 8 + 2 * e2; VT[(c16 + e) * SB + t] = (bf16_t)(vw[e2] & 0xffffu); VT[(c16 + e + 1) * SB + t] = (bf16_t)(vw[e2] >> 16); } }
    }
    __syncthreads();
    if (item >= 0) {
        f32x16 st = mm_lds(Kr, Qr, I, J, lane, f32x16{}); const int tt = 32 * J + r;
#pragma unroll
        for (int g = 0; g < 16; ++g) { const int ii = 32 * I + crow(g, hh); st[g] = (ii <= tt) ? st[g] * __builtin_amdgcn_exp2f(lg * (float)(tt - ii)) : 0.f; }
        tile_store_T(Sb, I, J, lane, st);
    }
    __syncthreads();
    if (item >= 0) {
        const f32x16 yi = mm_lds(VT, Sb, I, J, lane, f32x16{}); const f32x16 yc = mm_lds(RTL, Qr, I, J, lane, f32x16{});
        const int tt = 32 * J + r; const float qd = __builtin_amdgcn_exp2f(lg * (float)(tt + 1));
#pragma unroll
        for (int g = 0; g < 16; ++g) Y[tt * SF + 32 * I + crow(g, hh)] = yi[g] + qd * yc[g];
    }
    __syncthreads();
    if (item >= 0) {
        float y[16]; float s = 0.f;
#pragma unroll
        for (int e = 0; e < 16; ++e) { y[e] = Y[t * SF + c16 + e]; s += y[e]; }
        const float mu = quad_sum(s) * (1.f / 64.f); float s2 = 0.f;
#pragma unroll
        for (int e = 0; e < 16; ++e) { y[e] -= mu; s2 += y[e] * y[e]; }
        const float rstd = 1.0f / sqrtf(quad_sum(s2) * (1.f / 64.f) + 1e-6f);
        const u32x4* gp = (const u32x4*)(prow + C_TG + h * 64 + c16); unsigned ow[8];
#pragma unroll
        for (int hv = 0; hv < 2; ++hv) { const u32x4 gw = gp[hv];
#pragma unroll
            for (int e2 = 0; e2 < 4; ++e2) { const int e = hv * 8 + 2 * e2; const int ch = h * 64 + c16 + e; const float g0 = bflo(gw[e2]), g1 = bfhi(gw[e2]);
                ow[hv * 4 + e2] = pk2(y[e] * rstd * gn_g[ch] * (g0 * sigm(g0)), y[e + 1] * rstd * gn_g[ch + 1] * (g1 * sigm(g1))); } }
        u32x4* dst = (u32x4*)(MIXB + ((size_t)b * SEQ + pos) * 1024 + 768 + h * 64 + c16);
        dst[0] = (u32x4){ow[0], ow[1], ow[2], ow[3]}; dst[1] = (u32x4){ow[4], ow[5], ow[6], ow[7]};
    }
    if (item >= 0) { const f32x16 kvc = frag_load_bf((const bf16_t*)(cw + O_KV) + (size_t)item * 4096, wq, lane); const float g64 = __builtin_amdgcn_exp2f(lg * 64.0f);
#pragma unroll
        for (int g_ = 0; g_ < 16; ++g_) R[g_] = R[g_] * g64 + kvc[g_]; }
    __syncthreads();
    }
}
}

__device__ __forceinline__ void tr_tile(const float* __restrict__ src, size_t ld_src, bf16* __restrict__ dst, size_t ld_dst, float* scr, int lane) {
    pg8::f32x4 v[16];
#pragma unroll
    for (int i = 0; i < 16; ++i) v[i] = *(const pg8::f32x4*)(src + (size_t)(i * 4 + (lane >> 4)) * ld_src + (lane & 15) * 4);
#pragma unroll
    for (int i = 0; i < 16; ++i) { float* p = scr + (i * 4 + (lane >> 4)) * 65 + (lane & 15) * 4; p[0] = v[i][0]; p[1] = v[i][1]; p[2] = v[i][2]; p[3] = v[i][3]; }
    asm volatile("s_waitcnt lgkmcnt(0)" ::: "memory");
#pragma unroll
    for (int i = 0; i < 8; ++i) { const int n = i * 8 + (lane >> 3), kc = (lane & 7) * 8; const float* s = scr + kc * 65 + n;
        pg8::u32x4 o; o.x = pk2(s[0], s[65]); o.y = pk2(s[2 * 65], s[3 * 65]); o.z = pk2(s[4 * 65], s[5 * 65]); o.w = pk2(s[6 * 65], s[7 * 65]);
        *(pg8::u32x4*)(dst + (size_t)n * ld_dst + kc) = o; }
    asm volatile("s_waitcnt lgkmcnt(0)" ::: "memory");
}

constexpr int CV_13 = NE * 16 * 16, CV_2 = NE * 8 * 16, CV_L = CV_13 + CV_2, NCONV = DEPTH * CV_L;
__device__ __forceinline__ void conv_item(int it, const float* __restrict__ w1, const float* __restrict__ w3, const float* __restrict__ w2, bf16* __restrict__ W13, bf16* __restrict__ W2, float* scr, int lane) {
    const int l = it / CV_L; int r = it % CV_L;
    if (r < CV_13) { const int e = r >> 8, kb = (r >> 4) & 15, nb = r & 15;
        const int pn = nb >> 2, q = nb & 3; const float* srcw = (q < 2 ? w1 : w3) + ((size_t)l * NE + e) * DM * DE;
        tr_tile(srcw + (size_t)kb * 64 * DE + pn * 128 + (q & 1) * 64, DE, W13 + ((size_t)l * NE + e) * DM * DM + (size_t)nb * 64 * DM + kb * 64, DM, scr, lane); }
    else { r -= CV_13; const int e = r >> 7, kb = (r >> 4) & 7, nb = r & 15;
        tr_tile(w2 + ((size_t)l * NE + e) * DE * DM + (size_t)kb * 64 * DM + nb * 64, DM, W2 + ((size_t)l * NE + e) * DM * DE + (size_t)nb * 64 * DE + kb * 64, DE, scr, lane); }
}

#define LAS __attribute__((address_space(3)))
#define XB_TMO      128
#define XB_XCNT(j)  (256  + 64 * (j))
#define XB_XSUB(j)  (1280 + 64 * (j))
#define XB_XGEN(j)  (2304 + 64 * (j))
#define XB_TOP      3328
#define XB_TOPGEN   3392
#define XCD_BAR_WORDS 3456
#define XB_SPIN_CAP (1u << 18)

__device__ __forceinline__ unsigned xb_ld(unsigned* p)              { return __hip_atomic_load(p, __ATOMIC_RELAXED, __HIP_MEMORY_SCOPE_AGENT); }
__device__ __forceinline__ unsigned xb_add(unsigned* p, unsigned v) { return __hip_atomic_fetch_add(p, v, __ATOMIC_RELAXED, __HIP_MEMORY_SCOPE_AGENT); }
__device__ __forceinline__ unsigned xb_xcc_id() { return (unsigned)__builtin_amdgcn_s_getreg((3 << 11) | 20) & 0xFu; }
#define XB_SPIN(cond, bar) do { unsigned _sp = 0; while (cond) { __builtin_amdgcn_s_sleep(1); \
    if ((++_sp & 255u) == 0u) { if (xb_ld(&(bar)[XB_TMO])) break; if (_sp > XB_SPIN_CAP) { atomicAdd(&(bar)[XB_TMO], 1u); break; } } } } while (0)

struct XcdBarrier {
    unsigned* bar; unsigned x;
    volatile LAS unsigned* st;
};

__device__ __forceinline__ XcdBarrier xcd_barrier_post(unsigned* bar, volatile LAS unsigned* st) {
    XcdBarrier b; b.bar = bar; b.x = xb_xcc_id(); b.st = st;
    if (ltid() == 0) (void)xb_add(&bar[XB_XCNT(b.x)], 1u);
    return b;
}
__device__ __forceinline__ void xcd_barrier_complete(unsigned* bar, unsigned x, unsigned& nloc, unsigned& nx) {
    const unsigned G = gridDim.x * gridDim.y * gridDim.z;
    unsigned sum, cnt, mine, sp = 0u;
    for (;;) {
        sum = 0u; cnt = 0u; mine = 0u;
#pragma unroll
        for (unsigned j = 0; j < 16; ++j) { const unsigned c = xb_ld(&bar[XB_XCNT(j)]); sum += c; cnt += (c > 0u) ? 1u : 0u; mine = (j == x) ? c : mine; }
        if (sum == G) break;
        __builtin_amdgcn_s_sleep(1);
        if ((++sp & 255u) == 0u) { if (xb_ld(&bar[XB_TMO])) break; if (sp > XB_SPIN_CAP) { atomicAdd(&bar[XB_TMO], 1u); break; } }
    }
    nloc = mine > 0u ? mine : 1u; nx = cnt > 0u ? cnt : 1u;
}

__device__ __forceinline__ void xcd_barrier(const XcdBarrier& b) {
    asm volatile("s_waitcnt vmcnt(0)" ::: "memory");
    __syncthreads();
    if (ltid() == 0) {
        unsigned* bar = b.bar; asm volatile("" : "+s"(bar)); unsigned bx_ = b.x; asm volatile("" : "+s"(bx_));
        __builtin_amdgcn_s_waitcnt(0);
        unsigned nloc = b.st[0], nx = b.st[1];
        if (nloc == 0u) { xcd_barrier_complete(bar, bx_, nloc, nx); b.st[0] = nloc; b.st[1] = nx; }
        const unsigned old = xb_add(&bar[XB_XSUB(bx_)], 1u);
        const unsigned gen = old / nloc;
        if (old + 1u == (gen + 1u) * nloc) {
            __builtin_amdgcn_fence(__ATOMIC_RELEASE, "agent");
            asm volatile("s_waitcnt vmcnt(0)" ::: "memory");
            const unsigned og = xb_add(&bar[XB_TOP], 1u);
            const unsigned tg = og / nx;
            if (og + 1u == (tg + 1u) * nx) xb_add(&bar[XB_TOPGEN], 1u);
            else XB_SPIN(xb_ld(&bar[XB_TOPGEN]) == tg, bar);
            __builtin_amdgcn_fence(__ATOMIC_ACQUIRE, "agent");
            xb_add(&bar[XB_XGEN(bx_)], 1u);
            asm volatile("s_waitcnt vmcnt(0)" ::: "memory");
        } else {
            XB_SPIN(xb_ld(&bar[XB_XGEN(bx_)]) == gen, bar);
            __builtin_amdgcn_fence(__ATOMIC_ACQUIRE, "agent");
            asm volatile("s_waitcnt vmcnt(0)" ::: "memory");
        }
    }
    __syncthreads();
}


__global__ void __launch_bounds__(NTHREADS, 2) mk_fwd(Args args) {
    extern __shared__ __attribute__((aligned(16))) unsigned char lds_raw[];
    float* lds = (float*)lds_raw;
    const int tid = ltid(), lane = tid & 63, wid = __builtin_amdgcn_readfirstlane(tid >> 6);
    const int G = gridDim.x, bx = blockIdx.x;
    unsigned char* ws = args.ws;
    unsigned* ctl = (unsigned*)(ws + WS_CTL);
    float* X = args.out;
    bf16* XB = (bf16*)(ws + WS_XB);
    bf16* Pb = (bf16*)(ws + WS_P);
    bf16* WIN = (bf16*)(ws + WS_WIN); bf16* WOUT = (bf16*)(ws + WS_WOUT); bf16* W13 = (bf16*)(ws + WS_W13); bf16* W2 = (bf16*)(ws + WS_W2);
    float* ROPE = (float*)(ws + WS_ROPE);
    double* LCS = (double*)(ws + WS_LCS); double* TOT = (double*)(ws + WS_TOT);
    float* BE = (float*)(ws + WS_SKIP); float* QN2 = BE + 16 * 256; float* KN2 = QN2 + 16 * 128;
    unsigned char* KA = ws + WS_KA;
    unsigned char* cw = ws + WS_CK; bf16* LWT = (bf16*)(ws + WS_LW);
    int* EP = (int*)(ws + WS_EP);
    float* GATE = (float*)(ws + WS_GATE);
    bf16* MIXB = (bf16*)(ws + WS_MIXB);
    int* LIST = (int*)(ws + WS_XP); bf16* Hb = (bf16*)(ws + WS_H); bf16* YP = (bf16*)(ws + WS_YP); bf16* YO = (bf16*)(ws + WS_YO);
    typedef pg8::f32x4 f32x4;
    volatile LAS unsigned* MISC = (volatile LAS unsigned*)((LAS unsigned char*)lds_raw + LDS_MISC);
    for (int u = tid; u < (LDS_ALL - LDS_MISC) / 4; u += NTHREADS) MISC[u] = 0u;
    __syncthreads();
    XcdBarrier bar = xcd_barrier_post(ctl + CW_BAR, MISC + 8);
#define GRID_BAR() xcd_barrier(bar)
#ifndef TPROBE_SEL
#define TPROBE_SEL 0
#endif
#define TPROBE_MULT 4
    unsigned long long tp_acc = 0ull, tp_t0 = 0ull; (void)tp_acc; (void)tp_t0;
#define TP_BEGIN(id) do { if (TPROBE_SEL == (id)) tp_t0 = __builtin_amdgcn_s_memrealtime(); } while (0)
#define TP_END(id) do { if (TPROBE_SEL == (id)) tp_acc += __builtin_amdgcn_s_memrealtime() - tp_t0; } while (0)

    for (int rep_ = 0; rep_ < REP_P0; ++rep_) {
            const int tid = ltid(), lane = tid & 63, wid = __builtin_amdgcn_readfirstlane(tid >> 6); (void)lane; (void)wid;
        const f32x4* xi = (const f32x4*)args.in[0]; uint2* xb = (uint2*)XB;
        for (size_t i = (size_t)bx * NTHREADS + tid; i < (size_t)T * DM / 4; i += (size_t)G * NTHREADS) { const f32x4 v = xi[i]; xb[i] = make_uint2(pk2(v[0], v[1]), pk2(v[2], v[3])); }
        for (int i = bx * NTHREADS + tid; i < SEQ * 32; i += G * NTHREADS) {
            const int pos = i >> 5, f = i & 31;
            const double inv = pow(10000.0, -(double)f / 32.0);
            const double ang = (double)pos * inv;
            ROPE[2 * i] = (float)cos(ang); ROPE[2 * i + 1] = (float)sin(ang);
        }
        { bf16* WR = (bf16*)(ws + WS_WR);
          for (int i = bx * NTHREADS + tid; i < DEPTH * 48 * 1024; i += G * NTHREADS) { const int l_ = i / (48 * 1024), o = (i / 1024) % 48, k = i & 1023;
              const float wv = o < 4 ? args.in[21][((size_t)l_ * DM + k) * 4 + o] : (o < 36 ? args.in[23][((size_t)l_ * DM + k) * 32 + (o - 4)] : 0.f);
              const unsigned hi_ = f2bf(wv); const unsigned lo_ = f2bf(wv - bf2f((unsigned short)hi_));
              WR[((size_t)l_ * 2 + 0) * 48 * 1024 + o * 1024 + k] = (bf16)hi_; WR[((size_t)l_ * 2 + 1) * 48 * 1024 + o * 1024 + k] = (bf16)lo_; } }
        for (int i = bx * NTHREADS + tid; i < DEPTH * 256 * 256; i += G * NTHREADS) {
            const int l = i >> 16, rem = i & 65535, chg = rem >> 8, ii = rem & 255;
            if (ii < 64) LWT[((size_t)l * 256 + chg) * 64 + ii] = (bf16)f2bf(args.in[6][((size_t)l * 64 + ii) * 256 + chg]);
            else if (ii < 128) LWT[(size_t)DEPTH * 256 * 64 + ((size_t)l * 256 + chg) * 64 + (ii - 64)] = (bf16)f2bf(args.in[8][((size_t)l * 64 + (ii - 64)) * 256 + chg]);
            else LWT[(size_t)2 * DEPTH * 256 * 64 + ((size_t)l * 256 + chg) * 128 + (ii - 128)] = (bf16)f2bf(args.in[9][((size_t)l * 128 + (ii - 128)) * 256 + chg]);
        }
        float* scr = lds + wid * (64 * 65);
        constexpr int I_IN = 16 * 56, I_OUT = 16 * 16, I_L = I_IN + I_OUT;
        for (int it = bx * 8 + wid; it < DEPTH * I_L; it += G * 8) {
            const int l = it / I_L; int r = it % I_L;
            if (r < I_IN) { const int kb = r / 56, nb = r % 56; const int nsrc = nb * 64 + (nb >= 24 ? 8 : 0);
                tr_tile(args.in[1] + (size_t)l * DM * INW + (size_t)kb * 64 * INW + nsrc, INW, WIN + (size_t)l * PW * DM + (size_t)nb * 64 * DM + kb * 64, DM, scr, lane); }
            else { r -= I_IN; const int kb = r / 16, nb = r % 16;
                tr_tile(args.in[16] + (size_t)l * DM * DM + (size_t)kb * 64 * DM + nb * 64, DM, WOUT + (size_t)l * DM * DM + (size_t)nb * 64 * DM + kb * 64, DM, scr, lane); }
        }
        __syncthreads();
        {
            const float* wf = args.in[1] + O_FF; const float* fbias = args.in[2];
            float w[8][16];
#pragma unroll
            for (int jq = 0; jq < 4; ++jq)
#pragma unroll
                for (int e = 0; e < 4; ++e)
#pragma unroll
                    for (int h = 0; h < 8; ++h) w[h][jq * 4 + e] = wf[(size_t)(jq * 256 + lane * 4 + e) * INW + h];
            float* ffl = lds;
            for (int ch = bx; ch < T / 128; ch += G) {
                __syncthreads();
                for (int i = 0; i < 16; ++i) { const int tl = wid * 16 + i; const size_t m = (size_t)ch * 128 + tl;
                    float acc[8];
#pragma unroll
                    for (int h = 0; h < 8; ++h) acc[h] = 0.f;
#pragma unroll
                    for (int jq = 0; jq < 4; ++jq) { const f32x4 xv = *(const f32x4*)(args.in[0] + m * DM + jq * 256 + lane * 4);
#pragma unroll
                        for (int e = 0; e < 4; ++e)
#pragma unroll
                            for (int h = 0; h < 8; ++h) acc[h] += xv[e] * w[h][jq * 4 + e]; }
#pragma unroll
                    for (int h = 0; h < 8; ++h) acc[h] = wave_sum(acc[h]);
                    if (lane < 8) { float v = acc[0];
#pragma unroll
                        for (int h = 1; h < 8; ++h) v = (lane == h) ? acc[h] : v;
                        ffl[tl * 8 + lane] = v + fbias[lane]; } }
                __syncthreads();
                {
                    const int h = wid; const int bb = (ch * 128) / SEQ, t0 = (ch * 128) % SEQ; double carry = 0.0;
#pragma unroll
                    for (int half = 0; half < 2; ++half) { double v = (double)logsigmoidf_(ffl[(half * 64 + lane) * 8 + h]);
#pragma unroll
                        for (int o = 1; o < 64; o <<= 1) { const double n = __shfl_up(v, o); if (lane >= o) v += n; }
                        v += carry; LCS[(size_t)(bb * 8 + h) * SEQ + t0 + half * 64 + lane] = v; carry = __shfl(v, 63); }
                    if (lane == 0) TOT[(bb * 8 + h) * 128 + t0 / 128] = carry;
                }
            }
            __syncthreads();
        }
    }
    GRID_BAR();

    for (int l = 0; l < DEPTH; ++l) {
        for (int rep_ = 0; rep_ < REP_A; ++rep_) {
            const int tid = ltid(), lane = tid & 63, wid = __builtin_amdgcn_readfirstlane(tid >> 6); (void)lane; (void)wid;
            pg8::Gemm g{XB, WIN + (size_t)l * PW * DM, T, PW, DM}; pg8::StaticOrder S; S.init(T, PW, G, bx);
            pg8::EpiInProj E{Pb, PW, QC2};
            pg8::gemm_phase<pg8::EpiInProj, pg8::StaticOrder, true, true>((PG8_LAS unsigned char*)lds_raw, g, S, E);
        }
        GRID_BAR();
        for (int rep_ = 0; rep_ < REP_C; ++rep_) {
            const int tid = ltid(), lane = tid & 63, wid = __builtin_amdgcn_readfirstlane(tid >> 6); (void)lane; (void)wid;
            TP_BEGIN(6);
            for (int ch = bx; ch < T / 128; ch += G) {
                const int h = wid; const int bb = (ch * 128) / SEQ, t0 = (ch * 128) % SEQ, ci = t0 / 128;
                double pre = 0.0;
                { const double* tp = TOT + (bb * 8 + h) * 128; double a = (lane < ci) ? tp[lane] : 0.0; a += (lane + 64 < ci) ? tp[lane + 64] : 0.0;
#pragma unroll
                  for (int o = 1; o < 64; o <<= 1) a += __shfl_xor(a, o);
                  pre = a; }
#pragma unroll
                for (int half = 0; half < 2; ++half) { const int t = t0 + half * 64 + lane; const double v = pre + LCS[(size_t)(bb * 8 + h) * SEQ + t];
                    const double bd = -v * 1.4426950408889634; const unsigned h_ = f2bf((float)bd); const double r1 = bd - (double)bf2f((unsigned short)h_);
                    const unsigned m_ = f2bf((float)r1); const double r2 = r1 - (double)bf2f((unsigned short)m_); const unsigned l_ = f2bf((float)r2);
                    *(pg8::u32x4*)(KA + ((size_t)(bb * 8 + h) * SEQ + t) * 16) = (pg8::u32x4){h_ | (m_ << 16), l_ | (0x3f80u << 16), 0x3f803f80u, 0u};
                    if (lane == 63) BE[(bb * 8 + h) * 256 + t / 64] = (float)bd; }
                { LAS unsigned* nrm = (LAS unsigned*)lds_raw;
                  __syncthreads();
                  if (tid < 16) nrm[tid] = 0u;
                  __syncthreads();
                  const int tl = tid >> 2, part = tid & 3; const bf16* prow = Pb + ((size_t)ch * 128 + tl) * PW;
#pragma unroll
                  for (int hq = 0; hq < 2; ++hq) { const int hd = part * 2 + hq;
#pragma unroll
                      for (int qk = 0; qk < 2; ++qk) { const pg8::u32x4* vp = (const pg8::u32x4*)(prow + (qk ? C_FK : C_FQ) + hd * 64); float ss = 0.f;
#pragma unroll
                          for (int v8 = 0; v8 < 8; ++v8) { const pg8::u32x4 wv = vp[v8];
#pragma unroll
                              for (int e = 0; e < 4; ++e) { const float lo_ = __builtin_bit_cast(float, wv[e] << 16), hi_ = __builtin_bit_cast(float, wv[e] & 0xffff0000u); ss += lo_ * lo_ + hi_ * hi_; } }
                          atomicMax((unsigned*)(nrm + qk * 8 + hd), __float_as_uint(ss)); } }
                  __syncthreads();
                  if (tid < 16) { const int hd = tid & 7; ((tid < 8) ? QN2 : KN2)[(bb * 8 + hd) * 128 + ci] = __uint_as_float(nrm[tid]); }
                }
            }
            __syncthreads();
            const ck::RwkvParams rp{args.in[3] + l * 768, args.in[4] + l * 256, args.in[5] + l * 256, args.in[7] + l * 256, args.in[10] + l * 256, args.in[11] + l * 256, args.in[12] + l * 256,
                                    args.in[13] + l * 256, args.in[14] + l * 256, args.in[15] + l * 256,
                                    LWT + (size_t)l * 256 * 64, LWT + (size_t)DEPTH * 256 * 64 + (size_t)l * 256 * 64, LWT + (size_t)2 * DEPTH * 256 * 64 + (size_t)l * 256 * 128};
#ifndef REP_S1
#define REP_S1 1
#endif
#ifndef REP_R1
#define REP_R1 1
#endif
            TP_END(6);
            TP_BEGIN(7);
            for (int rr_ = 0; rr_ < REP_S1; ++rr_)
            for (int it = bx; it < 2048; it += G) ck::rwkv_stage1((CK_LAS unsigned char*)lds_raw, it, Pb, PW, C_RR, C_RK, C_RV, C_WD, SEQ, rp, cw);
            TP_END(7);
            TP_BEGIN(8);
            { const int quad = wid >> 2;
              for (int rr_ = 0; rr_ < REP_R1; ++rr_)
              for (int i0 = bx * 2; i0 < 2048; i0 += G * 2) ck::ret_stage1((CK_LAS unsigned char*)lds_raw + quad * 2 * ck::B9, i0 + quad, Pb, PW, C_TK, C_TV, SEQ, ROPE, cw); }
            TP_END(8);
        }
        GRID_BAR();
        {
            const int tid = ltid(), lane = tid & 63, wid = __builtin_amdgcn_readfirstlane(tid >> 6); (void)lane; (void)wid;
            const int quad = wid >> 2;
#ifndef REP_S
#define REP_S 1
#endif
            TP_BEGIN(1);
            for (int rep_ = 0; rep_ < REP_S; ++rep_) {
            if (bx < 128) {
                ck::rwkv_level1((CK_LAS unsigned char*)lds_raw, 2 * bx + quad, cw);
                asm volatile("s_waitcnt vmcnt(0)" ::: "memory"); __syncthreads();
                if (tid == 0) { __builtin_amdgcn_fence(__ATOMIC_RELEASE, "agent"); asm volatile("s_waitcnt vmcnt(0)" ::: "memory");
                                __hip_atomic_fetch_add(ctl + CW_L1 + 64 * (16 * l + (bx >> 4)), 2u, __ATOMIC_RELAXED, __HIP_MEMORY_SCOPE_AGENT); }
            }
            if (bx >= 128) {
                ck::ret_level1(2 * (bx - 128) + quad, cw);
                asm volatile("s_waitcnt vmcnt(0)" ::: "memory"); __syncthreads();
                if (tid == 0) { __builtin_amdgcn_fence(__ATOMIC_RELEASE, "agent"); asm volatile("s_waitcnt vmcnt(0)" ::: "memory");
                                __hip_atomic_fetch_add(ctl + CW_L1 + 64 * (16 * l + 8 + ((bx - 128) >> 4)), 2u, __ATOMIC_RELAXED, __HIP_MEMORY_SCOPE_AGENT); }
            }
            if (bx < 8) {
                if (wid == 0) { unsigned spins = 0;
                    while (__hip_atomic_load(ctl + CW_L1 + 64 * (16 * l + bx), __ATOMIC_RELAXED, __HIP_MEMORY_SCOPE_AGENT) < 32u) { if (++spins > (1u << 22)) break; __builtin_amdgcn_s_sleep(2); }
                    __builtin_amdgcn_fence(__ATOMIC_ACQUIRE, "agent"); asm volatile("s_waitcnt vmcnt(0)" ::: "memory"); }
                __syncthreads();
                ck::rwkv_scan<32>((CK_LAS unsigned char*)lds_raw, quad == 0 ? bx : -1, (const ck::bf16_t*)(cw + ck::O_PG), (const ck::bf16_t*)(cw + ck::O_QG), (ck::bf16_t*)(cw + ck::O_HG));
            }
            else if (bx < 16) {
                if (wid == 0) { unsigned spins = 0;
                    while (__hip_atomic_load(ctl + CW_L1 + 64 * (16 * l + bx), __ATOMIC_RELAXED, __HIP_MEMORY_SCOPE_AGENT) < 32u) { if (++spins > (1u << 22)) break; __builtin_amdgcn_s_sleep(2); }
                    __builtin_amdgcn_fence(__ATOMIC_ACQUIRE, "agent"); asm volatile("s_waitcnt vmcnt(0)" ::: "memory"); }
                __syncthreads();
                if (quad == 0) ck::ret_scan_groups(bx - 8, cw);
            }
            if (bx < 16) {
                asm volatile("s_waitcnt vmcnt(0)" ::: "memory"); __syncthreads();
                if (tid == 0) { __builtin_amdgcn_fence(__ATOMIC_RELEASE, "agent"); asm volatile("s_waitcnt vmcnt(0)" ::: "memory");
                                __hip_atomic_store(ctl + CW_SF + 64 * (16 * l + bx), 1u, __ATOMIC_RELAXED, __HIP_MEMORY_SCOPE_AGENT); }
            }
            }
            __syncthreads();
            TP_END(1);
            const attn_body::AttnTensors AT{(const attn_body::bf16*)(Pb + C_FQ), (const attn_body::bf16*)(Pb + C_FK), (const attn_body::bf16*)(Pb + C_FV), (attn_body::bf16*)MIXB, KA};
            bool cvdone = false;
#ifndef REP_D
#define REP_D 1
#endif
            for (int apass = 0; apass < 2; ++apass) {
            if (apass == 1) {
            __syncthreads();
            TP_BEGIN(4);
            if (wid == 0) {
                unsigned spins = 0;
                for (;;) { const unsigned f = lane < 16 ? __hip_atomic_load(ctl + CW_SF + 64 * (16 * l + lane), __ATOMIC_RELAXED, __HIP_MEMORY_SCOPE_AGENT) : 1u;
                    if (__all(f != 0u)) break; if (++spins > (1u << 22)) break; __builtin_amdgcn_s_sleep(2); }
                __builtin_amdgcn_fence(__ATOMIC_ACQUIRE, "agent"); asm volatile("s_waitcnt vmcnt(0)" ::: "memory");
            }
            __syncthreads();
            TP_END(4);
            TP_BEGIN(5);
            const ck::RwkvParams rp{args.in[3] + l * 768, args.in[4] + l * 256, args.in[5] + l * 256, args.in[7] + l * 256, args.in[10] + l * 256, args.in[11] + l * 256, args.in[12] + l * 256,
                                    args.in[13] + l * 256, args.in[14] + l * 256, args.in[15] + l * 256, nullptr, nullptr, nullptr};
            for (;;) {
                if (tid == 0) MISC[16] = atomicAdd(ctl + CW_EQ + 64 * l, 1u);
                __syncthreads();
                const int p = (int)MISC[16];
                __syncthreads();
                if (p >= 128 + 128) break;
                if (p < 128) ck::rwkv_stage3g((CK_LAS unsigned char*)lds_raw + quad * ck::L_RW3, 2 * p + quad, rp, cw, MIXB, SEQ);
                else ck::ret_stage3g((CK_LAS unsigned char*)lds_raw + quad * ck::L_RET3G, 2 * (p - 128) + quad, Pb, PW, C_TQ, C_TK, C_TV, C_TG, SEQ, ROPE, args.in[15] + l * 256, cw, MIXB);
            }
            __syncthreads();
            TP_END(5);
            }
            for (int rd_ = 0; rd_ < REP_D; ++rd_)
            for (int gtry = 0; gtry < 8; ++gtry) {
                int grp = (bx + gtry) & 7;
                if (apass == 0) { if (gtry >= 4) continue; const int k_ = bx & 7, g0 = (k_ & 4) ? 7 : 3, g2 = (k_ & 2) ? 6 : 2; grp = gtry == 0 ? g0 : gtry == 1 ? (g0 ^ 4) : gtry == 2 ? g2 : (g2 ^ 4); }
                else if ((grp & 3) >= 2) continue;
                unsigned* qh = ctl + (rd_ ? 20480 : CW_Q) + 64 * (8 * l + grp);
                for (;;) {
                    TP_BEGIN(2);
                    if (tid == 0) MISC[16] = atomicAdd(qh, 1u);
                    __syncthreads();
                    const unsigned idx = MISC[16];
                    if (idx >= 128u) { __syncthreads(); TP_END(2); break; }
                    const int qb = 63 - (int)(idx >> 1), bh = 2 * grp + (int)(idx & 1);
                    if (wid == 0) {
                        const float qn = sqrtf(fmaxf(QN2[bh * 128 + 2 * qb], QN2[bh * 128 + 2 * qb + 1])) * 1.001f;
                        const float kq = sqrtf(fmaxf(KN2[bh * 128 + 2 * qb], KN2[bh * 128 + 2 * qb + 1]));
                        const int ntq = 4 * qb;
                        const float bref = ntq > 0 ? BE[bh * 256 + ntq - 1] : 0.f;
                        float run = 0.f; int nsk = 0;
#pragma unroll
                        for (int q4 = 0; q4 < 4; ++q4) { const int tt = q4 * 64 + lane; const bool in = tt < ntq;
                            float ms = in ? 64.0f * __builtin_amdgcn_exp2f(fminf(qn * (sqrtf(KN2[bh * 128 + (tt >> 1)]) + kq) - (bref - BE[bh * 256 + tt]), 60.0f)) : 0.f;
#pragma unroll
                            for (int o = 1; o < 64; o <<= 1) { const float n_ = __shfl_up(ms, o); if (lane >= o) ms += n_; }
                            ms += run; run = __shfl(ms, 63);
                            nsk += __popcll(__ballot(in && ms <= 6.1035156e-5f)); }
                        if (lane == 0) MISC[17] = (unsigned)(nsk & ~1);
                    }
                    __syncthreads();
                    const int t0 = (int)MISC[17];
                    attn_body::attn_unit<8>(bh / attn_body::NHEAD, bh % attn_body::NHEAD, qb, t0, AT.Q, AT.K, AT.V, AT.O, AT.KA, (char*)lds_raw);
                    TP_END(2);
                    TP_BEGIN(3);
                    if (!cvdone) {
                        if (tid == 0) MISC[18] = atomicAdd(ctl + CW_CV, 16u);
                        __syncthreads();
                        const int tk = (int)MISC[18];
                        if (tk >= NCONV) cvdone = true;
                        else { const int t2 = ltid(), lane2 = t2 & 63, wid2 = __builtin_amdgcn_readfirstlane(t2 >> 6);
                            float* scr = lds + wid2 * (64 * 65);
                            _Pragma("clang loop unroll(disable)") for (int q2 = 0; q2 < 2; ++q2) { const int itc = tk + 8 * q2 + wid2; if (itc < NCONV) conv_item(itc, args.in[25], args.in[26], args.in[27], W13, W2, scr, lane2); } }
                        __syncthreads();
                    }
                    TP_END(3);
                }
            }
            }
        }
        GRID_BAR();
        for (int rep_ = 0; rep_ < REP_F; ++rep_) {
            const int tid = ltid(), lane = tid & 63, wid = __builtin_amdgcn_readfirstlane(tid >> 6); (void)lane; (void)wid;
            pg8::Gemm g{MIXB, WOUT + (size_t)l * DM * DM, T, DM, DM}; pg8::StaticOrder S; S.init(T, DM, G, bx);
            pg8::EpiInProj E{YO, DM, 1.0f};
            pg8::gemm_phase<pg8::EpiInProj, pg8::StaticOrder, true, true>((PG8_LAS unsigned char*)lds_raw, g, S, E);
        }
        GRID_BAR();
        {
            const int tid = ltid(), lane = tid & 63, wid = __builtin_amdgcn_readfirstlane(tid >> 6); (void)lane; (void)wid;
            const float* g1 = args.in[17] + l * DM; const float* b1 = args.in[18] + l * DM;
            const float* bg = args.in[22] + l * 4; const float* be = args.in[24] + l * 32;
            unsigned* cnt = ctl + CW_CNT + 64 * 32 * l;
            const bf16* WRh = (const bf16*)(ws + WS_WR) + (size_t)l * 2 * 48 * 1024; const bf16* WRl = WRh + 48 * 1024;
            constexpr int XS = 1032;
            LAS unsigned short* XT = (LAS unsigned short*)lds_raw;
            LAS float* PART = (LAS float*)((LAS unsigned char*)lds_raw + 32 * XS * 2);
            LAS float* LG = PART + 8 * 32 * 48;
            LAS unsigned* LCNT = (LAS unsigned*)(LG + 128 * 48);
            if (tid < 32) LCNT[tid] = 0u;
            pg8::bf16x8 wh[4][3], wl[4][3];
#pragma unroll
            for (int s_ = 0; s_ < 4; ++s_)
#pragma unroll
                for (int nt = 0; nt < 3; ++nt) { const size_t o = (size_t)(16 * nt + (lane & 15)) * 1024 + 128 * wid + 32 * s_ + 8 * (lane >> 4);
                    wh[s_][nt] = *(const pg8::bf16x8*)(WRh + o); wl[s_][nt] = *(const pg8::bf16x8*)(WRl + o); }
            float gg[16], bb[16];
#pragma unroll
            for (int jq = 0; jq < 4; ++jq) { const f32x4 gv = *(const f32x4*)(g1 + jq * 256 + lane * 4), bv = *(const f32x4*)(b1 + jq * 256 + lane * 4);
#pragma unroll
                for (int e = 0; e < 4; ++e) { gg[jq * 4 + e] = gv[e]; bb[jq * 4 + e] = bv[e]; } }
            for (int ch = bx; ch < T / 128; ch += G) {
                for (int blk = 0; blk < 4; ++blk) {
                    const size_t m0 = (size_t)ch * 128 + blk * 32;
                    uint2 xw[4][4], yw[4][4];
#pragma unroll
                    for (int i = 0; i < 4; ++i) { const size_t m = m0 + wid * 4 + i;
#pragma unroll
                        for (int jq = 0; jq < 4; ++jq) { xw[i][jq] = *(const uint2*)(XB + m * DM + jq * 256 + lane * 4); yw[i][jq] = *(const uint2*)(YO + m * DM + jq * 256 + lane * 4); } }
#pragma unroll
                    for (int i = 0; i < 4; ++i) { const int tl = wid * 4 + i; const size_t m = m0 + tl;
                        float v[16]; float sm = 0.f;
#pragma unroll
                        for (int jq = 0; jq < 4; ++jq) { const uint2 a_ = xw[i][jq], c_ = yw[i][jq];
                            const f32x4 xv = (f32x4){__builtin_bit_cast(float, a_.x << 16), __builtin_bit_cast(float, a_.x & 0xffff0000u), __builtin_bit_cast(float, a_.y << 16), __builtin_bit_cast(float, a_.y & 0xffff0000u)};
                            const f32x4 yv = (f32x4){__builtin_bit_cast(float, c_.x << 16), __builtin_bit_cast(float, c_.x & 0xffff0000u), __builtin_bit_cast(float, c_.y << 16), __builtin_bit_cast(float, c_.y & 0xffff0000u)};
#pragma unroll
                            for (int e = 0; e < 4; ++e) { v[jq * 4 + e] = ALPHA * xv[e] + yv[e]; sm += v[jq * 4 + e]; } }
                        const float mean = wave_sum(sm) * (1.f / DM); float s2 = 0.f;
#pragma unroll
                        for (int q = 0; q < 16; ++q) { v[q] -= mean; s2 += v[q] * v[q]; }
                        const float rstd = 1.0f / sqrtf(wave_sum(s2) * (1.f / DM) + LN_EPS);
#pragma unroll
                        for (int jq = 0; jq < 4; ++jq) { unsigned hw[4];
#pragma unroll
                            for (int e = 0; e < 4; ++e) hw[e] = f2bf(v[jq * 4 + e] * rstd * gg[jq * 4 + e] + bb[jq * 4 + e]);
                            const ck::u32x2 pw = (ck::u32x2){hw[0] | (hw[1] << 16), hw[2] | (hw[3] << 16)};
                            *(uint2*)(XB + m * DM + jq * 256 + lane * 4) = make_uint2(pw.x, pw.y);
                            *(LAS ck::u32x2*)(XT + tl * XS + jq * 256 + lane * 4) = pw; }
                    }
                    __syncthreads();
                    {
                        pg8::f32x4 acc[2][3];
#pragma unroll
                        for (int mt = 0; mt < 2; ++mt)
#pragma unroll
                            for (int nt = 0; nt < 3; ++nt) acc[mt][nt] = pg8::f32x4{0.f, 0.f, 0.f, 0.f};
#pragma unroll
                        for (int s_ = 0; s_ < 4; ++s_)
#pragma unroll
                            for (int mt = 0; mt < 2; ++mt) { const pg8::bf16x8 ax = *(const LAS pg8::bf16x8*)(XT + (16 * mt + (lane & 15)) * XS + 128 * wid + 32 * s_ + 8 * (lane >> 4));
#pragma unroll
                                for (int nt = 0; nt < 3; ++nt) { acc[mt][nt] = __builtin_amdgcn_mfma_f32_16x16x32_bf16(ax, wh[s_][nt], acc[mt][nt], 0, 0, 0); acc[mt][nt] = __builtin_amdgcn_mfma_f32_16x16x32_bf16(ax, wl[s_][nt], acc[mt][nt], 0, 0, 0); } }
#pragma unroll
                        for (int mt = 0; mt < 2; ++mt)
#pragma unroll
                            for (int nt = 0; nt < 3; ++nt)
#pragma unroll
                                for (int r_ = 0; r_ < 4; ++r_) PART[(wid * 32 + 16 * mt + 4 * (lane >> 4) + r_) * 48 + 16 * nt + (lane & 15)] = acc[mt][nt][r_];
                    }
                    __syncthreads();
                    for (int p_ = tid; p_ < 32 * 48; p_ += NTHREADS) { float a_ = 0.f;
#pragma unroll
                        for (int w_ = 0; w_ < 8; ++w_) a_ += PART[w_ * 32 * 48 + p_];
                        LG[blk * 32 * 48 + p_] = a_; }
                }
                __syncthreads();
                int ex0 = 0, ex1 = 0; unsigned lp0 = 0, lp1 = 0;
                if (tid < 128) { const LAS float* lg = LG + tid * 48; const size_t m = (size_t)ch * 128 + tid;
                    int grp = 0; float gbest = lg[0] + bg[0];
#pragma unroll
                    for (int o = 1; o < 4; ++o) { const float gv = lg[o] + bg[o]; if (gv > gbest) { gbest = gv; grp = o; } }
                    float den = 0.f;
#pragma unroll
                    for (int o = 0; o < 4; ++o) den += expf(lg[o] + bg[o] - gbest);
                    const float ggate = 1.0f / den;
                    int i0 = 0; float v0 = lg[4 + grp * 8] + be[grp * 8];
                    for (int o = 1; o < 8; ++o) { const float ev = lg[4 + grp * 8 + o] + be[grp * 8 + o]; if (ev > v0) { v0 = ev; i0 = o; } }
                    int i1 = -1; float v1 = -INFINITY;
                    for (int o = 0; o < 8; ++o) { const float ev = lg[4 + grp * 8 + o] + be[grp * 8 + o]; if (o != i0 && (i1 < 0 || ev > v1)) { v1 = ev; i1 = o; } }
                    const float e1 = expf(v1 - v0); const float p0 = 1.0f / (1.0f + e1), p1 = e1 / (1.0f + e1);
                    ex0 = grp * 8 + i0; ex1 = grp * 8 + i1;
                    lp0 = atomicAdd((unsigned*)(LCNT + ex0), 1u); lp1 = atomicAdd((unsigned*)(LCNT + ex1), 1u);
                    GATE[2 * m] = ggate * p0; GATE[2 * m + 1] = ggate * p1;
                }
                __syncthreads();
                if (tid < 32) { const unsigned c_ = LCNT[tid]; LCNT[32 + tid] = c_ ? atomicAdd(cnt + 64 * tid, c_) : 0u; }
                __syncthreads();
                if (tid < 128) { const size_t m = (size_t)ch * 128 + tid; const int q0 = (int)(LCNT[32 + ex0] + lp0), q1 = (int)(LCNT[32 + ex1] + lp1); EP[2 * m] = (ex0 << 16) | q0; EP[2 * m + 1] = (ex1 << 16) | q1;
                                 LIST[ex0 * LCAP + q0] = (int)m; LIST[ex1 * LCAP + q1] = (int)m; }
                __syncthreads();
                if (tid < 32) LCNT[tid] = 0u;
            }
            {
                __syncthreads();
                TP_BEGIN(9);
                const int endl = (l + 1) * CV_L;
                for (;;) { if (tid == 0) MISC[18] = atomicAdd(ctl + CW_CV, 8u);
                    __syncthreads();
                    const int tk = (int)MISC[18];
                    if (tk + wid < NCONV) conv_item(tk + wid, args.in[25], args.in[26], args.in[27], W13, W2, lds + wid * (64 * 65), lane);
                    __syncthreads();
                    if (tk + 8 >= endl) break; }
                TP_END(9);
            }
        }
        GRID_BAR();
        for (int rep_ = 0; rep_ < REP_IJ; ++rep_) {
            const int tid = ltid(), lane = tid & 63, wid = __builtin_amdgcn_readfirstlane(tid >> 6); (void)lane; (void)wid;
            unsigned* cnt = ctl + CW_CNT + 64 * 32 * l;
            PG8_LAS int* tile_e = (PG8_LAS int*)((PG8_LAS unsigned char*)lds_raw + 131072); PG8_LAS int* tst = tile_e + MAXTILES;
            __syncthreads();
            if (tid == 0) { int acc = 0; for (int e = 0; e < NE; ++e) { tst[e] = acc; acc += ((int)cnt[64 * e] + 255) >> 8; } tst[NE] = acc; }
            __syncthreads();
            const int ntile = tst[NE];
            if (tid < ntile) { int e = 0; while (tst[e + 1] <= tid) ++e; tile_e[tid] = e; }
            __syncthreads();
            pg8::MoeOrder S{ntile, G, bx, tile_e};
            PG8_LAS unsigned* rowoff = (PG8_LAS unsigned*)((PG8_LAS unsigned char*)lds_raw + 133120);
            for (int i = 0; i < 5; ++i) { const int L = i * G + bx; if (L >= ntile * 4) break;
                const int rt = L >> 2, e = tile_e[rt], p_ = (rt - tst[e]) * 256 + (tid & 255);
                if (tid < 256) rowoff[i * 256 + tid] = (p_ < (int)cnt[64 * e]) ? (unsigned)LIST[e * LCAP + p_] * (unsigned)(DM * 2) : 0u; }
            __syncthreads();
            { pg8::Gemm g{XB, W13 + (size_t)l * NE * DM * DM, ntile * 256, DM, DM}; pg8::EpiSwiGlu E{Hb, DE};
              pg8::gemm_phase<pg8::EpiSwiGlu, pg8::MoeOrder, true, true, true>((PG8_LAS unsigned char*)lds_raw, g, S, E, rowoff); }
            GRID_BAR();
            { pg8::Gemm g{Hb, W2 + (size_t)l * NE * DM * DE, ntile * 256, DM, DE}; pg8::EpiInProj E{YP, DM, 1.0f};
              pg8::gemm_phase<pg8::EpiInProj, pg8::MoeOrder, true, true>((PG8_LAS unsigned char*)lds_raw, g, S, E); }
        }
        GRID_BAR();
        for (int rep_ = 0; rep_ < REP_K; ++rep_) { float* Xo = (rep_ == REP_K - 1) ? X : (float*)(ws + WS_XP); bf16* XBo = (rep_ == REP_K - 1) ? XB : (bf16*)(ws + WS_H);
            const int tid = ltid(), lane = tid & 63, wid = __builtin_amdgcn_readfirstlane(tid >> 6); (void)lane; (void)wid;
            const float* g2 = args.in[19] + l * DM; const float* b2 = args.in[20] + l * DM;
            const bool doff = (l + 1 < DEPTH); const int ln = doff ? l + 1 : l;
            const float* wf = args.in[1] + (size_t)ln * DM * INW + O_FF; const float* fbias = args.in[2] + ln * 8;
            LAS f32x4* W4 = (LAS f32x4*)((LAS unsigned char*)lds_raw + 4096);
            __syncthreads();
            for (int q = tid; q < 40 * 64; q += NTHREADS) { const int row = q >> 6, ln_ = q & 63; f32x4 val;
                const int s4 = row & 3, col0 = (s4 >> 1) * 512 + ln_ * 8 + (s4 & 1) * 4;
                if (row < 32) { const int h = row >> 2;
#pragma unroll
                    for (int e = 0; e < 4; ++e) val[e] = wf[(size_t)(col0 + e) * INW + h]; }
                else if (row < 36) val = *(const f32x4*)(g2 + col0);
                else val = *(const f32x4*)(b2 + col0);
                W4[q] = val; }
            float* ffl = lds;
            LAS int* poffK = (LAS int*)((LAS unsigned char*)lds_raw + 49152);
            if (tid == 0) { const unsigned* cnt = ctl + CW_CNT + 64 * 32 * l; int acc = 0; for (int e = 0; e < NE; ++e) { poffK[e] = acc; acc += (((int)cnt[64 * e] + 255) >> 8) << 8; } }
            for (int ch = bx; ch < T / 128; ch += G) {
                __syncthreads();
                const size_t mw = (size_t)ch * 128 + wid * 16;
                const int eA = lane < 16 ? EP[2 * (mw + lane)] : 0, eB = lane < 16 ? EP[2 * (mw + lane) + 1] : 0; const int dA = poffK[eA >> 16] + (eA & 0xffff), dB = poffK[eB >> 16] + (eB & 0xffff);
                const float gA = lane < 16 ? GATE[2 * (mw + lane)] : 0.f, gB = lane < 16 ? GATE[2 * (mw + lane) + 1] : 0.f;
                f32x4 xA[2][4], xB[2][4]; uint2 aA[2][4], aB[2][4], bA[2][4], bB[2][4]; float gA2[2][2], gB2[2][2];
#define K_LOAD(XS, WAS, WBS, GS, IEXP) _Pragma("unroll")                     for (int u = 0; u < 2; ++u) { const size_t m = mw + IEXP + u;                         const size_t da = (size_t)__builtin_amdgcn_readlane(dA, IEXP + u), db = (size_t)__builtin_amdgcn_readlane(dB, IEXP + u);                         GS[u][0] = __builtin_bit_cast(float, __builtin_amdgcn_readlane(__builtin_bit_cast(int, gA), IEXP + u)); GS[u][1] = __builtin_bit_cast(float, __builtin_amdgcn_readlane(__builtin_bit_cast(int, gB), IEXP + u)); _Pragma("unroll")                         for (int j2 = 0; j2 < 2; ++j2) { { const pg8::u32x4 xw_ = *(const pg8::u32x4*)(XB + m * DM + j2 * 512 + lane * 8); XS[u][2 * j2] = (f32x4){__builtin_bit_cast(float, xw_.x << 16), __builtin_bit_cast(float, xw_.x & 0xffff0000u), __builtin_bit_cast(float, xw_.y << 16), __builtin_bit_cast(float, xw_.y & 0xffff0000u)}; XS[u][2 * j2 + 1] = (f32x4){__builtin_bit_cast(float, xw_.z << 16), __builtin_bit_cast(float, xw_.z & 0xffff0000u), __builtin_bit_cast(float, xw_.w << 16), __builtin_bit_cast(float, xw_.w & 0xffff0000u)}; }                             { const pg8::u32x4 wa_ = *(const pg8::u32x4*)(YP + da * DM + j2 * 512 + lane * 8), wb_ = *(const pg8::u32x4*)(YP + db * DM + j2 * 512 + lane * 8); WAS[u][2 * j2] = make_uint2(wa_.x, wa_.y); WAS[u][2 * j2 + 1] = make_uint2(wa_.z, wa_.w); WBS[u][2 * j2] = make_uint2(wb_.x, wb_.y); WBS[u][2 * j2 + 1] = make_uint2(wb_.z, wb_.w); } } }
                { const int i = 0; K_LOAD(xA, aA, bA, gA2, i); }
                for (int i = 0; i < 16; i += 4) {
                    { const int i1 = i + 2; K_LOAD(xB, aB, bB, gB2, i1); }
#pragma unroll
                    for (int u = 0; u < 2; ++u) { const int tl = wid * 16 + i + u; const size_t m = mw + i + u; const float ga = gA2[u][0], gb = gA2[u][1];
                    float v[16]; float s_ = 0.f;
#pragma unroll
                    for (int jq = 0; jq < 4; ++jq) { const uint2 w0 = aA[u][jq], w1 = bA[u][jq];
                        const f32x4 ya = (f32x4){__builtin_bit_cast(float, w0.x << 16), __builtin_bit_cast(float, w0.x & 0xffff0000u), __builtin_bit_cast(float, w0.y << 16), __builtin_bit_cast(float, w0.y & 0xffff0000u)};
                        const f32x4 yb = (f32x4){__builtin_bit_cast(float, w1.x << 16), __builtin_bit_cast(float, w1.x & 0xffff0000u), __builtin_bit_cast(float, w1.y << 16), __builtin_bit_cast(float, w1.y & 0xffff0000u)};
#pragma unroll
                        for (int e = 0; e < 4; ++e) { v[jq * 4 + e] = ALPHA * xA[u][jq][e] + (ga * ya[e] + gb * yb[e]); s_ += v[jq * 4 + e]; } }
                    const float mean = wave_sum(s_) * (1.f / DM); float s2 = 0.f;
#pragma unroll
                    for (int q = 0; q < 16; ++q) { v[q] -= mean; s2 += v[q] * v[q]; }
                    const float rstd = 1.0f / sqrtf(wave_sum(s2) * (1.f / DM) + LN_EPS);
                    float acc[8];
#pragma unroll
                    for (int h = 0; h < 8; ++h) acc[h] = 0.f;
#pragma unroll
                    for (int j2 = 0; j2 < 2; ++j2) { pg8::u32x4 pw;
#pragma unroll
                        for (int hf = 0; hf < 2; ++hf) { const int jq = 2 * j2 + hf; f32x4 ov;
                        const f32x4 gv = W4[(32 + jq) * 64 + lane], bv = W4[(36 + jq) * 64 + lane];
#pragma unroll
                        for (int e = 0; e < 4; ++e) ov[e] = v[jq * 4 + e] * rstd * gv[e] + bv[e];
                        if (doff) {
#pragma unroll
                            for (int h = 0; h < 8; ++h) { const f32x4 wv = W4[(h * 4 + jq) * 64 + lane]; acc[h] += (ov[0] * wv[0] + ov[1] * wv[1]) + (ov[2] * wv[2] + ov[3] * wv[3]); } }
                        if (!doff) *(f32x4*)(Xo + m * DM + j2 * 512 + lane * 8 + hf * 4) = ov;
                        pw[2 * hf] = pk2(ov[0], ov[1]); pw[2 * hf + 1] = pk2(ov[2], ov[3]); }
                        *(pg8::u32x4*)(XBo + m * DM + j2 * 512 + lane * 8) = pw; }
                    if (doff) {
#pragma unroll
                        for (int h = 0; h < 8; ++h) acc[h] = wave_sum(acc[h]);
                        if (lane < 8) { float fv = acc[0];
#pragma unroll
                            for (int h = 1; h < 8; ++h) fv = (lane == h) ? acc[h] : fv;
                            ffl[tl * 8 + lane] = fv + fbias[lane]; } }
                    }

                    if (i + 4 < 16) { const int i2 = i + 4; K_LOAD(xA, aA, bA, gA2, i2); }
#pragma unroll
                    for (int u = 0; u < 2; ++u) { const int tl = wid * 16 + (i + 2) + u; const size_t m = mw + (i + 2) + u; const float ga = gB2[u][0], gb = gB2[u][1];
                    float v[16]; float s_ = 0.f;
#pragma unroll
                    for (int jq = 0; jq < 4; ++jq) { const uint2 w0 = aB[u][jq], w1 = bB[u][jq];
                        const f32x4 ya = (f32x4){__builtin_bit_cast(float, w0.x << 16), __builtin_bit_cast(float, w0.x & 0xffff0000u), __builtin_bit_cast(float, w0.y << 16), __builtin_bit_cast(float, w0.y & 0xffff0000u)};
                        const f32x4 yb = (f32x4){__builtin_bit_cast(float, w1.x << 16), __builtin_bit_cast(float, w1.x & 0xffff0000u), __builtin_bit_cast(float, w1.y << 16), __builtin_bit_cast(float, w1.y & 0xffff0000u)};
#pragma unroll
                        for (int e = 0; e < 4; ++e) { v[jq * 4 + e] = ALPHA * xB[u][jq][e] + (ga * ya[e] + gb * yb[e]); s_ += v[jq * 4 + e]; } }
                    const float mean = wave_sum(s_) * (1.f / DM); float s2 = 0.f;
#pragma unroll
                    for (int q = 0; q < 16; ++q) { v[q] -= mean; s2 += v[q] * v[q]; }
                    const float rstd = 1.0f / sqrtf(wave_sum(s2) * (1.f / DM) + LN_EPS);
                    float acc[8];
#pragma unroll
                    for (int h = 0; h < 8; ++h) acc[h] = 0.f;
#pragma unroll
                    for (int j2 = 0; j2 < 2; ++j2) { pg8::u32x4 pw;
#pragma unroll
                        for (int hf = 0; hf < 2; ++hf) { const int jq = 2 * j2 + hf; f32x4 ov;
                        const f32x4 gv = W4[(32 + jq) * 64 + lane], bv = W4[(36 + jq) * 64 + lane];
#pragma unroll
                        for (int e = 0; e < 4; ++e) ov[e] = v[jq * 4 + e] * rstd * gv[e] + bv[e];
                        if (doff) {
#pragma unroll
                            for (int h = 0; h < 8; ++h) { const f32x4 wv = W4[(h * 4 + jq) * 64 + lane]; acc[h] += (ov[0] * wv[0] + ov[1] * wv[1]) + (ov[2] * wv[2] + ov[3] * wv[3]); } }
                        if (!doff) *(f32x4*)(Xo + m * DM + j2 * 512 + lane * 8 + hf * 4) = ov;
                        pw[2 * hf] = pk2(ov[0], ov[1]); pw[2 * hf + 1] = pk2(ov[2], ov[3]); }
                        *(pg8::u32x4*)(XBo + m * DM + j2 * 512 + lane * 8) = pw; }
                    if (doff) {
#pragma unroll
                        for (int h = 0; h < 8; ++h) acc[h] = wave_sum(acc[h]);
                        if (lane < 8) { float fv = acc[0];
#pragma unroll
                            for (int h = 1; h < 8; ++h) fv = (lane == h) ? acc[h] : fv;
                            ffl[tl * 8 + lane] = fv + fbias[lane]; } }
                    }

                }
#undef K_LOAD
                __syncthreads();
                if (doff) {
                    const int h = wid; const int bb = (ch * 128) / SEQ, t0 = (ch * 128) % SEQ; double carry = 0.0;
#pragma unroll
                    for (int half = 0; half < 2; ++half) { double vv = (double)logsigmoidf_(ffl[(half * 64 + lane) * 8 + h]);
#pragma unroll
                        for (int o = 1; o < 64; o <<= 1) { const double n = __shfl_up(vv, o); if (lane >= o) vv += n; }
                        vv += carry; LCS[(size_t)(bb * 8 + h) * SEQ + t0 + half * 64 + lane] = vv; carry = __shfl(vv, 63); }
                    if (lane == 0) TOT[(bb * 8 + h) * 128 + t0 / 128] = carry;
                }
            }
        }
        if (l + 1 < DEPTH) GRID_BAR();
    }
    if (TPROBE_SEL != 0) { unsigned long long* tsum = (unsigned long long*)(ctl + 200000);
        if (ltid() == 0) atomicAdd(tsum, tp_acc);
        xcd_barrier(bar);
        if (bx == 0 && ltid() == 0) { const unsigned long long tot = __hip_atomic_load(tsum, __ATOMIC_RELAXED, __HIP_MEMORY_SCOPE_AGENT); const unsigned long long waitt = tot * TPROBE_MULT / 256ull; const unsigned long long te = __builtin_amdgcn_s_memrealtime();
            while (__builtin_amdgcn_s_memrealtime() - te < waitt) __builtin_amdgcn_s_sleep(8); } }
}

extern "C" void kernel_launch(void* const* d_in, const int* in_sizes, int n_in, void* d_out, int out_size, void* d_ws, size_t ws_size, hipStream_t stream) {
    static int grid = 0;
    if (grid == 0) {
        if (n_in != 28 || out_size != T * DM || ws_size < WS_END) { fprintf(stderr, "kernel_launch: unexpected shapes (n_in %d out %d ws %zu)\n", n_in, out_size, ws_size); grid = -1; return; }
        int dev = 0, cus = 0, per_cu = 0;
        (void)hipGetDevice(&dev); (void)hipDeviceGetAttribute(&cus, hipDeviceAttributeMultiprocessorCount, dev);
        (void)hipFuncSetAttribute((const void*)mk_fwd, hipFuncAttributeMaxDynamicSharedMemorySize, LDS_ALL);
        if (hipOccupancyMaxActiveBlocksPerMultiprocessor(&per_cu, (const void*)mk_fwd, NTHREADS, LDS_ALL) != hipSuccess || per_cu < 1) fprintf(stderr, "kernel_launch: occupancy query says %d blocks per CU\n", per_cu);
        (void)hipGetLastError();
        grid = cus > 0 ? cus : 256;
        if (grid != 256) fprintf(stderr, "kernel_launch: %d CUs (built for 256)\n", grid);
    }
    if (grid < 0) return;
    (void)hipMemsetAsync((char*)d_ws + WS_CTL, 0, CTL_BYTES, stream);
    Args a{};
    for (int i = 0; i < 28; ++i) a.in[i] = (const float*)d_in[i];
    a.out = (float*)d_out; a.ws = (unsigned char*)d_ws;
    hipLaunchKernelGGL(mk_fwd, dim3(grid), dim3(NTHREADS), LDS_ALL, stream, a);
}
```

```cpp
#include <hip/hip_runtime.h>
#include <cstdio>
#include <cstdint>
#include <cmath>
__device__ __forceinline__ int ltid() { int t = __builtin_amdgcn_workitem_id_x(); asm volatile("" : "+v"(t)); return t; }

constexpr int BATCH = 2, SEQ = 16384, DM = 1024, DEPTH = 4, T = BATCH * SEQ;
constexpr int INW = 3592, PW = 3584;
constexpr int O_FF = 1536;
constexpr int C_FQ = 0, C_FK = 512, C_FV = 1024, C_RR = 1536, C_RK = 1792, C_RV = 2048, C_WD = 2304, C_AD = 2368, C_GD = 2432,
              C_TQ = 2560, C_TK = 2816, C_TV = 3072, C_TG = 3328;
constexpr int NE = 32, DE = 512, A_TOT = T * 2;
constexpr float ALPHA = 1.681792830507429f;
constexpr float LN_EPS = 1e-5f, RWKV_GN_EPS = 64e-5f, RET_GN_EPS = 1e-6f;
constexpr float QC2 = 0.125f * 1.4426950408889634f;
constexpr int NTHREADS = 512;
#ifndef REP_P0
#define REP_P0 1
#endif
#ifndef REP_A
#define REP_A 1
#endif
#ifndef REP_C
#define REP_C 1
#endif
#ifndef REP_E
#define REP_E 1
#endif
#ifndef REP_F
#define REP_F 1
#endif
#ifndef REP_H
#define REP_H 1
#endif
#ifndef REP_IJ
#define REP_IJ 1
#endif
#ifndef REP_G
#define REP_G 1
#endif
#ifndef REP_K
#define REP_K 1
#endif
constexpr int LDS_MISC = 147456, LDS_ALL = 148480;

constexpr size_t MiB = 1u << 20;
constexpr size_t WS_CTL = 0, CTL_BYTES = 1 * MiB;
constexpr size_t WS_EP = 1 * MiB;
constexpr size_t WS_DEST = 2 * MiB;
constexpr size_t WS_GATE = 9 * MiB;
constexpr size_t WS_ROPE = 11 * MiB;
constexpr size_t WS_RKD = 15 * MiB;
constexpr size_t WS_WIN = 16 * MiB;
constexpr size_t WS_WOUT = 44 * MiB;
constexpr size_t WS_W13 = 52 * MiB;
constexpr size_t WS_W2 = 308 * MiB;
constexpr size_t WS_XB = 436 * MiB;
constexpr size_t WS_P = 500 * MiB;
constexpr size_t WS_MIXB = 724 * MiB;
constexpr size_t WS_CK = 788 * MiB;
constexpr size_t WS_LW = 3 * MiB;
constexpr size_t WS_YO = 788 * MiB;
constexpr size_t WS_XP = 500 * MiB;
constexpr int LCAP = 32768;
constexpr size_t WS_H = 644 * MiB;
constexpr size_t WS_YP = 716 * MiB;
constexpr size_t WS_LCS = 1012 * MiB;
constexpr size_t WS_KA = 1014 * MiB;
constexpr size_t WS_END = 1018 * MiB;
constexpr size_t WS_WR = 5 * MiB;
constexpr size_t WS_SKIP = 4 * MiB + 65536;
constexpr size_t WS_TOT = 4 * MiB;
constexpr int CW_CNT = 32768;
constexpr int CW_Q = 2048;
constexpr int CW_L1 = 20480;
constexpr int CW_SF = 12288;
constexpr int CW_EQ = 4096;
constexpr int CW_CV = 6144;
constexpr int CW_BAR = 8192;
constexpr int MAXTILES = 288;

typedef float f32x16 __attribute__((ext_vector_type(16)));
typedef unsigned short bf16;

struct Args {
    const float* in[28]; float* out; unsigned char* ws;
};

__device__ __forceinline__ float sigmoidf_(float x) { return 1.0f / (1.0f + expf(-x)); }
__device__ __forceinline__ float logsigmoidf_(float x) { return x >= 0.f ? -log1pf(expf(-x)) : x - log1pf(expf(x)); }
__device__ __forceinline__ float wave_sum(float v) {
#define WS_DPP(ctrl, rmask) v += __builtin_bit_cast(float, __builtin_amdgcn_update_dpp(0, __builtin_bit_cast(int, v), ctrl, rmask, 0xf, false))
    WS_DPP(0x111, 0xf); WS_DPP(0x112, 0xf); WS_DPP(0x114, 0xf); WS_DPP(0x118, 0xf); WS_DPP(0x142, 0xa); WS_DPP(0x143, 0xc);
#undef WS_DPP
    return __builtin_bit_cast(float, __builtin_amdgcn_readlane(__builtin_bit_cast(int, v), 63));
}
typedef float f32x2hw __attribute__((ext_vector_type(2))); typedef __bf16 bf16x2hw __attribute__((ext_vector_type(2)));
__device__ __forceinline__ unsigned pk2(float lo, float hi) { f32x2hw v = {lo, hi}; bf16x2hw b = __builtin_convertvector(v, bf16x2hw); return __builtin_bit_cast(unsigned, b); }
__device__ __forceinline__ unsigned f2bf(float f) { return pk2(f, 0.f) & 0xffffu; }
__device__ __forceinline__ float bf2f(unsigned short b) { return __builtin_bit_cast(float, (unsigned)b << 16); }
__device__ __forceinline__ float pf(const bf16* Pb, size_t m, int c) { return bf2f(Pb[m * PW + c]); }

namespace pg8 {
#define PG8_LAS __attribute__((address_space(3)))
typedef unsigned short bf16_t;
typedef short bf16x8 __attribute__((ext_vector_type(8)));
typedef float f32x4 __attribute__((ext_vector_type(4)));
typedef unsigned u32x4 __attribute__((ext_vector_type(4)));
constexpr int BM = 256, BK = 64, HALF = 128, HTB = HALF * BK * 2  , STAGE_BYTES = 8 * HTB, NXCD = 8, WGM = 8;

__host__ __device__ __forceinline__ int lds_byte(int r, int c) { const int st = (r >> 4) * 2 + (c >> 5), rr = r & 15, cc = c & 31, ob = rr * 64 + cc * 2; return st * 1024 + (ob ^ (((ob >> 9) & 1) << 5)); }
__host__ __device__ __forceinline__ void stage_rc(int b, int& R, int& C) { const int st = b / 1024, sb = b % 1024, swz = sb ^ (((sb >> 9) & 1) << 5); R = (st >> 1) * 16 + swz / 64; C = (st & 1) * 32 + (swz % 64) / 2; }
__host__ __device__ __forceinline__ int perm32(int rho) { const int n = rho >> 4, i = rho & 15; return 8 * (i >> 2) + 4 * n + (i & 3); }

struct Unit { int pm, pn, pc; };
struct Gemm { const bf16_t* A; const bf16_t* Bt; int M, N, K; };

struct StaticOrder {
    int nM, nN, nwg, G, c;
    __host__ __device__ void init(int M, int N, int G_, int c_) { nM = M / BM; nN = N / BM; nwg = nM * nN; G = G_; c = c_; }
    __host__ __device__ bool next(int i, Unit& u) const {
        const long L = (long)i * G + c; if (L >= nwg) return false;
        int wgid = (int)L; { const int q = nwg / NXCD, r = nwg % NXCD, xcd = wgid % NXCD, off = wgid / NXCD; wgid = (xcd < r ? xcd * (q + 1) : r * (q + 1) + (xcd - r) * q) + off; }
        const int nig = WGM * nN, gid = wgid / nig, fm = gid * WGM, gsz = (nM - fm) < WGM ? (nM - fm) : WGM;
        u.pm = fm + ((wgid % nig) % gsz); u.pn = (wgid % nig) / gsz; u.pc = u.pn; return true;
    }
    __device__ __forceinline__ void a_ready(const Unit&) const {}
    __device__ __forceinline__ void done(const Unit&) const {}
};

__device__ __forceinline__ unsigned cvt_pk_bf16(float lo, float hi) { unsigned r; asm volatile("v_cvt_pk_bf16_f32 %0, %1, %2" : "=v"(r) : "v"(lo), "v"(hi)); return r; }

struct EpiF32 {
    static constexpr bool PERM = false, AFTER_DRAIN = false;
    float* O; int ldc;
    __device__ __forceinline__ void operator()(const f32x4 (&acc)[2][2][4][2], const Unit& u, int wr, int wc, int fr, int fq) const {
        const int row0 = u.pm * BM + wr * 64 + fr; const int col0 = u.pc * BM + wc * 32 + 4 * fq;
#pragma unroll
        for (int ai = 0; ai < 2; ++ai)
#pragma unroll
            for (int m = 0; m < 4; ++m) { float* rowp = O + (size_t)(row0 + ai * HALF + m * 16) * ldc + col0;
#pragma unroll
                for (int bj = 0; bj < 2; ++bj)
#pragma unroll
                    for (int n = 0; n < 2; ++n) *(f32x4*)(rowp + bj * HALF + n * 16) = acc[ai][bj][m][n]; }
    }
};
struct EpiSwiGlu {
    static constexpr bool PERM = true, AFTER_DRAIN = false;
    bf16_t* O; int ldc;
    __device__ __forceinline__ static float silu(float v) { return v * __builtin_amdgcn_rcpf(1.0f + __builtin_amdgcn_exp2f(-1.4426950408889634f * v)); }
    __device__ __forceinline__ void operator()(const f32x4 (&acc)[2][2][4][2], const Unit& u, int wr, int wc, int fr, int fq) const {
        const int row0 = u.pm * BM + wr * 64 + fr; const int col0 = u.pc * HALF + wc * 32 + 8 * fq;
#pragma unroll
        for (int ai = 0; ai < 2; ++ai)
#pragma unroll
            for (int m = 0; m < 4; ++m) { bf16_t* rowp = O + (size_t)(row0 + ai * HALF + m * 16) * ldc + col0;
                f32x4 h0, h1;
#pragma unroll
                for (int e = 0; e < 4; ++e) { h0[e] = silu(acc[ai][0][m][0][e]) * acc[ai][1][m][0][e]; h1[e] = silu(acc[ai][0][m][1][e]) * acc[ai][1][m][1][e]; }
                u32x4 w; w.x = cvt_pk_bf16(h0[0], h0[1]); w.y = cvt_pk_bf16(h0[2], h0[3]); w.z = cvt_pk_bf16(h1[0], h1[1]); w.w = cvt_pk_bf16(h1[2], h1[3]);
                *(u32x4*)rowp = w; }
    }
};
struct MoeOrder {
    int ntile, G, c; const PG8_LAS int* tile_e;
    __device__ __forceinline__ bool next(int i, Unit& u) const { const int L = i * G + c; if (L >= ntile * 4) return false; const int rt = L >> 2, pn = L & 3; u.pm = rt; u.pn = tile_e[rt] * 4 + pn; u.pc = pn; return true; }
    __device__ __forceinline__ void a_ready(const Unit&) const {}
    __device__ __forceinline__ void done(const Unit&) const {}
};
struct EpiInProj {
    static constexpr bool PERM = true, AFTER_DRAIN = false;
    bf16_t* O; int ldc; float qscale;
    __device__ __forceinline__ void operator()(const f32x4 (&acc)[2][2][4][2], const Unit& u, int wr, int wc, int fr, int fq) const {
        const int row0 = u.pm * BM + wr * 64 + fr; const int col0 = u.pc * BM + wc * 32 + 8 * fq;
        const float sc = (u.pc < 2) ? qscale : 1.f;
#pragma unroll
        for (int ai = 0; ai < 2; ++ai)
#pragma unroll
            for (int m = 0; m < 4; ++m) { bf16_t* rowp = O + (size_t)(row0 + ai * HALF + m * 16) * ldc + col0;
#pragma unroll
                for (int bj = 0; bj < 2; ++bj) { const f32x4 v0 = acc[ai][bj][m][0] * sc, v1 = acc[ai][bj][m][1] * sc;
                    u32x4 w; w.x = cvt_pk_bf16(v0[0], v0[1]); w.y = cvt_pk_bf16(v0[2], v0[3]); w.z = cvt_pk_bf16(v1[0], v1[1]); w.w = cvt_pk_bf16(v1[2], v1[3]);
                    *(u32x4*)(rowp + bj * HALF) = w; } }
    }
};
template <class Epi, class Sched, bool ALIGN_EPI = false, bool SP2 = false, bool GATHER = false>
__device__ __forceinline__ void gemm_phase(PG8_LAS unsigned char* lds, const Gemm g, const Sched& S, const Epi& E, const PG8_LAS unsigned* rowoff = nullptr) {
    static_assert(!GATHER || SP2, "GATHER is written for the SP2 loop only");
    const int tid = ltid(), wid = __builtin_amdgcn_readfirstlane(tid >> 6), lane = tid & 63, wr = wid >> 2, wc = wid & 3, fr = lane & 15, fq = lane >> 4;
    const int K = g.K, nt = K / BK;
    unsigned voffA[2], voffB[2];
#pragma unroll
    for (int i = 0; i < 2; ++i) { int R, C; stage_rc(tid * 16 + i * 8192, R, C); const int Rb = Epi::PERM ? ((R & ~31) + perm32(R & 31)) : R;
        voffA[i] = GATHER ? ((unsigned)(R * 4) | ((unsigned)(C * 2) << 16)) : (unsigned)(R * K + C) * 2u; voffB[i] = (unsigned)(Rb * K + C) * 2u; }
    unsigned vc[2][2];
#define PG8_GLOAD(dst, u_) do { _Pragma("unroll") for (int h_ = 0; h_ < 2; ++h_) _Pragma("unroll") for (int i_ = 0; i_ < 2; ++i_) \
        dst[h_][i_] = *(const PG8_LAS unsigned*)((const PG8_LAS unsigned char*)rowoff + (u_) * 1024 + h_ * 512 + (voffA[i_] & 0xffffu)) + (voffA[i_] >> 16); } while (0)
#define PG8_STAGE_A(bufoff, gbase, H, VG) do { if constexpr (GATHER) PG8_STAGE(bufoff, gbase, VG[H]); else PG8_STAGE(bufoff, (gbase) + (H) * hstep, voffA); } while (0)
    const size_t kstep = (size_t)(BK * 2);
    const size_t hstep = (size_t)HALF * K * 2;
    const size_t tstep = 2 * hstep;
    const unsigned ldsw = (unsigned)wid * 1024u;
    const int aoff = lds_byte(wr * 64 + fr, fq * 8), boff = lds_byte(wc * 32 + fr, fq * 8);
#define PG8_SA(b, h) (((b) * 2 + (h)) * HTB)
#define PG8_SB(b, h) ((4 + (b) * 2 + (h)) * HTB)
#define PG8_STAGE(bufoff, gbase, voff) do { _Pragma("unroll") for (int _i = 0; _i < 2; ++_i) \
        __builtin_amdgcn_global_load_lds((const unsigned*)((const char*)(gbase) + (voff)[_i]), (PG8_LAS unsigned*)(lds + (bufoff) + ldsw + _i * 8192), 16, 0, 0); } while (0)
#define PG8_LDA(dst, b, h) do { _Pragma("unroll") for (int m = 0; m < 4; ++m) _Pragma("unroll") for (int k = 0; k < 2; ++k) dst[m][k] = *(const PG8_LAS bf16x8*)(lds + PG8_SA(b, h) + aoff + m * 2048 + k * 1024); } while (0)
#define PG8_LDB(dst, b, h) do { _Pragma("unroll") for (int n = 0; n < 2; ++n) _Pragma("unroll") for (int k = 0; k < 2; ++k) dst[n][k] = *(const PG8_LAS bf16x8*)(lds + PG8_SB(b, h) + boff + n * 2048 + k * 1024); } while (0)
#define PG8_MMA(ai, bj, At, Bt) do { __builtin_amdgcn_s_setprio(1); _Pragma("unroll") for (int m = 0; m < 4; ++m) _Pragma("unroll") for (int n = 0; n < 2; ++n) _Pragma("unroll") for (int k = 0; k < 2; ++k) \
        acc[ai][bj][m][n] = __builtin_amdgcn_mfma_f32_16x16x32_bf16(Bt[n][k], At[m][k], acc[ai][bj][m][n], 0, 0, 0); __builtin_amdgcn_s_setprio(0); } while (0)
#define PG8_WAIT_V(n) asm volatile("s_waitcnt vmcnt(" #n ")" ::: "memory")
#define PG8_WAIT_L(n) asm volatile("s_waitcnt lgkmcnt(" #n ")" ::: "memory")
#define PG8_BAR __builtin_amdgcn_s_barrier()
#define PG8_SCHED __builtin_amdgcn_sched_barrier(0)
    Unit cur, nxt; int ui = 0;
    if (!S.next(0, cur)) return;
    f32x4 acc[2][2][4][2];
#pragma unroll
    for (int a = 0; a < 2; ++a)
#pragma unroll
        for (int b = 0; b < 2; ++b)
#pragma unroll
            for (int m = 0; m < 4; ++m)
#pragma unroll
                for (int n = 0; n < 2; ++n) acc[a][b][m][n] = (f32x4){0.f, 0.f, 0.f, 0.f};
    bf16x8 At[4][2], B0[2][2], B1[2][2];
    const char* cA = (const char*)g.A + (GATHER ? (size_t)0 : (size_t)cur.pm * tstep); const char* cB = (const char*)g.Bt + (size_t)cur.pn * tstep;
    S.a_ready(cur);
    if constexpr (GATHER) PG8_GLOAD(vc, 0);
    if constexpr (SP2) {
        PG8_STAGE(PG8_SB(0, 0), cB, voffB); PG8_STAGE(PG8_SB(0, 1), cB + hstep, voffB); PG8_STAGE_A(PG8_SA(0, 0), cA, 0, vc); PG8_STAGE_A(PG8_SA(0, 1), cA, 1, vc);
        if (wr == 1) PG8_BAR;
        PG8_WAIT_V(2); PG8_BAR;
        PG8_STAGE(PG8_SB(1, 0), cB + kstep, voffB); PG8_STAGE_A(PG8_SA(1, 0), cA + kstep, 0, vc); PG8_STAGE(PG8_SB(1, 1), cB + hstep + kstep, voffB);
        PG8_WAIT_V(6); PG8_BAR;
    } else {
        PG8_STAGE(PG8_SB(0, 0), cB, voffB); PG8_STAGE(PG8_SA(0, 0), cA, voffA); PG8_STAGE(PG8_SB(0, 1), cB + hstep, voffB); PG8_STAGE(PG8_SA(0, 1), cA + hstep, voffA);
        if (wr == 1) PG8_BAR;
        PG8_WAIT_V(4); PG8_BAR;
        PG8_STAGE(PG8_SB(1, 0), cB + kstep, voffB); PG8_STAGE(PG8_SA(1, 0), cA + kstep, voffA); PG8_STAGE(PG8_SB(1, 1), cB + hstep + kstep, voffB);
        PG8_WAIT_V(6); PG8_BAR;
    }
    for (;;) {
        const bool has_next = S.next(ui + 1, nxt);
        const char* nA = (has_next && !GATHER) ? (const char*)g.A + (size_t)nxt.pm * tstep : cA; const char* nB = has_next ? (const char*)g.Bt + (size_t)nxt.pn * tstep : cB;
        for (int t = 0; t < nt; t += 2) {
            const bool last = (t == nt - 2);
            const char* a1 = cA + (size_t)(t + 1) * kstep;
            const char* a2 = last ? nA : cA + (size_t)(t + 2) * kstep; const char* b2 = last ? nB : cB + (size_t)(t + 2) * kstep;
            const char* a3 = a2 + kstep; const char* b3 = b2 + kstep;
            if (last && has_next) S.a_ready(nxt);
            if constexpr (SP2) {
            PG8_LDB(B0, 0, 0); PG8_LDB(B1, 0, 1); PG8_SCHED; PG8_LDA(At, 0, 0); PG8_STAGE_A(PG8_SA(1, 1), a1, 1, vc);
            if constexpr (GATHER) { if (last && has_next) PG8_GLOAD(vc, ui + 1); }
            PG8_WAIT_V(8); PG8_WAIT_L(0); PG8_BAR; PG8_MMA(0, 0, At, B0); PG8_MMA(0, 1, At, B1); PG8_BAR; PG8_SCHED;
            PG8_LDA(At, 0, 1); PG8_STAGE(PG8_SB(0, 0), b2, voffB); PG8_STAGE(PG8_SB(0, 1), b2 + hstep, voffB); PG8_STAGE_A(PG8_SA(0, 0), a2, 0, vc);
            PG8_WAIT_V(8); PG8_WAIT_L(0); PG8_BAR; PG8_MMA(1, 0, At, B0); PG8_MMA(1, 1, At, B1); PG8_BAR; PG8_SCHED;
            PG8_LDB(B0, 1, 0); PG8_LDB(B1, 1, 1); PG8_SCHED; PG8_LDA(At, 1, 0); PG8_STAGE_A(PG8_SA(0, 1), a2, 1, vc);
            PG8_WAIT_V(8); PG8_WAIT_L(0); PG8_BAR; PG8_MMA(0, 0, At, B0); PG8_MMA(0, 1, At, B1); PG8_BAR; PG8_SCHED;
            PG8_LDA(At, 1, 1); PG8_STAGE(PG8_SB(1, 0), b3, voffB); PG8_STAGE(PG8_SB(1, 1), b3 + hstep, voffB); PG8_STAGE_A(PG8_SA(1, 0), a3, 0, vc);
            PG8_WAIT_V(8); PG8_WAIT_L(0); PG8_BAR; PG8_MMA(1, 0, At, B0); PG8_MMA(1, 1, At, B1); PG8_BAR; PG8_SCHED;
            } else {
            PG8_LDB(B0, 0, 0); PG8_SCHED; PG8_LDA(At, 0, 0); PG8_STAGE(PG8_SA(1, 1), a1 + hstep, voffA);
            PG8_WAIT_L(8); PG8_BAR; PG8_WAIT_L(0); PG8_MMA(0, 0, At, B0); PG8_BAR; PG8_SCHED;
            PG8_LDB(B1, 0, 1); PG8_STAGE(PG8_SB(0, 0), b2, voffB);
            PG8_BAR; PG8_WAIT_L(0); PG8_MMA(0, 1, At, B1); PG8_BAR;
            PG8_LDA(At, 0, 1); PG8_STAGE(PG8_SA(0, 0), a2, voffA);
            PG8_BAR; PG8_WAIT_L(0); PG8_MMA(1, 0, At, B0); PG8_BAR; PG8_SCHED;
            PG8_STAGE(PG8_SB(0, 1), b2 + hstep, voffB);
            PG8_WAIT_V(6); PG8_BAR; PG8_MMA(1, 1, At, B1); PG8_BAR;
            PG8_LDB(B0, 1, 0); PG8_SCHED; PG8_LDA(At, 1, 0); PG8_STAGE(PG8_SA(0, 1), a2 + hstep, voffA);
            PG8_WAIT_L(8); PG8_BAR; PG8_WAIT_L(0); PG8_MMA(0, 0, At, B0); PG8_BAR; PG8_SCHED;
            PG8_LDB(B1, 1, 1); PG8_STAGE(PG8_SB(1, 0), b3, voffB);
            PG8_BAR; PG8_WAIT_L(0); PG8_MMA(0, 1, At, B1); PG8_BAR;
            PG8_LDA(At, 1, 1); PG8_STAGE(PG8_SA(1, 0), a3, voffA);
            PG8_BAR; PG8_WAIT_L(0); PG8_MMA(1, 0, At, B0); PG8_BAR; PG8_SCHED;
            PG8_STAGE(PG8_SB(1, 1), b3 + hstep, voffB);
            PG8_WAIT_V(6); PG8_BAR; PG8_MMA(1, 1, At, B1); PG8_BAR;
            }
        }
        if constexpr (ALIGN_EPI) { if (wr == 0) PG8_BAR; }
        if constexpr (!Epi::AFTER_DRAIN) { E(acc, cur, wr, wc, fr, fq); S.done(cur); }
        if (!has_next) break;
#pragma unroll
        for (int a = 0; a < 2; ++a)
#pragma unroll
            for (int b = 0; b < 2; ++b)
#pragma unroll
                for (int m = 0; m < 4; ++m)
#pragma unroll
                    for (int n = 0; n < 2; ++n) acc[a][b][m][n] = (f32x4){0.f, 0.f, 0.f, 0.f};
        cur = nxt; cA = nA; cB = nB; ++ui;
        if constexpr (ALIGN_EPI) { if (wr == 1) PG8_BAR; }
    }
    PG8_WAIT_V(0);
    if constexpr (!ALIGN_EPI) { if (wr == 0) PG8_BAR; }
    PG8_BAR;
    if constexpr (Epi::AFTER_DRAIN) { E.fused(acc, cur, wr, wc, fr, fq, lds, wid, lane); S.done(cur); }
#undef PG8_SA
#undef PG8_SB
#undef PG8_STAGE
#undef PG8_STAGE_A
#undef PG8_GLOAD
#undef PG8_LDA
#undef PG8_LDB
#undef PG8_MMA
#undef PG8_WAIT_V
#undef PG8_WAIT_L
#undef PG8_BAR
#undef PG8_SCHED
}
}

template <class RowMap, class Epi>
__device__ __forceinline__ void gemm_tile_f32(float* lds, const float* __restrict__ A, int lda, RowMap rowmap, int nvalid,
                                              const float* __restrict__ B, int ldb, int col0, int N, int K, Epi epi) {
    float* As = lds;
    float* Bs = lds + 128 * 17;
    const int tid = ltid(), lane = tid & 63, wid = tid >> 6, wm = wid & 3, wn = wid >> 2;
    const int arow = tid >> 2, akq = (tid & 3) * 4;
    const int src = (arow < nvalid) ? rowmap(arow) : -1;
    const float* ap = A + (size_t)(src < 0 ? 0 : src) * lda + akq;
    const int bk = tid >> 5, bn = (tid & 31) * 4;
    const bool bok = (col0 + bn) < N;
    const float* bp = B + (size_t)bk * ldb + col0 + bn;
    f32x16 acc0 = {}, acc1 = {};
    for (int k0 = 0; k0 < K; k0 += 16) {
        pg8::f32x4 av = (pg8::f32x4){0.f, 0.f, 0.f, 0.f}, bv = (pg8::f32x4){0.f, 0.f, 0.f, 0.f};
        if (src >= 0) av = *(const pg8::f32x4*)(ap + k0);
        if (bok) bv = *(const pg8::f32x4*)(bp + (size_t)k0 * ldb);
        __syncthreads();
        As[arow * 17 + akq + 0] = av[0]; As[arow * 17 + akq + 1] = av[1]; As[arow * 17 + akq + 2] = av[2]; As[arow * 17 + akq + 3] = av[3];
        *(pg8::f32x4*)(Bs + bk * 132 + bn) = bv;
        __syncthreads();
#pragma unroll
        for (int kk = 0; kk < 16; kk += 2) {
            const float a = As[(32 * wm + (lane & 31)) * 17 + kk + (lane >> 5)];
            const float b0 = Bs[(kk + (lane >> 5)) * 132 + 64 * wn + (lane & 31)];
            const float b1 = Bs[(kk + (lane >> 5)) * 132 + 64 * wn + 32 + (lane & 31)];
            acc0 = __builtin_amdgcn_mfma_f32_32x32x2f32(a, b0, acc0, 0, 0, 0);
            acc1 = __builtin_amdgcn_mfma_f32_32x32x2f32(a, b1, acc1, 0, 0, 0);
        }
    }
#pragma unroll
    for (int r = 0; r < 16; ++r) {
        const int i = 32 * wm + (r & 3) + 8 * (r >> 2) + 4 * (lane >> 5);
        const int c0 = col0 + 64 * wn + (lane & 31);
        if (i < nvalid) {
            if (c0 < N) epi(i, c0, acc0[r]);
            if (c0 + 32 < N) epi(i, c0 + 32, acc1[r]);
        }
    }
}

#include <hip/hip_bf16.h>
namespace attn_body {
using bf16=__hip_bfloat16;
using bf16x8=__attribute__((ext_vector_type(8)))short;
using s16x4=__attribute__((ext_vector_type(4)))short;
using f32x16=__attribute__((ext_vector_type(16)))float;
using u32x4=__attribute__((ext_vector_type(4)))unsigned;
typedef float f32x4_t __attribute__((ext_vector_type(4)));
constexpr int BATCH=2,NHEAD=8,SEQ=16384,D=64,DM=3584,OP=1024;
constexpr int NW=8,QBLK=32,QB=QBLK*NW,KVBLK=64,NQB=SEQ/QB;
constexpr int ATTN_PITCH=DM, ATTN_UNIT_ROWS=QB;
__device__ __forceinline__ int crow(int r,int hi){return (r&3)+8*(r>>2)+4*hi;}
#define SBAR() __builtin_amdgcn_sched_barrier(0)
__device__ __forceinline__ void cmask(f32x16&p0,f32x16&p1,int jb,int qrel,int hi){
  const float NEG=-INFINITY; int kb=64*jb+4*hi;
  #pragma unroll
  for(int r=0;r<16;++r){int kv=kb+(r&3)+8*(r>>2); if(kv>qrel)p0[r]=NEG; if(kv+32>qrel)p1[r]=NEG;}
}

constexpr int NSLOT=3, SLOTB=8192;
constexpr int LDS_K=0, LDS_V=NSLOT*SLOTB, LDS_WS=2*NSLOT*SLOTB, LDS_OST=LDS_WS+NW*64*4, LDS_BYTES=LDS_OST+NW*4096;
constexpr float C2=0.125f*1.4426950408889634f;
__device__ __forceinline__ void glds16(const void*gsrc,unsigned lds_dst){unsigned keep;
  asm volatile("s_mov_b32 %0, m0\n\ts_mov_b32 m0, %2\n\ts_nop 0\n\tglobal_load_lds_dwordx4 %1, off\n\ts_mov_b32 m0, %0":"=&s"(keep):"v"(gsrc),"s"(lds_dst):"memory");}
__device__ __forceinline__ float max3f(float a,float b,float c){float r;asm("v_max3_f32 %0, %1, %2, %3":"=v"(r):"v"(a),"v"(b),"v"(c));return r;}
__device__ __forceinline__ float max2f(float a,float b){float r;asm("v_max_f32_e32 %0, %1, %2":"=v"(r):"v"(a),"v"(b));return r;}
__device__ __forceinline__ float fadd_s(float a,float b){float r;asm("v_add_f32_e32 %0, %1, %2":"=v"(r):"v"(a),"v"(b));return r;}
__device__ __forceinline__ float fsub_s(float a,float b){float r;asm("v_sub_f32_e32 %0, %1, %2":"=v"(r):"v"(a),"v"(b));return r;}
typedef float f32x2_t __attribute__((ext_vector_type(2))); typedef __bf16 bf16x2_t __attribute__((ext_vector_type(2)));
__device__ __forceinline__ unsigned cvtpk_s(float lo,float hi){f32x2_t v={lo,hi};bf16x2_t b=__builtin_convertvector(v,bf16x2_t);return __builtin_bit_cast(unsigned,b);}
#define WAIT_BAR(N) asm volatile("s_waitcnt vmcnt(" #N ") lgkmcnt(0)\n\ts_barrier":::"memory")

__device__ __forceinline__ void qkt(f32x16&p0,f32x16&p1,const char*Kslot,const bf16x8*qr,int r32,int hi){
  const char*kb=Kslot+hi*1024+r32*16;
  #pragma unroll
  for(int d0=0;d0<4;++d0){
    const bf16x8 b0=*reinterpret_cast<const bf16x8*>(kb+d0*2048);
    const bf16x8 b1=*reinterpret_cast<const bf16x8*>(kb+d0*2048+512);
    p0=__builtin_amdgcn_mfma_f32_32x32x16_bf16(b0,qr[d0],p0,0,0,0);p1=__builtin_amdgcn_mfma_f32_32x32x16_bf16(b1,qr[d0],p1,0,0,0);}
}
typedef __attribute__((address_space(3))) const char* lds_cptr;
typedef short v4i16_t __attribute__((ext_vector_type(4)));
__device__ __forceinline__ void kload8(bf16x8*kf,lds_cptr kp){
  kf[0]=*(const __attribute__((address_space(3))) bf16x8*)(kp);      kf[1]=*(const __attribute__((address_space(3))) bf16x8*)(kp+512);
  kf[2]=*(const __attribute__((address_space(3))) bf16x8*)(kp+2048); kf[3]=*(const __attribute__((address_space(3))) bf16x8*)(kp+2560);
  kf[4]=*(const __attribute__((address_space(3))) bf16x8*)(kp+4096); kf[5]=*(const __attribute__((address_space(3))) bf16x8*)(kp+4608);
  kf[6]=*(const __attribute__((address_space(3))) bf16x8*)(kp+6144); kf[7]=*(const __attribute__((address_space(3))) bf16x8*)(kp+6656);
}
__device__ __forceinline__ void kload2(bf16x8*kf,lds_cptr kp,int j){ kf[2*j]=*(const __attribute__((address_space(3))) bf16x8*)(kp+j*2048); kf[2*j+1]=*(const __attribute__((address_space(3))) bf16x8*)(kp+j*2048+512); }
__device__ __forceinline__ s16x4 vtr(lds_cptr p){ return __builtin_bit_cast(s16x4,__builtin_amdgcn_ds_read_tr16_b64_v4i16((__attribute__((address_space(3))) v4i16_t*)p)); }
__device__ __forceinline__ float rowmax(const f32x16&p0,const f32x16&p1){
  float a=max3f(p0[0],p0[1],p1[0]),b=max3f(p0[2],p0[3],p1[1]);a=max3f(a,p1[2],p1[3]);
  #pragma unroll
  for(int r=4;r<16;r+=4){a=max3f(a,p0[r],p0[r+1]);b=max3f(b,p0[r+2],p0[r+3]);a=max3f(a,p1[r],p1[r+1]);b=max3f(b,p1[r+2],p1[r+3]);}
  const float m=max2f(a,b);
  auto rr=__builtin_amdgcn_permlane32_swap(__float_as_uint(m),__float_as_uint(m),false,false);
  return max2f(__uint_as_float(rr[0]),__uint_as_float(rr[1]));
}
__device__ __forceinline__ void pv(f32x16*o,int vb,bf16x8 pa0,bf16x8 pa1,bf16x8 pa2,bf16x8 pa3){
  #pragma unroll
  for(int d0=0;d0<2;++d0){s16x4 lo[4],hi[4];
    #pragma unroll
    for(int ks=0;ks<4;++ks){
      asm volatile("ds_read_b64_tr_b16 %0,%1 offset:%c2":"=&v"(lo[ks]):"v"(vb),"i"(d0*4096+ks*1024):"memory");
      asm volatile("ds_read_b64_tr_b16 %0,%1 offset:%c2":"=&v"(hi[ks]):"v"(vb),"i"(d0*4096+ks*1024+512):"memory");}
    asm volatile("s_waitcnt lgkmcnt(0)":::"memory");SBAR();
    #define PK(k) (bf16x8){lo[k][0],lo[k][1],lo[k][2],lo[k][3],hi[k][0],hi[k][1],hi[k][2],hi[k][3]}
    o[d0]=__builtin_amdgcn_mfma_f32_32x32x16_bf16(pa0,PK(0),o[d0],0,0,0);
    o[d0]=__builtin_amdgcn_mfma_f32_32x32x16_bf16(pa1,PK(1),o[d0],0,0,0);
    o[d0]=__builtin_amdgcn_mfma_f32_32x32x16_bf16(pa2,PK(2),o[d0],0,0,0);
    o[d0]=__builtin_amdgcn_mfma_f32_32x32x16_bf16(pa3,PK(3),o[d0],0,0,0);
    #undef PK
  }
}

#ifndef ATTN_STORE16
#define ATTN_STORE16(p,v) (*(u32x4*)(p)=(v))
#endif
template<int THRL> __device__ __forceinline__ void attn_unit(int b,int h,int qb,int t0,const bf16*Q,const bf16*__restrict__ K,const bf16*__restrict__ V,bf16*O,const unsigned char*KAg,char*shm){
  const int tid=ltid(),lane=tid&63,r32=lane&31,hi=lane>>5; const int wid=__builtin_amdgcn_readfirstlane(tid>>6);
  const long rowbase=(long)b*SEQ; const int q0=qb*QB;
  const bf16*Qw=Q+(rowbase+q0+wid*QBLK)*DM+h*D;
  const bf16*Kh=K+(rowbase+(long)t0*KVBLK)*DM+h*D,*Vh=V+(rowbase+(long)t0*KVBLK)*DM+h*D;
  const unsigned lds0=(unsigned)(uintptr_t)shm;
  float*wsf=(float*)(shm+LDS_WS)+wid*64;
  const bf16*ksrc=Kh+(long)lane*DM+wid*8;
  const bf16*vsrc=Vh+(long)(16*(wid&3)+(lane>>2))*DM+(wid>>2)*32+(lane&3)*8;
  const unsigned kdst=lds0+LDS_K+wid*1024, vdst=lds0+LDS_V+wid*1024;
  #define DMA_K(t,slot) glds16(ksrc+(long)(t)*KVBLK*DM,(unsigned)__builtin_amdgcn_readfirstlane(kdst+(slot)))
  #define DMA_V(t,slot) glds16(vsrc+(long)(t)*KVBLK*DM,(unsigned)__builtin_amdgcn_readfirstlane(vdst+(slot)))
  const int vb0=(int)(lds0+LDS_V)+((lane>>4)&1)*32+(lane&3)*8+(4*hi+((lane&15)>>2))*64;
  const char*Kbase=shm+LDS_K; bf16x8 kf[8];
  const lds_cptr shm3=(lds_cptr)shm; const lds_cptr kp0=shm3+LDS_K+hi*1024+r32*16; const lds_cptr vp0=shm3+LDS_V+((lane>>4)&1)*32+(lane&3)*8+(4*hi+((lane&15)>>2))*64;
  const int NT=(q0+QB)/KVBLK-t0;
  u32x4 ka0,ka1; u32x4 qaw;
  const unsigned kavoff=(unsigned)r32*16u;
  const unsigned long long kab0=(unsigned long long)(uintptr_t)KAg+((unsigned long long)((b*NHEAD+h)*(long)SEQ+(long)t0*KVBLK))*16ull;
  #define KA_LOAD(t) do{ const unsigned long long a_=kab0+(unsigned long long)(t)*1024ull; const unsigned lo_=__builtin_amdgcn_readfirstlane((unsigned)a_),hi_=__builtin_amdgcn_readfirstlane((unsigned)(a_>>32)); \
    const unsigned long long sb_=((unsigned long long)hi_<<32)|lo_; \
    asm volatile("s_nop 4\n\tglobal_load_dwordx4 %0, %2, %3\n\tglobal_load_dwordx4 %1, %2, %3 offset:512":"=&v"(ka0),"=&v"(ka1):"v"(kavoff),"s"(sb_):"memory"); }while(0)
  #define QA_SET() do{ const float nm_=-mhat; const unsigned h_=cvtpk_s(nm_,0.f)&0xffffu; const float r1_=nm_-__uint_as_float(h_<<16); const unsigned m_=cvtpk_s(r1_,0.f)&0xffffu; \
    const float r2_=r1_-__uint_as_float(m_<<16); const unsigned l_=cvtpk_s(r2_,0.f)&0xffffu; \
    qaw[0]=hi?0u:0x3f803f80u; qaw[1]=hi?0u:(0x3f80u|(h_<<16)); qaw[2]=hi?0u:(m_|(l_<<16)); qaw[3]=0u; asm volatile("":"+v"(qaw)); }while(0)
  #define AUG(C0,C1) do{ C0=__builtin_amdgcn_mfma_f32_32x32x16_bf16(__builtin_bit_cast(bf16x8,ka0),__builtin_bit_cast(bf16x8,qaw),f32x16{},0,0,0); \
    C1=__builtin_amdgcn_mfma_f32_32x32x16_bf16(__builtin_bit_cast(bf16x8,ka1),__builtin_bit_cast(bf16x8,qaw),f32x16{},0,0,0); }while(0)
  #define PIN_KA() asm volatile("; KA landed":"+v"(ka0),"+v"(ka1)::"memory")
  #define WAIT_BAR_KA(N) do{ WAIT_BAR(N); PIN_KA(); }while(0)
  KA_LOAD(0);
  DMA_K(0,0);DMA_V(0,0);DMA_K(1,SLOTB);
  bf16x8 qr[4];
  #pragma unroll
  for(int d0=0;d0<4;++d0)qr[d0]=*reinterpret_cast<const bf16x8*>(&Qw[(long)r32*DM+d0*16+hi*8]);
  float mhat=0.f,l_reg=0.f;f32x16 o[2];o[0]=f32x16{};o[1]=f32x16{}; QA_SET();
  const int qrel=wid*QBLK+r32;
  #define CMASK(P0,P1,t) do{int jb_=(t)-(NT-4); if(jb_>=0)cmask(P0,P1,jb_,qrel,hi);}while(0)
  bool resc=false;
  #define START(P0,P1) do{ const float rm=rowmax(P0,P1); resc=false; \
    { const float dl=rm; mhat=fadd_s(mhat,dl); \
      _Pragma("unroll") for(int r=0;r<16;++r){P0[r]=fsub_s(P0[r],dl);P1[r]=fsub_s(P1[r],dl);} \
      QA_SET(); } \
    _Pragma("unroll") for(int r=0;r<16;++r)P0[r]=__builtin_amdgcn_exp2f(P0[r]); }while(0)
  #define RESC() do{ if(resc){ asm volatile("s_waitcnt lgkmcnt(0)":::"memory"); \
      _Pragma("unroll") for(int d_=0;d_<2;++d_) _Pragma("unroll") for(int r=0;r<16;++r)o[d_][r]*=wsf[crow(r,hi)]; } }while(0)
  f32x16 pA0,pA1,pB0,pB1;
  int sl_prev=0,sl_cur=0,sl_next=SLOTB;
  #define ROT() do{sl_prev=sl_cur;sl_cur=sl_next;sl_next=(sl_next==(NSLOT-1)*SLOTB)?0:sl_next+SLOTB;}while(0)
  DMA_K(2,2*SLOTB);
  WAIT_BAR_KA(3);
  AUG(pA0,pA1); qkt(pA0,pA1,Kbase,qr,r32,hi);asm volatile("s_nop 15\n\ts_nop 7":"+v"(pA0),"+v"(pA1));CMASK(pA0,pA1,0);
  START(pA0,pA1);
  _Pragma("unroll") for(int r=0;r<16;++r)pA1[r]=__builtin_amdgcn_exp2f(pA1[r]);
  WAIT_BAR(0);
  KA_LOAD(1);DMA_K(3,0);DMA_V(1,SLOTB);
  ROT();
  kload8(kf,kp0+sl_cur);
  WAIT_BAR_KA(2);
  s16x4 vlo[8],vhi[8]; u32x4 pw0,pw1,pw2,pw3;
  #define PKW(P,B) cvtpk_s(P[B],P[B+1])
  #define PAF(k) __builtin_bit_cast(bf16x8,pw##k)
  #define VFR(i) (bf16x8){vlo[i][0],vlo[i][1],vlo[i][2],vlo[i][3],vhi[i][0],vhi[i][1],vhi[i][2],vhi[i][3]}
  #define PIN(x) asm volatile("":"+v"(x))
  #define MX3(a,b,c) __builtin_fmaxf(__builtin_fmaxf((a),(b)),(c))
  #define GAPA(MF,A0,A1,A2,A3,W0,W1,PW) do{ MF; sacc+=A0; sacc+=A1; sacc+=A2; sacc+=A3; PIN(sacc); W0; W1; PIN(PW); SBAR(); }while(0)
  #define EX(v) __builtin_amdgcn_exp2f(v)
  #define GAPB(MF,X,B) do{ MF; X[B]=EX(X[B]); X[B+1]=EX(X[B+1]); X[B+2]=EX(X[B+2]); X[B+3]=EX(X[B+3]); PIN(X); SBAR(); }while(0)
  #define VRD(i) do{ vlo[i]=vtr(vp_+(((i)>>2)*4096+((i)&3)*1024)); vhi[i]=vtr(vp_+(((i)>>2)*4096+((i)&3)*1024+512)); }while(0)
  #define KRD(G,j) do{ if(G){ kload2(kf,kp0+sl_next,j); SBAR(); } }while(0)
  #define STEP(C0,C1,P0,P1,t,GK,GV,GL) do{ SBAR(); \
    const lds_cptr vp_=vp0+sl_prev; \
    AUG(C0,C1); SBAR(); \
    VRD(0); SBAR(); float sacc=(P0[0]+P0[1]); \
    GAPA(C0=__builtin_amdgcn_mfma_f32_32x32x16_bf16(kf[0],qr[0],C0,0,0,0), P0[2],P0[3],P0[4],P0[5],     pw0[0]=PKW(P0,0), pw0[1]=PKW(P0,2), pw0); \
    VRD(4); SBAR(); GAPA(C1=__builtin_amdgcn_mfma_f32_32x32x16_bf16(kf[1],qr[0],C1,0,0,0), P0[6],P0[7],P0[8],P0[9],     pw0[2]=PKW(P0,4), pw0[3]=PKW(P0,6), pw0); \
    VRD(1); SBAR(); GAPA(C0=__builtin_amdgcn_mfma_f32_32x32x16_bf16(kf[2],qr[1],C0,0,0,0),   P0[10],P0[11],P0[12],P0[13], pw1[0]=PKW(P0,8), pw1[1]=PKW(P0,10), pw1); \
    VRD(5); SBAR(); GAPA(C1=__builtin_amdgcn_mfma_f32_32x32x16_bf16(kf[3],qr[1],C1,0,0,0),   P0[14],P0[15],P1[0],P1[1],   pw1[2]=PKW(P0,12),pw1[3]=PKW(P0,14), pw1); \
    VRD(2); SBAR(); GAPA(C0=__builtin_amdgcn_mfma_f32_32x32x16_bf16(kf[4],qr[2],C0,0,0,0),   P1[2],P1[3],P1[4],P1[5],     pw2[0]=PKW(P1,0), pw2[1]=PKW(P1,2), pw2); \
    VRD(6); SBAR(); GAPA(C1=__builtin_amdgcn_mfma_f32_32x32x16_bf16(kf[5],qr[2],C1,0,0,0),   P1[6],P1[7],P1[8],P1[9],     pw2[2]=PKW(P1,4), pw2[3]=PKW(P1,6), pw2); \
    VRD(3); SBAR(); GAPA(C0=__builtin_amdgcn_mfma_f32_32x32x16_bf16(kf[6],qr[3],C0,0,0,0),   P1[10],P1[11],P1[12],P1[13], pw3[0]=PKW(P1,8), pw3[1]=PKW(P1,10), pw3); \
    VRD(7); SBAR(); GAPA(C1=__builtin_amdgcn_mfma_f32_32x32x16_bf16(kf[7],qr[3],C1,0,0,0),   P1[14],P1[15],0.f,0.f,       pw3[2]=PKW(P1,12),pw3[3]=PKW(P1,14), pw3); \
    l_reg+=sacc; \
    if(GL){KA_LOAD((t)+1);} if(GK){DMA_K((t)+3,sl_cur);} if(GV){DMA_V((t)+1,sl_next);} \
    CMASK(C0,C1,t); \
    { float a=MX3(C0[0],C0[1],C1[0]),b=MX3(C0[2],C0[3],C1[1]); a=MX3(a,C1[2],C1[3]); \
      _Pragma("unroll") for(int r=4;r<16;r+=4){a=MX3(a,C0[r],C0[r+1]);b=MX3(b,C0[r+2],C0[r+3]);a=MX3(a,C1[r],C1[r+1]);b=MX3(b,C1[r+2],C1[r+3]);} \
      float rm=__builtin_fmaxf(a,b); { auto rr=__builtin_amdgcn_permlane32_swap(__float_as_uint(rm),__float_as_uint(rm),false,false); rm=__builtin_fmaxf(__uint_as_float(rr[0]),__uint_as_float(rr[1])); } \
      resc=false; \
      if(__builtin_expect(__any(rm>(float)THRL),0)){ const float dl=__builtin_fmaxf(rm,0.f); mhat+=dl; \
        _Pragma("unroll") for(int r=0;r<16;++r){C0[r]-=dl;C1[r]-=dl;} \
        QA_SET(); \
        const float f=__builtin_amdgcn_exp2f(-dl); l_reg*=f; if(hi==0)wsf[r32]=f; resc=true; } } \
    SBAR(); \
    GAPB(o[0]=__builtin_amdgcn_mfma_f32_32x32x16_bf16(PAF(0),VFR(0),o[0],0,0,0), C0,0); \
    GAPB(o[1]=__builtin_amdgcn_mfma_f32_32x32x16_bf16(PAF(0),VFR(4),o[1],0,0,0), C0,4); \
    KRD(GL,0); GAPB(o[0]=__builtin_amdgcn_mfma_f32_32x32x16_bf16(PAF(1),VFR(1),o[0],0,0,0), C0,8); \
    KRD(GL,1); GAPB(o[1]=__builtin_amdgcn_mfma_f32_32x32x16_bf16(PAF(1),VFR(5),o[1],0,0,0), C0,12); \
    KRD(GL,2); GAPB(o[0]=__builtin_amdgcn_mfma_f32_32x32x16_bf16(PAF(2),VFR(2),o[0],0,0,0), C1,0); \
    KRD(GL,3); GAPB(o[1]=__builtin_amdgcn_mfma_f32_32x32x16_bf16(PAF(2),VFR(6),o[1],0,0,0), C1,4); \
    GAPB(o[0]=__builtin_amdgcn_mfma_f32_32x32x16_bf16(PAF(3),VFR(3),o[0],0,0,0), C1,8); \
    GAPB(o[1]=__builtin_amdgcn_mfma_f32_32x32x16_bf16(PAF(3),VFR(7),o[1],0,0,0), C1,12); \
    }while(0)
  int t=1;
  #undef CMASK
  #define CMASK(P0,P1,t) do{}while(0)
  for(;t+5<NT;t+=2){
    STEP(pB0,pB1,pA0,pA1,t,true,true,true);     WAIT_BAR_KA(2); RESC(); ROT();
    STEP(pA0,pA1,pB0,pB1,t+1,true,true,true);   WAIT_BAR_KA(2); RESC(); ROT();
  }
  #undef CMASK
  #define CMASK(P0,P1,t) do{int jb_=(t)-(NT-4); if(jb_>=0)cmask(P0,P1,jb_,qrel,hi);}while(0)
  #define ENDW(tt) do{ if((tt)+3<NT){WAIT_BAR(2);} else if((tt)+2<NT){WAIT_BAR(1);} else {WAIT_BAR(0);} PIN_KA(); }while(0)
  for(;t+1<NT;t+=2){
    STEP(pB0,pB1,pA0,pA1,t,(t+3<NT),(t+1<NT),(t+1<NT));       ENDW(t);   RESC(); ROT();
    STEP(pA0,pA1,pB0,pB1,t+1,(t+4<NT),(t+2<NT),(t+2<NT));     ENDW(t+1); RESC(); ROT();
  }
  STEP(pB0,pB1,pA0,pA1,NT-1,false,false,false); RESC();
  { float sacc=pB0[0]+pB0[1]; _Pragma("unroll") for(int r=2;r<16;++r)sacc+=pB0[r]; _Pragma("unroll") for(int r=0;r<16;++r)sacc+=pB1[r]; l_reg+=sacc;
    pw0=(u32x4){PKW(pB0,0),PKW(pB0,2),PKW(pB0,4),PKW(pB0,6)};pw1=(u32x4){PKW(pB0,8),PKW(pB0,10),PKW(pB0,12),PKW(pB0,14)};pw2=(u32x4){PKW(pB1,0),PKW(pB1,2),PKW(pB1,4),PKW(pB1,6)};pw3=(u32x4){PKW(pB1,8),PKW(pB1,10),PKW(pB1,12),PKW(pB1,14)};
    SBAR(); pv(o,vb0+sl_cur,PAF(0),PAF(1),PAF(2),PAF(3)); }
  #undef PKW
  #undef PAF
  #undef VFR
  #undef PIN
  #undef MX3
  #undef GAPA
  #undef GAPB
  #undef EX
  #undef VRD
  #undef KRD
  #undef STEP
  #undef ENDW
  {auto rr=__builtin_amdgcn_permlane32_swap(__float_as_uint(l_reg),__float_as_uint(l_reg),false,false);l_reg=__uint_as_float(rr[0])+__uint_as_float(rr[1]);}
  if(hi==0)wsf[32+r32]=l_reg;asm volatile("s_waitcnt lgkmcnt(0)":::"memory");
  float rli[16];
  #pragma unroll
  for(int r=0;r<16;++r)rli[r]=__builtin_amdgcn_rcpf(wsf[32+crow(r,hi)]);
  bf16*Ow=O+(rowbase+q0+wid*QBLK)*OP+h*D;
  { bf16*stg=(bf16*)(shm+LDS_OST)+wid*2048;
    #pragma unroll
    for(int r=0;r<16;++r){const int orow=crow(r,hi);
      #pragma unroll
      for(int d0=0;d0<2;++d0)stg[orow*64+d0*32+r32]=__float2bfloat16(o[d0][r]*rli[r]);}
    asm volatile("s_waitcnt lgkmcnt(0)":::"memory");
    #pragma unroll
    for(int i=0;i<4;++i){const int row=i*8+(lane>>3),ch=lane&7; const u32x4 v=*(const u32x4*)(stg+row*64+ch*8); ATTN_STORE16(Ow+(long)row*OP+ch*8,v);} }
  asm volatile("s_waitcnt lgkmcnt(0)\n\ts_barrier":::"memory");
  #undef DMA_K
  #undef DMA_V
  #undef KA_LOAD
  #undef QA_SET
  #undef AUG
  #undef WAIT_BAR_KA
  #undef PIN_KA
  #undef CMASK
  #undef START
  #undef RESC
  #undef ROT
}
constexpr int ATTN_LDS_BYTES=LDS_BYTES;
struct AttnTensors { const bf16* Q; const bf16* K; const bf16* V; bf16* O; const unsigned char* KA; };
struct AttnUnit { int bh; int qb; };
struct StaticOrder {
  int vcu;
  __device__ __forceinline__ explicit StaticOrder(int grid,int block):vcu((block%8)*(grid/8)+block/8){}
  __device__ __forceinline__ bool next(int i,AttnUnit&u)const{ if(i>=4)return false; const int s=vcu&15; u.bh=vcu>>4; u.qb=(i==0)?63-s:(i==1)?32+s:(i==2)?31-s:s; return true; }
  __device__ __forceinline__ void a_ready(const AttnUnit&)const{}
  __device__ __forceinline__ void done(const AttnUnit&)const{}
};
template<class Sched,int THRL=8> __device__ __forceinline__ void attn_phase(char*lds,const AttnTensors&T,const Sched&S){
  AttnUnit u;
  for(int i=0;S.next(i,u);++i){ S.a_ready(u); attn_unit<THRL>(u.bh/NHEAD,u.bh%NHEAD,u.qb,0,T.Q,T.K,T.V,T.O,T.KA,lds); S.done(u); }
}
#undef SBAR
#undef WAIT_BAR
}

#ifndef TPROBE_SEL
#define TPROBE_SEL 0
#endif
#define TPROBE_MULT 4
#define TP_BEGIN(id) do { if (TPROBE_SEL == (id)) tp_t0 = __builtin_amdgcn_s_memrealtime(); } while (0)
#define TP_END(id) do { if (TPROBE_SEL == (id)) tp_acc += __builtin_amdgcn_s_memrealtime() - tp_t0; } while (0)
namespace ck {
#define CK_LAS __attribute__((address_space(3)))
typedef unsigned short bf16_t;
typedef short bf16x8 __attribute__((ext_vector_type(8)));
typedef float f32x16 __attribute__((ext_vector_type(16)));
typedef float f32x4 __attribute__((ext_vector_type(4)));
typedef unsigned u32x4 __attribute__((ext_vector_type(4)));
typedef unsigned u32x2 __attribute__((ext_vector_type(2)));
typedef CK_LAS unsigned short* lbf;
typedef CK_LAS float* lf32;
constexpr int SB = 72;
constexpr int B9 = 64 * SB * 2;
constexpr int SF = 65;
constexpr int SM = 68;
constexpr int SX = 132;
__device__ __forceinline__ unsigned pk2(float lo, float hi) { return ::pk2(lo, hi); }
__device__ __forceinline__ unsigned f2bf(float f) { return ::f2bf(f); }
__device__ __forceinline__ float bflo(unsigned w) { return __builtin_bit_cast(float, w << 16); }
__device__ __forceinline__ float bfhi(unsigned w) { return __builtin_bit_cast(float, w & 0xffff0000u); }
__device__ __forceinline__ int crow(int reg, int hh) { return (reg & 3) + 8 * (reg >> 2) + 4 * hh; }
__device__ __forceinline__ f32x16 mm_lds(lbf A, lbf BT, int I, int J, int lane, f32x16 acc) {
    const int r = lane & 31, hh = lane >> 5;
    const lbf ap = A + (32 * I + r) * SB + 8 * hh; const lbf bp = BT + (32 * J + r) * SB + 8 * hh;
#pragma unroll
    for (int s = 0; s < 4; ++s) { const bf16x8 a = *(const CK_LAS bf16x8*)(ap + 16 * s); const bf16x8 b = *(const CK_LAS bf16x8*)(bp + 16 * s); acc = __builtin_amdgcn_mfma_f32_32x32x16_bf16(a, b, acc, 0, 0, 0); }
    return acc;
}
__device__ __forceinline__ f32x16 mm_gA(const bf16_t* __restrict__ Ag, lbf BT, int I, int J, int lane, f32x16 acc) {
    const int r = lane & 31, hh = lane >> 5;
    bf16x8 a[4];
#pragma unroll
    for (int s = 0; s < 4; ++s) a[s] = *(const bf16x8*)(Ag + (32 * I + r) * 64 + 16 * s + 8 * hh);
    const lbf bp = BT + (32 * J + r) * SB + 8 * hh;
#pragma unroll
    for (int s = 0; s < 4; ++s) { const bf16x8 b = *(const CK_LAS bf16x8*)(bp + 16 * s); acc = __builtin_amdgcn_mfma_f32_32x32x16_bf16(a[s], b, acc, 0, 0, 0); }
    return acc;
}
__device__ __forceinline__ f32x16 mm_gg(const bf16_t* __restrict__ Ag, const bf16_t* __restrict__ BTg, int I, int J, int lane, f32x16 acc) {
    const int r = lane & 31, hh = lane >> 5;
#pragma unroll
    for (int s = 0; s < 4; ++s) { const bf16x8 a = *(const bf16x8*)(Ag + (32 * I + r) * 64 + 16 * s + 8 * hh); const bf16x8 b = *(const bf16x8*)(BTg + (32 * J + r) * 64 + 16 * s + 8 * hh);
        acc = __builtin_amdgcn_mfma_f32_32x32x16_bf16(a, b, acc, 0, 0, 0); }
    return acc;
}
__device__ __forceinline__ f32x16 mm_rA(const bf16x8 (&a)[4], lbf BT, int J, int lane, f32x16 acc) {
    const int r = lane & 31, hh = lane >> 5; const lbf bp = BT + (32 * J + r) * SB + 8 * hh;
#pragma unroll
    for (int s = 0; s < 4; ++s) { const bf16x8 b = *(const CK_LAS bf16x8*)(bp + 16 * s); acc = __builtin_amdgcn_mfma_f32_32x32x16_bf16(a[s], b, acc, 0, 0, 0); }
    return acc;
}
__device__ __forceinline__ void load_gA(bf16x8 (&a)[4], const bf16_t* __restrict__ Ag, int I, int lane) {
    const int r = lane & 31, hh = lane >> 5;
#pragma unroll
    for (int s = 0; s < 4; ++s) a[s] = *(const bf16x8*)(Ag + (32 * I + r) * 64 + 16 * s + 8 * hh);
}
__device__ __forceinline__ f32x16 mm_lA_gB(lbf A, const bf16_t* __restrict__ BTg, int I, int J, int lane, f32x16 acc) {
    const int r = lane & 31, hh = lane >> 5; bf16x8 b[4];
#pragma unroll
    for (int s = 0; s < 4; ++s) b[s] = *(const bf16x8*)(BTg + (32 * J + r) * 64 + 16 * s + 8 * hh);
    const lbf ap = A + (32 * I + r) * SB + 8 * hh;
#pragma unroll
    for (int s = 0; s < 4; ++s) { const bf16x8 a = *(const CK_LAS bf16x8*)(ap + 16 * s); acc = __builtin_amdgcn_mfma_f32_32x32x16_bf16(a, b[s], acc, 0, 0, 0); }
    return acc;
}
__device__ __forceinline__ void frag_store(float* __restrict__ g, int wq, int lane, const f32x16& acc) {
    f32x4* p = (f32x4*)(g + ((size_t)(wq * 64 + lane)) * 16);
    p[0] = (f32x4){acc[0], acc[1], acc[2], acc[3]}; p[1] = (f32x4){acc[4], acc[5], acc[6], acc[7]}; p[2] = (f32x4){acc[8], acc[9], acc[10], acc[11]}; p[3] = (f32x4){acc[12], acc[13], acc[14], acc[15]};
}
__device__ __forceinline__ f32x16 frag_load(const float* __restrict__ g, int wq, int lane) {
    const f32x4* p = (const f32x4*)(g + ((size_t)(wq * 64 + lane)) * 16); const f32x4 a = p[0], b = p[1], c = p[2], d = p[3];
    return (f32x16){a[0], a[1], a[2], a[3], b[0], b[1], b[2], b[3], c[0], c[1], c[2], c[3], d[0], d[1], d[2], d[3]};
}
__device__ __forceinline__ void frag_store_bf(bf16_t* __restrict__ g, int wq, int lane, const f32x16& acc) {
    u32x4* p = (u32x4*)(g + ((size_t)(wq * 64 + lane)) * 16);
    p[0] = (u32x4){pk2(acc[0], acc[1]), pk2(acc[2], acc[3]), pk2(acc[4], acc[5]), pk2(acc[6], acc[7])}; p[1] = (u32x4){pk2(acc[8], acc[9]), pk2(acc[10], acc[11]), pk2(acc[12], acc[13]), pk2(acc[14], acc[15])};
}
__device__ __forceinline__ f32x16 frag_load_bf(const bf16_t* __restrict__ g, int wq, int lane) {
    const u32x4* p = (const u32x4*)(g + ((size_t)(wq * 64 + lane)) * 16); const u32x4 a = p[0], b = p[1];
    return (f32x16){bflo(a[0]), bfhi(a[0]), bflo(a[1]), bfhi(a[1]), bflo(a[2]), bfhi(a[2]), bflo(a[3]), bfhi(a[3]), bflo(b[0]), bfhi(b[0]), bflo(b[1]), bfhi(b[1]), bflo(b[2]), bfhi(b[2]), bflo(b[3]), bfhi(b[3])};
}
__device__ __forceinline__ void tile_store_T(lbf dst, int I, int J, int lane, const f32x16& acc) {
    const int r = lane & 31, hh = lane >> 5;
#pragma unroll
    for (int g = 0; g < 4; ++g) { u32x2 w; w.x = pk2(acc[4 * g], acc[4 * g + 1]); w.y = pk2(acc[4 * g + 2], acc[4 * g + 3]);
        *(CK_LAS u32x2*)(dst + (32 * J + r) * SB + 32 * I + 8 * g + 4 * hh) = w; }
}
__device__ __forceinline__ float fexp(float x) { return __builtin_amdgcn_exp2f(x * 1.4426950408889634f); }
__device__ __forceinline__ float sigm(float x) { return __builtin_amdgcn_rcpf(1.0f + fexp(-x)); }
__device__ __forceinline__ float ftanh(float x) { const float xc = fminf(fmaxf(x, -15.f), 15.f); return 1.0f - 2.0f * __builtin_amdgcn_rcpf(fexp(2.0f * xc) + 1.0f); }
__device__ __forceinline__ float logsig(float x) { const float ax = fabsf(x); return fminf(x, 0.f) - 0.6931471805599453f * __builtin_amdgcn_logf(1.0f + fexp(-ax)); }
template <int CTRL> __device__ __forceinline__ float dpp_f(float v) { return __builtin_bit_cast(float, __builtin_amdgcn_update_dpp(0, __builtin_bit_cast(int, v), CTRL, 0xf, 0xf, false)); }
__device__ __forceinline__ float quad_sum(float v) { v += dpp_f<0xB1>(v); v += dpp_f<0x4E>(v); return v; }

constexpr size_t O_PC = 0, O_QC = 16u << 20, O_GY = 48u << 20, O_YL = 64u << 20, O_VG = 96u << 20, O_GG = 112u << 20, O_H0 = 128u << 20, O_RKD = 144u << 20, O_KV = 145u << 20, O_RT = 177u << 20, O_END = 193u << 20,
                 O_PG = 193u << 20, O_QG = 195u << 20, O_HG = 197u << 20, O_KG = 199u << 20, O_RG = 203u << 20, O_END2 = 207u << 20;
struct RwkvParams {
    const float *mu_rkv, *mu_lora, *w0, *a0, *k_k, *k_a, *r_k, *ln_g, *ln_b, *gn_g;
    const bf16_t *w2t, *a2t, *g2t;
};

constexpr int L_U = 10 * B9, L_MM = L_U + 36864, L_GL = L_MM + 64 * SM * 4, L_END1 = L_GL + 256;
__device__ __forceinline__ void rwkv_stage1(CK_LAS unsigned char* lds, int item, const bf16_t* __restrict__ Pb, int PW, int C_RR, int C_RK, int C_RV, int C_WD, int SEQ, const RwkvParams& p, unsigned char* __restrict__ cw, unsigned long long& tp_acc, unsigned long long& tp_t0) {
    const int tid = ltid(), lane = tid & 63, wid = __builtin_amdgcn_readfirstlane(tid >> 6), quad = wid >> 2, wq = wid & 3, I = wq >> 1, J = wq & 1, r = lane & 31, hh = lane >> 5;
    const int b = item >> 10, h = (item >> 8) & 3, c = item & 255;
    const size_t m0 = (size_t)b * SEQ + (size_t)c * 64;
    const lbf Am = (lbf)(lds), Bm = (lbf)(lds + B9), Km = (lbf)(lds + 2 * B9), Rm = (lbf)(lds + 3 * B9), VT = (lbf)(lds + 4 * B9), BhT = (lbf)(lds + 5 * B9), KhT = (lbf)(lds + 6 * B9),
              Nm = (lbf)(lds + 7 * B9), Wb = (lbf)(lds + 8 * B9), Wk = (lbf)(lds + 9 * B9);
    const lbf TW = (lbf)(lds + L_U), AD = (lbf)(lds + L_U + B9), SG0 = (lbf)(lds + L_U + 2 * B9), SG1 = (lbf)(lds + L_U + 3 * B9);
    const lbf W2T = BhT, A2T = KhT, G2Ta = Nm, G2Tb = Wb;
    const lf32 X = (lf32)(lds + L_U), MM = (lf32)(lds + L_MM), GL = (lf32)(lds + L_GL);
    const lf32 AA = (lf32)(lds), GGl = (lf32)(lds + 2 * B9);
    const lbf ZlT = Km, X1T = Nm;
    TP_BEGIN(10);
    const int t = tid >> 3, c8 = (tid & 7) * 8;
    const size_t m = m0 + t; const bool hp = (c * 64 + t) > 0;
    const bf16_t* pr = Pb + m * PW; const bf16_t* pp = pr - PW;
    float rr[8], kx[8], vv[8];
    {
        const u32x4 z4 = (u32x4){0u, 0u, 0u, 0u};
        const u32x4 cr = *(const u32x4*)(pr + C_RR + h * 64 + c8), ckk = *(const u32x4*)(pr + C_RK + h * 64 + c8), cv = *(const u32x4*)(pr + C_RV + h * 64 + c8);
        const u32x4 qr = hp ? *(const u32x4*)(pp + C_RR + h * 64 + c8) : z4, qk = hp ? *(const u32x4*)(pp + C_RK + h * 64 + c8) : z4, qv = hp ? *(const u32x4*)(pp + C_RV + h * 64 + c8) : z4;
        u32x4 cl[4], ql[4];
#pragma unroll
        for (int q = 0; q < 4; ++q) { cl[q] = *(const u32x4*)(pr + C_WD + q * 64 + c8); ql[q] = hp ? *(const u32x4*)(pp + C_WD + q * 64 + c8) : z4; }
        const u32x4 lw0 = *(const u32x4*)(p.w2t + ((size_t)h * 64 + t) * 64 + c8), lw1 = *(const u32x4*)(p.a2t + ((size_t)h * 64 + t) * 64 + c8),
                    lw2 = *(const u32x4*)(p.g2t + ((size_t)h * 64 + t) * 128 + c8), lw3 = *(const u32x4*)(p.g2t + ((size_t)h * 64 + t) * 128 + 64 + c8);
        f32x4 mr[3][2], ml[4][2];
#pragma unroll
        for (int k = 0; k < 3; ++k) { mr[k][0] = *(const f32x4*)(p.mu_rkv + k * 256 + h * 64 + c8); mr[k][1] = *(const f32x4*)(p.mu_rkv + k * 256 + h * 64 + c8 + 4); }
#pragma unroll
        for (int q = 0; q < 4; ++q) { ml[q][0] = *(const f32x4*)(p.mu_lora + q * 64 + c8); ml[q][1] = *(const f32x4*)(p.mu_lora + q * 64 + c8 + 4); }
#pragma unroll
        for (int e = 0; e < 8; ++e) {
            const float a_ = (e & 1) ? bfhi(cr[e >> 1]) : bflo(cr[e >> 1]), b_ = (e & 1) ? bfhi(qr[e >> 1]) : bflo(qr[e >> 1]); rr[e] = a_ + (b_ - a_) * mr[0][e >> 2][e & 3];
            const float c_ = (e & 1) ? bfhi(ckk[e >> 1]) : bflo(ckk[e >> 1]), d_ = (e & 1) ? bfhi(qk[e >> 1]) : bflo(qk[e >> 1]); kx[e] = c_ + (d_ - c_) * mr[1][e >> 2][e & 3];
            const float e_ = (e & 1) ? bfhi(cv[e >> 1]) : bflo(cv[e >> 1]), f_ = (e & 1) ? bfhi(qv[e >> 1]) : bflo(qv[e >> 1]); vv[e] = e_ + (f_ - e_) * mr[2][e >> 2][e & 3]; }
#pragma unroll
        for (int q = 0; q < 4; ++q) {
            float lo[8];
#pragma unroll
            for (int e = 0; e < 8; ++e) { const float a_ = (e & 1) ? bfhi(cl[q][e >> 1]) : bflo(cl[q][e >> 1]), b_ = (e & 1) ? bfhi(ql[q][e >> 1]) : bflo(ql[q][e >> 1]); const float x = a_ + (b_ - a_) * ml[q][e >> 2][e & 3];
                lo[e] = (q == 0) ? ftanh(x) : (q == 1 ? x : sigm(x)); }
            u32x4 w; w.x = pk2(lo[0], lo[1]); w.y = pk2(lo[2], lo[3]); w.z = pk2(lo[4], lo[5]); w.w = pk2(lo[6], lo[7]);
            *(CK_LAS u32x4*)((q == 0 ? TW : q == 1 ? AD : q == 2 ? SG0 : SG1) + t * SB + c8) = w; }
        *(CK_LAS u32x4*)(W2T + t * SB + c8) = lw0; *(CK_LAS u32x4*)(A2T + t * SB + c8) = lw1; *(CK_LAS u32x4*)(G2Ta + t * SB + c8) = lw2; *(CK_LAS u32x4*)(G2Tb + t * SB + c8) = lw3;
    }
    __syncthreads();
    TP_END(10); TP_BEGIN(11);
    if (quad == 0) {
        f32x16 z = mm_lds(TW, W2T, I, J, lane, f32x16{}); f32x16 za = mm_lds(AD, A2T, I, J, lane, f32x16{});
        const int ch = 32 * J + r; const float w0c = p.w0[h * 64 + ch], a0c = p.a0[h * 64 + ch];
#pragma unroll
        for (int g = 0; g < 16; ++g) { const int tt = 32 * I + crow(g, hh); const float lw = logsig(w0c + z[g]) - 0.5f; MM[tt * SF + ch] = -fexp(lw); AA[tt * SF + ch] = sigm(a0c + za[g]); }
    } else {
        f32x16 zg = mm_lds(SG0, G2Ta, I, J, lane, f32x16{}); zg = mm_lds(SG1, G2Tb, I, J, lane, zg);
        const int ch = 32 * J + r;
#pragma unroll
        for (int g = 0; g < 16; ++g) { const int tt = 32 * I + crow(g, hh); GGl[tt * SF + ch] = zg[g]; }
    }
    __syncthreads();
    TP_END(11); TP_BEGIN(12);
    {
        const int ch = tid & 63, seg = tid >> 6; float v8[8]; float run = 0.f;
#pragma unroll
        for (int i = 0; i < 8; ++i) { run += MM[(seg * 8 + i) * SF + ch]; v8[i] = run; }
        const lf32 TOT = (lf32)(lds + L_U);
        TOT[seg * 64 + ch] = run;
        __syncthreads();
        float off = 0.f;
#pragma unroll
        for (int s2 = 0; s2 < 8; ++s2) off += (s2 < seg) ? TOT[s2 * 64 + ch] : 0.f;
#pragma unroll
        for (int i = 0; i < 8; ++i) MM[(seg * 8 + i) * SF + ch] = v8[i] + off;
    }
    __syncthreads();
    TP_END(12); TP_BEGIN(13);
    float aa[8], gg[8], lw[8], lwp[8], lwl[8];
#pragma unroll
    for (int e = 0; e < 8; ++e) { aa[e] = AA[t * SF + c8 + e]; gg[e] = GGl[t * SF + c8 + e]; lw[e] = MM[t * SF + c8 + e]; lwp[e] = t > 0 ? MM[(t - 1) * SF + c8 + e] : 0.f; lwl[e] = MM[63 * SF + c8 + e]; }
    __syncthreads();
    {
        float kk[8], k2[8]; float ss = 0.f, rk = 0.f;
#pragma unroll
        for (int e = 0; e < 8; ++e) { const int ch = h * 64 + c8 + e; kk[e] = kx[e] * p.k_k[ch]; ss += kk[e] * kk[e]; k2[e] = kx[e] * (1.0f + (aa[e] - 1.0f) * p.k_a[ch]); rk += rr[e] * k2[e] * p.r_k[ch]; }
        ss = quad_sum(ss); ss += dpp_f<0x141>(ss); rk = quad_sum(rk); rk += dpp_f<0x141>(rk);
        const float inv = 1.0f / fmaxf(sqrtf(ss), 1e-12f);
        float am[8], bm[8], km[8], rm[8];
#pragma unroll
        for (int e = 0; e < 8; ++e) { kk[e] *= inv; const float g_ = fexp(lw[e]), gi = fexp(-lw[e]), gp = fexp(lwp[e]), gl = fexp(lwl[e] - lw[e]); const float ka = kk[e] * aa[e];
            am[e] = -kk[e] * gp; bm[e] = ka * gi; km[e] = k2[e] * gi; rm[e] = rr[e] * g_;
            VT[(c8 + e) * SB + t] = (bf16_t)f2bf(vv[e]); BhT[(c8 + e) * SB + t] = (bf16_t)f2bf(ka * gl); KhT[(c8 + e) * SB + t] = (bf16_t)f2bf(k2[e] * gl);
            X[t * SX + c8 + e] = am[e]; }
        u32x4 w;
        w.x = pk2(am[0], am[1]); w.y = pk2(am[2], am[3]); w.z = pk2(am[4], am[5]); w.w = pk2(am[6], am[7]); *(CK_LAS u32x4*)(Am + t * SB + c8) = w;
        w.x = pk2(bm[0], bm[1]); w.y = pk2(bm[2], bm[3]); w.z = pk2(bm[4], bm[5]); w.w = pk2(bm[6], bm[7]); *(CK_LAS u32x4*)(Bm + t * SB + c8) = w;
        w.x = pk2(km[0], km[1]); w.y = pk2(km[2], km[3]); w.z = pk2(km[4], km[5]); w.w = pk2(km[6], km[7]); *(CK_LAS u32x4*)(Km + t * SB + c8) = w;
        w.x = pk2(rm[0], rm[1]); w.y = pk2(rm[2], rm[3]); w.z = pk2(rm[4], rm[5]); w.w = pk2(rm[6], rm[7]); *(CK_LAS u32x4*)(Rm + t * SB + c8) = w;
        if (t == 63) {
#pragma unroll
            for (int e = 0; e < 8; ++e) GL[c8 + e] = fexp(lwl[e]); }
        w.x = pk2(vv[0], vv[1]); w.y = pk2(vv[2], vv[3]); w.z = pk2(vv[4], vv[5]); w.w = pk2(vv[6], vv[7]); *(u32x4*)(cw + O_VG + (size_t)item * 8192 + (t * 64 + c8) * 2) = w;
        w.x = pk2(gg[0], gg[1]); w.y = pk2(gg[2], gg[3]); w.z = pk2(gg[4], gg[5]); w.w = pk2(gg[6], gg[7]); *(u32x4*)(cw + O_GG + (size_t)item * 8192 + (t * 64 + c8) * 2) = w;
        if ((tid & 7) == 0) *(float*)(cw + O_RKD + (size_t)item * 256 + t * 4) = rk;
    }
    __syncthreads();
    TP_END(13); TP_BEGIN(14);
    {
        const f32x16 p1 = mm_lds(Am, quad == 0 ? Bm : Km, I, J, lane, f32x16{}); const f32x16 p2 = mm_lds(Rm, quad == 0 ? Bm : Km, I, J, lane, f32x16{});
        const int ii = 32 * J + r;
#pragma unroll
        for (int g = 0; g < 16; ++g) { const int tt = 32 * I + crow(g, hh);
            if (quad == 0) { MM[tt * SM + (ii & 3) * 16 + (ii >> 2)] = (ii < tt) ? p1[g] : 0.f; Wb[tt * SB + ii] = (bf16_t)f2bf((ii <= tt) ? p2[g] : 0.f); }
            else { Nm[tt * SB + ii] = (bf16_t)f2bf((ii < tt) ? p1[g] : 0.f); Wk[tt * SB + ii] = (bf16_t)f2bf((ii <= tt) ? p2[g] : 0.f); } }
    }
    __syncthreads();
    if (quad == 0) { const f32x16 nv = mm_lds(Nm, VT, I, J, lane, f32x16{}); const int vcol = 64 + 32 * J + r;
#pragma unroll
        for (int g = 0; g < 16; ++g) X[(32 * I + crow(g, hh)) * SX + vcol] = nv[g]; }
    __syncthreads();
    TP_END(14); TP_BEGIN(15);
    {
        const int col = tid >> 2, q = tid & 3;
        float xs[16];
#pragma unroll
        for (int k = 0; k < 16; ++k) xs[k] = X[(q + 4 * k) * SX + col];
#pragma unroll
        for (int tt = 1; tt < 64; ++tt) {
            const CK_LAS f32x4* mr = (const CK_LAS f32x4*)(MM + tt * SM + q * 16);
            float s0 = 0.f, s1 = 0.f, s2 = 0.f, s3 = 0.f;
#pragma unroll
            for (int k4 = 0; k4 < (tt + 15) / 16; ++k4) { const f32x4 mv = mr[k4]; s0 += mv[0] * xs[4 * k4]; s1 += mv[1] * xs[4 * k4 + 1]; s2 += mv[2] * xs[4 * k4 + 2]; s3 += mv[3] * xs[4 * k4 + 3]; }
            const float sm = quad_sum((s0 + s1) + (s2 + s3));
            xs[tt >> 2] += (q == (tt & 3)) ? sm : 0.f;
        }
        const lbf dstT = (col < 64) ? (X1T + col * SB) : (ZlT + (col - 64) * SB);
#pragma unroll
        for (int k = 0; k < 16; ++k) dstT[q + 4 * k] = (bf16_t)f2bf(xs[k]);
    }
    __syncthreads();
    TP_END(15); TP_BEGIN(16);
    if (quad == 0) {
        const f32x16 gy = mm_lds(Wb, X1T, I, J, lane, f32x16{}); const f32x16 pc = mm_lds(BhT, X1T, I, J, lane, f32x16{});
        bf16_t* gyg = (bf16_t*)(cw + O_GY + (size_t)item * 8192); bf16_t* pcg = (bf16_t*)(cw + O_PC + (size_t)item * 8192);
        const int cc = 32 * J + r;
#pragma unroll
        for (int g = 0; g < 16; ++g) { const int rw = 32 * I + crow(g, hh);
            gyg[rw * 64 + cc] = (bf16_t)f2bf(gy[g] + __builtin_bit_cast(float, (unsigned)Rm[rw * SB + cc] << 16));
            pcg[rw * 64 + cc] = (bf16_t)f2bf(pc[g] + (rw == cc ? GL[cc] : 0.f)); }
    } else {
        f32x16 yl = mm_lds(ZlT, Wb, I, J, lane, f32x16{}); yl = mm_lds(VT, Wk, I, J, lane, yl);
        f32x16 qc = mm_lds(BhT, ZlT, I, J, lane, f32x16{}); qc = mm_lds(KhT, VT, I, J, lane, qc);
        frag_store((float*)(cw + O_YL + (size_t)item * 16384), wq, lane, yl); frag_store_bf((bf16_t*)(cw + O_QC) + (size_t)item * 4096, wq, lane, qc);
    }
    __syncthreads();
    TP_END(16);
}

template <int NST> __device__ __forceinline__ void rwkv_scan(CK_LAS unsigned char* lds, int chain, const bf16_t* __restrict__ pcb, const bf16_t* __restrict__ qcb, bf16_t* __restrict__ h0b) {
    const int tid = ltid(), lane = tid & 63, wid = __builtin_amdgcn_readfirstlane(tid >> 6), quad = wid >> 2, wq = wid & 3, I = wq >> 1, J = wq & 1, r = lane & 31, hh = lane >> 5, qtid = tid & 255;
    const lbf HT = (lbf)(lds + quad * B9);
    for (int i = qtid; i < 64 * SB / 2; i += 256) ((CK_LAS unsigned*)HT)[i] = 0u;
    __syncthreads();
    const bool on = chain >= 0; const size_t it0 = (size_t)(on ? chain : 0) * NST;
    const bf16_t* pcg = pcb + it0 * 4096; const bf16_t* qcg = qcb + it0 * 4096; bf16_t* h0g = h0b + it0 * 4096;
    constexpr int PD = 5;
    bf16x8 ar[PD][4]; f32x16 qr[PD];
#define CK_LOADSTEP(A_, Q_, cc) do { const int c_ = (cc) < NST ? (cc) : NST - 1; _Pragma("unroll") for (int s_ = 0; s_ < 4; ++s_) A_[s_] = *(const bf16x8*)(pcg + (size_t)c_ * 4096 + (32 * I + r) * 64 + 16 * s_ + 8 * hh); Q_ = frag_load_bf(qcg + (size_t)c_ * 4096, wq, lane); } while (0)
#pragma unroll
    for (int k = 0; k < PD; ++k) CK_LOADSTEP(ar[k], qr[k], k);
    for (int c = 0; c < NST + PD - 1; c += PD) {
#pragma unroll
        for (int k = 0; k < PD; ++k) {
            const int cc = c + k;
            if (cc < NST) {
            if (on) { const int row = qtid >> 2, seg = (qtid & 3) * 16; const u32x4 w0 = *(const CK_LAS u32x4*)(HT + row * SB + seg), w1 = *(const CK_LAS u32x4*)(HT + row * SB + seg + 8);
                      u32x4* dst = (u32x4*)(h0g + (size_t)cc * 4096 + row * 64 + seg); dst[0] = w0; dst[1] = w1; }
            f32x16 acc = qr[k];
            const lbf bp = HT + (32 * J + r) * SB + 8 * hh;
#pragma unroll
            for (int s_ = 0; s_ < 4; ++s_) { const bf16x8 bfr = *(const CK_LAS bf16x8*)(bp + 16 * s_); acc = __builtin_amdgcn_mfma_f32_32x32x16_bf16(ar[k][s_], bfr, acc, 0, 0, 0); }
            CK_LOADSTEP(ar[k], qr[k], cc + PD);
            asm volatile("s_waitcnt lgkmcnt(0)\n\ts_barrier" ::: "memory");
            tile_store_T(HT, I, J, lane, acc);
            asm volatile("s_waitcnt lgkmcnt(0)\n\ts_barrier" ::: "memory");
            }
        }
    }
#undef CK_LOADSTEP
}

__device__ __forceinline__ void rwkv_level1(CK_LAS unsigned char* lds, int task, unsigned char* __restrict__ cw) {
    const int tid = ltid(), lane = tid & 63, wid = __builtin_amdgcn_readfirstlane(tid >> 6), quad = wid >> 2, wq = wid & 3, I = wq >> 1, J = wq & 1, r = lane & 31, hh = lane >> 5;
    const lbf PTh = (lbf)(lds + quad * 4 * B9), PTl = PTh + 64 * SB, QTh = PTl + 64 * SB, QTl = QTh + 64 * SB;
    const bool on = task >= 0; const int tk = on ? task : 0; const size_t item0 = (size_t)(tk >> 5) * 256 + (size_t)(tk & 31) * 8;
    f32x16 PG, QG = f32x16{};
#pragma unroll
    for (int g = 0; g < 16; ++g) PG[g] = (I == J && crow(g, hh) == r) ? 1.0f : 0.0f;
    for (int j = 0; j < 8; ++j) {
        const size_t item = item0 + j;
        bf16x8 a[4]; load_gA(a, (const bf16_t*)(cw + O_PC) + item * 4096, I, lane);
        f32x16 qn = frag_load_bf((const bf16_t*)(cw + O_QC) + item * 4096, wq, lane);
        f32x16 pl, ql;
#pragma unroll
        for (int g = 0; g < 16; ++g) { pl[g] = PG[g] - __builtin_bit_cast(float, f2bf(PG[g]) << 16); ql[g] = QG[g] - __builtin_bit_cast(float, f2bf(QG[g]) << 16); }
        tile_store_T(PTh, I, J, lane, PG); tile_store_T(PTl, I, J, lane, pl); tile_store_T(QTh, I, J, lane, QG); tile_store_T(QTl, I, J, lane, ql);
        __syncthreads();
        f32x16 pn = mm_rA(a, PTh, J, lane, f32x16{}); pn = mm_rA(a, PTl, J, lane, pn);
        qn = mm_rA(a, QTh, J, lane, qn); qn = mm_rA(a, QTl, J, lane, qn);
        __syncthreads();
        PG = pn; QG = qn;
    }
    if (on) { bf16_t* pgg = (bf16_t*)(cw + O_PG) + (size_t)tk * 4096; const int cc = 32 * J + r;
#pragma unroll
        for (int g = 0; g < 16; ++g) pgg[(32 * I + crow(g, hh)) * 64 + cc] = (bf16_t)f2bf(PG[g]);
        frag_store_bf((bf16_t*)(cw + O_QG) + (size_t)tk * 4096, wq, lane, QG); }
}

constexpr int L_RW3 = B9 + 64 * SF * 4;
__device__ __forceinline__ void rwkv_stage3g(CK_LAS unsigned char* ldsq, int task, const RwkvParams& p, const unsigned char* __restrict__ cw, bf16_t* __restrict__ MIXB, int SEQ) {
    const int tid = ltid(), lane = tid & 63, wid = __builtin_amdgcn_readfirstlane(tid >> 6), wq = wid & 3, I = wq >> 1, J = wq & 1, r = lane & 31, hh = lane >> 5, qtid = tid & 255;
    const lbf HT = (lbf)ldsq; const lf32 Y = (lf32)(ldsq + B9);
    const bool on = task >= 0; const int tk = on ? task : 0; const int item0 = (tk >> 5) * 256 + (tk & 31) * 8;
    { const int row = qtid >> 2, seg = (qtid & 3) * 16; const u32x4* src = (const u32x4*)((const bf16_t*)(cw + O_HG) + (size_t)tk * 4096 + row * 64 + seg);
      *(CK_LAS u32x4*)(HT + row * SB + seg) = src[0]; *(CK_LAS u32x4*)(HT + row * SB + seg + 8) = src[1]; }
    __syncthreads();
    for (int j = 0; j < 8; ++j) {
        const int item = item0 + j;
        bf16x8 a[4]; load_gA(a, (const bf16_t*)(cw + O_PC) + (size_t)item * 4096, I, lane);
        f32x16 hn = frag_load_bf((const bf16_t*)(cw + O_QC) + (size_t)item * 4096, wq, lane);
        {
            f32x16 acc = frag_load((const float*)(cw + O_YL) + (size_t)item * 4096, wq, lane);
            acc = mm_lA_gB(HT, (const bf16_t*)(cw + O_GY) + (size_t)item * 4096, I, J, lane, acc);
#pragma unroll
            for (int g = 0; g < 16; ++g) Y[(32 * J + r) * SF + 32 * I + crow(g, hh)] = acc[g];
        }
        hn = mm_rA(a, HT, J, lane, hn);
        __syncthreads();
        tile_store_T(HT, I, J, lane, hn);
        if (on) {
            const int b = item >> 10, h = (item >> 8) & 3, c = item & 255; const int t = qtid >> 2, c16 = (qtid & 3) * 16;
            float y[16]; float s = 0.f;
#pragma unroll
            for (int e = 0; e < 16; ++e) { y[e] = Y[t * SF + c16 + e]; s += y[e]; }
            const float mu = quad_sum(s) * (1.f / 64.f); float s2 = 0.f;
#pragma unroll
            for (int e = 0; e < 16; ++e) { y[e] -= mu; s2 += y[e] * y[e]; }
            const float rstd = 1.0f / sqrtf(quad_sum(s2) * (1.f / 64.f) + 64e-5f);
            const u32x4* vg = (const u32x4*)(cw + O_VG + (size_t)item * 8192 + (t * 64 + c16) * 2); const u32x4* gg = (const u32x4*)(cw + O_GG + (size_t)item * 8192 + (t * 64 + c16) * 2);
            const float rk = *(const float*)(cw + O_RKD + (size_t)item * 256 + t * 4);
            unsigned ow[8];
#pragma unroll
            for (int hv = 0; hv < 2; ++hv) { const u32x4 vw = vg[hv], gw = gg[hv];
#pragma unroll
                for (int e2 = 0; e2 < 4; ++e2) { const int e = hv * 8 + 2 * e2; const int ch = h * 64 + c16 + e;
                    const float o0 = (y[e] * rstd * p.ln_g[ch] + p.ln_b[ch] + rk * bflo(vw[e2])) * bflo(gw[e2]);
                    const float o1 = (y[e + 1] * rstd * p.ln_g[ch + 1] + p.ln_b[ch + 1] + rk * bfhi(vw[e2])) * bfhi(gw[e2]);
                    ow[hv * 4 + e2] = pk2(o0, o1); } }
            u32x4* dst = (u32x4*)(MIXB + ((size_t)b * SEQ + (size_t)c * 64 + t) * 1024 + 512 + h * 64 + c16);
            dst[0] = (u32x4){ow[0], ow[1], ow[2], ow[3]}; dst[1] = (u32x4){ow[4], ow[5], ow[6], ow[7]};
        }
        __syncthreads();
    }
}

__device__ __forceinline__ void rwkv_stage3(CK_LAS unsigned char* ldsq, int item, const RwkvParams& p, const unsigned char* __restrict__ cw, bf16_t* __restrict__ MIXB, int SEQ) {
    const int tid = ltid(), lane = tid & 63, wid = __builtin_amdgcn_readfirstlane(tid >> 6), wq = wid & 3, I = wq >> 1, J = wq & 1, r = lane & 31, hh = lane >> 5, qtid = tid & 255;
    const lf32 Y = (lf32)ldsq;
    if (item >= 0) {
        f32x16 acc = frag_load((const float*)(cw + O_YL) + (size_t)item * 4096, wq, lane);
        acc = mm_gg((const bf16_t*)(cw + O_H0) + (size_t)item * 4096, (const bf16_t*)(cw + O_GY) + (size_t)item * 4096, I, J, lane, acc);
#pragma unroll
        for (int g = 0; g < 16; ++g) Y[(32 * J + r) * SF + 32 * I + crow(g, hh)] = acc[g];
    }
    __syncthreads();
    if (item >= 0) {
        const int b = item >> 10, h = (item >> 8) & 3, c = item & 255; const int t = qtid >> 2, c16 = (qtid & 3) * 16;
        float y[16]; float s = 0.f;
#pragma unroll
        for (int e = 0; e < 16; ++e) { y[e] = Y[t * SF + c16 + e]; s += y[e]; }
        const float mu = quad_sum(s) * (1.f / 64.f); float s2 = 0.f;
#pragma unroll
        for (int e = 0; e < 16; ++e) { y[e] -= mu; s2 += y[e] * y[e]; }
        const float rstd = 1.0f / sqrtf(quad_sum(s2) * (1.f / 64.f) + 64e-5f);
        const u32x4* vg = (const u32x4*)(cw + O_VG + (size_t)item * 8192 + (t * 64 + c16) * 2); const u32x4* gg = (const u32x4*)(cw + O_GG + (size_t)item * 8192 + (t * 64 + c16) * 2);
        const float rk = *(const float*)(cw + O_RKD + (size_t)item * 256 + t * 4);
        unsigned ow[8];
#pragma unroll
        for (int hv = 0; hv < 2; ++hv) { const u32x4 vw = vg[hv], gw = gg[hv];
#pragma unroll
            for (int e2 = 0; e2 < 4; ++e2) { const int e = hv * 8 + 2 * e2; const int ch = h * 64 + c16 + e;
                const float o0 = (y[e] * rstd * p.ln_g[ch] + p.ln_b[ch] + rk * bflo(vw[e2])) * bflo(gw[e2]);
                const float o1 = (y[e + 1] * rstd * p.ln_g[ch + 1] + p.ln_b[ch + 1] + rk * bfhi(vw[e2])) * bfhi(gw[e2]);
                ow[hv * 4 + e2] = pk2(o0, o1); } }
        u32x4* dst = (u32x4*)(MIXB + ((size_t)b * SEQ + (size_t)c * 64 + t) * 1024 + 512 + h * 64 + c16);
        dst[0] = (u32x4){ow[0], ow[1], ow[2], ow[3]}; dst[1] = (u32x4){ow[4], ow[5], ow[6], ow[7]};
    }
    __syncthreads();
}

__device__ __forceinline__ void rot16(float (&o)[16], const bf16_t* __restrict__ prow, int colbase, int c16, const float* __restrict__ ropet  ) {
    const u32x4* own = (const u32x4*)(prow + colbase + c16); const u32x4* par = (const u32x4*)(prow + colbase + (c16 ^ 32));
    const f32x4* cs = (const f32x4*)(ropet + 2 * (c16 & 31));
#pragma unroll
    for (int hv = 0; hv < 2; ++hv) { const u32x4 ow = own[hv], pw = par[hv];
#pragma unroll
        for (int e2 = 0; e2 < 4; ++e2) { const f32x4 csv = cs[hv * 4 + e2];
            const float x0 = bflo(ow[e2]), x1 = bfhi(ow[e2]), p0 = bflo(pw[e2]), p1 = bfhi(pw[e2]);
            o[hv * 8 + 2 * e2] = (c16 < 32) ? (x0 * csv[0] - p0 * csv[1]) : (p0 * csv[1] + x0 * csv[0]);
            o[hv * 8 + 2 * e2 + 1] = (c16 < 32) ? (x1 * csv[2] - p1 * csv[3]) : (p1 * csv[3] + x1 * csv[2]); } }
}
__device__ __forceinline__ void ret_stage1(CK_LAS unsigned char* ldsq, int item, const bf16_t* __restrict__ Pb, int PW, int C_TK, int C_TV, int SEQ, const float* __restrict__ ROPE, unsigned char* __restrict__ cw) {
    const int tid = ltid(), lane = tid & 63, wid = __builtin_amdgcn_readfirstlane(tid >> 6), wq = wid & 3, I = wq >> 1, J = wq & 1, qtid = tid & 255;
    const lbf VT = (lbf)ldsq, KdT = (lbf)(ldsq + B9);
    if (item >= 0) {
        const int b = item >> 10, h = (item >> 8) & 3, c = item & 255; const int t = qtid >> 2, c16 = (qtid & 3) * 16; const int pos = c * 64 + t;
        const bf16_t* prow = Pb + ((size_t)b * SEQ + pos) * PW;
        float kr[16]; rot16(kr, prow, C_TK + h * 64, c16, ROPE + (size_t)pos * 64);
        const float lg = __builtin_amdgcn_logf(1.0f - __builtin_amdgcn_exp2f(-5.0f - (float)h));
        const float dec = 0.125f * __builtin_amdgcn_exp2f(lg * (float)(63 - t));
        const u32x4* vp = (const u32x4*)(prow + C_TV + h * 64 + c16);
#pragma unroll
        for (int hv = 0; hv < 2; ++hv) { const u32x4 vw = vp[hv];
#pragma unroll
            for (int e2 = 0; e2 < 4; ++e2) { const int e = hv * 8 + 2 * e2;
                VT[(c16 + e) * SB + t] = (bf16_t)(vw[e2] & 0xffffu); VT[(c16 + e + 1) * SB + t] = (bf16_t)(vw[e2] >> 16);
                KdT[(c16 + e) * SB + t] = (bf16_t)f2bf(kr[e] * dec); KdT[(c16 + e + 1) * SB + t] = (bf16_t)f2bf(kr[e + 1] * dec); } }
    }
    __syncthreads();
    if (item >= 0) { const f32x16 kv = mm_lds(VT, KdT, I, J, lane, f32x16{}); frag_store_bf((bf16_t*)(cw + O_KV) + (size_t)item * 4096, wq, lane, kv); }
    __syncthreads();
}
__device__ __forceinline__ void ret_scan(int chain, unsigned char* __restrict__ cw) {
    const int tid = ltid(), lane = tid & 63, wid = __builtin_amdgcn_readfirstlane(tid >> 6), wq = wid & 3, I = wq >> 1, J = wq & 1, r = lane & 31, hh = lane >> 5;
    const int h = chain & 3; const float lg = __builtin_amdgcn_logf(1.0f - __builtin_amdgcn_exp2f(-5.0f - (float)h)); const float g64 = __builtin_amdgcn_exp2f(lg * 64.0f);
    const bf16_t* kvg = (const bf16_t*)(cw + O_KV) + (size_t)chain * 256 * 4096; bf16_t* rtg = (bf16_t*)(cw + O_RT) + (size_t)chain * 256 * 4096;
    f32x16 R = f32x16{}; constexpr int PD = 8; f32x16 nx[PD];
#pragma unroll
    for (int k = 0; k < PD; ++k) nx[k] = frag_load_bf(kvg + (size_t)k * 4096, wq, lane);
    for (int c = 0; c < 256; c += PD) {
#pragma unroll
        for (int k = 0; k < PD; ++k) { const int cc = c + k; bf16_t* dst = rtg + (size_t)cc * 4096;
#pragma unroll
            for (int g = 0; g < 16; ++g) dst[(32 * I + crow(g, hh)) * 64 + 32 * J + r] = (bf16_t)f2bf(R[g]);
            const f32x16 kvc = nx[k]; const int nn = cc + PD < 256 ? cc + PD : 255;
            nx[k] = frag_load_bf(kvg + (size_t)nn * 4096, wq, lane);
#pragma unroll
            for (int g = 0; g < 16; ++g) R[g] = R[g] * g64 + kvc[g]; }
    }
}
constexpr int L_RET3 = 4 * B9 + 64 * SF * 4;
__device__ __forceinline__ void ret_stage3(CK_LAS unsigned char* ldsq, int item, const bf16_t* __restrict__ Pb, int PW, int C_TQ, int C_TK, int C_TV, int C_TG, int SEQ, const float* __restrict__ ROPE,
                                           const float* __restrict__ gn_g, const unsigned char* __restrict__ cw, bf16_t* __restrict__ MIXB) {
    const int tid = ltid(), lane = tid & 63, wid = __builtin_amdgcn_readfirstlane(tid >> 6), wq = wid & 3, I = wq >> 1, J = wq & 1, r = lane & 31, hh = lane >> 5, qtid = tid & 255;
    const lbf Qr = (lbf)ldsq, Kr = (lbf)(ldsq + B9), VT = (lbf)(ldsq + 2 * B9), Sb = (lbf)(ldsq + 3 * B9); const lf32 Y = (lf32)(ldsq + 4 * B9);
    const int b = item >= 0 ? item >> 10 : 0, h = item >= 0 ? (item >> 8) & 3 : 0, c = item >= 0 ? item & 255 : 0; const int t = qtid >> 2, c16 = (qtid & 3) * 16; const int pos = c * 64 + t;
    const float lg = __builtin_amdgcn_logf(1.0f - __builtin_amdgcn_exp2f(-5.0f - (float)h));
    const bf16_t* prow = Pb + ((size_t)b * SEQ + pos) * PW;
    if (item >= 0) {
        float qr[16], kr[16]; rot16(qr, prow, C_TQ + h * 64, c16, ROPE + (size_t)pos * 64); rot16(kr, prow, C_TK + h * 64, c16, ROPE + (size_t)pos * 64);
        u32x4 w;
        w.x = pk2(qr[0], qr[1]); w.y = pk2(qr[2], qr[3]); w.z = pk2(qr[4], qr[5]); w.w = pk2(qr[6], qr[7]); *(CK_LAS u32x4*)(Qr + t * SB + c16) = w;
        w.x = pk2(qr[8], qr[9]); w.y = pk2(qr[10], qr[11]); w.z = pk2(qr[12], qr[13]); w.w = pk2(qr[14], qr[15]); *(CK_LAS u32x4*)(Qr + t * SB + c16 + 8) = w;
#pragma unroll
        for (int e = 0; e < 16; ++e) kr[e] *= 0.125f;
        w.x = pk2(kr[0], kr[1]); w.y = pk2(kr[2], kr[3]); w.z = pk2(kr[4], kr[5]); w.w = pk2(kr[6], kr[7]); *(CK_LAS u32x4*)(Kr + t * SB + c16) = w;
        w.x = pk2(kr[8], kr[9]); w.y = pk2(kr[10], kr[11]); w.z = pk2(kr[12], kr[13]); w.w = pk2(kr[14], kr[15]); *(CK_LAS u32x4*)(Kr + t * SB + c16 + 8) = w;
        const u32x4* vp = (const u32x4*)(prow + C_TV + h * 64 + c16);
#pragma unroll
        for (int hv = 0; hv < 2; ++hv) { const u32x4 vw = vp[hv];
#pragma unroll
            for (int e2 = 0; e2 < 4; ++e2) { const int e = hv * 8 + 2 * e2; VT[(c16 + e) * SB + t] = (bf16_t)(vw[e2] & 0xffffu); VT[(c16 + e + 1) * SB + t] = (bf16_t)(vw[e2] >> 16); } }
    }
    __syncthreads();
    if (item >= 0) {
        f32x16 st = mm_lds(Kr, Qr, I, J, lane, f32x16{}); const int tt = 32 * J + r;
#pragma unroll
        for (int g = 0; g < 16; ++g) { const int ii = 32 * I + crow(g, hh); st[g] = (ii <= tt) ? st[g] * __builtin_amdgcn_exp2f(lg * (float)(tt - ii)) : 0.f; }
        tile_store_T(Sb, I, J, lane, st);
    }
    __syncthreads();
    if (item >= 0) {
        const f32x16 yi = mm_lds(VT, Sb, I, J, lane, f32x16{}); const f32x16 yc = mm_gA((const bf16_t*)(cw + O_RT) + (size_t)item * 4096, Qr, I, J, lane, f32x16{});
        const int tt = 32 * J + r; const float qd = __builtin_amdgcn_exp2f(lg * (float)(tt + 1));
#pragma unroll
        for (int g = 0; g < 16; ++g) Y[tt * SF + 32 * I + crow(g, hh)] = yi[g] + qd * yc[g];
    }
    __syncthreads();
    if (item >= 0) {
        float y[16]; float s = 0.f;
#pragma unroll
        for (int e = 0; e < 16; ++e) { y[e] = Y[t * SF + c16 + e]; s += y[e]; }
        const float mu = quad_sum(s) * (1.f / 64.f); float s2 = 0.f;
#pragma unroll
        for (int e = 0; e < 16; ++e) { y[e] -= mu; s2 += y[e] * y[e]; }
        const float rstd = 1.0f / sqrtf(quad_sum(s2) * (1.f / 64.f) + 1e-6f);
        const u32x4* gp = (const u32x4*)(prow + C_TG + h * 64 + c16); unsigned ow[8];
#pragma unroll
        for (int hv = 0; hv < 2; ++hv) { const u32x4 gw = gp[hv];
#pragma unroll
            for (int e2 = 0; e2 < 4; ++e2) { const int e = hv * 8 + 2 * e2; const int ch = h * 64 + c16 + e; const float g0 = bflo(gw[e2]), g1 = bfhi(gw[e2]);
                ow[hv * 4 + e2] = pk2(y[e] * rstd * gn_g[ch] * (g0 * sigm(g0)), y[e + 1] * rstd * gn_g[ch + 1] * (g1 * sigm(g1))); } }
        u32x4* dst = (u32x4*)(MIXB + ((size_t)b * SEQ + pos) * 1024 + 768 + h * 64 + c16);
        dst[0] = (u32x4){ow[0], ow[1], ow[2], ow[3]}; dst[1] = (u32x4){ow[4], ow[5], ow[6], ow[7]};
    }
    __syncthreads();
}
__device__ __forceinline__ void ret_level1(int task, unsigned char* __restrict__ cw) {
    const int tid = ltid(), lane = tid & 63, wid = __builtin_amdgcn_readfirstlane(tid >> 6), wq = wid & 3;
    const int h = (task >> 5) & 3; const float lg = __builtin_amdgcn_logf(1.0f - __builtin_amdgcn_exp2f(-5.0f - (float)h)); const float g64 = __builtin_amdgcn_exp2f(lg * 64.0f);
    const bf16_t* kvg = (const bf16_t*)(cw + O_KV) + ((size_t)(task >> 5) * 256 + (size_t)(task & 31) * 8) * 4096;
    f32x16 kv[8];
#pragma unroll
    for (int j = 0; j < 8; ++j) kv[j] = frag_load_bf(kvg + (size_t)j * 4096, wq, lane);
    f32x16 acc = kv[0];
#pragma unroll
    for (int j = 1; j < 8; ++j)
#pragma unroll
        for (int g = 0; g < 16; ++g) acc[g] = acc[g] * g64 + kv[j][g];
    frag_store((float*)(cw + O_KG) + (size_t)task * 4096, wq, lane, acc);
}
__device__ __forceinline__ void ret_scan_groups(int chain, unsigned char* __restrict__ cw) {
    const int tid = ltid(), lane = tid & 63, wid = __builtin_amdgcn_readfirstlane(tid >> 6), wq = wid & 3;
    const int h = chain & 3; const float lg = __builtin_amdgcn_logf(1.0f - __builtin_amdgcn_exp2f(-5.0f - (float)h)); const float g512 = __builtin_amdgcn_exp2f(lg * 512.0f);
    const float* kgg = (const float*)(cw + O_KG) + (size_t)chain * 32 * 4096; float* rgg = (float*)(cw + O_RG) + (size_t)chain * 32 * 4096;
    f32x16 R = f32x16{}; f32x16 nx[4];
#pragma unroll
    for (int k = 0; k < 4; ++k) nx[k] = frag_load(kgg + (size_t)k * 4096, wq, lane);
    for (int c = 0; c < 32; c += 4) {
#pragma unroll
        for (int k = 0; k < 4; ++k) { const int cc = c + k; frag_store(rgg + (size_t)cc * 4096, wq, lane, R);
            const f32x16 kvc = nx[k]; const int nn = cc + 4 < 32 ? cc + 4 : 31; nx[k] = frag_load(kgg + (size_t)nn * 4096, wq, lane);
#pragma unroll
            for (int g = 0; g < 16; ++g) R[g] = R[g] * g512 + kvc[g]; }
    }
}
constexpr int L_RET3G = 5 * B9 + 64 * SF * 4;
__device__ __forceinline__ void ret_stage3g(CK_LAS unsigned char* ldsq, int task, const bf16_t* __restrict__ Pb, int PW, int C_TQ, int C_TK, int C_TV, int C_TG, int SEQ, const float* __restrict__ ROPE,
                                           const float* __restrict__ gn_g, const unsigned char* __restrict__ cw, bf16_t* __restrict__ MIXB) {
    const int tid = ltid(), lane = tid & 63, wid = __builtin_amdgcn_readfirstlane(tid >> 6), wq = wid & 3, I = wq >> 1, J = wq & 1, r = lane & 31, hh = lane >> 5, qtid = tid & 255;
    const lbf Qr = (lbf)ldsq, Kr = (lbf)(ldsq + B9), VT = (lbf)(ldsq + 2 * B9), Sb = (lbf)(ldsq + 3 * B9), RTL = (lbf)(ldsq + 4 * B9); const lf32 Y = (lf32)(ldsq + 5 * B9);
    const int tk = task >= 0 ? task : 0; const int item0 = (tk >> 5) * 256 + (tk & 31) * 8;
    f32x16 R = frag_load((const float*)(cw + O_RG) + (size_t)tk * 4096, wq, lane);
    for (int j = 0; j < 8; ++j) { const int item = task >= 0 ? item0 + j : -1;
    const int b = item >= 0 ? item >> 10 : 0, h = item >= 0 ? (item >> 8) & 3 : 0, c = item >= 0 ? item & 255 : 0; const int t = qtid >> 2, c16 = (qtid & 3) * 16; const int pos = c * 64 + t;
    const float lg = __builtin_amdgcn_logf(1.0f - __builtin_amdgcn_exp2f(-5.0f - (float)h));
    const bf16_t* prow = Pb + ((size_t)b * SEQ + pos) * PW;
    if (item >= 0) {
#pragma unroll
        for (int g_ = 0; g_ < 16; ++g_) RTL[(32 * I + crow(g_, hh)) * SB + 32 * J + r] = (bf16_t)f2bf(R[g_]);
        float qr[16], kr[16]; rot16(qr, prow, C_TQ + h * 64, c16, ROPE + (size_t)pos * 64); rot16(kr, prow, C_TK + h * 64, c16, ROPE + (size_t)pos * 64);
        u32x4 w;
        w.x = pk2(qr[0], qr[1]); w.y = pk2(qr[2], qr[3]); w.z = pk2(qr[4], qr[5]); w.w = pk2(qr[6], qr[7]); *(CK_LAS u32x4*)(Qr + t * SB + c16) = w;
        w.x = pk2(qr[8], qr[9]); w.y = pk2(qr[10], qr[11]); w.z = pk2(qr[12], qr[13]); w.w = pk2(qr[14], qr[15]); *(CK_LAS u32x4*)(Qr + t * SB + c16 + 8) = w;
#pragma unroll
        for (int e = 0; e < 16; ++e) kr[e] *= 0.125f;
        w.x = pk2(kr[0], kr[1]); w.y = pk2(kr[2], kr[3]); w.z = pk2(kr[4], kr[5]); w.w = pk2(kr[6], kr[7]); *(CK_LAS u32x4*)(Kr + t * SB + c16) = w;
        w.x = pk2(kr[8], kr[9]); w.y = pk2(kr[10], kr[11]); w.z = pk2(kr[12], kr[13]); w.w = pk2(kr[14], kr[15]); *(CK_LAS u32x4*)(Kr + t * SB + c16 + 8) = w;
        const u32x4* vp = (const u32x4*)(prow + C_TV + h * 64 + c16);
#pragma unroll
        for (int hv = 0; hv < 2; ++hv) { const u32x4 vw = vp[hv];
#pragma unroll
            for (int e2 = 0; e2 < 4; ++e2) { const int e = hv * 8 + 2 * e2; VT[(c16 + e) * SB + t] = (bf16_t)(vw[e2] & 0xffffu); VT[(c16 + e + 1) * SB + t] = (bf16_t)(vw[e2] >> 16); } }
    }
    __syncthreads();
    if (item >= 0) {
        f32x16 st = mm_lds(Kr, Qr, I, J, lane, f32x16{}); const int tt = 32 * J + r;
#pragma unroll
        for (int g = 0; g < 16; ++g) { const int ii = 32 * I + crow(g, hh); st[g] = (ii <= tt) ? st[g] * __builtin_amdgcn_exp2f(lg * (float)(tt - ii)) : 0.f; }
        tile_store_T(Sb, I, J, lane, st);
    }
    __syncthreads();
    if (item >= 0) {
        const f32x16 yi = mm_lds(VT, Sb, I, J, lane, f32x16{}); const f32x16 yc = mm_lds(RTL, Qr, I, J, lane, f32x16{});
        const int tt = 32 * J + r; const float qd = __builtin_amdgcn_exp2f(lg * (float)(tt + 1));
#pragma unroll
        for (int g = 0; g < 16; ++g) Y[tt * SF + 32 * I + crow(g, hh)] = yi[g] + qd * yc[g];
    }
    __syncthreads();
    if (item >= 0) {
        float y[16]; float s = 0.f;
#pragma unroll
        for (int e = 0; e < 16; ++e) { y[e] = Y[t * SF + c16 + e]; s += y[e]; }
        const float mu = quad_sum(s) * (1.f / 64.f); float s2 = 0.f;
#pragma unroll
        for (int e = 0; e < 16; ++e) { y[e] -= mu; s2 += y[e] * y[e]; }
        const float rstd = 1.0f / sqrtf(quad_sum(s2) * (1.f / 64.f) + 1e-6f);
        const u32x4* gp = (const u32x4*)(prow + C_TG + h * 64 + c16); unsigned ow[8];
#pragma unroll
        for (int hv = 0; hv < 2; ++hv) { const u32x4 gw = gp[hv];
#pragma unroll
            for (int e2 = 0; e2 < 4; ++e2) { const int e = hv * 8 + 2 * e2; const int ch = h * 64 + c16 + e; const float g0 = bflo(gw[e2]), g1 = bfhi(gw[e2]);
                ow[hv * 4 + e2] = pk2(y[e] * rstd * gn_g[ch] * (g0 * sigm(g0)), y[e + 1] * rstd * gn_g[ch + 1] * (g1 * sigm(g1))); } }
        u32x4* dst = (u32x4*)(MIXB + ((size_t)b * SEQ + pos) * 1024 + 768 + h * 64 + c16);
        dst[0] = (u32x4){ow[0], ow[1], ow[2], ow[3]}; dst[1] = (u32x4){ow[4], ow[5], ow[6], ow[7]};
    }
    if (item >= 0) { const f32x16 kvc = frag_load_bf((const bf16_t*)(cw + O_KV) + (size_t)item * 4096, wq, lane); const float g64 = __builtin_amdgcn_exp2f(lg * 64.0f);
#pragma unroll
        for (int g_ = 0; g_ < 16; ++g_) R[g_] = R[g_] * g64 + kvc[g_]; }
    __syncthreads();
    }
}
}

__device__ __forceinline__ void tr_tile(const float* __restrict__ src, size_t ld_src, bf16* __restrict__ dst, size_t ld_dst, float* scr, int lane) {
    pg8::f32x4 v[16];
#pragma unroll
    for (int i = 0; i < 16; ++i) v[i] = *(const pg8::f32x4*)(src + (size_t)(i * 4 + (lane >> 4)) * ld_src + (lane & 15) * 4);
#pragma unroll
    for (int i = 0; i < 16; ++i) { float* p = scr + (i * 4 + (lane >> 4)) * 65 + (lane & 15) * 4; p[0] = v[i][0]; p[1] = v[i][1]; p[2] = v[i][2]; p[3] = v[i][3]; }
    asm volatile("s_waitcnt lgkmcnt(0)" ::: "memory");
#pragma unroll
    for (int i = 0; i < 8; ++i) { const int n = i * 8 + (lane >> 3), kc = (lane & 7) * 8; const float* s = scr + kc * 65 + n;
        pg8::u32x4 o; o.x = pk2(s[0], s[65]); o.y = pk2(s[2 * 65], s[3 * 65]); o.z = pk2(s[4 * 65], s[5 * 65]); o.w = pk2(s[6 * 65], s[7 * 65]);
        *(pg8::u32x4*)(dst + (size_t)n * ld_dst + kc) = o; }
    asm volatile("s_waitcnt lgkmcnt(0)" ::: "memory");
}

constexpr int CV_13 = NE * 16 * 16, CV_2 = NE * 8 * 16, CV_L = CV_13 + CV_2, NCONV = DEPTH * CV_L;
__device__ __forceinline__ void conv_item(int it, const float* __restrict__ w1, const float* __restrict__ w3, const float* __restrict__ w2, bf16* __restrict__ W13, bf16* __restrict__ W2, float* scr, int lane) {
    const int l = it / CV_L; int r = it % CV_L;
    if (r < CV_13) { const int e = r >> 8, kb = (r >> 4) & 15, nb = r & 15;
        const int pn = nb >> 2, q = nb & 3; const float* srcw = (q < 2 ? w1 : w3) + ((size_t)l * NE + e) * DM * DE;
        tr_tile(srcw + (size_t)kb * 64 * DE + pn * 128 + (q & 1) * 64, DE, W13 + ((size_t)l * NE + e) * DM * DM + (size_t)nb * 64 * DM + kb * 64, DM, scr, lane); }
    else { r -= CV_13; const int e = r >> 7, kb = (r >> 4) & 7, nb = r & 15;
        tr_tile(w2 + ((size_t)l * NE + e) * DE * DM + (size_t)kb * 64 * DM + nb * 64, DM, W2 + ((size_t)l * NE + e) * DM * DE + (size_t)nb * 64 * DE + kb * 64, DE, scr, lane); }
}

#define LAS __attribute__((address_space(3)))
#define XB_TMO      128
#define XB_XCNT(j)  (256  + 64 * (j))
#define XB_XSUB(j)  (1280 + 64 * (j))
#define XB_XGEN(j)  (2304 + 64 * (j))
#define XB_TOP      3328
#define XB_TOPGEN   3392
#define XCD_BAR_WORDS 3456
#define XB_SPIN_CAP (1u << 18)

__device__ __forceinline__ unsigned xb_ld(unsigned* p)              { return __hip_atomic_load(p, __ATOMIC_RELAXED, __HIP_MEMORY_SCOPE_AGENT); }
__device__ __forceinline__ unsigned xb_add(unsigned* p, unsigned v) { return __hip_atomic_fetch_add(p, v, __ATOMIC_RELAXED, __HIP_MEMORY_SCOPE_AGENT); }
__device__ __forceinline__ unsigned xb_xcc_id() { return (unsigned)__builtin_amdgcn_s_getreg((3 << 11) | 20) & 0xFu; }
#define XB_SPIN(cond, bar) do { unsigned _sp = 0; while (cond) { __builtin_amdgcn_s_sleep(1); \
    if ((++_sp & 255u) == 0u) { if (xb_ld(&(bar)[XB_TMO])) break; if (_sp > XB_SPIN_CAP) { atomicAdd(&(bar)[XB_TMO], 1u); break; } } } } while (0)

struct XcdBarrier {
    unsigned* bar; unsigned x;
    volatile LAS unsigned* st;
};

__device__ __forceinline__ XcdBarrier xcd_barrier_post(unsigned* bar, volatile LAS unsigned* st) {
    XcdBarrier b; b.bar = bar; b.x = xb_xcc_id(); b.st = st;
    if (ltid() == 0) (void)xb_add(&bar[XB_XCNT(b.x)], 1u);
    return b;
}
__device__ __forceinline__ void xcd_barrier_complete(unsigned* bar, unsigned x, unsigned& nloc, unsigned& nx) {
    const unsigned G = gridDim.x * gridDim.y * gridDim.z;
    unsigned sum, cnt, mine, sp = 0u;
    for (;;) {
        sum = 0u; cnt = 0u; mine = 0u;
#pragma unroll
        for (unsigned j = 0; j < 16; ++j) { const unsigned c = xb_ld(&bar[XB_XCNT(j)]); sum += c; cnt += (c > 0u) ? 1u : 0u; mine = (j == x) ? c : mine; }
        if (sum == G) break;
        __builtin_amdgcn_s_sleep(1);
        if ((++sp & 255u) == 0u) { if (xb_ld(&bar[XB_TMO])) break; if (sp > XB_SPIN_CAP) { atomicAdd(&bar[XB_TMO], 1u); break; } }
    }
    nloc = mine > 0u ? mine : 1u; nx = cnt > 0u ? cnt : 1u;
}

__device__ __forceinline__ void xcd_barrier(const XcdBarrier& b) {
    asm volatile("s_waitcnt vmcnt(0)" ::: "memory");
    __syncthreads();
    if (ltid() == 0) {
        unsigned* bar = b.bar; asm volatile("" : "+s"(bar)); unsigned bx_ = b.x; asm volatile("" : "+s"(bx_));
        __builtin_amdgcn_s_waitcnt(0);
        unsigned nloc = b.st[0], nx = b.st[1];
        if (nloc == 0u) { xcd_barrier_complete(bar, bx_, nloc, nx); b.st[0] = nloc; b.st[1] = nx; }
        const unsigned old = xb_add(&bar[XB_XSUB(bx_)], 1u);
        const unsigned gen = old / nloc;
        if (old + 1u == (gen + 1u) * nloc) {
            __builtin_amdgcn_fence(__ATOMIC_RELEASE, "agent");
            asm volatile("s_waitcnt vmcnt(0)" ::: "memory");
            const unsigned og = xb_add(&bar[XB_TOP], 1u);
            const unsigned tg = og / nx;
            if (og + 1u == (tg + 1u) * nx) xb_add(&bar[XB_TOPGEN], 1u);
            else XB_SPIN(xb_ld(&bar[XB_TOPGEN]) == tg, bar);
            __builtin_amdgcn_fence(__ATOMIC_ACQUIRE, "agent");
            xb_add(&bar[XB_XGEN(bx_)], 1u);
            asm volatile("s_waitcnt vmcnt(0)" ::: "memory");
        } else {
            XB_SPIN(xb_ld(&bar[XB_XGEN(bx_)]) == gen, bar);
            __builtin_amdgcn_fence(__ATOMIC_ACQUIRE, "agent");
            asm volatile("s_waitcnt vmcnt(0)" ::: "memory");
        }
    }
    __syncthreads();
}


__global__ void __launch_bounds__(NTHREADS, 2) mk_fwd(Args args) {
    extern __shared__ __attribute__((aligned(16))) unsigned char lds_raw[];
    float* lds = (float*)lds_raw;
    const int tid = ltid(), lane = tid & 63, wid = __builtin_amdgcn_readfirstlane(tid >> 6);
    const int G = gridDim.x, bx = blockIdx.x;
    unsigned char* ws = args.ws;
    unsigned* ctl = (unsigned*)(ws + WS_CTL);
    float* X = args.out;
    bf16* XB = (bf16*)(ws + WS_XB);
    bf16* Pb = (bf16*)(ws + WS_P);
    bf16* WIN = (bf16*)(ws + WS_WIN); bf16* WOUT = (bf16*)(ws + WS_WOUT); bf16* W13 = (bf16*)(ws + WS_W13); bf16* W2 = (bf16*)(ws + WS_W2);
    float* ROPE = (float*)(ws + WS_ROPE);
    double* LCS = (double*)(ws + WS_LCS); double* TOT = (double*)(ws + WS_TOT);
    float* BE = (float*)(ws + WS_SKIP); float* QN2 = BE + 16 * 256; float* KN2 = QN2 + 16 * 128; float* SQM = KN2 + 16 * 128;
    unsigned char* KA = ws + WS_KA;
    unsigned char* cw = ws + WS_CK; bf16* LWT = (bf16*)(ws + WS_LW);
    int* EP = (int*)(ws + WS_EP);
    float* GATE = (float*)(ws + WS_GATE);
    bf16* MIXB = (bf16*)(ws + WS_MIXB);
    int* LIST = (int*)(ws + WS_XP); bf16* Hb = (bf16*)(ws + WS_H); bf16* YP = (bf16*)(ws + WS_YP); bf16* YO = (bf16*)(ws + WS_YO);
    typedef pg8::f32x4 f32x4;
    volatile LAS unsigned* MISC = (volatile LAS unsigned*)((LAS unsigned char*)lds_raw + LDS_MISC);
    for (int u = tid; u < (LDS_ALL - LDS_MISC) / 4; u += NTHREADS) MISC[u] = 0u;
    __syncthreads();
    XcdBarrier bar = xcd_barrier_post(ctl + CW_BAR, MISC + 8);
#define GRID_BAR() xcd_barrier(bar)
    unsigned long long tp_acc = 0ull, tp_t0 = 0ull; (void)tp_acc; (void)tp_t0;

    for (int rep_ = 0; rep_ < REP_P0; ++rep_) {
            const int tid = ltid(), lane = tid & 63, wid = __builtin_amdgcn_readfirstlane(tid >> 6); (void)lane; (void)wid;
        const f32x4* xi = (const f32x4*)args.in[0]; uint2* xb = (uint2*)XB;
        for (size_t i = (size_t)bx * NTHREADS + tid; i < (size_t)T * DM / 4; i += (size_t)G * NTHREADS) { const f32x4 v = xi[i]; xb[i] = make_uint2(pk2(v[0], v[1]), pk2(v[2], v[3])); }
        for (int i = bx * NTHREADS + tid; i < SEQ * 32; i += G * NTHREADS) {
            const int pos = i >> 5, f = i & 31;
            const double inv = pow(10000.0, -(double)f / 32.0);
            const double ang = (double)pos * inv;
            ROPE[2 * i] = (float)cos(ang); ROPE[2 * i + 1] = (float)sin(ang);
        }
        { bf16* WR = (bf16*)(ws + WS_WR);
          for (int i = bx * NTHREADS + tid; i < DEPTH * 48 * 1024; i += G * NTHREADS) { const int l_ = i / (48 * 1024), o = (i / 1024) % 48, k = i & 1023;
              const float wv = o < 4 ? args.in[21][((size_t)l_ * DM + k) * 4 + o] : (o < 36 ? args.in[23][((size_t)l_ * DM + k) * 32 + (o - 4)] : 0.f);
              const unsigned hi_ = f2bf(wv); const unsigned lo_ = f2bf(wv - bf2f((unsigned short)hi_));
              WR[((size_t)l_ * 2 + 0) * 48 * 1024 + o * 1024 + k] = (bf16)hi_; WR[((size_t)l_ * 2 + 1) * 48 * 1024 + o * 1024 + k] = (bf16)lo_; } }
        for (int i = bx * NTHREADS + tid; i < DEPTH * 256 * 256; i += G * NTHREADS) {
            const int l = i >> 16, rem = i & 65535, chg = rem >> 8, ii = rem & 255;
            if (ii < 64) LWT[((size_t)l * 256 + chg) * 64 + ii] = (bf16)f2bf(args.in[6][((size_t)l * 64 + ii) * 256 + chg]);
            else if (ii < 128) LWT[(size_t)DEPTH * 256 * 64 + ((size_t)l * 256 + chg) * 64 + (ii - 64)] = (bf16)f2bf(args.in[8][((size_t)l * 64 + (ii - 64)) * 256 + chg]);
            else LWT[(size_t)2 * DEPTH * 256 * 64 + ((size_t)l * 256 + chg) * 128 + (ii - 128)] = (bf16)f2bf(args.in[9][((size_t)l * 128 + (ii - 128)) * 256 + chg]);
        }
        float* scr = lds + wid * (64 * 65);
        constexpr int I_IN = 16 * 56, I_OUT = 16 * 16, I_L = I_IN + I_OUT;
        for (int it = bx * 8 + wid; it < DEPTH * I_L; it += G * 8) {
            const int l = it / I_L; int r = it % I_L;
            if (r < I_IN) { const int kb = r / 56, nb = r % 56; const int nsrc = nb * 64 + (nb >= 24 ? 8 : 0);
                tr_tile(args.in[1] + (size_t)l * DM * INW + (size_t)kb * 64 * INW + nsrc, INW, WIN + (size_t)l * PW * DM + (size_t)nb * 64 * DM + kb * 64, DM, scr, lane); }
            else { r -= I_IN; const int kb = r / 16, nb = r % 16;
                tr_tile(args.in[16] + (size_t)l * DM * DM + (size_t)kb * 64 * DM + nb * 64, DM, WOUT + (size_t)l * DM * DM + (size_t)nb * 64 * DM + kb * 64, DM, scr, lane); }
        }
        __syncthreads();
        {
            const float* wf = args.in[1] + O_FF; const float* fbias = args.in[2];
            float w[8][16];
#pragma unroll
            for (int jq = 0; jq < 4; ++jq)
#pragma unroll
                for (int e = 0; e < 4; ++e)
#pragma unroll
                    for (int h = 0; h < 8; ++h) w[h][jq * 4 + e] = wf[(size_t)(jq * 256 + lane * 4 + e) * INW + h];
            float* ffl = lds;
            for (int ch = bx; ch < T / 128; ch += G) {
                __syncthreads();
                for (int i = 0; i < 16; ++i) { const int tl = wid * 16 + i; const size_t m = (size_t)ch * 128 + tl;
                    float acc[8];
#pragma unroll
                    for (int h = 0; h < 8; ++h) acc[h] = 0.f;
#pragma unroll
                    for (int jq = 0; jq < 4; ++jq) { const f32x4 xv = *(const f32x4*)(args.in[0] + m * DM + jq * 256 + lane * 4);
#pragma unroll
                        for (int e = 0; e < 4; ++e)
#pragma unroll
                            for (int h = 0; h < 8; ++h) acc[h] += xv[e] * w[h][jq * 4 + e]; }
#pragma unroll
                    for (int h = 0; h < 8; ++h) acc[h] = wave_sum(acc[h]);
                    if (lane < 8) { float v = acc[0];
#pragma unroll
                        for (int h = 1; h < 8; ++h) v = (lane == h) ? acc[h] : v;
                        ffl[tl * 8 + lane] = v + fbias[lane]; } }
                __syncthreads();
                {
                    const int h = wid; const int bb = (ch * 128) / SEQ, t0 = (ch * 128) % SEQ; double carry = 0.0;
#pragma unroll
                    for (int half = 0; half < 2; ++half) { double v = (double)logsigmoidf_(ffl[(half * 64 + lane) * 8 + h]);
#pragma unroll
                        for (int o = 1; o < 64; o <<= 1) { const double n = __shfl_up(v, o); if (lane >= o) v += n; }
                        v += carry; LCS[(size_t)(bb * 8 + h) * SEQ + t0 + half * 64 + lane] = v; carry = __shfl(v, 63); }
                    if (lane == 0) TOT[(bb * 8 + h) * 128 + t0 / 128] = carry;
                }
            }
            __syncthreads();
        }
    }
    GRID_BAR();

    for (int l = 0; l < DEPTH; ++l) {
        for (int rep_ = 0; rep_ < REP_A; ++rep_) {
            const int tid = ltid(), lane = tid & 63, wid = __builtin_amdgcn_readfirstlane(tid >> 6); (void)lane; (void)wid;
            pg8::Gemm g{XB, WIN + (size_t)l * PW * DM, T, PW, DM}; pg8::StaticOrder S; S.init(T, PW, G, bx);
            pg8::EpiInProj E{Pb, PW, QC2};
            pg8::gemm_phase<pg8::EpiInProj, pg8::StaticOrder, true, true>((PG8_LAS unsigned char*)lds_raw, g, S, E);
        }
        GRID_BAR();
        for (int rep_ = 0; rep_ < REP_C; ++rep_) {
            const int tid = ltid(), lane = tid & 63, wid = __builtin_amdgcn_readfirstlane(tid >> 6); (void)lane; (void)wid;
            TP_BEGIN(6);
            for (int ch = bx; ch < T / 128; ch += G) {
                const int h = wid; const int bb = (ch * 128) / SEQ, t0 = (ch * 128) % SEQ, ci = t0 / 128;
                double pre = 0.0;
                { const double* tp = TOT + (bb * 8 + h) * 128; double a = (lane < ci) ? tp[lane] : 0.0; a += (lane + 64 < ci) ? tp[lane + 64] : 0.0;
#pragma unroll
                  for (int o = 1; o < 64; o <<= 1) a += __shfl_xor(a, o);
                  pre = a; }
#pragma unroll
                for (int half = 0; half < 2; ++half) { const int t = t0 + half * 64 + lane; const double v = pre + LCS[(size_t)(bb * 8 + h) * SEQ + t];
                    const double bd = -v * 1.4426950408889634; const unsigned h_ = f2bf((float)bd); const double r1 = bd - (double)bf2f((unsigned short)h_);
                    const unsigned m_ = f2bf((float)r1); const double r2 = r1 - (double)bf2f((unsigned short)m_); const unsigned l_ = f2bf((float)r2);
                    *(pg8::u32x4*)(KA + ((size_t)(bb * 8 + h) * SEQ + t) * 16) = (pg8::u32x4){h_ | (m_ << 16), l_ | (0x3f80u << 16), 0x3f803f80u, 0u};
                    if (lane == 63) BE[(bb * 8 + h) * 256 + t / 64] = (float)bd; }
                { LAS unsigned* nrm = (LAS unsigned*)lds_raw;
                  __syncthreads();
                  if (tid < 24) nrm[tid] = tid < 16 ? 0u : 0xffffffffu;
                  __syncthreads();
                  const int tl = tid >> 2, part = tid & 3; const bf16* prow = Pb + ((size_t)ch * 128 + tl) * PW;
                  pg8::u32x4 qv_[2][8], kv_[2][8];
#pragma unroll
                  for (int hq = 0; hq < 2; ++hq)
#pragma unroll
                      for (int v8 = 0; v8 < 8; ++v8) { qv_[hq][v8] = ((const pg8::u32x4*)(prow + C_FQ + (part * 2 + hq) * 64))[v8]; kv_[hq][v8] = ((const pg8::u32x4*)(prow + C_FK + (part * 2 + hq) * 64))[v8]; }
#pragma unroll
                  for (int hq = 0; hq < 2; ++hq) { const int hd = part * 2 + hq; float sq_ = 0.f, sk_ = 0.f, dt_ = 0.f;
#pragma unroll
                      for (int v8 = 0; v8 < 8; ++v8)
#pragma unroll
                          for (int e = 0; e < 4; ++e) { const float ql_ = __builtin_bit_cast(float, qv_[hq][v8][e] << 16), qh_ = __builtin_bit_cast(float, qv_[hq][v8][e] & 0xffff0000u);
                              const float kl_ = __builtin_bit_cast(float, kv_[hq][v8][e] << 16), kh_ = __builtin_bit_cast(float, kv_[hq][v8][e] & 0xffff0000u);
                              sq_ += ql_ * ql_ + qh_ * qh_; sk_ += kl_ * kl_ + kh_ * kh_; dt_ += ql_ * kl_ + qh_ * kh_; }
                      atomicMax((unsigned*)(nrm + hd), __float_as_uint(sq_)); atomicMax((unsigned*)(nrm + 8 + hd), __float_as_uint(sk_));
                      const unsigned db_ = __float_as_uint(dt_); atomicMin((unsigned*)(nrm + 16 + hd), db_ ^ ((db_ >> 31) ? 0xffffffffu : 0x80000000u)); }
                  __syncthreads();
                  if (tid < 16) { const int hd = tid & 7; ((tid < 8) ? QN2 : KN2)[(bb * 8 + hd) * 128 + ci] = __uint_as_float(nrm[tid]); }
                  else if (tid < 24) { const unsigned u_ = nrm[tid]; SQM[(bb * 8 + (tid & 7)) * 128 + ci] = __uint_as_float(u_ ^ ((u_ >> 31) ? 0x80000000u : 0xffffffffu)); }
                }
            }
            __syncthreads();
            const ck::RwkvParams rp{args.in[3] + l * 768, args.in[4] + l * 256, args.in[5] + l * 256, args.in[7] + l * 256, args.in[10] + l * 256, args.in[11] + l * 256, args.in[12] + l * 256,
                                    args.in[13] + l * 256, args.in[14] + l * 256, args.in[15] + l * 256,
                                    LWT + (size_t)l * 256 * 64, LWT + (size_t)DEPTH * 256 * 64 + (size_t)l * 256 * 64, LWT + (size_t)2 * DEPTH * 256 * 64 + (size_t)l * 256 * 128};
#ifndef REP_S1
#define REP_S1 1
#endif
#ifndef REP_R1
#define REP_R1 1
#endif
            TP_END(6);
            TP_BEGIN(7);
            for (int rr_ = 0; rr_ < REP_S1; ++rr_)
            for (int it = bx; it < 2048; it += G) ck::rwkv_stage1((CK_LAS unsigned char*)lds_raw, it, Pb, PW, C_RR, C_RK, C_RV, C_WD, SEQ, rp, cw, tp_acc, tp_t0);
            TP_END(7);
            TP_BEGIN(8);
            { const int quad = wid >> 2;
              for (int rr_ = 0; rr_ < REP_R1; ++rr_)
              for (int i0 = bx * 2; i0 < 2048; i0 += G * 2) ck::ret_stage1((CK_LAS unsigned char*)lds_raw + quad * 2 * ck::B9, i0 + quad, Pb, PW, C_TK, C_TV, SEQ, ROPE, cw); }
            TP_END(8);
        }
        GRID_BAR();
        {
            const int tid = ltid(), lane = tid & 63, wid = __builtin_amdgcn_readfirstlane(tid >> 6); (void)lane; (void)wid;
            const int quad = wid >> 2;
#ifndef REP_S
#define REP_S 1
#endif
            TP_BEGIN(1);
            for (int rep_ = 0; rep_ < REP_S; ++rep_) {
            if (bx < 128) {
                ck::rwkv_level1((CK_LAS unsigned char*)lds_raw, 2 * bx + quad, cw);
                asm volatile("s_waitcnt vmcnt(0)" ::: "memory"); __syncthreads();
                if (tid == 0) { __builtin_amdgcn_fence(__ATOMIC_RELEASE, "agent"); asm volatile("s_waitcnt vmcnt(0)" ::: "memory");
                                __hip_atomic_fetch_add(ctl + CW_L1 + 64 * (16 * l + (bx >> 4)), 2u, __ATOMIC_RELAXED, __HIP_MEMORY_SCOPE_AGENT); }
            }
            if (bx >= 128) {
                ck::ret_level1(2 * (bx - 128) + quad, cw);
                asm volatile("s_waitcnt vmcnt(0)" ::: "memory"); __syncthreads();
                if (tid == 0) { __builtin_amdgcn_fence(__ATOMIC_RELEASE, "agent"); asm volatile("s_waitcnt vmcnt(0)" ::: "memory");
                                __hip_atomic_fetch_add(ctl + CW_L1 + 64 * (16 * l + 8 + ((bx - 128) >> 4)), 2u, __ATOMIC_RELAXED, __HIP_MEMORY_SCOPE_AGENT); }
            }
            if (bx < 8) {
                if (wid == 0) { unsigned spins = 0;
                    while (__hip_atomic_load(ctl + CW_L1 + 64 * (16 * l + bx), __ATOMIC_RELAXED, __HIP_MEMORY_SCOPE_AGENT) < 32u) { if (++spins > (1u << 22)) break; __builtin_amdgcn_s_sleep(2); }
                    __builtin_amdgcn_fence(__ATOMIC_ACQUIRE, "agent"); asm volatile("s_waitcnt vmcnt(0)" ::: "memory"); }
                __syncthreads();
                ck::rwkv_scan<32>((CK_LAS unsigned char*)lds_raw, quad == 0 ? bx : -1, (const ck::bf16_t*)(cw + ck::O_PG), (const ck::bf16_t*)(cw + ck::O_QG), (ck::bf16_t*)(cw + ck::O_HG));
            }
            else if (bx < 16) {
                if (wid == 0) { unsigned spins = 0;
                    while (__hip_atomic_load(ctl + CW_L1 + 64 * (16 * l + bx), __ATOMIC_RELAXED, __HIP_MEMORY_SCOPE_AGENT) < 32u) { if (++spins > (1u << 22)) break; __builtin_amdgcn_s_sleep(2); }
                    __builtin_amdgcn_fence(__ATOMIC_ACQUIRE, "agent"); asm volatile("s_waitcnt vmcnt(0)" ::: "memory"); }
                __syncthreads();
                if (quad == 0) ck::ret_scan_groups(bx - 8, cw);
            }
            if (bx < 16) {
                asm volatile("s_waitcnt vmcnt(0)" ::: "memory"); __syncthreads();
                if (tid == 0) { __builtin_amdgcn_fence(__ATOMIC_RELEASE, "agent"); asm volatile("s_waitcnt vmcnt(0)" ::: "memory");
                                __hip_atomic_store(ctl + CW_SF + 64 * (16 * l + bx), 1u, __ATOMIC_RELAXED, __HIP_MEMORY_SCOPE_AGENT); }
            }
            }
            __syncthreads();
            TP_END(1);
            const attn_body::AttnTensors AT{(const attn_body::bf16*)(Pb + C_FQ), (const attn_body::bf16*)(Pb + C_FK), (const attn_body::bf16*)(Pb + C_FV), (attn_body::bf16*)MIXB, KA};
            bool cvdone = false;
#ifndef REP_D
#define REP_D 1
#endif
            for (int apass = 0; apass < 2; ++apass) {
            if (apass == 1) {
            __syncthreads();
            TP_BEGIN(4);
            if (wid == 0) {
                unsigned spins = 0;
                for (;;) { const unsigned f = lane < 16 ? __hip_atomic_load(ctl + CW_SF + 64 * (16 * l + lane), __ATOMIC_RELAXED, __HIP_MEMORY_SCOPE_AGENT) : 1u;
                    if (__all(f != 0u)) break; if (++spins > (1u << 22)) break; __builtin_amdgcn_s_sleep(2); }
                __builtin_amdgcn_fence(__ATOMIC_ACQUIRE, "agent"); asm volatile("s_waitcnt vmcnt(0)" ::: "memory");
            }
            __syncthreads();
            TP_END(4);
            TP_BEGIN(5);
            const ck::RwkvParams rp{args.in[3] + l * 768, args.in[4] + l * 256, args.in[5] + l * 256, args.in[7] + l * 256, args.in[10] + l * 256, args.in[11] + l * 256, args.in[12] + l * 256,
                                    args.in[13] + l * 256, args.in[14] + l * 256, args.in[15] + l * 256, nullptr, nullptr, nullptr};
            for (;;) {
                if (tid == 0) MISC[16] = atomicAdd(ctl + CW_EQ + 64 * l, 1u);
                __syncthreads();
                const int p = (int)MISC[16];
                __syncthreads();
                if (p >= 128 + 128) break;
                if (p < 128) ck::rwkv_stage3g((CK_LAS unsigned char*)lds_raw + quad * ck::L_RW3, 2 * p + quad, rp, cw, MIXB, SEQ);
                else ck::ret_stage3g((CK_LAS unsigned char*)lds_raw + quad * ck::L_RET3G, 2 * (p - 128) + quad, Pb, PW, C_TQ, C_TK, C_TV, C_TG, SEQ, ROPE, args.in[15] + l * 256, cw, MIXB);
            }
            __syncthreads();
            TP_END(5);
            }
            for (int rd_ = 0; rd_ < REP_D; ++rd_)
            for (int gtry = 0; gtry < 8; ++gtry) {
                int grp = (bx + gtry) & 7;
                if (apass == 0) { if (gtry >= 4) continue; const int k_ = bx & 7, g0 = (k_ & 4) ? 7 : 3, g2 = (k_ & 2) ? 6 : 2; grp = gtry == 0 ? g0 : gtry == 1 ? (g0 ^ 4) : gtry == 2 ? g2 : (g2 ^ 4); }
                else if ((grp & 3) >= 2) continue;
                unsigned* qh = ctl + (rd_ ? 20480 : CW_Q) + 64 * (8 * l + grp);
                for (;;) {
                    TP_BEGIN(2);
                    if (tid == 0) MISC[16] = atomicAdd(qh, 1u);
                    __syncthreads();
                    const unsigned idx = MISC[16];
                    if (idx >= 128u) { __syncthreads(); TP_END(2); break; }
                    const int qb = 63 - (int)(idx >> 1), bh = 2 * grp + (int)(idx & 1);
                    if (wid == 0) {
                        const float qn = sqrtf(fmaxf(QN2[bh * 128 + 2 * qb], QN2[bh * 128 + 2 * qb + 1])) * 1.001f;
                        const float sq0 = fminf(SQM[bh * 128 + 2 * qb], SQM[bh * 128 + 2 * qb + 1]) - 0.05f;
                        const int ntq = 4 * qb;
                        const float bref = ntq > 0 ? BE[bh * 256 + ntq - 1] : 0.f;
                        float run = 0.f; int nsk = 0; float knv[4], bev[4];
#pragma unroll
                        for (int q4 = 0; q4 < 4; ++q4) { const int tt = q4 * 64 + lane; const bool in = tt < ntq; knv[q4] = in ? KN2[bh * 128 + (tt >> 1)] : 0.f; bev[q4] = in ? BE[bh * 256 + tt] : 0.f; }
#pragma unroll
                        for (int q4 = 0; q4 < 4; ++q4) { const int tt = q4 * 64 + lane; const bool in = tt < ntq;
                            float ms = in ? 64.0f * __builtin_amdgcn_exp2f(fminf(qn * sqrtf(knv[q4]) - sq0 - (bref - bev[q4]), 60.0f)) : 0.f;
#pragma unroll
                            for (int o = 1; o < 64; o <<= 1) { const float n_ = __shfl_up(ms, o); if (lane >= o) ms += n_; }
                            ms += run; run = __shfl(ms, 63);
                            nsk += __popcll(__ballot(in && ms <= 6.1035156e-5f)); }
                        if (lane == 0) MISC[17] = (unsigned)(nsk & ~1);
                    }
                    __syncthreads();
                    const int t0 = (int)MISC[17];
                    attn_body::attn_unit<8>(bh / attn_body::NHEAD, bh % attn_body::NHEAD, qb, t0, AT.Q, AT.K, AT.V, AT.O, AT.KA, (char*)lds_raw);
                    TP_END(2);
                    TP_BEGIN(3);
                    if (!cvdone) {
                        if (tid == 0) MISC[18] = atomicAdd(ctl + CW_CV, 16u);
                        __syncthreads();
                        const int tk = (int)MISC[18];
                        if (tk >= NCONV) cvdone = true;
                        else { const int t2 = ltid(), lane2 = t2 & 63, wid2 = __builtin_amdgcn_readfirstlane(t2 >> 6);
                            float* scr = lds + wid2 * (64 * 65);
                            _Pragma("clang loop unroll(disable)") for (int q2 = 0; q2 < 2; ++q2) { const int itc = tk + 8 * q2 + wid2; if (itc < NCONV) conv_item(itc, args.in[25], args.in[26], args.in[27], W13, W2, scr, lane2); } }
                        __syncthreads();
                    }
                    TP_END(3);
                }
            }
            }
        }
        GRID_BAR();
        for (int rep_ = 0; rep_ < REP_F; ++rep_) {
            const int tid = ltid(), lane = tid & 63, wid = __builtin_amdgcn_readfirstlane(tid >> 6); (void)lane; (void)wid;
            pg8::Gemm g{MIXB, WOUT + (size_t)l * DM * DM, T, DM, DM}; pg8::StaticOrder S; S.init(T, DM, G, bx);
            pg8::EpiInProj E{YO, DM, 1.0f};
            pg8::gemm_phase<pg8::EpiInProj, pg8::StaticOrder, true, true>((PG8_LAS unsigned char*)lds_raw, g, S, E);
        }
        GRID_BAR();
        {
            const int tid = ltid(), lane = tid & 63, wid = __builtin_amdgcn_readfirstlane(tid >> 6); (void)lane; (void)wid;
            const float* g1 = args.in[17] + l * DM; const float* b1 = args.in[18] + l * DM;
            const float* bg = args.in[22] + l * 4; const float* be = args.in[24] + l * 32;
            unsigned* cnt = ctl + CW_CNT + 64 * 32 * l;
            const bf16* WRh = (const bf16*)(ws + WS_WR) + (size_t)l * 2 * 48 * 1024; const bf16* WRl = WRh + 48 * 1024;
            constexpr int XS = 1032;
            LAS unsigned short* XT = (LAS unsigned short*)lds_raw;
            LAS float* PART = (LAS float*)((LAS unsigned char*)lds_raw + 32 * XS * 2);
            LAS float* LG = PART + 8 * 32 * 48;
            LAS unsigned* LCNT = (LAS unsigned*)(LG + 128 * 48);
            if (tid < 32) LCNT[tid] = 0u;
            pg8::bf16x8 wh[4][3], wl[4][3];
#pragma unroll
            for (int s_ = 0; s_ < 4; ++s_)
#pragma unroll
                for (int nt = 0; nt < 3; ++nt) { const size_t o = (size_t)(16 * nt + (lane & 15)) * 1024 + 128 * wid + 32 * s_ + 8 * (lane >> 4);
                    wh[s_][nt] = *(const pg8::bf16x8*)(WRh + o); wl[s_][nt] = *(const pg8::bf16x8*)(WRl + o); }
            float gg[16], bb[16];
#pragma unroll
            for (int jq = 0; jq < 4; ++jq) { const f32x4 gv = *(const f32x4*)(g1 + jq * 256 + lane * 4), bv = *(const f32x4*)(b1 + jq * 256 + lane * 4);
#pragma unroll
                for (int e = 0; e < 4; ++e) { gg[jq * 4 + e] = gv[e]; bb[jq * 4 + e] = bv[e]; } }
            for (int ch = bx; ch < T / 128; ch += G) {
                for (int blk = 0; blk < 4; ++blk) {
                    const size_t m0 = (size_t)ch * 128 + blk * 32;
                    uint2 xw[4][4], yw[4][4];
#pragma unroll
                    for (int i = 0; i < 4; ++i) { const size_t m = m0 + wid * 4 + i;
#pragma unroll
                        for (int jq = 0; jq < 4; ++jq) { xw[i][jq] = *(const uint2*)(XB + m * DM + jq * 256 + lane * 4); yw[i][jq] = *(const uint2*)(YO + m * DM + jq * 256 + lane * 4); } }
#pragma unroll
                    for (int i = 0; i < 4; ++i) { const int tl = wid * 4 + i; const size_t m = m0 + tl;
                        float v[16]; float sm = 0.f;
#pragma unroll
                        for (int jq = 0; jq < 4; ++jq) { const uint2 a_ = xw[i][jq], c_ = yw[i][jq];
                            const f32x4 xv = (f32x4){__builtin_bit_cast(float, a_.x << 16), __builtin_bit_cast(float, a_.x & 0xffff0000u), __builtin_bit_cast(float, a_.y << 16), __builtin_bit_cast(float, a_.y & 0xffff0000u)};
                            const f32x4 yv = (f32x4){__builtin_bit_cast(float, c_.x << 16), __builtin_bit_cast(float, c_.x & 0xffff0000u), __builtin_bit_cast(float, c_.y << 16), __builtin_bit_cast(float, c_.y & 0xffff0000u)};
#pragma unroll
                            for (int e = 0; e < 4; ++e) { v[jq * 4 + e] = ALPHA * xv[e] + yv[e]; sm += v[jq * 4 + e]; } }
                        const float mean = wave_sum(sm) * (1.f / DM); float s2 = 0.f;
#pragma unroll
                        for (int q = 0; q < 16; ++q) { v[q] -= mean; s2 += v[q] * v[q]; }
                        const float rstd = 1.0f / sqrtf(wave_sum(s2) * (1.f / DM) + LN_EPS);
#pragma unroll
                        for (int jq = 0; jq < 4; ++jq) { unsigned hw[4];
#pragma unroll
                            for (int e = 0; e < 4; ++e) hw[e] = f2bf(v[jq * 4 + e] * rstd * gg[jq * 4 + e] + bb[jq * 4 + e]);
                            const ck::u32x2 pw = (ck::u32x2){hw[0] | (hw[1] << 16), hw[2] | (hw[3] << 16)};
                            *(uint2*)(XB + m * DM + jq * 256 + lane * 4) = make_uint2(pw.x, pw.y);
                            *(LAS ck::u32x2*)(XT + tl * XS + jq * 256 + lane * 4) = pw; }
                    }
                    __syncthreads();
                    {
                        pg8::f32x4 acc[2][3];
#pragma unroll
                        for (int mt = 0; mt < 2; ++mt)
#pragma unroll
                            for (int nt = 0; nt < 3; ++nt) acc[mt][nt] = pg8::f32x4{0.f, 0.f, 0.f, 0.f};
#pragma unroll
                        for (int s_ = 0; s_ < 4; ++s_)
#pragma unroll
                            for (int mt = 0; mt < 2; ++mt) { const pg8::bf16x8 ax = *(const LAS pg8::bf16x8*)(XT + (16 * mt + (lane & 15)) * XS + 128 * wid + 32 * s_ + 8 * (lane >> 4));
#pragma unroll
                                for (int nt = 0; nt < 3; ++nt) { acc[mt][nt] = __builtin_amdgcn_mfma_f32_16x16x32_bf16(ax, wh[s_][nt], acc[mt][nt], 0, 0, 0); acc[mt][nt] = __builtin_amdgcn_mfma_f32_16x16x32_bf16(ax, wl[s_][nt], acc[mt][nt], 0, 0, 0); } }
#pragma unroll
                        for (int mt = 0; mt < 2; ++mt)
#pragma unroll
                            for (int nt = 0; nt < 3; ++nt)
#pragma unroll
                                for (int r_ = 0; r_ < 4; ++r_) PART[(wid * 32 + 16 * mt + 4 * (lane >> 4) + r_) * 48 + 16 * nt + (lane & 15)] = acc[mt][nt][r_];
                    }
                    __syncthreads();
                    for (int p_ = tid; p_ < 32 * 48; p_ += NTHREADS) { float a_ = 0.f;
#pragma unroll
                        for (int w_ = 0; w_ < 8; ++w_) a_ += PART[w_ * 32 * 48 + p_];
                        LG[blk * 32 * 48 + p_] = a_; }
                }
                __syncthreads();
                int ex0 = 0, ex1 = 0; unsigned lp0 = 0, lp1 = 0;
                if (tid < 128) { const LAS float* lg = LG + tid * 48; const size_t m = (size_t)ch * 128 + tid;
                    int grp = 0; float gbest = lg[0] + bg[0];
#pragma unroll
                    for (int o = 1; o < 4; ++o) { const float gv = lg[o] + bg[o]; if (gv > gbest) { gbest = gv; grp = o; } }
                    float den = 0.f;
#pragma unroll
                    for (int o = 0; o < 4; ++o) den += expf(lg[o] + bg[o] - gbest);
                    const float ggate = 1.0f / den;
                    int i0 = 0; float v0 = lg[4 + grp * 8] + be[grp * 8];
                    for (int o = 1; o < 8; ++o) { const float ev = lg[4 + grp * 8 + o] + be[grp * 8 + o]; if (ev > v0) { v0 = ev; i0 = o; } }
                    int i1 = -1; float v1 = -INFINITY;
                    for (int o = 0; o < 8; ++o) { const float ev = lg[4 + grp * 8 + o] + be[grp * 8 + o]; if (o != i0 && (i1 < 0 || ev > v1)) { v1 = ev; i1 = o; } }
                    const float e1 = expf(v1 - v0); const float p0 = 1.0f / (1.0f + e1), p1 = e1 / (1.0f + e1);
                    ex0 = grp * 8 + i0; ex1 = grp * 8 + i1;
                    lp0 = atomicAdd((unsigned*)(LCNT + ex0), 1u); lp1 = atomicAdd((unsigned*)(LCNT + ex1), 1u);
                    GATE[2 * m] = ggate * p0; GATE[2 * m + 1] = ggate * p1;
                }
                __syncthreads();
                if (tid < 32) { const unsigned c_ = LCNT[tid]; LCNT[32 + tid] = c_ ? atomicAdd(cnt + 64 * tid, c_) : 0u; }
                __syncthreads();
                if (tid < 128) { const size_t m = (size_t)ch * 128 + tid; const int q0 = (int)(LCNT[32 + ex0] + lp0), q1 = (int)(LCNT[32 + ex1] + lp1); EP[2 * m] = (ex0 << 16) | q0; EP[2 * m + 1] = (ex1 << 16) | q1;
                                 LIST[ex0 * LCAP + q0] = (int)m; LIST[ex1 * LCAP + q1] = (int)m; }
                __syncthreads();
                if (tid < 32) LCNT[tid] = 0u;
            }
            {
                __syncthreads();
                TP_BEGIN(9);
                const int endl = (l + 1) * CV_L;
                for (;;) { if (tid == 0) MISC[18] = atomicAdd(ctl + CW_CV, 8u);
                    __syncthreads();
                    const int tk = (int)MISC[18];
                    if (tk + wid < NCONV) conv_item(tk + wid, args.in[25], args.in[26], args.in[27], W13, W2, lds + wid * (64 * 65), lane);
                    __syncthreads();
                    if (tk + 8 >= endl) break; }
                TP_END(9);
            }
        }
        GRID_BAR();
        for (int rep_ = 0; rep_ < REP_IJ; ++rep_) {
            const int tid = ltid(), lane = tid & 63, wid = __builtin_amdgcn_readfirstlane(tid >> 6); (void)lane; (void)wid;
            unsigned* cnt = ctl + CW_CNT + 64 * 32 * l;
            PG8_LAS int* tile_e = (PG8_LAS int*)((PG8_LAS unsigned char*)lds_raw + 131072); PG8_LAS int* tst = tile_e + MAXTILES;
            __syncthreads();
            PG8_LAS int* cntL = tst + NE + 1;
            if (tid < 64) { const int c_ = lane < NE ? (int)cnt[64 * lane] : 0; int v_ = (c_ + 255) >> 8;
#pragma unroll
                for (int o = 1; o < 32; o <<= 1) { const int n_ = __shfl_up(v_, o); if (lane >= o) v_ += n_; }
                if (lane < NE) { tst[lane + 1] = v_; cntL[lane] = c_; } if (lane == 0) tst[0] = 0; }
            __syncthreads();
            const int ntile = tst[NE];
            if (tid < ntile) { int e = 0; while (tst[e + 1] <= tid) ++e; tile_e[tid] = e; }
            __syncthreads();
            pg8::MoeOrder S{ntile, G, bx, tile_e};
            PG8_LAS unsigned* rowoff = (PG8_LAS unsigned*)((PG8_LAS unsigned char*)lds_raw + 133120);
            if (tid < 256) { int tk_[5];
#pragma unroll
                for (int i = 0; i < 5; ++i) { const int L = i * G + bx; tk_[i] = 0;
                    if (L < ntile * 4) { const int rt = L >> 2, e = tile_e[rt], p_ = (rt - tst[e]) * 256 + tid; if (p_ < cntL[e]) tk_[i] = LIST[e * LCAP + p_]; } }
#pragma unroll
                for (int i = 0; i < 5; ++i) rowoff[i * 256 + tid] = (unsigned)tk_[i] * (unsigned)(DM * 2); }
            __syncthreads();
            { pg8::Gemm g{XB, W13 + (size_t)l * NE * DM * DM, ntile * 256, DM, DM}; pg8::EpiSwiGlu E{Hb, DE};
              pg8::gemm_phase<pg8::EpiSwiGlu, pg8::MoeOrder, true, true, true>((PG8_LAS unsigned char*)lds_raw, g, S, E, rowoff); }
            GRID_BAR();
            { pg8::Gemm g{Hb, W2 + (size_t)l * NE * DM * DE, ntile * 256, DM, DE}; pg8::EpiInProj E{YP, DM, 1.0f};
              pg8::gemm_phase<pg8::EpiInProj, pg8::MoeOrder, true, true>((PG8_LAS unsigned char*)lds_raw, g, S, E); }
        }
        GRID_BAR();
        for (int rep_ = 0; rep_ < REP_K; ++rep_) { float* Xo = (rep_ == REP_K - 1) ? X : (float*)(ws + WS_XP); bf16* XBo = (rep_ == REP_K - 1) ? XB : (bf16*)(ws + WS_H);
            const int tid = ltid(), lane = tid & 63, wid = __builtin_amdgcn_readfirstlane(tid >> 6); (void)lane; (void)wid;
            const float* g2 = args.in[19] + l * DM; const float* b2 = args.in[20] + l * DM;
            const bool doff = (l + 1 < DEPTH); const int ln = doff ? l + 1 : l;
            const float* wf = args.in[1] + (size_t)ln * DM * INW + O_FF; const float* fbias = args.in[2] + ln * 8;
            LAS f32x4* W4 = (LAS f32x4*)((LAS unsigned char*)lds_raw + 4096);
            __syncthreads();
            for (int q = tid; q < 40 * 64; q += NTHREADS) { const int row = q >> 6, ln_ = q & 63; f32x4 val;
                const int s4 = row & 3, col0 = (s4 >> 1) * 512 + ln_ * 8 + (s4 & 1) * 4;
                if (row < 32) { const int h = row >> 2;
#pragma unroll
                    for (int e = 0; e < 4; ++e) val[e] = wf[(size_t)(col0 + e) * INW + h]; }
                else if (row < 36) val = *(const f32x4*)(g2 + col0);
                else val = *(const f32x4*)(b2 + col0);
                W4[q] = val; }
            float* ffl = lds;
            LAS int* poffK = (LAS int*)((LAS unsigned char*)lds_raw + 49152);
            if (tid < 64) { const unsigned* cnt = ctl + CW_CNT + 64 * 32 * l; const int pc_ = lane < NE ? ((((int)cnt[64 * lane] + 255) >> 8) << 8) : 0; int v_ = pc_;
#pragma unroll
                for (int o = 1; o < 32; o <<= 1) { const int n_ = __shfl_up(v_, o); if (lane >= o) v_ += n_; }
                if (lane < NE) poffK[lane] = v_ - pc_; }
            for (int ch = bx; ch < T / 128; ch += G) {
                __syncthreads();
                const size_t mw = (size_t)ch * 128 + wid * 16;
                const int eA = lane < 16 ? EP[2 * (mw + lane)] : 0, eB = lane < 16 ? EP[2 * (mw + lane) + 1] : 0; const int dA = poffK[eA >> 16] + (eA & 0xffff), dB = poffK[eB >> 16] + (eB & 0xffff);
                const float gA = lane < 16 ? GATE[2 * (mw + lane)] : 0.f, gB = lane < 16 ? GATE[2 * (mw + lane) + 1] : 0.f;
                f32x4 xA[2][4], xB[2][4]; uint2 aA[2][4], aB[2][4], bA[2][4], bB[2][4]; float gA2[2][2], gB2[2][2];
#define K_LOAD(XS, WAS, WBS, GS, IEXP) _Pragma("unroll")                     for (int u = 0; u < 2; ++u) { const size_t m = mw + IEXP + u;                         const size_t da = (size_t)__builtin_amdgcn_readlane(dA, IEXP + u), db = (size_t)__builtin_amdgcn_readlane(dB, IEXP + u);                         GS[u][0] = __builtin_bit_cast(float, __builtin_amdgcn_readlane(__builtin_bit_cast(int, gA), IEXP + u)); GS[u][1] = __builtin_bit_cast(float, __builtin_amdgcn_readlane(__builtin_bit_cast(int, gB), IEXP + u)); _Pragma("unroll")                         for (int j2 = 0; j2 < 2; ++j2) { { const pg8::u32x4 xw_ = *(const pg8::u32x4*)(XB + m * DM + j2 * 512 + lane * 8); XS[u][2 * j2] = (f32x4){__builtin_bit_cast(float, xw_.x << 16), __builtin_bit_cast(float, xw_.x & 0xffff0000u), __builtin_bit_cast(float, xw_.y << 16), __builtin_bit_cast(float, xw_.y & 0xffff0000u)}; XS[u][2 * j2 + 1] = (f32x4){__builtin_bit_cast(float, xw_.z << 16), __builtin_bit_cast(float, xw_.z & 0xffff0000u), __builtin_bit_cast(float, xw_.w << 16), __builtin_bit_cast(float, xw_.w & 0xffff0000u)}; }                             { const pg8::u32x4 wa_ = *(const pg8::u32x4*)(YP + da * DM + j2 * 512 + lane * 8), wb_ = *(const pg8::u32x4*)(YP + db * DM + j2 * 512 + lane * 8); WAS[u][2 * j2] = make_uint2(wa_.x, wa_.y); WAS[u][2 * j2 + 1] = make_uint2(wa_.z, wa_.w); WBS[u][2 * j2] = make_uint2(wb_.x, wb_.y); WBS[u][2 * j2 + 1] = make_uint2(wb_.z, wb_.w); } } }
                { const int i = 0; K_LOAD(xA, aA, bA, gA2, i); }
                for (int i = 0; i < 16; i += 4) {
                    { const int i1 = i + 2; K_LOAD(xB, aB, bB, gB2, i1); }
#pragma unroll
                    for (int u = 0; u < 2; ++u) { const int tl = wid * 16 + i + u; const size_t m = mw + i + u; const float ga = gA2[u][0], gb = gA2[u][1];
                    float v[16]; float s_ = 0.f;
#pragma unroll
                    for (int jq = 0; jq < 4; ++jq) { const uint2 w0 = aA[u][jq], w1 = bA[u][jq];
                        const f32x4 ya = (f32x4){__builtin_bit_cast(float, w0.x << 16), __builtin_bit_cast(float, w0.x & 0xffff0000u), __builtin_bit_cast(float, w0.y << 16), __builtin_bit_cast(float, w0.y & 0xffff0000u)};
                        const f32x4 yb = (f32x4){__builtin_bit_cast(float, w1.x << 16), __builtin_bit_cast(float, w1.x & 0xffff0000u), __builtin_bit_cast(float, w1.y << 16), __builtin_bit_cast(float, w1.y & 0xffff0000u)};
#pragma unroll
                        for (int e = 0; e < 4; ++e) { v[jq * 4 + e] = ALPHA * xA[u][jq][e] + (ga * ya[e] + gb * yb[e]); s_ += v[jq * 4 + e]; } }
                    const float mean = wave_sum(s_) * (1.f / DM); float s2 = 0.f;
#pragma unroll
                    for (int q = 0; q < 16; ++q) { v[q] -= mean; s2 += v[q] * v[q]; }
                    const float rstd = 1.0f / sqrtf(wave_sum(s2) * (1.f / DM) + LN_EPS);
                    float acc[8];
#pragma unroll
                    for (int h = 0; h < 8; ++h) acc[h] = 0.f;
#pragma unroll
                    for (int j2 = 0; j2 < 2; ++j2) { pg8::u32x4 pw;
#pragma unroll
                        for (int hf = 0; hf < 2; ++hf) { const int jq = 2 * j2 + hf; f32x4 ov;
                        const f32x4 gv = W4[(32 + jq) * 64 + lane], bv = W4[(36 + jq) * 64 + lane];
#pragma unroll
                        for (int e = 0; e < 4; ++e) ov[e] = v[jq * 4 + e] * rstd * gv[e] + bv[e];
                        if (doff) {
#pragma unroll
                            for (int h = 0; h < 8; ++h) { const f32x4 wv = W4[(h * 4 + jq) * 64 + lane]; acc[h] += (ov[0] * wv[0] + ov[1] * wv[1]) + (ov[2] * wv[2] + ov[3] * wv[3]); } }
                        if (!doff) *(f32x4*)(Xo + m * DM + j2 * 512 + lane * 8 + hf * 4) = ov;
                        pw[2 * hf] = pk2(ov[0], ov[1]); pw[2 * hf + 1] = pk2(ov[2], ov[3]); }
                        *(pg8::u32x4*)(XBo + m * DM + j2 * 512 + lane * 8) = pw; }
                    if (doff) {
#pragma unroll
                        for (int h = 0; h < 8; ++h) acc[h] = wave_sum(acc[h]);
                        if (lane < 8) { float fv = acc[0];
#pragma unroll
                            for (int h = 1; h < 8; ++h) fv = (lane == h) ? acc[h] : fv;
                            ffl[tl * 8 + lane] = fv + fbias[lane]; } }
                    }

                    if (i + 4 < 16) { const int i2 = i + 4; K_LOAD(xA, aA, bA, gA2, i2); }
#pragma unroll
                    for (int u = 0; u < 2; ++u) { const int tl = wid * 16 + (i + 2) + u; const size_t m = mw + (i + 2) + u; const float ga = gB2[u][0], gb = gB2[u][1];
                    float v[16]; float s_ = 0.f;
#pragma unroll
                    for (int jq = 0; jq < 4; ++jq) { const uint2 w0 = aB[u][jq], w1 = bB[u][jq];
                        const f32x4 ya = (f32x4){__builtin_bit_cast(float, w0.x << 16), __builtin_bit_cast(float, w0.x & 0xffff0000u), __builtin_bit_cast(float, w0.y << 16), __builtin_bit_cast(float, w0.y & 0xffff0000u)};
                        const f32x4 yb = (f32x4){__builtin_bit_cast(float, w1.x << 16), __builtin_bit_cast(float, w1.x & 0xffff0000u), __builtin_bit_cast(float, w1.y << 16), __builtin_bit_cast(float, w1.y & 0xffff0000u)};
#pragma unroll
                        for (int e = 0; e < 4; ++e) { v[jq * 4 + e] = ALPHA * xB[u][jq][e] + (ga * ya[e] + gb * yb[e]); s_ += v[jq * 4 + e]; } }
                    const float mean = wave_sum(s_) * (1.f / DM); float s2 = 0.f;
#pragma unroll
                    for (int q = 0; q < 16; ++q) { v[q] -= mean; s2 += v[q] * v[q]; }
                    const float rstd = 1.0f / sqrtf(wave_sum(s2) * (1.f / DM) + LN_EPS);
                    float acc[8];
#pragma unroll
                    for (int h = 0; h < 8; ++h) acc[h] = 0.f;
#pragma unroll
                    for (int j2 = 0; j2 < 2; ++j2) { pg8::u32x4 pw;
#pragma unroll
                        for (int hf = 0; hf < 2; ++hf) { const int jq = 2 * j2 + hf; f32x4 ov;
                        const f32x4 gv = W4[(32 + jq) * 64 + lane], bv = W4[(36 + jq) * 64 + lane];
#pragma unroll
                        for (int e = 0; e < 4; ++e) ov[e] = v[jq * 4 + e] * rstd * gv[e] + bv[e];
                        if (doff) {
#pragma unroll
                            for (int h = 0; h < 8; ++h) { const f32x4 wv = W4[(h * 4 + jq) * 64 + lane]; acc[h] += (ov[0] * wv[0] + ov[1] * wv[1]) + (ov[2] * wv[2] + ov[3] * wv[3]); } }
                        if (!doff) *(f32x4*)(Xo + m * DM + j2 * 512 + lane * 8 + hf * 4) = ov;
                        pw[2 * hf] = pk2(ov[0], ov[1]); pw[2 * hf + 1] = pk2(ov[2], ov[3]); }
                        *(pg8::u32x4*)(XBo + m * DM + j2 * 512 + lane * 8) = pw; }
                    if (doff) {
#pragma unroll
                        for (int h = 0; h < 8; ++h) acc[h] = wave_sum(acc[h]);
                        if (lane < 8) { float fv = acc[0];
#pragma unroll
                            for (int h = 1; h < 8; ++h) fv = (lane == h) ? acc[h] : fv;
                            ffl[tl * 8 + lane] = fv + fbias[lane]; } }
                    }

                }
#undef K_LOAD
                __syncthreads();
                if (doff) {
                    const int h = wid; const int bb = (ch * 128) / SEQ, t0 = (ch * 128) % SEQ; double carry = 0.0;
#pragma unroll
                    for (int half = 0; half < 2; ++half) { double vv = (double)logsigmoidf_(ffl[(half * 64 + lane) * 8 + h]);
#pragma unroll
                        for (int o = 1; o < 64; o <<= 1) { const double n = __shfl_up(vv, o); if (lane >= o) vv += n; }
                        vv += carry; LCS[(size_t)(bb * 8 + h) * SEQ + t0 + half * 64 + lane] = vv; carry = __shfl(vv, 63); }
                    if (lane == 0) TOT[(bb * 8 + h) * 128 + t0 / 128] = carry;
                }
            }
        }
        if (l + 1 < DEPTH) GRID_BAR();
    }
    if (TPROBE_SEL != 0) { unsigned long long* tsum = (unsigned long long*)(ctl + 200000);
        if (ltid() == 0) atomicAdd(tsum, tp_acc);
        xcd_barrier(bar);
        if (bx == 0 && ltid() == 0) { const unsigned long long tot = __hip_atomic_load(tsum, __ATOMIC_RELAXED, __HIP_MEMORY_SCOPE_AGENT); const unsigned long long waitt = tot * TPROBE_MULT / 256ull; const unsigned long long te = __builtin_amdgcn_s_memrealtime();
            while (__builtin_amdgcn_s_memrealtime() - te < waitt) __builtin_amdgcn_s_sleep(8); } }
}

extern "C" void kernel_launch(void* const* d_in, const int* in_sizes, int n_in, void* d_out, int out_size, void* d_ws, size_t ws_size, hipStream_t stream) {
    static int grid = 0;
    if (grid == 0) {
        if (n_in != 28 || out_size != T * DM || ws_size < WS_END) { fprintf(stderr, "kernel_launch: unexpected shapes (n_in %d out %d ws %zu)\n", n_in, out_size, ws_size); grid = -1; return; }
        int dev = 0, cus = 0, per_cu = 0;
        (void)hipGetDevice(&dev); (void)hipDeviceGetAttribute(&cus, hipDeviceAttributeMultiprocessorCount, dev);
        (void)hipFuncSetAttribute((const void*)mk_fwd, hipFuncAttributeMaxDynamicSharedMemorySize, LDS_ALL);
        if (hipOccupancyMaxActiveBlocksPerMultiprocessor(&per_cu, (const void*)mk_fwd, NTHREADS, LDS_ALL) != hipSuccess || per_cu < 1) fprintf(stderr, "kernel_launch: occupancy query says %d blocks per CU\n", per_cu);
        (void)hipGetLastError();
        grid = cus > 0 ? cus : 256;
        if (grid != 256) fprintf(stderr, "kernel_launch: %d CUs (built for 256)\n", grid);
    }
    if (grid < 0) return;
    (void)hipMemsetAsync((char*)d_ws + WS_CTL, 0, CTL_BYTES, stream);
    Args a{};
    for (int i = 0; i < 28; ++i) a.in[i] = (const float*)d_in[i];
    a.out = (float*)d_out; a.ws = (unsigned char*)d_ws;
    hipLaunchKernelGGL(mk_fwd, dim3(grid), dim3(NTHREADS), LDS_ALL, stream, a);
}
```

```cpp
#include <hip/hip_runtime.h>
#include <cstdio>
#include <cstdint>
#include <cmath>
__device__ __forceinline__ int ltid() { int t = __builtin_amdgcn_workitem_id_x(); asm volatile("" : "+v"(t)); return t; }

constexpr int BATCH = 2, SEQ = 16384, DM = 1024, DEPTH = 4, T = BATCH * SEQ;
constexpr int INW = 3592, PW = 3584;
constexpr int O_FF = 1536;
constexpr int C_FQ = 0, C_FK = 512, C_FV = 1024, C_RR = 1536, C_RK = 1792, C_RV = 2048, C_WD = 2304, C_AD = 2368, C_GD = 2432,
              C_TQ = 2560, C_TK = 2816, C_TV = 3072, C_TG = 3328;
constexpr int NE = 32, DE = 512, A_TOT = T * 2;
constexpr float ALPHA = 1.681792830507429f;
constexpr float LN_EPS = 1e-5f, RWKV_GN_EPS = 64e-5f, RET_GN_EPS = 1e-6f;
constexpr float QC2 = 0.125f * 1.4426950408889634f;
constexpr int NTHREADS = 512;
#ifndef REP_P0
#define REP_P0 1
#endif
#ifndef REP_A
#define REP_A 1
#endif
#ifndef REP_C
#define REP_C 1
#endif
#ifndef REP_E
#define REP_E 1
#endif
#ifndef REP_F
#define REP_F 1
#endif
#ifndef REP_H
#define REP_H 1
#endif
#ifndef REP_IJ
#define REP_IJ 1
#endif
#ifndef REP_G
#define REP_G 1
#endif
#ifndef REP_K
#define REP_K 1
#endif
constexpr int LDS_MISC = 147456, LDS_ALL = 148480;

constexpr size_t MiB = 1u << 20;
constexpr size_t WS_CTL = 0, CTL_BYTES = 1 * MiB;
constexpr size_t WS_EP = 1 * MiB;
constexpr size_t WS_DEST = 2 * MiB;
constexpr size_t WS_GATE = 9 * MiB;
constexpr size_t WS_ROPE = 11 * MiB;
constexpr size_t WS_RKD = 15 * MiB;
constexpr size_t WS_WIN = 16 * MiB;
constexpr size_t WS_WOUT = 44 * MiB;
constexpr size_t WS_W13 = 52 * MiB;
constexpr size_t WS_W2 = 308 * MiB;
constexpr size_t WS_XB = 436 * MiB;
constexpr size_t WS_P = 500 * MiB;
constexpr size_t WS_MIXB = 724 * MiB;
constexpr size_t WS_CK = 788 * MiB;
constexpr size_t WS_LW = 3 * MiB;
constexpr size_t WS_YO = 788 * MiB;
constexpr size_t WS_XP = 500 * MiB;
constexpr int LCAP = 32768;
constexpr size_t WS_H = 644 * MiB;
constexpr size_t WS_YP = 716 * MiB;
constexpr size_t WS_LCS = 1012 * MiB;
constexpr size_t WS_KA = 1014 * MiB;
constexpr size_t WS_END = 1018 * MiB;
constexpr size_t WS_WR = 5 * MiB;
constexpr size_t WS_SKIP = 4 * MiB + 65536;
constexpr size_t WS_TOT = 4 * MiB;
constexpr int CW_CNT = 32768;
constexpr int CW_Q = 2048;
constexpr int CW_L1 = 20480;
constexpr int CW_SF = 12288;
constexpr int CW_EQ = 4096;
constexpr int CW_CV = 6144;
constexpr int CW_BAR = 8192;
constexpr int MAXTILES = 288;

typedef float f32x16 __attribute__((ext_vector_type(16)));
typedef unsigned short bf16;

struct Args {
    const float* in[28]; float* out; unsigned char* ws;
};

__device__ __forceinline__ float sigmoidf_(float x) { return 1.0f / (1.0f + expf(-x)); }
__device__ __forceinline__ float logsigmoidf_(float x) { return x >= 0.f ? -log1pf(expf(-x)) : x - log1pf(expf(x)); }
__device__ __forceinline__ float wave_sum(float v) {
#define WS_DPP(ctrl, rmask) v += __builtin_bit_cast(float, __builtin_amdgcn_update_dpp(0, __builtin_bit_cast(int, v), ctrl, rmask, 0xf, false))
    WS_DPP(0x111, 0xf); WS_DPP(0x112, 0xf); WS_DPP(0x114, 0xf); WS_DPP(0x118, 0xf); WS_DPP(0x142, 0xa); WS_DPP(0x143, 0xc);
#undef WS_DPP
    return __builtin_bit_cast(float, __builtin_amdgcn_readlane(__builtin_bit_cast(int, v), 63));
}
typedef float f32x2hw __attribute__((ext_vector_type(2))); typedef __bf16 bf16x2hw __attribute__((ext_vector_type(2)));
__device__ __forceinline__ unsigned pk2(float lo, float hi) { f32x2hw v = {lo, hi}; bf16x2hw b = __builtin_convertvector(v, bf16x2hw); return __builtin_bit_cast(unsigned, b); }
__device__ __forceinline__ unsigned f2bf(float f) { return pk2(f, 0.f) & 0xffffu; }
__device__ __forceinline__ float bf2f(unsigned short b) { return __builtin_bit_cast(float, (unsigned)b << 16); }
__device__ __forceinline__ float pf(const bf16* Pb, size_t m, int c) { return bf2f(Pb[m * PW + c]); }

namespace pg8 {
#define PG8_LAS __attribute__((address_space(3)))
typedef unsigned short bf16_t;
typedef short bf16x8 __attribute__((ext_vector_type(8)));
typedef float f32x4 __attribute__((ext_vector_type(4)));
typedef unsigned u32x4 __attribute__((ext_vector_type(4)));
constexpr int BM = 256, BK = 64, HALF = 128, HTB = HALF * BK * 2  , STAGE_BYTES = 8 * HTB, NXCD = 8, WGM = 8;

__host__ __device__ __forceinline__ int lds_byte(int r, int c) { const int st = (r >> 4) * 2 + (c >> 5), rr = r & 15, cc = c & 31, ob = rr * 64 + cc * 2; return st * 1024 + (ob ^ (((ob >> 9) & 1) << 5)); }
__host__ __device__ __forceinline__ void stage_rc(int b, int& R, int& C) { const int st = b / 1024, sb = b % 1024, swz = sb ^ (((sb >> 9) & 1) << 5); R = (st >> 1) * 16 + swz / 64; C = (st & 1) * 32 + (swz % 64) / 2; }
__host__ __device__ __forceinline__ int perm32(int rho) { const int n = rho >> 4, i = rho & 15; return 8 * (i >> 2) + 4 * n + (i & 3); }

struct Unit { int pm, pn, pc; };
struct Gemm { const bf16_t* A; const bf16_t* Bt; int M, N, K; };

struct StaticOrder {
    int nM, nN, nwg, G, c;
    __host__ __device__ void init(int M, int N, int G_, int c_) { nM = M / BM; nN = N / BM; nwg = nM * nN; G = G_; c = c_; }
    __host__ __device__ bool next(int i, Unit& u) const {
        const long L = (long)i * G + c; if (L >= nwg) return false;
        int wgid = (int)L; { const int q = nwg / NXCD, r = nwg % NXCD, xcd = wgid % NXCD, off = wgid / NXCD; wgid = (xcd < r ? xcd * (q + 1) : r * (q + 1) + (xcd - r) * q) + off; }
        const int nig = WGM * nN, gid = wgid / nig, fm = gid * WGM, gsz = (nM - fm) < WGM ? (nM - fm) : WGM;
        u.pm = fm + ((wgid % nig) % gsz); u.pn = (wgid % nig) / gsz; u.pc = u.pn; return true;
    }
    __device__ __forceinline__ void a_ready(const Unit&) const {}
    __device__ __forceinline__ void done(const Unit&) const {}
};

__device__ __forceinline__ unsigned cvt_pk_bf16(float lo, float hi) { unsigned r; asm volatile("v_cvt_pk_bf16_f32 %0, %1, %2" : "=v"(r) : "v"(lo), "v"(hi)); return r; }

struct EpiF32 {
    static constexpr bool PERM = false, AFTER_DRAIN = false;
    float* O; int ldc;
    __device__ __forceinline__ void operator()(const f32x4 (&acc)[2][2][4][2], const Unit& u, int wr, int wc, int fr, int fq) const {
        const int row0 = u.pm * BM + wr * 64 + fr; const int col0 = u.pc * BM + wc * 32 + 4 * fq;
#pragma unroll
        for (int ai = 0; ai < 2; ++ai)
#pragma unroll
            for (int m = 0; m < 4; ++m) { float* rowp = O + (size_t)(row0 + ai * HALF + m * 16) * ldc + col0;
#pragma unroll
                for (int bj = 0; bj < 2; ++bj)
#pragma unroll
                    for (int n = 0; n < 2; ++n) *(f32x4*)(rowp + bj * HALF + n * 16) = acc[ai][bj][m][n]; }
    }
};
struct EpiSwiGlu {
    static constexpr bool PERM = true, AFTER_DRAIN = false;
    bf16_t* O; int ldc;
    __device__ __forceinline__ static float silu(float v) { return v * __builtin_amdgcn_rcpf(1.0f + __builtin_amdgcn_exp2f(-1.4426950408889634f * v)); }
    __device__ __forceinline__ void operator()(const f32x4 (&acc)[2][2][4][2], const Unit& u, int wr, int wc, int fr, int fq) const {
        const int row0 = u.pm * BM + wr * 64 + fr; const int col0 = u.pc * HALF + wc * 32 + 8 * fq;
#pragma unroll
        for (int ai = 0; ai < 2; ++ai)
#pragma unroll
            for (int m = 0; m < 4; ++m) { bf16_t* rowp = O + (size_t)(row0 + ai * HALF + m * 16) * ldc + col0;
                f32x4 h0, h1;
#pragma unroll
                for (int e = 0; e < 4; ++e) { h0[e] = silu(acc[ai][0][m][0][e]) * acc[ai][1][m][0][e]; h1[e] = silu(acc[ai][0][m][1][e]) * acc[ai][1][m][1][e]; }
                u32x4 w; w.x = cvt_pk_bf16(h0[0], h0[1]); w.y = cvt_pk_bf16(h0[2], h0[3]); w.z = cvt_pk_bf16(h1[0], h1[1]); w.w = cvt_pk_bf16(h1[2], h1[3]);
                *(u32x4*)rowp = w; }
    }
};
struct MoeOrder {
    int ntile, G, c; const PG8_LAS int* tile_e;
    __device__ __forceinline__ bool next(int i, Unit& u) const { const int L = i * G + c; if (L >= ntile * 4) return false; const int rt = L >> 2, pn = L & 3; u.pm = rt; u.pn = tile_e[rt] * 4 + pn; u.pc = pn; return true; }
    __device__ __forceinline__ void a_ready(const Unit&) const {}
    __device__ __forceinline__ void done(const Unit&) const {}
};
struct EpiInProj {
    static constexpr bool PERM = true, AFTER_DRAIN = false;
    bf16_t* O; int ldc; float qscale;
    __device__ __forceinline__ void operator()(const f32x4 (&acc)[2][2][4][2], const Unit& u, int wr, int wc, int fr, int fq) const {
        const int row0 = u.pm * BM + wr * 64 + fr; const int col0 = u.pc * BM + wc * 32 + 8 * fq;
        const float sc = (u.pc < 2) ? qscale : 1.f;
#pragma unroll
        for (int ai = 0; ai < 2; ++ai)
#pragma unroll
            for (int m = 0; m < 4; ++m) { bf16_t* rowp = O + (size_t)(row0 + ai * HALF + m * 16) * ldc + col0;
#pragma unroll
                for (int bj = 0; bj < 2; ++bj) { const f32x4 v0 = acc[ai][bj][m][0] * sc, v1 = acc[ai][bj][m][1] * sc;
                    u32x4 w; w.x = cvt_pk_bf16(v0[0], v0[1]); w.y = cvt_pk_bf16(v0[2], v0[3]); w.z = cvt_pk_bf16(v1[0], v1[1]); w.w = cvt_pk_bf16(v1[2], v1[3]);
                    *(u32x4*)(rowp + bj * HALF) = w; } }
    }
};
template <class Epi, class Sched, bool ALIGN_EPI = false, bool SP2 = false, bool GATHER = false>
__device__ __forceinline__ void gemm_phase(PG8_LAS unsigned char* lds, const Gemm g, const Sched& S, const Epi& E, const PG8_LAS unsigned* rowoff = nullptr) {
    static_assert(!GATHER || SP2, "GATHER is written for the SP2 loop only");
    const int tid = ltid(), wid = __builtin_amdgcn_readfirstlane(tid >> 6), lane = tid & 63, wr = wid >> 2, wc = wid & 3, fr = lane & 15, fq = lane >> 4;
    const int K = g.K, nt = K / BK;
    unsigned voffA[2], voffB[2];
#pragma unroll
    for (int i = 0; i < 2; ++i) { int R, C; stage_rc(tid * 16 + i * 8192, R, C); const int Rb = Epi::PERM ? ((R & ~31) + perm32(R & 31)) : R;
        voffA[i] = GATHER ? ((unsigned)(R * 4) | ((unsigned)(C * 2) << 16)) : (unsigned)(R * K + C) * 2u; voffB[i] = (unsigned)(Rb * K + C) * 2u; }
    unsigned vc[2][2];
#define PG8_GLOAD(dst, u_) do { _Pragma("unroll") for (int h_ = 0; h_ < 2; ++h_) _Pragma("unroll") for (int i_ = 0; i_ < 2; ++i_) \
        dst[h_][i_] = *(const PG8_LAS unsigned*)((const PG8_LAS unsigned char*)rowoff + (u_) * 1024 + h_ * 512 + (voffA[i_] & 0xffffu)) + (voffA[i_] >> 16); } while (0)
#define PG8_STAGE_A(bufoff, gbase, H, VG) do { if constexpr (GATHER) PG8_STAGE(bufoff, gbase, VG[H]); else PG8_STAGE(bufoff, (gbase) + (H) * hstep, voffA); } while (0)
    const size_t kstep = (size_t)(BK * 2);
    const size_t hstep = (size_t)HALF * K * 2;
    const size_t tstep = 2 * hstep;
    const unsigned ldsw = (unsigned)wid * 1024u;
    const int aoff = lds_byte(wr * 64 + fr, fq * 8), boff = lds_byte(wc * 32 + fr, fq * 8);
#define PG8_SA(b, h) (((b) * 2 + (h)) * HTB)
#define PG8_SB(b, h) ((4 + (b) * 2 + (h)) * HTB)
#define PG8_STAGE(bufoff, gbase, voff) do { _Pragma("unroll") for (int _i = 0; _i < 2; ++_i) \
        __builtin_amdgcn_global_load_lds((const unsigned*)((const char*)(gbase) + (voff)[_i]), (PG8_LAS unsigned*)(lds + (bufoff) + ldsw + _i * 8192), 16, 0, 0); } while (0)
#define PG8_LDA(dst, b, h) do { _Pragma("unroll") for (int m = 0; m < 4; ++m) _Pragma("unroll") for (int k = 0; k < 2; ++k) dst[m][k] = *(const PG8_LAS bf16x8*)(lds + PG8_SA(b, h) + aoff + m * 2048 + k * 1024); } while (0)
#define PG8_LDB(dst, b, h) do { _Pragma("unroll") for (int n = 0; n < 2; ++n) _Pragma("unroll") for (int k = 0; k < 2; ++k) dst[n][k] = *(const PG8_LAS bf16x8*)(lds + PG8_SB(b, h) + boff + n * 2048 + k * 1024); } while (0)
#define PG8_MMA(ai, bj, At, Bt) do { __builtin_amdgcn_s_setprio(1); _Pragma("unroll") for (int m = 0; m < 4; ++m) _Pragma("unroll") for (int n = 0; n < 2; ++n) _Pragma("unroll") for (int k = 0; k < 2; ++k) \
        acc[ai][bj][m][n] = __builtin_amdgcn_mfma_f32_16x16x32_bf16(Bt[n][k], At[m][k], acc[ai][bj][m][n], 0, 0, 0); __builtin_amdgcn_s_setprio(0); } while (0)
#define PG8_WAIT_V(n) asm volatile("s_waitcnt vmcnt(" #n ")" ::: "memory")
#define PG8_WAIT_L(n) asm volatile("s_waitcnt lgkmcnt(" #n ")" ::: "memory")
#define PG8_BAR __builtin_amdgcn_s_barrier()
#define PG8_SCHED __builtin_amdgcn_sched_barrier(0)
    Unit cur, nxt; int ui = 0;
    if (!S.next(0, cur)) return;
    f32x4 acc[2][2][4][2];
#pragma unroll
    for (int a = 0; a < 2; ++a)
#pragma unroll
        for (int b = 0; b < 2; ++b)
#pragma unroll
            for (int m = 0; m < 4; ++m)
#pragma unroll
                for (int n = 0; n < 2; ++n) acc[a][b][m][n] = (f32x4){0.f, 0.f, 0.f, 0.f};
    bf16x8 At[4][2], B0[2][2], B1[2][2];
    const char* cA = (const char*)g.A + (GATHER ? (size_t)0 : (size_t)cur.pm * tstep); const char* cB = (const char*)g.Bt + (size_t)cur.pn * tstep;
    S.a_ready(cur);
    if constexpr (GATHER) PG8_GLOAD(vc, 0);
    if constexpr (SP2) {
        PG8_STAGE(PG8_SB(0, 0), cB, voffB); PG8_STAGE(PG8_SB(0, 1), cB + hstep, voffB); PG8_STAGE_A(PG8_SA(0, 0), cA, 0, vc); PG8_STAGE_A(PG8_SA(0, 1), cA, 1, vc);
        if (wr == 1) PG8_BAR;
        PG8_WAIT_V(2); PG8_BAR;
        PG8_STAGE(PG8_SB(1, 0), cB + kstep, voffB); PG8_STAGE_A(PG8_SA(1, 0), cA + kstep, 0, vc); PG8_STAGE(PG8_SB(1, 1), cB + hstep + kstep, voffB);
        PG8_WAIT_V(6); PG8_BAR;
    } else {
        PG8_STAGE(PG8_SB(0, 0), cB, voffB); PG8_STAGE(PG8_SA(0, 0), cA, voffA); PG8_STAGE(PG8_SB(0, 1), cB + hstep, voffB); PG8_STAGE(PG8_SA(0, 1), cA + hstep, voffA);
        if (wr == 1) PG8_BAR;
        PG8_WAIT_V(4); PG8_BAR;
        PG8_STAGE(PG8_SB(1, 0), cB + kstep, voffB); PG8_STAGE(PG8_SA(1, 0), cA + kstep, voffA); PG8_STAGE(PG8_SB(1, 1), cB + hstep + kstep, voffB);
        PG8_WAIT_V(6); PG8_BAR;
    }
    for (;;) {
        const bool has_next = S.next(ui + 1, nxt);
        const char* nA = (has_next && !GATHER) ? (const char*)g.A + (size_t)nxt.pm * tstep : cA; const char* nB = has_next ? (const char*)g.Bt + (size_t)nxt.pn * tstep : cB;
        for (int t = 0; t < nt; t += 2) {
            const bool last = (t == nt - 2);
            const char* a1 = cA + (size_t)(t + 1) * kstep;
            const char* a2 = last ? nA : cA + (size_t)(t + 2) * kstep; const char* b2 = last ? nB : cB + (size_t)(t + 2) * kstep;
            const char* a3 = a2 + kstep; const char* b3 = b2 + kstep;
            if (last && has_next) S.a_ready(nxt);
            if constexpr (SP2) {
            PG8_LDB(B0, 0, 0); PG8_LDB(B1, 0, 1); PG8_SCHED; PG8_LDA(At, 0, 0); PG8_STAGE_A(PG8_SA(1, 1), a1, 1, vc);
            if constexpr (GATHER) { if (last && has_next) PG8_GLOAD(vc, ui + 1); }
            PG8_WAIT_V(8); PG8_WAIT_L(0); PG8_BAR; PG8_MMA(0, 0, At, B0); PG8_MMA(0, 1, At, B1); PG8_BAR; PG8_SCHED;
            PG8_LDA(At, 0, 1); PG8_STAGE(PG8_SB(0, 0), b2, voffB); PG8_STAGE(PG8_SB(0, 1), b2 + hstep, voffB); PG8_STAGE_A(PG8_SA(0, 0), a2, 0, vc);
            PG8_WAIT_V(8); PG8_WAIT_L(0); PG8_BAR; PG8_MMA(1, 0, At, B0); PG8_MMA(1, 1, At, B1); PG8_BAR; PG8_SCHED;
            PG8_LDB(B0, 1, 0); PG8_LDB(B1, 1, 1); PG8_SCHED; PG8_LDA(At, 1, 0); PG8_STAGE_A(PG8_SA(0, 1), a2, 1, vc);
            PG8_WAIT_V(8); PG8_WAIT_L(0); PG8_BAR; PG8_MMA(0, 0, At, B0); PG8_MMA(0, 1, At, B1); PG8_BAR; PG8_SCHED;
            PG8_LDA(At, 1, 1); PG8_STAGE(PG8_SB(1, 0), b3, voffB); PG8_STAGE(PG8_SB(1, 1), b3 + hstep, voffB); PG8_STAGE_A(PG8_SA(1, 0), a3, 0, vc);
            PG8_WAIT_V(8); PG8_WAIT_L(0); PG8_BAR; PG8_MMA(1, 0, At, B0); PG8_MMA(1, 1, At, B1); PG8_BAR; PG8_SCHED;
            } else {
            PG8_LDB(B0, 0, 0); PG8_SCHED; PG8_LDA(At, 0, 0); PG8_STAGE(PG8_SA(1, 1), a1 + hstep, voffA);
            PG8_WAIT_L(8); PG8_BAR; PG8_WAIT_L(0); PG8_MMA(0, 0, At, B0); PG8_BAR; PG8_SCHED;
            PG8_LDB(B1, 0, 1); PG8_STAGE(PG8_SB(0, 0), b2, voffB);
            PG8_BAR; PG8_WAIT_L(0); PG8_MMA(0, 1, At, B1); PG8_BAR;
            PG8_LDA(At, 0, 1); PG8_STAGE(PG8_SA(0, 0), a2, voffA);
            PG8_BAR; PG8_WAIT_L(0); PG8_MMA(1, 0, At, B0); PG8_BAR; PG8_SCHED;
            PG8_STAGE(PG8_SB(0, 1), b2 + hstep, voffB);
            PG8_WAIT_V(6); PG8_BAR; PG8_MMA(1, 1, At, B1); PG8_BAR;
            PG8_LDB(B0, 1, 0); PG8_SCHED; PG8_LDA(At, 1, 0); PG8_STAGE(PG8_SA(0, 1), a2 + hstep, voffA);
            PG8_WAIT_L(8); PG8_BAR; PG8_WAIT_L(0); PG8_MMA(0, 0, At, B0); PG8_BAR; PG8_SCHED;
            PG8_LDB(B1, 1, 1); PG8_STAGE(PG8_SB(1, 0), b3, voffB);
            PG8_BAR; PG8_WAIT_L(0); PG8_MMA(0, 1, At, B1); PG8_BAR;
            PG8_LDA(At, 1, 1); PG8_STAGE(PG8_SA(1, 0), a3, voffA);
            PG8_BAR; PG8_WAIT_L(0); PG8_MMA(1, 0, At, B0); PG8_BAR; PG8_SCHED;
            PG8_STAGE(PG8_SB(1, 1), b3 + hstep, voffB);
            PG8_WAIT_V(6); PG8_BAR; PG8_MMA(1, 1, At, B1); PG8_BAR;
            }
        }
        if constexpr (ALIGN_EPI) { if (wr == 0) PG8_BAR; }
        if constexpr (!Epi::AFTER_DRAIN) { E(acc, cur, wr, wc, fr, fq); S.done(cur); }
        if (!has_next) break;
#pragma unroll
        for (int a = 0; a < 2; ++a)
#pragma unroll
            for (int b = 0; b < 2; ++b)
#pragma unroll
                for (int m = 0; m < 4; ++m)
#pragma unroll
                    for (int n = 0; n < 2; ++n) acc[a][b][m][n] = (f32x4){0.f, 0.f, 0.f, 0.f};
        cur = nxt; cA = nA; cB = nB; ++ui;
        if constexpr (ALIGN_EPI) { if (wr == 1) PG8_BAR; }
    }
    PG8_WAIT_V(0);
    if constexpr (!ALIGN_EPI) { if (wr == 0) PG8_BAR; }
    PG8_BAR;
    if constexpr (Epi::AFTER_DRAIN) { E.fused(acc, cur, wr, wc, fr, fq, lds, wid, lane); S.done(cur); }
#undef PG8_SA
#undef PG8_SB
#undef PG8_STAGE
#undef PG8_STAGE_A
#undef PG8_GLOAD
#undef PG8_LDA
#undef PG8_LDB
#undef PG8_MMA
#undef PG8_WAIT_V
#undef PG8_WAIT_L
#undef PG8_BAR
#undef PG8_SCHED
}
}

template <class RowMap, class Epi>
__device__ __forceinline__ void gemm_tile_f32(float* lds, const float* __restrict__ A, int lda, RowMap rowmap, int nvalid,
                                              const float* __restrict__ B, int ldb, int col0, int N, int K, Epi epi) {
    float* As = lds;
    float* Bs = lds + 128 * 17;
    const int tid = ltid(), lane = tid & 63, wid = tid >> 6, wm = wid & 3, wn = wid >> 2;
    const int arow = tid >> 2, akq = (tid & 3) * 4;
    const int src = (arow < nvalid) ? rowmap(arow) : -1;
    const float* ap = A + (size_t)(src < 0 ? 0 : src) * lda + akq;
    const int bk = tid >> 5, bn = (tid & 31) * 4;
    const bool bok = (col0 + bn) < N;
    const float* bp = B + (size_t)bk * ldb + col0 + bn;
    f32x16 acc0 = {}, acc1 = {};
    for (int k0 = 0; k0 < K; k0 += 16) {
        pg8::f32x4 av = (pg8::f32x4){0.f, 0.f, 0.f, 0.f}, bv = (pg8::f32x4){0.f, 0.f, 0.f, 0.f};
        if (src >= 0) av = *(const pg8::f32x4*)(ap + k0);
        if (bok) bv = *(const pg8::f32x4*)(bp + (size_t)k0 * ldb);
        __syncthreads();
        As[arow * 17 + akq + 0] = av[0]; As[arow * 17 + akq + 1] = av[1]; As[arow * 17 + akq + 2] = av[2]; As[arow * 17 + akq + 3] = av[3];
        *(pg8::f32x4*)(Bs + bk * 132 + bn) = bv;
        __syncthreads();
#pragma unroll
        for (int kk = 0; kk < 16; kk += 2) {
            const float a = As[(32 * wm + (lane & 31)) * 17 + kk + (lane >> 5)];
            const float b0 = Bs[(kk + (lane >> 5)) * 132 + 64 * wn + (lane & 31)];
            const float b1 = Bs[(kk + (lane >> 5)) * 132 + 64 * wn + 32 + (lane & 31)];
            acc0 = __builtin_amdgcn_mfma_f32_32x32x2f32(a, b0, acc0, 0, 0, 0);
            acc1 = __builtin_amdgcn_mfma_f32_32x32x2f32(a, b1, acc1, 0, 0, 0);
        }
    }
#pragma unroll
    for (int r = 0; r < 16; ++r) {
        const int i = 32 * wm + (r & 3) + 8 * (r >> 2) + 4 * (lane >> 5);
        const int c0 = col0 + 64 * wn + (lane & 31);
        if (i < nvalid) {
            if (c0 < N) epi(i, c0, acc0[r]);
            if (c0 + 32 < N) epi(i, c0 + 32, acc1[r]);
        }
    }
}

#include <hip/hip_bf16.h>
namespace attn_body {
using bf16=__hip_bfloat16;
using bf16x8=__attribute__((ext_vector_type(8)))short;
using s16x4=__attribute__((ext_vector_type(4)))short;
using f32x16=__attribute__((ext_vector_type(16)))float;
using u32x4=__attribute__((ext_vector_type(4)))unsigned;
typedef float f32x4_t __attribute__((ext_vector_type(4)));
constexpr int BATCH=2,NHEAD=8,SEQ=16384,D=64,DM=3584,OP=1024;
constexpr int NW=8,QBLK=32,QB=QBLK*NW,KVBLK=64,NQB=SEQ/QB;
constexpr int ATTN_PITCH=DM, ATTN_UNIT_ROWS=QB;
__device__ __forceinline__ int crow(int r,int hi){return (r&3)+8*(r>>2)+4*hi;}
#define SBAR() __builtin_amdgcn_sched_barrier(0)
__device__ __forceinline__ void cmask(f32x16&p0,f32x16&p1,int jb,int qrel,int hi){
  const float NEG=-INFINITY; int kb=64*jb+4*hi;
  #pragma unroll
  for(int r=0;r<16;++r){int kv=kb+(r&3)+8*(r>>2); if(kv>qrel)p0[r]=NEG; if(kv+32>qrel)p1[r]=NEG;}
}

constexpr int NSLOT=3, SLOTB=8192;
constexpr int LDS_K=0, LDS_V=NSLOT*SLOTB, LDS_WS=2*NSLOT*SLOTB, LDS_OST=LDS_WS+NW*64*4, LDS_BYTES=LDS_OST+NW*4096;
constexpr float C2=0.125f*1.4426950408889634f;
__device__ __forceinline__ void glds16(const void*gsrc,unsigned lds_dst){unsigned keep;
  asm volatile("s_mov_b32 %0, m0\n\ts_mov_b32 m0, %2\n\ts_nop 0\n\tglobal_load_lds_dwordx4 %1, off\n\ts_mov_b32 m0, %0":"=&s"(keep):"v"(gsrc),"s"(lds_dst):"memory");}
__device__ __forceinline__ float max3f(float a,float b,float c){float r;asm("v_max3_f32 %0, %1, %2, %3":"=v"(r):"v"(a),"v"(b),"v"(c));return r;}
__device__ __forceinline__ float max2f(float a,float b){float r;asm("v_max_f32_e32 %0, %1, %2":"=v"(r):"v"(a),"v"(b));return r;}
__device__ __forceinline__ float fadd_s(float a,float b){float r;asm("v_add_f32_e32 %0, %1, %2":"=v"(r):"v"(a),"v"(b));return r;}
__device__ __forceinline__ float fsub_s(float a,float b){float r;asm("v_sub_f32_e32 %0, %1, %2":"=v"(r):"v"(a),"v"(b));return r;}
typedef float f32x2_t __attribute__((ext_vector_type(2))); typedef __bf16 bf16x2_t __attribute__((ext_vector_type(2)));
__device__ __forceinline__ unsigned cvtpk_s(float lo,float hi){f32x2_t v={lo,hi};bf16x2_t b=__builtin_convertvector(v,bf16x2_t);return __builtin_bit_cast(unsigned,b);}
#define WAIT_BAR(N) asm volatile("s_waitcnt vmcnt(" #N ") lgkmcnt(0)\n\ts_barrier":::"memory")

__device__ __forceinline__ void qkt(f32x16&p0,f32x16&p1,const char*Kslot,const bf16x8*qr,int r32,int hi){
  const char*kb=Kslot+hi*1024+r32*16;
  #pragma unroll
  for(int d0=0;d0<4;++d0){
    const bf16x8 b0=*reinterpret_cast<const bf16x8*>(kb+d0*2048);
    const bf16x8 b1=*reinterpret_cast<const bf16x8*>(kb+d0*2048+512);
    p0=__builtin_amdgcn_mfma_f32_32x32x16_bf16(b0,qr[d0],p0,0,0,0);p1=__builtin_amdgcn_mfma_f32_32x32x16_bf16(b1,qr[d0],p1,0,0,0);}
}
typedef __attribute__((address_space(3))) const char* lds_cptr;
typedef short v4i16_t __attribute__((ext_vector_type(4)));
__device__ __forceinline__ void kload8(bf16x8*kf,lds_cptr kp){
  kf[0]=*(const __attribute__((address_space(3))) bf16x8*)(kp);      kf[1]=*(const __attribute__((address_space(3))) bf16x8*)(kp+512);
  kf[2]=*(const __attribute__((address_space(3))) bf16x8*)(kp+2048); kf[3]=*(const __attribute__((address_space(3))) bf16x8*)(kp+2560);
  kf[4]=*(const __attribute__((address_space(3))) bf16x8*)(kp+4096); kf[5]=*(const __attribute__((address_space(3))) bf16x8*)(kp+4608);
  kf[6]=*(const __attribute__((address_space(3))) bf16x8*)(kp+6144); kf[7]=*(const __attribute__((address_space(3))) bf16x8*)(kp+6656);
}
__device__ __forceinline__ void kload2(bf16x8*kf,lds_cptr kp,int j){ kf[2*j]=*(const __attribute__((address_space(3))) bf16x8*)(kp+j*2048); kf[2*j+1]=*(const __attribute__((address_space(3))) bf16x8*)(kp+j*2048+512); }
__device__ __forceinline__ s16x4 vtr(lds_cptr p){ return __builtin_bit_cast(s16x4,__builtin_amdgcn_ds_read_tr16_b64_v4i16((__attribute__((address_space(3))) v4i16_t*)p)); }
__device__ __forceinline__ float rowmax(const f32x16&p0,const f32x16&p1){
  float a=max3f(p0[0],p0[1],p1[0]),b=max3f(p0[2],p0[3],p1[1]);a=max3f(a,p1[2],p1[3]);
  #pragma unroll
  for(int r=4;r<16;r+=4){a=max3f(a,p0[r],p0[r+1]);b=max3f(b,p0[r+2],p0[r+3]);a=max3f(a,p1[r],p1[r+1]);b=max3f(b,p1[r+2],p1[r+3]);}
  const float m=max2f(a,b);
  auto rr=__builtin_amdgcn_permlane32_swap(__float_as_uint(m),__float_as_uint(m),false,false);
  return max2f(__uint_as_float(rr[0]),__uint_as_float(rr[1]));
}
__device__ __forceinline__ void pv(f32x16*o,int vb,bf16x8 pa0,bf16x8 pa1,bf16x8 pa2,bf16x8 pa3){
  #pragma unroll
  for(int d0=0;d0<2;++d0){s16x4 lo[4],hi[4];
    #pragma unroll
    for(int ks=0;ks<4;++ks){
      asm volatile("ds_read_b64_tr_b16 %0,%1 offset:%c2":"=&v"(lo[ks]):"v"(vb),"i"(d0*4096+ks*1024):"memory");
      asm volatile("ds_read_b64_tr_b16 %0,%1 offset:%c2":"=&v"(hi[ks]):"v"(vb),"i"(d0*4096+ks*1024+512):"memory");}
    asm volatile("s_waitcnt lgkmcnt(0)":::"memory");SBAR();
    #define PK(k) (bf16x8){lo[k][0],lo[k][1],lo[k][2],lo[k][3],hi[k][0],hi[k][1],hi[k][2],hi[k][3]}
    o[d0]=__builtin_amdgcn_mfma_f32_32x32x16_bf16(pa0,PK(0),o[d0],0,0,0);
    o[d0]=__builtin_amdgcn_mfma_f32_32x32x16_bf16(pa1,PK(1),o[d0],0,0,0);
    o[d0]=__builtin_amdgcn_mfma_f32_32x32x16_bf16(pa2,PK(2),o[d0],0,0,0);
    o[d0]=__builtin_amdgcn_mfma_f32_32x32x16_bf16(pa3,PK(3),o[d0],0,0,0);
    #undef PK
  }
}

#ifndef ATTN_STORE16
#define ATTN_STORE16(p,v) (*(u32x4*)(p)=(v))
#endif
template<int THRL> __device__ __forceinline__ void attn_unit(int b,int h,int qb,int t0,const bf16*Q,const bf16*__restrict__ K,const bf16*__restrict__ V,bf16*O,const unsigned char*KAg,char*shm){
  const int tid=ltid(),lane=tid&63,r32=lane&31,hi=lane>>5; const int wid=__builtin_amdgcn_readfirstlane(tid>>6);
  const long rowbase=(long)b*SEQ; const int q0=qb*QB;
  const bf16*Qw=Q+(rowbase+q0+wid*QBLK)*DM+h*D;
  const bf16*Kh=K+(rowbase+(long)t0*KVBLK)*DM+h*D,*Vh=V+(rowbase+(long)t0*KVBLK)*DM+h*D;
  const unsigned lds0=(unsigned)(uintptr_t)shm;
  float*wsf=(float*)(shm+LDS_WS)+wid*64;
  const bf16*ksrc=Kh+(long)lane*DM+wid*8;
  const bf16*vsrc=Vh+(long)(16*(wid&3)+(lane>>2))*DM+(wid>>2)*32+(lane&3)*8;
  const unsigned kdst=lds0+LDS_K+wid*1024, vdst=lds0+LDS_V+wid*1024;
  #define DMA_K(t,slot) glds16(ksrc+(long)(t)*KVBLK*DM,(unsigned)__builtin_amdgcn_readfirstlane(kdst+(slot)))
  #define DMA_V(t,slot) glds16(vsrc+(long)(t)*KVBLK*DM,(unsigned)__builtin_amdgcn_readfirstlane(vdst+(slot)))
  const int vb0=(int)(lds0+LDS_V)+((lane>>4)&1)*32+(lane&3)*8+(4*hi+((lane&15)>>2))*64;
  const char*Kbase=shm+LDS_K; bf16x8 kf[8];
  const lds_cptr shm3=(lds_cptr)shm; const lds_cptr kp0=shm3+LDS_K+hi*1024+r32*16; const lds_cptr vp0=shm3+LDS_V+((lane>>4)&1)*32+(lane&3)*8+(4*hi+((lane&15)>>2))*64;
  const int NT=(q0+QB)/KVBLK-t0;
  u32x4 ka0,ka1; u32x4 qaw;
  const unsigned kavoff=(unsigned)r32*16u;
  const unsigned long long kab0=(unsigned long long)(uintptr_t)KAg+((unsigned long long)((b*NHEAD+h)*(long)SEQ+(long)t0*KVBLK))*16ull;
  #define KA_LOAD(t) do{ const unsigned long long a_=kab0+(unsigned long long)(t)*1024ull; const unsigned lo_=__builtin_amdgcn_readfirstlane((unsigned)a_),hi_=__builtin_amdgcn_readfirstlane((unsigned)(a_>>32)); \
    const unsigned long long sb_=((unsigned long long)hi_<<32)|lo_; \
    asm volatile("s_nop 4\n\tglobal_load_dwordx4 %0, %2, %3\n\tglobal_load_dwordx4 %1, %2, %3 offset:512":"=&v"(ka0),"=&v"(ka1):"v"(kavoff),"s"(sb_):"memory"); }while(0)
  #define QA_SET() do{ const float nm_=-mhat; const unsigned h_=cvtpk_s(nm_,0.f)&0xffffu; const float r1_=nm_-__uint_as_float(h_<<16); const unsigned m_=cvtpk_s(r1_,0.f)&0xffffu; \
    const float r2_=r1_-__uint_as_float(m_<<16); const unsigned l_=cvtpk_s(r2_,0.f)&0xffffu; \
    qaw[0]=hi?0u:0x3f803f80u; qaw[1]=hi?0u:(0x3f80u|(h_<<16)); qaw[2]=hi?0u:(m_|(l_<<16)); qaw[3]=0u; asm volatile("":"+v"(qaw)); }while(0)
  #define AUG(C0,C1) do{ C0=__builtin_amdgcn_mfma_f32_32x32x16_bf16(__builtin_bit_cast(bf16x8,ka0),__builtin_bit_cast(bf16x8,qaw),f32x16{},0,0,0); \
    C1=__builtin_amdgcn_mfma_f32_32x32x16_bf16(__builtin_bit_cast(bf16x8,ka1),__builtin_bit_cast(bf16x8,qaw),f32x16{},0,0,0); }while(0)
  #define PIN_KA() asm volatile("; KA landed":"+v"(ka0),"+v"(ka1)::"memory")
  #define WAIT_BAR_KA(N) do{ WAIT_BAR(N); PIN_KA(); }while(0)
  KA_LOAD(0);
  DMA_K(0,0);DMA_V(0,0);DMA_K(1,SLOTB);
  bf16x8 qr[4];
  #pragma unroll
  for(int d0=0;d0<4;++d0)qr[d0]=*reinterpret_cast<const bf16x8*>(&Qw[(long)r32*DM+d0*16+hi*8]);
  float mhat=0.f,l_reg=0.f;f32x16 o[2];o[0]=f32x16{};o[1]=f32x16{}; QA_SET();
  const int qrel=wid*QBLK+r32;
  #define CMASK(P0,P1,t) do{int jb_=(t)-(NT-4); if(jb_>=0)cmask(P0,P1,jb_,qrel,hi);}while(0)
  bool resc=false;
  #define START(P0,P1) do{ const float rm=rowmax(P0,P1); resc=false; \
    { const float dl=rm; mhat=fadd_s(mhat,dl); \
      _Pragma("unroll") for(int r=0;r<16;++r){P0[r]=fsub_s(P0[r],dl);P1[r]=fsub_s(P1[r],dl);} \
      QA_SET(); } \
    _Pragma("unroll") for(int r=0;r<16;++r)P0[r]=__builtin_amdgcn_exp2f(P0[r]); }while(0)
  #define RESC() do{ if(resc){ asm volatile("s_waitcnt lgkmcnt(0)":::"memory"); \
      _Pragma("unroll") for(int d_=0;d_<2;++d_) _Pragma("unroll") for(int r=0;r<16;++r)o[d_][r]*=wsf[crow(r,hi)]; } }while(0)
  f32x16 pA0,pA1,pB0,pB1;
  int sl_prev=0,sl_cur=0,sl_next=SLOTB;
  #define ROT() do{sl_prev=sl_cur;sl_cur=sl_next;sl_next=(sl_next==(NSLOT-1)*SLOTB)?0:sl_next+SLOTB;}while(0)
  DMA_K(2,2*SLOTB);
  WAIT_BAR_KA(3);
  AUG(pA0,pA1); qkt(pA0,pA1,Kbase,qr,r32,hi);asm volatile("s_nop 15\n\ts_nop 7":"+v"(pA0),"+v"(pA1));CMASK(pA0,pA1,0);
  START(pA0,pA1);
  _Pragma("unroll") for(int r=0;r<16;++r)pA1[r]=__builtin_amdgcn_exp2f(pA1[r]);
  WAIT_BAR(0);
  KA_LOAD(1);DMA_K(3,0);DMA_V(1,SLOTB);
  ROT();
  kload8(kf,kp0+sl_cur);
  WAIT_BAR_KA(2);
  s16x4 vlo[8],vhi[8]; u32x4 pw0,pw1,pw2,pw3;
  #define PKW(P,B) cvtpk_s(P[B],P[B+1])
  #define PAF(k) __builtin_bit_cast(bf16x8,pw##k)
  #define VFR(i) (bf16x8){vlo[i][0],vlo[i][1],vlo[i][2],vlo[i][3],vhi[i][0],vhi[i][1],vhi[i][2],vhi[i][3]}
  #define PIN(x) asm volatile("":"+v"(x))
  #define MX3(a,b,c) __builtin_fmaxf(__builtin_fmaxf((a),(b)),(c))
  #define GAPA(MF,A0,A1,A2,A3,W0,W1,PW) do{ MF; sacc+=A0; sacc+=A1; sacc+=A2; sacc+=A3; PIN(sacc); W0; W1; PIN(PW); SBAR(); }while(0)
  #define EX(v) __builtin_amdgcn_exp2f(v)
  #define GAPB(MF,X,B) do{ MF; X[B]=EX(X[B]); X[B+1]=EX(X[B+1]); X[B+2]=EX(X[B+2]); X[B+3]=EX(X[B+3]); PIN(X); SBAR(); }while(0)
  #define VRD(i) do{ vlo[i]=vtr(vp_+(((i)>>2)*4096+((i)&3)*1024)); vhi[i]=vtr(vp_+(((i)>>2)*4096+((i)&3)*1024+512)); }while(0)
  #define KRD(G,j) do{ if(G){ kload2(kf,kp0+sl_next,j); SBAR(); } }while(0)
  #define STEP(C0,C1,P0,P1,t,GK,GV,GL) do{ SBAR(); \
    const lds_cptr vp_=vp0+sl_prev; \
    AUG(C0,C1); SBAR(); \
    VRD(0); SBAR(); float sacc=(P0[0]+P0[1]); \
    GAPA(C0=__builtin_amdgcn_mfma_f32_32x32x16_bf16(kf[0],qr[0],C0,0,0,0), P0[2],P0[3],P0[4],P0[5],     pw0[0]=PKW(P0,0), pw0[1]=PKW(P0,2), pw0); \
    VRD(4); SBAR(); GAPA(C1=__builtin_amdgcn_mfma_f32_32x32x16_bf16(kf[1],qr[0],C1,0,0,0), P0[6],P0[7],P0[8],P0[9],     pw0[2]=PKW(P0,4), pw0[3]=PKW(P0,6), pw0); \
    VRD(1); SBAR(); GAPA(C0=__builtin_amdgcn_mfma_f32_32x32x16_bf16(kf[2],qr[1],C0,0,0,0),   P0[10],P0[11],P0[12],P0[13], pw1[0]=PKW(P0,8), pw1[1]=PKW(P0,10), pw1); \
    VRD(5); SBAR(); GAPA(C1=__builtin_amdgcn_mfma_f32_32x32x16_bf16(kf[3],qr[1],C1,0,0,0),   P0[14],P0[15],P1[0],P1[1],   pw1[2]=PKW(P0,12),pw1[3]=PKW(P0,14), pw1); \
    VRD(2); SBAR(); GAPA(C0=__builtin_amdgcn_mfma_f32_32x32x16_bf16(kf[4],qr[2],C0,0,0,0),   P1[2],P1[3],P1[4],P1[5],     pw2[0]=PKW(P1,0), pw2[1]=PKW(P1,2), pw2); \
    VRD(6); SBAR(); GAPA(C1=__builtin_amdgcn_mfma_f32_32x32x16_bf16(kf[5],qr[2],C1,0,0,0),   P1[6],P1[7],P1[8],P1[9],     pw2[2]=PKW(P1,4), pw2[3]=PKW(P1,6), pw2); \
    VRD(3); SBAR(); GAPA(C0=__builtin_amdgcn_mfma_f32_32x32x16_bf16(kf[6],qr[3],C0,0,0,0),   P1[10],P1[11],P1[12],P1[13], pw3[0]=PKW(P1,8), pw3[1]=PKW(P1,10), pw3); \
    VRD(7); SBAR(); GAPA(C1=__builtin_amdgcn_mfma_f32_32x32x16_bf16(kf[7],qr[3],C1,0,0,0),   P1[14],P1[15],0.f,0.f,       pw3[2]=PKW(P1,12),pw3[3]=PKW(P1,14), pw3); \
    l_reg+=sacc; \
    if(GL){KA_LOAD((t)+1);} if(GK){DMA_K((t)+3,sl_cur);} if(GV){DMA_V((t)+1,sl_next);} \
    CMASK(C0,C1,t); \
    { float a=MX3(C0[0],C0[1],C1[0]),b=MX3(C0[2],C0[3],C1[1]); a=MX3(a,C1[2],C1[3]); \
      _Pragma("unroll") for(int r=4;r<16;r+=4){a=MX3(a,C0[r],C0[r+1]);b=MX3(b,C0[r+2],C0[r+3]);a=MX3(a,C1[r],C1[r+1]);b=MX3(b,C1[r+2],C1[r+3]);} \
      float rm=__builtin_fmaxf(a,b); { auto rr=__builtin_amdgcn_permlane32_swap(__float_as_uint(rm),__float_as_uint(rm),false,false); rm=__builtin_fmaxf(__uint_as_float(rr[0]),__uint_as_float(rr[1])); } \
      resc=false; \
      if(__builtin_expect(__any(rm>(float)THRL),0)){ const float dl=__builtin_fmaxf(rm,0.f); mhat+=dl; \
        _Pragma("unroll") for(int r=0;r<16;++r){C0[r]-=dl;C1[r]-=dl;} \
        QA_SET(); \
        const float f=__builtin_amdgcn_exp2f(-dl); l_reg*=f; if(hi==0)wsf[r32]=f; resc=true; } } \
    SBAR(); \
    GAPB(o[0]=__builtin_amdgcn_mfma_f32_32x32x16_bf16(PAF(0),VFR(0),o[0],0,0,0), C0,0); \
    GAPB(o[1]=__builtin_amdgcn_mfma_f32_32x32x16_bf16(PAF(0),VFR(4),o[1],0,0,0), C0,4); \
    KRD(GL,0); GAPB(o[0]=__builtin_amdgcn_mfma_f32_32x32x16_bf16(PAF(1),VFR(1),o[0],0,0,0), C0,8); \
    KRD(GL,1); GAPB(o[1]=__builtin_amdgcn_mfma_f32_32x32x16_bf16(PAF(1),VFR(5),o[1],0,0,0), C0,12); \
    KRD(GL,2); GAPB(o[0]=__builtin_amdgcn_mfma_f32_32x32x16_bf16(PAF(2),VFR(2),o[0],0,0,0), C1,0); \
    KRD(GL,3); GAPB(o[1]=__builtin_amdgcn_mfma_f32_32x32x16_bf16(PAF(2),VFR(6),o[1],0,0,0), C1,4); \
    GAPB(o[0]=__builtin_amdgcn_mfma_f32_32x32x16_bf16(PAF(3),VFR(3),o[0],0,0,0), C1,8); \
    GAPB(o[1]=__builtin_amdgcn_mfma_f32_32x32x16_bf16(PAF(3),VFR(7),o[1],0,0,0), C1,12); \
    }while(0)
  int t=1;
  #undef CMASK
  #define CMASK(P0,P1,t) do{}while(0)
  for(;t+5<NT;t+=2){
    STEP(pB0,pB1,pA0,pA1,t,true,true,true);     WAIT_BAR_KA(2); RESC(); ROT();
    STEP(pA0,pA1,pB0,pB1,t+1,true,true,true);   WAIT_BAR_KA(2); RESC(); ROT();
  }
  #undef CMASK
  #define CMASK(P0,P1,t) do{int jb_=(t)-(NT-4); if(jb_>=0)cmask(P0,P1,jb_,qrel,hi);}while(0)
  #define ENDW(tt) do{ if((tt)+3<NT){WAIT_BAR(2);} else if((tt)+2<NT){WAIT_BAR(1);} else {WAIT_BAR(0);} PIN_KA(); }while(0)
  for(;t+1<NT;t+=2){
    STEP(pB0,pB1,pA0,pA1,t,(t+3<NT),(t+1<NT),(t+1<NT));       ENDW(t);   RESC(); ROT();
    STEP(pA0,pA1,pB0,pB1,t+1,(t+4<NT),(t+2<NT),(t+2<NT));     ENDW(t+1); RESC(); ROT();
  }
  STEP(pB0,pB1,pA0,pA1,NT-1,false,false,false); RESC();
  { float sacc=pB0[0]+pB0[1]; _Pragma("unroll") for(int r=2;r<16;++r)sacc+=pB0[r]; _Pragma("unroll") for(int r=0;r<16;++r)sacc+=pB1[r]; l_reg+=sacc;
    pw0=(u32x4){PKW(pB0,0),PKW(pB0,2),PKW(pB0,4),PKW(pB0,6)};pw1=(u32x4){PKW(pB0,8),PKW(pB0,10),PKW(pB0,12),PKW(pB0,14)};pw2=(u32x4){PKW(pB1,0),PKW(pB1,2),PKW(pB1,4),PKW(pB1,6)};pw3=(u32x4){PKW(pB1,8),PKW(pB1,10),PKW(pB1,12),PKW(pB1,14)};
    SBAR(); pv(o,vb0+sl_cur,PAF(0),PAF(1),PAF(2),PAF(3)); }
  #undef PKW
  #undef PAF
  #undef VFR
  #undef PIN
  #undef MX3
  #undef GAPA
  #undef GAPB
  #undef EX
  #undef VRD
  #undef KRD
  #undef STEP
  #undef ENDW
  {auto rr=__builtin_amdgcn_permlane32_swap(__float_as_uint(l_reg),__float_as_uint(l_reg),false,false);l_reg=__uint_as_float(rr[0])+__uint_as_float(rr[1]);}
  if(hi==0)wsf[32+r32]=l_reg;asm volatile("s_waitcnt lgkmcnt(0)":::"memory");
  float rli[16];
  #pragma unroll
  for(int r=0;r<16;++r)rli[r]=__builtin_amdgcn_rcpf(wsf[32+crow(r,hi)]);
  bf16*Ow=O+(rowbase+q0+wid*QBLK)*OP+h*D;
  { bf16*stg=(bf16*)(shm+LDS_OST)+wid*2048;
    #pragma unroll
    for(int r=0;r<16;++r){const int orow=crow(r,hi);
      #pragma unroll
      for(int d0=0;d0<2;++d0)stg[orow*64+d0*32+r32]=__float2bfloat16(o[d0][r]*rli[r]);}
    asm volatile("s_waitcnt lgkmcnt(0)":::"memory");
    #pragma unroll
    for(int i=0;i<4;++i){const int row=i*8+(lane>>3),ch=lane&7; const u32x4 v=*(const u32x4*)(stg+row*64+ch*8); ATTN_STORE16(Ow+(long)row*OP+ch*8,v);} }
  asm volatile("s_waitcnt lgkmcnt(0)\n\ts_barrier":::"memory");
  #undef DMA_K
  #undef DMA_V
  #undef KA_LOAD
  #undef QA_SET
  #undef AUG
  #undef WAIT_BAR_KA
  #undef PIN_KA
  #undef CMASK
  #undef START
  #undef RESC
  #undef ROT
}
constexpr int ATTN_LDS_BYTES=LDS_BYTES;
struct AttnTensors { const bf16* Q; const bf16* K; const bf16* V; bf16* O; const unsigned char* KA; };
struct AttnUnit { int bh; int qb; };
struct StaticOrder {
  int vcu;
  __device__ __forceinline__ explicit StaticOrder(int grid,int block):vcu((block%8)*(grid/8)+block/8){}
  __device__ __forceinline__ bool next(int i,AttnUnit&u)const{ if(i>=4)return false; const int s=vcu&15; u.bh=vcu>>4; u.qb=(i==0)?63-s:(i==1)?32+s:(i==2)?31-s:s; return true; }
  __device__ __forceinline__ void a_ready(const AttnUnit&)const{}
  __device__ __forceinline__ void done(const AttnUnit&)const{}
};
template<class Sched,int THRL=8> __device__ __forceinline__ void attn_phase(char*lds,const AttnTensors&T,const Sched&S){
  AttnUnit u;
  for(int i=0;S.next(i,u);++i){ S.a_ready(u); attn_unit<THRL>(u.bh/NHEAD,u.bh%NHEAD,u.qb,0,T.Q,T.K,T.V,T.O,T.KA,lds); S.done(u); }
}
#undef SBAR
#undef WAIT_BAR
}

#ifndef TPROBE_SEL
#define TPROBE_SEL 0
#endif
#define TPROBE_MULT 4
#define TP_BEGIN(id) do { if (TPROBE_SEL == (id)) tp_t0 = __builtin_amdgcn_s_memrealtime(); } while (0)
#define TP_END(id) do { if (TPROBE_SEL == (id)) tp_acc += __builtin_amdgcn_s_memrealtime() - tp_t0; } while (0)
namespace ck {
#define CK_LAS __attribute__((address_space(3)))
typedef unsigned short bf16_t;
typedef short bf16x8 __attribute__((ext_vector_type(8)));
typedef float f32x16 __attribute__((ext_vector_type(16)));
typedef float f32x4 __attribute__((ext_vector_type(4)));
typedef unsigned u32x4 __attribute__((ext_vector_type(4)));
typedef unsigned u32x2 __attribute__((ext_vector_type(2)));
typedef CK_LAS unsigned short* lbf;
typedef CK_LAS float* lf32;
constexpr int SB = 72;
constexpr int B9 = 64 * SB * 2;
constexpr int SF = 65;
constexpr int SM = 68;
constexpr int SX = 132;
__device__ __forceinline__ unsigned pk2(float lo, float hi) { return ::pk2(lo, hi); }
__device__ __forceinline__ unsigned f2bf(float f) { return ::f2bf(f); }
__device__ __forceinline__ float bflo(unsigned w) { return __builtin_bit_cast(float, w << 16); }
__device__ __forceinline__ float bfhi(unsigned w) { return __builtin_bit_cast(float, w & 0xffff0000u); }
__device__ __forceinline__ int crow(int reg, int hh) { return (reg & 3) + 8 * (reg >> 2) + 4 * hh; }
__device__ __forceinline__ f32x16 mm_lds(lbf A, lbf BT, int I, int J, int lane, f32x16 acc) {
    const int r = lane & 31, hh = lane >> 5;
    const lbf ap = A + (32 * I + r) * SB + 8 * hh; const lbf bp = BT + (32 * J + r) * SB + 8 * hh;
#pragma unroll
    for (int s = 0; s < 4; ++s) { const bf16x8 a = *(const CK_LAS bf16x8*)(ap + 16 * s); const bf16x8 b = *(const CK_LAS bf16x8*)(bp + 16 * s); acc = __builtin_amdgcn_mfma_f32_32x32x16_bf16(a, b, acc, 0, 0, 0); }
    return acc;
}
__device__ __forceinline__ f32x16 mm_gA(const bf16_t* __restrict__ Ag, lbf BT, int I, int J, int lane, f32x16 acc) {
    const int r = lane & 31, hh = lane >> 5;
    bf16x8 a[4];
#pragma unroll
    for (int s = 0; s < 4; ++s) a[s] = *(const bf16x8*)(Ag + (32 * I + r) * 64 + 16 * s + 8 * hh);
    const lbf bp = BT + (32 * J + r) * SB + 8 * hh;
#pragma unroll
    for (int s = 0; s < 4; ++s) { const bf16x8 b = *(const CK_LAS bf16x8*)(bp + 16 * s); acc = __builtin_amdgcn_mfma_f32_32x32x16_bf16(a[s], b, acc, 0, 0, 0); }
    return acc;
}
__device__ __forceinline__ f32x16 mm_gg(const bf16_t* __restrict__ Ag, const bf16_t* __restrict__ BTg, int I, int J, int lane, f32x16 acc) {
    const int r = lane & 31, hh = lane >> 5;
#pragma unroll
    for (int s = 0; s < 4; ++s) { const bf16x8 a = *(const bf16x8*)(Ag + (32 * I + r) * 64 + 16 * s + 8 * hh); const bf16x8 b = *(const bf16x8*)(BTg + (32 * J + r) * 64 + 16 * s + 8 * hh);
        acc = __builtin_amdgcn_mfma_f32_32x32x16_bf16(a, b, acc, 0, 0, 0); }
    return acc;
}
__device__ __forceinline__ f32x16 mm_rA(const bf16x8 (&a)[4], lbf BT, int J, int lane, f32x16 acc) {
    const int r = lane & 31, hh = lane >> 5; const lbf bp = BT + (32 * J + r) * SB + 8 * hh;
#pragma unroll
    for (int s = 0; s < 4; ++s) { const bf16x8 b = *(const CK_LAS bf16x8*)(bp + 16 * s); acc = __builtin_amdgcn_mfma_f32_32x32x16_bf16(a[s], b, acc, 0, 0, 0); }
    return acc;
}
__device__ __forceinline__ void load_gA(bf16x8 (&a)[4], const bf16_t* __restrict__ Ag, int I, int lane) {
    const int r = lane & 31, hh = lane >> 5;
#pragma unroll
    for (int s = 0; s < 4; ++s) a[s] = *(const bf16x8*)(Ag + (32 * I + r) * 64 + 16 * s + 8 * hh);
}
__device__ __forceinline__ f32x16 mm_lA_gB(lbf A, const bf16_t* __restrict__ BTg, int I, int J, int lane, f32x16 acc) {
    const int r = lane & 31, hh = lane >> 5; bf16x8 b[4];
#pragma unroll
    for (int s = 0; s < 4; ++s) b[s] = *(const bf16x8*)(BTg + (32 * J + r) * 64 + 16 * s + 8 * hh);
    const lbf ap = A + (32 * I + r) * SB + 8 * hh;
#pragma unroll
    for (int s = 0; s < 4; ++s) { const bf16x8 a = *(const CK_LAS bf16x8*)(ap + 16 * s); acc = __builtin_amdgcn_mfma_f32_32x32x16_bf16(a, b[s], acc, 0, 0, 0); }
    return acc;
}
__device__ __forceinline__ void frag_store(float* __restrict__ g, int wq, int lane, const f32x16& acc) {
    f32x4* p = (f32x4*)(g + ((size_t)(wq * 64 + lane)) * 16);
    p[0] = (f32x4){acc[0], acc[1], acc[2], acc[3]}; p[1] = (f32x4){acc[4], acc[5], acc[6], acc[7]}; p[2] = (f32x4){acc[8], acc[9], acc[10], acc[11]}; p[3] = (f32x4){acc[12], acc[13], acc[14], acc[15]};
}
__device__ __forceinline__ f32x16 frag_load(const float* __restrict__ g, int wq, int lane) {
    const f32x4* p = (const f32x4*)(g + ((size_t)(wq * 64 + lane)) * 16); const f32x4 a = p[0], b = p[1], c = p[2], d = p[3];
    return (f32x16){a[0], a[1], a[2], a[3], b[0], b[1], b[2], b[3], c[0], c[1], c[2], c[3], d[0], d[1], d[2], d[3]};
}
__device__ __forceinline__ void frag_store_bf(bf16_t* __restrict__ g, int wq, int lane, const f32x16& acc) {
    u32x4* p = (u32x4*)(g + ((size_t)(wq * 64 + lane)) * 16);
    p[0] = (u32x4){pk2(acc[0], acc[1]), pk2(acc[2], acc[3]), pk2(acc[4], acc[5]), pk2(acc[6], acc[7])}; p[1] = (u32x4){pk2(acc[8], acc[9]), pk2(acc[10], acc[11]), pk2(acc[12], acc[13]), pk2(acc[14], acc[15])};
}
__device__ __forceinline__ f32x16 frag_load_bf(const bf16_t* __restrict__ g, int wq, int lane) {
    const u32x4* p = (const u32x4*)(g + ((size_t)(wq * 64 + lane)) * 16); const u32x4 a = p[0], b = p[1];
    return (f32x16){bflo(a[0]), bfhi(a[0]), bflo(a[1]), bfhi(a[1]), bflo(a[2]), bfhi(a[2]), bflo(a[3]), bfhi(a[3]), bflo(b[0]), bfhi(b[0]), bflo(b[1]), bfhi(b[1]), bflo(b[2]), bfhi(b[2]), bflo(b[3]), bfhi(b[3])};
}
__device__ __forceinline__ void tile_store_T(lbf dst, int I, int J, int lane, const f32x16& acc) {
    const int r = lane & 31, hh = lane >> 5;
#pragma unroll
    for (int g = 0; g < 4; ++g) { u32x2 w; w.x = pk2(acc[4 * g], acc[4 * g + 1]); w.y = pk2(acc[4 * g + 2], acc[4 * g + 3]);
        *(CK_LAS u32x2*)(dst + (32 * J + r) * SB + 32 * I + 8 * g + 4 * hh) = w; }
}
__device__ __forceinline__ float fexp(float x) { return __builtin_amdgcn_exp2f(x * 1.4426950408889634f); }
__device__ __forceinline__ float sigm(float x) { return __builtin_amdgcn_rcpf(1.0f + fexp(-x)); }
__device__ __forceinline__ float ftanh(float x) { const float xc = fminf(fmaxf(x, -15.f), 15.f); return 1.0f - 2.0f * __builtin_amdgcn_rcpf(fexp(2.0f * xc) + 1.0f); }
__device__ __forceinline__ float logsig(float x) { const float ax = fabsf(x); return fminf(x, 0.f) - 0.6931471805599453f * __builtin_amdgcn_logf(1.0f + fexp(-ax)); }
template <int CTRL> __device__ __forceinline__ float dpp_f(float v) { return __builtin_bit_cast(float, __builtin_amdgcn_update_dpp(0, __builtin_bit_cast(int, v), CTRL, 0xf, 0xf, false)); }
__device__ __forceinline__ float quad_sum(float v) { v += dpp_f<0xB1>(v); v += dpp_f<0x4E>(v); return v; }

constexpr size_t O_PC = 0, O_QC = 16u << 20, O_GY = 48u << 20, O_YL = 64u << 20, O_VG = 96u << 20, O_GG = 112u << 20, O_H0 = 128u << 20, O_RKD = 144u << 20, O_KV = 145u << 20, O_RT = 177u << 20, O_END = 193u << 20,
                 O_PG = 193u << 20, O_QG = 195u << 20, O_HG = 197u << 20, O_KG = 199u << 20, O_RG = 203u << 20, O_END2 = 207u << 20;
struct RwkvParams {
    const float *mu_rkv, *mu_lora, *w0, *a0, *k_k, *k_a, *r_k, *ln_g, *ln_b, *gn_g;
    const bf16_t *w2t, *a2t, *g2t;
};

constexpr int L_U = 10 * B9, L_MM = L_U + 36864, L_GL = L_MM + 64 * SM * 4, L_END1 = L_GL + 256;
__device__ __forceinline__ void rwkv_stage1(CK_LAS unsigned char* lds, int item, const bf16_t* __restrict__ Pb, int PW, int C_RR, int C_RK, int C_RV, int C_WD, int SEQ, const RwkvParams& p, unsigned char* __restrict__ cw, unsigned long long& tp_acc, unsigned long long& tp_t0) {
    const int tid = ltid(), lane = tid & 63, wid = __builtin_amdgcn_readfirstlane(tid >> 6), quad = wid >> 2, wq = wid & 3, I = wq >> 1, J = wq & 1, r = lane & 31, hh = lane >> 5;
    const int b = item >> 10, h = (item >> 8) & 3, c = item & 255;
    const size_t m0 = (size_t)b * SEQ + (size_t)c * 64;
    const lbf Am = (lbf)(lds), Bm = (lbf)(lds + B9), Km = (lbf)(lds + 2 * B9), Rm = (lbf)(lds + 3 * B9), VT = (lbf)(lds + 4 * B9), BhT = (lbf)(lds + 5 * B9), KhT = (lbf)(lds + 6 * B9),
              Nm = (lbf)(lds + 7 * B9), Wb = (lbf)(lds + 8 * B9), Wk = (lbf)(lds + 9 * B9);
    const lbf TW = (lbf)(lds + L_U), AD = (lbf)(lds + L_U + B9), SG0 = (lbf)(lds + L_U + 2 * B9), SG1 = (lbf)(lds + L_U + 3 * B9);
    const lbf W2T = BhT, A2T = KhT, G2Ta = Nm, G2Tb = Wb;
    const lf32 X = (lf32)(lds + L_U), MM = (lf32)(lds + L_MM), GL = (lf32)(lds + L_GL);
    const lf32 AA = (lf32)(lds), GGl = (lf32)(lds + 2 * B9);
    const lbf ZlT = Km, X1T = Nm;
    TP_BEGIN(10);
    const int t = tid >> 3, c8 = (tid & 7) * 8;
    const size_t m = m0 + t; const bool hp = (c * 64 + t) > 0;
    const bf16_t* pr = Pb + m * PW; const bf16_t* pp = pr - PW;
    float rr[8], kx[8], vv[8];
    {
        const u32x4 z4 = (u32x4){0u, 0u, 0u, 0u};
        const u32x4 cr = *(const u32x4*)(pr + C_RR + h * 64 + c8), ckk = *(const u32x4*)(pr + C_RK + h * 64 + c8), cv = *(const u32x4*)(pr + C_RV + h * 64 + c8);
        const u32x4 qr = hp ? *(const u32x4*)(pp + C_RR + h * 64 + c8) : z4, qk = hp ? *(const u32x4*)(pp + C_RK + h * 64 + c8) : z4, qv = hp ? *(const u32x4*)(pp + C_RV + h * 64 + c8) : z4;
        u32x4 cl[4], ql[4];
#pragma unroll
        for (int q = 0; q < 4; ++q) { cl[q] = *(const u32x4*)(pr + C_WD + q * 64 + c8); ql[q] = hp ? *(const u32x4*)(pp + C_WD + q * 64 + c8) : z4; }
        const u32x4 lw0 = *(const u32x4*)(p.w2t + ((size_t)h * 64 + t) * 64 + c8), lw1 = *(const u32x4*)(p.a2t + ((size_t)h * 64 + t) * 64 + c8),
                    lw2 = *(const u32x4*)(p.g2t + ((size_t)h * 64 + t) * 128 + c8), lw3 = *(const u32x4*)(p.g2t + ((size_t)h * 64 + t) * 128 + 64 + c8);
        f32x4 mr[3][2], ml[4][2];
#pragma unroll
        for (int k = 0; k < 3; ++k) { mr[k][0] = *(const f32x4*)(p.mu_rkv + k * 256 + h * 64 + c8); mr[k][1] = *(const f32x4*)(p.mu_rkv + k * 256 + h * 64 + c8 + 4); }
#pragma unroll
        for (int q = 0; q < 4; ++q) { ml[q][0] = *(const f32x4*)(p.mu_lora + q * 64 + c8); ml[q][1] = *(const f32x4*)(p.mu_lora + q * 64 + c8 + 4); }
#pragma unroll
        for (int e = 0; e < 8; ++e) {
            const float a_ = (e & 1) ? bfhi(cr[e >> 1]) : bflo(cr[e >> 1]), b_ = (e & 1) ? bfhi(qr[e >> 1]) : bflo(qr[e >> 1]); rr[e] = a_ + (b_ - a_) * mr[0][e >> 2][e & 3];
            const float c_ = (e & 1) ? bfhi(ckk[e >> 1]) : bflo(ckk[e >> 1]), d_ = (e & 1) ? bfhi(qk[e >> 1]) : bflo(qk[e >> 1]); kx[e] = c_ + (d_ - c_) * mr[1][e >> 2][e & 3];
            const float e_ = (e & 1) ? bfhi(cv[e >> 1]) : bflo(cv[e >> 1]), f_ = (e & 1) ? bfhi(qv[e >> 1]) : bflo(qv[e >> 1]); vv[e] = e_ + (f_ - e_) * mr[2][e >> 2][e & 3]; }
#pragma unroll
        for (int q = 0; q < 4; ++q) {
            float lo[8];
#pragma unroll
            for (int e = 0; e < 8; ++e) { const float a_ = (e & 1) ? bfhi(cl[q][e >> 1]) : bflo(cl[q][e >> 1]), b_ = (e & 1) ? bfhi(ql[q][e >> 1]) : bflo(ql[q][e >> 1]); const float x = a_ + (b_ - a_) * ml[q][e >> 2][e & 3];
                lo[e] = (q == 0) ? ftanh(x) : (q == 1 ? x : sigm(x)); }
            u32x4 w; w.x = pk2(lo[0], lo[1]); w.y = pk2(lo[2], lo[3]); w.z = pk2(lo[4], lo[5]); w.w = pk2(lo[6], lo[7]);
            *(CK_LAS u32x4*)((q == 0 ? TW : q == 1 ? AD : q == 2 ? SG0 : SG1) + t * SB + c8) = w; }
        *(CK_LAS u32x4*)(W2T + t * SB + c8) = lw0; *(CK_LAS u32x4*)(A2T + t * SB + c8) = lw1; *(CK_LAS u32x4*)(G2Ta + t * SB + c8) = lw2; *(CK_LAS u32x4*)(G2Tb + t * SB + c8) = lw3;
    }
    __syncthreads();
    TP_END(10); TP_BEGIN(11);
    if (quad == 0) {
        f32x16 z = mm_lds(TW, W2T, I, J, lane, f32x16{}); f32x16 za = mm_lds(AD, A2T, I, J, lane, f32x16{});
        const int ch = 32 * J + r; const float w0c = p.w0[h * 64 + ch], a0c = p.a0[h * 64 + ch];
#pragma unroll
        for (int g = 0; g < 16; ++g) { const int tt = 32 * I + crow(g, hh); const float lw = logsig(w0c + z[g]) - 0.5f; MM[tt * SF + ch] = -fexp(lw); AA[tt * SF + ch] = sigm(a0c + za[g]); }
    } else {
        f32x16 zg = mm_lds(SG0, G2Ta, I, J, lane, f32x16{}); zg = mm_lds(SG1, G2Tb, I, J, lane, zg);
        const int ch = 32 * J + r;
#pragma unroll
        for (int g = 0; g < 16; ++g) { const int tt = 32 * I + crow(g, hh); GGl[tt * SF + ch] = zg[g]; }
    }
    __syncthreads();
    TP_END(11); TP_BEGIN(12);
    {
        const int ch = tid & 63, seg = tid >> 6; float v8[8]; float run = 0.f;
#pragma unroll
        for (int i = 0; i < 8; ++i) { run += MM[(seg * 8 + i) * SF + ch]; v8[i] = run; }
        const lf32 TOT = (lf32)(lds + L_U);
        TOT[seg * 64 + ch] = run;
        __syncthreads();
        float off = 0.f;
#pragma unroll
        for (int s2 = 0; s2 < 8; ++s2) off += (s2 < seg) ? TOT[s2 * 64 + ch] : 0.f;
#pragma unroll
        for (int i = 0; i < 8; ++i) MM[(seg * 8 + i) * SF + ch] = v8[i] + off;
    }
    __syncthreads();
    TP_END(12); TP_BEGIN(13);
    float aa[8], gg[8], lw[8], lwp[8], lwl[8];
#pragma unroll
    for (int e = 0; e < 8; ++e) { aa[e] = AA[t * SF + c8 + e]; gg[e] = GGl[t * SF + c8 + e]; lw[e] = MM[t * SF + c8 + e]; lwp[e] = t > 0 ? MM[(t - 1) * SF + c8 + e] : 0.f; lwl[e] = MM[63 * SF + c8 + e]; }
    __syncthreads();
    {
        float kk[8], k2[8]; float ss = 0.f, rk = 0.f;
#pragma unroll
        for (int e = 0; e < 8; ++e) { const int ch = h * 64 + c8 + e; kk[e] = kx[e] * p.k_k[ch]; ss += kk[e] * kk[e]; k2[e] = kx[e] * (1.0f + (aa[e] - 1.0f) * p.k_a[ch]); rk += rr[e] * k2[e] * p.r_k[ch]; }
        ss = quad_sum(ss); ss += dpp_f<0x141>(ss); rk = quad_sum(rk); rk += dpp_f<0x141>(rk);
        const float inv = 1.0f / fmaxf(sqrtf(ss), 1e-12f);
        float am[8], bm[8], km[8], rm[8];
#pragma unroll
        for (int e = 0; e < 8; ++e) { kk[e] *= inv; const float g_ = fexp(lw[e]), gi = fexp(-lw[e]), gp = fexp(lwp[e]), gl = fexp(lwl[e] - lw[e]); const float ka = kk[e] * aa[e];
            am[e] = -kk[e] * gp; bm[e] = ka * gi; km[e] = k2[e] * gi; rm[e] = rr[e] * g_;
            VT[(c8 + e) * SB + t] = (bf16_t)f2bf(vv[e]); BhT[(c8 + e) * SB + t] = (bf16_t)f2bf(ka * gl); KhT[(c8 + e) * SB + t] = (bf16_t)f2bf(k2[e] * gl);
            X[t * SX + c8 + e] = am[e]; }
        u32x4 w;
        w.x = pk2(am[0], am[1]); w.y = pk2(am[2], am[3]); w.z = pk2(am[4], am[5]); w.w = pk2(am[6], am[7]); *(CK_LAS u32x4*)(Am + t * SB + c8) = w;
        w.x = pk2(bm[0], bm[1]); w.y = pk2(bm[2], bm[3]); w.z = pk2(bm[4], bm[5]); w.w = pk2(bm[6], bm[7]); *(CK_LAS u32x4*)(Bm + t * SB + c8) = w;
        w.x = pk2(km[0], km[1]); w.y = pk2(km[2], km[3]); w.z = pk2(km[4], km[5]); w.w = pk2(km[6], km[7]); *(CK_LAS u32x4*)(Km + t * SB + c8) = w;
        w.x = pk2(rm[0], rm[1]); w.y = pk2(rm[2], rm[3]); w.z = pk2(rm[4], rm[5]); w.w = pk2(rm[6], rm[7]); *(CK_LAS u32x4*)(Rm + t * SB + c8) = w;
        if (t == 63) {
#pragma unroll
            for (int e = 0; e < 8; ++e) GL[c8 + e] = fexp(lwl[e]); }
        w.x = pk2(vv[0], vv[1]); w.y = pk2(vv[2], vv[3]); w.z = pk2(vv[4], vv[5]); w.w = pk2(vv[6], vv[7]); *(u32x4*)(cw + O_VG + (size_t)item * 8192 + (t * 64 + c8) * 2) = w;
        w.x = pk2(gg[0], gg[1]); w.y = pk2(gg[2], gg[3]); w.z = pk2(gg[4], gg[5]); w.w = pk2(gg[6], gg[7]); *(u32x4*)(cw + O_GG + (size_t)item * 8192 + (t * 64 + c8) * 2) = w;
        if ((tid & 7) == 0) *(float*)(cw + O_RKD + (size_t)item * 256 + t * 4) = rk;
    }
    __syncthreads();
    TP_END(13); TP_BEGIN(14);
    {
        const f32x16 p1 = mm_lds(Am, quad == 0 ? Bm : Km, I, J, lane, f32x16{}); const f32x16 p2 = mm_lds(Rm, quad == 0 ? Bm : Km, I, J, lane, f32x16{});
        const int ii = 32 * J + r;
#pragma unroll
        for (int g = 0; g < 16; ++g) { const int tt = 32 * I + crow(g, hh);
            if (quad == 0) { MM[tt * SM + (ii & 3) * 16 + (ii >> 2)] = (ii < tt) ? p1[g] : 0.f; Wb[tt * SB + ii] = (bf16_t)f2bf((ii <= tt) ? p2[g] : 0.f); }
            else { Nm[tt * SB + ii] = (bf16_t)f2bf((ii < tt) ? p1[g] : 0.f); Wk[tt * SB + ii] = (bf16_t)f2bf((ii <= tt) ? p2[g] : 0.f); } }
    }
    __syncthreads();
    if (quad == 0) { const f32x16 nv = mm_lds(Nm, VT, I, J, lane, f32x16{}); const int vcol = 64 + 32 * J + r;
#pragma unroll
        for (int g = 0; g < 16; ++g) X[(32 * I + crow(g, hh)) * SX + vcol] = nv[g]; }
    __syncthreads();
    TP_END(14); TP_BEGIN(15);
    {
        const int col = tid >> 2, q = tid & 3;
        float xs[16];
#pragma unroll
        for (int k = 0; k < 16; ++k) xs[k] = X[(q + 4 * k) * SX + col];
#pragma unroll
        for (int tt = 1; tt < 64; ++tt) {
            const CK_LAS f32x4* mr = (const CK_LAS f32x4*)(MM + tt * SM + q * 16);
            float s0 = 0.f, s1 = 0.f, s2 = 0.f, s3 = 0.f;
#pragma unroll
            for (int k4 = 0; k4 < (tt + 15) / 16; ++k4) { const f32x4 mv = mr[k4]; s0 += mv[0] * xs[4 * k4]; s1 += mv[1] * xs[4 * k4 + 1]; s2 += mv[2] * xs[4 * k4 + 2]; s3 += mv[3] * xs[4 * k4 + 3]; }
            const float sm = quad_sum((s0 + s1) + (s2 + s3));
            xs[tt >> 2] += (q == (tt & 3)) ? sm : 0.f;
        }
        const lbf dstT = (col < 64) ? (X1T + col * SB) : (ZlT + (col - 64) * SB);
#pragma unroll
        for (int k = 0; k < 16; ++k) dstT[q + 4 * k] = (bf16_t)f2bf(xs[k]);
    }
    __syncthreads();
    TP_END(15); TP_BEGIN(16);
    if (quad == 0) {
        const f32x16 gy = mm_lds(Wb, X1T, I, J, lane, f32x16{}); const f32x16 pc = mm_lds(BhT, X1T, I, J, lane, f32x16{});
        bf16_t* gyg = (bf16_t*)(cw + O_GY + (size_t)item * 8192); bf16_t* pcg = (bf16_t*)(cw + O_PC + (size_t)item * 8192);
        const int cc = 32 * J + r;
#pragma unroll
        for (int g = 0; g < 16; ++g) { const int rw = 32 * I + crow(g, hh);
            gyg[rw * 64 + cc] = (bf16_t)f2bf(gy[g] + __builtin_bit_cast(float, (unsigned)Rm[rw * SB + cc] << 16));
            pcg[rw * 64 + cc] = (bf16_t)f2bf(pc[g] + (rw == cc ? GL[cc] : 0.f)); }
    } else {
        f32x16 yl = mm_lds(ZlT, Wb, I, J, lane, f32x16{}); yl = mm_lds(VT, Wk, I, J, lane, yl);
        f32x16 qc = mm_lds(BhT, ZlT, I, J, lane, f32x16{}); qc = mm_lds(KhT, VT, I, J, lane, qc);
        frag_store((float*)(cw + O_YL + (size_t)item * 16384), wq, lane, yl); frag_store_bf((bf16_t*)(cw + O_QC) + (size_t)item * 4096, wq, lane, qc);
    }
    __syncthreads();
    TP_END(16);
}

template <int NST> __device__ __forceinline__ void rwkv_scan(CK_LAS unsigned char* lds, int chain, const bf16_t* __restrict__ pcb, const bf16_t* __restrict__ qcb, bf16_t* __restrict__ h0b) {
    const int tid = ltid(), lane = tid & 63, wid = __builtin_amdgcn_readfirstlane(tid >> 6), quad = wid >> 2, wq = wid & 3, I = wq >> 1, J = wq & 1, r = lane & 31, hh = lane >> 5, qtid = tid & 255;
    const lbf HT = (lbf)(lds + quad * B9);
    for (int i = qtid; i < 64 * SB / 2; i += 256) ((CK_LAS unsigned*)HT)[i] = 0u;
    __syncthreads();
    const bool on = chain >= 0; const size_t it0 = (size_t)(on ? chain : 0) * NST;
    const bf16_t* pcg = pcb + it0 * 4096; const bf16_t* qcg = qcb + it0 * 4096; bf16_t* h0g = h0b + it0 * 4096;
    constexpr int PD = 5;
    bf16x8 ar[PD][4]; f32x16 qr[PD];
#define CK_LOADSTEP(A_, Q_, cc) do { const int c_ = (cc) < NST ? (cc) : NST - 1; _Pragma("unroll") for (int s_ = 0; s_ < 4; ++s_) A_[s_] = *(const bf16x8*)(pcg + (size_t)c_ * 4096 + (32 * I + r) * 64 + 16 * s_ + 8 * hh); Q_ = frag_load_bf(qcg + (size_t)c_ * 4096, wq, lane); } while (0)
#pragma unroll
    for (int k = 0; k < PD; ++k) CK_LOADSTEP(ar[k], qr[k], k);
    for (int c = 0; c < NST + PD - 1; c += PD) {
#pragma unroll
        for (int k = 0; k < PD; ++k) {
            const int cc = c + k;
            if (cc < NST) {
            if (on) { const int row = qtid >> 2, seg = (qtid & 3) * 16; const u32x4 w0 = *(const CK_LAS u32x4*)(HT + row * SB + seg), w1 = *(const CK_LAS u32x4*)(HT + row * SB + seg + 8);
                      u32x4* dst = (u32x4*)(h0g + (size_t)cc * 4096 + row * 64 + seg); dst[0] = w0; dst[1] = w1; }
            f32x16 acc = qr[k];
            const lbf bp = HT + (32 * J + r) * SB + 8 * hh;
#pragma unroll
            for (int s_ = 0; s_ < 4; ++s_) { const bf16x8 bfr = *(const CK_LAS bf16x8*)(bp + 16 * s_); acc = __builtin_amdgcn_mfma_f32_32x32x16_bf16(ar[k][s_], bfr, acc, 0, 0, 0); }
            CK_LOADSTEP(ar[k], qr[k], cc + PD);
            asm volatile("s_waitcnt lgkmcnt(0)\n\ts_barrier" ::: "memory");
            tile_store_T(HT, I, J, lane, acc);
            asm volatile("s_waitcnt lgkmcnt(0)\n\ts_barrier" ::: "memory");
            }
        }
    }
#undef CK_LOADSTEP
}

__device__ __forceinline__ void rwkv_level1(CK_LAS unsigned char* lds, int task, unsigned char* __restrict__ cw) {
    const int tid = ltid(), lane = tid & 63, wid = __builtin_amdgcn_readfirstlane(tid >> 6), quad = wid >> 2, wq = wid & 3, I = wq >> 1, J = wq & 1, r = lane & 31, hh = lane >> 5;
    const lbf PTh = (lbf)(lds + quad * 4 * B9), PTl = PTh + 64 * SB, QTh = PTl + 64 * SB, QTl = QTh + 64 * SB;
    const bool on = task >= 0; const int tk = on ? task : 0; const size_t item0 = (size_t)(tk >> 5) * 256 + (size_t)(tk & 31) * 8;
    f32x16 PG, QG = f32x16{};
#pragma unroll
    for (int g = 0; g < 16; ++g) PG[g] = (I == J && crow(g, hh) == r) ? 1.0f : 0.0f;
    for (int j = 0; j < 8; ++j) {
        const size_t item = item0 + j;
        bf16x8 a[4]; load_gA(a, (const bf16_t*)(cw + O_PC) + item * 4096, I, lane);
        f32x16 qn = frag_load_bf((const bf16_t*)(cw + O_QC) + item * 4096, wq, lane);
        f32x16 pl, ql;
#pragma unroll
        for (int g = 0; g < 16; ++g) { pl[g] = PG[g] - __builtin_bit_cast(float, f2bf(PG[g]) << 16); ql[g] = QG[g] - __builtin_bit_cast(float, f2bf(QG[g]) << 16); }
        tile_store_T(PTh, I, J, lane, PG); tile_store_T(PTl, I, J, lane, pl); tile_store_T(QTh, I, J, lane, QG); tile_store_T(QTl, I, J, lane, ql);
        __syncthreads();
        f32x16 pn = mm_rA(a, PTh, J, lane, f32x16{}); pn = mm_rA(a, PTl, J, lane, pn);
        qn = mm_rA(a, QTh, J, lane, qn); qn = mm_rA(a, QTl, J, lane, qn);
        __syncthreads();
        PG = pn; QG = qn;
    }
    if (on) { bf16_t* pgg = (bf16_t*)(cw + O_PG) + (size_t)tk * 4096; const int cc = 32 * J + r;
#pragma unroll
        for (int g = 0; g < 16; ++g) pgg[(32 * I + crow(g, hh)) * 64 + cc] = (bf16_t)f2bf(PG[g]);
        frag_store_bf((bf16_t*)(cw + O_QG) + (size_t)tk * 4096, wq, lane, QG); }
}

constexpr int L_RW3 = B9 + 64 * SF * 4;
__device__ __forceinline__ void rwkv_stage3g(CK_LAS unsigned char* ldsq, int task, const RwkvParams& p, const unsigned char* __restrict__ cw, bf16_t* __restrict__ MIXB, int SEQ) {
    const int tid = ltid(), lane = tid & 63, wid = __builtin_amdgcn_readfirstlane(tid >> 6), wq = wid & 3, I = wq >> 1, J = wq & 1, r = lane & 31, hh = lane >> 5, qtid = tid & 255;
    const lbf HT = (lbf)ldsq; const lf32 Y = (lf32)(ldsq + B9);
    const bool on = task >= 0; const int tk = on ? task : 0; const int item0 = (tk >> 5) * 256 + (tk & 31) * 8;
    { const int row = qtid >> 2, seg = (qtid & 3) * 16; const u32x4* src = (const u32x4*)((const bf16_t*)(cw + O_HG) + (size_t)tk * 4096 + row * 64 + seg);
      *(CK_LAS u32x4*)(HT + row * SB + seg) = src[0]; *(CK_LAS u32x4*)(HT + row * SB + seg + 8) = src[1]; }
    __syncthreads();
    f32x4 lng[4], lnb[4];
    { const int h0 = (item0 >> 8) & 3, c16_ = (qtid & 3) * 16;
#pragma unroll
      for (int i = 0; i < 4; ++i) { lng[i] = *(const f32x4*)(p.ln_g + h0 * 64 + c16_ + 4 * i); lnb[i] = *(const f32x4*)(p.ln_b + h0 * 64 + c16_ + 4 * i); } }
    for (int j = 0; j < 8; ++j) {
        const int item = item0 + j;
        bf16x8 a[4]; load_gA(a, (const bf16_t*)(cw + O_PC) + (size_t)item * 4096, I, lane);
        f32x16 hn = frag_load_bf((const bf16_t*)(cw + O_QC) + (size_t)item * 4096, wq, lane);
        u32x4 vgw[2], ggw[2]; float rk;
        { const int t_ = qtid >> 2, c16_ = (qtid & 3) * 16; const u32x4* vg = (const u32x4*)(cw + O_VG + (size_t)item * 8192 + (t_ * 64 + c16_) * 2); const u32x4* gg = (const u32x4*)(cw + O_GG + (size_t)item * 8192 + (t_ * 64 + c16_) * 2);
          vgw[0] = vg[0]; vgw[1] = vg[1]; ggw[0] = gg[0]; ggw[1] = gg[1]; rk = *(const float*)(cw + O_RKD + (size_t)item * 256 + t_ * 4); }
        {
            f32x16 acc = frag_load((const float*)(cw + O_YL) + (size_t)item * 4096, wq, lane);
            acc = mm_lA_gB(HT, (const bf16_t*)(cw + O_GY) + (size_t)item * 4096, I, J, lane, acc);
#pragma unroll
            for (int g = 0; g < 16; ++g) Y[(32 * J + r) * SF + 32 * I + crow(g, hh)] = acc[g];
        }
        hn = mm_rA(a, HT, J, lane, hn);
        __syncthreads();
        tile_store_T(HT, I, J, lane, hn);
        if (on) {
            const int b = item >> 10, h = (item >> 8) & 3, c = item & 255; const int t = qtid >> 2, c16 = (qtid & 3) * 16;
            float y[16]; float s = 0.f;
#pragma unroll
            for (int e = 0; e < 16; ++e) { y[e] = Y[t * SF + c16 + e]; s += y[e]; }
            const float mu = quad_sum(s) * (1.f / 64.f); float s2 = 0.f;
#pragma unroll
            for (int e = 0; e < 16; ++e) { y[e] -= mu; s2 += y[e] * y[e]; }
            const float rstd = 1.0f / sqrtf(quad_sum(s2) * (1.f / 64.f) + 64e-5f);
            unsigned ow[8];
#pragma unroll
            for (int hv = 0; hv < 2; ++hv) { const u32x4 vw = vgw[hv], gw = ggw[hv];
#pragma unroll
                for (int e2 = 0; e2 < 4; ++e2) { const int e = hv * 8 + 2 * e2;
                    const float o0 = (y[e] * rstd * lng[e >> 2][e & 3] + lnb[e >> 2][e & 3] + rk * bflo(vw[e2])) * bflo(gw[e2]);
                    const float o1 = (y[e + 1] * rstd * lng[(e + 1) >> 2][(e + 1) & 3] + lnb[(e + 1) >> 2][(e + 1) & 3] + rk * bfhi(vw[e2])) * bfhi(gw[e2]);
                    ow[hv * 4 + e2] = pk2(o0, o1); } }
            u32x4* dst = (u32x4*)(MIXB + ((size_t)b * SEQ + (size_t)c * 64 + t) * 1024 + 512 + h * 64 + c16);
            dst[0] = (u32x4){ow[0], ow[1], ow[2], ow[3]}; dst[1] = (u32x4){ow[4], ow[5], ow[6], ow[7]};
        }
        __syncthreads();
    }
}

__device__ __forceinline__ void rwkv_stage3(CK_LAS unsigned char* ldsq, int item, const RwkvParams& p, const unsigned char* __restrict__ cw, bf16_t* __restrict__ MIXB, int SEQ) {
    const int tid = ltid(), lane = tid & 63, wid = __builtin_amdgcn_readfirstlane(tid >> 6), wq = wid & 3, I = wq >> 1, J = wq & 1, r = lane & 31, hh = lane >> 5, qtid = tid & 255;
    const lf32 Y = (lf32)ldsq;
    if (item >= 0) {
        f32x16 acc = frag_load((const float*)(cw + O_YL) + (size_t)item * 4096, wq, lane);
        acc = mm_gg((const bf16_t*)(cw + O_H0) + (size_t)item * 4096, (const bf16_t*)(cw + O_GY) + (size_t)item * 4096, I, J, lane, acc);
#pragma unroll
        for (int g = 0; g < 16; ++g) Y[(32 * J + r) * SF + 32 * I + crow(g, hh)] = acc[g];
    }
    __syncthreads();
    if (item >= 0) {
        const int b = item >> 10, h = (item >> 8) & 3, c = item & 255; const int t = qtid >> 2, c16 = (qtid & 3) * 16;
        float y[16]; float s = 0.f;
#pragma unroll
        for (int e = 0; e < 16; ++e) { y[e] = Y[t * SF + c16 + e]; s += y[e]; }
        const float mu = quad_sum(s) * (1.f / 64.f); float s2 = 0.f;
#pragma unroll
        for (int e = 0; e < 16; ++e) { y[e] -= mu; s2 += y[e] * y[e]; }
        const float rstd = 1.0f / sqrtf(quad_sum(s2) * (1.f / 64.f) + 64e-5f);
        const u32x4* vg = (const u32x4*)(cw + O_VG + (size_t)item * 8192 + (t * 64 + c16) * 2); const u32x4* gg = (const u32x4*)(cw + O_GG + (size_t)item * 8192 + (t * 64 + c16) * 2);
        const float rk = *(const float*)(cw + O_RKD + (size_t)item * 256 + t * 4);
        unsigned ow[8];
#pragma unroll
        for (int hv = 0; hv < 2; ++hv) { const u32x4 vw = vg[hv], gw = gg[hv];
#pragma unroll
            for (int e2 = 0; e2 < 4; ++e2) { const int e = hv * 8 + 2 * e2; const int ch = h * 64 + c16 + e;
                const float o0 = (y[e] * rstd * p.ln_g[ch] + p.ln_b[ch] + rk * bflo(vw[e2])) * bflo(gw[e2]);
                const float o1 = (y[e + 1] * rstd * p.ln_g[ch + 1] + p.ln_b[ch + 1] + rk * bfhi(vw[e2])) * bfhi(gw[e2]);
                ow[hv * 4 + e2] = pk2(o0, o1); } }
        u32x4* dst = (u32x4*)(MIXB + ((size_t)b * SEQ + (size_t)c * 64 + t) * 1024 + 512 + h * 64 + c16);
        dst[0] = (u32x4){ow[0], ow[1], ow[2], ow[3]}; dst[1] = (u32x4){ow[4], ow[5], ow[6], ow[7]};
    }
    __syncthreads();
}

__device__ __forceinline__ void rot16(float (&o)[16], const bf16_t* __restrict__ prow, int colbase, int c16, const float* __restrict__ ropet  ) {
    const u32x4* own = (const u32x4*)(prow + colbase + c16); const u32x4* par = (const u32x4*)(prow + colbase + (c16 ^ 32));
    const f32x4* cs = (const f32x4*)(ropet + 2 * (c16 & 31));
#pragma unroll
    for (int hv = 0; hv < 2; ++hv) { const u32x4 ow = own[hv], pw = par[hv];
#pragma unroll
        for (int e2 = 0; e2 < 4; ++e2) { const f32x4 csv = cs[hv * 4 + e2];
            const float x0 = bflo(ow[e2]), x1 = bfhi(ow[e2]), p0 = bflo(pw[e2]), p1 = bfhi(pw[e2]);
            o[hv * 8 + 2 * e2] = (c16 < 32) ? (x0 * csv[0] - p0 * csv[1]) : (p0 * csv[1] + x0 * csv[0]);
            o[hv * 8 + 2 * e2 + 1] = (c16 < 32) ? (x1 * csv[2] - p1 * csv[3]) : (p1 * csv[3] + x1 * csv[2]); } }
}
struct RotIn { u32x4 own[2], par[2]; f32x4 cs[8]; };
__device__ __forceinline__ void rot_load(RotIn& R_, const bf16_t* __restrict__ prow, int colbase, int c16) { const u32x4* own = (const u32x4*)(prow + colbase + c16); const u32x4* par = (const u32x4*)(prow + colbase + (c16 ^ 32));
    R_.own[0] = own[0]; R_.own[1] = own[1]; R_.par[0] = par[0]; R_.par[1] = par[1]; }
__device__ __forceinline__ void rot_cs(f32x4 (&cs)[8], int c16, const float* __restrict__ ropet) { const f32x4* p = (const f32x4*)(ropet + 2 * (c16 & 31));
#pragma unroll
    for (int i = 0; i < 8; ++i) cs[i] = p[i]; }
__device__ __forceinline__ void rot16r(float (&o)[16], const u32x4 (&own)[2], const u32x4 (&par)[2], const f32x4 (&cs)[8], int c16) {
#pragma unroll
    for (int hv = 0; hv < 2; ++hv) { const u32x4 ow = own[hv], pw = par[hv];
#pragma unroll
        for (int e2 = 0; e2 < 4; ++e2) { const f32x4 csv = cs[hv * 4 + e2];
            const float x0 = bflo(ow[e2]), x1 = bfhi(ow[e2]), p0 = bflo(pw[e2]), p1 = bfhi(pw[e2]);
            o[hv * 8 + 2 * e2] = (c16 < 32) ? (x0 * csv[0] - p0 * csv[1]) : (p0 * csv[1] + x0 * csv[0]);
            o[hv * 8 + 2 * e2 + 1] = (c16 < 32) ? (x1 * csv[2] - p1 * csv[3]) : (p1 * csv[3] + x1 * csv[2]); } }
}
__device__ __forceinline__ void ret_stage1(CK_LAS unsigned char* ldsq, int item, const bf16_t* __restrict__ Pb, int PW, int C_TK, int C_TV, int SEQ, const float* __restrict__ ROPE, unsigned char* __restrict__ cw) {
    const int tid = ltid(), lane = tid & 63, wid = __builtin_amdgcn_readfirstlane(tid >> 6), wq = wid & 3, I = wq >> 1, J = wq & 1, qtid = tid & 255;
    const lbf VT = (lbf)ldsq, KdT = (lbf)(ldsq + B9);
    if (item >= 0) {
        const int b = item >> 10, h = (item >> 8) & 3, c = item & 255; const int t = qtid >> 2, c16 = (qtid & 3) * 16; const int pos = c * 64 + t;
        const bf16_t* prow = Pb + ((size_t)b * SEQ + pos) * PW;
        RotIn ki; rot_load(ki, prow, C_TK + h * 64, c16); rot_cs(ki.cs, c16, ROPE + (size_t)pos * 64);
        const u32x4* vp = (const u32x4*)(prow + C_TV + h * 64 + c16); const u32x4 vw2[2] = {vp[0], vp[1]};
        float kr[16]; rot16r(kr, ki.own, ki.par, ki.cs, c16);
        const float lg = __builtin_amdgcn_logf(1.0f - __builtin_amdgcn_exp2f(-5.0f - (float)h));
        const float dec = 0.125f * __builtin_amdgcn_exp2f(lg * (float)(63 - t));
#pragma unroll
        for (int hv = 0; hv < 2; ++hv) { const u32x4 vw = vw2[hv];
#pragma unroll
            for (int e2 = 0; e2 < 4; ++e2) { const int e = hv * 8 + 2 * e2;
                VT[(c16 + e) * SB + t] = (bf16_t)(vw[e2] & 0xffffu); VT[(c16 + e + 1) * SB + t] = (bf16_t)(vw[e2] >> 16);
                KdT[(c16 + e) * SB + t] = (bf16_t)f2bf(kr[e] * dec); KdT[(c16 + e + 1) * SB + t] = (bf16_t)f2bf(kr[e + 1] * dec); } }
    }
    __syncthreads();
    if (item >= 0) { const f32x16 kv = mm_lds(VT, KdT, I, J, lane, f32x16{}); frag_store_bf((bf16_t*)(cw + O_KV) + (size_t)item * 4096, wq, lane, kv); }
    __syncthreads();
}
__device__ __forceinline__ void ret_scan(int chain, unsigned char* __restrict__ cw) {
    const int tid = ltid(), lane = tid & 63, wid = __builtin_amdgcn_readfirstlane(tid >> 6), wq = wid & 3, I = wq >> 1, J = wq & 1, r = lane & 31, hh = lane >> 5;
    const int h = chain & 3; const float lg = __builtin_amdgcn_logf(1.0f - __builtin_amdgcn_exp2f(-5.0f - (float)h)); const float g64 = __builtin_amdgcn_exp2f(lg * 64.0f);
    const bf16_t* kvg = (const bf16_t*)(cw + O_KV) + (size_t)chain * 256 * 4096; bf16_t* rtg = (bf16_t*)(cw + O_RT) + (size_t)chain * 256 * 4096;
    f32x16 R = f32x16{}; constexpr int PD = 8; f32x16 nx[PD];
#pragma unroll
    for (int k = 0; k < PD; ++k) nx[k] = frag_load_bf(kvg + (size_t)k * 4096, wq, lane);
    for (int c = 0; c < 256; c += PD) {
#pragma unroll
        for (int k = 0; k < PD; ++k) { const int cc = c + k; bf16_t* dst = rtg + (size_t)cc * 4096;
#pragma unroll
            for (int g = 0; g < 16; ++g) dst[(32 * I + crow(g, hh)) * 64 + 32 * J + r] = (bf16_t)f2bf(R[g]);
            const f32x16 kvc = nx[k]; const int nn = cc + PD < 256 ? cc + PD : 255;
            nx[k] = frag_load_bf(kvg + (size_t)nn * 4096, wq, lane);
#pragma unroll
            for (int g = 0; g < 16; ++g) R[g] = R[g] * g64 + kvc[g]; }
    }
}
constexpr int L_RET3 = 4 * B9 + 64 * SF * 4;
__device__ __forceinline__ void ret_stage3(CK_LAS unsigned char* ldsq, int item, const bf16_t* __restrict__ Pb, int PW, int C_TQ, int C_TK, int C_TV, int C_TG, int SEQ, const float* __restrict__ ROPE,
                                           const float* __restrict__ gn_g, const unsigned char* __restrict__ cw, bf16_t* __restrict__ MIXB) {
    const int tid = ltid(), lane = tid & 63, wid = __builtin_amdgcn_readfirstlane(tid >> 6), wq = wid & 3, I = wq >> 1, J = wq & 1, r = lane & 31, hh = lane >> 5, qtid = tid & 255;
    const lbf Qr = (lbf)ldsq, Kr = (lbf)(ldsq + B9), VT = (lbf)(ldsq + 2 * B9), Sb = (lbf)(ldsq + 3 * B9); const lf32 Y = (lf32)(ldsq + 4 * B9);
    const int b = item >= 0 ? item >> 10 : 0, h = item >= 0 ? (item >> 8) & 3 : 0, c = item >= 0 ? item & 255 : 0; const int t = qtid >> 2, c16 = (qtid & 3) * 16; const int pos = c * 64 + t;
    const float lg = __builtin_amdgcn_logf(1.0f - __builtin_amdgcn_exp2f(-5.0f - (float)h));
    const bf16_t* prow = Pb + ((size_t)b * SEQ + pos) * PW;
    if (item >= 0) {
        float qr[16], kr[16]; rot16(qr, prow, C_TQ + h * 64, c16, ROPE + (size_t)pos * 64); rot16(kr, prow, C_TK + h * 64, c16, ROPE + (size_t)pos * 64);
        u32x4 w;
        w.x = pk2(qr[0], qr[1]); w.y = pk2(qr[2], qr[3]); w.z = pk2(qr[4], qr[5]); w.w = pk2(qr[6], qr[7]); *(CK_LAS u32x4*)(Qr + t * SB + c16) = w;
        w.x = pk2(qr[8], qr[9]); w.y = pk2(qr[10], qr[11]); w.z = pk2(qr[12], qr[13]); w.w = pk2(qr[14], qr[15]); *(CK_LAS u32x4*)(Qr + t * SB + c16 + 8) = w;
#pragma unroll
        for (int e = 0; e < 16; ++e) kr[e] *= 0.125f;
        w.x = pk2(kr[0], kr[1]); w.y = pk2(kr[2], kr[3]); w.z = pk2(kr[4], kr[5]); w.w = pk2(kr[6], kr[7]); *(CK_LAS u32x4*)(Kr + t * SB + c16) = w;
        w.x = pk2(kr[8], kr[9]); w.y = pk2(kr[10], kr[11]); w.z = pk2(kr[12], kr[13]); w.w = pk2(kr[14], kr[15]); *(CK_LAS u32x4*)(Kr + t * SB + c16 + 8) = w;
        const u32x4* vp = (const u32x4*)(prow + C_TV + h * 64 + c16);
#pragma unroll
        for (int hv = 0; hv < 2; ++hv) { const u32x4 vw = vp[hv];
#pragma unroll
            for (int e2 = 0; e2 < 4; ++e2) { const int e = hv * 8 + 2 * e2; VT[(c16 + e) * SB + t] = (bf16_t)(vw[e2] & 0xffffu); VT[(c16 + e + 1) * SB + t] = (bf16_t)(vw[e2] >> 16); } }
    }
    __syncthreads();
    if (item >= 0) {
        f32x16 st = mm_lds(Kr, Qr, I, J, lane, f32x16{}); const int tt = 32 * J + r;
#pragma unroll
        for (int g = 0; g < 16; ++g) { const int ii = 32 * I + crow(g, hh); st[g] = (ii <= tt) ? st[g] * __builtin_amdgcn_exp2f(lg * (float)(tt - ii)) : 0.f; }
        tile_store_T(Sb, I, J, lane, st);
    }
    __syncthreads();
    if (item >= 0) {
        const f32x16 yi = mm_lds(VT, Sb, I, J, lane, f32x16{}); const f32x16 yc = mm_gA((const bf16_t*)(cw + O_RT) + (size_t)item * 4096, Qr, I, J, lane, f32x16{});
        const int tt = 32 * J + r; const float qd = __builtin_amdgcn_exp2f(lg * (float)(tt + 1));
#pragma unroll
        for (int g = 0; g < 16; ++g) Y[tt * SF + 32 * I + crow(g, hh)] = yi[g] + qd * yc[g];
    }
    __syncthreads();
    if (item >= 0) {
        float y[16]; float s = 0.f;
#pragma unroll
        for (int e = 0; e < 16; ++e) { y[e] = Y[t * SF + c16 + e]; s += y[e]; }
        const float mu = quad_sum(s) * (1.f / 64.f); float s2 = 0.f;
#pragma unroll
        for (int e = 0; e < 16; ++e) { y[e] -= mu; s2 += y[e] * y[e]; }
        const float rstd = 1.0f / sqrtf(quad_sum(s2) * (1.f / 64.f) + 1e-6f);
        const u32x4* gp = (const u32x4*)(prow + C_TG + h * 64 + c16); unsigned ow[8];
#pragma unroll
        for (int hv = 0; hv < 2; ++hv) { const u32x4 gw = gp[hv];
#pragma unroll
            for (int e2 = 0; e2 < 4; ++e2) { const int e = hv * 8 + 2 * e2; const int ch = h * 64 + c16 + e; const float g0 = bflo(gw[e2]), g1 = bfhi(gw[e2]);
                ow[hv * 4 + e2] = pk2(y[e] * rstd * gn_g[ch] * (g0 * sigm(g0)), y[e + 1] * rstd * gn_g[ch + 1] * (g1 * sigm(g1))); } }
        u32x4* dst = (u32x4*)(MIXB + ((size_t)b * SEQ + pos) * 1024 + 768 + h * 64 + c16);
        dst[0] = (u32x4){ow[0], ow[1], ow[2], ow[3]}; dst[1] = (u32x4){ow[4], ow[5], ow[6], ow[7]};
    }
    __syncthreads();
}
__device__ __forceinline__ void ret_level1(int task, unsigned char* __restrict__ cw) {
    const int tid = ltid(), lane = tid & 63, wid = __builtin_amdgcn_readfirstlane(tid >> 6), wq = wid & 3;
    int h = (task >> 5) & 3; asm volatile("" : "+s"(h));
    const float lg = __builtin_amdgcn_logf(1.0f - __builtin_amdgcn_exp2f(-5.0f - (float)h)); const float g64 = __builtin_amdgcn_exp2f(lg * 64.0f);
    const bf16_t* kvg = (const bf16_t*)(cw + O_KV) + ((size_t)(task >> 5) * 256 + (size_t)(task & 31) * 8) * 4096;
    f32x16 kv[8];
#pragma unroll
    for (int j = 0; j < 8; ++j) kv[j] = frag_load_bf(kvg + (size_t)j * 4096, wq, lane);
    f32x16 acc = kv[0];
#pragma unroll
    for (int j = 1; j < 8; ++j)
#pragma unroll
        for (int g = 0; g < 16; ++g) acc[g] = acc[g] * g64 + kv[j][g];
    frag_store((float*)(cw + O_KG) + (size_t)task * 4096, wq, lane, acc);
}
__device__ __forceinline__ void ret_scan_groups(int chain, unsigned char* __restrict__ cw) {
    const int tid = ltid(), lane = tid & 63, wid = __builtin_amdgcn_readfirstlane(tid >> 6), wq = wid & 3;
    int h = chain & 3; asm volatile("" : "+s"(h)); const float lg = __builtin_amdgcn_logf(1.0f - __builtin_amdgcn_exp2f(-5.0f - (float)h)); const float g512 = __builtin_amdgcn_exp2f(lg * 512.0f);
    const float* kgg = (const float*)(cw + O_KG) + (size_t)chain * 32 * 4096; float* rgg = (float*)(cw + O_RG) + (size_t)chain * 32 * 4096;
    f32x16 R = f32x16{}; f32x16 nx[4];
#pragma unroll
    for (int k = 0; k < 4; ++k) nx[k] = frag_load(kgg + (size_t)k * 4096, wq, lane);
    for (int c = 0; c < 32; c += 4) {
#pragma unroll
        for (int k = 0; k < 4; ++k) { const int cc = c + k; frag_store(rgg + (size_t)cc * 4096, wq, lane, R);
            const f32x16 kvc = nx[k]; const int nn = cc + 4 < 32 ? cc + 4 : 31; nx[k] = frag_load(kgg + (size_t)nn * 4096, wq, lane);
#pragma unroll
            for (int g = 0; g < 16; ++g) R[g] = R[g] * g512 + kvc[g]; }
    }
}
constexpr int L_RET3G = 5 * B9 + 64 * SF * 4;
__device__ __forceinline__ void ret_stage3g(CK_LAS unsigned char* ldsq, int task, const bf16_t* __restrict__ Pb, int PW, int C_TQ, int C_TK, int C_TV, int C_TG, int SEQ, const float* __restrict__ ROPE,
                                           const float* __restrict__ gn_g, const unsigned char* __restrict__ cw, bf16_t* __restrict__ MIXB) {
    const int tid = ltid(), lane = tid & 63, wid = __builtin_amdgcn_readfirstlane(tid >> 6), wq = wid & 3, I = wq >> 1, J = wq & 1, r = lane & 31, hh = lane >> 5, qtid = tid & 255;
    const lbf Qr = (lbf)ldsq, Kr = (lbf)(ldsq + B9), VT = (lbf)(ldsq + 2 * B9), Sb = (lbf)(ldsq + 3 * B9), RTL = (lbf)(ldsq + 4 * B9); const lf32 Y = (lf32)(ldsq + 5 * B9);
    const int tk = task >= 0 ? task : 0; const int item0 = (tk >> 5) * 256 + (tk & 31) * 8;
    f32x16 R = frag_load((const float*)(cw + O_RG) + (size_t)tk * 4096, wq, lane);
    f32x4 gng[4];
    { const int h0 = (item0 >> 8) & 3, c16_ = (qtid & 3) * 16;
#pragma unroll
      for (int i = 0; i < 4; ++i) gng[i] = *(const f32x4*)(gn_g + h0 * 64 + c16_ + 4 * i); }
    for (int j = 0; j < 8; ++j) { const int item = task >= 0 ? item0 + j : -1;
    const int b = item >= 0 ? item >> 10 : 0, h = item >= 0 ? (item >> 8) & 3 : 0, c = item >= 0 ? item & 255 : 0; const int t = qtid >> 2, c16 = (qtid & 3) * 16; const int pos = c * 64 + t;
    const float lg = __builtin_amdgcn_logf(1.0f - __builtin_amdgcn_exp2f(-5.0f - (float)h));
    const bf16_t* prow = Pb + ((size_t)b * SEQ + pos) * PW;
    RotIn qi, ki; u32x4 vw2[2], gw2[2]; u32x4 kvw[2];
    { rot_load(qi, prow, C_TQ + h * 64, c16); rot_load(ki, prow, C_TK + h * 64, c16); rot_cs(qi.cs, c16, ROPE + (size_t)pos * 64);
      const u32x4* vp = (const u32x4*)(prow + C_TV + h * 64 + c16); vw2[0] = vp[0]; vw2[1] = vp[1];
      const u32x4* gp = (const u32x4*)(prow + C_TG + h * 64 + c16); gw2[0] = gp[0]; gw2[1] = gp[1];
      const u32x4* kp = (const u32x4*)((const bf16_t*)(cw + O_KV) + (size_t)(item >= 0 ? item : 0) * 4096 + ((size_t)(wq * 64 + lane)) * 16); kvw[0] = kp[0]; kvw[1] = kp[1]; }
    if (item >= 0) {
#pragma unroll
        for (int g_ = 0; g_ < 16; ++g_) RTL[(32 * I + crow(g_, hh)) * SB + 32 * J + r] = (bf16_t)f2bf(R[g_]);
        float qr[16], kr[16]; rot16r(qr, qi.own, qi.par, qi.cs, c16); rot16r(kr, ki.own, ki.par, qi.cs, c16);
        u32x4 w;
        w.x = pk2(qr[0], qr[1]); w.y = pk2(qr[2], qr[3]); w.z = pk2(qr[4], qr[5]); w.w = pk2(qr[6], qr[7]); *(CK_LAS u32x4*)(Qr + t * SB + c16) = w;
        w.x = pk2(qr[8], qr[9]); w.y = pk2(qr[10], qr[11]); w.z = pk2(qr[12], qr[13]); w.w = pk2(qr[14], qr[15]); *(CK_LAS u32x4*)(Qr + t * SB + c16 + 8) = w;
#pragma unroll
        for (int e = 0; e < 16; ++e) kr[e] *= 0.125f;
        w.x = pk2(kr[0], kr[1]); w.y = pk2(kr[2], kr[3]); w.z = pk2(kr[4], kr[5]); w.w = pk2(kr[6], kr[7]); *(CK_LAS u32x4*)(Kr + t * SB + c16) = w;
        w.x = pk2(kr[8], kr[9]); w.y = pk2(kr[10], kr[11]); w.z = pk2(kr[12], kr[13]); w.w = pk2(kr[14], kr[15]); *(CK_LAS u32x4*)(Kr + t * SB + c16 + 8) = w;
#pragma unroll
        for (int hv = 0; hv < 2; ++hv) { const u32x4 vw = vw2[hv];
#pragma unroll
            for (int e2 = 0; e2 < 4; ++e2) { const int e = hv * 8 + 2 * e2; VT[(c16 + e) * SB + t] = (bf16_t)(vw[e2] & 0xffffu); VT[(c16 + e + 1) * SB + t] = (bf16_t)(vw[e2] >> 16); } }
    }
    __syncthreads();
    if (item >= 0) {
        f32x16 st = mm_lds(Kr, Qr, I, J, lane, f32x16{}); const int tt = 32 * J + r;
#pragma unroll
        for (int g = 0; g < 16; ++g) { const int ii = 32 * I + crow(g, hh); st[g] = (ii <= tt) ? st[g] * __builtin_amdgcn_exp2f(lg * (float)(tt - ii)) : 0.f; }
        tile_store_T(Sb, I, J, lane, st);
    }
    __syncthreads();
    if (item >= 0) {
        const f32x16 yi = mm_lds(VT, Sb, I, J, lane, f32x16{}); const f32x16 yc = mm_lds(RTL, Qr, I, J, lane, f32x16{});
        const int tt = 32 * J + r; const float qd = __builtin_amdgcn_exp2f(lg * (float)(tt + 1));
#pragma unroll
        for (int g = 0; g < 16; ++g) Y[tt * SF + 32 * I + crow(g, hh)] = yi[g] + qd * yc[g];
    }
    __syncthreads();
    if (item >= 0) {
        float y[16]; float s = 0.f;
#pragma unroll
        for (int e = 0; e < 16; ++e) { y[e] = Y[t * SF + c16 + e]; s += y[e]; }
        const float mu = quad_sum(s) * (1.f / 64.f); float s2 = 0.f;
#pragma unroll
        for (int e = 0; e < 16; ++e) { y[e] -= mu; s2 += y[e] * y[e]; }
        const float rstd = 1.0f / sqrtf(quad_sum(s2) * (1.f / 64.f) + 1e-6f);
        unsigned ow[8];
#pragma unroll
        for (int hv = 0; hv < 2; ++hv) { const u32x4 gw = gw2[hv];
#pragma unroll
            for (int e2 = 0; e2 < 4; ++e2) { const int e = hv * 8 + 2 * e2; const float g0 = bflo(gw[e2]), g1 = bfhi(gw[e2]);
                ow[hv * 4 + e2] = pk2(y[e] * rstd * gng[e >> 2][e & 3] * (g0 * sigm(g0)), y[e + 1] * rstd * gng[(e + 1) >> 2][(e + 1) & 3] * (g1 * sigm(g1))); } }
        u32x4* dst = (u32x4*)(MIXB + ((size_t)b * SEQ + pos) * 1024 + 768 + h * 64 + c16);
        dst[0] = (u32x4){ow[0], ow[1], ow[2], ow[3]}; dst[1] = (u32x4){ow[4], ow[5], ow[6], ow[7]};
    }
    if (item >= 0) { const u32x4 a = kvw[0], b2 = kvw[1];
        const f32x16 kvc = (f32x16){bflo(a[0]), bfhi(a[0]), bflo(a[1]), bfhi(a[1]), bflo(a[2]), bfhi(a[2]), bflo(a[3]), bfhi(a[3]), bflo(b2[0]), bfhi(b2[0]), bflo(b2[1]), bfhi(b2[1]), bflo(b2[2]), bfhi(b2[2]), bflo(b2[3]), bfhi(b2[3])};
        const float g64 = __builtin_amdgcn_exp2f(lg * 64.0f);
#pragma unroll
        for (int g_ = 0; g_ < 16; ++g_) R[g_] = R[g_] * g64 + kvc[g_]; }
    __syncthreads();
    }
}
}

__device__ __forceinline__ void tr_tile(const float* __restrict__ src, size_t ld_src, bf16* __restrict__ dst, size_t ld_dst, float* scr, int lane) {
    pg8::f32x4 v[16];
#pragma unroll
    for (int i = 0; i < 16; ++i) v[i] = *(const pg8::f32x4*)(src + (size_t)(i * 4 + (lane >> 4)) * ld_src + (lane & 15) * 4);
#pragma unroll
    for (int i = 0; i < 16; ++i) { float* p = scr + (i * 4 + (lane >> 4)) * 65 + (lane & 15) * 4; p[0] = v[i][0]; p[1] = v[i][1]; p[2] = v[i][2]; p[3] = v[i][3]; }
    asm volatile("s_waitcnt lgkmcnt(0)" ::: "memory");
#pragma unroll
    for (int i = 0; i < 8; ++i) { const int n = i * 8 + (lane >> 3), kc = (lane & 7) * 8; const float* s = scr + kc * 65 + n;
        pg8::u32x4 o; o.x = pk2(s[0], s[65]); o.y = pk2(s[2 * 65], s[3 * 65]); o.z = pk2(s[4 * 65], s[5 * 65]); o.w = pk2(s[6 * 65], s[7 * 65]);
        *(pg8::u32x4*)(dst + (size_t)n * ld_dst + kc) = o; }
    asm volatile("s_waitcnt lgkmcnt(0)" ::: "memory");
}

constexpr int CV_13 = NE * 16 * 16, CV_2 = NE * 8 * 16, CV_L = CV_13 + CV_2, NCONV = DEPTH * CV_L;
__device__ __forceinline__ void conv_item(int it, const float* __restrict__ w1, const float* __restrict__ w3, const float* __restrict__ w2, bf16* __restrict__ W13, bf16* __restrict__ W2, float* scr, int lane) {
    const int l = it / CV_L; int r = it % CV_L;
    if (r < CV_13) { const int e = r >> 8, kb = (r >> 4) & 15, nb = r & 15;
        const int pn = nb >> 2, q = nb & 3; const float* srcw = (q < 2 ? w1 : w3) + ((size_t)l * NE + e) * DM * DE;
        tr_tile(srcw + (size_t)kb * 64 * DE + pn * 128 + (q & 1) * 64, DE, W13 + ((size_t)l * NE + e) * DM * DM + (size_t)nb * 64 * DM + kb * 64, DM, scr, lane); }
    else { r -= CV_13; const int e = r >> 7, kb = (r >> 4) & 7, nb = r & 15;
        tr_tile(w2 + ((size_t)l * NE + e) * DE * DM + (size_t)kb * 64 * DM + nb * 64, DM, W2 + ((size_t)l * NE + e) * DM * DE + (size_t)nb * 64 * DE + kb * 64, DE, scr, lane); }
}

#define LAS __attribute__((address_space(3)))
#define XB_TMO      128
#define XB_XCNT(j)  (256  + 64 * (j))
#define XB_XSUB(j)  (1280 + 64 * (j))
#define XB_XGEN(j)  (2304 + 64 * (j))
#define XB_TOP      3328
#define XB_TOPGEN   3392
#define XCD_BAR_WORDS 3456
#define XB_SPIN_CAP (1u << 18)

__device__ __forceinline__ unsigned xb_ld(unsigned* p)              { return __hip_atomic_load(p, __ATOMIC_RELAXED, __HIP_MEMORY_SCOPE_AGENT); }
__device__ __forceinline__ unsigned xb_add(unsigned* p, unsigned v) { return __hip_atomic_fetch_add(p, v, __ATOMIC_RELAXED, __HIP_MEMORY_SCOPE_AGENT); }
__device__ __forceinline__ unsigned xb_xcc_id() { return (unsigned)__builtin_amdgcn_s_getreg((3 << 11) | 20) & 0xFu; }
#define XB_SPIN(cond, bar) do { unsigned _sp = 0; while (cond) { __builtin_amdgcn_s_sleep(1); \
    if ((++_sp & 255u) == 0u) { if (xb_ld(&(bar)[XB_TMO])) break; if (_sp > XB_SPIN_CAP) { atomicAdd(&(bar)[XB_TMO], 1u); break; } } } } while (0)

struct XcdBarrier {
    unsigned* bar; unsigned x;
    volatile LAS unsigned* st;
};

__device__ __forceinline__ XcdBarrier xcd_barrier_post(unsigned* bar, volatile LAS unsigned* st) {
    XcdBarrier b; b.bar = bar; b.x = xb_xcc_id(); b.st = st;
    if (ltid() == 0) (void)xb_add(&bar[XB_XCNT(b.x)], 1u);
    return b;
}
__device__ __forceinline__ void xcd_barrier_complete(unsigned* bar, unsigned x, unsigned& nloc, unsigned& nx) {
    const unsigned G = gridDim.x * gridDim.y * gridDim.z;
    unsigned sum, cnt, mine, sp = 0u;
    for (;;) {
        sum = 0u; cnt = 0u; mine = 0u;
#pragma unroll
        for (unsigned j = 0; j < 16; ++j) { const unsigned c = xb_ld(&bar[XB_XCNT(j)]); sum += c; cnt += (c > 0u) ? 1u : 0u; mine = (j == x) ? c : mine; }
        if (sum == G) break;
        __builtin_amdgcn_s_sleep(1);
        if ((++sp & 255u) == 0u) { if (xb_ld(&bar[XB_TMO])) break; if (sp > XB_SPIN_CAP) { atomicAdd(&bar[XB_TMO], 1u); break; } }
    }
    nloc = mine > 0u ? mine : 1u; nx = cnt > 0u ? cnt : 1u;
}

__device__ __forceinline__ void xcd_barrier(const XcdBarrier& b) {
    asm volatile("s_waitcnt vmcnt(0)" ::: "memory");
    __syncthreads();
    if (ltid() == 0) {
        unsigned* bar = b.bar; asm volatile("" : "+s"(bar)); unsigned bx_ = b.x; asm volatile("" : "+s"(bx_));
        __builtin_amdgcn_s_waitcnt(0);
        unsigned nloc = b.st[0], nx = b.st[1];
        if (nloc == 0u) { xcd_barrier_complete(bar, bx_, nloc, nx); b.st[0] = nloc; b.st[1] = nx; }
        const unsigned old = xb_add(&bar[XB_XSUB(bx_)], 1u);
        const unsigned gen = old / nloc;
        if (old + 1u == (gen + 1u) * nloc) {
            __builtin_amdgcn_fence(__ATOMIC_RELEASE, "agent");
            asm volatile("s_waitcnt vmcnt(0)" ::: "memory");
            const unsigned og = xb_add(&bar[XB_TOP], 1u);
            const unsigned tg = og / nx;
            if (og + 1u == (tg + 1u) * nx) xb_add(&bar[XB_TOPGEN], 1u);
            else XB_SPIN(xb_ld(&bar[XB_TOPGEN]) == tg, bar);
            __builtin_amdgcn_fence(__ATOMIC_ACQUIRE, "agent");
            xb_add(&bar[XB_XGEN(bx_)], 1u);
            asm volatile("s_waitcnt vmcnt(0)" ::: "memory");
        } else {
            XB_SPIN(xb_ld(&bar[XB_XGEN(bx_)]) == gen, bar);
            __builtin_amdgcn_fence(__ATOMIC_ACQUIRE, "agent");
            asm volatile("s_waitcnt vmcnt(0)" ::: "memory");
        }
    }
    __syncthreads();
}


__global__ void __launch_bounds__(NTHREADS, 2) mk_fwd(Args args) {
    extern __shared__ __attribute__((aligned(16))) unsigned char lds_raw[];
    float* lds = (float*)lds_raw;
    const int tid = ltid(), lane = tid & 63, wid = __builtin_amdgcn_readfirstlane(tid >> 6);
    const int G = gridDim.x, bx = blockIdx.x;
    unsigned char* ws = args.ws;
    unsigned* ctl = (unsigned*)(ws + WS_CTL);
    float* X = args.out;
    bf16* XB = (bf16*)(ws + WS_XB);
    bf16* Pb = (bf16*)(ws + WS_P);
    bf16* WIN = (bf16*)(ws + WS_WIN); bf16* WOUT = (bf16*)(ws + WS_WOUT); bf16* W13 = (bf16*)(ws + WS_W13); bf16* W2 = (bf16*)(ws + WS_W2);
    float* ROPE = (float*)(ws + WS_ROPE);
    double* LCS = (double*)(ws + WS_LCS); double* TOT = (double*)(ws + WS_TOT);
    float* BE = (float*)(ws + WS_SKIP); float* QN2 = BE + 16 * 256; float* KN2 = QN2 + 16 * 128; float* SQM = KN2 + 16 * 128;
    unsigned char* KA = ws + WS_KA;
    unsigned char* cw = ws + WS_CK; bf16* LWT = (bf16*)(ws + WS_LW);
    int* EP = (int*)(ws + WS_EP);
    float* GATE = (float*)(ws + WS_GATE);
    bf16* MIXB = (bf16*)(ws + WS_MIXB);
    bf16* Hb = (bf16*)(ws + WS_H); bf16* YP = (bf16*)(ws + WS_YP); bf16* YO = (bf16*)(ws + WS_YO);
    typedef pg8::f32x4 f32x4;
    volatile LAS unsigned* MISC = (volatile LAS unsigned*)((LAS unsigned char*)lds_raw + LDS_MISC);
    for (int u = tid; u < (LDS_ALL - LDS_MISC) / 4; u += NTHREADS) MISC[u] = 0u;
    __syncthreads();
    XcdBarrier bar = xcd_barrier_post(ctl + CW_BAR, MISC + 8);
#define GRID_BAR() xcd_barrier(bar)
    unsigned long long tp_acc = 0ull, tp_t0 = 0ull; (void)tp_acc; (void)tp_t0;

    for (int rep_ = 0; rep_ < REP_P0; ++rep_) {
            const int tid = ltid(), lane = tid & 63, wid = __builtin_amdgcn_readfirstlane(tid >> 6); (void)lane; (void)wid;
        const f32x4* xi = (const f32x4*)args.in[0]; uint2* xb = (uint2*)XB;
        for (size_t i = (size_t)bx * NTHREADS + tid; i < (size_t)T * DM / 4; i += (size_t)G * NTHREADS) { const f32x4 v = xi[i]; xb[i] = make_uint2(pk2(v[0], v[1]), pk2(v[2], v[3])); }
        for (int i = bx * NTHREADS + tid; i < SEQ * 32; i += G * NTHREADS) {
            const int pos = i >> 5, f = i & 31;
            const double inv = pow(10000.0, -(double)f / 32.0);
            const double ang = (double)pos * inv;
            ROPE[2 * i] = (float)cos(ang); ROPE[2 * i + 1] = (float)sin(ang);
        }
        { bf16* WR = (bf16*)(ws + WS_WR);
          for (int i = bx * NTHREADS + tid; i < DEPTH * 48 * 1024; i += G * NTHREADS) { const int l_ = i / (48 * 1024), o = (i / 1024) % 48, k = i & 1023;
              const float wv = o < 4 ? args.in[21][((size_t)l_ * DM + k) * 4 + o] : (o < 36 ? args.in[23][((size_t)l_ * DM + k) * 32 + (o - 4)] : 0.f);
              const unsigned hi_ = f2bf(wv); const unsigned lo_ = f2bf(wv - bf2f((unsigned short)hi_));
              WR[((size_t)l_ * 2 + 0) * 48 * 1024 + o * 1024 + k] = (bf16)hi_; WR[((size_t)l_ * 2 + 1) * 48 * 1024 + o * 1024 + k] = (bf16)lo_; } }
        for (int i = bx * NTHREADS + tid; i < DEPTH * 256 * 256; i += G * NTHREADS) {
            const int l = i >> 16, rem = i & 65535, chg = rem >> 8, ii = rem & 255;
            if (ii < 64) LWT[((size_t)l * 256 + chg) * 64 + ii] = (bf16)f2bf(args.in[6][((size_t)l * 64 + ii) * 256 + chg]);
            else if (ii < 128) LWT[(size_t)DEPTH * 256 * 64 + ((size_t)l * 256 + chg) * 64 + (ii - 64)] = (bf16)f2bf(args.in[8][((size_t)l * 64 + (ii - 64)) * 256 + chg]);
            else LWT[(size_t)2 * DEPTH * 256 * 64 + ((size_t)l * 256 + chg) * 128 + (ii - 128)] = (bf16)f2bf(args.in[9][((size_t)l * 128 + (ii - 128)) * 256 + chg]);
        }
        float* scr = lds + wid * (64 * 65);
        constexpr int I_IN = 16 * 56, I_OUT = 16 * 16, I_L = I_IN + I_OUT;
        for (int it = bx * 8 + wid; it < DEPTH * I_L; it += G * 8) {
            const int l = it / I_L; int r = it % I_L;
            if (r < I_IN) { const int kb = r / 56, nb = r % 56; const int nsrc = nb * 64 + (nb >= 24 ? 8 : 0);
                tr_tile(args.in[1] + (size_t)l * DM * INW + (size_t)kb * 64 * INW + nsrc, INW, WIN + (size_t)l * PW * DM + (size_t)nb * 64 * DM + kb * 64, DM, scr, lane); }
            else { r -= I_IN; const int kb = r / 16, nb = r % 16;
                tr_tile(args.in[16] + (size_t)l * DM * DM + (size_t)kb * 64 * DM + nb * 64, DM, WOUT + (size_t)l * DM * DM + (size_t)nb * 64 * DM + kb * 64, DM, scr, lane); }
        }
        __syncthreads();
        {
            const float* wf = args.in[1] + O_FF; const float* fbias = args.in[2];
            float w[8][16];
#pragma unroll
            for (int jq = 0; jq < 4; ++jq)
#pragma unroll
                for (int e = 0; e < 4; ++e)
#pragma unroll
                    for (int h = 0; h < 8; ++h) w[h][jq * 4 + e] = wf[(size_t)(jq * 256 + lane * 4 + e) * INW + h];
            float* ffl = lds;
            for (int ch = bx; ch < T / 128; ch += G) {
                __syncthreads();
                for (int i = 0; i < 16; ++i) { const int tl = wid * 16 + i; const size_t m = (size_t)ch * 128 + tl;
                    float acc[8];
#pragma unroll
                    for (int h = 0; h < 8; ++h) acc[h] = 0.f;
#pragma unroll
                    for (int jq = 0; jq < 4; ++jq) { const f32x4 xv = *(const f32x4*)(args.in[0] + m * DM + jq * 256 + lane * 4);
#pragma unroll
                        for (int e = 0; e < 4; ++e)
#pragma unroll
                            for (int h = 0; h < 8; ++h) acc[h] += xv[e] * w[h][jq * 4 + e]; }
#pragma unroll
                    for (int h = 0; h < 8; ++h) acc[h] = wave_sum(acc[h]);
                    if (lane < 8) { float v = acc[0];
#pragma unroll
                        for (int h = 1; h < 8; ++h) v = (lane == h) ? acc[h] : v;
                        ffl[tl * 8 + lane] = v + fbias[lane]; } }
                __syncthreads();
                {
                    const int h = wid; const int bb = (ch * 128) / SEQ, t0 = (ch * 128) % SEQ; double carry = 0.0;
#pragma unroll
                    for (int half = 0; half < 2; ++half) { double v = (double)logsigmoidf_(ffl[(half * 64 + lane) * 8 + h]);
#pragma unroll
                        for (int o = 1; o < 64; o <<= 1) { const double n = __shfl_up(v, o); if (lane >= o) v += n; }
                        v += carry; LCS[(size_t)(bb * 8 + h) * SEQ + t0 + half * 64 + lane] = v; carry = __shfl(v, 63); }
                    if (lane == 0) TOT[(bb * 8 + h) * 128 + t0 / 128] = carry;
                }
            }
            __syncthreads();
        }
    }
    GRID_BAR();

    for (int l = 0; l < DEPTH; ++l) {
        for (int rep_ = 0; rep_ < REP_A; ++rep_) {
            const int tid = ltid(), lane = tid & 63, wid = __builtin_amdgcn_readfirstlane(tid >> 6); (void)lane; (void)wid;
            pg8::Gemm g{XB, WIN + (size_t)l * PW * DM, T, PW, DM}; pg8::StaticOrder S; S.init(T, PW, G, bx);
            pg8::EpiInProj E{Pb, PW, QC2};
            pg8::gemm_phase<pg8::EpiInProj, pg8::StaticOrder, true, true>((PG8_LAS unsigned char*)lds_raw, g, S, E);
        }
        GRID_BAR();
        for (int rep_ = 0; rep_ < REP_C; ++rep_) {
            const int tid = ltid(), lane = tid & 63, wid = __builtin_amdgcn_readfirstlane(tid >> 6); (void)lane; (void)wid;
            TP_BEGIN(6);
            for (int ch = bx; ch < T / 128; ch += G) {
                const int h = wid; const int bb = (ch * 128) / SEQ, t0 = (ch * 128) % SEQ, ci = t0 / 128;
                double pre = 0.0;
                { const double* tp = TOT + (bb * 8 + h) * 128; double a = (lane < ci) ? tp[lane] : 0.0; a += (lane + 64 < ci) ? tp[lane + 64] : 0.0;
#pragma unroll
                  for (int o = 1; o < 64; o <<= 1) a += __shfl_xor(a, o);
                  pre = a; }
#pragma unroll
                for (int half = 0; half < 2; ++half) { const int t = t0 + half * 64 + lane; const double v = pre + LCS[(size_t)(bb * 8 + h) * SEQ + t];
                    const double bd = -v * 1.4426950408889634; const unsigned h_ = f2bf((float)bd); const double r1 = bd - (double)bf2f((unsigned short)h_);
                    const unsigned m_ = f2bf((float)r1); const double r2 = r1 - (double)bf2f((unsigned short)m_); const unsigned l_ = f2bf((float)r2);
                    *(pg8::u32x4*)(KA + ((size_t)(bb * 8 + h) * SEQ + t) * 16) = (pg8::u32x4){h_ | (m_ << 16), l_ | (0x3f80u << 16), 0x3f803f80u, 0u};
                    if (lane == 63) BE[(bb * 8 + h) * 256 + t / 64] = (float)bd; }
                { LAS unsigned* nrm = (LAS unsigned*)lds_raw;
                  __syncthreads();
                  if (tid < 24) nrm[tid] = tid < 16 ? 0u : 0xffffffffu;
                  __syncthreads();
                  const int tl = tid >> 2, part = tid & 3; const bf16* prow = Pb + ((size_t)ch * 128 + tl) * PW;
                  pg8::u32x4 qv_[2][8], kv_[2][8];
#pragma unroll
                  for (int hq = 0; hq < 2; ++hq)
#pragma unroll
                      for (int v8 = 0; v8 < 8; ++v8) { qv_[hq][v8] = ((const pg8::u32x4*)(prow + C_FQ + (part * 2 + hq) * 64))[v8]; kv_[hq][v8] = ((const pg8::u32x4*)(prow + C_FK + (part * 2 + hq) * 64))[v8]; }
#pragma unroll
                  for (int hq = 0; hq < 2; ++hq) { const int hd = part * 2 + hq; float sq_ = 0.f, sk_ = 0.f, dt_ = 0.f;
#pragma unroll
                      for (int v8 = 0; v8 < 8; ++v8)
#pragma unroll
                          for (int e = 0; e < 4; ++e) { const float ql_ = __builtin_bit_cast(float, qv_[hq][v8][e] << 16), qh_ = __builtin_bit_cast(float, qv_[hq][v8][e] & 0xffff0000u);
                              const float kl_ = __builtin_bit_cast(float, kv_[hq][v8][e] << 16), kh_ = __builtin_bit_cast(float, kv_[hq][v8][e] & 0xffff0000u);
                              sq_ += ql_ * ql_ + qh_ * qh_; sk_ += kl_ * kl_ + kh_ * kh_; dt_ += ql_ * kl_ + qh_ * kh_; }
                      atomicMax((unsigned*)(nrm + hd), __float_as_uint(sq_)); atomicMax((unsigned*)(nrm + 8 + hd), __float_as_uint(sk_));
                      const unsigned db_ = __float_as_uint(dt_); atomicMin((unsigned*)(nrm + 16 + hd), db_ ^ ((db_ >> 31) ? 0xffffffffu : 0x80000000u)); }
                  __syncthreads();
                  if (tid < 16) { const int hd = tid & 7; ((tid < 8) ? QN2 : KN2)[(bb * 8 + hd) * 128 + ci] = __uint_as_float(nrm[tid]); }
                  else if (tid < 24) { const unsigned u_ = nrm[tid]; SQM[(bb * 8 + (tid & 7)) * 128 + ci] = __uint_as_float(u_ ^ ((u_ >> 31) ? 0x80000000u : 0xffffffffu)); }
                }
            }
            __syncthreads();
            const ck::RwkvParams rp{args.in[3] + l * 768, args.in[4] + l * 256, args.in[5] + l * 256, args.in[7] + l * 256, args.in[10] + l * 256, args.in[11] + l * 256, args.in[12] + l * 256,
                                    args.in[13] + l * 256, args.in[14] + l * 256, args.in[15] + l * 256,
                                    LWT + (size_t)l * 256 * 64, LWT + (size_t)DEPTH * 256 * 64 + (size_t)l * 256 * 64, LWT + (size_t)2 * DEPTH * 256 * 64 + (size_t)l * 256 * 128};
#ifndef REP_S1
#define REP_S1 1
#endif
#ifndef REP_R1
#define REP_R1 1
#endif
            TP_END(6);
            TP_BEGIN(7);
            for (int rr_ = 0; rr_ < REP_S1; ++rr_)
            for (int it = bx; it < 2048; it += G) ck::rwkv_stage1((CK_LAS unsigned char*)lds_raw, it, Pb, PW, C_RR, C_RK, C_RV, C_WD, SEQ, rp, cw, tp_acc, tp_t0);
            TP_END(7);
            TP_BEGIN(8);
            { const int quad = wid >> 2;
              for (int rr_ = 0; rr_ < REP_R1; ++rr_)
              for (int i0 = bx * 2; i0 < 2048; i0 += G * 2) ck::ret_stage1((CK_LAS unsigned char*)lds_raw + quad * 2 * ck::B9, i0 + quad, Pb, PW, C_TK, C_TV, SEQ, ROPE, cw); }
            TP_END(8);
        }
        GRID_BAR();
        {
            const int tid = ltid(), lane = tid & 63, wid = __builtin_amdgcn_readfirstlane(tid >> 6); (void)lane; (void)wid;
            const int quad = wid >> 2;
#ifndef REP_S
#define REP_S 1
#endif
            TP_BEGIN(1);
            for (int rep_ = 0; rep_ < REP_S; ++rep_) {
            if (bx < 128) {
                ck::rwkv_level1((CK_LAS unsigned char*)lds_raw, 2 * bx + quad, cw);
                asm volatile("s_waitcnt vmcnt(0)" ::: "memory"); __syncthreads();
                if (tid == 0) { __builtin_amdgcn_fence(__ATOMIC_RELEASE, "agent"); asm volatile("s_waitcnt vmcnt(0)" ::: "memory");
                                __hip_atomic_fetch_add(ctl + CW_L1 + 64 * (16 * l + (bx >> 4)), 2u, __ATOMIC_RELAXED, __HIP_MEMORY_SCOPE_AGENT); }
            }
            if (bx >= 128) {
                ck::ret_level1(2 * (bx - 128) + quad, cw);
                asm volatile("s_waitcnt vmcnt(0)" ::: "memory"); __syncthreads();
                if (tid == 0) { __builtin_amdgcn_fence(__ATOMIC_RELEASE, "agent"); asm volatile("s_waitcnt vmcnt(0)" ::: "memory");
                                __hip_atomic_fetch_add(ctl + CW_L1 + 64 * (16 * l + 8 + ((bx - 128) >> 4)), 2u, __ATOMIC_RELAXED, __HIP_MEMORY_SCOPE_AGENT); }
            }
            if (bx < 8) {
                if (wid == 0) { unsigned spins = 0;
                    while (__hip_atomic_load(ctl + CW_L1 + 64 * (16 * l + bx), __ATOMIC_RELAXED, __HIP_MEMORY_SCOPE_AGENT) < 32u) { if (++spins > (1u << 22)) break; __builtin_amdgcn_s_sleep(2); }
                    __builtin_amdgcn_fence(__ATOMIC_ACQUIRE, "agent"); asm volatile("s_waitcnt vmcnt(0)" ::: "memory"); }
                __syncthreads();
                ck::rwkv_scan<32>((CK_LAS unsigned char*)lds_raw, quad == 0 ? bx : -1, (const ck::bf16_t*)(cw + ck::O_PG), (const ck::bf16_t*)(cw + ck::O_QG), (ck::bf16_t*)(cw + ck::O_HG));
            }
            else if (bx < 16) {
                if (wid == 0) { unsigned spins = 0;
                    while (__hip_atomic_load(ctl + CW_L1 + 64 * (16 * l + bx), __ATOMIC_RELAXED, __HIP_MEMORY_SCOPE_AGENT) < 32u) { if (++spins > (1u << 22)) break; __builtin_amdgcn_s_sleep(2); }
                    __builtin_amdgcn_fence(__ATOMIC_ACQUIRE, "agent"); asm volatile("s_waitcnt vmcnt(0)" ::: "memory"); }
                __syncthreads();
                if (quad == 0) ck::ret_scan_groups(bx - 8, cw);
            }
            if (bx < 16) {
                asm volatile("s_waitcnt vmcnt(0)" ::: "memory"); __syncthreads();
                if (tid == 0) { __builtin_amdgcn_fence(__ATOMIC_RELEASE, "agent"); asm volatile("s_waitcnt vmcnt(0)" ::: "memory");
                                __hip_atomic_store(ctl + CW_SF + 64 * (16 * l + bx), 1u, __ATOMIC_RELAXED, __HIP_MEMORY_SCOPE_AGENT); }
            }
            }
            __syncthreads();
            TP_END(1);
            const attn_body::AttnTensors AT{(const attn_body::bf16*)(Pb + C_FQ), (const attn_body::bf16*)(Pb + C_FK), (const attn_body::bf16*)(Pb + C_FV), (attn_body::bf16*)MIXB, KA};
            bool cvdone = false;
#ifndef REP_D
#define REP_D 1
#endif
            for (int apass = 0; apass < 2; ++apass) {
            if (apass == 1) {
            __syncthreads();
            TP_BEGIN(4);
            if (wid == 0) {
                unsigned spins = 0;
                for (;;) { const unsigned f = lane < 16 ? __hip_atomic_load(ctl + CW_SF + 64 * (16 * l + lane), __ATOMIC_RELAXED, __HIP_MEMORY_SCOPE_AGENT) : 1u;
                    if (__all(f != 0u)) break; if (++spins > (1u << 22)) break; __builtin_amdgcn_s_sleep(2); }
                __builtin_amdgcn_fence(__ATOMIC_ACQUIRE, "agent"); asm volatile("s_waitcnt vmcnt(0)" ::: "memory");
            }
            __syncthreads();
            TP_END(4);
            TP_BEGIN(5);
            const ck::RwkvParams rp{args.in[3] + l * 768, args.in[4] + l * 256, args.in[5] + l * 256, args.in[7] + l * 256, args.in[10] + l * 256, args.in[11] + l * 256, args.in[12] + l * 256,
                                    args.in[13] + l * 256, args.in[14] + l * 256, args.in[15] + l * 256, nullptr, nullptr, nullptr};
            for (;;) {
                if (tid == 0) MISC[16] = atomicAdd(ctl + CW_EQ + 64 * l, 1u);
                __syncthreads();
                const int p = (int)MISC[16];
                __syncthreads();
                if (p >= 128 + 128) break;
                if (p < 128) ck::rwkv_stage3g((CK_LAS unsigned char*)lds_raw + quad * ck::L_RW3, 2 * p + quad, rp, cw, MIXB, SEQ);
                else ck::ret_stage3g((CK_LAS unsigned char*)lds_raw + quad * ck::L_RET3G, 2 * (p - 128) + quad, Pb, PW, C_TQ, C_TK, C_TV, C_TG, SEQ, ROPE, args.in[15] + l * 256, cw, MIXB);
            }
            __syncthreads();
            TP_END(5);
            }
            for (int rd_ = 0; rd_ < REP_D; ++rd_)
            for (int gtry = 0; gtry < 8; ++gtry) {
                int grp = (bx + gtry) & 7;
                if (apass == 0) { if (gtry >= 4) continue; const int k_ = bx & 7, g0 = (k_ & 4) ? 7 : 3, g2 = (k_ & 2) ? 6 : 2; grp = gtry == 0 ? g0 : gtry == 1 ? (g0 ^ 4) : gtry == 2 ? g2 : (g2 ^ 4); }
                else if ((grp & 3) >= 2) continue;
                unsigned* qh = ctl + (rd_ ? 20480 : CW_Q) + 64 * (8 * l + grp);
                for (;;) {
                    TP_BEGIN(2);
                    if (tid == 0) MISC[16] = atomicAdd(qh, 1u);
                    __syncthreads();
                    const unsigned idx = MISC[16];
                    if (idx >= 128u) { __syncthreads(); TP_END(2); break; }
                    const int qb = 63 - (int)(idx >> 1), bh = 2 * grp + (int)(idx & 1);
                    if (wid == 0) {
                        const float qn = sqrtf(fmaxf(QN2[bh * 128 + 2 * qb], QN2[bh * 128 + 2 * qb + 1])) * 1.001f;
                        const float sq0 = fminf(SQM[bh * 128 + 2 * qb], SQM[bh * 128 + 2 * qb + 1]) - 0.05f;
                        const int ntq = 4 * qb;
                        const float bref = ntq > 0 ? BE[bh * 256 + ntq - 1] : 0.f;
                        float run = 0.f; int nsk = 0; float knv[4], bev[4];
#pragma unroll
                        for (int q4 = 0; q4 < 4; ++q4) { const int tt = q4 * 64 + lane; const bool in = tt < ntq; knv[q4] = in ? KN2[bh * 128 + (tt >> 1)] : 0.f; bev[q4] = in ? BE[bh * 256 + tt] : 0.f; }
#pragma unroll
                        for (int q4 = 0; q4 < 4; ++q4) { const int tt = q4 * 64 + lane; const bool in = tt < ntq;
                            float ms = in ? 64.0f * __builtin_amdgcn_exp2f(fminf(qn * sqrtf(knv[q4]) - sq0 - (bref - bev[q4]), 60.0f)) : 0.f;
#pragma unroll
                            for (int o = 1; o < 64; o <<= 1) { const float n_ = __shfl_up(ms, o); if (lane >= o) ms += n_; }
                            ms += run; run = __shfl(ms, 63);
                            nsk += __popcll(__ballot(in && ms <= 6.1035156e-5f)); }
                        if (lane == 0) MISC[17] = (unsigned)(nsk & ~1);
                    }
                    __syncthreads();
                    const int t0 = (int)MISC[17];
                    attn_body::attn_unit<8>(bh / attn_body::NHEAD, bh % attn_body::NHEAD, qb, t0, AT.Q, AT.K, AT.V, AT.O, AT.KA, (char*)lds_raw);
                    TP_END(2);
                    TP_BEGIN(3);
                    if (!cvdone) {
                        if (tid == 0) MISC[18] = atomicAdd(ctl + CW_CV, 16u);
                        __syncthreads();
                        const int tk = (int)MISC[18];
                        if (tk >= NCONV) cvdone = true;
                        else { const int t2 = ltid(), lane2 = t2 & 63, wid2 = __builtin_amdgcn_readfirstlane(t2 >> 6);
                            float* scr = lds + wid2 * (64 * 65);
                            _Pragma("clang loop unroll(disable)") for (int q2 = 0; q2 < 2; ++q2) { const int itc = tk + 8 * q2 + wid2; if (itc < NCONV) conv_item(itc, args.in[25], args.in[26], args.in[27], W13, W2, scr, lane2); } }
                        __syncthreads();
                    }
                    TP_END(3);
                }
            }
            }
        }
        GRID_BAR();
        for (int rep_ = 0; rep_ < REP_F; ++rep_) {
            const int tid = ltid(), lane = tid & 63, wid = __builtin_amdgcn_readfirstlane(tid >> 6); (void)lane; (void)wid;
            pg8::Gemm g{MIXB, WOUT + (size_t)l * DM * DM, T, DM, DM}; pg8::StaticOrder S; S.init(T, DM, G, bx);
            pg8::EpiInProj E{YO, DM, 1.0f};
            pg8::gemm_phase<pg8::EpiInProj, pg8::StaticOrder, true, true>((PG8_LAS unsigned char*)lds_raw, g, S, E);
        }
        GRID_BAR();
        {
            const int tid = ltid(), lane = tid & 63, wid = __builtin_amdgcn_readfirstlane(tid >> 6); (void)lane; (void)wid;
            float alpha_o = ALPHA; asm volatile("" : "+v"(alpha_o));
            const float* g1 = args.in[17] + l * DM; const float* b1 = args.in[18] + l * DM;
            const float* bg = args.in[22] + l * 4; const float* be = args.in[24] + l * 32;
            unsigned* cnt = ctl + CW_CNT + 64 * 32 * l;
            const bf16* WRh = (const bf16*)(ws + WS_WR) + (size_t)l * 2 * 48 * 1024; const bf16* WRl = WRh + 48 * 1024;
            constexpr int XS = 1032;
            LAS unsigned short* XT = (LAS unsigned short*)lds_raw;
            LAS float* PART = (LAS float*)((LAS unsigned char*)lds_raw + 32 * XS * 2);
            LAS float* LG = PART + 8 * 32 * 48;
            LAS unsigned* LCNT = (LAS unsigned*)(LG + 128 * 48);
            if (tid < 32) LCNT[tid] = 0u;
            pg8::bf16x8 wh[4][3], wl[4][3];
#pragma unroll
            for (int s_ = 0; s_ < 4; ++s_)
#pragma unroll
                for (int nt = 0; nt < 3; ++nt) { const size_t o = (size_t)(16 * nt + (lane & 15)) * 1024 + 128 * wid + 32 * s_ + 8 * (lane >> 4);
                    wh[s_][nt] = *(const pg8::bf16x8*)(WRh + o); wl[s_][nt] = *(const pg8::bf16x8*)(WRl + o); }
            float gg[16], bb[16];
#pragma unroll
            for (int jq = 0; jq < 4; ++jq) { const f32x4 gv = *(const f32x4*)(g1 + jq * 256 + lane * 4), bv = *(const f32x4*)(b1 + jq * 256 + lane * 4);
#pragma unroll
                for (int e = 0; e < 4; ++e) { gg[jq * 4 + e] = gv[e]; bb[jq * 4 + e] = bv[e]; } }
            for (int ch = bx; ch < T / 128; ch += G) {
                for (int blk = 0; blk < 4; ++blk) {
                    const size_t m0 = (size_t)ch * 128 + blk * 32;
                    uint2 xw[4][4], yw[4][4];
#pragma unroll
                    for (int i = 0; i < 4; ++i) { const size_t m = m0 + wid * 4 + i;
#pragma unroll
                        for (int jq = 0; jq < 4; ++jq) { xw[i][jq] = *(const uint2*)(XB + m * DM + jq * 256 + lane * 4); yw[i][jq] = *(const uint2*)(YO + m * DM + jq * 256 + lane * 4); } }
#pragma unroll
                    for (int i = 0; i < 4; ++i) { const int tl = wid * 4 + i; const size_t m = m0 + tl;
                        float v[16]; float sm = 0.f;
#pragma unroll
                        for (int jq = 0; jq < 4; ++jq) { const uint2 a_ = xw[i][jq], c_ = yw[i][jq];
                            const f32x4 xv = (f32x4){__builtin_bit_cast(float, a_.x << 16), __builtin_bit_cast(float, a_.x & 0xffff0000u), __builtin_bit_cast(float, a_.y << 16), __builtin_bit_cast(float, a_.y & 0xffff0000u)};
                            const f32x4 yv = (f32x4){__builtin_bit_cast(float, c_.x << 16), __builtin_bit_cast(float, c_.x & 0xffff0000u), __builtin_bit_cast(float, c_.y << 16), __builtin_bit_cast(float, c_.y & 0xffff0000u)};
#pragma unroll
                            for (int e = 0; e < 4; ++e) { v[jq * 4 + e] = alpha_o * xv[e] + yv[e]; sm += v[jq * 4 + e]; } }
                        const float mean = wave_sum(sm) * (1.f / DM); float s2 = 0.f;
#pragma unroll
                        for (int q = 0; q < 16; ++q) { v[q] -= mean; s2 += v[q] * v[q]; }
                        const float rstd = 1.0f / sqrtf(wave_sum(s2) * (1.f / DM) + LN_EPS);
#pragma unroll
                        for (int jq = 0; jq < 4; ++jq) { unsigned hw[4];
#pragma unroll
                            for (int e = 0; e < 4; ++e) hw[e] = f2bf(v[jq * 4 + e] * rstd * gg[jq * 4 + e] + bb[jq * 4 + e]);
                            const ck::u32x2 pw = (ck::u32x2){hw[0] | (hw[1] << 16), hw[2] | (hw[3] << 16)};
                            *(uint2*)(XB + m * DM + jq * 256 + lane * 4) = make_uint2(pw.x, pw.y);
                            *(LAS ck::u32x2*)(XT + tl * XS + jq * 256 + lane * 4) = pw; }
                    }
                    __syncthreads();
                    {
                        pg8::f32x4 acc[2][3];
#pragma unroll
                        for (int mt = 0; mt < 2; ++mt)
#pragma unroll
                            for (int nt = 0; nt < 3; ++nt) acc[mt][nt] = pg8::f32x4{0.f, 0.f, 0.f, 0.f};
#pragma unroll
                        for (int s_ = 0; s_ < 4; ++s_)
#pragma unroll
                            for (int mt = 0; mt < 2; ++mt) { const pg8::bf16x8 ax = *(const LAS pg8::bf16x8*)(XT + (16 * mt + (lane & 15)) * XS + 128 * wid + 32 * s_ + 8 * (lane >> 4));
#pragma unroll
                                for (int nt = 0; nt < 3; ++nt) { acc[mt][nt] = __builtin_amdgcn_mfma_f32_16x16x32_bf16(ax, wh[s_][nt], acc[mt][nt], 0, 0, 0); acc[mt][nt] = __builtin_amdgcn_mfma_f32_16x16x32_bf16(ax, wl[s_][nt], acc[mt][nt], 0, 0, 0); } }
#pragma unroll
                        for (int mt = 0; mt < 2; ++mt)
#pragma unroll
                            for (int nt = 0; nt < 3; ++nt)
#pragma unroll
                                for (int r_ = 0; r_ < 4; ++r_) PART[(wid * 32 + 16 * mt + 4 * (lane >> 4) + r_) * 48 + 16 * nt + (lane & 15)] = acc[mt][nt][r_];
                    }
                    __syncthreads();
                    for (int p_ = tid; p_ < 32 * 48; p_ += NTHREADS) { float a_ = 0.f;
#pragma unroll
                        for (int w_ = 0; w_ < 8; ++w_) a_ += PART[w_ * 32 * 48 + p_];
                        LG[blk * 32 * 48 + p_] = a_; }
                }
                __syncthreads();
                int ex0 = 0, ex1 = 0; unsigned lp0 = 0, lp1 = 0;
                if (tid < 128) { const LAS float* lg = LG + tid * 48; const size_t m = (size_t)ch * 128 + tid;
                    int grp = 0; float gbest = lg[0] + bg[0];
#pragma unroll
                    for (int o = 1; o < 4; ++o) { const float gv = lg[o] + bg[o]; if (gv > gbest) { gbest = gv; grp = o; } }
                    float den = 0.f;
#pragma unroll
                    for (int o = 0; o < 4; ++o) den += expf(lg[o] + bg[o] - gbest);
                    const float ggate = 1.0f / den;
                    int i0 = 0; float v0 = lg[4 + grp * 8] + be[grp * 8];
                    for (int o = 1; o < 8; ++o) { const float ev = lg[4 + grp * 8 + o] + be[grp * 8 + o]; if (ev > v0) { v0 = ev; i0 = o; } }
                    int i1 = -1; float v1 = -INFINITY;
                    for (int o = 0; o < 8; ++o) { const float ev = lg[4 + grp * 8 + o] + be[grp * 8 + o]; if (o != i0 && (i1 < 0 || ev > v1)) { v1 = ev; i1 = o; } }
                    const float e1 = expf(v1 - v0); const float p0 = 1.0f / (1.0f + e1), p1 = e1 / (1.0f + e1);
                    ex0 = grp * 8 + i0; ex1 = grp * 8 + i1;
                    lp0 = atomicAdd((unsigned*)(LCNT + ex0), 1u); lp1 = atomicAdd((unsigned*)(LCNT + ex1), 1u);
                    GATE[2 * m] = ggate * p0; GATE[2 * m + 1] = ggate * p1;
                }
                __syncthreads();
                if (tid < 32) { const unsigned c_ = LCNT[tid]; LCNT[32 + tid] = c_ ? atomicAdd(cnt + 64 * tid, c_) : 0u; }
                __syncthreads();
                if (tid < 128) { const size_t m = (size_t)ch * 128 + tid; const int q0 = (int)(LCNT[32 + ex0] + lp0), q1 = (int)(LCNT[32 + ex1] + lp1); EP[2 * m] = (ex0 << 16) | q0; EP[2 * m + 1] = (ex1 << 16) | q1;
                                 int* LIST = (int*)(args.ws + WS_XP); LIST[ex0 * LCAP + q0] = (int)m; LIST[ex1 * LCAP + q1] = (int)m; }
                __syncthreads();
                if (tid < 32) LCNT[tid] = 0u;
            }
            {
                __syncthreads();
                TP_BEGIN(9);
                const int endl = (l + 1) * CV_L;
                for (;;) { if (tid == 0) MISC[18] = atomicAdd(ctl + CW_CV, 8u);
                    __syncthreads();
                    const int tk = (int)MISC[18];
                    if (tk + wid < NCONV) conv_item(tk + wid, args.in[25], args.in[26], args.in[27], W13, W2, lds + wid * (64 * 65), lane);
                    __syncthreads();
                    if (tk + 8 >= endl) break; }
                TP_END(9);
            }
        }
        GRID_BAR();
        for (int rep_ = 0; rep_ < REP_IJ; ++rep_) {
            const int tid = ltid(), lane = tid & 63, wid = __builtin_amdgcn_readfirstlane(tid >> 6); (void)lane; (void)wid;
            unsigned* cnt = ctl + CW_CNT + 64 * 32 * l;
            PG8_LAS int* tile_e = (PG8_LAS int*)((PG8_LAS unsigned char*)lds_raw + 131072); PG8_LAS int* tst = tile_e + MAXTILES;
            __syncthreads();
            PG8_LAS int* cntL = tst + NE + 1;
            if (tid < 64) { const int c_ = lane < NE ? (int)cnt[64 * lane] : 0; int v_ = (c_ + 255) >> 8;
#pragma unroll
                for (int o = 1; o < 32; o <<= 1) { const int n_ = __shfl_up(v_, o); if (lane >= o) v_ += n_; }
                if (lane < NE) { tst[lane + 1] = v_; cntL[lane] = c_; } if (lane == 0) tst[0] = 0; }
            __syncthreads();
            const int ntile = tst[NE];
            if (tid < ntile) { int e = 0; while (tst[e + 1] <= tid) ++e; tile_e[tid] = e; }
            __syncthreads();
            pg8::MoeOrder S{ntile, G, bx, tile_e};
            PG8_LAS unsigned* rowoff = (PG8_LAS unsigned*)((PG8_LAS unsigned char*)lds_raw + 133120);
            if (tid < 256) { int tk_[5]; const int* LIST = (const int*)(args.ws + WS_XP);
#pragma unroll
                for (int i = 0; i < 5; ++i) { const int L = i * G + bx; tk_[i] = 0;
                    if (L < ntile * 4) { const int rt = L >> 2, e = tile_e[rt], p_ = (rt - tst[e]) * 256 + tid; if (p_ < cntL[e]) tk_[i] = LIST[e * LCAP + p_]; } }
#pragma unroll
                for (int i = 0; i < 5; ++i) rowoff[i * 256 + tid] = (unsigned)tk_[i] * (unsigned)(DM * 2); }
            __syncthreads();
            { pg8::Gemm g{XB, W13 + (size_t)l * NE * DM * DM, ntile * 256, DM, DM}; pg8::EpiSwiGlu E{Hb, DE};
              pg8::gemm_phase<pg8::EpiSwiGlu, pg8::MoeOrder, true, true, true>((PG8_LAS unsigned char*)lds_raw, g, S, E, rowoff); }
            GRID_BAR();
            { pg8::Gemm g{Hb, W2 + (size_t)l * NE * DM * DE, ntile * 256, DM, DE}; pg8::EpiInProj E{YP, DM, 1.0f};
              pg8::gemm_phase<pg8::EpiInProj, pg8::MoeOrder, true, true>((PG8_LAS unsigned char*)lds_raw, g, S, E); }
        }
        GRID_BAR();
        for (int rep_ = 0; rep_ < REP_K; ++rep_) { float* Xo = (rep_ == REP_K - 1) ? X : (float*)(ws + WS_XP); bf16* XBo = (rep_ == REP_K - 1) ? XB : (bf16*)(ws + WS_H);
            const int tid = ltid(), lane = tid & 63, wid = __builtin_amdgcn_readfirstlane(tid >> 6); (void)lane; (void)wid;
            float alpha_o = ALPHA; asm volatile("" : "+v"(alpha_o));
            const float* g2 = args.in[19] + l * DM; const float* b2 = args.in[20] + l * DM;
            const bool doff = (l + 1 < DEPTH); const int ln = doff ? l + 1 : l;
            const float* wf = args.in[1] + (size_t)ln * DM * INW + O_FF; const float* fbias = args.in[2] + ln * 8;
            LAS f32x4* W4 = (LAS f32x4*)((LAS unsigned char*)lds_raw + 4096);
            __syncthreads();
            for (int q = tid; q < 40 * 64; q += NTHREADS) { const int row = q >> 6, ln_ = q & 63; f32x4 val;
                const int s4 = row & 3, col0 = (s4 >> 1) * 512 + ln_ * 8 + (s4 & 1) * 4;
                if (row < 32) { const int h = row >> 2;
#pragma unroll
                    for (int e = 0; e < 4; ++e) val[e] = wf[(size_t)(col0 + e) * INW + h]; }
                else if (row < 36) val = *(const f32x4*)(g2 + col0);
                else val = *(const f32x4*)(b2 + col0);
                W4[q] = val; }
            float* ffl = lds;
            const float fbk = lane < 8 ? fbias[lane] : 0.f;
            LAS int* poffK = (LAS int*)((LAS unsigned char*)lds_raw + 49152);
            if (tid < 64) { const unsigned* cnt = ctl + CW_CNT + 64 * 32 * l; const int pc_ = lane < NE ? ((((int)cnt[64 * lane] + 255) >> 8) << 8) : 0; int v_ = pc_;
#pragma unroll
                for (int o = 1; o < 32; o <<= 1) { const int n_ = __shfl_up(v_, o); if (lane >= o) v_ += n_; }
                if (lane < NE) poffK[lane] = v_ - pc_; }
            for (int ch = bx; ch < T / 128; ch += G) {
                __syncthreads();
                const size_t mw = (size_t)ch * 128 + wid * 16;
                const int eA = lane < 16 ? EP[2 * (mw + lane)] : 0, eB = lane < 16 ? EP[2 * (mw + lane) + 1] : 0; const int dA = poffK[eA >> 16] + (eA & 0xffff), dB = poffK[eB >> 16] + (eB & 0xffff);
                const float gA = lane < 16 ? GATE[2 * (mw + lane)] : 0.f, gB = lane < 16 ? GATE[2 * (mw + lane) + 1] : 0.f;
                uint2 xA[2][4], xB[2][4]; uint2 aA[2][4], aB[2][4], bA[2][4], bB[2][4]; float gA2[2][2], gB2[2][2];
#define K_LOAD(XS, WAS, WBS, GS, IEXP) _Pragma("unroll")                     for (int u = 0; u < 2; ++u) { const size_t m = mw + IEXP + u;                         const size_t da = (size_t)__builtin_amdgcn_readlane(dA, IEXP + u), db = (size_t)__builtin_amdgcn_readlane(dB, IEXP + u);                         GS[u][0] = __builtin_bit_cast(float, __builtin_amdgcn_readlane(__builtin_bit_cast(int, gA), IEXP + u)); GS[u][1] = __builtin_bit_cast(float, __builtin_amdgcn_readlane(__builtin_bit_cast(int, gB), IEXP + u)); _Pragma("unroll")                         for (int j2 = 0; j2 < 2; ++j2) { { const pg8::u32x4 xw_ = *(const pg8::u32x4*)(XB + m * DM + j2 * 512 + lane * 8); XS[u][2 * j2] = make_uint2(xw_.x, xw_.y); XS[u][2 * j2 + 1] = make_uint2(xw_.z, xw_.w); }                             { const pg8::u32x4 wa_ = *(const pg8::u32x4*)(YP + da * DM + j2 * 512 + lane * 8), wb_ = *(const pg8::u32x4*)(YP + db * DM + j2 * 512 + lane * 8); WAS[u][2 * j2] = make_uint2(wa_.x, wa_.y); WAS[u][2 * j2 + 1] = make_uint2(wa_.z, wa_.w); WBS[u][2 * j2] = make_uint2(wb_.x, wb_.y); WBS[u][2 * j2 + 1] = make_uint2(wb_.z, wb_.w); } } }
                { const int i = 0; K_LOAD(xA, aA, bA, gA2, i); }
#define K_PAIR(XS, WAS, WBS, GS, IB) do { float ov_[2][16]; _Pragma("unroll") for (int u = 0; u < 2; ++u) { const float ga = GS[u][0], gb = GS[u][1]; float s_ = 0.f; \
                        _Pragma("unroll") for (int jq = 0; jq < 4; ++jq) { const uint2 w0 = WAS[u][jq], w1 = WBS[u][jq], wx = XS[u][jq]; \
                            const f32x4 xv = (f32x4){__builtin_bit_cast(float, wx.x << 16), __builtin_bit_cast(float, wx.x & 0xffff0000u), __builtin_bit_cast(float, wx.y << 16), __builtin_bit_cast(float, wx.y & 0xffff0000u)}; \
                            const f32x4 ya = (f32x4){__builtin_bit_cast(float, w0.x << 16), __builtin_bit_cast(float, w0.x & 0xffff0000u), __builtin_bit_cast(float, w0.y << 16), __builtin_bit_cast(float, w0.y & 0xffff0000u)}; \
                            const f32x4 yb = (f32x4){__builtin_bit_cast(float, w1.x << 16), __builtin_bit_cast(float, w1.x & 0xffff0000u), __builtin_bit_cast(float, w1.y << 16), __builtin_bit_cast(float, w1.y & 0xffff0000u)}; \
                            _Pragma("unroll") for (int e = 0; e < 4; ++e) { ov_[u][jq * 4 + e] = alpha_o * xv[e] + (ga * ya[e] + gb * yb[e]); s_ += ov_[u][jq * 4 + e]; } } \
                        const float mean = wave_sum(s_) * (1.f / DM); float s2 = 0.f; \
                        _Pragma("unroll") for (int q = 0; q < 16; ++q) { ov_[u][q] -= mean; s2 += ov_[u][q] * ov_[u][q]; } \
                        const float rstd = 1.0f / sqrtf(wave_sum(s2) * (1.f / DM) + LN_EPS); \
                        _Pragma("unroll") for (int q = 0; q < 16; ++q) ov_[u][q] *= rstd; } \
                    { _Pragma("unroll") for (int jq = 0; jq < 4; ++jq) { const f32x4 gv_ = W4[(32 + jq) * 64 + lane], bv_ = W4[(36 + jq) * 64 + lane]; \
                        _Pragma("unroll") for (int u = 0; u < 2; ++u) _Pragma("unroll") for (int e = 0; e < 4; ++e) ov_[u][jq * 4 + e] = ov_[u][jq * 4 + e] * gv_[e] + bv_[e]; } \
                      _Pragma("unroll") for (int u = 0; u < 2; ++u) { const size_t m = mw + (IB) + u; \
                        _Pragma("unroll") for (int j2 = 0; j2 < 2; ++j2) { \
                            if (!doff) { *(f32x4*)(Xo + m * DM + j2 * 512 + lane * 8) = (f32x4){ov_[u][8 * j2], ov_[u][8 * j2 + 1], ov_[u][8 * j2 + 2], ov_[u][8 * j2 + 3]}; *(f32x4*)(Xo + m * DM + j2 * 512 + lane * 8 + 4) = (f32x4){ov_[u][8 * j2 + 4], ov_[u][8 * j2 + 5], ov_[u][8 * j2 + 6], ov_[u][8 * j2 + 7]}; } \
                            *(pg8::u32x4*)(XBo + m * DM + j2 * 512 + lane * 8) = (pg8::u32x4){pk2(ov_[u][8 * j2], ov_[u][8 * j2 + 1]), pk2(ov_[u][8 * j2 + 2], ov_[u][8 * j2 + 3]), pk2(ov_[u][8 * j2 + 4], ov_[u][8 * j2 + 5]), pk2(ov_[u][8 * j2 + 6], ov_[u][8 * j2 + 7])}; } } } \
                    if (doff) { _Pragma("unroll") for (int hb = 0; hb < 2; ++hb) { float acc_[2][4]; _Pragma("unroll") for (int u = 0; u < 2; ++u) _Pragma("unroll") for (int h = 0; h < 4; ++h) acc_[u][h] = 0.f; \
                        _Pragma("unroll") for (int jq = 0; jq < 4; ++jq) { f32x4 wv_[4]; _Pragma("unroll") for (int h = 0; h < 4; ++h) wv_[h] = W4[((4 * hb + h) * 4 + jq) * 64 + lane]; \
                            _Pragma("unroll") for (int u = 0; u < 2; ++u) _Pragma("unroll") for (int h = 0; h < 4; ++h) \
                                acc_[u][h] += (ov_[u][jq * 4] * wv_[h][0] + ov_[u][jq * 4 + 1] * wv_[h][1]) + (ov_[u][jq * 4 + 2] * wv_[h][2] + ov_[u][jq * 4 + 3] * wv_[h][3]); } \
                        _Pragma("unroll") for (int u = 0; u < 2; ++u) { const int tl = wid * 16 + (IB) + u; \
                            _Pragma("unroll") for (int h = 0; h < 4; ++h) acc_[u][h] = wave_sum(acc_[u][h]); \
                            if ((lane >> 2) == hb) { float fv = acc_[u][0]; _Pragma("unroll") for (int h = 1; h < 4; ++h) fv = ((lane & 3) == h) ? acc_[u][h] : fv; ffl[tl * 8 + lane] = fv + fbk; } } } } } while (0)
                for (int i = 0; i < 16; i += 4) {
                    { const int i1 = i + 2; K_LOAD(xB, aB, bB, gB2, i1); }
                    K_PAIR(xA, aA, bA, gA2, i);
                    if (i + 4 < 16) { const int i2 = i + 4; K_LOAD(xA, aA, bA, gA2, i2); }
                    K_PAIR(xB, aB, bB, gB2, i + 2);
                }
#undef K_PAIR
#undef K_LOAD
                __syncthreads();
                if (doff) {
                    const int h = wid; const int bb = (ch * 128) / SEQ, t0 = (ch * 128) % SEQ; double carry = 0.0;
#pragma unroll
                    for (int half = 0; half < 2; ++half) { double vv = (double)logsigmoidf_(ffl[(half * 64 + lane) * 8 + h]);
#pragma unroll
                        for (int o = 1; o < 64; o <<= 1) { const double n = __shfl_up(vv, o); if (lane >= o) vv += n; }
                        vv += carry; LCS[(size_t)(bb * 8 + h) * SEQ + t0 + half * 64 + lane] = vv; carry = __shfl(vv, 63); }
                    if (lane == 0) TOT[(bb * 8 + h) * 128 + t0 / 128] = carry;
                }
            }
        }
        if (l + 1 < DEPTH) GRID_BAR();
    }
    if (TPROBE_SEL != 0) { unsigned long long* tsum = (unsigned long long*)(ctl + 200000);
        if (ltid() == 0) atomicAdd(tsum, tp_acc);
        xcd_barrier(bar);
        if (bx == 0 && ltid() == 0) { const unsigned long long tot = __hip_atomic_load(tsum, __ATOMIC_RELAXED, __HIP_MEMORY_SCOPE_AGENT); const unsigned long long waitt = tot * TPROBE_MULT / 256ull; const unsigned long long te = __builtin_amdgcn_s_memrealtime();
            while (__builtin_amdgcn_s_memrealtime() - te < waitt) __builtin_amdgcn_s_sleep(8); } }
}

extern "C" void kernel_launch(void* const* d_in, const int* in_sizes, int n_in, void* d_out, int out_size, void* d_ws, size_t ws_size, hipStream_t stream) {
    static int grid = 0;
    if (grid == 0) {
        if (n_in != 28 || out_size != T * DM || ws_size < WS_END) { fprintf(stderr, "kernel_launch: unexpected shapes (n_in %d out %d ws %zu)\n", n_in, out_size, ws_size); grid = -1; return; }
        int dev = 0, cus = 0, per_cu = 0;
        (void)hipGetDevice(&dev); (void)hipDeviceGetAttribute(&cus, hipDeviceAttributeMultiprocessorCount, dev);
        (void)hipFuncSetAttribute((const void*)mk_fwd, hipFuncAttributeMaxDynamicSharedMemorySize, LDS_ALL);
        if (hipOccupancyMaxActiveBlocksPerMultiprocessor(&per_cu, (const void*)mk_fwd, NTHREADS, LDS_ALL) != hipSuccess || per_cu < 1) fprintf(stderr, "kernel_launch: occupancy query says %d blocks per CU\n", per_cu);
        (void)hipGetLastError();
        grid = cus > 0 ? cus : 256;
        if (grid != 256) fprintf(stderr, "kernel_launch: %d CUs (built for 256)\n", grid);
    }
    if (grid < 0) return;
    (void)hipMemsetAsync((char*)d_ws + WS_CTL, 0, CTL_BYTES, stream);
    Args a{};
    for (int i = 0; i < 28; ++i) a.in[i] = (const float*)d_in[i];
    a.out = (float*)d_out; a.ws = (unsigned char*)d_ws;
    hipLaunchKernelGGL(mk_fwd, dim3(grid), dim3(NTHREADS), LDS_ALL, stream, a);
}
```

```cpp
#include <hip/hip_runtime.h>
#include <cstdio>
#include <cstdint>
#include <cmath>
__device__ __forceinline__ int ltid() { int t = __builtin_amdgcn_workitem_id_x(); asm volatile("" : "+v"(t)); return t; }

constexpr int BATCH = 2, SEQ = 16384, DM = 1024, DEPTH = 4, T = BATCH * SEQ;
constexpr int INW = 3592, PW = 3584;
constexpr int O_FF = 1536;
constexpr int C_FQ = 0, C_FK = 512, C_FV = 1024, C_RR = 1536, C_RK = 1792, C_RV = 2048, C_WD = 2304, C_AD = 2368, C_GD = 2432,
              C_TQ = 2560, C_TK = 2816, C_TV = 3072, C_TG = 3328;
constexpr int NE = 32, DE = 512, A_TOT = T * 2;
constexpr float ALPHA = 1.681792830507429f;
constexpr float LN_EPS = 1e-5f, RWKV_GN_EPS = 64e-5f, RET_GN_EPS = 1e-6f;
constexpr float QC2 = 0.125f * 1.4426950408889634f;
constexpr int NTHREADS = 512;
#ifndef REP_P0
#define REP_P0 1
#endif
#ifndef REP_A
#define REP_A 1
#endif
#ifndef REP_C
#define REP_C 1
#endif
#ifndef REP_E
#define REP_E 1
#endif
#ifndef REP_F
#define REP_F 1
#endif
#ifndef REP_H
#define REP_H 1
#endif
#ifndef REP_IJ
#define REP_IJ 1
#endif
#ifndef REP_G
#define REP_G 1
#endif
#ifndef REP_K
#define REP_K 1
#endif
constexpr int LDS_MISC = 147456, LDS_ALL = 148480;

constexpr size_t MiB = 1u << 20;
constexpr size_t WS_CTL = 0, CTL_BYTES = 1 * MiB;
constexpr size_t WS_EP = 1 * MiB;
constexpr size_t WS_DEST = 2 * MiB;
constexpr size_t WS_GATE = 9 * MiB;
constexpr size_t WS_ROPE = 11 * MiB;
constexpr size_t WS_RKD = 15 * MiB;
constexpr size_t WS_WIN = 16 * MiB;
constexpr size_t WS_WOUT = 44 * MiB;
constexpr size_t WS_W13 = 52 * MiB;
constexpr size_t WS_W2 = 308 * MiB;
constexpr size_t WS_XB = 436 * MiB;
constexpr size_t WS_P = 500 * MiB;
constexpr size_t WS_MIXB = 724 * MiB;
constexpr size_t WS_CK = 788 * MiB;
constexpr size_t WS_LW = 3 * MiB;
constexpr size_t WS_YO = 788 * MiB;
constexpr size_t WS_XP = 500 * MiB;
constexpr int LCAP = 32768;
constexpr size_t WS_XA8 = 864 * MiB;
constexpr size_t WS_H = 644 * MiB;
constexpr size_t WS_YP = 716 * MiB;
constexpr size_t WS_LCS = 1012 * MiB;
constexpr size_t WS_KA = 1014 * MiB;
constexpr size_t WS_END = 1018 * MiB;
constexpr size_t WS_WR = 5 * MiB;
constexpr size_t WS_SKIP = 4 * MiB + 65536;
constexpr size_t WS_TOT = 4 * MiB;
constexpr int CW_CNT = 32768;
constexpr int CW_Q = 2048;
constexpr int CW_L1 = 20480;
constexpr int CW_SF = 12288;
constexpr int CW_EQ = 4096;
constexpr int CW_CV = 6144;
constexpr int CW_BAR = 8192;
constexpr int MAXTILES = 288;

typedef float f32x16 __attribute__((ext_vector_type(16)));
typedef unsigned short bf16;

struct Args {
    const float* in[28]; float* out; unsigned char* ws;
};

__device__ __forceinline__ float sigmoidf_(float x) { return 1.0f / (1.0f + expf(-x)); }
__device__ __forceinline__ float logsigmoidf_(float x) { return x >= 0.f ? -log1pf(expf(-x)) : x - log1pf(expf(x)); }
__device__ __forceinline__ float wave_sum(float v) {
#define WS_DPP(ctrl, rmask) v += __builtin_bit_cast(float, __builtin_amdgcn_update_dpp(0, __builtin_bit_cast(int, v), ctrl, rmask, 0xf, false))
    WS_DPP(0x111, 0xf); WS_DPP(0x112, 0xf); WS_DPP(0x114, 0xf); WS_DPP(0x118, 0xf); WS_DPP(0x142, 0xa); WS_DPP(0x143, 0xc);
#undef WS_DPP
    return __builtin_bit_cast(float, __builtin_amdgcn_readlane(__builtin_bit_cast(int, v), 63));
}
typedef float f32x2hw __attribute__((ext_vector_type(2))); typedef __bf16 bf16x2hw __attribute__((ext_vector_type(2)));
__device__ __forceinline__ unsigned pk2(float lo, float hi) { f32x2hw v = {lo, hi}; bf16x2hw b = __builtin_convertvector(v, bf16x2hw); return __builtin_bit_cast(unsigned, b); }
__device__ __forceinline__ unsigned f2bf(float f) { return pk2(f, 0.f) & 0xffffu; }
__device__ __forceinline__ unsigned pk4_fp8(float a, float b, float c, float d) { int v = __builtin_amdgcn_cvt_pk_fp8_f32(a, b, 0, false); v = __builtin_amdgcn_cvt_pk_fp8_f32(c, d, v, true); return (unsigned)v; }
constexpr int INPROJ_FP8_FROM = DEPTH - 1;
constexpr float WIN_SCALE = 16.0f;
constexpr float W13_SCALE = 16.0f, W2_SCALE = 32.0f;
__device__ __forceinline__ float bf2f(unsigned short b) { return __builtin_bit_cast(float, (unsigned)b << 16); }
__device__ __forceinline__ float pf(const bf16* Pb, size_t m, int c) { return bf2f(Pb[m * PW + c]); }

namespace pg8 {
#define PG8_LAS __attribute__((address_space(3)))
typedef unsigned short bf16_t;
typedef short bf16x8 __attribute__((ext_vector_type(8)));
typedef float f32x4 __attribute__((ext_vector_type(4)));
typedef unsigned u32x4 __attribute__((ext_vector_type(4)));
typedef long l64x2 __attribute__((ext_vector_type(2)));
typedef int i32x4 __attribute__((ext_vector_type(4))); typedef int i32x8 __attribute__((ext_vector_type(8)));
template <bool F8> struct Frag2 { bf16x8 k[2];
    __device__ __forceinline__ void load(const PG8_LAS unsigned char* p) { k[0] = *(const PG8_LAS bf16x8*)p; k[1] = *(const PG8_LAS bf16x8*)(p + 1024); } };
template <> struct Frag2<true> { i32x8 v;
    __device__ __forceinline__ void load(const PG8_LAS unsigned char* p) { const i32x4 lo = *(const PG8_LAS i32x4*)p, hi = *(const PG8_LAS i32x4*)(p + 1024); v = __builtin_shufflevector(lo, hi, 0, 1, 2, 3, 4, 5, 6, 7); } };
__device__ __forceinline__ f32x4 mma2(const Frag2<false>& b, const Frag2<false>& a, f32x4 c) { c = __builtin_amdgcn_mfma_f32_16x16x32_bf16(b.k[0], a.k[0], c, 0, 0, 0); return __builtin_amdgcn_mfma_f32_16x16x32_bf16(b.k[1], a.k[1], c, 0, 0, 0); }
__device__ __forceinline__ f32x4 mma2(const Frag2<true>& b, const Frag2<true>& a, f32x4 c) { return __builtin_amdgcn_mfma_scale_f32_16x16x128_f8f6f4(b.v, a.v, c, 0, 0, 0, 0x7f7f7f7f, 0, 0x7f7f7f7f); }
constexpr int BM = 256, BK = 64, HALF = 128, HTB = HALF * BK * 2  , STAGE_BYTES = 8 * HTB, NXCD = 8, WGM = 8;

__host__ __device__ __forceinline__ int lds_byte(int r, int c) { const int st = (r >> 4) * 2 + (c >> 5), rr = r & 15, cc = c & 31, ob = rr * 64 + cc * 2; return st * 1024 + (ob ^ (((ob >> 9) & 1) << 5)); }
__host__ __device__ __forceinline__ void stage_rc(int b, int& R, int& C) { const int st = b / 1024, sb = b % 1024, swz = sb ^ (((sb >> 9) & 1) << 5); R = (st >> 1) * 16 + swz / 64; C = (st & 1) * 32 + (swz % 64) / 2; }
__host__ __device__ __forceinline__ int perm32(int rho) { const int n = rho >> 4, i = rho & 15; return 8 * (i >> 2) + 4 * n + (i & 3); }

struct Unit { int pm, pn, pc; };
struct Gemm { const bf16_t* A; const bf16_t* Bt; int M, N, K; };

struct StaticOrder {
    int nM, nN, nwg, G, c;
    __host__ __device__ void init(int M, int N, int G_, int c_) { nM = M / BM; nN = N / BM; nwg = nM * nN; G = G_; c = c_; }
    __host__ __device__ __forceinline__ bool next(int i, Unit& u) const {
        int cc_ = c;
#if defined(__HIP_DEVICE_COMPILE__)
        asm volatile("" : "+s"(cc_));
#endif
        const long L = (long)i * G + cc_; if (L >= nwg) return false;
        int wgid = (int)L; { const int q = nwg / NXCD, r = nwg % NXCD, xcd = wgid % NXCD, off = wgid / NXCD; wgid = (xcd < r ? xcd * (q + 1) : r * (q + 1) + (xcd - r) * q) + off; }
        const int nig = WGM * nN, gid = wgid / nig, fm = gid * WGM, gsz = (nM - fm) < WGM ? (nM - fm) : WGM;
        u.pm = fm + ((wgid % nig) % gsz); u.pn = (wgid % nig) / gsz; u.pc = u.pn; return true;
    }
    __device__ __forceinline__ void a_ready(const Unit&) const {}
    __device__ __forceinline__ void done(const Unit&) const {}
};

__device__ __forceinline__ unsigned cvt_pk_bf16(float lo, float hi) { unsigned r; asm volatile("v_cvt_pk_bf16_f32 %0, %1, %2" : "=v"(r) : "v"(lo), "v"(hi)); return r; }

struct EpiF32 {
    static constexpr bool PERM = false, AFTER_DRAIN = false;
    float* O; int ldc;
    __device__ __forceinline__ void operator()(const f32x4 (&acc)[2][2][4][2], const Unit& u, int wr, int wc, int fr, int fq) const {
        const int row0 = u.pm * BM + wr * 64 + fr; const int col0 = u.pc * BM + wc * 32 + 4 * fq;
#pragma unroll
        for (int ai = 0; ai < 2; ++ai)
#pragma unroll
            for (int m = 0; m < 4; ++m) { float* rowp = O + (size_t)(row0 + ai * HALF + m * 16) * ldc + col0;
#pragma unroll
                for (int bj = 0; bj < 2; ++bj)
#pragma unroll
                    for (int n = 0; n < 2; ++n) *(f32x4*)(rowp + bj * HALF + n * 16) = acc[ai][bj][m][n]; }
    }
};
struct EpiSwiGlu {
    static constexpr bool PERM = true, AFTER_DRAIN = false;
    bf16_t* O; int ldc; float isc;
    __device__ __forceinline__ static float silu(float v) { return v * __builtin_amdgcn_rcpf(1.0f + __builtin_amdgcn_exp2f(-1.4426950408889634f * v)); }
    __device__ __forceinline__ void operator()(const f32x4 (&acc)[2][2][4][2], const Unit& u, int wr, int wc, int fr, int fq) const {
        const int row0 = u.pm * BM + wr * 64 + fr; const int col0 = u.pc * HALF + wc * 32 + 8 * fq;
#pragma unroll
        for (int ai = 0; ai < 2; ++ai)
#pragma unroll
            for (int m = 0; m < 4; ++m) { bf16_t* rowp = O + (size_t)(row0 + ai * HALF + m * 16) * ldc + (col0 >> 1);
                f32x4 h0, h1;
#pragma unroll
                for (int e = 0; e < 4; ++e) { h0[e] = silu(acc[ai][0][m][0][e] * isc) * (acc[ai][1][m][0][e] * isc); h1[e] = silu(acc[ai][0][m][1][e] * isc) * (acc[ai][1][m][1][e] * isc); }
                *(uint2*)rowp = make_uint2(::pk4_fp8(h0[0], h0[1], h0[2], h0[3]), ::pk4_fp8(h1[0], h1[1], h1[2], h1[3])); }
    }
};
struct MoeOrder {
    int ntile, G, c; const PG8_LAS int* tile_e;
    __device__ __forceinline__ bool next(int i, Unit& u) const { const int L = i * G + c; if (L >= ntile * 4) return false; const int rt = L >> 2, pn = L & 3; u.pm = rt; u.pn = tile_e[rt] * 4 + pn; u.pc = pn; return true; }
    __device__ __forceinline__ void a_ready(const Unit&) const {}
    __device__ __forceinline__ void done(const Unit&) const {}
};
struct EpiInProj {
    static constexpr bool PERM = true, AFTER_DRAIN = false;
    bf16_t* O; int ldc; float qscale; float allscale = 1.0f;
    __device__ __forceinline__ void operator()(const f32x4 (&acc)[2][2][4][2], const Unit& u, int wr, int wc, int fr, int fq) const {
        int row0 = u.pm * BM + wr * 64 + fr; int col0 = u.pc * BM + wc * 32 + 8 * fq; asm volatile("" : "+v"(row0), "+v"(col0));
        const float sc = ((u.pc < 2) ? qscale : 1.f) * allscale;
#pragma unroll
        for (int ai = 0; ai < 2; ++ai)
#pragma unroll
            for (int m = 0; m < 4; ++m) { bf16_t* rowp = O + (size_t)(row0 + ai * HALF + m * 16) * ldc + col0;
#pragma unroll
                for (int bj = 0; bj < 2; ++bj) { const f32x4 v0 = acc[ai][bj][m][0] * sc, v1 = acc[ai][bj][m][1] * sc;
                    u32x4 w; w.x = cvt_pk_bf16(v0[0], v0[1]); w.y = cvt_pk_bf16(v0[2], v0[3]); w.z = cvt_pk_bf16(v1[0], v1[1]); w.w = cvt_pk_bf16(v1[2], v1[3]);
                    *(u32x4*)(rowp + bj * HALF) = w; } }
    }
};
struct EpiFp8Rows {
    static constexpr bool PERM = true, AFTER_DRAIN = false;
    bf16_t* O; int ldc;
    __device__ __forceinline__ void operator()(const f32x4 (&acc)[2][2][4][2], const Unit& u, int wr, int wc, int fr, int fq) const {
        const int row0 = u.pm * BM + wr * 64 + fr; const int col0 = u.pc * BM + wc * 32 + 8 * fq;
#pragma unroll
        for (int ai = 0; ai < 2; ++ai)
#pragma unroll
            for (int m = 0; m < 4; ++m) { bf16_t* rowp = O + (size_t)(row0 + ai * HALF + m * 16) * ldc + (col0 >> 1);
#pragma unroll
                for (int bj = 0; bj < 2; ++bj) { const f32x4 v0 = acc[ai][bj][m][0], v1 = acc[ai][bj][m][1];
                    *(uint2*)(rowp + bj * (HALF >> 1)) = make_uint2(::pk4_fp8(v0[0], v0[1], v0[2], v0[3]), ::pk4_fp8(v1[0], v1[1], v1[2], v1[3])); } }
    }
};
template <class Epi, class Sched, bool ALIGN_EPI = false, bool SP2 = false, bool GATHER = false, bool FP8 = false>
__device__ __forceinline__ void gemm_phase(PG8_LAS unsigned char* lds, const Gemm g, const Sched& S, const Epi& E, const PG8_LAS unsigned* rowoff = nullptr) {
    static_assert(!GATHER || SP2, "GATHER is written for the SP2 loop only");
    const int tid = ltid(), wid = __builtin_amdgcn_readfirstlane(tid >> 6), lane = tid & 63, wr = wid >> 2, wc = wid & 3, fr = lane & 15, fq = lane >> 4;
    const int K = g.K, nt = K / BK;
    unsigned voffA[2], voffB[2];
#pragma unroll
    for (int i = 0; i < 2; ++i) { int R, C; stage_rc(tid * 16 + i * 8192, R, C); const int Rb = Epi::PERM ? ((R & ~31) + perm32(R & 31)) : R;
        voffA[i] = GATHER ? ((unsigned)(R * 4) | ((unsigned)(C * 2) << 16)) : (unsigned)(R * K + C) * 2u; voffB[i] = (unsigned)(Rb * K + C) * 2u; }
    unsigned vc[2][2];
#define PG8_GLOAD(dst, u_) do { _Pragma("unroll") for (int h_ = 0; h_ < 2; ++h_) _Pragma("unroll") for (int i_ = 0; i_ < 2; ++i_) \
        dst[h_][i_] = *(const PG8_LAS unsigned*)((const PG8_LAS unsigned char*)rowoff + (u_) * 1024 + h_ * 512 + (voffA[i_] & 0xffffu)) + (voffA[i_] >> 16); } while (0)
#define PG8_STAGE_A(bufoff, gbase, H, VG) do { if constexpr (GATHER) PG8_STAGE(bufoff, gbase, VG[H]); else PG8_STAGE(bufoff, (gbase) + (H) * hstep, voffA); } while (0)
    const size_t kstep = (size_t)(BK * 2);
    const size_t hstep = (size_t)HALF * K * 2;
    const size_t tstep = 2 * hstep;
    const unsigned ldsw = (unsigned)wid * 1024u;
    const int aoff = lds_byte(wr * 64 + fr, fq * 8), boff = lds_byte(wc * 32 + fr, fq * 8);
#define PG8_SA(b, h) (((b) * 2 + (h)) * HTB)
#define PG8_SB(b, h) ((4 + (b) * 2 + (h)) * HTB)
#define PG8_STAGE(bufoff, gbase, voff) do { _Pragma("unroll") for (int _i = 0; _i < 2; ++_i) \
        __builtin_amdgcn_global_load_lds((const unsigned*)((const char*)(gbase) + (voff)[_i]), (PG8_LAS unsigned*)(lds + (bufoff) + ldsw + _i * 8192), 16, 0, 0); } while (0)
#define PG8_LDA(dst, b, h) do { _Pragma("unroll") for (int m = 0; m < 4; ++m) dst[m].load(lds + PG8_SA(b, h) + aoff + m * 2048); } while (0)
#define PG8_LDB(dst, b, h) do { _Pragma("unroll") for (int n = 0; n < 2; ++n) dst[n].load(lds + PG8_SB(b, h) + boff + n * 2048); } while (0)
#define PG8_MMA(ai, bj, At, Bt) do { __builtin_amdgcn_s_setprio(1); _Pragma("unroll") for (int m = 0; m < 4; ++m) _Pragma("unroll") for (int n = 0; n < 2; ++n) \
        acc[ai][bj][m][n] = mma2(Bt[n], At[m], acc[ai][bj][m][n]); __builtin_amdgcn_s_setprio(0); } while (0)
#define PG8_WAIT_V(n) asm volatile("s_waitcnt vmcnt(" #n ")" ::: "memory")
#define PG8_WAIT_L(n) asm volatile("s_waitcnt lgkmcnt(" #n ")" ::: "memory")
#define PG8_BAR __builtin_amdgcn_s_barrier()
#define PG8_SCHED __builtin_amdgcn_sched_barrier(0)
    Unit cur, nxt; int ui = 0;
    if (!S.next(0, cur)) return;
    f32x4 acc[2][2][4][2];
#pragma unroll
    for (int a = 0; a < 2; ++a)
#pragma unroll
        for (int b = 0; b < 2; ++b)
#pragma unroll
            for (int m = 0; m < 4; ++m)
#pragma unroll
                for (int n = 0; n < 2; ++n) acc[a][b][m][n] = (f32x4){0.f, 0.f, 0.f, 0.f};
    Frag2<FP8> At[4], B0[2], B1[2];
    const char* cA = (const char*)g.A + (GATHER ? (size_t)0 : (size_t)cur.pm * tstep); const char* cB = (const char*)g.Bt + (size_t)cur.pn * tstep;
    S.a_ready(cur);
    if constexpr (GATHER) PG8_GLOAD(vc, 0);
    if constexpr (SP2) {
        PG8_STAGE(PG8_SB(0, 0), cB, voffB); PG8_STAGE(PG8_SB(0, 1), cB + hstep, voffB); PG8_STAGE_A(PG8_SA(0, 0), cA, 0, vc); PG8_STAGE_A(PG8_SA(0, 1), cA, 1, vc);
        if (wr == 1) PG8_BAR;
        PG8_WAIT_V(2); PG8_BAR;
        PG8_STAGE(PG8_SB(1, 0), cB + kstep, voffB); PG8_STAGE_A(PG8_SA(1, 0), cA + kstep, 0, vc); PG8_STAGE(PG8_SB(1, 1), cB + hstep + kstep, voffB);
        PG8_WAIT_V(6); PG8_BAR;
    } else {
        PG8_STAGE(PG8_SB(0, 0), cB, voffB); PG8_STAGE(PG8_SA(0, 0), cA, voffA); PG8_STAGE(PG8_SB(0, 1), cB + hstep, voffB); PG8_STAGE(PG8_SA(0, 1), cA + hstep, voffA);
        if (wr == 1) PG8_BAR;
        PG8_WAIT_V(4); PG8_BAR;
        PG8_STAGE(PG8_SB(1, 0), cB + kstep, voffB); PG8_STAGE(PG8_SA(1, 0), cA + kstep, voffA); PG8_STAGE(PG8_SB(1, 1), cB + hstep + kstep, voffB);
        PG8_WAIT_V(6); PG8_BAR;
    }
    for (;;) {
        const bool has_next = S.next(ui + 1, nxt);
        const char* nA = (has_next && !GATHER) ? (const char*)g.A + (size_t)nxt.pm * tstep : cA; const char* nB = has_next ? (const char*)g.Bt + (size_t)nxt.pn * tstep : cB;
        _Pragma("clang loop unroll(disable)")
        for (int t = 0; t < nt; t += 2) {
            const bool last = (t == nt - 2);
            const char* a1 = cA + (size_t)(t + 1) * kstep;
            const char* a2 = last ? nA : cA + (size_t)(t + 2) * kstep; const char* b2 = last ? nB : cB + (size_t)(t + 2) * kstep;
            const char* a3 = a2 + kstep; const char* b3 = b2 + kstep;
            if (last && has_next) S.a_ready(nxt);
            if constexpr (SP2) {
            PG8_LDB(B0, 0, 0); PG8_LDB(B1, 0, 1); PG8_SCHED; PG8_LDA(At, 0, 0); PG8_STAGE_A(PG8_SA(1, 1), a1, 1, vc);
            if constexpr (GATHER) { if (last && has_next) PG8_GLOAD(vc, ui + 1); }
            PG8_WAIT_V(8); PG8_WAIT_L(0); PG8_BAR; PG8_MMA(0, 0, At, B0); PG8_MMA(0, 1, At, B1); PG8_BAR; PG8_SCHED;
            PG8_LDA(At, 0, 1); PG8_STAGE(PG8_SB(0, 0), b2, voffB); PG8_STAGE(PG8_SB(0, 1), b2 + hstep, voffB); PG8_STAGE_A(PG8_SA(0, 0), a2, 0, vc);
            PG8_WAIT_V(8); PG8_WAIT_L(0); PG8_BAR; PG8_MMA(1, 0, At, B0); PG8_MMA(1, 1, At, B1); PG8_BAR; PG8_SCHED;
            PG8_LDB(B0, 1, 0); PG8_LDB(B1, 1, 1); PG8_SCHED; PG8_LDA(At, 1, 0); PG8_STAGE_A(PG8_SA(0, 1), a2, 1, vc);
            PG8_WAIT_V(8); PG8_WAIT_L(0); PG8_BAR; PG8_MMA(0, 0, At, B0); PG8_MMA(0, 1, At, B1); PG8_BAR; PG8_SCHED;
            PG8_LDA(At, 1, 1); PG8_STAGE(PG8_SB(1, 0), b3, voffB); PG8_STAGE(PG8_SB(1, 1), b3 + hstep, voffB); PG8_STAGE_A(PG8_SA(1, 0), a3, 0, vc);
            PG8_WAIT_V(8); PG8_WAIT_L(0); PG8_BAR; PG8_MMA(1, 0, At, B0); PG8_MMA(1, 1, At, B1); PG8_BAR; PG8_SCHED;
            } else {
            PG8_LDB(B0, 0, 0); PG8_SCHED; PG8_LDA(At, 0, 0); PG8_STAGE(PG8_SA(1, 1), a1 + hstep, voffA);
            PG8_WAIT_L(8); PG8_BAR; PG8_WAIT_L(0); PG8_MMA(0, 0, At, B0); PG8_BAR; PG8_SCHED;
            PG8_LDB(B1, 0, 1); PG8_STAGE(PG8_SB(0, 0), b2, voffB);
            PG8_BAR; PG8_WAIT_L(0); PG8_MMA(0, 1, At, B1); PG8_BAR;
            PG8_LDA(At, 0, 1); PG8_STAGE(PG8_SA(0, 0), a2, voffA);
            PG8_BAR; PG8_WAIT_L(0); PG8_MMA(1, 0, At, B0); PG8_BAR; PG8_SCHED;
            PG8_STAGE(PG8_SB(0, 1), b2 + hstep, voffB);
            PG8_WAIT_V(6); PG8_BAR; PG8_MMA(1, 1, At, B1); PG8_BAR;
            PG8_LDB(B0, 1, 0); PG8_SCHED; PG8_LDA(At, 1, 0); PG8_STAGE(PG8_SA(0, 1), a2 + hstep, voffA);
            PG8_WAIT_L(8); PG8_BAR; PG8_WAIT_L(0); PG8_MMA(0, 0, At, B0); PG8_BAR; PG8_SCHED;
            PG8_LDB(B1, 1, 1); PG8_STAGE(PG8_SB(1, 0), b3, voffB);
            PG8_BAR; PG8_WAIT_L(0); PG8_MMA(0, 1, At, B1); PG8_BAR;
            PG8_LDA(At, 1, 1); PG8_STAGE(PG8_SA(1, 0), a3, voffA);
            PG8_BAR; PG8_WAIT_L(0); PG8_MMA(1, 0, At, B0); PG8_BAR; PG8_SCHED;
            PG8_STAGE(PG8_SB(1, 1), b3 + hstep, voffB);
            PG8_WAIT_V(6); PG8_BAR; PG8_MMA(1, 1, At, B1); PG8_BAR;
            }
        }
        if constexpr (ALIGN_EPI) { if (wr == 0) PG8_BAR; }
        if constexpr (!Epi::AFTER_DRAIN) { E(acc, cur, wr, wc, fr, fq); S.done(cur); }
        if (!has_next) break;
#pragma unroll
        for (int a = 0; a < 2; ++a)
#pragma unroll
            for (int b = 0; b < 2; ++b)
#pragma unroll
                for (int m = 0; m < 4; ++m)
#pragma unroll
                    for (int n = 0; n < 2; ++n) acc[a][b][m][n] = (f32x4){0.f, 0.f, 0.f, 0.f};
        cur = nxt; cA = nA; cB = nB; ++ui;
        if constexpr (ALIGN_EPI) { if (wr == 1) PG8_BAR; }
    }
    PG8_WAIT_V(0);
    if constexpr (!ALIGN_EPI) { if (wr == 0) PG8_BAR; }
    PG8_BAR;
    if constexpr (Epi::AFTER_DRAIN) { E.fused(acc, cur, wr, wc, fr, fq, lds, wid, lane); S.done(cur); }
#undef PG8_SA
#undef PG8_SB
#undef PG8_STAGE
#undef PG8_STAGE_A
#undef PG8_GLOAD
#undef PG8_LDA
#undef PG8_LDB
#undef PG8_MMA
#undef PG8_WAIT_V
#undef PG8_WAIT_L
#undef PG8_BAR
#undef PG8_SCHED
}
}

template <class RowMap, class Epi>
__device__ __forceinline__ void gemm_tile_f32(float* lds, const float* __restrict__ A, int lda, RowMap rowmap, int nvalid,
                                              const float* __restrict__ B, int ldb, int col0, int N, int K, Epi epi) {
    float* As = lds;
    float* Bs = lds + 128 * 17;
    const int tid = ltid(), lane = tid & 63, wid = tid >> 6, wm = wid & 3, wn = wid >> 2;
    const int arow = tid >> 2, akq = (tid & 3) * 4;
    const int src = (arow < nvalid) ? rowmap(arow) : -1;
    const float* ap = A + (size_t)(src < 0 ? 0 : src) * lda + akq;
    const int bk = tid >> 5, bn = (tid & 31) * 4;
    const bool bok = (col0 + bn) < N;
    const float* bp = B + (size_t)bk * ldb + col0 + bn;
    f32x16 acc0 = {}, acc1 = {};
    for (int k0 = 0; k0 < K; k0 += 16) {
        pg8::f32x4 av = (pg8::f32x4){0.f, 0.f, 0.f, 0.f}, bv = (pg8::f32x4){0.f, 0.f, 0.f, 0.f};
        if (src >= 0) av = *(const pg8::f32x4*)(ap + k0);
        if (bok) bv = *(const pg8::f32x4*)(bp + (size_t)k0 * ldb);
        __syncthreads();
        As[arow * 17 + akq + 0] = av[0]; As[arow * 17 + akq + 1] = av[1]; As[arow * 17 + akq + 2] = av[2]; As[arow * 17 + akq + 3] = av[3];
        *(pg8::f32x4*)(Bs + bk * 132 + bn) = bv;
        __syncthreads();
#pragma unroll
        for (int kk = 0; kk < 16; kk += 2) {
            const float a = As[(32 * wm + (lane & 31)) * 17 + kk + (lane >> 5)];
            const float b0 = Bs[(kk + (lane >> 5)) * 132 + 64 * wn + (lane & 31)];
            const float b1 = Bs[(kk + (lane >> 5)) * 132 + 64 * wn + 32 + (lane & 31)];
            acc0 = __builtin_amdgcn_mfma_f32_32x32x2f32(a, b0, acc0, 0, 0, 0);
            acc1 = __builtin_amdgcn_mfma_f32_32x32x2f32(a, b1, acc1, 0, 0, 0);
        }
    }
#pragma unroll
    for (int r = 0; r < 16; ++r) {
        const int i = 32 * wm + (r & 3) + 8 * (r >> 2) + 4 * (lane >> 5);
        const int c0 = col0 + 64 * wn + (lane & 31);
        if (i < nvalid) {
            if (c0 < N) epi(i, c0, acc0[r]);
            if (c0 + 32 < N) epi(i, c0 + 32, acc1[r]);
        }
    }
}

#include <hip/hip_bf16.h>
namespace attn_body {
using bf16=__hip_bfloat16;
using bf16x8=__attribute__((ext_vector_type(8)))short;
using s16x4=__attribute__((ext_vector_type(4)))short;
using f32x16=__attribute__((ext_vector_type(16)))float;
using u32x4=__attribute__((ext_vector_type(4)))unsigned;
typedef float f32x4_t __attribute__((ext_vector_type(4)));
constexpr int BATCH=2,NHEAD=8,SEQ=16384,D=64,DM=3584,OP=1024;
constexpr int NW=8,QBLK=32,QB=QBLK*NW,KVBLK=64,NQB=SEQ/QB;
constexpr int ATTN_PITCH=DM, ATTN_UNIT_ROWS=QB;
__device__ __forceinline__ int crow(int r,int hi){return (r&3)+8*(r>>2)+4*hi;}
#define SBAR() __builtin_amdgcn_sched_barrier(0)
__device__ __forceinline__ void cmask(f32x16&p0,f32x16&p1,int jb,int qrel,int hi){
  const float NEG=-INFINITY; int kb=64*jb+4*hi;
  #pragma unroll
  for(int r=0;r<16;++r){int kv=kb+(r&3)+8*(r>>2); if(kv>qrel)p0[r]=NEG; if(kv+32>qrel)p1[r]=NEG;}
}

constexpr int NSLOT=3, SLOTB=8192;
constexpr int LDS_K=0, LDS_V=NSLOT*SLOTB, LDS_WS=2*NSLOT*SLOTB, LDS_OST=LDS_WS+NW*64*4, LDS_BYTES=LDS_OST+NW*4096;
constexpr float C2=0.125f*1.4426950408889634f;
__device__ __forceinline__ void glds16(const void*gsrc,unsigned lds_dst){unsigned keep;
  asm volatile("s_mov_b32 %0, m0\n\ts_mov_b32 m0, %2\n\ts_nop 0\n\tglobal_load_lds_dwordx4 %1, off\n\ts_mov_b32 m0, %0":"=&s"(keep):"v"(gsrc),"s"(lds_dst):"memory");}
__device__ __forceinline__ float max3f(float a,float b,float c){float r;asm("v_max3_f32 %0, %1, %2, %3":"=v"(r):"v"(a),"v"(b),"v"(c));return r;}
__device__ __forceinline__ float max2f(float a,float b){float r;asm("v_max_f32_e32 %0, %1, %2":"=v"(r):"v"(a),"v"(b));return r;}
__device__ __forceinline__ float fadd_s(float a,float b){float r;asm("v_add_f32_e32 %0, %1, %2":"=v"(r):"v"(a),"v"(b));return r;}
__device__ __forceinline__ float fsub_s(float a,float b){float r;asm("v_sub_f32_e32 %0, %1, %2":"=v"(r):"v"(a),"v"(b));return r;}
typedef float f32x2_t __attribute__((ext_vector_type(2))); typedef __bf16 bf16x2_t __attribute__((ext_vector_type(2)));
__device__ __forceinline__ unsigned cvtpk_s(float lo,float hi){f32x2_t v={lo,hi};bf16x2_t b=__builtin_convertvector(v,bf16x2_t);return __builtin_bit_cast(unsigned,b);}
#define WAIT_BAR(N) asm volatile("s_waitcnt vmcnt(" #N ") lgkmcnt(0)\n\ts_barrier":::"memory")

__device__ __forceinline__ void qkt(f32x16&p0,f32x16&p1,const char*Kslot,const bf16x8*qr,int r32,int hi){
  const char*kb=Kslot+hi*1024+r32*16;
  #pragma unroll
  for(int d0=0;d0<4;++d0){
    const bf16x8 b0=*reinterpret_cast<const bf16x8*>(kb+d0*2048);
    const bf16x8 b1=*reinterpret_cast<const bf16x8*>(kb+d0*2048+512);
    p0=__builtin_amdgcn_mfma_f32_32x32x16_bf16(b0,qr[d0],p0,0,0,0);p1=__builtin_amdgcn_mfma_f32_32x32x16_bf16(b1,qr[d0],p1,0,0,0);}
}
typedef __attribute__((address_space(3))) const char* lds_cptr;
typedef short v4i16_t __attribute__((ext_vector_type(4)));
__device__ __forceinline__ void kload8(bf16x8*kf,lds_cptr kp){
  kf[0]=*(const __attribute__((address_space(3))) bf16x8*)(kp);      kf[1]=*(const __attribute__((address_space(3))) bf16x8*)(kp+512);
  kf[2]=*(const __attribute__((address_space(3))) bf16x8*)(kp+2048); kf[3]=*(const __attribute__((address_space(3))) bf16x8*)(kp+2560);
  kf[4]=*(const __attribute__((address_space(3))) bf16x8*)(kp+4096); kf[5]=*(const __attribute__((address_space(3))) bf16x8*)(kp+4608);
  kf[6]=*(const __attribute__((address_space(3))) bf16x8*)(kp+6144); kf[7]=*(const __attribute__((address_space(3))) bf16x8*)(kp+6656);
}
__device__ __forceinline__ void kload2(bf16x8*kf,lds_cptr kp,int j){ kf[2*j]=*(const __attribute__((address_space(3))) bf16x8*)(kp+j*2048); kf[2*j+1]=*(const __attribute__((address_space(3))) bf16x8*)(kp+j*2048+512); }
__device__ __forceinline__ s16x4 vtr(lds_cptr p){ return __builtin_bit_cast(s16x4,__builtin_amdgcn_ds_read_tr16_b64_v4i16((__attribute__((address_space(3))) v4i16_t*)p)); }
__device__ __forceinline__ float rowmax(const f32x16&p0,const f32x16&p1){
  float a=max3f(p0[0],p0[1],p1[0]),b=max3f(p0[2],p0[3],p1[1]);a=max3f(a,p1[2],p1[3]);
  #pragma unroll
  for(int r=4;r<16;r+=4){a=max3f(a,p0[r],p0[r+1]);b=max3f(b,p0[r+2],p0[r+3]);a=max3f(a,p1[r],p1[r+1]);b=max3f(b,p1[r+2],p1[r+3]);}
  const float m=max2f(a,b);
  auto rr=__builtin_amdgcn_permlane32_swap(__float_as_uint(m),__float_as_uint(m),false,false);
  return max2f(__uint_as_float(rr[0]),__uint_as_float(rr[1]));
}
__device__ __forceinline__ void pv(f32x16*o,int vb,bf16x8 pa0,bf16x8 pa1,bf16x8 pa2,bf16x8 pa3){
  #pragma unroll
  for(int d0=0;d0<2;++d0){s16x4 lo[4],hi[4];
    #pragma unroll
    for(int ks=0;ks<4;++ks){
      asm volatile("ds_read_b64_tr_b16 %0,%1 offset:%c2":"=&v"(lo[ks]):"v"(vb),"i"(d0*4096+ks*1024):"memory");
      asm volatile("ds_read_b64_tr_b16 %0,%1 offset:%c2":"=&v"(hi[ks]):"v"(vb),"i"(d0*4096+ks*1024+512):"memory");}
    asm volatile("s_waitcnt lgkmcnt(0)":::"memory");SBAR();
    #define PK(k) (bf16x8){lo[k][0],lo[k][1],lo[k][2],lo[k][3],hi[k][0],hi[k][1],hi[k][2],hi[k][3]}
    o[d0]=__builtin_amdgcn_mfma_f32_32x32x16_bf16(pa0,PK(0),o[d0],0,0,0);
    o[d0]=__builtin_amdgcn_mfma_f32_32x32x16_bf16(pa1,PK(1),o[d0],0,0,0);
    o[d0]=__builtin_amdgcn_mfma_f32_32x32x16_bf16(pa2,PK(2),o[d0],0,0,0);
    o[d0]=__builtin_amdgcn_mfma_f32_32x32x16_bf16(pa3,PK(3),o[d0],0,0,0);
    #undef PK
  }
}

#ifndef ATTN_STORE16
#define ATTN_STORE16(p,v) (*(u32x4*)(p)=(v))
#endif
template<int THRL> __device__ __forceinline__ void attn_unit(int b,int h,int qb,int t0,const bf16*Q,const bf16*__restrict__ K,const bf16*__restrict__ V,bf16*O,const unsigned char*KAg,char*shm){
  const int tid=ltid(),lane=tid&63,r32=lane&31,hi=lane>>5; const int wid=__builtin_amdgcn_readfirstlane(tid>>6);
  const long rowbase=(long)b*SEQ; const int q0=qb*QB;
  const bf16*Qw=Q+(rowbase+q0+wid*QBLK)*DM+h*D;
  const bf16*Kh=K+(rowbase+(long)t0*KVBLK)*DM+h*D,*Vh=V+(rowbase+(long)t0*KVBLK)*DM+h*D;
  const unsigned lds0=(unsigned)(uintptr_t)shm;
  float*wsf=(float*)(shm+LDS_WS)+wid*64;
  const bf16*ksrc=Kh+(long)lane*DM+wid*8;
  const bf16*vsrc=Vh+(long)(16*(wid&3)+(lane>>2))*DM+(wid>>2)*32+(lane&3)*8;
  const unsigned kdst=lds0+LDS_K+wid*1024, vdst=lds0+LDS_V+wid*1024;
  #define DMA_K(t,slot) glds16(ksrc+(long)(t)*KVBLK*DM,(unsigned)__builtin_amdgcn_readfirstlane(kdst+(slot)))
  #define DMA_V(t,slot) glds16(vsrc+(long)(t)*KVBLK*DM,(unsigned)__builtin_amdgcn_readfirstlane(vdst+(slot)))
  const int vb0=(int)(lds0+LDS_V)+((lane>>4)&1)*32+(lane&3)*8+(4*hi+((lane&15)>>2))*64;
  const char*Kbase=shm+LDS_K; bf16x8 kf[8];
  const lds_cptr shm3=(lds_cptr)shm; const lds_cptr kp0=shm3+LDS_K+hi*1024+r32*16; const lds_cptr vp0=shm3+LDS_V+((lane>>4)&1)*32+(lane&3)*8+(4*hi+((lane&15)>>2))*64;
  const int NT=(q0+QB)/KVBLK-t0;
  u32x4 ka0,ka1; u32x4 qaw;
  const unsigned kavoff=(unsigned)r32*16u;
  const unsigned long long kab0=(unsigned long long)(uintptr_t)KAg+((unsigned long long)((b*NHEAD+h)*(long)SEQ+(long)t0*KVBLK))*16ull;
  #define KA_LOAD(t) do{ const unsigned long long a_=kab0+(unsigned long long)(t)*1024ull; const unsigned lo_=__builtin_amdgcn_readfirstlane((unsigned)a_),hi_=__builtin_amdgcn_readfirstlane((unsigned)(a_>>32)); \
    const unsigned long long sb_=((unsigned long long)hi_<<32)|lo_; \
    asm volatile("s_nop 4\n\tglobal_load_dwordx4 %0, %2, %3\n\tglobal_load_dwordx4 %1, %2, %3 offset:512":"=&v"(ka0),"=&v"(ka1):"v"(kavoff),"s"(sb_):"memory"); }while(0)
  #define QA_SET() do{ const float nm_=-mhat; const unsigned h_=cvtpk_s(nm_,0.f)&0xffffu; const float r1_=nm_-__uint_as_float(h_<<16); const unsigned m_=cvtpk_s(r1_,0.f)&0xffffu; \
    const float r2_=r1_-__uint_as_float(m_<<16); const unsigned l_=cvtpk_s(r2_,0.f)&0xffffu; \
    qaw[0]=hi?0u:0x3f803f80u; qaw[1]=hi?0u:(0x3f80u|(h_<<16)); qaw[2]=hi?0u:(m_|(l_<<16)); qaw[3]=0u; asm volatile("":"+v"(qaw)); }while(0)
  #define AUG(C0,C1) do{ C0=__builtin_amdgcn_mfma_f32_32x32x16_bf16(__builtin_bit_cast(bf16x8,ka0),__builtin_bit_cast(bf16x8,qaw),f32x16{},0,0,0); \
    C1=__builtin_amdgcn_mfma_f32_32x32x16_bf16(__builtin_bit_cast(bf16x8,ka1),__builtin_bit_cast(bf16x8,qaw),f32x16{},0,0,0); }while(0)
  #define PIN_KA() asm volatile("; KA landed":"+v"(ka0),"+v"(ka1)::"memory")
  #define WAIT_BAR_KA(N) do{ WAIT_BAR(N); PIN_KA(); }while(0)
  KA_LOAD(0);
  DMA_K(0,0);DMA_V(0,0);DMA_K(1,SLOTB);
  bf16x8 qr[4];
  #pragma unroll
  for(int d0=0;d0<4;++d0)qr[d0]=*reinterpret_cast<const bf16x8*>(&Qw[(long)r32*DM+d0*16+hi*8]);
  float mhat=0.f,l_reg=0.f;f32x16 o[2];o[0]=f32x16{};o[1]=f32x16{}; QA_SET();
  const int qrel=wid*QBLK+r32;
  #define CMASK(P0,P1,t) do{int jb_=(t)-(NT-4); if(jb_>=0)cmask(P0,P1,jb_,qrel,hi);}while(0)
  bool resc=false;
  #define START(P0,P1) do{ const float rm=rowmax(P0,P1); resc=false; \
    { const float dl=rm; mhat=fadd_s(mhat,dl); \
      _Pragma("unroll") for(int r=0;r<16;++r){P0[r]=fsub_s(P0[r],dl);P1[r]=fsub_s(P1[r],dl);} \
      QA_SET(); } \
    _Pragma("unroll") for(int r=0;r<16;++r)P0[r]=__builtin_amdgcn_exp2f(P0[r]); }while(0)
  #define RESC() do{ if(resc){ asm volatile("s_waitcnt lgkmcnt(0)":::"memory"); \
      _Pragma("unroll") for(int d_=0;d_<2;++d_) _Pragma("unroll") for(int r=0;r<16;++r)o[d_][r]*=wsf[crow(r,hi)]; } }while(0)
  f32x16 pA0,pA1,pB0,pB1;
  int sl_prev=0,sl_cur=0,sl_next=SLOTB;
  #define ROT() do{sl_prev=sl_cur;sl_cur=sl_next;sl_next=(sl_next==(NSLOT-1)*SLOTB)?0:sl_next+SLOTB;}while(0)
  DMA_K(2,2*SLOTB);
  WAIT_BAR_KA(3);
  AUG(pA0,pA1); qkt(pA0,pA1,Kbase,qr,r32,hi);asm volatile("s_nop 15\n\ts_nop 7":"+v"(pA0),"+v"(pA1));CMASK(pA0,pA1,0);
  START(pA0,pA1);
  _Pragma("unroll") for(int r=0;r<16;++r)pA1[r]=__builtin_amdgcn_exp2f(pA1[r]);
  WAIT_BAR(0);
  KA_LOAD(1);DMA_K(3,0);DMA_V(1,SLOTB);
  ROT();
  kload8(kf,kp0+sl_cur);
  WAIT_BAR_KA(2);
  s16x4 vlo[8],vhi[8]; u32x4 pw0,pw1,pw2,pw3;
  #define PKW(P,B) cvtpk_s(P[B],P[B+1])
  #define PAF(k) __builtin_bit_cast(bf16x8,pw##k)
  #define VFR(i) (bf16x8){vlo[i][0],vlo[i][1],vlo[i][2],vlo[i][3],vhi[i][0],vhi[i][1],vhi[i][2],vhi[i][3]}
  #define PIN(x) asm volatile("":"+v"(x))
  #define MX3(a,b,c) __builtin_fmaxf(__builtin_fmaxf((a),(b)),(c))
  #define GAPA(MF,A0,A1,A2,A3,W0,W1,PW) do{ MF; sacc+=A0; sacc+=A1; sacc+=A2; sacc+=A3; PIN(sacc); W0; W1; PIN(PW); SBAR(); }while(0)
  #define EX(v) __builtin_amdgcn_exp2f(v)
  #define GAPB(MF,X,B) do{ MF; X[B]=EX(X[B]); X[B+1]=EX(X[B+1]); X[B+2]=EX(X[B+2]); X[B+3]=EX(X[B+3]); PIN(X); SBAR(); }while(0)
  #define VRD(i) do{ vlo[i]=vtr(vp_+(((i)>>2)*4096+((i)&3)*1024)); vhi[i]=vtr(vp_+(((i)>>2)*4096+((i)&3)*1024+512)); }while(0)
  #define KRD(G,j) do{ if(G){ kload2(kf,kp0+sl_next,j); SBAR(); } }while(0)
  #define STEP(C0,C1,P0,P1,t,GK,GV,GL) do{ SBAR(); \
    const lds_cptr vp_=vp0+sl_prev; \
    AUG(C0,C1); SBAR(); \
    VRD(0); SBAR(); float sacc=(P0[0]+P0[1]); \
    GAPA(C0=__builtin_amdgcn_mfma_f32_32x32x16_bf16(kf[0],qr[0],C0,0,0,0), P0[2],P0[3],P0[4],P0[5],     pw0[0]=PKW(P0,0), pw0[1]=PKW(P0,2), pw0); \
    VRD(4); SBAR(); GAPA(C1=__builtin_amdgcn_mfma_f32_32x32x16_bf16(kf[1],qr[0],C1,0,0,0), P0[6],P0[7],P0[8],P0[9],     pw0[2]=PKW(P0,4), pw0[3]=PKW(P0,6), pw0); \
    VRD(1); SBAR(); GAPA(C0=__builtin_amdgcn_mfma_f32_32x32x16_bf16(kf[2],qr[1],C0,0,0,0),   P0[10],P0[11],P0[12],P0[13], pw1[0]=PKW(P0,8), pw1[1]=PKW(P0,10), pw1); \
    VRD(5); SBAR(); GAPA(C1=__builtin_amdgcn_mfma_f32_32x32x16_bf16(kf[3],qr[1],C1,0,0,0),   P0[14],P0[15],P1[0],P1[1],   pw1[2]=PKW(P0,12),pw1[3]=PKW(P0,14), pw1); \
    VRD(2); SBAR(); GAPA(C0=__builtin_amdgcn_mfma_f32_32x32x16_bf16(kf[4],qr[2],C0,0,0,0),   P1[2],P1[3],P1[4],P1[5],     pw2[0]=PKW(P1,0), pw2[1]=PKW(P1,2), pw2); \
    VRD(6); SBAR(); GAPA(C1=__builtin_amdgcn_mfma_f32_32x32x16_bf16(kf[5],qr[2],C1,0,0,0),   P1[6],P1[7],P1[8],P1[9],     pw2[2]=PKW(P1,4), pw2[3]=PKW(P1,6), pw2); \
    VRD(3); SBAR(); GAPA(C0=__builtin_amdgcn_mfma_f32_32x32x16_bf16(kf[6],qr[3],C0,0,0,0),   P1[10],P1[11],P1[12],P1[13], pw3[0]=PKW(P1,8), pw3[1]=PKW(P1,10), pw3); \
    VRD(7); SBAR(); GAPA(C1=__builtin_amdgcn_mfma_f32_32x32x16_bf16(kf[7],qr[3],C1,0,0,0),   P1[14],P1[15],0.f,0.f,       pw3[2]=PKW(P1,12),pw3[3]=PKW(P1,14), pw3); \
    l_reg+=sacc; \
    if(GL){KA_LOAD((t)+1);} if(GK){DMA_K((t)+3,sl_cur);} if(GV){DMA_V((t)+1,sl_next);} \
    CMASK(C0,C1,t); \
    { float a=MX3(C0[0],C0[1],C1[0]),b=MX3(C0[2],C0[3],C1[1]); a=MX3(a,C1[2],C1[3]); \
      _Pragma("unroll") for(int r=4;r<16;r+=4){a=MX3(a,C0[r],C0[r+1]);b=MX3(b,C0[r+2],C0[r+3]);a=MX3(a,C1[r],C1[r+1]);b=MX3(b,C1[r+2],C1[r+3]);} \
      float rm=__builtin_fmaxf(a,b); { auto rr=__builtin_amdgcn_permlane32_swap(__float_as_uint(rm),__float_as_uint(rm),false,false); rm=__builtin_fmaxf(__uint_as_float(rr[0]),__uint_as_float(rr[1])); } \
      resc=false; \
      if(__builtin_expect(__any(rm>(float)THRL),0)){ const float dl=__builtin_fmaxf(rm,0.f); mhat+=dl; \
        _Pragma("unroll") for(int r=0;r<16;++r){C0[r]-=dl;C1[r]-=dl;} \
        QA_SET(); \
        const float f=__builtin_amdgcn_exp2f(-dl); l_reg*=f; if(hi==0)wsf[r32]=f; resc=true; } } \
    SBAR(); \
    GAPB(o[0]=__builtin_amdgcn_mfma_f32_32x32x16_bf16(PAF(0),VFR(0),o[0],0,0,0), C0,0); \
    GAPB(o[1]=__builtin_amdgcn_mfma_f32_32x32x16_bf16(PAF(0),VFR(4),o[1],0,0,0), C0,4); \
    KRD(GL,0); GAPB(o[0]=__builtin_amdgcn_mfma_f32_32x32x16_bf16(PAF(1),VFR(1),o[0],0,0,0), C0,8); \
    KRD(GL,1); GAPB(o[1]=__builtin_amdgcn_mfma_f32_32x32x16_bf16(PAF(1),VFR(5),o[1],0,0,0), C0,12); \
    KRD(GL,2); GAPB(o[0]=__builtin_amdgcn_mfma_f32_32x32x16_bf16(PAF(2),VFR(2),o[0],0,0,0), C1,0); \
    KRD(GL,3); GAPB(o[1]=__builtin_amdgcn_mfma_f32_32x32x16_bf16(PAF(2),VFR(6),o[1],0,0,0), C1,4); \
    GAPB(o[0]=__builtin_amdgcn_mfma_f32_32x32x16_bf16(PAF(3),VFR(3),o[0],0,0,0), C1,8); \
    GAPB(o[1]=__builtin_amdgcn_mfma_f32_32x32x16_bf16(PAF(3),VFR(7),o[1],0,0,0), C1,12); \
    }while(0)
  int t=1;
  #undef CMASK
  #define CMASK(P0,P1,t) do{}while(0)
  for(;t+5<NT;t+=2){
    STEP(pB0,pB1,pA0,pA1,t,true,true,true);     WAIT_BAR_KA(2); RESC(); ROT();
    STEP(pA0,pA1,pB0,pB1,t+1,true,true,true);   WAIT_BAR_KA(2); RESC(); ROT();
  }
  #undef CMASK
  #define CMASK(P0,P1,t) do{int jb_=(t)-(NT-4); if(jb_>=0)cmask(P0,P1,jb_,qrel,hi);}while(0)
  #define ENDW(tt) do{ if((tt)+3<NT){WAIT_BAR(2);} else if((tt)+2<NT){WAIT_BAR(1);} else {WAIT_BAR(0);} PIN_KA(); }while(0)
  for(;t+1<NT;t+=2){
    STEP(pB0,pB1,pA0,pA1,t,(t+3<NT),(t+1<NT),(t+1<NT));       ENDW(t);   RESC(); ROT();
    STEP(pA0,pA1,pB0,pB1,t+1,(t+4<NT),(t+2<NT),(t+2<NT));     ENDW(t+1); RESC(); ROT();
  }
  STEP(pB0,pB1,pA0,pA1,NT-1,false,false,false); RESC();
  { float sacc=pB0[0]+pB0[1]; _Pragma("unroll") for(int r=2;r<16;++r)sacc+=pB0[r]; _Pragma("unroll") for(int r=0;r<16;++r)sacc+=pB1[r]; l_reg+=sacc;
    pw0=(u32x4){PKW(pB0,0),PKW(pB0,2),PKW(pB0,4),PKW(pB0,6)};pw1=(u32x4){PKW(pB0,8),PKW(pB0,10),PKW(pB0,12),PKW(pB0,14)};pw2=(u32x4){PKW(pB1,0),PKW(pB1,2),PKW(pB1,4),PKW(pB1,6)};pw3=(u32x4){PKW(pB1,8),PKW(pB1,10),PKW(pB1,12),PKW(pB1,14)};
    SBAR(); pv(o,vb0+sl_cur,PAF(0),PAF(1),PAF(2),PAF(3)); }
  #undef PKW
  #undef PAF
  #undef VFR
  #undef PIN
  #undef MX3
  #undef GAPA
  #undef GAPB
  #undef EX
  #undef VRD
  #undef KRD
  #undef STEP
  #undef ENDW
  {auto rr=__builtin_amdgcn_permlane32_swap(__float_as_uint(l_reg),__float_as_uint(l_reg),false,false);l_reg=__uint_as_float(rr[0])+__uint_as_float(rr[1]);}
  if(hi==0)wsf[32+r32]=l_reg;asm volatile("s_waitcnt lgkmcnt(0)":::"memory");
  float rli[16];
  #pragma unroll
  for(int r=0;r<16;++r)rli[r]=__builtin_amdgcn_rcpf(wsf[32+crow(r,hi)]);
  bf16*Ow=O+(rowbase+q0+wid*QBLK)*OP+h*D;
  { bf16*stg=(bf16*)(shm+LDS_OST)+wid*2048;
    #pragma unroll
    for(int r=0;r<16;++r){const int orow=crow(r,hi);
      #pragma unroll
      for(int d0=0;d0<2;++d0)stg[orow*64+d0*32+r32]=__float2bfloat16(o[d0][r]*rli[r]);}
    asm volatile("s_waitcnt lgkmcnt(0)":::"memory");
    #pragma unroll
    for(int i=0;i<4;++i){const int row=i*8+(lane>>3),ch=lane&7; const u32x4 v=*(const u32x4*)(stg+row*64+ch*8); ATTN_STORE16(Ow+(long)row*OP+ch*8,v);} }
  asm volatile("s_waitcnt lgkmcnt(0)\n\ts_barrier":::"memory");
  #undef DMA_K
  #undef DMA_V
  #undef KA_LOAD
  #undef QA_SET
  #undef AUG
  #undef WAIT_BAR_KA
  #undef PIN_KA
  #undef CMASK
  #undef START
  #undef RESC
  #undef ROT
}
constexpr int ATTN_LDS_BYTES=LDS_BYTES;
struct AttnTensors { const bf16* Q; const bf16* K; const bf16* V; bf16* O; const unsigned char* KA; };
struct AttnUnit { int bh; int qb; };
struct StaticOrder {
  int vcu;
  __device__ __forceinline__ explicit StaticOrder(int grid,int block):vcu((block%8)*(grid/8)+block/8){}
  __device__ __forceinline__ bool next(int i,AttnUnit&u)const{ if(i>=4)return false; const int s=vcu&15; u.bh=vcu>>4; u.qb=(i==0)?63-s:(i==1)?32+s:(i==2)?31-s:s; return true; }
  __device__ __forceinline__ void a_ready(const AttnUnit&)const{}
  __device__ __forceinline__ void done(const AttnUnit&)const{}
};
template<class Sched,int THRL=8> __device__ __forceinline__ void attn_phase(char*lds,const AttnTensors&T,const Sched&S){
  AttnUnit u;
  for(int i=0;S.next(i,u);++i){ S.a_ready(u); attn_unit<THRL>(u.bh/NHEAD,u.bh%NHEAD,u.qb,0,T.Q,T.K,T.V,T.O,T.KA,lds); S.done(u); }
}
#undef SBAR
#undef WAIT_BAR
}

#ifndef TPROBE_SEL
#define TPROBE_SEL 0
#endif
#define TPROBE_MULT 4
#define TP_BEGIN(id) do { if (TPROBE_SEL == (id)) tp_t0 = __builtin_amdgcn_s_memrealtime(); } while (0)
#define TP_END(id) do { if (TPROBE_SEL == (id)) tp_acc += __builtin_amdgcn_s_memrealtime() - tp_t0; } while (0)
namespace ck {
#define CK_LAS __attribute__((address_space(3)))
typedef unsigned short bf16_t;
typedef short bf16x8 __attribute__((ext_vector_type(8)));
typedef float f32x16 __attribute__((ext_vector_type(16)));
typedef float f32x4 __attribute__((ext_vector_type(4)));
typedef unsigned u32x4 __attribute__((ext_vector_type(4)));
typedef unsigned u32x2 __attribute__((ext_vector_type(2)));
typedef CK_LAS unsigned short* lbf;
typedef CK_LAS float* lf32;
constexpr int SB = 72;
constexpr int B9 = 64 * SB * 2;
constexpr int SF = 65;
constexpr int SM = 68;
constexpr int SX = 132;
__device__ __forceinline__ unsigned pk2(float lo, float hi) { return ::pk2(lo, hi); }
__device__ __forceinline__ unsigned f2bf(float f) { return ::f2bf(f); }
__device__ __forceinline__ float bflo(unsigned w) { return __builtin_bit_cast(float, w << 16); }
__device__ __forceinline__ float bfhi(unsigned w) { return __builtin_bit_cast(float, w & 0xffff0000u); }
__device__ __forceinline__ int crow(int reg, int hh) { return (reg & 3) + 8 * (reg >> 2) + 4 * hh; }
__device__ __forceinline__ f32x16 mm_lds(lbf A, lbf BT, int I, int J, int lane, f32x16 acc) {
    const int r = lane & 31, hh = lane >> 5;
    const lbf ap = A + (32 * I + r) * SB + 8 * hh; const lbf bp = BT + (32 * J + r) * SB + 8 * hh;
#pragma unroll
    for (int s = 0; s < 4; ++s) { const bf16x8 a = *(const CK_LAS bf16x8*)(ap + 16 * s); const bf16x8 b = *(const CK_LAS bf16x8*)(bp + 16 * s); acc = __builtin_amdgcn_mfma_f32_32x32x16_bf16(a, b, acc, 0, 0, 0); }
    return acc;
}
__device__ __forceinline__ f32x16 mm_gA(const bf16_t* __restrict__ Ag, lbf BT, int I, int J, int lane, f32x16 acc) {
    const int r = lane & 31, hh = lane >> 5;
    bf16x8 a[4];
#pragma unroll
    for (int s = 0; s < 4; ++s) a[s] = *(const bf16x8*)(Ag + (32 * I + r) * 64 + 16 * s + 8 * hh);
    const lbf bp = BT + (32 * J + r) * SB + 8 * hh;
#pragma unroll
    for (int s = 0; s < 4; ++s) { const bf16x8 b = *(const CK_LAS bf16x8*)(bp + 16 * s); acc = __builtin_amdgcn_mfma_f32_32x32x16_bf16(a[s], b, acc, 0, 0, 0); }
    return acc;
}
__device__ __forceinline__ f32x16 mm_gg(const bf16_t* __restrict__ Ag, const bf16_t* __restrict__ BTg, int I, int J, int lane, f32x16 acc) {
    const int r = lane & 31, hh = lane >> 5;
#pragma unroll
    for (int s = 0; s < 4; ++s) { const bf16x8 a = *(const bf16x8*)(Ag + (32 * I + r) * 64 + 16 * s + 8 * hh); const bf16x8 b = *(const bf16x8*)(BTg + (32 * J + r) * 64 + 16 * s + 8 * hh);
        acc = __builtin_amdgcn_mfma_f32_32x32x16_bf16(a, b, acc, 0, 0, 0); }
    return acc;
}
__device__ __forceinline__ f32x16 mm_rA(const bf16x8 (&a)[4], lbf BT, int J, int lane, f32x16 acc) {
    const int r = lane & 31, hh = lane >> 5; const lbf bp = BT + (32 * J + r) * SB + 8 * hh;
#pragma unroll
    for (int s = 0; s < 4; ++s) { const bf16x8 b = *(const CK_LAS bf16x8*)(bp + 16 * s); acc = __builtin_amdgcn_mfma_f32_32x32x16_bf16(a[s], b, acc, 0, 0, 0); }
    return acc;
}
__device__ __forceinline__ void load_gA(bf16x8 (&a)[4], const bf16_t* __restrict__ Ag, int I, int lane) {
    const int r = lane & 31, hh = lane >> 5;
#pragma unroll
    for (int s = 0; s < 4; ++s) a[s] = *(const bf16x8*)(Ag + (32 * I + r) * 64 + 16 * s + 8 * hh);
}
__device__ __forceinline__ f32x16 mm_lA_gB(lbf A, const bf16_t* __restrict__ BTg, int I, int J, int lane, f32x16 acc) {
    const int r = lane & 31, hh = lane >> 5; bf16x8 b[4];
#pragma unroll
    for (int s = 0; s < 4; ++s) b[s] = *(const bf16x8*)(BTg + (32 * J + r) * 64 + 16 * s + 8 * hh);
    const lbf ap = A + (32 * I + r) * SB + 8 * hh;
#pragma unroll
    for (int s = 0; s < 4; ++s) { const bf16x8 a = *(const CK_LAS bf16x8*)(ap + 16 * s); acc = __builtin_amdgcn_mfma_f32_32x32x16_bf16(a, b[s], acc, 0, 0, 0); }
    return acc;
}
__device__ __forceinline__ void frag_store(float* __restrict__ g, int wq, int lane, const f32x16& acc) {
    f32x4* p = (f32x4*)(g + ((size_t)(wq * 64 + lane)) * 16);
    p[0] = (f32x4){acc[0], acc[1], acc[2], acc[3]}; p[1] = (f32x4){acc[4], acc[5], acc[6], acc[7]}; p[2] = (f32x4){acc[8], acc[9], acc[10], acc[11]}; p[3] = (f32x4){acc[12], acc[13], acc[14], acc[15]};
}
__device__ __forceinline__ f32x16 frag_load(const float* __restrict__ g, int wq, int lane) {
    const f32x4* p = (const f32x4*)(g + ((size_t)(wq * 64 + lane)) * 16); const f32x4 a = p[0], b = p[1], c = p[2], d = p[3];
    return (f32x16){a[0], a[1], a[2], a[3], b[0], b[1], b[2], b[3], c[0], c[1], c[2], c[3], d[0], d[1], d[2], d[3]};
}
__device__ __forceinline__ void frag_store_bf(bf16_t* __restrict__ g, int wq, int lane, const f32x16& acc) {
    u32x4* p = (u32x4*)(g + ((size_t)(wq * 64 + lane)) * 16);
    p[0] = (u32x4){pk2(acc[0], acc[1]), pk2(acc[2], acc[3]), pk2(acc[4], acc[5]), pk2(acc[6], acc[7])}; p[1] = (u32x4){pk2(acc[8], acc[9]), pk2(acc[10], acc[11]), pk2(acc[12], acc[13]), pk2(acc[14], acc[15])};
}
__device__ __forceinline__ f32x16 frag_load_bf(const bf16_t* __restrict__ g, int wq, int lane) {
    const u32x4* p = (const u32x4*)(g + ((size_t)(wq * 64 + lane)) * 16); const u32x4 a = p[0], b = p[1];
    return (f32x16){bflo(a[0]), bfhi(a[0]), bflo(a[1]), bfhi(a[1]), bflo(a[2]), bfhi(a[2]), bflo(a[3]), bfhi(a[3]), bflo(b[0]), bfhi(b[0]), bflo(b[1]), bfhi(b[1]), bflo(b[2]), bfhi(b[2]), bflo(b[3]), bfhi(b[3])};
}
__device__ __forceinline__ void tile_store_T(lbf dst, int I, int J, int lane, const f32x16& acc) {
    const int r = lane & 31, hh = lane >> 5;
#pragma unroll
    for (int g = 0; g < 4; ++g) { u32x2 w; w.x = pk2(acc[4 * g], acc[4 * g + 1]); w.y = pk2(acc[4 * g + 2], acc[4 * g + 3]);
        *(CK_LAS u32x2*)(dst + (32 * J + r) * SB + 32 * I + 8 * g + 4 * hh) = w; }
}
__device__ __forceinline__ float fexp(float x) { return __builtin_amdgcn_exp2f(x * 1.4426950408889634f); }
__device__ __forceinline__ float sigm(float x) { return __builtin_amdgcn_rcpf(1.0f + fexp(-x)); }
__device__ __forceinline__ float ftanh(float x) { const float xc = fminf(fmaxf(x, -15.f), 15.f); return 1.0f - 2.0f * __builtin_amdgcn_rcpf(fexp(2.0f * xc) + 1.0f); }
__device__ __forceinline__ float logsig(float x) { const float ax = fabsf(x); return fminf(x, 0.f) - 0.6931471805599453f * __builtin_amdgcn_logf(1.0f + fexp(-ax)); }
template <int CTRL> __device__ __forceinline__ float dpp_f(float v) { return __builtin_bit_cast(float, __builtin_amdgcn_update_dpp(0, __builtin_bit_cast(int, v), CTRL, 0xf, 0xf, false)); }
__device__ __forceinline__ float quad_sum(float v) { v += dpp_f<0xB1>(v); v += dpp_f<0x4E>(v); return v; }

constexpr size_t O_PC = 0, O_QC = 16u << 20, O_GY = 48u << 20, O_YL = 64u << 20, O_VG = 96u << 20, O_GG = 112u << 20, O_H0 = 128u << 20, O_RKD = 144u << 20, O_KV = 145u << 20, O_RT = 177u << 20, O_END = 193u << 20,
                 O_PG = 193u << 20, O_QG = 195u << 20, O_HG = 197u << 20, O_KG = 199u << 20, O_RG = 203u << 20, O_END2 = 207u << 20;
struct RwkvParams {
    const float *mu_rkv, *mu_lora, *w0, *a0, *k_k, *k_a, *r_k, *ln_g, *ln_b, *gn_g;
    const bf16_t *w2t, *a2t, *g2t;
};

struct S1Pre { u32x4 d[14]; u32x4 lw[4]; f32x4 mr[3][2]; f32x4 ml[4][2]; };
struct RwkvParams;
__device__ __forceinline__ void s1_load(S1Pre& Q, int item, const bf16_t* __restrict__ Pb, int PW, int C_RR, int C_RK, int C_RV, int C_WD, int SEQ, const bf16_t* __restrict__ w2t, const bf16_t* __restrict__ a2t, const bf16_t* __restrict__ g2t, const float* __restrict__ mu_rkv) {
    const int tid = ltid(), t = tid >> 3, c8 = (tid & 7) * 8;
    const int b = item >> 10, h = (item >> 8) & 3, c = item & 255;
    const size_t m = (size_t)b * SEQ + (size_t)c * 64 + t; const bool hp = (c * 64 + t) > 0;
    const bf16_t* pr = Pb + m * PW; const bf16_t* pp = hp ? pr - PW : pr;
    Q.d[0] = *(const u32x4*)(pr + C_RR + h * 64 + c8); Q.d[1] = *(const u32x4*)(pr + C_RK + h * 64 + c8); Q.d[2] = *(const u32x4*)(pr + C_RV + h * 64 + c8);
    Q.d[3] = *(const u32x4*)(pp + C_RR + h * 64 + c8); Q.d[4] = *(const u32x4*)(pp + C_RK + h * 64 + c8); Q.d[5] = *(const u32x4*)(pp + C_RV + h * 64 + c8);
#pragma unroll
    for (int q = 0; q < 4; ++q) { Q.d[6 + q] = *(const u32x4*)(pr + C_WD + q * 64 + c8); Q.d[10 + q] = *(const u32x4*)(pp + C_WD + q * 64 + c8); }
    Q.lw[0] = *(const u32x4*)(w2t + ((size_t)h * 64 + t) * 64 + c8); Q.lw[1] = *(const u32x4*)(a2t + ((size_t)h * 64 + t) * 64 + c8); Q.lw[2] = *(const u32x4*)(g2t + ((size_t)h * 64 + t) * 128 + c8); Q.lw[3] = *(const u32x4*)(g2t + ((size_t)h * 64 + t) * 128 + 64 + c8);
#pragma unroll
    for (int k = 0; k < 3; ++k) { Q.mr[k][0] = *(const f32x4*)(mu_rkv + k * 256 + h * 64 + c8); Q.mr[k][1] = *(const f32x4*)(mu_rkv + k * 256 + h * 64 + c8 + 4); }
}
constexpr int L_U = 10 * B9, L_MM = L_U + 36864, L_GL = L_MM + 64 * SM * 4, L_END1 = L_GL + 256;
__device__ __forceinline__ void rwkv_stage1(CK_LAS unsigned char* lds, int item, const bf16_t* __restrict__ Pb, int PW, int C_RR, int C_RK, int C_RV, int C_WD, int SEQ, const RwkvParams& p, unsigned char* __restrict__ cw, S1Pre& PRE, int next_item, unsigned long long& tp_acc, unsigned long long& tp_t0) {
    const int tid = ltid(), lane = tid & 63, wid = __builtin_amdgcn_readfirstlane(tid >> 6), quad = wid >> 2, wq = wid & 3, I = wq >> 1, J = wq & 1, r = lane & 31, hh = lane >> 5;
    const int b = item >> 10, h = (item >> 8) & 3, c = item & 255;
    const size_t m0 = (size_t)b * SEQ + (size_t)c * 64;
    const lbf Am = (lbf)(lds), Bm = (lbf)(lds + B9), Km = (lbf)(lds + 2 * B9), Rm = (lbf)(lds + 3 * B9), VT = (lbf)(lds + 4 * B9), BhT = (lbf)(lds + 5 * B9), KhT = (lbf)(lds + 6 * B9),
              Nm = (lbf)(lds + 7 * B9), Wb = (lbf)(lds + 8 * B9), Wk = (lbf)(lds + 9 * B9);
    const lbf TW = (lbf)(lds + L_U), AD = (lbf)(lds + L_U + B9), SG0 = (lbf)(lds + L_U + 2 * B9), SG1 = (lbf)(lds + L_U + 3 * B9);
    const lbf W2T = BhT, A2T = KhT, G2Ta = Nm, G2Tb = Wb;
    const lf32 X = (lf32)(lds + L_U), MM = (lf32)(lds + L_MM), GL = (lf32)(lds + L_GL);
    const lf32 AA = (lf32)(lds), GGl = (lf32)(lds + 2 * B9);
    constexpr int S1F = 68;
    const lbf ZlT = Km, X1T = Nm;
    TP_BEGIN(10);
    const int t = tid >> 3, c8 = (tid & 7) * 8;
    const size_t m = m0 + t; const bool hp = (c * 64 + t) > 0;
    const bf16_t* pr = Pb + m * PW; const bf16_t* pp = hp ? pr - PW : pr;
    float rr[8], kx[8], vv[8]; f32x4 pkk[2], pka[2], prk[2];
    {
        const u32x4 z4 = (u32x4){0u, 0u, 0u, 0u};
        (void)pr; (void)pp;
        const u32x4 cr = PRE.d[0], ckk = PRE.d[1], cv = PRE.d[2]; u32x4 qr = PRE.d[3], qk = PRE.d[4], qv = PRE.d[5];
        u32x4 cl[4], ql[4];
#pragma unroll
        for (int q = 0; q < 4; ++q) { cl[q] = PRE.d[6 + q]; ql[q] = PRE.d[10 + q]; }
        const u32x4 lw0 = PRE.lw[0], lw1 = PRE.lw[1], lw2 = PRE.lw[2], lw3 = PRE.lw[3];
        f32x4 mr[3][2], ml[4][2];
#pragma unroll
        for (int i = 0; i < 2; ++i) { pkk[i] = *(const f32x4*)(p.k_k + h * 64 + c8 + 4 * i); pka[i] = *(const f32x4*)(p.k_a + h * 64 + c8 + 4 * i); prk[i] = *(const f32x4*)(p.r_k + h * 64 + c8 + 4 * i); }
#pragma unroll
        for (int k = 0; k < 3; ++k) { mr[k][0] = PRE.mr[k][0]; mr[k][1] = PRE.mr[k][1]; }
#pragma unroll
        for (int q = 0; q < 4; ++q) { ml[q][0] = PRE.ml[q][0]; ml[q][1] = PRE.ml[q][1]; }
        if (!hp) { qr = z4; qk = z4; qv = z4;
#pragma unroll
            for (int q = 0; q < 4; ++q) ql[q] = z4; }
#pragma unroll
        for (int e = 0; e < 8; ++e) {
            const float a_ = (e & 1) ? bfhi(cr[e >> 1]) : bflo(cr[e >> 1]), b_ = (e & 1) ? bfhi(qr[e >> 1]) : bflo(qr[e >> 1]); rr[e] = a_ + (b_ - a_) * mr[0][e >> 2][e & 3];
            const float c_ = (e & 1) ? bfhi(ckk[e >> 1]) : bflo(ckk[e >> 1]), d_ = (e & 1) ? bfhi(qk[e >> 1]) : bflo(qk[e >> 1]); kx[e] = c_ + (d_ - c_) * mr[1][e >> 2][e & 3];
            const float e_ = (e & 1) ? bfhi(cv[e >> 1]) : bflo(cv[e >> 1]), f_ = (e & 1) ? bfhi(qv[e >> 1]) : bflo(qv[e >> 1]); vv[e] = e_ + (f_ - e_) * mr[2][e >> 2][e & 3]; }
#pragma unroll
        for (int q = 0; q < 4; ++q) {
            float lo[8];
#pragma unroll
            for (int e = 0; e < 8; ++e) { const float a_ = (e & 1) ? bfhi(cl[q][e >> 1]) : bflo(cl[q][e >> 1]), b_ = (e & 1) ? bfhi(ql[q][e >> 1]) : bflo(ql[q][e >> 1]); const float x = a_ + (b_ - a_) * ml[q][e >> 2][e & 3];
                lo[e] = (q == 0) ? ftanh(x) : (q == 1 ? x : sigm(x)); }
            u32x4 w; w.x = pk2(lo[0], lo[1]); w.y = pk2(lo[2], lo[3]); w.z = pk2(lo[4], lo[5]); w.w = pk2(lo[6], lo[7]);
            *(CK_LAS u32x4*)((q == 0 ? TW : q == 1 ? AD : q == 2 ? SG0 : SG1) + t * SB + c8) = w; }
        *(CK_LAS u32x4*)(W2T + t * SB + c8) = lw0; *(CK_LAS u32x4*)(A2T + t * SB + c8) = lw1; *(CK_LAS u32x4*)(G2Ta + t * SB + c8) = lw2; *(CK_LAS u32x4*)(G2Tb + t * SB + c8) = lw3;
    }
    __syncthreads();
    TP_END(10); TP_BEGIN(11);
    if (quad == 0) {
        f32x16 z = mm_lds(TW, W2T, I, J, lane, f32x16{}); f32x16 za = mm_lds(AD, A2T, I, J, lane, f32x16{});
        const int ch = 32 * J + r; const float w0c = p.w0[h * 64 + ch], a0c = p.a0[h * 64 + ch];
#pragma unroll
        for (int g = 0; g < 16; ++g) { const int tt = 32 * I + crow(g, hh); const float lw = logsig(w0c + z[g]) - 0.5f; MM[tt * S1F + ch] = -fexp(lw); AA[tt * S1F + ch] = sigm(a0c + za[g]); }
    } else {
        f32x16 zg = mm_lds(SG0, G2Ta, I, J, lane, f32x16{}); zg = mm_lds(SG1, G2Tb, I, J, lane, zg);
        const int ch = 32 * J + r;
#pragma unroll
        for (int g = 0; g < 16; ++g) { const int tt = 32 * I + crow(g, hh); GGl[tt * S1F + ch] = zg[g]; }
    }
    __syncthreads();
    TP_END(11); TP_BEGIN(12);
    {
        const int ch = tid & 63, seg = tid >> 6; float v8[8]; float run = 0.f;
#pragma unroll
        for (int i = 0; i < 8; ++i) { run += MM[(seg * 8 + i) * S1F + ch]; v8[i] = run; }
        const lf32 TOT = (lf32)(lds + L_U);
        TOT[seg * 64 + ch] = run;
        __syncthreads();
        float off = 0.f;
#pragma unroll
        for (int s2 = 0; s2 < 8; ++s2) off += (s2 < seg) ? TOT[s2 * 64 + ch] : 0.f;
#pragma unroll
        for (int i = 0; i < 8; ++i) MM[(seg * 8 + i) * S1F + ch] = v8[i] + off;
    }
    __syncthreads();
    TP_END(12); TP_BEGIN(13);
    float aa[8], gg[8], lw[8], lwp[8], lwl[8];
#pragma unroll
    for (int v4 = 0; v4 < 2; ++v4) { const f32x4 a4 = *(const CK_LAS f32x4*)(AA + t * S1F + c8 + 4 * v4), g4 = *(const CK_LAS f32x4*)(GGl + t * S1F + c8 + 4 * v4), w4 = *(const CK_LAS f32x4*)(MM + t * S1F + c8 + 4 * v4),
                                                 p4 = *(const CK_LAS f32x4*)(MM + (t > 0 ? t - 1 : 0) * S1F + c8 + 4 * v4), l4 = *(const CK_LAS f32x4*)(MM + 63 * S1F + c8 + 4 * v4);
#pragma unroll
        for (int e = 0; e < 4; ++e) { aa[4 * v4 + e] = a4[e]; gg[4 * v4 + e] = g4[e]; lw[4 * v4 + e] = w4[e]; lwp[4 * v4 + e] = t > 0 ? p4[e] : 0.f; lwl[4 * v4 + e] = l4[e]; } }
    __syncthreads();
    {
        float kk[8], k2[8]; float ss = 0.f, rk = 0.f;
#pragma unroll
        for (int e = 0; e < 8; ++e) { kk[e] = kx[e] * pkk[e >> 2][e & 3]; ss += kk[e] * kk[e]; k2[e] = kx[e] * (1.0f + (aa[e] - 1.0f) * pka[e >> 2][e & 3]); rk += rr[e] * k2[e] * prk[e >> 2][e & 3]; }
        ss = quad_sum(ss); ss += dpp_f<0x141>(ss); rk = quad_sum(rk); rk += dpp_f<0x141>(rk);
        const float inv = 1.0f / fmaxf(sqrtf(ss), 1e-12f);
        float am[8], bm[8], km[8], rm[8];
#pragma unroll
        for (int e = 0; e < 8; ++e) { kk[e] *= inv; const float g_ = fexp(lw[e]), gi = fexp(-lw[e]), gp = fexp(lwp[e]), gl = fexp(lwl[e] - lw[e]); const float ka = kk[e] * aa[e];
            am[e] = -kk[e] * gp; bm[e] = ka * gi; km[e] = k2[e] * gi; rm[e] = rr[e] * g_;
            VT[(c8 + e) * SB + t] = (bf16_t)f2bf(vv[e]); BhT[(c8 + e) * SB + t] = (bf16_t)f2bf(ka * gl); KhT[(c8 + e) * SB + t] = (bf16_t)f2bf(k2[e] * gl);
            X[t * SX + c8 + e] = am[e]; }
        u32x4 w;
        w.x = pk2(am[0], am[1]); w.y = pk2(am[2], am[3]); w.z = pk2(am[4], am[5]); w.w = pk2(am[6], am[7]); *(CK_LAS u32x4*)(Am + t * SB + c8) = w;
        w.x = pk2(bm[0], bm[1]); w.y = pk2(bm[2], bm[3]); w.z = pk2(bm[4], bm[5]); w.w = pk2(bm[6], bm[7]); *(CK_LAS u32x4*)(Bm + t * SB + c8) = w;
        w.x = pk2(km[0], km[1]); w.y = pk2(km[2], km[3]); w.z = pk2(km[4], km[5]); w.w = pk2(km[6], km[7]); *(CK_LAS u32x4*)(Km + t * SB + c8) = w;
        w.x = pk2(rm[0], rm[1]); w.y = pk2(rm[2], rm[3]); w.z = pk2(rm[4], rm[5]); w.w = pk2(rm[6], rm[7]); *(CK_LAS u32x4*)(Rm + t * SB + c8) = w;
        if (t == 63) {
#pragma unroll
            for (int e = 0; e < 8; ++e) GL[c8 + e] = fexp(lwl[e]); }
        w.x = pk2(vv[0], vv[1]); w.y = pk2(vv[2], vv[3]); w.z = pk2(vv[4], vv[5]); w.w = pk2(vv[6], vv[7]); *(u32x4*)(cw + O_VG + (size_t)item * 8192 + (t * 64 + c8) * 2) = w;
        w.x = pk2(gg[0], gg[1]); w.y = pk2(gg[2], gg[3]); w.z = pk2(gg[4], gg[5]); w.w = pk2(gg[6], gg[7]); *(u32x4*)(cw + O_GG + (size_t)item * 8192 + (t * 64 + c8) * 2) = w;
        if ((tid & 7) == 0) *(float*)(cw + O_RKD + (size_t)item * 256 + t * 4) = rk;
    }
    __syncthreads();
    TP_END(13); TP_BEGIN(14);
    {
        const f32x16 p1 = mm_lds(Am, quad == 0 ? Bm : Km, I, J, lane, f32x16{}); const f32x16 p2 = mm_lds(Rm, quad == 0 ? Bm : Km, I, J, lane, f32x16{});
        const int ii = 32 * J + r;
#pragma unroll
        for (int g = 0; g < 16; ++g) { const int tt = 32 * I + crow(g, hh);
            if (quad == 0) { MM[ii * SM + (tt & 3) * 16 + (tt >> 2)] = (ii < tt) ? p1[g] : 0.f;        Wb[tt * SB + ii] = (bf16_t)f2bf((ii <= tt) ? p2[g] : 0.f); }
            else { Nm[tt * SB + ii] = (bf16_t)f2bf((ii < tt) ? p1[g] : 0.f); Wk[tt * SB + ii] = (bf16_t)f2bf((ii <= tt) ? p2[g] : 0.f); } }
    }
    __syncthreads();
    if (quad == 0) { const f32x16 nv = mm_lds(Nm, VT, I, J, lane, f32x16{}); const int vcol = 64 + 32 * J + r;
#pragma unroll
        for (int g = 0; g < 16; ++g) X[(32 * I + crow(g, hh)) * SX + vcol] = nv[g]; }
    __syncthreads();
    TP_END(14); TP_BEGIN(15);
    s1_load(PRE, next_item, Pb, PW, C_RR, C_RK, C_RV, C_WD, SEQ, p.w2t, p.a2t, p.g2t, p.mu_rkv);
    {
        const int col = tid >> 2, q = tid & 3;
        float xs[16];
#pragma unroll
        for (int k = 0; k < 16; ++k) xs[k] = X[(q + 4 * k) * SX + col];
#define CK_BC4(J_, v_) ((J_) == 0 ? dpp_f<0x00>(v_) : (J_) == 1 ? dpp_f<0x55>(v_) : (J_) == 2 ? dpp_f<0xAA>(v_) : dpp_f<0xFF>(v_))
#pragma unroll
        for (int j = 0; j < 63; ++j) {
            const float xj = CK_BC4(j & 3, xs[j >> 2]);
            const CK_LAS f32x4* mc = (const CK_LAS f32x4*)(MM + j * SM + q * 16);
#pragma unroll
            for (int k4 = (j + 1) / 16; k4 < 4; ++k4) { const f32x4 mv = mc[k4]; xs[4 * k4] += mv[0] * xj; xs[4 * k4 + 1] += mv[1] * xj; xs[4 * k4 + 2] += mv[2] * xj; xs[4 * k4 + 3] += mv[3] * xj; }
        }
#undef CK_BC4
        const lbf dstT = (col < 64) ? (X1T + col * SB) : (ZlT + (col - 64) * SB);
#pragma unroll
        for (int k = 0; k < 16; ++k) dstT[q + 4 * k] = (bf16_t)f2bf(xs[k]);
    }
    asm volatile("s_waitcnt lgkmcnt(0)\n\ts_barrier" ::: "memory");
    TP_END(15); TP_BEGIN(16);
    if (quad == 0) {
        const f32x16 gy = mm_lds(Wb, X1T, I, J, lane, f32x16{}); const f32x16 pc = mm_lds(BhT, X1T, I, J, lane, f32x16{});
        bf16_t* gyg = (bf16_t*)(cw + O_GY + (size_t)item * 8192); bf16_t* pcg = (bf16_t*)(cw + O_PC + (size_t)item * 8192);
        const int cc = 32 * J + r;
#pragma unroll
        for (int g = 0; g < 16; ++g) { const int rw = 32 * I + crow(g, hh);
            gyg[rw * 64 + cc] = (bf16_t)f2bf(gy[g] + __builtin_bit_cast(float, (unsigned)Rm[rw * SB + cc] << 16));
            pcg[rw * 64 + cc] = (bf16_t)f2bf(pc[g] + (rw == cc ? GL[cc] : 0.f)); }
    } else {
        f32x16 yl = mm_lds(ZlT, Wb, I, J, lane, f32x16{}); yl = mm_lds(VT, Wk, I, J, lane, yl);
        f32x16 qc = mm_lds(BhT, ZlT, I, J, lane, f32x16{}); qc = mm_lds(KhT, VT, I, J, lane, qc);
        frag_store((float*)(cw + O_YL + (size_t)item * 16384), wq, lane, yl); frag_store_bf((bf16_t*)(cw + O_QC) + (size_t)item * 4096, wq, lane, qc);
    }
    asm volatile("s_waitcnt lgkmcnt(0)\n\ts_barrier" ::: "memory");
    TP_END(16);
}

template <int NST> __device__ __forceinline__ void rwkv_scan(CK_LAS unsigned char* lds, int chain, const bf16_t* __restrict__ pcb, const bf16_t* __restrict__ qcb, bf16_t* __restrict__ h0b) {
    const int tid = ltid(), lane = tid & 63, wid = __builtin_amdgcn_readfirstlane(tid >> 6), quad = wid >> 2, wq = wid & 3, I = wq >> 1, J = wq & 1, r = lane & 31, hh = lane >> 5, qtid = tid & 255;
    const lbf HT = (lbf)(lds + quad * B9);
    for (int i = qtid; i < 64 * SB / 2; i += 256) ((CK_LAS unsigned*)HT)[i] = 0u;
    __syncthreads();
    const bool on = chain >= 0; const size_t it0 = (size_t)(on ? chain : 0) * NST;
    const bf16_t* pcg = pcb + it0 * 4096; const bf16_t* qcg = qcb + it0 * 4096; bf16_t* h0g = h0b + it0 * 4096;
    constexpr int PD = 5;
    bf16x8 ar[PD][4]; f32x16 qr[PD];
#define CK_LOADSTEP(A_, Q_, cc) do { const int c_ = (cc) < NST ? (cc) : NST - 1; _Pragma("unroll") for (int s_ = 0; s_ < 4; ++s_) A_[s_] = *(const bf16x8*)(pcg + (size_t)c_ * 4096 + (32 * I + r) * 64 + 16 * s_ + 8 * hh); Q_ = frag_load_bf(qcg + (size_t)c_ * 4096, wq, lane); } while (0)
#pragma unroll
    for (int k = 0; k < PD; ++k) CK_LOADSTEP(ar[k], qr[k], k);
    for (int c = 0; c < NST + PD - 1; c += PD) {
#pragma unroll
        for (int k = 0; k < PD; ++k) {
            const int cc = c + k;
            if (cc < NST) {
            if (on) { const int row = qtid >> 2, seg = (qtid & 3) * 16; const u32x4 w0 = *(const CK_LAS u32x4*)(HT + row * SB + seg), w1 = *(const CK_LAS u32x4*)(HT + row * SB + seg + 8);
                      u32x4* dst = (u32x4*)(h0g + (size_t)cc * 4096 + row * 64 + seg); dst[0] = w0; dst[1] = w1; }
            f32x16 acc = qr[k];
            const lbf bp = HT + (32 * J + r) * SB + 8 * hh;
#pragma unroll
            for (int s_ = 0; s_ < 4; ++s_) { const bf16x8 bfr = *(const CK_LAS bf16x8*)(bp + 16 * s_); acc = __builtin_amdgcn_mfma_f32_32x32x16_bf16(ar[k][s_], bfr, acc, 0, 0, 0); }
            CK_LOADSTEP(ar[k], qr[k], cc + PD);
            asm volatile("s_waitcnt lgkmcnt(0)\n\ts_barrier" ::: "memory");
            tile_store_T(HT, I, J, lane, acc);
            asm volatile("s_waitcnt lgkmcnt(0)\n\ts_barrier" ::: "memory");
            }
        }
    }
#undef CK_LOADSTEP
}

__device__ __forceinline__ void rwkv_level1(CK_LAS unsigned char* lds, int task, unsigned char* __restrict__ cw) {
    const int tid = ltid(), lane = tid & 63, wid = __builtin_amdgcn_readfirstlane(tid >> 6), quad = wid >> 2, wq = wid & 3, I = wq >> 1, J = wq & 1, r = lane & 31, hh = lane >> 5;
    const lbf PTh = (lbf)(lds + quad * 4 * B9), PTl = PTh + 64 * SB, QTh = PTl + 64 * SB, QTl = QTh + 64 * SB;
    const bool on = task >= 0; const int tk = on ? task : 0; const size_t item0 = (size_t)(tk >> 5) * 256 + (size_t)(tk & 31) * 8;
    f32x16 PG, QG = f32x16{};
#pragma unroll
    for (int g = 0; g < 16; ++g) PG[g] = (I == J && crow(g, hh) == r) ? 1.0f : 0.0f;
    for (int j = 0; j < 8; ++j) {
        const size_t item = item0 + j;
        bf16x8 a[4]; load_gA(a, (const bf16_t*)(cw + O_PC) + item * 4096, I, lane);
        f32x16 qn = frag_load_bf((const bf16_t*)(cw + O_QC) + item * 4096, wq, lane);
        f32x16 pl, ql;
#pragma unroll
        for (int g = 0; g < 16; ++g) { pl[g] = PG[g] - __builtin_bit_cast(float, f2bf(PG[g]) << 16); ql[g] = QG[g] - __builtin_bit_cast(float, f2bf(QG[g]) << 16); }
        tile_store_T(PTh, I, J, lane, PG); tile_store_T(PTl, I, J, lane, pl); tile_store_T(QTh, I, J, lane, QG); tile_store_T(QTl, I, J, lane, ql);
        __syncthreads();
        f32x16 pn = mm_rA(a, PTh, J, lane, f32x16{}); pn = mm_rA(a, PTl, J, lane, pn);
        qn = mm_rA(a, QTh, J, lane, qn); qn = mm_rA(a, QTl, J, lane, qn);
        __syncthreads();
        PG = pn; QG = qn;
    }
    if (on) { bf16_t* pgg = (bf16_t*)(cw + O_PG) + (size_t)tk * 4096; const int cc = 32 * J + r;
#pragma unroll
        for (int g = 0; g < 16; ++g) pgg[(32 * I + crow(g, hh)) * 64 + cc] = (bf16_t)f2bf(PG[g]);
        frag_store_bf((bf16_t*)(cw + O_QG) + (size_t)tk * 4096, wq, lane, QG); }
}

constexpr int L_RW3 = B9 + 64 * SF * 4;
__device__ __forceinline__ void rwkv_stage3g(CK_LAS unsigned char* ldsq, int task, const RwkvParams& p, const unsigned char* __restrict__ cw, bf16_t* __restrict__ MIXB, int SEQ) {
    const int tid = ltid(), lane = tid & 63, wid = __builtin_amdgcn_readfirstlane(tid >> 6), wq = wid & 3, I = wq >> 1, J = wq & 1, r = lane & 31, hh = lane >> 5, qtid = tid & 255;
    const lbf HT = (lbf)ldsq; const lf32 Y = (lf32)(ldsq + B9);
    const bool on = task >= 0; const int tk = on ? task : 0; const int item0 = (tk >> 5) * 256 + (tk & 31) * 8;
    { const int row = qtid >> 2, seg = (qtid & 3) * 16; const u32x4* src = (const u32x4*)((const bf16_t*)(cw + O_HG) + (size_t)tk * 4096 + row * 64 + seg);
      *(CK_LAS u32x4*)(HT + row * SB + seg) = src[0]; *(CK_LAS u32x4*)(HT + row * SB + seg + 8) = src[1]; }
    __syncthreads();
    f32x4 lng[4], lnb[4];
    { const int h0 = (item0 >> 8) & 3, c16_ = (qtid & 3) * 16;
#pragma unroll
      for (int i = 0; i < 4; ++i) { lng[i] = *(const f32x4*)(p.ln_g + h0 * 64 + c16_ + 4 * i); lnb[i] = *(const f32x4*)(p.ln_b + h0 * 64 + c16_ + 4 * i); } }
    bf16x8 a[4], gyb[4]; u32x4 hnw[2]; f32x4 ylw[4]; u32x4 vgw[2], ggw[2]; float rk;
#define CK_R3_LOADM(it_) do { const size_t it__ = (size_t)(it_); load_gA(a, (const bf16_t*)(cw + O_PC) + it__ * 4096, I, lane); \
        { const u32x4* p_ = (const u32x4*)((const bf16_t*)(cw + O_QC) + it__ * 4096 + ((size_t)(wq * 64 + lane)) * 16); hnw[0] = p_[0]; hnw[1] = p_[1]; } \
        { const f32x4* p_ = (const f32x4*)((const float*)(cw + O_YL) + it__ * 4096 + ((size_t)(wq * 64 + lane)) * 16); ylw[0] = p_[0]; ylw[1] = p_[1]; ylw[2] = p_[2]; ylw[3] = p_[3]; } \
        _Pragma("unroll") for (int s_ = 0; s_ < 4; ++s_) gyb[s_] = *(const bf16x8*)((const bf16_t*)(cw + O_GY) + it__ * 4096 + (32 * J + r) * 64 + 16 * s_ + 8 * hh); } while (0)
#define CK_R3_LOADP(it_) do { const size_t it__ = (size_t)(it_); const int t_ = qtid >> 2, c16_ = (qtid & 3) * 16; const u32x4* vg = (const u32x4*)(cw + O_VG + it__ * 8192 + (t_ * 64 + c16_) * 2); const u32x4* gg = (const u32x4*)(cw + O_GG + it__ * 8192 + (t_ * 64 + c16_) * 2); \
        vgw[0] = vg[0]; vgw[1] = vg[1]; ggw[0] = gg[0]; ggw[1] = gg[1]; rk = *(const float*)(cw + O_RKD + it__ * 256 + t_ * 4); } while (0)
    CK_R3_LOADM(item0); CK_R3_LOADP(item0);
    for (int j = 0; j < 8; ++j) {
        const int item = item0 + j, nitem = item0 + (j < 7 ? j + 1 : 7);
        f32x16 hn = (f32x16){bflo(hnw[0][0]), bfhi(hnw[0][0]), bflo(hnw[0][1]), bfhi(hnw[0][1]), bflo(hnw[0][2]), bfhi(hnw[0][2]), bflo(hnw[0][3]), bfhi(hnw[0][3]),
                             bflo(hnw[1][0]), bfhi(hnw[1][0]), bflo(hnw[1][1]), bfhi(hnw[1][1]), bflo(hnw[1][2]), bfhi(hnw[1][2]), bflo(hnw[1][3]), bfhi(hnw[1][3])};
        {
            f32x16 acc = (f32x16){ylw[0][0], ylw[0][1], ylw[0][2], ylw[0][3], ylw[1][0], ylw[1][1], ylw[1][2], ylw[1][3], ylw[2][0], ylw[2][1], ylw[2][2], ylw[2][3], ylw[3][0], ylw[3][1], ylw[3][2], ylw[3][3]};
            { const lbf ap = HT + (32 * I + r) * SB + 8 * hh;
#pragma unroll
              for (int s_ = 0; s_ < 4; ++s_) { const bf16x8 av = *(const CK_LAS bf16x8*)(ap + 16 * s_); acc = __builtin_amdgcn_mfma_f32_32x32x16_bf16(av, gyb[s_], acc, 0, 0, 0); } }
#pragma unroll
            for (int g = 0; g < 16; ++g) Y[(32 * J + r) * SF + 32 * I + crow(g, hh)] = acc[g];
        }
        hn = mm_rA(a, HT, J, lane, hn);
        CK_R3_LOADM(nitem);
        asm volatile("s_waitcnt lgkmcnt(0)\n\ts_barrier" ::: "memory");
        tile_store_T(HT, I, J, lane, hn);
        if (on) {
            const int b = item >> 10, h = (item >> 8) & 3, c = item & 255; const int t = qtid >> 2, c16 = (qtid & 3) * 16;
            float y[16]; float s = 0.f;
#pragma unroll
            for (int e = 0; e < 16; ++e) { y[e] = Y[t * SF + c16 + e]; s += y[e]; }
            const float mu = quad_sum(s) * (1.f / 64.f); float s2 = 0.f;
#pragma unroll
            for (int e = 0; e < 16; ++e) { y[e] -= mu; s2 += y[e] * y[e]; }
            const float rstd = 1.0f / sqrtf(quad_sum(s2) * (1.f / 64.f) + 64e-5f);
            unsigned ow[8];
#pragma unroll
            for (int hv = 0; hv < 2; ++hv) { const u32x4 vw = vgw[hv], gw = ggw[hv];
#pragma unroll
                for (int e2 = 0; e2 < 4; ++e2) { const int e = hv * 8 + 2 * e2;
                    const float o0 = (y[e] * rstd * lng[e >> 2][e & 3] + lnb[e >> 2][e & 3] + rk * bflo(vw[e2])) * bflo(gw[e2]);
                    const float o1 = (y[e + 1] * rstd * lng[(e + 1) >> 2][(e + 1) & 3] + lnb[(e + 1) >> 2][(e + 1) & 3] + rk * bfhi(vw[e2])) * bfhi(gw[e2]);
                    ow[hv * 4 + e2] = pk2(o0, o1); } }
            u32x4* dst = (u32x4*)(MIXB + ((size_t)b * SEQ + (size_t)c * 64 + t) * 1024 + 512 + h * 64 + c16);
            dst[0] = (u32x4){ow[0], ow[1], ow[2], ow[3]}; dst[1] = (u32x4){ow[4], ow[5], ow[6], ow[7]};
        }
        CK_R3_LOADP(nitem);
        asm volatile("s_waitcnt lgkmcnt(0)\n\ts_barrier" ::: "memory");
    }
#undef CK_R3_LOADM
#undef CK_R3_LOADP
}

__device__ __forceinline__ void rwkv_stage3(CK_LAS unsigned char* ldsq, int item, const RwkvParams& p, const unsigned char* __restrict__ cw, bf16_t* __restrict__ MIXB, int SEQ) {
    const int tid = ltid(), lane = tid & 63, wid = __builtin_amdgcn_readfirstlane(tid >> 6), wq = wid & 3, I = wq >> 1, J = wq & 1, r = lane & 31, hh = lane >> 5, qtid = tid & 255;
    const lf32 Y = (lf32)ldsq;
    if (item >= 0) {
        f32x16 acc = frag_load((const float*)(cw + O_YL) + (size_t)item * 4096, wq, lane);
        acc = mm_gg((const bf16_t*)(cw + O_H0) + (size_t)item * 4096, (const bf16_t*)(cw + O_GY) + (size_t)item * 4096, I, J, lane, acc);
#pragma unroll
        for (int g = 0; g < 16; ++g) Y[(32 * J + r) * SF + 32 * I + crow(g, hh)] = acc[g];
    }
    __syncthreads();
    if (item >= 0) {
        const int b = item >> 10, h = (item >> 8) & 3, c = item & 255; const int t = qtid >> 2, c16 = (qtid & 3) * 16;
        float y[16]; float s = 0.f;
#pragma unroll
        for (int e = 0; e < 16; ++e) { y[e] = Y[t * SF + c16 + e]; s += y[e]; }
        const float mu = quad_sum(s) * (1.f / 64.f); float s2 = 0.f;
#pragma unroll
        for (int e = 0; e < 16; ++e) { y[e] -= mu; s2 += y[e] * y[e]; }
        const float rstd = 1.0f / sqrtf(quad_sum(s2) * (1.f / 64.f) + 64e-5f);
        const u32x4* vg = (const u32x4*)(cw + O_VG + (size_t)item * 8192 + (t * 64 + c16) * 2); const u32x4* gg = (const u32x4*)(cw + O_GG + (size_t)item * 8192 + (t * 64 + c16) * 2);
        const float rk = *(const float*)(cw + O_RKD + (size_t)item * 256 + t * 4);
        unsigned ow[8];
#pragma unroll
        for (int hv = 0; hv < 2; ++hv) { const u32x4 vw = vg[hv], gw = gg[hv];
#pragma unroll
            for (int e2 = 0; e2 < 4; ++e2) { const int e = hv * 8 + 2 * e2; const int ch = h * 64 + c16 + e;
                const float o0 = (y[e] * rstd * p.ln_g[ch] + p.ln_b[ch] + rk * bflo(vw[e2])) * bflo(gw[e2]);
                const float o1 = (y[e + 1] * rstd * p.ln_g[ch + 1] + p.ln_b[ch + 1] + rk * bfhi(vw[e2])) * bfhi(gw[e2]);
                ow[hv * 4 + e2] = pk2(o0, o1); } }
        u32x4* dst = (u32x4*)(MIXB + ((size_t)b * SEQ + (size_t)c * 64 + t) * 1024 + 512 + h * 64 + c16);
        dst[0] = (u32x4){ow[0], ow[1], ow[2], ow[3]}; dst[1] = (u32x4){ow[4], ow[5], ow[6], ow[7]};
    }
    __syncthreads();
}

__device__ __forceinline__ void rot16(float (&o)[16], const bf16_t* __restrict__ prow, int colbase, int c16, const float* __restrict__ ropet  ) {
    const u32x4* own = (const u32x4*)(prow + colbase + c16); const u32x4* par = (const u32x4*)(prow + colbase + (c16 ^ 32));
    const f32x4* cs = (const f32x4*)(ropet + 2 * (c16 & 31));
#pragma unroll
    for (int hv = 0; hv < 2; ++hv) { const u32x4 ow = own[hv], pw = par[hv];
#pragma unroll
        for (int e2 = 0; e2 < 4; ++e2) { const f32x4 csv = cs[hv * 4 + e2];
            const float x0 = bflo(ow[e2]), x1 = bfhi(ow[e2]), p0 = bflo(pw[e2]), p1 = bfhi(pw[e2]);
            o[hv * 8 + 2 * e2] = (c16 < 32) ? (x0 * csv[0] - p0 * csv[1]) : (p0 * csv[1] + x0 * csv[0]);
            o[hv * 8 + 2 * e2 + 1] = (c16 < 32) ? (x1 * csv[2] - p1 * csv[3]) : (p1 * csv[3] + x1 * csv[2]); } }
}
struct RotIn { u32x4 own[2], par[2]; f32x4 cs[8]; };
__device__ __forceinline__ void rot_load(RotIn& R_, const bf16_t* __restrict__ prow, int colbase, int c16) { const u32x4* own = (const u32x4*)(prow + colbase + c16); const u32x4* par = (const u32x4*)(prow + colbase + (c16 ^ 32));
    R_.own[0] = own[0]; R_.own[1] = own[1]; R_.par[0] = par[0]; R_.par[1] = par[1]; }
__device__ __forceinline__ void rot_cs(f32x4 (&cs)[8], int c16, const float* __restrict__ ropet) { const f32x4* p = (const f32x4*)(ropet + 2 * (c16 & 31));
#pragma unroll
    for (int i = 0; i < 8; ++i) cs[i] = p[i]; }
__device__ __forceinline__ void rot16r(float (&o)[16], const u32x4 (&own)[2], const u32x4 (&par)[2], const f32x4 (&cs)[8], int c16) {
#pragma unroll
    for (int hv = 0; hv < 2; ++hv) { const u32x4 ow = own[hv], pw = par[hv];
#pragma unroll
        for (int e2 = 0; e2 < 4; ++e2) { const f32x4 csv = cs[hv * 4 + e2];
            const float x0 = bflo(ow[e2]), x1 = bfhi(ow[e2]), p0 = bflo(pw[e2]), p1 = bfhi(pw[e2]);
            o[hv * 8 + 2 * e2] = (c16 < 32) ? (x0 * csv[0] - p0 * csv[1]) : (p0 * csv[1] + x0 * csv[0]);
            o[hv * 8 + 2 * e2 + 1] = (c16 < 32) ? (x1 * csv[2] - p1 * csv[3]) : (p1 * csv[3] + x1 * csv[2]); } }
}
__device__ __forceinline__ void ret_stage1(CK_LAS unsigned char* ldsq, int item, const bf16_t* __restrict__ Pb, int PW, int C_TK, int C_TV, int SEQ, const float* __restrict__ ROPE, unsigned char* __restrict__ cw) {
    const int tid = ltid(), lane = tid & 63, wid = __builtin_amdgcn_readfirstlane(tid >> 6), wq = wid & 3, I = wq >> 1, J = wq & 1, qtid = tid & 255;
    const lbf VT = (lbf)ldsq, KdT = (lbf)(ldsq + B9);
    if (item >= 0) {
        const int b = item >> 10, h = (item >> 8) & 3, c = item & 255; const int t = qtid >> 2, c16 = (qtid & 3) * 16; const int pos = c * 64 + t;
        const bf16_t* prow = Pb + ((size_t)b * SEQ + pos) * PW;
        RotIn ki; rot_load(ki, prow, C_TK + h * 64, c16); rot_cs(ki.cs, c16, ROPE + (size_t)pos * 64);
        const u32x4* vp = (const u32x4*)(prow + C_TV + h * 64 + c16); const u32x4 vw2[2] = {vp[0], vp[1]};
        float kr[16]; rot16r(kr, ki.own, ki.par, ki.cs, c16);
        const float lg = __builtin_amdgcn_logf(1.0f - __builtin_amdgcn_exp2f(-5.0f - (float)h));
        const float dec = 0.125f * __builtin_amdgcn_exp2f(lg * (float)(63 - t));
#pragma unroll
        for (int hv = 0; hv < 2; ++hv) { const u32x4 vw = vw2[hv];
#pragma unroll
            for (int e2 = 0; e2 < 4; ++e2) { const int e = hv * 8 + 2 * e2;
                VT[(c16 + e) * SB + t] = (bf16_t)(vw[e2] & 0xffffu); VT[(c16 + e + 1) * SB + t] = (bf16_t)(vw[e2] >> 16);
                KdT[(c16 + e) * SB + t] = (bf16_t)f2bf(kr[e] * dec); KdT[(c16 + e + 1) * SB + t] = (bf16_t)f2bf(kr[e + 1] * dec); } }
    }
    __syncthreads();
    if (item >= 0) { const f32x16 kv = mm_lds(VT, KdT, I, J, lane, f32x16{}); frag_store_bf((bf16_t*)(cw + O_KV) + (size_t)item * 4096, wq, lane, kv); }
    __syncthreads();
}
__device__ __forceinline__ void ret_scan(int chain, unsigned char* __restrict__ cw) {
    const int tid = ltid(), lane = tid & 63, wid = __builtin_amdgcn_readfirstlane(tid >> 6), wq = wid & 3, I = wq >> 1, J = wq & 1, r = lane & 31, hh = lane >> 5;
    const int h = chain & 3; const float lg = __builtin_amdgcn_logf(1.0f - __builtin_amdgcn_exp2f(-5.0f - (float)h)); const float g64 = __builtin_amdgcn_exp2f(lg * 64.0f);
    const bf16_t* kvg = (const bf16_t*)(cw + O_KV) + (size_t)chain * 256 * 4096; bf16_t* rtg = (bf16_t*)(cw + O_RT) + (size_t)chain * 256 * 4096;
    f32x16 R = f32x16{}; constexpr int PD = 8; f32x16 nx[PD];
#pragma unroll
    for (int k = 0; k < PD; ++k) nx[k] = frag_load_bf(kvg + (size_t)k * 4096, wq, lane);
    for (int c = 0; c < 256; c += PD) {
#pragma unroll
        for (int k = 0; k < PD; ++k) { const int cc = c + k; bf16_t* dst = rtg + (size_t)cc * 4096;
#pragma unroll
            for (int g = 0; g < 16; ++g) dst[(32 * I + crow(g, hh)) * 64 + 32 * J + r] = (bf16_t)f2bf(R[g]);
            const f32x16 kvc = nx[k]; const int nn = cc + PD < 256 ? cc + PD : 255;
            nx[k] = frag_load_bf(kvg + (size_t)nn * 4096, wq, lane);
#pragma unroll
            for (int g = 0; g < 16; ++g) R[g] = R[g] * g64 + kvc[g]; }
    }
}
constexpr int L_RET3 = 4 * B9 + 64 * SF * 4;
__device__ __forceinline__ void ret_stage3(CK_LAS unsigned char* ldsq, int item, const bf16_t* __restrict__ Pb, int PW, int C_TQ, int C_TK, int C_TV, int C_TG, int SEQ, const float* __restrict__ ROPE,
                                           const float* __restrict__ gn_g, const unsigned char* __restrict__ cw, bf16_t* __restrict__ MIXB) {
    const int tid = ltid(), lane = tid & 63, wid = __builtin_amdgcn_readfirstlane(tid >> 6), wq = wid & 3, I = wq >> 1, J = wq & 1, r = lane & 31, hh = lane >> 5, qtid = tid & 255;
    const lbf Qr = (lbf)ldsq, Kr = (lbf)(ldsq + B9), VT = (lbf)(ldsq + 2 * B9), Sb = (lbf)(ldsq + 3 * B9); const lf32 Y = (lf32)(ldsq + 4 * B9);
    const int b = item >= 0 ? item >> 10 : 0, h = item >= 0 ? (item >> 8) & 3 : 0, c = item >= 0 ? item & 255 : 0; const int t = qtid >> 2, c16 = (qtid & 3) * 16; const int pos = c * 64 + t;
    const float lg = __builtin_amdgcn_logf(1.0f - __builtin_amdgcn_exp2f(-5.0f - (float)h));
    const bf16_t* prow = Pb + ((size_t)b * SEQ + pos) * PW;
    if (item >= 0) {
        float qr[16], kr[16]; rot16(qr, prow, C_TQ + h * 64, c16, ROPE + (size_t)pos * 64); rot16(kr, prow, C_TK + h * 64, c16, ROPE + (size_t)pos * 64);
        u32x4 w;
        w.x = pk2(qr[0], qr[1]); w.y = pk2(qr[2], qr[3]); w.z = pk2(qr[4], qr[5]); w.w = pk2(qr[6], qr[7]); *(CK_LAS u32x4*)(Qr + t * SB + c16) = w;
        w.x = pk2(qr[8], qr[9]); w.y = pk2(qr[10], qr[11]); w.z = pk2(qr[12], qr[13]); w.w = pk2(qr[14], qr[15]); *(CK_LAS u32x4*)(Qr + t * SB + c16 + 8) = w;
#pragma unroll
        for (int e = 0; e < 16; ++e) kr[e] *= 0.125f;
        w.x = pk2(kr[0], kr[1]); w.y = pk2(kr[2], kr[3]); w.z = pk2(kr[4], kr[5]); w.w = pk2(kr[6], kr[7]); *(CK_LAS u32x4*)(Kr + t * SB + c16) = w;
        w.x = pk2(kr[8], kr[9]); w.y = pk2(kr[10], kr[11]); w.z = pk2(kr[12], kr[13]); w.w = pk2(kr[14], kr[15]); *(CK_LAS u32x4*)(Kr + t * SB + c16 + 8) = w;
        const u32x4* vp = (const u32x4*)(prow + C_TV + h * 64 + c16);
#pragma unroll
        for (int hv = 0; hv < 2; ++hv) { const u32x4 vw = vp[hv];
#pragma unroll
            for (int e2 = 0; e2 < 4; ++e2) { const int e = hv * 8 + 2 * e2; VT[(c16 + e) * SB + t] = (bf16_t)(vw[e2] & 0xffffu); VT[(c16 + e + 1) * SB + t] = (bf16_t)(vw[e2] >> 16); } }
    }
    __syncthreads();
    if (item >= 0) {
        f32x16 st = mm_lds(Kr, Qr, I, J, lane, f32x16{}); const int tt = 32 * J + r;
#pragma unroll
        for (int g = 0; g < 16; ++g) { const int ii = 32 * I + crow(g, hh); st[g] = (ii <= tt) ? st[g] * __builtin_amdgcn_exp2f(lg * (float)(tt - ii)) : 0.f; }
        tile_store_T(Sb, I, J, lane, st);
    }
    __syncthreads();
    if (item >= 0) {
        const f32x16 yi = mm_lds(VT, Sb, I, J, lane, f32x16{}); const f32x16 yc = mm_gA((const bf16_t*)(cw + O_RT) + (size_t)item * 4096, Qr, I, J, lane, f32x16{});
        const int tt = 32 * J + r; const float qd = __builtin_amdgcn_exp2f(lg * (float)(tt + 1));
#pragma unroll
        for (int g = 0; g < 16; ++g) Y[tt * SF + 32 * I + crow(g, hh)] = yi[g] + qd * yc[g];
    }
    __syncthreads();
    if (item >= 0) {
        float y[16]; float s = 0.f;
#pragma unroll
        for (int e = 0; e < 16; ++e) { y[e] = Y[t * SF + c16 + e]; s += y[e]; }
        const float mu = quad_sum(s) * (1.f / 64.f); float s2 = 0.f;
#pragma unroll
        for (int e = 0; e < 16; ++e) { y[e] -= mu; s2 += y[e] * y[e]; }
        const float rstd = 1.0f / sqrtf(quad_sum(s2) * (1.f / 64.f) + 1e-6f);
        const u32x4* gp = (const u32x4*)(prow + C_TG + h * 64 + c16); unsigned ow[8];
#pragma unroll
        for (int hv = 0; hv < 2; ++hv) { const u32x4 gw = gp[hv];
#pragma unroll
            for (int e2 = 0; e2 < 4; ++e2) { const int e = hv * 8 + 2 * e2; const int ch = h * 64 + c16 + e; const float g0 = bflo(gw[e2]), g1 = bfhi(gw[e2]);
                ow[hv * 4 + e2] = pk2(y[e] * rstd * gn_g[ch] * (g0 * sigm(g0)), y[e + 1] * rstd * gn_g[ch + 1] * (g1 * sigm(g1))); } }
        u32x4* dst = (u32x4*)(MIXB + ((size_t)b * SEQ + pos) * 1024 + 768 + h * 64 + c16);
        dst[0] = (u32x4){ow[0], ow[1], ow[2], ow[3]}; dst[1] = (u32x4){ow[4], ow[5], ow[6], ow[7]};
    }
    __syncthreads();
}
__device__ __forceinline__ void ret_level1(int task, unsigned char* __restrict__ cw) {
    const int tid = ltid(), lane = tid & 63, wid = __builtin_amdgcn_readfirstlane(tid >> 6), wq = wid & 3;
    int h = (task >> 5) & 3; asm volatile("" : "+s"(h));
    const float lg = __builtin_amdgcn_logf(1.0f - __builtin_amdgcn_exp2f(-5.0f - (float)h)); const float g64 = __builtin_amdgcn_exp2f(lg * 64.0f);
    const bf16_t* kvg = (const bf16_t*)(cw + O_KV) + ((size_t)(task >> 5) * 256 + (size_t)(task & 31) * 8) * 4096;
    f32x16 kv[8];
#pragma unroll
    for (int j = 0; j < 8; ++j) kv[j] = frag_load_bf(kvg + (size_t)j * 4096, wq, lane);
    f32x16 acc = kv[0];
#pragma unroll
    for (int j = 1; j < 8; ++j)
#pragma unroll
        for (int g = 0; g < 16; ++g) acc[g] = acc[g] * g64 + kv[j][g];
    frag_store((float*)(cw + O_KG) + (size_t)task * 4096, wq, lane, acc);
}
__device__ __forceinline__ void ret_scan_groups(int chain, unsigned char* __restrict__ cw) {
    const int tid = ltid(), lane = tid & 63, wid = __builtin_amdgcn_readfirstlane(tid >> 6), wq = wid & 3;
    int h = chain & 3; asm volatile("" : "+s"(h)); const float lg = __builtin_amdgcn_logf(1.0f - __builtin_amdgcn_exp2f(-5.0f - (float)h)); const float g512 = __builtin_amdgcn_exp2f(lg * 512.0f);
    const float* kgg = (const float*)(cw + O_KG) + (size_t)chain * 32 * 4096; float* rgg = (float*)(cw + O_RG) + (size_t)chain * 32 * 4096;
    f32x16 R = f32x16{}; f32x16 nx[4];
#pragma unroll
    for (int k = 0; k < 4; ++k) nx[k] = frag_load(kgg + (size_t)k * 4096, wq, lane);
    for (int c = 0; c < 32; c += 4) {
#pragma unroll
        for (int k = 0; k < 4; ++k) { const int cc = c + k; frag_store(rgg + (size_t)cc * 4096, wq, lane, R);
            const f32x16 kvc = nx[k]; const int nn = cc + 4 < 32 ? cc + 4 : 31; nx[k] = frag_load(kgg + (size_t)nn * 4096, wq, lane);
#pragma unroll
            for (int g = 0; g < 16; ++g) R[g] = R[g] * g512 + kvc[g]; }
    }
}
constexpr int L_RET3G = 5 * B9 + 64 * SF * 4;
__device__ __forceinline__ void ret_stage3g(CK_LAS unsigned char* ldsq, int task, const bf16_t* __restrict__ Pb, int PW, int C_TQ, int C_TK, int C_TV, int C_TG, int SEQ, const float* __restrict__ ROPE,
                                           const float* __restrict__ gn_g, const unsigned char* __restrict__ cw, bf16_t* __restrict__ MIXB) {
    const int tid = ltid(), lane = tid & 63, wid = __builtin_amdgcn_readfirstlane(tid >> 6), wq = wid & 3, I = wq >> 1, J = wq & 1, r = lane & 31, hh = lane >> 5, qtid = tid & 255;
    const lbf Qr = (lbf)ldsq, Kr = (lbf)(ldsq + B9), VT = (lbf)(ldsq + 2 * B9), Sb = (lbf)(ldsq + 3 * B9), RTL = (lbf)(ldsq + 4 * B9); const lf32 Y = (lf32)(ldsq + 5 * B9);
    const int tk = task >= 0 ? task : 0; const int item0 = (tk >> 5) * 256 + (tk & 31) * 8;
    f32x16 R = frag_load((const float*)(cw + O_RG) + (size_t)tk * 4096, wq, lane);
    f32x4 gng[4];
    { const int h0 = (item0 >> 8) & 3, c16_ = (qtid & 3) * 16;
#pragma unroll
      for (int i = 0; i < 4; ++i) gng[i] = *(const f32x4*)(gn_g + h0 * 64 + c16_ + 4 * i); }
    RotIn qi, ki; u32x4 vw2[2], gw2[2]; u32x4 kvw[2];
    const int t = qtid >> 2, c16 = (qtid & 3) * 16;
#define CK_T3_ROW(it_) (Pb + ((size_t)((it_) >> 10) * SEQ + (size_t)((it_) & 255) * 64 + t) * PW)
#define CK_T3_LOADA(it_) do { const int i__ = (it_); const int h__ = (i__ >> 8) & 3; const bf16_t* pr__ = CK_T3_ROW(i__); rot_load(qi, pr__, C_TQ + h__ * 64, c16); rot_load(ki, pr__, C_TK + h__ * 64, c16); rot_cs(qi.cs, c16, ROPE + (size_t)((i__ & 255) * 64 + t) * 64); \
        const u32x4* vp = (const u32x4*)(pr__ + C_TV + h__ * 64 + c16); vw2[0] = vp[0]; vw2[1] = vp[1]; } while (0)
#define CK_T3_LOADB(it_) do { const int i__ = (it_); const int h__ = (i__ >> 8) & 3; const bf16_t* pr__ = CK_T3_ROW(i__); const u32x4* gp = (const u32x4*)(pr__ + C_TG + h__ * 64 + c16); gw2[0] = gp[0]; gw2[1] = gp[1]; \
        const u32x4* kp = (const u32x4*)((const bf16_t*)(cw + O_KV) + (size_t)i__ * 4096 + ((size_t)(wq * 64 + lane)) * 16); kvw[0] = kp[0]; kvw[1] = kp[1]; } while (0)
    CK_T3_LOADA(item0); CK_T3_LOADB(item0);
    for (int j = 0; j < 8; ++j) { const int item = task >= 0 ? item0 + j : -1; const int nitem = item0 + (j < 7 ? j + 1 : 7);
    const int b = item >= 0 ? item >> 10 : 0, h = item >= 0 ? (item >> 8) & 3 : 0, c = item >= 0 ? item & 255 : 0; const int pos = c * 64 + t;
    const float lg = __builtin_amdgcn_logf(1.0f - __builtin_amdgcn_exp2f(-5.0f - (float)h));
    if (item >= 0) {
#pragma unroll
        for (int g_ = 0; g_ < 16; ++g_) RTL[(32 * I + crow(g_, hh)) * SB + 32 * J + r] = (bf16_t)f2bf(R[g_]);
        float qr[16], kr[16]; rot16r(qr, qi.own, qi.par, qi.cs, c16); rot16r(kr, ki.own, ki.par, qi.cs, c16);
        u32x4 w;
        w.x = pk2(qr[0], qr[1]); w.y = pk2(qr[2], qr[3]); w.z = pk2(qr[4], qr[5]); w.w = pk2(qr[6], qr[7]); *(CK_LAS u32x4*)(Qr + t * SB + c16) = w;
        w.x = pk2(qr[8], qr[9]); w.y = pk2(qr[10], qr[11]); w.z = pk2(qr[12], qr[13]); w.w = pk2(qr[14], qr[15]); *(CK_LAS u32x4*)(Qr + t * SB + c16 + 8) = w;
#pragma unroll
        for (int e = 0; e < 16; ++e) kr[e] *= 0.125f;
        w.x = pk2(kr[0], kr[1]); w.y = pk2(kr[2], kr[3]); w.z = pk2(kr[4], kr[5]); w.w = pk2(kr[6], kr[7]); *(CK_LAS u32x4*)(Kr + t * SB + c16) = w;
        w.x = pk2(kr[8], kr[9]); w.y = pk2(kr[10], kr[11]); w.z = pk2(kr[12], kr[13]); w.w = pk2(kr[14], kr[15]); *(CK_LAS u32x4*)(Kr + t * SB + c16 + 8) = w;
#pragma unroll
        for (int hv = 0; hv < 2; ++hv) { const u32x4 vw = vw2[hv];
#pragma unroll
            for (int e2 = 0; e2 < 4; ++e2) { const int e = hv * 8 + 2 * e2; VT[(c16 + e) * SB + t] = (bf16_t)(vw[e2] & 0xffffu); VT[(c16 + e + 1) * SB + t] = (bf16_t)(vw[e2] >> 16); } }
    }
    CK_T3_LOADA(nitem);
    asm volatile("s_waitcnt lgkmcnt(0)\n\ts_barrier" ::: "memory");
    if (item >= 0) {
        f32x16 st = mm_lds(Kr, Qr, I, J, lane, f32x16{}); const int tt = 32 * J + r;
#pragma unroll
        for (int g = 0; g < 16; ++g) { const int ii = 32 * I + crow(g, hh); st[g] = (ii <= tt) ? st[g] * __builtin_amdgcn_exp2f(lg * (float)(tt - ii)) : 0.f; }
        tile_store_T(Sb, I, J, lane, st);
    }
    asm volatile("s_waitcnt lgkmcnt(0)\n\ts_barrier" ::: "memory");
    if (item >= 0) {
        const f32x16 yi = mm_lds(VT, Sb, I, J, lane, f32x16{}); const f32x16 yc = mm_lds(RTL, Qr, I, J, lane, f32x16{});
        const int tt = 32 * J + r; const float qd = __builtin_amdgcn_exp2f(lg * (float)(tt + 1));
#pragma unroll
        for (int g = 0; g < 16; ++g) Y[tt * SF + 32 * I + crow(g, hh)] = yi[g] + qd * yc[g];
    }
    asm volatile("s_waitcnt lgkmcnt(0)\n\ts_barrier" ::: "memory");
    if (item >= 0) {
        float y[16]; float s = 0.f;
#pragma unroll
        for (int e = 0; e < 16; ++e) { y[e] = Y[t * SF + c16 + e]; s += y[e]; }
        const float mu = quad_sum(s) * (1.f / 64.f); float s2 = 0.f;
#pragma unroll
        for (int e = 0; e < 16; ++e) { y[e] -= mu; s2 += y[e] * y[e]; }
        const float rstd = 1.0f / sqrtf(quad_sum(s2) * (1.f / 64.f) + 1e-6f);
        unsigned ow[8];
#pragma unroll
        for (int hv = 0; hv < 2; ++hv) { const u32x4 gw = gw2[hv];
#pragma unroll
            for (int e2 = 0; e2 < 4; ++e2) { const int e = hv * 8 + 2 * e2; const float g0 = bflo(gw[e2]), g1 = bfhi(gw[e2]);
                ow[hv * 4 + e2] = pk2(y[e] * rstd * gng[e >> 2][e & 3] * (g0 * sigm(g0)), y[e + 1] * rstd * gng[(e + 1) >> 2][(e + 1) & 3] * (g1 * sigm(g1))); } }
        u32x4* dst = (u32x4*)(MIXB + ((size_t)b * SEQ + pos) * 1024 + 768 + h * 64 + c16);
        dst[0] = (u32x4){ow[0], ow[1], ow[2], ow[3]}; dst[1] = (u32x4){ow[4], ow[5], ow[6], ow[7]};
    }
    if (item >= 0) { const u32x4 a = kvw[0], b2 = kvw[1];
        const f32x16 kvc = (f32x16){bflo(a[0]), bfhi(a[0]), bflo(a[1]), bfhi(a[1]), bflo(a[2]), bfhi(a[2]), bflo(a[3]), bfhi(a[3]), bflo(b2[0]), bfhi(b2[0]), bflo(b2[1]), bfhi(b2[1]), bflo(b2[2]), bfhi(b2[2]), bflo(b2[3]), bfhi(b2[3])};
        const float g64 = __builtin_amdgcn_exp2f(lg * 64.0f);
#pragma unroll
        for (int g_ = 0; g_ < 16; ++g_) R[g_] = R[g_] * g64 + kvc[g_]; }
    CK_T3_LOADB(nitem);
    asm volatile("s_waitcnt lgkmcnt(0)\n\ts_barrier" ::: "memory");
    }
#undef CK_T3_ROW
#undef CK_T3_LOADA
#undef CK_T3_LOADB
}
}

__device__ __forceinline__ void tr_tile(const float* __restrict__ src, size_t ld_src, bf16* __restrict__ dst, size_t ld_dst, float* scr, int lane) {
    pg8::f32x4 v[16];
#pragma unroll
    for (int i = 0; i < 16; ++i) v[i] = *(const pg8::f32x4*)(src + (size_t)(i * 4 + (lane >> 4)) * ld_src + (lane & 15) * 4);
#pragma unroll
    for (int i = 0; i < 16; ++i) { float* p = scr + (i * 4 + (lane >> 4)) * 65 + (lane & 15) * 4; p[0] = v[i][0]; p[1] = v[i][1]; p[2] = v[i][2]; p[3] = v[i][3]; }
    asm volatile("s_waitcnt lgkmcnt(0)" ::: "memory");
#pragma unroll
    for (int i = 0; i < 8; ++i) { const int n = i * 8 + (lane >> 3), kc = (lane & 7) * 8; const float* s = scr + kc * 65 + n;
        pg8::u32x4 o; o.x = pk2(s[0], s[65]); o.y = pk2(s[2 * 65], s[3 * 65]); o.z = pk2(s[4 * 65], s[5 * 65]); o.w = pk2(s[6 * 65], s[7 * 65]);
        *(pg8::u32x4*)(dst + (size_t)n * ld_dst + kc) = o; }
    asm volatile("s_waitcnt lgkmcnt(0)" ::: "memory");
}

__device__ __forceinline__ void tr_tile_fp8(const float* __restrict__ src, size_t ld_src, unsigned char* __restrict__ dst, size_t ld_dst, float* scr, int lane, float scale) {
    pg8::f32x4 v[16];
#pragma unroll
    for (int i = 0; i < 16; ++i) v[i] = *(const pg8::f32x4*)(src + (size_t)(i * 4 + (lane >> 4)) * ld_src + (lane & 15) * 4);
#pragma unroll
    for (int i = 0; i < 16; ++i) { float* p = scr + (i * 4 + (lane >> 4)) * 65 + (lane & 15) * 4; p[0] = v[i][0] * scale; p[1] = v[i][1] * scale; p[2] = v[i][2] * scale; p[3] = v[i][3] * scale; }
    asm volatile("s_waitcnt lgkmcnt(0)" ::: "memory");
#pragma unroll
    for (int i = 0; i < 8; ++i) { const int n = i * 8 + (lane >> 3), kc = (lane & 7) * 8; const float* s = scr + kc * 65 + n;
        *(uint2*)(dst + (size_t)n * ld_dst + kc) = make_uint2(pk4_fp8(s[0], s[65], s[2 * 65], s[3 * 65]), pk4_fp8(s[4 * 65], s[5 * 65], s[6 * 65], s[7 * 65])); }
    asm volatile("s_waitcnt lgkmcnt(0)" ::: "memory");
}

constexpr int CV_13 = NE * 16 * 16, CV_2 = NE * 8 * 16, CV_L = CV_13 + CV_2, NCONV = DEPTH * CV_L;
__device__ __forceinline__ void conv_item(int it, const float* __restrict__ w1, const float* __restrict__ w3, const float* __restrict__ w2, unsigned char* __restrict__ W13, bf16* __restrict__ W2, float* scr, int lane) {
    const int l = it / CV_L; int r = it % CV_L;
    if (r < CV_13) { const int e = r >> 8, kb = (r >> 4) & 15, nb = r & 15;
        const int pn = nb >> 2, q = nb & 3; const float* srcw = (q < 2 ? w1 : w3) + ((size_t)l * NE + e) * DM * DE;
        tr_tile_fp8(srcw + (size_t)kb * 64 * DE + pn * 128 + (q & 1) * 64, DE, W13 + ((size_t)l * NE + e) * DM * DM + (size_t)nb * 64 * DM + kb * 64, DM, scr, lane, W13_SCALE); }
    else { r -= CV_13; const int e = r >> 7, kb = (r >> 4) & 7, nb = r & 15;
        tr_tile_fp8(w2 + ((size_t)l * NE + e) * DE * DM + (size_t)kb * 64 * DM + nb * 64, DM, (unsigned char*)W2 + ((size_t)l * NE + e) * DM * DE + (size_t)nb * 64 * DE + kb * 64, DE, scr, lane, W2_SCALE); }
}

#define LAS __attribute__((address_space(3)))
#define XB_TMO      128
#define XB_XCNT(j)  (256  + 64 * (j))
#define XB_XSUB(j)  (1280 + 64 * (j))
#define XB_XGEN(j)  (2304 + 64 * (j))
#define XB_TOP      3328
#define XB_TOPGEN   3392
#define XCD_BAR_WORDS 3456
#define XB_SPIN_CAP (1u << 18)

__device__ __forceinline__ unsigned xb_ld(unsigned* p)              { return __hip_atomic_load(p, __ATOMIC_RELAXED, __HIP_MEMORY_SCOPE_AGENT); }
__device__ __forceinline__ unsigned xb_add(unsigned* p, unsigned v) { return __hip_atomic_fetch_add(p, v, __ATOMIC_RELAXED, __HIP_MEMORY_SCOPE_AGENT); }
__device__ __forceinline__ unsigned xb_xcc_id() { return (unsigned)__builtin_amdgcn_s_getreg((3 << 11) | 20) & 0xFu; }
#define XB_SPIN(cond, bar) do { unsigned _sp = 0; while (cond) { __builtin_amdgcn_s_sleep(1); \
    if ((++_sp & 255u) == 0u) { if (xb_ld(&(bar)[XB_TMO])) break; if (_sp > XB_SPIN_CAP) { atomicAdd(&(bar)[XB_TMO], 1u); break; } } } } while (0)

struct XcdBarrier {
    unsigned* bar; unsigned x;
    volatile LAS unsigned* st;
};

__device__ __forceinline__ XcdBarrier xcd_barrier_post(unsigned* bar, volatile LAS unsigned* st) {
    XcdBarrier b; b.bar = bar; b.x = xb_xcc_id(); b.st = st;
    if (ltid() == 0) (void)xb_add(&bar[XB_XCNT(b.x)], 1u);
    return b;
}
__device__ __forceinline__ void xcd_barrier_complete(unsigned* bar, unsigned x, unsigned& nloc, unsigned& nx) {
    const unsigned G = gridDim.x * gridDim.y * gridDim.z;
    unsigned sum, cnt, mine, sp = 0u;
    for (;;) {
        sum = 0u; cnt = 0u; mine = 0u;
#pragma unroll
        for (unsigned j = 0; j < 16; ++j) { const unsigned c = xb_ld(&bar[XB_XCNT(j)]); sum += c; cnt += (c > 0u) ? 1u : 0u; mine = (j == x) ? c : mine; }
        if (sum == G) break;
        __builtin_amdgcn_s_sleep(1);
        if ((++sp & 255u) == 0u) { if (xb_ld(&bar[XB_TMO])) break; if (sp > XB_SPIN_CAP) { atomicAdd(&bar[XB_TMO], 1u); break; } }
    }
    nloc = mine > 0u ? mine : 1u; nx = cnt > 0u ? cnt : 1u;
}

__device__ __forceinline__ void xcd_barrier(const XcdBarrier& b) {
    asm volatile("s_waitcnt vmcnt(0)" ::: "memory");
    __syncthreads();
    if (ltid() == 0) {
        unsigned* bar = b.bar; asm volatile("" : "+s"(bar)); unsigned bx_ = b.x; asm volatile("" : "+s"(bx_));
        __builtin_amdgcn_s_waitcnt(0);
        unsigned nloc = b.st[0], nx = b.st[1];
        if (nloc == 0u) { xcd_barrier_complete(bar, bx_, nloc, nx); b.st[0] = nloc; b.st[1] = nx; }
        const unsigned old = xb_add(&bar[XB_XSUB(bx_)], 1u);
        const unsigned gen = old / nloc;
        if (old + 1u == (gen + 1u) * nloc) {
            __builtin_amdgcn_fence(__ATOMIC_RELEASE, "agent");
            asm volatile("s_waitcnt vmcnt(0)" ::: "memory");
            const unsigned og = xb_add(&bar[XB_TOP], 1u);
            const unsigned tg = og / nx;
            if (og + 1u == (tg + 1u) * nx) xb_add(&bar[XB_TOPGEN], 1u);
            else XB_SPIN(xb_ld(&bar[XB_TOPGEN]) == tg, bar);
            __builtin_amdgcn_fence(__ATOMIC_ACQUIRE, "agent");
            xb_add(&bar[XB_XGEN(bx_)], 1u);
            asm volatile("s_waitcnt vmcnt(0)" ::: "memory");
        } else {
            XB_SPIN(xb_ld(&bar[XB_XGEN(bx_)]) == gen, bar);
            __builtin_amdgcn_fence(__ATOMIC_ACQUIRE, "agent");
            asm volatile("s_waitcnt vmcnt(0)" ::: "memory");
        }
    }
    __syncthreads();
}


__global__ void __launch_bounds__(NTHREADS, 2) mk_fwd(Args args) {
    extern __shared__ __attribute__((aligned(16))) unsigned char lds_raw[];
    float* lds = (float*)lds_raw;
    const int tid = ltid(), lane = tid & 63, wid = __builtin_amdgcn_readfirstlane(tid >> 6);
    const int G = gridDim.x, bx = blockIdx.x;
    unsigned char* ws = args.ws;
    unsigned* ctl = (unsigned*)(ws + WS_CTL);
    float* X = args.out;
    bf16* XB = (bf16*)(ws + WS_XB);
    bf16* Pb = (bf16*)(ws + WS_P);
    bf16* WIN = (bf16*)(ws + WS_WIN); bf16* WOUT = (bf16*)(ws + WS_WOUT); unsigned char* W13 = ws + WS_W13; bf16* W2 = (bf16*)(ws + WS_W2);
    float* ROPE = (float*)(ws + WS_ROPE);
    double* LCS = (double*)(ws + WS_LCS); double* TOT = (double*)(ws + WS_TOT);
    float* BE = (float*)(ws + WS_SKIP); float* QN2 = BE + 16 * 256; float* KN2 = QN2 + 16 * 128; float* SQM = KN2 + 16 * 128;
    unsigned char* KA = ws + WS_KA;
    unsigned char* cw = ws + WS_CK; bf16* LWT = (bf16*)(ws + WS_LW);
    int* EP = (int*)(ws + WS_EP);
    float* GATE = (float*)(ws + WS_GATE);
    bf16* MIXB = (bf16*)(ws + WS_MIXB);
    unsigned char* XB8 = ws + WS_XP + 8 * MiB; bf16* Hb = (bf16*)(ws + WS_H);
    bf16* YP = (bf16*)(ws + WS_YP); bf16* YO = (bf16*)(ws + WS_YO);
    typedef pg8::f32x4 f32x4;
    volatile LAS unsigned* MISC = (volatile LAS unsigned*)((LAS unsigned char*)lds_raw + LDS_MISC);
    for (int u = tid; u < (LDS_ALL - LDS_MISC) / 4; u += NTHREADS) MISC[u] = 0u;
    __syncthreads();
    XcdBarrier bar = xcd_barrier_post(ctl + CW_BAR, MISC + 8);
#define GRID_BAR() xcd_barrier(bar)
    unsigned long long tp_acc = 0ull, tp_t0 = 0ull; (void)tp_acc; (void)tp_t0;

    for (int rep_ = 0; rep_ < REP_P0; ++rep_) {
            const int tid = ltid(), lane = tid & 63, wid = __builtin_amdgcn_readfirstlane(tid >> 6); (void)lane; (void)wid;
        { const double inv = pow(10000.0, -(double)(tid & 31) / 32.0);
          for (int i = bx * NTHREADS + tid; i < SEQ * 32; i += G * NTHREADS) {
            const int pos = i >> 5;
            const double ang = (double)pos * inv; double sn_, cs_; sincos(ang, &sn_, &cs_);
            ROPE[2 * i] = (float)cs_; ROPE[2 * i + 1] = (float)sn_;
          } }
        { bf16* WR = (bf16*)(ws + WS_WR);
          for (int i = bx * NTHREADS + tid; i < DEPTH * 48 * 1024; i += G * NTHREADS) { const int l_ = i / (48 * 1024), o = (i / 1024) % 48, k = i & 1023;
              const float wv = o < 4 ? args.in[21][((size_t)l_ * DM + k) * 4 + o] : (o < 36 ? args.in[23][((size_t)l_ * DM + k) * 32 + (o - 4)] : 0.f);
              const unsigned hi_ = f2bf(wv); const unsigned lo_ = f2bf(wv - bf2f((unsigned short)hi_));
              WR[((size_t)l_ * 2 + 0) * 48 * 1024 + o * 1024 + k] = (bf16)hi_; WR[((size_t)l_ * 2 + 1) * 48 * 1024 + o * 1024 + k] = (bf16)lo_; } }
        for (int i = bx * NTHREADS + tid; i < DEPTH * 256 * 256; i += G * NTHREADS) {
            const int l = i >> 16, rem = i & 65535, chg = rem >> 8, ii = rem & 255;
            if (ii < 64) LWT[((size_t)l * 256 + chg) * 64 + ii] = (bf16)f2bf(args.in[6][((size_t)l * 64 + ii) * 256 + chg]);
            else if (ii < 128) LWT[(size_t)DEPTH * 256 * 64 + ((size_t)l * 256 + chg) * 64 + (ii - 64)] = (bf16)f2bf(args.in[8][((size_t)l * 64 + (ii - 64)) * 256 + chg]);
            else LWT[(size_t)2 * DEPTH * 256 * 64 + ((size_t)l * 256 + chg) * 128 + (ii - 128)] = (bf16)f2bf(args.in[9][((size_t)l * 128 + (ii - 128)) * 256 + chg]);
        }
        float* scr = lds + wid * (64 * 65);
        constexpr int I_IN = 16 * 56, I_OUT = 16 * 16, I_L = I_IN + I_OUT;
        for (int it = bx * 8 + wid; it < DEPTH * I_L; it += G * 8) {
            const int l = it / I_L; int r = it % I_L;
            if (r < I_IN) { const int kb = r / 56, nb = r % 56; const int nsrc = nb * 64 + (nb >= 24 ? 8 : 0);
                if (l >= INPROJ_FP8_FROM) tr_tile_fp8(args.in[1] + (size_t)l * DM * INW + (size_t)kb * 64 * INW + nsrc, INW, (unsigned char*)(WIN + (size_t)l * PW * DM) + (size_t)nb * 64 * DM + kb * 64, DM, scr, lane, WIN_SCALE);
                else tr_tile(args.in[1] + (size_t)l * DM * INW + (size_t)kb * 64 * INW + nsrc, INW, WIN + (size_t)l * PW * DM + (size_t)nb * 64 * DM + kb * 64, DM, scr, lane); }
            else { r -= I_IN; const int kb = r / 16, nb = r % 16;
                tr_tile(args.in[16] + (size_t)l * DM * DM + (size_t)kb * 64 * DM + nb * 64, DM, WOUT + (size_t)l * DM * DM + (size_t)nb * 64 * DM + kb * 64, DM, scr, lane); }
        }
        __syncthreads();
        {
            const float* wf = args.in[1] + O_FF; const float* fbias = args.in[2];
            float w[8][16];
#pragma unroll
            for (int jq = 0; jq < 4; ++jq)
#pragma unroll
                for (int e = 0; e < 4; ++e)
#pragma unroll
                    for (int h = 0; h < 8; ++h) w[h][jq * 4 + e] = wf[(size_t)(jq * 256 + lane * 4 + e) * INW + h];
            float* ffl = lds;
            for (int ch = bx; ch < T / 128; ch += G) {
                __syncthreads();
                f32x4 xn[4];
#pragma unroll
                for (int jq = 0; jq < 4; ++jq) xn[jq] = *(const f32x4*)(args.in[0] + ((size_t)ch * 128 + wid * 16) * DM + jq * 256 + lane * 4);
                for (int i = 0; i < 16; ++i) { const int tl = wid * 16 + i; const size_t m = (size_t)ch * 128 + tl;
                    float acc[8];
#pragma unroll
                    for (int h = 0; h < 8; ++h) acc[h] = 0.f;
                    f32x4 xc[4];
#pragma unroll
                    for (int jq = 0; jq < 4; ++jq) { xc[jq] = xn[jq]; *(uint2*)(XB + m * DM + jq * 256 + lane * 4) = make_uint2(pk2(xc[jq][0], xc[jq][1]), pk2(xc[jq][2], xc[jq][3])); }
                    if (i + 1 < 16) {
#pragma unroll
                        for (int jq = 0; jq < 4; ++jq) xn[jq] = *(const f32x4*)(args.in[0] + (m + 1) * DM + jq * 256 + lane * 4); }
#pragma unroll
                    for (int jq = 0; jq < 4; ++jq) { const f32x4 xv = xc[jq];
#pragma unroll
                        for (int e = 0; e < 4; ++e)
#pragma unroll
                            for (int h = 0; h < 8; ++h) acc[h] += xv[e] * w[h][jq * 4 + e]; }
#pragma unroll
                    for (int h = 0; h < 8; ++h) acc[h] = wave_sum(acc[h]);
                    if (lane < 8) { float v = acc[0];
#pragma unroll
                        for (int h = 1; h < 8; ++h) v = (lane == h) ? acc[h] : v;
                        ffl[tl * 8 + lane] = v + fbias[lane]; } }
                __syncthreads();
                {
                    const int h = wid; const int bb = (ch * 128) / SEQ, t0 = (ch * 128) % SEQ; double carry = 0.0;
#pragma unroll
                    for (int half = 0; half < 2; ++half) { double v = (double)logsigmoidf_(ffl[(half * 64 + lane) * 8 + h]);
#pragma unroll
                        for (int o = 1; o < 64; o <<= 1) { const double n = __shfl_up(v, o); if (lane >= o) v += n; }
                        v += carry; LCS[(size_t)(bb * 8 + h) * SEQ + t0 + half * 64 + lane] = v; carry = __shfl(v, 63); }
                    if (lane == 0) TOT[(bb * 8 + h) * 128 + t0 / 128] = carry;
                }
            }
            __syncthreads();
        }
    }
    GRID_BAR();

    for (int l = 0; l < DEPTH; ++l) {
        for (int rep_ = 0; rep_ < REP_A; ++rep_) {
            const int tid = ltid(), lane = tid & 63, wid = __builtin_amdgcn_readfirstlane(tid >> 6); (void)lane; (void)wid;
            pg8::StaticOrder S; S.init(T, PW, G, bx);
            if (l >= INPROJ_FP8_FROM) {
            pg8::Gemm g{(const pg8::bf16_t*)(args.ws + WS_XA8), WIN + (size_t)l * PW * DM, T, PW, DM / 2};
            pg8::EpiInProj E{Pb, PW, QC2, 1.0f / WIN_SCALE};
            PG8_LAS unsigned* rowoffA = (PG8_LAS unsigned*)((PG8_LAS unsigned char*)lds_raw + 133120);
            __syncthreads();
            _Pragma("clang loop unroll(disable)") for (int i = 0; i < 8; ++i) { pg8::Unit u_; if (!S.next(i, u_)) break; rowoffA[i * 256 + (tid & 255)] = (unsigned)((u_.pm * 256 + (tid & 255)) * DM); }
            __syncthreads();
            pg8::gemm_phase<pg8::EpiInProj, pg8::StaticOrder, true, true, true, true>((PG8_LAS unsigned char*)lds_raw, g, S, E, rowoffA);
            } else {
            pg8::Gemm g{XB, WIN + (size_t)l * PW * DM, T, PW, DM};
            pg8::EpiInProj E{Pb, PW, QC2};
            pg8::gemm_phase<pg8::EpiInProj, pg8::StaticOrder, true, true>((PG8_LAS unsigned char*)lds_raw, g, S, E);
            }
        }
        GRID_BAR();
        for (int rep_ = 0; rep_ < REP_C; ++rep_) {
            const int tid = ltid(), lane = tid & 63, wid = __builtin_amdgcn_readfirstlane(tid >> 6); (void)lane; (void)wid;
            TP_BEGIN(6);
            for (int ch = bx; ch < T / 128; ch += G) {
                const int h = wid; const int bb = (ch * 128) / SEQ, t0 = (ch * 128) % SEQ, ci = t0 / 128;
                double pre = 0.0;
                { const double* tp = TOT + (bb * 8 + h) * 128; double a = (lane < ci) ? tp[lane] : 0.0; a += (lane + 64 < ci) ? tp[lane + 64] : 0.0;
#pragma unroll
                  for (int o = 1; o < 64; o <<= 1) a += __shfl_xor(a, o);
                  pre = a; }
#pragma unroll
                for (int half = 0; half < 2; ++half) { const int t = t0 + half * 64 + lane; const double v = pre + LCS[(size_t)(bb * 8 + h) * SEQ + t];
                    const double bd = -v * 1.4426950408889634; const unsigned h_ = f2bf((float)bd); const double r1 = bd - (double)bf2f((unsigned short)h_);
                    const unsigned m_ = f2bf((float)r1); const double r2 = r1 - (double)bf2f((unsigned short)m_); const unsigned l_ = f2bf((float)r2);
                    *(pg8::u32x4*)(KA + ((size_t)(bb * 8 + h) * SEQ + t) * 16) = (pg8::u32x4){h_ | (m_ << 16), l_ | (0x3f80u << 16), 0x3f803f80u, 0u};
                    if (lane == 63) BE[(bb * 8 + h) * 256 + t / 64] = (float)bd; }
                { LAS unsigned* nrm = (LAS unsigned*)lds_raw;
                  __syncthreads();
                  if (tid < 24) nrm[tid] = tid < 16 ? 0u : 0xffffffffu;
                  __syncthreads();
                  const int tl = tid >> 2, part = tid & 3; const bf16* prow = Pb + ((size_t)ch * 128 + tl) * PW;
                  pg8::u32x4 qv_[2][8], kv_[2][8];
#pragma unroll
                  for (int hq = 0; hq < 2; ++hq)
#pragma unroll
                      for (int v8 = 0; v8 < 8; ++v8) { qv_[hq][v8] = ((const pg8::u32x4*)(prow + C_FQ + (part * 2 + hq) * 64))[v8]; kv_[hq][v8] = ((const pg8::u32x4*)(prow + C_FK + (part * 2 + hq) * 64))[v8]; }
#pragma unroll
                  for (int hq = 0; hq < 2; ++hq) { const int hd = part * 2 + hq; float sq_ = 0.f, sk_ = 0.f, dt_ = 0.f;
#pragma unroll
                      for (int v8 = 0; v8 < 8; ++v8)
#pragma unroll
                          for (int e = 0; e < 4; ++e) { const float ql_ = __builtin_bit_cast(float, qv_[hq][v8][e] << 16), qh_ = __builtin_bit_cast(float, qv_[hq][v8][e] & 0xffff0000u);
                              const float kl_ = __builtin_bit_cast(float, kv_[hq][v8][e] << 16), kh_ = __builtin_bit_cast(float, kv_[hq][v8][e] & 0xffff0000u);
                              sq_ += ql_ * ql_ + qh_ * qh_; sk_ += kl_ * kl_ + kh_ * kh_; dt_ += ql_ * kl_ + qh_ * kh_; }
                      atomicMax((unsigned*)(nrm + hd), __float_as_uint(sq_)); atomicMax((unsigned*)(nrm + 8 + hd), __float_as_uint(sk_));
                      const unsigned db_ = __float_as_uint(dt_); atomicMin((unsigned*)(nrm + 16 + hd), db_ ^ ((db_ >> 31) ? 0xffffffffu : 0x80000000u)); }
                  __syncthreads();
                  if (tid < 16) { const int hd = tid & 7; ((tid < 8) ? QN2 : KN2)[(bb * 8 + hd) * 128 + ci] = __uint_as_float(nrm[tid]); }
                  else if (tid < 24) { const unsigned u_ = nrm[tid]; SQM[(bb * 8 + (tid & 7)) * 128 + ci] = __uint_as_float(u_ ^ ((u_ >> 31) ? 0x80000000u : 0xffffffffu)); }
                }
            }
            __syncthreads();
            const ck::RwkvParams rp{args.in[3] + l * 768, args.in[4] + l * 256, args.in[5] + l * 256, args.in[7] + l * 256, args.in[10] + l * 256, args.in[11] + l * 256, args.in[12] + l * 256,
                                    args.in[13] + l * 256, args.in[14] + l * 256, args.in[15] + l * 256,
                                    LWT + (size_t)l * 256 * 64, LWT + (size_t)DEPTH * 256 * 64 + (size_t)l * 256 * 64, LWT + (size_t)2 * DEPTH * 256 * 64 + (size_t)l * 256 * 128};
#ifndef REP_S1
#define REP_S1 1
#endif
#ifndef REP_R1
#define REP_R1 1
#endif
            TP_END(6);
            TP_BEGIN(7);
            for (int rr_ = 0; rr_ < REP_S1; ++rr_)
            { ck::S1Pre pre; ck::s1_load(pre, bx < 2048 ? bx : 0, Pb, PW, C_RR, C_RK, C_RV, C_WD, SEQ, rp.w2t, rp.a2t, rp.g2t, rp.mu_rkv);
              { const int c8_ = (ltid() & 7) * 8;
#pragma unroll
                for (int q = 0; q < 4; ++q) { pre.ml[q][0] = *(const ck::f32x4*)(rp.mu_lora + q * 64 + c8_); pre.ml[q][1] = *(const ck::f32x4*)(rp.mu_lora + q * 64 + c8_ + 4); } }
              for (int it = bx; it < 2048; it += G) ck::rwkv_stage1((CK_LAS unsigned char*)lds_raw, it, Pb, PW, C_RR, C_RK, C_RV, C_WD, SEQ, rp, cw, pre, it + G < 2048 ? it + G : it, tp_acc, tp_t0); }
            TP_END(7);
            TP_BEGIN(8);
            { const int quad = wid >> 2;
              for (int rr_ = 0; rr_ < REP_R1; ++rr_)
              for (int i0 = bx * 2; i0 < 2048; i0 += G * 2) ck::ret_stage1((CK_LAS unsigned char*)lds_raw + quad * 2 * ck::B9, i0 + quad, Pb, PW, C_TK, C_TV, SEQ, ROPE, cw); }
            TP_END(8);
        }
        GRID_BAR();
        {
            const int tid = ltid(), lane = tid & 63, wid = __builtin_amdgcn_readfirstlane(tid >> 6); (void)lane; (void)wid;
            const int quad = wid >> 2;
#ifndef REP_S
#define REP_S 1
#endif
            TP_BEGIN(1);
            for (int rep_ = 0; rep_ < REP_S; ++rep_) {
            if (bx < 128) {
                ck::rwkv_level1((CK_LAS unsigned char*)lds_raw, 2 * bx + quad, cw);
                asm volatile("s_waitcnt vmcnt(0)" ::: "memory"); __syncthreads();
                if (tid == 0) { __builtin_amdgcn_fence(__ATOMIC_RELEASE, "agent"); asm volatile("s_waitcnt vmcnt(0)" ::: "memory");
                                __hip_atomic_fetch_add(ctl + CW_L1 + 64 * (16 * l + (bx >> 4)), 2u, __ATOMIC_RELAXED, __HIP_MEMORY_SCOPE_AGENT); }
            }
            if (bx >= 128) {
                ck::ret_level1(2 * (bx - 128) + quad, cw);
                asm volatile("s_waitcnt vmcnt(0)" ::: "memory"); __syncthreads();
                if (tid == 0) { __builtin_amdgcn_fence(__ATOMIC_RELEASE, "agent"); asm volatile("s_waitcnt vmcnt(0)" ::: "memory");
                                __hip_atomic_fetch_add(ctl + CW_L1 + 64 * (16 * l + 8 + ((bx - 128) >> 4)), 2u, __ATOMIC_RELAXED, __HIP_MEMORY_SCOPE_AGENT); }
            }
            if (bx < 8) {
                if (wid == 0) { unsigned spins = 0;
                    while (__hip_atomic_load(ctl + CW_L1 + 64 * (16 * l + bx), __ATOMIC_RELAXED, __HIP_MEMORY_SCOPE_AGENT) < 32u) { if (++spins > (1u << 22)) break; __builtin_amdgcn_s_sleep(2); }
                    __builtin_amdgcn_fence(__ATOMIC_ACQUIRE, "agent"); asm volatile("s_waitcnt vmcnt(0)" ::: "memory"); }
                __syncthreads();
                ck::rwkv_scan<32>((CK_LAS unsigned char*)lds_raw, quad == 0 ? bx : -1, (const ck::bf16_t*)(cw + ck::O_PG), (const ck::bf16_t*)(cw + ck::O_QG), (ck::bf16_t*)(cw + ck::O_HG));
            }
            else if (bx < 16) {
                if (wid == 0) { unsigned spins = 0;
                    while (__hip_atomic_load(ctl + CW_L1 + 64 * (16 * l + bx), __ATOMIC_RELAXED, __HIP_MEMORY_SCOPE_AGENT) < 32u) { if (++spins > (1u << 22)) break; __builtin_amdgcn_s_sleep(2); }
                    __builtin_amdgcn_fence(__ATOMIC_ACQUIRE, "agent"); asm volatile("s_waitcnt vmcnt(0)" ::: "memory"); }
                __syncthreads();
                if (quad == 0) ck::ret_scan_groups(bx - 8, cw);
            }
            if (bx < 16) {
                asm volatile("s_waitcnt vmcnt(0)" ::: "memory"); __syncthreads();
                if (tid == 0) { __builtin_amdgcn_fence(__ATOMIC_RELEASE, "agent"); asm volatile("s_waitcnt vmcnt(0)" ::: "memory");
                                __hip_atomic_store(ctl + CW_SF + 64 * (16 * l + bx), 1u, __ATOMIC_RELAXED, __HIP_MEMORY_SCOPE_AGENT); }
            }
            }
            __syncthreads();
            TP_END(1);
            const attn_body::AttnTensors AT{(const attn_body::bf16*)(Pb + C_FQ), (const attn_body::bf16*)(Pb + C_FK), (const attn_body::bf16*)(Pb + C_FV), (attn_body::bf16*)MIXB, KA};
            bool cvdone = false;
#ifndef REP_D
#define REP_D 1
#endif
            const ck::RwkvParams rpE{args.in[3] + l * 768, args.in[4] + l * 256, args.in[5] + l * 256, args.in[7] + l * 256, args.in[10] + l * 256, args.in[11] + l * 256, args.in[12] + l * 256,
                                     args.in[13] + l * 256, args.in[14] + l * 256, args.in[15] + l * 256, nullptr, nullptr, nullptr};
            int gi = 0; bool edone = false, poll = false;
            for (;;) {
                if (!edone && (poll || gi >= 8)) {
                    const bool block = gi >= 8;
                    TP_BEGIN(4);
                    if (wid == 0) { unsigned spins = 0; bool ok;
                        for (;;) { const unsigned f = lane < 16 ? __hip_atomic_load(ctl + CW_SF + 64 * (16 * l + lane), __ATOMIC_RELAXED, __HIP_MEMORY_SCOPE_AGENT) : 1u;
                            ok = __all(f != 0u); if (ok || !block) break; if (++spins > (1u << 22)) { ok = true; break; } __builtin_amdgcn_s_sleep(2); }
                        if (ok) { __builtin_amdgcn_fence(__ATOMIC_ACQUIRE, "agent"); asm volatile("s_waitcnt vmcnt(0)" ::: "memory"); }
                        if (lane == 0) MISC[19] = ok ? 1u : 0u; }
                    __syncthreads();
                    const bool ready = MISC[19] != 0u;
                    __syncthreads();
                    TP_END(4);
                    if (ready) {
                        TP_BEGIN(5);
                        for (;;) {
                            if (tid == 0) MISC[16] = atomicAdd(ctl + CW_EQ + 64 * l, 1u);
                            __syncthreads();
                            const int p = (int)MISC[16];
                            __syncthreads();
                            if (p >= 128 + 128) break;
                            if ((p & 1) == 0) ck::rwkv_stage3g((CK_LAS unsigned char*)lds_raw + quad * ck::L_RW3, 2 * (p >> 1) + quad, rpE, cw, MIXB, SEQ);
                            else ck::ret_stage3g((CK_LAS unsigned char*)lds_raw + quad * ck::L_RET3G, 2 * (p >> 1) + quad, Pb, PW, C_TQ, C_TK, C_TV, C_TG, SEQ, ROPE, args.in[15] + l * 256, cw, MIXB);
                        }
                        __syncthreads();
                        TP_END(5);
                        edone = true;
                    }
                }
                poll = false;
                if (gi >= 8) break;
                int grp;
                { const int k_ = bx & 7, g0 = (k_ & 4) ? 7 : 3, g2 = (k_ & 2) ? 6 : 2, lg = (k_ + (gi & 3)) & 3;
                  grp = gi == 0 ? g0 : gi == 1 ? (g0 ^ 4) : gi == 2 ? g2 : gi == 3 ? (g2 ^ 4) : ((lg & 1) | ((lg & 2) << 1)); }
                unsigned* qh = ctl + CW_Q + 64 * (8 * l + grp);
                {
                    TP_BEGIN(2);
                    if (tid == 0) MISC[16] = atomicAdd(qh, 1u);
                    __syncthreads();
                    const unsigned idx = MISC[16];
                    if (idx >= 128u) { __syncthreads(); TP_END(2); ++gi; continue; }
                    const int qb = 63 - (int)(idx >> 1), bh = 2 * grp + (int)(idx & 1);
                    if (wid == 0) {
                        const float qn = sqrtf(fmaxf(QN2[bh * 128 + 2 * qb], QN2[bh * 128 + 2 * qb + 1])) * 1.001f;
                        const float sq0 = fminf(SQM[bh * 128 + 2 * qb], SQM[bh * 128 + 2 * qb + 1]) - 0.05f;
                        const int ntq = 4 * qb;
                        const float bref = ntq > 0 ? BE[bh * 256 + ntq - 1] : 0.f;
                        float run = 0.f; int nsk = 0; float knv[4], bev[4];
#pragma unroll
                        for (int q4 = 0; q4 < 4; ++q4) { const int tt = q4 * 64 + lane; const bool in = tt < ntq; knv[q4] = in ? KN2[bh * 128 + (tt >> 1)] : 0.f; bev[q4] = in ? BE[bh * 256 + tt] : 0.f; }
#pragma unroll
                        for (int q4 = 0; q4 < 4; ++q4) { const int tt = q4 * 64 + lane; const bool in = tt < ntq;
                            float ms = in ? 64.0f * __builtin_amdgcn_exp2f(fminf(qn * sqrtf(knv[q4]) - sq0 - (bref - bev[q4]), 60.0f)) : 0.f;
#define SK_DPP(ctrl, rmask) ms += __builtin_bit_cast(float, __builtin_amdgcn_update_dpp(0, __builtin_bit_cast(int, ms), ctrl, rmask, 0xf, false))
                            SK_DPP(0x111, 0xf); SK_DPP(0x112, 0xf); SK_DPP(0x114, 0xf); SK_DPP(0x118, 0xf); SK_DPP(0x142, 0xa); SK_DPP(0x143, 0xc);
#undef SK_DPP
                            ms += run; run = __builtin_bit_cast(float, __builtin_amdgcn_readlane(__builtin_bit_cast(int, ms), 63));
                            nsk += __popcll(__ballot(in && ms <= 6.1035156e-5f)); }
                        if (lane == 0) MISC[17] = (unsigned)(nsk & ~1);
                    }
                    __syncthreads();
                    const int t0 = (int)MISC[17];
                    attn_body::attn_unit<8>(bh / attn_body::NHEAD, bh % attn_body::NHEAD, qb, t0, AT.Q, AT.K, AT.V, AT.O, AT.KA, (char*)lds_raw);
                    TP_END(2);
                    TP_BEGIN(3);
                    if (!cvdone) {
                        if (tid == 0) MISC[18] = atomicAdd(ctl + CW_CV, 16u);
                        __syncthreads();
                        const int tk = (int)MISC[18];
                        if (tk >= NCONV) cvdone = true;
                        else { const int t2 = ltid(), lane2 = t2 & 63, wid2 = __builtin_amdgcn_readfirstlane(t2 >> 6);
                            float* scr = lds + wid2 * (64 * 65);
                            _Pragma("clang loop unroll(disable)") for (int q2 = 0; q2 < 2; ++q2) { const int itc = tk + 8 * q2 + wid2; if (itc < NCONV) conv_item(itc, args.in[25], args.in[26], args.in[27], W13, W2, scr, lane2); } }
                        __syncthreads();
                    }
                    TP_END(3);
                    poll = true;
                }
            }
        }
        GRID_BAR();
        for (int rep_ = 0; rep_ < REP_F; ++rep_) {
            const int tid = ltid(), lane = tid & 63, wid = __builtin_amdgcn_readfirstlane(tid >> 6); (void)lane; (void)wid;
            pg8::Gemm g{MIXB, WOUT + (size_t)l * DM * DM, T, DM, DM}; pg8::StaticOrder S; S.init(T, DM, G, bx);
            pg8::EpiInProj E{YO, DM, 1.0f};
            pg8::gemm_phase<pg8::EpiInProj, pg8::StaticOrder, true, true>((PG8_LAS unsigned char*)lds_raw, g, S, E);
        }
        GRID_BAR();
        {
            const int tid = ltid(), lane = tid & 63, wid = __builtin_amdgcn_readfirstlane(tid >> 6); (void)lane; (void)wid;
            float alpha_o = ALPHA; asm volatile("" : "+v"(alpha_o));
            const float* g1 = args.in[17] + l * DM; const float* b1 = args.in[18] + l * DM;
            const float* bg = args.in[22] + l * 4; const float* be = args.in[24] + l * 32;
            unsigned* cnt = ctl + CW_CNT + 64 * 32 * l;
            const bf16* WRh = (const bf16*)(ws + WS_WR) + (size_t)l * 2 * 48 * 1024; const bf16* WRl = WRh + 48 * 1024;
            constexpr int XS = 1032;
            LAS unsigned short* XT = (LAS unsigned short*)lds_raw;
            LAS float* PART = (LAS float*)((LAS unsigned char*)lds_raw + 32 * XS * 2);
            LAS float* LG = PART + 8 * 32 * 48;
            LAS unsigned* LCNT = (LAS unsigned*)(LG + 128 * 48);
            if (tid < 32) LCNT[tid] = 0u;
            pg8::bf16x8 wh[4][3], wl[4][3];
#pragma unroll
            for (int s_ = 0; s_ < 4; ++s_)
#pragma unroll
                for (int nt = 0; nt < 3; ++nt) { const size_t o = (size_t)(16 * nt + (lane & 15)) * 1024 + 128 * wid + 32 * s_ + 8 * (lane >> 4);
                    wh[s_][nt] = *(const pg8::bf16x8*)(WRh + o); wl[s_][nt] = *(const pg8::bf16x8*)(WRl + o); }
            float gg[16], bb[16];
#pragma unroll
            for (int jq = 0; jq < 4; ++jq) { const f32x4 gv = *(const f32x4*)(g1 + jq * 256 + lane * 4), bv = *(const f32x4*)(b1 + jq * 256 + lane * 4);
#pragma unroll
                for (int e = 0; e < 4; ++e) { gg[jq * 4 + e] = gv[e]; bb[jq * 4 + e] = bv[e]; } }
            for (int ch = bx; ch < T / 128; ch += G) {
                for (int blk = 0; blk < 4; ++blk) {
                    const size_t m0 = (size_t)ch * 128 + blk * 32;
                    uint2 xw[4][4], yw[4][4];
#pragma unroll
                    for (int i = 0; i < 4; ++i) { const size_t m = m0 + wid * 4 + i;
#pragma unroll
                        for (int jq = 0; jq < 4; ++jq) { xw[i][jq] = *(const uint2*)(XB + m * DM + jq * 256 + lane * 4); yw[i][jq] = *(const uint2*)(YO + m * DM + jq * 256 + lane * 4); } }
#pragma unroll
                    for (int i = 0; i < 4; ++i) { const int tl = wid * 4 + i; const size_t m = m0 + tl;
                        float v[16]; float sm = 0.f;
#pragma unroll
                        for (int jq = 0; jq < 4; ++jq) { const uint2 a_ = xw[i][jq], c_ = yw[i][jq];
                            const f32x4 xv = (f32x4){__builtin_bit_cast(float, a_.x << 16), __builtin_bit_cast(float, a_.x & 0xffff0000u), __builtin_bit_cast(float, a_.y << 16), __builtin_bit_cast(float, a_.y & 0xffff0000u)};
                            const f32x4 yv = (f32x4){__builtin_bit_cast(float, c_.x << 16), __builtin_bit_cast(float, c_.x & 0xffff0000u), __builtin_bit_cast(float, c_.y << 16), __builtin_bit_cast(float, c_.y & 0xffff0000u)};
#pragma unroll
                            for (int e = 0; e < 4; ++e) { v[jq * 4 + e] = alpha_o * xv[e] + yv[e]; sm += v[jq * 4 + e]; } }
                        const float mean = wave_sum(sm) * (1.f / DM); float s2 = 0.f;
#pragma unroll
                        for (int q = 0; q < 16; ++q) { v[q] -= mean; s2 += v[q] * v[q]; }
                        const float rstd = 1.0f / sqrtf(wave_sum(s2) * (1.f / DM) + LN_EPS);
#pragma unroll
                        for (int jq = 0; jq < 4; ++jq) { unsigned hw[4]; float fo[4];
#pragma unroll
                            for (int e = 0; e < 4; ++e) { fo[e] = v[jq * 4 + e] * rstd * gg[jq * 4 + e] + bb[jq * 4 + e]; hw[e] = f2bf(fo[e]); }
                            *(unsigned*)(XB8 + m * DM + jq * 256 + lane * 4) = pk4_fp8(fo[0], fo[1], fo[2], fo[3]);
                            const ck::u32x2 pw = (ck::u32x2){hw[0] | (hw[1] << 16), hw[2] | (hw[3] << 16)};
                            *(uint2*)(XB + m * DM + jq * 256 + lane * 4) = make_uint2(pw.x, pw.y);
                            *(LAS ck::u32x2*)(XT + tl * XS + jq * 256 + lane * 4) = pw; }
                    }
                    __syncthreads();
                    {
                        pg8::f32x4 acc[2][3];
#pragma unroll
                        for (int mt = 0; mt < 2; ++mt)
#pragma unroll
                            for (int nt = 0; nt < 3; ++nt) acc[mt][nt] = pg8::f32x4{0.f, 0.f, 0.f, 0.f};
#pragma unroll
                        for (int s_ = 0; s_ < 4; ++s_)
#pragma unroll
                            for (int mt = 0; mt < 2; ++mt) { const pg8::bf16x8 ax = *(const LAS pg8::bf16x8*)(XT + (16 * mt + (lane & 15)) * XS + 128 * wid + 32 * s_ + 8 * (lane >> 4));
#pragma unroll
                                for (int nt = 0; nt < 3; ++nt) { acc[mt][nt] = __builtin_amdgcn_mfma_f32_16x16x32_bf16(ax, wh[s_][nt], acc[mt][nt], 0, 0, 0); acc[mt][nt] = __builtin_amdgcn_mfma_f32_16x16x32_bf16(ax, wl[s_][nt], acc[mt][nt], 0, 0, 0); } }
#pragma unroll
                        for (int mt = 0; mt < 2; ++mt)
#pragma unroll
                            for (int nt = 0; nt < 3; ++nt)
#pragma unroll
                                for (int r_ = 0; r_ < 4; ++r_) PART[(wid * 32 + 16 * mt + 4 * (lane >> 4) + r_) * 48 + 16 * nt + (lane & 15)] = acc[mt][nt][r_];
                    }
                    __syncthreads();
                    for (int p_ = tid; p_ < 32 * 48; p_ += NTHREADS) { float a_ = 0.f;
#pragma unroll
                        for (int w_ = 0; w_ < 8; ++w_) a_ += PART[w_ * 32 * 48 + p_];
                        LG[blk * 32 * 48 + p_] = a_; }
                }
                __syncthreads();
                int ex0 = 0, ex1 = 0; unsigned lp0 = 0, lp1 = 0;
                if (tid < 128) { const LAS float* lg = LG + tid * 48; const size_t m = (size_t)ch * 128 + tid;
                    int grp = 0; float gbest = lg[0] + bg[0];
#pragma unroll
                    for (int o = 1; o < 4; ++o) { const float gv = lg[o] + bg[o]; if (gv > gbest) { gbest = gv; grp = o; } }
                    float den = 0.f;
#pragma unroll
                    for (int o = 0; o < 4; ++o) den += expf(lg[o] + bg[o] - gbest);
                    const float ggate = 1.0f / den;
                    int i0 = 0; float v0 = lg[4 + grp * 8] + be[grp * 8];
                    for (int o = 1; o < 8; ++o) { const float ev = lg[4 + grp * 8 + o] + be[grp * 8 + o]; if (ev > v0) { v0 = ev; i0 = o; } }
                    int i1 = -1; float v1 = -INFINITY;
                    for (int o = 0; o < 8; ++o) { const float ev = lg[4 + grp * 8 + o] + be[grp * 8 + o]; if (o != i0 && (i1 < 0 || ev > v1)) { v1 = ev; i1 = o; } }
                    const float e1 = expf(v1 - v0); const float p0 = 1.0f / (1.0f + e1), p1 = e1 / (1.0f + e1);
                    ex0 = grp * 8 + i0; ex1 = grp * 8 + i1;
                    lp0 = atomicAdd((unsigned*)(LCNT + ex0), 1u); lp1 = atomicAdd((unsigned*)(LCNT + ex1), 1u);
                    GATE[2 * m] = ggate * p0; GATE[2 * m + 1] = ggate * p1;
                }
                __syncthreads();
                if (tid < 32) { const unsigned c_ = LCNT[tid]; LCNT[32 + tid] = c_ ? atomicAdd(cnt + 64 * tid, c_) : 0u; }
                __syncthreads();
                if (tid < 128) { const size_t m = (size_t)ch * 128 + tid; const int q0 = (int)(LCNT[32 + ex0] + lp0), q1 = (int)(LCNT[32 + ex1] + lp1); EP[2 * m] = (ex0 << 16) | q0; EP[2 * m + 1] = (ex1 << 16) | q1;
                                 int* LIST = (int*)(args.ws + WS_XP); LIST[ex0 * LCAP + q0] = (int)m; LIST[ex1 * LCAP + q1] = (int)m; }
                __syncthreads();
                if (tid < 32) LCNT[tid] = 0u;
            }
            {
                __syncthreads();
                TP_BEGIN(9);
                const int endl = (l + 1) * CV_L;
                for (;;) { if (tid == 0) MISC[18] = atomicAdd(ctl + CW_CV, 8u);
                    __syncthreads();
                    const int tk = (int)MISC[18];
                    if (tk + wid < NCONV) conv_item(tk + wid, args.in[25], args.in[26], args.in[27], W13, W2, lds + wid * (64 * 65), lane);
                    __syncthreads();
                    if (tk + 8 >= endl) break; }
                TP_END(9);
            }
        }
        GRID_BAR();
        for (int rep_ = 0; rep_ < REP_IJ; ++rep_) {
            const int tid = ltid(), lane = tid & 63, wid = __builtin_amdgcn_readfirstlane(tid >> 6); (void)lane; (void)wid;
            unsigned* cnt = ctl + CW_CNT + 64 * 32 * l;
            PG8_LAS int* tile_e = (PG8_LAS int*)((PG8_LAS unsigned char*)lds_raw + 131072); PG8_LAS int* tst = tile_e + MAXTILES;
            __syncthreads();
            PG8_LAS int* cntL = tst + NE + 1;
            if (tid < 64) { const int c_ = lane < NE ? (int)cnt[64 * lane] : 0; int v_ = (c_ + 255) >> 8;
#pragma unroll
                for (int o = 1; o < 32; o <<= 1) { const int n_ = __shfl_up(v_, o); if (lane >= o) v_ += n_; }
                if (lane < NE) { tst[lane + 1] = v_; cntL[lane] = c_; } if (lane == 0) tst[0] = 0; }
            __syncthreads();
            const int ntile = tst[NE];
            if (tid < ntile) { int e = 0; while (tst[e + 1] <= tid) ++e; tile_e[tid] = e; }
            __syncthreads();
            pg8::MoeOrder S{ntile, G, bx, tile_e};
            PG8_LAS unsigned* rowoff = (PG8_LAS unsigned*)((PG8_LAS unsigned char*)lds_raw + 133120);
            if (tid < 256) { int tk_[5]; const int* LIST = (const int*)(args.ws + WS_XP);
#pragma unroll
                for (int i = 0; i < 5; ++i) { const int L = i * G + bx; tk_[i] = 0;
                    if (L < ntile * 4) { const int rt = L >> 2, e = tile_e[rt], p_ = (rt - tst[e]) * 256 + tid; if (p_ < cntL[e]) tk_[i] = LIST[e * LCAP + p_]; } }
#pragma unroll
                for (int i = 0; i < 5; ++i) { rowoff[i * 256 + tid] = (unsigned)tk_[i] * (unsigned)DM;
                    const int L = i * G + bx; rowoff[1280 + i * 256 + tid] = (unsigned)(((L >> 2) * 256 + tid) * DE); } }
            __syncthreads();
            { pg8::Gemm g{(const pg8::bf16_t*)XB8, (const pg8::bf16_t*)(W13 + (size_t)l * NE * DM * DM), ntile * 256, DM, DM / 2}; pg8::EpiSwiGlu E{Hb, DE / 2, 1.0f / W13_SCALE};
              pg8::gemm_phase<pg8::EpiSwiGlu, pg8::MoeOrder, true, true, true, true>((PG8_LAS unsigned char*)lds_raw, g, S, E, rowoff); }
            GRID_BAR();
            { pg8::Gemm g{Hb, (const pg8::bf16_t*)((const unsigned char*)W2 + (size_t)l * NE * DM * DE), ntile * 256, DM, DE / 2}; pg8::EpiFp8Rows E{YP, DM / 2};
              pg8::gemm_phase<pg8::EpiFp8Rows, pg8::MoeOrder, true, true, true, true>((PG8_LAS unsigned char*)lds_raw, g, S, E, rowoff + 1280); }
        }
        GRID_BAR();
        for (int rep_ = 0; rep_ < REP_K; ++rep_) { float* Xo = (rep_ == REP_K - 1) ? X : (float*)(ws + WS_XP); bf16* XBo = (rep_ == REP_K - 1) ? XB : (bf16*)(ws + WS_H);
            const int tid = ltid(), lane = tid & 63, wid = __builtin_amdgcn_readfirstlane(tid >> 6); (void)lane; (void)wid;
            float alpha_o = ALPHA; asm volatile("" : "+v"(alpha_o));
            const float* g2 = args.in[19] + l * DM; const float* b2 = args.in[20] + l * DM;
            const bool doff = (l + 1 < DEPTH); const int ln = doff ? l + 1 : l;
            const float* wf = args.in[1] + (size_t)ln * DM * INW + O_FF; const float* fbias = args.in[2] + ln * 8;
            LAS f32x4* W4 = (LAS f32x4*)((LAS unsigned char*)lds_raw + 4096);
            __syncthreads();
            for (int q = tid; q < 40 * 64; q += NTHREADS) { const int row = q >> 6, ln_ = q & 63; f32x4 val;
                const int s4 = row & 3, col0 = (s4 >> 1) * 512 + ln_ * 8 + (s4 & 1) * 4;
                if (row < 32) { const int h = row >> 2;
#pragma unroll
                    for (int e = 0; e < 4; ++e) val[e] = wf[(size_t)(col0 + e) * INW + h]; }
                else if (row < 36) val = *(const f32x4*)(g2 + col0);
                else val = *(const f32x4*)(b2 + col0);
                W4[q] = val; }
            float* ffl = lds;
            const float fbk = lane < 8 ? fbias[lane] : 0.f;
            LAS int* poffK = (LAS int*)((LAS unsigned char*)lds_raw + 49152);
            if (tid < 64) { const unsigned* cnt = ctl + CW_CNT + 64 * 32 * l; const int pc_ = lane < NE ? ((((int)cnt[64 * lane] + 255) >> 8) << 8) : 0; int v_ = pc_;
#pragma unroll
                for (int o = 1; o < 32; o <<= 1) { const int n_ = __shfl_up(v_, o); if (lane >= o) v_ += n_; }
                if (lane < NE) poffK[lane] = v_ - pc_; }
            for (int ch = bx; ch < T / 128; ch += G) {
                __syncthreads();
                const size_t mw = (size_t)ch * 128 + wid * 16;
                const int eA = lane < 16 ? EP[2 * (mw + lane)] : 0, eB = lane < 16 ? EP[2 * (mw + lane) + 1] : 0; const int dA = poffK[eA >> 16] + (eA & 0xffff), dB = poffK[eB >> 16] + (eB & 0xffff);
                const float gA = lane < 16 ? GATE[2 * (mw + lane)] * (1.0f / W2_SCALE) : 0.f, gB = lane < 16 ? GATE[2 * (mw + lane) + 1] * (1.0f / W2_SCALE) : 0.f;
                uint2 xA[2][4], xB[2][4]; uint2 aA[2][2], aB[2][2], bA[2][2], bB[2][2]; float gA2[2][2], gB2[2][2];
#define K_LOAD(XS, WAS, WBS, GS, IEXP) _Pragma("unroll")                     for (int u = 0; u < 2; ++u) { const size_t m = mw + IEXP + u;                         const size_t da = (size_t)__builtin_amdgcn_readlane(dA, IEXP + u), db = (size_t)__builtin_amdgcn_readlane(dB, IEXP + u);                         GS[u][0] = __builtin_bit_cast(float, __builtin_amdgcn_readlane(__builtin_bit_cast(int, gA), IEXP + u)); GS[u][1] = __builtin_bit_cast(float, __builtin_amdgcn_readlane(__builtin_bit_cast(int, gB), IEXP + u)); _Pragma("unroll")                         for (int j2 = 0; j2 < 2; ++j2) { { const pg8::u32x4 xw_ = *(const pg8::u32x4*)(XB + m * DM + j2 * 512 + lane * 8); XS[u][2 * j2] = make_uint2(xw_.x, xw_.y); XS[u][2 * j2 + 1] = make_uint2(xw_.z, xw_.w); }                             { WAS[u][j2] = *(const uint2*)((const unsigned char*)YP + da * DM + j2 * 512 + lane * 8); WBS[u][j2] = *(const uint2*)((const unsigned char*)YP + db * DM + j2 * 512 + lane * 8); } } }
                { const int i = 0; K_LOAD(xA, aA, bA, gA2, i); }
#define K_PAIR(XS, WAS, WBS, GS, IB) do { float ov_[2][16]; _Pragma("unroll") for (int u = 0; u < 2; ++u) { const float ga = GS[u][0], gb = GS[u][1]; float s_ = 0.f; \
                        _Pragma("unroll") for (int jq = 0; jq < 4; ++jq) { const unsigned w0 = (jq & 1) ? WAS[u][jq >> 1].y : WAS[u][jq >> 1].x, w1 = (jq & 1) ? WBS[u][jq >> 1].y : WBS[u][jq >> 1].x; const uint2 wx = XS[u][jq]; \
                            const f32x4 xv = (f32x4){__builtin_bit_cast(float, wx.x << 16), __builtin_bit_cast(float, wx.x & 0xffff0000u), __builtin_bit_cast(float, wx.y << 16), __builtin_bit_cast(float, wx.y & 0xffff0000u)}; \
                            const f32x2hw a01 = __builtin_amdgcn_cvt_pk_f32_fp8((int)w0, false), a23 = __builtin_amdgcn_cvt_pk_f32_fp8((int)w0, true), b01 = __builtin_amdgcn_cvt_pk_f32_fp8((int)w1, false), b23 = __builtin_amdgcn_cvt_pk_f32_fp8((int)w1, true); \
                            const f32x4 ya = (f32x4){a01[0], a01[1], a23[0], a23[1]}; const f32x4 yb = (f32x4){b01[0], b01[1], b23[0], b23[1]}; \
                            _Pragma("unroll") for (int e = 0; e < 4; ++e) { ov_[u][jq * 4 + e] = alpha_o * xv[e] + (ga * ya[e] + gb * yb[e]); s_ += ov_[u][jq * 4 + e]; } } \
                        const float mean = wave_sum(s_) * (1.f / DM); float s2 = 0.f; \
                        _Pragma("unroll") for (int q = 0; q < 16; ++q) { ov_[u][q] -= mean; s2 += ov_[u][q] * ov_[u][q]; } \
                        const float rstd = 1.0f / sqrtf(wave_sum(s2) * (1.f / DM) + LN_EPS); \
                        _Pragma("unroll") for (int q = 0; q < 16; ++q) ov_[u][q] *= rstd; } \
                    { _Pragma("unroll") for (int jq = 0; jq < 4; ++jq) { const f32x4 gv_ = W4[(32 + jq) * 64 + lane], bv_ = W4[(36 + jq) * 64 + lane]; \
                        _Pragma("unroll") for (int u = 0; u < 2; ++u) _Pragma("unroll") for (int e = 0; e < 4; ++e) ov_[u][jq * 4 + e] = ov_[u][jq * 4 + e] * gv_[e] + bv_[e]; } \
                      _Pragma("unroll") for (int u = 0; u < 2; ++u) { const size_t m = mw + (IB) + u; \
                        _Pragma("unroll") for (int j2 = 0; j2 < 2; ++j2) { \
                            if (!doff) { *(f32x4*)(Xo + m * DM + j2 * 512 + lane * 8) = (f32x4){ov_[u][8 * j2], ov_[u][8 * j2 + 1], ov_[u][8 * j2 + 2], ov_[u][8 * j2 + 3]}; *(f32x4*)(Xo + m * DM + j2 * 512 + lane * 8 + 4) = (f32x4){ov_[u][8 * j2 + 4], ov_[u][8 * j2 + 5], ov_[u][8 * j2 + 6], ov_[u][8 * j2 + 7]}; } \
                            if (doff) *(pg8::u32x4*)(XBo + m * DM + j2 * 512 + lane * 8) = (pg8::u32x4){pk2(ov_[u][8 * j2], ov_[u][8 * j2 + 1]), pk2(ov_[u][8 * j2 + 2], ov_[u][8 * j2 + 3]), pk2(ov_[u][8 * j2 + 4], ov_[u][8 * j2 + 5]), pk2(ov_[u][8 * j2 + 6], ov_[u][8 * j2 + 7])}; \
                            if (l + 1 == INPROJ_FP8_FROM) *(uint2*)((args.ws + WS_XA8) + m * DM + j2 * 512 + lane * 8) = make_uint2(pk4_fp8(ov_[u][8 * j2], ov_[u][8 * j2 + 1], ov_[u][8 * j2 + 2], ov_[u][8 * j2 + 3]), pk4_fp8(ov_[u][8 * j2 + 4], ov_[u][8 * j2 + 5], ov_[u][8 * j2 + 6], ov_[u][8 * j2 + 7])); } } } \
                    if (doff) { _Pragma("unroll") for (int hb = 0; hb < 2; ++hb) { float acc_[2][4]; _Pragma("unroll") for (int u = 0; u < 2; ++u) _Pragma("unroll") for (int h = 0; h < 4; ++h) acc_[u][h] = 0.f; \
                        _Pragma("unroll") for (int jq = 0; jq < 4; ++jq) { f32x4 wv_[4]; _Pragma("unroll") for (int h = 0; h < 4; ++h) wv_[h] = W4[((4 * hb + h) * 4 + jq) * 64 + lane]; \
                            _Pragma("unroll") for (int u = 0; u < 2; ++u) _Pragma("unroll") for (int h = 0; h < 4; ++h) \
                                acc_[u][h] += (ov_[u][jq * 4] * wv_[h][0] + ov_[u][jq * 4 + 1] * wv_[h][1]) + (ov_[u][jq * 4 + 2] * wv_[h][2] + ov_[u][jq * 4 + 3] * wv_[h][3]); } \
                        _Pragma("unroll") for (int u = 0; u < 2; ++u) { const int tl = wid * 16 + (IB) + u; \
                            _Pragma("unroll") for (int h = 0; h < 4; ++h) acc_[u][h] = wave_sum(acc_[u][h]); \
                            if ((lane >> 2) == hb) { float fv = acc_[u][0]; _Pragma("unroll") for (int h = 1; h < 4; ++h) fv = ((lane & 3) == h) ? acc_[u][h] : fv; ffl[tl * 8 + lane] = fv + fbk; } } } } } while (0)
                for (int i = 0; i < 16; i += 4) {
                    { const int i1 = i + 2; K_LOAD(xB, aB, bB, gB2, i1); }
                    K_PAIR(xA, aA, bA, gA2, i);
                    if (i + 4 < 16) { const int i2 = i + 4; K_LOAD(xA, aA, bA, gA2, i2); }
                    K_PAIR(xB, aB, bB, gB2, i + 2);
                }
#undef K_PAIR
#undef K_LOAD
                __syncthreads();
                if (doff) {
                    const int h = wid; const int bb = (ch * 128) / SEQ, t0 = (ch * 128) % SEQ; double carry = 0.0;
#pragma unroll
                    for (int half = 0; half < 2; ++half) { double vv = (double)logsigmoidf_(ffl[(half * 64 + lane) * 8 + h]);
#pragma unroll
                        for (int o = 1; o < 64; o <<= 1) { const double n = __shfl_up(vv, o); if (lane >= o) vv += n; }
                        vv += carry; LCS[(size_t)(bb * 8 + h) * SEQ + t0 + half * 64 + lane] = vv; carry = __shfl(vv, 63); }
                    if (lane == 0) TOT[(bb * 8 + h) * 128 + t0 / 128] = carry;
                }
            }
        }
        if (l + 1 < DEPTH) GRID_BAR();
    }
    if (TPROBE_SEL != 0) { unsigned long long* tsum = (unsigned long long*)(ctl + 200000);
        if (ltid() == 0) atomicAdd(tsum, tp_acc);
        xcd_barrier(bar);
        if (bx == 0 && ltid() == 0) { const unsigned long long tot = __hip_atomic_load(tsum, __ATOMIC_RELAXED, __HIP_MEMORY_SCOPE_AGENT); const unsigned long long waitt = tot * TPROBE_MULT / 256ull; const unsigned long long te = __builtin_amdgcn_s_memrealtime();
            while (__builtin_amdgcn_s_memrealtime() - te < waitt) __builtin_amdgcn_s_sleep(8); } }
}

extern "C" void kernel_launch(void* const* d_in, const int* in_sizes, int n_in, void* d_out, int out_size, void* d_ws, size_t ws_size, hipStream_t stream) {
    static int grid = 0;
    if (grid == 0) {
        if (n_in != 28 || out_size != T * DM || ws_size < WS_END) { fprintf(stderr, "kernel_launch: unexpected shapes (n_in %d out %d ws %zu)\n", n_in, out_size, ws_size); grid = -1; return; }
        int dev = 0, cus = 0, per_cu = 0;
        (void)hipGetDevice(&dev); (void)hipDeviceGetAttribute(&cus, hipDeviceAttributeMultiprocessorCount, dev);
        (void)hipFuncSetAttribute((const void*)mk_fwd, hipFuncAttributeMaxDynamicSharedMemorySize, LDS_ALL);
        if (hipOccupancyMaxActiveBlocksPerMultiprocessor(&per_cu, (const void*)mk_fwd, NTHREADS, LDS_ALL) != hipSuccess || per_cu < 1) fprintf(stderr, "kernel_launch: occupancy query says %d blocks per CU\n", per_cu);
        (void)hipGetLastError();
        grid = cus > 0 ? cus : 256;
        if (grid != 256) fprintf(stderr, "kernel_launch: %d CUs (built for 256)\n", grid);
    }
    if (grid < 0) return;
    (void)hipMemsetAsync((char*)d_ws + WS_CTL, 0, CTL_BYTES, stream);
    Args a{};
    for (int i = 0; i < 28; ++i) a.in[i] = (const float*)d_in[i];
    a.out = (float*)d_out; a.ws = (unsigned char*)d_ws;
    hipLaunchKernelGGL(mk_fwd, dim3(grid), dim3(NTHREADS), LDS_ALL, stream, a);
}
```
